# Optimizing an MI355X kernel written in HIP

```python
import math
import jax, jax.numpy as jnp
from jax import lax
import numpy as np

D_MODEL = 1024
BATCH = 4
SEQ = 4096
DEPTH = 1

MEM_LEN = 256
EPS = 1e-6
ATTN_BLOCK = 128
MLA_HEADS = 8
MLA_NOPE = 64
MLA_ROPE = 32
MLA_V = 64
MLA_Q_RANK = 384
MLA_KV_RANK = 256
ROPE_THETA = 10000.0
DIL_HEADS = 8
DIL_HEAD_DIM = 64
DIL_CONFIGS = ((128, 1), (512, 4), (2048, 16))
MLA_WIDTH = MLA_HEADS * MLA_V
DIL_WIDTH = DIL_HEADS * DIL_HEAD_DIM
MIX_WIDTH = MLA_WIDTH + DIL_WIDTH
IN_COLS = MLA_Q_RANK + MLA_KV_RANK + MLA_ROPE + 3 * DIL_WIDTH
MEM_HEADS = 4
MEM_HEAD_DIM = D_MODEL // MEM_HEADS
PEER_HEADS = 8
PEER_KEYS = 128
PEER_N = PEER_KEYS * PEER_KEYS
PEER_QDIM = 256
PEER_TOPK = 16
PEER_CHUNK = 128

kernel_name = 'hybrid_mla_dilated_peer_block'


def rms_norm(x, g):
    xf = x.astype(jnp.float32)
    y = xf * lax.rsqrt(jnp.mean(xf * xf, axis=-1, keepdims=True) + EPS)
    return (y * g.astype(jnp.float32)).astype(x.dtype)


def alibi_slopes(n):
    return jnp.exp2(-8.0 * jnp.arange(1, n + 1, dtype=jnp.float32) / n)


def rope_tables(seq, dim):
    inv = 1.0 / (ROPE_THETA ** (jnp.arange(0, dim, 2, dtype=jnp.float32) / dim))
    ang = jnp.arange(seq, dtype=jnp.float32)[:, None] * inv[None, :]
    return jnp.cos(ang), jnp.sin(ang)


def apply_rope(x, cos, sin):
    x1, x2 = jnp.split(x.astype(jnp.float32), 2, axis=-1)
    return jnp.concatenate([x1 * cos - x2 * sin, x2 * cos + x1 * sin], axis=-1).astype(x.dtype)


def mla_attention(c_q, c_kv, k_rope, q_norm, kv_norm, w_uq, w_ukv):
    B, S, _ = c_q.shape
    H, dqk = MLA_HEADS, MLA_NOPE + MLA_ROPE
    q = (rms_norm(c_q, q_norm) @ w_uq).reshape(B, S, H, dqk)
    kv = (rms_norm(c_kv, kv_norm) @ w_ukv).reshape(B, S, H, MLA_NOPE + MLA_V)
    k_nope, v = kv[..., :MLA_NOPE], kv[..., MLA_NOPE:]
    cos, sin = rope_tables(S, MLA_ROPE)
    q_rope = apply_rope(q[..., MLA_NOPE:], cos[:, None], sin[:, None])
    k_rope = apply_rope(k_rope, cos, sin)
    q = jnp.concatenate([q[..., :MLA_NOPE], q_rope], axis=-1)
    k = jnp.concatenate([k_nope, jnp.broadcast_to(k_rope[:, :, None, :], (B, S, H, MLA_ROPE))], axis=-1)
    scale = dqk ** -0.5
    nb = S // ATTN_BLOCK
    q_blocks = q.reshape(B, nb, ATTN_BLOCK, H, dqk).transpose(1, 0, 2, 3, 4)
    key_pos = jnp.arange(S)

    def attend(args):
        qb, n = args
        s = jnp.einsum('bqhd,bkhd->bhqk', qb, k).astype(jnp.float32) * scale
        q_pos = n * ATTN_BLOCK + jnp.arange(ATTN_BLOCK)
        s = jnp.where(key_pos[None, :] <= q_pos[:, None], s, -jnp.inf)
        p = jax.nn.softmax(s, axis=-1).astype(v.dtype)
        return jnp.einsum('bhqk,bkhd->bqhd', p, v)

    o = lax.map(attend, (q_blocks, jnp.arange(nb)))
    return o.transpose(1, 0, 2, 3, 4).reshape(B, S, H * MLA_V)


def dilated_branch(q, k, v, window, dilation, slopes):
    B, S, H, Dh = q.shape
    W = window // dilation
    L = S // dilation
    nb = -(-L // W)
    Lp = nb * W

    def to_sub(t):
        t = t.reshape(B, L, dilation, H, Dh).transpose(0, 2, 3, 1, 4)
        return jnp.pad(t, ((0, 0), (0, 0), (0, 0), (0, Lp - L), (0, 0)))

    def band(t):
        tp = jnp.pad(t, ((0, 0), (0, 0), (0, 0), (W, 0), (0, 0)))
        prev = tp[..., :Lp, :].reshape(B, dilation, H, nb, W, Dh)
        cur = t.reshape(B, dilation, H, nb, W, Dh)
        return jnp.concatenate([prev, cur], axis=4)

    qs, ks, vs = to_sub(q), to_sub(k), to_sub(v)
    qb = qs.reshape(B, dilation, H, nb, W, Dh)
    kb, vb = band(ks), band(vs)
    s = jnp.einsum('brhnqd,brhnkd->brhnqk', qb, kb).astype(jnp.float32) * (Dh ** -0.5)
    qi = jnp.arange(W)[:, None]
    kj = jnp.arange(2 * W)[None, :]
    steps = W + qi - kj
    blk = jnp.arange(nb)[:, None, None]
    valid = (steps >= 0) & (steps <= W) & ((blk > 0) | (kj >= W))
    bias = -slopes[:, None, None, None] * (steps * dilation).astype(jnp.float32)
    s = jnp.where(valid, s + bias, -jnp.inf)
    lse = jax.nn.logsumexp(s, axis=-1)
    p = jnp.exp(s - lse[..., None]).astype(v.dtype)
    o = jnp.einsum('brhnqk,brhnkd->brhnqd', p, vb)
    o = o.reshape(B, dilation, H, Lp, Dh)[:, :, :, :L].transpose(0, 3, 1, 2, 4).reshape(B, S, H, Dh)
    lse = lse.reshape(B, dilation, H, Lp)[:, :, :, :L].transpose(0, 3, 1, 2).reshape(B, S, H)
    return o, lse


def dilated_attention(q, k, v):
    B, S, H, Dh = q.shape
    slopes = alibi_slopes(H)
    results = [dilated_branch(q, k, v, w, d, slopes) for (w, d) in DIL_CONFIGS]
    outs = jnp.stack([r[0] for r in results], axis=0)
    lses = jnp.stack([r[1] for r in results], axis=0)
    wts = jax.nn.softmax(lses, axis=0).astype(outs.dtype)
    o = jnp.einsum('gbsh,gbshd->bshd', wts, outs)
    return o.reshape(B, S, H * Dh)


def memory_attention(hn, memn, w_q, w_kv, w_o):
    B, S, _ = hn.shape
    M = memn.shape[1]
    q = (hn @ w_q).reshape(B, S, MEM_HEADS, MEM_HEAD_DIM)
    kv = (memn @ w_kv).reshape(B, M, 2, MEM_HEADS, MEM_HEAD_DIM)
    k, v = kv[:, :, 0], kv[:, :, 1]
    s = jnp.einsum('bshd,bmhd->bhsm', q, k).astype(jnp.float32) * (MEM_HEAD_DIM ** -0.5)
    p = jax.nn.softmax(s, axis=-1).astype(v.dtype)
    o = jnp.einsum('bhsm,bmhd->bshd', p, v).reshape(B, S, MEM_HEADS * MEM_HEAD_DIM)
    return o @ w_o


def peer_ffn(xn, w_q, sub_keys, u_tab, v_tab):
    B, S, D = xn.shape
    C, Hh, K = PEER_CHUNK, PEER_HEADS, PEER_TOPK
    half = PEER_QDIM // 2
    xt = xn.reshape((B * S) // C, C, D)

    def chunk(xc):
        q = (xc @ w_q).reshape(C, Hh, 2, half).astype(jnp.float32)
        s = jnp.einsum('chpd,hpnd->chpn', q, sub_keys.astype(jnp.float32))
        top_s, top_i = lax.top_k(s, K)
        cand = top_s[:, :, 0, :, None] + top_s[:, :, 1, None, :]
        best_s, best_j = lax.top_k(cand.reshape(C, Hh, K * K), K)
        ia = jnp.take_along_axis(top_i[:, :, 0], best_j // K, axis=-1)
        ib = jnp.take_along_axis(top_i[:, :, 1], best_j % K, axis=-1)
        expert = ia * PEER_KEYS + ib
        g = jax.nn.softmax(best_s, axis=-1)
        u = u_tab[expert]
        a = jax.nn.gelu(jnp.einsum('cd,chkd->chk', xc, u).astype(jnp.float32), approximate=False)
        coeff = (g * a).astype(xc.dtype)
        return jnp.einsum('chk,chkd->cd', coeff, v_tab[expert])

    return lax.map(chunk, xt).reshape(B, S, D)


def setup_inputs(seed: int = 0) -> dict:
    key = jax.random.key(seed)
    ks = jax.random.split(key, 22)
    f32 = jnp.float32

    def nrm(k, shape, scale):
        return jax.random.normal(k, shape, f32) * scale

    def gain(k, shape):
        return 1.0 + 0.02 * jax.random.normal(k, shape, f32)

    L = DEPTH
    return {
        'x': nrm(ks[0], (BATCH, SEQ, D_MODEL), 1.0),
        'mem': nrm(ks[1], (BATCH, MEM_LEN, D_MODEL), 1.0),
        'norm_mix': gain(ks[2], (L, D_MODEL)),
        'w_in': nrm(ks[3], (L, D_MODEL, IN_COLS), D_MODEL ** -0.5),
        'mla_q_norm': gain(ks[4], (L, MLA_Q_RANK)),
        'mla_kv_norm': gain(ks[5], (L, MLA_KV_RANK)),
        'mla_w_uq': nrm(ks[6], (L, MLA_Q_RANK, MLA_HEADS * (MLA_NOPE + MLA_ROPE)), MLA_Q_RANK ** -0.5),
        'mla_w_ukv': nrm(ks[7], (L, MLA_KV_RANK, MLA_HEADS * (MLA_NOPE + MLA_V)), MLA_KV_RANK ** -0.5),
        'grp_norm_mla': gain(ks[8], (L, MLA_WIDTH)),
        'grp_norm_dil': gain(ks[9], (L, DIL_WIDTH)),
        'w_out': nrm(ks[10], (L, MIX_WIDTH, D_MODEL), MIX_WIDTH ** -0.5),
        'norm_mem_q': gain(ks[11], (L, D_MODEL)),
        'norm_mem_kv': gain(ks[12], (L, D_MODEL)),
        'w_mem_q': nrm(ks[13], (L, D_MODEL, MEM_HEADS * MEM_HEAD_DIM), D_MODEL ** -0.5),
        'w_mem_kv': nrm(ks[14], (L, D_MODEL, 2 * MEM_HEADS * MEM_HEAD_DIM), D_MODEL ** -0.5),
        'w_mem_o': nrm(ks[15], (L, MEM_HEADS * MEM_HEAD_DIM, D_MODEL), D_MODEL ** -0.5),
        'norm_ffn': gain(ks[16], (L, D_MODEL)),
        'peer_w_q': nrm(ks[17], (L, D_MODEL, PEER_HEADS * PEER_QDIM), D_MODEL ** -0.5),
        'peer_sub_keys': nrm(ks[18], (L, PEER_HEADS, 2, PEER_KEYS, PEER_QDIM // 2), (PEER_QDIM // 2) ** -0.5),
        'peer_u': nrm(ks[19], (L, PEER_N, D_MODEL), D_MODEL ** -0.5),
        'peer_v': nrm(ks[20], (L, PEER_N, D_MODEL), PEER_HEADS ** -0.5),
        'norm_final': gain(ks[21], (D_MODEL,)),
    }


def reference(x, mem, norm_mix, w_in, mla_q_norm, mla_kv_norm, mla_w_uq, mla_w_ukv,
              grp_norm_mla, grp_norm_dil, w_out, norm_mem_q, norm_mem_kv, w_mem_q, w_mem_kv,
              w_mem_o, norm_ffn, peer_w_q, peer_sub_keys, peer_u, peer_v, norm_final):
    B, S, _ = x.shape
    o1 = MLA_Q_RANK
    o2 = o1 + MLA_KV_RANK
    o3 = o2 + MLA_ROPE
    o4 = o3 + DIL_WIDTH
    o5 = o4 + DIL_WIDTH
    h = x
    for l in range(DEPTH):
        proj = rms_norm(h, norm_mix[l]) @ w_in[l]
        c_q, c_kv, k_rope, dq, dk, dv = jnp.split(proj, [o1, o2, o3, o4, o5], axis=-1)
        o_mla = mla_attention(c_q, c_kv, k_rope, mla_q_norm[l], mla_kv_norm[l], mla_w_uq[l], mla_w_ukv[l])
        dshape = (B, S, DIL_HEADS, DIL_HEAD_DIM)
        o_dil = dilated_attention(dq.reshape(dshape), dk.reshape(dshape), dv.reshape(dshape))
        mixed = jnp.concatenate([rms_norm(o_mla, grp_norm_mla[l]), rms_norm(o_dil, grp_norm_dil[l])], axis=-1)
        h = h + mixed @ w_out[l]
        h = h + memory_attention(rms_norm(h, norm_mem_q[l]), rms_norm(mem, norm_mem_kv[l]),
                                 w_mem_q[l], w_mem_kv[l], w_mem_o[l])
        h = h + peer_ffn(rms_norm(h, norm_ffn[l]), peer_w_q[l], peer_sub_keys[l], peer_u[l], peer_v[l])
    return rms_norm(h, norm_final)
```

```cpp
#include <hip/hip_runtime.h>
#include <hip/hip_cooperative_groups.h>
#include <math.h>
#include <stdint.h>
#include <stdio.h>
namespace nv {

struct RopeInv { float v[16]; };

__global__ void k_rope_table(float* cs, RopeInv inv) {
    int idx = blockIdx.x * blockDim.x + threadIdx.x;
    int s = idx >> 4, i = idx & 15;
    float ang = (float)s * inv.v[i];
    double a = (double)ang;
    const double twopi = 6.283185307179586476925;
    double r = a - twopi * rint(a / twopi);
    float rf = (float)r;
    cs[idx] = cosf(rf);
    cs[65536 + idx] = sinf(rf);
}

__global__ void __launch_bounds__(256) k_rmsnorm(const float* in, int ldi, const float* g, float* out, int ldo, int R, int C) {
    int row = blockIdx.x * 4 + (threadIdx.x >> 6);
    int lane = threadIdx.x & 63;
    if (row >= R) return;
    const float* p = in + (size_t)row * ldi;
    float ss = 0.f;
    for (int c = lane; c < C; c += 64) { float v = p[c]; ss += v * v; }
    for (int o = 32; o; o >>= 1) ss += __shfl_xor(ss, o);
    float rs = rsqrtf(ss / (float)C + 1e-6f);
    float* q = out + (size_t)row * ldo;
    for (int c = lane; c < C; c += 64) q[c] = p[c] * rs * g[c];
}

template <bool TB>
__global__ void __launch_bounds__(256) k_gemm(const float* A, int lda, const float* W, int ldw, float* C, int ldc,
                                              const float* R, int ldr, int M, int N, int K) {
    __shared__ float As[16][65];
    __shared__ float Ws[16][65];
    const int tx = threadIdx.x & 15, ty = threadIdx.x >> 4;
    const int m0 = blockIdx.y * 64, n0 = blockIdx.x * 64;
    float acc[4][4];
#pragma unroll
    for (int i = 0; i < 4; ++i)
#pragma unroll
        for (int j = 0; j < 4; ++j) acc[i][j] = 0.f;
    for (int k0 = 0; k0 < K; k0 += 16) {
        for (int i = threadIdx.x; i < 1024; i += 256) {
            int m = i >> 4, k = i & 15;
            As[k][m] = (m0 + m < M) ? A[(size_t)(m0 + m) * lda + k0 + k] : 0.f;
        }
        if (TB) {
            for (int i = threadIdx.x; i < 1024; i += 256) {
                int n = i >> 4, k = i & 15;
                Ws[k][n] = (n0 + n < N) ? W[(size_t)(n0 + n) * ldw + k0 + k] : 0.f;
            }
        } else {
            for (int i = threadIdx.x; i < 1024; i += 256) {
                int k = i >> 6, n = i & 63;
                Ws[k][n] = (n0 + n < N) ? W[(size_t)(k0 + k) * ldw + n0 + n] : 0.f;
            }
        }
        __syncthreads();
#pragma unroll
        for (int k = 0; k < 16; ++k) {
            float a[4], w[4];
#pragma unroll
            for (int i = 0; i < 4; ++i) a[i] = As[k][ty * 4 + i];
#pragma unroll
            for (int j = 0; j < 4; ++j) w[j] = Ws[k][tx * 4 + j];
#pragma unroll
            for (int i = 0; i < 4; ++i)
#pragma unroll
                for (int j = 0; j < 4; ++j) acc[i][j] += a[i] * w[j];
        }
        __syncthreads();
    }
#pragma unroll
    for (int i = 0; i < 4; ++i)
#pragma unroll
        for (int j = 0; j < 4; ++j) {
            int m = m0 + ty * 4 + i, n = n0 + tx * 4 + j;
            if (m < M && n < N) {
                float v = acc[i][j];
                if (R) v += R[(size_t)m * ldr + n];
                C[(size_t)m * ldc + n] = v;
            }
        }
}

__global__ void k_rope_apply(float* q, const float* proj, float* kr, const float* cs, int Tb) {
    int idx = blockIdx.x * blockDim.x + threadIdx.x;
    if (idx >= Tb * 9 * 16) return;
    int i = idx & 15, hh = (idx >> 4) % 9, t = idx / (9 * 16);
    float c = cs[t * 16 + i], s = cs[65536 + t * 16 + i];
    if (hh < 8) {
        float* p = q + (size_t)t * 768 + hh * 96 + 64;
        float x1 = p[i], x2 = p[16 + i];
        p[i] = x1 * c - x2 * s;
        p[16 + i] = x2 * c + x1 * s;
    } else {
        const float* p = proj + (size_t)t * 2208 + 640;
        float x1 = p[i], x2 = p[16 + i];
        kr[t * 32 + i] = x1 * c - x2 * s;
        kr[t * 32 + 16 + i] = x2 * c + x1 * s;
    }
}

__global__ void __launch_bounds__(64) k_mla_attn(const float* q, const float* kv, const float* kr, float* o, int ldo) {
    const int h = blockIdx.y, t = blockIdx.x * 64 + threadIdx.x;
    const float scale = 0.10206207261596575f;
    float qv[96], ov[64];
#pragma unroll
    for (int i = 0; i < 96; ++i) qv[i] = q[(size_t)t * 768 + h * 96 + i] * scale;
#pragma unroll
    for (int i = 0; i < 64; ++i) ov[i] = 0.f;
    float m = -INFINITY, l = 0.f;
    const int tmax = blockIdx.x * 64 + 63;
    for (int j = 0; j <= tmax; ++j) {
        const float* kn = kv + (size_t)j * 1024 + h * 128;
        const float* krj = kr + (size_t)j * 32;
        float s = 0.f;
#pragma unroll
        for (int i = 0; i < 64; ++i) s += qv[i] * kn[i];
#pragma unroll
        for (int i = 0; i < 32; ++i) s += qv[64 + i] * krj[i];
        if (j <= t) {
            float mn = fmaxf(m, s);
            float a = __expf(m - mn), p = __expf(s - mn);
            l = l * a + p;
#pragma unroll
            for (int d = 0; d < 64; ++d) ov[d] = ov[d] * a + p * kn[64 + d];
            m = mn;
        }
    }
    float inv = 1.f / l;
#pragma unroll
    for (int d = 0; d < 64; ++d) o[(size_t)t * ldo + h * 64 + d] = ov[d] * inv;
}

__global__ void __launch_bounds__(64) k_dil_attn(const float* proj, float* o, int ldo) {
    const int h = blockIdx.y, t = blockIdx.x * 64 + threadIdx.x;
    float qv[64], ov[64];
#pragma unroll
    for (int i = 0; i < 64; ++i) qv[i] = proj[(size_t)t * 2208 + 672 + h * 64 + i] * 0.125f;
#pragma unroll
    for (int i = 0; i < 64; ++i) ov[i] = 0.f;
    float m = -INFINITY, l = 0.f;
    const float slope = exp2f(-(float)(h + 1));
    for (int g = 0; g < 3; ++g) {
        const int d = (g == 0) ? 1 : (g == 1 ? 4 : 16);
        for (int j = 0; j <= 128; ++j) {
            int pos = t - j * d;
            if (pos >= 0) {
                const float* kp = proj + (size_t)pos * 2208 + 1184 + h * 64;
                const float* vp = proj + (size_t)pos * 2208 + 1696 + h * 64;
                float s = 0.f;
#pragma unroll
                for (int i = 0; i < 64; ++i) s += qv[i] * kp[i];
                s -= slope * (float)(j * d);
                float mn = fmaxf(m, s);
                float a = __expf(m - mn), p = __expf(s - mn);
                l = l * a + p;
#pragma unroll
                for (int dd = 0; dd < 64; ++dd) ov[dd] = ov[dd] * a + p * vp[dd];
                m = mn;
            }
        }
    }
    float inv = 1.f / l;
#pragma unroll
    for (int dd = 0; dd < 64; ++dd) o[(size_t)t * ldo + h * 64 + dd] = ov[dd] * inv;
}

__global__ void __launch_bounds__(256) k_softmax256(float* s, int R, float scale) {
    int row = blockIdx.x * 4 + (threadIdx.x >> 6);
    int lane = threadIdx.x & 63;
    if (row >= R) return;
    float* p = s + (size_t)row * 256;
    float v[4];
    float mx = -INFINITY;
#pragma unroll
    for (int i = 0; i < 4; ++i) { v[i] = p[lane + 64 * i] * scale; mx = fmaxf(mx, v[i]); }
    for (int o = 32; o; o >>= 1) mx = fmaxf(mx, __shfl_xor(mx, o));
    float sum = 0.f;
#pragma unroll
    for (int i = 0; i < 4; ++i) { v[i] = __expf(v[i] - mx); sum += v[i]; }
    for (int o = 32; o; o >>= 1) sum += __shfl_xor(sum, o);
    float inv = 1.f / sum;
#pragma unroll
    for (int i = 0; i < 4; ++i) p[lane + 64 * i] = v[i] * inv;
}

__global__ void __launch_bounds__(256) k_peer(const float* sc, const float* xn, const float* utab, const float* vtab,
                                              const float* gfinal, float* hio, int Tb) {
    __shared__ float tS[4][16][16];
    __shared__ int tI[4][16][16];
    __shared__ float eG[4][128];
    __shared__ int eI[4][128];
    const int w = threadIdx.x >> 6, lane = threadIdx.x & 63;
    const int t = blockIdx.x * 4 + w;
    if (lane < 16) {
        const float* s = sc + (size_t)t * 2048 + lane * 128;
        float pv = INFINITY; int pi = -1;
        for (int r = 0; r < 16; ++r) {
            float bv = -INFINITY; int bi = -1;
            for (int n = 0; n < 128; ++n) {
                float v = s[n];
                bool elig = (v < pv) || (v == pv && n > pi);
                if (elig && v > bv) { bv = v; bi = n; }
            }
            tS[w][lane][r] = bv; tI[w][lane][r] = bi;
            pv = bv; pi = bi;
        }
    }
    __syncthreads();
    if (lane < 8) {
        const int h = lane;
        float pv = INFINITY; int pj = -1;
        float bs[16];
        float mx = 0.f;
        for (int r = 0; r < 16; ++r) {
            float bv = -INFINITY; int bj = -1;
            for (int j = 0; j < 256; ++j) {
                float v = tS[w][2 * h][j >> 4] + tS[w][2 * h + 1][j & 15];
                bool elig = (v < pv) || (v == pv && j > pj);
                if (elig && v > bv) { bv = v; bj = j; }
            }
            if (r == 0) mx = bv;
            eG[w][h * 16 + r] = bv;
            eI[w][h * 16 + r] = tI[w][2 * h][bj >> 4] * 128 + tI[w][2 * h + 1][bj & 15];
            pv = bv; pj = bj;
        }
        float sum = 0.f;
        for (int r = 0; r < 16; ++r) { float e = __expf(eG[w][h * 16 + r] - mx); eG[w][h * 16 + r] = e; sum += e; }
        float inv = 1.f / sum;
        for (int r = 0; r < 16; ++r) eG[w][h * 16 + r] *= inv;
        (void)bs;
    }
    __syncthreads();
    float xv[16], acc[16];
#pragma unroll
    for (int i = 0; i < 16; ++i) { xv[i] = xn[(size_t)t * 1024 + lane + 64 * i]; acc[i] = 0.f; }
    for (int e = 0; e < 128; ++e) {
        const int id = eI[w][e];
        const float g = eG[w][e];
        const float* up = utab + (size_t)id * 1024;
        const float* vp = vtab + (size_t)id * 1024;
        float d = 0.f;
#pragma unroll
        for (int i = 0; i < 16; ++i) d += xv[i] * up[lane + 64 * i];
        for (int o = 32; o; o >>= 1) d += __shfl_xor(d, o);
        float a = 0.5f * d * (1.f + erff(d * 0.70710678118654752f));
        float c = g * a;
#pragma unroll
        for (int i = 0; i < 16; ++i) acc[i] += c * vp[lane + 64 * i];
    }
    float* hp = hio + (size_t)t * 1024;
    float ss = 0.f;
#pragma unroll
    for (int i = 0; i < 16; ++i) { acc[i] += hp[lane + 64 * i]; ss += acc[i] * acc[i]; }
    for (int o = 32; o; o >>= 1) ss += __shfl_xor(ss, o);
    float rs = rsqrtf(ss / 1024.f + 1e-6f);
#pragma unroll
    for (int i = 0; i < 16; ++i) hp[lane + 64 * i] = acc[i] * rs * gfinal[lane + 64 * i];
}

}
static void naive_forward(void* const* d_in, float* out, float* ws, hipStream_t st) {
    const float* x = (const float*)d_in[0];
    const float* mem = (const float*)d_in[1];
    const float* norm_mix = (const float*)d_in[2];
    const float* w_in = (const float*)d_in[3];
    const float* q_norm = (const float*)d_in[4];
    const float* kv_norm = (const float*)d_in[5];
    const float* w_uq = (const float*)d_in[6];
    const float* w_ukv = (const float*)d_in[7];
    const float* gn_mla = (const float*)d_in[8];
    const float* gn_dil = (const float*)d_in[9];
    const float* w_out = (const float*)d_in[10];
    const float* norm_mem_q = (const float*)d_in[11];
    const float* norm_mem_kv = (const float*)d_in[12];
    const float* w_mem_q = (const float*)d_in[13];
    const float* w_mem_kv = (const float*)d_in[14];
    const float* w_mem_o = (const float*)d_in[15];
    const float* norm_ffn = (const float*)d_in[16];
    const float* peer_w_q = (const float*)d_in[17];
    const float* sub_keys = (const float*)d_in[18];
    const float* peer_u = (const float*)d_in[19];
    const float* peer_v = (const float*)d_in[20];
    const float* norm_final = (const float*)d_in[21];
    const int Tb = 4096;
    size_t off = 0;
    auto alloc = [&](size_t n) { float* p = ws + off; off += (n + 63) & ~(size_t)63; return p; };
    float* cs = alloc(131072);
    float* xn = alloc((size_t)Tb * 1024);
    float* proj = alloc((size_t)Tb * 2208);
    float* cqn = alloc((size_t)Tb * 384);
    float* ckvn = alloc((size_t)Tb * 256);
    float* q = alloc((size_t)Tb * 768);
    float* kv = alloc((size_t)Tb * 1024);
    float* kr = alloc((size_t)Tb * 32);
    float* omix = alloc((size_t)Tb * 1024);
    float* qm = alloc((size_t)Tb * 1024);
    float* memn = alloc(256 * 1024);
    float* kvm = alloc(256 * 2048);
    float* scm = alloc((size_t)Tb * 1024);
    float* om = alloc((size_t)Tb * 1024);
    float* sc = alloc((size_t)Tb * 2048);
    float* pq = proj;
    nv::RopeInv inv;
    for (int i = 0; i < 16; ++i) inv.v[i] = 1.0f / powf(10000.0f, (float)(2 * i) / 32.0f);
    nv::k_rope_table<<<65536 / 256, 256, 0, st>>>(cs, inv);
    auto gemm = [&](const float* A, int lda, const float* W, int ldw, float* C, int ldc, const float* R, int ldr, int M, int N, int K, bool tb) {
        dim3 g((N + 63) / 64, (M + 63) / 64);
        if (tb) nv::k_gemm<true><<<g, 256, 0, st>>>(A, lda, W, ldw, C, ldc, R, ldr, M, N, K);
        else nv::k_gemm<false><<<g, 256, 0, st>>>(A, lda, W, ldw, C, ldc, R, ldr, M, N, K);
    };
    for (int b = 0; b < 4; ++b) {
        const float* xb = x + (size_t)b * Tb * 1024;
        float* ob = out + (size_t)b * Tb * 1024;
        nv::k_rmsnorm<<<Tb / 4, 256, 0, st>>>(xb, 1024, norm_mix, xn, 1024, Tb, 1024);
        gemm(xn, 1024, w_in, 2208, proj, 2208, nullptr, 0, Tb, 2208, 1024, false);
        nv::k_rmsnorm<<<Tb / 4, 256, 0, st>>>(proj, 2208, q_norm, cqn, 384, Tb, 384);
        nv::k_rmsnorm<<<Tb / 4, 256, 0, st>>>(proj + 384, 2208, kv_norm, ckvn, 256, Tb, 256);
        gemm(cqn, 384, w_uq, 768, q, 768, nullptr, 0, Tb, 768, 384, false);
        gemm(ckvn, 256, w_ukv, 1024, kv, 1024, nullptr, 0, Tb, 1024, 256, false);
        nv::k_rope_apply<<<(Tb * 9 * 16 + 255) / 256, 256, 0, st>>>(q, proj, kr, cs, Tb);
        nv::k_mla_attn<<<dim3(Tb / 64, 8), 64, 0, st>>>(q, kv, kr, omix, 1024);
        nv::k_dil_attn<<<dim3(Tb / 64, 8), 64, 0, st>>>(proj, omix + 512, 1024);
        nv::k_rmsnorm<<<Tb / 4, 256, 0, st>>>(omix, 1024, gn_mla, omix, 1024, Tb, 512);
        nv::k_rmsnorm<<<Tb / 4, 256, 0, st>>>(omix + 512, 1024, gn_dil, omix + 512, 1024, Tb, 512);
        gemm(omix, 1024, w_out, 1024, ob, 1024, xb, 1024, Tb, 1024, 1024, false);
        nv::k_rmsnorm<<<Tb / 4, 256, 0, st>>>(ob, 1024, norm_mem_q, xn, 1024, Tb, 1024);
        gemm(xn, 1024, w_mem_q, 1024, qm, 1024, nullptr, 0, Tb, 1024, 1024, false);
        nv::k_rmsnorm<<<256 / 4, 256, 0, st>>>(mem + (size_t)b * 256 * 1024, 1024, norm_mem_kv, memn, 1024, 256, 1024);
        gemm(memn, 1024, w_mem_kv, 2048, kvm, 2048, nullptr, 0, 256, 2048, 1024, false);
        for (int h = 0; h < 4; ++h)
            gemm(qm + h * 256, 1024, kvm + h * 256, 2048, scm + h * 256, 1024, nullptr, 0, Tb, 256, 256, true);
        nv::k_softmax256<<<Tb * 4 / 4, 256, 0, st>>>(scm, Tb * 4, 0.0625f);
        for (int h = 0; h < 4; ++h)
            gemm(scm + h * 256, 1024, kvm + 1024 + h * 256, 2048, om + h * 256, 1024, nullptr, 0, Tb, 256, 256, false);
        gemm(om, 1024, w_mem_o, 1024, ob, 1024, ob, 1024, Tb, 1024, 1024, false);
        nv::k_rmsnorm<<<Tb / 4, 256, 0, st>>>(ob, 1024, norm_ffn, xn, 1024, Tb, 1024);
        gemm(xn, 1024, peer_w_q, 2048, pq, 2048, nullptr, 0, Tb, 2048, 1024, false);
        for (int hp = 0; hp < 16; ++hp)
            gemm(pq + hp * 128, 2048, sub_keys + (size_t)hp * 128 * 128, 128, sc + hp * 128, 2048, nullptr, 0, Tb, 128, 128, true);
        nv::k_peer<<<Tb / 4, 256, 0, st>>>(sc, xn, peer_u, peer_v, norm_final, ob, Tb);
    }
}
extern "C" void kernel_launch(void* const* d_in, const int* in_sizes, int n_in, void* d_out, int out_size, void* d_ws, size_t ws_size,
                              hipStream_t stream) {
    naive_forward(d_in, (float*)d_out, (float*)d_ws, stream);
}
```

```cpp
#include <hip/hip_runtime.h>
#include <hip/hip_cooperative_groups.h>
#include <math.h>
#include <stdint.h>
#include <stdio.h>
#include <string.h>
#define DI __device__ __forceinline__
typedef unsigned short bf16_t;
typedef short bf16x8 __attribute__((ext_vector_type(8)));
typedef short s16x4 __attribute__((ext_vector_type(4)));
typedef float f32x16 __attribute__((ext_vector_type(16)));
typedef float f32x4 __attribute__((ext_vector_type(4)));
typedef float f32x2 __attribute__((ext_vector_type(2)));
typedef unsigned u32x4 __attribute__((ext_vector_type(4)));
typedef unsigned u32x2 __attribute__((ext_vector_type(2)));
typedef __bf16 bf16x2v __attribute__((ext_vector_type(2)));
#define LAS __attribute__((address_space(3)))
#define MFMA32(a, b, c) __builtin_amdgcn_mfma_f32_32x32x16_bf16((a), (b), (c), 0, 0, 0)

constexpr int T_TOK = 16384, SEQ_L = 4096, DM = 1024, INC = 2208;
constexpr float LOG2E = 1.4426950408889634f;

DI unsigned pack2(float lo, float hi) { f32x2 f = {lo, hi}; return __builtin_bit_cast(unsigned, __builtin_convertvector(f, bf16x2v)); }
DI float bf_lo(unsigned u) { return __uint_as_float(u << 16); }
DI float bf_hi(unsigned u) { return __uint_as_float(u & 0xffff0000u); }
DI float bf2f(bf16_t v) { return __uint_as_float(((unsigned)v) << 16); }
DI int crow(int reg, int hh) { return (reg & 3) + 8 * (reg >> 2) + 4 * hh; }
DI f32x16 zero16() { f32x16 z;
#pragma unroll
    for (int i = 0; i < 16; ++i) z[i] = 0.f; return z; }
DI float xhalf_max(float v) { auto r = __builtin_amdgcn_permlane32_swap(__float_as_uint(v), __float_as_uint(v), false, false); return fmaxf(__uint_as_float(r[0]), __uint_as_float(r[1])); }
DI float xhalf_sum(float v) { auto r = __builtin_amdgcn_permlane32_swap(__float_as_uint(v), __float_as_uint(v), false, false); return __uint_as_float(r[0]) + __uint_as_float(r[1]); }
DI bf16x8 ld16(const void* p) { return *(const bf16x8*)p; }
DI u32x4 ldu4(const void* p) { return *(const u32x4*)p; }
DI float fast_exp2(float x) { return __builtin_amdgcn_exp2f(x); }
DI bf16x8 pack_step(const f32x16& x, int s) {
    u32x4 p;
    p[0] = pack2(x[8 * s + 0], x[8 * s + 1]); p[1] = pack2(x[8 * s + 2], x[8 * s + 3]);
    p[2] = pack2(x[8 * s + 4], x[8 * s + 5]); p[3] = pack2(x[8 * s + 6], x[8 * s + 7]);
    return __builtin_bit_cast(bf16x8, p);
}
DI s16x4 tr_read(unsigned lds_byte_addr) {
    return __builtin_amdgcn_ds_read_tr16_b64_v4i16((LAS s16x4*)(uintptr_t)lds_byte_addr);
}

constexpr size_t MiB = 1ull << 20;
constexpr size_t OFF_BAR = 0;
constexpr size_t OFF_WT_IN = 65536;
constexpr size_t OFF_WT_UQ = OFF_WT_IN + 2304ull * 1024 * 2;
constexpr size_t OFF_WT_UKV = OFF_WT_UQ + 768ull * 384 * 2;
constexpr size_t OFF_WT_OUT = OFF_WT_UKV + 1024ull * 256 * 2;
constexpr size_t OFF_WT_MQ = OFF_WT_OUT + 1024ull * 1024 * 2;
constexpr size_t OFF_WT_MKV = OFF_WT_MQ + 1024ull * 1024 * 2;
constexpr size_t OFF_WT_MO = OFF_WT_MKV + 2048ull * 1024 * 2;
constexpr size_t OFF_WT_PQ = OFF_WT_MO + 1024ull * 1024 * 2;
constexpr size_t OFF_KEYS = OFF_WT_PQ + 2048ull * 1024 * 2;
constexpr size_t OFF_ROPE = OFF_KEYS + 16ull * 128 * 128 * 2;
constexpr size_t OFF_KR = OFF_ROPE + 2ull * 4096 * 16 * 4;
constexpr size_t OFF_LSE = OFF_KR + (size_t)T_TOK * 32 * 2;
constexpr size_t OFF_SS1 = OFF_LSE + 3ull * T_TOK * 8 * 4;
constexpr size_t OFF_SS2 = OFF_SS1 + (size_t)T_TOK * 16 * 4;
constexpr size_t OFF_MEMN = OFF_SS2 + (size_t)T_TOK * 16 * 4;
constexpr size_t OFF_SMALL_END = OFF_MEMN + 1024ull * 1024 * 2;
static_assert(OFF_SMALL_END <= 28 * MiB, "small region overflow");
constexpr size_t OFF_A = 28 * MiB;
constexpr size_t OFF_PROJ = OFF_A;
constexpr size_t OFF_UB = OFF_A;
constexpr size_t OFF_VB = OFF_A + 32 * MiB;
constexpr size_t OFF_B = 97 * MiB;
constexpr size_t OFF_XN = OFF_B, OFF_QMLA = OFF_B, OFF_MIXED = OFF_B, OFF_QM = OFF_B;
constexpr size_t OFF_C = 129 * MiB;
constexpr size_t OFF_KVMLA = OFF_C, OFF_HB = OFF_C;
constexpr size_t OFF_D = 161 * MiB;
constexpr size_t OFF_ODIL = OFF_D, OFF_OMLA = OFF_D + 48 * MiB, OFF_OM = OFF_D, OFF_PQ = OFF_D;
constexpr size_t OFF_SELID = 225 * MiB;
constexpr size_t OFF_SELG = 229 * MiB;
constexpr size_t OFF_KVM = 237 * MiB;
constexpr size_t WS_NEEDED = 241 * MiB;

struct Params {
    const float* x; const float* mem; const float* norm_mix; const float* w_in; const float* q_norm; const float* kv_norm;
    const float* w_uq; const float* w_ukv; const float* gn_mla; const float* gn_dil; const float* w_out; const float* norm_mem_q;
    const float* norm_mem_kv; const float* w_mem_q; const float* w_mem_kv; const float* w_mem_o; const float* norm_ffn;
    const float* peer_w_q; const float* sub_keys; const float* peer_u; const float* peer_v; const float* norm_final;
    float* out; char* ws;
    float inv_freq[16];
};
DI void transpose_tile(const float* __restrict__ W, int K, int N, const float* __restrict__ g, bf16_t* __restrict__ Wt, int kt, int nt, char* lds) {
    float* sm = (float*)lds;
    const int t = threadIdx.x;
    const int k0 = kt * 64, n0 = nt * 64;
    __syncthreads();
#pragma unroll
    for (int i = 0; i < 16; ++i) {
        const int id = t + 256 * i, k = id >> 6, n = id & 63;
        float v = 0.f;
        if (n0 + n < N) { v = W[(size_t)(k0 + k) * N + n0 + n]; if (g) v *= g[k0 + k]; }
        sm[k * 65 + n] = v;
    }
    __syncthreads();
    const int n = t >> 2, kc = (t & 3) * 16;
    u32x4 o0, o1;
    o0[0] = pack2(sm[(kc + 0) * 65 + n], sm[(kc + 1) * 65 + n]); o0[1] = pack2(sm[(kc + 2) * 65 + n], sm[(kc + 3) * 65 + n]);
    o0[2] = pack2(sm[(kc + 4) * 65 + n], sm[(kc + 5) * 65 + n]); o0[3] = pack2(sm[(kc + 6) * 65 + n], sm[(kc + 7) * 65 + n]);
    o1[0] = pack2(sm[(kc + 8) * 65 + n], sm[(kc + 9) * 65 + n]); o1[1] = pack2(sm[(kc + 10) * 65 + n], sm[(kc + 11) * 65 + n]);
    o1[2] = pack2(sm[(kc + 12) * 65 + n], sm[(kc + 13) * 65 + n]); o1[3] = pack2(sm[(kc + 14) * 65 + n], sm[(kc + 15) * 65 + n]);
    bf16_t* dst = Wt + (size_t)(n0 + n) * K + k0 + kc;
    *(u32x4*)dst = o0; *(u32x4*)(dst + 8) = o1;
}

DI void rmsnorm_row_bf16(const float* __restrict__ in, const float* __restrict__ g, bf16_t* __restrict__ out, int lane) {
    f32x4 v[4]; float ss = 0.f;
#pragma unroll
    for (int i = 0; i < 4; ++i) { v[i] = *(const f32x4*)(in + 4 * lane + 256 * i); ss += v[i][0] * v[i][0] + v[i][1] * v[i][1] + v[i][2] * v[i][2] + v[i][3] * v[i][3]; }
#pragma unroll
    for (int o = 32; o; o >>= 1) ss += __shfl_xor(ss, o);
    const float rs = rsqrtf(ss * (1.0f / 1024.0f) + 1e-6f);
#pragma unroll
    for (int i = 0; i < 4; ++i) {
        const f32x4 gg = *(const f32x4*)(g + 4 * lane + 256 * i);
        u32x2 o; o[0] = pack2(v[i][0] * rs * gg[0], v[i][1] * rs * gg[1]); o[1] = pack2(v[i][2] * rs * gg[2], v[i][3] * rs * gg[3]);
        *(u32x2*)(out + 4 * lane + 256 * i) = o;
    }
}

struct TrJob { const float* W; const float* g; size_t off; int K, N, Npad; };

DI void phase_prep(const Params& p, char* lds) {
    char* ws = p.ws;
    const int t = threadIdx.x, lane = t & 63, wv = t >> 6;
    const int c0 = 576, c1 = c0 + 72, c2 = c1 + 64, c3 = c2 + 256, c4 = c3 + 256, c5 = c4 + 512, c6 = c5 + 256, c7 = c6 + 512;
    const int nrow = (T_TOK + 1024) / 4;
    const int nkeys = 128, nrope = 256;
    const int total = c7 + nrow + nkeys + nrope;
    for (int item = blockIdx.x; item < total; item += gridDim.x) {
        if (item < c7) {
            const float* W; const float* g; size_t off; int K, N, Npad, local;
            if (item < c0)      { W = p.w_in;     g = nullptr;      off = OFF_WT_IN;  K = 1024; N = 2208; Npad = 2304; local = item; }
            else if (item < c1) { W = p.w_uq;     g = p.q_norm;     off = OFF_WT_UQ;  K = 384;  N = 768;  Npad = 768;  local = item - c0; }
            else if (item < c2) { W = p.w_ukv;    g = p.kv_norm;    off = OFF_WT_UKV; K = 256;  N = 1024; Npad = 1024; local = item - c1; }
            else if (item < c3) { W = p.w_out;    g = nullptr;      off = OFF_WT_OUT; K = 1024; N = 1024; Npad = 1024; local = item - c2; }
            else if (item < c4) { W = p.w_mem_q;  g = p.norm_mem_q; off = OFF_WT_MQ;  K = 1024; N = 1024; Npad = 1024; local = item - c3; }
            else if (item < c5) { W = p.w_mem_kv; g = nullptr;      off = OFF_WT_MKV; K = 1024; N = 2048; Npad = 2048; local = item - c4; }
            else if (item < c6) { W = p.w_mem_o;  g = nullptr;      off = OFF_WT_MO;  K = 1024; N = 1024; Npad = 1024; local = item - c5; }
            else                { W = p.peer_w_q; g = p.norm_ffn;   off = OFF_WT_PQ;  K = 1024; N = 2048; Npad = 2048; local = item - c6; }
            const int ntn = Npad / 64;
            transpose_tile(W, K, N, g, (bf16_t*)(ws + off), local / ntn, local % ntn, lds);
        } else if (item < c7 + nrow) {
            const int row = (item - c7) * 4 + wv;
            if (row < T_TOK) rmsnorm_row_bf16(p.x + (size_t)row * 1024, p.norm_mix, (bf16_t*)(ws + OFF_XN) + (size_t)row * 1024, lane);
            else rmsnorm_row_bf16(p.mem + (size_t)(row - T_TOK) * 1024, p.norm_mem_kv, (bf16_t*)(ws + OFF_MEMN) + (size_t)(row - T_TOK) * 1024, lane);
        } else if (item < c7 + nrow + nkeys) {
            const int idx = ((item - c7 - nrow) * 256 + t) * 8;
            const f32x4 a = *(const f32x4*)(p.sub_keys + idx), b = *(const f32x4*)(p.sub_keys + idx + 4);
            u32x4 o; o[0] = pack2(a[0], a[1]); o[1] = pack2(a[2], a[3]); o[2] = pack2(b[0], b[1]); o[3] = pack2(b[2], b[3]);
            *(u32x4*)((bf16_t*)(ws + OFF_KEYS) + idx) = o;
        } else {
            const int idx = (item - c7 - nrow - nkeys) * 256 + t;
            const int s = idx >> 4, i = idx & 15;
            const float ang = (float)s * p.inv_freq[i];
            const double a = (double)ang;
            const double twopi = 6.283185307179586476925;
            const float rf = (float)(a - twopi * rint(a / twopi));
            float* cs = (float*)(ws + OFF_ROPE);
            cs[idx] = cosf(rf); cs[65536 + idx] = sinf(rf);
        }
    }
}
constexpr int GEMM_STAGE = 32768;
constexpr int GEMM_LDS = 2 * GEMM_STAGE;
DI unsigned sw_off(int row, int chunk) { return (unsigned)(row * 128 + ((chunk ^ ((row >> 1) & 7)) << 4)); }

template <class Epi>
DI void gemm_tile(const bf16_t* __restrict__ Wt, const bf16_t* __restrict__ X, int ldx, int K, int n0, int m0, char* lds, const Epi& epi) {
    const int t = threadIdx.x, lane = t & 63, wv = t >> 6, r = lane & 31, hh = lane >> 5;
    const int wn = wv & 1, wm = wv >> 1;
    const int lrow = t >> 3, lch = t & 7;
    const bf16_t* wsrc = Wt + (size_t)(n0 + lrow) * K + lch * 8;
    const bf16_t* xsrc = X + (size_t)(m0 + lrow) * ldx + lch * 8;
    const size_t wstep = (size_t)32 * K, xstep = (size_t)32 * ldx;
    f32x16 acc[2][2];
#pragma unroll
    for (int i = 0; i < 2; ++i)
#pragma unroll
        for (int j = 0; j < 2; ++j) acc[i][j] = zero16();
    u32x4 wr[4], xr[4];
    const int nk = K >> 6;
#pragma unroll
    for (int i = 0; i < 4; ++i) { wr[i] = ldu4(wsrc + i * wstep); xr[i] = ldu4(xsrc + i * xstep); }
    __syncthreads();
#pragma unroll
    for (int i = 0; i < 4; ++i) {
        *(u32x4*)(lds + sw_off(lrow + 32 * i, lch)) = wr[i];
        *(u32x4*)(lds + 16384 + sw_off(lrow + 32 * i, lch)) = xr[i];
    }
    __syncthreads();
    for (int kt = 0; kt < nk; ++kt) {
        const bool more = (kt + 1 < nk);
        if (more) {
#pragma unroll
            for (int i = 0; i < 4; ++i) { wr[i] = ldu4(wsrc + i * wstep + (kt + 1) * 64); xr[i] = ldu4(xsrc + i * xstep + (kt + 1) * 64); }
        }
        const char* sb = lds + (kt & 1) * GEMM_STAGE;
#pragma unroll
        for (int s = 0; s < 4; ++s) {
            bf16x8 a[2], b[2];
#pragma unroll
            for (int i = 0; i < 2; ++i) a[i] = ld16(sb + sw_off(64 * wn + 32 * i + r, 2 * s + hh));
#pragma unroll
            for (int j = 0; j < 2; ++j) b[j] = ld16(sb + 16384 + sw_off(64 * wm + 32 * j + r, 2 * s + hh));
#pragma unroll
            for (int i = 0; i < 2; ++i)
#pragma unroll
                for (int j = 0; j < 2; ++j) acc[i][j] = MFMA32(a[i], b[j], acc[i][j]);
        }
        if (more) {
            char* nb = lds + ((kt + 1) & 1) * GEMM_STAGE;
#pragma unroll
            for (int i = 0; i < 4; ++i) {
                *(u32x4*)(nb + sw_off(lrow + 32 * i, lch)) = wr[i];
                *(u32x4*)(nb + 16384 + sw_off(lrow + 32 * i, lch)) = xr[i];
            }
        }
        __syncthreads();
    }
    epi(acc, n0 + 64 * wn, m0 + 64 * wm, r, hh);
}

DI u32x2 pack4(float a, float b, float c, float d) { u32x2 o; o[0] = pack2(a, b); o[1] = pack2(c, d); return o; }

struct EpiPlain {
    bf16_t* out; int ld;
    DI void operator()(const f32x16 (&acc)[2][2], int nb, int mb, int r, int hh) const {
#pragma unroll
        for (int i = 0; i < 2; ++i)
#pragma unroll
            for (int j = 0; j < 2; ++j) {
                bf16_t* row = out + (size_t)(mb + 32 * j + r) * ld + nb + 32 * i + 4 * hh;
#pragma unroll
                for (int g = 0; g < 4; ++g) *(u32x2*)(row + 8 * g) = pack4(acc[i][j][4 * g], acc[i][j][4 * g + 1], acc[i][j][4 * g + 2], acc[i][j][4 * g + 3]);
            }
    }
};

DI void rope_store(const f32x16& a, float scale, const float* __restrict__ cs, int pos, int hh, bf16_t* dst  ) {
#pragma unroll
    for (int g = 0; g < 2; ++g) {
        const f32x4 c = *(const f32x4*)(cs + pos * 16 + 8 * g + 4 * hh);
        const f32x4 s = *(const f32x4*)(cs + 65536 + pos * 16 + 8 * g + 4 * hh);
        float o1[4], o2[4];
#pragma unroll
        for (int e = 0; e < 4; ++e) {
            const float x1 = a[4 * g + e] * scale, x2 = a[4 * (g + 2) + e] * scale;
            o1[e] = x1 * c[e] - x2 * s[e];
            o2[e] = x2 * c[e] + x1 * s[e];
        }
        *(u32x2*)(dst + 8 * g + 4 * hh) = pack4(o1[0], o1[1], o1[2], o1[3]);
        *(u32x2*)(dst + 16 + 8 * g + 4 * hh) = pack4(o2[0], o2[1], o2[2], o2[3]);
    }
}

struct EpiProj {
    bf16_t* proj; bf16_t* kr; const float* cs;
    DI void operator()(const f32x16 (&acc)[2][2], int nb, int mb, int r, int hh) const {
#pragma unroll
        for (int i = 0; i < 2; ++i) {
            const int nsub = nb + 32 * i;
            if (nsub >= INC) continue;
#pragma unroll
            for (int j = 0; j < 2; ++j) {
                const int tok = mb + 32 * j + r;
                if (nsub == 640) {
                    rope_store(acc[i][j], 1.0f, cs, tok & (SEQ_L - 1), hh, kr + (size_t)tok * 32);
                } else {
                    const float sc = (nsub >= 672 && nsub < 1184) ? 0.125f * LOG2E : 1.0f;
                    bf16_t* row = proj + (size_t)tok * INC + nsub + 4 * hh;
#pragma unroll
                    for (int g = 0; g < 4; ++g)
                        *(u32x2*)(row + 8 * g) = pack4(acc[i][j][4 * g] * sc, acc[i][j][4 * g + 1] * sc, acc[i][j][4 * g + 2] * sc, acc[i][j][4 * g + 3] * sc);
                }
            }
        }
    }
};

struct EpiUpQ {
    bf16_t* q; const float* cs; const float* lds_rs;
    DI void operator()(const f32x16 (&acc)[2][2], int nb, int mb, int r, int hh) const {
        const float qs = 0.10206207261596575f * LOG2E;
#pragma unroll
        for (int j = 0; j < 2; ++j) {
            const int tl = (mb & 127) + 32 * j + r;
            const int tok = (mb & ~127) + tl;
            const float sc = lds_rs[tl] * qs;
#pragma unroll
            for (int i = 0; i < 2; ++i) {
                const int nsub = nb + 32 * i;
                if ((nsub % 96) == 64) {
                    rope_store(acc[i][j], sc, cs, tok & (SEQ_L - 1), hh, q + (size_t)tok * 768 + nsub);
                } else {
                    bf16_t* row = q + (size_t)tok * 768 + nsub + 4 * hh;
#pragma unroll
                    for (int g = 0; g < 4; ++g)
                        *(u32x2*)(row + 8 * g) = pack4(acc[i][j][4 * g] * sc, acc[i][j][4 * g + 1] * sc, acc[i][j][4 * g + 2] * sc, acc[i][j][4 * g + 3] * sc);
                }
            }
        }
    }
};

struct EpiUpKV {
    bf16_t* kv; const float* lds_rs;
    DI void operator()(const f32x16 (&acc)[2][2], int nb, int mb, int r, int hh) const {
#pragma unroll
        for (int j = 0; j < 2; ++j) {
            const int tl = (mb & 127) + 32 * j + r;
            const int tok = (mb & ~127) + tl;
            const float sc = lds_rs[tl];
#pragma unroll
            for (int i = 0; i < 2; ++i) {
                bf16_t* row = kv + (size_t)tok * 1024 + nb + 32 * i + 4 * hh;
#pragma unroll
                for (int g = 0; g < 4; ++g)
                    *(u32x2*)(row + 8 * g) = pack4(acc[i][j][4 * g] * sc, acc[i][j][4 * g + 1] * sc, acc[i][j][4 * g + 2] * sc, acc[i][j][4 * g + 3] * sc);
            }
        }
    }
};

struct EpiResid {
    const float* R; float* H; bf16_t* HB; float* SS;
    DI void operator()(const f32x16 (&acc)[2][2], int nb, int mb, int r, int hh) const {
#pragma unroll
        for (int j = 0; j < 2; ++j) {
            const int tok = mb + 32 * j + r;
            float ss = 0.f;
#pragma unroll
            for (int i = 0; i < 2; ++i) {
                const size_t base = (size_t)tok * 1024 + nb + 32 * i + 4 * hh;
#pragma unroll
                for (int g = 0; g < 4; ++g) {
                    f32x4 h = *(const f32x4*)(R + base + 8 * g);
                    h[0] += acc[i][j][4 * g]; h[1] += acc[i][j][4 * g + 1]; h[2] += acc[i][j][4 * g + 2]; h[3] += acc[i][j][4 * g + 3];
                    ss += h[0] * h[0] + h[1] * h[1] + h[2] * h[2] + h[3] * h[3];
                    *(f32x4*)(H + base + 8 * g) = h;
                    *(u32x2*)(HB + base + 8 * g) = pack4(h[0], h[1], h[2], h[3]);
                }
            }
            ss = xhalf_sum(ss);
            if (hh == 0) SS[(size_t)tok * 16 + (nb >> 6)] = ss;
        }
    }
};

struct EpiRowScale {
    bf16_t* out; int ld; const float* SS; float extra;
    DI void operator()(const f32x16 (&acc)[2][2], int nb, int mb, int r, int hh) const {
#pragma unroll
        for (int j = 0; j < 2; ++j) {
            const int tok = mb + 32 * j + r;
            const f32x4 s0 = *(const f32x4*)(SS + (size_t)tok * 16), s1 = *(const f32x4*)(SS + (size_t)tok * 16 + 4),
                        s2 = *(const f32x4*)(SS + (size_t)tok * 16 + 8), s3 = *(const f32x4*)(SS + (size_t)tok * 16 + 12);
            const float tot = (s0[0] + s0[1] + s0[2] + s0[3]) + (s1[0] + s1[1] + s1[2] + s1[3]) + (s2[0] + s2[1] + s2[2] + s2[3]) + (s3[0] + s3[1] + s3[2] + s3[3]);
            const float sc = rsqrtf(tot * (1.0f / 1024.0f) + 1e-6f) * extra;
#pragma unroll
            for (int i = 0; i < 2; ++i) {
                bf16_t* row = out + (size_t)tok * ld + nb + 32 * i + 4 * hh;
#pragma unroll
                for (int g = 0; g < 4; ++g)
                    *(u32x2*)(row + 8 * g) = pack4(acc[i][j][4 * g] * sc, acc[i][j][4 * g + 1] * sc, acc[i][j][4 * g + 2] * sc, acc[i][j][4 * g + 3] * sc);
            }
        }
    }
};

DI void compute_row_rs(const bf16_t* __restrict__ X, int ldx, int K, int m0, float* lds_rs) {
    const int t = threadIdx.x;
    const int tl = t >> 1, half = t & 1;
    const bf16_t* src = X + (size_t)(m0 + tl) * ldx + half * (K >> 1);
    float ss = 0.f;
    for (int c = 0; c < (K >> 4); ++c) {
        const u32x4 v = ldu4(src + c * 8);
#pragma unroll
        for (int e = 0; e < 4; ++e) { const float a = bf_lo(v[e]), b = bf_hi(v[e]); ss += a * a + b * b; }
    }
    ss += __shfl_xor(ss, 1);
    if (half == 0) lds_rs[tl] = rsqrtf(ss / (float)K + 1e-6f);
}

DI void phase_p1(const Params& p, char* lds) {
    char* ws = p.ws;
    const int nproj = 18 * 128, nkvm = 16 * 8;
    for (int item = blockIdx.x; item < nproj + nkvm; item += gridDim.x) {
        if (item < nproj) {
            const int nt = item % 18, mt = item / 18;
            EpiProj e{(bf16_t*)(ws + OFF_PROJ), (bf16_t*)(ws + OFF_KR), (const float*)(ws + OFF_ROPE)};
            gemm_tile((const bf16_t*)(ws + OFF_WT_IN), (const bf16_t*)(ws + OFF_XN), 1024, 1024, nt * 128, mt * 128, lds, e);
        } else {
            const int it = item - nproj, nt = it % 16, mt = it / 16;
            EpiPlain e{(bf16_t*)(ws + OFF_KVM), 2048};
            gemm_tile((const bf16_t*)(ws + OFF_WT_MKV), (const bf16_t*)(ws + OFF_MEMN), 1024, 1024, nt * 128, mt * 128, lds, e);
        }
    }
}

DI void phase_p2(const Params& p, char* lds) {
    char* ws = p.ws;
    float* lds_rs = (float*)(lds + GEMM_LDS);
    const int nq = 6 * 128, nkv = 8 * 128;
    for (int item = blockIdx.x; item < nq + nkv; item += gridDim.x) {
        __syncthreads();
        if (item < nq) {
            const int nt = item % 6, mt = item / 6;
            const bf16_t* X = (const bf16_t*)(ws + OFF_PROJ);
            compute_row_rs(X, INC, 384, mt * 128, lds_rs);
            EpiUpQ e{(bf16_t*)(ws + OFF_QMLA), (const float*)(ws + OFF_ROPE), lds_rs};
            gemm_tile((const bf16_t*)(ws + OFF_WT_UQ), X, INC, 384, nt * 128, mt * 128, lds, e);
        } else {
            const int it = item - nq, nt = it % 8, mt = it / 8;
            const bf16_t* X = (const bf16_t*)(ws + OFF_PROJ) + 384;
            compute_row_rs(X, INC, 256, mt * 128, lds_rs);
            EpiUpKV e{(bf16_t*)(ws + OFF_KVMLA), lds_rs};
            gemm_tile((const bf16_t*)(ws + OFF_WT_UKV), X, INC, 256, nt * 128, mt * 128, lds, e);
        }
    }
}

DI void phase_resid(const Params& p, char* lds, size_t off_w, size_t off_a, const float* R, size_t off_ss) {
    char* ws = p.ws;
    for (int item = blockIdx.x; item < 8 * 128; item += gridDim.x) {
        const int nt = item % 8, mt = item / 8;
        EpiResid e{R, p.out, (bf16_t*)(ws + OFF_HB), (float*)(ws + off_ss)};
        gemm_tile((const bf16_t*)(ws + off_w), (const bf16_t*)(ws + off_a), 1024, 1024, nt * 128, mt * 128, lds, e);
    }
}

DI void phase_rowscale(const Params& p, char* lds, size_t off_w, int N, size_t off_out, size_t off_ss, float extra) {
    char* ws = p.ws;
    const int ntn = N / 128;
    for (int item = blockIdx.x; item < ntn * 128; item += gridDim.x) {
        const int nt = item % ntn, mt = item / ntn;
        EpiRowScale e{(bf16_t*)(ws + off_out), N, (const float*)(ws + off_ss), extra};
        gemm_tile((const bf16_t*)(ws + off_w), (const bf16_t*)(ws + OFF_HB), 1024, 1024, nt * 128, mt * 128, lds, e);
    }
}
DI unsigned v128_off(int row, int chunk) { return (unsigned)(row * 128 + ((chunk ^ (((row >> 1) & 1) << 2)) << 4)); }
DI unsigned v128_tr_addr(unsigned base, int R0, int c, int lane) {
    const int blk = (lane >> 4) & 1, qq = (lane & 15) >> 2, pp = lane & 3;
    return base + v128_off(R0 + qq, 4 * c + 2 * blk + (pp >> 1)) + 8 * (pp & 1);
}
DI bf16x8 cat44(s16x4 lo, s16x4 hi) { return __builtin_shufflevector(lo, hi, 0, 1, 2, 3, 4, 5, 6, 7); }

constexpr int MLA_KROW = 208;
constexpr int MLA_STAGE = 64 * MLA_KROW + 64 * 128;
DI void mla_unit(const Params& p, char* lds, int b, int h, int qt) {
    char* ws = p.ws;
    const int t = threadIdx.x, lane = t & 63, wv = t >> 6, r = lane & 31, hh = lane >> 5;
    const bf16_t* Q = (const bf16_t*)(ws + OFF_QMLA);
    const bf16_t* KV = (const bf16_t*)(ws + OFF_KVMLA);
    const bf16_t* KR = (const bf16_t*)(ws + OFF_KR);
    const int q0 = qt * 128 + 32 * wv;
    const size_t tokq = (size_t)b * SEQ_L + q0 + r;
    bf16x8 qf[6];
#pragma unroll
    for (int s = 0; s < 6; ++s) qf[s] = ld16(Q + tokq * 768 + h * 96 + 16 * s + 8 * hh);
    f32x16 o[2]; o[0] = zero16(); o[1] = zero16();
    float m = -INFINITY, l = 0.f;
    int kkey[3], kc[3];
#pragma unroll
    for (int i = 0; i < 3; ++i) { const int id = t + 256 * i; kkey[i] = id / 12; kc[i] = id % 12; }
    const int vkey0 = t >> 3, vc = t & 7;
    const size_t tokb = (size_t)b * SEQ_L;
    const int ntiles = 2 * qt + 2;
    u32x4 kr_[3], vr_[2];
    auto load_tile = [&](int kt) {
#pragma unroll
        for (int i = 0; i < 3; ++i) {
            const size_t tk = tokb + 64 * kt + kkey[i];
            kr_[i] = (kc[i] < 8) ? ldu4(KV + tk * 1024 + h * 128 + 8 * kc[i]) : ldu4(KR + tk * 32 + 8 * (kc[i] - 8));
        }
#pragma unroll
        for (int i = 0; i < 2; ++i) {
            const size_t tk = tokb + 64 * kt + vkey0 + 32 * i;
            vr_[i] = ldu4(KV + tk * 1024 + h * 128 + 64 + 8 * vc);
        }
    };
    auto store_tile = [&](char* sb) {
#pragma unroll
        for (int i = 0; i < 3; ++i) *(u32x4*)(sb + kkey[i] * MLA_KROW + kc[i] * 16) = kr_[i];
#pragma unroll
        for (int i = 0; i < 2; ++i) *(u32x4*)(sb + 64 * MLA_KROW + v128_off(vkey0 + 32 * i, vc)) = vr_[i];
    };
    load_tile(0);
    __syncthreads();
    store_tile(lds);
    __syncthreads();
    for (int kt = 0; kt < ntiles; ++kt) {
        const bool more = (kt + 1 < ntiles);
        if (more) load_tile(kt + 1);
        const char* sb = lds + (kt & 1) * MLA_STAGE;
        const unsigned vb = (unsigned)(uintptr_t)(sb + 64 * MLA_KROW);
        f32x16 s[2];
#pragma unroll
        for (int k2 = 0; k2 < 2; ++k2) {
            s[k2] = zero16();
#pragma unroll
            for (int ss = 0; ss < 6; ++ss) s[k2] = MFMA32(ld16(sb + (32 * k2 + r) * MLA_KROW + (2 * ss + hh) * 16), qf[ss], s[k2]);
        }
        if (kt >= 2 * qt) {
            const int qpos = q0 + r;
#pragma unroll
            for (int k2 = 0; k2 < 2; ++k2)
#pragma unroll
                for (int i = 0; i < 16; ++i) { const int kpos = 64 * kt + 32 * k2 + crow(i, hh); if (kpos > qpos) s[k2][i] = -INFINITY; }
        }
        float mx = s[0][0];
#pragma unroll
        for (int k2 = 0; k2 < 2; ++k2)
#pragma unroll
            for (int i = 0; i < 16; ++i) mx = fmaxf(mx, s[k2][i]);
        mx = xhalf_max(mx);
        const float mn = fmaxf(m, mx);
        const float alpha = fast_exp2(m - mn);
        float ps = 0.f;
#pragma unroll
        for (int k2 = 0; k2 < 2; ++k2)
#pragma unroll
            for (int i = 0; i < 16; ++i) { const float e = fast_exp2(s[k2][i] - mn); s[k2][i] = e; ps += e; }
        l = l * alpha + ps;
        m = mn;
#pragma unroll
        for (int c = 0; c < 2; ++c)
#pragma unroll
            for (int i = 0; i < 16; ++i) o[c][i] *= alpha;
#pragma unroll
        for (int k2 = 0; k2 < 2; ++k2)
#pragma unroll
            for (int st = 0; st < 2; ++st) {
                const bf16x8 pb = pack_step(s[k2], st);
#pragma unroll
                for (int c = 0; c < 2; ++c) {
                    const s16x4 lo = tr_read(v128_tr_addr(vb, 32 * k2 + 16 * st + 4 * hh, c, lane));
                    const s16x4 hi = tr_read(v128_tr_addr(vb, 32 * k2 + 16 * st + 8 + 4 * hh, c, lane));
                    o[c] = MFMA32(cat44(lo, hi), pb, o[c]);
                }
            }
        if (more) store_tile(lds + ((kt + 1) & 1) * MLA_STAGE);
        __syncthreads();
    }
    const float inv = 1.0f / xhalf_sum(l);
    bf16_t* dst = (bf16_t*)(ws + OFF_OMLA) + tokq * 512 + h * 64 + 4 * hh;
#pragma unroll
    for (int c = 0; c < 2; ++c)
#pragma unroll
        for (int g = 0; g < 4; ++g)
            *(u32x2*)(dst + 32 * c + 8 * g) = pack4(o[c][4 * g] * inv, o[c][4 * g + 1] * inv, o[c][4 * g + 2] * inv, o[c][4 * g + 3] * inv);
}

DI void dil_unit(const Params& p, char* lds, int g, int b, int h, int rr, int lb) {
    char* ws = p.ws;
    const int t = threadIdx.x, lane = t & 63, wv = t >> 6, r = lane & 31, hh = lane >> 5;
    const int d = (g == 0) ? 1 : (g == 1 ? 4 : 16);
    const bf16_t* PJ = (const bf16_t*)(ws + OFF_PROJ);
    const size_t tokb = (size_t)b * SEQ_L;
    char* kimg = lds;
    char* vimg = lds + 32768;
    __syncthreads();
    {
        const int c = t & 7;
#pragma unroll
        for (int half = 0; half < 2; ++half) {
            u32x4 kk[4], vv[4];
#pragma unroll
            for (int i = 0; i < 4; ++i) {
                const int key = (t >> 3) + 32 * (4 * half + i);
                const int lk = 128 * lb - 128 + key;
                if (lk >= 0) {
                    const size_t tk = tokb + (size_t)lk * d + rr;
                    kk[i] = ldu4(PJ + tk * INC + 1184 + h * 64 + 8 * c);
                    vv[i] = ldu4(PJ + tk * INC + 1696 + h * 64 + 8 * c);
                } else { kk[i] = (u32x4){0u, 0u, 0u, 0u}; vv[i] = (u32x4){0u, 0u, 0u, 0u}; }
            }
#pragma unroll
            for (int i = 0; i < 4; ++i) {
                const int key = (t >> 3) + 32 * (4 * half + i);
                *(u32x4*)(kimg + sw_off(key, c)) = kk[i];
                *(u32x4*)(vimg + v128_off(key, c)) = vv[i];
            }
        }
    }
    const int lq = 128 * lb + 32 * wv + r;
    const size_t tokq = tokb + (size_t)lq * d + rr;
    bf16x8 qf[4];
#pragma unroll
    for (int s = 0; s < 4; ++s) qf[s] = ld16(PJ + tokq * INC + 672 + h * 64 + 16 * s + 8 * hh);
    __syncthreads();
    const float slope2 = exp2f(-(float)(h + 1)) * (float)d * LOG2E;
    const int u0 = (lb == 0) ? (4 - wv) : 0;
    f32x16 o[2]; o[0] = zero16(); o[1] = zero16();
    float m = -INFINITY, lsum = 0.f;
    const unsigned vb = (unsigned)(uintptr_t)vimg;
#pragma unroll 1
    for (int u = u0; u < 5; ++u) {
        const int rowb = 32 * (wv + u);
        f32x16 s = zero16();
#pragma unroll
        for (int ss = 0; ss < 4; ++ss) s = MFMA32(ld16(kimg + sw_off(rowb + r, 2 * ss + hh)), qf[ss], s);
        const int dbase = r + 128 - 32 * u;
        float mx = -INFINITY;
#pragma unroll
        for (int i = 0; i < 16; ++i) {
            const int dist = dbase - crow(i, hh);
            const bool valid = (dist >= 0) && (dist <= 128);
            const float v = valid ? (s[i] - slope2 * (float)dist) : -INFINITY;
            s[i] = v;
            mx = fmaxf(mx, v);
        }
        mx = xhalf_max(mx);
        const float mn = fmaxf(m, mx);
        const float alpha = fast_exp2(m - mn);
        float ps = 0.f;
#pragma unroll
        for (int i = 0; i < 16; ++i) { const float e = fast_exp2(s[i] - mn); s[i] = e; ps += e; }
        lsum = lsum * alpha + ps;
        m = mn;
#pragma unroll
        for (int c = 0; c < 2; ++c)
#pragma unroll
            for (int i = 0; i < 16; ++i) o[c][i] *= alpha;
#pragma unroll
        for (int st = 0; st < 2; ++st) {
            const bf16x8 pb = pack_step(s, st);
#pragma unroll
            for (int c = 0; c < 2; ++c) {
                const s16x4 lo = tr_read(v128_tr_addr(vb, rowb + 16 * st + 4 * hh, c, lane));
                const s16x4 hi = tr_read(v128_tr_addr(vb, rowb + 16 * st + 8 + 4 * hh, c, lane));
                o[c] = MFMA32(cat44(lo, hi), pb, o[c]);
            }
        }
    }
    const float ltot = xhalf_sum(lsum);
    const float mx = m;
    const float inv = 1.0f / ltot;
    bf16_t* dst = (bf16_t*)(ws + OFF_ODIL) + ((size_t)g * T_TOK + tokq) * 512 + h * 64 + 4 * hh;
#pragma unroll
    for (int c = 0; c < 2; ++c)
#pragma unroll
        for (int gg = 0; gg < 4; ++gg)
            *(u32x2*)(dst + 32 * c + 8 * gg) = pack4(o[c][4 * gg] * inv, o[c][4 * gg + 1] * inv, o[c][4 * gg + 2] * inv, o[c][4 * gg + 3] * inv);
    if (hh == 0) ((float*)(ws + OFF_LSE))[((size_t)g * T_TOK + tokq) * 8 + h] = mx + __log2f(ltot);
}

DI void phase_p3(const Params& p, char* lds) {
    for (int item = blockIdx.x; item < 512; item += gridDim.x) {
        const int b = item >> 7, h = (item >> 4) & 7, pr = item & 15;
#pragma unroll 1
        for (int rep = 0; rep < 2; ++rep) mla_unit(p, lds, b, h, rep ? pr : 31 - pr);
    }
    for (int u = blockIdx.x; u < 3072; u += gridDim.x) {
        const int g = u >> 10, rem = u & 1023, b = rem >> 8, h = (rem >> 5) & 7, k = rem & 31;
        int rr, lb;
        if (g == 0) { rr = 0; lb = k; } else if (g == 1) { rr = k >> 3; lb = k & 7; } else { rr = k >> 1; lb = k & 1; }
        dil_unit(p, lds, g, b, h, rr, lb);
    }
}

DI void phase_p35(const Params& p, char* lds) {
    char* ws = p.ws;
    const int t = threadIdx.x, lane = t & 63, wv = t >> 6;
    const int ntok = T_TOK / 4, ncv = 8192;
    for (int item = blockIdx.x; item < ntok + 2 * ncv; item += gridDim.x) {
        if (item < ntok) {
            const size_t tok = (size_t)item * 4 + wv;
            const int head = lane >> 3;
            const float* LS = (const float*)(ws + OFF_LSE);
            const float l0 = LS[tok * 8 + head], l1 = LS[((size_t)T_TOK + tok) * 8 + head], l2 = LS[((size_t)2 * T_TOK + tok) * 8 + head];
            const float mx = fmaxf(l0, fmaxf(l1, l2));
            float w0 = fast_exp2(l0 - mx), w1 = fast_exp2(l1 - mx), w2 = fast_exp2(l2 - mx);
            const float wi = 1.0f / (w0 + w1 + w2);
            w0 *= wi; w1 *= wi; w2 *= wi;
            const bf16_t* OD = (const bf16_t*)(ws + OFF_ODIL);
            const u32x4 a0 = ldu4(OD + tok * 512 + 8 * lane), a1 = ldu4(OD + ((size_t)T_TOK + tok) * 512 + 8 * lane),
                        a2 = ldu4(OD + ((size_t)2 * T_TOK + tok) * 512 + 8 * lane);
            const u32x4 am = ldu4((const bf16_t*)(ws + OFF_OMLA) + tok * 512 + 8 * lane);
            float od[8], om[8]; float sd = 0.f, sm = 0.f;
#pragma unroll
            for (int e = 0; e < 4; ++e) {
                od[2 * e] = w0 * bf_lo(a0[e]) + w1 * bf_lo(a1[e]) + w2 * bf_lo(a2[e]);
                od[2 * e + 1] = w0 * bf_hi(a0[e]) + w1 * bf_hi(a1[e]) + w2 * bf_hi(a2[e]);
                om[2 * e] = bf_lo(am[e]); om[2 * e + 1] = bf_hi(am[e]);
                sd += od[2 * e] * od[2 * e] + od[2 * e + 1] * od[2 * e + 1];
                sm += om[2 * e] * om[2 * e] + om[2 * e + 1] * om[2 * e + 1];
            }
#pragma unroll
            for (int o = 32; o; o >>= 1) { sd += __shfl_xor(sd, o); sm += __shfl_xor(sm, o); }
            const float rd = rsqrtf(sd * (1.0f / 512.0f) + 1e-6f), rm = rsqrtf(sm * (1.0f / 512.0f) + 1e-6f);
            const f32x4 gm0 = *(const f32x4*)(p.gn_mla + 8 * lane), gm1 = *(const f32x4*)(p.gn_mla + 8 * lane + 4);
            const f32x4 gd0 = *(const f32x4*)(p.gn_dil + 8 * lane), gd1 = *(const f32x4*)(p.gn_dil + 8 * lane + 4);
            u32x4 o1, o2;
            o1[0] = pack2(om[0] * rm * gm0[0], om[1] * rm * gm0[1]); o1[1] = pack2(om[2] * rm * gm0[2], om[3] * rm * gm0[3]);
            o1[2] = pack2(om[4] * rm * gm1[0], om[5] * rm * gm1[1]); o1[3] = pack2(om[6] * rm * gm1[2], om[7] * rm * gm1[3]);
            o2[0] = pack2(od[0] * rd * gd0[0], od[1] * rd * gd0[1]); o2[1] = pack2(od[2] * rd * gd0[2], od[3] * rd * gd0[3]);
            o2[2] = pack2(od[4] * rd * gd1[0], od[5] * rd * gd1[1]); o2[3] = pack2(od[6] * rd * gd1[2], od[7] * rd * gd1[3]);
            bf16_t* MX = (bf16_t*)(ws + OFF_MIXED) + tok * 1024;
            *(u32x4*)(MX + 8 * lane) = o1;
            *(u32x4*)(MX + 512 + 8 * lane) = o2;
        } else {
            const int it = item - ntok;
            const float* src = (it < ncv) ? p.peer_u : p.peer_v;
            bf16_t* dst = (bf16_t*)(ws + ((it < ncv) ? OFF_UB : OFF_VB));
            const size_t idx = ((size_t)(it % ncv) * 256 + t) * 8;
            const f32x4 a = *(const f32x4*)(src + idx), b = *(const f32x4*)(src + idx + 4);
            u32x4 o; o[0] = pack2(a[0], a[1]); o[1] = pack2(a[2], a[3]); o[2] = pack2(b[0], b[1]); o[3] = pack2(b[2], b[3]);
            *(u32x4*)(dst + idx) = o;
        }
    }
}

DI unsigned m512_off(int row, int chunk) { return (unsigned)(row * 512 + ((chunk ^ (row & 15)) << 4)); }
DI unsigned v512_off(int row, int chunk) { return (unsigned)(row * 512 + ((chunk ^ ((row & 3) << 2)) << 4)); }
DI void memattn_unit(const Params& p, char* lds, int b, int h, int tt) {
    char* ws = p.ws;
    const int t = threadIdx.x, lane = t & 63, wv = t >> 6, r = lane & 31, hh = lane >> 5;
    const int qg = wv & 1, dh = wv >> 1;
    const bf16_t* QM = (const bf16_t*)(ws + OFF_QM);
    const bf16_t* KVM = (const bf16_t*)(ws + OFF_KVM);
    const size_t tokq = (size_t)b * SEQ_L + tt * 64 + 32 * qg + r;
    bf16x8 qf[16];
#pragma unroll
    for (int s = 0; s < 16; ++s) qf[s] = ld16(QM + tokq * 1024 + h * 256 + 16 * s + 8 * hh);
    f32x16 o[4];
#pragma unroll
    for (int c = 0; c < 4; ++c) o[c] = zero16();
    float m = -INFINITY, l = 0.f;
    const int lkey = t >> 5, lc = t & 31;
    u32x4 kr_[4], vr_[4];
    auto load_tile = [&](int kt) {
#pragma unroll
        for (int i = 0; i < 4; ++i) {
            const size_t mrow = (size_t)b * 256 + 32 * kt + lkey + 8 * i;
            kr_[i] = ldu4(KVM + mrow * 2048 + h * 256 + 8 * lc);
            vr_[i] = ldu4(KVM + mrow * 2048 + 1024 + h * 256 + 8 * lc);
        }
    };
    auto store_tile = [&](char* sb) {
#pragma unroll
        for (int i = 0; i < 4; ++i) {
            *(u32x4*)(sb + m512_off(lkey + 8 * i, lc)) = kr_[i];
            *(u32x4*)(sb + 16384 + v512_off(lkey + 8 * i, lc)) = vr_[i];
        }
    };
    load_tile(0);
    __syncthreads();
    store_tile(lds);
    __syncthreads();
    for (int kt = 0; kt < 8; ++kt) {
        const bool more = (kt + 1 < 8);
        if (more) load_tile(kt + 1);
        const char* sb = lds + (kt & 1) * 32768;
        const unsigned vb = (unsigned)(uintptr_t)(sb + 16384);
        f32x16 s = zero16();
#pragma unroll
        for (int ss = 0; ss < 16; ++ss) s = MFMA32(ld16(sb + m512_off(r, 2 * ss + hh)), qf[ss], s);
        float mx = s[0];
#pragma unroll
        for (int i = 1; i < 16; ++i) mx = fmaxf(mx, s[i]);
        mx = xhalf_max(mx);
        const float mn = fmaxf(m, mx);
        const float alpha = fast_exp2(m - mn);
        float ps = 0.f;
#pragma unroll
        for (int i = 0; i < 16; ++i) { const float e = fast_exp2(s[i] - mn); s[i] = e; ps += e; }
        l = l * alpha + ps;
        m = mn;
#pragma unroll
        for (int c = 0; c < 4; ++c)
#pragma unroll
            for (int i = 0; i < 16; ++i) o[c][i] *= alpha;
        const int blk = (lane >> 4) & 1, qq = (lane & 15) >> 2, pp = lane & 3;
#pragma unroll
        for (int st = 0; st < 2; ++st) {
            const bf16x8 pb = pack_step(s, st);
#pragma unroll
            for (int c = 0; c < 4; ++c) {
                const int ch = 16 * dh + 4 * c + 2 * blk + (pp >> 1);
                const s16x4 lo = tr_read(vb + v512_off(16 * st + 4 * hh + qq, ch) + 8 * (pp & 1));
                const s16x4 hi = tr_read(vb + v512_off(16 * st + 8 + 4 * hh + qq, ch) + 8 * (pp & 1));
                o[c] = MFMA32(cat44(lo, hi), pb, o[c]);
            }
        }
        if (more) store_tile(lds + ((kt + 1) & 1) * 32768);
        __syncthreads();
    }
    const float inv = 1.0f / xhalf_sum(l);
    bf16_t* dst = (bf16_t*)(ws + OFF_OM) + tokq * 1024 + h * 256 + 128 * dh + 4 * hh;
#pragma unroll
    for (int c = 0; c < 4; ++c)
#pragma unroll
        for (int g = 0; g < 4; ++g)
            *(u32x2*)(dst + 32 * c + 8 * g) = pack4(o[c][4 * g] * inv, o[c][4 * g + 1] * inv, o[c][4 * g + 2] * inv, o[c][4 * g + 3] * inv);
}

DI void phase_memattn(const Params& p, char* lds) {
    for (int item = blockIdx.x; item < 1024; item += gridDim.x) {
        const int b = item >> 8, h = (item >> 6) & 3, tt = item & 63;
        memattn_unit(p, lds, b, h, tt);
    }
}
DI unsigned f2sort(float f) { const unsigned b = __float_as_uint(f); return b ^ ((b & 0x80000000u) ? 0xFFFFFFFFu : 0x80000000u); }
DI float sort2f(unsigned u) { const unsigned b = (u & 0x80000000u) ? (u ^ 0x80000000u) : ~u; return __uint_as_float(b); }
DI void cswap(unsigned& a, unsigned& b) { const unsigned hi = max(a, b), lo = min(a, b); a = hi; b = lo; }

template <int LO, int N> struct BClean {
    template <int M> static DI void run(unsigned (&a)[M]) {
#pragma unroll
        for (int i = 0; i < N / 2; ++i) cswap(a[LO + i], a[LO + i + N / 2]);
        BClean<LO, N / 2>::run(a); BClean<LO + N / 2, N / 2>::run(a);
    }
};
template <int LO> struct BClean<LO, 1> { template <int M> static DI void run(unsigned (&)[M]) {} };
template <int LO, int N> struct BSort {
    template <int M> static DI void run(unsigned (&a)[M]) {
        BSort<LO, N / 2>::run(a); BSort<LO + N / 2, N / 2>::run(a);
#pragma unroll
        for (int i = 0; i < N / 2; ++i) cswap(a[LO + i], a[LO + N - 1 - i]);
        BClean<LO, N / 2>::run(a); BClean<LO + N / 2, N / 2>::run(a);
    }
};
template <int LO> struct BSort<LO, 1> { template <int M> static DI void run(unsigned (&)[M]) {} };
DI void merge_top16(unsigned (&a)[16], const unsigned (&b)[16]) {
#pragma unroll
    for (int i = 0; i < 16; ++i) a[i] = max(a[i], b[15 - i]);
    BClean<0, 16>::run(a);
}

DI void peer_top16(const bf16_t* __restrict__ keys_hp, const bf16_t* __restrict__ pq_row_hp, int r, int hh, unsigned (&top)[16]) {
    bf16x8 qf[8];
#pragma unroll
    for (int s = 0; s < 8; ++s) qf[s] = ld16(pq_row_hp + 16 * s + 8 * hh);
    unsigned cur[16];
#pragma unroll
    for (int kt = 0; kt < 4; ++kt) {
        f32x16 acc = zero16();
#pragma unroll
        for (int s = 0; s < 8; ++s) acc = MFMA32(ld16(keys_hp + (size_t)(32 * kt + r) * 128 + 16 * s + 8 * hh), qf[s], acc);
        unsigned k[16];
#pragma unroll
        for (int i = 0; i < 16; ++i) k[i] = (f2sort(acc[i]) & ~0x7Fu) | (unsigned)(32 * kt + crow(i, hh));
        BSort<0, 16>::run(k);
        if (kt == 0) {
#pragma unroll
            for (int i = 0; i < 16; ++i) cur[i] = k[i];
        } else merge_top16(cur, k);
    }
    unsigned r0[16], r1[16];
#pragma unroll
    for (int i = 0; i < 16; ++i) { auto rr = __builtin_amdgcn_permlane32_swap(cur[i], cur[i], false, false); r0[i] = rr[0]; r1[i] = rr[1]; }
#pragma unroll
    for (int i = 0; i < 16; ++i) top[i] = max(r0[i], r1[15 - i]);
    BClean<0, 16>::run(top);
}

DI void peer_select_unit(const Params& p, char* lds, int mt, int h) {
    char* ws = p.ws;
    const int t = threadIdx.x, lane = t & 63, wv = t >> 6, r = lane & 31, hh = lane >> 5;
    const size_t tok = (size_t)mt * 128 + 32 * wv + r;
    const bf16_t* KEYS = (const bf16_t*)(ws + OFF_KEYS);
    const bf16_t* PQ = (const bf16_t*)(ws + OFF_PQ);
    unsigned tA[16], tB[16];
    peer_top16(KEYS + (size_t)(2 * h) * 16384, PQ + tok * 2048 + (2 * h) * 128, r, hh, tA);
    peer_top16(KEYS + (size_t)(2 * h + 1) * 16384, PQ + tok * 2048 + (2 * h + 1) * 128, r, hh, tB);
    float fA[16], fB[16];
#pragma unroll
    for (int i = 0; i < 16; ++i) { fA[i] = sort2f(tA[i] & ~0x7Fu); fB[i] = sort2f(tB[i] & ~0x7Fu); }
    unsigned* tab = (unsigned*)lds + wv * 1024;
    __syncthreads();
#pragma unroll
    for (int i = 0; i < 16; ++i) tab[i * 64 + lane] = (tA[i] & 0x7Fu) | ((tB[i] & 0x7Fu) << 16);
    unsigned c[64];
#pragma unroll
    for (int i = 0; i < 64; ++i) c[i] = 0u;
    {
        int n = 0;
#pragma unroll
        for (int a = 0; a < 16; ++a)
#pragma unroll
            for (int b = 0; b < 16; ++b)
                if ((a + 1) * (b + 1) <= 16) { c[n] = (f2sort(fA[a] + fB[b]) & ~0xFFu) | (unsigned)(a * 16 + b); ++n; }
    }
    unsigned g0[16], g1[16], g2[16], g3[16];
#pragma unroll
    for (int i = 0; i < 16; ++i) { g0[i] = c[i]; g1[i] = c[16 + i]; g2[i] = c[32 + i]; g3[i] = c[48 + i]; }
    BSort<0, 16>::run(g0); BSort<0, 16>::run(g1); BSort<0, 16>::run(g2); BSort<0, 16>::run(g3);
    merge_top16(g0, g1); merge_top16(g2, g3); merge_top16(g0, g2);
    float e[16]; float sum = 0.f;
    const float v0 = sort2f(g0[0] & ~0xFFu);
    unsigned ids[16];
#pragma unroll
    for (int i = 0; i < 16; ++i) {
        const float v = sort2f(g0[i] & ~0xFFu);
        e[i] = fast_exp2((v - v0) * LOG2E); sum += e[i];
        const unsigned a = (g0[i] >> 4) & 15u, b = g0[i] & 15u;
        const unsigned ia = tab[a * 64 + lane] & 0x7Fu, ib = (tab[b * 64 + lane] >> 16) & 0x7Fu;
        ids[i] = ia * 128u + ib;
    }
    const float inv = 1.0f / sum;
    if (hh == 0) {
        unsigned short* SID = (unsigned short*)(ws + OFF_SELID) + tok * 128 + h * 16;
        float* SG = (float*)(ws + OFF_SELG) + tok * 128 + h * 16;
        u32x4 w0, w1;
        w0[0] = ids[0] | (ids[1] << 16); w0[1] = ids[2] | (ids[3] << 16); w0[2] = ids[4] | (ids[5] << 16); w0[3] = ids[6] | (ids[7] << 16);
        w1[0] = ids[8] | (ids[9] << 16); w1[1] = ids[10] | (ids[11] << 16); w1[2] = ids[12] | (ids[13] << 16); w1[3] = ids[14] | (ids[15] << 16);
        *(u32x4*)SID = w0; *(u32x4*)(SID + 8) = w1;
#pragma unroll
        for (int q = 0; q < 4; ++q) *(f32x4*)(SG + 4 * q) = (f32x4){e[4 * q] * inv, e[4 * q + 1] * inv, e[4 * q + 2] * inv, e[4 * q + 3] * inv};
    }
}

DI void phase_select(const Params& p, char* lds) {
    for (int item = blockIdx.x; item < 1024; item += gridDim.x) peer_select_unit(p, lds, item >> 3, item & 7);
}

DI float gelu_erf(float a) { return 0.5f * a * (1.0f + erff(a * 0.70710678118654752f)); }
DI float dot2bf(unsigned a, unsigned b, float acc) { return __builtin_amdgcn_fdot2_f32_bf16(__builtin_bit_cast(bf16x2v, a), __builtin_bit_cast(bf16x2v, b), acc, false); }

DI void gather_token(const Params& p, size_t tok, int lane) {
    char* ws = p.ws;
    const bf16_t* UB = (const bf16_t*)(ws + OFF_UB);
    const bf16_t* VB = (const bf16_t*)(ws + OFF_VB);
    float* hrow = p.out + tok * 1024;
    float hv[16];
    {
        const f32x4 a0 = *(const f32x4*)(hrow + 8 * lane), a1 = *(const f32x4*)(hrow + 8 * lane + 4);
        const f32x4 b0 = *(const f32x4*)(hrow + 512 + 8 * lane), b1 = *(const f32x4*)(hrow + 512 + 8 * lane + 4);
#pragma unroll
        for (int e = 0; e < 4; ++e) { hv[e] = a0[e]; hv[4 + e] = a1[e]; hv[8 + e] = b0[e]; hv[12 + e] = b1[e]; }
    }
    float rs;
    {
        const float* SS = (const float*)(ws + OFF_SS2) + tok * 16;
        const f32x4 s0 = *(const f32x4*)SS, s1 = *(const f32x4*)(SS + 4), s2 = *(const f32x4*)(SS + 8), s3 = *(const f32x4*)(SS + 12);
        const float tot = (s0[0] + s0[1] + s0[2] + s0[3]) + (s1[0] + s1[1] + s1[2] + s1[3]) + (s2[0] + s2[1] + s2[2] + s2[3]) + (s3[0] + s3[1] + s3[2] + s3[3]);
        rs = rsqrtf(tot * (1.0f / 1024.0f) + 1e-6f);
    }
    unsigned xn[8];
    {
        const f32x4 g0 = *(const f32x4*)(p.norm_ffn + 8 * lane), g1 = *(const f32x4*)(p.norm_ffn + 8 * lane + 4);
        const f32x4 g2 = *(const f32x4*)(p.norm_ffn + 512 + 8 * lane), g3 = *(const f32x4*)(p.norm_ffn + 512 + 8 * lane + 4);
        xn[0] = pack2(hv[0] * rs * g0[0], hv[1] * rs * g0[1]); xn[1] = pack2(hv[2] * rs * g0[2], hv[3] * rs * g0[3]);
        xn[2] = pack2(hv[4] * rs * g1[0], hv[5] * rs * g1[1]); xn[3] = pack2(hv[6] * rs * g1[2], hv[7] * rs * g1[3]);
        xn[4] = pack2(hv[8] * rs * g2[0], hv[9] * rs * g2[1]); xn[5] = pack2(hv[10] * rs * g2[2], hv[11] * rs * g2[3]);
        xn[6] = pack2(hv[12] * rs * g3[0], hv[13] * rs * g3[1]); xn[7] = pack2(hv[14] * rs * g3[2], hv[15] * rs * g3[3]);
    }
    const unsigned idpair = *((const unsigned*)(ws + OFF_SELID) + tok * 64 + lane);
    const f32x2 gpair = *((const f32x2*)(ws + OFF_SELG) + tok * 64 + lane);
    float acc[16];
#pragma unroll
    for (int i = 0; i < 16; ++i) acc[i] = 0.f;
    for (int eb = 0; eb < 128; eb += 4) {
        u32x4 U[4][2], V[4][2]; float gate[4];
#pragma unroll
        for (int j = 0; j < 4; ++j) {
            const int e = eb + j;
            const unsigned pr = __shfl(idpair, e >> 1);
            const unsigned id = (e & 1) ? (pr >> 16) : (pr & 0xFFFFu);
            const f32x2 gp = {__shfl(gpair[0], e >> 1), __shfl(gpair[1], e >> 1)};
            gate[j] = (e & 1) ? gp[1] : gp[0];
            const bf16_t* ur = UB + (size_t)id * 1024 + 8 * lane;
            const bf16_t* vr = VB + (size_t)id * 1024 + 8 * lane;
            U[j][0] = ldu4(ur); U[j][1] = ldu4(ur + 512);
            V[j][0] = ldu4(vr); V[j][1] = ldu4(vr + 512);
        }
#pragma unroll
        for (int j = 0; j < 4; ++j) {
            float d = 0.f;
#pragma unroll
            for (int q = 0; q < 4; ++q) { d = dot2bf(U[j][0][q], xn[q], d); d = dot2bf(U[j][1][q], xn[4 + q], d); }
#pragma unroll
            for (int o = 32; o; o >>= 1) d += __shfl_xor(d, o);
            const float cf = gate[j] * gelu_erf(d);
#pragma unroll
            for (int q = 0; q < 4; ++q) {
                acc[2 * q] += cf * bf_lo(V[j][0][q]); acc[2 * q + 1] += cf * bf_hi(V[j][0][q]);
                acc[8 + 2 * q] += cf * bf_lo(V[j][1][q]); acc[8 + 2 * q + 1] += cf * bf_hi(V[j][1][q]);
            }
        }
    }
    float ss = 0.f;
#pragma unroll
    for (int i = 0; i < 16; ++i) { acc[i] += hv[i]; ss += acc[i] * acc[i]; }
#pragma unroll
    for (int o = 32; o; o >>= 1) ss += __shfl_xor(ss, o);
    const float rf = rsqrtf(ss * (1.0f / 1024.0f) + 1e-6f);
    const f32x4 n0 = *(const f32x4*)(p.norm_final + 8 * lane), n1 = *(const f32x4*)(p.norm_final + 8 * lane + 4);
    const f32x4 n2 = *(const f32x4*)(p.norm_final + 512 + 8 * lane), n3 = *(const f32x4*)(p.norm_final + 512 + 8 * lane + 4);
    *(f32x4*)(hrow + 8 * lane) = (f32x4){acc[0] * rf * n0[0], acc[1] * rf * n0[1], acc[2] * rf * n0[2], acc[3] * rf * n0[3]};
    *(f32x4*)(hrow + 8 * lane + 4) = (f32x4){acc[4] * rf * n1[0], acc[5] * rf * n1[1], acc[6] * rf * n1[2], acc[7] * rf * n1[3]};
    *(f32x4*)(hrow + 512 + 8 * lane) = (f32x4){acc[8] * rf * n2[0], acc[9] * rf * n2[1], acc[10] * rf * n2[2], acc[11] * rf * n2[3]};
    *(f32x4*)(hrow + 512 + 8 * lane + 4) = (f32x4){acc[12] * rf * n3[0], acc[13] * rf * n3[1], acc[14] * rf * n3[2], acc[15] * rf * n3[3]};
}

DI void phase_gather(const Params& p) {
    const int lane = threadIdx.x & 63, wv = threadIdx.x >> 6;
    for (int item = blockIdx.x; item < T_TOK / 4; item += gridDim.x) gather_token(p, (size_t)item * 4 + wv, lane);
}
constexpr int LDS_BYTES = 66048;
constexpr int NPHASE = 12;
template <int PH> DI void run_phase(const Params& p, char* lds) {
    if (PH == 0) phase_prep(p, lds);
    else if (PH == 1) phase_p1(p, lds);
    else if (PH == 2) phase_p2(p, lds);
    else if (PH == 3) phase_p3(p, lds);
    else if (PH == 4) phase_p35(p, lds);
    else if (PH == 5) phase_resid(p, lds, OFF_WT_OUT, OFF_MIXED, p.x, OFF_SS1);
    else if (PH == 6) phase_rowscale(p, lds, OFF_WT_MQ, 1024, OFF_QM, OFF_SS1, 0.0625f * LOG2E);
    else if (PH == 7) phase_memattn(p, lds);
    else if (PH == 8) phase_resid(p, lds, OFF_WT_MO, OFF_OM, p.out, OFF_SS2);
    else if (PH == 9) phase_rowscale(p, lds, OFF_WT_PQ, 2048, OFF_PQ, OFF_SS2, 1.0f);
    else if (PH == 10) phase_select(p, lds);
    else if (PH == 11) phase_gather(p);
}

template <int PH> __global__ void __launch_bounds__(256, 2) k_phase(Params p) {
    __shared__ __attribute__((aligned(16))) char smem[LDS_BYTES];
    run_phase<PH>(p, smem);
}

static Params make_params(void* const* d_in, void* d_out, void* d_ws) {
    Params p;
    memset(&p, 0, sizeof(p));
    p.x = (const float*)d_in[0]; p.mem = (const float*)d_in[1]; p.norm_mix = (const float*)d_in[2]; p.w_in = (const float*)d_in[3];
    p.q_norm = (const float*)d_in[4]; p.kv_norm = (const float*)d_in[5]; p.w_uq = (const float*)d_in[6]; p.w_ukv = (const float*)d_in[7];
    p.gn_mla = (const float*)d_in[8]; p.gn_dil = (const float*)d_in[9]; p.w_out = (const float*)d_in[10]; p.norm_mem_q = (const float*)d_in[11];
    p.norm_mem_kv = (const float*)d_in[12]; p.w_mem_q = (const float*)d_in[13]; p.w_mem_kv = (const float*)d_in[14]; p.w_mem_o = (const float*)d_in[15];
    p.norm_ffn = (const float*)d_in[16]; p.peer_w_q = (const float*)d_in[17]; p.sub_keys = (const float*)d_in[18]; p.peer_u = (const float*)d_in[19];
    p.peer_v = (const float*)d_in[20]; p.norm_final = (const float*)d_in[21];
    p.out = (float*)d_out; p.ws = (char*)d_ws;
    for (int i = 0; i < 16; ++i) p.inv_freq[i] = 1.0f / powf(10000.0f, (float)(2 * i) / 32.0f);
    return p;
}
extern "C" void kernel_launch(void* const* d_in, const int* in_sizes, int n_in, void* d_out, int out_size, void* d_ws, size_t ws_size,
                              hipStream_t stream) {
    Params p = make_params(d_in, d_out, d_ws);
    const int G = 512;
    k_phase<0><<<G, 256, 0, stream>>>(p);
    k_phase<1><<<G, 256, 0, stream>>>(p);
    k_phase<2><<<G, 256, 0, stream>>>(p);
    k_phase<3><<<G, 256, 0, stream>>>(p);
    k_phase<4><<<G, 256, 0, stream>>>(p);
    k_phase<5><<<G, 256, 0, stream>>>(p);
    k_phase<6><<<G, 256, 0, stream>>>(p);
    k_phase<7><<<G, 256, 0, stream>>>(p);
    k_phase<8><<<G, 256, 0, stream>>>(p);
    k_phase<9><<<G, 256, 0, stream>>>(p);
    k_phase<10><<<G, 256, 0, stream>>>(p);
    k_phase<11><<<G, 256, 0, stream>>>(p);
}
```

```cpp
#include <hip/hip_runtime.h>
#include <hip/hip_cooperative_groups.h>
#include <math.h>
#include <stdint.h>
#include <stdio.h>
#include <string.h>
#define DI __device__ __forceinline__
typedef unsigned short bf16_t;
typedef short bf16x8 __attribute__((ext_vector_type(8)));
typedef short s16x4 __attribute__((ext_vector_type(4)));
typedef float f32x16 __attribute__((ext_vector_type(16)));
typedef float f32x4 __attribute__((ext_vector_type(4)));
typedef float f32x2 __attribute__((ext_vector_type(2)));
typedef unsigned u32x4 __attribute__((ext_vector_type(4)));
typedef unsigned u32x2 __attribute__((ext_vector_type(2)));
typedef __bf16 bf16x2v __attribute__((ext_vector_type(2)));
#define LAS __attribute__((address_space(3)))
#define MFMA32(a, b, c) __builtin_amdgcn_mfma_f32_32x32x16_bf16((a), (b), (c), 0, 0, 0)

constexpr int T_TOK = 16384, SEQ_L = 4096, DM = 1024, INC = 2208;
constexpr float LOG2E = 1.4426950408889634f;

DI unsigned pack2(float lo, float hi) { f32x2 f = {lo, hi}; return __builtin_bit_cast(unsigned, __builtin_convertvector(f, bf16x2v)); }
DI float bf_lo(unsigned u) { return __uint_as_float(u << 16); }
DI float bf_hi(unsigned u) { return __uint_as_float(u & 0xffff0000u); }
DI float bf2f(bf16_t v) { return __uint_as_float(((unsigned)v) << 16); }
DI int crow(int reg, int hh) { return (reg & 3) + 8 * (reg >> 2) + 4 * hh; }
DI f32x16 zero16() { f32x16 z;
#pragma unroll
    for (int i = 0; i < 16; ++i) z[i] = 0.f; return z; }
DI float xhalf_max(float v) { auto r = __builtin_amdgcn_permlane32_swap(__float_as_uint(v), __float_as_uint(v), false, false); return fmaxf(__uint_as_float(r[0]), __uint_as_float(r[1])); }
DI float xhalf_sum(float v) { auto r = __builtin_amdgcn_permlane32_swap(__float_as_uint(v), __float_as_uint(v), false, false); return __uint_as_float(r[0]) + __uint_as_float(r[1]); }
DI bf16x8 ld16(const void* p) { return *(const bf16x8*)p; }
DI u32x4 ldu4(const void* p) { return *(const u32x4*)p; }
DI float fast_exp2(float x) { return __builtin_amdgcn_exp2f(x); }
DI bf16x8 pack_step(const f32x16& x, int s) {
    u32x4 p;
    p[0] = pack2(x[8 * s + 0], x[8 * s + 1]); p[1] = pack2(x[8 * s + 2], x[8 * s + 3]);
    p[2] = pack2(x[8 * s + 4], x[8 * s + 5]); p[3] = pack2(x[8 * s + 6], x[8 * s + 7]);
    return __builtin_bit_cast(bf16x8, p);
}
DI s16x4 tr_read(unsigned lds_byte_addr) {
    return __builtin_amdgcn_ds_read_tr16_b64_v4i16((LAS s16x4*)(uintptr_t)lds_byte_addr);
}

constexpr size_t MiB = 1ull << 20;
constexpr size_t OFF_BAR = 0;
constexpr size_t OFF_WT_IN = 65536;
constexpr size_t OFF_WT_UQ = OFF_WT_IN + 2304ull * 1024 * 2;
constexpr size_t OFF_WT_UKV = OFF_WT_UQ + 768ull * 384 * 2;
constexpr size_t OFF_WT_OUT = OFF_WT_UKV + 1024ull * 256 * 2;
constexpr size_t OFF_WT_MQ = OFF_WT_OUT + 1024ull * 1024 * 2;
constexpr size_t OFF_WT_MKV = OFF_WT_MQ + 1024ull * 1024 * 2;
constexpr size_t OFF_WT_MO = OFF_WT_MKV + 2048ull * 1024 * 2;
constexpr size_t OFF_WT_PQ = OFF_WT_MO + 1024ull * 1024 * 2;
constexpr size_t OFF_KEYS = OFF_WT_PQ + 2048ull * 1024 * 2;
constexpr size_t OFF_ROPE = OFF_KEYS + 16ull * 128 * 128 * 2;
constexpr size_t OFF_KR = OFF_ROPE + 2ull * 4096 * 16 * 4;
constexpr size_t OFF_LSE = OFF_KR + (size_t)T_TOK * 32 * 2;
constexpr size_t OFF_SS1 = OFF_LSE + 3ull * T_TOK * 8 * 4;
constexpr size_t OFF_SS2 = OFF_SS1 + (size_t)T_TOK * 16 * 4;
constexpr size_t OFF_MEMN = OFF_SS2 + (size_t)T_TOK * 16 * 4;
constexpr size_t OFF_SMALL_END = OFF_MEMN + 1024ull * 1024 * 2;
static_assert(OFF_SMALL_END <= 28 * MiB, "small region overflow");
constexpr size_t OFF_A = 28 * MiB;
constexpr size_t OFF_PROJ = OFF_A;
constexpr size_t OFF_UB = OFF_A;
constexpr size_t OFF_VB = OFF_A + 32 * MiB;
constexpr size_t OFF_B = 97 * MiB;
constexpr size_t OFF_XN = OFF_B, OFF_QMLA = OFF_B, OFF_MIXED = OFF_B, OFF_QM = OFF_B;
constexpr size_t OFF_C = 129 * MiB;
constexpr size_t OFF_KVMLA = OFF_C, OFF_HB = OFF_C;
constexpr size_t OFF_D = 161 * MiB;
constexpr size_t OFF_ODIL = OFF_D, OFF_OMLA = OFF_D + 48 * MiB, OFF_OM = OFF_D, OFF_PQ = OFF_D;
constexpr size_t OFF_SELID = 225 * MiB;
constexpr size_t OFF_SELG = 229 * MiB;
constexpr size_t OFF_KVM = 237 * MiB;
constexpr size_t WS_NEEDED = 241 * MiB;

struct Params {
    const float* x; const float* mem; const float* norm_mix; const float* w_in; const float* q_norm; const float* kv_norm;
    const float* w_uq; const float* w_ukv; const float* gn_mla; const float* gn_dil; const float* w_out; const float* norm_mem_q;
    const float* norm_mem_kv; const float* w_mem_q; const float* w_mem_kv; const float* w_mem_o; const float* norm_ffn;
    const float* peer_w_q; const float* sub_keys; const float* peer_u; const float* peer_v; const float* norm_final;
    float* out; char* ws;
    float inv_freq[16];
};
#define XB_TMO      128
#define XB_XCNT(j)  (256  + 64 * (j))
#define XB_XSUB(j)  (1280 + 64 * (j))
#define XB_XGEN(j)  (2304 + 64 * (j))
#define XB_TOP      3328
#define XB_TOPGEN   3392
#define XCD_BAR_WORDS 3456
#define XB_SPIN_CAP (1u << 20)
DI unsigned xb_ld(unsigned* p) { return __hip_atomic_load(p, __ATOMIC_RELAXED, __HIP_MEMORY_SCOPE_AGENT); }
DI unsigned xb_add(unsigned* p, unsigned v) { return __hip_atomic_fetch_add(p, v, __ATOMIC_RELAXED, __HIP_MEMORY_SCOPE_AGENT); }
DI unsigned xb_xcc_id() { return (unsigned)__builtin_amdgcn_s_getreg((3 << 11) | 20) & 0xFu; }
#define XB_SPIN(cond, bar) do { unsigned _sp = 0; while (cond) { __builtin_amdgcn_s_sleep(1); \
    if ((++_sp & 255u) == 0u) { if (xb_ld(&(bar)[XB_TMO])) break; if (_sp > XB_SPIN_CAP) { atomicAdd(&(bar)[XB_TMO], 1u); break; } } } } while (0)
struct XcdBarrier { unsigned* bar; unsigned x; volatile LAS unsigned* st; };
DI XcdBarrier xcd_barrier_post(unsigned* bar, volatile LAS unsigned* st) {
    XcdBarrier b; b.bar = bar; b.x = xb_xcc_id(); b.st = st;
    if (threadIdx.x == 0) (void)xb_add(&bar[XB_XCNT(b.x)], 1u);
    return b;
}
DI void xcd_barrier_complete(unsigned* bar, unsigned x, unsigned& nloc, unsigned& nx) {
    const unsigned G = gridDim.x * gridDim.y * gridDim.z;
    unsigned sum, cnt, mine, sp = 0u;
    for (;;) {
        sum = 0u; cnt = 0u; mine = 0u;
#pragma unroll
        for (unsigned j = 0; j < 16; ++j) { const unsigned c = xb_ld(&bar[XB_XCNT(j)]); sum += c; cnt += (c > 0u) ? 1u : 0u; mine = (j == x) ? c : mine; }
        if (sum == G) break;
        __builtin_amdgcn_s_sleep(1);
        if ((++sp & 255u) == 0u) { if (xb_ld(&bar[XB_TMO])) break; if (sp > XB_SPIN_CAP) { atomicAdd(&bar[XB_TMO], 1u); break; } }
    }
    nloc = mine > 0u ? mine : 1u; nx = cnt > 0u ? cnt : 1u;
}
DI void xcd_barrier(const XcdBarrier& b) {
    asm volatile("s_waitcnt vmcnt(0)" ::: "memory");
    __syncthreads();
    if (threadIdx.x == 0) {
        unsigned* bar = b.bar;
        __builtin_amdgcn_s_waitcnt(0);
        unsigned nloc = b.st[0], nx = b.st[1];
        if (nloc == 0u) { xcd_barrier_complete(bar, b.x, nloc, nx); b.st[0] = nloc; b.st[1] = nx; }
        const unsigned old = xb_add(&bar[XB_XSUB(b.x)], 1u);
        const unsigned gen = old / nloc;
        if (old + 1u == (gen + 1u) * nloc) {
            __builtin_amdgcn_fence(__ATOMIC_RELEASE, "agent");
            asm volatile("s_waitcnt vmcnt(0)" ::: "memory");
            const unsigned og = xb_add(&bar[XB_TOP], 1u);
            const unsigned tg = og / nx;
            if (og + 1u == (tg + 1u) * nx) xb_add(&bar[XB_TOPGEN], 1u);
            else XB_SPIN(xb_ld(&bar[XB_TOPGEN]) == tg, bar);
            __builtin_amdgcn_fence(__ATOMIC_ACQUIRE, "agent");
            xb_add(&bar[XB_XGEN(b.x)], 1u);
            asm volatile("s_waitcnt vmcnt(0)" ::: "memory");
        } else {
            XB_SPIN(xb_ld(&bar[XB_XGEN(b.x)]) == gen, bar);
            __builtin_amdgcn_fence(__ATOMIC_ACQUIRE, "agent");
            asm volatile("s_waitcnt vmcnt(0)" ::: "memory");
        }
    }
    __syncthreads();
}
DI void transpose_tile(const float* __restrict__ W, int K, int N, const float* __restrict__ g, bf16_t* __restrict__ Wt, int kt, int nt, char* lds) {
    float* sm = (float*)lds;
    const int t = threadIdx.x;
    const int k0 = kt * 64, n0 = nt * 64;
    __syncthreads();
#pragma unroll
    for (int i = 0; i < 16; ++i) {
        const int id = t + 256 * i, k = id >> 6, n = id & 63;
        float v = 0.f;
        if (n0 + n < N) { v = W[(size_t)(k0 + k) * N + n0 + n]; if (g) v *= g[k0 + k]; }
        sm[k * 65 + n] = v;
    }
    __syncthreads();
    const int n = t >> 2, kc = (t & 3) * 16;
    u32x4 o0, o1;
    o0[0] = pack2(sm[(kc + 0) * 65 + n], sm[(kc + 1) * 65 + n]); o0[1] = pack2(sm[(kc + 2) * 65 + n], sm[(kc + 3) * 65 + n]);
    o0[2] = pack2(sm[(kc + 4) * 65 + n], sm[(kc + 5) * 65 + n]); o0[3] = pack2(sm[(kc + 6) * 65 + n], sm[(kc + 7) * 65 + n]);
    o1[0] = pack2(sm[(kc + 8) * 65 + n], sm[(kc + 9) * 65 + n]); o1[1] = pack2(sm[(kc + 10) * 65 + n], sm[(kc + 11) * 65 + n]);
    o1[2] = pack2(sm[(kc + 12) * 65 + n], sm[(kc + 13) * 65 + n]); o1[3] = pack2(sm[(kc + 14) * 65 + n], sm[(kc + 15) * 65 + n]);
    bf16_t* dst = Wt + (size_t)(n0 + n) * K + k0 + kc;
    *(u32x4*)dst = o0; *(u32x4*)(dst + 8) = o1;
}

DI void rmsnorm_row_bf16(const float* __restrict__ in, const float* __restrict__ g, bf16_t* __restrict__ out, int lane) {
    f32x4 v[4]; float ss = 0.f;
#pragma unroll
    for (int i = 0; i < 4; ++i) { v[i] = *(const f32x4*)(in + 4 * lane + 256 * i); ss += v[i][0] * v[i][0] + v[i][1] * v[i][1] + v[i][2] * v[i][2] + v[i][3] * v[i][3]; }
#pragma unroll
    for (int o = 32; o; o >>= 1) ss += __shfl_xor(ss, o);
    const float rs = rsqrtf(ss * (1.0f / 1024.0f) + 1e-6f);
#pragma unroll
    for (int i = 0; i < 4; ++i) {
        const f32x4 gg = *(const f32x4*)(g + 4 * lane + 256 * i);
        u32x2 o; o[0] = pack2(v[i][0] * rs * gg[0], v[i][1] * rs * gg[1]); o[1] = pack2(v[i][2] * rs * gg[2], v[i][3] * rs * gg[3]);
        *(u32x2*)(out + 4 * lane + 256 * i) = o;
    }
}

struct TrJob { const float* W; const float* g; size_t off; int K, N, Npad; };

DI void phase_prep(const Params& p, char* lds) {
    char* ws = p.ws;
    const int t = threadIdx.x, lane = t & 63, wv = t >> 6;
    const int c0 = 576, c1 = c0 + 72, c2 = c1 + 64, c3 = c2 + 256, c4 = c3 + 256, c5 = c4 + 512, c6 = c5 + 256, c7 = c6 + 512;
    const int nrow = (T_TOK + 1024) / 4;
    const int nkeys = 128, nrope = 256;
    const int total = c7 + nrow + nkeys + nrope;
    for (int item = blockIdx.x; item < total; item += gridDim.x) {
        if (item < c7) {
            const float* W; const float* g; size_t off; int K, N, Npad, local;
            if (item < c0)      { W = p.w_in;     g = nullptr;      off = OFF_WT_IN;  K = 1024; N = 2208; Npad = 2304; local = item; }
            else if (item < c1) { W = p.w_uq;     g = p.q_norm;     off = OFF_WT_UQ;  K = 384;  N = 768;  Npad = 768;  local = item - c0; }
            else if (item < c2) { W = p.w_ukv;    g = p.kv_norm;    off = OFF_WT_UKV; K = 256;  N = 1024; Npad = 1024; local = item - c1; }
            else if (item < c3) { W = p.w_out;    g = nullptr;      off = OFF_WT_OUT; K = 1024; N = 1024; Npad = 1024; local = item - c2; }
            else if (item < c4) { W = p.w_mem_q;  g = p.norm_mem_q; off = OFF_WT_MQ;  K = 1024; N = 1024; Npad = 1024; local = item - c3; }
            else if (item < c5) { W = p.w_mem_kv; g = nullptr;      off = OFF_WT_MKV; K = 1024; N = 2048; Npad = 2048; local = item - c4; }
            else if (item < c6) { W = p.w_mem_o;  g = nullptr;      off = OFF_WT_MO;  K = 1024; N = 1024; Npad = 1024; local = item - c5; }
            else                { W = p.peer_w_q; g = p.norm_ffn;   off = OFF_WT_PQ;  K = 1024; N = 2048; Npad = 2048; local = item - c6; }
            const int ntn = Npad / 64;
            transpose_tile(W, K, N, g, (bf16_t*)(ws + off), local / ntn, local % ntn, lds);
        } else if (item < c7 + nrow) {
            const int row = (item - c7) * 4 + wv;
            if (row < T_TOK) rmsnorm_row_bf16(p.x + (size_t)row * 1024, p.norm_mix, (bf16_t*)(ws + OFF_XN) + (size_t)row * 1024, lane);
            else rmsnorm_row_bf16(p.mem + (size_t)(row - T_TOK) * 1024, p.norm_mem_kv, (bf16_t*)(ws + OFF_MEMN) + (size_t)(row - T_TOK) * 1024, lane);
        } else if (item < c7 + nrow + nkeys) {
            const int idx = ((item - c7 - nrow) * 256 + t) * 8;
            const f32x4 a = *(const f32x4*)(p.sub_keys + idx), b = *(const f32x4*)(p.sub_keys + idx + 4);
            u32x4 o; o[0] = pack2(a[0], a[1]); o[1] = pack2(a[2], a[3]); o[2] = pack2(b[0], b[1]); o[3] = pack2(b[2], b[3]);
            *(u32x4*)((bf16_t*)(ws + OFF_KEYS) + idx) = o;
        } else {
            const int idx = (item - c7 - nrow - nkeys) * 256 + t;
            const int s = idx >> 4, i = idx & 15;
            const float ang = (float)s * p.inv_freq[i];
            const double a = (double)ang;
            const double twopi = 6.283185307179586476925;
            const float rf = (float)(a - twopi * rint(a / twopi));
            float* cs = (float*)(ws + OFF_ROPE);
            cs[idx] = cosf(rf); cs[65536 + idx] = sinf(rf);
        }
    }
}
constexpr int GEMM_STAGE = 32768;
constexpr int GEMM_LDS = 2 * GEMM_STAGE;
DI unsigned sw_off(int row, int chunk) { return (unsigned)(row * 128 + ((chunk ^ ((row >> 1) & 7)) << 4)); }

template <class Epi>
DI void gemm_tile(const bf16_t* __restrict__ Wt, const bf16_t* __restrict__ X, int ldx, int K, int n0, int m0, char* lds, const Epi& epi) {
    const int t = threadIdx.x, lane = t & 63, wv = t >> 6, r = lane & 31, hh = lane >> 5;
    const int wn = wv & 1, wm = wv >> 1;
    const int lrow = t >> 3, lch = t & 7;
    const bf16_t* wsrc = Wt + (size_t)(n0 + lrow) * K + lch * 8;
    const bf16_t* xsrc = X + (size_t)(m0 + lrow) * ldx + lch * 8;
    const size_t wstep = (size_t)32 * K, xstep = (size_t)32 * ldx;
    f32x16 acc[2][2];
#pragma unroll
    for (int i = 0; i < 2; ++i)
#pragma unroll
        for (int j = 0; j < 2; ++j) acc[i][j] = zero16();
    u32x4 wr[4], xr[4];
    const int nk = K >> 6;
#pragma unroll
    for (int i = 0; i < 4; ++i) { wr[i] = ldu4(wsrc + i * wstep); xr[i] = ldu4(xsrc + i * xstep); }
    __syncthreads();
#pragma unroll
    for (int i = 0; i < 4; ++i) {
        *(u32x4*)(lds + sw_off(lrow + 32 * i, lch)) = wr[i];
        *(u32x4*)(lds + 16384 + sw_off(lrow + 32 * i, lch)) = xr[i];
    }
    __syncthreads();
    for (int kt = 0; kt < nk; ++kt) {
        const bool more = (kt + 1 < nk);
        if (more) {
#pragma unroll
            for (int i = 0; i < 4; ++i) { wr[i] = ldu4(wsrc + i * wstep + (kt + 1) * 64); xr[i] = ldu4(xsrc + i * xstep + (kt + 1) * 64); }
        }
        const char* sb = lds + (kt & 1) * GEMM_STAGE;
#pragma unroll
        for (int s = 0; s < 4; ++s) {
            bf16x8 a[2], b[2];
#pragma unroll
            for (int i = 0; i < 2; ++i) a[i] = ld16(sb + sw_off(64 * wn + 32 * i + r, 2 * s + hh));
#pragma unroll
            for (int j = 0; j < 2; ++j) b[j] = ld16(sb + 16384 + sw_off(64 * wm + 32 * j + r, 2 * s + hh));
#pragma unroll
            for (int i = 0; i < 2; ++i)
#pragma unroll
                for (int j = 0; j < 2; ++j) acc[i][j] = MFMA32(a[i], b[j], acc[i][j]);
        }
        if (more) {
            char* nb = lds + ((kt + 1) & 1) * GEMM_STAGE;
#pragma unroll
            for (int i = 0; i < 4; ++i) {
                *(u32x4*)(nb + sw_off(lrow + 32 * i, lch)) = wr[i];
                *(u32x4*)(nb + 16384 + sw_off(lrow + 32 * i, lch)) = xr[i];
            }
        }
        __syncthreads();
    }
    epi(acc, n0 + 64 * wn, m0 + 64 * wm, r, hh);
}

DI u32x2 pack4(float a, float b, float c, float d) { u32x2 o; o[0] = pack2(a, b); o[1] = pack2(c, d); return o; }

struct EpiPlain {
    bf16_t* out; int ld;
    DI void operator()(const f32x16 (&acc)[2][2], int nb, int mb, int r, int hh) const {
#pragma unroll
        for (int i = 0; i < 2; ++i)
#pragma unroll
            for (int j = 0; j < 2; ++j) {
                bf16_t* row = out + (size_t)(mb + 32 * j + r) * ld + nb + 32 * i + 4 * hh;
#pragma unroll
                for (int g = 0; g < 4; ++g) *(u32x2*)(row + 8 * g) = pack4(acc[i][j][4 * g], acc[i][j][4 * g + 1], acc[i][j][4 * g + 2], acc[i][j][4 * g + 3]);
            }
    }
};

DI void rope_store(const f32x16& a, float scale, const float* __restrict__ cs, int pos, int hh, bf16_t* dst  ) {
#pragma unroll
    for (int g = 0; g < 2; ++g) {
        const f32x4 c = *(const f32x4*)(cs + pos * 16 + 8 * g + 4 * hh);
        const f32x4 s = *(const f32x4*)(cs + 65536 + pos * 16 + 8 * g + 4 * hh);
        float o1[4], o2[4];
#pragma unroll
        for (int e = 0; e < 4; ++e) {
            const float x1 = a[4 * g + e] * scale, x2 = a[4 * (g + 2) + e] * scale;
            o1[e] = x1 * c[e] - x2 * s[e];
            o2[e] = x2 * c[e] + x1 * s[e];
        }
        *(u32x2*)(dst + 8 * g + 4 * hh) = pack4(o1[0], o1[1], o1[2], o1[3]);
        *(u32x2*)(dst + 16 + 8 * g + 4 * hh) = pack4(o2[0], o2[1], o2[2], o2[3]);
    }
}

struct EpiProj {
    bf16_t* proj; bf16_t* kr; const float* cs;
    DI void operator()(const f32x16 (&acc)[2][2], int nb, int mb, int r, int hh) const {
#pragma unroll
        for (int i = 0; i < 2; ++i) {
            const int nsub = nb + 32 * i;
            if (nsub >= INC) continue;
#pragma unroll
            for (int j = 0; j < 2; ++j) {
                const int tok = mb + 32 * j + r;
                if (nsub == 640) {
                    rope_store(acc[i][j], 1.0f, cs, tok & (SEQ_L - 1), hh, kr + (size_t)tok * 32);
                } else {
                    const float sc = (nsub >= 672 && nsub < 1184) ? 0.125f * LOG2E : 1.0f;
                    bf16_t* row = proj + (size_t)tok * INC + nsub + 4 * hh;
#pragma unroll
                    for (int g = 0; g < 4; ++g)
                        *(u32x2*)(row + 8 * g) = pack4(acc[i][j][4 * g] * sc, acc[i][j][4 * g + 1] * sc, acc[i][j][4 * g + 2] * sc, acc[i][j][4 * g + 3] * sc);
                }
            }
        }
    }
};

struct EpiUpQ {
    bf16_t* q; const float* cs; const float* lds_rs;
    DI void operator()(const f32x16 (&acc)[2][2], int nb, int mb, int r, int hh) const {
        const float qs = 0.10206207261596575f * LOG2E;
#pragma unroll
        for (int j = 0; j < 2; ++j) {
            const int tl = (mb & 127) + 32 * j + r;
            const int tok = (mb & ~127) + tl;
            const float sc = lds_rs[tl] * qs;
#pragma unroll
            for (int i = 0; i < 2; ++i) {
                const int nsub = nb + 32 * i;
                if ((nsub % 96) == 64) {
                    rope_store(acc[i][j], sc, cs, tok & (SEQ_L - 1), hh, q + (size_t)tok * 768 + nsub);
                } else {
                    bf16_t* row = q + (size_t)tok * 768 + nsub + 4 * hh;
#pragma unroll
                    for (int g = 0; g < 4; ++g)
                        *(u32x2*)(row + 8 * g) = pack4(acc[i][j][4 * g] * sc, acc[i][j][4 * g + 1] * sc, acc[i][j][4 * g + 2] * sc, acc[i][j][4 * g + 3] * sc);
                }
            }
        }
    }
};

struct EpiUpKV {
    bf16_t* kv; const float* lds_rs;
    DI void operator()(const f32x16 (&acc)[2][2], int nb, int mb, int r, int hh) const {
#pragma unroll
        for (int j = 0; j < 2; ++j) {
            const int tl = (mb & 127) + 32 * j + r;
            const int tok = (mb & ~127) + tl;
            const float sc = lds_rs[tl];
#pragma unroll
            for (int i = 0; i < 2; ++i) {
                bf16_t* row = kv + (size_t)tok * 1024 + nb + 32 * i + 4 * hh;
#pragma unroll
                for (int g = 0; g < 4; ++g)
                    *(u32x2*)(row + 8 * g) = pack4(acc[i][j][4 * g] * sc, acc[i][j][4 * g + 1] * sc, acc[i][j][4 * g + 2] * sc, acc[i][j][4 * g + 3] * sc);
            }
        }
    }
};

struct EpiResid {
    const float* R; float* H; bf16_t* HB; float* SS;
    DI void operator()(const f32x16 (&acc)[2][2], int nb, int mb, int r, int hh) const {
#pragma unroll
        for (int j = 0; j < 2; ++j) {
            const int tok = mb + 32 * j + r;
            float ss = 0.f;
#pragma unroll
            for (int i = 0; i < 2; ++i) {
                const size_t base = (size_t)tok * 1024 + nb + 32 * i + 4 * hh;
#pragma unroll
                for (int g = 0; g < 4; ++g) {
                    f32x4 h = *(const f32x4*)(R + base + 8 * g);
                    h[0] += acc[i][j][4 * g]; h[1] += acc[i][j][4 * g + 1]; h[2] += acc[i][j][4 * g + 2]; h[3] += acc[i][j][4 * g + 3];
                    ss += h[0] * h[0] + h[1] * h[1] + h[2] * h[2] + h[3] * h[3];
                    *(f32x4*)(H + base + 8 * g) = h;
                    *(u32x2*)(HB + base + 8 * g) = pack4(h[0], h[1], h[2], h[3]);
                }
            }
            ss = xhalf_sum(ss);
            if (hh == 0) SS[(size_t)tok * 16 + (nb >> 6)] = ss;
        }
    }
};

struct EpiRowScale {
    bf16_t* out; int ld; const float* SS; float extra;
    DI void operator()(const f32x16 (&acc)[2][2], int nb, int mb, int r, int hh) const {
#pragma unroll
        for (int j = 0; j < 2; ++j) {
            const int tok = mb + 32 * j + r;
            const f32x4 s0 = *(const f32x4*)(SS + (size_t)tok * 16), s1 = *(const f32x4*)(SS + (size_t)tok * 16 + 4),
                        s2 = *(const f32x4*)(SS + (size_t)tok * 16 + 8), s3 = *(const f32x4*)(SS + (size_t)tok * 16 + 12);
            const float tot = (s0[0] + s0[1] + s0[2] + s0[3]) + (s1[0] + s1[1] + s1[2] + s1[3]) + (s2[0] + s2[1] + s2[2] + s2[3]) + (s3[0] + s3[1] + s3[2] + s3[3]);
            const float sc = rsqrtf(tot * (1.0f / 1024.0f) + 1e-6f) * extra;
#pragma unroll
            for (int i = 0; i < 2; ++i) {
                bf16_t* row = out + (size_t)tok * ld + nb + 32 * i + 4 * hh;
#pragma unroll
                for (int g = 0; g < 4; ++g)
                    *(u32x2*)(row + 8 * g) = pack4(acc[i][j][4 * g] * sc, acc[i][j][4 * g + 1] * sc, acc[i][j][4 * g + 2] * sc, acc[i][j][4 * g + 3] * sc);
            }
        }
    }
};

DI void compute_row_rs(const bf16_t* __restrict__ X, int ldx, int K, int m0, float* lds_rs) {
    const int t = threadIdx.x;
    const int tl = t >> 1, half = t & 1;
    const bf16_t* src = X + (size_t)(m0 + tl) * ldx + half * (K >> 1);
    float ss = 0.f;
    for (int c = 0; c < (K >> 4); ++c) {
        const u32x4 v = ldu4(src + c * 8);
#pragma unroll
        for (int e = 0; e < 4; ++e) { const float a = bf_lo(v[e]), b = bf_hi(v[e]); ss += a * a + b * b; }
    }
    ss += __shfl_xor(ss, 1);
    if (half == 0) lds_rs[tl] = rsqrtf(ss / (float)K + 1e-6f);
}

DI void phase_p1(const Params& p, char* lds) {
    char* ws = p.ws;
    const int nproj = 18 * 128, nkvm = 16 * 8;
    for (int item = blockIdx.x; item < nproj + nkvm; item += gridDim.x) {
        if (item < nproj) {
            const int nt = item % 18, mt = item / 18;
            EpiProj e{(bf16_t*)(ws + OFF_PROJ), (bf16_t*)(ws + OFF_KR), (const float*)(ws + OFF_ROPE)};
            gemm_tile((const bf16_t*)(ws + OFF_WT_IN), (const bf16_t*)(ws + OFF_XN), 1024, 1024, nt * 128, mt * 128, lds, e);
        } else {
            const int it = item - nproj, nt = it % 16, mt = it / 16;
            EpiPlain e{(bf16_t*)(ws + OFF_KVM), 2048};
            gemm_tile((const bf16_t*)(ws + OFF_WT_MKV), (const bf16_t*)(ws + OFF_MEMN), 1024, 1024, nt * 128, mt * 128, lds, e);
        }
    }
}

DI void phase_p2(const Params& p, char* lds) {
    char* ws = p.ws;
    float* lds_rs = (float*)(lds + GEMM_LDS);
    const int nq = 6 * 128, nkv = 8 * 128;
    for (int item = blockIdx.x; item < nq + nkv; item += gridDim.x) {
        __syncthreads();
        if (item < nq) {
            const int nt = item % 6, mt = item / 6;
            const bf16_t* X = (const bf16_t*)(ws + OFF_PROJ);
            compute_row_rs(X, INC, 384, mt * 128, lds_rs);
            EpiUpQ e{(bf16_t*)(ws + OFF_QMLA), (const float*)(ws + OFF_ROPE), lds_rs};
            gemm_tile((const bf16_t*)(ws + OFF_WT_UQ), X, INC, 384, nt * 128, mt * 128, lds, e);
        } else {
            const int it = item - nq, nt = it % 8, mt = it / 8;
            const bf16_t* X = (const bf16_t*)(ws + OFF_PROJ) + 384;
            compute_row_rs(X, INC, 256, mt * 128, lds_rs);
            EpiUpKV e{(bf16_t*)(ws + OFF_KVMLA), lds_rs};
            gemm_tile((const bf16_t*)(ws + OFF_WT_UKV), X, INC, 256, nt * 128, mt * 128, lds, e);
        }
    }
}

DI void phase_resid(const Params& p, char* lds, size_t off_w, size_t off_a, const float* R, size_t off_ss) {
    char* ws = p.ws;
    for (int item = blockIdx.x; item < 8 * 128; item += gridDim.x) {
        const int nt = item % 8, mt = item / 8;
        EpiResid e{R, p.out, (bf16_t*)(ws + OFF_HB), (float*)(ws + off_ss)};
        gemm_tile((const bf16_t*)(ws + off_w), (const bf16_t*)(ws + off_a), 1024, 1024, nt * 128, mt * 128, lds, e);
    }
}

DI void phase_rowscale(const Params& p, char* lds, size_t off_w, int N, size_t off_out, size_t off_ss, float extra) {
    char* ws = p.ws;
    const int ntn = N / 128;
    for (int item = blockIdx.x; item < ntn * 128; item += gridDim.x) {
        const int nt = item % ntn, mt = item / ntn;
        EpiRowScale e{(bf16_t*)(ws + off_out), N, (const float*)(ws + off_ss), extra};
        gemm_tile((const bf16_t*)(ws + off_w), (const bf16_t*)(ws + OFF_HB), 1024, 1024, nt * 128, mt * 128, lds, e);
    }
}
DI unsigned v128_off(int row, int chunk) { return (unsigned)(row * 128 + ((chunk ^ (((row >> 1) & 1) << 2)) << 4)); }
DI unsigned v128_tr_addr(unsigned base, int R0, int c, int lane) {
    const int blk = (lane >> 4) & 1, qq = (lane & 15) >> 2, pp = lane & 3;
    return base + v128_off(R0 + qq, 4 * c + 2 * blk + (pp >> 1)) + 8 * (pp & 1);
}
DI bf16x8 cat44(s16x4 lo, s16x4 hi) { return __builtin_shufflevector(lo, hi, 0, 1, 2, 3, 4, 5, 6, 7); }

constexpr int MLA_KROW = 208;
constexpr int MLA_STAGE = 64 * MLA_KROW + 64 * 128;
DI void mla_unit(const Params& p, char* lds, int b, int h, int qt) {
    char* ws = p.ws;
    const int t = threadIdx.x, lane = t & 63, wv = t >> 6, r = lane & 31, hh = lane >> 5;
    const bf16_t* Q = (const bf16_t*)(ws + OFF_QMLA);
    const bf16_t* KV = (const bf16_t*)(ws + OFF_KVMLA);
    const bf16_t* KR = (const bf16_t*)(ws + OFF_KR);
    const int q0 = qt * 128 + 32 * wv;
    const size_t tokq = (size_t)b * SEQ_L + q0 + r;
    bf16x8 qf[6];
#pragma unroll
    for (int s = 0; s < 6; ++s) qf[s] = ld16(Q + tokq * 768 + h * 96 + 16 * s + 8 * hh);
    f32x16 o[2]; o[0] = zero16(); o[1] = zero16();
    float m = -INFINITY, l = 0.f;
    int kkey[3], kc[3];
#pragma unroll
    for (int i = 0; i < 3; ++i) { const int id = t + 256 * i; kkey[i] = id / 12; kc[i] = id % 12; }
    const int vkey0 = t >> 3, vc = t & 7;
    const size_t tokb = (size_t)b * SEQ_L;
    const int ntiles = 2 * qt + 2;
    u32x4 kr_[3], vr_[2];
    auto load_tile = [&](int kt) {
#pragma unroll
        for (int i = 0; i < 3; ++i) {
            const size_t tk = tokb + 64 * kt + kkey[i];
            kr_[i] = (kc[i] < 8) ? ldu4(KV + tk * 1024 + h * 128 + 8 * kc[i]) : ldu4(KR + tk * 32 + 8 * (kc[i] - 8));
        }
#pragma unroll
        for (int i = 0; i < 2; ++i) {
            const size_t tk = tokb + 64 * kt + vkey0 + 32 * i;
            vr_[i] = ldu4(KV + tk * 1024 + h * 128 + 64 + 8 * vc);
        }
    };
    auto store_tile = [&](char* sb) {
#pragma unroll
        for (int i = 0; i < 3; ++i) *(u32x4*)(sb + kkey[i] * MLA_KROW + kc[i] * 16) = kr_[i];
#pragma unroll
        for (int i = 0; i < 2; ++i) *(u32x4*)(sb + 64 * MLA_KROW + v128_off(vkey0 + 32 * i, vc)) = vr_[i];
    };
    load_tile(0);
    __syncthreads();
    store_tile(lds);
    __syncthreads();
    for (int kt = 0; kt < ntiles; ++kt) {
        const bool more = (kt + 1 < ntiles);
        if (more) load_tile(kt + 1);
        const char* sb = lds + (kt & 1) * MLA_STAGE;
        const unsigned vb = (unsigned)(uintptr_t)(sb + 64 * MLA_KROW);
        f32x16 s[2];
#pragma unroll
        for (int k2 = 0; k2 < 2; ++k2) {
            s[k2] = zero16();
#pragma unroll
            for (int ss = 0; ss < 6; ++ss) s[k2] = MFMA32(ld16(sb + (32 * k2 + r) * MLA_KROW + (2 * ss + hh) * 16), qf[ss], s[k2]);
        }
        if (kt >= 2 * qt) {
            const int qpos = q0 + r;
#pragma unroll
            for (int k2 = 0; k2 < 2; ++k2)
#pragma unroll
                for (int i = 0; i < 16; ++i) { const int kpos = 64 * kt + 32 * k2 + crow(i, hh); if (kpos > qpos) s[k2][i] = -INFINITY; }
        }
        float mx = s[0][0];
#pragma unroll
        for (int k2 = 0; k2 < 2; ++k2)
#pragma unroll
            for (int i = 0; i < 16; ++i) mx = fmaxf(mx, s[k2][i]);
        mx = xhalf_max(mx);
        const float mn = fmaxf(m, mx);
        const float alpha = fast_exp2(m - mn);
        float ps = 0.f;
#pragma unroll
        for (int k2 = 0; k2 < 2; ++k2)
#pragma unroll
            for (int i = 0; i < 16; ++i) { const float e = fast_exp2(s[k2][i] - mn); s[k2][i] = e; ps += e; }
        l = l * alpha + ps;
        m = mn;
#pragma unroll
        for (int c = 0; c < 2; ++c)
#pragma unroll
            for (int i = 0; i < 16; ++i) o[c][i] *= alpha;
#pragma unroll
        for (int k2 = 0; k2 < 2; ++k2)
#pragma unroll
            for (int st = 0; st < 2; ++st) {
                const bf16x8 pb = pack_step(s[k2], st);
#pragma unroll
                for (int c = 0; c < 2; ++c) {
                    const s16x4 lo = tr_read(v128_tr_addr(vb, 32 * k2 + 16 * st + 4 * hh, c, lane));
                    const s16x4 hi = tr_read(v128_tr_addr(vb, 32 * k2 + 16 * st + 8 + 4 * hh, c, lane));
                    o[c] = MFMA32(cat44(lo, hi), pb, o[c]);
                }
            }
        if (more) store_tile(lds + ((kt + 1) & 1) * MLA_STAGE);
        __syncthreads();
    }
    const float inv = 1.0f / xhalf_sum(l);
    bf16_t* dst = (bf16_t*)(ws + OFF_OMLA) + tokq * 512 + h * 64 + 4 * hh;
#pragma unroll
    for (int c = 0; c < 2; ++c)
#pragma unroll
        for (int g = 0; g < 4; ++g)
            *(u32x2*)(dst + 32 * c + 8 * g) = pack4(o[c][4 * g] * inv, o[c][4 * g + 1] * inv, o[c][4 * g + 2] * inv, o[c][4 * g + 3] * inv);
}

DI void dil_unit(const Params& p, char* lds, int g, int b, int h, int rr, int lb) {
    char* ws = p.ws;
    const int t = threadIdx.x, lane = t & 63, wv = t >> 6, r = lane & 31, hh = lane >> 5;
    const int d = (g == 0) ? 1 : (g == 1 ? 4 : 16);
    const bf16_t* PJ = (const bf16_t*)(ws + OFF_PROJ);
    const size_t tokb = (size_t)b * SEQ_L;
    char* kimg = lds;
    char* vimg = lds + 32768;
    __syncthreads();
    {
        const int c = t & 7;
#pragma unroll
        for (int half = 0; half < 2; ++half) {
            u32x4 kk[4], vv[4];
#pragma unroll
            for (int i = 0; i < 4; ++i) {
                const int key = (t >> 3) + 32 * (4 * half + i);
                const int lk = 128 * lb - 128 + key;
                if (lk >= 0) {
                    const size_t tk = tokb + (size_t)lk * d + rr;
                    kk[i] = ldu4(PJ + tk * INC + 1184 + h * 64 + 8 * c);
                    vv[i] = ldu4(PJ + tk * INC + 1696 + h * 64 + 8 * c);
                } else { kk[i] = (u32x4){0u, 0u, 0u, 0u}; vv[i] = (u32x4){0u, 0u, 0u, 0u}; }
            }
#pragma unroll
            for (int i = 0; i < 4; ++i) {
                const int key = (t >> 3) + 32 * (4 * half + i);
                *(u32x4*)(kimg + sw_off(key, c)) = kk[i];
                *(u32x4*)(vimg + v128_off(key, c)) = vv[i];
            }
        }
    }
    const int lq = 128 * lb + 32 * wv + r;
    const size_t tokq = tokb + (size_t)lq * d + rr;
    bf16x8 qf[4];
#pragma unroll
    for (int s = 0; s < 4; ++s) qf[s] = ld16(PJ + tokq * INC + 672 + h * 64 + 16 * s + 8 * hh);
    __syncthreads();
    const float slope2 = exp2f(-(float)(h + 1)) * (float)d * LOG2E;
    const int u0 = (lb == 0) ? (4 - wv) : 0;
    f32x16 o[2]; o[0] = zero16(); o[1] = zero16();
    float m = -INFINITY, lsum = 0.f;
    const unsigned vb = (unsigned)(uintptr_t)vimg;
#pragma unroll 1
    for (int u = u0; u < 5; ++u) {
        const int rowb = 32 * (wv + u);
        f32x16 s = zero16();
#pragma unroll
        for (int ss = 0; ss < 4; ++ss) s = MFMA32(ld16(kimg + sw_off(rowb + r, 2 * ss + hh)), qf[ss], s);
        const int dbase = r + 128 - 32 * u;
        float mx = -INFINITY;
#pragma unroll
        for (int i = 0; i < 16; ++i) {
            const int dist = dbase - crow(i, hh);
            const bool valid = (dist >= 0) && (dist <= 128);
            const float v = valid ? (s[i] - slope2 * (float)dist) : -INFINITY;
            s[i] = v;
            mx = fmaxf(mx, v);
        }
        mx = xhalf_max(mx);
        const float mn = fmaxf(m, mx);
        const float alpha = fast_exp2(m - mn);
        float ps = 0.f;
#pragma unroll
        for (int i = 0; i < 16; ++i) { const float e = fast_exp2(s[i] - mn); s[i] = e; ps += e; }
        lsum = lsum * alpha + ps;
        m = mn;
#pragma unroll
        for (int c = 0; c < 2; ++c)
#pragma unroll
            for (int i = 0; i < 16; ++i) o[c][i] *= alpha;
#pragma unroll
        for (int st = 0; st < 2; ++st) {
            const bf16x8 pb = pack_step(s, st);
#pragma unroll
            for (int c = 0; c < 2; ++c) {
                const s16x4 lo = tr_read(v128_tr_addr(vb, rowb + 16 * st + 4 * hh, c, lane));
                const s16x4 hi = tr_read(v128_tr_addr(vb, rowb + 16 * st + 8 + 4 * hh, c, lane));
                o[c] = MFMA32(cat44(lo, hi), pb, o[c]);
            }
        }
    }
    const float ltot = xhalf_sum(lsum);
    const float mx = m;
    const float inv = 1.0f / ltot;
    bf16_t* dst = (bf16_t*)(ws + OFF_ODIL) + ((size_t)g * T_TOK + tokq) * 512 + h * 64 + 4 * hh;
#pragma unroll
    for (int c = 0; c < 2; ++c)
#pragma unroll
        for (int gg = 0; gg < 4; ++gg)
            *(u32x2*)(dst + 32 * c + 8 * gg) = pack4(o[c][4 * gg] * inv, o[c][4 * gg + 1] * inv, o[c][4 * gg + 2] * inv, o[c][4 * gg + 3] * inv);
    if (hh == 0) ((float*)(ws + OFF_LSE))[((size_t)g * T_TOK + tokq) * 8 + h] = mx + __log2f(ltot);
}

DI void phase_p3(const Params& p, char* lds) {
    for (int item = blockIdx.x; item < 512; item += gridDim.x) {
        const int b = item >> 7, h = (item >> 4) & 7, pr = item & 15;
#pragma unroll 1
        for (int rep = 0; rep < 2; ++rep) mla_unit(p, lds, b, h, rep ? pr : 31 - pr);
    }
    for (int u = blockIdx.x; u < 3072; u += gridDim.x) {
        const int g = u >> 10, rem = u & 1023, b = rem >> 8, h = (rem >> 5) & 7, k = rem & 31;
        int rr, lb;
        if (g == 0) { rr = 0; lb = k; } else if (g == 1) { rr = k >> 3; lb = k & 7; } else { rr = k >> 1; lb = k & 1; }
        dil_unit(p, lds, g, b, h, rr, lb);
    }
}

DI void phase_p35(const Params& p, char* lds) {
    char* ws = p.ws;
    const int t = threadIdx.x, lane = t & 63, wv = t >> 6;
    const int ntok = T_TOK / 4, ncv = 8192;
    for (int item = blockIdx.x; item < ntok + 2 * ncv; item += gridDim.x) {
        if (item < ntok) {
            const size_t tok = (size_t)item * 4 + wv;
            const int head = lane >> 3;
            const float* LS = (const float*)(ws + OFF_LSE);
            const float l0 = LS[tok * 8 + head], l1 = LS[((size_t)T_TOK + tok) * 8 + head], l2 = LS[((size_t)2 * T_TOK + tok) * 8 + head];
            const float mx = fmaxf(l0, fmaxf(l1, l2));
            float w0 = fast_exp2(l0 - mx), w1 = fast_exp2(l1 - mx), w2 = fast_exp2(l2 - mx);
            const float wi = 1.0f / (w0 + w1 + w2);
            w0 *= wi; w1 *= wi; w2 *= wi;
            const bf16_t* OD = (const bf16_t*)(ws + OFF_ODIL);
            const u32x4 a0 = ldu4(OD + tok * 512 + 8 * lane), a1 = ldu4(OD + ((size_t)T_TOK + tok) * 512 + 8 * lane),
                        a2 = ldu4(OD + ((size_t)2 * T_TOK + tok) * 512 + 8 * lane);
            const u32x4 am = ldu4((const bf16_t*)(ws + OFF_OMLA) + tok * 512 + 8 * lane);
            float od[8], om[8]; float sd = 0.f, sm = 0.f;
#pragma unroll
            for (int e = 0; e < 4; ++e) {
                od[2 * e] = w0 * bf_lo(a0[e]) + w1 * bf_lo(a1[e]) + w2 * bf_lo(a2[e]);
                od[2 * e + 1] = w0 * bf_hi(a0[e]) + w1 * bf_hi(a1[e]) + w2 * bf_hi(a2[e]);
                om[2 * e] = bf_lo(am[e]); om[2 * e + 1] = bf_hi(am[e]);
                sd += od[2 * e] * od[2 * e] + od[2 * e + 1] * od[2 * e + 1];
                sm += om[2 * e] * om[2 * e] + om[2 * e + 1] * om[2 * e + 1];
            }
#pragma unroll
            for (int o = 32; o; o >>= 1) { sd += __shfl_xor(sd, o); sm += __shfl_xor(sm, o); }
            const float rd = rsqrtf(sd * (1.0f / 512.0f) + 1e-6f), rm = rsqrtf(sm * (1.0f / 512.0f) + 1e-6f);
            const f32x4 gm0 = *(const f32x4*)(p.gn_mla + 8 * lane), gm1 = *(const f32x4*)(p.gn_mla + 8 * lane + 4);
            const f32x4 gd0 = *(const f32x4*)(p.gn_dil + 8 * lane), gd1 = *(const f32x4*)(p.gn_dil + 8 * lane + 4);
            u32x4 o1, o2;
            o1[0] = pack2(om[0] * rm * gm0[0], om[1] * rm * gm0[1]); o1[1] = pack2(om[2] * rm * gm0[2], om[3] * rm * gm0[3]);
            o1[2] = pack2(om[4] * rm * gm1[0], om[5] * rm * gm1[1]); o1[3] = pack2(om[6] * rm * gm1[2], om[7] * rm * gm1[3]);
            o2[0] = pack2(od[0] * rd * gd0[0], od[1] * rd * gd0[1]); o2[1] = pack2(od[2] * rd * gd0[2], od[3] * rd * gd0[3]);
            o2[2] = pack2(od[4] * rd * gd1[0], od[5] * rd * gd1[1]); o2[3] = pack2(od[6] * rd * gd1[2], od[7] * rd * gd1[3]);
            bf16_t* MX = (bf16_t*)(ws + OFF_MIXED) + tok * 1024;
            *(u32x4*)(MX + 8 * lane) = o1;
            *(u32x4*)(MX + 512 + 8 * lane) = o2;
        } else {
            const int it = item - ntok;
            const float* src = (it < ncv) ? p.peer_u : p.peer_v;
            bf16_t* dst = (bf16_t*)(ws + ((it < ncv) ? OFF_UB : OFF_VB));
            const size_t idx = ((size_t)(it % ncv) * 256 + t) * 8;
            const f32x4 a = *(const f32x4*)(src + idx), b = *(const f32x4*)(src + idx + 4);
            u32x4 o; o[0] = pack2(a[0], a[1]); o[1] = pack2(a[2], a[3]); o[2] = pack2(b[0], b[1]); o[3] = pack2(b[2], b[3]);
            *(u32x4*)(dst + idx) = o;
        }
    }
}

DI unsigned m512_off(int row, int chunk) { return (unsigned)(row * 512 + ((chunk ^ (row & 15)) << 4)); }
DI unsigned v512_off(int row, int chunk) { return (unsigned)(row * 512 + ((chunk ^ ((row & 3) << 2)) << 4)); }
DI void memattn_unit(const Params& p, char* lds, int b, int h, int tt) {
    char* ws = p.ws;
    const int t = threadIdx.x, lane = t & 63, wv = t >> 6, r = lane & 31, hh = lane >> 5;
    const int qg = wv & 1, dh = wv >> 1;
    const bf16_t* QM = (const bf16_t*)(ws + OFF_QM);
    const bf16_t* KVM = (const bf16_t*)(ws + OFF_KVM);
    const size_t tokq = (size_t)b * SEQ_L + tt * 64 + 32 * qg + r;
    bf16x8 qf[16];
#pragma unroll
    for (int s = 0; s < 16; ++s) qf[s] = ld16(QM + tokq * 1024 + h * 256 + 16 * s + 8 * hh);
    f32x16 o[4];
#pragma unroll
    for (int c = 0; c < 4; ++c) o[c] = zero16();
    float m = -INFINITY, l = 0.f;
    const int lkey = t >> 5, lc = t & 31;
    u32x4 kr_[4], vr_[4];
    auto load_tile = [&](int kt) {
#pragma unroll
        for (int i = 0; i < 4; ++i) {
            const size_t mrow = (size_t)b * 256 + 32 * kt + lkey + 8 * i;
            kr_[i] = ldu4(KVM + mrow * 2048 + h * 256 + 8 * lc);
            vr_[i] = ldu4(KVM + mrow * 2048 + 1024 + h * 256 + 8 * lc);
        }
    };
    auto store_tile = [&](char* sb) {
#pragma unroll
        for (int i = 0; i < 4; ++i) {
            *(u32x4*)(sb + m512_off(lkey + 8 * i, lc)) = kr_[i];
            *(u32x4*)(sb + 16384 + v512_off(lkey + 8 * i, lc)) = vr_[i];
        }
    };
    load_tile(0);
    __syncthreads();
    store_tile(lds);
    __syncthreads();
    for (int kt = 0; kt < 8; ++kt) {
        const bool more = (kt + 1 < 8);
        if (more) load_tile(kt + 1);
        const char* sb = lds + (kt & 1) * 32768;
        const unsigned vb = (unsigned)(uintptr_t)(sb + 16384);
        f32x16 s = zero16();
#pragma unroll
        for (int ss = 0; ss < 16; ++ss) s = MFMA32(ld16(sb + m512_off(r, 2 * ss + hh)), qf[ss], s);
        float mx = s[0];
#pragma unroll
        for (int i = 1; i < 16; ++i) mx = fmaxf(mx, s[i]);
        mx = xhalf_max(mx);
        const float mn = fmaxf(m, mx);
        const float alpha = fast_exp2(m - mn);
        float ps = 0.f;
#pragma unroll
        for (int i = 0; i < 16; ++i) { const float e = fast_exp2(s[i] - mn); s[i] = e; ps += e; }
        l = l * alpha + ps;
        m = mn;
#pragma unroll
        for (int c = 0; c < 4; ++c)
#pragma unroll
            for (int i = 0; i < 16; ++i) o[c][i] *= alpha;
        const int blk = (lane >> 4) & 1, qq = (lane & 15) >> 2, pp = lane & 3;
#pragma unroll
        for (int st = 0; st < 2; ++st) {
            const bf16x8 pb = pack_step(s, st);
#pragma unroll
            for (int c = 0; c < 4; ++c) {
                const int ch = 16 * dh + 4 * c + 2 * blk + (pp >> 1);
                const s16x4 lo = tr_read(vb + v512_off(16 * st + 4 * hh + qq, ch) + 8 * (pp & 1));
                const s16x4 hi = tr_read(vb + v512_off(16 * st + 8 + 4 * hh + qq, ch) + 8 * (pp & 1));
                o[c] = MFMA32(cat44(lo, hi), pb, o[c]);
            }
        }
        if (more) store_tile(lds + ((kt + 1) & 1) * 32768);
        __syncthreads();
    }
    const float inv = 1.0f / xhalf_sum(l);
    bf16_t* dst = (bf16_t*)(ws + OFF_OM) + tokq * 1024 + h * 256 + 128 * dh + 4 * hh;
#pragma unroll
    for (int c = 0; c < 4; ++c)
#pragma unroll
        for (int g = 0; g < 4; ++g)
            *(u32x2*)(dst + 32 * c + 8 * g) = pack4(o[c][4 * g] * inv, o[c][4 * g + 1] * inv, o[c][4 * g + 2] * inv, o[c][4 * g + 3] * inv);
}

DI void phase_memattn(const Params& p, char* lds) {
    for (int item = blockIdx.x; item < 1024; item += gridDim.x) {
        const int b = item >> 8, h = (item >> 6) & 3, tt = item & 63;
        memattn_unit(p, lds, b, h, tt);
    }
}
DI unsigned f2sort(float f) { const unsigned b = __float_as_uint(f); return b ^ ((b & 0x80000000u) ? 0xFFFFFFFFu : 0x80000000u); }
DI float sort2f(unsigned u) { const unsigned b = (u & 0x80000000u) ? (u ^ 0x80000000u) : ~u; return __uint_as_float(b); }
DI void cswap(unsigned& a, unsigned& b) { const unsigned hi = max(a, b), lo = min(a, b); a = hi; b = lo; }

template <int LO, int N> struct BClean {
    template <int M> static DI void run(unsigned (&a)[M]) {
#pragma unroll
        for (int i = 0; i < N / 2; ++i) cswap(a[LO + i], a[LO + i + N / 2]);
        BClean<LO, N / 2>::run(a); BClean<LO + N / 2, N / 2>::run(a);
    }
};
template <int LO> struct BClean<LO, 1> { template <int M> static DI void run(unsigned (&)[M]) {} };
template <int LO, int N> struct BSort {
    template <int M> static DI void run(unsigned (&a)[M]) {
        BSort<LO, N / 2>::run(a); BSort<LO + N / 2, N / 2>::run(a);
#pragma unroll
        for (int i = 0; i < N / 2; ++i) cswap(a[LO + i], a[LO + N - 1 - i]);
        BClean<LO, N / 2>::run(a); BClean<LO + N / 2, N / 2>::run(a);
    }
};
template <int LO> struct BSort<LO, 1> { template <int M> static DI void run(unsigned (&)[M]) {} };
DI void merge_top16(unsigned (&a)[16], const unsigned (&b)[16]) {
#pragma unroll
    for (int i = 0; i < 16; ++i) a[i] = max(a[i], b[15 - i]);
    BClean<0, 16>::run(a);
}

DI void peer_top16(const bf16_t* __restrict__ keys_hp, const bf16_t* __restrict__ pq_row_hp, int r, int hh, unsigned (&top)[16]) {
    bf16x8 qf[8];
#pragma unroll
    for (int s = 0; s < 8; ++s) qf[s] = ld16(pq_row_hp + 16 * s + 8 * hh);
    unsigned cur[16];
#pragma unroll
    for (int kt = 0; kt < 4; ++kt) {
        f32x16 acc = zero16();
#pragma unroll
        for (int s = 0; s < 8; ++s) acc = MFMA32(ld16(keys_hp + (size_t)(32 * kt + r) * 128 + 16 * s + 8 * hh), qf[s], acc);
        unsigned k[16];
#pragma unroll
        for (int i = 0; i < 16; ++i) k[i] = (f2sort(acc[i]) & ~0x7Fu) | (unsigned)(32 * kt + crow(i, hh));
        BSort<0, 16>::run(k);
        if (kt == 0) {
#pragma unroll
            for (int i = 0; i < 16; ++i) cur[i] = k[i];
        } else merge_top16(cur, k);
    }
    unsigned r0[16], r1[16];
#pragma unroll
    for (int i = 0; i < 16; ++i) { auto rr = __builtin_amdgcn_permlane32_swap(cur[i], cur[i], false, false); r0[i] = rr[0]; r1[i] = rr[1]; }
#pragma unroll
    for (int i = 0; i < 16; ++i) top[i] = max(r0[i], r1[15 - i]);
    BClean<0, 16>::run(top);
}

DI void peer_select_unit(const Params& p, char* lds, int mt, int h) {
    char* ws = p.ws;
    const int t = threadIdx.x, lane = t & 63, wv = t >> 6, r = lane & 31, hh = lane >> 5;
    const size_t tok = (size_t)mt * 128 + 32 * wv + r;
    const bf16_t* KEYS = (const bf16_t*)(ws + OFF_KEYS);
    const bf16_t* PQ = (const bf16_t*)(ws + OFF_PQ);
    unsigned tA[16], tB[16];
    peer_top16(KEYS + (size_t)(2 * h) * 16384, PQ + tok * 2048 + (2 * h) * 128, r, hh, tA);
    peer_top16(KEYS + (size_t)(2 * h + 1) * 16384, PQ + tok * 2048 + (2 * h + 1) * 128, r, hh, tB);
    float fA[16], fB[16];
#pragma unroll
    for (int i = 0; i < 16; ++i) { fA[i] = sort2f(tA[i] & ~0x7Fu); fB[i] = sort2f(tB[i] & ~0x7Fu); }
    unsigned* tab = (unsigned*)lds + wv * 1024;
    __syncthreads();
#pragma unroll
    for (int i = 0; i < 16; ++i) tab[i * 64 + lane] = (tA[i] & 0x7Fu) | ((tB[i] & 0x7Fu) << 16);
    unsigned c[64];
#pragma unroll
    for (int i = 0; i < 64; ++i) c[i] = 0u;
    {
        int n = 0;
#pragma unroll
        for (int a = 0; a < 16; ++a)
#pragma unroll
            for (int b = 0; b < 16; ++b)
                if ((a + 1) * (b + 1) <= 16) { c[n] = (f2sort(fA[a] + fB[b]) & ~0xFFu) | (unsigned)(a * 16 + b); ++n; }
    }
    unsigned g0[16], g1[16], g2[16], g3[16];
#pragma unroll
    for (int i = 0; i < 16; ++i) { g0[i] = c[i]; g1[i] = c[16 + i]; g2[i] = c[32 + i]; g3[i] = c[48 + i]; }
    BSort<0, 16>::run(g0); BSort<0, 16>::run(g1); BSort<0, 16>::run(g2); BSort<0, 16>::run(g3);
    merge_top16(g0, g1); merge_top16(g2, g3); merge_top16(g0, g2);
    float e[16]; float sum = 0.f;
    const float v0 = sort2f(g0[0] & ~0xFFu);
    unsigned ids[16];
#pragma unroll
    for (int i = 0; i < 16; ++i) {
        const float v = sort2f(g0[i] & ~0xFFu);
        e[i] = fast_exp2((v - v0) * LOG2E); sum += e[i];
        const unsigned a = (g0[i] >> 4) & 15u, b = g0[i] & 15u;
        const unsigned ia = tab[a * 64 + lane] & 0x7Fu, ib = (tab[b * 64 + lane] >> 16) & 0x7Fu;
        ids[i] = ia * 128u + ib;
    }
    const float inv = 1.0f / sum;
    if (hh == 0) {
        unsigned short* SID = (unsigned short*)(ws + OFF_SELID) + tok * 128 + h * 16;
        float* SG = (float*)(ws + OFF_SELG) + tok * 128 + h * 16;
        u32x4 w0, w1;
        w0[0] = ids[0] | (ids[1] << 16); w0[1] = ids[2] | (ids[3] << 16); w0[2] = ids[4] | (ids[5] << 16); w0[3] = ids[6] | (ids[7] << 16);
        w1[0] = ids[8] | (ids[9] << 16); w1[1] = ids[10] | (ids[11] << 16); w1[2] = ids[12] | (ids[13] << 16); w1[3] = ids[14] | (ids[15] << 16);
        *(u32x4*)SID = w0; *(u32x4*)(SID + 8) = w1;
#pragma unroll
        for (int q = 0; q < 4; ++q) *(f32x4*)(SG + 4 * q) = (f32x4){e[4 * q] * inv, e[4 * q + 1] * inv, e[4 * q + 2] * inv, e[4 * q + 3] * inv};
    }
}

DI void phase_select(const Params& p, char* lds) {
    for (int item = blockIdx.x; item < 1024; item += gridDim.x) peer_select_unit(p, lds, item >> 3, item & 7);
}

DI float gelu_erf(float a) { return 0.5f * a * (1.0f + erff(a * 0.70710678118654752f)); }
DI float dot2bf(unsigned a, unsigned b, float acc) { return __builtin_amdgcn_fdot2_f32_bf16(__builtin_bit_cast(bf16x2v, a), __builtin_bit_cast(bf16x2v, b), acc, false); }

DI void gather_token(const Params& p, size_t tok, int lane) {
    char* ws = p.ws;
    const bf16_t* UB = (const bf16_t*)(ws + OFF_UB);
    const bf16_t* VB = (const bf16_t*)(ws + OFF_VB);
    float* hrow = p.out + tok * 1024;
    float hv[16];
    {
        const f32x4 a0 = *(const f32x4*)(hrow + 8 * lane), a1 = *(const f32x4*)(hrow + 8 * lane + 4);
        const f32x4 b0 = *(const f32x4*)(hrow + 512 + 8 * lane), b1 = *(const f32x4*)(hrow + 512 + 8 * lane + 4);
#pragma unroll
        for (int e = 0; e < 4; ++e) { hv[e] = a0[e]; hv[4 + e] = a1[e]; hv[8 + e] = b0[e]; hv[12 + e] = b1[e]; }
    }
    float rs;
    {
        const float* SS = (const float*)(ws + OFF_SS2) + tok * 16;
        const f32x4 s0 = *(const f32x4*)SS, s1 = *(const f32x4*)(SS + 4), s2 = *(const f32x4*)(SS + 8), s3 = *(const f32x4*)(SS + 12);
        const float tot = (s0[0] + s0[1] + s0[2] + s0[3]) + (s1[0] + s1[1] + s1[2] + s1[3]) + (s2[0] + s2[1] + s2[2] + s2[3]) + (s3[0] + s3[1] + s3[2] + s3[3]);
        rs = rsqrtf(tot * (1.0f / 1024.0f) + 1e-6f);
    }
    unsigned xn[8];
    {
        const f32x4 g0 = *(const f32x4*)(p.norm_ffn + 8 * lane), g1 = *(const f32x4*)(p.norm_ffn + 8 * lane + 4);
        const f32x4 g2 = *(const f32x4*)(p.norm_ffn + 512 + 8 * lane), g3 = *(const f32x4*)(p.norm_ffn + 512 + 8 * lane + 4);
        xn[0] = pack2(hv[0] * rs * g0[0], hv[1] * rs * g0[1]); xn[1] = pack2(hv[2] * rs * g0[2], hv[3] * rs * g0[3]);
        xn[2] = pack2(hv[4] * rs * g1[0], hv[5] * rs * g1[1]); xn[3] = pack2(hv[6] * rs * g1[2], hv[7] * rs * g1[3]);
        xn[4] = pack2(hv[8] * rs * g2[0], hv[9] * rs * g2[1]); xn[5] = pack2(hv[10] * rs * g2[2], hv[11] * rs * g2[3]);
        xn[6] = pack2(hv[12] * rs * g3[0], hv[13] * rs * g3[1]); xn[7] = pack2(hv[14] * rs * g3[2], hv[15] * rs * g3[3]);
    }
    const unsigned idpair = *((const unsigned*)(ws + OFF_SELID) + tok * 64 + lane);
    const f32x2 gpair = *((const f32x2*)(ws + OFF_SELG) + tok * 64 + lane);
    float acc[16];
#pragma unroll
    for (int i = 0; i < 16; ++i) acc[i] = 0.f;
    for (int eb = 0; eb < 128; eb += 4) {
        u32x4 U[4][2], V[4][2]; float gate[4];
#pragma unroll
        for (int j = 0; j < 4; ++j) {
            const int e = eb + j;
            const unsigned pr = __shfl(idpair, e >> 1);
            const unsigned id = (e & 1) ? (pr >> 16) : (pr & 0xFFFFu);
            const f32x2 gp = {__shfl(gpair[0], e >> 1), __shfl(gpair[1], e >> 1)};
            gate[j] = (e & 1) ? gp[1] : gp[0];
            const bf16_t* ur = UB + (size_t)id * 1024 + 8 * lane;
            const bf16_t* vr = VB + (size_t)id * 1024 + 8 * lane;
            U[j][0] = ldu4(ur); U[j][1] = ldu4(ur + 512);
            V[j][0] = ldu4(vr); V[j][1] = ldu4(vr + 512);
        }
#pragma unroll
        for (int j = 0; j < 4; ++j) {
            float d = 0.f;
#pragma unroll
            for (int q = 0; q < 4; ++q) { d = dot2bf(U[j][0][q], xn[q], d); d = dot2bf(U[j][1][q], xn[4 + q], d); }
#pragma unroll
            for (int o = 32; o; o >>= 1) d += __shfl_xor(d, o);
            const float cf = gate[j] * gelu_erf(d);
#pragma unroll
            for (int q = 0; q < 4; ++q) {
                acc[2 * q] += cf * bf_lo(V[j][0][q]); acc[2 * q + 1] += cf * bf_hi(V[j][0][q]);
                acc[8 + 2 * q] += cf * bf_lo(V[j][1][q]); acc[8 + 2 * q + 1] += cf * bf_hi(V[j][1][q]);
            }
        }
    }
    float ss = 0.f;
#pragma unroll
    for (int i = 0; i < 16; ++i) { acc[i] += hv[i]; ss += acc[i] * acc[i]; }
#pragma unroll
    for (int o = 32; o; o >>= 1) ss += __shfl_xor(ss, o);
    const float rf = rsqrtf(ss * (1.0f / 1024.0f) + 1e-6f);
    const f32x4 n0 = *(const f32x4*)(p.norm_final + 8 * lane), n1 = *(const f32x4*)(p.norm_final + 8 * lane + 4);
    const f32x4 n2 = *(const f32x4*)(p.norm_final + 512 + 8 * lane), n3 = *(const f32x4*)(p.norm_final + 512 + 8 * lane + 4);
    *(f32x4*)(hrow + 8 * lane) = (f32x4){acc[0] * rf * n0[0], acc[1] * rf * n0[1], acc[2] * rf * n0[2], acc[3] * rf * n0[3]};
    *(f32x4*)(hrow + 8 * lane + 4) = (f32x4){acc[4] * rf * n1[0], acc[5] * rf * n1[1], acc[6] * rf * n1[2], acc[7] * rf * n1[3]};
    *(f32x4*)(hrow + 512 + 8 * lane) = (f32x4){acc[8] * rf * n2[0], acc[9] * rf * n2[1], acc[10] * rf * n2[2], acc[11] * rf * n2[3]};
    *(f32x4*)(hrow + 512 + 8 * lane + 4) = (f32x4){acc[12] * rf * n3[0], acc[13] * rf * n3[1], acc[14] * rf * n3[2], acc[15] * rf * n3[3]};
}

DI void phase_gather(const Params& p) {
    const int lane = threadIdx.x & 63, wv = threadIdx.x >> 6;
    for (int item = blockIdx.x; item < T_TOK / 4; item += gridDim.x) gather_token(p, (size_t)item * 4 + wv, lane);
}
constexpr int LDS_BYTES = 66048;
constexpr int NPHASE = 12;
template <int PH> DI void run_phase(const Params& p, char* lds) {
    if (PH == 0) phase_prep(p, lds);
    else if (PH == 1) phase_p1(p, lds);
    else if (PH == 2) phase_p2(p, lds);
    else if (PH == 3) phase_p3(p, lds);
    else if (PH == 4) phase_p35(p, lds);
    else if (PH == 5) phase_resid(p, lds, OFF_WT_OUT, OFF_MIXED, p.x, OFF_SS1);
    else if (PH == 6) phase_rowscale(p, lds, OFF_WT_MQ, 1024, OFF_QM, OFF_SS1, 0.0625f * LOG2E);
    else if (PH == 7) phase_memattn(p, lds);
    else if (PH == 8) phase_resid(p, lds, OFF_WT_MO, OFF_OM, p.out, OFF_SS2);
    else if (PH == 9) phase_rowscale(p, lds, OFF_WT_PQ, 2048, OFF_PQ, OFF_SS2, 1.0f);
    else if (PH == 10) phase_select(p, lds);
    else if (PH == 11) phase_gather(p);
}

template <int PH> __global__ void __launch_bounds__(256, 2) k_phase(Params p) {
    __shared__ __attribute__((aligned(16))) char smem[LDS_BYTES];
    run_phase<PH>(p, smem);
}

static Params make_params(void* const* d_in, void* d_out, void* d_ws) {
    Params p;
    memset(&p, 0, sizeof(p));
    p.x = (const float*)d_in[0]; p.mem = (const float*)d_in[1]; p.norm_mix = (const float*)d_in[2]; p.w_in = (const float*)d_in[3];
    p.q_norm = (const float*)d_in[4]; p.kv_norm = (const float*)d_in[5]; p.w_uq = (const float*)d_in[6]; p.w_ukv = (const float*)d_in[7];
    p.gn_mla = (const float*)d_in[8]; p.gn_dil = (const float*)d_in[9]; p.w_out = (const float*)d_in[10]; p.norm_mem_q = (const float*)d_in[11];
    p.norm_mem_kv = (const float*)d_in[12]; p.w_mem_q = (const float*)d_in[13]; p.w_mem_kv = (const float*)d_in[14]; p.w_mem_o = (const float*)d_in[15];
    p.norm_ffn = (const float*)d_in[16]; p.peer_w_q = (const float*)d_in[17]; p.sub_keys = (const float*)d_in[18]; p.peer_u = (const float*)d_in[19];
    p.peer_v = (const float*)d_in[20]; p.norm_final = (const float*)d_in[21];
    p.out = (float*)d_out; p.ws = (char*)d_ws;
    for (int i = 0; i < 16; ++i) p.inv_freq[i] = 1.0f / powf(10000.0f, (float)(2 * i) / 32.0f);
    return p;
}
__global__ void __launch_bounds__(256, 2) k_mega(Params p) {
    __shared__ __attribute__((aligned(16))) char smem[LDS_BYTES + 16];
    volatile LAS unsigned* st = (volatile LAS unsigned*)(LAS char*)(smem + LDS_BYTES);
    if (threadIdx.x == 0) { st[0] = 0u; st[1] = 0u; st[2] = 0u; st[3] = 0u; }
    __syncthreads();
    const XcdBarrier xb = xcd_barrier_post((unsigned*)(p.ws + OFF_BAR), st);
    run_phase<0>(p, smem);  xcd_barrier(xb);
    run_phase<1>(p, smem);  xcd_barrier(xb);
    run_phase<2>(p, smem);  xcd_barrier(xb);
    run_phase<3>(p, smem);  xcd_barrier(xb);
    run_phase<4>(p, smem);  xcd_barrier(xb);
    run_phase<5>(p, smem);  xcd_barrier(xb);
    run_phase<6>(p, smem);  xcd_barrier(xb);
    run_phase<7>(p, smem);  xcd_barrier(xb);
    run_phase<8>(p, smem);  xcd_barrier(xb);
    run_phase<9>(p, smem);  xcd_barrier(xb);
    run_phase<10>(p, smem); xcd_barrier(xb);
    run_phase<11>(p, smem);
}

extern "C" void kernel_launch(void* const* d_in, const int* in_sizes, int n_in, void* d_out, int out_size, void* d_ws, size_t ws_size,
                              hipStream_t stream) {
    static int grid_blocks = 0;
    if (!grid_blocks) {
        int dev = 0, cus = 0, per_cu = 0;
        (void)hipGetDevice(&dev);
        (void)hipDeviceGetAttribute(&cus, hipDeviceAttributeMultiprocessorCount, dev);
        (void)hipOccupancyMaxActiveBlocksPerMultiprocessor(&per_cu, k_mega, 256, 0);
        if (per_cu > 2) per_cu = 2;
        if (per_cu < 1) per_cu = 1;
        grid_blocks = cus * per_cu;
    }
    Params p = make_params(d_in, d_out, d_ws);
    (void)hipMemsetAsync((char*)d_ws + OFF_BAR, 0, XCD_BAR_WORDS * 4, stream);
    void* args[] = {&p};
    hipError_t e = hipLaunchCooperativeKernel((const void*)k_mega, dim3(grid_blocks), dim3(256), args, 0, stream);
    if (e != hipSuccess) fprintf(stderr, "cooperative launch failed: %s (grid %d)\n", hipGetErrorString(e), grid_blocks);
}
```

```cpp
#include <hip/hip_runtime.h>
#include <hip/hip_cooperative_groups.h>
#include <math.h>
#include <stdint.h>
#include <stdio.h>
#include <string.h>
#define DI __device__ __forceinline__
typedef unsigned short bf16_t;
typedef short bf16x8 __attribute__((ext_vector_type(8)));
typedef short s16x4 __attribute__((ext_vector_type(4)));
typedef float f32x16 __attribute__((ext_vector_type(16)));
typedef float f32x4 __attribute__((ext_vector_type(4)));
typedef float f32x2 __attribute__((ext_vector_type(2)));
typedef unsigned u32x4 __attribute__((ext_vector_type(4)));
typedef unsigned u32x2 __attribute__((ext_vector_type(2)));
typedef __bf16 bf16x2v __attribute__((ext_vector_type(2)));
#define LAS __attribute__((address_space(3)))
#define MFMA32(a, b, c) __builtin_amdgcn_mfma_f32_32x32x16_bf16((a), (b), (c), 0, 0, 0)

constexpr int T_TOK = 16384, SEQ_L = 4096, DM = 1024, INC = 2208;
constexpr float LOG2E = 1.4426950408889634f;

DI unsigned pack2(float lo, float hi) { f32x2 f = {lo, hi}; return __builtin_bit_cast(unsigned, __builtin_convertvector(f, bf16x2v)); }
DI float bf_lo(unsigned u) { return __uint_as_float(u << 16); }
DI float bf_hi(unsigned u) { return __uint_as_float(u & 0xffff0000u); }
DI float bf2f(bf16_t v) { return __uint_as_float(((unsigned)v) << 16); }
DI int crow(int reg, int hh) { return (reg & 3) + 8 * (reg >> 2) + 4 * hh; }
DI f32x16 zero16() { f32x16 z;
#pragma unroll
    for (int i = 0; i < 16; ++i) z[i] = 0.f; return z; }
DI float xhalf_max(float v) { auto r = __builtin_amdgcn_permlane32_swap(__float_as_uint(v), __float_as_uint(v), false, false); return fmaxf(__uint_as_float(r[0]), __uint_as_float(r[1])); }
DI float xhalf_sum(float v) { auto r = __builtin_amdgcn_permlane32_swap(__float_as_uint(v), __float_as_uint(v), false, false); return __uint_as_float(r[0]) + __uint_as_float(r[1]); }
DI bf16x8 ld16(const void* p) { return *(const bf16x8*)p; }
DI u32x4 ldu4(const void* p) { return *(const u32x4*)p; }
DI float fast_exp2(float x) { return __builtin_amdgcn_exp2f(x); }
DI bf16x8 pack_step(const f32x16& x, int s) {
    u32x4 p;
    p[0] = pack2(x[8 * s + 0], x[8 * s + 1]); p[1] = pack2(x[8 * s + 2], x[8 * s + 3]);
    p[2] = pack2(x[8 * s + 4], x[8 * s + 5]); p[3] = pack2(x[8 * s + 6], x[8 * s + 7]);
    return __builtin_bit_cast(bf16x8, p);
}
DI s16x4 tr_read(unsigned lds_byte_addr) {
    return __builtin_amdgcn_ds_read_tr16_b64_v4i16((LAS s16x4*)(uintptr_t)lds_byte_addr);
}

constexpr size_t MiB = 1ull << 20;
constexpr size_t OFF_BAR = 0;
constexpr size_t OFF_WT_IN = 65536;
constexpr size_t OFF_WT_UQ = OFF_WT_IN + 2304ull * 1024 * 2;
constexpr size_t OFF_WT_UKV = OFF_WT_UQ + 768ull * 384 * 2;
constexpr size_t OFF_WT_OUT = OFF_WT_UKV + 1024ull * 256 * 2;
constexpr size_t OFF_WT_MQ = OFF_WT_OUT + 1024ull * 1024 * 2;
constexpr size_t OFF_WT_MKV = OFF_WT_MQ + 1024ull * 1024 * 2;
constexpr size_t OFF_WT_MO = OFF_WT_MKV + 2048ull * 1024 * 2;
constexpr size_t OFF_WT_PQ = OFF_WT_MO + 1024ull * 1024 * 2;
constexpr size_t OFF_KEYS = OFF_WT_PQ + 2048ull * 1024 * 2;
constexpr size_t OFF_ROPE = OFF_KEYS + 16ull * 128 * 128 * 2;
constexpr size_t OFF_KR = OFF_ROPE + 2ull * 4096 * 16 * 4;
constexpr size_t OFF_LSE = OFF_KR + (size_t)T_TOK * 32 * 2;
constexpr size_t OFF_SS1 = OFF_LSE + 3ull * T_TOK * 8 * 4;
constexpr size_t OFF_SS2 = OFF_SS1 + (size_t)T_TOK * 16 * 4;
constexpr size_t OFF_MEMN = OFF_SS2 + (size_t)T_TOK * 16 * 4;
constexpr size_t OFF_SMALL_END = OFF_MEMN + 1024ull * 1024 * 2;
static_assert(OFF_SMALL_END <= 28 * MiB, "small region overflow");
constexpr size_t OFF_A = 28 * MiB;
constexpr size_t OFF_PROJ = OFF_A;
constexpr size_t OFF_UQ = OFF_A;
constexpr size_t OFF_VQ = OFF_A + 16 * MiB;
constexpr size_t OFF_SU = OFF_A + 32 * MiB;
constexpr size_t OFF_SV = OFF_SU + 65536;
constexpr size_t OFF_B = 97 * MiB;
constexpr size_t OFF_XN = OFF_B, OFF_QMLA = OFF_B, OFF_MIXED = OFF_B, OFF_QM = OFF_B;
constexpr size_t OFF_C = 129 * MiB;
constexpr size_t OFF_KVMLA = OFF_C, OFF_HB = OFF_C;
constexpr size_t OFF_D = 161 * MiB;
constexpr size_t OFF_ODIL = OFF_D, OFF_OMLA = OFF_D + 48 * MiB, OFF_OM = OFF_D, OFF_PQ = OFF_D;
constexpr size_t OFF_SELID = 225 * MiB;
constexpr size_t OFF_SELG = 229 * MiB;
constexpr size_t OFF_KVM = 237 * MiB;
constexpr size_t WS_NEEDED = 241 * MiB;

struct Params {
    const float* x; const float* mem; const float* norm_mix; const float* w_in; const float* q_norm; const float* kv_norm;
    const float* w_uq; const float* w_ukv; const float* gn_mla; const float* gn_dil; const float* w_out; const float* norm_mem_q;
    const float* norm_mem_kv; const float* w_mem_q; const float* w_mem_kv; const float* w_mem_o; const float* norm_ffn;
    const float* peer_w_q; const float* sub_keys; const float* peer_u; const float* peer_v; const float* norm_final;
    float* out; char* ws;
    float inv_freq[16];
    int prof; int pad_;
};
#define XB_TMO      128
#define XB_XCNT(j)  (256  + 64 * (j))
#define XB_XSUB(j)  (1280 + 64 * (j))
#define XB_XGEN(j)  (2304 + 64 * (j))
#define XB_TOP      3328
#define XB_TOPGEN   3392
#define XCD_BAR_WORDS 3456
#define XB_SPIN_CAP (1u << 20)
DI unsigned xb_ld(unsigned* p) { return __hip_atomic_load(p, __ATOMIC_RELAXED, __HIP_MEMORY_SCOPE_AGENT); }
DI unsigned xb_add(unsigned* p, unsigned v) { return __hip_atomic_fetch_add(p, v, __ATOMIC_RELAXED, __HIP_MEMORY_SCOPE_AGENT); }
DI unsigned xb_xcc_id() { return (unsigned)__builtin_amdgcn_s_getreg((3 << 11) | 20) & 0xFu; }
#define XB_SPIN(cond, bar) do { unsigned _sp = 0; while (cond) { __builtin_amdgcn_s_sleep(1); \
    if ((++_sp & 255u) == 0u) { if (xb_ld(&(bar)[XB_TMO])) break; if (_sp > XB_SPIN_CAP) { atomicAdd(&(bar)[XB_TMO], 1u); break; } } } } while (0)
struct XcdBarrier { unsigned* bar; unsigned x; volatile LAS unsigned* st; };
DI XcdBarrier xcd_barrier_post(unsigned* bar, volatile LAS unsigned* st) {
    XcdBarrier b; b.bar = bar; b.x = xb_xcc_id(); b.st = st;
    if (threadIdx.x == 0) (void)xb_add(&bar[XB_XCNT(b.x)], 1u);
    return b;
}
DI void xcd_barrier_complete(unsigned* bar, unsigned x, unsigned& nloc, unsigned& nx) {
    const unsigned G = gridDim.x * gridDim.y * gridDim.z;
    unsigned sum, cnt, mine, sp = 0u;
    for (;;) {
        sum = 0u; cnt = 0u; mine = 0u;
#pragma unroll
        for (unsigned j = 0; j < 16; ++j) { const unsigned c = xb_ld(&bar[XB_XCNT(j)]); sum += c; cnt += (c > 0u) ? 1u : 0u; mine = (j == x) ? c : mine; }
        if (sum == G) break;
        __builtin_amdgcn_s_sleep(1);
        if ((++sp & 255u) == 0u) { if (xb_ld(&bar[XB_TMO])) break; if (sp > XB_SPIN_CAP) { atomicAdd(&bar[XB_TMO], 1u); break; } }
    }
    nloc = mine > 0u ? mine : 1u; nx = cnt > 0u ? cnt : 1u;
}
DI void xcd_barrier(const XcdBarrier& b) {
    asm volatile("s_waitcnt vmcnt(0)" ::: "memory");
    __syncthreads();
    if (threadIdx.x == 0) {
        unsigned* bar = b.bar;
        __builtin_amdgcn_s_waitcnt(0);
        unsigned nloc = b.st[0], nx = b.st[1];
        if (nloc == 0u) { xcd_barrier_complete(bar, b.x, nloc, nx); b.st[0] = nloc; b.st[1] = nx; }
        const unsigned old = xb_add(&bar[XB_XSUB(b.x)], 1u);
        const unsigned gen = old / nloc;
        if (old + 1u == (gen + 1u) * nloc) {
            __builtin_amdgcn_fence(__ATOMIC_RELEASE, "agent");
            asm volatile("s_waitcnt vmcnt(0)" ::: "memory");
            const unsigned og = xb_add(&bar[XB_TOP], 1u);
            const unsigned tg = og / nx;
            if (og + 1u == (tg + 1u) * nx) xb_add(&bar[XB_TOPGEN], 1u);
            else XB_SPIN(xb_ld(&bar[XB_TOPGEN]) == tg, bar);
            __builtin_amdgcn_fence(__ATOMIC_ACQUIRE, "agent");
            xb_add(&bar[XB_XGEN(b.x)], 1u);
            asm volatile("s_waitcnt vmcnt(0)" ::: "memory");
        } else {
            XB_SPIN(xb_ld(&bar[XB_XGEN(b.x)]) == gen, bar);
            __builtin_amdgcn_fence(__ATOMIC_ACQUIRE, "agent");
            asm volatile("s_waitcnt vmcnt(0)" ::: "memory");
        }
    }
    __syncthreads();
}
DI void transpose_tile(const float* __restrict__ W, int K, int N, const float* __restrict__ g, bf16_t* __restrict__ Wt, int kt, int nt, char* lds) {
    float* sm = (float*)lds;
    const int t = threadIdx.x;
    const int k0 = kt * 64, n0 = nt * 64;
    __syncthreads();
#pragma unroll
    for (int i = 0; i < 16; ++i) {
        const int id = t + 256 * i, k = id >> 6, n = id & 63;
        float v = 0.f;
        if (n0 + n < N) { v = W[(size_t)(k0 + k) * N + n0 + n]; if (g) v *= g[k0 + k]; }
        sm[k * 65 + n] = v;
    }
    __syncthreads();
    const int n = t >> 2, kc = (t & 3) * 16;
    u32x4 o0, o1;
    o0[0] = pack2(sm[(kc + 0) * 65 + n], sm[(kc + 1) * 65 + n]); o0[1] = pack2(sm[(kc + 2) * 65 + n], sm[(kc + 3) * 65 + n]);
    o0[2] = pack2(sm[(kc + 4) * 65 + n], sm[(kc + 5) * 65 + n]); o0[3] = pack2(sm[(kc + 6) * 65 + n], sm[(kc + 7) * 65 + n]);
    o1[0] = pack2(sm[(kc + 8) * 65 + n], sm[(kc + 9) * 65 + n]); o1[1] = pack2(sm[(kc + 10) * 65 + n], sm[(kc + 11) * 65 + n]);
    o1[2] = pack2(sm[(kc + 12) * 65 + n], sm[(kc + 13) * 65 + n]); o1[3] = pack2(sm[(kc + 14) * 65 + n], sm[(kc + 15) * 65 + n]);
    bf16_t* dst = Wt + (size_t)(n0 + n) * K + k0 + kc;
    *(u32x4*)dst = o0; *(u32x4*)(dst + 8) = o1;
}

DI void rmsnorm_row_bf16(const float* __restrict__ in, const float* __restrict__ g, bf16_t* __restrict__ out, int lane) {
    f32x4 v[4]; float ss = 0.f;
#pragma unroll
    for (int i = 0; i < 4; ++i) { v[i] = *(const f32x4*)(in + 4 * lane + 256 * i); ss += v[i][0] * v[i][0] + v[i][1] * v[i][1] + v[i][2] * v[i][2] + v[i][3] * v[i][3]; }
#pragma unroll
    for (int o = 32; o; o >>= 1) ss += __shfl_xor(ss, o);
    const float rs = rsqrtf(ss * (1.0f / 1024.0f) + 1e-6f);
#pragma unroll
    for (int i = 0; i < 4; ++i) {
        const f32x4 gg = *(const f32x4*)(g + 4 * lane + 256 * i);
        u32x2 o; o[0] = pack2(v[i][0] * rs * gg[0], v[i][1] * rs * gg[1]); o[1] = pack2(v[i][2] * rs * gg[2], v[i][3] * rs * gg[3]);
        *(u32x2*)(out + 4 * lane + 256 * i) = o;
    }
}

struct TrJob { const float* W; const float* g; size_t off; int K, N, Npad; };

DI void phase_prep(const Params& p, char* lds) {
    char* ws = p.ws;
    const int t = threadIdx.x, lane = t & 63, wv = t >> 6;
    const int c0 = 576, c1 = c0 + 72, c2 = c1 + 64, c3 = c2 + 256, c4 = c3 + 256, c5 = c4 + 512, c6 = c5 + 256, c7 = c6 + 512;
    const int nrow = (T_TOK + 1024) / 4;
    const int nkeys = 128, nrope = 256;
    const int total = c7 + nrow + nkeys + nrope;
    for (int item = blockIdx.x; item < total; item += gridDim.x) {
        if (item < c7) {
            const float* W; const float* g; size_t off; int K, N, Npad, local;
            if (item < c0)      { W = p.w_in;     g = nullptr;      off = OFF_WT_IN;  K = 1024; N = 2208; Npad = 2304; local = item; }
            else if (item < c1) { W = p.w_uq;     g = p.q_norm;     off = OFF_WT_UQ;  K = 384;  N = 768;  Npad = 768;  local = item - c0; }
            else if (item < c2) { W = p.w_ukv;    g = p.kv_norm;    off = OFF_WT_UKV; K = 256;  N = 1024; Npad = 1024; local = item - c1; }
            else if (item < c3) { W = p.w_out;    g = nullptr;      off = OFF_WT_OUT; K = 1024; N = 1024; Npad = 1024; local = item - c2; }
            else if (item < c4) { W = p.w_mem_q;  g = p.norm_mem_q; off = OFF_WT_MQ;  K = 1024; N = 1024; Npad = 1024; local = item - c3; }
            else if (item < c5) { W = p.w_mem_kv; g = nullptr;      off = OFF_WT_MKV; K = 1024; N = 2048; Npad = 2048; local = item - c4; }
            else if (item < c6) { W = p.w_mem_o;  g = nullptr;      off = OFF_WT_MO;  K = 1024; N = 1024; Npad = 1024; local = item - c5; }
            else                { W = p.peer_w_q; g = p.norm_ffn;   off = OFF_WT_PQ;  K = 1024; N = 2048; Npad = 2048; local = item - c6; }
            const int ntn = Npad / 64;
            transpose_tile(W, K, N, g, (bf16_t*)(ws + off), local / ntn, local % ntn, lds);
        } else if (item < c7 + nrow) {
            const int row = (item - c7) * 4 + wv;
            if (row < T_TOK) rmsnorm_row_bf16(p.x + (size_t)row * 1024, p.norm_mix, (bf16_t*)(ws + OFF_XN) + (size_t)row * 1024, lane);
            else rmsnorm_row_bf16(p.mem + (size_t)(row - T_TOK) * 1024, p.norm_mem_kv, (bf16_t*)(ws + OFF_MEMN) + (size_t)(row - T_TOK) * 1024, lane);
        } else if (item < c7 + nrow + nkeys) {
            const int idx = ((item - c7 - nrow) * 256 + t) * 8;
            const f32x4 a = *(const f32x4*)(p.sub_keys + idx), b = *(const f32x4*)(p.sub_keys + idx + 4);
            u32x4 o; o[0] = pack2(a[0], a[1]); o[1] = pack2(a[2], a[3]); o[2] = pack2(b[0], b[1]); o[3] = pack2(b[2], b[3]);
            *(u32x4*)((bf16_t*)(ws + OFF_KEYS) + idx) = o;
        } else {
            const int idx = (item - c7 - nrow - nkeys) * 256 + t;
            const int s = idx >> 4, i = idx & 15;
            const float ang = (float)s * p.inv_freq[i];
            const double a = (double)ang;
            const double twopi = 6.283185307179586476925;
            const float rf = (float)(a - twopi * rint(a / twopi));
            float* cs = (float*)(ws + OFF_ROPE);
            cs[idx] = cosf(rf); cs[65536 + idx] = sinf(rf);
        }
    }
}
constexpr int GEMM_STAGE = 32768;
constexpr int GEMM_LDS = 2 * GEMM_STAGE;
DI unsigned sw_off(int row, int chunk) { return (unsigned)(row * 128 + ((chunk ^ ((row >> 1) & 7)) << 4)); }

template <class Epi>
DI void gemm_tile(const bf16_t* __restrict__ Wt, const bf16_t* __restrict__ X, int ldx, int K, int n0, int m0, char* lds, const Epi& epi) {
    const int t = threadIdx.x, lane = t & 63, wv = t >> 6, r = lane & 31, hh = lane >> 5;
    const int wn = wv & 1, wm = wv >> 1;
    const int lrow = t >> 3, lch = t & 7;
    const bf16_t* wsrc = Wt + (size_t)(n0 + lrow) * K + lch * 8;
    const bf16_t* xsrc = X + (size_t)(m0 + lrow) * ldx + lch * 8;
    const size_t wstep = (size_t)32 * K, xstep = (size_t)32 * ldx;
    f32x16 acc[2][2];
#pragma unroll
    for (int i = 0; i < 2; ++i)
#pragma unroll
        for (int j = 0; j < 2; ++j) acc[i][j] = zero16();
    u32x4 wr[4], xr[4];
    const int nk = K >> 6;
#pragma unroll
    for (int i = 0; i < 4; ++i) { wr[i] = ldu4(wsrc + i * wstep); xr[i] = ldu4(xsrc + i * xstep); }
    __syncthreads();
#pragma unroll
    for (int i = 0; i < 4; ++i) {
        *(u32x4*)(lds + sw_off(lrow + 32 * i, lch)) = wr[i];
        *(u32x4*)(lds + 16384 + sw_off(lrow + 32 * i, lch)) = xr[i];
    }
    __syncthreads();
    for (int kt = 0; kt < nk; ++kt) {
        const bool more = (kt + 1 < nk);
        if (more) {
#pragma unroll
            for (int i = 0; i < 4; ++i) { wr[i] = ldu4(wsrc + i * wstep + (kt + 1) * 64); xr[i] = ldu4(xsrc + i * xstep + (kt + 1) * 64); }
        }
        const char* sb = lds + (kt & 1) * GEMM_STAGE;
#pragma unroll
        for (int s = 0; s < 4; ++s) {
            bf16x8 a[2], b[2];
#pragma unroll
            for (int i = 0; i < 2; ++i) a[i] = ld16(sb + sw_off(64 * wn + 32 * i + r, 2 * s + hh));
#pragma unroll
            for (int j = 0; j < 2; ++j) b[j] = ld16(sb + 16384 + sw_off(64 * wm + 32 * j + r, 2 * s + hh));
#pragma unroll
            for (int i = 0; i < 2; ++i)
#pragma unroll
                for (int j = 0; j < 2; ++j) acc[i][j] = MFMA32(a[i], b[j], acc[i][j]);
        }
        if (more) {
            char* nb = lds + ((kt + 1) & 1) * GEMM_STAGE;
#pragma unroll
            for (int i = 0; i < 4; ++i) {
                *(u32x4*)(nb + sw_off(lrow + 32 * i, lch)) = wr[i];
                *(u32x4*)(nb + 16384 + sw_off(lrow + 32 * i, lch)) = xr[i];
            }
        }
        __syncthreads();
    }
    epi(acc, n0 + 64 * wn, m0 + 64 * wm, r, hh);
}

DI u32x2 pack4(float a, float b, float c, float d) { u32x2 o; o[0] = pack2(a, b); o[1] = pack2(c, d); return o; }

struct EpiPlain {
    bf16_t* out; int ld;
    DI void operator()(const f32x16 (&acc)[2][2], int nb, int mb, int r, int hh) const {
#pragma unroll
        for (int i = 0; i < 2; ++i)
#pragma unroll
            for (int j = 0; j < 2; ++j) {
                bf16_t* row = out + (size_t)(mb + 32 * j + r) * ld + nb + 32 * i + 4 * hh;
#pragma unroll
                for (int g = 0; g < 4; ++g) *(u32x2*)(row + 8 * g) = pack4(acc[i][j][4 * g], acc[i][j][4 * g + 1], acc[i][j][4 * g + 2], acc[i][j][4 * g + 3]);
            }
    }
};

DI void rope_store(const f32x16& a, float scale, const float* __restrict__ cs, int pos, int hh, bf16_t* dst  ) {
#pragma unroll
    for (int g = 0; g < 2; ++g) {
        const f32x4 c = *(const f32x4*)(cs + pos * 16 + 8 * g + 4 * hh);
        const f32x4 s = *(const f32x4*)(cs + 65536 + pos * 16 + 8 * g + 4 * hh);
        float o1[4], o2[4];
#pragma unroll
        for (int e = 0; e < 4; ++e) {
            const float x1 = a[4 * g + e] * scale, x2 = a[4 * (g + 2) + e] * scale;
            o1[e] = x1 * c[e] - x2 * s[e];
            o2[e] = x2 * c[e] + x1 * s[e];
        }
        *(u32x2*)(dst + 8 * g + 4 * hh) = pack4(o1[0], o1[1], o1[2], o1[3]);
        *(u32x2*)(dst + 16 + 8 * g + 4 * hh) = pack4(o2[0], o2[1], o2[2], o2[3]);
    }
}

struct EpiProj {
    bf16_t* proj; bf16_t* kr; const float* cs;
    DI void operator()(const f32x16 (&acc)[2][2], int nb, int mb, int r, int hh) const {
#pragma unroll
        for (int i = 0; i < 2; ++i) {
            const int nsub = nb + 32 * i;
            if (nsub >= INC) continue;
#pragma unroll
            for (int j = 0; j < 2; ++j) {
                const int tok = mb + 32 * j + r;
                if (nsub == 640) {
                    rope_store(acc[i][j], 1.0f, cs, tok & (SEQ_L - 1), hh, kr + (size_t)tok * 32);
                } else {
                    const float sc = (nsub >= 672 && nsub < 1184) ? 0.125f * LOG2E : 1.0f;
                    bf16_t* row = proj + (size_t)tok * INC + nsub + 4 * hh;
#pragma unroll
                    for (int g = 0; g < 4; ++g)
                        *(u32x2*)(row + 8 * g) = pack4(acc[i][j][4 * g] * sc, acc[i][j][4 * g + 1] * sc, acc[i][j][4 * g + 2] * sc, acc[i][j][4 * g + 3] * sc);
                }
            }
        }
    }
};

struct EpiUpQ {
    bf16_t* q; const float* cs; const float* lds_rs;
    DI void operator()(const f32x16 (&acc)[2][2], int nb, int mb, int r, int hh) const {
        const float qs = 0.10206207261596575f * LOG2E;
#pragma unroll
        for (int j = 0; j < 2; ++j) {
            const int tl = (mb & 127) + 32 * j + r;
            const int tok = (mb & ~127) + tl;
            const float sc = lds_rs[tl] * qs;
#pragma unroll
            for (int i = 0; i < 2; ++i) {
                const int nsub = nb + 32 * i;
                if ((nsub % 96) == 64) {
                    rope_store(acc[i][j], sc, cs, tok & (SEQ_L - 1), hh, q + (size_t)tok * 768 + nsub);
                } else {
                    bf16_t* row = q + (size_t)tok * 768 + nsub + 4 * hh;
#pragma unroll
                    for (int g = 0; g < 4; ++g)
                        *(u32x2*)(row + 8 * g) = pack4(acc[i][j][4 * g] * sc, acc[i][j][4 * g + 1] * sc, acc[i][j][4 * g + 2] * sc, acc[i][j][4 * g + 3] * sc);
                }
            }
        }
    }
};

struct EpiUpKV {
    bf16_t* kv; const float* lds_rs;
    DI void operator()(const f32x16 (&acc)[2][2], int nb, int mb, int r, int hh) const {
#pragma unroll
        for (int j = 0; j < 2; ++j) {
            const int tl = (mb & 127) + 32 * j + r;
            const int tok = (mb & ~127) + tl;
            const float sc = lds_rs[tl];
#pragma unroll
            for (int i = 0; i < 2; ++i) {
                bf16_t* row = kv + (size_t)tok * 1024 + nb + 32 * i + 4 * hh;
#pragma unroll
                for (int g = 0; g < 4; ++g)
                    *(u32x2*)(row + 8 * g) = pack4(acc[i][j][4 * g] * sc, acc[i][j][4 * g + 1] * sc, acc[i][j][4 * g + 2] * sc, acc[i][j][4 * g + 3] * sc);
            }
        }
    }
};

struct EpiResid {
    const float* R; float* H; bf16_t* HB; float* SS;
    DI void operator()(const f32x16 (&acc)[2][2], int nb, int mb, int r, int hh) const {
#pragma unroll
        for (int j = 0; j < 2; ++j) {
            const int tok = mb + 32 * j + r;
            float ss = 0.f;
#pragma unroll
            for (int i = 0; i < 2; ++i) {
                const size_t base = (size_t)tok * 1024 + nb + 32 * i + 4 * hh;
#pragma unroll
                for (int g = 0; g < 4; ++g) {
                    f32x4 h = *(const f32x4*)(R + base + 8 * g);
                    h[0] += acc[i][j][4 * g]; h[1] += acc[i][j][4 * g + 1]; h[2] += acc[i][j][4 * g + 2]; h[3] += acc[i][j][4 * g + 3];
                    ss += h[0] * h[0] + h[1] * h[1] + h[2] * h[2] + h[3] * h[3];
                    *(f32x4*)(H + base + 8 * g) = h;
                    *(u32x2*)(HB + base + 8 * g) = pack4(h[0], h[1], h[2], h[3]);
                }
            }
            ss = xhalf_sum(ss);
            if (hh == 0) SS[(size_t)tok * 16 + (nb >> 6)] = ss;
        }
    }
};

struct EpiRowScale {
    bf16_t* out; int ld; const float* SS; float extra;
    DI void operator()(const f32x16 (&acc)[2][2], int nb, int mb, int r, int hh) const {
#pragma unroll
        for (int j = 0; j < 2; ++j) {
            const int tok = mb + 32 * j + r;
            const f32x4 s0 = *(const f32x4*)(SS + (size_t)tok * 16), s1 = *(const f32x4*)(SS + (size_t)tok * 16 + 4),
                        s2 = *(const f32x4*)(SS + (size_t)tok * 16 + 8), s3 = *(const f32x4*)(SS + (size_t)tok * 16 + 12);
            const float tot = (s0[0] + s0[1] + s0[2] + s0[3]) + (s1[0] + s1[1] + s1[2] + s1[3]) + (s2[0] + s2[1] + s2[2] + s2[3]) + (s3[0] + s3[1] + s3[2] + s3[3]);
            const float sc = rsqrtf(tot * (1.0f / 1024.0f) + 1e-6f) * extra;
#pragma unroll
            for (int i = 0; i < 2; ++i) {
                bf16_t* row = out + (size_t)tok * ld + nb + 32 * i + 4 * hh;
#pragma unroll
                for (int g = 0; g < 4; ++g)
                    *(u32x2*)(row + 8 * g) = pack4(acc[i][j][4 * g] * sc, acc[i][j][4 * g + 1] * sc, acc[i][j][4 * g + 2] * sc, acc[i][j][4 * g + 3] * sc);
            }
        }
    }
};

DI void compute_row_rs(const bf16_t* __restrict__ X, int ldx, int K, int m0, float* lds_rs) {
    const int t = threadIdx.x;
    const int tl = t >> 1, half = t & 1;
    const bf16_t* src = X + (size_t)(m0 + tl) * ldx + half * (K >> 1);
    float ss = 0.f;
    for (int c = 0; c < (K >> 4); ++c) {
        const u32x4 v = ldu4(src + c * 8);
#pragma unroll
        for (int e = 0; e < 4; ++e) { const float a = bf_lo(v[e]), b = bf_hi(v[e]); ss += a * a + b * b; }
    }
    ss += __shfl_xor(ss, 1);
    if (half == 0) lds_rs[tl] = rsqrtf(ss / (float)K + 1e-6f);
}

DI void phase_p1(const Params& p, char* lds) {
    char* ws = p.ws;
    const int nproj = 18 * 128, nkvm = 16 * 8;
    for (int item = blockIdx.x; item < nproj + nkvm; item += gridDim.x) {
        if (item < nproj) {
            const int nt = item % 18, mt = item / 18;
            EpiProj e{(bf16_t*)(ws + OFF_PROJ), (bf16_t*)(ws + OFF_KR), (const float*)(ws + OFF_ROPE)};
            gemm_tile((const bf16_t*)(ws + OFF_WT_IN), (const bf16_t*)(ws + OFF_XN), 1024, 1024, nt * 128, mt * 128, lds, e);
        } else {
            const int it = item - nproj, nt = it % 16, mt = it / 16;
            EpiPlain e{(bf16_t*)(ws + OFF_KVM), 2048};
            gemm_tile((const bf16_t*)(ws + OFF_WT_MKV), (const bf16_t*)(ws + OFF_MEMN), 1024, 1024, nt * 128, mt * 128, lds, e);
        }
    }
}

DI void phase_p2(const Params& p, char* lds) {
    char* ws = p.ws;
    float* lds_rs = (float*)(lds + GEMM_LDS);
    const int nq = 6 * 128, nkv = 8 * 128;
    for (int item = blockIdx.x; item < nq + nkv; item += gridDim.x) {
        __syncthreads();
        if (item < nq) {
            const int nt = item % 6, mt = item / 6;
            const bf16_t* X = (const bf16_t*)(ws + OFF_PROJ);
            compute_row_rs(X, INC, 384, mt * 128, lds_rs);
            EpiUpQ e{(bf16_t*)(ws + OFF_QMLA), (const float*)(ws + OFF_ROPE), lds_rs};
            gemm_tile((const bf16_t*)(ws + OFF_WT_UQ), X, INC, 384, nt * 128, mt * 128, lds, e);
        } else {
            const int it = item - nq, nt = it % 8, mt = it / 8;
            const bf16_t* X = (const bf16_t*)(ws + OFF_PROJ) + 384;
            compute_row_rs(X, INC, 256, mt * 128, lds_rs);
            EpiUpKV e{(bf16_t*)(ws + OFF_KVMLA), lds_rs};
            gemm_tile((const bf16_t*)(ws + OFF_WT_UKV), X, INC, 256, nt * 128, mt * 128, lds, e);
        }
    }
}

DI void phase_resid(const Params& p, char* lds, size_t off_w, size_t off_a, const float* R, size_t off_ss, bool dry = false) {
    char* ws = p.ws;
    for (int item = blockIdx.x; item < 8 * 128; item += gridDim.x) {
        const int nt = item % 8, mt = item / 8;
        EpiResid e{R, p.out, (bf16_t*)(ws + OFF_HB), (float*)(ws + off_ss)};
        if (dry) { e.H = (float*)(ws + OFF_B) - (size_t)((mt * 128) & ~8191) * 1024; e.HB = (bf16_t*)(ws + 193 * MiB); e.SS = (float*)(ws + OFF_SS1); }
        gemm_tile((const bf16_t*)(ws + off_w), (const bf16_t*)(ws + off_a), 1024, 1024, nt * 128, mt * 128, lds, e);
    }
}

DI void phase_rowscale(const Params& p, char* lds, size_t off_w, int N, size_t off_out, size_t off_ss, float extra) {
    char* ws = p.ws;
    const int ntn = N / 128;
    for (int item = blockIdx.x; item < ntn * 128; item += gridDim.x) {
        const int nt = item % ntn, mt = item / ntn;
        EpiRowScale e{(bf16_t*)(ws + off_out), N, (const float*)(ws + off_ss), extra};
        gemm_tile((const bf16_t*)(ws + off_w), (const bf16_t*)(ws + OFF_HB), 1024, 1024, nt * 128, mt * 128, lds, e);
    }
}
DI unsigned v128_off(int row, int chunk) { return (unsigned)(row * 128 + ((chunk ^ (((row >> 1) & 1) << 2)) << 4)); }
DI unsigned v128_tr_addr(unsigned base, int R0, int c, int lane) {
    const int blk = (lane >> 4) & 1, qq = (lane & 15) >> 2, pp = lane & 3;
    return base + v128_off(R0 + qq, 4 * c + 2 * blk + (pp >> 1)) + 8 * (pp & 1);
}
DI bf16x8 cat44(s16x4 lo, s16x4 hi) { return __builtin_shufflevector(lo, hi, 0, 1, 2, 3, 4, 5, 6, 7); }

constexpr int MLA_KROW = 208;
constexpr int MLA_STAGE = 64 * MLA_KROW + 64 * 128;
DI void mla_unit(const Params& p, char* lds, int b, int h, int qt) {
    char* ws = p.ws;
    const int t = threadIdx.x, lane = t & 63, wv = t >> 6, r = lane & 31, hh = lane >> 5;
    const bf16_t* Q = (const bf16_t*)(ws + OFF_QMLA);
    const bf16_t* KV = (const bf16_t*)(ws + OFF_KVMLA);
    const bf16_t* KR = (const bf16_t*)(ws + OFF_KR);
    const int q0 = qt * 128 + 32 * wv;
    const size_t tokq = (size_t)b * SEQ_L + q0 + r;
    bf16x8 qf[6];
#pragma unroll
    for (int s = 0; s < 6; ++s) qf[s] = ld16(Q + tokq * 768 + h * 96 + 16 * s + 8 * hh);
    f32x16 o[2]; o[0] = zero16(); o[1] = zero16();
    float m = -INFINITY, l = 0.f;
    int kkey[3], kc[3];
#pragma unroll
    for (int i = 0; i < 3; ++i) { const int id = t + 256 * i; kkey[i] = id / 12; kc[i] = id % 12; }
    const int vkey0 = t >> 3, vc = t & 7;
    const size_t tokb = (size_t)b * SEQ_L;
    const int ntiles = 2 * qt + 2;
    u32x4 kr_[3], vr_[2];
    auto load_tile = [&](int kt) {
#pragma unroll
        for (int i = 0; i < 3; ++i) {
            const size_t tk = tokb + 64 * kt + kkey[i];
            kr_[i] = (kc[i] < 8) ? ldu4(KV + tk * 1024 + h * 128 + 8 * kc[i]) : ldu4(KR + tk * 32 + 8 * (kc[i] - 8));
        }
#pragma unroll
        for (int i = 0; i < 2; ++i) {
            const size_t tk = tokb + 64 * kt + vkey0 + 32 * i;
            vr_[i] = ldu4(KV + tk * 1024 + h * 128 + 64 + 8 * vc);
        }
    };
    auto store_tile = [&](char* sb) {
#pragma unroll
        for (int i = 0; i < 3; ++i) *(u32x4*)(sb + kkey[i] * MLA_KROW + kc[i] * 16) = kr_[i];
#pragma unroll
        for (int i = 0; i < 2; ++i) *(u32x4*)(sb + 64 * MLA_KROW + v128_off(vkey0 + 32 * i, vc)) = vr_[i];
    };
    load_tile(0);
    __syncthreads();
    store_tile(lds);
    __syncthreads();
    for (int kt = 0; kt < ntiles; ++kt) {
        const bool more = (kt + 1 < ntiles);
        if (more) load_tile(kt + 1);
        const char* sb = lds + (kt & 1) * MLA_STAGE;
        const unsigned vb = (unsigned)(uintptr_t)(sb + 64 * MLA_KROW);
        f32x16 s[2];
#pragma unroll
        for (int k2 = 0; k2 < 2; ++k2) {
            s[k2] = zero16();
#pragma unroll
            for (int ss = 0; ss < 6; ++ss) s[k2] = MFMA32(ld16(sb + (32 * k2 + r) * MLA_KROW + (2 * ss + hh) * 16), qf[ss], s[k2]);
        }
        if (kt >= 2 * qt) {
            const int qpos = q0 + r;
#pragma unroll
            for (int k2 = 0; k2 < 2; ++k2)
#pragma unroll
                for (int i = 0; i < 16; ++i) { const int kpos = 64 * kt + 32 * k2 + crow(i, hh); if (kpos > qpos) s[k2][i] = -INFINITY; }
        }
        float mx = s[0][0];
#pragma unroll
        for (int k2 = 0; k2 < 2; ++k2)
#pragma unroll
            for (int i = 0; i < 16; ++i) mx = fmaxf(mx, s[k2][i]);
        mx = xhalf_max(mx);
        const float mn = fmaxf(m, mx);
        const float alpha = fast_exp2(m - mn);
        float ps = 0.f;
#pragma unroll
        for (int k2 = 0; k2 < 2; ++k2)
#pragma unroll
            for (int i = 0; i < 16; ++i) { const float e = fast_exp2(s[k2][i] - mn); s[k2][i] = e; ps += e; }
        l = l * alpha + ps;
        m = mn;
#pragma unroll
        for (int c = 0; c < 2; ++c)
#pragma unroll
            for (int i = 0; i < 16; ++i) o[c][i] *= alpha;
#pragma unroll
        for (int k2 = 0; k2 < 2; ++k2)
#pragma unroll
            for (int st = 0; st < 2; ++st) {
                const bf16x8 pb = pack_step(s[k2], st);
#pragma unroll
                for (int c = 0; c < 2; ++c) {
                    const s16x4 lo = tr_read(v128_tr_addr(vb, 32 * k2 + 16 * st + 4 * hh, c, lane));
                    const s16x4 hi = tr_read(v128_tr_addr(vb, 32 * k2 + 16 * st + 8 + 4 * hh, c, lane));
                    o[c] = MFMA32(cat44(lo, hi), pb, o[c]);
                }
            }
        if (more) store_tile(lds + ((kt + 1) & 1) * MLA_STAGE);
        __syncthreads();
    }
    const float inv = 1.0f / xhalf_sum(l);
    bf16_t* dst = (bf16_t*)(ws + OFF_OMLA) + tokq * 512 + h * 64 + 4 * hh;
#pragma unroll
    for (int c = 0; c < 2; ++c)
#pragma unroll
        for (int g = 0; g < 4; ++g)
            *(u32x2*)(dst + 32 * c + 8 * g) = pack4(o[c][4 * g] * inv, o[c][4 * g + 1] * inv, o[c][4 * g + 2] * inv, o[c][4 * g + 3] * inv);
}

DI void dil_unit(const Params& p, char* lds, int g, int b, int h, int rr, int lb) {
    char* ws = p.ws;
    const int t = threadIdx.x, lane = t & 63, wv = t >> 6, r = lane & 31, hh = lane >> 5;
    const int d = (g == 0) ? 1 : (g == 1 ? 4 : 16);
    const bf16_t* PJ = (const bf16_t*)(ws + OFF_PROJ);
    const size_t tokb = (size_t)b * SEQ_L;
    char* kimg = lds;
    char* vimg = lds + 32768;
    __syncthreads();
    {
        const int c = t & 7;
#pragma unroll
        for (int half = 0; half < 2; ++half) {
            u32x4 kk[4], vv[4];
#pragma unroll
            for (int i = 0; i < 4; ++i) {
                const int key = (t >> 3) + 32 * (4 * half + i);
                const int lk = 128 * lb - 128 + key;
                if (lk >= 0) {
                    const size_t tk = tokb + (size_t)lk * d + rr;
                    kk[i] = ldu4(PJ + tk * INC + 1184 + h * 64 + 8 * c);
                    vv[i] = ldu4(PJ + tk * INC + 1696 + h * 64 + 8 * c);
                } else { kk[i] = (u32x4){0u, 0u, 0u, 0u}; vv[i] = (u32x4){0u, 0u, 0u, 0u}; }
            }
#pragma unroll
            for (int i = 0; i < 4; ++i) {
                const int key = (t >> 3) + 32 * (4 * half + i);
                *(u32x4*)(kimg + sw_off(key, c)) = kk[i];
                *(u32x4*)(vimg + v128_off(key, c)) = vv[i];
            }
        }
    }
    const int lq = 128 * lb + 32 * wv + r;
    const size_t tokq = tokb + (size_t)lq * d + rr;
    bf16x8 qf[4];
#pragma unroll
    for (int s = 0; s < 4; ++s) qf[s] = ld16(PJ + tokq * INC + 672 + h * 64 + 16 * s + 8 * hh);
    __syncthreads();
    const float slope2 = exp2f(-(float)(h + 1)) * (float)d * LOG2E;
    const int u0 = (lb == 0) ? (4 - wv) : 0;
    f32x16 o[2]; o[0] = zero16(); o[1] = zero16();
    float m = -INFINITY, lsum = 0.f;
    const unsigned vb = (unsigned)(uintptr_t)vimg;
#pragma unroll 1
    for (int u = u0; u < 5; ++u) {
        const int rowb = 32 * (wv + u);
        f32x16 s = zero16();
#pragma unroll
        for (int ss = 0; ss < 4; ++ss) s = MFMA32(ld16(kimg + sw_off(rowb + r, 2 * ss + hh)), qf[ss], s);
        const int dbase = r + 128 - 32 * u;
        float mx = -INFINITY;
#pragma unroll
        for (int i = 0; i < 16; ++i) {
            const int dist = dbase - crow(i, hh);
            const bool valid = (dist >= 0) && (dist <= 128);
            const float v = valid ? (s[i] - slope2 * (float)dist) : -INFINITY;
            s[i] = v;
            mx = fmaxf(mx, v);
        }
        mx = xhalf_max(mx);
        const float mn = fmaxf(m, mx);
        const float alpha = fast_exp2(m - mn);
        float ps = 0.f;
#pragma unroll
        for (int i = 0; i < 16; ++i) { const float e = fast_exp2(s[i] - mn); s[i] = e; ps += e; }
        lsum = lsum * alpha + ps;
        m = mn;
#pragma unroll
        for (int c = 0; c < 2; ++c)
#pragma unroll
            for (int i = 0; i < 16; ++i) o[c][i] *= alpha;
#pragma unroll
        for (int st = 0; st < 2; ++st) {
            const bf16x8 pb = pack_step(s, st);
#pragma unroll
            for (int c = 0; c < 2; ++c) {
                const s16x4 lo = tr_read(v128_tr_addr(vb, rowb + 16 * st + 4 * hh, c, lane));
                const s16x4 hi = tr_read(v128_tr_addr(vb, rowb + 16 * st + 8 + 4 * hh, c, lane));
                o[c] = MFMA32(cat44(lo, hi), pb, o[c]);
            }
        }
    }
    const float ltot = xhalf_sum(lsum);
    const float mx = m;
    const float inv = 1.0f / ltot;
    bf16_t* dst = (bf16_t*)(ws + OFF_ODIL) + ((size_t)g * T_TOK + tokq) * 512 + h * 64 + 4 * hh;
#pragma unroll
    for (int c = 0; c < 2; ++c)
#pragma unroll
        for (int gg = 0; gg < 4; ++gg)
            *(u32x2*)(dst + 32 * c + 8 * gg) = pack4(o[c][4 * gg] * inv, o[c][4 * gg + 1] * inv, o[c][4 * gg + 2] * inv, o[c][4 * gg + 3] * inv);
    if (hh == 0) ((float*)(ws + OFF_LSE))[((size_t)g * T_TOK + tokq) * 8 + h] = mx + __log2f(ltot);
}

DI void phase_p3(const Params& p, char* lds) {
    for (int item = blockIdx.x; item < 512; item += gridDim.x) {
        const int b = item >> 7, h = (item >> 4) & 7, pr = item & 15;
#pragma unroll 1
        for (int rep = 0; rep < 2; ++rep) mla_unit(p, lds, b, h, rep ? pr : 31 - pr);
    }
    for (int u = blockIdx.x; u < 3072; u += gridDim.x) {
        const int g = u >> 10, rem = u & 1023, b = rem >> 8, h = (rem >> 5) & 7, k = rem & 31;
        int rr, lb;
        if (g == 0) { rr = 0; lb = k; } else if (g == 1) { rr = k >> 3; lb = k & 7; } else { rr = k >> 1; lb = k & 1; }
        dil_unit(p, lds, g, b, h, rr, lb);
    }
}

DI void phase_p35(const Params& p, char* lds) {
    char* ws = p.ws;
    const int t = threadIdx.x, lane = t & 63, wv = t >> 6;
    const int ntok = T_TOK / 4, ncv = 4096;
    for (int item = blockIdx.x; item < ntok + 2 * ncv; item += gridDim.x) {
        if (item < ntok) {
            const size_t tok = (size_t)item * 4 + wv;
            const int head = lane >> 3;
            const float* LS = (const float*)(ws + OFF_LSE);
            const float l0 = LS[tok * 8 + head], l1 = LS[((size_t)T_TOK + tok) * 8 + head], l2 = LS[((size_t)2 * T_TOK + tok) * 8 + head];
            const float mx = fmaxf(l0, fmaxf(l1, l2));
            float w0 = fast_exp2(l0 - mx), w1 = fast_exp2(l1 - mx), w2 = fast_exp2(l2 - mx);
            const float wi = 1.0f / (w0 + w1 + w2);
            w0 *= wi; w1 *= wi; w2 *= wi;
            const bf16_t* OD = (const bf16_t*)(ws + OFF_ODIL);
            const u32x4 a0 = ldu4(OD + tok * 512 + 8 * lane), a1 = ldu4(OD + ((size_t)T_TOK + tok) * 512 + 8 * lane),
                        a2 = ldu4(OD + ((size_t)2 * T_TOK + tok) * 512 + 8 * lane);
            const u32x4 am = ldu4((const bf16_t*)(ws + OFF_OMLA) + tok * 512 + 8 * lane);
            float od[8], om[8]; float sd = 0.f, sm = 0.f;
#pragma unroll
            for (int e = 0; e < 4; ++e) {
                od[2 * e] = w0 * bf_lo(a0[e]) + w1 * bf_lo(a1[e]) + w2 * bf_lo(a2[e]);
                od[2 * e + 1] = w0 * bf_hi(a0[e]) + w1 * bf_hi(a1[e]) + w2 * bf_hi(a2[e]);
                om[2 * e] = bf_lo(am[e]); om[2 * e + 1] = bf_hi(am[e]);
                sd += od[2 * e] * od[2 * e] + od[2 * e + 1] * od[2 * e + 1];
                sm += om[2 * e] * om[2 * e] + om[2 * e + 1] * om[2 * e + 1];
            }
#pragma unroll
            for (int o = 32; o; o >>= 1) { sd += __shfl_xor(sd, o); sm += __shfl_xor(sm, o); }
            const float rd = rsqrtf(sd * (1.0f / 512.0f) + 1e-6f), rm = rsqrtf(sm * (1.0f / 512.0f) + 1e-6f);
            const f32x4 gm0 = *(const f32x4*)(p.gn_mla + 8 * lane), gm1 = *(const f32x4*)(p.gn_mla + 8 * lane + 4);
            const f32x4 gd0 = *(const f32x4*)(p.gn_dil + 8 * lane), gd1 = *(const f32x4*)(p.gn_dil + 8 * lane + 4);
            u32x4 o1, o2;
            o1[0] = pack2(om[0] * rm * gm0[0], om[1] * rm * gm0[1]); o1[1] = pack2(om[2] * rm * gm0[2], om[3] * rm * gm0[3]);
            o1[2] = pack2(om[4] * rm * gm1[0], om[5] * rm * gm1[1]); o1[3] = pack2(om[6] * rm * gm1[2], om[7] * rm * gm1[3]);
            o2[0] = pack2(od[0] * rd * gd0[0], od[1] * rd * gd0[1]); o2[1] = pack2(od[2] * rd * gd0[2], od[3] * rd * gd0[3]);
            o2[2] = pack2(od[4] * rd * gd1[0], od[5] * rd * gd1[1]); o2[3] = pack2(od[6] * rd * gd1[2], od[7] * rd * gd1[3]);
            bf16_t* MX = (bf16_t*)(ws + OFF_MIXED) + tok * 1024;
            *(u32x4*)(MX + 8 * lane) = o1;
            *(u32x4*)(MX + 512 + 8 * lane) = o2;
        } else {
            const int it = item - ntok;
            const bool isv = it >= ncv;
            const size_t row = (size_t)(isv ? it - ncv : it) * 4 + wv;
            const float* src = (isv ? p.peer_v : p.peer_u) + row * 1024 + 16 * lane;
            f32x4 v[4]; float am = 0.f;
#pragma unroll
            for (int i = 0; i < 4; ++i) { v[i] = *(const f32x4*)(src + 4 * i); am = fmaxf(am, fmaxf(fmaxf(fabsf(v[i][0]), fabsf(v[i][1])), fmaxf(fabsf(v[i][2]), fabsf(v[i][3])))); }
#pragma unroll
            for (int o = 32; o; o >>= 1) am = fmaxf(am, __shfl_xor(am, o));
            const float sc = (am > 0.f) ? am * (1.0f / 127.0f) : 1.0f;
            const float inv = 1.0f / sc;
            const int bias = isv ? 128 : 0;
            u32x4 o;
#pragma unroll
            for (int i = 0; i < 4; ++i) {
                unsigned w = 0u;
#pragma unroll
                for (int e = 0; e < 4; ++e) { const int q = (int)rintf(v[i][e] * inv) + bias; w |= ((unsigned)q & 0xFFu) << (8 * e); }
                o[i] = w;
            }
            *(u32x4*)(ws + (isv ? OFF_VQ : OFF_UQ) + row * 1024 + 16 * lane) = o;
            if (lane == 0) ((float*)(ws + (isv ? OFF_SV : OFF_SU)))[row] = sc;
        }
    }
}

DI unsigned m512_off(int row, int chunk) { return (unsigned)(row * 512 + ((chunk ^ (row & 15)) << 4)); }
DI unsigned v512_off(int row, int chunk) { return (unsigned)(row * 512 + ((chunk ^ ((row & 3) << 2)) << 4)); }
DI void memattn_unit(const Params& p, char* lds, int b, int h, int tt) {
    char* ws = p.ws;
    const int t = threadIdx.x, lane = t & 63, wv = t >> 6, r = lane & 31, hh = lane >> 5;
    const int qg = wv & 1, dh = wv >> 1;
    const bf16_t* QM = (const bf16_t*)(ws + OFF_QM);
    const bf16_t* KVM = (const bf16_t*)(ws + OFF_KVM);
    const size_t tokq = (size_t)b * SEQ_L + tt * 64 + 32 * qg + r;
    bf16x8 qf[16];
#pragma unroll
    for (int s = 0; s < 16; ++s) qf[s] = ld16(QM + tokq * 1024 + h * 256 + 16 * s + 8 * hh);
    f32x16 o[4];
#pragma unroll
    for (int c = 0; c < 4; ++c) o[c] = zero16();
    float m = -INFINITY, l = 0.f;
    const int lkey = t >> 5, lc = t & 31;
    u32x4 kr_[4], vr_[4];
    auto load_tile = [&](int kt) {
#pragma unroll
        for (int i = 0; i < 4; ++i) {
            const size_t mrow = (size_t)b * 256 + 32 * kt + lkey + 8 * i;
            kr_[i] = ldu4(KVM + mrow * 2048 + h * 256 + 8 * lc);
            vr_[i] = ldu4(KVM + mrow * 2048 + 1024 + h * 256 + 8 * lc);
        }
    };
    auto store_tile = [&](char* sb) {
#pragma unroll
        for (int i = 0; i < 4; ++i) {
            *(u32x4*)(sb + m512_off(lkey + 8 * i, lc)) = kr_[i];
            *(u32x4*)(sb + 16384 + v512_off(lkey + 8 * i, lc)) = vr_[i];
        }
    };
    load_tile(0);
    __syncthreads();
    store_tile(lds);
    __syncthreads();
    for (int kt = 0; kt < 8; ++kt) {
        const bool more = (kt + 1 < 8);
        if (more) load_tile(kt + 1);
        const char* sb = lds + (kt & 1) * 32768;
        const unsigned vb = (unsigned)(uintptr_t)(sb + 16384);
        f32x16 s = zero16();
#pragma unroll
        for (int ss = 0; ss < 16; ++ss) s = MFMA32(ld16(sb + m512_off(r, 2 * ss + hh)), qf[ss], s);
        float mx = s[0];
#pragma unroll
        for (int i = 1; i < 16; ++i) mx = fmaxf(mx, s[i]);
        mx = xhalf_max(mx);
        const float mn = fmaxf(m, mx);
        const float alpha = fast_exp2(m - mn);
        float ps = 0.f;
#pragma unroll
        for (int i = 0; i < 16; ++i) { const float e = fast_exp2(s[i] - mn); s[i] = e; ps += e; }
        l = l * alpha + ps;
        m = mn;
#pragma unroll
        for (int c = 0; c < 4; ++c)
#pragma unroll
            for (int i = 0; i < 16; ++i) o[c][i] *= alpha;
        const int blk = (lane >> 4) & 1, qq = (lane & 15) >> 2, pp = lane & 3;
#pragma unroll
        for (int st = 0; st < 2; ++st) {
            const bf16x8 pb = pack_step(s, st);
#pragma unroll
            for (int c = 0; c < 4; ++c) {
                const int ch = 16 * dh + 4 * c + 2 * blk + (pp >> 1);
                const s16x4 lo = tr_read(vb + v512_off(16 * st + 4 * hh + qq, ch) + 8 * (pp & 1));
                const s16x4 hi = tr_read(vb + v512_off(16 * st + 8 + 4 * hh + qq, ch) + 8 * (pp & 1));
                o[c] = MFMA32(cat44(lo, hi), pb, o[c]);
            }
        }
        if (more) store_tile(lds + ((kt + 1) & 1) * 32768);
        __syncthreads();
    }
    const float inv = 1.0f / xhalf_sum(l);
    bf16_t* dst = (bf16_t*)(ws + OFF_OM) + tokq * 1024 + h * 256 + 128 * dh + 4 * hh;
#pragma unroll
    for (int c = 0; c < 4; ++c)
#pragma unroll
        for (int g = 0; g < 4; ++g)
            *(u32x2*)(dst + 32 * c + 8 * g) = pack4(o[c][4 * g] * inv, o[c][4 * g + 1] * inv, o[c][4 * g + 2] * inv, o[c][4 * g + 3] * inv);
}

DI void phase_memattn(const Params& p, char* lds) {
    for (int item = blockIdx.x; item < 1024; item += gridDim.x) {
        const int b = item >> 8, h = (item >> 6) & 3, tt = item & 63;
        memattn_unit(p, lds, b, h, tt);
    }
}
DI unsigned f2sort(float f) { const unsigned b = __float_as_uint(f); return b ^ ((b & 0x80000000u) ? 0xFFFFFFFFu : 0x80000000u); }
DI float sort2f(unsigned u) { const unsigned b = (u & 0x80000000u) ? (u ^ 0x80000000u) : ~u; return __uint_as_float(b); }
DI void cswap(unsigned& a, unsigned& b) { const unsigned hi = max(a, b), lo = min(a, b); a = hi; b = lo; }

template <int LO, int N> struct BClean {
    template <int M> static DI void run(unsigned (&a)[M]) {
#pragma unroll
        for (int i = 0; i < N / 2; ++i) cswap(a[LO + i], a[LO + i + N / 2]);
        BClean<LO, N / 2>::run(a); BClean<LO + N / 2, N / 2>::run(a);
    }
};
template <int LO> struct BClean<LO, 1> { template <int M> static DI void run(unsigned (&)[M]) {} };
template <int LO, int N> struct BSort {
    template <int M> static DI void run(unsigned (&a)[M]) {
        BSort<LO, N / 2>::run(a); BSort<LO + N / 2, N / 2>::run(a);
#pragma unroll
        for (int i = 0; i < N / 2; ++i) cswap(a[LO + i], a[LO + N - 1 - i]);
        BClean<LO, N / 2>::run(a); BClean<LO + N / 2, N / 2>::run(a);
    }
};
template <int LO> struct BSort<LO, 1> { template <int M> static DI void run(unsigned (&)[M]) {} };
DI void merge_top16(unsigned (&a)[16], const unsigned (&b)[16]) {
#pragma unroll
    for (int i = 0; i < 16; ++i) a[i] = max(a[i], b[15 - i]);
    BClean<0, 16>::run(a);
}

DI void peer_top16(const bf16_t* __restrict__ keys_hp, const bf16_t* __restrict__ pq_row_hp, int r, int hh, unsigned (&top)[16]) {
    bf16x8 qf[8];
#pragma unroll
    for (int s = 0; s < 8; ++s) qf[s] = ld16(pq_row_hp + 16 * s + 8 * hh);
    unsigned cur[16];
#pragma unroll
    for (int kt = 0; kt < 4; ++kt) {
        f32x16 acc = zero16();
#pragma unroll
        for (int s = 0; s < 8; ++s) acc = MFMA32(ld16(keys_hp + (size_t)(32 * kt + r) * 128 + 16 * s + 8 * hh), qf[s], acc);
        unsigned k[16];
#pragma unroll
        for (int i = 0; i < 16; ++i) k[i] = (f2sort(acc[i]) & ~0x7Fu) | (unsigned)(32 * kt + crow(i, hh));
        BSort<0, 16>::run(k);
        if (kt == 0) {
#pragma unroll
            for (int i = 0; i < 16; ++i) cur[i] = k[i];
        } else merge_top16(cur, k);
    }
    unsigned r0[16], r1[16];
#pragma unroll
    for (int i = 0; i < 16; ++i) { auto rr = __builtin_amdgcn_permlane32_swap(cur[i], cur[i], false, false); r0[i] = rr[0]; r1[i] = rr[1]; }
#pragma unroll
    for (int i = 0; i < 16; ++i) top[i] = max(r0[i], r1[15 - i]);
    BClean<0, 16>::run(top);
}

DI void peer_select_unit(const Params& p, char* lds, int mt, int h) {
    char* ws = p.ws;
    const int t = threadIdx.x, lane = t & 63, wv = t >> 6, r = lane & 31, hh = lane >> 5;
    const size_t tok = (size_t)mt * 128 + 32 * wv + r;
    const bf16_t* KEYS = (const bf16_t*)(ws + OFF_KEYS);
    const bf16_t* PQ = (const bf16_t*)(ws + OFF_PQ);
    unsigned tA[16], tB[16];
    peer_top16(KEYS + (size_t)(2 * h) * 16384, PQ + tok * 2048 + (2 * h) * 128, r, hh, tA);
    peer_top16(KEYS + (size_t)(2 * h + 1) * 16384, PQ + tok * 2048 + (2 * h + 1) * 128, r, hh, tB);
    float fA[16], fB[16];
#pragma unroll
    for (int i = 0; i < 16; ++i) { fA[i] = sort2f(tA[i] & ~0x7Fu); fB[i] = sort2f(tB[i] & ~0x7Fu); }
    unsigned* tab = (unsigned*)lds + wv * 1024;
    __syncthreads();
#pragma unroll
    for (int i = 0; i < 16; ++i) tab[i * 64 + lane] = (tA[i] & 0x7Fu) | ((tB[i] & 0x7Fu) << 16);
    unsigned c[64];
#pragma unroll
    for (int i = 0; i < 64; ++i) c[i] = 0u;
    {
        int n = 0;
#pragma unroll
        for (int a = 0; a < 16; ++a)
#pragma unroll
            for (int b = 0; b < 16; ++b)
                if ((a + 1) * (b + 1) <= 16) { c[n] = (f2sort(fA[a] + fB[b]) & ~0xFFu) | (unsigned)(a * 16 + b); ++n; }
    }
    unsigned g0[16], g1[16], g2[16], g3[16];
#pragma unroll
    for (int i = 0; i < 16; ++i) { g0[i] = c[i]; g1[i] = c[16 + i]; g2[i] = c[32 + i]; g3[i] = c[48 + i]; }
    BSort<0, 16>::run(g0); BSort<0, 16>::run(g1); BSort<0, 16>::run(g2); BSort<0, 16>::run(g3);
    merge_top16(g0, g1); merge_top16(g2, g3); merge_top16(g0, g2);
    float e[16]; float sum = 0.f;
    const float v0 = sort2f(g0[0] & ~0xFFu);
    unsigned ids[16];
#pragma unroll
    for (int i = 0; i < 16; ++i) {
        const float v = sort2f(g0[i] & ~0xFFu);
        e[i] = fast_exp2((v - v0) * LOG2E); sum += e[i];
        const unsigned a = (g0[i] >> 4) & 15u, b = g0[i] & 15u;
        const unsigned ia = tab[a * 64 + lane] & 0x7Fu, ib = (tab[b * 64 + lane] >> 16) & 0x7Fu;
        ids[i] = ia * 128u + ib;
    }
    const float inv = 1.0f / sum;
    if (hh == 0) {
        unsigned short* SID = (unsigned short*)(ws + OFF_SELID) + tok * 128 + h * 16;
        float* SG = (float*)(ws + OFF_SELG) + tok * 128 + h * 16;
        u32x4 w0, w1;
        w0[0] = ids[0] | (ids[1] << 16); w0[1] = ids[2] | (ids[3] << 16); w0[2] = ids[4] | (ids[5] << 16); w0[3] = ids[6] | (ids[7] << 16);
        w1[0] = ids[8] | (ids[9] << 16); w1[1] = ids[10] | (ids[11] << 16); w1[2] = ids[12] | (ids[13] << 16); w1[3] = ids[14] | (ids[15] << 16);
        *(u32x4*)SID = w0; *(u32x4*)(SID + 8) = w1;
#pragma unroll
        for (int q = 0; q < 4; ++q) *(f32x4*)(SG + 4 * q) = (f32x4){e[4 * q] * inv, e[4 * q + 1] * inv, e[4 * q + 2] * inv, e[4 * q + 3] * inv};
    }
}

DI void phase_select(const Params& p, char* lds) {
    for (int item = blockIdx.x; item < 1024; item += gridDim.x) peer_select_unit(p, lds, item >> 3, item & 7);
}

DI float gelu_erf(float a) { return 0.5f * a * (1.0f + erff(a * 0.70710678118654752f)); }
DI int dppi(int v, const int ctrl) { return v; }
#define DPP_I(v, ctrl) __builtin_amdgcn_update_dpp(0, (v), (ctrl), 0xf, 0xf, true)
DI float ub0(unsigned w) { return (float)(w & 0xFFu); }
DI float ub1(unsigned w) { return (float)((w >> 8) & 0xFFu); }
DI float ub2(unsigned w) { return (float)((w >> 16) & 0xFFu); }
DI float ub3(unsigned w) { return (float)(w >> 24); }

struct GBatch { u32x4 U[4], V[4]; float su[4], sv[4], gate[4]; };

DI void gather_load(GBatch& B, const char* __restrict__ ws, unsigned idpair, f32x2 gpair, int eb, int lane) {
#pragma unroll
    for (int j = 0; j < 4; ++j) {
        const int e = eb + j;
        const unsigned pr = __shfl(idpair, e >> 1);
        const unsigned id = (j & 1) ? (pr >> 16) : (pr & 0xFFFFu);
        const float g0 = __shfl(gpair[0], e >> 1), g1 = __shfl(gpair[1], e >> 1);
        B.gate[j] = (j & 1) ? g1 : g0;
        B.U[j] = ldu4(ws + OFF_UQ + (size_t)id * 1024 + 16 * lane);
        B.V[j] = ldu4(ws + OFF_VQ + (size_t)id * 1024 + 16 * lane);
        B.su[j] = ((const float*)(ws + OFF_SU))[id];
        B.sv[j] = ((const float*)(ws + OFF_SV))[id];
    }
}

DI void gather_compute(const GBatch& B, const unsigned (&qx)[4], float sx, float (&acc)[16], float& csum, int lane) {
    int pd[4];
#pragma unroll
    for (int j = 0; j < 4; ++j) {
        int d = 0;
#pragma unroll
        for (int q = 0; q < 4; ++q) d = __builtin_amdgcn_sdot4((int)B.U[j][q], (int)qx[q], d, false);
        pd[j] = d;
    }
    const bool b0 = lane & 1, b1 = lane & 2;
    const int kA = b0 ? pd[1] : pd[0], kB = b0 ? pd[3] : pd[2], sA = b0 ? pd[0] : pd[1], sB = b0 ? pd[2] : pd[3];
    const int qA = kA + DPP_I(sA, 0xB1), qB = kB + DPP_I(sB, 0xB1);
    const int kp = b1 ? qB : qA, sd = b1 ? qA : qB;
    int tot = kp + DPP_I(sd, 0x4E);
    tot += DPP_I(tot, 0x124);
    tot += DPP_I(tot, 0x128);
    tot += __builtin_amdgcn_ds_swizzle(tot, 0x401F);
    { auto rr = __builtin_amdgcn_permlane32_swap((unsigned)tot, (unsigned)tot, false, false); tot = (int)rr[0] + (int)rr[1]; }
    const int j3 = lane & 3;
    const float su_sel = (j3 == 0) ? B.su[0] : (j3 == 1 ? B.su[1] : (j3 == 2 ? B.su[2] : B.su[3]));
    const float ge = gelu_erf((float)tot * sx * su_sel);
#pragma unroll
    for (int j = 0; j < 4; ++j) {
        const float cf = B.gate[j] * B.sv[j] * __shfl(ge, j);
        csum += cf;
#pragma unroll
        for (int q = 0; q < 4; ++q) {
            const unsigned w = B.V[j][q];
            acc[4 * q] += cf * ub0(w); acc[4 * q + 1] += cf * ub1(w); acc[4 * q + 2] += cf * ub2(w); acc[4 * q + 3] += cf * ub3(w);
        }
    }
}

DI void gather_token(const Params& p, size_t tok, int lane, float* dst_base) {
    char* ws = p.ws;
    float* hrow = p.out + tok * 1024 + 16 * lane;
    float hv[16];
#pragma unroll
    for (int i = 0; i < 4; ++i) { const f32x4 a = *(const f32x4*)(hrow + 4 * i); hv[4 * i] = a[0]; hv[4 * i + 1] = a[1]; hv[4 * i + 2] = a[2]; hv[4 * i + 3] = a[3]; }
    float rs;
    {
        const float* SS = (const float*)(ws + OFF_SS2) + tok * 16;
        const f32x4 s0 = *(const f32x4*)SS, s1 = *(const f32x4*)(SS + 4), s2 = *(const f32x4*)(SS + 8), s3 = *(const f32x4*)(SS + 12);
        const float tot = (s0[0] + s0[1] + s0[2] + s0[3]) + (s1[0] + s1[1] + s1[2] + s1[3]) + (s2[0] + s2[1] + s2[2] + s2[3]) + (s3[0] + s3[1] + s3[2] + s3[3]);
        rs = rsqrtf(tot * (1.0f / 1024.0f) + 1e-6f);
    }
    float xf[16]; float am = 0.f;
#pragma unroll
    for (int i = 0; i < 4; ++i) {
        const f32x4 g = *(const f32x4*)(p.norm_ffn + 16 * lane + 4 * i);
#pragma unroll
        for (int e = 0; e < 4; ++e) { xf[4 * i + e] = hv[4 * i + e] * rs * g[e]; am = fmaxf(am, fabsf(xf[4 * i + e])); }
    }
#pragma unroll
    for (int o = 32; o; o >>= 1) am = fmaxf(am, __shfl_xor(am, o));
    const float sx = (am > 0.f) ? am * (1.0f / 127.0f) : 1.0f;
    const float isx = 1.0f / sx;
    unsigned qx[4];
#pragma unroll
    for (int i = 0; i < 4; ++i) {
        unsigned w = 0u;
#pragma unroll
        for (int e = 0; e < 4; ++e) w |= ((unsigned)(int)rintf(xf[4 * i + e] * isx) & 0xFFu) << (8 * e);
        qx[i] = w;
    }
    const unsigned idpair = *((const unsigned*)(ws + OFF_SELID) + tok * 64 + lane);
    const f32x2 gpair = *((const f32x2*)(ws + OFF_SELG) + tok * 64 + lane);
    float acc[16]; float csum = 0.f;
#pragma unroll
    for (int i = 0; i < 16; ++i) acc[i] = 0.f;
    GBatch B0, B1;
    gather_load(B0, ws, idpair, gpair, 0, lane);
#pragma unroll 1
    for (int eb = 0; eb < 128; eb += 8) {
        gather_load(B1, ws, idpair, gpair, eb + 4, lane);
        gather_compute(B0, qx, sx, acc, csum, lane);
        if (eb + 8 < 128) gather_load(B0, ws, idpair, gpair, eb + 8, lane);
        gather_compute(B1, qx, sx, acc, csum, lane);
    }
    float ss = 0.f;
#pragma unroll
    for (int i = 0; i < 16; ++i) { acc[i] = acc[i] - 128.0f * csum + hv[i]; ss += acc[i] * acc[i]; }
#pragma unroll
    for (int o = 32; o; o >>= 1) ss += __shfl_xor(ss, o);
    const float rf = rsqrtf(ss * (1.0f / 1024.0f) + 1e-6f);
    float* drow = dst_base + tok * 1024 + 16 * lane;
#pragma unroll
    for (int i = 0; i < 4; ++i) {
        const f32x4 n = *(const f32x4*)(p.norm_final + 16 * lane + 4 * i);
        *(f32x4*)(drow + 4 * i) = (f32x4){acc[4 * i] * rf * n[0], acc[4 * i + 1] * rf * n[1], acc[4 * i + 2] * rf * n[2], acc[4 * i + 3] * rf * n[3]};
    }
}

DI void phase_gather(const Params& p, bool dry = false) {
    const int lane = threadIdx.x & 63, wv = threadIdx.x >> 6;
    float* dst = dry ? (float*)(p.ws + OFF_PQ) : p.out;
    for (int item = blockIdx.x; item < T_TOK / 4; item += gridDim.x) gather_token(p, (size_t)item * 4 + wv, lane, dst);
}
constexpr int LDS_BYTES = 66048;
constexpr int NPHASE = 12;
template <int PH> DI void run_phase(const Params& p, char* lds) {
    if (PH == 0) phase_prep(p, lds);
    else if (PH == 1) phase_p1(p, lds);
    else if (PH == 2) phase_p2(p, lds);
    else if (PH == 3) phase_p3(p, lds);
    else if (PH == 4) phase_p35(p, lds);
    else if (PH == 5) phase_resid(p, lds, OFF_WT_OUT, OFF_MIXED, p.x, OFF_SS1);
    else if (PH == 6) phase_rowscale(p, lds, OFF_WT_MQ, 1024, OFF_QM, OFF_SS1, 0.0625f * LOG2E);
    else if (PH == 7) phase_memattn(p, lds);
    else if (PH == 8) phase_resid(p, lds, OFF_WT_MO, OFF_OM, p.out, OFF_SS2);
    else if (PH == 9) phase_rowscale(p, lds, OFF_WT_PQ, 2048, OFF_PQ, OFF_SS2, 1.0f);
    else if (PH == 10) phase_select(p, lds);
    else if (PH == 11) phase_gather(p);
}

template <int PH> __global__ void __launch_bounds__(256, 2) k_phase(Params p) {
    __shared__ __attribute__((aligned(16))) char smem[LDS_BYTES];
    run_phase<PH>(p, smem);
}

static Params make_params(void* const* d_in, void* d_out, void* d_ws) {
    Params p;
    memset(&p, 0, sizeof(p));
    p.x = (const float*)d_in[0]; p.mem = (const float*)d_in[1]; p.norm_mix = (const float*)d_in[2]; p.w_in = (const float*)d_in[3];
    p.q_norm = (const float*)d_in[4]; p.kv_norm = (const float*)d_in[5]; p.w_uq = (const float*)d_in[6]; p.w_ukv = (const float*)d_in[7];
    p.gn_mla = (const float*)d_in[8]; p.gn_dil = (const float*)d_in[9]; p.w_out = (const float*)d_in[10]; p.norm_mem_q = (const float*)d_in[11];
    p.norm_mem_kv = (const float*)d_in[12]; p.w_mem_q = (const float*)d_in[13]; p.w_mem_kv = (const float*)d_in[14]; p.w_mem_o = (const float*)d_in[15];
    p.norm_ffn = (const float*)d_in[16]; p.peer_w_q = (const float*)d_in[17]; p.sub_keys = (const float*)d_in[18]; p.peer_u = (const float*)d_in[19];
    p.peer_v = (const float*)d_in[20]; p.norm_final = (const float*)d_in[21];
    p.out = (float*)d_out; p.ws = (char*)d_ws;
    for (int i = 0; i < 16; ++i) p.inv_freq[i] = 1.0f / powf(10000.0f, (float)(2 * i) / 32.0f);
    return p;
}
__global__ void __launch_bounds__(256, 2) k_mega(Params p) {
    __shared__ __attribute__((aligned(16))) char smem[LDS_BYTES + 16];
    volatile LAS unsigned* st = (volatile LAS unsigned*)(LAS char*)(smem + LDS_BYTES);
    if (threadIdx.x == 0) { st[0] = 0u; st[1] = 0u; st[2] = 0u; st[3] = 0u; }
    __syncthreads();
    const XcdBarrier xb = xcd_barrier_post((unsigned*)(p.ws + OFF_BAR), st);
#define RP(n) run_phase<n>(p, smem); xcd_barrier(xb);
    RP(0) RP(1) RP(2) RP(3) RP(4) RP(5) RP(6) RP(7) RP(8) RP(9) RP(10)
    run_phase<11>(p, smem);
}

extern "C" void kernel_launch(void* const* d_in, const int* in_sizes, int n_in, void* d_out, int out_size, void* d_ws, size_t ws_size,
                              hipStream_t stream) {
    static int grid_blocks = 0;
    if (!grid_blocks) {
        int dev = 0, cus = 0, per_cu = 0;
        (void)hipGetDevice(&dev);
        (void)hipDeviceGetAttribute(&cus, hipDeviceAttributeMultiprocessorCount, dev);
        (void)hipOccupancyMaxActiveBlocksPerMultiprocessor(&per_cu, k_mega, 256, 0);
        if (per_cu > 2) per_cu = 2;
        if (per_cu < 1) per_cu = 1;
        grid_blocks = cus * per_cu;
    }
    Params p = make_params(d_in, d_out, d_ws);
    (void)hipMemsetAsync((char*)d_ws + OFF_BAR, 0, XCD_BAR_WORDS * 4, stream);
    void* args[] = {&p};
    hipError_t e = hipLaunchCooperativeKernel((const void*)k_mega, dim3(grid_blocks), dim3(256), args, 0, stream);
    if (e != hipSuccess) fprintf(stderr, "cooperative launch failed: %s (grid %d)\n", hipGetErrorString(e), grid_blocks);
}
```

```cpp
#include <hip/hip_runtime.h>
#include <hip/hip_cooperative_groups.h>
#include <math.h>
#include <stdint.h>
#include <stdio.h>
#include <string.h>
#define DI __device__ __forceinline__
typedef unsigned short bf16_t;
typedef short bf16x8 __attribute__((ext_vector_type(8)));
typedef short s16x4 __attribute__((ext_vector_type(4)));
typedef float f32x16 __attribute__((ext_vector_type(16)));
typedef float f32x4 __attribute__((ext_vector_type(4)));
typedef float f32x2 __attribute__((ext_vector_type(2)));
typedef unsigned u32x4 __attribute__((ext_vector_type(4)));
typedef unsigned u32x2 __attribute__((ext_vector_type(2)));
typedef __bf16 bf16x2v __attribute__((ext_vector_type(2)));
#define LAS __attribute__((address_space(3)))
#define MFMA32(a, b, c) __builtin_amdgcn_mfma_f32_32x32x16_bf16((a), (b), (c), 0, 0, 0)

constexpr int T_TOK = 16384, SEQ_L = 4096, DM = 1024, INC = 2208;
constexpr float LOG2E = 1.4426950408889634f;

DI int otid() { int t = threadIdx.x & 255; asm volatile("" : "+v"(t)); return t; }
DI int vhalf() { return __builtin_amdgcn_readfirstlane((int)(threadIdx.x >> 8)); }
DI int vbid() { return (int)blockIdx.x * 2 + vhalf(); }
DI int vgrid() { return (int)gridDim.x * 2; }
DI unsigned pack2(float lo, float hi) { f32x2 f = {lo, hi}; return __builtin_bit_cast(unsigned, __builtin_convertvector(f, bf16x2v)); }
DI float bf_lo(unsigned u) { return __uint_as_float(u << 16); }
DI float bf_hi(unsigned u) { return __uint_as_float(u & 0xffff0000u); }
DI float bf2f(bf16_t v) { return __uint_as_float(((unsigned)v) << 16); }
DI int crow(int reg, int hh) { return (reg & 3) + 8 * (reg >> 2) + 4 * hh; }
DI f32x16 zero16() { f32x16 z;
#pragma unroll
    for (int i = 0; i < 16; ++i) z[i] = 0.f; return z; }
DI float xhalf_max(float v) { auto r = __builtin_amdgcn_permlane32_swap(__float_as_uint(v), __float_as_uint(v), false, false); return fmaxf(__uint_as_float(r[0]), __uint_as_float(r[1])); }
DI float xhalf_other(float v, int lane) { auto r = __builtin_amdgcn_permlane32_swap(__float_as_uint(v), __float_as_uint(v), false, false); return __uint_as_float((lane & 32) ? r[0] : r[1]); }
DI float xhalf_sum(float v) { auto r = __builtin_amdgcn_permlane32_swap(__float_as_uint(v), __float_as_uint(v), false, false); return __uint_as_float(r[0]) + __uint_as_float(r[1]); }
DI bf16x8 ld16(const void* p) { return *(const bf16x8*)p; }
DI u32x4 ldu4(const void* p) { return *(const u32x4*)p; }
DI float fast_exp2(float x) { return __builtin_amdgcn_exp2f(x); }
DI bf16x8 pack_step(const f32x16& x, int s) {
    u32x4 p;
    p[0] = pack2(x[8 * s + 0], x[8 * s + 1]); p[1] = pack2(x[8 * s + 2], x[8 * s + 3]);
    p[2] = pack2(x[8 * s + 4], x[8 * s + 5]); p[3] = pack2(x[8 * s + 6], x[8 * s + 7]);
    return __builtin_bit_cast(bf16x8, p);
}
DI s16x4 tr_read(unsigned lds_byte_addr) {
    return __builtin_amdgcn_ds_read_tr16_b64_v4i16((LAS s16x4*)(uintptr_t)lds_byte_addr);
}

constexpr size_t MiB = 1ull << 20;
constexpr size_t OFF_BAR = 0;
constexpr size_t OFF_WT_IN = 65536;
constexpr size_t OFF_WT_UQ = OFF_WT_IN + 2304ull * 1024 * 2;
constexpr size_t OFF_WT_UKV = OFF_WT_UQ + 768ull * 384 * 2;
constexpr size_t OFF_WT_OUT = OFF_WT_UKV + 1024ull * 256 * 2;
constexpr size_t OFF_WT_MQ = OFF_WT_OUT + 1024ull * 1024 * 2;
constexpr size_t OFF_WT_MKV = OFF_WT_MQ + 1024ull * 1024 * 2;
constexpr size_t OFF_WT_MO = OFF_WT_MKV + 2048ull * 1024 * 2;
constexpr size_t OFF_WT_PQ = OFF_WT_MO + 1024ull * 1024 * 2;
constexpr size_t OFF_KEYS = OFF_WT_PQ + 2048ull * 1024 * 2;
constexpr size_t OFF_ROPE = OFF_KEYS + 16ull * 128 * 128 * 2;
constexpr size_t OFF_KR = OFF_ROPE + 2ull * 4096 * 16 * 4;
constexpr size_t OFF_LSE = OFF_KR + (size_t)T_TOK * 32 * 2;
constexpr size_t OFF_SS1 = OFF_LSE + 3ull * T_TOK * 8 * 4;
constexpr size_t OFF_SS2 = OFF_SS1 + (size_t)T_TOK * 16 * 4;
constexpr size_t OFF_MEMN = OFF_SS2 + (size_t)T_TOK * 16 * 4;
constexpr size_t OFF_SMALL_END = OFF_MEMN + 1024ull * 1024 * 2;
static_assert(OFF_SMALL_END <= 28 * MiB, "small region overflow");
constexpr size_t OFF_A = 28 * MiB;
constexpr size_t OFF_PROJ = OFF_A;
constexpr size_t OFF_UQ = OFF_A;
constexpr size_t OFF_VQ = OFF_A + 16 * MiB;
constexpr size_t OFF_SU = OFF_A + 32 * MiB;
constexpr size_t OFF_SV = OFF_SU + 65536;
constexpr size_t OFF_B = 97 * MiB;
constexpr size_t OFF_XN = OFF_B, OFF_QMLA = OFF_B, OFF_MIXED = OFF_B, OFF_QM = OFF_B;
constexpr size_t OFF_C = 129 * MiB;
constexpr size_t OFF_KVMLA = OFF_C, OFF_HB = OFF_C;
constexpr size_t OFF_D = 161 * MiB;
constexpr size_t OFF_ODIL = OFF_D, OFF_OMLA = OFF_D + 48 * MiB, OFF_OM = OFF_D, OFF_PQ = OFF_D;
constexpr size_t OFF_SELID = 225 * MiB;
constexpr size_t OFF_SELG = 229 * MiB;
constexpr size_t OFF_KVM = 237 * MiB;
constexpr size_t OFF_SSQ = 241 * MiB;
constexpr size_t WS_NEEDED = 243 * MiB;

struct Params {
    const float* x; const float* mem; const float* norm_mix; const float* w_in; const float* q_norm; const float* kv_norm;
    const float* w_uq; const float* w_ukv; const float* gn_mla; const float* gn_dil; const float* w_out; const float* norm_mem_q;
    const float* norm_mem_kv; const float* w_mem_q; const float* w_mem_kv; const float* w_mem_o; const float* norm_ffn;
    const float* peer_w_q; const float* sub_keys; const float* peer_u; const float* peer_v; const float* norm_final;
    float* out; char* ws;
    float inv_freq[16];
    int prof; int pad_;
};
#define XB_TMO      128
#define XB_XCNT(j)  (256  + 64 * (j))
#define XB_XSUB(j)  (1280 + 64 * (j))
#define XB_XGEN(j)  (2304 + 64 * (j))
#define XB_TOP      3328
#define XB_TOPGEN   3392
#define XCD_BAR_WORDS 3456
#define XB_SPIN_CAP (1u << 20)
DI unsigned xb_ld(unsigned* p) { return __hip_atomic_load(p, __ATOMIC_RELAXED, __HIP_MEMORY_SCOPE_AGENT); }
DI unsigned xb_add(unsigned* p, unsigned v) { return __hip_atomic_fetch_add(p, v, __ATOMIC_RELAXED, __HIP_MEMORY_SCOPE_AGENT); }
DI unsigned xb_xcc_id() { return (unsigned)__builtin_amdgcn_s_getreg((3 << 11) | 20) & 0xFu; }
#define XB_SPIN(cond, bar) do { unsigned _sp = 0; while (cond) { __builtin_amdgcn_s_sleep(1); \
    if ((++_sp & 255u) == 0u) { if (xb_ld(&(bar)[XB_TMO])) break; if (_sp > XB_SPIN_CAP) { atomicAdd(&(bar)[XB_TMO], 1u); break; } } } } while (0)
struct XcdBarrier { unsigned* bar; unsigned x; volatile LAS unsigned* st; };
DI XcdBarrier xcd_barrier_post(unsigned* bar, volatile LAS unsigned* st) {
    XcdBarrier b; b.bar = bar; b.x = xb_xcc_id(); b.st = st;
    if (threadIdx.x == 0) (void)xb_add(&bar[XB_XCNT(b.x)], 1u);
    return b;
}
DI void xcd_barrier_complete(unsigned* bar, unsigned x, unsigned& nloc, unsigned& nx) {
    const unsigned G = gridDim.x * gridDim.y * gridDim.z;
    unsigned sum, cnt, mine, sp = 0u;
    for (;;) {
        sum = 0u; cnt = 0u; mine = 0u;
#pragma unroll
        for (unsigned j = 0; j < 16; ++j) { const unsigned c = xb_ld(&bar[XB_XCNT(j)]); sum += c; cnt += (c > 0u) ? 1u : 0u; mine = (j == x) ? c : mine; }
        if (sum == G) break;
        __builtin_amdgcn_s_sleep(1);
        if ((++sp & 255u) == 0u) { if (xb_ld(&bar[XB_TMO])) break; if (sp > XB_SPIN_CAP) { atomicAdd(&bar[XB_TMO], 1u); break; } }
    }
    nloc = mine > 0u ? mine : 1u; nx = cnt > 0u ? cnt : 1u;
}
DI void xcd_barrier(const XcdBarrier& b) {
    asm volatile("s_waitcnt vmcnt(0)" ::: "memory");
    __syncthreads();
    if (threadIdx.x == 0) {
        unsigned* bar = b.bar;
        __builtin_amdgcn_s_waitcnt(0);
        unsigned nloc = b.st[0], nx = b.st[1];
        if (nloc == 0u) { xcd_barrier_complete(bar, b.x, nloc, nx); b.st[0] = nloc; b.st[1] = nx; }
        const unsigned old = xb_add(&bar[XB_XSUB(b.x)], 1u);
        const unsigned gen = old / nloc;
        if (old + 1u == (gen + 1u) * nloc) {
            __builtin_amdgcn_fence(__ATOMIC_RELEASE, "agent");
            asm volatile("s_waitcnt vmcnt(0)" ::: "memory");
            const unsigned og = xb_add(&bar[XB_TOP], 1u);
            const unsigned tg = og / nx;
            if (og + 1u == (tg + 1u) * nx) xb_add(&bar[XB_TOPGEN], 1u);
            else XB_SPIN(xb_ld(&bar[XB_TOPGEN]) == tg, bar);
            __builtin_amdgcn_fence(__ATOMIC_ACQUIRE, "agent");
            xb_add(&bar[XB_XGEN(b.x)], 1u);
            asm volatile("s_waitcnt vmcnt(0)" ::: "memory");
        } else {
            XB_SPIN(xb_ld(&bar[XB_XGEN(b.x)]) == gen, bar);
            __builtin_amdgcn_fence(__ATOMIC_ACQUIRE, "agent");
            asm volatile("s_waitcnt vmcnt(0)" ::: "memory");
        }
    }
    __syncthreads();
}
DI void transpose_tile(const float* __restrict__ W, int K, int N, const float* __restrict__ g, bf16_t* __restrict__ Wt, int kt, int nt, char* lds, bool valid) {
    float* sm = (float*)lds;
    const int t = otid();
    const int k0 = kt * 64, n0 = nt * 64;
    __syncthreads();
#pragma unroll
    for (int i = 0; i < 16; ++i) {
        const int id = t + 256 * i, k = id >> 6, n = id & 63;
        float v = 0.f;
        if (valid && n0 + n < N) { v = W[(size_t)(k0 + k) * N + n0 + n]; if (g) v *= g[k0 + k]; }
        sm[k * 65 + n] = v;
    }
    __syncthreads();
    const int n = t >> 2, kc = (t & 3) * 16;
    u32x4 o0, o1;
    o0[0] = pack2(sm[(kc + 0) * 65 + n], sm[(kc + 1) * 65 + n]); o0[1] = pack2(sm[(kc + 2) * 65 + n], sm[(kc + 3) * 65 + n]);
    o0[2] = pack2(sm[(kc + 4) * 65 + n], sm[(kc + 5) * 65 + n]); o0[3] = pack2(sm[(kc + 6) * 65 + n], sm[(kc + 7) * 65 + n]);
    o1[0] = pack2(sm[(kc + 8) * 65 + n], sm[(kc + 9) * 65 + n]); o1[1] = pack2(sm[(kc + 10) * 65 + n], sm[(kc + 11) * 65 + n]);
    o1[2] = pack2(sm[(kc + 12) * 65 + n], sm[(kc + 13) * 65 + n]); o1[3] = pack2(sm[(kc + 14) * 65 + n], sm[(kc + 15) * 65 + n]);
    bf16_t* dst = Wt + (size_t)(n0 + n) * K + k0 + kc;
    if (valid) { *(u32x4*)dst = o0; *(u32x4*)(dst + 8) = o1; }
}

DI void rmsnorm_row_bf16(const float* __restrict__ in, const float* __restrict__ g, bf16_t* __restrict__ out, int lane) {
    f32x4 v[4]; float ss = 0.f;
#pragma unroll
    for (int i = 0; i < 4; ++i) { v[i] = *(const f32x4*)(in + 4 * lane + 256 * i); ss += v[i][0] * v[i][0] + v[i][1] * v[i][1] + v[i][2] * v[i][2] + v[i][3] * v[i][3]; }
#pragma unroll
    for (int o = 32; o; o >>= 1) ss += __shfl_xor(ss, o);
    const float rs = rsqrtf(ss * (1.0f / 1024.0f) + 1e-6f);
#pragma unroll
    for (int i = 0; i < 4; ++i) {
        const f32x4 gg = *(const f32x4*)(g + 4 * lane + 256 * i);
        u32x2 o; o[0] = pack2(v[i][0] * rs * gg[0], v[i][1] * rs * gg[1]); o[1] = pack2(v[i][2] * rs * gg[2], v[i][3] * rs * gg[3]);
        *(u32x2*)(out + 4 * lane + 256 * i) = o;
    }
}

struct TrJob { const float* W; const float* g; size_t off; int K, N, Npad; };

DI void phase_prep(const Params& p, char* lds) {
    char* ws = p.ws;
    const int t = otid(), lane = t & 63, wv = t >> 6;
    const int c0 = 576, c1 = c0 + 72, c2 = c1 + 64, c3 = c2 + 256, c4 = c3 + 256, c5 = c4 + 512, c6 = c5 + 256, c7 = c6 + 512;
    const int nrow = (T_TOK + 1024) / 4;
    const int nkeys = 128, nrope = 256;
    const int total = c7 + nrow + nkeys + nrope;
    for (int k = 0; k < (c7 + vgrid() - 1) / vgrid(); ++k) {
        const int raw = vbid() + k * vgrid();
        const bool valid = raw < c7;
        const int item = valid ? raw : 0;
        const float* W; const float* g; size_t off; int K, N, Npad, local;
        if (item < c0)      { W = p.w_in;     g = nullptr;      off = OFF_WT_IN;  K = 1024; N = 2208; Npad = 2304; local = item; }
        else if (item < c1) { W = p.w_uq;     g = p.q_norm;     off = OFF_WT_UQ;  K = 384;  N = 768;  Npad = 768;  local = item - c0; }
        else if (item < c2) { W = p.w_ukv;    g = p.kv_norm;    off = OFF_WT_UKV; K = 256;  N = 1024; Npad = 1024; local = item - c1; }
        else if (item < c3) { W = p.w_out;    g = nullptr;      off = OFF_WT_OUT; K = 1024; N = 1024; Npad = 1024; local = item - c2; }
        else if (item < c4) { W = p.w_mem_q;  g = p.norm_mem_q; off = OFF_WT_MQ;  K = 1024; N = 1024; Npad = 1024; local = item - c3; }
        else if (item < c5) { W = p.w_mem_kv; g = nullptr;      off = OFF_WT_MKV; K = 1024; N = 2048; Npad = 2048; local = item - c4; }
        else if (item < c6) { W = p.w_mem_o;  g = nullptr;      off = OFF_WT_MO;  K = 1024; N = 1024; Npad = 1024; local = item - c5; }
        else                { W = p.peer_w_q; g = p.norm_ffn;   off = OFF_WT_PQ;  K = 1024; N = 2048; Npad = 2048; local = item - c6; }
        const int ntn = Npad / 64;
        transpose_tile(W, K, N, g, (bf16_t*)(ws + off), local / ntn, local % ntn, lds, valid);
    }
    for (int item = c7 + vbid(); item < total; item += vgrid()) {
        if (item < c7 + nrow) {
            const int row = (item - c7) * 4 + wv;
            if (row < T_TOK) rmsnorm_row_bf16(p.x + (size_t)row * 1024, p.norm_mix, (bf16_t*)(ws + OFF_XN) + (size_t)row * 1024, lane);
            else rmsnorm_row_bf16(p.mem + (size_t)(row - T_TOK) * 1024, p.norm_mem_kv, (bf16_t*)(ws + OFF_MEMN) + (size_t)(row - T_TOK) * 1024, lane);
        } else if (item < c7 + nrow + nkeys) {
            const int idx = ((item - c7 - nrow) * 256 + t) * 8;
            const f32x4 a = *(const f32x4*)(p.sub_keys + idx), b = *(const f32x4*)(p.sub_keys + idx + 4);
            u32x4 o; o[0] = pack2(a[0], a[1]); o[1] = pack2(a[2], a[3]); o[2] = pack2(b[0], b[1]); o[3] = pack2(b[2], b[3]);
            *(u32x4*)((bf16_t*)(ws + OFF_KEYS) + idx) = o;
        } else {
            const int idx = (item - c7 - nrow - nkeys) * 256 + t;
            const int s = idx >> 4, i = idx & 15;
            const float ang = (float)s * p.inv_freq[i];
            const double a = (double)ang;
            const double twopi = 6.283185307179586476925;
            const float rf = (float)(a - twopi * rint(a / twopi));
            float* cs = (float*)(ws + OFF_ROPE);
            cs[idx] = cosf(rf); cs[65536 + idx] = sinf(rf);
        }
    }
}
namespace pg8 {
#define PG8_LAS __attribute__((address_space(3)))
typedef unsigned short bf16_t;
typedef short bf16x8 __attribute__((ext_vector_type(8)));
typedef float f32x4 __attribute__((ext_vector_type(4)));
typedef unsigned u32x4 __attribute__((ext_vector_type(4)));
constexpr int BM = 256, BK = 64, HALF = 128, HTB = HALF * BK * 2  , STAGE_BYTES = 8 * HTB, NXCD = 8, WGM = 8;

__host__ __device__ __forceinline__ int lds_byte(int r, int c) { const int st = (r >> 4) * 2 + (c >> 5), rr = r & 15, cc = c & 31, ob = rr * 64 + cc * 2; return st * 1024 + (ob ^ (((ob >> 9) & 1) << 5)); }
__host__ __device__ __forceinline__ void stage_rc(int b, int& R, int& C) { const int st = b / 1024, sb = b % 1024, swz = sb ^ (((sb >> 9) & 1) << 5); R = (st >> 1) * 16 + swz / 64; C = (st & 1) * 32 + (swz % 64) / 2; }
__host__ __device__ __forceinline__ int perm32(int rho) { const int n = rho >> 4, i = rho & 15; return 8 * (i >> 2) + 4 * n + (i & 3); }

struct Unit { int pm, pn; };
struct Gemm { const bf16_t* A; const bf16_t* Bt; int M, N, K, lda; };

struct StaticOrder {
    int nM, nN, nwg, G, c;
    __host__ __device__ void init(int M, int N, int G_, int c_) { nM = M / BM; nN = N / BM; nwg = nM * nN; G = G_; c = c_; }
    __host__ __device__ bool next(int i, Unit& u) const {
        const long L = (long)i * G + c; if (L >= nwg) return false;
        int wgid = (int)L; { const int q = nwg / NXCD, r = nwg % NXCD, xcd = wgid % NXCD, off = wgid / NXCD; wgid = (xcd < r ? xcd * (q + 1) : r * (q + 1) + (xcd - r) * q) + off; }
        const int nig = WGM * nN, gid = wgid / nig, fm = gid * WGM, gsz = (nM - fm) < WGM ? (nM - fm) : WGM;
        u.pm = fm + ((wgid % nig) % gsz); u.pn = (wgid % nig) / gsz; return true;
    }
    __device__ __forceinline__ void a_ready(const Unit&) const {}
    __device__ __forceinline__ void done(const Unit&) const {}
};

template <class Epi, class Sched, bool ALIGN_EPI = false, bool SP2 = false>
__device__ __forceinline__ void gemm_phase(PG8_LAS unsigned char* lds, const Gemm g, const Sched& S, const Epi& E) {
    int tid_ = threadIdx.x; asm volatile("" : "+v"(tid_));
    const int tid = tid_, wid = __builtin_amdgcn_readfirstlane(tid >> 6), lane = tid & 63, wr = wid >> 2, wc = wid & 3, fr = lane & 15, fq = lane >> 4;
    const int K = g.K, nt = K / BK, lda = g.lda;
    unsigned voffA[2], voffB[2];
#pragma unroll
    for (int i = 0; i < 2; ++i) { int R, C; stage_rc(tid * 16 + i * 8192, R, C); const int Rb = Epi::PERM ? ((R & ~31) + perm32(R & 31)) : R;
        voffA[i] = (unsigned)(R * lda + C) * 2u; voffB[i] = (unsigned)(Rb * K + C) * 2u; }
    const size_t kstep = (size_t)(BK * 2);
    const size_t hstepB = (size_t)HALF * K * 2, hstepA = (size_t)HALF * lda * 2;
    const size_t tstepB = 2 * hstepB, tstepA = 2 * hstepA;
    const unsigned ldsw = (unsigned)wid * 1024u;
    const int aoff = lds_byte(wr * 64 + fr, fq * 8), boff = lds_byte(wc * 32 + fr, fq * 8);
#define PG8_SA(b, h) (((b) * 2 + (h)) * HTB)
#define PG8_SB(b, h) ((4 + (b) * 2 + (h)) * HTB)
#define PG8_STAGE(bufoff, gbase, voff) do { _Pragma("unroll") for (int _i = 0; _i < 2; ++_i) \
        __builtin_amdgcn_global_load_lds((const unsigned*)((const char*)(gbase) + (voff)[_i]), (PG8_LAS unsigned*)(lds + (bufoff) + ldsw + _i * 8192), 16, 0, 0); } while (0)
#define PG8_LDA(dst, b, h) do { _Pragma("unroll") for (int m = 0; m < 4; ++m) _Pragma("unroll") for (int k = 0; k < 2; ++k) dst[m][k] = *(const PG8_LAS bf16x8*)(lds + PG8_SA(b, h) + aoff + m * 2048 + k * 1024); } while (0)
#define PG8_LDB(dst, b, h) do { _Pragma("unroll") for (int n = 0; n < 2; ++n) _Pragma("unroll") for (int k = 0; k < 2; ++k) dst[n][k] = *(const PG8_LAS bf16x8*)(lds + PG8_SB(b, h) + boff + n * 2048 + k * 1024); } while (0)
#define PG8_MMA(ai, bj, At, Bt) do { __builtin_amdgcn_s_setprio(1); _Pragma("unroll") for (int m = 0; m < 4; ++m) _Pragma("unroll") for (int n = 0; n < 2; ++n) _Pragma("unroll") for (int k = 0; k < 2; ++k) \
        acc[ai][bj][m][n] = __builtin_amdgcn_mfma_f32_16x16x32_bf16(Bt[n][k], At[m][k], acc[ai][bj][m][n], 0, 0, 0); __builtin_amdgcn_s_setprio(0); } while (0)
#define PG8_WAIT_V(n) asm volatile("s_waitcnt vmcnt(" #n ")" ::: "memory")
#define PG8_WAIT_L(n) asm volatile("s_waitcnt lgkmcnt(" #n ")" ::: "memory")
#define PG8_BAR __builtin_amdgcn_s_barrier()
#define PG8_SCHED __builtin_amdgcn_sched_barrier(0)
    Unit cur, nxt; int ui = 0;
    if (!S.next(0, cur)) return;
    f32x4 acc[2][2][4][2];
#pragma unroll
    for (int a = 0; a < 2; ++a)
#pragma unroll
        for (int b = 0; b < 2; ++b)
#pragma unroll
            for (int m = 0; m < 4; ++m)
#pragma unroll
                for (int n = 0; n < 2; ++n) acc[a][b][m][n] = (f32x4){0.f, 0.f, 0.f, 0.f};
    bf16x8 At[4][2], B0[2][2], B1[2][2];
    const char* cA = (const char*)g.A + (size_t)cur.pm * tstepA; const char* cB = (const char*)g.Bt + (size_t)cur.pn * tstepB;
    S.a_ready(cur);
    if constexpr (SP2) {
        PG8_STAGE(PG8_SB(0, 0), cB, voffB); PG8_STAGE(PG8_SB(0, 1), cB + hstepB, voffB); PG8_STAGE(PG8_SA(0, 0), cA, voffA); PG8_STAGE(PG8_SA(0, 1), cA + hstepA, voffA);
        if (wr == 1) PG8_BAR;
        PG8_WAIT_V(2); PG8_BAR;
        PG8_STAGE(PG8_SB(1, 0), cB + kstep, voffB); PG8_STAGE(PG8_SA(1, 0), cA + kstep, voffA); PG8_STAGE(PG8_SB(1, 1), cB + hstepB + kstep, voffB);
        PG8_WAIT_V(6); PG8_BAR;
    } else {
        PG8_STAGE(PG8_SB(0, 0), cB, voffB); PG8_STAGE(PG8_SA(0, 0), cA, voffA); PG8_STAGE(PG8_SB(0, 1), cB + hstepB, voffB); PG8_STAGE(PG8_SA(0, 1), cA + hstepA, voffA);
        if (wr == 1) PG8_BAR;
        PG8_WAIT_V(4); PG8_BAR;
        PG8_STAGE(PG8_SB(1, 0), cB + kstep, voffB); PG8_STAGE(PG8_SA(1, 0), cA + kstep, voffA); PG8_STAGE(PG8_SB(1, 1), cB + hstepB + kstep, voffB);
        PG8_WAIT_V(6); PG8_BAR;
    }
    for (;;) {
        const bool has_next = S.next(ui + 1, nxt);
        const char* nA = has_next ? (const char*)g.A + (size_t)nxt.pm * tstepA : cA; const char* nB = has_next ? (const char*)g.Bt + (size_t)nxt.pn * tstepB : cB;
#pragma unroll 1
        for (int t = 0; t < nt; t += 2) {
            const bool last = (t == nt - 2);
            const char* a1 = cA + (size_t)(t + 1) * kstep;
            const char* a2 = last ? nA : cA + (size_t)(t + 2) * kstep; const char* b2 = last ? nB : cB + (size_t)(t + 2) * kstep;
            const char* a3 = a2 + kstep; const char* b3 = b2 + kstep;
            if (last && has_next) S.a_ready(nxt);
            if constexpr (SP2) {
            PG8_LDB(B0, 0, 0); PG8_LDB(B1, 0, 1); PG8_SCHED; PG8_LDA(At, 0, 0); PG8_STAGE(PG8_SA(1, 1), a1 + hstepA, voffA);
            PG8_WAIT_V(8); PG8_WAIT_L(0); PG8_BAR; PG8_MMA(0, 0, At, B0); PG8_MMA(0, 1, At, B1); PG8_BAR; PG8_SCHED;
            PG8_LDA(At, 0, 1); PG8_STAGE(PG8_SB(0, 0), b2, voffB); PG8_STAGE(PG8_SB(0, 1), b2 + hstepB, voffB); PG8_STAGE(PG8_SA(0, 0), a2, voffA);
            PG8_WAIT_V(8); PG8_WAIT_L(0); PG8_BAR; PG8_MMA(1, 0, At, B0); PG8_MMA(1, 1, At, B1); PG8_BAR; PG8_SCHED;
            PG8_LDB(B0, 1, 0); PG8_LDB(B1, 1, 1); PG8_SCHED; PG8_LDA(At, 1, 0); PG8_STAGE(PG8_SA(0, 1), a2 + hstepA, voffA);
            PG8_WAIT_V(8); PG8_WAIT_L(0); PG8_BAR; PG8_MMA(0, 0, At, B0); PG8_MMA(0, 1, At, B1); PG8_BAR; PG8_SCHED;
            PG8_LDA(At, 1, 1); PG8_STAGE(PG8_SB(1, 0), b3, voffB); PG8_STAGE(PG8_SB(1, 1), b3 + hstepB, voffB); PG8_STAGE(PG8_SA(1, 0), a3, voffA);
            PG8_WAIT_V(8); PG8_WAIT_L(0); PG8_BAR; PG8_MMA(1, 0, At, B0); PG8_MMA(1, 1, At, B1); PG8_BAR; PG8_SCHED;
            } else {
            PG8_LDB(B0, 0, 0); PG8_SCHED; PG8_LDA(At, 0, 0); PG8_STAGE(PG8_SA(1, 1), a1 + hstepA, voffA);
            PG8_WAIT_L(8); PG8_BAR; PG8_WAIT_L(0); PG8_MMA(0, 0, At, B0); PG8_BAR; PG8_SCHED;
            PG8_LDB(B1, 0, 1); PG8_STAGE(PG8_SB(0, 0), b2, voffB);
            PG8_BAR; PG8_WAIT_L(0); PG8_MMA(0, 1, At, B1); PG8_BAR;
            PG8_LDA(At, 0, 1); PG8_STAGE(PG8_SA(0, 0), a2, voffA);
            PG8_BAR; PG8_WAIT_L(0); PG8_MMA(1, 0, At, B0); PG8_BAR; PG8_SCHED;
            PG8_STAGE(PG8_SB(0, 1), b2 + hstepB, voffB);
            PG8_WAIT_V(6); PG8_BAR; PG8_MMA(1, 1, At, B1); PG8_BAR;
            PG8_LDB(B0, 1, 0); PG8_SCHED; PG8_LDA(At, 1, 0); PG8_STAGE(PG8_SA(0, 1), a2 + hstepA, voffA);
            PG8_WAIT_L(8); PG8_BAR; PG8_WAIT_L(0); PG8_MMA(0, 0, At, B0); PG8_BAR; PG8_SCHED;
            PG8_LDB(B1, 1, 1); PG8_STAGE(PG8_SB(1, 0), b3, voffB);
            PG8_BAR; PG8_WAIT_L(0); PG8_MMA(0, 1, At, B1); PG8_BAR;
            PG8_LDA(At, 1, 1); PG8_STAGE(PG8_SA(1, 0), a3, voffA);
            PG8_BAR; PG8_WAIT_L(0); PG8_MMA(1, 0, At, B0); PG8_BAR; PG8_SCHED;
            PG8_STAGE(PG8_SB(1, 1), b3 + hstepB, voffB);
            PG8_WAIT_V(6); PG8_BAR; PG8_MMA(1, 1, At, B1); PG8_BAR;
            }
        }
        if constexpr (ALIGN_EPI) { if (wr == 0) PG8_BAR; }
        if constexpr (!Epi::AFTER_DRAIN) { E(acc, cur, wr, wc, fr, fq); S.done(cur); }
        if (!has_next) break;
#pragma unroll
        for (int a = 0; a < 2; ++a)
#pragma unroll
            for (int b = 0; b < 2; ++b)
#pragma unroll
                for (int m = 0; m < 4; ++m)
#pragma unroll
                    for (int n = 0; n < 2; ++n) acc[a][b][m][n] = (f32x4){0.f, 0.f, 0.f, 0.f};
        cur = nxt; cA = nA; cB = nB; ++ui;
        if constexpr (ALIGN_EPI) { if (wr == 1) PG8_BAR; }
    }
    PG8_WAIT_V(0);
    if constexpr (!ALIGN_EPI) { if (wr == 0) PG8_BAR; }
    PG8_BAR;
    if constexpr (Epi::AFTER_DRAIN) { E.fused(acc, cur, wr, wc, fr, fq, lds, wid, lane); S.done(cur); }
#undef PG8_SA
#undef PG8_SB
#undef PG8_STAGE
#undef PG8_LDA
#undef PG8_LDB
#undef PG8_MMA
#undef PG8_WAIT_V
#undef PG8_WAIT_L
#undef PG8_BAR
#undef PG8_SCHED
}
}
DI unsigned sw_off(int row, int chunk) { return (unsigned)(row * 128 + ((chunk ^ ((row >> 1) & 7)) << 4)); }
#define GLDS16(gsrc, ldst) __builtin_amdgcn_global_load_lds((const unsigned*)(gsrc), (unsigned*)(ldst), 16, 0, 0)
DI u32x2 pack4(float a, float b, float c, float d) { u32x2 o; o[0] = pack2(a, b); o[1] = pack2(c, d); return o; }
#define EPI_ARGS const f32x4 (&acc)[2][2][4][2], const pg8::Unit& u, int wr, int wc, int fr, int fq
DI float xq_sum(float v) {
    v += __uint_as_float((unsigned)__builtin_amdgcn_ds_swizzle((int)__float_as_uint(v), 0x401F));
    return xhalf_sum(v);
}
DI u32x4 pack8(const float (&v)[8], float sc) {
    u32x4 o; o[0] = pack2(v[0] * sc, v[1] * sc); o[1] = pack2(v[2] * sc, v[3] * sc); o[2] = pack2(v[4] * sc, v[5] * sc); o[3] = pack2(v[6] * sc, v[7] * sc); return o;
}
DI void rope8(const float (&v)[8], float sc, const float* __restrict__ cs, int pos, int fq, int lane, bf16_t* dst32  ) {
    const int i0 = 8 * (fq & 1);
    const f32x4 c0 = *(const f32x4*)(cs + pos * 16 + i0), c1 = *(const f32x4*)(cs + pos * 16 + i0 + 4);
    const f32x4 s0 = *(const f32x4*)(cs + 65536 + pos * 16 + i0), s1 = *(const f32x4*)(cs + 65536 + pos * 16 + i0 + 4);
    const float sg = (fq < 2) ? -1.0f : 1.0f;
    float o[8];
#pragma unroll
    for (int e = 0; e < 8; ++e) {
        const float own = v[e] * sc, oth = xhalf_other(own, lane);
        const float c = (e < 4) ? c0[e & 3] : c1[e & 3], s = (e < 4) ? s0[e & 3] : s1[e & 3];
        o[e] = own * c + sg * oth * s;
    }
    *(u32x4*)(dst32 + 8 * fq) = pack8(o, 1.0f);
}
#define EPI_LOAD8(v, ai, bj, m) float v[8]; { const f32x4 x0_ = acc[ai][bj][m][0], x1_ = acc[ai][bj][m][1]; v[0] = x0_[0]; v[1] = x0_[1]; v[2] = x0_[2]; v[3] = x0_[3]; v[4] = x1_[0]; v[5] = x1_[1]; v[6] = x1_[2]; v[7] = x1_[3]; }

struct EpiPlain8 {
    static constexpr bool PERM = true, AFTER_DRAIN = false;
    bf16_t* out; int ld;
    DI void operator()(EPI_ARGS) const {
#pragma unroll
        for (int ai = 0; ai < 2; ++ai)
#pragma unroll
            for (int m = 0; m < 4; ++m) {
                int fr_ = fr; asm volatile("" : "+v"(fr_));
                const size_t tok = (size_t)u.pm * 256 + ai * 128 + wr * 64 + m * 16 + fr_;
#pragma unroll
                for (int bj = 0; bj < 2; ++bj) { EPI_LOAD8(v, ai, bj, m); *(u32x4*)(out + tok * ld + u.pn * 256 + bj * 128 + wc * 32 + 8 * fq) = pack8(v, 1.0f); }
            }
    }
};

struct EpiProj8 {
    static constexpr bool PERM = true, AFTER_DRAIN = false;
    bf16_t* proj; bf16_t* kr; const float* cs; float* ssq;
    DI void operator()(EPI_ARGS) const {
        const int lane = fr + 16 * fq;
#pragma unroll
        for (int bj = 0; bj < 2; ++bj) {
            const int cg = u.pn * 256 + bj * 128 + wc * 32;
            if (cg >= INC) continue;
            const int g32 = cg >> 5;
            const float sc = (cg >= 672 && cg < 1184) ? 0.125f * LOG2E : 1.0f;
#pragma unroll
            for (int ai = 0; ai < 2; ++ai)
#pragma unroll
                for (int m = 0; m < 4; ++m) {
                    int fr_ = fr; asm volatile("" : "+v"(fr_));
                const size_t tok = (size_t)u.pm * 256 + ai * 128 + wr * 64 + m * 16 + fr_;
                    EPI_LOAD8(v, ai, bj, m);
                    if (g32 < 20) {
                        float ss = 0.f;
#pragma unroll
                        for (int e = 0; e < 8; ++e) ss += v[e] * v[e];
                        ss = xq_sum(ss);
                        if (fq == 0) ssq[tok * 24 + g32] = ss;
                    }
                    if (cg == 640) rope8(v, 1.0f, cs, (int)(tok & (SEQ_L - 1)), fq, lane, kr + tok * 32);
                    else *(u32x4*)(proj + tok * INC + cg + 8 * fq) = pack8(v, sc);
                }
        }
    }
};

struct EpiUpQ8 {
    static constexpr bool PERM = true, AFTER_DRAIN = false;
    bf16_t* q; const float* cs; const float* ssq;
    DI void operator()(EPI_ARGS) const {
        const int lane = fr + 16 * fq;
        const float qs = 0.10206207261596575f * LOG2E;
#pragma unroll
        for (int ai = 0; ai < 2; ++ai)
#pragma unroll
            for (int m = 0; m < 4; ++m) {
                int fr_ = fr; asm volatile("" : "+v"(fr_));
                const size_t tok = (size_t)u.pm * 256 + ai * 128 + wr * 64 + m * 16 + fr_;
                const f32x4 a0 = *(const f32x4*)(ssq + tok * 24), a1 = *(const f32x4*)(ssq + tok * 24 + 4), a2 = *(const f32x4*)(ssq + tok * 24 + 8);
                const float tot = (a0[0] + a0[1] + a0[2] + a0[3]) + (a1[0] + a1[1] + a1[2] + a1[3]) + (a2[0] + a2[1] + a2[2] + a2[3]);
                const float sc = rsqrtf(tot * (1.0f / 384.0f) + 1e-6f) * qs;
#pragma unroll
                for (int bj = 0; bj < 2; ++bj) {
                    const int cg = u.pn * 256 + bj * 128 + wc * 32;
                    EPI_LOAD8(v, ai, bj, m);
                    if ((cg % 96) == 64) rope8(v, sc, cs, (int)(tok & (SEQ_L - 1)), fq, lane, q + tok * 768 + cg);
                    else *(u32x4*)(q + tok * 768 + cg + 8 * fq) = pack8(v, sc);
                }
            }
    }
};

struct EpiUpKV8 {
    static constexpr bool PERM = true, AFTER_DRAIN = false;
    bf16_t* kv; const float* ssq;
    DI void operator()(EPI_ARGS) const {
#pragma unroll
        for (int ai = 0; ai < 2; ++ai)
#pragma unroll
            for (int m = 0; m < 4; ++m) {
                int fr_ = fr; asm volatile("" : "+v"(fr_));
                const size_t tok = (size_t)u.pm * 256 + ai * 128 + wr * 64 + m * 16 + fr_;
                const f32x4 a0 = *(const f32x4*)(ssq + tok * 24 + 12), a1 = *(const f32x4*)(ssq + tok * 24 + 16);
                const float tot = (a0[0] + a0[1] + a0[2] + a0[3]) + (a1[0] + a1[1] + a1[2] + a1[3]);
                const float sc = rsqrtf(tot * (1.0f / 256.0f) + 1e-6f);
#pragma unroll
                for (int bj = 0; bj < 2; ++bj) { EPI_LOAD8(v, ai, bj, m); *(u32x4*)(kv + tok * 1024 + u.pn * 256 + bj * 128 + wc * 32 + 8 * fq) = pack8(v, sc); }
            }
    }
};

struct EpiResid8 {
    static constexpr bool PERM = true, AFTER_DRAIN = false;
    const float* R; float* H; bf16_t* HB; float* SS;
    DI void operator()(EPI_ARGS) const {
#pragma unroll
        for (int ai = 0; ai < 2; ++ai) {
            f32x4 rv[4][2][2];
#pragma unroll
            for (int m = 0; m < 4; ++m)
#pragma unroll
                for (int bj = 0; bj < 2; ++bj) {
                    const size_t off = ((size_t)u.pm * 256 + ai * 128 + wr * 64 + m * 16 + fr) * 1024 + u.pn * 256 + bj * 128 + wc * 32 + 8 * fq;
                    rv[m][bj][0] = *(const f32x4*)(R + off); rv[m][bj][1] = *(const f32x4*)(R + off + 4);
                }
#pragma unroll
            for (int m = 0; m < 4; ++m) {
                int fr_ = fr; asm volatile("" : "+v"(fr_));
                const size_t tok = (size_t)u.pm * 256 + ai * 128 + wr * 64 + m * 16 + fr_;
                float ss = 0.f;
#pragma unroll
                for (int bj = 0; bj < 2; ++bj) {
                    const size_t off = tok * 1024 + u.pn * 256 + bj * 128 + wc * 32 + 8 * fq;
                    const f32x4 h0 = rv[m][bj][0] + acc[ai][bj][m][0], h1 = rv[m][bj][1] + acc[ai][bj][m][1];
                    ss += (h0[0] * h0[0] + h0[1] * h0[1]) + (h0[2] * h0[2] + h0[3] * h0[3]) + (h1[0] * h1[0] + h1[1] * h1[1]) + (h1[2] * h1[2] + h1[3] * h1[3]);
                    *(f32x4*)(H + off) = h0; *(f32x4*)(H + off + 4) = h1;
                    u32x4 o; o[0] = pack2(h0[0], h0[1]); o[1] = pack2(h0[2], h0[3]); o[2] = pack2(h1[0], h1[1]); o[3] = pack2(h1[2], h1[3]);
                    *(u32x4*)(HB + off) = o;
                }
                ss = xq_sum(ss);
                if (fq == 0) SS[tok * 16 + 4 * u.pn + wc] = ss;
            }
        }
    }
};

struct EpiRowScale8 {
    static constexpr bool PERM = true, AFTER_DRAIN = false;
    bf16_t* out; int ld; const float* SS; float extra;
    DI void operator()(EPI_ARGS) const {
#pragma unroll
        for (int ai = 0; ai < 2; ++ai)
#pragma unroll
            for (int m = 0; m < 4; ++m) {
                int fr_ = fr; asm volatile("" : "+v"(fr_));
                const size_t tok = (size_t)u.pm * 256 + ai * 128 + wr * 64 + m * 16 + fr_;
                const f32x4 s0 = *(const f32x4*)(SS + tok * 16), s1 = *(const f32x4*)(SS + tok * 16 + 4), s2 = *(const f32x4*)(SS + tok * 16 + 8), s3 = *(const f32x4*)(SS + tok * 16 + 12);
                const float tot = (s0[0] + s0[1] + s0[2] + s0[3]) + (s1[0] + s1[1] + s1[2] + s1[3]) + (s2[0] + s2[1] + s2[2] + s2[3]) + (s3[0] + s3[1] + s3[2] + s3[3]);
                const float sc = rsqrtf(tot * (1.0f / 1024.0f) + 1e-6f) * extra;
#pragma unroll
                for (int bj = 0; bj < 2; ++bj) { EPI_LOAD8(v, ai, bj, m); *(u32x4*)(out + tok * ld + u.pn * 256 + bj * 128 + wc * 32 + 8 * fq) = pack8(v, sc); }
            }
    }
};

template <class Epi>
DI void gemm8(char* smem, const bf16_t* A, int lda, const bf16_t* Bt, int M, int N, int K, const Epi& e) {
    pg8::Gemm g; g.A = A; g.Bt = Bt; g.M = M; g.N = N; g.K = K; g.lda = lda;
    pg8::StaticOrder S; S.init(M, N, (int)gridDim.x, (int)blockIdx.x);
    pg8::gemm_phase<Epi, pg8::StaticOrder, true, true>((PG8_LAS unsigned char*)smem, g, S, e);
}

DI void phase_p1(const Params& p, char* smem) {
    char* ws = p.ws;
    { EpiProj8 e{(bf16_t*)(ws + OFF_PROJ), (bf16_t*)(ws + OFF_KR), (const float*)(ws + OFF_ROPE), (float*)(ws + OFF_SSQ)};
      gemm8(smem, (const bf16_t*)(ws + OFF_XN), 1024, (const bf16_t*)(ws + OFF_WT_IN), T_TOK, 2304, 1024, e); }
    { EpiPlain8 e{(bf16_t*)(ws + OFF_KVM), 2048};
      gemm8(smem, (const bf16_t*)(ws + OFF_MEMN), 1024, (const bf16_t*)(ws + OFF_WT_MKV), 1024, 2048, 1024, e); }
}
DI void phase_p2(const Params& p, char* smem) {
    char* ws = p.ws;
    { EpiUpQ8 e{(bf16_t*)(ws + OFF_QMLA), (const float*)(ws + OFF_ROPE), (const float*)(ws + OFF_SSQ)};
      gemm8(smem, (const bf16_t*)(ws + OFF_PROJ), INC, (const bf16_t*)(ws + OFF_WT_UQ), T_TOK, 768, 384, e); }
    { EpiUpKV8 e{(bf16_t*)(ws + OFF_KVMLA), (const float*)(ws + OFF_SSQ)};
      gemm8(smem, (const bf16_t*)(ws + OFF_PROJ) + 384, INC, (const bf16_t*)(ws + OFF_WT_UKV), T_TOK, 1024, 256, e); }
}
DI void phase_resid(const Params& p, char* smem, size_t off_w, size_t off_a, const float* R, size_t off_ss, bool dry = false) {
    char* ws = p.ws;
    EpiResid8 e{R, p.out, (bf16_t*)(ws + OFF_HB), (float*)(ws + off_ss)};
    if (dry) { e.H = (float*)(ws + OFF_PQ); e.HB = (bf16_t*)(ws + OFF_B); e.SS = (float*)(ws + OFF_SS1); }
    gemm8(smem, (const bf16_t*)(ws + off_a), 1024, (const bf16_t*)(ws + off_w), T_TOK, 1024, 1024, e);
}
DI void phase_rowscale(const Params& p, char* smem, size_t off_w, int N, size_t off_out, size_t off_ss, float extra) {
    char* ws = p.ws;
    EpiRowScale8 e{(bf16_t*)(ws + off_out), N, (const float*)(ws + off_ss), extra};
    gemm8(smem, (const bf16_t*)(ws + OFF_HB), 1024, (const bf16_t*)(ws + off_w), T_TOK, N, 1024, e);
}
DI unsigned v128_off(int row, int chunk) { return (unsigned)(row * 128 + ((chunk ^ (((row >> 1) & 1) << 2)) << 4)); }
DI unsigned v128_tr_addr(unsigned base, int R0, int c, int lane) {
    const int blk = (lane >> 4) & 1, qq = (lane & 15) >> 2, pp = lane & 3;
    return base + v128_off(R0 + qq, 4 * c + 2 * blk + (pp >> 1)) + 8 * (pp & 1);
}
DI bf16x8 cat44(s16x4 lo, s16x4 hi) { return __builtin_shufflevector(lo, hi, 0, 1, 2, 3, 4, 5, 6, 7); }

constexpr int MLA_KROW = 208;
constexpr int MLA_STAGE = 64 * MLA_KROW + 64 * 128;
DI void mla_unit(const Params& p, char* lds, int b, int h, int qt) {
    char* ws = p.ws;
    const int t = otid(), lane = t & 63, wv = t >> 6, r = lane & 31, hh = lane >> 5;
    const bf16_t* Q = (const bf16_t*)(ws + OFF_QMLA);
    const bf16_t* KV = (const bf16_t*)(ws + OFF_KVMLA);
    const bf16_t* KR = (const bf16_t*)(ws + OFF_KR);
    const int q0 = qt * 128 + 32 * wv;
    const size_t tokq = (size_t)b * SEQ_L + q0 + r;
    bf16x8 qf[6];
#pragma unroll
    for (int s = 0; s < 6; ++s) qf[s] = ld16(Q + tokq * 768 + h * 96 + 16 * s + 8 * hh);
    f32x16 o[2]; o[0] = zero16(); o[1] = zero16();
    float m = -INFINITY, l = 0.f;
    int kkey[3], kc[3];
#pragma unroll
    for (int i = 0; i < 3; ++i) { const int id = t + 256 * i; kkey[i] = id / 12; kc[i] = id % 12; }
    const int vkey0 = t >> 3, vc = t & 7;
    const size_t tokb = (size_t)b * SEQ_L;
    const int ntiles = 2 * qt + 2;
    u32x4 kr_[3], vr_[2];
    auto load_tile = [&](int kt) {
#pragma unroll
        for (int i = 0; i < 3; ++i) {
            const size_t tk = tokb + 64 * kt + kkey[i];
            kr_[i] = (kc[i] < 8) ? ldu4(KV + tk * 1024 + h * 128 + 8 * kc[i]) : ldu4(KR + tk * 32 + 8 * (kc[i] - 8));
        }
#pragma unroll
        for (int i = 0; i < 2; ++i) {
            const size_t tk = tokb + 64 * kt + vkey0 + 32 * i;
            vr_[i] = ldu4(KV + tk * 1024 + h * 128 + 64 + 8 * vc);
        }
    };
    auto store_tile = [&](char* sb) {
#pragma unroll
        for (int i = 0; i < 3; ++i) *(u32x4*)(sb + kkey[i] * MLA_KROW + kc[i] * 16) = kr_[i];
#pragma unroll
        for (int i = 0; i < 2; ++i) *(u32x4*)(sb + 64 * MLA_KROW + v128_off(vkey0 + 32 * i, vc)) = vr_[i];
    };
    load_tile(0);
    __syncthreads();
    store_tile(lds);
    __syncthreads();
    for (int kt = 0; kt < ntiles; ++kt) {
        const bool more = (kt + 1 < ntiles);
        if (more) load_tile(kt + 1);
        const char* sb = lds + (kt & 1) * MLA_STAGE;
        const unsigned vb = (unsigned)(uintptr_t)(sb + 64 * MLA_KROW);
        f32x16 s[2];
#pragma unroll
        for (int k2 = 0; k2 < 2; ++k2) {
            s[k2] = zero16();
#pragma unroll
            for (int ss = 0; ss < 6; ++ss) s[k2] = MFMA32(ld16(sb + (32 * k2 + r) * MLA_KROW + (2 * ss + hh) * 16), qf[ss], s[k2]);
        }
        if (kt >= 2 * qt) {
            const int qpos = q0 + r;
#pragma unroll
            for (int k2 = 0; k2 < 2; ++k2)
#pragma unroll
                for (int i = 0; i < 16; ++i) { const int kpos = 64 * kt + 32 * k2 + crow(i, hh); if (kpos > qpos) s[k2][i] = -INFINITY; }
        }
        float mx = s[0][0];
#pragma unroll
        for (int k2 = 0; k2 < 2; ++k2)
#pragma unroll
            for (int i = 0; i < 16; ++i) mx = fmaxf(mx, s[k2][i]);
        mx = xhalf_max(mx);
        const float mn = fmaxf(m, mx);
        const float alpha = fast_exp2(m - mn);
        float ps = 0.f;
#pragma unroll
        for (int k2 = 0; k2 < 2; ++k2)
#pragma unroll
            for (int i = 0; i < 16; ++i) { const float e = fast_exp2(s[k2][i] - mn); s[k2][i] = e; ps += e; }
        l = l * alpha + ps;
        m = mn;
#pragma unroll
        for (int c = 0; c < 2; ++c)
#pragma unroll
            for (int i = 0; i < 16; ++i) o[c][i] *= alpha;
#pragma unroll
        for (int k2 = 0; k2 < 2; ++k2)
#pragma unroll
            for (int st = 0; st < 2; ++st) {
                const bf16x8 pb = pack_step(s[k2], st);
#pragma unroll
                for (int c = 0; c < 2; ++c) {
                    const s16x4 lo = tr_read(v128_tr_addr(vb, 32 * k2 + 16 * st + 4 * hh, c, lane));
                    const s16x4 hi = tr_read(v128_tr_addr(vb, 32 * k2 + 16 * st + 8 + 4 * hh, c, lane));
                    o[c] = MFMA32(cat44(lo, hi), pb, o[c]);
                }
            }
        if (more) store_tile(lds + ((kt + 1) & 1) * MLA_STAGE);
        __syncthreads();
    }
    const float inv = 1.0f / xhalf_sum(l);
    bf16_t* dst = (bf16_t*)(ws + OFF_OMLA) + tokq * 512 + h * 64 + 4 * hh;
#pragma unroll
    for (int c = 0; c < 2; ++c)
#pragma unroll
        for (int g = 0; g < 4; ++g)
            *(u32x2*)(dst + 32 * c + 8 * g) = pack4(o[c][4 * g] * inv, o[c][4 * g + 1] * inv, o[c][4 * g + 2] * inv, o[c][4 * g + 3] * inv);
}

DI void dil_unit(const Params& p, char* lds, int g, int b, int h, int rr, int lb) {
    char* ws = p.ws;
    const int t = otid(), lane = t & 63, wv = t >> 6, r = lane & 31, hh = lane >> 5;
    const int d = (g == 0) ? 1 : (g == 1 ? 4 : 16);
    const bf16_t* PJ = (const bf16_t*)(ws + OFF_PROJ);
    const size_t tokb = (size_t)b * SEQ_L;
    char* kimg = lds;
    char* vimg = lds + 32768;
    __syncthreads();
    {
        const int c = t & 7;
#pragma unroll
        for (int half = 0; half < 2; ++half) {
            u32x4 kk[4], vv[4];
#pragma unroll
            for (int i = 0; i < 4; ++i) {
                const int key = (t >> 3) + 32 * (4 * half + i);
                const int lk = 128 * lb - 128 + key;
                if (lk >= 0) {
                    const size_t tk = tokb + (size_t)lk * d + rr;
                    kk[i] = ldu4(PJ + tk * INC + 1184 + h * 64 + 8 * c);
                    vv[i] = ldu4(PJ + tk * INC + 1696 + h * 64 + 8 * c);
                } else { kk[i] = (u32x4){0u, 0u, 0u, 0u}; vv[i] = (u32x4){0u, 0u, 0u, 0u}; }
            }
#pragma unroll
            for (int i = 0; i < 4; ++i) {
                const int key = (t >> 3) + 32 * (4 * half + i);
                *(u32x4*)(kimg + sw_off(key, c)) = kk[i];
                *(u32x4*)(vimg + v128_off(key, c)) = vv[i];
            }
        }
    }
    const int lq = 128 * lb + 32 * wv + r;
    const size_t tokq = tokb + (size_t)lq * d + rr;
    bf16x8 qf[4];
#pragma unroll
    for (int s = 0; s < 4; ++s) qf[s] = ld16(PJ + tokq * INC + 672 + h * 64 + 16 * s + 8 * hh);
    __syncthreads();
    const float slope2 = exp2f(-(float)(h + 1)) * (float)d * LOG2E;
    const int u0 = (lb == 0) ? (4 - wv) : 0;
    f32x16 o[2]; o[0] = zero16(); o[1] = zero16();
    float m = -INFINITY, lsum = 0.f;
    const unsigned vb = (unsigned)(uintptr_t)vimg;
#pragma unroll 1
    for (int u = u0; u < 5; ++u) {
        const int rowb = 32 * (wv + u);
        f32x16 s = zero16();
#pragma unroll
        for (int ss = 0; ss < 4; ++ss) s = MFMA32(ld16(kimg + sw_off(rowb + r, 2 * ss + hh)), qf[ss], s);
        const int dbase = r + 128 - 32 * u;
        float mx = -INFINITY;
#pragma unroll
        for (int i = 0; i < 16; ++i) {
            const int dist = dbase - crow(i, hh);
            const bool valid = (dist >= 0) && (dist <= 128);
            const float v = valid ? (s[i] - slope2 * (float)dist) : -INFINITY;
            s[i] = v;
            mx = fmaxf(mx, v);
        }
        mx = xhalf_max(mx);
        const float mn = fmaxf(m, mx);
        const float alpha = fast_exp2(m - mn);
        float ps = 0.f;
#pragma unroll
        for (int i = 0; i < 16; ++i) { const float e = fast_exp2(s[i] - mn); s[i] = e; ps += e; }
        lsum = lsum * alpha + ps;
        m = mn;
#pragma unroll
        for (int c = 0; c < 2; ++c)
#pragma unroll
            for (int i = 0; i < 16; ++i) o[c][i] *= alpha;
#pragma unroll
        for (int st = 0; st < 2; ++st) {
            const bf16x8 pb = pack_step(s, st);
#pragma unroll
            for (int c = 0; c < 2; ++c) {
                const s16x4 lo = tr_read(v128_tr_addr(vb, rowb + 16 * st + 4 * hh, c, lane));
                const s16x4 hi = tr_read(v128_tr_addr(vb, rowb + 16 * st + 8 + 4 * hh, c, lane));
                o[c] = MFMA32(cat44(lo, hi), pb, o[c]);
            }
        }
    }
    const float ltot = xhalf_sum(lsum);
    const float mx = m;
    const float inv = 1.0f / ltot;
    bf16_t* dst = (bf16_t*)(ws + OFF_ODIL) + ((size_t)g * T_TOK + tokq) * 512 + h * 64 + 4 * hh;
#pragma unroll
    for (int c = 0; c < 2; ++c)
#pragma unroll
        for (int gg = 0; gg < 4; ++gg)
            *(u32x2*)(dst + 32 * c + 8 * gg) = pack4(o[c][4 * gg] * inv, o[c][4 * gg + 1] * inv, o[c][4 * gg + 2] * inv, o[c][4 * gg + 3] * inv);
    if (hh == 0) ((float*)(ws + OFF_LSE))[((size_t)g * T_TOK + tokq) * 8 + h] = mx + __log2f(ltot);
}

DI void phase_p3(const Params& p, char* lds) {
    for (int item = vbid(); item < 512; item += vgrid()) {
        const int b = item >> 7, pr = (item >> 3) & 15, h = item & 7;
#pragma unroll 1
        for (int rep = 0; rep < 2; ++rep) mla_unit(p, lds, b, h, rep ? pr : 31 - pr);
    }
    for (int u = vbid(); u < 3072; u += vgrid()) {
        const int g = u >> 10, rem = u & 1023, b = rem >> 8, h = (rem >> 5) & 7, k = rem & 31;
        int rr, lb;
        if (g == 0) { rr = 0; lb = k; } else if (g == 1) { rr = k >> 3; lb = k & 7; } else { rr = k >> 1; lb = k & 1; }
        dil_unit(p, lds, g, b, h, rr, lb);
    }
}

DI void phase_p35(const Params& p, char* lds) {
    char* ws = p.ws;
    const int t = otid(), lane = t & 63, wv = t >> 6;
    const int ntok = T_TOK / 4, ncv = 4096;
    for (int item = vbid(); item < ntok + 2 * ncv; item += vgrid()) {
        if (item < ntok) {
            const size_t tok = (size_t)item * 4 + wv;
            const int head = lane >> 3;
            const float* LS = (const float*)(ws + OFF_LSE);
            const float l0 = LS[tok * 8 + head], l1 = LS[((size_t)T_TOK + tok) * 8 + head], l2 = LS[((size_t)2 * T_TOK + tok) * 8 + head];
            const float mx = fmaxf(l0, fmaxf(l1, l2));
            float w0 = fast_exp2(l0 - mx), w1 = fast_exp2(l1 - mx), w2 = fast_exp2(l2 - mx);
            const float wi = 1.0f / (w0 + w1 + w2);
            w0 *= wi; w1 *= wi; w2 *= wi;
            const bf16_t* OD = (const bf16_t*)(ws + OFF_ODIL);
            const u32x4 a0 = ldu4(OD + tok * 512 + 8 * lane), a1 = ldu4(OD + ((size_t)T_TOK + tok) * 512 + 8 * lane),
                        a2 = ldu4(OD + ((size_t)2 * T_TOK + tok) * 512 + 8 * lane);
            const u32x4 am = ldu4((const bf16_t*)(ws + OFF_OMLA) + tok * 512 + 8 * lane);
            float od[8], om[8]; float sd = 0.f, sm = 0.f;
#pragma unroll
            for (int e = 0; e < 4; ++e) {
                od[2 * e] = w0 * bf_lo(a0[e]) + w1 * bf_lo(a1[e]) + w2 * bf_lo(a2[e]);
                od[2 * e + 1] = w0 * bf_hi(a0[e]) + w1 * bf_hi(a1[e]) + w2 * bf_hi(a2[e]);
                om[2 * e] = bf_lo(am[e]); om[2 * e + 1] = bf_hi(am[e]);
                sd += od[2 * e] * od[2 * e] + od[2 * e + 1] * od[2 * e + 1];
                sm += om[2 * e] * om[2 * e] + om[2 * e + 1] * om[2 * e + 1];
            }
#pragma unroll
            for (int o = 32; o; o >>= 1) { sd += __shfl_xor(sd, o); sm += __shfl_xor(sm, o); }
            const float rd = rsqrtf(sd * (1.0f / 512.0f) + 1e-6f), rm = rsqrtf(sm * (1.0f / 512.0f) + 1e-6f);
            const f32x4 gm0 = *(const f32x4*)(p.gn_mla + 8 * lane), gm1 = *(const f32x4*)(p.gn_mla + 8 * lane + 4);
            const f32x4 gd0 = *(const f32x4*)(p.gn_dil + 8 * lane), gd1 = *(const f32x4*)(p.gn_dil + 8 * lane + 4);
            u32x4 o1, o2;
            o1[0] = pack2(om[0] * rm * gm0[0], om[1] * rm * gm0[1]); o1[1] = pack2(om[2] * rm * gm0[2], om[3] * rm * gm0[3]);
            o1[2] = pack2(om[4] * rm * gm1[0], om[5] * rm * gm1[1]); o1[3] = pack2(om[6] * rm * gm1[2], om[7] * rm * gm1[3]);
            o2[0] = pack2(od[0] * rd * gd0[0], od[1] * rd * gd0[1]); o2[1] = pack2(od[2] * rd * gd0[2], od[3] * rd * gd0[3]);
            o2[2] = pack2(od[4] * rd * gd1[0], od[5] * rd * gd1[1]); o2[3] = pack2(od[6] * rd * gd1[2], od[7] * rd * gd1[3]);
            bf16_t* MX = (bf16_t*)(ws + OFF_MIXED) + tok * 1024;
            *(u32x4*)(MX + 8 * lane) = o1;
            *(u32x4*)(MX + 512 + 8 * lane) = o2;
        } else {
            const int it = item - ntok;
            const bool isv = it >= ncv;
            const size_t row = (size_t)(isv ? it - ncv : it) * 4 + wv;
            const float* src = (isv ? p.peer_v : p.peer_u) + row * 1024 + 16 * lane;
            f32x4 v[4]; float am = 0.f;
#pragma unroll
            for (int i = 0; i < 4; ++i) { v[i] = *(const f32x4*)(src + 4 * i); am = fmaxf(am, fmaxf(fmaxf(fabsf(v[i][0]), fabsf(v[i][1])), fmaxf(fabsf(v[i][2]), fabsf(v[i][3])))); }
#pragma unroll
            for (int o = 32; o; o >>= 1) am = fmaxf(am, __shfl_xor(am, o));
            const float sc = (am > 0.f) ? am * (1.0f / 127.0f) : 1.0f;
            const float inv = 1.0f / sc;
            const int bias = isv ? 128 : 0;
            u32x4 o;
#pragma unroll
            for (int i = 0; i < 4; ++i) {
                unsigned w = 0u;
#pragma unroll
                for (int e = 0; e < 4; ++e) { const int q = (int)rintf(v[i][e] * inv) + bias; w |= ((unsigned)q & 0xFFu) << (8 * e); }
                o[i] = w;
            }
            *(u32x4*)(ws + (isv ? OFF_VQ : OFF_UQ) + row * 1024 + 16 * lane) = o;
            if (lane == 0) ((float*)(ws + (isv ? OFF_SV : OFF_SU)))[row] = sc;
        }
    }
}

DI unsigned m512_off(int row, int chunk) { return (unsigned)(row * 512 + ((chunk ^ (row & 15)) << 4)); }
DI unsigned v512_off(int row, int chunk) { return (unsigned)(row * 512 + ((chunk ^ ((row & 3) << 2)) << 4)); }
DI void memattn_unit(const Params& p, char* lds, int b, int h, int tt) {
    char* ws = p.ws;
    const int t = otid(), lane = t & 63, wv = t >> 6, r = lane & 31, hh = lane >> 5;
    const int qg = wv & 1, dh = wv >> 1;
    const bf16_t* QM = (const bf16_t*)(ws + OFF_QM);
    const bf16_t* KVM = (const bf16_t*)(ws + OFF_KVM);
    const size_t tokq = (size_t)b * SEQ_L + tt * 64 + 32 * qg + r;
    bf16x8 qf[16];
#pragma unroll
    for (int s = 0; s < 16; ++s) qf[s] = ld16(QM + tokq * 1024 + h * 256 + 16 * s + 8 * hh);
    f32x16 o[4];
#pragma unroll
    for (int c = 0; c < 4; ++c) o[c] = zero16();
    float m = -INFINITY, l = 0.f;
    const bf16_t* ksrc[4]; const bf16_t* vsrc[4];
#pragma unroll
    for (int i = 0; i < 4; ++i) {
        const int row = 2 * (wv + 4 * i) + (lane >> 5), pch = lane & 31;
        const size_t mrow = (size_t)b * 256 + row;
        ksrc[i] = KVM + mrow * 2048 + h * 256 + 8 * (pch ^ (row & 15));
        vsrc[i] = KVM + mrow * 2048 + 1024 + h * 256 + 8 * (pch ^ ((row & 3) << 2));
    }
    char* ldst = lds + wv * 1024 + lane * 16;
    auto stage_tile = [&](int kt, char* sb) {
#pragma unroll
        for (int i = 0; i < 4; ++i) { GLDS16(ksrc[i] + (size_t)kt * 32 * 2048, sb + i * 4096); GLDS16(vsrc[i] + (size_t)kt * 32 * 2048, sb + 16384 + i * 4096); }
    };
    __syncthreads();
    stage_tile(0, ldst);
    __syncthreads();
#pragma unroll 1
    for (int kt = 0; kt < 8; ++kt) {
        if (kt + 1 < 8) stage_tile(kt + 1, ldst + ((kt + 1) & 1) * 32768);
        const char* sb = lds + (kt & 1) * 32768;
        const unsigned vb = (unsigned)(uintptr_t)(sb + 16384);
        f32x16 s = zero16();
#pragma unroll
        for (int ss = 0; ss < 16; ++ss) s = MFMA32(ld16(sb + m512_off(r, 2 * ss + hh)), qf[ss], s);
        float mx = s[0];
#pragma unroll
        for (int i = 1; i < 16; ++i) mx = fmaxf(mx, s[i]);
        mx = xhalf_max(mx);
        const float mn = fmaxf(m, mx);
        const float alpha = fast_exp2(m - mn);
        float ps = 0.f;
#pragma unroll
        for (int i = 0; i < 16; ++i) { const float e = fast_exp2(s[i] - mn); s[i] = e; ps += e; }
        l = l * alpha + ps;
        m = mn;
#pragma unroll
        for (int c = 0; c < 4; ++c)
#pragma unroll
            for (int i = 0; i < 16; ++i) o[c][i] *= alpha;
        const int blk = (lane >> 4) & 1, qq = (lane & 15) >> 2, pp = lane & 3;
#pragma unroll
        for (int st = 0; st < 2; ++st) {
            const bf16x8 pb = pack_step(s, st);
#pragma unroll
            for (int c = 0; c < 4; ++c) {
                const int ch = 16 * dh + 4 * c + 2 * blk + (pp >> 1);
                const s16x4 lo = tr_read(vb + v512_off(16 * st + 4 * hh + qq, ch) + 8 * (pp & 1));
                const s16x4 hi = tr_read(vb + v512_off(16 * st + 8 + 4 * hh + qq, ch) + 8 * (pp & 1));
                o[c] = MFMA32(cat44(lo, hi), pb, o[c]);
            }
        }
        __syncthreads();
    }
    const float inv = 1.0f / xhalf_sum(l);
    bf16_t* dst = (bf16_t*)(ws + OFF_OM) + tokq * 1024 + h * 256 + 128 * dh + 4 * hh;
#pragma unroll
    for (int c = 0; c < 4; ++c)
#pragma unroll
        for (int g = 0; g < 4; ++g)
            *(u32x2*)(dst + 32 * c + 8 * g) = pack4(o[c][4 * g] * inv, o[c][4 * g + 1] * inv, o[c][4 * g + 2] * inv, o[c][4 * g + 3] * inv);
}

DI void phase_memattn(const Params& p, char* lds) {
    for (int item = vbid(); item < 1024; item += vgrid()) {
        const int b = item >> 8, h = (item >> 6) & 3, tt = item & 63;
        memattn_unit(p, lds, b, h, tt);
    }
}
DI unsigned f2sort(float f) { const unsigned b = __float_as_uint(f); return b ^ ((b & 0x80000000u) ? 0xFFFFFFFFu : 0x80000000u); }
DI float sort2f(unsigned u) { const unsigned b = (u & 0x80000000u) ? (u ^ 0x80000000u) : ~u; return __uint_as_float(b); }
DI void cswap(unsigned& a, unsigned& b) { const unsigned hi = max(a, b), lo = min(a, b); a = hi; b = lo; }

template <int LO, int N> struct BClean {
    template <int M> static DI void run(unsigned (&a)[M]) {
#pragma unroll
        for (int i = 0; i < N / 2; ++i) cswap(a[LO + i], a[LO + i + N / 2]);
        BClean<LO, N / 2>::run(a); BClean<LO + N / 2, N / 2>::run(a);
    }
};
template <int LO> struct BClean<LO, 1> { template <int M> static DI void run(unsigned (&)[M]) {} };
template <int LO, int N> struct BSort {
    template <int M> static DI void run(unsigned (&a)[M]) {
        BSort<LO, N / 2>::run(a); BSort<LO + N / 2, N / 2>::run(a);
#pragma unroll
        for (int i = 0; i < N / 2; ++i) cswap(a[LO + i], a[LO + N - 1 - i]);
        BClean<LO, N / 2>::run(a); BClean<LO + N / 2, N / 2>::run(a);
    }
};
template <int LO> struct BSort<LO, 1> { template <int M> static DI void run(unsigned (&)[M]) {} };
DI void merge_top16(unsigned (&a)[16], const unsigned (&b)[16]) {
#pragma unroll
    for (int i = 0; i < 16; ++i) a[i] = max(a[i], b[15 - i]);
    BClean<0, 16>::run(a);
}

DI void peer_top16(const bf16_t* __restrict__ keys_hp, const bf16_t* __restrict__ pq_row_hp, int r, int hh, unsigned (&top)[16]) {
    bf16x8 qf[8];
#pragma unroll
    for (int s = 0; s < 8; ++s) qf[s] = ld16(pq_row_hp + 16 * s + 8 * hh);
    unsigned cur[16];
#pragma unroll
    for (int kt = 0; kt < 4; ++kt) {
        f32x16 acc = zero16();
#pragma unroll
        for (int s = 0; s < 8; ++s) acc = MFMA32(ld16(keys_hp + (size_t)(32 * kt + r) * 128 + 16 * s + 8 * hh), qf[s], acc);
        unsigned k[16];
#pragma unroll
        for (int i = 0; i < 16; ++i) k[i] = (f2sort(acc[i]) & ~0x7Fu) | (unsigned)(32 * kt + crow(i, hh));
        BSort<0, 16>::run(k);
        if (kt == 0) {
#pragma unroll
            for (int i = 0; i < 16; ++i) cur[i] = k[i];
        } else merge_top16(cur, k);
    }
    unsigned r0[16], r1[16];
#pragma unroll
    for (int i = 0; i < 16; ++i) { auto rr = __builtin_amdgcn_permlane32_swap(cur[i], cur[i], false, false); r0[i] = rr[0]; r1[i] = rr[1]; }
#pragma unroll
    for (int i = 0; i < 16; ++i) top[i] = max(r0[i], r1[15 - i]);
    BClean<0, 16>::run(top);
}

DI void peer_select_unit(const Params& p, char* lds, int mt, int h) {
    char* ws = p.ws;
    const int t = otid(), lane = t & 63, wv = t >> 6, r = lane & 31, hh = lane >> 5;
    const size_t tok = (size_t)mt * 128 + 32 * wv + r;
    const bf16_t* KEYS = (const bf16_t*)(ws + OFF_KEYS);
    const bf16_t* PQ = (const bf16_t*)(ws + OFF_PQ);
    unsigned tA[16], tB[16];
    peer_top16(KEYS + (size_t)(2 * h) * 16384, PQ + tok * 2048 + (2 * h) * 128, r, hh, tA);
    peer_top16(KEYS + (size_t)(2 * h + 1) * 16384, PQ + tok * 2048 + (2 * h + 1) * 128, r, hh, tB);
    float fA[16], fB[16];
#pragma unroll
    for (int i = 0; i < 16; ++i) { fA[i] = sort2f(tA[i] & ~0x7Fu); fB[i] = sort2f(tB[i] & ~0x7Fu); }
    unsigned* tab = (unsigned*)lds + wv * 1024;
    __syncthreads();
#pragma unroll
    for (int i = 0; i < 16; ++i) tab[i * 64 + lane] = (tA[i] & 0x7Fu) | ((tB[i] & 0x7Fu) << 16);
    unsigned c[64];
#pragma unroll
    for (int i = 0; i < 64; ++i) c[i] = 0u;
    {
        int n = 0;
#pragma unroll
        for (int a = 0; a < 16; ++a)
#pragma unroll
            for (int b = 0; b < 16; ++b)
                if ((a + 1) * (b + 1) <= 16) { c[n] = (f2sort(fA[a] + fB[b]) & ~0xFFu) | (unsigned)(a * 16 + b); ++n; }
    }
    unsigned g0[16], g1[16], g2[16], g3[16];
#pragma unroll
    for (int i = 0; i < 16; ++i) { g0[i] = c[i]; g1[i] = c[16 + i]; g2[i] = c[32 + i]; g3[i] = c[48 + i]; }
    BSort<0, 16>::run(g0); BSort<0, 16>::run(g1); BSort<0, 16>::run(g2); BSort<0, 16>::run(g3);
    merge_top16(g0, g1); merge_top16(g2, g3); merge_top16(g0, g2);
    float e[16]; float sum = 0.f;
    const float v0 = sort2f(g0[0] & ~0xFFu);
    unsigned ids[16];
#pragma unroll
    for (int i = 0; i < 16; ++i) {
        const float v = sort2f(g0[i] & ~0xFFu);
        e[i] = fast_exp2((v - v0) * LOG2E); sum += e[i];
        const unsigned a = (g0[i] >> 4) & 15u, b = g0[i] & 15u;
        const unsigned ia = tab[a * 64 + lane] & 0x7Fu, ib = (tab[b * 64 + lane] >> 16) & 0x7Fu;
        ids[i] = ia * 128u + ib;
    }
    const float inv = 1.0f / sum;
    if (hh == 0) {
        unsigned short* SID = (unsigned short*)(ws + OFF_SELID) + tok * 128 + h * 16;
        float* SG = (float*)(ws + OFF_SELG) + tok * 128 + h * 16;
        u32x4 w0, w1;
        w0[0] = ids[0] | (ids[1] << 16); w0[1] = ids[2] | (ids[3] << 16); w0[2] = ids[4] | (ids[5] << 16); w0[3] = ids[6] | (ids[7] << 16);
        w1[0] = ids[8] | (ids[9] << 16); w1[1] = ids[10] | (ids[11] << 16); w1[2] = ids[12] | (ids[13] << 16); w1[3] = ids[14] | (ids[15] << 16);
        *(u32x4*)SID = w0; *(u32x4*)(SID + 8) = w1;
#pragma unroll
        for (int q = 0; q < 4; ++q) *(f32x4*)(SG + 4 * q) = (f32x4){e[4 * q] * inv, e[4 * q + 1] * inv, e[4 * q + 2] * inv, e[4 * q + 3] * inv};
    }
}

DI void phase_select(const Params& p, char* lds) {
    for (int item = vbid(); item < 1024; item += vgrid()) peer_select_unit(p, lds, item >> 3, item & 7);
}

DI float gelu_erf(float a) { return 0.5f * a * (1.0f + erff(a * 0.70710678118654752f)); }
DI int dppi(int v, const int ctrl) { return v; }
#define DPP_I(v, ctrl) __builtin_amdgcn_update_dpp(0, (v), (ctrl), 0xf, 0xf, true)
DI float ub0(unsigned w) { return (float)(w & 0xFFu); }
DI float ub1(unsigned w) { return (float)((w >> 8) & 0xFFu); }
DI float ub2(unsigned w) { return (float)((w >> 16) & 0xFFu); }
DI float ub3(unsigned w) { return (float)(w >> 24); }

struct GBatch { u32x4 U[4], V[4]; float su[4], sv[4], gate[4]; };

DI void gather_load(GBatch& B, const char* __restrict__ ws, unsigned idpair, f32x2 gpair, int eb, int lane) {
#pragma unroll
    for (int j = 0; j < 4; ++j) {
        const int e = eb + j;
        const unsigned pr = __shfl(idpair, e >> 1);
        const unsigned id = (j & 1) ? (pr >> 16) : (pr & 0xFFFFu);
        const float g0 = __shfl(gpair[0], e >> 1), g1 = __shfl(gpair[1], e >> 1);
        B.gate[j] = (j & 1) ? g1 : g0;
        B.U[j] = ldu4(ws + OFF_UQ + (size_t)id * 1024 + 16 * lane);
        B.V[j] = ldu4(ws + OFF_VQ + (size_t)id * 1024 + 16 * lane);
        B.su[j] = ((const float*)(ws + OFF_SU))[id];
        B.sv[j] = ((const float*)(ws + OFF_SV))[id];
    }
}

DI void gather_compute(const GBatch& B, const unsigned (&qx)[4], float sx, float (&acc)[16], float& csum, int lane) {
    int pd[4];
#pragma unroll
    for (int j = 0; j < 4; ++j) {
        int d = 0;
#pragma unroll
        for (int q = 0; q < 4; ++q) d = __builtin_amdgcn_sdot4((int)B.U[j][q], (int)qx[q], d, false);
        pd[j] = d;
    }
    const bool b0 = lane & 1, b1 = lane & 2;
    const int kA = b0 ? pd[1] : pd[0], kB = b0 ? pd[3] : pd[2], sA = b0 ? pd[0] : pd[1], sB = b0 ? pd[2] : pd[3];
    const int qA = kA + DPP_I(sA, 0xB1), qB = kB + DPP_I(sB, 0xB1);
    const int kp = b1 ? qB : qA, sd = b1 ? qA : qB;
    int tot = kp + DPP_I(sd, 0x4E);
    tot += DPP_I(tot, 0x124);
    tot += DPP_I(tot, 0x128);
    tot += __builtin_amdgcn_ds_swizzle(tot, 0x401F);
    { auto rr = __builtin_amdgcn_permlane32_swap((unsigned)tot, (unsigned)tot, false, false); tot = (int)rr[0] + (int)rr[1]; }
    const int j3 = lane & 3;
    const float su_sel = (j3 == 0) ? B.su[0] : (j3 == 1 ? B.su[1] : (j3 == 2 ? B.su[2] : B.su[3]));
    const float ge = gelu_erf((float)tot * sx * su_sel);
#pragma unroll
    for (int j = 0; j < 4; ++j) {
        const float cf = B.gate[j] * B.sv[j] * __shfl(ge, j);
        csum += cf;
#pragma unroll
        for (int q = 0; q < 4; ++q) {
            const unsigned w = B.V[j][q];
            acc[4 * q] += cf * ub0(w); acc[4 * q + 1] += cf * ub1(w); acc[4 * q + 2] += cf * ub2(w); acc[4 * q + 3] += cf * ub3(w);
        }
    }
}

DI void gather_token(const Params& p, size_t tok, int lane, float* dst_base) {
    char* ws = p.ws;
    float* hrow = p.out + tok * 1024 + 16 * lane;
    float hv[16];
#pragma unroll
    for (int i = 0; i < 4; ++i) { const f32x4 a = *(const f32x4*)(hrow + 4 * i); hv[4 * i] = a[0]; hv[4 * i + 1] = a[1]; hv[4 * i + 2] = a[2]; hv[4 * i + 3] = a[3]; }
    float rs;
    {
        const float* SS = (const float*)(ws + OFF_SS2) + tok * 16;
        const f32x4 s0 = *(const f32x4*)SS, s1 = *(const f32x4*)(SS + 4), s2 = *(const f32x4*)(SS + 8), s3 = *(const f32x4*)(SS + 12);
        const float tot = (s0[0] + s0[1] + s0[2] + s0[3]) + (s1[0] + s1[1] + s1[2] + s1[3]) + (s2[0] + s2[1] + s2[2] + s2[3]) + (s3[0] + s3[1] + s3[2] + s3[3]);
        rs = rsqrtf(tot * (1.0f / 1024.0f) + 1e-6f);
    }
    float xf[16]; float am = 0.f;
#pragma unroll
    for (int i = 0; i < 4; ++i) {
        const f32x4 g = *(const f32x4*)(p.norm_ffn + 16 * lane + 4 * i);
#pragma unroll
        for (int e = 0; e < 4; ++e) { xf[4 * i + e] = hv[4 * i + e] * rs * g[e]; am = fmaxf(am, fabsf(xf[4 * i + e])); }
    }
#pragma unroll
    for (int o = 32; o; o >>= 1) am = fmaxf(am, __shfl_xor(am, o));
    const float sx = (am > 0.f) ? am * (1.0f / 127.0f) : 1.0f;
    const float isx = 1.0f / sx;
    unsigned qx[4];
#pragma unroll
    for (int i = 0; i < 4; ++i) {
        unsigned w = 0u;
#pragma unroll
        for (int e = 0; e < 4; ++e) w |= ((unsigned)(int)rintf(xf[4 * i + e] * isx) & 0xFFu) << (8 * e);
        qx[i] = w;
    }
    const unsigned idpair = *((const unsigned*)(ws + OFF_SELID) + tok * 64 + lane);
    const f32x2 gpair = *((const f32x2*)(ws + OFF_SELG) + tok * 64 + lane);
    float acc[16]; float csum = 0.f;
#pragma unroll
    for (int i = 0; i < 16; ++i) acc[i] = 0.f;
    GBatch B0, B1;
    gather_load(B0, ws, idpair, gpair, 0, lane);
#pragma unroll 1
    for (int eb = 0; eb < 128; eb += 8) {
        gather_load(B1, ws, idpair, gpair, eb + 4, lane);
        gather_compute(B0, qx, sx, acc, csum, lane);
        if (eb + 8 < 128) gather_load(B0, ws, idpair, gpair, eb + 8, lane);
        gather_compute(B1, qx, sx, acc, csum, lane);
    }
    float ss = 0.f;
#pragma unroll
    for (int i = 0; i < 16; ++i) { acc[i] = acc[i] - 128.0f * csum + hv[i]; ss += acc[i] * acc[i]; }
#pragma unroll
    for (int o = 32; o; o >>= 1) ss += __shfl_xor(ss, o);
    const float rf = rsqrtf(ss * (1.0f / 1024.0f) + 1e-6f);
    float* drow = dst_base + tok * 1024 + 16 * lane;
#pragma unroll
    for (int i = 0; i < 4; ++i) {
        const f32x4 n = *(const f32x4*)(p.norm_final + 16 * lane + 4 * i);
        *(f32x4*)(drow + 4 * i) = (f32x4){acc[4 * i] * rf * n[0], acc[4 * i + 1] * rf * n[1], acc[4 * i + 2] * rf * n[2], acc[4 * i + 3] * rf * n[3]};
    }
}

DI void phase_gather(const Params& p, bool dry = false) {
    const int lane = otid() & 63, wv = otid() >> 6;
    float* dst = dry ? (float*)(p.ws + OFF_PQ) : p.out;
    for (int item = vbid(); item < T_TOK / 4; item += vgrid()) gather_token(p, (size_t)item * 4 + wv, lane, dst);
}
constexpr int LDS_BYTES = 131072 + 1024;
constexpr int NPHASE = 12;
template <int PH> DI void run_phase(const Params& p, char* smem) {
    char* lds = smem + vhalf() * 65536;
    if (PH == 0) phase_prep(p, lds);
    else if (PH == 1) phase_p1(p, smem);
    else if (PH == 2) phase_p2(p, smem);
    else if (PH == 3) phase_p3(p, lds);
    else if (PH == 4) phase_p35(p, lds);
    else if (PH == 5) phase_resid(p, smem, OFF_WT_OUT, OFF_MIXED, p.x, OFF_SS1);
    else if (PH == 6) phase_rowscale(p, smem, OFF_WT_MQ, 1024, OFF_QM, OFF_SS1, 0.0625f * LOG2E);
    else if (PH == 7) phase_memattn(p, lds);
    else if (PH == 8) phase_resid(p, smem, OFF_WT_MO, OFF_OM, p.out, OFF_SS2);
    else if (PH == 9) phase_rowscale(p, smem, OFF_WT_PQ, 2048, OFF_PQ, OFF_SS2, 1.0f);
    else if (PH == 10) phase_select(p, lds);
    else if (PH == 11) phase_gather(p);
}

template <int PH> __global__ void __launch_bounds__(512, 2) k_phase(Params p) {
    __shared__ __attribute__((aligned(16))) char smem[LDS_BYTES];
    run_phase<PH>(p, smem);
}

static Params make_params(void* const* d_in, void* d_out, void* d_ws) {
    Params p;
    memset(&p, 0, sizeof(p));
    p.x = (const float*)d_in[0]; p.mem = (const float*)d_in[1]; p.norm_mix = (const float*)d_in[2]; p.w_in = (const float*)d_in[3];
    p.q_norm = (const float*)d_in[4]; p.kv_norm = (const float*)d_in[5]; p.w_uq = (const float*)d_in[6]; p.w_ukv = (const float*)d_in[7];
    p.gn_mla = (const float*)d_in[8]; p.gn_dil = (const float*)d_in[9]; p.w_out = (const float*)d_in[10]; p.norm_mem_q = (const float*)d_in[11];
    p.norm_mem_kv = (const float*)d_in[12]; p.w_mem_q = (const float*)d_in[13]; p.w_mem_kv = (const float*)d_in[14]; p.w_mem_o = (const float*)d_in[15];
    p.norm_ffn = (const float*)d_in[16]; p.peer_w_q = (const float*)d_in[17]; p.sub_keys = (const float*)d_in[18]; p.peer_u = (const float*)d_in[19];
    p.peer_v = (const float*)d_in[20]; p.norm_final = (const float*)d_in[21];
    p.out = (float*)d_out; p.ws = (char*)d_ws;
    for (int i = 0; i < 16; ++i) p.inv_freq[i] = 1.0f / powf(10000.0f, (float)(2 * i) / 32.0f);
    return p;
}
__global__ void __launch_bounds__(512, 2) k_mega(Params p) {
    __shared__ __attribute__((aligned(16))) char smem[LDS_BYTES + 16];
    volatile LAS unsigned* st = (volatile LAS unsigned*)(LAS char*)(smem + LDS_BYTES);
    if (threadIdx.x == 0) { st[0] = 0u; st[1] = 0u; st[2] = 0u; st[3] = 0u; }
    __syncthreads();
    const XcdBarrier xb = xcd_barrier_post((unsigned*)(p.ws + OFF_BAR), st);
#define RP(n) run_phase<n>(p, smem); xcd_barrier(xb);
    RP(0) RP(1) RP(2) RP(3) RP(4) RP(5) RP(6) RP(7) RP(8) RP(9) RP(10)
    run_phase<11>(p, smem);
}

extern "C" void kernel_launch(void* const* d_in, const int* in_sizes, int n_in, void* d_out, int out_size, void* d_ws, size_t ws_size,
                              hipStream_t stream) {
    static int grid_blocks = 0;
    if (!grid_blocks) {
        int dev = 0, cus = 0, per_cu = 0;
        (void)hipGetDevice(&dev);
        (void)hipDeviceGetAttribute(&cus, hipDeviceAttributeMultiprocessorCount, dev);
        (void)hipOccupancyMaxActiveBlocksPerMultiprocessor(&per_cu, k_mega, 512, 0);
        if (per_cu > 1) per_cu = 1;
        if (per_cu < 1) per_cu = 1;
        grid_blocks = cus * per_cu;
    }
    Params p = make_params(d_in, d_out, d_ws);
    (void)hipMemsetAsync((char*)d_ws + OFF_BAR, 0, XCD_BAR_WORDS * 4, stream);
    void* args[] = {&p};
    hipError_t e = hipLaunchCooperativeKernel((const void*)k_mega, dim3(grid_blocks), dim3(512), args, 0, stream);
    if (e != hipSuccess) fprintf(stderr, "cooperative launch failed: %s (grid %d)\n", hipGetErrorString(e), grid_blocks);
}
```

```cpp
#include <hip/hip_runtime.h>
#include <hip/hip_cooperative_groups.h>
#include <math.h>
#include <stdint.h>
#include <stdio.h>
#include <string.h>
#define DI __device__ __forceinline__
typedef unsigned short bf16_t;
typedef short bf16x8 __attribute__((ext_vector_type(8)));
typedef short s16x4 __attribute__((ext_vector_type(4)));
typedef float f32x16 __attribute__((ext_vector_type(16)));
typedef float f32x4 __attribute__((ext_vector_type(4)));
typedef float f32x2 __attribute__((ext_vector_type(2)));
typedef unsigned u32x4 __attribute__((ext_vector_type(4)));
typedef unsigned u32x2 __attribute__((ext_vector_type(2)));
typedef __bf16 bf16x2v __attribute__((ext_vector_type(2)));
#define LAS __attribute__((address_space(3)))
#define MFMA32(a, b, c) __builtin_amdgcn_mfma_f32_32x32x16_bf16((a), (b), (c), 0, 0, 0)

constexpr int T_TOK = 16384, SEQ_L = 4096, DM = 1024, INC = 2208;
constexpr float LOG2E = 1.4426950408889634f;

DI int otid() { int t = threadIdx.x & 255; asm volatile("" : "+v"(t)); return t; }
DI int vhalf() { return __builtin_amdgcn_readfirstlane((int)(threadIdx.x >> 8)); }
DI int vbid() { return (int)blockIdx.x * 2 + vhalf(); }
DI int vgrid() { return (int)gridDim.x * 2; }
DI unsigned pack2(float lo, float hi) { f32x2 f = {lo, hi}; return __builtin_bit_cast(unsigned, __builtin_convertvector(f, bf16x2v)); }
DI float bf_lo(unsigned u) { return __uint_as_float(u << 16); }
DI float bf_hi(unsigned u) { return __uint_as_float(u & 0xffff0000u); }
DI float bf2f(bf16_t v) { return __uint_as_float(((unsigned)v) << 16); }
DI int crow(int reg, int hh) { return (reg & 3) + 8 * (reg >> 2) + 4 * hh; }
DI f32x16 zero16() { f32x16 z;
#pragma unroll
    for (int i = 0; i < 16; ++i) z[i] = 0.f; return z; }
DI float xhalf_max(float v) { auto r = __builtin_amdgcn_permlane32_swap(__float_as_uint(v), __float_as_uint(v), false, false); return fmaxf(__uint_as_float(r[0]), __uint_as_float(r[1])); }
DI float xhalf_other(float v, int lane) { auto r = __builtin_amdgcn_permlane32_swap(__float_as_uint(v), __float_as_uint(v), false, false); return __uint_as_float((lane & 32) ? r[0] : r[1]); }
DI float xhalf_sum(float v) { auto r = __builtin_amdgcn_permlane32_swap(__float_as_uint(v), __float_as_uint(v), false, false); return __uint_as_float(r[0]) + __uint_as_float(r[1]); }
DI bf16x8 ld16(const void* p) { return *(const bf16x8*)p; }
DI u32x4 ldu4(const void* p) { return *(const u32x4*)p; }
DI float fast_exp2(float x) { return __builtin_amdgcn_exp2f(x); }
DI bf16x8 pack_step(const f32x16& x, int s) {
    u32x4 p;
    p[0] = pack2(x[8 * s + 0], x[8 * s + 1]); p[1] = pack2(x[8 * s + 2], x[8 * s + 3]);
    p[2] = pack2(x[8 * s + 4], x[8 * s + 5]); p[3] = pack2(x[8 * s + 6], x[8 * s + 7]);
    return __builtin_bit_cast(bf16x8, p);
}
DI s16x4 tr_read_a(unsigned lds_byte_addr) { s16x4 r; asm volatile("ds_read_b64_tr_b16 %0, %1" : "=v"(r) : "v"(lds_byte_addr)); return r; }
#define TR_WAIT() do { asm volatile("s_waitcnt lgkmcnt(0)" ::: "memory"); __builtin_amdgcn_sched_barrier(0); } while (0)
DI s16x4 tr_read(unsigned lds_byte_addr) {
    return __builtin_amdgcn_ds_read_tr16_b64_v4i16((LAS s16x4*)(uintptr_t)lds_byte_addr);
}

constexpr size_t MiB = 1ull << 20;
constexpr size_t OFF_BAR = 0;
constexpr size_t OFF_WT_IN = 65536;
constexpr size_t OFF_WT_UQ = OFF_WT_IN + 2304ull * 1024 * 2;
constexpr size_t OFF_WT_UKV = OFF_WT_UQ + 768ull * 384 * 2;
constexpr size_t OFF_WT_OUT = OFF_WT_UKV + 1024ull * 256 * 2;
constexpr size_t OFF_WT_MQ = OFF_WT_OUT + 1024ull * 1024 * 2;
constexpr size_t OFF_WT_MKV = OFF_WT_MQ + 1024ull * 1024 * 2;
constexpr size_t OFF_WT_MO = OFF_WT_MKV + 2048ull * 1024 * 2;
constexpr size_t OFF_WT_PQ = OFF_WT_MO + 1024ull * 1024 * 2;
constexpr size_t OFF_KEYS = OFF_WT_PQ + 2048ull * 1024 * 2;
constexpr size_t OFF_ROPE = OFF_KEYS + 16ull * 128 * 128 * 2;
constexpr size_t OFF_KR = OFF_ROPE + 2ull * 4096 * 16 * 4;
constexpr size_t OFF_LSE = OFF_KR + (size_t)T_TOK * 32 * 2;
constexpr size_t OFF_SS1 = OFF_LSE + 3ull * T_TOK * 8 * 4;
constexpr size_t OFF_SS2 = OFF_SS1 + (size_t)T_TOK * 16 * 4;
constexpr size_t OFF_MEMN = OFF_SS2 + (size_t)T_TOK * 16 * 4;
constexpr size_t OFF_SMALL_END = OFF_MEMN + 1024ull * 1024 * 2;
static_assert(OFF_SMALL_END <= 28 * MiB, "small region overflow");
constexpr size_t OFF_A = 28 * MiB;
constexpr size_t OFF_PROJ = OFF_A;
constexpr size_t OFF_UQ = OFF_A;
constexpr size_t OFF_VQ = OFF_A + 16 * MiB;
constexpr size_t OFF_SU = OFF_A + 32 * MiB;
constexpr size_t OFF_SV = OFF_SU + 65536;
constexpr size_t OFF_B = 97 * MiB;
constexpr size_t OFF_XN = OFF_B, OFF_QMLA = OFF_B, OFF_MIXED = OFF_B, OFF_QM = OFF_B;
constexpr size_t OFF_C = 129 * MiB;
constexpr size_t OFF_KVMLA = OFF_C, OFF_HB = OFF_C;
constexpr size_t OFF_D = 161 * MiB;
constexpr size_t OFF_ODIL = OFF_D, OFF_OMLA = OFF_D + 48 * MiB, OFF_OM = OFF_D, OFF_PQ = OFF_D;
constexpr size_t OFF_SELID = 225 * MiB;
constexpr size_t OFF_SELG = 229 * MiB;
constexpr size_t OFF_KVM = 237 * MiB;
constexpr size_t OFF_SSQ = 241 * MiB;
constexpr size_t WS_NEEDED = 243 * MiB;

struct Params {
    const float* x; const float* mem; const float* norm_mix; const float* w_in; const float* q_norm; const float* kv_norm;
    const float* w_uq; const float* w_ukv; const float* gn_mla; const float* gn_dil; const float* w_out; const float* norm_mem_q;
    const float* norm_mem_kv; const float* w_mem_q; const float* w_mem_kv; const float* w_mem_o; const float* norm_ffn;
    const float* peer_w_q; const float* sub_keys; const float* peer_u; const float* peer_v; const float* norm_final;
    float* out; char* ws;
    float inv_freq[16];
    int prof; int pad_;
};
#define XB_TMO      128
#define XB_XCNT(j)  (256  + 64 * (j))
#define XB_XSUB(j)  (1280 + 64 * (j))
#define XB_XGEN(j)  (2304 + 64 * (j))
#define XB_TOP      3328
#define XB_TOPGEN   3392
#define XCD_BAR_WORDS 3456
#define XB_SPIN_CAP (1u << 20)
DI unsigned xb_ld(unsigned* p) { return __hip_atomic_load(p, __ATOMIC_RELAXED, __HIP_MEMORY_SCOPE_AGENT); }
DI unsigned xb_add(unsigned* p, unsigned v) { return __hip_atomic_fetch_add(p, v, __ATOMIC_RELAXED, __HIP_MEMORY_SCOPE_AGENT); }
DI unsigned xb_xcc_id() { return (unsigned)__builtin_amdgcn_s_getreg((3 << 11) | 20) & 0xFu; }
#define XB_SPIN(cond, bar) do { unsigned _sp = 0; while (cond) { __builtin_amdgcn_s_sleep(1); \
    if ((++_sp & 255u) == 0u) { if (xb_ld(&(bar)[XB_TMO])) break; if (_sp > XB_SPIN_CAP) { atomicAdd(&(bar)[XB_TMO], 1u); break; } } } } while (0)
struct XcdBarrier { unsigned* bar; unsigned x; volatile LAS unsigned* st; };
DI XcdBarrier xcd_barrier_post(unsigned* bar, volatile LAS unsigned* st) {
    XcdBarrier b; b.bar = bar; b.x = xb_xcc_id(); b.st = st;
    if (threadIdx.x == 0) (void)xb_add(&bar[XB_XCNT(b.x)], 1u);
    return b;
}
DI void xcd_barrier_complete(unsigned* bar, unsigned x, unsigned& nloc, unsigned& nx) {
    const unsigned G = gridDim.x * gridDim.y * gridDim.z;
    unsigned sum, cnt, mine, sp = 0u;
    for (;;) {
        sum = 0u; cnt = 0u; mine = 0u;
#pragma unroll
        for (unsigned j = 0; j < 16; ++j) { const unsigned c = xb_ld(&bar[XB_XCNT(j)]); sum += c; cnt += (c > 0u) ? 1u : 0u; mine = (j == x) ? c : mine; }
        if (sum == G) break;
        __builtin_amdgcn_s_sleep(1);
        if ((++sp & 255u) == 0u) { if (xb_ld(&bar[XB_TMO])) break; if (sp > XB_SPIN_CAP) { atomicAdd(&bar[XB_TMO], 1u); break; } }
    }
    nloc = mine > 0u ? mine : 1u; nx = cnt > 0u ? cnt : 1u;
}
DI void xcd_barrier(const XcdBarrier& b) {
    asm volatile("s_waitcnt vmcnt(0)" ::: "memory");
    __syncthreads();
    if (threadIdx.x == 0) {
        unsigned* bar = b.bar;
        __builtin_amdgcn_s_waitcnt(0);
        unsigned nloc = b.st[0], nx = b.st[1];
        if (nloc == 0u) { xcd_barrier_complete(bar, b.x, nloc, nx); b.st[0] = nloc; b.st[1] = nx; }
        const unsigned old = xb_add(&bar[XB_XSUB(b.x)], 1u);
        const unsigned gen = old / nloc;
        if (old + 1u == (gen + 1u) * nloc) {
            __builtin_amdgcn_fence(__ATOMIC_RELEASE, "agent");
            asm volatile("s_waitcnt vmcnt(0)" ::: "memory");
            const unsigned og = xb_add(&bar[XB_TOP], 1u);
            const unsigned tg = og / nx;
            if (og + 1u == (tg + 1u) * nx) xb_add(&bar[XB_TOPGEN], 1u);
            else XB_SPIN(xb_ld(&bar[XB_TOPGEN]) == tg, bar);
            __builtin_amdgcn_fence(__ATOMIC_ACQUIRE, "agent");
            xb_add(&bar[XB_XGEN(b.x)], 1u);
            asm volatile("s_waitcnt vmcnt(0)" ::: "memory");
        } else {
            XB_SPIN(xb_ld(&bar[XB_XGEN(b.x)]) == gen, bar);
            __builtin_amdgcn_fence(__ATOMIC_ACQUIRE, "agent");
            asm volatile("s_waitcnt vmcnt(0)" ::: "memory");
        }
    }
    __syncthreads();
}
DI void transpose_tile(const float* __restrict__ W, int K, int N, const float* __restrict__ g, bf16_t* __restrict__ Wt, int kt, int nt, char* lds, bool valid) {
    float* sm = (float*)lds;
    const int t = otid();
    const int k0 = kt * 64, n0 = nt * 64;
    __syncthreads();
#pragma unroll
    for (int i = 0; i < 16; ++i) {
        const int id = t + 256 * i, k = id >> 6, n = id & 63;
        float v = 0.f;
        if (valid && n0 + n < N) { v = W[(size_t)(k0 + k) * N + n0 + n]; if (g) v *= g[k0 + k]; }
        sm[k * 65 + n] = v;
    }
    __syncthreads();
    const int n = t >> 2, kc = (t & 3) * 16;
    u32x4 o0, o1;
    o0[0] = pack2(sm[(kc + 0) * 65 + n], sm[(kc + 1) * 65 + n]); o0[1] = pack2(sm[(kc + 2) * 65 + n], sm[(kc + 3) * 65 + n]);
    o0[2] = pack2(sm[(kc + 4) * 65 + n], sm[(kc + 5) * 65 + n]); o0[3] = pack2(sm[(kc + 6) * 65 + n], sm[(kc + 7) * 65 + n]);
    o1[0] = pack2(sm[(kc + 8) * 65 + n], sm[(kc + 9) * 65 + n]); o1[1] = pack2(sm[(kc + 10) * 65 + n], sm[(kc + 11) * 65 + n]);
    o1[2] = pack2(sm[(kc + 12) * 65 + n], sm[(kc + 13) * 65 + n]); o1[3] = pack2(sm[(kc + 14) * 65 + n], sm[(kc + 15) * 65 + n]);
    bf16_t* dst = Wt + (size_t)(n0 + n) * K + k0 + kc;
    if (valid) { *(u32x4*)dst = o0; *(u32x4*)(dst + 8) = o1; }
}

DI void rmsnorm_row_bf16(const float* __restrict__ in, const float* __restrict__ g, bf16_t* __restrict__ out, int lane) {
    f32x4 v[4]; float ss = 0.f;
#pragma unroll
    for (int i = 0; i < 4; ++i) { v[i] = *(const f32x4*)(in + 4 * lane + 256 * i); ss += v[i][0] * v[i][0] + v[i][1] * v[i][1] + v[i][2] * v[i][2] + v[i][3] * v[i][3]; }
#pragma unroll
    for (int o = 32; o; o >>= 1) ss += __shfl_xor(ss, o);
    const float rs = rsqrtf(ss * (1.0f / 1024.0f) + 1e-6f);
#pragma unroll
    for (int i = 0; i < 4; ++i) {
        const f32x4 gg = *(const f32x4*)(g + 4 * lane + 256 * i);
        u32x2 o; o[0] = pack2(v[i][0] * rs * gg[0], v[i][1] * rs * gg[1]); o[1] = pack2(v[i][2] * rs * gg[2], v[i][3] * rs * gg[3]);
        *(u32x2*)(out + 4 * lane + 256 * i) = o;
    }
}

struct TrJob { const float* W; const float* g; size_t off; int K, N, Npad; };

DI void phase_prep(const Params& p, char* lds) {
    char* ws = p.ws;
    const int t = otid(), lane = t & 63, wv = t >> 6;
    const int c0 = 576, c1 = c0 + 72, c2 = c1 + 64, c3 = c2 + 256, c4 = c3 + 256, c5 = c4 + 512, c6 = c5 + 256, c7 = c6 + 512;
    const int nrow = (T_TOK + 1024) / 4;
    const int nkeys = 128, nrope = 256;
    const int total = c7 + nrow + nkeys + nrope;
    for (int k = 0; k < (c7 + vgrid() - 1) / vgrid(); ++k) {
        const int raw = vbid() + k * vgrid();
        const bool valid = raw < c7;
        const int item = valid ? raw : 0;
        const float* W; const float* g; size_t off; int K, N, Npad, local;
        if (item < c0)      { W = p.w_in;     g = nullptr;      off = OFF_WT_IN;  K = 1024; N = 2208; Npad = 2304; local = item; }
        else if (item < c1) { W = p.w_uq;     g = p.q_norm;     off = OFF_WT_UQ;  K = 384;  N = 768;  Npad = 768;  local = item - c0; }
        else if (item < c2) { W = p.w_ukv;    g = p.kv_norm;    off = OFF_WT_UKV; K = 256;  N = 1024; Npad = 1024; local = item - c1; }
        else if (item < c3) { W = p.w_out;    g = nullptr;      off = OFF_WT_OUT; K = 1024; N = 1024; Npad = 1024; local = item - c2; }
        else if (item < c4) { W = p.w_mem_q;  g = p.norm_mem_q; off = OFF_WT_MQ;  K = 1024; N = 1024; Npad = 1024; local = item - c3; }
        else if (item < c5) { W = p.w_mem_kv; g = nullptr;      off = OFF_WT_MKV; K = 1024; N = 2048; Npad = 2048; local = item - c4; }
        else if (item < c6) { W = p.w_mem_o;  g = nullptr;      off = OFF_WT_MO;  K = 1024; N = 1024; Npad = 1024; local = item - c5; }
        else                { W = p.peer_w_q; g = p.norm_ffn;   off = OFF_WT_PQ;  K = 1024; N = 2048; Npad = 2048; local = item - c6; }
        const int ntn = Npad / 64;
        transpose_tile(W, K, N, g, (bf16_t*)(ws + off), local / ntn, local % ntn, lds, valid);
    }
    for (int item = c7 + vbid(); item < total; item += vgrid()) {
        if (item < c7 + nrow) {
            const int row = (item - c7) * 4 + wv;
            if (row < T_TOK) rmsnorm_row_bf16(p.x + (size_t)row * 1024, p.norm_mix, (bf16_t*)(ws + OFF_XN) + (size_t)row * 1024, lane);
            else rmsnorm_row_bf16(p.mem + (size_t)(row - T_TOK) * 1024, p.norm_mem_kv, (bf16_t*)(ws + OFF_MEMN) + (size_t)(row - T_TOK) * 1024, lane);
        } else if (item < c7 + nrow + nkeys) {
            const int idx = ((item - c7 - nrow) * 256 + t) * 8;
            const f32x4 a = *(const f32x4*)(p.sub_keys + idx), b = *(const f32x4*)(p.sub_keys + idx + 4);
            u32x4 o; o[0] = pack2(a[0], a[1]); o[1] = pack2(a[2], a[3]); o[2] = pack2(b[0], b[1]); o[3] = pack2(b[2], b[3]);
            *(u32x4*)((bf16_t*)(ws + OFF_KEYS) + idx) = o;
        } else {
            const int idx = (item - c7 - nrow - nkeys) * 256 + t;
            const int s = idx >> 4, i = idx & 15;
            const float ang = (float)s * p.inv_freq[i];
            const double a = (double)ang;
            const double twopi = 6.283185307179586476925;
            const float rf = (float)(a - twopi * rint(a / twopi));
            float* cs = (float*)(ws + OFF_ROPE);
            cs[idx] = cosf(rf); cs[65536 + idx] = sinf(rf);
        }
    }
}
namespace pg8 {
#define PG8_LAS __attribute__((address_space(3)))
typedef unsigned short bf16_t;
typedef short bf16x8 __attribute__((ext_vector_type(8)));
typedef float f32x4 __attribute__((ext_vector_type(4)));
typedef unsigned u32x4 __attribute__((ext_vector_type(4)));
constexpr int BM = 256, BK = 64, HALF = 128, HTB = HALF * BK * 2  , STAGE_BYTES = 8 * HTB, NXCD = 8, WGM = 8;

__host__ __device__ __forceinline__ int lds_byte(int r, int c) { const int st = (r >> 4) * 2 + (c >> 5), rr = r & 15, cc = c & 31, ob = rr * 64 + cc * 2; return st * 1024 + (ob ^ (((ob >> 9) & 1) << 5)); }
__host__ __device__ __forceinline__ void stage_rc(int b, int& R, int& C) { const int st = b / 1024, sb = b % 1024, swz = sb ^ (((sb >> 9) & 1) << 5); R = (st >> 1) * 16 + swz / 64; C = (st & 1) * 32 + (swz % 64) / 2; }
__host__ __device__ __forceinline__ int perm32(int rho) { const int n = rho >> 4, i = rho & 15; return 8 * (i >> 2) + 4 * n + (i & 3); }

struct Unit { int pm, pn; };
struct Gemm { const bf16_t* A; const bf16_t* Bt; int M, N, K, lda; };

struct StaticOrder {
    int nM, nN, nwg, G, c;
    __host__ __device__ void init(int M, int N, int G_, int c_) { nM = M / BM; nN = N / BM; nwg = nM * nN; G = G_; c = c_; }
    __host__ __device__ bool next(int i, Unit& u) const {
        const long L = (long)i * G + c; if (L >= nwg) return false;
        int wgid = (int)L; { const int q = nwg / NXCD, r = nwg % NXCD, xcd = wgid % NXCD, off = wgid / NXCD; wgid = (xcd < r ? xcd * (q + 1) : r * (q + 1) + (xcd - r) * q) + off; }
        const int nig = WGM * nN, gid = wgid / nig, fm = gid * WGM, gsz = (nM - fm) < WGM ? (nM - fm) : WGM;
        u.pm = fm + ((wgid % nig) % gsz); u.pn = (wgid % nig) / gsz; return true;
    }
    __device__ __forceinline__ void a_ready(const Unit&) const {}
    __device__ __forceinline__ void done(const Unit&) const {}
};

template <class Epi, class Sched, bool ALIGN_EPI = false, bool SP2 = false>
__device__ __forceinline__ void gemm_phase(PG8_LAS unsigned char* lds, const Gemm g, const Sched& S, const Epi& E) {
    int tid_ = threadIdx.x; asm volatile("" : "+v"(tid_));
    const int tid = tid_, wid = __builtin_amdgcn_readfirstlane(tid >> 6), lane = tid & 63, wr = wid >> 2, wc = wid & 3, fr = lane & 15, fq = lane >> 4;
    const int K = g.K, nt = K / BK, lda = g.lda;
    unsigned voffA[2], voffB[2];
#pragma unroll
    for (int i = 0; i < 2; ++i) { int R, C; stage_rc(tid * 16 + i * 8192, R, C); const int Rb = Epi::PERM ? ((R & ~31) + perm32(R & 31)) : R;
        voffA[i] = (unsigned)(R * lda + C) * 2u; voffB[i] = (unsigned)(Rb * K + C) * 2u; }
    const size_t kstep = (size_t)(BK * 2);
    const size_t hstepB = (size_t)HALF * K * 2, hstepA = (size_t)HALF * lda * 2;
    const size_t tstepB = 2 * hstepB, tstepA = 2 * hstepA;
    const unsigned ldsw = (unsigned)wid * 1024u;
    const int aoff = lds_byte(wr * 64 + fr, fq * 8), boff = lds_byte(wc * 32 + fr, fq * 8);
#define PG8_SA(b, h) (((b) * 2 + (h)) * HTB)
#define PG8_SB(b, h) ((4 + (b) * 2 + (h)) * HTB)
#define PG8_STAGE(bufoff, gbase, voff) do { _Pragma("unroll") for (int _i = 0; _i < 2; ++_i) \
        __builtin_amdgcn_global_load_lds((const unsigned*)((const char*)(gbase) + (voff)[_i]), (PG8_LAS unsigned*)(lds + (bufoff) + ldsw + _i * 8192), 16, 0, 0); } while (0)
#define PG8_LDA(dst, b, h) do { _Pragma("unroll") for (int m = 0; m < 4; ++m) _Pragma("unroll") for (int k = 0; k < 2; ++k) dst[m][k] = *(const PG8_LAS bf16x8*)(lds + PG8_SA(b, h) + aoff + m * 2048 + k * 1024); } while (0)
#define PG8_LDB(dst, b, h) do { _Pragma("unroll") for (int n = 0; n < 2; ++n) _Pragma("unroll") for (int k = 0; k < 2; ++k) dst[n][k] = *(const PG8_LAS bf16x8*)(lds + PG8_SB(b, h) + boff + n * 2048 + k * 1024); } while (0)
#define PG8_MMA(ai, bj, At, Bt) do { __builtin_amdgcn_s_setprio(1); _Pragma("unroll") for (int m = 0; m < 4; ++m) _Pragma("unroll") for (int n = 0; n < 2; ++n) _Pragma("unroll") for (int k = 0; k < 2; ++k) \
        acc[ai][bj][m][n] = __builtin_amdgcn_mfma_f32_16x16x32_bf16(Bt[n][k], At[m][k], acc[ai][bj][m][n], 0, 0, 0); __builtin_amdgcn_s_setprio(0); } while (0)
#define PG8_WAIT_V(n) asm volatile("s_waitcnt vmcnt(" #n ")" ::: "memory")
#define PG8_WAIT_L(n) asm volatile("s_waitcnt lgkmcnt(" #n ")" ::: "memory")
#define PG8_BAR __builtin_amdgcn_s_barrier()
#define PG8_SCHED __builtin_amdgcn_sched_barrier(0)
    Unit cur, nxt; int ui = 0;
    if (!S.next(0, cur)) return;
    f32x4 acc[2][2][4][2];
#pragma unroll
    for (int a = 0; a < 2; ++a)
#pragma unroll
        for (int b = 0; b < 2; ++b)
#pragma unroll
            for (int m = 0; m < 4; ++m)
#pragma unroll
                for (int n = 0; n < 2; ++n) acc[a][b][m][n] = (f32x4){0.f, 0.f, 0.f, 0.f};
    bf16x8 At[4][2], B0[2][2], B1[2][2];
    const char* cA = (const char*)g.A + (size_t)cur.pm * tstepA; const char* cB = (const char*)g.Bt + (size_t)cur.pn * tstepB;
    S.a_ready(cur);
    if constexpr (SP2) {
        PG8_STAGE(PG8_SB(0, 0), cB, voffB); PG8_STAGE(PG8_SB(0, 1), cB + hstepB, voffB); PG8_STAGE(PG8_SA(0, 0), cA, voffA); PG8_STAGE(PG8_SA(0, 1), cA + hstepA, voffA);
        if (wr == 1) PG8_BAR;
        PG8_WAIT_V(2); PG8_BAR;
        PG8_STAGE(PG8_SB(1, 0), cB + kstep, voffB); PG8_STAGE(PG8_SA(1, 0), cA + kstep, voffA); PG8_STAGE(PG8_SB(1, 1), cB + hstepB + kstep, voffB);
        PG8_WAIT_V(6); PG8_BAR;
    } else {
        PG8_STAGE(PG8_SB(0, 0), cB, voffB); PG8_STAGE(PG8_SA(0, 0), cA, voffA); PG8_STAGE(PG8_SB(0, 1), cB + hstepB, voffB); PG8_STAGE(PG8_SA(0, 1), cA + hstepA, voffA);
        if (wr == 1) PG8_BAR;
        PG8_WAIT_V(4); PG8_BAR;
        PG8_STAGE(PG8_SB(1, 0), cB + kstep, voffB); PG8_STAGE(PG8_SA(1, 0), cA + kstep, voffA); PG8_STAGE(PG8_SB(1, 1), cB + hstepB + kstep, voffB);
        PG8_WAIT_V(6); PG8_BAR;
    }
    for (;;) {
        const bool has_next = S.next(ui + 1, nxt);
        const char* nA = has_next ? (const char*)g.A + (size_t)nxt.pm * tstepA : cA; const char* nB = has_next ? (const char*)g.Bt + (size_t)nxt.pn * tstepB : cB;
#pragma unroll 1
        for (int t = 0; t < nt; t += 2) {
            const bool last = (t == nt - 2);
            const char* a1 = cA + (size_t)(t + 1) * kstep;
            const char* a2 = last ? nA : cA + (size_t)(t + 2) * kstep; const char* b2 = last ? nB : cB + (size_t)(t + 2) * kstep;
            const char* a3 = a2 + kstep; const char* b3 = b2 + kstep;
            if (last && has_next) S.a_ready(nxt);
            if constexpr (SP2) {
            PG8_LDB(B0, 0, 0); PG8_LDB(B1, 0, 1); PG8_SCHED; PG8_LDA(At, 0, 0); PG8_STAGE(PG8_SA(1, 1), a1 + hstepA, voffA);
            PG8_WAIT_V(8); PG8_WAIT_L(0); PG8_BAR; PG8_MMA(0, 0, At, B0); PG8_MMA(0, 1, At, B1); PG8_BAR; PG8_SCHED;
            PG8_LDA(At, 0, 1); PG8_STAGE(PG8_SB(0, 0), b2, voffB); PG8_STAGE(PG8_SB(0, 1), b2 + hstepB, voffB); PG8_STAGE(PG8_SA(0, 0), a2, voffA);
            PG8_WAIT_V(8); PG8_WAIT_L(0); PG8_BAR; PG8_MMA(1, 0, At, B0); PG8_MMA(1, 1, At, B1); PG8_BAR; PG8_SCHED;
            PG8_LDB(B0, 1, 0); PG8_LDB(B1, 1, 1); PG8_SCHED; PG8_LDA(At, 1, 0); PG8_STAGE(PG8_SA(0, 1), a2 + hstepA, voffA);
            PG8_WAIT_V(8); PG8_WAIT_L(0); PG8_BAR; PG8_MMA(0, 0, At, B0); PG8_MMA(0, 1, At, B1); PG8_BAR; PG8_SCHED;
            PG8_LDA(At, 1, 1); PG8_STAGE(PG8_SB(1, 0), b3, voffB); PG8_STAGE(PG8_SB(1, 1), b3 + hstepB, voffB); PG8_STAGE(PG8_SA(1, 0), a3, voffA);
            PG8_WAIT_V(8); PG8_WAIT_L(0); PG8_BAR; PG8_MMA(1, 0, At, B0); PG8_MMA(1, 1, At, B1); PG8_BAR; PG8_SCHED;
            } else {
            PG8_LDB(B0, 0, 0); PG8_SCHED; PG8_LDA(At, 0, 0); PG8_STAGE(PG8_SA(1, 1), a1 + hstepA, voffA);
            PG8_WAIT_L(8); PG8_BAR; PG8_WAIT_L(0); PG8_MMA(0, 0, At, B0); PG8_BAR; PG8_SCHED;
            PG8_LDB(B1, 0, 1); PG8_STAGE(PG8_SB(0, 0), b2, voffB);
            PG8_BAR; PG8_WAIT_L(0); PG8_MMA(0, 1, At, B1); PG8_BAR;
            PG8_LDA(At, 0, 1); PG8_STAGE(PG8_SA(0, 0), a2, voffA);
            PG8_BAR; PG8_WAIT_L(0); PG8_MMA(1, 0, At, B0); PG8_BAR; PG8_SCHED;
            PG8_STAGE(PG8_SB(0, 1), b2 + hstepB, voffB);
            PG8_WAIT_V(6); PG8_BAR; PG8_MMA(1, 1, At, B1); PG8_BAR;
            PG8_LDB(B0, 1, 0); PG8_SCHED; PG8_LDA(At, 1, 0); PG8_STAGE(PG8_SA(0, 1), a2 + hstepA, voffA);
            PG8_WAIT_L(8); PG8_BAR; PG8_WAIT_L(0); PG8_MMA(0, 0, At, B0); PG8_BAR; PG8_SCHED;
            PG8_LDB(B1, 1, 1); PG8_STAGE(PG8_SB(1, 0), b3, voffB);
            PG8_BAR; PG8_WAIT_L(0); PG8_MMA(0, 1, At, B1); PG8_BAR;
            PG8_LDA(At, 1, 1); PG8_STAGE(PG8_SA(1, 0), a3, voffA);
            PG8_BAR; PG8_WAIT_L(0); PG8_MMA(1, 0, At, B0); PG8_BAR; PG8_SCHED;
            PG8_STAGE(PG8_SB(1, 1), b3 + hstepB, voffB);
            PG8_WAIT_V(6); PG8_BAR; PG8_MMA(1, 1, At, B1); PG8_BAR;
            }
        }
        if constexpr (ALIGN_EPI) { if (wr == 0) PG8_BAR; }
        if constexpr (!Epi::AFTER_DRAIN) { E(acc, cur, wr, wc, fr, fq); S.done(cur); }
        if (!has_next) break;
#pragma unroll
        for (int a = 0; a < 2; ++a)
#pragma unroll
            for (int b = 0; b < 2; ++b)
#pragma unroll
                for (int m = 0; m < 4; ++m)
#pragma unroll
                    for (int n = 0; n < 2; ++n) acc[a][b][m][n] = (f32x4){0.f, 0.f, 0.f, 0.f};
        cur = nxt; cA = nA; cB = nB; ++ui;
        if constexpr (ALIGN_EPI) { if (wr == 1) PG8_BAR; }
    }
    PG8_WAIT_V(0);
    if constexpr (!ALIGN_EPI) { if (wr == 0) PG8_BAR; }
    PG8_BAR;
    if constexpr (Epi::AFTER_DRAIN) { E.fused(acc, cur, wr, wc, fr, fq, lds, wid, lane); S.done(cur); }
#undef PG8_SA
#undef PG8_SB
#undef PG8_STAGE
#undef PG8_LDA
#undef PG8_LDB
#undef PG8_MMA
#undef PG8_WAIT_V
#undef PG8_WAIT_L
#undef PG8_BAR
#undef PG8_SCHED
}
}
DI unsigned sw_off(int row, int chunk) { return (unsigned)(row * 128 + ((chunk ^ ((row >> 1) & 7)) << 4)); }
#define GLDS16(gsrc, ldst) __builtin_amdgcn_global_load_lds((const unsigned*)(gsrc), (unsigned*)(ldst), 16, 0, 0)
DI u32x2 pack4(float a, float b, float c, float d) { u32x2 o; o[0] = pack2(a, b); o[1] = pack2(c, d); return o; }
#define EPI_ARGS const f32x4 (&acc)[2][2][4][2], const pg8::Unit& u, int wr, int wc, int fr, int fq
DI float xq_sum(float v) {
    v += __uint_as_float((unsigned)__builtin_amdgcn_ds_swizzle((int)__float_as_uint(v), 0x401F));
    return xhalf_sum(v);
}
DI u32x4 pack8(const float (&v)[8], float sc) {
    u32x4 o; o[0] = pack2(v[0] * sc, v[1] * sc); o[1] = pack2(v[2] * sc, v[3] * sc); o[2] = pack2(v[4] * sc, v[5] * sc); o[3] = pack2(v[6] * sc, v[7] * sc); return o;
}
DI void rope8(const float (&v)[8], float sc, const float* __restrict__ cs, int pos, int fq, int lane, bf16_t* dst32  ) {
    const int i0 = 8 * (fq & 1);
    const f32x4 c0 = *(const f32x4*)(cs + pos * 16 + i0), c1 = *(const f32x4*)(cs + pos * 16 + i0 + 4);
    const f32x4 s0 = *(const f32x4*)(cs + 65536 + pos * 16 + i0), s1 = *(const f32x4*)(cs + 65536 + pos * 16 + i0 + 4);
    const float sg = (fq < 2) ? -1.0f : 1.0f;
    float o[8];
#pragma unroll
    for (int e = 0; e < 8; ++e) {
        const float own = v[e] * sc, oth = xhalf_other(own, lane);
        const float c = (e < 4) ? c0[e & 3] : c1[e & 3], s = (e < 4) ? s0[e & 3] : s1[e & 3];
        o[e] = own * c + sg * oth * s;
    }
    *(u32x4*)(dst32 + 8 * fq) = pack8(o, 1.0f);
}
#define EPI_LOAD8(v, ai, bj, m) float v[8]; { const f32x4 x0_ = acc[ai][bj][m][0], x1_ = acc[ai][bj][m][1]; v[0] = x0_[0]; v[1] = x0_[1]; v[2] = x0_[2]; v[3] = x0_[3]; v[4] = x1_[0]; v[5] = x1_[1]; v[6] = x1_[2]; v[7] = x1_[3]; }

struct EpiPlain8 {
    static constexpr bool PERM = true, AFTER_DRAIN = false;
    bf16_t* out; int ld;
    DI void operator()(EPI_ARGS) const {
#pragma unroll
        for (int ai = 0; ai < 2; ++ai)
#pragma unroll
            for (int m = 0; m < 4; ++m) {
                int fr_ = fr; asm volatile("" : "+v"(fr_));
                const size_t tok = (size_t)u.pm * 256 + ai * 128 + wr * 64 + m * 16 + fr_;
#pragma unroll
                for (int bj = 0; bj < 2; ++bj) { EPI_LOAD8(v, ai, bj, m); *(u32x4*)(out + tok * ld + u.pn * 256 + bj * 128 + wc * 32 + 8 * fq) = pack8(v, 1.0f); }
            }
    }
};

struct EpiProj8 {
    static constexpr bool PERM = true, AFTER_DRAIN = false;
    bf16_t* proj; bf16_t* kr; const float* cs; float* ssq;
    DI void operator()(EPI_ARGS) const {
        const int lane = fr + 16 * fq;
#pragma unroll
        for (int bj = 0; bj < 2; ++bj) {
            const int cg = u.pn * 256 + bj * 128 + wc * 32;
            if (cg >= INC) continue;
            const int g32 = cg >> 5;
            const float sc = (cg >= 672 && cg < 1184) ? 0.125f * LOG2E : 1.0f;
#pragma unroll
            for (int ai = 0; ai < 2; ++ai)
#pragma unroll
                for (int m = 0; m < 4; ++m) {
                    int fr_ = fr; asm volatile("" : "+v"(fr_));
                const size_t tok = (size_t)u.pm * 256 + ai * 128 + wr * 64 + m * 16 + fr_;
                    EPI_LOAD8(v, ai, bj, m);
                    if (g32 < 20) {
                        float ss = 0.f;
#pragma unroll
                        for (int e = 0; e < 8; ++e) ss += v[e] * v[e];
                        ss = xq_sum(ss);
                        if (fq == 0) ssq[tok * 24 + g32] = ss;
                    }
                    if (cg == 640) rope8(v, 1.0f, cs, (int)(tok & (SEQ_L - 1)), fq, lane, kr + tok * 32);
                    else *(u32x4*)(proj + tok * INC + cg + 8 * fq) = pack8(v, sc);
                }
        }
    }
};

struct EpiUpQ8 {
    static constexpr bool PERM = true, AFTER_DRAIN = false;
    bf16_t* q; const float* cs; const float* ssq;
    DI void operator()(EPI_ARGS) const {
        const int lane = fr + 16 * fq;
        const float qs = 0.10206207261596575f * LOG2E;
#pragma unroll
        for (int ai = 0; ai < 2; ++ai)
#pragma unroll
            for (int m = 0; m < 4; ++m) {
                int fr_ = fr; asm volatile("" : "+v"(fr_));
                const size_t tok = (size_t)u.pm * 256 + ai * 128 + wr * 64 + m * 16 + fr_;
                const f32x4 a0 = *(const f32x4*)(ssq + tok * 24), a1 = *(const f32x4*)(ssq + tok * 24 + 4), a2 = *(const f32x4*)(ssq + tok * 24 + 8);
                const float tot = (a0[0] + a0[1] + a0[2] + a0[3]) + (a1[0] + a1[1] + a1[2] + a1[3]) + (a2[0] + a2[1] + a2[2] + a2[3]);
                const float sc = rsqrtf(tot * (1.0f / 384.0f) + 1e-6f) * qs;
#pragma unroll
                for (int bj = 0; bj < 2; ++bj) {
                    const int cg = u.pn * 256 + bj * 128 + wc * 32;
                    EPI_LOAD8(v, ai, bj, m);
                    if ((cg % 96) == 64) rope8(v, sc, cs, (int)(tok & (SEQ_L - 1)), fq, lane, q + tok * 768 + cg);
                    else *(u32x4*)(q + tok * 768 + cg + 8 * fq) = pack8(v, sc);
                }
            }
    }
};

struct EpiUpKV8 {
    static constexpr bool PERM = true, AFTER_DRAIN = false;
    bf16_t* kv; const float* ssq;
    DI void operator()(EPI_ARGS) const {
#pragma unroll
        for (int ai = 0; ai < 2; ++ai)
#pragma unroll
            for (int m = 0; m < 4; ++m) {
                int fr_ = fr; asm volatile("" : "+v"(fr_));
                const size_t tok = (size_t)u.pm * 256 + ai * 128 + wr * 64 + m * 16 + fr_;
                const f32x4 a0 = *(const f32x4*)(ssq + tok * 24 + 12), a1 = *(const f32x4*)(ssq + tok * 24 + 16);
                const float tot = (a0[0] + a0[1] + a0[2] + a0[3]) + (a1[0] + a1[1] + a1[2] + a1[3]);
                const float sc = rsqrtf(tot * (1.0f / 256.0f) + 1e-6f);
#pragma unroll
                for (int bj = 0; bj < 2; ++bj) { EPI_LOAD8(v, ai, bj, m); *(u32x4*)(kv + tok * 1024 + u.pn * 256 + bj * 128 + wc * 32 + 8 * fq) = pack8(v, sc); }
            }
    }
};

struct EpiResid8 {
    static constexpr bool PERM = true, AFTER_DRAIN = false;
    const float* R; float* H; bf16_t* HB; float* SS;
    DI void operator()(EPI_ARGS) const {
#pragma unroll
        for (int ai = 0; ai < 2; ++ai) {
            f32x4 rv[4][2][2];
#pragma unroll
            for (int m = 0; m < 4; ++m)
#pragma unroll
                for (int bj = 0; bj < 2; ++bj) {
                    const size_t off = ((size_t)u.pm * 256 + ai * 128 + wr * 64 + m * 16 + fr) * 1024 + u.pn * 256 + bj * 128 + wc * 32 + 8 * fq;
                    rv[m][bj][0] = *(const f32x4*)(R + off); rv[m][bj][1] = *(const f32x4*)(R + off + 4);
                }
#pragma unroll
            for (int m = 0; m < 4; ++m) {
                int fr_ = fr; asm volatile("" : "+v"(fr_));
                const size_t tok = (size_t)u.pm * 256 + ai * 128 + wr * 64 + m * 16 + fr_;
                float ss = 0.f;
#pragma unroll
                for (int bj = 0; bj < 2; ++bj) {
                    const size_t off = tok * 1024 + u.pn * 256 + bj * 128 + wc * 32 + 8 * fq;
                    const f32x4 h0 = rv[m][bj][0] + acc[ai][bj][m][0], h1 = rv[m][bj][1] + acc[ai][bj][m][1];
                    ss += (h0[0] * h0[0] + h0[1] * h0[1]) + (h0[2] * h0[2] + h0[3] * h0[3]) + (h1[0] * h1[0] + h1[1] * h1[1]) + (h1[2] * h1[2] + h1[3] * h1[3]);
                    *(f32x4*)(H + off) = h0; *(f32x4*)(H + off + 4) = h1;
                    u32x4 o; o[0] = pack2(h0[0], h0[1]); o[1] = pack2(h0[2], h0[3]); o[2] = pack2(h1[0], h1[1]); o[3] = pack2(h1[2], h1[3]);
                    *(u32x4*)(HB + off) = o;
                }
                ss = xq_sum(ss);
                if (fq == 0) SS[tok * 16 + 4 * u.pn + wc] = ss;
            }
        }
    }
};

struct EpiRowScale8 {
    static constexpr bool PERM = true, AFTER_DRAIN = false;
    bf16_t* out; int ld; const float* SS; float extra;
    DI void operator()(EPI_ARGS) const {
#pragma unroll
        for (int ai = 0; ai < 2; ++ai)
#pragma unroll
            for (int m = 0; m < 4; ++m) {
                int fr_ = fr; asm volatile("" : "+v"(fr_));
                const size_t tok = (size_t)u.pm * 256 + ai * 128 + wr * 64 + m * 16 + fr_;
                const f32x4 s0 = *(const f32x4*)(SS + tok * 16), s1 = *(const f32x4*)(SS + tok * 16 + 4), s2 = *(const f32x4*)(SS + tok * 16 + 8), s3 = *(const f32x4*)(SS + tok * 16 + 12);
                const float tot = (s0[0] + s0[1] + s0[2] + s0[3]) + (s1[0] + s1[1] + s1[2] + s1[3]) + (s2[0] + s2[1] + s2[2] + s2[3]) + (s3[0] + s3[1] + s3[2] + s3[3]);
                const float sc = rsqrtf(tot * (1.0f / 1024.0f) + 1e-6f) * extra;
#pragma unroll
                for (int bj = 0; bj < 2; ++bj) { EPI_LOAD8(v, ai, bj, m); *(u32x4*)(out + tok * ld + u.pn * 256 + bj * 128 + wc * 32 + 8 * fq) = pack8(v, sc); }
            }
    }
};

template <class Epi>
DI void gemm8(char* smem, const bf16_t* A, int lda, const bf16_t* Bt, int M, int N, int K, const Epi& e) {
    pg8::Gemm g; g.A = A; g.Bt = Bt; g.M = M; g.N = N; g.K = K; g.lda = lda;
    pg8::StaticOrder S; S.init(M, N, (int)gridDim.x, (int)blockIdx.x);
    pg8::gemm_phase<Epi, pg8::StaticOrder, true, true>((PG8_LAS unsigned char*)smem, g, S, e);
}

DI void phase_p1(const Params& p, char* smem) {
    char* ws = p.ws;
    { EpiProj8 e{(bf16_t*)(ws + OFF_PROJ), (bf16_t*)(ws + OFF_KR), (const float*)(ws + OFF_ROPE), (float*)(ws + OFF_SSQ)};
      gemm8(smem, (const bf16_t*)(ws + OFF_XN), 1024, (const bf16_t*)(ws + OFF_WT_IN), T_TOK, 2304, 1024, e); }
    { EpiPlain8 e{(bf16_t*)(ws + OFF_KVM), 2048};
      gemm8(smem, (const bf16_t*)(ws + OFF_MEMN), 1024, (const bf16_t*)(ws + OFF_WT_MKV), 1024, 2048, 1024, e); }
}
DI void phase_p2(const Params& p, char* smem) {
    char* ws = p.ws;
    { EpiUpQ8 e{(bf16_t*)(ws + OFF_QMLA), (const float*)(ws + OFF_ROPE), (const float*)(ws + OFF_SSQ)};
      gemm8(smem, (const bf16_t*)(ws + OFF_PROJ), INC, (const bf16_t*)(ws + OFF_WT_UQ), T_TOK, 768, 384, e); }
    { EpiUpKV8 e{(bf16_t*)(ws + OFF_KVMLA), (const float*)(ws + OFF_SSQ)};
      gemm8(smem, (const bf16_t*)(ws + OFF_PROJ) + 384, INC, (const bf16_t*)(ws + OFF_WT_UKV), T_TOK, 1024, 256, e); }
}
DI void phase_resid(const Params& p, char* smem, size_t off_w, size_t off_a, const float* R, size_t off_ss, bool dry = false) {
    char* ws = p.ws;
    EpiResid8 e{R, p.out, (bf16_t*)(ws + OFF_HB), (float*)(ws + off_ss)};
    if (dry) { e.H = (float*)(ws + OFF_PQ); e.HB = (bf16_t*)(ws + OFF_B); e.SS = (float*)(ws + OFF_SS1); }
    gemm8(smem, (const bf16_t*)(ws + off_a), 1024, (const bf16_t*)(ws + off_w), T_TOK, 1024, 1024, e);
}
DI void phase_rowscale(const Params& p, char* smem, size_t off_w, int N, size_t off_out, size_t off_ss, float extra) {
    char* ws = p.ws;
    EpiRowScale8 e{(bf16_t*)(ws + off_out), N, (const float*)(ws + off_ss), extra};
    gemm8(smem, (const bf16_t*)(ws + OFF_HB), 1024, (const bf16_t*)(ws + off_w), T_TOK, N, 1024, e);
}
DI unsigned v128_off(int row, int chunk) { return (unsigned)(row * 128 + ((chunk ^ (((row >> 1) & 1) << 2)) << 4)); }
DI unsigned v128_tr_addr(unsigned base, int R0, int c, int lane) {
    const int blk = (lane >> 4) & 1, qq = (lane & 15) >> 2, pp = lane & 3;
    return base + v128_off(R0 + qq, 4 * c + 2 * blk + (pp >> 1)) + 8 * (pp & 1);
}
DI bf16x8 cat44(s16x4 lo, s16x4 hi) { return __builtin_shufflevector(lo, hi, 0, 1, 2, 3, 4, 5, 6, 7); }

constexpr int MLA_STAGE = 64 * 192 + 64 * 128;
DI unsigned k192_off(int row, int chunk) { return (unsigned)(row * 192 + (((chunk & ~3) | ((chunk & 3) ^ ((row >> 2) & 3))) << 4)); }
DI void mla_unit(const Params& p, char* lds, int b, int h, int qt) {
    char* ws = p.ws;
    const int t = otid(), lane = t & 63, wv = t >> 6, r = lane & 31, hh = lane >> 5;
    const bf16_t* Q = (const bf16_t*)(ws + OFF_QMLA);
    const bf16_t* KV = (const bf16_t*)(ws + OFF_KVMLA);
    const bf16_t* KR = (const bf16_t*)(ws + OFF_KR);
    const int q0 = qt * 128 + 32 * wv;
    const size_t tokq = (size_t)b * SEQ_L + q0 + r;
    const size_t tokb = (size_t)b * SEQ_L;
    bf16x8 qf[6];
#pragma unroll
    for (int s = 0; s < 6; ++s) qf[s] = ld16(Q + tokq * 768 + h * 96 + 16 * s + 8 * hh);
    f32x16 o[2]; o[0] = zero16(); o[1] = zero16();
    float m = -INFINITY, l = 0.f;
    const bf16_t* ksrc[3]; int kadv[3]; const bf16_t* vsrc[2];
#pragma unroll
    for (int i = 0; i < 3; ++i) {
        const int o_ = 1024 * (wv + 4 * i) + 16 * lane, row = o_ / 192, pch = (o_ % 192) >> 4;
        const int c = (pch & ~3) | ((pch & 3) ^ ((row >> 2) & 3));
        if (c < 8) { ksrc[i] = KV + (tokb + row) * 1024 + h * 128 + 8 * c; kadv[i] = 64 * 1024; }
        else       { ksrc[i] = KR + (tokb + row) * 32 + 8 * (c - 8);       kadv[i] = 64 * 32; }
    }
#pragma unroll
    for (int i = 0; i < 2; ++i) {
        const int row = 8 * (wv + 4 * i) + (lane >> 3), pch = lane & 7;
        vsrc[i] = KV + (tokb + row) * 1024 + h * 128 + 64 + 8 * (pch ^ (((row >> 1) & 1) << 2));
    }
    char* ldst = lds + wv * 1024 + lane * 16;
    auto issue = [&](int kt) {
        char* d = ldst + (kt % 3) * MLA_STAGE;
#pragma unroll
        for (int i = 0; i < 3; ++i) GLDS16(ksrc[i] + (size_t)kt * kadv[i], d + i * 4096);
#pragma unroll
        for (int i = 0; i < 2; ++i) GLDS16(vsrc[i] + (size_t)kt * (64 * 1024), d + 12288 + i * 4096);
    };
    const int ntiles = 2 * qt + 2;
    __syncthreads();
    issue(0); issue(1);
#pragma unroll
    for (int s = 0; s < 6; ++s) asm volatile("" :: "v"(qf[s]));
#pragma unroll 1
    for (int kt = 0; kt < ntiles; ++kt) {
        if (kt + 1 < ntiles) asm volatile("s_waitcnt vmcnt(5)\n\ts_barrier" ::: "memory");
        else asm volatile("s_waitcnt vmcnt(0)\n\ts_barrier" ::: "memory");
        if (kt + 2 < ntiles) issue(kt + 2);
        const char* sb = lds + (kt % 3) * MLA_STAGE;
        const unsigned vb = (unsigned)(uintptr_t)(sb + 12288);
        f32x16 s[2];
#pragma unroll
        for (int k2 = 0; k2 < 2; ++k2) {
            s[k2] = zero16();
#pragma unroll
            for (int ss = 0; ss < 6; ++ss) s[k2] = MFMA32(ld16(sb + k192_off(32 * k2 + r, 2 * ss + hh)), qf[ss], s[k2]);
        }
        s16x4 vt[2][2][2][2];
#pragma unroll
        for (int k2 = 0; k2 < 2; ++k2)
#pragma unroll
            for (int st = 0; st < 2; ++st)
#pragma unroll
                for (int c = 0; c < 2; ++c) {
                    vt[k2][st][c][0] = tr_read_a(v128_tr_addr(vb, 32 * k2 + 16 * st + 4 * hh, c, lane));
                    vt[k2][st][c][1] = tr_read_a(v128_tr_addr(vb, 32 * k2 + 16 * st + 8 + 4 * hh, c, lane));
                }
        if (__builtin_amdgcn_readfirstlane(kt >= 2 * qt)) {
            asm volatile("");
            const int qpos = q0 + r;
#pragma unroll
            for (int k2 = 0; k2 < 2; ++k2)
#pragma unroll
                for (int i = 0; i < 16; ++i) { const int kpos = 64 * kt + 32 * k2 + crow(i, hh); if (kpos > qpos) s[k2][i] = -INFINITY; }
        }
        float mx = s[0][0];
#pragma unroll
        for (int k2 = 0; k2 < 2; ++k2)
#pragma unroll
            for (int i = 0; i < 16; ++i) mx = fmaxf(mx, s[k2][i]);
        mx = xhalf_max(mx);
        if (__any(mx > m + 8.0f)) {
            asm volatile("");
            const float mn = fmaxf(m, mx);
            const float alpha = fast_exp2(m - mn);
            l *= alpha;
            m = mn;
#pragma unroll
            for (int c = 0; c < 2; ++c)
#pragma unroll
                for (int i = 0; i < 16; ++i) o[c][i] *= alpha;
        }
        f32x2 ps2 = {0.f, 0.f};
        const f32x2 m2 = {m, m};
#pragma unroll
        for (int k2 = 0; k2 < 2; ++k2)
#pragma unroll
            for (int i = 0; i < 16; i += 2) {
                f32x2 x = {s[k2][i], s[k2][i + 1]};
                x = x - m2;
                f32x2 e; e[0] = fast_exp2(x[0]); e[1] = fast_exp2(x[1]);
                s[k2][i] = e[0]; s[k2][i + 1] = e[1];
                ps2 += e;
            }
        l += ps2[0] + ps2[1];
        TR_WAIT();
#pragma unroll
        for (int k2 = 0; k2 < 2; ++k2)
#pragma unroll
            for (int st = 0; st < 2; ++st) {
                const bf16x8 pb = pack_step(s[k2], st);
#pragma unroll
                for (int c = 0; c < 2; ++c) o[c] = MFMA32(cat44(vt[k2][st][c][0], vt[k2][st][c][1]), pb, o[c]);
            }
    }
    const float inv = 1.0f / xhalf_sum(l);
    bf16_t* dst = (bf16_t*)(ws + OFF_OMLA) + tokq * 512 + h * 64 + 4 * hh;
#pragma unroll
    for (int c = 0; c < 2; ++c)
#pragma unroll
        for (int g = 0; g < 4; ++g)
            *(u32x2*)(dst + 32 * c + 8 * g) = pack4(o[c][4 * g] * inv, o[c][4 * g + 1] * inv, o[c][4 * g + 2] * inv, o[c][4 * g + 3] * inv);
}

DI void dil_unit(const Params& p, char* lds, int g, int b, int h, int rr, int lb) {
    char* ws = p.ws;
    const int t = otid(), lane = t & 63, wv = t >> 6, r = lane & 31, hh = lane >> 5;
    const int d = (g == 0) ? 1 : (g == 1 ? 4 : 16);
    const bf16_t* PJ = (const bf16_t*)(ws + OFF_PROJ);
    const size_t tokb = (size_t)b * SEQ_L;
    char* kimg = lds;
    char* vimg = lds + 32768;
    __syncthreads();
    {
        const int c = t & 7;
#pragma unroll
        for (int half = 0; half < 2; ++half) {
            u32x4 kk[4], vv[4];
#pragma unroll
            for (int i = 0; i < 4; ++i) {
                const int key = (t >> 3) + 32 * (4 * half + i);
                const int lk = 128 * lb - 128 + key;
                if (lk >= 0) {
                    const size_t tk = tokb + (size_t)lk * d + rr;
                    kk[i] = ldu4(PJ + tk * INC + 1184 + h * 64 + 8 * c);
                    vv[i] = ldu4(PJ + tk * INC + 1696 + h * 64 + 8 * c);
                } else { kk[i] = (u32x4){0u, 0u, 0u, 0u}; vv[i] = (u32x4){0u, 0u, 0u, 0u}; }
            }
#pragma unroll
            for (int i = 0; i < 4; ++i) {
                const int key = (t >> 3) + 32 * (4 * half + i);
                *(u32x4*)(kimg + sw_off(key, c)) = kk[i];
                *(u32x4*)(vimg + v128_off(key, c)) = vv[i];
            }
        }
    }
    const int lq = 128 * lb + 32 * wv + r;
    const size_t tokq = tokb + (size_t)lq * d + rr;
    bf16x8 qf[4];
#pragma unroll
    for (int s = 0; s < 4; ++s) qf[s] = ld16(PJ + tokq * INC + 672 + h * 64 + 16 * s + 8 * hh);
    __syncthreads();
    const float slope2 = exp2f(-(float)(h + 1)) * (float)d * LOG2E;
    const int u0 = (lb == 0) ? (4 - wv) : 0;
    f32x16 o[2]; o[0] = zero16(); o[1] = zero16();
    float m = -INFINITY, lsum = 0.f;
    const unsigned vb = (unsigned)(uintptr_t)vimg;
#pragma unroll 1
    for (int u = u0; u < 5; ++u) {
        const int rowb = 32 * (wv + u);
        f32x16 s = zero16();
#pragma unroll
        for (int ss = 0; ss < 4; ++ss) s = MFMA32(ld16(kimg + sw_off(rowb + r, 2 * ss + hh)), qf[ss], s);
        const int dbase = r + 128 - 32 * u;
        float mx = -INFINITY;
#pragma unroll
        for (int i = 0; i < 16; ++i) {
            const int dist = dbase - crow(i, hh);
            const bool valid = (dist >= 0) && (dist <= 128);
            const float v = valid ? (s[i] - slope2 * (float)dist) : -INFINITY;
            s[i] = v;
            mx = fmaxf(mx, v);
        }
        mx = xhalf_max(mx);
        const float mn = fmaxf(m, mx);
        const float alpha = fast_exp2(m - mn);
        float ps = 0.f;
#pragma unroll
        for (int i = 0; i < 16; ++i) { const float e = fast_exp2(s[i] - mn); s[i] = e; ps += e; }
        lsum = lsum * alpha + ps;
        m = mn;
#pragma unroll
        for (int c = 0; c < 2; ++c)
#pragma unroll
            for (int i = 0; i < 16; ++i) o[c][i] *= alpha;
#pragma unroll
        for (int st = 0; st < 2; ++st) {
            const bf16x8 pb = pack_step(s, st);
#pragma unroll
            for (int c = 0; c < 2; ++c) {
                const s16x4 lo = tr_read(v128_tr_addr(vb, rowb + 16 * st + 4 * hh, c, lane));
                const s16x4 hi = tr_read(v128_tr_addr(vb, rowb + 16 * st + 8 + 4 * hh, c, lane));
                o[c] = MFMA32(cat44(lo, hi), pb, o[c]);
            }
        }
    }
    const float ltot = xhalf_sum(lsum);
    const float mx = m;
    const float inv = 1.0f / ltot;
    bf16_t* dst = (bf16_t*)(ws + OFF_ODIL) + ((size_t)g * T_TOK + tokq) * 512 + h * 64 + 4 * hh;
#pragma unroll
    for (int c = 0; c < 2; ++c)
#pragma unroll
        for (int gg = 0; gg < 4; ++gg)
            *(u32x2*)(dst + 32 * c + 8 * gg) = pack4(o[c][4 * gg] * inv, o[c][4 * gg + 1] * inv, o[c][4 * gg + 2] * inv, o[c][4 * gg + 3] * inv);
    if (hh == 0) ((float*)(ws + OFF_LSE))[((size_t)g * T_TOK + tokq) * 8 + h] = mx + __log2f(ltot);
}

DI void phase_p3(const Params& p, char* lds, int which = 3) {
    const int xg = (int)blockIdx.x & 7, nloc = (vgrid() >> 3), loc = ((int)blockIdx.x >> 3) * 2 + vhalf();
    if (which & 1) for (int i = loc; i < 64; i += nloc) {
        const int bh = xg * 4 + (i >> 4), pr = i & 15, b = bh >> 3, h = bh & 7;
#pragma unroll 1
        for (int rep = 0; rep < 2; ++rep) mla_unit(p, lds, b, h, rep ? pr : 31 - pr);
    }
    if (which & 2) for (int i = loc; i < 384; i += nloc) {
        const int bh = xg * 4 + i / 96, k96 = i % 96, g = k96 >> 5, k = k96 & 31, b = bh >> 3, h = bh & 7;
        int rr, lb;
        if (g == 0) { rr = 0; lb = k; } else if (g == 1) { rr = k >> 3; lb = k & 7; } else { rr = k >> 1; lb = k & 1; }
        dil_unit(p, lds, g, b, h, rr, lb);
    }
}

DI void phase_p35(const Params& p, char* lds) {
    char* ws = p.ws;
    const int t = otid(), lane = t & 63, wv = t >> 6;
    const int ntok = T_TOK / 4, ncv = 4096;
    for (int item = vbid(); item < ntok + 2 * ncv; item += vgrid()) {
        if (item < ntok) {
            const size_t tok = (size_t)item * 4 + wv;
            const int head = lane >> 3;
            const float* LS = (const float*)(ws + OFF_LSE);
            const float l0 = LS[tok * 8 + head], l1 = LS[((size_t)T_TOK + tok) * 8 + head], l2 = LS[((size_t)2 * T_TOK + tok) * 8 + head];
            const float mx = fmaxf(l0, fmaxf(l1, l2));
            float w0 = fast_exp2(l0 - mx), w1 = fast_exp2(l1 - mx), w2 = fast_exp2(l2 - mx);
            const float wi = 1.0f / (w0 + w1 + w2);
            w0 *= wi; w1 *= wi; w2 *= wi;
            const bf16_t* OD = (const bf16_t*)(ws + OFF_ODIL);
            const u32x4 a0 = ldu4(OD + tok * 512 + 8 * lane), a1 = ldu4(OD + ((size_t)T_TOK + tok) * 512 + 8 * lane),
                        a2 = ldu4(OD + ((size_t)2 * T_TOK + tok) * 512 + 8 * lane);
            const u32x4 am = ldu4((const bf16_t*)(ws + OFF_OMLA) + tok * 512 + 8 * lane);
            float od[8], om[8]; float sd = 0.f, sm = 0.f;
#pragma unroll
            for (int e = 0; e < 4; ++e) {
                od[2 * e] = w0 * bf_lo(a0[e]) + w1 * bf_lo(a1[e]) + w2 * bf_lo(a2[e]);
                od[2 * e + 1] = w0 * bf_hi(a0[e]) + w1 * bf_hi(a1[e]) + w2 * bf_hi(a2[e]);
                om[2 * e] = bf_lo(am[e]); om[2 * e + 1] = bf_hi(am[e]);
                sd += od[2 * e] * od[2 * e] + od[2 * e + 1] * od[2 * e + 1];
                sm += om[2 * e] * om[2 * e] + om[2 * e + 1] * om[2 * e + 1];
            }
#pragma unroll
            for (int o = 32; o; o >>= 1) { sd += __shfl_xor(sd, o); sm += __shfl_xor(sm, o); }
            const float rd = rsqrtf(sd * (1.0f / 512.0f) + 1e-6f), rm = rsqrtf(sm * (1.0f / 512.0f) + 1e-6f);
            const f32x4 gm0 = *(const f32x4*)(p.gn_mla + 8 * lane), gm1 = *(const f32x4*)(p.gn_mla + 8 * lane + 4);
            const f32x4 gd0 = *(const f32x4*)(p.gn_dil + 8 * lane), gd1 = *(const f32x4*)(p.gn_dil + 8 * lane + 4);
            u32x4 o1, o2;
            o1[0] = pack2(om[0] * rm * gm0[0], om[1] * rm * gm0[1]); o1[1] = pack2(om[2] * rm * gm0[2], om[3] * rm * gm0[3]);
            o1[2] = pack2(om[4] * rm * gm1[0], om[5] * rm * gm1[1]); o1[3] = pack2(om[6] * rm * gm1[2], om[7] * rm * gm1[3]);
            o2[0] = pack2(od[0] * rd * gd0[0], od[1] * rd * gd0[1]); o2[1] = pack2(od[2] * rd * gd0[2], od[3] * rd * gd0[3]);
            o2[2] = pack2(od[4] * rd * gd1[0], od[5] * rd * gd1[1]); o2[3] = pack2(od[6] * rd * gd1[2], od[7] * rd * gd1[3]);
            bf16_t* MX = (bf16_t*)(ws + OFF_MIXED) + tok * 1024;
            *(u32x4*)(MX + 8 * lane) = o1;
            *(u32x4*)(MX + 512 + 8 * lane) = o2;
        } else {
            const int it = item - ntok;
            const bool isv = it >= ncv;
            const size_t row = (size_t)(isv ? it - ncv : it) * 4 + wv;
            const float* src = (isv ? p.peer_v : p.peer_u) + row * 1024 + 16 * lane;
            f32x4 v[4]; float am = 0.f;
#pragma unroll
            for (int i = 0; i < 4; ++i) { v[i] = *(const f32x4*)(src + 4 * i); am = fmaxf(am, fmaxf(fmaxf(fabsf(v[i][0]), fabsf(v[i][1])), fmaxf(fabsf(v[i][2]), fabsf(v[i][3])))); }
#pragma unroll
            for (int o = 32; o; o >>= 1) am = fmaxf(am, __shfl_xor(am, o));
            const float sc = (am > 0.f) ? am * (1.0f / 127.0f) : 1.0f;
            const float inv = 1.0f / sc;
            const int bias = isv ? 128 : 0;
            u32x4 o;
#pragma unroll
            for (int i = 0; i < 4; ++i) {
                unsigned w = 0u;
#pragma unroll
                for (int e = 0; e < 4; ++e) { const int q = (int)rintf(v[i][e] * inv) + bias; w |= ((unsigned)q & 0xFFu) << (8 * e); }
                o[i] = w;
            }
            *(u32x4*)(ws + (isv ? OFF_VQ : OFF_UQ) + row * 1024 + 16 * lane) = o;
            if (lane == 0) ((float*)(ws + (isv ? OFF_SV : OFF_SU)))[row] = sc;
        }
    }
}

DI unsigned m512_off(int row, int chunk) { return (unsigned)(row * 512 + ((chunk ^ (row & 15)) << 4)); }
DI unsigned v512_off(int row, int chunk) { return (unsigned)(row * 512 + ((chunk ^ ((row & 3) << 2)) << 4)); }
DI void memattn_unit(const Params& p, char* lds, int b, int h, int tt) {
    char* ws = p.ws;
    const int t = otid(), lane = t & 63, wv = t >> 6, r = lane & 31, hh = lane >> 5;
    const int qg = wv & 1, dh = wv >> 1;
    const bf16_t* QM = (const bf16_t*)(ws + OFF_QM);
    const bf16_t* KVM = (const bf16_t*)(ws + OFF_KVM);
    const size_t tokq = (size_t)b * SEQ_L + tt * 64 + 32 * qg + r;
    bf16x8 qf[16];
#pragma unroll
    for (int s = 0; s < 16; ++s) qf[s] = ld16(QM + tokq * 1024 + h * 256 + 16 * s + 8 * hh);
    f32x16 o[4];
#pragma unroll
    for (int c = 0; c < 4; ++c) o[c] = zero16();
    float m = -INFINITY, l = 0.f;
    const bf16_t* ksrc[4]; const bf16_t* vsrc[4];
#pragma unroll
    for (int i = 0; i < 4; ++i) {
        const int row = 2 * (wv + 4 * i) + (lane >> 5), pch = lane & 31;
        const size_t mrow = (size_t)b * 256 + row;
        ksrc[i] = KVM + mrow * 2048 + h * 256 + 8 * (pch ^ (row & 15));
        vsrc[i] = KVM + mrow * 2048 + 1024 + h * 256 + 8 * (pch ^ ((row & 3) << 2));
    }
    char* ldst = lds + wv * 1024 + lane * 16;
    auto stage_tile = [&](int kt, char* sb) {
#pragma unroll
        for (int i = 0; i < 4; ++i) { GLDS16(ksrc[i] + (size_t)kt * 32 * 2048, sb + i * 4096); GLDS16(vsrc[i] + (size_t)kt * 32 * 2048, sb + 16384 + i * 4096); }
    };
    __syncthreads();
    stage_tile(0, ldst);
    __syncthreads();
#pragma unroll 1
    for (int kt = 0; kt < 8; ++kt) {
        if (kt + 1 < 8) stage_tile(kt + 1, ldst + ((kt + 1) & 1) * 32768);
        const char* sb = lds + (kt & 1) * 32768;
        const unsigned vb = (unsigned)(uintptr_t)(sb + 16384);
        f32x16 s = zero16();
#pragma unroll
        for (int ss = 0; ss < 16; ++ss) s = MFMA32(ld16(sb + m512_off(r, 2 * ss + hh)), qf[ss], s);
        float mx = s[0];
#pragma unroll
        for (int i = 1; i < 16; ++i) mx = fmaxf(mx, s[i]);
        mx = xhalf_max(mx);
        const float mn = fmaxf(m, mx);
        const float alpha = fast_exp2(m - mn);
        float ps = 0.f;
#pragma unroll
        for (int i = 0; i < 16; ++i) { const float e = fast_exp2(s[i] - mn); s[i] = e; ps += e; }
        l = l * alpha + ps;
        m = mn;
#pragma unroll
        for (int c = 0; c < 4; ++c)
#pragma unroll
            for (int i = 0; i < 16; ++i) o[c][i] *= alpha;
        const int blk = (lane >> 4) & 1, qq = (lane & 15) >> 2, pp = lane & 3;
#pragma unroll
        for (int st = 0; st < 2; ++st) {
            const bf16x8 pb = pack_step(s, st);
#pragma unroll
            for (int c = 0; c < 4; ++c) {
                const int ch = 16 * dh + 4 * c + 2 * blk + (pp >> 1);
                const s16x4 lo = tr_read(vb + v512_off(16 * st + 4 * hh + qq, ch) + 8 * (pp & 1));
                const s16x4 hi = tr_read(vb + v512_off(16 * st + 8 + 4 * hh + qq, ch) + 8 * (pp & 1));
                o[c] = MFMA32(cat44(lo, hi), pb, o[c]);
            }
        }
        __syncthreads();
    }
    const float inv = 1.0f / xhalf_sum(l);
    bf16_t* dst = (bf16_t*)(ws + OFF_OM) + tokq * 1024 + h * 256 + 128 * dh + 4 * hh;
#pragma unroll
    for (int c = 0; c < 4; ++c)
#pragma unroll
        for (int g = 0; g < 4; ++g)
            *(u32x2*)(dst + 32 * c + 8 * g) = pack4(o[c][4 * g] * inv, o[c][4 * g + 1] * inv, o[c][4 * g + 2] * inv, o[c][4 * g + 3] * inv);
}

DI void phase_memattn(const Params& p, char* lds) {
    for (int item = vbid(); item < 1024; item += vgrid()) {
        const int b = item >> 8, h = (item >> 6) & 3, tt = item & 63;
        memattn_unit(p, lds, b, h, tt);
    }
}
DI unsigned f2sort(float f) { const unsigned b = __float_as_uint(f); return b ^ ((b & 0x80000000u) ? 0xFFFFFFFFu : 0x80000000u); }
DI float sort2f(unsigned u) { const unsigned b = (u & 0x80000000u) ? (u ^ 0x80000000u) : ~u; return __uint_as_float(b); }
DI void cswap(unsigned& a, unsigned& b) { const unsigned hi = max(a, b), lo = min(a, b); a = hi; b = lo; }

template <int LO, int N> struct BClean {
    template <int M> static DI void run(unsigned (&a)[M]) {
#pragma unroll
        for (int i = 0; i < N / 2; ++i) cswap(a[LO + i], a[LO + i + N / 2]);
        BClean<LO, N / 2>::run(a); BClean<LO + N / 2, N / 2>::run(a);
    }
};
template <int LO> struct BClean<LO, 1> { template <int M> static DI void run(unsigned (&)[M]) {} };
template <int LO, int N> struct BSort {
    template <int M> static DI void run(unsigned (&a)[M]) {
        BSort<LO, N / 2>::run(a); BSort<LO + N / 2, N / 2>::run(a);
#pragma unroll
        for (int i = 0; i < N / 2; ++i) cswap(a[LO + i], a[LO + N - 1 - i]);
        BClean<LO, N / 2>::run(a); BClean<LO + N / 2, N / 2>::run(a);
    }
};
template <int LO> struct BSort<LO, 1> { template <int M> static DI void run(unsigned (&)[M]) {} };
DI void merge_top16(unsigned (&a)[16], const unsigned (&b)[16]) {
#pragma unroll
    for (int i = 0; i < 16; ++i) a[i] = max(a[i], b[15 - i]);
    BClean<0, 16>::run(a);
}

DI void peer_top16(const bf16_t* __restrict__ keys_hp, const bf16_t* __restrict__ pq_row_hp, int r, int hh, unsigned (&top)[16]) {
    bf16x8 qf[8];
#pragma unroll
    for (int s = 0; s < 8; ++s) qf[s] = ld16(pq_row_hp + 16 * s + 8 * hh);
    unsigned cur[16];
#pragma unroll
    for (int kt = 0; kt < 4; ++kt) {
        f32x16 acc = zero16();
#pragma unroll
        for (int s = 0; s < 8; ++s) acc = MFMA32(ld16(keys_hp + (size_t)(32 * kt + r) * 128 + 16 * s + 8 * hh), qf[s], acc);
        unsigned k[16];
#pragma unroll
        for (int i = 0; i < 16; ++i) k[i] = (f2sort(acc[i]) & ~0x7Fu) | (unsigned)(32 * kt + crow(i, hh));
        BSort<0, 16>::run(k);
        if (kt == 0) {
#pragma unroll
            for (int i = 0; i < 16; ++i) cur[i] = k[i];
        } else merge_top16(cur, k);
    }
    unsigned r0[16], r1[16];
#pragma unroll
    for (int i = 0; i < 16; ++i) { auto rr = __builtin_amdgcn_permlane32_swap(cur[i], cur[i], false, false); r0[i] = rr[0]; r1[i] = rr[1]; }
#pragma unroll
    for (int i = 0; i < 16; ++i) top[i] = max(r0[i], r1[15 - i]);
    BClean<0, 16>::run(top);
}

DI void peer_select_unit(const Params& p, char* lds, int mt, int h) {
    char* ws = p.ws;
    const int t = otid(), lane = t & 63, wv = t >> 6, r = lane & 31, hh = lane >> 5;
    const size_t tok = (size_t)mt * 128 + 32 * wv + r;
    const bf16_t* KEYS = (const bf16_t*)(ws + OFF_KEYS);
    const bf16_t* PQ = (const bf16_t*)(ws + OFF_PQ);
    unsigned tA[16], tB[16];
    peer_top16(KEYS + (size_t)(2 * h) * 16384, PQ + tok * 2048 + (2 * h) * 128, r, hh, tA);
    peer_top16(KEYS + (size_t)(2 * h + 1) * 16384, PQ + tok * 2048 + (2 * h + 1) * 128, r, hh, tB);
    float fA[16], fB[16];
#pragma unroll
    for (int i = 0; i < 16; ++i) { fA[i] = sort2f(tA[i] & ~0x7Fu); fB[i] = sort2f(tB[i] & ~0x7Fu); }
    unsigned* tab = (unsigned*)lds + wv * 1024;
    __syncthreads();
#pragma unroll
    for (int i = 0; i < 16; ++i) tab[i * 64 + lane] = (tA[i] & 0x7Fu) | ((tB[i] & 0x7Fu) << 16);
    unsigned c[64];
#pragma unroll
    for (int i = 0; i < 64; ++i) c[i] = 0u;
    {
        int n = 0;
#pragma unroll
        for (int a = 0; a < 16; ++a)
#pragma unroll
            for (int b = 0; b < 16; ++b)
                if ((a + 1) * (b + 1) <= 16) { c[n] = (f2sort(fA[a] + fB[b]) & ~0xFFu) | (unsigned)(a * 16 + b); ++n; }
    }
    unsigned g0[16], g1[16], g2[16], g3[16];
#pragma unroll
    for (int i = 0; i < 16; ++i) { g0[i] = c[i]; g1[i] = c[16 + i]; g2[i] = c[32 + i]; g3[i] = c[48 + i]; }
    BSort<0, 16>::run(g0); BSort<0, 16>::run(g1); BSort<0, 16>::run(g2); BSort<0, 16>::run(g3);
    merge_top16(g0, g1); merge_top16(g2, g3); merge_top16(g0, g2);
    float e[16]; float sum = 0.f;
    const float v0 = sort2f(g0[0] & ~0xFFu);
    unsigned ids[16];
#pragma unroll
    for (int i = 0; i < 16; ++i) {
        const float v = sort2f(g0[i] & ~0xFFu);
        e[i] = fast_exp2((v - v0) * LOG2E); sum += e[i];
        const unsigned a = (g0[i] >> 4) & 15u, b = g0[i] & 15u;
        const unsigned ia = tab[a * 64 + lane] & 0x7Fu, ib = (tab[b * 64 + lane] >> 16) & 0x7Fu;
        ids[i] = ia * 128u + ib;
    }
    const float inv = 1.0f / sum;
    if (hh == 0) {
        unsigned short* SID = (unsigned short*)(ws + OFF_SELID) + tok * 128 + h * 16;
        float* SG = (float*)(ws + OFF_SELG) + tok * 128 + h * 16;
        u32x4 w0, w1;
        w0[0] = ids[0] | (ids[1] << 16); w0[1] = ids[2] | (ids[3] << 16); w0[2] = ids[4] | (ids[5] << 16); w0[3] = ids[6] | (ids[7] << 16);
        w1[0] = ids[8] | (ids[9] << 16); w1[1] = ids[10] | (ids[11] << 16); w1[2] = ids[12] | (ids[13] << 16); w1[3] = ids[14] | (ids[15] << 16);
        *(u32x4*)SID = w0; *(u32x4*)(SID + 8) = w1;
#pragma unroll
        for (int q = 0; q < 4; ++q) *(f32x4*)(SG + 4 * q) = (f32x4){e[4 * q] * inv, e[4 * q + 1] * inv, e[4 * q + 2] * inv, e[4 * q + 3] * inv};
    }
}

DI void phase_select(const Params& p, char* lds) {
    for (int item = vbid(); item < 1024; item += vgrid()) peer_select_unit(p, lds, item >> 3, item & 7);
}

DI float gelu_erf(float a) { return 0.5f * a * (1.0f + erff(a * 0.70710678118654752f)); }
DI int dppi(int v, const int ctrl) { return v; }
#define DPP_I(v, ctrl) __builtin_amdgcn_update_dpp(0, (v), (ctrl), 0xf, 0xf, true)
DI float ub0(unsigned w) { return (float)(w & 0xFFu); }
DI float ub1(unsigned w) { return (float)((w >> 8) & 0xFFu); }
DI float ub2(unsigned w) { return (float)((w >> 16) & 0xFFu); }
DI float ub3(unsigned w) { return (float)(w >> 24); }

struct GBatch { u32x4 U[4], V[4]; float su[4], sv[4], gate[4]; };

DI void gather_load(GBatch& B, const char* __restrict__ ws, unsigned idpair, f32x2 gpair, int eb, int lane) {
#pragma unroll
    for (int j = 0; j < 4; ++j) {
        const int e = eb + j;
        const unsigned pr = __shfl(idpair, e >> 1);
        const unsigned id = (j & 1) ? (pr >> 16) : (pr & 0xFFFFu);
        const float g0 = __shfl(gpair[0], e >> 1), g1 = __shfl(gpair[1], e >> 1);
        B.gate[j] = (j & 1) ? g1 : g0;
        B.U[j] = ldu4(ws + OFF_UQ + (size_t)id * 1024 + 16 * lane);
        B.V[j] = ldu4(ws + OFF_VQ + (size_t)id * 1024 + 16 * lane);
        B.su[j] = ((const float*)(ws + OFF_SU))[id];
        B.sv[j] = ((const float*)(ws + OFF_SV))[id];
    }
}

DI void gather_compute(const GBatch& B, const unsigned (&qx)[4], float sx, float (&acc)[16], float& csum, int lane) {
    int pd[4];
#pragma unroll
    for (int j = 0; j < 4; ++j) {
        int d = 0;
#pragma unroll
        for (int q = 0; q < 4; ++q) d = __builtin_amdgcn_sdot4((int)B.U[j][q], (int)qx[q], d, false);
        pd[j] = d;
    }
    const bool b0 = lane & 1, b1 = lane & 2;
    const int kA = b0 ? pd[1] : pd[0], kB = b0 ? pd[3] : pd[2], sA = b0 ? pd[0] : pd[1], sB = b0 ? pd[2] : pd[3];
    const int qA = kA + DPP_I(sA, 0xB1), qB = kB + DPP_I(sB, 0xB1);
    const int kp = b1 ? qB : qA, sd = b1 ? qA : qB;
    int tot = kp + DPP_I(sd, 0x4E);
    tot += DPP_I(tot, 0x124);
    tot += DPP_I(tot, 0x128);
    tot += __builtin_amdgcn_ds_swizzle(tot, 0x401F);
    { auto rr = __builtin_amdgcn_permlane32_swap((unsigned)tot, (unsigned)tot, false, false); tot = (int)rr[0] + (int)rr[1]; }
    const int j3 = lane & 3;
    const float su_sel = (j3 == 0) ? B.su[0] : (j3 == 1 ? B.su[1] : (j3 == 2 ? B.su[2] : B.su[3]));
    const float ge = gelu_erf((float)tot * sx * su_sel);
#pragma unroll
    for (int j = 0; j < 4; ++j) {
        const float cf = B.gate[j] * B.sv[j] * __shfl(ge, j);
        csum += cf;
#pragma unroll
        for (int q = 0; q < 4; ++q) {
            const unsigned w = B.V[j][q];
            acc[4 * q] += cf * ub0(w); acc[4 * q + 1] += cf * ub1(w); acc[4 * q + 2] += cf * ub2(w); acc[4 * q + 3] += cf * ub3(w);
        }
    }
}

DI void gather_token(const Params& p, size_t tok, int lane, float* dst_base) {
    char* ws = p.ws;
    float* hrow = p.out + tok * 1024 + 16 * lane;
    float hv[16];
#pragma unroll
    for (int i = 0; i < 4; ++i) { const f32x4 a = *(const f32x4*)(hrow + 4 * i); hv[4 * i] = a[0]; hv[4 * i + 1] = a[1]; hv[4 * i + 2] = a[2]; hv[4 * i + 3] = a[3]; }
    float rs;
    {
        const float* SS = (const float*)(ws + OFF_SS2) + tok * 16;
        const f32x4 s0 = *(const f32x4*)SS, s1 = *(const f32x4*)(SS + 4), s2 = *(const f32x4*)(SS + 8), s3 = *(const f32x4*)(SS + 12);
        const float tot = (s0[0] + s0[1] + s0[2] + s0[3]) + (s1[0] + s1[1] + s1[2] + s1[3]) + (s2[0] + s2[1] + s2[2] + s2[3]) + (s3[0] + s3[1] + s3[2] + s3[3]);
        rs = rsqrtf(tot * (1.0f / 1024.0f) + 1e-6f);
    }
    float xf[16]; float am = 0.f;
#pragma unroll
    for (int i = 0; i < 4; ++i) {
        const f32x4 g = *(const f32x4*)(p.norm_ffn + 16 * lane + 4 * i);
#pragma unroll
        for (int e = 0; e < 4; ++e) { xf[4 * i + e] = hv[4 * i + e] * rs * g[e]; am = fmaxf(am, fabsf(xf[4 * i + e])); }
    }
#pragma unroll
    for (int o = 32; o; o >>= 1) am = fmaxf(am, __shfl_xor(am, o));
    const float sx = (am > 0.f) ? am * (1.0f / 127.0f) : 1.0f;
    const float isx = 1.0f / sx;
    unsigned qx[4];
#pragma unroll
    for (int i = 0; i < 4; ++i) {
        unsigned w = 0u;
#pragma unroll
        for (int e = 0; e < 4; ++e) w |= ((unsigned)(int)rintf(xf[4 * i + e] * isx) & 0xFFu) << (8 * e);
        qx[i] = w;
    }
    const unsigned idpair = *((const unsigned*)(ws + OFF_SELID) + tok * 64 + lane);
    const f32x2 gpair = *((const f32x2*)(ws + OFF_SELG) + tok * 64 + lane);
    float acc[16]; float csum = 0.f;
#pragma unroll
    for (int i = 0; i < 16; ++i) acc[i] = 0.f;
    GBatch B0, B1;
    gather_load(B0, ws, idpair, gpair, 0, lane);
#pragma unroll 1
    for (int eb = 0; eb < 128; eb += 8) {
        gather_load(B1, ws, idpair, gpair, eb + 4, lane);
        gather_compute(B0, qx, sx, acc, csum, lane);
        if (eb + 8 < 128) gather_load(B0, ws, idpair, gpair, eb + 8, lane);
        gather_compute(B1, qx, sx, acc, csum, lane);
    }
    float ss = 0.f;
#pragma unroll
    for (int i = 0; i < 16; ++i) { acc[i] = acc[i] - 128.0f * csum + hv[i]; ss += acc[i] * acc[i]; }
#pragma unroll
    for (int o = 32; o; o >>= 1) ss += __shfl_xor(ss, o);
    const float rf = rsqrtf(ss * (1.0f / 1024.0f) + 1e-6f);
    float* drow = dst_base + tok * 1024 + 16 * lane;
#pragma unroll
    for (int i = 0; i < 4; ++i) {
        const f32x4 n = *(const f32x4*)(p.norm_final + 16 * lane + 4 * i);
        *(f32x4*)(drow + 4 * i) = (f32x4){acc[4 * i] * rf * n[0], acc[4 * i + 1] * rf * n[1], acc[4 * i + 2] * rf * n[2], acc[4 * i + 3] * rf * n[3]};
    }
}

DI void phase_gather(const Params& p, bool dry = false) {
    const int lane = otid() & 63, wv = otid() >> 6;
    float* dst = dry ? (float*)(p.ws + OFF_PQ) : p.out;
    for (int item = vbid(); item < T_TOK / 4; item += vgrid()) gather_token(p, (size_t)item * 4 + wv, lane, dst);
}
constexpr int LDS_BYTES = 131072 + 1024;
constexpr int NPHASE = 12;
template <int PH> DI void run_phase(const Params& p, char* smem) {
    char* lds = smem + vhalf() * 65536;
    if (PH == 0) phase_prep(p, lds);
    else if (PH == 1) phase_p1(p, smem);
    else if (PH == 2) phase_p2(p, smem);
    else if (PH == 3) phase_p3(p, lds);
    else if (PH == 4) phase_p35(p, lds);
    else if (PH == 5) phase_resid(p, smem, OFF_WT_OUT, OFF_MIXED, p.x, OFF_SS1);
    else if (PH == 6) phase_rowscale(p, smem, OFF_WT_MQ, 1024, OFF_QM, OFF_SS1, 0.0625f * LOG2E);
    else if (PH == 7) phase_memattn(p, lds);
    else if (PH == 8) phase_resid(p, smem, OFF_WT_MO, OFF_OM, p.out, OFF_SS2);
    else if (PH == 9) phase_rowscale(p, smem, OFF_WT_PQ, 2048, OFF_PQ, OFF_SS2, 1.0f);
    else if (PH == 10) phase_select(p, lds);
    else if (PH == 11) phase_gather(p);
}

template <int PH> __global__ void __launch_bounds__(512, 2) k_phase(Params p) {
    __shared__ __attribute__((aligned(16))) char smem[LDS_BYTES];
    run_phase<PH>(p, smem);
}

static Params make_params(void* const* d_in, void* d_out, void* d_ws) {
    Params p;
    memset(&p, 0, sizeof(p));
    p.x = (const float*)d_in[0]; p.mem = (const float*)d_in[1]; p.norm_mix = (const float*)d_in[2]; p.w_in = (const float*)d_in[3];
    p.q_norm = (const float*)d_in[4]; p.kv_norm = (const float*)d_in[5]; p.w_uq = (const float*)d_in[6]; p.w_ukv = (const float*)d_in[7];
    p.gn_mla = (const float*)d_in[8]; p.gn_dil = (const float*)d_in[9]; p.w_out = (const float*)d_in[10]; p.norm_mem_q = (const float*)d_in[11];
    p.norm_mem_kv = (const float*)d_in[12]; p.w_mem_q = (const float*)d_in[13]; p.w_mem_kv = (const float*)d_in[14]; p.w_mem_o = (const float*)d_in[15];
    p.norm_ffn = (const float*)d_in[16]; p.peer_w_q = (const float*)d_in[17]; p.sub_keys = (const float*)d_in[18]; p.peer_u = (const float*)d_in[19];
    p.peer_v = (const float*)d_in[20]; p.norm_final = (const float*)d_in[21];
    p.out = (float*)d_out; p.ws = (char*)d_ws;
    for (int i = 0; i < 16; ++i) p.inv_freq[i] = 1.0f / powf(10000.0f, (float)(2 * i) / 32.0f);
    return p;
}
__global__ void __launch_bounds__(512, 2) k_mega(Params p) {
    __shared__ __attribute__((aligned(16))) char smem[LDS_BYTES + 16];
    volatile LAS unsigned* st = (volatile LAS unsigned*)(LAS char*)(smem + LDS_BYTES);
    if (threadIdx.x == 0) { st[0] = 0u; st[1] = 0u; st[2] = 0u; st[3] = 0u; }
    __syncthreads();
    const XcdBarrier xb = xcd_barrier_post((unsigned*)(p.ws + OFF_BAR), st);
#define RP(n) run_phase<n>(p, smem); xcd_barrier(xb);
    RP(0) RP(1) RP(2) RP(3) RP(4) RP(5) RP(6) RP(7) RP(8) RP(9) RP(10)
    run_phase<11>(p, smem);
}

extern "C" void kernel_launch(void* const* d_in, const int* in_sizes, int n_in, void* d_out, int out_size, void* d_ws, size_t ws_size,
                              hipStream_t stream) {
    static int grid_blocks = 0;
    if (!grid_blocks) {
        int dev = 0, cus = 0, per_cu = 0;
        (void)hipGetDevice(&dev);
        (void)hipDeviceGetAttribute(&cus, hipDeviceAttributeMultiprocessorCount, dev);
        (void)hipOccupancyMaxActiveBlocksPerMultiprocessor(&per_cu, k_mega, 512, 0);
        if (per_cu > 1) per_cu = 1;
        if (per_cu < 1) per_cu = 1;
        grid_blocks = cus * per_cu;
    }
    Params p = make_params(d_in, d_out, d_ws);
    (void)hipMemsetAsync((char*)d_ws + OFF_BAR, 0, XCD_BAR_WORDS * 4, stream);
    void* args[] = {&p};
    hipError_t e = hipLaunchCooperativeKernel((const void*)k_mega, dim3(grid_blocks), dim3(512), args, 0, stream);
    if (e != hipSuccess) fprintf(stderr, "cooperative launch failed: %s (grid %d)\n", hipGetErrorString(e), grid_blocks);
}
```

```cpp
#include <hip/hip_runtime.h>
#include <hip/hip_cooperative_groups.h>
#include <math.h>
#include <stdint.h>
#include <stdio.h>
#include <string.h>
#define DI __device__ __forceinline__
typedef unsigned short bf16_t;
typedef short bf16x8 __attribute__((ext_vector_type(8)));
typedef short s16x4 __attribute__((ext_vector_type(4)));
typedef float f32x16 __attribute__((ext_vector_type(16)));
typedef float f32x4 __attribute__((ext_vector_type(4)));
typedef float f32x2 __attribute__((ext_vector_type(2)));
typedef unsigned u32x4 __attribute__((ext_vector_type(4)));
typedef unsigned u32x2 __attribute__((ext_vector_type(2)));
typedef __bf16 bf16x2v __attribute__((ext_vector_type(2)));
#define LAS __attribute__((address_space(3)))
#define MFMA32(a, b, c) __builtin_amdgcn_mfma_f32_32x32x16_bf16((a), (b), (c), 0, 0, 0)

constexpr int T_TOK = 16384, SEQ_L = 4096, DM = 1024, INC = 2208;
constexpr float LOG2E = 1.4426950408889634f;

DI int otid() { int t = threadIdx.x & 255; asm volatile("" : "+v"(t)); return t; }
DI int vhalf() { return __builtin_amdgcn_readfirstlane((int)(threadIdx.x >> 8)); }
DI int vbid() { return (int)blockIdx.x * 2 + vhalf(); }
DI int vgrid() { return (int)gridDim.x * 2; }
DI unsigned pack2(float lo, float hi) { f32x2 f = {lo, hi}; return __builtin_bit_cast(unsigned, __builtin_convertvector(f, bf16x2v)); }
DI float bf_lo(unsigned u) { return __uint_as_float(u << 16); }
DI float bf_hi(unsigned u) { return __uint_as_float(u & 0xffff0000u); }
DI float bf2f(bf16_t v) { return __uint_as_float(((unsigned)v) << 16); }
DI int crow(int reg, int hh) { return (reg & 3) + 8 * (reg >> 2) + 4 * hh; }
DI f32x16 zero16() { f32x16 z;
#pragma unroll
    for (int i = 0; i < 16; ++i) z[i] = 0.f; return z; }
DI float xhalf_max(float v) { auto r = __builtin_amdgcn_permlane32_swap(__float_as_uint(v), __float_as_uint(v), false, false); return fmaxf(__uint_as_float(r[0]), __uint_as_float(r[1])); }
DI float xhalf_other(float v, int lane) { auto r = __builtin_amdgcn_permlane32_swap(__float_as_uint(v), __float_as_uint(v), false, false); return __uint_as_float((lane & 32) ? r[0] : r[1]); }
DI float xhalf_sum(float v) { auto r = __builtin_amdgcn_permlane32_swap(__float_as_uint(v), __float_as_uint(v), false, false); return __uint_as_float(r[0]) + __uint_as_float(r[1]); }
DI bf16x8 ld16(const void* p) { return *(const bf16x8*)p; }
DI u32x4 ldu4(const void* p) { return *(const u32x4*)p; }
DI float fast_exp2(float x) { return __builtin_amdgcn_exp2f(x); }
DI bf16x8 pack_step(const f32x16& x, int s) {
    u32x4 p;
    p[0] = pack2(x[8 * s + 0], x[8 * s + 1]); p[1] = pack2(x[8 * s + 2], x[8 * s + 3]);
    p[2] = pack2(x[8 * s + 4], x[8 * s + 5]); p[3] = pack2(x[8 * s + 6], x[8 * s + 7]);
    return __builtin_bit_cast(bf16x8, p);
}
DI s16x4 tr_read_a(unsigned lds_byte_addr) { s16x4 r; asm volatile("ds_read_b64_tr_b16 %0, %1" : "=v"(r) : "v"(lds_byte_addr)); return r; }
#define TR_WAIT() do { asm volatile("s_waitcnt lgkmcnt(0)" ::: "memory"); __builtin_amdgcn_sched_barrier(0); } while (0)
DI s16x4 tr_read(unsigned lds_byte_addr) {
    return __builtin_amdgcn_ds_read_tr16_b64_v4i16((LAS s16x4*)(uintptr_t)lds_byte_addr);
}

constexpr size_t MiB = 1ull << 20;
constexpr size_t OFF_BAR = 0;
constexpr size_t OFF_WT_IN = 65536;
constexpr size_t OFF_WT_UQ = OFF_WT_IN + 2304ull * 1024 * 2;
constexpr size_t OFF_WT_UKV = OFF_WT_UQ + 768ull * 384 * 2;
constexpr size_t OFF_WT_OUT = OFF_WT_UKV + 1024ull * 256 * 2;
constexpr size_t OFF_WT_MQ = OFF_WT_OUT + 1024ull * 1024 * 2;
constexpr size_t OFF_WT_MKV = OFF_WT_MQ + 1024ull * 1024 * 2;
constexpr size_t OFF_WT_MO = OFF_WT_MKV + 2048ull * 1024 * 2;
constexpr size_t OFF_WT_PQ = OFF_WT_MO + 1024ull * 1024 * 2;
constexpr size_t OFF_KEYS = OFF_WT_PQ + 2048ull * 1024 * 2;
constexpr size_t OFF_ROPE = OFF_KEYS + 16ull * 128 * 128 * 2;
constexpr size_t OFF_KR = OFF_ROPE + 2ull * 4096 * 16 * 4;
constexpr size_t OFF_LSE = OFF_KR + (size_t)T_TOK * 32 * 2;
constexpr size_t OFF_SS1 = OFF_LSE + 3ull * T_TOK * 8 * 4;
constexpr size_t OFF_SS2 = OFF_SS1 + (size_t)T_TOK * 16 * 4;
constexpr size_t OFF_MEMN = OFF_SS2 + (size_t)T_TOK * 16 * 4;
constexpr size_t OFF_SMALL_END = OFF_MEMN + 1024ull * 1024 * 2;
static_assert(OFF_SMALL_END <= 28 * MiB, "small region overflow");
constexpr size_t OFF_A = 28 * MiB;
constexpr size_t OFF_PROJ = OFF_A;
constexpr size_t OFF_UQ = 193 * MiB;
constexpr size_t OFF_VQ = 209 * MiB;
constexpr size_t OFF_SU = 243 * MiB;
constexpr size_t OFF_SV = OFF_SU + 65536;
constexpr size_t OUT_ODIL = 0;
constexpr size_t OUT_OMLA = 48 * MiB;
constexpr size_t OUT_PQ = 0;
constexpr size_t OFF_B = 97 * MiB;
constexpr size_t OFF_XN = OFF_B, OFF_QMLA = OFF_B, OFF_MIXED = OFF_B, OFF_QM = OFF_B;
constexpr size_t OFF_C = 129 * MiB;
constexpr size_t OFF_KVMLA = OFF_C, OFF_HB = OFF_C;
constexpr size_t OFF_D = 161 * MiB;
constexpr size_t OFF_OM = OFF_D;
constexpr size_t OFF_SELID = 225 * MiB;
constexpr size_t OFF_SELG = 229 * MiB;
constexpr size_t OFF_KVM = 237 * MiB;
constexpr size_t OFF_SSQ = 241 * MiB;
constexpr size_t WS_NEEDED = 244 * MiB;

struct Params {
    const float* x; const float* mem; const float* norm_mix; const float* w_in; const float* q_norm; const float* kv_norm;
    const float* w_uq; const float* w_ukv; const float* gn_mla; const float* gn_dil; const float* w_out; const float* norm_mem_q;
    const float* norm_mem_kv; const float* w_mem_q; const float* w_mem_kv; const float* w_mem_o; const float* norm_ffn;
    const float* peer_w_q; const float* sub_keys; const float* peer_u; const float* peer_v; const float* norm_final;
    float* out; char* ws;
    float inv_freq[16];
    int prof; int pad_;
};
#define XB_TMO      128
#define XB_XCNT(j)  (256  + 64 * (j))
#define XB_XSUB(j)  (1280 + 64 * (j))
#define XB_XGEN(j)  (2304 + 64 * (j))
#define XB_TOP      3328
#define XB_TOPGEN   3392
#define XCD_BAR_WORDS 3456
#define XB_SPIN_CAP (1u << 20)
DI unsigned xb_ld(unsigned* p) { return __hip_atomic_load(p, __ATOMIC_RELAXED, __HIP_MEMORY_SCOPE_AGENT); }
DI unsigned xb_add(unsigned* p, unsigned v) { return __hip_atomic_fetch_add(p, v, __ATOMIC_RELAXED, __HIP_MEMORY_SCOPE_AGENT); }
DI unsigned xb_xcc_id() { return (unsigned)__builtin_amdgcn_s_getreg((3 << 11) | 20) & 0xFu; }
#define XB_SPIN(cond, bar) do { unsigned _sp = 0; while (cond) { __builtin_amdgcn_s_sleep(1); \
    if ((++_sp & 255u) == 0u) { if (xb_ld(&(bar)[XB_TMO])) break; if (_sp > XB_SPIN_CAP) { atomicAdd(&(bar)[XB_TMO], 1u); break; } } } } while (0)
struct XcdBarrier { unsigned* bar; unsigned x; volatile LAS unsigned* st; };
DI XcdBarrier xcd_barrier_post(unsigned* bar, volatile LAS unsigned* st) {
    XcdBarrier b; b.bar = bar; b.x = xb_xcc_id(); b.st = st;
    if (threadIdx.x == 0) (void)xb_add(&bar[XB_XCNT(b.x)], 1u);
    return b;
}
DI void xcd_barrier_complete(unsigned* bar, unsigned x, unsigned& nloc, unsigned& nx) {
    const unsigned G = gridDim.x * gridDim.y * gridDim.z;
    unsigned sum, cnt, mine, sp = 0u;
    for (;;) {
        sum = 0u; cnt = 0u; mine = 0u;
#pragma unroll
        for (unsigned j = 0; j < 16; ++j) { const unsigned c = xb_ld(&bar[XB_XCNT(j)]); sum += c; cnt += (c > 0u) ? 1u : 0u; mine = (j == x) ? c : mine; }
        if (sum == G) break;
        __builtin_amdgcn_s_sleep(1);
        if ((++sp & 255u) == 0u) { if (xb_ld(&bar[XB_TMO])) break; if (sp > XB_SPIN_CAP) { atomicAdd(&bar[XB_TMO], 1u); break; } }
    }
    nloc = mine > 0u ? mine : 1u; nx = cnt > 0u ? cnt : 1u;
}
DI void xcd_barrier(const XcdBarrier& b) {
    asm volatile("s_waitcnt vmcnt(0)" ::: "memory");
    __syncthreads();
    if (threadIdx.x == 0) {
        unsigned* bar = b.bar;
        __builtin_amdgcn_s_waitcnt(0);
        unsigned nloc = b.st[0], nx = b.st[1];
        if (nloc == 0u) { xcd_barrier_complete(bar, b.x, nloc, nx); b.st[0] = nloc; b.st[1] = nx; }
        const unsigned old = xb_add(&bar[XB_XSUB(b.x)], 1u);
        const unsigned gen = old / nloc;
        if (old + 1u == (gen + 1u) * nloc) {
            __builtin_amdgcn_fence(__ATOMIC_RELEASE, "agent");
            asm volatile("s_waitcnt vmcnt(0)" ::: "memory");
            const unsigned og = xb_add(&bar[XB_TOP], 1u);
            const unsigned tg = og / nx;
            if (og + 1u == (tg + 1u) * nx) xb_add(&bar[XB_TOPGEN], 1u);
            else XB_SPIN(xb_ld(&bar[XB_TOPGEN]) == tg, bar);
            __builtin_amdgcn_fence(__ATOMIC_ACQUIRE, "agent");
            xb_add(&bar[XB_XGEN(b.x)], 1u);
            asm volatile("s_waitcnt vmcnt(0)" ::: "memory");
        } else {
            XB_SPIN(xb_ld(&bar[XB_XGEN(b.x)]) == gen, bar);
            __builtin_amdgcn_fence(__ATOMIC_ACQUIRE, "agent");
            asm volatile("s_waitcnt vmcnt(0)" ::: "memory");
        }
    }
    __syncthreads();
}
DI void transpose_tile(const float* __restrict__ W, int K, int N, const float* __restrict__ g, bf16_t* __restrict__ Wt, int kt, int nt, char* lds, bool valid) {
    float* sm = (float*)lds;
    const int t = otid();
    const int k0 = kt * 64, n0 = nt * 64;
    __syncthreads();
#pragma unroll
    for (int i = 0; i < 16; ++i) {
        const int id = t + 256 * i, k = id >> 6, n = id & 63;
        float v = 0.f;
        if (valid && n0 + n < N) { v = W[(size_t)(k0 + k) * N + n0 + n]; if (g) v *= g[k0 + k]; }
        sm[k * 65 + n] = v;
    }
    __syncthreads();
    const int n = t >> 2, kc = (t & 3) * 16;
    u32x4 o0, o1;
    o0[0] = pack2(sm[(kc + 0) * 65 + n], sm[(kc + 1) * 65 + n]); o0[1] = pack2(sm[(kc + 2) * 65 + n], sm[(kc + 3) * 65 + n]);
    o0[2] = pack2(sm[(kc + 4) * 65 + n], sm[(kc + 5) * 65 + n]); o0[3] = pack2(sm[(kc + 6) * 65 + n], sm[(kc + 7) * 65 + n]);
    o1[0] = pack2(sm[(kc + 8) * 65 + n], sm[(kc + 9) * 65 + n]); o1[1] = pack2(sm[(kc + 10) * 65 + n], sm[(kc + 11) * 65 + n]);
    o1[2] = pack2(sm[(kc + 12) * 65 + n], sm[(kc + 13) * 65 + n]); o1[3] = pack2(sm[(kc + 14) * 65 + n], sm[(kc + 15) * 65 + n]);
    bf16_t* dst = Wt + (size_t)(n0 + n) * K + k0 + kc;
    if (valid) { *(u32x4*)dst = o0; *(u32x4*)(dst + 8) = o1; }
}

DI void rmsnorm_row_bf16(const float* __restrict__ in, const float* __restrict__ g, bf16_t* __restrict__ out, int lane) {
    f32x4 v[4]; float ss = 0.f;
#pragma unroll
    for (int i = 0; i < 4; ++i) { v[i] = *(const f32x4*)(in + 4 * lane + 256 * i); ss += v[i][0] * v[i][0] + v[i][1] * v[i][1] + v[i][2] * v[i][2] + v[i][3] * v[i][3]; }
#pragma unroll
    for (int o = 32; o; o >>= 1) ss += __shfl_xor(ss, o);
    const float rs = rsqrtf(ss * (1.0f / 1024.0f) + 1e-6f);
#pragma unroll
    for (int i = 0; i < 4; ++i) {
        const f32x4 gg = *(const f32x4*)(g + 4 * lane + 256 * i);
        u32x2 o; o[0] = pack2(v[i][0] * rs * gg[0], v[i][1] * rs * gg[1]); o[1] = pack2(v[i][2] * rs * gg[2], v[i][3] * rs * gg[3]);
        *(u32x2*)(out + 4 * lane + 256 * i) = o;
    }
}

struct TrJob { const float* W; const float* g; size_t off; int K, N, Npad; };

DI void phase_prep(const Params& p, char* lds) {
    char* ws = p.ws;
    const int t = otid(), lane = t & 63, wv = t >> 6;
    const int c0 = 576, c1 = c0 + 72, c2 = c1 + 64, c3 = c2 + 256, c4 = c3 + 256, c5 = c4 + 512, c6 = c5 + 256, c7 = c6 + 512;
    const int nrow = (T_TOK + 1024) / 4;
    const int nkeys = 128, nrope = 256;
    const int total = c7 + nrow + nkeys + nrope;
    for (int k = 0; k < (c7 + vgrid() - 1) / vgrid(); ++k) {
        const int raw = vbid() + k * vgrid();
        const bool valid = raw < c7;
        const int item = valid ? raw : 0;
        const float* W; const float* g; size_t off; int K, N, Npad, local;
        if (item < c0)      { W = p.w_in;     g = nullptr;      off = OFF_WT_IN;  K = 1024; N = 2208; Npad = 2304; local = item; }
        else if (item < c1) { W = p.w_uq;     g = p.q_norm;     off = OFF_WT_UQ;  K = 384;  N = 768;  Npad = 768;  local = item - c0; }
        else if (item < c2) { W = p.w_ukv;    g = p.kv_norm;    off = OFF_WT_UKV; K = 256;  N = 1024; Npad = 1024; local = item - c1; }
        else if (item < c3) { W = p.w_out;    g = nullptr;      off = OFF_WT_OUT; K = 1024; N = 1024; Npad = 1024; local = item - c2; }
        else if (item < c4) { W = p.w_mem_q;  g = p.norm_mem_q; off = OFF_WT_MQ;  K = 1024; N = 1024; Npad = 1024; local = item - c3; }
        else if (item < c5) { W = p.w_mem_kv; g = nullptr;      off = OFF_WT_MKV; K = 1024; N = 2048; Npad = 2048; local = item - c4; }
        else if (item < c6) { W = p.w_mem_o;  g = nullptr;      off = OFF_WT_MO;  K = 1024; N = 1024; Npad = 1024; local = item - c5; }
        else                { W = p.peer_w_q; g = p.norm_ffn;   off = OFF_WT_PQ;  K = 1024; N = 2048; Npad = 2048; local = item - c6; }
        const int ntn = Npad / 64;
        transpose_tile(W, K, N, g, (bf16_t*)(ws + off), local / ntn, local % ntn, lds, valid);
    }
    for (int item = c7 + vbid(); item < total; item += vgrid()) {
        if (item < c7 + nrow) {
            const int row = (item - c7) * 4 + wv;
            if (row < T_TOK) rmsnorm_row_bf16(p.x + (size_t)row * 1024, p.norm_mix, (bf16_t*)(ws + OFF_XN) + (size_t)row * 1024, lane);
            else rmsnorm_row_bf16(p.mem + (size_t)(row - T_TOK) * 1024, p.norm_mem_kv, (bf16_t*)(ws + OFF_MEMN) + (size_t)(row - T_TOK) * 1024, lane);
        } else if (item < c7 + nrow + nkeys) {
            const int idx = ((item - c7 - nrow) * 256 + t) * 8;
            const f32x4 a = *(const f32x4*)(p.sub_keys + idx), b = *(const f32x4*)(p.sub_keys + idx + 4);
            u32x4 o; o[0] = pack2(a[0], a[1]); o[1] = pack2(a[2], a[3]); o[2] = pack2(b[0], b[1]); o[3] = pack2(b[2], b[3]);
            *(u32x4*)((bf16_t*)(ws + OFF_KEYS) + idx) = o;
        } else {
            const int idx = (item - c7 - nrow - nkeys) * 256 + t;
            const int s = idx >> 4, i = idx & 15;
            const float ang = (float)s * p.inv_freq[i];
            const double a = (double)ang;
            const double twopi = 6.283185307179586476925;
            const float rf = (float)(a - twopi * rint(a / twopi));
            float* cs = (float*)(ws + OFF_ROPE);
            cs[idx] = cosf(rf); cs[65536 + idx] = sinf(rf);
        }
    }
}
namespace pg8 {
#define PG8_LAS __attribute__((address_space(3)))
typedef unsigned short bf16_t;
typedef short bf16x8 __attribute__((ext_vector_type(8)));
typedef float f32x4 __attribute__((ext_vector_type(4)));
typedef unsigned u32x4 __attribute__((ext_vector_type(4)));
constexpr int BM = 256, BK = 64, HALF = 128, HTB = HALF * BK * 2  , STAGE_BYTES = 8 * HTB, NXCD = 8, WGM = 8;

__host__ __device__ __forceinline__ int lds_byte(int r, int c) { const int st = (r >> 4) * 2 + (c >> 5), rr = r & 15, cc = c & 31, ob = rr * 64 + cc * 2; return st * 1024 + (ob ^ (((ob >> 9) & 1) << 5)); }
__host__ __device__ __forceinline__ void stage_rc(int b, int& R, int& C) { const int st = b / 1024, sb = b % 1024, swz = sb ^ (((sb >> 9) & 1) << 5); R = (st >> 1) * 16 + swz / 64; C = (st & 1) * 32 + (swz % 64) / 2; }
__host__ __device__ __forceinline__ int perm32(int rho) { const int n = rho >> 4, i = rho & 15; return 8 * (i >> 2) + 4 * n + (i & 3); }

struct Unit { int pm, pn; };
struct Gemm { const bf16_t* A; const bf16_t* Bt; int M, N, K, lda; };

struct StaticOrder {
    int nM, nN, nwg, G, c;
    __host__ __device__ void init(int M, int N, int G_, int c_) { nM = M / BM; nN = N / BM; nwg = nM * nN; G = G_; c = c_; }
    __host__ __device__ bool next(int i, Unit& u) const {
        const long L = (long)i * G + c; if (L >= nwg) return false;
        int wgid = (int)L; { const int q = nwg / NXCD, r = nwg % NXCD, xcd = wgid % NXCD, off = wgid / NXCD; wgid = (xcd < r ? xcd * (q + 1) : r * (q + 1) + (xcd - r) * q) + off; }
        const int nig = WGM * nN, gid = wgid / nig, fm = gid * WGM, gsz = (nM - fm) < WGM ? (nM - fm) : WGM;
        u.pm = fm + ((wgid % nig) % gsz); u.pn = (wgid % nig) / gsz; return true;
    }
    __device__ __forceinline__ void a_ready(const Unit&) const {}
    __device__ __forceinline__ void done(const Unit&) const {}
};

template <class Epi, class Sched, bool ALIGN_EPI = false, bool SP2 = false>
__device__ __forceinline__ void gemm_phase(PG8_LAS unsigned char* lds, const Gemm g, const Sched& S, const Epi& E) {
    int tid_ = threadIdx.x; asm volatile("" : "+v"(tid_));
    const int tid = tid_, wid = __builtin_amdgcn_readfirstlane(tid >> 6), lane = tid & 63, wr = wid >> 2, wc = wid & 3, fr = lane & 15, fq = lane >> 4;
    const int K = g.K, nt = K / BK, lda = g.lda;
    unsigned voffA[2], voffB[2];
#pragma unroll
    for (int i = 0; i < 2; ++i) { int R, C; stage_rc(tid * 16 + i * 8192, R, C); const int Rb = Epi::PERM ? ((R & ~31) + perm32(R & 31)) : R;
        voffA[i] = (unsigned)(R * lda + C) * 2u; voffB[i] = (unsigned)(Rb * K + C) * 2u; }
    const size_t kstep = (size_t)(BK * 2);
    const size_t hstepB = (size_t)HALF * K * 2, hstepA = (size_t)HALF * lda * 2;
    const size_t tstepB = 2 * hstepB, tstepA = 2 * hstepA;
    const unsigned ldsw = (unsigned)wid * 1024u;
    const int aoff = lds_byte(wr * 64 + fr, fq * 8), boff = lds_byte(wc * 32 + fr, fq * 8);
#define PG8_SA(b, h) (((b) * 2 + (h)) * HTB)
#define PG8_SB(b, h) ((4 + (b) * 2 + (h)) * HTB)
#define PG8_STAGE(bufoff, gbase, voff) do { _Pragma("unroll") for (int _i = 0; _i < 2; ++_i) \
        __builtin_amdgcn_global_load_lds((const unsigned*)((const char*)(gbase) + (voff)[_i]), (PG8_LAS unsigned*)(lds + (bufoff) + ldsw + _i * 8192), 16, 0, 0); } while (0)
#define PG8_LDA(dst, b, h) do { _Pragma("unroll") for (int m = 0; m < 4; ++m) _Pragma("unroll") for (int k = 0; k < 2; ++k) dst[m][k] = *(const PG8_LAS bf16x8*)(lds + PG8_SA(b, h) + aoff + m * 2048 + k * 1024); } while (0)
#define PG8_LDB(dst, b, h) do { _Pragma("unroll") for (int n = 0; n < 2; ++n) _Pragma("unroll") for (int k = 0; k < 2; ++k) dst[n][k] = *(const PG8_LAS bf16x8*)(lds + PG8_SB(b, h) + boff + n * 2048 + k * 1024); } while (0)
#define PG8_MMA(ai, bj, At, Bt) do { __builtin_amdgcn_s_setprio(1); _Pragma("unroll") for (int m = 0; m < 4; ++m) _Pragma("unroll") for (int n = 0; n < 2; ++n) _Pragma("unroll") for (int k = 0; k < 2; ++k) \
        acc[ai][bj][m][n] = __builtin_amdgcn_mfma_f32_16x16x32_bf16(Bt[n][k], At[m][k], acc[ai][bj][m][n], 0, 0, 0); __builtin_amdgcn_s_setprio(0); } while (0)
#define PG8_WAIT_V(n) asm volatile("s_waitcnt vmcnt(" #n ")" ::: "memory")
#define PG8_WAIT_L(n) asm volatile("s_waitcnt lgkmcnt(" #n ")" ::: "memory")
#define PG8_BAR __builtin_amdgcn_s_barrier()
#define PG8_SCHED __builtin_amdgcn_sched_barrier(0)
    Unit cur, nxt; int ui = 0;
    if (!S.next(0, cur)) return;
    f32x4 acc[2][2][4][2];
#pragma unroll
    for (int a = 0; a < 2; ++a)
#pragma unroll
        for (int b = 0; b < 2; ++b)
#pragma unroll
            for (int m = 0; m < 4; ++m)
#pragma unroll
                for (int n = 0; n < 2; ++n) acc[a][b][m][n] = (f32x4){0.f, 0.f, 0.f, 0.f};
    bf16x8 At[4][2], B0[2][2], B1[2][2];
    const char* cA = (const char*)g.A + (size_t)cur.pm * tstepA; const char* cB = (const char*)g.Bt + (size_t)cur.pn * tstepB;
    S.a_ready(cur);
    if constexpr (SP2) {
        PG8_STAGE(PG8_SB(0, 0), cB, voffB); PG8_STAGE(PG8_SB(0, 1), cB + hstepB, voffB); PG8_STAGE(PG8_SA(0, 0), cA, voffA); PG8_STAGE(PG8_SA(0, 1), cA + hstepA, voffA);
        if (wr == 1) PG8_BAR;
        PG8_WAIT_V(2); PG8_BAR;
        PG8_STAGE(PG8_SB(1, 0), cB + kstep, voffB); PG8_STAGE(PG8_SA(1, 0), cA + kstep, voffA); PG8_STAGE(PG8_SB(1, 1), cB + hstepB + kstep, voffB);
        PG8_WAIT_V(6); PG8_BAR;
    } else {
        PG8_STAGE(PG8_SB(0, 0), cB, voffB); PG8_STAGE(PG8_SA(0, 0), cA, voffA); PG8_STAGE(PG8_SB(0, 1), cB + hstepB, voffB); PG8_STAGE(PG8_SA(0, 1), cA + hstepA, voffA);
        if (wr == 1) PG8_BAR;
        PG8_WAIT_V(4); PG8_BAR;
        PG8_STAGE(PG8_SB(1, 0), cB + kstep, voffB); PG8_STAGE(PG8_SA(1, 0), cA + kstep, voffA); PG8_STAGE(PG8_SB(1, 1), cB + hstepB + kstep, voffB);
        PG8_WAIT_V(6); PG8_BAR;
    }
    for (;;) {
        const bool has_next = S.next(ui + 1, nxt);
        const char* nA = has_next ? (const char*)g.A + (size_t)nxt.pm * tstepA : cA; const char* nB = has_next ? (const char*)g.Bt + (size_t)nxt.pn * tstepB : cB;
#pragma unroll 1
        for (int t = 0; t < nt; t += 2) {
            const bool last = (t == nt - 2);
            const char* a1 = cA + (size_t)(t + 1) * kstep;
            const char* a2 = last ? nA : cA + (size_t)(t + 2) * kstep; const char* b2 = last ? nB : cB + (size_t)(t + 2) * kstep;
            const char* a3 = a2 + kstep; const char* b3 = b2 + kstep;
            if (last && has_next) S.a_ready(nxt);
            if constexpr (SP2) {
            PG8_LDB(B0, 0, 0); PG8_LDB(B1, 0, 1); PG8_SCHED; PG8_LDA(At, 0, 0); PG8_STAGE(PG8_SA(1, 1), a1 + hstepA, voffA);
            PG8_WAIT_V(8); PG8_WAIT_L(0); PG8_BAR; PG8_MMA(0, 0, At, B0); PG8_MMA(0, 1, At, B1); PG8_BAR; PG8_SCHED;
            PG8_LDA(At, 0, 1); PG8_STAGE(PG8_SB(0, 0), b2, voffB); PG8_STAGE(PG8_SB(0, 1), b2 + hstepB, voffB); PG8_STAGE(PG8_SA(0, 0), a2, voffA);
            PG8_WAIT_V(8); PG8_WAIT_L(0); PG8_BAR; PG8_MMA(1, 0, At, B0); PG8_MMA(1, 1, At, B1); PG8_BAR; PG8_SCHED;
            PG8_LDB(B0, 1, 0); PG8_LDB(B1, 1, 1); PG8_SCHED; PG8_LDA(At, 1, 0); PG8_STAGE(PG8_SA(0, 1), a2 + hstepA, voffA);
            PG8_WAIT_V(8); PG8_WAIT_L(0); PG8_BAR; PG8_MMA(0, 0, At, B0); PG8_MMA(0, 1, At, B1); PG8_BAR; PG8_SCHED;
            PG8_LDA(At, 1, 1); PG8_STAGE(PG8_SB(1, 0), b3, voffB); PG8_STAGE(PG8_SB(1, 1), b3 + hstepB, voffB); PG8_STAGE(PG8_SA(1, 0), a3, voffA);
            PG8_WAIT_V(8); PG8_WAIT_L(0); PG8_BAR; PG8_MMA(1, 0, At, B0); PG8_MMA(1, 1, At, B1); PG8_BAR; PG8_SCHED;
            } else {
            PG8_LDB(B0, 0, 0); PG8_SCHED; PG8_LDA(At, 0, 0); PG8_STAGE(PG8_SA(1, 1), a1 + hstepA, voffA);
            PG8_WAIT_L(8); PG8_BAR; PG8_WAIT_L(0); PG8_MMA(0, 0, At, B0); PG8_BAR; PG8_SCHED;
            PG8_LDB(B1, 0, 1); PG8_STAGE(PG8_SB(0, 0), b2, voffB);
            PG8_BAR; PG8_WAIT_L(0); PG8_MMA(0, 1, At, B1); PG8_BAR;
            PG8_LDA(At, 0, 1); PG8_STAGE(PG8_SA(0, 0), a2, voffA);
            PG8_BAR; PG8_WAIT_L(0); PG8_MMA(1, 0, At, B0); PG8_BAR; PG8_SCHED;
            PG8_STAGE(PG8_SB(0, 1), b2 + hstepB, voffB);
            PG8_WAIT_V(6); PG8_BAR; PG8_MMA(1, 1, At, B1); PG8_BAR;
            PG8_LDB(B0, 1, 0); PG8_SCHED; PG8_LDA(At, 1, 0); PG8_STAGE(PG8_SA(0, 1), a2 + hstepA, voffA);
            PG8_WAIT_L(8); PG8_BAR; PG8_WAIT_L(0); PG8_MMA(0, 0, At, B0); PG8_BAR; PG8_SCHED;
            PG8_LDB(B1, 1, 1); PG8_STAGE(PG8_SB(1, 0), b3, voffB);
            PG8_BAR; PG8_WAIT_L(0); PG8_MMA(0, 1, At, B1); PG8_BAR;
            PG8_LDA(At, 1, 1); PG8_STAGE(PG8_SA(1, 0), a3, voffA);
            PG8_BAR; PG8_WAIT_L(0); PG8_MMA(1, 0, At, B0); PG8_BAR; PG8_SCHED;
            PG8_STAGE(PG8_SB(1, 1), b3 + hstepB, voffB);
            PG8_WAIT_V(6); PG8_BAR; PG8_MMA(1, 1, At, B1); PG8_BAR;
            }
        }
        if constexpr (ALIGN_EPI) { if (wr == 0) PG8_BAR; }
        if constexpr (!Epi::AFTER_DRAIN) { E(acc, cur, wr, wc, fr, fq); S.done(cur); }
        if (!has_next) break;
#pragma unroll
        for (int a = 0; a < 2; ++a)
#pragma unroll
            for (int b = 0; b < 2; ++b)
#pragma unroll
                for (int m = 0; m < 4; ++m)
#pragma unroll
                    for (int n = 0; n < 2; ++n) acc[a][b][m][n] = (f32x4){0.f, 0.f, 0.f, 0.f};
        cur = nxt; cA = nA; cB = nB; ++ui;
        if constexpr (ALIGN_EPI) { if (wr == 1) PG8_BAR; }
    }
    PG8_WAIT_V(0);
    if constexpr (!ALIGN_EPI) { if (wr == 0) PG8_BAR; }
    PG8_BAR;
    if constexpr (Epi::AFTER_DRAIN) { E.fused(acc, cur, wr, wc, fr, fq, lds, wid, lane); S.done(cur); }
#undef PG8_SA
#undef PG8_SB
#undef PG8_STAGE
#undef PG8_LDA
#undef PG8_LDB
#undef PG8_MMA
#undef PG8_WAIT_V
#undef PG8_WAIT_L
#undef PG8_BAR
#undef PG8_SCHED
}
}
DI unsigned sw_off(int row, int chunk) { return (unsigned)(row * 128 + ((chunk ^ ((row >> 1) & 7)) << 4)); }
#define GLDS16(gsrc, ldst) __builtin_amdgcn_global_load_lds((const unsigned*)(gsrc), (unsigned*)(ldst), 16, 0, 0)
DI u32x2 pack4(float a, float b, float c, float d) { u32x2 o; o[0] = pack2(a, b); o[1] = pack2(c, d); return o; }
#define EPI_ARGS const f32x4 (&acc)[2][2][4][2], const pg8::Unit& u, int wr, int wc, int fr, int fq
DI float xq_sum(float v) {
    v += __uint_as_float((unsigned)__builtin_amdgcn_ds_swizzle((int)__float_as_uint(v), 0x401F));
    return xhalf_sum(v);
}
DI u32x4 pack8(const float (&v)[8], float sc) {
    u32x4 o; o[0] = pack2(v[0] * sc, v[1] * sc); o[1] = pack2(v[2] * sc, v[3] * sc); o[2] = pack2(v[4] * sc, v[5] * sc); o[3] = pack2(v[6] * sc, v[7] * sc); return o;
}
DI void rope8(const float (&v)[8], float sc, const float* __restrict__ cs, int pos, int fq, int lane, bf16_t* dst32  ) {
    const int i0 = 8 * (fq & 1);
    const f32x4 c0 = *(const f32x4*)(cs + pos * 16 + i0), c1 = *(const f32x4*)(cs + pos * 16 + i0 + 4);
    const f32x4 s0 = *(const f32x4*)(cs + 65536 + pos * 16 + i0), s1 = *(const f32x4*)(cs + 65536 + pos * 16 + i0 + 4);
    const float sg = (fq < 2) ? -1.0f : 1.0f;
    float o[8];
#pragma unroll
    for (int e = 0; e < 8; ++e) {
        const float own = v[e] * sc, oth = xhalf_other(own, lane);
        const float c = (e < 4) ? c0[e & 3] : c1[e & 3], s = (e < 4) ? s0[e & 3] : s1[e & 3];
        o[e] = own * c + sg * oth * s;
    }
    *(u32x4*)(dst32 + 8 * fq) = pack8(o, 1.0f);
}
#define EPI_LOAD8(v, ai, bj, m) float v[8]; { const f32x4 x0_ = acc[ai][bj][m][0], x1_ = acc[ai][bj][m][1]; v[0] = x0_[0]; v[1] = x0_[1]; v[2] = x0_[2]; v[3] = x0_[3]; v[4] = x1_[0]; v[5] = x1_[1]; v[6] = x1_[2]; v[7] = x1_[3]; }

struct EpiPlain8 {
    static constexpr bool PERM = true, AFTER_DRAIN = false;
    bf16_t* out; int ld;
    DI void operator()(EPI_ARGS) const {
#pragma unroll
        for (int ai = 0; ai < 2; ++ai)
#pragma unroll
            for (int m = 0; m < 4; ++m) {
                int fr_ = fr; asm volatile("" : "+v"(fr_));
                const size_t tok = (size_t)u.pm * 256 + ai * 128 + wr * 64 + m * 16 + fr_;
#pragma unroll
                for (int bj = 0; bj < 2; ++bj) { EPI_LOAD8(v, ai, bj, m); *(u32x4*)(out + tok * ld + u.pn * 256 + bj * 128 + wc * 32 + 8 * fq) = pack8(v, 1.0f); }
            }
    }
};

struct EpiProj8 {
    static constexpr bool PERM = true, AFTER_DRAIN = false;
    bf16_t* proj; bf16_t* kr; const float* cs; float* ssq;
    DI void operator()(EPI_ARGS) const {
        const int lane = fr + 16 * fq;
#pragma unroll
        for (int bj = 0; bj < 2; ++bj) {
            const int cg = u.pn * 256 + bj * 128 + wc * 32;
            if (cg >= INC) continue;
            const int g32 = cg >> 5;
            const float sc = (cg >= 672 && cg < 1184) ? 0.125f * LOG2E : 1.0f;
#pragma unroll
            for (int ai = 0; ai < 2; ++ai)
#pragma unroll
                for (int m = 0; m < 4; ++m) {
                    int fr_ = fr; asm volatile("" : "+v"(fr_));
                const size_t tok = (size_t)u.pm * 256 + ai * 128 + wr * 64 + m * 16 + fr_;
                    EPI_LOAD8(v, ai, bj, m);
                    if (g32 < 20) {
                        float ss = 0.f;
#pragma unroll
                        for (int e = 0; e < 8; ++e) ss += v[e] * v[e];
                        ss = xq_sum(ss);
                        if (fq == 0) ssq[tok * 24 + g32] = ss;
                    }
                    if (cg == 640) rope8(v, 1.0f, cs, (int)(tok & (SEQ_L - 1)), fq, lane, kr + tok * 32);
                    else *(u32x4*)(proj + tok * INC + cg + 8 * fq) = pack8(v, sc);
                }
        }
    }
};

struct EpiUpQ8 {
    static constexpr bool PERM = true, AFTER_DRAIN = false;
    bf16_t* q; const float* cs; const float* ssq;
    DI void operator()(EPI_ARGS) const {
        const int lane = fr + 16 * fq;
        const float qs = 0.10206207261596575f * LOG2E;
#pragma unroll
        for (int ai = 0; ai < 2; ++ai)
#pragma unroll
            for (int m = 0; m < 4; ++m) {
                int fr_ = fr; asm volatile("" : "+v"(fr_));
                const size_t tok = (size_t)u.pm * 256 + ai * 128 + wr * 64 + m * 16 + fr_;
                const f32x4 a0 = *(const f32x4*)(ssq + tok * 24), a1 = *(const f32x4*)(ssq + tok * 24 + 4), a2 = *(const f32x4*)(ssq + tok * 24 + 8);
                const float tot = (a0[0] + a0[1] + a0[2] + a0[3]) + (a1[0] + a1[1] + a1[2] + a1[3]) + (a2[0] + a2[1] + a2[2] + a2[3]);
                const float sc = rsqrtf(tot * (1.0f / 384.0f) + 1e-6f) * qs;
#pragma unroll
                for (int bj = 0; bj < 2; ++bj) {
                    const int cg = u.pn * 256 + bj * 128 + wc * 32;
                    EPI_LOAD8(v, ai, bj, m);
                    if ((cg % 96) == 64) rope8(v, sc, cs, (int)(tok & (SEQ_L - 1)), fq, lane, q + tok * 768 + cg);
                    else *(u32x4*)(q + tok * 768 + cg + 8 * fq) = pack8(v, sc);
                }
            }
    }
};

struct EpiUpKV8 {
    static constexpr bool PERM = true, AFTER_DRAIN = false;
    bf16_t* kv; const float* ssq;
    DI void operator()(EPI_ARGS) const {
#pragma unroll
        for (int ai = 0; ai < 2; ++ai)
#pragma unroll
            for (int m = 0; m < 4; ++m) {
                int fr_ = fr; asm volatile("" : "+v"(fr_));
                const size_t tok = (size_t)u.pm * 256 + ai * 128 + wr * 64 + m * 16 + fr_;
                const f32x4 a0 = *(const f32x4*)(ssq + tok * 24 + 12), a1 = *(const f32x4*)(ssq + tok * 24 + 16);
                const float tot = (a0[0] + a0[1] + a0[2] + a0[3]) + (a1[0] + a1[1] + a1[2] + a1[3]);
                const float sc = rsqrtf(tot * (1.0f / 256.0f) + 1e-6f);
#pragma unroll
                for (int bj = 0; bj < 2; ++bj) { EPI_LOAD8(v, ai, bj, m); *(u32x4*)(kv + tok * 1024 + u.pn * 256 + bj * 128 + wc * 32 + 8 * fq) = pack8(v, sc); }
            }
    }
};

template <bool RBF16>
struct EpiResid8 {
    static constexpr bool PERM = true, AFTER_DRAIN = false;
    const void* R; bf16_t* HB; float* SS;
    DI void operator()(EPI_ARGS) const {
#pragma unroll
        for (int ai = 0; ai < 2; ++ai) {
            f32x4 rv[4][2][2];
#pragma unroll
            for (int m = 0; m < 4; ++m)
#pragma unroll
                for (int bj = 0; bj < 2; ++bj) {
                    const size_t off = ((size_t)u.pm * 256 + ai * 128 + wr * 64 + m * 16 + fr) * 1024 + u.pn * 256 + bj * 128 + wc * 32 + 8 * fq;
                    if (RBF16) {
                        const u32x4 w = ldu4((const bf16_t*)R + off);
                        rv[m][bj][0] = (f32x4){bf_lo(w[0]), bf_hi(w[0]), bf_lo(w[1]), bf_hi(w[1])};
                        rv[m][bj][1] = (f32x4){bf_lo(w[2]), bf_hi(w[2]), bf_lo(w[3]), bf_hi(w[3])};
                    } else {
                        rv[m][bj][0] = *(const f32x4*)((const float*)R + off); rv[m][bj][1] = *(const f32x4*)((const float*)R + off + 4);
                    }
                }
#pragma unroll
            for (int m = 0; m < 4; ++m) {
                int fr_ = fr; asm volatile("" : "+v"(fr_));
                const size_t tok = (size_t)u.pm * 256 + ai * 128 + wr * 64 + m * 16 + fr_;
                float ss = 0.f;
#pragma unroll
                for (int bj = 0; bj < 2; ++bj) {
                    const size_t off = tok * 1024 + u.pn * 256 + bj * 128 + wc * 32 + 8 * fq;
                    const f32x4 h0 = rv[m][bj][0] + acc[ai][bj][m][0], h1 = rv[m][bj][1] + acc[ai][bj][m][1];
                    u32x4 o; o[0] = pack2(h0[0], h0[1]); o[1] = pack2(h0[2], h0[3]); o[2] = pack2(h1[0], h1[1]); o[3] = pack2(h1[2], h1[3]);
                    *(u32x4*)(HB + off) = o;
                    const float a0 = bf_lo(o[0]), a1 = bf_hi(o[0]), a2 = bf_lo(o[1]), a3 = bf_hi(o[1]), a4 = bf_lo(o[2]), a5 = bf_hi(o[2]), a6 = bf_lo(o[3]), a7 = bf_hi(o[3]);
                    ss += (a0 * a0 + a1 * a1) + (a2 * a2 + a3 * a3) + (a4 * a4 + a5 * a5) + (a6 * a6 + a7 * a7);
                }
                ss = xq_sum(ss);
                if (fq == 0) SS[tok * 16 + 4 * u.pn + wc] = ss;
            }
        }
    }
};

struct EpiRowScale8 {
    static constexpr bool PERM = true, AFTER_DRAIN = false;
    bf16_t* out; int ld; const float* SS; float extra;
    DI void operator()(EPI_ARGS) const {
#pragma unroll
        for (int ai = 0; ai < 2; ++ai)
#pragma unroll
            for (int m = 0; m < 4; ++m) {
                int fr_ = fr; asm volatile("" : "+v"(fr_));
                const size_t tok = (size_t)u.pm * 256 + ai * 128 + wr * 64 + m * 16 + fr_;
                const f32x4 s0 = *(const f32x4*)(SS + tok * 16), s1 = *(const f32x4*)(SS + tok * 16 + 4), s2 = *(const f32x4*)(SS + tok * 16 + 8), s3 = *(const f32x4*)(SS + tok * 16 + 12);
                const float tot = (s0[0] + s0[1] + s0[2] + s0[3]) + (s1[0] + s1[1] + s1[2] + s1[3]) + (s2[0] + s2[1] + s2[2] + s2[3]) + (s3[0] + s3[1] + s3[2] + s3[3]);
                const float sc = rsqrtf(tot * (1.0f / 1024.0f) + 1e-6f) * extra;
#pragma unroll
                for (int bj = 0; bj < 2; ++bj) { EPI_LOAD8(v, ai, bj, m); *(u32x4*)(out + tok * ld + u.pn * 256 + bj * 128 + wc * 32 + 8 * fq) = pack8(v, sc); }
            }
    }
};

template <class Epi>
DI void gemm8(char* smem, const bf16_t* A, int lda, const bf16_t* Bt, int M, int N, int K, const Epi& e, int cshift = 0) {
    pg8::Gemm g; g.A = A; g.Bt = Bt; g.M = M; g.N = N; g.K = K; g.lda = lda;
    const int G = (int)gridDim.x;
    pg8::StaticOrder S; S.init(M, N, G, ((int)blockIdx.x + G - cshift) % G);
    pg8::gemm_phase<Epi, pg8::StaticOrder, true, true>((PG8_LAS unsigned char*)smem, g, S, e);
}

DI void quant_rows4(const Params& p, int it, int wv, int lane);
DI void phase_p1(const Params& p, char* smem) {
    char* ws = p.ws;
    const int G = (int)gridDim.x, nproj = 9 * 64, nkvm = 8 * 4;
    const int last = nproj % G;
    { EpiProj8 e{(bf16_t*)(ws + OFF_PROJ), (bf16_t*)(ws + OFF_KR), (const float*)(ws + OFF_ROPE), (float*)(ws + OFF_SSQ)};
      gemm8(smem, (const bf16_t*)(ws + OFF_XN), 1024, (const bf16_t*)(ws + OFF_WT_IN), T_TOK, 2304, 1024, e); }
    { EpiPlain8 e{(bf16_t*)(ws + OFF_KVM), 2048};
      gemm8(smem, (const bf16_t*)(ws + OFF_MEMN), 1024, (const bf16_t*)(ws + OFF_WT_MKV), 1024, 2048, 1024, e, last); }
    int q0 = last + nkvm, nq = G - q0;
    if (last == 0 || nq <= 0) { q0 = 0; nq = G; }
    if ((int)blockIdx.x >= q0) {
        const int t = otid(), lane = t & 63, wv = t >> 6;
        for (int it = ((int)blockIdx.x - q0) * 2 + vhalf(); it < 8192; it += 2 * nq) quant_rows4(p, it, wv, lane);
    }
}
DI void phase_p2(const Params& p, char* smem) {
    char* ws = p.ws;
    { EpiUpQ8 e{(bf16_t*)(ws + OFF_QMLA), (const float*)(ws + OFF_ROPE), (const float*)(ws + OFF_SSQ)};
      gemm8(smem, (const bf16_t*)(ws + OFF_PROJ), INC, (const bf16_t*)(ws + OFF_WT_UQ), T_TOK, 768, 384, e); }
    { EpiUpKV8 e{(bf16_t*)(ws + OFF_KVMLA), (const float*)(ws + OFF_SSQ)};
      gemm8(smem, (const bf16_t*)(ws + OFF_PROJ) + 384, INC, (const bf16_t*)(ws + OFF_WT_UKV), T_TOK, 1024, 256, e); }
}
template <bool RBF16>
DI void phase_resid(const Params& p, char* smem, size_t off_w, size_t off_a, const void* R, size_t off_ss, bool dry = false) {
    char* ws = p.ws;
    EpiResid8<RBF16> e{R, (bf16_t*)(ws + OFF_HB), (float*)(ws + off_ss)};
    if (dry) { e.HB = (bf16_t*)(ws + OFF_B); e.SS = (float*)(ws + OFF_SS1); }
    gemm8(smem, (const bf16_t*)(ws + off_a), 1024, (const bf16_t*)(ws + off_w), T_TOK, 1024, 1024, e);
}
DI void phase_rowscale(const Params& p, char* smem, size_t off_w, int N, bf16_t* outp, size_t off_ss, float extra) {
    char* ws = p.ws;
    EpiRowScale8 e{outp, N, (const float*)(ws + off_ss), extra};
    gemm8(smem, (const bf16_t*)(ws + OFF_HB), 1024, (const bf16_t*)(ws + off_w), T_TOK, N, 1024, e);
}
DI unsigned v128_off(int row, int chunk) { return (unsigned)(row * 128 + ((chunk ^ (((row >> 1) & 1) << 2)) << 4)); }
DI unsigned v128_tr_addr(unsigned base, int R0, int c, int lane) {
    const int blk = (lane >> 4) & 1, qq = (lane & 15) >> 2, pp = lane & 3;
    return base + v128_off(R0 + qq, 4 * c + 2 * blk + (pp >> 1)) + 8 * (pp & 1);
}
DI bf16x8 cat44(s16x4 lo, s16x4 hi) { return __builtin_shufflevector(lo, hi, 0, 1, 2, 3, 4, 5, 6, 7); }

constexpr int MLA_STAGE = 64 * 192 + 64 * 128;
DI unsigned k192_off(int row, int chunk) { return (unsigned)(row * 192 + (((chunk & ~3) | ((chunk & 3) ^ ((row >> 2) & 3))) << 4)); }
DI void mla_unit(const Params& p, char* lds, int b, int h, int qt) {
    char* ws = p.ws;
    const int t = otid(), lane = t & 63, wv = t >> 6, r = lane & 31, hh = lane >> 5;
    const bf16_t* Q = (const bf16_t*)(ws + OFF_QMLA);
    const bf16_t* KV = (const bf16_t*)(ws + OFF_KVMLA);
    const bf16_t* KR = (const bf16_t*)(ws + OFF_KR);
    const int q0 = qt * 128 + 32 * wv;
    const size_t tokq = (size_t)b * SEQ_L + q0 + r;
    const size_t tokb = (size_t)b * SEQ_L;
    bf16x8 qf[6];
#pragma unroll
    for (int s = 0; s < 6; ++s) qf[s] = ld16(Q + tokq * 768 + h * 96 + 16 * s + 8 * hh);
    f32x16 o[2]; o[0] = zero16(); o[1] = zero16();
    float m = -INFINITY, l = 0.f;
    const bf16_t* ksrc[3]; int kadv[3]; const bf16_t* vsrc[2];
#pragma unroll
    for (int i = 0; i < 3; ++i) {
        const int o_ = 1024 * (wv + 4 * i) + 16 * lane, row = o_ / 192, pch = (o_ % 192) >> 4;
        const int c = (pch & ~3) | ((pch & 3) ^ ((row >> 2) & 3));
        if (c < 8) { ksrc[i] = KV + (tokb + row) * 1024 + h * 128 + 8 * c; kadv[i] = 64 * 1024; }
        else       { ksrc[i] = KR + (tokb + row) * 32 + 8 * (c - 8);       kadv[i] = 64 * 32; }
    }
#pragma unroll
    for (int i = 0; i < 2; ++i) {
        const int row = 8 * (wv + 4 * i) + (lane >> 3), pch = lane & 7;
        vsrc[i] = KV + (tokb + row) * 1024 + h * 128 + 64 + 8 * (pch ^ (((row >> 1) & 1) << 2));
    }
    char* ldst = lds + wv * 1024 + lane * 16;
    auto issue = [&](int kt) {
        char* d = ldst + (kt % 3) * MLA_STAGE;
#pragma unroll
        for (int i = 0; i < 3; ++i) GLDS16(ksrc[i] + (size_t)kt * kadv[i], d + i * 4096);
#pragma unroll
        for (int i = 0; i < 2; ++i) GLDS16(vsrc[i] + (size_t)kt * (64 * 1024), d + 12288 + i * 4096);
    };
    const int ntiles = 2 * qt + 2;
    __syncthreads();
    issue(0); issue(1);
#pragma unroll
    for (int s = 0; s < 6; ++s) asm volatile("" :: "v"(qf[s]));
#pragma unroll 1
    for (int kt = 0; kt < ntiles; ++kt) {
        if (kt + 1 < ntiles) asm volatile("s_waitcnt vmcnt(5)\n\ts_barrier" ::: "memory");
        else asm volatile("s_waitcnt vmcnt(0)\n\ts_barrier" ::: "memory");
        if (kt + 2 < ntiles) issue(kt + 2);
        const char* sb = lds + (kt % 3) * MLA_STAGE;
        const unsigned vb = (unsigned)(uintptr_t)(sb + 12288);
        f32x16 s[2];
#pragma unroll
        for (int k2 = 0; k2 < 2; ++k2) {
            s[k2] = zero16();
#pragma unroll
            for (int ss = 0; ss < 6; ++ss) s[k2] = MFMA32(ld16(sb + k192_off(32 * k2 + r, 2 * ss + hh)), qf[ss], s[k2]);
        }
        s16x4 vt[2][2][2][2];
#pragma unroll
        for (int k2 = 0; k2 < 2; ++k2)
#pragma unroll
            for (int st = 0; st < 2; ++st)
#pragma unroll
                for (int c = 0; c < 2; ++c) {
                    vt[k2][st][c][0] = tr_read_a(v128_tr_addr(vb, 32 * k2 + 16 * st + 4 * hh, c, lane));
                    vt[k2][st][c][1] = tr_read_a(v128_tr_addr(vb, 32 * k2 + 16 * st + 8 + 4 * hh, c, lane));
                }
        if (__builtin_amdgcn_readfirstlane(kt >= 2 * qt)) {
            asm volatile("");
            const int qpos = q0 + r;
#pragma unroll
            for (int k2 = 0; k2 < 2; ++k2)
#pragma unroll
                for (int i = 0; i < 16; ++i) { const int kpos = 64 * kt + 32 * k2 + crow(i, hh); if (kpos > qpos) s[k2][i] = -INFINITY; }
        }
        float mx = s[0][0];
#pragma unroll
        for (int k2 = 0; k2 < 2; ++k2)
#pragma unroll
            for (int i = 0; i < 16; ++i) mx = fmaxf(mx, s[k2][i]);
        mx = xhalf_max(mx);
        if (__any(mx > m + 8.0f)) {
            asm volatile("");
            const float mn = fmaxf(m, mx);
            const float alpha = fast_exp2(m - mn);
            l *= alpha;
            m = mn;
#pragma unroll
            for (int c = 0; c < 2; ++c)
#pragma unroll
                for (int i = 0; i < 16; ++i) o[c][i] *= alpha;
        }
        f32x2 ps2 = {0.f, 0.f};
        const f32x2 m2 = {m, m};
#pragma unroll
        for (int k2 = 0; k2 < 2; ++k2)
#pragma unroll
            for (int i = 0; i < 16; i += 2) {
                f32x2 x = {s[k2][i], s[k2][i + 1]};
                x = x - m2;
                f32x2 e; e[0] = fast_exp2(x[0]); e[1] = fast_exp2(x[1]);
                s[k2][i] = e[0]; s[k2][i + 1] = e[1];
                ps2 += e;
            }
        l += ps2[0] + ps2[1];
        TR_WAIT();
#pragma unroll
        for (int k2 = 0; k2 < 2; ++k2)
#pragma unroll
            for (int st = 0; st < 2; ++st) {
                const bf16x8 pb = pack_step(s[k2], st);
#pragma unroll
                for (int c = 0; c < 2; ++c) o[c] = MFMA32(cat44(vt[k2][st][c][0], vt[k2][st][c][1]), pb, o[c]);
            }
    }
    const float inv = 1.0f / xhalf_sum(l);
    bf16_t* dst = (bf16_t*)((char*)p.out + OUT_OMLA) + tokq * 512 + h * 64 + 4 * hh;
#pragma unroll
    for (int c = 0; c < 2; ++c)
#pragma unroll
        for (int g = 0; g < 4; ++g)
            *(u32x2*)(dst + 32 * c + 8 * g) = pack4(o[c][4 * g] * inv, o[c][4 * g + 1] * inv, o[c][4 * g + 2] * inv, o[c][4 * g + 3] * inv);
}

DI void dil_unit(const Params& p, char* lds, int g, int b, int h, int rr, int lb) {
    char* ws = p.ws;
    const int t = otid(), lane = t & 63, wv = t >> 6, r = lane & 31, hh = lane >> 5;
    const int d = (g == 0) ? 1 : (g == 1 ? 4 : 16);
    const bf16_t* PJ = (const bf16_t*)(ws + OFF_PROJ);
    const size_t tokb = (size_t)b * SEQ_L;
    char* kimg = lds;
    char* vimg = lds + 32768;
    __syncthreads();
    {
        const int c = t & 7;
#pragma unroll
        for (int half = 0; half < 2; ++half) {
            u32x4 kk[4], vv[4];
#pragma unroll
            for (int i = 0; i < 4; ++i) {
                const int key = (t >> 3) + 32 * (4 * half + i);
                const int lk = 128 * lb - 128 + key;
                if (lk >= 0) {
                    const size_t tk = tokb + (size_t)lk * d + rr;
                    kk[i] = ldu4(PJ + tk * INC + 1184 + h * 64 + 8 * c);
                    vv[i] = ldu4(PJ + tk * INC + 1696 + h * 64 + 8 * c);
                } else { kk[i] = (u32x4){0u, 0u, 0u, 0u}; vv[i] = (u32x4){0u, 0u, 0u, 0u}; }
            }
#pragma unroll
            for (int i = 0; i < 4; ++i) {
                const int key = (t >> 3) + 32 * (4 * half + i);
                *(u32x4*)(kimg + sw_off(key, c)) = kk[i];
                *(u32x4*)(vimg + v128_off(key, c)) = vv[i];
            }
        }
    }
    const int lq = 128 * lb + 32 * wv + r;
    const size_t tokq = tokb + (size_t)lq * d + rr;
    bf16x8 qf[4];
#pragma unroll
    for (int s = 0; s < 4; ++s) qf[s] = ld16(PJ + tokq * INC + 672 + h * 64 + 16 * s + 8 * hh);
    __syncthreads();
    const float slope2 = exp2f(-(float)(h + 1)) * (float)d * LOG2E;
    const int u0 = (lb == 0) ? (4 - wv) : 0;
    f32x16 o[2]; o[0] = zero16(); o[1] = zero16();
    float m = -INFINITY, lsum = 0.f;
    const unsigned vb = (unsigned)(uintptr_t)vimg;
#pragma unroll 1
    for (int u = u0; u < 5; ++u) {
        const int rowb = 32 * (wv + u);
        f32x16 s = zero16();
#pragma unroll
        for (int ss = 0; ss < 4; ++ss) s = MFMA32(ld16(kimg + sw_off(rowb + r, 2 * ss + hh)), qf[ss], s);
        const int dbase = r + 128 - 32 * u;
        float mx = -INFINITY;
#pragma unroll
        for (int i = 0; i < 16; ++i) {
            const int dist = dbase - crow(i, hh);
            const bool valid = (dist >= 0) && (dist <= 128);
            const float v = valid ? (s[i] - slope2 * (float)dist) : -INFINITY;
            s[i] = v;
            mx = fmaxf(mx, v);
        }
        mx = xhalf_max(mx);
        const float mn = fmaxf(m, mx);
        const float alpha = fast_exp2(m - mn);
        float ps = 0.f;
#pragma unroll
        for (int i = 0; i < 16; ++i) { const float e = fast_exp2(s[i] - mn); s[i] = e; ps += e; }
        lsum = lsum * alpha + ps;
        m = mn;
#pragma unroll
        for (int c = 0; c < 2; ++c)
#pragma unroll
            for (int i = 0; i < 16; ++i) o[c][i] *= alpha;
#pragma unroll
        for (int st = 0; st < 2; ++st) {
            const bf16x8 pb = pack_step(s, st);
#pragma unroll
            for (int c = 0; c < 2; ++c) {
                const s16x4 lo = tr_read(v128_tr_addr(vb, rowb + 16 * st + 4 * hh, c, lane));
                const s16x4 hi = tr_read(v128_tr_addr(vb, rowb + 16 * st + 8 + 4 * hh, c, lane));
                o[c] = MFMA32(cat44(lo, hi), pb, o[c]);
            }
        }
    }
    const float ltot = xhalf_sum(lsum);
    const float mx = m;
    const float inv = 1.0f / ltot;
    bf16_t* dst = (bf16_t*)((char*)p.out + OUT_ODIL) + ((size_t)g * T_TOK + tokq) * 512 + h * 64 + 4 * hh;
#pragma unroll
    for (int c = 0; c < 2; ++c)
#pragma unroll
        for (int gg = 0; gg < 4; ++gg)
            *(u32x2*)(dst + 32 * c + 8 * gg) = pack4(o[c][4 * gg] * inv, o[c][4 * gg + 1] * inv, o[c][4 * gg + 2] * inv, o[c][4 * gg + 3] * inv);
    if (hh == 0) ((float*)(ws + OFF_LSE))[((size_t)g * T_TOK + tokq) * 8 + h] = mx + __log2f(ltot);
}

DI void phase_p3(const Params& p, char* lds, int which = 3) {
    const int xg = (int)blockIdx.x & 7, nloc = (vgrid() >> 3), loc = ((int)blockIdx.x >> 3) * 2 + vhalf();
    if (which & 1) for (int i = loc; i < 64; i += nloc) {
        const int bh = xg * 4 + (i >> 4), pr = i & 15, b = bh >> 3, h = bh & 7;
#pragma unroll 1
        for (int rep = 0; rep < 2; ++rep) mla_unit(p, lds, b, h, rep ? pr : 31 - pr);
    }
    if (which & 2) for (int i = loc; i < 384; i += nloc) {
        const int bh = xg * 4 + i / 96, k96 = i % 96, g = k96 >> 5, k = k96 & 31, b = bh >> 3, h = bh & 7;
        int rr, lb;
        if (g == 0) { rr = 0; lb = k; } else if (g == 1) { rr = k >> 3; lb = k & 7; } else { rr = k >> 1; lb = k & 1; }
        dil_unit(p, lds, g, b, h, rr, lb);
    }
}

DI void quant_rows4(const Params& p, int it, int wv, int lane) {
    char* ws = p.ws;
    const int ncv = 4096;
    const bool isv = it >= ncv;
    const size_t row = (size_t)(isv ? it - ncv : it) * 4 + wv;
    const float* src = (isv ? p.peer_v : p.peer_u) + row * 1024 + 16 * lane;
    f32x4 v[4]; float am = 0.f;
#pragma unroll
    for (int i = 0; i < 4; ++i) { v[i] = *(const f32x4*)(src + 4 * i); am = fmaxf(am, fmaxf(fmaxf(fabsf(v[i][0]), fabsf(v[i][1])), fmaxf(fabsf(v[i][2]), fabsf(v[i][3])))); }
#pragma unroll
    for (int o = 32; o; o >>= 1) am = fmaxf(am, __shfl_xor(am, o));
    const float sc = (am > 0.f) ? am * (1.0f / 127.0f) : 1.0f;
    const float inv = 1.0f / sc;
    const int bias = isv ? 128 : 0;
    u32x4 o;
#pragma unroll
    for (int i = 0; i < 4; ++i) {
        unsigned w = 0u;
#pragma unroll
        for (int e = 0; e < 4; ++e) { const int q = (int)rintf(v[i][e] * inv) + bias; w |= ((unsigned)q & 0xFFu) << (8 * e); }
        o[i] = w;
    }
    *(u32x4*)(ws + (isv ? OFF_VQ : OFF_UQ) + row * 1024 + 16 * lane) = o;
    if (lane == 0) ((float*)(ws + (isv ? OFF_SV : OFF_SU)))[row] = sc;
}

DI void phase_p35(const Params& p, char* lds) {
    char* ws = p.ws;
    const int t = otid(), lane = t & 63, wv = t >> 6;
    const int ntok = T_TOK / 4;
    for (int item = vbid(); item < ntok; item += vgrid()) {
        {
            const size_t tok = (size_t)item * 4 + wv;
            const int head = lane >> 3;
            const float* LS = (const float*)(ws + OFF_LSE);
            const float l0 = LS[tok * 8 + head], l1 = LS[((size_t)T_TOK + tok) * 8 + head], l2 = LS[((size_t)2 * T_TOK + tok) * 8 + head];
            const float mx = fmaxf(l0, fmaxf(l1, l2));
            float w0 = fast_exp2(l0 - mx), w1 = fast_exp2(l1 - mx), w2 = fast_exp2(l2 - mx);
            const float wi = 1.0f / (w0 + w1 + w2);
            w0 *= wi; w1 *= wi; w2 *= wi;
            const bf16_t* OD = (const bf16_t*)((const char*)p.out + OUT_ODIL);
            const u32x4 a0 = ldu4(OD + tok * 512 + 8 * lane), a1 = ldu4(OD + ((size_t)T_TOK + tok) * 512 + 8 * lane),
                        a2 = ldu4(OD + ((size_t)2 * T_TOK + tok) * 512 + 8 * lane);
            const u32x4 am = ldu4((const bf16_t*)((const char*)p.out + OUT_OMLA) + tok * 512 + 8 * lane);
            float od[8], om[8]; float sd = 0.f, sm = 0.f;
#pragma unroll
            for (int e = 0; e < 4; ++e) {
                od[2 * e] = w0 * bf_lo(a0[e]) + w1 * bf_lo(a1[e]) + w2 * bf_lo(a2[e]);
                od[2 * e + 1] = w0 * bf_hi(a0[e]) + w1 * bf_hi(a1[e]) + w2 * bf_hi(a2[e]);
                om[2 * e] = bf_lo(am[e]); om[2 * e + 1] = bf_hi(am[e]);
                sd += od[2 * e] * od[2 * e] + od[2 * e + 1] * od[2 * e + 1];
                sm += om[2 * e] * om[2 * e] + om[2 * e + 1] * om[2 * e + 1];
            }
#pragma unroll
            for (int o = 32; o; o >>= 1) { sd += __shfl_xor(sd, o); sm += __shfl_xor(sm, o); }
            const float rd = rsqrtf(sd * (1.0f / 512.0f) + 1e-6f), rm = rsqrtf(sm * (1.0f / 512.0f) + 1e-6f);
            const f32x4 gm0 = *(const f32x4*)(p.gn_mla + 8 * lane), gm1 = *(const f32x4*)(p.gn_mla + 8 * lane + 4);
            const f32x4 gd0 = *(const f32x4*)(p.gn_dil + 8 * lane), gd1 = *(const f32x4*)(p.gn_dil + 8 * lane + 4);
            u32x4 o1, o2;
            o1[0] = pack2(om[0] * rm * gm0[0], om[1] * rm * gm0[1]); o1[1] = pack2(om[2] * rm * gm0[2], om[3] * rm * gm0[3]);
            o1[2] = pack2(om[4] * rm * gm1[0], om[5] * rm * gm1[1]); o1[3] = pack2(om[6] * rm * gm1[2], om[7] * rm * gm1[3]);
            o2[0] = pack2(od[0] * rd * gd0[0], od[1] * rd * gd0[1]); o2[1] = pack2(od[2] * rd * gd0[2], od[3] * rd * gd0[3]);
            o2[2] = pack2(od[4] * rd * gd1[0], od[5] * rd * gd1[1]); o2[3] = pack2(od[6] * rd * gd1[2], od[7] * rd * gd1[3]);
            bf16_t* MX = (bf16_t*)(ws + OFF_MIXED) + tok * 1024;
            *(u32x4*)(MX + 8 * lane) = o1;
            *(u32x4*)(MX + 512 + 8 * lane) = o2;
        }
    }
}

DI unsigned m512_off(int row, int chunk) { return (unsigned)(row * 512 + ((chunk ^ (row & 15)) << 4)); }
DI unsigned v512_off(int row, int chunk) { return (unsigned)(row * 512 + ((chunk ^ ((row & 3) << 2)) << 4)); }
DI void memattn_unit(const Params& p, char* lds, int b, int h, int tt) {
    char* ws = p.ws;
    const int t = otid(), lane = t & 63, wv = t >> 6, r = lane & 31, hh = lane >> 5;
    const int qg = wv & 1, dh = wv >> 1;
    const bf16_t* QM = (const bf16_t*)(ws + OFF_QM);
    const bf16_t* KVM = (const bf16_t*)(ws + OFF_KVM);
    const size_t tokq = (size_t)b * SEQ_L + tt * 64 + 32 * qg + r;
    bf16x8 qf[16];
#pragma unroll
    for (int s = 0; s < 16; ++s) qf[s] = ld16(QM + tokq * 1024 + h * 256 + 16 * s + 8 * hh);
    f32x16 o[4];
#pragma unroll
    for (int c = 0; c < 4; ++c) o[c] = zero16();
    float m = -INFINITY, l = 0.f;
    const bf16_t* ksrc[4]; const bf16_t* vsrc[4];
#pragma unroll
    for (int i = 0; i < 4; ++i) {
        const int row = 2 * (wv + 4 * i) + (lane >> 5), pch = lane & 31;
        const size_t mrow = (size_t)b * 256 + row;
        ksrc[i] = KVM + mrow * 2048 + h * 256 + 8 * (pch ^ (row & 15));
        vsrc[i] = KVM + mrow * 2048 + 1024 + h * 256 + 8 * (pch ^ ((row & 3) << 2));
    }
    char* ldst = lds + wv * 1024 + lane * 16;
    auto stage_tile = [&](int kt, char* sb) {
#pragma unroll
        for (int i = 0; i < 4; ++i) { GLDS16(ksrc[i] + (size_t)kt * 32 * 2048, sb + i * 4096); GLDS16(vsrc[i] + (size_t)kt * 32 * 2048, sb + 16384 + i * 4096); }
    };
    __syncthreads();
    stage_tile(0, ldst);
    __syncthreads();
#pragma unroll 1
    for (int kt = 0; kt < 8; ++kt) {
        if (kt + 1 < 8) stage_tile(kt + 1, ldst + ((kt + 1) & 1) * 32768);
        const char* sb = lds + (kt & 1) * 32768;
        const unsigned vb = (unsigned)(uintptr_t)(sb + 16384);
        f32x16 s = zero16();
#pragma unroll
        for (int ss = 0; ss < 16; ++ss) s = MFMA32(ld16(sb + m512_off(r, 2 * ss + hh)), qf[ss], s);
        float mx = s[0];
#pragma unroll
        for (int i = 1; i < 16; ++i) mx = fmaxf(mx, s[i]);
        mx = xhalf_max(mx);
        const float mn = fmaxf(m, mx);
        const float alpha = fast_exp2(m - mn);
        float ps = 0.f;
#pragma unroll
        for (int i = 0; i < 16; ++i) { const float e = fast_exp2(s[i] - mn); s[i] = e; ps += e; }
        l = l * alpha + ps;
        m = mn;
#pragma unroll
        for (int c = 0; c < 4; ++c)
#pragma unroll
            for (int i = 0; i < 16; ++i) o[c][i] *= alpha;
        const int blk = (lane >> 4) & 1, qq = (lane & 15) >> 2, pp = lane & 3;
#pragma unroll
        for (int st = 0; st < 2; ++st) {
            const bf16x8 pb = pack_step(s, st);
#pragma unroll
            for (int c = 0; c < 4; ++c) {
                const int ch = 16 * dh + 4 * c + 2 * blk + (pp >> 1);
                const s16x4 lo = tr_read(vb + v512_off(16 * st + 4 * hh + qq, ch) + 8 * (pp & 1));
                const s16x4 hi = tr_read(vb + v512_off(16 * st + 8 + 4 * hh + qq, ch) + 8 * (pp & 1));
                o[c] = MFMA32(cat44(lo, hi), pb, o[c]);
            }
        }
        __syncthreads();
    }
    const float inv = 1.0f / xhalf_sum(l);
    bf16_t* dst = (bf16_t*)(ws + OFF_OM) + tokq * 1024 + h * 256 + 128 * dh + 4 * hh;
#pragma unroll
    for (int c = 0; c < 4; ++c)
#pragma unroll
        for (int g = 0; g < 4; ++g)
            *(u32x2*)(dst + 32 * c + 8 * g) = pack4(o[c][4 * g] * inv, o[c][4 * g + 1] * inv, o[c][4 * g + 2] * inv, o[c][4 * g + 3] * inv);
}

DI void phase_memattn(const Params& p, char* lds) {
    for (int item = vbid(); item < 1024; item += vgrid()) {
        const int b = item >> 8, h = (item >> 6) & 3, tt = item & 63;
        memattn_unit(p, lds, b, h, tt);
    }
}
DI unsigned f2sort(float f) { const unsigned b = __float_as_uint(f); return b ^ ((b & 0x80000000u) ? 0xFFFFFFFFu : 0x80000000u); }
DI float sort2f(unsigned u) { const unsigned b = (u & 0x80000000u) ? (u ^ 0x80000000u) : ~u; return __uint_as_float(b); }
DI void cswap(unsigned& a, unsigned& b) { const unsigned hi = max(a, b), lo = min(a, b); a = hi; b = lo; }

template <int LO, int N> struct BClean {
    template <int M> static DI void run(unsigned (&a)[M]) {
#pragma unroll
        for (int i = 0; i < N / 2; ++i) cswap(a[LO + i], a[LO + i + N / 2]);
        BClean<LO, N / 2>::run(a); BClean<LO + N / 2, N / 2>::run(a);
    }
};
template <int LO> struct BClean<LO, 1> { template <int M> static DI void run(unsigned (&)[M]) {} };
template <int LO, int N> struct BSort {
    template <int M> static DI void run(unsigned (&a)[M]) {
        BSort<LO, N / 2>::run(a); BSort<LO + N / 2, N / 2>::run(a);
#pragma unroll
        for (int i = 0; i < N / 2; ++i) cswap(a[LO + i], a[LO + N - 1 - i]);
        BClean<LO, N / 2>::run(a); BClean<LO + N / 2, N / 2>::run(a);
    }
};
template <int LO> struct BSort<LO, 1> { template <int M> static DI void run(unsigned (&)[M]) {} };
DI void merge_top16(unsigned (&a)[16], const unsigned (&b)[16]) {
#pragma unroll
    for (int i = 0; i < 16; ++i) a[i] = max(a[i], b[15 - i]);
    BClean<0, 16>::run(a);
}

DI void peer_top16(const bf16_t* __restrict__ keys_hp, const bf16_t* __restrict__ pq_row_hp, int r, int hh, unsigned (&top)[16]) {
    bf16x8 qf[8];
#pragma unroll
    for (int s = 0; s < 8; ++s) qf[s] = ld16(pq_row_hp + 16 * s + 8 * hh);
    unsigned cur[16];
#pragma unroll
    for (int kt = 0; kt < 4; ++kt) {
        f32x16 acc = zero16();
#pragma unroll
        for (int s = 0; s < 8; ++s) acc = MFMA32(ld16(keys_hp + (size_t)(32 * kt + r) * 128 + 16 * s + 8 * hh), qf[s], acc);
        unsigned k[16];
#pragma unroll
        for (int i = 0; i < 16; ++i) k[i] = (f2sort(acc[i]) & ~0x7Fu) | (unsigned)(32 * kt + crow(i, hh));
        BSort<0, 16>::run(k);
        if (kt == 0) {
#pragma unroll
            for (int i = 0; i < 16; ++i) cur[i] = k[i];
        } else merge_top16(cur, k);
    }
    unsigned r0[16], r1[16];
#pragma unroll
    for (int i = 0; i < 16; ++i) { auto rr = __builtin_amdgcn_permlane32_swap(cur[i], cur[i], false, false); r0[i] = rr[0]; r1[i] = rr[1]; }
#pragma unroll
    for (int i = 0; i < 16; ++i) top[i] = max(r0[i], r1[15 - i]);
    BClean<0, 16>::run(top);
}

DI void peer_select_unit(const Params& p, char* lds, int mt, int h) {
    char* ws = p.ws;
    const int t = otid(), lane = t & 63, wv = t >> 6, r = lane & 31, hh = lane >> 5;
    const size_t tok = (size_t)mt * 128 + 32 * wv + r;
    const bf16_t* KEYS = (const bf16_t*)(ws + OFF_KEYS);
    const bf16_t* PQ = (const bf16_t*)((const char*)p.out + OUT_PQ);
    unsigned tA[16], tB[16];
    peer_top16(KEYS + (size_t)(2 * h) * 16384, PQ + tok * 2048 + (2 * h) * 128, r, hh, tA);
    peer_top16(KEYS + (size_t)(2 * h + 1) * 16384, PQ + tok * 2048 + (2 * h + 1) * 128, r, hh, tB);
    float fA[16], fB[16];
#pragma unroll
    for (int i = 0; i < 16; ++i) { fA[i] = sort2f(tA[i] & ~0x7Fu); fB[i] = sort2f(tB[i] & ~0x7Fu); }
    unsigned* tab = (unsigned*)lds + wv * 1024;
    __syncthreads();
#pragma unroll
    for (int i = 0; i < 16; ++i) tab[i * 64 + lane] = (tA[i] & 0x7Fu) | ((tB[i] & 0x7Fu) << 16);
    unsigned c[64];
#pragma unroll
    for (int i = 0; i < 64; ++i) c[i] = 0u;
    {
        int n = 0;
#pragma unroll
        for (int a = 0; a < 16; ++a)
#pragma unroll
            for (int b = 0; b < 16; ++b)
                if ((a + 1) * (b + 1) <= 16) { c[n] = (f2sort(fA[a] + fB[b]) & ~0xFFu) | (unsigned)(a * 16 + b); ++n; }
    }
    unsigned g0[16], g1[16], g2[16], g3[16];
#pragma unroll
    for (int i = 0; i < 16; ++i) { g0[i] = c[i]; g1[i] = c[16 + i]; g2[i] = c[32 + i]; g3[i] = c[48 + i]; }
    BSort<0, 16>::run(g0); BSort<0, 16>::run(g1); BSort<0, 16>::run(g2); BSort<0, 16>::run(g3);
    merge_top16(g0, g1); merge_top16(g2, g3); merge_top16(g0, g2);
    float e[16]; float sum = 0.f;
    const float v0 = sort2f(g0[0] & ~0xFFu);
    unsigned ids[16];
#pragma unroll
    for (int i = 0; i < 16; ++i) {
        const float v = sort2f(g0[i] & ~0xFFu);
        e[i] = fast_exp2((v - v0) * LOG2E); sum += e[i];
        const unsigned a = (g0[i] >> 4) & 15u, b = g0[i] & 15u;
        const unsigned ia = tab[a * 64 + lane] & 0x7Fu, ib = (tab[b * 64 + lane] >> 16) & 0x7Fu;
        ids[i] = ia * 128u + ib;
    }
    const float inv = 1.0f / sum;
    if (hh == 0) {
        unsigned short* SID = (unsigned short*)(ws + OFF_SELID) + tok * 128 + h * 16;
        float* SG = (float*)(ws + OFF_SELG) + tok * 128 + h * 16;
        u32x4 w0, w1;
        w0[0] = ids[0] | (ids[1] << 16); w0[1] = ids[2] | (ids[3] << 16); w0[2] = ids[4] | (ids[5] << 16); w0[3] = ids[6] | (ids[7] << 16);
        w1[0] = ids[8] | (ids[9] << 16); w1[1] = ids[10] | (ids[11] << 16); w1[2] = ids[12] | (ids[13] << 16); w1[3] = ids[14] | (ids[15] << 16);
        *(u32x4*)SID = w0; *(u32x4*)(SID + 8) = w1;
#pragma unroll
        for (int q = 0; q < 4; ++q) *(f32x4*)(SG + 4 * q) = (f32x4){e[4 * q] * inv, e[4 * q + 1] * inv, e[4 * q + 2] * inv, e[4 * q + 3] * inv};
    }
}

DI void phase_select(const Params& p, char* lds) {
    for (int item = vbid(); item < 1024; item += vgrid()) peer_select_unit(p, lds, item >> 3, item & 7);
}

DI float gelu_erf(float a) { return 0.5f * a * (1.0f + erff(a * 0.70710678118654752f)); }
DI int dppi(int v, const int ctrl) { return v; }
#define DPP_I(v, ctrl) __builtin_amdgcn_update_dpp(0, (v), (ctrl), 0xf, 0xf, true)
DI float ub0(unsigned w) { return (float)(w & 0xFFu); }
DI float ub1(unsigned w) { return (float)((w >> 8) & 0xFFu); }
DI float ub2(unsigned w) { return (float)((w >> 16) & 0xFFu); }
DI float ub3(unsigned w) { return (float)(w >> 24); }

struct GBatch { u32x4 U[4], V[4]; float su[4], sv[4], gate[4]; };

DI void gather_load(GBatch& B, const char* __restrict__ ws, unsigned idpair, f32x2 gpair, int eb, int lane) {
#pragma unroll
    for (int j = 0; j < 4; ++j) {
        const int e = eb + j;
        const unsigned pr = __shfl(idpair, e >> 1);
        const unsigned id = (j & 1) ? (pr >> 16) : (pr & 0xFFFFu);
        const float g0 = __shfl(gpair[0], e >> 1), g1 = __shfl(gpair[1], e >> 1);
        B.gate[j] = (j & 1) ? g1 : g0;
        B.U[j] = ldu4(ws + OFF_UQ + (size_t)id * 1024 + 16 * lane);
        B.V[j] = ldu4(ws + OFF_VQ + (size_t)id * 1024 + 16 * lane);
        B.su[j] = ((const float*)(ws + OFF_SU))[id];
        B.sv[j] = ((const float*)(ws + OFF_SV))[id];
    }
}

DI void gather_compute(const GBatch& B, const unsigned (&qx)[4], float sx, float (&acc)[16], float& csum, int lane) {
    int pd[4];
#pragma unroll
    for (int j = 0; j < 4; ++j) {
        int d = 0;
#pragma unroll
        for (int q = 0; q < 4; ++q) d = __builtin_amdgcn_sdot4((int)B.U[j][q], (int)qx[q], d, false);
        pd[j] = d;
    }
    const bool b0 = lane & 1, b1 = lane & 2;
    const int kA = b0 ? pd[1] : pd[0], kB = b0 ? pd[3] : pd[2], sA = b0 ? pd[0] : pd[1], sB = b0 ? pd[2] : pd[3];
    const int qA = kA + DPP_I(sA, 0xB1), qB = kB + DPP_I(sB, 0xB1);
    const int kp = b1 ? qB : qA, sd = b1 ? qA : qB;
    int tot = kp + DPP_I(sd, 0x4E);
    tot += DPP_I(tot, 0x124);
    tot += DPP_I(tot, 0x128);
    tot += __builtin_amdgcn_ds_swizzle(tot, 0x401F);
    { auto rr = __builtin_amdgcn_permlane32_swap((unsigned)tot, (unsigned)tot, false, false); tot = (int)rr[0] + (int)rr[1]; }
    const int j3 = lane & 3;
    const float su_sel = (j3 == 0) ? B.su[0] : (j3 == 1 ? B.su[1] : (j3 == 2 ? B.su[2] : B.su[3]));
    const float ge = gelu_erf((float)tot * sx * su_sel);
#pragma unroll
    for (int j = 0; j < 4; ++j) {
        const float cf = B.gate[j] * B.sv[j] * __shfl(ge, j);
        csum += cf;
#pragma unroll
        for (int q = 0; q < 4; ++q) {
            const unsigned w = B.V[j][q];
            acc[4 * q] += cf * ub0(w); acc[4 * q + 1] += cf * ub1(w); acc[4 * q + 2] += cf * ub2(w); acc[4 * q + 3] += cf * ub3(w);
        }
    }
}

DI void gather_token(const Params& p, size_t tok, int lane, float* dst_base) {
    char* ws = p.ws;
    const bf16_t* hrow = (const bf16_t*)(ws + OFF_HB) + tok * 1024 + 16 * lane;
    float hv[16];
    {
        const u32x4 w0 = ldu4(hrow), w1 = ldu4(hrow + 8);
#pragma unroll
        for (int e = 0; e < 4; ++e) { hv[2 * e] = bf_lo(w0[e]); hv[2 * e + 1] = bf_hi(w0[e]); hv[8 + 2 * e] = bf_lo(w1[e]); hv[8 + 2 * e + 1] = bf_hi(w1[e]); }
    }
    float rs;
    {
        const float* SS = (const float*)(ws + OFF_SS2) + tok * 16;
        const f32x4 s0 = *(const f32x4*)SS, s1 = *(const f32x4*)(SS + 4), s2 = *(const f32x4*)(SS + 8), s3 = *(const f32x4*)(SS + 12);
        const float tot = (s0[0] + s0[1] + s0[2] + s0[3]) + (s1[0] + s1[1] + s1[2] + s1[3]) + (s2[0] + s2[1] + s2[2] + s2[3]) + (s3[0] + s3[1] + s3[2] + s3[3]);
        rs = rsqrtf(tot * (1.0f / 1024.0f) + 1e-6f);
    }
    float xf[16]; float am = 0.f;
#pragma unroll
    for (int i = 0; i < 4; ++i) {
        const f32x4 g = *(const f32x4*)(p.norm_ffn + 16 * lane + 4 * i);
#pragma unroll
        for (int e = 0; e < 4; ++e) { xf[4 * i + e] = hv[4 * i + e] * rs * g[e]; am = fmaxf(am, fabsf(xf[4 * i + e])); }
    }
#pragma unroll
    for (int o = 32; o; o >>= 1) am = fmaxf(am, __shfl_xor(am, o));
    const float sx = (am > 0.f) ? am * (1.0f / 127.0f) : 1.0f;
    const float isx = 1.0f / sx;
    unsigned qx[4];
#pragma unroll
    for (int i = 0; i < 4; ++i) {
        unsigned w = 0u;
#pragma unroll
        for (int e = 0; e < 4; ++e) w |= ((unsigned)(int)rintf(xf[4 * i + e] * isx) & 0xFFu) << (8 * e);
        qx[i] = w;
    }
    const unsigned idpair = *((const unsigned*)(ws + OFF_SELID) + tok * 64 + lane);
    const f32x2 gpair = *((const f32x2*)(ws + OFF_SELG) + tok * 64 + lane);
    float acc[16]; float csum = 0.f;
#pragma unroll
    for (int i = 0; i < 16; ++i) acc[i] = 0.f;
    GBatch B0, B1;
    gather_load(B0, ws, idpair, gpair, 0, lane);
#pragma unroll 1
    for (int eb = 0; eb < 128; eb += 8) {
        gather_load(B1, ws, idpair, gpair, eb + 4, lane);
        gather_compute(B0, qx, sx, acc, csum, lane);
        if (eb + 8 < 128) gather_load(B0, ws, idpair, gpair, eb + 8, lane);
        gather_compute(B1, qx, sx, acc, csum, lane);
    }
    float ss = 0.f;
#pragma unroll
    for (int i = 0; i < 16; ++i) { acc[i] = acc[i] - 128.0f * csum + hv[i]; ss += acc[i] * acc[i]; }
#pragma unroll
    for (int o = 32; o; o >>= 1) ss += __shfl_xor(ss, o);
    const float rf = rsqrtf(ss * (1.0f / 1024.0f) + 1e-6f);
    float* drow = dst_base + tok * 1024 + 16 * lane;
#pragma unroll
    for (int i = 0; i < 4; ++i) {
        const f32x4 n = *(const f32x4*)(p.norm_final + 16 * lane + 4 * i);
        *(f32x4*)(drow + 4 * i) = (f32x4){acc[4 * i] * rf * n[0], acc[4 * i + 1] * rf * n[1], acc[4 * i + 2] * rf * n[2], acc[4 * i + 3] * rf * n[3]};
    }
}

DI void phase_gather(const Params& p, bool dry = false) {
    const int lane = otid() & 63, wv = otid() >> 6;
    float* dst = dry ? (float*)(p.ws + OFF_A) : p.out;
    for (int item = vbid(); item < T_TOK / 4; item += vgrid()) gather_token(p, (size_t)item * 4 + wv, lane, dst);
}
constexpr int LDS_BYTES = 131072 + 1024;
constexpr int NPHASE = 12;
template <int PH> DI void run_phase(const Params& p, char* smem) {
    char* lds = smem + vhalf() * 65536;
    if (PH == 0) phase_prep(p, lds);
    else if (PH == 1) phase_p1(p, smem);
    else if (PH == 2) phase_p2(p, smem);
    else if (PH == 3) phase_p3(p, lds);
    else if (PH == 4) phase_p35(p, lds);
    else if (PH == 5) phase_resid<false>(p, smem, OFF_WT_OUT, OFF_MIXED, p.x, OFF_SS1);
    else if (PH == 6) phase_rowscale(p, smem, OFF_WT_MQ, 1024, (bf16_t*)(p.ws + OFF_QM), OFF_SS1, 0.0625f * LOG2E);
    else if (PH == 7) phase_memattn(p, lds);
    else if (PH == 8) phase_resid<true>(p, smem, OFF_WT_MO, OFF_OM, p.ws + OFF_HB, OFF_SS2);
    else if (PH == 9) phase_rowscale(p, smem, OFF_WT_PQ, 2048, (bf16_t*)((char*)p.out + OUT_PQ), OFF_SS2, 1.0f);
    else if (PH == 10) phase_select(p, lds);
    else if (PH == 11) phase_gather(p);
}

template <int PH> __global__ void __launch_bounds__(512, 2) k_phase(Params p) {
    __shared__ __attribute__((aligned(16))) char smem[LDS_BYTES];
    run_phase<PH>(p, smem);
}

static Params make_params(void* const* d_in, void* d_out, void* d_ws) {
    Params p;
    memset(&p, 0, sizeof(p));
    p.x = (const float*)d_in[0]; p.mem = (const float*)d_in[1]; p.norm_mix = (const float*)d_in[2]; p.w_in = (const float*)d_in[3];
    p.q_norm = (const float*)d_in[4]; p.kv_norm = (const float*)d_in[5]; p.w_uq = (const float*)d_in[6]; p.w_ukv = (const float*)d_in[7];
    p.gn_mla = (const float*)d_in[8]; p.gn_dil = (const float*)d_in[9]; p.w_out = (const float*)d_in[10]; p.norm_mem_q = (const float*)d_in[11];
    p.norm_mem_kv = (const float*)d_in[12]; p.w_mem_q = (const float*)d_in[13]; p.w_mem_kv = (const float*)d_in[14]; p.w_mem_o = (const float*)d_in[15];
    p.norm_ffn = (const float*)d_in[16]; p.peer_w_q = (const float*)d_in[17]; p.sub_keys = (const float*)d_in[18]; p.peer_u = (const float*)d_in[19];
    p.peer_v = (const float*)d_in[20]; p.norm_final = (const float*)d_in[21];
    p.out = (float*)d_out; p.ws = (char*)d_ws;
    for (int i = 0; i < 16; ++i) p.inv_freq[i] = 1.0f / powf(10000.0f, (float)(2 * i) / 32.0f);
    return p;
}
__global__ void __launch_bounds__(512, 2) k_mega(Params p) {
    __shared__ __attribute__((aligned(16))) char smem[LDS_BYTES + 16];
    volatile LAS unsigned* st = (volatile LAS unsigned*)(LAS char*)(smem + LDS_BYTES);
    if (threadIdx.x == 0) { st[0] = 0u; st[1] = 0u; st[2] = 0u; st[3] = 0u; }
    __syncthreads();
    const XcdBarrier xb = xcd_barrier_post((unsigned*)(p.ws + OFF_BAR), st);
#define RP(n) run_phase<n>(p, smem); xcd_barrier(xb);
    RP(0) RP(1) RP(2) RP(3) RP(4) RP(5) RP(6) RP(7) RP(8) RP(9) RP(10)
    run_phase<11>(p, smem);
}

extern "C" void kernel_launch(void* const* d_in, const int* in_sizes, int n_in, void* d_out, int out_size, void* d_ws, size_t ws_size,
                              hipStream_t stream) {
    static int grid_blocks = 0;
    if (!grid_blocks) {
        int dev = 0, cus = 0, per_cu = 0;
        (void)hipGetDevice(&dev);
        (void)hipDeviceGetAttribute(&cus, hipDeviceAttributeMultiprocessorCount, dev);
        (void)hipOccupancyMaxActiveBlocksPerMultiprocessor(&per_cu, k_mega, 512, 0);
        if (per_cu > 1) per_cu = 1;
        if (per_cu < 1) per_cu = 1;
        grid_blocks = cus * per_cu;
    }
    Params p = make_params(d_in, d_out, d_ws);
    (void)hipMemsetAsync((char*)d_ws + OFF_BAR, 0, XCD_BAR_WORDS * 4, stream);
    void* args[] = {&p};
    hipError_t e = hipLaunchCooperativeKernel((const void*)k_mega, dim3(grid_blocks), dim3(512), args, 0, stream);
    if (e != hipSuccess) fprintf(stderr, "cooperative launch failed: %s (grid %d)\n", hipGetErrorString(e), grid_blocks);
}
```

```cpp
#include <hip/hip_runtime.h>
#include <hip/hip_cooperative_groups.h>
#include <math.h>
#include <stdint.h>
#include <stdio.h>
#include <string.h>
#define DI __device__ __forceinline__
typedef unsigned short bf16_t;
typedef short bf16x8 __attribute__((ext_vector_type(8)));
typedef short s16x4 __attribute__((ext_vector_type(4)));
typedef float f32x16 __attribute__((ext_vector_type(16)));
typedef float f32x4 __attribute__((ext_vector_type(4)));
typedef float f32x2 __attribute__((ext_vector_type(2)));
typedef unsigned u32x4 __attribute__((ext_vector_type(4)));
typedef unsigned u32x2 __attribute__((ext_vector_type(2)));
typedef __bf16 bf16x2v __attribute__((ext_vector_type(2)));
#define LAS __attribute__((address_space(3)))
#define MFMA32(a, b, c) __builtin_amdgcn_mfma_f32_32x32x16_bf16((a), (b), (c), 0, 0, 0)

constexpr int T_TOK = 16384, SEQ_L = 4096, DM = 1024, INC = 2208;
constexpr float LOG2E = 1.4426950408889634f;

DI int otid() { int t = threadIdx.x & 255; asm volatile("" : "+v"(t)); return t; }
DI int vhalf() { return __builtin_amdgcn_readfirstlane((int)(threadIdx.x >> 8)); }
DI int vbid() { return (int)blockIdx.x * 2 + vhalf(); }
DI int vgrid() { return (int)gridDim.x * 2; }
DI unsigned pack2(float lo, float hi) { f32x2 f = {lo, hi}; return __builtin_bit_cast(unsigned, __builtin_convertvector(f, bf16x2v)); }
DI float bf_lo(unsigned u) { return __uint_as_float(u << 16); }
DI float bf_hi(unsigned u) { return __uint_as_float(u & 0xffff0000u); }
DI float bf2f(bf16_t v) { return __uint_as_float(((unsigned)v) << 16); }
DI int crow(int reg, int hh) { return (reg & 3) + 8 * (reg >> 2) + 4 * hh; }
DI f32x16 zero16() { f32x16 z;
#pragma unroll
    for (int i = 0; i < 16; ++i) z[i] = 0.f; return z; }
DI float xhalf_max(float v) { auto r = __builtin_amdgcn_permlane32_swap(__float_as_uint(v), __float_as_uint(v), false, false); return fmaxf(__uint_as_float(r[0]), __uint_as_float(r[1])); }
DI float xhalf_other(float v, int lane) { auto r = __builtin_amdgcn_permlane32_swap(__float_as_uint(v), __float_as_uint(v), false, false); return __uint_as_float((lane & 32) ? r[0] : r[1]); }
DI float xhalf_sum(float v) { auto r = __builtin_amdgcn_permlane32_swap(__float_as_uint(v), __float_as_uint(v), false, false); return __uint_as_float(r[0]) + __uint_as_float(r[1]); }
DI bf16x8 ld16(const void* p) { return *(const bf16x8*)p; }
DI u32x4 ldu4(const void* p) { return *(const u32x4*)p; }
DI float fast_exp2(float x) { return __builtin_amdgcn_exp2f(x); }
DI bf16x8 pack_step(const f32x16& x, int s) {
    u32x4 p;
    p[0] = pack2(x[8 * s + 0], x[8 * s + 1]); p[1] = pack2(x[8 * s + 2], x[8 * s + 3]);
    p[2] = pack2(x[8 * s + 4], x[8 * s + 5]); p[3] = pack2(x[8 * s + 6], x[8 * s + 7]);
    return __builtin_bit_cast(bf16x8, p);
}
DI s16x4 tr_read_a(unsigned lds_byte_addr) { s16x4 r; asm volatile("ds_read_b64_tr_b16 %0, %1" : "=v"(r) : "v"(lds_byte_addr)); return r; }
#define TR_WAIT() do { asm volatile("s_waitcnt lgkmcnt(0)" ::: "memory"); __builtin_amdgcn_sched_barrier(0); } while (0)
DI s16x4 tr_read(unsigned lds_byte_addr) {
    return __builtin_amdgcn_ds_read_tr16_b64_v4i16((LAS s16x4*)(uintptr_t)lds_byte_addr);
}

constexpr size_t MiB = 1ull << 20;
constexpr size_t OFF_BAR = 0;
constexpr size_t OFF_WT_IN = 65536;
constexpr size_t OFF_WT_UQ = OFF_WT_IN + 2304ull * 1024 * 2;
constexpr size_t OFF_WT_UKV = OFF_WT_UQ + 768ull * 384 * 2;
constexpr size_t OFF_WT_OUT = OFF_WT_UKV + 1024ull * 256 * 2;
constexpr size_t OFF_WT_MQ = OFF_WT_OUT + 1024ull * 1024 * 2;
constexpr size_t OFF_WT_MKV = OFF_WT_MQ + 1024ull * 1024 * 2;
constexpr size_t OFF_WT_MO = OFF_WT_MKV + 2048ull * 1024 * 2;
constexpr size_t OFF_WT_PQ = OFF_WT_MO + 1024ull * 1024 * 2;
constexpr size_t OFF_KEYS = OFF_WT_PQ + 2048ull * 1024 * 2;
constexpr size_t OFF_ROPE = OFF_KEYS + 16ull * 128 * 128 * 2;
constexpr size_t OFF_KR = OFF_ROPE + 2ull * 4096 * 16 * 4;
constexpr size_t OFF_LSE = OFF_KR + (size_t)T_TOK * 32 * 2;
constexpr size_t OFF_SS1 = OFF_LSE + 3ull * T_TOK * 8 * 4;
constexpr size_t OFF_SS2 = OFF_SS1 + (size_t)T_TOK * 16 * 4;
constexpr size_t OFF_MEMN = OFF_SS2 + (size_t)T_TOK * 16 * 4;
constexpr size_t OFF_SMALL_END = OFF_MEMN + 1024ull * 1024 * 2;
static_assert(OFF_SMALL_END <= 28 * MiB, "small region overflow");
constexpr size_t OFF_A = 28 * MiB;
constexpr size_t OFF_PROJ = OFF_A;
constexpr size_t OFF_UQ = 193 * MiB;
constexpr size_t OFF_VQ = 209 * MiB;
constexpr size_t OFF_SU = 243 * MiB;
constexpr size_t OFF_SV = OFF_SU + 65536;
constexpr size_t OUT_ODIL = 0;
constexpr size_t OUT_OMLA = 48 * MiB;
constexpr size_t OUT_PQ = 0;
constexpr size_t OFF_B = 97 * MiB;
constexpr size_t OFF_XN = OFF_B, OFF_QMLA = OFF_B, OFF_MIXED = OFF_B, OFF_QM = OFF_B;
constexpr size_t OFF_C = 129 * MiB;
constexpr size_t OFF_KVMLA = OFF_C, OFF_HB = OFF_C;
constexpr size_t OFF_D = 161 * MiB;
constexpr size_t OFF_OM = OFF_D;
constexpr size_t OFF_SELID = 225 * MiB;
constexpr size_t OFF_SELG = 229 * MiB;
constexpr size_t OFF_KVM = 237 * MiB;
constexpr size_t OFF_SSQ = 241 * MiB;
constexpr size_t WS_NEEDED = 244 * MiB;

struct Params {
    const float* x; const float* mem; const float* norm_mix; const float* w_in; const float* q_norm; const float* kv_norm;
    const float* w_uq; const float* w_ukv; const float* gn_mla; const float* gn_dil; const float* w_out; const float* norm_mem_q;
    const float* norm_mem_kv; const float* w_mem_q; const float* w_mem_kv; const float* w_mem_o; const float* norm_ffn;
    const float* peer_w_q; const float* sub_keys; const float* peer_u; const float* peer_v; const float* norm_final;
    float* out; char* ws;
    float inv_freq[16];
    int prof; int pad_;
};
#define XB_TMO      128
#define XB_XCNT(j)  (256  + 64 * (j))
#define XB_XSUB(j)  (1280 + 64 * (j))
#define XB_XGEN(j)  (2304 + 64 * (j))
#define XB_TOP      3328
#define XB_TOPGEN   3392
#define XCD_BAR_WORDS 3456
#define XB_SPIN_CAP (1u << 20)
DI unsigned xb_ld(unsigned* p) { return __hip_atomic_load(p, __ATOMIC_RELAXED, __HIP_MEMORY_SCOPE_AGENT); }
DI unsigned xb_add(unsigned* p, unsigned v) { return __hip_atomic_fetch_add(p, v, __ATOMIC_RELAXED, __HIP_MEMORY_SCOPE_AGENT); }
DI unsigned xb_xcc_id() { return (unsigned)__builtin_amdgcn_s_getreg((3 << 11) | 20) & 0xFu; }
#define XB_SPIN(cond, bar) do { unsigned _sp = 0; while (cond) { __builtin_amdgcn_s_sleep(1); \
    if ((++_sp & 255u) == 0u) { if (xb_ld(&(bar)[XB_TMO])) break; if (_sp > XB_SPIN_CAP) { atomicAdd(&(bar)[XB_TMO], 1u); break; } } } } while (0)
struct XcdBarrier { unsigned* bar; unsigned x; volatile LAS unsigned* st; };
DI XcdBarrier xcd_barrier_post(unsigned* bar, volatile LAS unsigned* st) {
    XcdBarrier b; b.bar = bar; b.x = xb_xcc_id(); b.st = st;
    if (threadIdx.x == 0) (void)xb_add(&bar[XB_XCNT(b.x)], 1u);
    return b;
}
DI void xcd_barrier_complete(unsigned* bar, unsigned x, unsigned& nloc, unsigned& nx) {
    const unsigned G = gridDim.x * gridDim.y * gridDim.z;
    unsigned sum, cnt, mine, sp = 0u;
    for (;;) {
        sum = 0u; cnt = 0u; mine = 0u;
#pragma unroll
        for (unsigned j = 0; j < 16; ++j) { const unsigned c = xb_ld(&bar[XB_XCNT(j)]); sum += c; cnt += (c > 0u) ? 1u : 0u; mine = (j == x) ? c : mine; }
        if (sum == G) break;
        __builtin_amdgcn_s_sleep(1);
        if ((++sp & 255u) == 0u) { if (xb_ld(&bar[XB_TMO])) break; if (sp > XB_SPIN_CAP) { atomicAdd(&bar[XB_TMO], 1u); break; } }
    }
    nloc = mine > 0u ? mine : 1u; nx = cnt > 0u ? cnt : 1u;
}
DI void xcd_barrier(const XcdBarrier& b) {
    asm volatile("s_waitcnt vmcnt(0)" ::: "memory");
    __syncthreads();
    if (threadIdx.x == 0) {
        unsigned* bar = b.bar;
        __builtin_amdgcn_s_waitcnt(0);
        unsigned nloc = b.st[0], nx = b.st[1];
        if (nloc == 0u) { xcd_barrier_complete(bar, b.x, nloc, nx); b.st[0] = nloc; b.st[1] = nx; }
        const unsigned old = xb_add(&bar[XB_XSUB(b.x)], 1u);
        const unsigned gen = old / nloc;
        if (old + 1u == (gen + 1u) * nloc) {
            __builtin_amdgcn_fence(__ATOMIC_RELEASE, "agent");
            asm volatile("s_waitcnt vmcnt(0)" ::: "memory");
            const unsigned og = xb_add(&bar[XB_TOP], 1u);
            const unsigned tg = og / nx;
            if (og + 1u == (tg + 1u) * nx) xb_add(&bar[XB_TOPGEN], 1u);
            else XB_SPIN(xb_ld(&bar[XB_TOPGEN]) == tg, bar);
            __builtin_amdgcn_fence(__ATOMIC_ACQUIRE, "agent");
            xb_add(&bar[XB_XGEN(b.x)], 1u);
            asm volatile("s_waitcnt vmcnt(0)" ::: "memory");
        } else {
            XB_SPIN(xb_ld(&bar[XB_XGEN(b.x)]) == gen, bar);
            __builtin_amdgcn_fence(__ATOMIC_ACQUIRE, "agent");
            asm volatile("s_waitcnt vmcnt(0)" ::: "memory");
        }
    }
    __syncthreads();
}
DI void transpose_tile(const float* __restrict__ W, int K, int N, const float* __restrict__ g, bf16_t* __restrict__ Wt, int kt, int nt, char* lds, bool valid) {
    float* sm = (float*)lds;
    const int t = otid();
    const int k0 = kt * 64, n0 = nt * 64;
    __syncthreads();
#pragma unroll
    for (int i = 0; i < 16; ++i) {
        const int id = t + 256 * i, k = id >> 6, n = id & 63;
        float v = 0.f;
        if (valid && n0 + n < N) { v = W[(size_t)(k0 + k) * N + n0 + n]; if (g) v *= g[k0 + k]; }
        sm[k * 65 + n] = v;
    }
    __syncthreads();
    const int n = t >> 2, kc = (t & 3) * 16;
    u32x4 o0, o1;
    o0[0] = pack2(sm[(kc + 0) * 65 + n], sm[(kc + 1) * 65 + n]); o0[1] = pack2(sm[(kc + 2) * 65 + n], sm[(kc + 3) * 65 + n]);
    o0[2] = pack2(sm[(kc + 4) * 65 + n], sm[(kc + 5) * 65 + n]); o0[3] = pack2(sm[(kc + 6) * 65 + n], sm[(kc + 7) * 65 + n]);
    o1[0] = pack2(sm[(kc + 8) * 65 + n], sm[(kc + 9) * 65 + n]); o1[1] = pack2(sm[(kc + 10) * 65 + n], sm[(kc + 11) * 65 + n]);
    o1[2] = pack2(sm[(kc + 12) * 65 + n], sm[(kc + 13) * 65 + n]); o1[3] = pack2(sm[(kc + 14) * 65 + n], sm[(kc + 15) * 65 + n]);
    bf16_t* dst = Wt + (size_t)(n0 + n) * K + k0 + kc;
    if (valid) { *(u32x4*)dst = o0; *(u32x4*)(dst + 8) = o1; }
}

DI void rmsnorm_row_bf16(const float* __restrict__ in, const float* __restrict__ g, bf16_t* __restrict__ out, int lane) {
    f32x4 v[4]; float ss = 0.f;
#pragma unroll
    for (int i = 0; i < 4; ++i) { v[i] = *(const f32x4*)(in + 4 * lane + 256 * i); ss += v[i][0] * v[i][0] + v[i][1] * v[i][1] + v[i][2] * v[i][2] + v[i][3] * v[i][3]; }
#pragma unroll
    for (int o = 32; o; o >>= 1) ss += __shfl_xor(ss, o);
    const float rs = rsqrtf(ss * (1.0f / 1024.0f) + 1e-6f);
#pragma unroll
    for (int i = 0; i < 4; ++i) {
        const f32x4 gg = *(const f32x4*)(g + 4 * lane + 256 * i);
        u32x2 o; o[0] = pack2(v[i][0] * rs * gg[0], v[i][1] * rs * gg[1]); o[1] = pack2(v[i][2] * rs * gg[2], v[i][3] * rs * gg[3]);
        *(u32x2*)(out + 4 * lane + 256 * i) = o;
    }
}

struct TrJob { const float* W; const float* g; size_t off; int K, N, Npad; };

DI void phase_prep(const Params& p, char* lds) {
    char* ws = p.ws;
    const int t = otid(), lane = t & 63, wv = t >> 6;
    const int c0 = 576, c1 = c0 + 72, c2 = c1 + 64, c3 = c2 + 256, c4 = c3 + 256, c5 = c4 + 512, c6 = c5 + 256, c7 = c6 + 512;
    const int nrow = (T_TOK + 1024) / 4;
    const int nkeys = 128, nrope = 256;
    const int total = c7 + nrow + nkeys + nrope;
    for (int k = 0; k < (c7 + vgrid() - 1) / vgrid(); ++k) {
        const int raw = vbid() + k * vgrid();
        const bool valid = raw < c7;
        const int item = valid ? raw : 0;
        const float* W; const float* g; size_t off; int K, N, Npad, local;
        if (item < c0)      { W = p.w_in;     g = nullptr;      off = OFF_WT_IN;  K = 1024; N = 2208; Npad = 2304; local = item; }
        else if (item < c1) { W = p.w_uq;     g = p.q_norm;     off = OFF_WT_UQ;  K = 384;  N = 768;  Npad = 768;  local = item - c0; }
        else if (item < c2) { W = p.w_ukv;    g = p.kv_norm;    off = OFF_WT_UKV; K = 256;  N = 1024; Npad = 1024; local = item - c1; }
        else if (item < c3) { W = p.w_out;    g = nullptr;      off = OFF_WT_OUT; K = 1024; N = 1024; Npad = 1024; local = item - c2; }
        else if (item < c4) { W = p.w_mem_q;  g = p.norm_mem_q; off = OFF_WT_MQ;  K = 1024; N = 1024; Npad = 1024; local = item - c3; }
        else if (item < c5) { W = p.w_mem_kv; g = nullptr;      off = OFF_WT_MKV; K = 1024; N = 2048; Npad = 2048; local = item - c4; }
        else if (item < c6) { W = p.w_mem_o;  g = nullptr;      off = OFF_WT_MO;  K = 1024; N = 1024; Npad = 1024; local = item - c5; }
        else                { W = p.peer_w_q; g = p.norm_ffn;   off = OFF_WT_PQ;  K = 1024; N = 2048; Npad = 2048; local = item - c6; }
        const int ntn = Npad / 64;
        transpose_tile(W, K, N, g, (bf16_t*)(ws + off), local / ntn, local % ntn, lds, valid);
    }
    for (int item = c7 + vbid(); item < total; item += vgrid()) {
        if (item < c7 + nrow) {
            const int row = (item - c7) * 4 + wv;
            if (row < T_TOK) rmsnorm_row_bf16(p.x + (size_t)row * 1024, p.norm_mix, (bf16_t*)(ws + OFF_XN) + (size_t)row * 1024, lane);
            else rmsnorm_row_bf16(p.mem + (size_t)(row - T_TOK) * 1024, p.norm_mem_kv, (bf16_t*)(ws + OFF_MEMN) + (size_t)(row - T_TOK) * 1024, lane);
        } else if (item < c7 + nrow + nkeys) {
            const int idx = ((item - c7 - nrow) * 256 + t) * 8;
            const f32x4 a = *(const f32x4*)(p.sub_keys + idx), b = *(const f32x4*)(p.sub_keys + idx + 4);
            u32x4 o; o[0] = pack2(a[0], a[1]); o[1] = pack2(a[2], a[3]); o[2] = pack2(b[0], b[1]); o[3] = pack2(b[2], b[3]);
            *(u32x4*)((bf16_t*)(ws + OFF_KEYS) + idx) = o;
        } else {
            const int idx = (item - c7 - nrow - nkeys) * 256 + t;
            const int s = idx >> 4, i = idx & 15;
            const float ang = (float)s * p.inv_freq[i];
            const double a = (double)ang;
            const double twopi = 6.283185307179586476925;
            const float rf = (float)(a - twopi * rint(a / twopi));
            float* cs = (float*)(ws + OFF_ROPE);
            cs[idx] = cosf(rf); cs[65536 + idx] = sinf(rf);
        }
    }
}
namespace pg8 {
#define PG8_LAS __attribute__((address_space(3)))
typedef unsigned short bf16_t;
typedef short bf16x8 __attribute__((ext_vector_type(8)));
typedef float f32x4 __attribute__((ext_vector_type(4)));
typedef unsigned u32x4 __attribute__((ext_vector_type(4)));
constexpr int BM = 256, BK = 64, HALF = 128, HTB = HALF * BK * 2  , STAGE_BYTES = 8 * HTB, NXCD = 8, WGM = 8;

__host__ __device__ __forceinline__ int lds_byte(int r, int c) { const int st = (r >> 4) * 2 + (c >> 5), rr = r & 15, cc = c & 31, ob = rr * 64 + cc * 2; return st * 1024 + (ob ^ (((ob >> 9) & 1) << 5)); }
__host__ __device__ __forceinline__ void stage_rc(int b, int& R, int& C) { const int st = b / 1024, sb = b % 1024, swz = sb ^ (((sb >> 9) & 1) << 5); R = (st >> 1) * 16 + swz / 64; C = (st & 1) * 32 + (swz % 64) / 2; }
__host__ __device__ __forceinline__ int perm32(int rho) { const int n = rho >> 4, i = rho & 15; return 8 * (i >> 2) + 4 * n + (i & 3); }

struct Unit { int pm, pn; };
struct Gemm { const bf16_t* A; const bf16_t* Bt; int M, N, K, lda; };

struct StaticOrder {
    int nM, nN, nwg, G, c;
    __host__ __device__ void init(int M, int N, int G_, int c_) { nM = M / BM; nN = N / BM; nwg = nM * nN; G = G_; c = c_; }
    __host__ __device__ bool next(int i, Unit& u) const {
        const long L = (long)i * G + c; if (L >= nwg) return false;
        int wgid = (int)L; { const int q = nwg / NXCD, r = nwg % NXCD, xcd = wgid % NXCD, off = wgid / NXCD; wgid = (xcd < r ? xcd * (q + 1) : r * (q + 1) + (xcd - r) * q) + off; }
        const int nig = WGM * nN, gid = wgid / nig, fm = gid * WGM, gsz = (nM - fm) < WGM ? (nM - fm) : WGM;
        u.pm = fm + ((wgid % nig) % gsz); u.pn = (wgid % nig) / gsz; return true;
    }
    __device__ __forceinline__ void a_ready(const Unit&) const {}
    __device__ __forceinline__ void done(const Unit&) const {}
};

template <class Epi, class Sched, bool ALIGN_EPI = false, bool SP2 = false>
__device__ __forceinline__ void gemm_phase(PG8_LAS unsigned char* lds, const Gemm g, const Sched& S, const Epi& E) {
    int tid_ = threadIdx.x; asm volatile("" : "+v"(tid_));
    const int tid = tid_, wid = __builtin_amdgcn_readfirstlane(tid >> 6), lane = tid & 63, wr = wid >> 2, wc = wid & 3, fr = lane & 15, fq = lane >> 4;
    const int K = g.K, nt = K / BK, lda = g.lda;
    unsigned voffA[2], voffB[2];
#pragma unroll
    for (int i = 0; i < 2; ++i) { int R, C; stage_rc(tid * 16 + i * 8192, R, C); const int Rb = Epi::PERM ? ((R & ~31) + perm32(R & 31)) : R;
        voffA[i] = (unsigned)(R * lda + C) * 2u; voffB[i] = (unsigned)(Rb * K + C) * 2u; }
    const size_t kstep = (size_t)(BK * 2);
    const size_t hstepB = (size_t)HALF * K * 2, hstepA = (size_t)HALF * lda * 2;
    const size_t tstepB = 2 * hstepB, tstepA = 2 * hstepA;
    const unsigned ldsw = (unsigned)wid * 1024u;
    const int aoff = lds_byte(wr * 64 + fr, fq * 8), boff = lds_byte(wc * 32 + fr, fq * 8);
#define PG8_SA(b, h) (((b) * 2 + (h)) * HTB)
#define PG8_SB(b, h) ((4 + (b) * 2 + (h)) * HTB)
#define PG8_STAGE(bufoff, gbase, voff) do { _Pragma("unroll") for (int _i = 0; _i < 2; ++_i) \
        __builtin_amdgcn_global_load_lds((const unsigned*)((const char*)(gbase) + (voff)[_i]), (PG8_LAS unsigned*)(lds + (bufoff) + ldsw + _i * 8192), 16, 0, 0); } while (0)
#define PG8_LDA(dst, b, h) do { _Pragma("unroll") for (int m = 0; m < 4; ++m) _Pragma("unroll") for (int k = 0; k < 2; ++k) dst[m][k] = *(const PG8_LAS bf16x8*)(lds + PG8_SA(b, h) + aoff + m * 2048 + k * 1024); } while (0)
#define PG8_LDB(dst, b, h) do { _Pragma("unroll") for (int n = 0; n < 2; ++n) _Pragma("unroll") for (int k = 0; k < 2; ++k) dst[n][k] = *(const PG8_LAS bf16x8*)(lds + PG8_SB(b, h) + boff + n * 2048 + k * 1024); } while (0)
#define PG8_MMA(ai, bj, At, Bt) do { __builtin_amdgcn_s_setprio(1); _Pragma("unroll") for (int m = 0; m < 4; ++m) _Pragma("unroll") for (int n = 0; n < 2; ++n) _Pragma("unroll") for (int k = 0; k < 2; ++k) \
        acc[ai][bj][m][n] = __builtin_amdgcn_mfma_f32_16x16x32_bf16(Bt[n][k], At[m][k], acc[ai][bj][m][n], 0, 0, 0); __builtin_amdgcn_s_setprio(0); } while (0)
#define PG8_WAIT_V(n) asm volatile("s_waitcnt vmcnt(" #n ")" ::: "memory")
#define PG8_WAIT_L(n) asm volatile("s_waitcnt lgkmcnt(" #n ")" ::: "memory")
#define PG8_BAR __builtin_amdgcn_s_barrier()
#define PG8_SCHED __builtin_amdgcn_sched_barrier(0)
    Unit cur, nxt; int ui = 0;
    if (!S.next(0, cur)) return;
    f32x4 acc[2][2][4][2];
#pragma unroll
    for (int a = 0; a < 2; ++a)
#pragma unroll
        for (int b = 0; b < 2; ++b)
#pragma unroll
            for (int m = 0; m < 4; ++m)
#pragma unroll
                for (int n = 0; n < 2; ++n) acc[a][b][m][n] = (f32x4){0.f, 0.f, 0.f, 0.f};
    bf16x8 At[4][2], B0[2][2], B1[2][2];
    const char* cA = (const char*)g.A + (size_t)cur.pm * tstepA; const char* cB = (const char*)g.Bt + (size_t)cur.pn * tstepB;
    S.a_ready(cur);
    if constexpr (SP2) {
        PG8_STAGE(PG8_SB(0, 0), cB, voffB); PG8_STAGE(PG8_SB(0, 1), cB + hstepB, voffB); PG8_STAGE(PG8_SA(0, 0), cA, voffA); PG8_STAGE(PG8_SA(0, 1), cA + hstepA, voffA);
        if (wr == 1) PG8_BAR;
        PG8_WAIT_V(2); PG8_BAR;
        PG8_STAGE(PG8_SB(1, 0), cB + kstep, voffB); PG8_STAGE(PG8_SA(1, 0), cA + kstep, voffA); PG8_STAGE(PG8_SB(1, 1), cB + hstepB + kstep, voffB);
        PG8_WAIT_V(6); PG8_BAR;
    } else {
        PG8_STAGE(PG8_SB(0, 0), cB, voffB); PG8_STAGE(PG8_SA(0, 0), cA, voffA); PG8_STAGE(PG8_SB(0, 1), cB + hstepB, voffB); PG8_STAGE(PG8_SA(0, 1), cA + hstepA, voffA);
        if (wr == 1) PG8_BAR;
        PG8_WAIT_V(4); PG8_BAR;
        PG8_STAGE(PG8_SB(1, 0), cB + kstep, voffB); PG8_STAGE(PG8_SA(1, 0), cA + kstep, voffA); PG8_STAGE(PG8_SB(1, 1), cB + hstepB + kstep, voffB);
        PG8_WAIT_V(6); PG8_BAR;
    }
    for (;;) {
        const bool has_next = S.next(ui + 1, nxt);
        const char* nA = has_next ? (const char*)g.A + (size_t)nxt.pm * tstepA : cA; const char* nB = has_next ? (const char*)g.Bt + (size_t)nxt.pn * tstepB : cB;
#pragma unroll 1
        for (int t = 0; t < nt; t += 2) {
            const bool last = (t == nt - 2);
            const char* a1 = cA + (size_t)(t + 1) * kstep;
            const char* a2 = last ? nA : cA + (size_t)(t + 2) * kstep; const char* b2 = last ? nB : cB + (size_t)(t + 2) * kstep;
            const char* a3 = a2 + kstep; const char* b3 = b2 + kstep;
            if (last && has_next) S.a_ready(nxt);
            if constexpr (SP2) {
            PG8_LDB(B0, 0, 0); PG8_LDB(B1, 0, 1); PG8_SCHED; PG8_LDA(At, 0, 0); PG8_STAGE(PG8_SA(1, 1), a1 + hstepA, voffA);
            PG8_WAIT_V(8); PG8_WAIT_L(0); PG8_BAR; PG8_MMA(0, 0, At, B0); PG8_MMA(0, 1, At, B1); PG8_BAR; PG8_SCHED;
            PG8_LDA(At, 0, 1); PG8_STAGE(PG8_SB(0, 0), b2, voffB); PG8_STAGE(PG8_SB(0, 1), b2 + hstepB, voffB); PG8_STAGE(PG8_SA(0, 0), a2, voffA);
            PG8_WAIT_V(8); PG8_WAIT_L(0); PG8_BAR; PG8_MMA(1, 0, At, B0); PG8_MMA(1, 1, At, B1); PG8_BAR; PG8_SCHED;
            PG8_LDB(B0, 1, 0); PG8_LDB(B1, 1, 1); PG8_SCHED; PG8_LDA(At, 1, 0); PG8_STAGE(PG8_SA(0, 1), a2 + hstepA, voffA);
            PG8_WAIT_V(8); PG8_WAIT_L(0); PG8_BAR; PG8_MMA(0, 0, At, B0); PG8_MMA(0, 1, At, B1); PG8_BAR; PG8_SCHED;
            PG8_LDA(At, 1, 1); PG8_STAGE(PG8_SB(1, 0), b3, voffB); PG8_STAGE(PG8_SB(1, 1), b3 + hstepB, voffB); PG8_STAGE(PG8_SA(1, 0), a3, voffA);
            PG8_WAIT_V(8); PG8_WAIT_L(0); PG8_BAR; PG8_MMA(1, 0, At, B0); PG8_MMA(1, 1, At, B1); PG8_BAR; PG8_SCHED;
            } else {
            PG8_LDB(B0, 0, 0); PG8_SCHED; PG8_LDA(At, 0, 0); PG8_STAGE(PG8_SA(1, 1), a1 + hstepA, voffA);
            PG8_WAIT_L(8); PG8_BAR; PG8_WAIT_L(0); PG8_MMA(0, 0, At, B0); PG8_BAR; PG8_SCHED;
            PG8_LDB(B1, 0, 1); PG8_STAGE(PG8_SB(0, 0), b2, voffB);
            PG8_BAR; PG8_WAIT_L(0); PG8_MMA(0, 1, At, B1); PG8_BAR;
            PG8_LDA(At, 0, 1); PG8_STAGE(PG8_SA(0, 0), a2, voffA);
            PG8_BAR; PG8_WAIT_L(0); PG8_MMA(1, 0, At, B0); PG8_BAR; PG8_SCHED;
            PG8_STAGE(PG8_SB(0, 1), b2 + hstepB, voffB);
            PG8_WAIT_V(6); PG8_BAR; PG8_MMA(1, 1, At, B1); PG8_BAR;
            PG8_LDB(B0, 1, 0); PG8_SCHED; PG8_LDA(At, 1, 0); PG8_STAGE(PG8_SA(0, 1), a2 + hstepA, voffA);
            PG8_WAIT_L(8); PG8_BAR; PG8_WAIT_L(0); PG8_MMA(0, 0, At, B0); PG8_BAR; PG8_SCHED;
            PG8_LDB(B1, 1, 1); PG8_STAGE(PG8_SB(1, 0), b3, voffB);
            PG8_BAR; PG8_WAIT_L(0); PG8_MMA(0, 1, At, B1); PG8_BAR;
            PG8_LDA(At, 1, 1); PG8_STAGE(PG8_SA(1, 0), a3, voffA);
            PG8_BAR; PG8_WAIT_L(0); PG8_MMA(1, 0, At, B0); PG8_BAR; PG8_SCHED;
            PG8_STAGE(PG8_SB(1, 1), b3 + hstepB, voffB);
            PG8_WAIT_V(6); PG8_BAR; PG8_MMA(1, 1, At, B1); PG8_BAR;
            }
        }
        if constexpr (ALIGN_EPI) { if (wr == 0) PG8_BAR; }
        if constexpr (!Epi::AFTER_DRAIN) { E(acc, cur, wr, wc, fr, fq); S.done(cur); }
        if (!has_next) break;
#pragma unroll
        for (int a = 0; a < 2; ++a)
#pragma unroll
            for (int b = 0; b < 2; ++b)
#pragma unroll
                for (int m = 0; m < 4; ++m)
#pragma unroll
                    for (int n = 0; n < 2; ++n) acc[a][b][m][n] = (f32x4){0.f, 0.f, 0.f, 0.f};
        cur = nxt; cA = nA; cB = nB; ++ui;
        if constexpr (ALIGN_EPI) { if (wr == 1) PG8_BAR; }
    }
    PG8_WAIT_V(0);
    if constexpr (!ALIGN_EPI) { if (wr == 0) PG8_BAR; }
    PG8_BAR;
    if constexpr (Epi::AFTER_DRAIN) { E.fused(acc, cur, wr, wc, fr, fq, lds, wid, lane); S.done(cur); }
#undef PG8_SA
#undef PG8_SB
#undef PG8_STAGE
#undef PG8_LDA
#undef PG8_LDB
#undef PG8_MMA
#undef PG8_WAIT_V
#undef PG8_WAIT_L
#undef PG8_BAR
#undef PG8_SCHED
}
}
DI unsigned sw_off(int row, int chunk) { return (unsigned)(row * 128 + ((chunk ^ ((row >> 1) & 7)) << 4)); }
#define GLDS16(gsrc, ldst) __builtin_amdgcn_global_load_lds((const unsigned*)(gsrc), (unsigned*)(ldst), 16, 0, 0)
DI u32x2 pack4(float a, float b, float c, float d) { u32x2 o; o[0] = pack2(a, b); o[1] = pack2(c, d); return o; }
#define EPI_ARGS const f32x4 (&acc)[2][2][4][2], const pg8::Unit& u, int wr, int wc, int fr, int fq
DI float xq_sum(float v) {
    v += __uint_as_float((unsigned)__builtin_amdgcn_ds_swizzle((int)__float_as_uint(v), 0x401F));
    return xhalf_sum(v);
}
DI u32x4 pack8(const float (&v)[8], float sc) {
    u32x4 o; o[0] = pack2(v[0] * sc, v[1] * sc); o[1] = pack2(v[2] * sc, v[3] * sc); o[2] = pack2(v[4] * sc, v[5] * sc); o[3] = pack2(v[6] * sc, v[7] * sc); return o;
}
DI void rope8(const float (&v)[8], float sc, const float* __restrict__ cs, int pos, int fq, int lane, bf16_t* dst32  ) {
    const int i0 = 8 * (fq & 1);
    const f32x4 c0 = *(const f32x4*)(cs + pos * 16 + i0), c1 = *(const f32x4*)(cs + pos * 16 + i0 + 4);
    const f32x4 s0 = *(const f32x4*)(cs + 65536 + pos * 16 + i0), s1 = *(const f32x4*)(cs + 65536 + pos * 16 + i0 + 4);
    const float sg = (fq < 2) ? -1.0f : 1.0f;
    float o[8];
#pragma unroll
    for (int e = 0; e < 8; ++e) {
        const float own = v[e] * sc, oth = xhalf_other(own, lane);
        const float c = (e < 4) ? c0[e & 3] : c1[e & 3], s = (e < 4) ? s0[e & 3] : s1[e & 3];
        o[e] = own * c + sg * oth * s;
    }
    *(u32x4*)(dst32 + 8 * fq) = pack8(o, 1.0f);
}
#define EPI_LOAD8(v, ai, bj, m) float v[8]; { const f32x4 x0_ = acc[ai][bj][m][0], x1_ = acc[ai][bj][m][1]; v[0] = x0_[0]; v[1] = x0_[1]; v[2] = x0_[2]; v[3] = x0_[3]; v[4] = x1_[0]; v[5] = x1_[1]; v[6] = x1_[2]; v[7] = x1_[3]; }

struct EpiPlain8 {
    static constexpr bool PERM = true, AFTER_DRAIN = false;
    bf16_t* out; int ld;
    DI void operator()(EPI_ARGS) const {
#pragma unroll
        for (int ai = 0; ai < 2; ++ai)
#pragma unroll
            for (int m = 0; m < 4; ++m) {
                int fr_ = fr; asm volatile("" : "+v"(fr_));
                const size_t tok = (size_t)u.pm * 256 + ai * 128 + wr * 64 + m * 16 + fr_;
#pragma unroll
                for (int bj = 0; bj < 2; ++bj) { EPI_LOAD8(v, ai, bj, m); *(u32x4*)(out + tok * ld + u.pn * 256 + bj * 128 + wc * 32 + 8 * fq) = pack8(v, 1.0f); }
            }
    }
};

struct EpiProj8 {
    static constexpr bool PERM = true, AFTER_DRAIN = false;
    bf16_t* proj; bf16_t* kr; const float* cs; float* ssq;
    DI void operator()(EPI_ARGS) const {
        const int lane = fr + 16 * fq;
#pragma unroll
        for (int bj = 0; bj < 2; ++bj) {
            const int cg = u.pn * 256 + bj * 128 + wc * 32;
            if (cg >= INC) continue;
            const int g32 = cg >> 5;
            const float sc = (cg >= 672 && cg < 1184) ? 0.125f * LOG2E : 1.0f;
#pragma unroll
            for (int ai = 0; ai < 2; ++ai)
#pragma unroll
                for (int m = 0; m < 4; ++m) {
                    int fr_ = fr; asm volatile("" : "+v"(fr_));
                const size_t tok = (size_t)u.pm * 256 + ai * 128 + wr * 64 + m * 16 + fr_;
                    EPI_LOAD8(v, ai, bj, m);
                    if (g32 < 20) {
                        float ss = 0.f;
#pragma unroll
                        for (int e = 0; e < 8; ++e) ss += v[e] * v[e];
                        ss = xq_sum(ss);
                        if (fq == 0) ssq[tok * 24 + g32] = ss;
                    }
                    if (cg == 640) rope8(v, 1.0f, cs, (int)(tok & (SEQ_L - 1)), fq, lane, kr + tok * 32);
                    else *(u32x4*)(proj + tok * INC + cg + 8 * fq) = pack8(v, sc);
                }
        }
    }
};

struct EpiUpQ8 {
    static constexpr bool PERM = true, AFTER_DRAIN = false;
    bf16_t* q; const float* cs; const float* ssq;
    DI void operator()(EPI_ARGS) const {
        const int lane = fr + 16 * fq;
        const float qs = 0.10206207261596575f * LOG2E;
#pragma unroll
        for (int ai = 0; ai < 2; ++ai)
#pragma unroll
            for (int m = 0; m < 4; ++m) {
                int fr_ = fr; asm volatile("" : "+v"(fr_));
                const size_t tok = (size_t)u.pm * 256 + ai * 128 + wr * 64 + m * 16 + fr_;
                const f32x4 a0 = *(const f32x4*)(ssq + tok * 24), a1 = *(const f32x4*)(ssq + tok * 24 + 4), a2 = *(const f32x4*)(ssq + tok * 24 + 8);
                const float tot = (a0[0] + a0[1] + a0[2] + a0[3]) + (a1[0] + a1[1] + a1[2] + a1[3]) + (a2[0] + a2[1] + a2[2] + a2[3]);
                const float sc = rsqrtf(tot * (1.0f / 384.0f) + 1e-6f) * qs;
#pragma unroll
                for (int bj = 0; bj < 2; ++bj) {
                    const int cg = u.pn * 256 + bj * 128 + wc * 32;
                    EPI_LOAD8(v, ai, bj, m);
                    if ((cg % 96) == 64) rope8(v, sc, cs, (int)(tok & (SEQ_L - 1)), fq, lane, q + tok * 768 + cg);
                    else *(u32x4*)(q + tok * 768 + cg + 8 * fq) = pack8(v, sc);
                }
            }
    }
};

struct EpiUpKV8 {
    static constexpr bool PERM = true, AFTER_DRAIN = false;
    bf16_t* kv; const float* ssq;
    DI void operator()(EPI_ARGS) const {
#pragma unroll
        for (int ai = 0; ai < 2; ++ai)
#pragma unroll
            for (int m = 0; m < 4; ++m) {
                int fr_ = fr; asm volatile("" : "+v"(fr_));
                const size_t tok = (size_t)u.pm * 256 + ai * 128 + wr * 64 + m * 16 + fr_;
                const f32x4 a0 = *(const f32x4*)(ssq + tok * 24 + 12), a1 = *(const f32x4*)(ssq + tok * 24 + 16);
                const float tot = (a0[0] + a0[1] + a0[2] + a0[3]) + (a1[0] + a1[1] + a1[2] + a1[3]);
                const float sc = rsqrtf(tot * (1.0f / 256.0f) + 1e-6f);
#pragma unroll
                for (int bj = 0; bj < 2; ++bj) { EPI_LOAD8(v, ai, bj, m); *(u32x4*)(kv + tok * 1024 + u.pn * 256 + bj * 128 + wc * 32 + 8 * fq) = pack8(v, sc); }
            }
    }
};

template <bool RBF16>
struct EpiResid8 {
    static constexpr bool PERM = true, AFTER_DRAIN = false;
    const void* R; bf16_t* HB; float* SS;
    DI void operator()(EPI_ARGS) const {
#pragma unroll
        for (int ai = 0; ai < 2; ++ai) {
            f32x4 rv[4][2][2];
#pragma unroll
            for (int m = 0; m < 4; ++m)
#pragma unroll
                for (int bj = 0; bj < 2; ++bj) {
                    const size_t off = ((size_t)u.pm * 256 + ai * 128 + wr * 64 + m * 16 + fr) * 1024 + u.pn * 256 + bj * 128 + wc * 32 + 8 * fq;
                    if (RBF16) {
                        const u32x4 w = ldu4((const bf16_t*)R + off);
                        rv[m][bj][0] = (f32x4){bf_lo(w[0]), bf_hi(w[0]), bf_lo(w[1]), bf_hi(w[1])};
                        rv[m][bj][1] = (f32x4){bf_lo(w[2]), bf_hi(w[2]), bf_lo(w[3]), bf_hi(w[3])};
                    } else {
                        rv[m][bj][0] = *(const f32x4*)((const float*)R + off); rv[m][bj][1] = *(const f32x4*)((const float*)R + off + 4);
                    }
                }
#pragma unroll
            for (int m = 0; m < 4; ++m) {
                int fr_ = fr; asm volatile("" : "+v"(fr_));
                const size_t tok = (size_t)u.pm * 256 + ai * 128 + wr * 64 + m * 16 + fr_;
                float ss = 0.f;
#pragma unroll
                for (int bj = 0; bj < 2; ++bj) {
                    const size_t off = tok * 1024 + u.pn * 256 + bj * 128 + wc * 32 + 8 * fq;
                    const f32x4 h0 = rv[m][bj][0] + acc[ai][bj][m][0], h1 = rv[m][bj][1] + acc[ai][bj][m][1];
                    u32x4 o; o[0] = pack2(h0[0], h0[1]); o[1] = pack2(h0[2], h0[3]); o[2] = pack2(h1[0], h1[1]); o[3] = pack2(h1[2], h1[3]);
                    *(u32x4*)(HB + off) = o;
                    const float a0 = bf_lo(o[0]), a1 = bf_hi(o[0]), a2 = bf_lo(o[1]), a3 = bf_hi(o[1]), a4 = bf_lo(o[2]), a5 = bf_hi(o[2]), a6 = bf_lo(o[3]), a7 = bf_hi(o[3]);
                    ss += (a0 * a0 + a1 * a1) + (a2 * a2 + a3 * a3) + (a4 * a4 + a5 * a5) + (a6 * a6 + a7 * a7);
                }
                ss = xq_sum(ss);
                if (fq == 0) SS[tok * 16 + 4 * u.pn + wc] = ss;
            }
        }
    }
};

struct EpiRowScale8 {
    static constexpr bool PERM = true, AFTER_DRAIN = false;
    bf16_t* out; int ld; const float* SS; float extra;
    DI void operator()(EPI_ARGS) const {
#pragma unroll
        for (int ai = 0; ai < 2; ++ai)
#pragma unroll
            for (int m = 0; m < 4; ++m) {
                int fr_ = fr; asm volatile("" : "+v"(fr_));
                const size_t tok = (size_t)u.pm * 256 + ai * 128 + wr * 64 + m * 16 + fr_;
                const f32x4 s0 = *(const f32x4*)(SS + tok * 16), s1 = *(const f32x4*)(SS + tok * 16 + 4), s2 = *(const f32x4*)(SS + tok * 16 + 8), s3 = *(const f32x4*)(SS + tok * 16 + 12);
                const float tot = (s0[0] + s0[1] + s0[2] + s0[3]) + (s1[0] + s1[1] + s1[2] + s1[3]) + (s2[0] + s2[1] + s2[2] + s2[3]) + (s3[0] + s3[1] + s3[2] + s3[3]);
                const float sc = rsqrtf(tot * (1.0f / 1024.0f) + 1e-6f) * extra;
#pragma unroll
                for (int bj = 0; bj < 2; ++bj) { EPI_LOAD8(v, ai, bj, m); *(u32x4*)(out + tok * ld + u.pn * 256 + bj * 128 + wc * 32 + 8 * fq) = pack8(v, sc); }
            }
    }
};

template <class Epi>
DI void gemm8(char* smem, const bf16_t* A, int lda, const bf16_t* Bt, int M, int N, int K, const Epi& e, int cshift = 0) {
    pg8::Gemm g; g.A = A; g.Bt = Bt; g.M = M; g.N = N; g.K = K; g.lda = lda;
    const int G = (int)gridDim.x;
    pg8::StaticOrder S; S.init(M, N, G, ((int)blockIdx.x + G - cshift) % G);
    pg8::gemm_phase<Epi, pg8::StaticOrder, true, true>((PG8_LAS unsigned char*)smem, g, S, e);
}

DI void quant_rows4(const Params& p, int it, int wv, int lane);
DI void phase_p1(const Params& p, char* smem) {
    char* ws = p.ws;
    const int G = (int)gridDim.x, nproj = 9 * 64, nkvm = 8 * 4;
    const int last = nproj % G;
    { EpiProj8 e{(bf16_t*)(ws + OFF_PROJ), (bf16_t*)(ws + OFF_KR), (const float*)(ws + OFF_ROPE), (float*)(ws + OFF_SSQ)};
      gemm8(smem, (const bf16_t*)(ws + OFF_XN), 1024, (const bf16_t*)(ws + OFF_WT_IN), T_TOK, 2304, 1024, e); }
    { EpiPlain8 e{(bf16_t*)(ws + OFF_KVM), 2048};
      gemm8(smem, (const bf16_t*)(ws + OFF_MEMN), 1024, (const bf16_t*)(ws + OFF_WT_MKV), 1024, 2048, 1024, e, last); }
    int q0 = last + nkvm, nq = G - q0;
    if (last == 0 || nq <= 0) { q0 = 0; nq = G; }
    if ((int)blockIdx.x >= q0) {
        const int t = otid(), lane = t & 63, wv = t >> 6;
        for (int it = ((int)blockIdx.x - q0) * 2 + vhalf(); it < 8192; it += 2 * nq) quant_rows4(p, it, wv, lane);
    }
}
DI void phase_p2(const Params& p, char* smem) {
    char* ws = p.ws;
    { EpiUpQ8 e{(bf16_t*)(ws + OFF_QMLA), (const float*)(ws + OFF_ROPE), (const float*)(ws + OFF_SSQ)};
      gemm8(smem, (const bf16_t*)(ws + OFF_PROJ), INC, (const bf16_t*)(ws + OFF_WT_UQ), T_TOK, 768, 384, e); }
    { EpiUpKV8 e{(bf16_t*)(ws + OFF_KVMLA), (const float*)(ws + OFF_SSQ)};
      gemm8(smem, (const bf16_t*)(ws + OFF_PROJ) + 384, INC, (const bf16_t*)(ws + OFF_WT_UKV), T_TOK, 1024, 256, e); }
}
template <bool RBF16>
DI void phase_resid(const Params& p, char* smem, size_t off_w, size_t off_a, const void* R, size_t off_ss, bool dry = false) {
    char* ws = p.ws;
    EpiResid8<RBF16> e{R, (bf16_t*)(ws + OFF_HB), (float*)(ws + off_ss)};
    if (dry) { e.HB = (bf16_t*)(ws + OFF_B); e.SS = (float*)(ws + OFF_SS1); }
    gemm8(smem, (const bf16_t*)(ws + off_a), 1024, (const bf16_t*)(ws + off_w), T_TOK, 1024, 1024, e);
}
DI void phase_rowscale(const Params& p, char* smem, size_t off_w, int N, bf16_t* outp, size_t off_ss, float extra) {
    char* ws = p.ws;
    EpiRowScale8 e{outp, N, (const float*)(ws + off_ss), extra};
    gemm8(smem, (const bf16_t*)(ws + OFF_HB), 1024, (const bf16_t*)(ws + off_w), T_TOK, N, 1024, e);
}
DI unsigned v128_off(int row, int chunk) { return (unsigned)(row * 128 + ((chunk ^ (((row >> 1) & 1) << 2)) << 4)); }
DI unsigned v128_tr_addr(unsigned base, int R0, int c, int lane) {
    const int blk = (lane >> 4) & 1, qq = (lane & 15) >> 2, pp = lane & 3;
    return base + v128_off(R0 + qq, 4 * c + 2 * blk + (pp >> 1)) + 8 * (pp & 1);
}
DI bf16x8 cat44(s16x4 lo, s16x4 hi) { return __builtin_shufflevector(lo, hi, 0, 1, 2, 3, 4, 5, 6, 7); }

constexpr int MLA_STAGE = 64 * 192 + 64 * 128;
DI unsigned k192_off(int row, int chunk) { return (unsigned)(row * 192 + (((chunk & ~3) | ((chunk & 3) ^ ((row >> 2) & 3))) << 4)); }
DI void mla_unit(const Params& p, char* lds, int b, int h, int qt) {
    char* ws = p.ws;
    const int t = otid(), lane = t & 63, wv = t >> 6, r = lane & 31, hh = lane >> 5;
    const bf16_t* Q = (const bf16_t*)(ws + OFF_QMLA);
    const bf16_t* KV = (const bf16_t*)(ws + OFF_KVMLA);
    const bf16_t* KR = (const bf16_t*)(ws + OFF_KR);
    const int q0 = qt * 128 + 32 * wv;
    const size_t tokq = (size_t)b * SEQ_L + q0 + r;
    const size_t tokb = (size_t)b * SEQ_L;
    bf16x8 qf[6];
#pragma unroll
    for (int s = 0; s < 6; ++s) qf[s] = ld16(Q + tokq * 768 + h * 96 + 16 * s + 8 * hh);
    f32x16 o[2]; o[0] = zero16(); o[1] = zero16();
    float m = -INFINITY, l = 0.f;
    const bf16_t* ksrc[3]; int kadv[3]; const bf16_t* vsrc[2];
#pragma unroll
    for (int i = 0; i < 3; ++i) {
        const int o_ = 1024 * (wv + 4 * i) + 16 * lane, row = o_ / 192, pch = (o_ % 192) >> 4;
        const int c = (pch & ~3) | ((pch & 3) ^ ((row >> 2) & 3));
        if (c < 8) { ksrc[i] = KV + (tokb + row) * 1024 + h * 128 + 8 * c; kadv[i] = 64 * 1024; }
        else       { ksrc[i] = KR + (tokb + row) * 32 + 8 * (c - 8);       kadv[i] = 64 * 32; }
    }
#pragma unroll
    for (int i = 0; i < 2; ++i) {
        const int row = 8 * (wv + 4 * i) + (lane >> 3), pch = lane & 7;
        vsrc[i] = KV + (tokb + row) * 1024 + h * 128 + 64 + 8 * (pch ^ (((row >> 1) & 1) << 2));
    }
    char* ldst = lds + wv * 1024 + lane * 16;
    auto issue = [&](int kt) {
        char* d = ldst + (kt % 3) * MLA_STAGE;
#pragma unroll
        for (int i = 0; i < 3; ++i) GLDS16(ksrc[i] + (size_t)kt * kadv[i], d + i * 4096);
#pragma unroll
        for (int i = 0; i < 2; ++i) GLDS16(vsrc[i] + (size_t)kt * (64 * 1024), d + 12288 + i * 4096);
    };
    const int ntiles = 2 * qt + 2;
    __syncthreads();
    issue(0); issue(1);
#pragma unroll
    for (int s = 0; s < 6; ++s) asm volatile("" :: "v"(qf[s]));
#pragma unroll 1
    for (int kt = 0; kt < ntiles; ++kt) {
        if (kt + 1 < ntiles) asm volatile("s_waitcnt vmcnt(5)\n\ts_barrier" ::: "memory");
        else asm volatile("s_waitcnt vmcnt(0)\n\ts_barrier" ::: "memory");
        if (kt + 2 < ntiles) issue(kt + 2);
        const char* sb = lds + (kt % 3) * MLA_STAGE;
        const unsigned vb = (unsigned)(uintptr_t)(sb + 12288);
        f32x16 s[2];
#pragma unroll
        for (int k2 = 0; k2 < 2; ++k2) {
            s[k2] = zero16();
#pragma unroll
            for (int ss = 0; ss < 6; ++ss) s[k2] = MFMA32(ld16(sb + k192_off(32 * k2 + r, 2 * ss + hh)), qf[ss], s[k2]);
        }
        s16x4 vt[2][2][2][2];
#pragma unroll
        for (int k2 = 0; k2 < 2; ++k2)
#pragma unroll
            for (int st = 0; st < 2; ++st)
#pragma unroll
                for (int c = 0; c < 2; ++c) {
                    vt[k2][st][c][0] = tr_read_a(v128_tr_addr(vb, 32 * k2 + 16 * st + 4 * hh, c, lane));
                    vt[k2][st][c][1] = tr_read_a(v128_tr_addr(vb, 32 * k2 + 16 * st + 8 + 4 * hh, c, lane));
                }
        if (__builtin_amdgcn_readfirstlane(kt >= 2 * qt)) {
            asm volatile("");
            const int qpos = q0 + r;
#pragma unroll
            for (int k2 = 0; k2 < 2; ++k2)
#pragma unroll
                for (int i = 0; i < 16; ++i) { const int kpos = 64 * kt + 32 * k2 + crow(i, hh); if (kpos > qpos) s[k2][i] = -INFINITY; }
        }
        float mx = s[0][0];
#pragma unroll
        for (int k2 = 0; k2 < 2; ++k2)
#pragma unroll
            for (int i = 0; i < 16; ++i) mx = fmaxf(mx, s[k2][i]);
        mx = xhalf_max(mx);
        if (__any(mx > m + 8.0f)) {
            asm volatile("");
            const float mn = fmaxf(m, mx);
            const float alpha = fast_exp2(m - mn);
            l *= alpha;
            m = mn;
#pragma unroll
            for (int c = 0; c < 2; ++c)
#pragma unroll
                for (int i = 0; i < 16; ++i) o[c][i] *= alpha;
        }
        f32x2 ps2 = {0.f, 0.f};
        const f32x2 m2 = {m, m};
#pragma unroll
        for (int k2 = 0; k2 < 2; ++k2)
#pragma unroll
            for (int i = 0; i < 16; i += 2) {
                f32x2 x = {s[k2][i], s[k2][i + 1]};
                x = x - m2;
                f32x2 e; e[0] = fast_exp2(x[0]); e[1] = fast_exp2(x[1]);
                s[k2][i] = e[0]; s[k2][i + 1] = e[1];
                ps2 += e;
            }
        l += ps2[0] + ps2[1];
        TR_WAIT();
#pragma unroll
        for (int k2 = 0; k2 < 2; ++k2)
#pragma unroll
            for (int st = 0; st < 2; ++st) {
                const bf16x8 pb = pack_step(s[k2], st);
#pragma unroll
                for (int c = 0; c < 2; ++c) o[c] = MFMA32(cat44(vt[k2][st][c][0], vt[k2][st][c][1]), pb, o[c]);
            }
    }
    const float inv = 1.0f / xhalf_sum(l);
    bf16_t* dst = (bf16_t*)((char*)p.out + OUT_OMLA) + tokq * 512 + h * 64 + 4 * hh;
#pragma unroll
    for (int c = 0; c < 2; ++c)
#pragma unroll
        for (int g = 0; g < 4; ++g)
            *(u32x2*)(dst + 32 * c + 8 * g) = pack4(o[c][4 * g] * inv, o[c][4 * g + 1] * inv, o[c][4 * g + 2] * inv, o[c][4 * g + 3] * inv);
}

DI void dil_unit(const Params& p, char* lds, int g, int b, int h, int rr, int lb) {
    char* ws = p.ws;
    const int t = otid(), lane = t & 63, wv = t >> 6, r = lane & 31, hh = lane >> 5;
    const int d = (g == 0) ? 1 : (g == 1 ? 4 : 16);
    const bf16_t* PJ = (const bf16_t*)(ws + OFF_PROJ);
    const size_t tokb = (size_t)b * SEQ_L;
    char* kimg = lds;
    char* vimg = lds + 32768;
    __syncthreads();
    {
        const int c = t & 7;
#pragma unroll
        for (int half = 0; half < 2; ++half) {
            u32x4 kk[4], vv[4];
#pragma unroll
            for (int i = 0; i < 4; ++i) {
                const int key = (t >> 3) + 32 * (4 * half + i);
                const int lk = 128 * lb - 128 + key;
                if (lk >= 0) {
                    const size_t tk = tokb + (size_t)lk * d + rr;
                    kk[i] = ldu4(PJ + tk * INC + 1184 + h * 64 + 8 * c);
                    vv[i] = ldu4(PJ + tk * INC + 1696 + h * 64 + 8 * c);
                } else { kk[i] = (u32x4){0u, 0u, 0u, 0u}; vv[i] = (u32x4){0u, 0u, 0u, 0u}; }
            }
#pragma unroll
            for (int i = 0; i < 4; ++i) {
                const int key = (t >> 3) + 32 * (4 * half + i);
                *(u32x4*)(kimg + sw_off(key, c)) = kk[i];
                *(u32x4*)(vimg + v128_off(key, c)) = vv[i];
            }
        }
    }
    const int lq = 128 * lb + 32 * wv + r;
    const size_t tokq = tokb + (size_t)lq * d + rr;
    bf16x8 qf[4];
#pragma unroll
    for (int s = 0; s < 4; ++s) qf[s] = ld16(PJ + tokq * INC + 672 + h * 64 + 16 * s + 8 * hh);
    __syncthreads();
    const float slope2 = exp2f(-(float)(h + 1)) * (float)d * LOG2E;
    const int u0 = (lb == 0) ? (4 - wv) : 0;
    f32x16 o[2]; o[0] = zero16(); o[1] = zero16();
    float m = -INFINITY, lsum = 0.f;
    const unsigned vb = (unsigned)(uintptr_t)vimg;
#pragma unroll 1
    for (int u = u0; u < 5; ++u) {
        const int rowb = 32 * (wv + u);
        f32x16 s = zero16();
#pragma unroll
        for (int ss = 0; ss < 4; ++ss) s = MFMA32(ld16(kimg + sw_off(rowb + r, 2 * ss + hh)), qf[ss], s);
        const int dbase = r + 128 - 32 * u;
        float mx = -INFINITY;
#pragma unroll
        for (int i = 0; i < 16; ++i) {
            const int dist = dbase - crow(i, hh);
            const bool valid = (dist >= 0) && (dist <= 128);
            const float v = valid ? (s[i] - slope2 * (float)dist) : -INFINITY;
            s[i] = v;
            mx = fmaxf(mx, v);
        }
        mx = xhalf_max(mx);
        const float mn = fmaxf(m, mx);
        const float alpha = fast_exp2(m - mn);
        float ps = 0.f;
#pragma unroll
        for (int i = 0; i < 16; ++i) { const float e = fast_exp2(s[i] - mn); s[i] = e; ps += e; }
        lsum = lsum * alpha + ps;
        m = mn;
#pragma unroll
        for (int c = 0; c < 2; ++c)
#pragma unroll
            for (int i = 0; i < 16; ++i) o[c][i] *= alpha;
#pragma unroll
        for (int st = 0; st < 2; ++st) {
            const bf16x8 pb = pack_step(s, st);
#pragma unroll
            for (int c = 0; c < 2; ++c) {
                const s16x4 lo = tr_read(v128_tr_addr(vb, rowb + 16 * st + 4 * hh, c, lane));
                const s16x4 hi = tr_read(v128_tr_addr(vb, rowb + 16 * st + 8 + 4 * hh, c, lane));
                o[c] = MFMA32(cat44(lo, hi), pb, o[c]);
            }
        }
    }
    const float ltot = xhalf_sum(lsum);
    const float mx = m;
    const float inv = 1.0f / ltot;
    bf16_t* dst = (bf16_t*)((char*)p.out + OUT_ODIL) + ((size_t)g * T_TOK + tokq) * 512 + h * 64 + 4 * hh;
#pragma unroll
    for (int c = 0; c < 2; ++c)
#pragma unroll
        for (int gg = 0; gg < 4; ++gg)
            *(u32x2*)(dst + 32 * c + 8 * gg) = pack4(o[c][4 * gg] * inv, o[c][4 * gg + 1] * inv, o[c][4 * gg + 2] * inv, o[c][4 * gg + 3] * inv);
    if (hh == 0) ((float*)(ws + OFF_LSE))[((size_t)g * T_TOK + tokq) * 8 + h] = mx + __log2f(ltot);
}

DI void phase_p3(const Params& p, char* lds, int which = 3) {
    const int xg = (int)blockIdx.x & 7, nloc = (vgrid() >> 3), loc = ((int)blockIdx.x >> 3) * 2 + vhalf();
    if (which & 1) for (int i = loc; i < 64; i += nloc) {
        const int bh = xg * 4 + (i >> 4), pr = i & 15, b = bh >> 3, h = bh & 7;
#pragma unroll 1
        for (int rep = 0; rep < 2; ++rep) mla_unit(p, lds, b, h, rep ? pr : 31 - pr);
    }
    if (which & 2) for (int i = loc; i < 384; i += nloc) {
        const int bh = xg * 4 + i / 96, k96 = i % 96, g = k96 >> 5, k = k96 & 31, b = bh >> 3, h = bh & 7;
        int rr, lb;
        if (g == 0) { rr = 0; lb = k; } else if (g == 1) { rr = k >> 3; lb = k & 7; } else { rr = k >> 1; lb = k & 1; }
        dil_unit(p, lds, g, b, h, rr, lb);
    }
}

DI void quant_rows4(const Params& p, int it, int wv, int lane) {
    char* ws = p.ws;
    const int ncv = 4096;
    const bool isv = it >= ncv;
    const size_t row = (size_t)(isv ? it - ncv : it) * 4 + wv;
    const float* src = (isv ? p.peer_v : p.peer_u) + row * 1024 + 16 * lane;
    f32x4 v[4]; float am = 0.f;
#pragma unroll
    for (int i = 0; i < 4; ++i) { v[i] = *(const f32x4*)(src + 4 * i); am = fmaxf(am, fmaxf(fmaxf(fabsf(v[i][0]), fabsf(v[i][1])), fmaxf(fabsf(v[i][2]), fabsf(v[i][3])))); }
#pragma unroll
    for (int o = 32; o; o >>= 1) am = fmaxf(am, __shfl_xor(am, o));
    const float sc = (am > 0.f) ? am * (1.0f / 127.0f) : 1.0f;
    const float inv = 1.0f / sc;
    const int bias = isv ? 128 : 0;
    u32x4 o;
#pragma unroll
    for (int i = 0; i < 4; ++i) {
        unsigned w = 0u;
#pragma unroll
        for (int e = 0; e < 4; ++e) { const int q = (int)rintf(v[i][e] * inv) + bias; w |= ((unsigned)q & 0xFFu) << (8 * e); }
        o[i] = w;
    }
    *(u32x4*)(ws + (isv ? OFF_VQ : OFF_UQ) + row * 1024 + 16 * lane) = o;
    if (lane == 0) ((float*)(ws + (isv ? OFF_SV : OFF_SU)))[row] = sc;
}

DI void phase_p35(const Params& p, char* lds) {
    char* ws = p.ws;
    const int t = otid(), lane = t & 63, wv = t >> 6;
    const int ntok = T_TOK / 4;
    for (int item = vbid(); item < ntok; item += vgrid()) {
        {
            const size_t tok = (size_t)item * 4 + wv;
            const int head = lane >> 3;
            const float* LS = (const float*)(ws + OFF_LSE);
            const float l0 = LS[tok * 8 + head], l1 = LS[((size_t)T_TOK + tok) * 8 + head], l2 = LS[((size_t)2 * T_TOK + tok) * 8 + head];
            const float mx = fmaxf(l0, fmaxf(l1, l2));
            float w0 = fast_exp2(l0 - mx), w1 = fast_exp2(l1 - mx), w2 = fast_exp2(l2 - mx);
            const float wi = 1.0f / (w0 + w1 + w2);
            w0 *= wi; w1 *= wi; w2 *= wi;
            const bf16_t* OD = (const bf16_t*)((const char*)p.out + OUT_ODIL);
            const u32x4 a0 = ldu4(OD + tok * 512 + 8 * lane), a1 = ldu4(OD + ((size_t)T_TOK + tok) * 512 + 8 * lane),
                        a2 = ldu4(OD + ((size_t)2 * T_TOK + tok) * 512 + 8 * lane);
            const u32x4 am = ldu4((const bf16_t*)((const char*)p.out + OUT_OMLA) + tok * 512 + 8 * lane);
            float od[8], om[8]; float sd = 0.f, sm = 0.f;
#pragma unroll
            for (int e = 0; e < 4; ++e) {
                od[2 * e] = w0 * bf_lo(a0[e]) + w1 * bf_lo(a1[e]) + w2 * bf_lo(a2[e]);
                od[2 * e + 1] = w0 * bf_hi(a0[e]) + w1 * bf_hi(a1[e]) + w2 * bf_hi(a2[e]);
                om[2 * e] = bf_lo(am[e]); om[2 * e + 1] = bf_hi(am[e]);
                sd += od[2 * e] * od[2 * e] + od[2 * e + 1] * od[2 * e + 1];
                sm += om[2 * e] * om[2 * e] + om[2 * e + 1] * om[2 * e + 1];
            }
#pragma unroll
            for (int o = 32; o; o >>= 1) { sd += __shfl_xor(sd, o); sm += __shfl_xor(sm, o); }
            const float rd = rsqrtf(sd * (1.0f / 512.0f) + 1e-6f), rm = rsqrtf(sm * (1.0f / 512.0f) + 1e-6f);
            const f32x4 gm0 = *(const f32x4*)(p.gn_mla + 8 * lane), gm1 = *(const f32x4*)(p.gn_mla + 8 * lane + 4);
            const f32x4 gd0 = *(const f32x4*)(p.gn_dil + 8 * lane), gd1 = *(const f32x4*)(p.gn_dil + 8 * lane + 4);
            u32x4 o1, o2;
            o1[0] = pack2(om[0] * rm * gm0[0], om[1] * rm * gm0[1]); o1[1] = pack2(om[2] * rm * gm0[2], om[3] * rm * gm0[3]);
            o1[2] = pack2(om[4] * rm * gm1[0], om[5] * rm * gm1[1]); o1[3] = pack2(om[6] * rm * gm1[2], om[7] * rm * gm1[3]);
            o2[0] = pack2(od[0] * rd * gd0[0], od[1] * rd * gd0[1]); o2[1] = pack2(od[2] * rd * gd0[2], od[3] * rd * gd0[3]);
            o2[2] = pack2(od[4] * rd * gd1[0], od[5] * rd * gd1[1]); o2[3] = pack2(od[6] * rd * gd1[2], od[7] * rd * gd1[3]);
            bf16_t* MX = (bf16_t*)(ws + OFF_MIXED) + tok * 1024;
            *(u32x4*)(MX + 8 * lane) = o1;
            *(u32x4*)(MX + 512 + 8 * lane) = o2;
        }
    }
}

DI unsigned m512_off(int row, int chunk) { return (unsigned)(row * 512 + ((chunk ^ (row & 15)) << 4)); }
DI unsigned v512_off(int row, int chunk) { return (unsigned)(row * 512 + ((chunk ^ ((row & 3) << 2)) << 4)); }
DI void memattn_unit(const Params& p, char* lds, int b, int h, int tt) {
    char* ws = p.ws;
    const int t = otid(), lane = t & 63, wv = t >> 6, r = lane & 31, hh = lane >> 5;
    const int qg = wv & 1, dh = wv >> 1;
    const bf16_t* QM = (const bf16_t*)(ws + OFF_QM);
    const bf16_t* KVM = (const bf16_t*)(ws + OFF_KVM);
    const size_t tokq = (size_t)b * SEQ_L + tt * 64 + 32 * qg + r;
    bf16x8 qf[16];
#pragma unroll
    for (int s = 0; s < 16; ++s) qf[s] = ld16(QM + tokq * 1024 + h * 256 + 16 * s + 8 * hh);
    f32x16 o[4];
#pragma unroll
    for (int c = 0; c < 4; ++c) o[c] = zero16();
    float m = -INFINITY, l = 0.f;
    const bf16_t* ksrc[4]; const bf16_t* vsrc[4];
#pragma unroll
    for (int i = 0; i < 4; ++i) {
        const int row = 2 * (wv + 4 * i) + (lane >> 5), pch = lane & 31;
        const size_t mrow = (size_t)b * 256 + row;
        ksrc[i] = KVM + mrow * 2048 + h * 256 + 8 * (pch ^ (row & 15));
        vsrc[i] = KVM + mrow * 2048 + 1024 + h * 256 + 8 * (pch ^ ((row & 3) << 2));
    }
    char* ldst = lds + wv * 1024 + lane * 16;
    auto stage_tile = [&](int kt, char* sb) {
#pragma unroll
        for (int i = 0; i < 4; ++i) { GLDS16(ksrc[i] + (size_t)kt * 32 * 2048, sb + i * 4096); GLDS16(vsrc[i] + (size_t)kt * 32 * 2048, sb + 16384 + i * 4096); }
    };
    __syncthreads();
    stage_tile(0, ldst);
    __syncthreads();
#pragma unroll 1
    for (int kt = 0; kt < 8; ++kt) {
        if (kt + 1 < 8) stage_tile(kt + 1, ldst + ((kt + 1) & 1) * 32768);
        const char* sb = lds + (kt & 1) * 32768;
        const unsigned vb = (unsigned)(uintptr_t)(sb + 16384);
        f32x16 s = zero16();
#pragma unroll
        for (int ss = 0; ss < 16; ++ss) s = MFMA32(ld16(sb + m512_off(r, 2 * ss + hh)), qf[ss], s);
        float mx = s[0];
#pragma unroll
        for (int i = 1; i < 16; ++i) mx = fmaxf(mx, s[i]);
        mx = xhalf_max(mx);
        const float mn = fmaxf(m, mx);
        const float alpha = fast_exp2(m - mn);
        float ps = 0.f;
#pragma unroll
        for (int i = 0; i < 16; ++i) { const float e = fast_exp2(s[i] - mn); s[i] = e; ps += e; }
        l = l * alpha + ps;
        m = mn;
#pragma unroll
        for (int c = 0; c < 4; ++c)
#pragma unroll
            for (int i = 0; i < 16; ++i) o[c][i] *= alpha;
        const int blk = (lane >> 4) & 1, qq = (lane & 15) >> 2, pp = lane & 3;
#pragma unroll
        for (int st = 0; st < 2; ++st) {
            const bf16x8 pb = pack_step(s, st);
#pragma unroll
            for (int c = 0; c < 4; ++c) {
                const int ch = 16 * dh + 4 * c + 2 * blk + (pp >> 1);
                const s16x4 lo = tr_read(vb + v512_off(16 * st + 4 * hh + qq, ch) + 8 * (pp & 1));
                const s16x4 hi = tr_read(vb + v512_off(16 * st + 8 + 4 * hh + qq, ch) + 8 * (pp & 1));
                o[c] = MFMA32(cat44(lo, hi), pb, o[c]);
            }
        }
        __syncthreads();
    }
    const float inv = 1.0f / xhalf_sum(l);
    bf16_t* dst = (bf16_t*)(ws + OFF_OM) + tokq * 1024 + h * 256 + 128 * dh + 4 * hh;
#pragma unroll
    for (int c = 0; c < 4; ++c)
#pragma unroll
        for (int g = 0; g < 4; ++g)
            *(u32x2*)(dst + 32 * c + 8 * g) = pack4(o[c][4 * g] * inv, o[c][4 * g + 1] * inv, o[c][4 * g + 2] * inv, o[c][4 * g + 3] * inv);
}

DI void phase_memattn(const Params& p, char* lds) {
    for (int item = vbid(); item < 1024; item += vgrid()) {
        const int b = item >> 8, h = (item >> 6) & 3, tt = item & 63;
        memattn_unit(p, lds, b, h, tt);
    }
}
DI unsigned f2sort(float f) { const unsigned b = __float_as_uint(f); return b ^ ((b & 0x80000000u) ? 0xFFFFFFFFu : 0x80000000u); }
DI float sort2f(unsigned u) { const unsigned b = (u & 0x80000000u) ? (u ^ 0x80000000u) : ~u; return __uint_as_float(b); }
DI void cswap(unsigned& a, unsigned& b) { const unsigned hi = max(a, b), lo = min(a, b); a = hi; b = lo; }

template <int LO, int N> struct BClean {
    template <int M> static DI void run(unsigned (&a)[M]) {
#pragma unroll
        for (int i = 0; i < N / 2; ++i) cswap(a[LO + i], a[LO + i + N / 2]);
        BClean<LO, N / 2>::run(a); BClean<LO + N / 2, N / 2>::run(a);
    }
};
template <int LO> struct BClean<LO, 1> { template <int M> static DI void run(unsigned (&)[M]) {} };
template <int LO, int N> struct BSort {
    template <int M> static DI void run(unsigned (&a)[M]) {
        BSort<LO, N / 2>::run(a); BSort<LO + N / 2, N / 2>::run(a);
#pragma unroll
        for (int i = 0; i < N / 2; ++i) cswap(a[LO + i], a[LO + N - 1 - i]);
        BClean<LO, N / 2>::run(a); BClean<LO + N / 2, N / 2>::run(a);
    }
};
template <int LO> struct BSort<LO, 1> { template <int M> static DI void run(unsigned (&)[M]) {} };
DI void merge_top16(unsigned (&a)[16], const unsigned (&b)[16]) {
#pragma unroll
    for (int i = 0; i < 16; ++i) a[i] = max(a[i], b[15 - i]);
    BClean<0, 16>::run(a);
}

DI void peer_top16(const bf16_t* __restrict__ keys_hp, const bf16_t* __restrict__ pq_row_hp, int r, int hh, unsigned (&top)[16]) {
    bf16x8 qf[8];
#pragma unroll
    for (int s = 0; s < 8; ++s) qf[s] = ld16(pq_row_hp + 16 * s + 8 * hh);
    unsigned cur[16];
#pragma unroll
    for (int kt = 0; kt < 4; ++kt) {
        f32x16 acc = zero16();
#pragma unroll
        for (int s = 0; s < 8; ++s) acc = MFMA32(ld16(keys_hp + (size_t)(32 * kt + r) * 128 + 16 * s + 8 * hh), qf[s], acc);
        unsigned k[16];
#pragma unroll
        for (int i = 0; i < 16; ++i) k[i] = (f2sort(acc[i]) & ~0x7Fu) | (unsigned)(32 * kt + crow(i, hh));
        BSort<0, 16>::run(k);
        if (kt == 0) {
#pragma unroll
            for (int i = 0; i < 16; ++i) cur[i] = k[i];
        } else merge_top16(cur, k);
    }
    unsigned r0[16], r1[16];
#pragma unroll
    for (int i = 0; i < 16; ++i) { auto rr = __builtin_amdgcn_permlane32_swap(cur[i], cur[i], false, false); r0[i] = rr[0]; r1[i] = rr[1]; }
#pragma unroll
    for (int i = 0; i < 16; ++i) top[i] = max(r0[i], r1[15 - i]);
    BClean<0, 16>::run(top);
}

DI void peer_select_unit(const Params& p, char* lds, int mt, int h) {
    char* ws = p.ws;
    const int t = otid(), lane = t & 63, wv = t >> 6, r = lane & 31, hh = lane >> 5;
    const size_t tok = (size_t)mt * 128 + 32 * wv + r;
    const bf16_t* KEYS = (const bf16_t*)(ws + OFF_KEYS);
    const bf16_t* PQ = (const bf16_t*)((const char*)p.out + OUT_PQ);
    unsigned tA[16], tB[16];
    peer_top16(KEYS + (size_t)(2 * h) * 16384, PQ + tok * 2048 + (2 * h) * 128, r, hh, tA);
    peer_top16(KEYS + (size_t)(2 * h + 1) * 16384, PQ + tok * 2048 + (2 * h + 1) * 128, r, hh, tB);
    float fA[16], fB[16];
#pragma unroll
    for (int i = 0; i < 16; ++i) { fA[i] = sort2f(tA[i] & ~0x7Fu); fB[i] = sort2f(tB[i] & ~0x7Fu); }
    unsigned* tab = (unsigned*)lds + wv * 1024;
    __syncthreads();
#pragma unroll
    for (int i = 0; i < 16; ++i) tab[i * 64 + lane] = (tA[i] & 0x7Fu) | ((tB[i] & 0x7Fu) << 16);
    unsigned c[64];
#pragma unroll
    for (int i = 0; i < 64; ++i) c[i] = 0u;
    {
        int n = 0;
#pragma unroll
        for (int a = 0; a < 16; ++a)
#pragma unroll
            for (int b = 0; b < 16; ++b)
                if ((a + 1) * (b + 1) <= 16) { c[n] = (f2sort(fA[a] + fB[b]) & ~0xFFu) | (unsigned)(a * 16 + b); ++n; }
    }
    unsigned g0[16], g1[16], g2[16], g3[16];
#pragma unroll
    for (int i = 0; i < 16; ++i) { g0[i] = c[i]; g1[i] = c[16 + i]; g2[i] = c[32 + i]; g3[i] = c[48 + i]; }
    BSort<0, 16>::run(g0); BSort<0, 16>::run(g1); BSort<0, 16>::run(g2); BSort<0, 16>::run(g3);
    merge_top16(g0, g1); merge_top16(g2, g3); merge_top16(g0, g2);
    float e[16]; float sum = 0.f;
    const float v0 = sort2f(g0[0] & ~0xFFu);
    unsigned ids[16];
#pragma unroll
    for (int i = 0; i < 16; ++i) {
        const float v = sort2f(g0[i] & ~0xFFu);
        e[i] = fast_exp2((v - v0) * LOG2E); sum += e[i];
        const unsigned a = (g0[i] >> 4) & 15u, b = g0[i] & 15u;
        const unsigned ia = tab[a * 64 + lane] & 0x7Fu, ib = (tab[b * 64 + lane] >> 16) & 0x7Fu;
        ids[i] = ia * 128u + ib;
    }
    const float inv = 1.0f / sum;
    if (hh == 0) {
        unsigned short* SID = (unsigned short*)(ws + OFF_SELID) + tok * 128 + h * 16;
        float* SG = (float*)(ws + OFF_SELG) + tok * 128 + h * 16;
        u32x4 w0, w1;
        w0[0] = ids[0] | (ids[1] << 16); w0[1] = ids[2] | (ids[3] << 16); w0[2] = ids[4] | (ids[5] << 16); w0[3] = ids[6] | (ids[7] << 16);
        w1[0] = ids[8] | (ids[9] << 16); w1[1] = ids[10] | (ids[11] << 16); w1[2] = ids[12] | (ids[13] << 16); w1[3] = ids[14] | (ids[15] << 16);
        *(u32x4*)SID = w0; *(u32x4*)(SID + 8) = w1;
#pragma unroll
        for (int q = 0; q < 4; ++q) *(f32x4*)(SG + 4 * q) = (f32x4){e[4 * q] * inv, e[4 * q + 1] * inv, e[4 * q + 2] * inv, e[4 * q + 3] * inv};
    }
}

DI void phase_select(const Params& p, char* lds) {
    for (int item = vbid(); item < 1024; item += vgrid()) peer_select_unit(p, lds, item >> 3, item & 7);
}

DI float gelu_erf(float a) { return 0.5f * a * (1.0f + erff(a * 0.70710678118654752f)); }
DI int dppi(int v, const int ctrl) { return v; }
#define DPP_I(v, ctrl) __builtin_amdgcn_update_dpp(0, (v), (ctrl), 0xf, 0xf, true)
DI float ub0(unsigned w) { return (float)(w & 0xFFu); }
DI float ub1(unsigned w) { return (float)((w >> 8) & 0xFFu); }
DI float ub2(unsigned w) { return (float)((w >> 16) & 0xFFu); }
DI float ub3(unsigned w) { return (float)(w >> 24); }

struct GBatch { u32x4 U[4], V[4]; float su[4], sv[4], gate[4]; };

DI void gather_load(GBatch& B, const char* __restrict__ ws, unsigned idpair, f32x2 gpair, int eb, int lane) {
#pragma unroll
    for (int j = 0; j < 4; ++j) {
        const int e = eb + j;
        const unsigned pr = __shfl(idpair, e >> 1);
        const unsigned id = (j & 1) ? (pr >> 16) : (pr & 0xFFFFu);
        const float g0 = __shfl(gpair[0], e >> 1), g1 = __shfl(gpair[1], e >> 1);
        B.gate[j] = (j & 1) ? g1 : g0;
        B.U[j] = ldu4(ws + OFF_UQ + (size_t)id * 1024 + 16 * lane);
        B.V[j] = ldu4(ws + OFF_VQ + (size_t)id * 1024 + 16 * lane);
        B.su[j] = ((const float*)(ws + OFF_SU))[id];
        B.sv[j] = ((const float*)(ws + OFF_SV))[id];
    }
}

DI void gather_compute(const GBatch& B, const unsigned (&qx)[4], float sx, float (&acc)[16], float& csum, int lane) {
    int pd[4];
#pragma unroll
    for (int j = 0; j < 4; ++j) {
        int d = 0;
#pragma unroll
        for (int q = 0; q < 4; ++q) d = __builtin_amdgcn_sdot4((int)B.U[j][q], (int)qx[q], d, false);
        pd[j] = d;
    }
    const bool b0 = lane & 1, b1 = lane & 2;
    const int kA = b0 ? pd[1] : pd[0], kB = b0 ? pd[3] : pd[2], sA = b0 ? pd[0] : pd[1], sB = b0 ? pd[2] : pd[3];
    const int qA = kA + DPP_I(sA, 0xB1), qB = kB + DPP_I(sB, 0xB1);
    const int kp = b1 ? qB : qA, sd = b1 ? qA : qB;
    int tot = kp + DPP_I(sd, 0x4E);
    tot += DPP_I(tot, 0x124);
    tot += DPP_I(tot, 0x128);
    tot += __builtin_amdgcn_ds_swizzle(tot, 0x401F);
    { auto rr = __builtin_amdgcn_permlane32_swap((unsigned)tot, (unsigned)tot, false, false); tot = (int)rr[0] + (int)rr[1]; }
    const int j3 = lane & 3;
    const float su_sel = (j3 == 0) ? B.su[0] : (j3 == 1 ? B.su[1] : (j3 == 2 ? B.su[2] : B.su[3]));
    const float ge = gelu_erf((float)tot * sx * su_sel);
#pragma unroll
    for (int j = 0; j < 4; ++j) {
        const float cf = B.gate[j] * B.sv[j] * __uint_as_float((unsigned)__builtin_amdgcn_readlane((int)__float_as_uint(ge), j));
        csum += cf;
#pragma unroll
        for (int q = 0; q < 4; ++q) {
            const unsigned w = B.V[j][q];
            acc[4 * q] += cf * ub0(w); acc[4 * q + 1] += cf * ub1(w); acc[4 * q + 2] += cf * ub2(w); acc[4 * q + 3] += cf * ub3(w);
        }
    }
}

DI void gather_token(const Params& p, size_t tok, int lane, float* dst_base) {
    char* ws = p.ws;
    const bf16_t* hrow = (const bf16_t*)(ws + OFF_HB) + tok * 1024 + 16 * lane;
    float hv[16];
    {
        const u32x4 w0 = ldu4(hrow), w1 = ldu4(hrow + 8);
#pragma unroll
        for (int e = 0; e < 4; ++e) { hv[2 * e] = bf_lo(w0[e]); hv[2 * e + 1] = bf_hi(w0[e]); hv[8 + 2 * e] = bf_lo(w1[e]); hv[8 + 2 * e + 1] = bf_hi(w1[e]); }
    }
    float rs;
    {
        const float* SS = (const float*)(ws + OFF_SS2) + tok * 16;
        const f32x4 s0 = *(const f32x4*)SS, s1 = *(const f32x4*)(SS + 4), s2 = *(const f32x4*)(SS + 8), s3 = *(const f32x4*)(SS + 12);
        const float tot = (s0[0] + s0[1] + s0[2] + s0[3]) + (s1[0] + s1[1] + s1[2] + s1[3]) + (s2[0] + s2[1] + s2[2] + s2[3]) + (s3[0] + s3[1] + s3[2] + s3[3]);
        rs = rsqrtf(tot * (1.0f / 1024.0f) + 1e-6f);
    }
    float xf[16]; float am = 0.f;
#pragma unroll
    for (int i = 0; i < 4; ++i) {
        const f32x4 g = *(const f32x4*)(p.norm_ffn + 16 * lane + 4 * i);
#pragma unroll
        for (int e = 0; e < 4; ++e) { xf[4 * i + e] = hv[4 * i + e] * rs * g[e]; am = fmaxf(am, fabsf(xf[4 * i + e])); }
    }
#pragma unroll
    for (int o = 32; o; o >>= 1) am = fmaxf(am, __shfl_xor(am, o));
    const float sx = (am > 0.f) ? am * (1.0f / 127.0f) : 1.0f;
    const float isx = 1.0f / sx;
    unsigned qx[4];
#pragma unroll
    for (int i = 0; i < 4; ++i) {
        unsigned w = 0u;
#pragma unroll
        for (int e = 0; e < 4; ++e) w |= ((unsigned)(int)rintf(xf[4 * i + e] * isx) & 0xFFu) << (8 * e);
        qx[i] = w;
    }
    const unsigned idpair = *((const unsigned*)(ws + OFF_SELID) + tok * 64 + lane);
    const f32x2 gpair = *((const f32x2*)(ws + OFF_SELG) + tok * 64 + lane);
    float acc[16]; float csum = 0.f;
#pragma unroll
    for (int i = 0; i < 16; ++i) acc[i] = 0.f;
    GBatch B0, B1;
    gather_load(B0, ws, idpair, gpair, 0, lane);
#pragma unroll 1
    for (int eb = 0; eb < 128; eb += 8) {
        gather_load(B1, ws, idpair, gpair, eb + 4, lane);
        gather_compute(B0, qx, sx, acc, csum, lane);
        if (eb + 8 < 128) gather_load(B0, ws, idpair, gpair, eb + 8, lane);
        gather_compute(B1, qx, sx, acc, csum, lane);
    }
    float ss = 0.f;
#pragma unroll
    for (int i = 0; i < 16; ++i) { acc[i] = acc[i] - 128.0f * csum + hv[i]; ss += acc[i] * acc[i]; }
#pragma unroll
    for (int o = 32; o; o >>= 1) ss += __shfl_xor(ss, o);
    const float rf = rsqrtf(ss * (1.0f / 1024.0f) + 1e-6f);
    float* drow = dst_base + tok * 1024 + 16 * lane;
#pragma unroll
    for (int i = 0; i < 4; ++i) {
        const f32x4 n = *(const f32x4*)(p.norm_final + 16 * lane + 4 * i);
        *(f32x4*)(drow + 4 * i) = (f32x4){acc[4 * i] * rf * n[0], acc[4 * i + 1] * rf * n[1], acc[4 * i + 2] * rf * n[2], acc[4 * i + 3] * rf * n[3]};
    }
}

DI void phase_gather(const Params& p, bool dry = false) {
    const int lane = otid() & 63, wv = otid() >> 6;
    float* dst = dry ? (float*)(p.ws + OFF_A) : p.out;
    for (int item = vbid(); item < T_TOK / 4; item += vgrid()) gather_token(p, (size_t)item * 4 + wv, lane, dst);
}

constexpr size_t GS_SIDS = OFF_A;
constexpr size_t GS_SGS = GS_SIDS + (size_t)T_TOK * 256;
constexpr size_t GS_OFF = GS_SGS + (size_t)T_TOK * 512;
constexpr size_t GS_XQ = GS_OFF + (size_t)T_TOK * 64;
constexpr size_t GS_SX = GS_XQ + (size_t)T_TOK * 1024;
constexpr size_t GS_ACC = GS_SX + (size_t)T_TOK * 4;
static_assert(GS_ACC + (size_t)T_TOK * 2048 <= OFF_A + 69 * MiB, "gather scratch overflows region A");

DI void gs_load(GBatch& B, const char* __restrict__ ws, unsigned myid, float mygate, int j0, int n, int lane) {
#pragma unroll
    for (int j = 0; j < 4; ++j) {
        const int e = __builtin_amdgcn_readfirstlane(j0 + j);
        const bool ok = e < n;
        const int src = ok ? e : 0;
        const unsigned id = (unsigned)__builtin_amdgcn_readlane((int)myid, src);
        const float g = __uint_as_float((unsigned)__builtin_amdgcn_readlane((int)__float_as_uint(mygate), src));
        B.gate[j] = ok ? g : 0.f;
        const char* urow = ws + OFF_UQ + (size_t)id * 1024;
        const char* vrow = ws + OFF_VQ + (size_t)id * 1024;
        B.U[j] = ldu4(urow + 16 * lane);
        B.V[j] = ldu4(vrow + 16 * lane);
        B.su[j] = ((const float*)(ws + OFF_SU))[id];
        B.sv[j] = ((const float*)(ws + OFF_SV))[id];
    }
}

DI void phase_gather_sliced(const Params& p, char* smem) {
    char* ws = p.ws;
    const bool acc_lds = (T_TOK / 8) <= 8 * (((int)gridDim.x >> 3) * 8);
    char* lacc = smem + (threadIdx.x >> 6) * 16384 + (threadIdx.x & 63) * 32;
    unsigned short* lids = (unsigned short*)(smem + 131072 + (threadIdx.x >> 6) * 2048);
    unsigned char* loff = (unsigned char*)(smem + 131072 + 16384 + (threadIdx.x >> 6) * 128);
    const int lane = threadIdx.x & 63;
    const int x = (int)blockIdx.x & 7, nW = ((int)gridDim.x >> 3) * 8, lw = ((int)blockIdx.x >> 3) * 8 + (int)(threadIdx.x >> 6);
    const int TPX = T_TOK / 8;
    for (int tl = lw; tl < TPX; tl += nW) {
        const size_t tok = (size_t)x * TPX + tl;
        const bf16_t* hrow = (const bf16_t*)(ws + OFF_HB) + tok * 1024 + 16 * lane;
        float hv[16];
        {
            const u32x4 w0 = ldu4(hrow), w1 = ldu4(hrow + 8);
#pragma unroll
            for (int e = 0; e < 4; ++e) { hv[2 * e] = bf_lo(w0[e]); hv[2 * e + 1] = bf_hi(w0[e]); hv[8 + 2 * e] = bf_lo(w1[e]); hv[8 + 2 * e + 1] = bf_hi(w1[e]); }
        }
        float rs;
        {
            const float* SS = (const float*)(ws + OFF_SS2) + tok * 16;
            const f32x4 s0 = *(const f32x4*)SS, s1 = *(const f32x4*)(SS + 4), s2 = *(const f32x4*)(SS + 8), s3 = *(const f32x4*)(SS + 12);
            const float tot = (s0[0] + s0[1] + s0[2] + s0[3]) + (s1[0] + s1[1] + s1[2] + s1[3]) + (s2[0] + s2[1] + s2[2] + s2[3]) + (s3[0] + s3[1] + s3[2] + s3[3]);
            rs = rsqrtf(tot * (1.0f / 1024.0f) + 1e-6f);
        }
        float xf[16]; float am = 0.f;
#pragma unroll
        for (int i = 0; i < 4; ++i) {
            const f32x4 g = *(const f32x4*)(p.norm_ffn + 16 * lane + 4 * i);
#pragma unroll
            for (int e = 0; e < 4; ++e) { xf[4 * i + e] = hv[4 * i + e] * rs * g[e]; am = fmaxf(am, fabsf(xf[4 * i + e])); }
        }
#pragma unroll
        for (int o = 32; o; o >>= 1) am = fmaxf(am, __shfl_xor(am, o));
        const float sx = (am > 0.f) ? am * (1.0f / 127.0f) : 1.0f;
        const float isx = 1.0f / sx;
        u32x4 qx;
#pragma unroll
        for (int i = 0; i < 4; ++i) {
            unsigned w = 0u;
#pragma unroll
            for (int e = 0; e < 4; ++e) w |= ((unsigned)(int)rintf(xf[4 * i + e] * isx) & 0xFFu) << (8 * e);
            qx[i] = w;
        }
        *(u32x4*)(ws + GS_XQ + tok * 1024 + 16 * lane) = qx;
        if (lane == 0) ((float*)(ws + GS_SX))[tok] = sx;
        const unsigned idpair = *((const unsigned*)(ws + OFF_SELID) + tok * 64 + lane);
        const f32x2 gpair = *((const f32x2*)(ws + OFF_SELG) + tok * 64 + lane);
        const unsigned id0 = idpair & 0xFFFFu, id1 = idpair >> 16;
        const int sl0 = (int)(id0 >> 11), sl1 = (int)(id1 >> 11);
        const unsigned long long lt = (1ull << lane) - 1ull;
        int base = 0, pos0 = 0, pos1 = 0, myoff = 0;
#pragma unroll
        for (int s = 0; s < 8; ++s) {
            const unsigned long long m0 = __ballot(sl0 == s), m1 = __ballot(sl1 == s);
            const int c0 = __popcll(m0), c1 = __popcll(m1);
            if (sl0 == s) pos0 = base + __popcll(m0 & lt);
            if (sl1 == s) pos1 = base + c0 + __popcll(m1 & lt);
            if (lane == s) myoff = base;
            base += c0 + c1;
        }
        if (lane == 8) myoff = base;
        unsigned short* sid = (unsigned short*)(ws + GS_SIDS) + tok * 128;
        float* sg = (float*)(ws + GS_SGS) + tok * 128;
        sid[pos0] = (unsigned short)id0; sid[pos1] = (unsigned short)id1;
        if (acc_lds) { const int k = (tl - lw) / nW; lids[k * 128 + pos0] = (unsigned short)id0; lids[k * 128 + pos1] = (unsigned short)id1; if (lane < 9) loff[k * 16 + lane] = (unsigned char)myoff; }
        sg[pos0] = gpair[0]; sg[pos1] = gpair[1];
        if (lane < 9) ((int*)(ws + GS_OFF))[tok * 16 + lane] = myoff;
    }
    __syncthreads();
#pragma unroll 1
    for (int pass = 0; pass < 8; ++pass) {
        const int slice = (pass + x) & 7;
#pragma unroll 1
        for (int tl = lw; tl < TPX; tl += nW) {
            const size_t tok = (size_t)x * TPX + tl;
            const int* offp = (const int*)(ws + GS_OFF) + tok * 16;
            const int kslot = (tl - lw) / nW;
            const int o0 = __builtin_amdgcn_readfirstlane(acc_lds ? (int)loff[kslot * 16 + slice] : offp[slice]), o1 = __builtin_amdgcn_readfirstlane(acc_lds ? (int)loff[kslot * 16 + slice + 1] : offp[slice + 1]);
            const int n = o1 - o0;
            if (n == 0 && pass != 0 && pass != 7) continue;
            float acc[16]; float csum = 0.f;
            if (pass == 0) {
#pragma unroll
                for (int i = 0; i < 16; ++i) acc[i] = 0.f;
            } else {
                const bf16_t* ap = (const bf16_t*)(ws + GS_ACC) + tok * 1024 + 16 * lane;
                const char* la = lacc + ((tl - lw) / nW) * 2048;
                const u32x4 w0 = acc_lds ? *(const u32x4*)la : ldu4(ap), w1 = acc_lds ? *(const u32x4*)(la + 16) : ldu4(ap + 8);
#pragma unroll
                for (int e = 0; e < 4; ++e) { acc[2 * e] = bf_lo(w0[e]); acc[2 * e + 1] = bf_hi(w0[e]); acc[8 + 2 * e] = bf_lo(w1[e]); acc[8 + 2 * e + 1] = bf_hi(w1[e]); }
            }
            if (n > 0) {
                const u32x4 qv = ldu4(ws + GS_XQ + tok * 1024 + 16 * lane);
                const unsigned qx[4] = {qv[0], qv[1], qv[2], qv[3]};
                const float sx = ((const float*)(ws + GS_SX))[tok];
#pragma unroll 1
                for (int c0 = 0; c0 < n; c0 += 64) {
                    const int nc = (n - c0) < 64 ? (n - c0) : 64;
                    const int li = (lane < nc) ? lane : 0;
                    const unsigned myid = acc_lds ? (unsigned)lids[kslot * 128 + o0 + c0 + li] : (unsigned)((const unsigned short*)(ws + GS_SIDS))[tok * 128 + o0 + c0 + li];
                    const float mygate = ((const float*)(ws + GS_SGS))[tok * 128 + o0 + c0 + li];
                    GBatch B0, B1;
                    gs_load(B0, ws, myid, mygate, 0, nc, lane);
#pragma unroll 1
                    for (int j0 = 0; j0 < nc; j0 += 8) {
                        if (j0 + 4 < nc) gs_load(B1, ws, myid, mygate, j0 + 4, nc, lane);
                        gather_compute(B0, qx, sx, acc, csum, lane);
                        if (j0 + 4 < nc) {
                            if (j0 + 8 < nc) gs_load(B0, ws, myid, mygate, j0 + 8, nc, lane);
                            gather_compute(B1, qx, sx, acc, csum, lane);
                        }
                    }
                }
#pragma unroll
                for (int i = 0; i < 16; ++i) acc[i] -= 128.0f * csum;
            }
            if (pass < 7) {
                bf16_t* ap = (bf16_t*)(ws + GS_ACC) + tok * 1024 + 16 * lane;
                u32x4 w0, w1;
#pragma unroll
                for (int e = 0; e < 4; ++e) { w0[e] = pack2(acc[2 * e], acc[2 * e + 1]); w1[e] = pack2(acc[8 + 2 * e], acc[8 + 2 * e + 1]); }
                char* la = lacc + ((tl - lw) / nW) * 2048;
                if (acc_lds) { *(u32x4*)la = w0; *(u32x4*)(la + 16) = w1; } else { *(u32x4*)ap = w0; *(u32x4*)(ap + 8) = w1; }
            } else {
                const bf16_t* hrow = (const bf16_t*)(ws + OFF_HB) + tok * 1024 + 16 * lane;
                const u32x4 w0 = ldu4(hrow), w1 = ldu4(hrow + 8);
                float ss = 0.f;
#pragma unroll
                for (int e = 0; e < 4; ++e) {
                    acc[2 * e] += bf_lo(w0[e]); acc[2 * e + 1] += bf_hi(w0[e]); acc[8 + 2 * e] += bf_lo(w1[e]); acc[8 + 2 * e + 1] += bf_hi(w1[e]);
                }
#pragma unroll
                for (int i = 0; i < 16; ++i) ss += acc[i] * acc[i];
#pragma unroll
                for (int o = 32; o; o >>= 1) ss += __shfl_xor(ss, o);
                const float rf = rsqrtf(ss * (1.0f / 1024.0f) + 1e-6f);
                float* drow = p.out + tok * 1024 + 16 * lane;
#pragma unroll
                for (int i = 0; i < 4; ++i) {
                    const f32x4 nn = *(const f32x4*)(p.norm_final + 16 * lane + 4 * i);
                    *(f32x4*)(drow + 4 * i) = (f32x4){acc[4 * i] * rf * nn[0], acc[4 * i + 1] * rf * nn[1], acc[4 * i + 2] * rf * nn[2], acc[4 * i + 3] * rf * nn[3]};
                }
            }
        }
    }
}
constexpr int LDS_BYTES = 131072 + 16384 + 1024;
constexpr int NPHASE = 12;
template <int PH> DI void run_phase(const Params& p, char* smem) {
    char* lds = smem + vhalf() * 65536;
    if (PH == 0) phase_prep(p, lds);
    else if (PH == 1) phase_p1(p, smem);
    else if (PH == 2) phase_p2(p, smem);
    else if (PH == 3) phase_p3(p, lds);
    else if (PH == 4) phase_p35(p, lds);
    else if (PH == 5) phase_resid<false>(p, smem, OFF_WT_OUT, OFF_MIXED, p.x, OFF_SS1);
    else if (PH == 6) phase_rowscale(p, smem, OFF_WT_MQ, 1024, (bf16_t*)(p.ws + OFF_QM), OFF_SS1, 0.0625f * LOG2E);
    else if (PH == 7) phase_memattn(p, lds);
    else if (PH == 8) phase_resid<true>(p, smem, OFF_WT_MO, OFF_OM, p.ws + OFF_HB, OFF_SS2);
    else if (PH == 9) phase_rowscale(p, smem, OFF_WT_PQ, 2048, (bf16_t*)((char*)p.out + OUT_PQ), OFF_SS2, 1.0f);
    else if (PH == 10) phase_select(p, lds);
    else if (PH == 11) phase_gather_sliced(p, smem);
}

template <int PH> __global__ void __launch_bounds__(512, 2) k_phase(Params p) {
    __shared__ __attribute__((aligned(16))) char smem[LDS_BYTES];
    run_phase<PH>(p, smem);
}

static Params make_params(void* const* d_in, void* d_out, void* d_ws) {
    Params p;
    memset(&p, 0, sizeof(p));
    p.x = (const float*)d_in[0]; p.mem = (const float*)d_in[1]; p.norm_mix = (const float*)d_in[2]; p.w_in = (const float*)d_in[3];
    p.q_norm = (const float*)d_in[4]; p.kv_norm = (const float*)d_in[5]; p.w_uq = (const float*)d_in[6]; p.w_ukv = (const float*)d_in[7];
    p.gn_mla = (const float*)d_in[8]; p.gn_dil = (const float*)d_in[9]; p.w_out = (const float*)d_in[10]; p.norm_mem_q = (const float*)d_in[11];
    p.norm_mem_kv = (const float*)d_in[12]; p.w_mem_q = (const float*)d_in[13]; p.w_mem_kv = (const float*)d_in[14]; p.w_mem_o = (const float*)d_in[15];
    p.norm_ffn = (const float*)d_in[16]; p.peer_w_q = (const float*)d_in[17]; p.sub_keys = (const float*)d_in[18]; p.peer_u = (const float*)d_in[19];
    p.peer_v = (const float*)d_in[20]; p.norm_final = (const float*)d_in[21];
    p.out = (float*)d_out; p.ws = (char*)d_ws;
    for (int i = 0; i < 16; ++i) p.inv_freq[i] = 1.0f / powf(10000.0f, (float)(2 * i) / 32.0f);
    return p;
}
__global__ void __launch_bounds__(512, 2) k_mega(Params p) {
    __shared__ __attribute__((aligned(16))) char smem[LDS_BYTES + 16];
    volatile LAS unsigned* st = (volatile LAS unsigned*)(LAS char*)(smem + LDS_BYTES);
    if (threadIdx.x == 0) { st[0] = 0u; st[1] = 0u; st[2] = 0u; st[3] = 0u; }
    __syncthreads();
    const XcdBarrier xb = xcd_barrier_post((unsigned*)(p.ws + OFF_BAR), st);
#define RP(n) run_phase<n>(p, smem); xcd_barrier(xb);
    RP(0) RP(1) RP(2) RP(3) RP(4) RP(5) RP(6) RP(7) RP(8) RP(9) RP(10)
    run_phase<11>(p, smem);
}

extern "C" void kernel_launch(void* const* d_in, const int* in_sizes, int n_in, void* d_out, int out_size, void* d_ws, size_t ws_size,
                              hipStream_t stream) {
    static int grid_blocks = 0;
    if (!grid_blocks) {
        int dev = 0, cus = 0, per_cu = 0;
        (void)hipGetDevice(&dev);
        (void)hipDeviceGetAttribute(&cus, hipDeviceAttributeMultiprocessorCount, dev);
        (void)hipOccupancyMaxActiveBlocksPerMultiprocessor(&per_cu, k_mega, 512, 0);
        if (per_cu > 1) per_cu = 1;
        if (per_cu < 1) per_cu = 1;
        grid_blocks = cus * per_cu;
    }
    Params p = make_params(d_in, d_out, d_ws);
    (void)hipMemsetAsync((char*)d_ws + OFF_BAR, 0, XCD_BAR_WORDS * 4, stream);
    void* args[] = {&p};
    hipError_t e = hipLaunchCooperativeKernel((const void*)k_mega, dim3(grid_blocks), dim3(512), args, 0, stream);
    if (e != hipSuccess) fprintf(stderr, "cooperative launch failed: %s (grid %d)\n", hipGetErrorString(e), grid_blocks);
}
```

```cpp
#include <hip/hip_runtime.h>
#include <hip/hip_cooperative_groups.h>
#include <math.h>
#include <stdint.h>
#include <stdio.h>
#include <string.h>
#define DI __device__ __forceinline__
typedef unsigned short bf16_t;
typedef short bf16x8 __attribute__((ext_vector_type(8)));
typedef short s16x4 __attribute__((ext_vector_type(4)));
typedef float f32x16 __attribute__((ext_vector_type(16)));
typedef float f32x4 __attribute__((ext_vector_type(4)));
typedef float f32x2 __attribute__((ext_vector_type(2)));
typedef unsigned u32x4 __attribute__((ext_vector_type(4)));
typedef unsigned u32x2 __attribute__((ext_vector_type(2)));
typedef __bf16 bf16x2v __attribute__((ext_vector_type(2)));
#define LAS __attribute__((address_space(3)))
#define MFMA32(a, b, c) __builtin_amdgcn_mfma_f32_32x32x16_bf16((a), (b), (c), 0, 0, 0)

constexpr int T_TOK = 16384, SEQ_L = 4096, DM = 1024, INC = 2208;
constexpr float LOG2E = 1.4426950408889634f;

DI int otid() { int t = threadIdx.x & 255; asm volatile("" : "+v"(t)); return t; }
DI int vhalf() { return __builtin_amdgcn_readfirstlane((int)(threadIdx.x >> 8)); }
DI int vbid() { return (int)blockIdx.x * 2 + vhalf(); }
DI int vgrid() { return (int)gridDim.x * 2; }
DI unsigned pack2(float lo, float hi) { f32x2 f = {lo, hi}; return __builtin_bit_cast(unsigned, __builtin_convertvector(f, bf16x2v)); }
DI float bf_lo(unsigned u) { return __uint_as_float(u << 16); }
DI float bf_hi(unsigned u) { return __uint_as_float(u & 0xffff0000u); }
DI float bf2f(bf16_t v) { return __uint_as_float(((unsigned)v) << 16); }
DI int crow(int reg, int hh) { return (reg & 3) + 8 * (reg >> 2) + 4 * hh; }
DI f32x16 zero16() { f32x16 z;
#pragma unroll
    for (int i = 0; i < 16; ++i) z[i] = 0.f; return z; }
DI float xhalf_max(float v) { auto r = __builtin_amdgcn_permlane32_swap(__float_as_uint(v), __float_as_uint(v), false, false); return fmaxf(__uint_as_float(r[0]), __uint_as_float(r[1])); }
DI float xhalf_other(float v, int lane) { auto r = __builtin_amdgcn_permlane32_swap(__float_as_uint(v), __float_as_uint(v), false, false); return __uint_as_float((lane & 32) ? r[0] : r[1]); }
DI float xhalf_sum(float v) { auto r = __builtin_amdgcn_permlane32_swap(__float_as_uint(v), __float_as_uint(v), false, false); return __uint_as_float(r[0]) + __uint_as_float(r[1]); }
DI bf16x8 ld16(const void* p) { return *(const bf16x8*)p; }
DI u32x4 ldu4(const void* p) { return *(const u32x4*)p; }
DI float fast_exp2(float x) { return __builtin_amdgcn_exp2f(x); }
DI bf16x8 pack_step(const f32x16& x, int s) {
    u32x4 p;
    p[0] = pack2(x[8 * s + 0], x[8 * s + 1]); p[1] = pack2(x[8 * s + 2], x[8 * s + 3]);
    p[2] = pack2(x[8 * s + 4], x[8 * s + 5]); p[3] = pack2(x[8 * s + 6], x[8 * s + 7]);
    return __builtin_bit_cast(bf16x8, p);
}
DI s16x4 tr_read_a(unsigned lds_byte_addr) { s16x4 r; asm volatile("ds_read_b64_tr_b16 %0, %1" : "=v"(r) : "v"(lds_byte_addr)); return r; }
#define TR_WAIT() do { asm volatile("s_waitcnt lgkmcnt(0)" ::: "memory"); __builtin_amdgcn_sched_barrier(0); } while (0)
DI s16x4 tr_read(unsigned lds_byte_addr) {
    return __builtin_amdgcn_ds_read_tr16_b64_v4i16((LAS s16x4*)(uintptr_t)lds_byte_addr);
}

constexpr size_t MiB = 1ull << 20;
constexpr size_t OFF_BAR = 0;
constexpr size_t OFF_WT_IN = 65536;
constexpr size_t OFF_WT_UQ = OFF_WT_IN + 2304ull * 1024 * 2;
constexpr size_t OFF_WT_UKV = OFF_WT_UQ + 768ull * 384 * 2;
constexpr size_t OFF_WT_OUT = OFF_WT_UKV + 1024ull * 256 * 2;
constexpr size_t OFF_WT_MQ = OFF_WT_OUT + 1024ull * 1024 * 2;
constexpr size_t OFF_WT_MKV = OFF_WT_MQ + 1024ull * 1024 * 2;
constexpr size_t OFF_WT_MO = OFF_WT_MKV + 2048ull * 1024 * 2;
constexpr size_t OFF_WT_PQ = OFF_WT_MO + 1024ull * 1024 * 2;
constexpr size_t OFF_KEYS = OFF_WT_PQ + 2048ull * 1024 * 2;
constexpr size_t OFF_ROPE = OFF_KEYS + 16ull * 128 * 128 * 2;
constexpr size_t OFF_KR = OFF_ROPE + 2ull * 4096 * 16 * 4;
constexpr size_t OFF_LSE = OFF_KR + (size_t)T_TOK * 32 * 2;
constexpr size_t OFF_SS1 = OFF_LSE + 3ull * T_TOK * 8 * 4;
constexpr size_t OFF_SS2 = OFF_SS1 + (size_t)T_TOK * 16 * 4;
constexpr size_t OFF_MEMN = OFF_SS2 + (size_t)T_TOK * 16 * 4;
constexpr size_t OFF_SMALL_END = OFF_MEMN + 1024ull * 1024 * 2;
static_assert(OFF_SMALL_END <= 28 * MiB, "small region overflow");
constexpr size_t OFF_A = 28 * MiB;
constexpr size_t OFF_PROJ = OFF_A;
constexpr size_t OFF_UQ = 193 * MiB;
constexpr size_t OFF_VQ = 209 * MiB;
constexpr size_t OFF_SU = 243 * MiB;
constexpr size_t OFF_SV = OFF_SU + 65536;
constexpr size_t OUT_ODIL = 0;
constexpr size_t OUT_OMLA = 48 * MiB;
constexpr size_t OUT_PQ = 0;
constexpr size_t OFF_B = 97 * MiB;
constexpr size_t OFF_XN = OFF_B, OFF_QMLA = OFF_B, OFF_MIXED = OFF_B, OFF_QM = OFF_B;
constexpr size_t OFF_C = 129 * MiB;
constexpr size_t OFF_KVMLA = OFF_C, OFF_HB = OFF_C;
constexpr size_t OFF_D = 161 * MiB;
constexpr size_t OFF_OM = OFF_D;
constexpr size_t OFF_SELID = 225 * MiB;
constexpr size_t OFF_SELG = 229 * MiB;
constexpr size_t OFF_KVM = 237 * MiB;
constexpr size_t OFF_SSQ = 241 * MiB;
constexpr size_t WS_NEEDED = 244 * MiB;

struct Params {
    const float* x; const float* mem; const float* norm_mix; const float* w_in; const float* q_norm; const float* kv_norm;
    const float* w_uq; const float* w_ukv; const float* gn_mla; const float* gn_dil; const float* w_out; const float* norm_mem_q;
    const float* norm_mem_kv; const float* w_mem_q; const float* w_mem_kv; const float* w_mem_o; const float* norm_ffn;
    const float* peer_w_q; const float* sub_keys; const float* peer_u; const float* peer_v; const float* norm_final;
    float* out; char* ws;
    float inv_freq[16];
    int prof; int pad_;
};
#define XB_TMO      128
#define XB_XCNT(j)  (256  + 64 * (j))
#define XB_XSUB(j)  (1280 + 64 * (j))
#define XB_XGEN(j)  (2304 + 64 * (j))
#define XB_TOP      3328
#define XB_TOPGEN   3392
#define XCD_BAR_WORDS 3456
#define XB_SPIN_CAP (1u << 20)
DI unsigned xb_ld(unsigned* p) { return __hip_atomic_load(p, __ATOMIC_RELAXED, __HIP_MEMORY_SCOPE_AGENT); }
DI unsigned xb_add(unsigned* p, unsigned v) { return __hip_atomic_fetch_add(p, v, __ATOMIC_RELAXED, __HIP_MEMORY_SCOPE_AGENT); }
DI unsigned xb_xcc_id() { return (unsigned)__builtin_amdgcn_s_getreg((3 << 11) | 20) & 0xFu; }
#define XB_SPIN(cond, bar) do { unsigned _sp = 0; while (cond) { __builtin_amdgcn_s_sleep(1); \
    if ((++_sp & 255u) == 0u) { if (xb_ld(&(bar)[XB_TMO])) break; if (_sp > XB_SPIN_CAP) { atomicAdd(&(bar)[XB_TMO], 1u); break; } } } } while (0)
struct XcdBarrier { unsigned* bar; unsigned x; volatile LAS unsigned* st; };
DI XcdBarrier xcd_barrier_post(unsigned* bar, volatile LAS unsigned* st) {
    XcdBarrier b; b.bar = bar; b.x = xb_xcc_id(); b.st = st;
    if (threadIdx.x == 0) (void)xb_add(&bar[XB_XCNT(b.x)], 1u);
    return b;
}
DI void xcd_barrier_complete(unsigned* bar, unsigned x, unsigned& nloc, unsigned& nx) {
    const unsigned G = gridDim.x * gridDim.y * gridDim.z;
    unsigned sum, cnt, mine, sp = 0u;
    for (;;) {
        sum = 0u; cnt = 0u; mine = 0u;
#pragma unroll
        for (unsigned j = 0; j < 16; ++j) { const unsigned c = xb_ld(&bar[XB_XCNT(j)]); sum += c; cnt += (c > 0u) ? 1u : 0u; mine = (j == x) ? c : mine; }
        if (sum == G) break;
        __builtin_amdgcn_s_sleep(1);
        if ((++sp & 255u) == 0u) { if (xb_ld(&bar[XB_TMO])) break; if (sp > XB_SPIN_CAP) { atomicAdd(&bar[XB_TMO], 1u); break; } }
    }
    nloc = mine > 0u ? mine : 1u; nx = cnt > 0u ? cnt : 1u;
}
DI void xcd_barrier(const XcdBarrier& b) {
    asm volatile("s_waitcnt vmcnt(0)" ::: "memory");
    __syncthreads();
    if (threadIdx.x == 0) {
        unsigned* bar = b.bar;
        __builtin_amdgcn_s_waitcnt(0);
        unsigned nloc = b.st[0], nx = b.st[1];
        if (nloc == 0u) { xcd_barrier_complete(bar, b.x, nloc, nx); b.st[0] = nloc; b.st[1] = nx; }
        const unsigned old = xb_add(&bar[XB_XSUB(b.x)], 1u);
        const unsigned gen = old / nloc;
        if (old + 1u == (gen + 1u) * nloc) {
            __builtin_amdgcn_fence(__ATOMIC_RELEASE, "agent");
            asm volatile("s_waitcnt vmcnt(0)" ::: "memory");
            const unsigned og = xb_add(&bar[XB_TOP], 1u);
            const unsigned tg = og / nx;
            if (og + 1u == (tg + 1u) * nx) xb_add(&bar[XB_TOPGEN], 1u);
            else XB_SPIN(xb_ld(&bar[XB_TOPGEN]) == tg, bar);
            __builtin_amdgcn_fence(__ATOMIC_ACQUIRE, "agent");
            xb_add(&bar[XB_XGEN(b.x)], 1u);
            asm volatile("s_waitcnt vmcnt(0)" ::: "memory");
        } else {
            XB_SPIN(xb_ld(&bar[XB_XGEN(b.x)]) == gen, bar);
            __builtin_amdgcn_fence(__ATOMIC_ACQUIRE, "agent");
            asm volatile("s_waitcnt vmcnt(0)" ::: "memory");
        }
    }
    __syncthreads();
}
DI void transpose_tile(const float* __restrict__ W, int K, int N, const float* __restrict__ g, bf16_t* __restrict__ Wt, int kt, int nt, char* lds, bool valid) {
    float* sm = (float*)lds;
    const int t = otid();
    const int k0 = kt * 64, n0 = nt * 64;
    __syncthreads();
#pragma unroll
    for (int i = 0; i < 16; ++i) {
        const int id = t + 256 * i, k = id >> 6, n = id & 63;
        float v = 0.f;
        if (valid && n0 + n < N) { v = W[(size_t)(k0 + k) * N + n0 + n]; if (g) v *= g[k0 + k]; }
        sm[k * 65 + n] = v;
    }
    __syncthreads();
    const int n = t >> 2, kc = (t & 3) * 16;
    u32x4 o0, o1;
    o0[0] = pack2(sm[(kc + 0) * 65 + n], sm[(kc + 1) * 65 + n]); o0[1] = pack2(sm[(kc + 2) * 65 + n], sm[(kc + 3) * 65 + n]);
    o0[2] = pack2(sm[(kc + 4) * 65 + n], sm[(kc + 5) * 65 + n]); o0[3] = pack2(sm[(kc + 6) * 65 + n], sm[(kc + 7) * 65 + n]);
    o1[0] = pack2(sm[(kc + 8) * 65 + n], sm[(kc + 9) * 65 + n]); o1[1] = pack2(sm[(kc + 10) * 65 + n], sm[(kc + 11) * 65 + n]);
    o1[2] = pack2(sm[(kc + 12) * 65 + n], sm[(kc + 13) * 65 + n]); o1[3] = pack2(sm[(kc + 14) * 65 + n], sm[(kc + 15) * 65 + n]);
    bf16_t* dst = Wt + (size_t)(n0 + n) * K + k0 + kc;
    if (valid) { *(u32x4*)dst = o0; *(u32x4*)(dst + 8) = o1; }
}

DI void rmsnorm_row_bf16(const float* __restrict__ in, const float* __restrict__ g, bf16_t* __restrict__ out, int lane) {
    f32x4 v[4]; float ss = 0.f;
#pragma unroll
    for (int i = 0; i < 4; ++i) { v[i] = *(const f32x4*)(in + 4 * lane + 256 * i); ss += v[i][0] * v[i][0] + v[i][1] * v[i][1] + v[i][2] * v[i][2] + v[i][3] * v[i][3]; }
#pragma unroll
    for (int o = 32; o; o >>= 1) ss += __shfl_xor(ss, o);
    const float rs = rsqrtf(ss * (1.0f / 1024.0f) + 1e-6f);
#pragma unroll
    for (int i = 0; i < 4; ++i) {
        const f32x4 gg = *(const f32x4*)(g + 4 * lane + 256 * i);
        u32x2 o; o[0] = pack2(v[i][0] * rs * gg[0], v[i][1] * rs * gg[1]); o[1] = pack2(v[i][2] * rs * gg[2], v[i][3] * rs * gg[3]);
        *(u32x2*)(out + 4 * lane + 256 * i) = o;
    }
}

struct TrJob { const float* W; const float* g; size_t off; int K, N, Npad; };

DI void phase_prep(const Params& p, char* lds) {
    char* ws = p.ws;
    const int t = otid(), lane = t & 63, wv = t >> 6;
    const int c0 = 576, c1 = c0 + 72, c2 = c1 + 64, c3 = c2 + 256, c4 = c3 + 256, c5 = c4 + 512, c6 = c5 + 256, c7 = c6 + 512;
    const int nrow = (T_TOK + 1024) / 4;
    const int nkeys = 128, nrope = 256;
    const int total = c7 + nrow + nkeys + nrope;
    for (int k = 0; k < (c7 + vgrid() - 1) / vgrid(); ++k) {
        const int raw = vbid() + k * vgrid();
        const bool valid = raw < c7;
        const int item = valid ? raw : 0;
        const float* W; const float* g; size_t off; int K, N, Npad, local;
        if (item < c0)      { W = p.w_in;     g = nullptr;      off = OFF_WT_IN;  K = 1024; N = 2208; Npad = 2304; local = item; }
        else if (item < c1) { W = p.w_uq;     g = p.q_norm;     off = OFF_WT_UQ;  K = 384;  N = 768;  Npad = 768;  local = item - c0; }
        else if (item < c2) { W = p.w_ukv;    g = p.kv_norm;    off = OFF_WT_UKV; K = 256;  N = 1024; Npad = 1024; local = item - c1; }
        else if (item < c3) { W = p.w_out;    g = nullptr;      off = OFF_WT_OUT; K = 1024; N = 1024; Npad = 1024; local = item - c2; }
        else if (item < c4) { W = p.w_mem_q;  g = p.norm_mem_q; off = OFF_WT_MQ;  K = 1024; N = 1024; Npad = 1024; local = item - c3; }
        else if (item < c5) { W = p.w_mem_kv; g = nullptr;      off = OFF_WT_MKV; K = 1024; N = 2048; Npad = 2048; local = item - c4; }
        else if (item < c6) { W = p.w_mem_o;  g = nullptr;      off = OFF_WT_MO;  K = 1024; N = 1024; Npad = 1024; local = item - c5; }
        else                { W = p.peer_w_q; g = p.norm_ffn;   off = OFF_WT_PQ;  K = 1024; N = 2048; Npad = 2048; local = item - c6; }
        const int ntn = Npad / 64;
        transpose_tile(W, K, N, g, (bf16_t*)(ws + off), local / ntn, local % ntn, lds, valid);
    }
    for (int item = c7 + vbid(); item < total; item += vgrid()) {
        if (item < c7 + nrow) {
            const int row = (item - c7) * 4 + wv;
            if (row < T_TOK) rmsnorm_row_bf16(p.x + (size_t)row * 1024, p.norm_mix, (bf16_t*)(ws + OFF_XN) + (size_t)row * 1024, lane);
            else rmsnorm_row_bf16(p.mem + (size_t)(row - T_TOK) * 1024, p.norm_mem_kv, (bf16_t*)(ws + OFF_MEMN) + (size_t)(row - T_TOK) * 1024, lane);
        } else if (item < c7 + nrow + nkeys) {
            const int idx = ((item - c7 - nrow) * 256 + t) * 8;
            const f32x4 a = *(const f32x4*)(p.sub_keys + idx), b = *(const f32x4*)(p.sub_keys + idx + 4);
            u32x4 o; o[0] = pack2(a[0], a[1]); o[1] = pack2(a[2], a[3]); o[2] = pack2(b[0], b[1]); o[3] = pack2(b[2], b[3]);
            *(u32x4*)((bf16_t*)(ws + OFF_KEYS) + idx) = o;
        } else {
            const int idx = (item - c7 - nrow - nkeys) * 256 + t;
            const int s = idx >> 4, i = idx & 15;
            const float ang = (float)s * p.inv_freq[i];
            const double a = (double)ang;
            const double twopi = 6.283185307179586476925;
            const float rf = (float)(a - twopi * rint(a / twopi));
            float* cs = (float*)(ws + OFF_ROPE);
            cs[idx] = cosf(rf); cs[65536 + idx] = sinf(rf);
        }
    }
}
namespace pg8 {
#define PG8_LAS __attribute__((address_space(3)))
typedef unsigned short bf16_t;
typedef short bf16x8 __attribute__((ext_vector_type(8)));
typedef float f32x4 __attribute__((ext_vector_type(4)));
typedef unsigned u32x4 __attribute__((ext_vector_type(4)));
constexpr int BM = 256, BK = 64, HALF = 128, HTB = HALF * BK * 2  , STAGE_BYTES = 8 * HTB, NXCD = 8, WGM = 8;

__host__ __device__ __forceinline__ int lds_byte(int r, int c) { const int st = (r >> 4) * 2 + (c >> 5), rr = r & 15, cc = c & 31, ob = rr * 64 + cc * 2; return st * 1024 + (ob ^ (((ob >> 9) & 1) << 5)); }
__host__ __device__ __forceinline__ void stage_rc(int b, int& R, int& C) { const int st = b / 1024, sb = b % 1024, swz = sb ^ (((sb >> 9) & 1) << 5); R = (st >> 1) * 16 + swz / 64; C = (st & 1) * 32 + (swz % 64) / 2; }
__host__ __device__ __forceinline__ int perm32(int rho) { const int n = rho >> 4, i = rho & 15; return 8 * (i >> 2) + 4 * n + (i & 3); }

struct Unit { int pm, pn; };
struct Gemm { const bf16_t* A; const bf16_t* Bt; int M, N, K, lda; };

struct StaticOrder {
    int nM, nN, nwg, G, c;
    __host__ __device__ void init(int M, int N, int G_, int c_) { nM = M / BM; nN = N / BM; nwg = nM * nN; G = G_; c = c_; }
    __host__ __device__ bool next(int i, Unit& u) const {
        const long L = (long)i * G + c; if (L >= nwg) return false;
        int wgid = (int)L; { const int q = nwg / NXCD, r = nwg % NXCD, xcd = wgid % NXCD, off = wgid / NXCD; wgid = (xcd < r ? xcd * (q + 1) : r * (q + 1) + (xcd - r) * q) + off; }
        const int nig = WGM * nN, gid = wgid / nig, fm = gid * WGM, gsz = (nM - fm) < WGM ? (nM - fm) : WGM;
        u.pm = fm + ((wgid % nig) % gsz); u.pn = (wgid % nig) / gsz; return true;
    }
    __device__ __forceinline__ void a_ready(const Unit&) const {}
    __device__ __forceinline__ void done(const Unit&) const {}
};

template <class Epi, class Sched, bool ALIGN_EPI = false, bool SP2 = false>
__device__ __forceinline__ void gemm_phase(PG8_LAS unsigned char* lds, const Gemm g, const Sched& S, const Epi& E) {
    int tid_ = threadIdx.x; asm volatile("" : "+v"(tid_));
    const int tid = tid_, wid = __builtin_amdgcn_readfirstlane(tid >> 6), lane = tid & 63, wr = wid >> 2, wc = wid & 3, fr = lane & 15, fq = lane >> 4;
    const int K = g.K, nt = K / BK, lda = g.lda;
    unsigned voffA[2], voffB[2];
#pragma unroll
    for (int i = 0; i < 2; ++i) { int R, C; stage_rc(tid * 16 + i * 8192, R, C); const int Rb = Epi::PERM ? ((R & ~31) + perm32(R & 31)) : R;
        voffA[i] = (unsigned)(R * lda + C) * 2u; voffB[i] = (unsigned)(Rb * K + C) * 2u; }
    const size_t kstep = (size_t)(BK * 2);
    const size_t hstepB = (size_t)HALF * K * 2, hstepA = (size_t)HALF * lda * 2;
    const size_t tstepB = 2 * hstepB, tstepA = 2 * hstepA;
    const unsigned ldsw = (unsigned)wid * 1024u;
    const int aoff = lds_byte(wr * 64 + fr, fq * 8), boff = lds_byte(wc * 32 + fr, fq * 8);
#define PG8_SA(b, h) (((b) * 2 + (h)) * HTB)
#define PG8_SB(b, h) ((4 + (b) * 2 + (h)) * HTB)
#define PG8_STAGE(bufoff, gbase, voff) do { _Pragma("unroll") for (int _i = 0; _i < 2; ++_i) \
        __builtin_amdgcn_global_load_lds((const unsigned*)((const char*)(gbase) + (voff)[_i]), (PG8_LAS unsigned*)(lds + (bufoff) + ldsw + _i * 8192), 16, 0, 0); } while (0)
#define PG8_LDA(dst, b, h) do { _Pragma("unroll") for (int m = 0; m < 4; ++m) _Pragma("unroll") for (int k = 0; k < 2; ++k) dst[m][k] = *(const PG8_LAS bf16x8*)(lds + PG8_SA(b, h) + aoff + m * 2048 + k * 1024); } while (0)
#define PG8_LDB(dst, b, h) do { _Pragma("unroll") for (int n = 0; n < 2; ++n) _Pragma("unroll") for (int k = 0; k < 2; ++k) dst[n][k] = *(const PG8_LAS bf16x8*)(lds + PG8_SB(b, h) + boff + n * 2048 + k * 1024); } while (0)
#define PG8_MMA(ai, bj, At, Bt) do { __builtin_amdgcn_s_setprio(1); _Pragma("unroll") for (int m = 0; m < 4; ++m) _Pragma("unroll") for (int n = 0; n < 2; ++n) _Pragma("unroll") for (int k = 0; k < 2; ++k) \
        acc[ai][bj][m][n] = __builtin_amdgcn_mfma_f32_16x16x32_bf16(Bt[n][k], At[m][k], acc[ai][bj][m][n], 0, 0, 0); __builtin_amdgcn_s_setprio(0); } while (0)
#define PG8_WAIT_V(n) asm volatile("s_waitcnt vmcnt(" #n ")" ::: "memory")
#define PG8_WAIT_L(n) asm volatile("s_waitcnt lgkmcnt(" #n ")" ::: "memory")
#define PG8_BAR __builtin_amdgcn_s_barrier()
#define PG8_SCHED __builtin_amdgcn_sched_barrier(0)
    Unit cur, nxt; int ui = 0;
    if (!S.next(0, cur)) return;
    f32x4 acc[2][2][4][2];
#pragma unroll
    for (int a = 0; a < 2; ++a)
#pragma unroll
        for (int b = 0; b < 2; ++b)
#pragma unroll
            for (int m = 0; m < 4; ++m)
#pragma unroll
                for (int n = 0; n < 2; ++n) acc[a][b][m][n] = (f32x4){0.f, 0.f, 0.f, 0.f};
    bf16x8 At[4][2], B0[2][2], B1[2][2];
    const char* cA = (const char*)g.A + (size_t)cur.pm * tstepA; const char* cB = (const char*)g.Bt + (size_t)cur.pn * tstepB;
    S.a_ready(cur);
    if constexpr (SP2) {
        PG8_STAGE(PG8_SB(0, 0), cB, voffB); PG8_STAGE(PG8_SB(0, 1), cB + hstepB, voffB); PG8_STAGE(PG8_SA(0, 0), cA, voffA); PG8_STAGE(PG8_SA(0, 1), cA + hstepA, voffA);
        if (wr == 1) PG8_BAR;
        PG8_WAIT_V(2); PG8_BAR;
        PG8_STAGE(PG8_SB(1, 0), cB + kstep, voffB); PG8_STAGE(PG8_SA(1, 0), cA + kstep, voffA); PG8_STAGE(PG8_SB(1, 1), cB + hstepB + kstep, voffB);
        PG8_WAIT_V(6); PG8_BAR;
    } else {
        PG8_STAGE(PG8_SB(0, 0), cB, voffB); PG8_STAGE(PG8_SA(0, 0), cA, voffA); PG8_STAGE(PG8_SB(0, 1), cB + hstepB, voffB); PG8_STAGE(PG8_SA(0, 1), cA + hstepA, voffA);
        if (wr == 1) PG8_BAR;
        PG8_WAIT_V(4); PG8_BAR;
        PG8_STAGE(PG8_SB(1, 0), cB + kstep, voffB); PG8_STAGE(PG8_SA(1, 0), cA + kstep, voffA); PG8_STAGE(PG8_SB(1, 1), cB + hstepB + kstep, voffB);
        PG8_WAIT_V(6); PG8_BAR;
    }
    for (;;) {
        const bool has_next = S.next(ui + 1, nxt);
        const char* nA = has_next ? (const char*)g.A + (size_t)nxt.pm * tstepA : cA; const char* nB = has_next ? (const char*)g.Bt + (size_t)nxt.pn * tstepB : cB;
#pragma unroll 1
        for (int t = 0; t < nt; t += 2) {
            const bool last = (t == nt - 2);
            const char* a1 = cA + (size_t)(t + 1) * kstep;
            const char* a2 = last ? nA : cA + (size_t)(t + 2) * kstep; const char* b2 = last ? nB : cB + (size_t)(t + 2) * kstep;
            const char* a3 = a2 + kstep; const char* b3 = b2 + kstep;
            if (last && has_next) S.a_ready(nxt);
            if constexpr (SP2) {
            PG8_LDB(B0, 0, 0); PG8_LDB(B1, 0, 1); PG8_SCHED; PG8_LDA(At, 0, 0); PG8_STAGE(PG8_SA(1, 1), a1 + hstepA, voffA);
            PG8_WAIT_V(8); PG8_WAIT_L(0); PG8_BAR; PG8_MMA(0, 0, At, B0); PG8_MMA(0, 1, At, B1); PG8_BAR; PG8_SCHED;
            PG8_LDA(At, 0, 1); PG8_STAGE(PG8_SB(0, 0), b2, voffB); PG8_STAGE(PG8_SB(0, 1), b2 + hstepB, voffB); PG8_STAGE(PG8_SA(0, 0), a2, voffA);
            PG8_WAIT_V(8); PG8_WAIT_L(0); PG8_BAR; PG8_MMA(1, 0, At, B0); PG8_MMA(1, 1, At, B1); PG8_BAR; PG8_SCHED;
            PG8_LDB(B0, 1, 0); PG8_LDB(B1, 1, 1); PG8_SCHED; PG8_LDA(At, 1, 0); PG8_STAGE(PG8_SA(0, 1), a2 + hstepA, voffA);
            PG8_WAIT_V(8); PG8_WAIT_L(0); PG8_BAR; PG8_MMA(0, 0, At, B0); PG8_MMA(0, 1, At, B1); PG8_BAR; PG8_SCHED;
            PG8_LDA(At, 1, 1); PG8_STAGE(PG8_SB(1, 0), b3, voffB); PG8_STAGE(PG8_SB(1, 1), b3 + hstepB, voffB); PG8_STAGE(PG8_SA(1, 0), a3, voffA);
            PG8_WAIT_V(8); PG8_WAIT_L(0); PG8_BAR; PG8_MMA(1, 0, At, B0); PG8_MMA(1, 1, At, B1); PG8_BAR; PG8_SCHED;
            } else {
            PG8_LDB(B0, 0, 0); PG8_SCHED; PG8_LDA(At, 0, 0); PG8_STAGE(PG8_SA(1, 1), a1 + hstepA, voffA);
            PG8_WAIT_L(8); PG8_BAR; PG8_WAIT_L(0); PG8_MMA(0, 0, At, B0); PG8_BAR; PG8_SCHED;
            PG8_LDB(B1, 0, 1); PG8_STAGE(PG8_SB(0, 0), b2, voffB);
            PG8_BAR; PG8_WAIT_L(0); PG8_MMA(0, 1, At, B1); PG8_BAR;
            PG8_LDA(At, 0, 1); PG8_STAGE(PG8_SA(0, 0), a2, voffA);
            PG8_BAR; PG8_WAIT_L(0); PG8_MMA(1, 0, At, B0); PG8_BAR; PG8_SCHED;
            PG8_STAGE(PG8_SB(0, 1), b2 + hstepB, voffB);
            PG8_WAIT_V(6); PG8_BAR; PG8_MMA(1, 1, At, B1); PG8_BAR;
            PG8_LDB(B0, 1, 0); PG8_SCHED; PG8_LDA(At, 1, 0); PG8_STAGE(PG8_SA(0, 1), a2 + hstepA, voffA);
            PG8_WAIT_L(8); PG8_BAR; PG8_WAIT_L(0); PG8_MMA(0, 0, At, B0); PG8_BAR; PG8_SCHED;
            PG8_LDB(B1, 1, 1); PG8_STAGE(PG8_SB(1, 0), b3, voffB);
            PG8_BAR; PG8_WAIT_L(0); PG8_MMA(0, 1, At, B1); PG8_BAR;
            PG8_LDA(At, 1, 1); PG8_STAGE(PG8_SA(1, 0), a3, voffA);
            PG8_BAR; PG8_WAIT_L(0); PG8_MMA(1, 0, At, B0); PG8_BAR; PG8_SCHED;
            PG8_STAGE(PG8_SB(1, 1), b3 + hstepB, voffB);
            PG8_WAIT_V(6); PG8_BAR; PG8_MMA(1, 1, At, B1); PG8_BAR;
            }
        }
        if constexpr (ALIGN_EPI) { if (wr == 0) PG8_BAR; }
        if constexpr (!Epi::AFTER_DRAIN) { E(acc, cur, wr, wc, fr, fq); S.done(cur); }
        if (!has_next) break;
#pragma unroll
        for (int a = 0; a < 2; ++a)
#pragma unroll
            for (int b = 0; b < 2; ++b)
#pragma unroll
                for (int m = 0; m < 4; ++m)
#pragma unroll
                    for (int n = 0; n < 2; ++n) acc[a][b][m][n] = (f32x4){0.f, 0.f, 0.f, 0.f};
        cur = nxt; cA = nA; cB = nB; ++ui;
        if constexpr (ALIGN_EPI) { if (wr == 1) PG8_BAR; }
    }
    PG8_WAIT_V(0);
    if constexpr (!ALIGN_EPI) { if (wr == 0) PG8_BAR; }
    PG8_BAR;
    if constexpr (Epi::AFTER_DRAIN) { E.fused(acc, cur, wr, wc, fr, fq, lds, wid, lane); S.done(cur); }
#undef PG8_SA
#undef PG8_SB
#undef PG8_STAGE
#undef PG8_LDA
#undef PG8_LDB
#undef PG8_MMA
#undef PG8_WAIT_V
#undef PG8_WAIT_L
#undef PG8_BAR
#undef PG8_SCHED
}
}
DI unsigned sw_off(int row, int chunk) { return (unsigned)(row * 128 + ((chunk ^ ((row >> 1) & 7)) << 4)); }
#define GLDS16(gsrc, ldst) __builtin_amdgcn_global_load_lds((const unsigned*)(gsrc), (unsigned*)(ldst), 16, 0, 0)
DI u32x2 pack4(float a, float b, float c, float d) { u32x2 o; o[0] = pack2(a, b); o[1] = pack2(c, d); return o; }
#define EPI_ARGS const f32x4 (&acc)[2][2][4][2], const pg8::Unit& u, int wr, int wc, int fr, int fq
DI float xq_sum(float v) {
    v += __uint_as_float((unsigned)__builtin_amdgcn_ds_swizzle((int)__float_as_uint(v), 0x401F));
    return xhalf_sum(v);
}
DI u32x4 pack8(const float (&v)[8], float sc) {
    u32x4 o; o[0] = pack2(v[0] * sc, v[1] * sc); o[1] = pack2(v[2] * sc, v[3] * sc); o[2] = pack2(v[4] * sc, v[5] * sc); o[3] = pack2(v[6] * sc, v[7] * sc); return o;
}
DI void rope8(const float (&v)[8], float sc, const float* __restrict__ cs, int pos, int fq, int lane, bf16_t* dst32  ) {
    const int i0 = 8 * (fq & 1);
    const f32x4 c0 = *(const f32x4*)(cs + pos * 16 + i0), c1 = *(const f32x4*)(cs + pos * 16 + i0 + 4);
    const f32x4 s0 = *(const f32x4*)(cs + 65536 + pos * 16 + i0), s1 = *(const f32x4*)(cs + 65536 + pos * 16 + i0 + 4);
    const float sg = (fq < 2) ? -1.0f : 1.0f;
    float o[8];
#pragma unroll
    for (int e = 0; e < 8; ++e) {
        const float own = v[e] * sc, oth = xhalf_other(own, lane);
        const float c = (e < 4) ? c0[e & 3] : c1[e & 3], s = (e < 4) ? s0[e & 3] : s1[e & 3];
        o[e] = own * c + sg * oth * s;
    }
    *(u32x4*)(dst32 + 8 * fq) = pack8(o, 1.0f);
}
#define EPI_LOAD8(v, ai, bj, m) float v[8]; { const f32x4 x0_ = acc[ai][bj][m][0], x1_ = acc[ai][bj][m][1]; v[0] = x0_[0]; v[1] = x0_[1]; v[2] = x0_[2]; v[3] = x0_[3]; v[4] = x1_[0]; v[5] = x1_[1]; v[6] = x1_[2]; v[7] = x1_[3]; }

struct EpiPlain8 {
    static constexpr bool PERM = true, AFTER_DRAIN = false;
    bf16_t* out; int ld;
    DI void operator()(EPI_ARGS) const {
#pragma unroll
        for (int ai = 0; ai < 2; ++ai)
#pragma unroll
            for (int m = 0; m < 4; ++m) {
                int fr_ = fr; asm volatile("" : "+v"(fr_));
                const size_t tok = (size_t)u.pm * 256 + ai * 128 + wr * 64 + m * 16 + fr_;
#pragma unroll
                for (int bj = 0; bj < 2; ++bj) { EPI_LOAD8(v, ai, bj, m); *(u32x4*)(out + tok * ld + u.pn * 256 + bj * 128 + wc * 32 + 8 * fq) = pack8(v, 1.0f); }
            }
    }
};

struct EpiProj8 {
    static constexpr bool PERM = true, AFTER_DRAIN = false;
    bf16_t* proj; bf16_t* kr; const float* cs; float* ssq;
    DI void operator()(EPI_ARGS) const {
        const int lane = fr + 16 * fq;
#pragma unroll
        for (int bj = 0; bj < 2; ++bj) {
            const int cg = u.pn * 256 + bj * 128 + wc * 32;
            if (cg >= INC) continue;
            const int g32 = cg >> 5;
            const float sc = (cg >= 672 && cg < 1184) ? 0.125f * LOG2E : 1.0f;
#pragma unroll
            for (int ai = 0; ai < 2; ++ai)
#pragma unroll
                for (int m = 0; m < 4; ++m) {
                    int fr_ = fr; asm volatile("" : "+v"(fr_));
                const size_t tok = (size_t)u.pm * 256 + ai * 128 + wr * 64 + m * 16 + fr_;
                    EPI_LOAD8(v, ai, bj, m);
                    if (g32 < 20) {
                        float ss = 0.f;
#pragma unroll
                        for (int e = 0; e < 8; ++e) ss += v[e] * v[e];
                        ss = xq_sum(ss);
                        if (fq == 0) ssq[tok * 24 + g32] = ss;
                    }
                    if (cg == 640) rope8(v, 1.0f, cs, (int)(tok & (SEQ_L - 1)), fq, lane, kr + tok * 32);
                    else *(u32x4*)(proj + tok * INC + cg + 8 * fq) = pack8(v, sc);
                }
        }
    }
};

struct EpiUpQ8 {
    static constexpr bool PERM = true, AFTER_DRAIN = false;
    bf16_t* q; const float* cs; const float* ssq;
    DI void operator()(EPI_ARGS) const {
        const int lane = fr + 16 * fq;
        const float qs = 0.10206207261596575f * LOG2E;
#pragma unroll
        for (int ai = 0; ai < 2; ++ai)
#pragma unroll
            for (int m = 0; m < 4; ++m) {
                int fr_ = fr; asm volatile("" : "+v"(fr_));
                const size_t tok = (size_t)u.pm * 256 + ai * 128 + wr * 64 + m * 16 + fr_;
                const f32x4 a0 = *(const f32x4*)(ssq + tok * 24), a1 = *(const f32x4*)(ssq + tok * 24 + 4), a2 = *(const f32x4*)(ssq + tok * 24 + 8);
                const float tot = (a0[0] + a0[1] + a0[2] + a0[3]) + (a1[0] + a1[1] + a1[2] + a1[3]) + (a2[0] + a2[1] + a2[2] + a2[3]);
                const float sc = rsqrtf(tot * (1.0f / 384.0f) + 1e-6f) * qs;
#pragma unroll
                for (int bj = 0; bj < 2; ++bj) {
                    const int cg = u.pn * 256 + bj * 128 + wc * 32;
                    EPI_LOAD8(v, ai, bj, m);
                    if ((cg % 96) == 64) rope8(v, sc, cs, (int)(tok & (SEQ_L - 1)), fq, lane, q + tok * 768 + cg);
                    else *(u32x4*)(q + tok * 768 + cg + 8 * fq) = pack8(v, sc);
                }
            }
    }
};

struct EpiUpKV8 {
    static constexpr bool PERM = true, AFTER_DRAIN = false;
    bf16_t* kv; const float* ssq;
    DI void operator()(EPI_ARGS) const {
#pragma unroll
        for (int ai = 0; ai < 2; ++ai)
#pragma unroll
            for (int m = 0; m < 4; ++m) {
                int fr_ = fr; asm volatile("" : "+v"(fr_));
                const size_t tok = (size_t)u.pm * 256 + ai * 128 + wr * 64 + m * 16 + fr_;
                const f32x4 a0 = *(const f32x4*)(ssq + tok * 24 + 12), a1 = *(const f32x4*)(ssq + tok * 24 + 16);
                const float tot = (a0[0] + a0[1] + a0[2] + a0[3]) + (a1[0] + a1[1] + a1[2] + a1[3]);
                const float sc = rsqrtf(tot * (1.0f / 256.0f) + 1e-6f);
#pragma unroll
                for (int bj = 0; bj < 2; ++bj) { EPI_LOAD8(v, ai, bj, m); *(u32x4*)(kv + tok * 1024 + u.pn * 256 + bj * 128 + wc * 32 + 8 * fq) = pack8(v, sc); }
            }
    }
};

template <bool RBF16>
struct EpiResid8 {
    static constexpr bool PERM = true, AFTER_DRAIN = false;
    const void* R; bf16_t* HB; float* SS;
    DI void operator()(EPI_ARGS) const {
#pragma unroll
        for (int ai = 0; ai < 2; ++ai) {
            f32x4 rv[4][2][2];
#pragma unroll
            for (int m = 0; m < 4; ++m)
#pragma unroll
                for (int bj = 0; bj < 2; ++bj) {
                    const size_t off = ((size_t)u.pm * 256 + ai * 128 + wr * 64 + m * 16 + fr) * 1024 + u.pn * 256 + bj * 128 + wc * 32 + 8 * fq;
                    if (RBF16) {
                        const u32x4 w = ldu4((const bf16_t*)R + off);
                        rv[m][bj][0] = (f32x4){bf_lo(w[0]), bf_hi(w[0]), bf_lo(w[1]), bf_hi(w[1])};
                        rv[m][bj][1] = (f32x4){bf_lo(w[2]), bf_hi(w[2]), bf_lo(w[3]), bf_hi(w[3])};
                    } else {
                        rv[m][bj][0] = *(const f32x4*)((const float*)R + off); rv[m][bj][1] = *(const f32x4*)((const float*)R + off + 4);
                    }
                }
#pragma unroll
            for (int m = 0; m < 4; ++m) {
                int fr_ = fr; asm volatile("" : "+v"(fr_));
                const size_t tok = (size_t)u.pm * 256 + ai * 128 + wr * 64 + m * 16 + fr_;
                float ss = 0.f;
#pragma unroll
                for (int bj = 0; bj < 2; ++bj) {
                    const size_t off = tok * 1024 + u.pn * 256 + bj * 128 + wc * 32 + 8 * fq;
                    const f32x4 h0 = rv[m][bj][0] + acc[ai][bj][m][0], h1 = rv[m][bj][1] + acc[ai][bj][m][1];
                    u32x4 o; o[0] = pack2(h0[0], h0[1]); o[1] = pack2(h0[2], h0[3]); o[2] = pack2(h1[0], h1[1]); o[3] = pack2(h1[2], h1[3]);
                    *(u32x4*)(HB + off) = o;
                    const float a0 = bf_lo(o[0]), a1 = bf_hi(o[0]), a2 = bf_lo(o[1]), a3 = bf_hi(o[1]), a4 = bf_lo(o[2]), a5 = bf_hi(o[2]), a6 = bf_lo(o[3]), a7 = bf_hi(o[3]);
                    ss += (a0 * a0 + a1 * a1) + (a2 * a2 + a3 * a3) + (a4 * a4 + a5 * a5) + (a6 * a6 + a7 * a7);
                }
                ss = xq_sum(ss);
                if (fq == 0) SS[tok * 16 + 4 * u.pn + wc] = ss;
            }
        }
    }
};

struct EpiRowScale8 {
    static constexpr bool PERM = true, AFTER_DRAIN = false;
    bf16_t* out; int ld; const float* SS; float extra;
    DI void operator()(EPI_ARGS) const {
#pragma unroll
        for (int ai = 0; ai < 2; ++ai)
#pragma unroll
            for (int m = 0; m < 4; ++m) {
                int fr_ = fr; asm volatile("" : "+v"(fr_));
                const size_t tok = (size_t)u.pm * 256 + ai * 128 + wr * 64 + m * 16 + fr_;
                const f32x4 s0 = *(const f32x4*)(SS + tok * 16), s1 = *(const f32x4*)(SS + tok * 16 + 4), s2 = *(const f32x4*)(SS + tok * 16 + 8), s3 = *(const f32x4*)(SS + tok * 16 + 12);
                const float tot = (s0[0] + s0[1] + s0[2] + s0[3]) + (s1[0] + s1[1] + s1[2] + s1[3]) + (s2[0] + s2[1] + s2[2] + s2[3]) + (s3[0] + s3[1] + s3[2] + s3[3]);
                const float sc = rsqrtf(tot * (1.0f / 1024.0f) + 1e-6f) * extra;
#pragma unroll
                for (int bj = 0; bj < 2; ++bj) { EPI_LOAD8(v, ai, bj, m); *(u32x4*)(out + tok * ld + u.pn * 256 + bj * 128 + wc * 32 + 8 * fq) = pack8(v, sc); }
            }
    }
};

template <class Epi>
DI void gemm8(char* smem, const bf16_t* A, int lda, const bf16_t* Bt, int M, int N, int K, const Epi& e, int cshift = 0) {
    pg8::Gemm g; g.A = A; g.Bt = Bt; g.M = M; g.N = N; g.K = K; g.lda = lda;
    const int G = (int)gridDim.x;
    pg8::StaticOrder S; S.init(M, N, G, ((int)blockIdx.x + G - cshift) % G);
    pg8::gemm_phase<Epi, pg8::StaticOrder, true, true>((PG8_LAS unsigned char*)smem, g, S, e);
}

DI void quant_rows4(const Params& p, int it, int wv, int lane);
DI void phase_p1(const Params& p, char* smem) {
    char* ws = p.ws;
    const int G = (int)gridDim.x, nproj = 9 * 64, nkvm = 8 * 4;
    const int last = nproj % G;
    { EpiProj8 e{(bf16_t*)(ws + OFF_PROJ), (bf16_t*)(ws + OFF_KR), (const float*)(ws + OFF_ROPE), (float*)(ws + OFF_SSQ)};
      gemm8(smem, (const bf16_t*)(ws + OFF_XN), 1024, (const bf16_t*)(ws + OFF_WT_IN), T_TOK, 2304, 1024, e); }
    { EpiPlain8 e{(bf16_t*)(ws + OFF_KVM), 2048};
      gemm8(smem, (const bf16_t*)(ws + OFF_MEMN), 1024, (const bf16_t*)(ws + OFF_WT_MKV), 1024, 2048, 1024, e, last); }
    int q0 = last + nkvm, nq = G - q0;
    if (last == 0 || nq <= 0) { q0 = 0; nq = G; }
    if ((int)blockIdx.x >= q0) {
        const int t = otid(), lane = t & 63, wv = t >> 6;
        for (int it = ((int)blockIdx.x - q0) * 2 + vhalf(); it < 8192; it += 2 * nq) quant_rows4(p, it, wv, lane);
    }
}
DI void phase_p2(const Params& p, char* smem) {
    char* ws = p.ws;
    { EpiUpQ8 e{(bf16_t*)(ws + OFF_QMLA), (const float*)(ws + OFF_ROPE), (const float*)(ws + OFF_SSQ)};
      gemm8(smem, (const bf16_t*)(ws + OFF_PROJ), INC, (const bf16_t*)(ws + OFF_WT_UQ), T_TOK, 768, 384, e); }
    { EpiUpKV8 e{(bf16_t*)(ws + OFF_KVMLA), (const float*)(ws + OFF_SSQ)};
      gemm8(smem, (const bf16_t*)(ws + OFF_PROJ) + 384, INC, (const bf16_t*)(ws + OFF_WT_UKV), T_TOK, 1024, 256, e); }
}
template <bool RBF16>
DI void phase_resid(const Params& p, char* smem, size_t off_w, size_t off_a, const void* R, size_t off_ss, bool dry = false) {
    char* ws = p.ws;
    EpiResid8<RBF16> e{R, (bf16_t*)(ws + OFF_HB), (float*)(ws + off_ss)};
    if (dry) { e.HB = (bf16_t*)(ws + OFF_B); e.SS = (float*)(ws + OFF_SS1); }
    gemm8(smem, (const bf16_t*)(ws + off_a), 1024, (const bf16_t*)(ws + off_w), T_TOK, 1024, 1024, e);
}
DI void phase_rowscale(const Params& p, char* smem, size_t off_w, int N, bf16_t* outp, size_t off_ss, float extra) {
    char* ws = p.ws;
    EpiRowScale8 e{outp, N, (const float*)(ws + off_ss), extra};
    gemm8(smem, (const bf16_t*)(ws + OFF_HB), 1024, (const bf16_t*)(ws + off_w), T_TOK, N, 1024, e);
}
DI unsigned v128_off(int row, int chunk) { return (unsigned)(row * 128 + ((chunk ^ (((row >> 1) & 1) << 2)) << 4)); }
DI unsigned v128_tr_addr(unsigned base, int R0, int c, int lane) {
    const int blk = (lane >> 4) & 1, qq = (lane & 15) >> 2, pp = lane & 3;
    return base + v128_off(R0 + qq, 4 * c + 2 * blk + (pp >> 1)) + 8 * (pp & 1);
}
DI bf16x8 cat44(s16x4 lo, s16x4 hi) { return __builtin_shufflevector(lo, hi, 0, 1, 2, 3, 4, 5, 6, 7); }

constexpr int MLA_STAGE = 64 * 192 + 64 * 128;
DI unsigned k192_off(int row, int chunk) { return (unsigned)(row * 192 + (((chunk & ~3) | ((chunk & 3) ^ ((row >> 2) & 3))) << 4)); }
DI void mla_unit(const Params& p, char* lds, int b, int h, int qt) {
    char* ws = p.ws;
    const int t = otid(), lane = t & 63, wv = t >> 6, r = lane & 31, hh = lane >> 5;
    const bf16_t* Q = (const bf16_t*)(ws + OFF_QMLA);
    const bf16_t* KV = (const bf16_t*)(ws + OFF_KVMLA);
    const bf16_t* KR = (const bf16_t*)(ws + OFF_KR);
    const int q0 = qt * 128 + 32 * wv;
    const size_t tokq = (size_t)b * SEQ_L + q0 + r;
    const size_t tokb = (size_t)b * SEQ_L;
    bf16x8 qf[6];
#pragma unroll
    for (int s = 0; s < 6; ++s) qf[s] = ld16(Q + tokq * 768 + h * 96 + 16 * s + 8 * hh);
    f32x16 o[2]; o[0] = zero16(); o[1] = zero16();
    float m = -INFINITY, l = 0.f;
    const bf16_t* ksrc[3]; int kadv[3]; const bf16_t* vsrc[2];
#pragma unroll
    for (int i = 0; i < 3; ++i) {
        const int o_ = 1024 * (wv + 4 * i) + 16 * lane, row = o_ / 192, pch = (o_ % 192) >> 4;
        const int c = (pch & ~3) | ((pch & 3) ^ ((row >> 2) & 3));
        if (c < 8) { ksrc[i] = KV + (tokb + row) * 1024 + h * 128 + 8 * c; kadv[i] = 64 * 1024; }
        else       { ksrc[i] = KR + (tokb + row) * 32 + 8 * (c - 8);       kadv[i] = 64 * 32; }
    }
#pragma unroll
    for (int i = 0; i < 2; ++i) {
        const int row = 8 * (wv + 4 * i) + (lane >> 3), pch = lane & 7;
        vsrc[i] = KV + (tokb + row) * 1024 + h * 128 + 64 + 8 * (pch ^ (((row >> 1) & 1) << 2));
    }
    char* ldst = lds + wv * 1024 + lane * 16;
    auto issue = [&](int kt) {
        char* d = ldst + (kt % 3) * MLA_STAGE;
#pragma unroll
        for (int i = 0; i < 3; ++i) GLDS16(ksrc[i] + (size_t)kt * kadv[i], d + i * 4096);
#pragma unroll
        for (int i = 0; i < 2; ++i) GLDS16(vsrc[i] + (size_t)kt * (64 * 1024), d + 12288 + i * 4096);
    };
    const int ntiles = 2 * qt + 2;
    __syncthreads();
    issue(0); issue(1);
#pragma unroll
    for (int s = 0; s < 6; ++s) asm volatile("" :: "v"(qf[s]));
#pragma unroll 1
    for (int kt = 0; kt < ntiles; ++kt) {
        if (kt + 1 < ntiles) asm volatile("s_waitcnt vmcnt(5)\n\ts_barrier" ::: "memory");
        else asm volatile("s_waitcnt vmcnt(0)\n\ts_barrier" ::: "memory");
        if (kt + 2 < ntiles) issue(kt + 2);
        const char* sb = lds + (kt % 3) * MLA_STAGE;
        const unsigned vb = (unsigned)(uintptr_t)(sb + 12288);
        f32x16 s[2];
#pragma unroll
        for (int k2 = 0; k2 < 2; ++k2) {
            s[k2] = zero16();
#pragma unroll
            for (int ss = 0; ss < 6; ++ss) s[k2] = MFMA32(ld16(sb + k192_off(32 * k2 + r, 2 * ss + hh)), qf[ss], s[k2]);
        }
        s16x4 vt[2][2][2][2];
#pragma unroll
        for (int k2 = 0; k2 < 2; ++k2)
#pragma unroll
            for (int st = 0; st < 2; ++st)
#pragma unroll
                for (int c = 0; c < 2; ++c) {
                    vt[k2][st][c][0] = tr_read_a(v128_tr_addr(vb, 32 * k2 + 16 * st + 4 * hh, c, lane));
                    vt[k2][st][c][1] = tr_read_a(v128_tr_addr(vb, 32 * k2 + 16 * st + 8 + 4 * hh, c, lane));
                }
        if (__builtin_amdgcn_readfirstlane(kt >= 2 * qt)) {
            asm volatile("");
            const int qpos = q0 + r;
#pragma unroll
            for (int k2 = 0; k2 < 2; ++k2)
#pragma unroll
                for (int i = 0; i < 16; ++i) { const int kpos = 64 * kt + 32 * k2 + crow(i, hh); if (kpos > qpos) s[k2][i] = -INFINITY; }
        }
        float mx = s[0][0];
#pragma unroll
        for (int k2 = 0; k2 < 2; ++k2)
#pragma unroll
            for (int i = 0; i < 16; ++i) mx = fmaxf(mx, s[k2][i]);
        mx = xhalf_max(mx);
        if (__any(mx > m + 8.0f)) {
            asm volatile("");
            const float mn = fmaxf(m, mx);
            const float alpha = fast_exp2(m - mn);
            l *= alpha;
            m = mn;
#pragma unroll
            for (int c = 0; c < 2; ++c)
#pragma unroll
                for (int i = 0; i < 16; ++i) o[c][i] *= alpha;
        }
        f32x2 ps2 = {0.f, 0.f};
        const f32x2 m2 = {m, m};
#pragma unroll
        for (int k2 = 0; k2 < 2; ++k2)
#pragma unroll
            for (int i = 0; i < 16; i += 2) {
                f32x2 x = {s[k2][i], s[k2][i + 1]};
                x = x - m2;
                f32x2 e; e[0] = fast_exp2(x[0]); e[1] = fast_exp2(x[1]);
                s[k2][i] = e[0]; s[k2][i + 1] = e[1];
                ps2 += e;
            }
        l += ps2[0] + ps2[1];
        TR_WAIT();
#pragma unroll
        for (int k2 = 0; k2 < 2; ++k2)
#pragma unroll
            for (int st = 0; st < 2; ++st) {
                const bf16x8 pb = pack_step(s[k2], st);
#pragma unroll
                for (int c = 0; c < 2; ++c) o[c] = MFMA32(cat44(vt[k2][st][c][0], vt[k2][st][c][1]), pb, o[c]);
            }
    }
    const float inv = 1.0f / xhalf_sum(l);
    bf16_t* dst = (bf16_t*)((char*)p.out + OUT_OMLA) + tokq * 512 + h * 64 + 4 * hh;
#pragma unroll
    for (int c = 0; c < 2; ++c)
#pragma unroll
        for (int g = 0; g < 4; ++g)
            *(u32x2*)(dst + 32 * c + 8 * g) = pack4(o[c][4 * g] * inv, o[c][4 * g + 1] * inv, o[c][4 * g + 2] * inv, o[c][4 * g + 3] * inv);
}

DI void dil_unit(const Params& p, char* lds, int g, int b, int h, int rr, int lb) {
    char* ws = p.ws;
    const int t = otid(), lane = t & 63, wv = t >> 6, r = lane & 31, hh = lane >> 5;
    const int d = (g == 0) ? 1 : (g == 1 ? 4 : 16);
    const bf16_t* PJ = (const bf16_t*)(ws + OFF_PROJ);
    const size_t tokb = (size_t)b * SEQ_L;
    char* kimg = lds;
    char* vimg = lds + 32768;
    __syncthreads();
    {
        const int c = t & 7;
#pragma unroll
        for (int half = 0; half < 2; ++half) {
            u32x4 kk[4], vv[4];
#pragma unroll
            for (int i = 0; i < 4; ++i) {
                const int key = (t >> 3) + 32 * (4 * half + i);
                const int lk = 128 * lb - 128 + key;
                if (lk >= 0) {
                    const size_t tk = tokb + (size_t)lk * d + rr;
                    kk[i] = ldu4(PJ + tk * INC + 1184 + h * 64 + 8 * c);
                    vv[i] = ldu4(PJ + tk * INC + 1696 + h * 64 + 8 * c);
                } else { kk[i] = (u32x4){0u, 0u, 0u, 0u}; vv[i] = (u32x4){0u, 0u, 0u, 0u}; }
            }
#pragma unroll
            for (int i = 0; i < 4; ++i) {
                const int key = (t >> 3) + 32 * (4 * half + i);
                *(u32x4*)(kimg + sw_off(key, c)) = kk[i];
                *(u32x4*)(vimg + v128_off(key, c)) = vv[i];
            }
        }
    }
    const int lq = 128 * lb + 32 * wv + r;
    const size_t tokq = tokb + (size_t)lq * d + rr;
    bf16x8 qf[4];
#pragma unroll
    for (int s = 0; s < 4; ++s) qf[s] = ld16(PJ + tokq * INC + 672 + h * 64 + 16 * s + 8 * hh);
    __syncthreads();
    const float slope2 = exp2f(-(float)(h + 1)) * (float)d * LOG2E;
    const int u0 = (lb == 0) ? (4 - wv) : 0;
    f32x16 o[2]; o[0] = zero16(); o[1] = zero16();
    float m = -INFINITY, lsum = 0.f;
    const unsigned vb = (unsigned)(uintptr_t)vimg;
#pragma unroll 1
    for (int u = u0; u < 5; ++u) {
        const int rowb = 32 * (wv + u);
        f32x16 s = zero16();
#pragma unroll
        for (int ss = 0; ss < 4; ++ss) s = MFMA32(ld16(kimg + sw_off(rowb + r, 2 * ss + hh)), qf[ss], s);
        const int dbase = r + 128 - 32 * u;
        float mx = -INFINITY;
#pragma unroll
        for (int i = 0; i < 16; ++i) {
            const int dist = dbase - crow(i, hh);
            const bool valid = (dist >= 0) && (dist <= 128);
            const float v = valid ? (s[i] - slope2 * (float)dist) : -INFINITY;
            s[i] = v;
            mx = fmaxf(mx, v);
        }
        mx = xhalf_max(mx);
        const float mn = fmaxf(m, mx);
        const float alpha = fast_exp2(m - mn);
        float ps = 0.f;
#pragma unroll
        for (int i = 0; i < 16; ++i) { const float e = fast_exp2(s[i] - mn); s[i] = e; ps += e; }
        lsum = lsum * alpha + ps;
        m = mn;
#pragma unroll
        for (int c = 0; c < 2; ++c)
#pragma unroll
            for (int i = 0; i < 16; ++i) o[c][i] *= alpha;
#pragma unroll
        for (int st = 0; st < 2; ++st) {
            const bf16x8 pb = pack_step(s, st);
#pragma unroll
            for (int c = 0; c < 2; ++c) {
                const s16x4 lo = tr_read(v128_tr_addr(vb, rowb + 16 * st + 4 * hh, c, lane));
                const s16x4 hi = tr_read(v128_tr_addr(vb, rowb + 16 * st + 8 + 4 * hh, c, lane));
                o[c] = MFMA32(cat44(lo, hi), pb, o[c]);
            }
        }
    }
    const float ltot = xhalf_sum(lsum);
    const float mx = m;
    const float inv = 1.0f / ltot;
    bf16_t* dst = (bf16_t*)((char*)p.out + OUT_ODIL) + ((size_t)g * T_TOK + tokq) * 512 + h * 64 + 4 * hh;
#pragma unroll
    for (int c = 0; c < 2; ++c)
#pragma unroll
        for (int gg = 0; gg < 4; ++gg)
            *(u32x2*)(dst + 32 * c + 8 * gg) = pack4(o[c][4 * gg] * inv, o[c][4 * gg + 1] * inv, o[c][4 * gg + 2] * inv, o[c][4 * gg + 3] * inv);
    if (hh == 0) ((float*)(ws + OFF_LSE))[((size_t)g * T_TOK + tokq) * 8 + h] = mx + __log2f(ltot);
}

DI void phase_p3(const Params& p, char* lds, int which = 3) {
    const int xg = (int)blockIdx.x & 7, nloc = (vgrid() >> 3), loc = ((int)blockIdx.x >> 3) * 2 + vhalf();
    if (which & 1) for (int i = loc; i < 64; i += nloc) {
        const int bh = xg * 4 + (i >> 4), pr = i & 15, b = bh >> 3, h = bh & 7;
#pragma unroll 1
        for (int rep = 0; rep < 2; ++rep) mla_unit(p, lds, b, h, rep ? pr : 31 - pr);
    }
    if (which & 2) for (int i = loc; i < 384; i += nloc) {
        const int bh = xg * 4 + i / 96, k96 = i % 96, g = k96 >> 5, k = k96 & 31, b = bh >> 3, h = bh & 7;
        int rr, lb;
        if (g == 0) { rr = 0; lb = k; } else if (g == 1) { rr = k >> 3; lb = k & 7; } else { rr = k >> 1; lb = k & 1; }
        dil_unit(p, lds, g, b, h, rr, lb);
    }
}

DI void quant_rows4(const Params& p, int it, int wv, int lane) {
    char* ws = p.ws;
    const int ncv = 4096;
    const bool isv = it >= ncv;
    const size_t row = (size_t)(isv ? it - ncv : it) * 4 + wv;
    const float* src = (isv ? p.peer_v : p.peer_u) + row * 1024 + 16 * lane;
    f32x4 v[4]; float am = 0.f;
#pragma unroll
    for (int i = 0; i < 4; ++i) { v[i] = *(const f32x4*)(src + 4 * i); am = fmaxf(am, fmaxf(fmaxf(fabsf(v[i][0]), fabsf(v[i][1])), fmaxf(fabsf(v[i][2]), fabsf(v[i][3])))); }
#pragma unroll
    for (int o = 32; o; o >>= 1) am = fmaxf(am, __shfl_xor(am, o));
    const float sc = (am > 0.f) ? am * (isv ? (1.0f / 384.0f) : (1.0f / 127.0f)) : 1.0f;
    const float inv = 1.0f / sc;
    u32x4 o;
#pragma unroll
    for (int i = 0; i < 4; ++i) {
        if (isv) {
            int w = 0;
            w = __builtin_amdgcn_cvt_pk_fp8_f32(v[i][0] * inv, v[i][1] * inv, w, false);
            w = __builtin_amdgcn_cvt_pk_fp8_f32(v[i][2] * inv, v[i][3] * inv, w, true);
            o[i] = (unsigned)w;
        } else {
            unsigned w = 0u;
#pragma unroll
            for (int e = 0; e < 4; ++e) { const int q = (int)rintf(v[i][e] * inv); w |= ((unsigned)q & 0xFFu) << (8 * e); }
            o[i] = w;
        }
    }
    *(u32x4*)(ws + (isv ? OFF_VQ : OFF_UQ) + row * 1024 + 16 * lane) = o;
    if (lane == 0) ((float*)(ws + (isv ? OFF_SV : OFF_SU)))[row] = sc;
}

DI void phase_p35(const Params& p, char* lds) {
    char* ws = p.ws;
    const int t = otid(), lane = t & 63, wv = t >> 6;
    const int ntok = T_TOK / 4;
    for (int item = vbid(); item < ntok; item += vgrid()) {
        {
            const size_t tok = (size_t)item * 4 + wv;
            const int head = lane >> 3;
            const float* LS = (const float*)(ws + OFF_LSE);
            const float l0 = LS[tok * 8 + head], l1 = LS[((size_t)T_TOK + tok) * 8 + head], l2 = LS[((size_t)2 * T_TOK + tok) * 8 + head];
            const float mx = fmaxf(l0, fmaxf(l1, l2));
            float w0 = fast_exp2(l0 - mx), w1 = fast_exp2(l1 - mx), w2 = fast_exp2(l2 - mx);
            const float wi = 1.0f / (w0 + w1 + w2);
            w0 *= wi; w1 *= wi; w2 *= wi;
            const bf16_t* OD = (const bf16_t*)((const char*)p.out + OUT_ODIL);
            const u32x4 a0 = ldu4(OD + tok * 512 + 8 * lane), a1 = ldu4(OD + ((size_t)T_TOK + tok) * 512 + 8 * lane),
                        a2 = ldu4(OD + ((size_t)2 * T_TOK + tok) * 512 + 8 * lane);
            const u32x4 am = ldu4((const bf16_t*)((const char*)p.out + OUT_OMLA) + tok * 512 + 8 * lane);
            float od[8], om[8]; float sd = 0.f, sm = 0.f;
#pragma unroll
            for (int e = 0; e < 4; ++e) {
                od[2 * e] = w0 * bf_lo(a0[e]) + w1 * bf_lo(a1[e]) + w2 * bf_lo(a2[e]);
                od[2 * e + 1] = w0 * bf_hi(a0[e]) + w1 * bf_hi(a1[e]) + w2 * bf_hi(a2[e]);
                om[2 * e] = bf_lo(am[e]); om[2 * e + 1] = bf_hi(am[e]);
                sd += od[2 * e] * od[2 * e] + od[2 * e + 1] * od[2 * e + 1];
                sm += om[2 * e] * om[2 * e] + om[2 * e + 1] * om[2 * e + 1];
            }
#pragma unroll
            for (int o = 32; o; o >>= 1) { sd += __shfl_xor(sd, o); sm += __shfl_xor(sm, o); }
            const float rd = rsqrtf(sd * (1.0f / 512.0f) + 1e-6f), rm = rsqrtf(sm * (1.0f / 512.0f) + 1e-6f);
            const f32x4 gm0 = *(const f32x4*)(p.gn_mla + 8 * lane), gm1 = *(const f32x4*)(p.gn_mla + 8 * lane + 4);
            const f32x4 gd0 = *(const f32x4*)(p.gn_dil + 8 * lane), gd1 = *(const f32x4*)(p.gn_dil + 8 * lane + 4);
            u32x4 o1, o2;
            o1[0] = pack2(om[0] * rm * gm0[0], om[1] * rm * gm0[1]); o1[1] = pack2(om[2] * rm * gm0[2], om[3] * rm * gm0[3]);
            o1[2] = pack2(om[4] * rm * gm1[0], om[5] * rm * gm1[1]); o1[3] = pack2(om[6] * rm * gm1[2], om[7] * rm * gm1[3]);
            o2[0] = pack2(od[0] * rd * gd0[0], od[1] * rd * gd0[1]); o2[1] = pack2(od[2] * rd * gd0[2], od[3] * rd * gd0[3]);
            o2[2] = pack2(od[4] * rd * gd1[0], od[5] * rd * gd1[1]); o2[3] = pack2(od[6] * rd * gd1[2], od[7] * rd * gd1[3]);
            bf16_t* MX = (bf16_t*)(ws + OFF_MIXED) + tok * 1024;
            *(u32x4*)(MX + 8 * lane) = o1;
            *(u32x4*)(MX + 512 + 8 * lane) = o2;
        }
    }
}

DI unsigned m512_off(int row, int chunk) { return (unsigned)(row * 512 + ((chunk ^ (row & 15)) << 4)); }
DI unsigned v512_off(int row, int chunk) { return (unsigned)(row * 512 + ((chunk ^ ((row & 3) << 2)) << 4)); }
DI void memattn_unit(const Params& p, char* lds, int b, int h, int tt) {
    char* ws = p.ws;
    const int t = otid(), lane = t & 63, wv = t >> 6, r = lane & 31, hh = lane >> 5;
    const int qg = wv & 1, dh = wv >> 1;
    const bf16_t* QM = (const bf16_t*)(ws + OFF_QM);
    const bf16_t* KVM = (const bf16_t*)(ws + OFF_KVM);
    const size_t tokq = (size_t)b * SEQ_L + tt * 64 + 32 * qg + r;
    bf16x8 qf[16];
#pragma unroll
    for (int s = 0; s < 16; ++s) qf[s] = ld16(QM + tokq * 1024 + h * 256 + 16 * s + 8 * hh);
    f32x16 o[4];
#pragma unroll
    for (int c = 0; c < 4; ++c) o[c] = zero16();
    float m = -INFINITY, l = 0.f;
    const bf16_t* ksrc[4]; const bf16_t* vsrc[4];
#pragma unroll
    for (int i = 0; i < 4; ++i) {
        const int row = 2 * (wv + 4 * i) + (lane >> 5), pch = lane & 31;
        const size_t mrow = (size_t)b * 256 + row;
        ksrc[i] = KVM + mrow * 2048 + h * 256 + 8 * (pch ^ (row & 15));
        vsrc[i] = KVM + mrow * 2048 + 1024 + h * 256 + 8 * (pch ^ ((row & 3) << 2));
    }
    char* ldst = lds + wv * 1024 + lane * 16;
    auto stage_tile = [&](int kt, char* sb) {
#pragma unroll
        for (int i = 0; i < 4; ++i) { GLDS16(ksrc[i] + (size_t)kt * 32 * 2048, sb + i * 4096); GLDS16(vsrc[i] + (size_t)kt * 32 * 2048, sb + 16384 + i * 4096); }
    };
    __syncthreads();
    stage_tile(0, ldst);
    __syncthreads();
#pragma unroll 1
    for (int kt = 0; kt < 8; ++kt) {
        if (kt + 1 < 8) stage_tile(kt + 1, ldst + ((kt + 1) & 1) * 32768);
        const char* sb = lds + (kt & 1) * 32768;
        const unsigned vb = (unsigned)(uintptr_t)(sb + 16384);
        f32x16 s = zero16();
#pragma unroll
        for (int ss = 0; ss < 16; ++ss) s = MFMA32(ld16(sb + m512_off(r, 2 * ss + hh)), qf[ss], s);
        float mx = s[0];
#pragma unroll
        for (int i = 1; i < 16; ++i) mx = fmaxf(mx, s[i]);
        mx = xhalf_max(mx);
        const float mn = fmaxf(m, mx);
        const float alpha = fast_exp2(m - mn);
        float ps = 0.f;
#pragma unroll
        for (int i = 0; i < 16; ++i) { const float e = fast_exp2(s[i] - mn); s[i] = e; ps += e; }
        l = l * alpha + ps;
        m = mn;
#pragma unroll
        for (int c = 0; c < 4; ++c)
#pragma unroll
            for (int i = 0; i < 16; ++i) o[c][i] *= alpha;
        const int blk = (lane >> 4) & 1, qq = (lane & 15) >> 2, pp = lane & 3;
#pragma unroll
        for (int st = 0; st < 2; ++st) {
            const bf16x8 pb = pack_step(s, st);
#pragma unroll
            for (int c = 0; c < 4; ++c) {
                const int ch = 16 * dh + 4 * c + 2 * blk + (pp >> 1);
                const s16x4 lo = tr_read(vb + v512_off(16 * st + 4 * hh + qq, ch) + 8 * (pp & 1));
                const s16x4 hi = tr_read(vb + v512_off(16 * st + 8 + 4 * hh + qq, ch) + 8 * (pp & 1));
                o[c] = MFMA32(cat44(lo, hi), pb, o[c]);
            }
        }
        __syncthreads();
    }
    const float inv = 1.0f / xhalf_sum(l);
    bf16_t* dst = (bf16_t*)(ws + OFF_OM) + tokq * 1024 + h * 256 + 128 * dh + 4 * hh;
#pragma unroll
    for (int c = 0; c < 4; ++c)
#pragma unroll
        for (int g = 0; g < 4; ++g)
            *(u32x2*)(dst + 32 * c + 8 * g) = pack4(o[c][4 * g] * inv, o[c][4 * g + 1] * inv, o[c][4 * g + 2] * inv, o[c][4 * g + 3] * inv);
}

DI void phase_memattn(const Params& p, char* lds) {
    for (int item = vbid(); item < 1024; item += vgrid()) {
        const int b = item >> 8, h = (item >> 6) & 3, tt = item & 63;
        memattn_unit(p, lds, b, h, tt);
    }
}
DI unsigned f2sort(float f) { const unsigned b = __float_as_uint(f); return b ^ ((b & 0x80000000u) ? 0xFFFFFFFFu : 0x80000000u); }
DI float sort2f(unsigned u) { const unsigned b = (u & 0x80000000u) ? (u ^ 0x80000000u) : ~u; return __uint_as_float(b); }
DI void cswap(unsigned& a, unsigned& b) { const unsigned hi = max(a, b), lo = min(a, b); a = hi; b = lo; }

template <int LO, int N> struct BClean {
    template <int M> static DI void run(unsigned (&a)[M]) {
#pragma unroll
        for (int i = 0; i < N / 2; ++i) cswap(a[LO + i], a[LO + i + N / 2]);
        BClean<LO, N / 2>::run(a); BClean<LO + N / 2, N / 2>::run(a);
    }
};
template <int LO> struct BClean<LO, 1> { template <int M> static DI void run(unsigned (&)[M]) {} };
template <int LO, int N> struct BSort {
    template <int M> static DI void run(unsigned (&a)[M]) {
        BSort<LO, N / 2>::run(a); BSort<LO + N / 2, N / 2>::run(a);
#pragma unroll
        for (int i = 0; i < N / 2; ++i) cswap(a[LO + i], a[LO + N - 1 - i]);
        BClean<LO, N / 2>::run(a); BClean<LO + N / 2, N / 2>::run(a);
    }
};
template <int LO> struct BSort<LO, 1> { template <int M> static DI void run(unsigned (&)[M]) {} };
DI void merge_top16(unsigned (&a)[16], const unsigned (&b)[16]) {
#pragma unroll
    for (int i = 0; i < 16; ++i) a[i] = max(a[i], b[15 - i]);
    BClean<0, 16>::run(a);
}

DI void peer_top16(const bf16_t* __restrict__ keys_hp, const bf16_t* __restrict__ pq_row_hp, int r, int hh, unsigned (&top)[16]) {
    bf16x8 qf[8];
#pragma unroll
    for (int s = 0; s < 8; ++s) qf[s] = ld16(pq_row_hp + 16 * s + 8 * hh);
    unsigned cur[16];
#pragma unroll
    for (int kt = 0; kt < 4; ++kt) {
        f32x16 acc = zero16();
#pragma unroll
        for (int s = 0; s < 8; ++s) acc = MFMA32(ld16(keys_hp + (size_t)(32 * kt + r) * 128 + 16 * s + 8 * hh), qf[s], acc);
        unsigned k[16];
#pragma unroll
        for (int i = 0; i < 16; ++i) k[i] = (f2sort(acc[i]) & ~0x7Fu) | (unsigned)(32 * kt + crow(i, hh));
        BSort<0, 16>::run(k);
        if (kt == 0) {
#pragma unroll
            for (int i = 0; i < 16; ++i) cur[i] = k[i];
        } else merge_top16(cur, k);
    }
    unsigned r0[16], r1[16];
#pragma unroll
    for (int i = 0; i < 16; ++i) { auto rr = __builtin_amdgcn_permlane32_swap(cur[i], cur[i], false, false); r0[i] = rr[0]; r1[i] = rr[1]; }
#pragma unroll
    for (int i = 0; i < 16; ++i) top[i] = max(r0[i], r1[15 - i]);
    BClean<0, 16>::run(top);
}

DI void peer_select_unit(const Params& p, char* lds, int mt, int h) {
    char* ws = p.ws;
    const int t = otid(), lane = t & 63, wv = t >> 6, r = lane & 31, hh = lane >> 5;
    const size_t tok = (size_t)mt * 128 + 32 * wv + r;
    const bf16_t* KEYS = (const bf16_t*)(ws + OFF_KEYS);
    const bf16_t* PQ = (const bf16_t*)((const char*)p.out + OUT_PQ);
    unsigned tA[16], tB[16];
    peer_top16(KEYS + (size_t)(2 * h) * 16384, PQ + tok * 2048 + (2 * h) * 128, r, hh, tA);
    peer_top16(KEYS + (size_t)(2 * h + 1) * 16384, PQ + tok * 2048 + (2 * h + 1) * 128, r, hh, tB);
    float fA[16], fB[16];
#pragma unroll
    for (int i = 0; i < 16; ++i) { fA[i] = sort2f(tA[i] & ~0x7Fu); fB[i] = sort2f(tB[i] & ~0x7Fu); }
    unsigned* tab = (unsigned*)lds + wv * 1024;
    __syncthreads();
#pragma unroll
    for (int i = 0; i < 16; ++i) tab[i * 64 + lane] = (tA[i] & 0x7Fu) | ((tB[i] & 0x7Fu) << 16);
    unsigned c[64];
#pragma unroll
    for (int i = 0; i < 64; ++i) c[i] = 0u;
    {
        int n = 0;
#pragma unroll
        for (int a = 0; a < 16; ++a)
#pragma unroll
            for (int b = 0; b < 16; ++b)
                if ((a + 1) * (b + 1) <= 16) { c[n] = (f2sort(fA[a] + fB[b]) & ~0xFFu) | (unsigned)(a * 16 + b); ++n; }
    }
    unsigned g0[16], g1[16], g2[16], g3[16];
#pragma unroll
    for (int i = 0; i < 16; ++i) { g0[i] = c[i]; g1[i] = c[16 + i]; g2[i] = c[32 + i]; g3[i] = c[48 + i]; }
    BSort<0, 16>::run(g0); BSort<0, 16>::run(g1); BSort<0, 16>::run(g2); BSort<0, 16>::run(g3);
    merge_top16(g0, g1); merge_top16(g2, g3); merge_top16(g0, g2);
    float e[16]; float sum = 0.f;
    const float v0 = sort2f(g0[0] & ~0xFFu);
    unsigned ids[16];
#pragma unroll
    for (int i = 0; i < 16; ++i) {
        const float v = sort2f(g0[i] & ~0xFFu);
        e[i] = fast_exp2((v - v0) * LOG2E); sum += e[i];
        const unsigned a = (g0[i] >> 4) & 15u, b = g0[i] & 15u;
        const unsigned ia = tab[a * 64 + lane] & 0x7Fu, ib = (tab[b * 64 + lane] >> 16) & 0x7Fu;
        ids[i] = ia * 128u + ib;
    }
    const float inv = 1.0f / sum;
    if (hh == 0) {
        unsigned short* SID = (unsigned short*)(ws + OFF_SELID) + tok * 128 + h * 16;
        float* SG = (float*)(ws + OFF_SELG) + tok * 128 + h * 16;
        u32x4 w0, w1;
        w0[0] = ids[0] | (ids[1] << 16); w0[1] = ids[2] | (ids[3] << 16); w0[2] = ids[4] | (ids[5] << 16); w0[3] = ids[6] | (ids[7] << 16);
        w1[0] = ids[8] | (ids[9] << 16); w1[1] = ids[10] | (ids[11] << 16); w1[2] = ids[12] | (ids[13] << 16); w1[3] = ids[14] | (ids[15] << 16);
        *(u32x4*)SID = w0; *(u32x4*)(SID + 8) = w1;
#pragma unroll
        for (int q = 0; q < 4; ++q) *(f32x4*)(SG + 4 * q) = (f32x4){e[4 * q] * inv, e[4 * q + 1] * inv, e[4 * q + 2] * inv, e[4 * q + 3] * inv};
    }
}

DI void phase_select(const Params& p, char* lds) {
    for (int item = vbid(); item < 1024; item += vgrid()) peer_select_unit(p, lds, item >> 3, item & 7);
}

DI float gelu_erf(float v) {
    const float av = fabsf(v), t = __builtin_amdgcn_rcpf(av * 0.2316418882f + 1.0f);
    float q = t * 0.5307027145f + (-0.7265760135f); q = q * t + 0.7107068705f; q = q * t + (-0.142248368f); q = q * t + 0.127414796f; q = q * t;
    const float e = __builtin_amdgcn_exp2f((v * v) * (-0.72134752044f));
    const float m = v * (q * e), r = v - m;
    return v < 0.f ? m : r;
}
DI int dppi(int v, const int ctrl) { return v; }
#define DPP_I(v, ctrl) __builtin_amdgcn_update_dpp(0, (v), (ctrl), 0xf, 0xf, true)
DI float ub0(unsigned w) { return (float)(w & 0xFFu); }
DI float ub1(unsigned w) { return (float)((w >> 8) & 0xFFu); }
DI float ub2(unsigned w) { return (float)((w >> 16) & 0xFFu); }
DI float ub3(unsigned w) { return (float)(w >> 24); }

struct GBatch { u32x4 U[4], V[4]; float su[4], sv[4], gate[4]; };

DI void gather_load(GBatch& B, const char* __restrict__ ws, unsigned idpair, f32x2 gpair, int eb, int lane) {
#pragma unroll
    for (int j = 0; j < 4; ++j) {
        const int e = eb + j;
        const unsigned pr = __shfl(idpair, e >> 1);
        const unsigned id = (j & 1) ? (pr >> 16) : (pr & 0xFFFFu);
        const float g0 = __shfl(gpair[0], e >> 1), g1 = __shfl(gpair[1], e >> 1);
        B.gate[j] = (j & 1) ? g1 : g0;
        B.U[j] = ldu4(ws + OFF_UQ + (size_t)id * 1024 + 16 * lane);
        B.V[j] = ldu4(ws + OFF_VQ + (size_t)id * 1024 + 16 * lane);
        B.su[j] = ((const float*)(ws + OFF_SU))[id];
        B.sv[j] = ((const float*)(ws + OFF_SV))[id];
    }
}

DI void gather_compute(const GBatch& B, const unsigned (&qx)[4], float sx, float (&acc)[16], float& csum, int lane) {
    int pd[4];
#pragma unroll
    for (int j = 0; j < 4; ++j) {
        int d = 0;
#pragma unroll
        for (int q = 0; q < 4; ++q) d = __builtin_amdgcn_sdot4((int)B.U[j][q], (int)qx[q], d, false);
        pd[j] = d;
    }
    const bool b0 = lane & 1, b1 = lane & 2;
    const int kA = b0 ? pd[1] : pd[0], kB = b0 ? pd[3] : pd[2], sA = b0 ? pd[0] : pd[1], sB = b0 ? pd[2] : pd[3];
    const int qA = kA + DPP_I(sA, 0xB1), qB = kB + DPP_I(sB, 0xB1);
    const int kp = b1 ? qB : qA, sd = b1 ? qA : qB;
    int tot = kp + DPP_I(sd, 0x4E);
    tot += DPP_I(tot, 0x124);
    tot += DPP_I(tot, 0x128);
    tot += __builtin_amdgcn_ds_swizzle(tot, 0x401F);
    { auto rr = __builtin_amdgcn_permlane32_swap((unsigned)tot, (unsigned)tot, false, false); tot = (int)rr[0] + (int)rr[1]; }
    const int j3 = lane & 3;
    const float su_sel = (j3 == 0) ? B.su[0] : (j3 == 1 ? B.su[1] : (j3 == 2 ? B.su[2] : B.su[3]));
    const float ge = gelu_erf((float)tot * sx * su_sel);
#pragma unroll
    for (int j = 0; j < 4; ++j) {
        const float cf = B.gate[j] * B.sv[j] * __uint_as_float((unsigned)__builtin_amdgcn_readlane((int)__float_as_uint(ge), j));
#pragma unroll
        for (int q = 0; q < 4; ++q) {
            const int w = (int)B.V[j][q];
            const f32x2 lo = __builtin_amdgcn_cvt_pk_f32_fp8(w, false), hi = __builtin_amdgcn_cvt_pk_f32_fp8(w, true);
            acc[4 * q] += cf * lo[0]; acc[4 * q + 1] += cf * lo[1]; acc[4 * q + 2] += cf * hi[0]; acc[4 * q + 3] += cf * hi[1];
        }
    }
}

DI void gather_token(const Params& p, size_t tok, int lane, float* dst_base) {
    char* ws = p.ws;
    const bf16_t* hrow = (const bf16_t*)(ws + OFF_HB) + tok * 1024 + 16 * lane;
    float hv[16];
    {
        const u32x4 w0 = ldu4(hrow), w1 = ldu4(hrow + 8);
#pragma unroll
        for (int e = 0; e < 4; ++e) { hv[2 * e] = bf_lo(w0[e]); hv[2 * e + 1] = bf_hi(w0[e]); hv[8 + 2 * e] = bf_lo(w1[e]); hv[8 + 2 * e + 1] = bf_hi(w1[e]); }
    }
    float rs;
    {
        const float* SS = (const float*)(ws + OFF_SS2) + tok * 16;
        const f32x4 s0 = *(const f32x4*)SS, s1 = *(const f32x4*)(SS + 4), s2 = *(const f32x4*)(SS + 8), s3 = *(const f32x4*)(SS + 12);
        const float tot = (s0[0] + s0[1] + s0[2] + s0[3]) + (s1[0] + s1[1] + s1[2] + s1[3]) + (s2[0] + s2[1] + s2[2] + s2[3]) + (s3[0] + s3[1] + s3[2] + s3[3]);
        rs = rsqrtf(tot * (1.0f / 1024.0f) + 1e-6f);
    }
    float xf[16]; float am = 0.f;
#pragma unroll
    for (int i = 0; i < 4; ++i) {
        const f32x4 g = *(const f32x4*)(p.norm_ffn + 16 * lane + 4 * i);
#pragma unroll
        for (int e = 0; e < 4; ++e) { xf[4 * i + e] = hv[4 * i + e] * rs * g[e]; am = fmaxf(am, fabsf(xf[4 * i + e])); }
    }
#pragma unroll
    for (int o = 32; o; o >>= 1) am = fmaxf(am, __shfl_xor(am, o));
    const float sx = (am > 0.f) ? am * (1.0f / 127.0f) : 1.0f;
    const float isx = 1.0f / sx;
    unsigned qx[4];
#pragma unroll
    for (int i = 0; i < 4; ++i) {
        unsigned w = 0u;
#pragma unroll
        for (int e = 0; e < 4; ++e) w |= ((unsigned)(int)rintf(xf[4 * i + e] * isx) & 0xFFu) << (8 * e);
        qx[i] = w;
    }
    const unsigned idpair = *((const unsigned*)(ws + OFF_SELID) + tok * 64 + lane);
    const f32x2 gpair = *((const f32x2*)(ws + OFF_SELG) + tok * 64 + lane);
    float acc[16]; float csum = 0.f;
#pragma unroll
    for (int i = 0; i < 16; ++i) acc[i] = 0.f;
    GBatch B0, B1;
    gather_load(B0, ws, idpair, gpair, 0, lane);
#pragma unroll 1
    for (int eb = 0; eb < 128; eb += 8) {
        gather_load(B1, ws, idpair, gpair, eb + 4, lane);
        gather_compute(B0, qx, sx, acc, csum, lane);
        if (eb + 8 < 128) gather_load(B0, ws, idpair, gpair, eb + 8, lane);
        gather_compute(B1, qx, sx, acc, csum, lane);
    }
    float ss = 0.f;
#pragma unroll
    for (int i = 0; i < 16; ++i) { acc[i] = acc[i] - 128.0f * csum + hv[i]; ss += acc[i] * acc[i]; }
#pragma unroll
    for (int o = 32; o; o >>= 1) ss += __shfl_xor(ss, o);
    const float rf = rsqrtf(ss * (1.0f / 1024.0f) + 1e-6f);
    float* drow = dst_base + tok * 1024 + 16 * lane;
#pragma unroll
    for (int i = 0; i < 4; ++i) {
        const f32x4 n = *(const f32x4*)(p.norm_final + 16 * lane + 4 * i);
        *(f32x4*)(drow + 4 * i) = (f32x4){acc[4 * i] * rf * n[0], acc[4 * i + 1] * rf * n[1], acc[4 * i + 2] * rf * n[2], acc[4 * i + 3] * rf * n[3]};
    }
}

DI void phase_gather(const Params& p, bool dry = false) {
    const int lane = otid() & 63, wv = otid() >> 6;
    float* dst = dry ? (float*)(p.ws + OFF_A) : p.out;
    for (int item = vbid(); item < T_TOK / 4; item += vgrid()) gather_token(p, (size_t)item * 4 + wv, lane, dst);
}

constexpr size_t GS_SIDS = OFF_A;
constexpr size_t GS_SGS = GS_SIDS + (size_t)T_TOK * 256;
constexpr size_t GS_OFF = GS_SGS + (size_t)T_TOK * 512;
constexpr size_t GS_XQ = GS_OFF + (size_t)T_TOK * 64;
constexpr size_t GS_SX = GS_XQ + (size_t)T_TOK * 1024;
constexpr size_t GS_ACC = GS_SX + (size_t)T_TOK * 4;
static_assert(GS_ACC + (size_t)T_TOK * 2048 <= OFF_A + 69 * MiB, "gather scratch overflows region A");

DI void gs_load(GBatch& B, const char* __restrict__ ws, unsigned myid, float mygate, int j0, int n, int lane) {
#pragma unroll
    for (int j = 0; j < 4; ++j) {
        const int e = __builtin_amdgcn_readfirstlane(j0 + j);
        const bool ok = e < n;
        const int src = ok ? e : 0;
        const unsigned id = (unsigned)__builtin_amdgcn_readlane((int)myid, src);
        const float g = __uint_as_float((unsigned)__builtin_amdgcn_readlane((int)__float_as_uint(mygate), src));
        B.gate[j] = ok ? g : 0.f;
        const char* urow = ws + OFF_UQ + (size_t)id * 1024;
        const char* vrow = ws + OFF_VQ + (size_t)id * 1024;
        B.U[j] = ldu4(urow + 16 * lane);
        B.V[j] = ldu4(vrow + 16 * lane);
        B.su[j] = ((const float*)(ws + OFF_SU))[id];
        B.sv[j] = ((const float*)(ws + OFF_SV))[id];
    }
}

DI void phase_gather_sliced(const Params& p, char* smem) {
    char* ws = p.ws;
    if ((T_TOK / 8) > 8 * (((int)gridDim.x >> 3) * 8) || ((int)gridDim.x & 7)) { phase_gather(p); return; }
    char* lacc = smem + (threadIdx.x >> 6) * 16384 + (threadIdx.x & 63) * 32;
    unsigned short* lids = (unsigned short*)(smem + 131072 + (threadIdx.x >> 6) * 2048);
    unsigned char* loff = (unsigned char*)(smem + 131072 + 16384 + (threadIdx.x >> 6) * 128);
    const int lane = threadIdx.x & 63;
    const int x = (int)blockIdx.x & 7, nW = ((int)gridDim.x >> 3) * 8, lw = ((int)blockIdx.x >> 3) * 8 + (int)(threadIdx.x >> 6);
    const int TPX = T_TOK / 8;
    for (int tl = lw; tl < TPX; tl += nW) {
        const size_t tok = (size_t)x * TPX + tl;
        const bf16_t* hrow = (const bf16_t*)(ws + OFF_HB) + tok * 1024 + 16 * lane;
        float hv[16];
        {
            const u32x4 w0 = ldu4(hrow), w1 = ldu4(hrow + 8);
#pragma unroll
            for (int e = 0; e < 4; ++e) { hv[2 * e] = bf_lo(w0[e]); hv[2 * e + 1] = bf_hi(w0[e]); hv[8 + 2 * e] = bf_lo(w1[e]); hv[8 + 2 * e + 1] = bf_hi(w1[e]); }
        }
        float rs;
        {
            const float* SS = (const float*)(ws + OFF_SS2) + tok * 16;
            const f32x4 s0 = *(const f32x4*)SS, s1 = *(const f32x4*)(SS + 4), s2 = *(const f32x4*)(SS + 8), s3 = *(const f32x4*)(SS + 12);
            const float tot = (s0[0] + s0[1] + s0[2] + s0[3]) + (s1[0] + s1[1] + s1[2] + s1[3]) + (s2[0] + s2[1] + s2[2] + s2[3]) + (s3[0] + s3[1] + s3[2] + s3[3]);
            rs = rsqrtf(tot * (1.0f / 1024.0f) + 1e-6f);
        }
        float xf[16]; float am = 0.f;
#pragma unroll
        for (int i = 0; i < 4; ++i) {
            const f32x4 g = *(const f32x4*)(p.norm_ffn + 16 * lane + 4 * i);
#pragma unroll
            for (int e = 0; e < 4; ++e) { xf[4 * i + e] = hv[4 * i + e] * rs * g[e]; am = fmaxf(am, fabsf(xf[4 * i + e])); }
        }
#pragma unroll
        for (int o = 32; o; o >>= 1) am = fmaxf(am, __shfl_xor(am, o));
        const float sx = (am > 0.f) ? am * (1.0f / 127.0f) : 1.0f;
        const float isx = 1.0f / sx;
        u32x4 qx;
#pragma unroll
        for (int i = 0; i < 4; ++i) {
            unsigned w = 0u;
#pragma unroll
            for (int e = 0; e < 4; ++e) w |= ((unsigned)(int)rintf(xf[4 * i + e] * isx) & 0xFFu) << (8 * e);
            qx[i] = w;
        }
        *(u32x4*)(ws + GS_XQ + tok * 1024 + 16 * lane) = qx;
        if (lane == 0) ((float*)(ws + GS_SX))[tok] = sx;
        const unsigned idpair = *((const unsigned*)(ws + OFF_SELID) + tok * 64 + lane);
        const f32x2 gpair = *((const f32x2*)(ws + OFF_SELG) + tok * 64 + lane);
        const unsigned id0 = idpair & 0xFFFFu, id1 = idpair >> 16;
        const int sl0 = (int)(id0 >> 11), sl1 = (int)(id1 >> 11);
        const unsigned long long lt = (1ull << lane) - 1ull;
        int base = 0, pos0 = 0, pos1 = 0, myoff = 0;
#pragma unroll
        for (int s = 0; s < 8; ++s) {
            const unsigned long long m0 = __ballot(sl0 == s), m1 = __ballot(sl1 == s);
            const int c0 = __popcll(m0), c1 = __popcll(m1);
            if (sl0 == s) pos0 = base + __popcll(m0 & lt);
            if (sl1 == s) pos1 = base + c0 + __popcll(m1 & lt);
            if (lane == s) myoff = base;
            base += c0 + c1;
        }
        if (lane == 8) myoff = base;
        unsigned short* sid = (unsigned short*)(ws + GS_SIDS) + tok * 128;
        float* sg = (float*)(ws + GS_SGS) + tok * 128;
        sid[pos0] = (unsigned short)id0; sid[pos1] = (unsigned short)id1;
        { const int k = (tl - lw) / nW; lids[k * 128 + pos0] = (unsigned short)id0; lids[k * 128 + pos1] = (unsigned short)id1; if (lane < 9) loff[k * 16 + lane] = (unsigned char)myoff; }
        sg[pos0] = gpair[0]; sg[pos1] = gpair[1];
        if (lane < 9) ((int*)(ws + GS_OFF))[tok * 16 + lane] = myoff;
    }
    __syncthreads();
#pragma unroll 1
    for (int pass = 0; pass < 8; ++pass) {
        const int slice = (pass + x) & 7;
#pragma unroll 1
        for (int tl = lw; tl < TPX; tl += nW) {
            const size_t tok = (size_t)x * TPX + tl;
            const int* offp = (const int*)(ws + GS_OFF) + tok * 16;
            const int kslot = (tl - lw) / nW;
            const int o0 = __builtin_amdgcn_readfirstlane((int)loff[kslot * 16 + slice]), o1 = __builtin_amdgcn_readfirstlane((int)loff[kslot * 16 + slice + 1]);
            const int n = o1 - o0;
            if (n == 0 && pass != 0 && pass != 7) continue;
            float acc[16]; float csum = 0.f;
            if (pass == 0) {
#pragma unroll
                for (int i = 0; i < 16; ++i) acc[i] = 0.f;
            } else {
                const bf16_t* ap = (const bf16_t*)(ws + GS_ACC) + tok * 1024 + 16 * lane;
                const char* la = lacc + ((tl - lw) / nW) * 2048;
                const u32x4 w0 = *(const u32x4*)la, w1 = *(const u32x4*)(la + 16);
#pragma unroll
                for (int e = 0; e < 4; ++e) { acc[2 * e] = bf_lo(w0[e]); acc[2 * e + 1] = bf_hi(w0[e]); acc[8 + 2 * e] = bf_lo(w1[e]); acc[8 + 2 * e + 1] = bf_hi(w1[e]); }
            }
            if (n > 0) {
                const u32x4 qv = ldu4(ws + GS_XQ + tok * 1024 + 16 * lane);
                const unsigned qx[4] = {qv[0], qv[1], qv[2], qv[3]};
                const float sx = ((const float*)(ws + GS_SX))[tok];
#pragma unroll 1
                for (int c0 = 0; c0 < n; c0 += 64) {
                    const int nc = (n - c0) < 64 ? (n - c0) : 64;
                    const int li = (lane < nc) ? lane : 0;
                    const unsigned myid = (unsigned)lids[kslot * 128 + o0 + c0 + li];
                    const float mygate = ((const float*)(ws + GS_SGS))[tok * 128 + o0 + c0 + li];
                    GBatch B0, B1;
                    gs_load(B0, ws, myid, mygate, 0, nc, lane);
#pragma unroll 1
                    for (int j0 = 0; j0 < nc; j0 += 8) {
                        if (j0 + 4 < nc) gs_load(B1, ws, myid, mygate, j0 + 4, nc, lane);
                        gather_compute(B0, qx, sx, acc, csum, lane);
                        if (j0 + 4 < nc) {
                            if (j0 + 8 < nc) gs_load(B0, ws, myid, mygate, j0 + 8, nc, lane);
                            gather_compute(B1, qx, sx, acc, csum, lane);
                        }
                    }
                }
#pragma unroll
                for (int i = 0; i < 16; ++i) acc[i] -= 128.0f * csum;
            }
            if (pass < 7) {
                bf16_t* ap = (bf16_t*)(ws + GS_ACC) + tok * 1024 + 16 * lane;
                u32x4 w0, w1;
#pragma unroll
                for (int e = 0; e < 4; ++e) { w0[e] = pack2(acc[2 * e], acc[2 * e + 1]); w1[e] = pack2(acc[8 + 2 * e], acc[8 + 2 * e + 1]); }
                char* la = lacc + ((tl - lw) / nW) * 2048;
                *(u32x4*)la = w0; *(u32x4*)(la + 16) = w1;
            } else {
                const bf16_t* hrow = (const bf16_t*)(ws + OFF_HB) + tok * 1024 + 16 * lane;
                const u32x4 w0 = ldu4(hrow), w1 = ldu4(hrow + 8);
                float ss = 0.f;
#pragma unroll
                for (int e = 0; e < 4; ++e) {
                    acc[2 * e] += bf_lo(w0[e]); acc[2 * e + 1] += bf_hi(w0[e]); acc[8 + 2 * e] += bf_lo(w1[e]); acc[8 + 2 * e + 1] += bf_hi(w1[e]);
                }
#pragma unroll
                for (int i = 0; i < 16; ++i) ss += acc[i] * acc[i];
#pragma unroll
                for (int o = 32; o; o >>= 1) ss += __shfl_xor(ss, o);
                const float rf = rsqrtf(ss * (1.0f / 1024.0f) + 1e-6f);
                float* drow = p.out + tok * 1024 + 16 * lane;
#pragma unroll
                for (int i = 0; i < 4; ++i) {
                    const f32x4 nn = *(const f32x4*)(p.norm_final + 16 * lane + 4 * i);
                    *(f32x4*)(drow + 4 * i) = (f32x4){acc[4 * i] * rf * nn[0], acc[4 * i + 1] * rf * nn[1], acc[4 * i + 2] * rf * nn[2], acc[4 * i + 3] * rf * nn[3]};
                }
            }
        }
    }
}
constexpr int LDS_BYTES = 131072 + 16384 + 1024;
constexpr int NPHASE = 12;
template <int PH> DI void run_phase(const Params& p, char* smem) {
    char* lds = smem + vhalf() * 65536;
    if (PH == 0) phase_prep(p, lds);
    else if (PH == 1) phase_p1(p, smem);
    else if (PH == 2) phase_p2(p, smem);
    else if (PH == 3) phase_p3(p, lds);
    else if (PH == 4) phase_p35(p, lds);
    else if (PH == 5) phase_resid<false>(p, smem, OFF_WT_OUT, OFF_MIXED, p.x, OFF_SS1);
    else if (PH == 6) phase_rowscale(p, smem, OFF_WT_MQ, 1024, (bf16_t*)(p.ws + OFF_QM), OFF_SS1, 0.0625f * LOG2E);
    else if (PH == 7) phase_memattn(p, lds);
    else if (PH == 8) phase_resid<true>(p, smem, OFF_WT_MO, OFF_OM, p.ws + OFF_HB, OFF_SS2);
    else if (PH == 9) phase_rowscale(p, smem, OFF_WT_PQ, 2048, (bf16_t*)((char*)p.out + OUT_PQ), OFF_SS2, 1.0f);
    else if (PH == 10) phase_select(p, lds);
    else if (PH == 11) phase_gather_sliced(p, smem);
}

template <int PH> __global__ void __launch_bounds__(512, 2) k_phase(Params p) {
    __shared__ __attribute__((aligned(16))) char smem[LDS_BYTES];
    run_phase<PH>(p, smem);
}

static Params make_params(void* const* d_in, void* d_out, void* d_ws) {
    Params p;
    memset(&p, 0, sizeof(p));
    p.x = (const float*)d_in[0]; p.mem = (const float*)d_in[1]; p.norm_mix = (const float*)d_in[2]; p.w_in = (const float*)d_in[3];
    p.q_norm = (const float*)d_in[4]; p.kv_norm = (const float*)d_in[5]; p.w_uq = (const float*)d_in[6]; p.w_ukv = (const float*)d_in[7];
    p.gn_mla = (const float*)d_in[8]; p.gn_dil = (const float*)d_in[9]; p.w_out = (const float*)d_in[10]; p.norm_mem_q = (const float*)d_in[11];
    p.norm_mem_kv = (const float*)d_in[12]; p.w_mem_q = (const float*)d_in[13]; p.w_mem_kv = (const float*)d_in[14]; p.w_mem_o = (const float*)d_in[15];
    p.norm_ffn = (const float*)d_in[16]; p.peer_w_q = (const float*)d_in[17]; p.sub_keys = (const float*)d_in[18]; p.peer_u = (const float*)d_in[19];
    p.peer_v = (const float*)d_in[20]; p.norm_final = (const float*)d_in[21];
    p.out = (float*)d_out; p.ws = (char*)d_ws;
    for (int i = 0; i < 16; ++i) p.inv_freq[i] = 1.0f / powf(10000.0f, (float)(2 * i) / 32.0f);
    return p;
}
__global__ void __launch_bounds__(512, 2) k_mega(Params p) {
    __shared__ __attribute__((aligned(16))) char smem[LDS_BYTES + 16];
    volatile LAS unsigned* st = (volatile LAS unsigned*)(LAS char*)(smem + LDS_BYTES);
    if (threadIdx.x == 0) { st[0] = 0u; st[1] = 0u; st[2] = 0u; st[3] = 0u; }
    __syncthreads();
    const XcdBarrier xb = xcd_barrier_post((unsigned*)(p.ws + OFF_BAR), st);
#define RP(n) run_phase<n>(p, smem); xcd_barrier(xb);
    RP(0) RP(1) RP(2) RP(3) RP(4) RP(5) RP(6) RP(7) RP(8) RP(9) RP(10)
    run_phase<11>(p, smem);
}

extern "C" void kernel_launch(void* const* d_in, const int* in_sizes, int n_in, void* d_out, int out_size, void* d_ws, size_t ws_size,
                              hipStream_t stream) {
    static int grid_blocks = 0;
    if (!grid_blocks) {
        int dev = 0, cus = 0, per_cu = 0;
        (void)hipGetDevice(&dev);
        (void)hipDeviceGetAttribute(&cus, hipDeviceAttributeMultiprocessorCount, dev);
        (void)hipOccupancyMaxActiveBlocksPerMultiprocessor(&per_cu, k_mega, 512, 0);
        if (per_cu > 1) per_cu = 1;
        if (per_cu < 1) per_cu = 1;
        grid_blocks = cus * per_cu;
    }
    Params p = make_params(d_in, d_out, d_ws);
    (void)hipMemsetAsync((char*)d_ws + OFF_BAR, 0, XCD_BAR_WORDS * 4, stream);
    void* args[] = {&p};
    hipError_t e = hipLaunchCooperativeKernel((const void*)k_mega, dim3(grid_blocks), dim3(512), args, 0, stream);
    if (e != hipSuccess) fprintf(stderr, "cooperative launch failed: %s (grid %d)\n", hipGetErrorString(e), grid_blocks);
}
```

```cpp
#include <hip/hip_runtime.h>
#include <hip/hip_cooperative_groups.h>
#include <math.h>
#include <stdint.h>
#include <stdio.h>
#include <string.h>
#define DI __device__ __forceinline__
typedef unsigned short bf16_t;
typedef short bf16x8 __attribute__((ext_vector_type(8)));
typedef short s16x4 __attribute__((ext_vector_type(4)));
typedef float f32x16 __attribute__((ext_vector_type(16)));
typedef float f32x4 __attribute__((ext_vector_type(4)));
typedef float f32x2 __attribute__((ext_vector_type(2)));
typedef unsigned u32x4 __attribute__((ext_vector_type(4)));
typedef unsigned u32x2 __attribute__((ext_vector_type(2)));
typedef __bf16 bf16x2v __attribute__((ext_vector_type(2)));
#define LAS __attribute__((address_space(3)))
#define MFMA32(a, b, c) __builtin_amdgcn_mfma_f32_32x32x16_bf16((a), (b), (c), 0, 0, 0)

constexpr int T_TOK = 16384, SEQ_L = 4096, DM = 1024, INC = 2208;
constexpr float LOG2E = 1.4426950408889634f;

DI int otid() { int t = threadIdx.x & 255; asm volatile("" : "+v"(t)); return t; }
DI int vhalf() { return __builtin_amdgcn_readfirstlane((int)(threadIdx.x >> 8)); }
DI int vbid() { return (int)blockIdx.x * 2 + vhalf(); }
DI int vgrid() { return (int)gridDim.x * 2; }
DI unsigned pack2(float lo, float hi) { f32x2 f = {lo, hi}; return __builtin_bit_cast(unsigned, __builtin_convertvector(f, bf16x2v)); }
DI float bf_lo(unsigned u) { return __uint_as_float(u << 16); }
DI float bf_hi(unsigned u) { return __uint_as_float(u & 0xffff0000u); }
DI float bf2f(bf16_t v) { return __uint_as_float(((unsigned)v) << 16); }
DI int crow(int reg, int hh) { return (reg & 3) + 8 * (reg >> 2) + 4 * hh; }
DI f32x16 zero16() { f32x16 z;
#pragma unroll
    for (int i = 0; i < 16; ++i) z[i] = 0.f; return z; }
DI float xhalf_max(float v) { auto r = __builtin_amdgcn_permlane32_swap(__float_as_uint(v), __float_as_uint(v), false, false); return fmaxf(__uint_as_float(r[0]), __uint_as_float(r[1])); }
DI float xhalf_other(float v, int lane) { auto r = __builtin_amdgcn_permlane32_swap(__float_as_uint(v), __float_as_uint(v), false, false); return __uint_as_float((lane & 32) ? r[0] : r[1]); }
DI float xhalf_sum(float v) { auto r = __builtin_amdgcn_permlane32_swap(__float_as_uint(v), __float_as_uint(v), false, false); return __uint_as_float(r[0]) + __uint_as_float(r[1]); }
DI bf16x8 ld16(const void* p) { return *(const bf16x8*)p; }
DI u32x4 ldu4(const void* p) { return *(const u32x4*)p; }
DI float fast_exp2(float x) { return __builtin_amdgcn_exp2f(x); }
DI bf16x8 pack_step(const f32x16& x, int s) {
    u32x4 p;
    p[0] = pack2(x[8 * s + 0], x[8 * s + 1]); p[1] = pack2(x[8 * s + 2], x[8 * s + 3]);
    p[2] = pack2(x[8 * s + 4], x[8 * s + 5]); p[3] = pack2(x[8 * s + 6], x[8 * s + 7]);
    return __builtin_bit_cast(bf16x8, p);
}
DI s16x4 tr_read_a(unsigned lds_byte_addr) { s16x4 r; asm volatile("ds_read_b64_tr_b16 %0, %1" : "=v"(r) : "v"(lds_byte_addr)); return r; }
#define TR_WAIT() do { asm volatile("s_waitcnt lgkmcnt(0)" ::: "memory"); __builtin_amdgcn_sched_barrier(0); } while (0)
DI s16x4 tr_read(unsigned lds_byte_addr) {
    return __builtin_amdgcn_ds_read_tr16_b64_v4i16((LAS s16x4*)(uintptr_t)lds_byte_addr);
}

constexpr size_t MiB = 1ull << 20;
constexpr size_t OFF_BAR = 0;
constexpr size_t OFF_WT_IN = 65536;
constexpr size_t OFF_WT_UQ = OFF_WT_IN + 2304ull * 1024 * 2;
constexpr size_t OFF_WT_UKV = OFF_WT_UQ + 768ull * 384 * 2;
constexpr size_t OFF_WT_OUT = OFF_WT_UKV + 1024ull * 256 * 2;
constexpr size_t OFF_WT_MQ = OFF_WT_OUT + 1024ull * 1024 * 2;
constexpr size_t OFF_WT_MKV = OFF_WT_MQ + 1024ull * 1024 * 2;
constexpr size_t OFF_WT_MO = OFF_WT_MKV + 2048ull * 1024 * 2;
constexpr size_t OFF_WT_PQ = OFF_WT_MO + 1024ull * 1024 * 2;
constexpr size_t OFF_KEYS = OFF_WT_PQ + 2048ull * 1024 * 2;
constexpr size_t OFF_ROPE = OFF_KEYS + 16ull * 128 * 128 * 2;
constexpr size_t OFF_KR = OFF_ROPE + 2ull * 4096 * 16 * 4;
constexpr size_t OFF_LSE = OFF_KR + (size_t)T_TOK * 32 * 2;
constexpr size_t OFF_SS1 = OFF_LSE + 3ull * T_TOK * 8 * 4;
constexpr size_t OFF_SS2 = OFF_SS1 + (size_t)T_TOK * 16 * 4;
constexpr size_t OFF_MEMN = OFF_SS2 + (size_t)T_TOK * 16 * 4;
constexpr size_t OFF_SMALL_END = OFF_MEMN + 1024ull * 1024 * 2;
static_assert(OFF_SMALL_END <= 28 * MiB, "small region overflow");
constexpr size_t OFF_A = 28 * MiB;
constexpr size_t OFF_PROJ = OFF_A;
constexpr size_t OFF_UQ = 193 * MiB;
constexpr size_t OFF_VQ = 209 * MiB;
constexpr size_t OFF_SU = 243 * MiB;
constexpr size_t OFF_SV = OFF_SU + 65536;
constexpr size_t OUT_ODIL = 0;
constexpr size_t OUT_OMLA = 48 * MiB;
constexpr size_t OUT_PQ = 0;
constexpr size_t OFF_B = 97 * MiB;
constexpr size_t OFF_XN = OFF_B, OFF_QMLA = OFF_B, OFF_MIXED = OFF_B, OFF_QM = OFF_B;
constexpr size_t OFF_C = 129 * MiB;
constexpr size_t OFF_KVMLA = OFF_C, OFF_HB = OFF_C;
constexpr size_t OFF_D = 161 * MiB;
constexpr size_t OFF_OM = OFF_D;
constexpr size_t OFF_SELID = 225 * MiB;
constexpr size_t OFF_SELG = 229 * MiB;
constexpr size_t OFF_KVM = 237 * MiB;
constexpr size_t OFF_SSQ = 241 * MiB;
constexpr size_t WS_NEEDED = 244 * MiB;

struct Params {
    const float* x; const float* mem; const float* norm_mix; const float* w_in; const float* q_norm; const float* kv_norm;
    const float* w_uq; const float* w_ukv; const float* gn_mla; const float* gn_dil; const float* w_out; const float* norm_mem_q;
    const float* norm_mem_kv; const float* w_mem_q; const float* w_mem_kv; const float* w_mem_o; const float* norm_ffn;
    const float* peer_w_q; const float* sub_keys; const float* peer_u; const float* peer_v; const float* norm_final;
    float* out; char* ws;
    float inv_freq[16];
    int prof; int pad_;
};
#define XB_TMO      128
#define XB_XCNT(j)  (256  + 64 * (j))
#define XB_XSUB(j)  (1280 + 64 * (j))
#define XB_XGEN(j)  (2304 + 64 * (j))
#define XB_TOP      3328
#define XB_TOPGEN   3392
#define XCD_BAR_WORDS 3456
#define XB_SPIN_CAP (1u << 20)
DI unsigned xb_ld(unsigned* p) { return __hip_atomic_load(p, __ATOMIC_RELAXED, __HIP_MEMORY_SCOPE_AGENT); }
DI unsigned xb_add(unsigned* p, unsigned v) { return __hip_atomic_fetch_add(p, v, __ATOMIC_RELAXED, __HIP_MEMORY_SCOPE_AGENT); }
DI unsigned xb_xcc_id() { return (unsigned)__builtin_amdgcn_s_getreg((3 << 11) | 20) & 0xFu; }
#define XB_SPIN(cond, bar) do { unsigned _sp = 0; while (cond) { __builtin_amdgcn_s_sleep(1); \
    if ((++_sp & 255u) == 0u) { if (xb_ld(&(bar)[XB_TMO])) break; if (_sp > XB_SPIN_CAP) { atomicAdd(&(bar)[XB_TMO], 1u); break; } } } } while (0)
struct XcdBarrier { unsigned* bar; unsigned x; volatile LAS unsigned* st; };
DI XcdBarrier xcd_barrier_post(unsigned* bar, volatile LAS unsigned* st) {
    XcdBarrier b; b.bar = bar; b.x = xb_xcc_id(); b.st = st;
    if (threadIdx.x == 0) (void)xb_add(&bar[XB_XCNT(b.x)], 1u);
    return b;
}
DI void xcd_barrier_complete(unsigned* bar, unsigned x, unsigned& nloc, unsigned& nx) {
    const unsigned G = gridDim.x * gridDim.y * gridDim.z;
    unsigned sum, cnt, mine, sp = 0u;
    for (;;) {
        sum = 0u; cnt = 0u; mine = 0u;
#pragma unroll
        for (unsigned j = 0; j < 16; ++j) { const unsigned c = xb_ld(&bar[XB_XCNT(j)]); sum += c; cnt += (c > 0u) ? 1u : 0u; mine = (j == x) ? c : mine; }
        if (sum == G) break;
        __builtin_amdgcn_s_sleep(1);
        if ((++sp & 255u) == 0u) { if (xb_ld(&bar[XB_TMO])) break; if (sp > XB_SPIN_CAP) { atomicAdd(&bar[XB_TMO], 1u); break; } }
    }
    nloc = mine > 0u ? mine : 1u; nx = cnt > 0u ? cnt : 1u;
}
DI void xcd_barrier(const XcdBarrier& b) {
    asm volatile("s_waitcnt vmcnt(0)" ::: "memory");
    __syncthreads();
    if (threadIdx.x == 0) {
        unsigned* bar = b.bar;
        __builtin_amdgcn_s_waitcnt(0);
        unsigned nloc = b.st[0], nx = b.st[1];
        if (nloc == 0u) { xcd_barrier_complete(bar, b.x, nloc, nx); b.st[0] = nloc; b.st[1] = nx; }
        const unsigned old = xb_add(&bar[XB_XSUB(b.x)], 1u);
        const unsigned gen = old / nloc;
        if (old + 1u == (gen + 1u) * nloc) {
            __builtin_amdgcn_fence(__ATOMIC_RELEASE, "agent");
            asm volatile("s_waitcnt vmcnt(0)" ::: "memory");
            const unsigned og = xb_add(&bar[XB_TOP], 1u);
            const unsigned tg = og / nx;
            if (og + 1u == (tg + 1u) * nx) xb_add(&bar[XB_TOPGEN], 1u);
            else XB_SPIN(xb_ld(&bar[XB_TOPGEN]) == tg, bar);
            __builtin_amdgcn_fence(__ATOMIC_ACQUIRE, "agent");
            xb_add(&bar[XB_XGEN(b.x)], 1u);
            asm volatile("s_waitcnt vmcnt(0)" ::: "memory");
        } else {
            XB_SPIN(xb_ld(&bar[XB_XGEN(b.x)]) == gen, bar);
            __builtin_amdgcn_fence(__ATOMIC_ACQUIRE, "agent");
            asm volatile("s_waitcnt vmcnt(0)" ::: "memory");
        }
    }
    __syncthreads();
}
DI void transpose_tile(const float* __restrict__ W, int K, int N, const float* __restrict__ g, bf16_t* __restrict__ Wt, int kt, int nt, char* lds, bool valid) {
    float* sm = (float*)lds;
    const int t = otid();
    const int k0 = kt * 64, n0 = nt * 64;
    __syncthreads();
#pragma unroll
    for (int i = 0; i < 16; ++i) {
        const int id = t + 256 * i, k = id >> 6, n = id & 63;
        float v = 0.f;
        if (valid && n0 + n < N) { v = W[(size_t)(k0 + k) * N + n0 + n]; if (g) v *= g[k0 + k]; }
        sm[k * 65 + n] = v;
    }
    __syncthreads();
    const int n = t >> 2, kc = (t & 3) * 16;
    u32x4 o0, o1;
    o0[0] = pack2(sm[(kc + 0) * 65 + n], sm[(kc + 1) * 65 + n]); o0[1] = pack2(sm[(kc + 2) * 65 + n], sm[(kc + 3) * 65 + n]);
    o0[2] = pack2(sm[(kc + 4) * 65 + n], sm[(kc + 5) * 65 + n]); o0[3] = pack2(sm[(kc + 6) * 65 + n], sm[(kc + 7) * 65 + n]);
    o1[0] = pack2(sm[(kc + 8) * 65 + n], sm[(kc + 9) * 65 + n]); o1[1] = pack2(sm[(kc + 10) * 65 + n], sm[(kc + 11) * 65 + n]);
    o1[2] = pack2(sm[(kc + 12) * 65 + n], sm[(kc + 13) * 65 + n]); o1[3] = pack2(sm[(kc + 14) * 65 + n], sm[(kc + 15) * 65 + n]);
    bf16_t* dst = Wt + (size_t)(n0 + n) * K + k0 + kc;
    if (valid) { *(u32x4*)dst = o0; *(u32x4*)(dst + 8) = o1; }
}

DI void rmsnorm_row_bf16(const float* __restrict__ in, const float* __restrict__ g, bf16_t* __restrict__ out, int lane) {
    f32x4 v[4]; float ss = 0.f;
#pragma unroll
    for (int i = 0; i < 4; ++i) { v[i] = *(const f32x4*)(in + 4 * lane + 256 * i); ss += v[i][0] * v[i][0] + v[i][1] * v[i][1] + v[i][2] * v[i][2] + v[i][3] * v[i][3]; }
#pragma unroll
    for (int o = 32; o; o >>= 1) ss += __shfl_xor(ss, o);
    const float rs = rsqrtf(ss * (1.0f / 1024.0f) + 1e-6f);
#pragma unroll
    for (int i = 0; i < 4; ++i) {
        const f32x4 gg = *(const f32x4*)(g + 4 * lane + 256 * i);
        u32x2 o; o[0] = pack2(v[i][0] * rs * gg[0], v[i][1] * rs * gg[1]); o[1] = pack2(v[i][2] * rs * gg[2], v[i][3] * rs * gg[3]);
        *(u32x2*)(out + 4 * lane + 256 * i) = o;
    }
}

struct TrJob { const float* W; const float* g; size_t off; int K, N, Npad; };

DI void phase_prep(const Params& p, char* lds) {
    char* ws = p.ws;
    const int t = otid(), lane = t & 63, wv = t >> 6;
    const int c0 = 576, c1 = c0 + 72, c2 = c1 + 64, c3 = c2 + 256, c4 = c3 + 256, c5 = c4 + 512, c6 = c5 + 256, c7 = c6 + 512;
    const int nrow = (T_TOK + 1024) / 4;
    const int nkeys = 128, nrope = 256;
    const int total = c7 + nrow + nkeys + nrope;
    for (int k = 0; k < (c7 + vgrid() - 1) / vgrid(); ++k) {
        const int raw = vbid() + k * vgrid();
        const bool valid = raw < c7;
        const int item = valid ? raw : 0;
        const float* W; const float* g; size_t off; int K, N, Npad, local;
        if (item < c0)      { W = p.w_in;     g = nullptr;      off = OFF_WT_IN;  K = 1024; N = 2208; Npad = 2304; local = item; }
        else if (item < c1) { W = p.w_uq;     g = p.q_norm;     off = OFF_WT_UQ;  K = 384;  N = 768;  Npad = 768;  local = item - c0; }
        else if (item < c2) { W = p.w_ukv;    g = p.kv_norm;    off = OFF_WT_UKV; K = 256;  N = 1024; Npad = 1024; local = item - c1; }
        else if (item < c3) { W = p.w_out;    g = nullptr;      off = OFF_WT_OUT; K = 1024; N = 1024; Npad = 1024; local = item - c2; }
        else if (item < c4) { W = p.w_mem_q;  g = p.norm_mem_q; off = OFF_WT_MQ;  K = 1024; N = 1024; Npad = 1024; local = item - c3; }
        else if (item < c5) { W = p.w_mem_kv; g = nullptr;      off = OFF_WT_MKV; K = 1024; N = 2048; Npad = 2048; local = item - c4; }
        else if (item < c6) { W = p.w_mem_o;  g = nullptr;      off = OFF_WT_MO;  K = 1024; N = 1024; Npad = 1024; local = item - c5; }
        else                { W = p.peer_w_q; g = p.norm_ffn;   off = OFF_WT_PQ;  K = 1024; N = 2048; Npad = 2048; local = item - c6; }
        const int ntn = Npad / 64;
        transpose_tile(W, K, N, g, (bf16_t*)(ws + off), local / ntn, local % ntn, lds, valid);
    }
    for (int item = c7 + vbid(); item < total; item += vgrid()) {
        if (item < c7 + nrow) {
            const int row = (item - c7) * 4 + wv;
            if (row < T_TOK) rmsnorm_row_bf16(p.x + (size_t)row * 1024, p.norm_mix, (bf16_t*)(ws + OFF_XN) + (size_t)row * 1024, lane);
            else rmsnorm_row_bf16(p.mem + (size_t)(row - T_TOK) * 1024, p.norm_mem_kv, (bf16_t*)(ws + OFF_MEMN) + (size_t)(row - T_TOK) * 1024, lane);
        } else if (item < c7 + nrow + nkeys) {
            const int idx = ((item - c7 - nrow) * 256 + t) * 8;
            const f32x4 a = *(const f32x4*)(p.sub_keys + idx), b = *(const f32x4*)(p.sub_keys + idx + 4);
            u32x4 o; o[0] = pack2(a[0], a[1]); o[1] = pack2(a[2], a[3]); o[2] = pack2(b[0], b[1]); o[3] = pack2(b[2], b[3]);
            *(u32x4*)((bf16_t*)(ws + OFF_KEYS) + idx) = o;
        } else {
            const int idx = (item - c7 - nrow - nkeys) * 256 + t;
            const int s = idx >> 4, i = idx & 15;
            const float ang = (float)s * p.inv_freq[i];
            const double a = (double)ang;
            const double twopi = 6.283185307179586476925;
            const float rf = (float)(a - twopi * rint(a / twopi));
            float* cs = (float*)(ws + OFF_ROPE);
            cs[idx] = cosf(rf); cs[65536 + idx] = sinf(rf);
        }
    }
}
namespace pg8 {
#define PG8_LAS __attribute__((address_space(3)))
typedef unsigned short bf16_t;
typedef short bf16x8 __attribute__((ext_vector_type(8)));
typedef float f32x4 __attribute__((ext_vector_type(4)));
typedef unsigned u32x4 __attribute__((ext_vector_type(4)));
constexpr int BM = 256, BK = 64, HALF = 128, HTB = HALF * BK * 2  , STAGE_BYTES = 8 * HTB, NXCD = 8, WGM = 8;

__host__ __device__ __forceinline__ int lds_byte(int r, int c) { const int st = (r >> 4) * 2 + (c >> 5), rr = r & 15, cc = c & 31, ob = rr * 64 + cc * 2; return st * 1024 + (ob ^ (((ob >> 9) & 1) << 5)); }
__host__ __device__ __forceinline__ void stage_rc(int b, int& R, int& C) { const int st = b / 1024, sb = b % 1024, swz = sb ^ (((sb >> 9) & 1) << 5); R = (st >> 1) * 16 + swz / 64; C = (st & 1) * 32 + (swz % 64) / 2; }
__host__ __device__ __forceinline__ int perm32(int rho) { const int n = rho >> 4, i = rho & 15; return 8 * (i >> 2) + 4 * n + (i & 3); }

struct Unit { int pm, pn; };
struct Gemm { const bf16_t* A; const bf16_t* Bt; int M, N, K, lda; };

struct StaticOrder {
    int nM, nN, nwg, G, c;
    __host__ __device__ void init(int M, int N, int G_, int c_) { nM = M / BM; nN = N / BM; nwg = nM * nN; G = G_; c = c_; }
    __host__ __device__ bool next(int i, Unit& u) const {
        const long L = (long)i * G + c; if (L >= nwg) return false;
        int wgid = (int)L; { const int q = nwg / NXCD, r = nwg % NXCD, xcd = wgid % NXCD, off = wgid / NXCD; wgid = (xcd < r ? xcd * (q + 1) : r * (q + 1) + (xcd - r) * q) + off; }
        const int nig = WGM * nN, gid = wgid / nig, fm = gid * WGM, gsz = (nM - fm) < WGM ? (nM - fm) : WGM;
        u.pm = fm + ((wgid % nig) % gsz); u.pn = (wgid % nig) / gsz; return true;
    }
    __device__ __forceinline__ void a_ready(const Unit&) const {}
    __device__ __forceinline__ void done(const Unit&) const {}
};

template <class Epi, class Sched, bool ALIGN_EPI = false, bool SP2 = false>
__device__ __forceinline__ void gemm_phase(PG8_LAS unsigned char* lds, const Gemm g, const Sched& S, const Epi& E) {
    int tid_ = threadIdx.x; asm volatile("" : "+v"(tid_));
    const int tid = tid_, wid = __builtin_amdgcn_readfirstlane(tid >> 6), lane = tid & 63, wr = wid >> 2, wc = wid & 3, fr = lane & 15, fq = lane >> 4;
    const int K = g.K, nt = K / BK, lda = g.lda;
    unsigned voffA[2], voffB[2];
#pragma unroll
    for (int i = 0; i < 2; ++i) { int R, C; stage_rc(tid * 16 + i * 8192, R, C); const int Rb = Epi::PERM ? ((R & ~31) + perm32(R & 31)) : R;
        voffA[i] = (unsigned)(R * lda + C) * 2u; voffB[i] = (unsigned)(Rb * K + C) * 2u; }
    const size_t kstep = (size_t)(BK * 2);
    const size_t hstepB = (size_t)HALF * K * 2, hstepA = (size_t)HALF * lda * 2;
    const size_t tstepB = 2 * hstepB, tstepA = 2 * hstepA;
    const unsigned ldsw = (unsigned)wid * 1024u;
    const int aoff = lds_byte(wr * 64 + fr, fq * 8), boff = lds_byte(wc * 32 + fr, fq * 8);
#define PG8_SA(b, h) (((b) * 2 + (h)) * HTB)
#define PG8_SB(b, h) ((4 + (b) * 2 + (h)) * HTB)
#define PG8_STAGE(bufoff, gbase, voff) do { _Pragma("unroll") for (int _i = 0; _i < 2; ++_i) \
        __builtin_amdgcn_global_load_lds((const unsigned*)((const char*)(gbase) + (voff)[_i]), (PG8_LAS unsigned*)(lds + (bufoff) + ldsw + _i * 8192), 16, 0, 0); } while (0)
#define PG8_LDA(dst, b, h) do { _Pragma("unroll") for (int m = 0; m < 4; ++m) _Pragma("unroll") for (int k = 0; k < 2; ++k) dst[m][k] = *(const PG8_LAS bf16x8*)(lds + PG8_SA(b, h) + aoff + m * 2048 + k * 1024); } while (0)
#define PG8_LDB(dst, b, h) do { _Pragma("unroll") for (int n = 0; n < 2; ++n) _Pragma("unroll") for (int k = 0; k < 2; ++k) dst[n][k] = *(const PG8_LAS bf16x8*)(lds + PG8_SB(b, h) + boff + n * 2048 + k * 1024); } while (0)
#define PG8_MMA(ai, bj, At, Bt) do { __builtin_amdgcn_s_setprio(1); _Pragma("unroll") for (int m = 0; m < 4; ++m) _Pragma("unroll") for (int n = 0; n < 2; ++n) _Pragma("unroll") for (int k = 0; k < 2; ++k) \
        acc[ai][bj][m][n] = __builtin_amdgcn_mfma_f32_16x16x32_bf16(Bt[n][k], At[m][k], acc[ai][bj][m][n], 0, 0, 0); __builtin_amdgcn_s_setprio(0); } while (0)
#define PG8_WAIT_V(n) asm volatile("s_waitcnt vmcnt(" #n ")" ::: "memory")
#define PG8_WAIT_L(n) asm volatile("s_waitcnt lgkmcnt(" #n ")" ::: "memory")
#define PG8_BAR __builtin_amdgcn_s_barrier()
#define PG8_SCHED __builtin_amdgcn_sched_barrier(0)
    Unit cur, nxt; int ui = 0;
    if (!S.next(0, cur)) return;
    f32x4 acc[2][2][4][2];
#pragma unroll
    for (int a = 0; a < 2; ++a)
#pragma unroll
        for (int b = 0; b < 2; ++b)
#pragma unroll
            for (int m = 0; m < 4; ++m)
#pragma unroll
                for (int n = 0; n < 2; ++n) acc[a][b][m][n] = (f32x4){0.f, 0.f, 0.f, 0.f};
    bf16x8 At[4][2], B0[2][2], B1[2][2];
    const char* cA = (const char*)g.A + (size_t)cur.pm * tstepA; const char* cB = (const char*)g.Bt + (size_t)cur.pn * tstepB;
    S.a_ready(cur);
    if constexpr (SP2) {
        PG8_STAGE(PG8_SB(0, 0), cB, voffB); PG8_STAGE(PG8_SB(0, 1), cB + hstepB, voffB); PG8_STAGE(PG8_SA(0, 0), cA, voffA); PG8_STAGE(PG8_SA(0, 1), cA + hstepA, voffA);
        if (wr == 1) PG8_BAR;
        PG8_WAIT_V(2); PG8_BAR;
        PG8_STAGE(PG8_SB(1, 0), cB + kstep, voffB); PG8_STAGE(PG8_SA(1, 0), cA + kstep, voffA); PG8_STAGE(PG8_SB(1, 1), cB + hstepB + kstep, voffB);
        PG8_WAIT_V(6); PG8_BAR;
    } else {
        PG8_STAGE(PG8_SB(0, 0), cB, voffB); PG8_STAGE(PG8_SA(0, 0), cA, voffA); PG8_STAGE(PG8_SB(0, 1), cB + hstepB, voffB); PG8_STAGE(PG8_SA(0, 1), cA + hstepA, voffA);
        if (wr == 1) PG8_BAR;
        PG8_WAIT_V(4); PG8_BAR;
        PG8_STAGE(PG8_SB(1, 0), cB + kstep, voffB); PG8_STAGE(PG8_SA(1, 0), cA + kstep, voffA); PG8_STAGE(PG8_SB(1, 1), cB + hstepB + kstep, voffB);
        PG8_WAIT_V(6); PG8_BAR;
    }
    for (;;) {
        const bool has_next = S.next(ui + 1, nxt);
        const char* nA = has_next ? (const char*)g.A + (size_t)nxt.pm * tstepA : cA; const char* nB = has_next ? (const char*)g.Bt + (size_t)nxt.pn * tstepB : cB;
#pragma unroll 1
        for (int t = 0; t < nt; t += 2) {
            const bool last = (t == nt - 2);
            const char* a1 = cA + (size_t)(t + 1) * kstep;
            const char* a2 = last ? nA : cA + (size_t)(t + 2) * kstep; const char* b2 = last ? nB : cB + (size_t)(t + 2) * kstep;
            const char* a3 = a2 + kstep; const char* b3 = b2 + kstep;
            if (last && has_next) S.a_ready(nxt);
            if constexpr (SP2) {
            PG8_LDB(B0, 0, 0); PG8_LDB(B1, 0, 1); PG8_SCHED; PG8_LDA(At, 0, 0); PG8_STAGE(PG8_SA(1, 1), a1 + hstepA, voffA);
            PG8_WAIT_V(8); PG8_WAIT_L(0); PG8_BAR; PG8_MMA(0, 0, At, B0); PG8_MMA(0, 1, At, B1); PG8_BAR; PG8_SCHED;
            PG8_LDA(At, 0, 1); PG8_STAGE(PG8_SB(0, 0), b2, voffB); PG8_STAGE(PG8_SB(0, 1), b2 + hstepB, voffB); PG8_STAGE(PG8_SA(0, 0), a2, voffA);
            PG8_WAIT_V(8); PG8_WAIT_L(0); PG8_BAR; PG8_MMA(1, 0, At, B0); PG8_MMA(1, 1, At, B1); PG8_BAR; PG8_SCHED;
            PG8_LDB(B0, 1, 0); PG8_LDB(B1, 1, 1); PG8_SCHED; PG8_LDA(At, 1, 0); PG8_STAGE(PG8_SA(0, 1), a2 + hstepA, voffA);
            PG8_WAIT_V(8); PG8_WAIT_L(0); PG8_BAR; PG8_MMA(0, 0, At, B0); PG8_MMA(0, 1, At, B1); PG8_BAR; PG8_SCHED;
            PG8_LDA(At, 1, 1); PG8_STAGE(PG8_SB(1, 0), b3, voffB); PG8_STAGE(PG8_SB(1, 1), b3 + hstepB, voffB); PG8_STAGE(PG8_SA(1, 0), a3, voffA);
            PG8_WAIT_V(8); PG8_WAIT_L(0); PG8_BAR; PG8_MMA(1, 0, At, B0); PG8_MMA(1, 1, At, B1); PG8_BAR; PG8_SCHED;
            } else {
            PG8_LDB(B0, 0, 0); PG8_SCHED; PG8_LDA(At, 0, 0); PG8_STAGE(PG8_SA(1, 1), a1 + hstepA, voffA);
            PG8_WAIT_L(8); PG8_BAR; PG8_WAIT_L(0); PG8_MMA(0, 0, At, B0); PG8_BAR; PG8_SCHED;
            PG8_LDB(B1, 0, 1); PG8_STAGE(PG8_SB(0, 0), b2, voffB);
            PG8_BAR; PG8_WAIT_L(0); PG8_MMA(0, 1, At, B1); PG8_BAR;
            PG8_LDA(At, 0, 1); PG8_STAGE(PG8_SA(0, 0), a2, voffA);
            PG8_BAR; PG8_WAIT_L(0); PG8_MMA(1, 0, At, B0); PG8_BAR; PG8_SCHED;
            PG8_STAGE(PG8_SB(0, 1), b2 + hstepB, voffB);
            PG8_WAIT_V(6); PG8_BAR; PG8_MMA(1, 1, At, B1); PG8_BAR;
            PG8_LDB(B0, 1, 0); PG8_SCHED; PG8_LDA(At, 1, 0); PG8_STAGE(PG8_SA(0, 1), a2 + hstepA, voffA);
            PG8_WAIT_L(8); PG8_BAR; PG8_WAIT_L(0); PG8_MMA(0, 0, At, B0); PG8_BAR; PG8_SCHED;
            PG8_LDB(B1, 1, 1); PG8_STAGE(PG8_SB(1, 0), b3, voffB);
            PG8_BAR; PG8_WAIT_L(0); PG8_MMA(0, 1, At, B1); PG8_BAR;
            PG8_LDA(At, 1, 1); PG8_STAGE(PG8_SA(1, 0), a3, voffA);
            PG8_BAR; PG8_WAIT_L(0); PG8_MMA(1, 0, At, B0); PG8_BAR; PG8_SCHED;
            PG8_STAGE(PG8_SB(1, 1), b3 + hstepB, voffB);
            PG8_WAIT_V(6); PG8_BAR; PG8_MMA(1, 1, At, B1); PG8_BAR;
            }
        }
        if constexpr (ALIGN_EPI) { if (wr == 0) PG8_BAR; }
        if constexpr (!Epi::AFTER_DRAIN) { E(acc, cur, wr, wc, fr, fq); S.done(cur); }
        if (!has_next) break;
#pragma unroll
        for (int a = 0; a < 2; ++a)
#pragma unroll
            for (int b = 0; b < 2; ++b)
#pragma unroll
                for (int m = 0; m < 4; ++m)
#pragma unroll
                    for (int n = 0; n < 2; ++n) acc[a][b][m][n] = (f32x4){0.f, 0.f, 0.f, 0.f};
        cur = nxt; cA = nA; cB = nB; ++ui;
        if constexpr (ALIGN_EPI) { if (wr == 1) PG8_BAR; }
    }
    PG8_WAIT_V(0);
    if constexpr (!ALIGN_EPI) { if (wr == 0) PG8_BAR; }
    PG8_BAR;
    if constexpr (Epi::AFTER_DRAIN) { E.fused(acc, cur, wr, wc, fr, fq, lds, wid, lane); S.done(cur); }
#undef PG8_SA
#undef PG8_SB
#undef PG8_STAGE
#undef PG8_LDA
#undef PG8_LDB
#undef PG8_MMA
#undef PG8_WAIT_V
#undef PG8_WAIT_L
#undef PG8_BAR
#undef PG8_SCHED
}
}
DI unsigned sw_off(int row, int chunk) { return (unsigned)(row * 128 + ((chunk ^ ((row >> 1) & 7)) << 4)); }
#define GLDS16(gsrc, ldst) __builtin_amdgcn_global_load_lds((const unsigned*)(gsrc), (unsigned*)(ldst), 16, 0, 0)
DI u32x2 pack4(float a, float b, float c, float d) { u32x2 o; o[0] = pack2(a, b); o[1] = pack2(c, d); return o; }
#define EPI_ARGS const f32x4 (&acc)[2][2][4][2], const pg8::Unit& u, int wr, int wc, int fr, int fq
DI float xq_sum(float v) {
    v += __uint_as_float((unsigned)__builtin_amdgcn_ds_swizzle((int)__float_as_uint(v), 0x401F));
    return xhalf_sum(v);
}
DI u32x4 pack8(const float (&v)[8], float sc) {
    u32x4 o; o[0] = pack2(v[0] * sc, v[1] * sc); o[1] = pack2(v[2] * sc, v[3] * sc); o[2] = pack2(v[4] * sc, v[5] * sc); o[3] = pack2(v[6] * sc, v[7] * sc); return o;
}
DI void rope8(const float (&v)[8], float sc, const float* __restrict__ cs, int pos, int fq, int lane, bf16_t* dst32  ) {
    const int i0 = 8 * (fq & 1);
    const f32x4 c0 = *(const f32x4*)(cs + pos * 16 + i0), c1 = *(const f32x4*)(cs + pos * 16 + i0 + 4);
    const f32x4 s0 = *(const f32x4*)(cs + 65536 + pos * 16 + i0), s1 = *(const f32x4*)(cs + 65536 + pos * 16 + i0 + 4);
    const float sg = (fq < 2) ? -1.0f : 1.0f;
    float o[8];
#pragma unroll
    for (int e = 0; e < 8; ++e) {
        const float own = v[e] * sc, oth = xhalf_other(own, lane);
        const float c = (e < 4) ? c0[e & 3] : c1[e & 3], s = (e < 4) ? s0[e & 3] : s1[e & 3];
        o[e] = own * c + sg * oth * s;
    }
    *(u32x4*)(dst32 + 8 * fq) = pack8(o, 1.0f);
}
#define EPI_LOAD8(v, ai, bj, m) float v[8]; { const f32x4 x0_ = acc[ai][bj][m][0], x1_ = acc[ai][bj][m][1]; v[0] = x0_[0]; v[1] = x0_[1]; v[2] = x0_[2]; v[3] = x0_[3]; v[4] = x1_[0]; v[5] = x1_[1]; v[6] = x1_[2]; v[7] = x1_[3]; }

struct EpiPlain8 {
    static constexpr bool PERM = true, AFTER_DRAIN = false;
    bf16_t* out; int ld;
    DI void operator()(EPI_ARGS) const {
#pragma unroll
        for (int ai = 0; ai < 2; ++ai)
#pragma unroll
            for (int m = 0; m < 4; ++m) {
                int fr_ = fr; asm volatile("" : "+v"(fr_));
                const size_t tok = (size_t)u.pm * 256 + ai * 128 + wr * 64 + m * 16 + fr_;
#pragma unroll
                for (int bj = 0; bj < 2; ++bj) { EPI_LOAD8(v, ai, bj, m); *(u32x4*)(out + tok * ld + u.pn * 256 + bj * 128 + wc * 32 + 8 * fq) = pack8(v, 1.0f); }
            }
    }
};

struct EpiProj8 {
    static constexpr bool PERM = true, AFTER_DRAIN = false;
    bf16_t* proj; bf16_t* kr; const float* cs; float* ssq;
    DI void operator()(EPI_ARGS) const {
        const int lane = fr + 16 * fq;
#pragma unroll
        for (int bj = 0; bj < 2; ++bj) {
            const int cg = u.pn * 256 + bj * 128 + wc * 32;
            if (cg >= INC) continue;
            const int g32 = cg >> 5;
            const float sc = (cg >= 672 && cg < 1184) ? 0.125f * LOG2E : 1.0f;
#pragma unroll
            for (int ai = 0; ai < 2; ++ai)
#pragma unroll
                for (int m = 0; m < 4; ++m) {
                    int fr_ = fr; asm volatile("" : "+v"(fr_));
                const size_t tok = (size_t)u.pm * 256 + ai * 128 + wr * 64 + m * 16 + fr_;
                    EPI_LOAD8(v, ai, bj, m);
                    if (g32 < 20) {
                        float ss = 0.f;
#pragma unroll
                        for (int e = 0; e < 8; ++e) ss += v[e] * v[e];
                        ss = xq_sum(ss);
                        if (fq == 0) ssq[tok * 24 + g32] = ss;
                    }
                    if (cg == 640) rope8(v, 1.0f, cs, (int)(tok & (SEQ_L - 1)), fq, lane, kr + tok * 32);
                    else *(u32x4*)(proj + tok * INC + cg + 8 * fq) = pack8(v, sc);
                }
        }
    }
};

struct EpiUpQ8 {
    static constexpr bool PERM = true, AFTER_DRAIN = false;
    bf16_t* q; const float* cs; const float* ssq;
    DI void operator()(EPI_ARGS) const {
        const int lane = fr + 16 * fq;
        const float qs = 0.10206207261596575f * LOG2E;
#pragma unroll
        for (int ai = 0; ai < 2; ++ai)
#pragma unroll
            for (int m = 0; m < 4; ++m) {
                int fr_ = fr; asm volatile("" : "+v"(fr_));
                const size_t tok = (size_t)u.pm * 256 + ai * 128 + wr * 64 + m * 16 + fr_;
                const f32x4 a0 = *(const f32x4*)(ssq + tok * 24), a1 = *(const f32x4*)(ssq + tok * 24 + 4), a2 = *(const f32x4*)(ssq + tok * 24 + 8);
                const float tot = (a0[0] + a0[1] + a0[2] + a0[3]) + (a1[0] + a1[1] + a1[2] + a1[3]) + (a2[0] + a2[1] + a2[2] + a2[3]);
                const float sc = rsqrtf(tot * (1.0f / 384.0f) + 1e-6f) * qs;
#pragma unroll
                for (int bj = 0; bj < 2; ++bj) {
                    const int cg = u.pn * 256 + bj * 128 + wc * 32;
                    EPI_LOAD8(v, ai, bj, m);
                    if ((cg % 96) == 64) rope8(v, sc, cs, (int)(tok & (SEQ_L - 1)), fq, lane, q + tok * 768 + cg);
                    else *(u32x4*)(q + tok * 768 + cg + 8 * fq) = pack8(v, sc);
                }
            }
    }
};

struct EpiUpKV8 {
    static constexpr bool PERM = true, AFTER_DRAIN = false;
    bf16_t* kv; const float* ssq;
    DI void operator()(EPI_ARGS) const {
#pragma unroll
        for (int ai = 0; ai < 2; ++ai)
#pragma unroll
            for (int m = 0; m < 4; ++m) {
                int fr_ = fr; asm volatile("" : "+v"(fr_));
                const size_t tok = (size_t)u.pm * 256 + ai * 128 + wr * 64 + m * 16 + fr_;
                const f32x4 a0 = *(const f32x4*)(ssq + tok * 24 + 12), a1 = *(const f32x4*)(ssq + tok * 24 + 16);
                const float tot = (a0[0] + a0[1] + a0[2] + a0[3]) + (a1[0] + a1[1] + a1[2] + a1[3]);
                const float sc = rsqrtf(tot * (1.0f / 256.0f) + 1e-6f);
#pragma unroll
                for (int bj = 0; bj < 2; ++bj) { EPI_LOAD8(v, ai, bj, m); *(u32x4*)(kv + tok * 1024 + u.pn * 256 + bj * 128 + wc * 32 + 8 * fq) = pack8(v, sc); }
            }
    }
};

template <bool RBF16>
struct EpiResid8 {
    static constexpr bool PERM = true, AFTER_DRAIN = false;
    const void* R; bf16_t* HB; float* SS;
    DI void operator()(EPI_ARGS) const {
#pragma unroll
        for (int ai = 0; ai < 2; ++ai) {
            f32x4 rv[4][2][2];
#pragma unroll
            for (int m = 0; m < 4; ++m)
#pragma unroll
                for (int bj = 0; bj < 2; ++bj) {
                    const size_t off = ((size_t)u.pm * 256 + ai * 128 + wr * 64 + m * 16 + fr) * 1024 + u.pn * 256 + bj * 128 + wc * 32 + 8 * fq;
                    if (RBF16) {
                        const u32x4 w = ldu4((const bf16_t*)R + off);
                        rv[m][bj][0] = (f32x4){bf_lo(w[0]), bf_hi(w[0]), bf_lo(w[1]), bf_hi(w[1])};
                        rv[m][bj][1] = (f32x4){bf_lo(w[2]), bf_hi(w[2]), bf_lo(w[3]), bf_hi(w[3])};
                    } else {
                        rv[m][bj][0] = *(const f32x4*)((const float*)R + off); rv[m][bj][1] = *(const f32x4*)((const float*)R + off + 4);
                    }
                }
#pragma unroll
            for (int m = 0; m < 4; ++m) {
                int fr_ = fr; asm volatile("" : "+v"(fr_));
                const size_t tok = (size_t)u.pm * 256 + ai * 128 + wr * 64 + m * 16 + fr_;
                float ss = 0.f;
#pragma unroll
                for (int bj = 0; bj < 2; ++bj) {
                    const size_t off = tok * 1024 + u.pn * 256 + bj * 128 + wc * 32 + 8 * fq;
                    const f32x4 h0 = rv[m][bj][0] + acc[ai][bj][m][0], h1 = rv[m][bj][1] + acc[ai][bj][m][1];
                    u32x4 o; o[0] = pack2(h0[0], h0[1]); o[1] = pack2(h0[2], h0[3]); o[2] = pack2(h1[0], h1[1]); o[3] = pack2(h1[2], h1[3]);
                    *(u32x4*)(HB + off) = o;
                    const float a0 = bf_lo(o[0]), a1 = bf_hi(o[0]), a2 = bf_lo(o[1]), a3 = bf_hi(o[1]), a4 = bf_lo(o[2]), a5 = bf_hi(o[2]), a6 = bf_lo(o[3]), a7 = bf_hi(o[3]);
                    ss += (a0 * a0 + a1 * a1) + (a2 * a2 + a3 * a3) + (a4 * a4 + a5 * a5) + (a6 * a6 + a7 * a7);
                }
                ss = xq_sum(ss);
                if (fq == 0) SS[tok * 16 + 4 * u.pn + wc] = ss;
            }
        }
    }
};

struct EpiRowScale8 {
    static constexpr bool PERM = true, AFTER_DRAIN = false;
    bf16_t* out; int ld; const float* SS; float extra;
    DI void operator()(EPI_ARGS) const {
#pragma unroll
        for (int ai = 0; ai < 2; ++ai)
#pragma unroll
            for (int m = 0; m < 4; ++m) {
                int fr_ = fr; asm volatile("" : "+v"(fr_));
                const size_t tok = (size_t)u.pm * 256 + ai * 128 + wr * 64 + m * 16 + fr_;
                const f32x4 s0 = *(const f32x4*)(SS + tok * 16), s1 = *(const f32x4*)(SS + tok * 16 + 4), s2 = *(const f32x4*)(SS + tok * 16 + 8), s3 = *(const f32x4*)(SS + tok * 16 + 12);
                const float tot = (s0[0] + s0[1] + s0[2] + s0[3]) + (s1[0] + s1[1] + s1[2] + s1[3]) + (s2[0] + s2[1] + s2[2] + s2[3]) + (s3[0] + s3[1] + s3[2] + s3[3]);
                const float sc = rsqrtf(tot * (1.0f / 1024.0f) + 1e-6f) * extra;
#pragma unroll
                for (int bj = 0; bj < 2; ++bj) { EPI_LOAD8(v, ai, bj, m); *(u32x4*)(out + tok * ld + u.pn * 256 + bj * 128 + wc * 32 + 8 * fq) = pack8(v, sc); }
            }
    }
};

template <class Epi>
DI void gemm8(char* smem, const bf16_t* A, int lda, const bf16_t* Bt, int M, int N, int K, const Epi& e, int cshift = 0) {
    pg8::Gemm g; g.A = A; g.Bt = Bt; g.M = M; g.N = N; g.K = K; g.lda = lda;
    const int G = (int)gridDim.x;
    pg8::StaticOrder S; S.init(M, N, G, ((int)blockIdx.x + G - cshift) % G);
    pg8::gemm_phase<Epi, pg8::StaticOrder, true, true>((PG8_LAS unsigned char*)smem, g, S, e);
}

DI void quant_rows4(const Params& p, int it, int wv, int lane);
DI void phase_p1(const Params& p, char* smem) {
    char* ws = p.ws;
    const int G = (int)gridDim.x, nproj = 9 * 64, nkvm = 8 * 4;
    const int last = nproj % G;
    { EpiProj8 e{(bf16_t*)(ws + OFF_PROJ), (bf16_t*)(ws + OFF_KR), (const float*)(ws + OFF_ROPE), (float*)(ws + OFF_SSQ)};
      gemm8(smem, (const bf16_t*)(ws + OFF_XN), 1024, (const bf16_t*)(ws + OFF_WT_IN), T_TOK, 2304, 1024, e); }
    { EpiPlain8 e{(bf16_t*)(ws + OFF_KVM), 2048};
      gemm8(smem, (const bf16_t*)(ws + OFF_MEMN), 1024, (const bf16_t*)(ws + OFF_WT_MKV), 1024, 2048, 1024, e, last); }
    int q0 = last + nkvm, nq = G - q0;
    if (last == 0 || nq <= 0) { q0 = 0; nq = G; }
    if ((int)blockIdx.x >= q0) {
        const int t = otid(), lane = t & 63, wv = t >> 6;
        for (int it = ((int)blockIdx.x - q0) * 2 + vhalf(); it < 8192; it += 2 * nq) quant_rows4(p, it, wv, lane);
    }
}
DI void phase_p2(const Params& p, char* smem) {
    char* ws = p.ws;
    { EpiUpQ8 e{(bf16_t*)(ws + OFF_QMLA), (const float*)(ws + OFF_ROPE), (const float*)(ws + OFF_SSQ)};
      gemm8(smem, (const bf16_t*)(ws + OFF_PROJ), INC, (const bf16_t*)(ws + OFF_WT_UQ), T_TOK, 768, 384, e); }
    { EpiUpKV8 e{(bf16_t*)(ws + OFF_KVMLA), (const float*)(ws + OFF_SSQ)};
      gemm8(smem, (const bf16_t*)(ws + OFF_PROJ) + 384, INC, (const bf16_t*)(ws + OFF_WT_UKV), T_TOK, 1024, 256, e); }
}
template <bool RBF16>
DI void phase_resid(const Params& p, char* smem, size_t off_w, size_t off_a, const void* R, size_t off_ss, bool dry = false) {
    char* ws = p.ws;
    EpiResid8<RBF16> e{R, (bf16_t*)(ws + OFF_HB), (float*)(ws + off_ss)};
    if (dry) { e.HB = (bf16_t*)(ws + OFF_B); e.SS = (float*)(ws + OFF_SS1); }
    gemm8(smem, (const bf16_t*)(ws + off_a), 1024, (const bf16_t*)(ws + off_w), T_TOK, 1024, 1024, e);
}
DI void phase_rowscale(const Params& p, char* smem, size_t off_w, int N, bf16_t* outp, size_t off_ss, float extra) {
    char* ws = p.ws;
    EpiRowScale8 e{outp, N, (const float*)(ws + off_ss), extra};
    gemm8(smem, (const bf16_t*)(ws + OFF_HB), 1024, (const bf16_t*)(ws + off_w), T_TOK, N, 1024, e);
}
DI unsigned v128_off(int row, int chunk) { return (unsigned)(row * 128 + ((chunk ^ (((row >> 1) & 1) << 2)) << 4)); }
DI unsigned v128_tr_addr(unsigned base, int R0, int c, int lane) {
    const int blk = (lane >> 4) & 1, qq = (lane & 15) >> 2, pp = lane & 3;
    return base + v128_off(R0 + qq, 4 * c + 2 * blk + (pp >> 1)) + 8 * (pp & 1);
}
DI bf16x8 cat44(s16x4 lo, s16x4 hi) { return __builtin_shufflevector(lo, hi, 0, 1, 2, 3, 4, 5, 6, 7); }

constexpr int MLA_STAGE = 64 * 192 + 64 * 128;
DI unsigned k192_off(int row, int chunk) { return (unsigned)(row * 192 + (((chunk & ~3) | ((chunk & 3) ^ ((row >> 2) & 3))) << 4)); }
DI void mla_unit(const Params& p, char* lds, int b, int h, int qt) {
    char* ws = p.ws;
    const int t = otid(), lane = t & 63, wv = t >> 6, r = lane & 31, hh = lane >> 5;
    const bf16_t* Q = (const bf16_t*)(ws + OFF_QMLA);
    const bf16_t* KV = (const bf16_t*)(ws + OFF_KVMLA);
    const bf16_t* KR = (const bf16_t*)(ws + OFF_KR);
    const int q0 = qt * 128 + 32 * wv;
    const size_t tokq = (size_t)b * SEQ_L + q0 + r;
    const size_t tokb = (size_t)b * SEQ_L;
    bf16x8 qf[6];
#pragma unroll
    for (int s = 0; s < 6; ++s) qf[s] = ld16(Q + tokq * 768 + h * 96 + 16 * s + 8 * hh);
    f32x16 o[2]; o[0] = zero16(); o[1] = zero16();
    float m = -INFINITY, l = 0.f;
    const bf16_t* ksrc[3]; int kadv[3]; const bf16_t* vsrc[2];
#pragma unroll
    for (int i = 0; i < 3; ++i) {
        const int o_ = 1024 * (wv + 4 * i) + 16 * lane, row = o_ / 192, pch = (o_ % 192) >> 4;
        const int c = (pch & ~3) | ((pch & 3) ^ ((row >> 2) & 3));
        if (c < 8) { ksrc[i] = KV + (tokb + row) * 1024 + h * 128 + 8 * c; kadv[i] = 64 * 1024; }
        else       { ksrc[i] = KR + (tokb + row) * 32 + 8 * (c - 8);       kadv[i] = 64 * 32; }
    }
#pragma unroll
    for (int i = 0; i < 2; ++i) {
        const int row = 8 * (wv + 4 * i) + (lane >> 3), pch = lane & 7;
        vsrc[i] = KV + (tokb + row) * 1024 + h * 128 + 64 + 8 * (pch ^ (((row >> 1) & 1) << 2));
    }
    char* ldst = lds + wv * 1024 + lane * 16;
    auto issue = [&](int kt) {
        char* d = ldst + (kt % 3) * MLA_STAGE;
#pragma unroll
        for (int i = 0; i < 3; ++i) GLDS16(ksrc[i] + (size_t)kt * kadv[i], d + i * 4096);
#pragma unroll
        for (int i = 0; i < 2; ++i) GLDS16(vsrc[i] + (size_t)kt * (64 * 1024), d + 12288 + i * 4096);
    };
    const int ntiles = 2 * qt + 2;
    __syncthreads();
    issue(0); issue(1);
#pragma unroll
    for (int s = 0; s < 6; ++s) asm volatile("" :: "v"(qf[s]));
#pragma unroll 1
    for (int kt = 0; kt < ntiles; ++kt) {
        if (kt + 1 < ntiles) asm volatile("s_waitcnt vmcnt(5)\n\ts_barrier" ::: "memory");
        else asm volatile("s_waitcnt vmcnt(0)\n\ts_barrier" ::: "memory");
        if (kt + 2 < ntiles) issue(kt + 2);
        const char* sb = lds + (kt % 3) * MLA_STAGE;
        const unsigned vb = (unsigned)(uintptr_t)(sb + 12288);
        f32x16 s[2];
#pragma unroll
        for (int k2 = 0; k2 < 2; ++k2) {
            s[k2] = zero16();
#pragma unroll
            for (int ss = 0; ss < 6; ++ss) s[k2] = MFMA32(ld16(sb + k192_off(32 * k2 + r, 2 * ss + hh)), qf[ss], s[k2]);
        }
        s16x4 vt[2][2][2][2];
#pragma unroll
        for (int k2 = 0; k2 < 2; ++k2)
#pragma unroll
            for (int st = 0; st < 2; ++st)
#pragma unroll
                for (int c = 0; c < 2; ++c) {
                    vt[k2][st][c][0] = tr_read_a(v128_tr_addr(vb, 32 * k2 + 16 * st + 4 * hh, c, lane));
                    vt[k2][st][c][1] = tr_read_a(v128_tr_addr(vb, 32 * k2 + 16 * st + 8 + 4 * hh, c, lane));
                }
        if (__builtin_amdgcn_readfirstlane(kt >= 2 * qt)) {
            asm volatile("");
            const int qpos = q0 + r;
#pragma unroll
            for (int k2 = 0; k2 < 2; ++k2)
#pragma unroll
                for (int i = 0; i < 16; ++i) { const int kpos = 64 * kt + 32 * k2 + crow(i, hh); if (kpos > qpos) s[k2][i] = -INFINITY; }
        }
        float mx = s[0][0];
#pragma unroll
        for (int k2 = 0; k2 < 2; ++k2)
#pragma unroll
            for (int i = 0; i < 16; ++i) mx = fmaxf(mx, s[k2][i]);
        mx = xhalf_max(mx);
        if (__any(mx > m + 8.0f)) {
            asm volatile("");
            const float mn = fmaxf(m, mx);
            const float alpha = fast_exp2(m - mn);
            l *= alpha;
            m = mn;
#pragma unroll
            for (int c = 0; c < 2; ++c)
#pragma unroll
                for (int i = 0; i < 16; ++i) o[c][i] *= alpha;
        }
        f32x2 ps2 = {0.f, 0.f};
        const f32x2 m2 = {m, m};
#pragma unroll
        for (int k2 = 0; k2 < 2; ++k2)
#pragma unroll
            for (int i = 0; i < 16; i += 2) {
                f32x2 x = {s[k2][i], s[k2][i + 1]};
                x = x - m2;
                f32x2 e; e[0] = fast_exp2(x[0]); e[1] = fast_exp2(x[1]);
                s[k2][i] = e[0]; s[k2][i + 1] = e[1];
                ps2 += e;
            }
        l += ps2[0] + ps2[1];
        TR_WAIT();
#pragma unroll
        for (int k2 = 0; k2 < 2; ++k2)
#pragma unroll
            for (int st = 0; st < 2; ++st) {
                const bf16x8 pb = pack_step(s[k2], st);
#pragma unroll
                for (int c = 0; c < 2; ++c) o[c] = MFMA32(cat44(vt[k2][st][c][0], vt[k2][st][c][1]), pb, o[c]);
            }
    }
    const float inv = 1.0f / xhalf_sum(l);
    bf16_t* dst = (bf16_t*)((char*)p.out + OUT_OMLA) + tokq * 512 + h * 64 + 4 * hh;
#pragma unroll
    for (int c = 0; c < 2; ++c)
#pragma unroll
        for (int g = 0; g < 4; ++g)
            *(u32x2*)(dst + 32 * c + 8 * g) = pack4(o[c][4 * g] * inv, o[c][4 * g + 1] * inv, o[c][4 * g + 2] * inv, o[c][4 * g + 3] * inv);
}

DI void dil_unit(const Params& p, char* lds, int g, int b, int h, int rr, int lb) {
    char* ws = p.ws;
    const int t = otid(), lane = t & 63, wv = t >> 6, r = lane & 31, hh = lane >> 5;
    const int d = (g == 0) ? 1 : (g == 1 ? 4 : 16);
    const bf16_t* PJ = (const bf16_t*)(ws + OFF_PROJ);
    const size_t tokb = (size_t)b * SEQ_L;
    char* kimg = lds;
    char* vimg = lds + 32768;
    __syncthreads();
    {
        const int c = t & 7;
#pragma unroll
        for (int half = 0; half < 2; ++half) {
            u32x4 kk[4], vv[4];
#pragma unroll
            for (int i = 0; i < 4; ++i) {
                const int key = (t >> 3) + 32 * (4 * half + i);
                const int lk = 128 * lb - 128 + key;
                if (lk >= 0) {
                    const size_t tk = tokb + (size_t)lk * d + rr;
                    kk[i] = ldu4(PJ + tk * INC + 1184 + h * 64 + 8 * c);
                    vv[i] = ldu4(PJ + tk * INC + 1696 + h * 64 + 8 * c);
                } else { kk[i] = (u32x4){0u, 0u, 0u, 0u}; vv[i] = (u32x4){0u, 0u, 0u, 0u}; }
            }
#pragma unroll
            for (int i = 0; i < 4; ++i) {
                const int key = (t >> 3) + 32 * (4 * half + i);
                *(u32x4*)(kimg + sw_off(key, c)) = kk[i];
                *(u32x4*)(vimg + v128_off(key, c)) = vv[i];
            }
        }
    }
    const int lq = 128 * lb + 32 * wv + r;
    const size_t tokq = tokb + (size_t)lq * d + rr;
    bf16x8 qf[4];
#pragma unroll
    for (int s = 0; s < 4; ++s) qf[s] = ld16(PJ + tokq * INC + 672 + h * 64 + 16 * s + 8 * hh);
    __syncthreads();
    const float slope2 = exp2f(-(float)(h + 1)) * (float)d * LOG2E;
    const int u0 = (lb == 0) ? (4 - wv) : 0;
    f32x16 o[2]; o[0] = zero16(); o[1] = zero16();
    float m = -INFINITY, lsum = 0.f;
    const unsigned vb = (unsigned)(uintptr_t)vimg;
    float cb[16];
#pragma unroll
    for (int i = 0; i < 16; ++i) cb[i] = slope2 * (float)crow(i, hh);
#pragma unroll 1
    for (int u = u0; u < 5; ++u) {
        const int rowb = 32 * (wv + u);
        f32x16 s = zero16();
#pragma unroll
        for (int ss = 0; ss < 4; ++ss) s = MFMA32(ld16(kimg + sw_off(rowb + r, 2 * ss + hh)), qf[ss], s);
        const int dbase = r + 128 - 32 * u;
        const float b0 = -slope2 * (float)dbase;
#pragma unroll
        for (int i = 0; i < 16; ++i) s[i] += cb[i];
        if (__builtin_amdgcn_readfirstlane(u == 0 || u == 4)) {
            asm volatile("");
#pragma unroll
            for (int i = 0; i < 16; ++i) { const int dist = dbase - crow(i, hh); if (dist < 0 || dist > 128) s[i] = -INFINITY; }
        }
        float mx = s[0];
#pragma unroll
        for (int i = 1; i < 16; ++i) mx = fmaxf(mx, s[i]);
        mx = xhalf_max(mx) + b0;
        if (__any(mx > m + 8.0f)) {
            asm volatile("");
            const float mn = fmaxf(m, mx);
            const float alpha = fast_exp2(m - mn);
            lsum *= alpha;
            m = mn;
#pragma unroll
            for (int c = 0; c < 2; ++c)
#pragma unroll
                for (int i = 0; i < 16; ++i) o[c][i] *= alpha;
        }
        f32x2 ps2 = {0.f, 0.f};
        const float mb = m - b0;
        const f32x2 m2 = {mb, mb};
#pragma unroll
        for (int i = 0; i < 16; i += 2) {
            f32x2 xx = {s[i], s[i + 1]};
            xx = xx - m2;
            f32x2 e; e[0] = fast_exp2(xx[0]); e[1] = fast_exp2(xx[1]);
            s[i] = e[0]; s[i + 1] = e[1];
            ps2 += e;
        }
        lsum += ps2[0] + ps2[1];
#pragma unroll
        for (int st = 0; st < 2; ++st) {
            const bf16x8 pb = pack_step(s, st);
#pragma unroll
            for (int c = 0; c < 2; ++c) {
                const s16x4 lo = tr_read(v128_tr_addr(vb, rowb + 16 * st + 4 * hh, c, lane));
                const s16x4 hi = tr_read(v128_tr_addr(vb, rowb + 16 * st + 8 + 4 * hh, c, lane));
                o[c] = MFMA32(cat44(lo, hi), pb, o[c]);
            }
        }
    }
    const float ltot = xhalf_sum(lsum);
    const float mx = m;
    const float inv = 1.0f / ltot;
    bf16_t* dst = (bf16_t*)((char*)p.out + OUT_ODIL) + ((size_t)g * T_TOK + tokq) * 512 + h * 64 + 4 * hh;
#pragma unroll
    for (int c = 0; c < 2; ++c)
#pragma unroll
        for (int gg = 0; gg < 4; ++gg)
            *(u32x2*)(dst + 32 * c + 8 * gg) = pack4(o[c][4 * gg] * inv, o[c][4 * gg + 1] * inv, o[c][4 * gg + 2] * inv, o[c][4 * gg + 3] * inv);
    if (hh == 0) ((float*)(ws + OFF_LSE))[((size_t)g * T_TOK + tokq) * 8 + h] = mx + __log2f(ltot);
}

DI void phase_p3(const Params& p, char* lds, int which = 3) {
    const int xg = (int)blockIdx.x & 7, nloc = (vgrid() >> 3), loc = ((int)blockIdx.x >> 3) * 2 + vhalf();
    if (which & 1) for (int i = loc; i < 64; i += nloc) {
        const int bh = xg * 4 + (i >> 4), pr = i & 15, b = bh >> 3, h = bh & 7;
#pragma unroll 1
        for (int rep = 0; rep < 2; ++rep) mla_unit(p, lds, b, h, rep ? pr : 31 - pr);
    }
    if (which & 2) for (int i = loc; i < 384; i += nloc) {
        const int bh = xg * 4 + i / 96, k96 = i % 96, g = k96 >> 5, k = k96 & 31, b = bh >> 3, h = bh & 7;
        int rr, lb;
        if (g == 0) { rr = 0; lb = k; } else if (g == 1) { rr = k >> 3; lb = k & 7; } else { rr = k >> 1; lb = k & 1; }
        dil_unit(p, lds, g, b, h, rr, lb);
    }
}

DI void quant_rows4(const Params& p, int it, int wv, int lane) {
    char* ws = p.ws;
    const int ncv = 4096;
    const bool isv = it >= ncv;
    const size_t row = (size_t)(isv ? it - ncv : it) * 4 + wv;
    const float* src = (isv ? p.peer_v : p.peer_u) + row * 1024 + 16 * lane;
    f32x4 v[4]; float am = 0.f;
#pragma unroll
    for (int i = 0; i < 4; ++i) { v[i] = *(const f32x4*)(src + 4 * i); am = fmaxf(am, fmaxf(fmaxf(fabsf(v[i][0]), fabsf(v[i][1])), fmaxf(fabsf(v[i][2]), fabsf(v[i][3])))); }
#pragma unroll
    for (int o = 32; o; o >>= 1) am = fmaxf(am, __shfl_xor(am, o));
    const float sc = (am > 0.f) ? am * (isv ? (1.0f / 384.0f) : (1.0f / 127.0f)) : 1.0f;
    const float inv = 1.0f / sc;
    u32x4 o;
#pragma unroll
    for (int i = 0; i < 4; ++i) {
        if (isv) {
            int w = 0;
            w = __builtin_amdgcn_cvt_pk_fp8_f32(v[i][0] * inv, v[i][1] * inv, w, false);
            w = __builtin_amdgcn_cvt_pk_fp8_f32(v[i][2] * inv, v[i][3] * inv, w, true);
            o[i] = (unsigned)w;
        } else {
            unsigned w = 0u;
#pragma unroll
            for (int e = 0; e < 4; ++e) { const int q = (int)rintf(v[i][e] * inv); w |= ((unsigned)q & 0xFFu) << (8 * e); }
            o[i] = w;
        }
    }
    *(u32x4*)(ws + (isv ? OFF_VQ : OFF_UQ) + row * 1024 + 16 * lane) = o;
    if (lane == 0) ((float*)(ws + (isv ? OFF_SV : OFF_SU)))[row] = sc;
}

DI void phase_p35(const Params& p, char* lds) {
    char* ws = p.ws;
    const int t = otid(), lane = t & 63, wv = t >> 6;
    const int ntok = T_TOK / 4;
    for (int item = vbid(); item < ntok; item += vgrid()) {
        {
            const size_t tok = (size_t)item * 4 + wv;
            const int head = lane >> 3;
            const float* LS = (const float*)(ws + OFF_LSE);
            const float l0 = LS[tok * 8 + head], l1 = LS[((size_t)T_TOK + tok) * 8 + head], l2 = LS[((size_t)2 * T_TOK + tok) * 8 + head];
            const float mx = fmaxf(l0, fmaxf(l1, l2));
            float w0 = fast_exp2(l0 - mx), w1 = fast_exp2(l1 - mx), w2 = fast_exp2(l2 - mx);
            const float wi = 1.0f / (w0 + w1 + w2);
            w0 *= wi; w1 *= wi; w2 *= wi;
            const bf16_t* OD = (const bf16_t*)((const char*)p.out + OUT_ODIL);
            const u32x4 a0 = ldu4(OD + tok * 512 + 8 * lane), a1 = ldu4(OD + ((size_t)T_TOK + tok) * 512 + 8 * lane),
                        a2 = ldu4(OD + ((size_t)2 * T_TOK + tok) * 512 + 8 * lane);
            const u32x4 am = ldu4((const bf16_t*)((const char*)p.out + OUT_OMLA) + tok * 512 + 8 * lane);
            float od[8], om[8]; float sd = 0.f, sm = 0.f;
#pragma unroll
            for (int e = 0; e < 4; ++e) {
                od[2 * e] = w0 * bf_lo(a0[e]) + w1 * bf_lo(a1[e]) + w2 * bf_lo(a2[e]);
                od[2 * e + 1] = w0 * bf_hi(a0[e]) + w1 * bf_hi(a1[e]) + w2 * bf_hi(a2[e]);
                om[2 * e] = bf_lo(am[e]); om[2 * e + 1] = bf_hi(am[e]);
                sd += od[2 * e] * od[2 * e] + od[2 * e + 1] * od[2 * e + 1];
                sm += om[2 * e] * om[2 * e] + om[2 * e + 1] * om[2 * e + 1];
            }
#pragma unroll
            for (int o = 32; o; o >>= 1) { sd += __shfl_xor(sd, o); sm += __shfl_xor(sm, o); }
            const float rd = rsqrtf(sd * (1.0f / 512.0f) + 1e-6f), rm = rsqrtf(sm * (1.0f / 512.0f) + 1e-6f);
            const f32x4 gm0 = *(const f32x4*)(p.gn_mla + 8 * lane), gm1 = *(const f32x4*)(p.gn_mla + 8 * lane + 4);
            const f32x4 gd0 = *(const f32x4*)(p.gn_dil + 8 * lane), gd1 = *(const f32x4*)(p.gn_dil + 8 * lane + 4);
            u32x4 o1, o2;
            o1[0] = pack2(om[0] * rm * gm0[0], om[1] * rm * gm0[1]); o1[1] = pack2(om[2] * rm * gm0[2], om[3] * rm * gm0[3]);
            o1[2] = pack2(om[4] * rm * gm1[0], om[5] * rm * gm1[1]); o1[3] = pack2(om[6] * rm * gm1[2], om[7] * rm * gm1[3]);
            o2[0] = pack2(od[0] * rd * gd0[0], od[1] * rd * gd0[1]); o2[1] = pack2(od[2] * rd * gd0[2], od[3] * rd * gd0[3]);
            o2[2] = pack2(od[4] * rd * gd1[0], od[5] * rd * gd1[1]); o2[3] = pack2(od[6] * rd * gd1[2], od[7] * rd * gd1[3]);
            bf16_t* MX = (bf16_t*)(ws + OFF_MIXED) + tok * 1024;
            *(u32x4*)(MX + 8 * lane) = o1;
            *(u32x4*)(MX + 512 + 8 * lane) = o2;
        }
    }
}

DI unsigned m512_off(int row, int chunk) { return (unsigned)(row * 512 + ((chunk ^ (row & 15)) << 4)); }
DI unsigned v512_off(int row, int chunk) { return (unsigned)(row * 512 + ((chunk ^ ((row & 3) << 2)) << 4)); }
DI void memattn_unit(const Params& p, char* lds, int b, int h, int tt) {
    char* ws = p.ws;
    const int t = otid(), lane = t & 63, wv = t >> 6, r = lane & 31, hh = lane >> 5;
    const int qg = wv & 1, dh = wv >> 1;
    const bf16_t* QM = (const bf16_t*)(ws + OFF_QM);
    const bf16_t* KVM = (const bf16_t*)(ws + OFF_KVM);
    const size_t tokq = (size_t)b * SEQ_L + tt * 64 + 32 * qg + r;
    bf16x8 qf[16];
#pragma unroll
    for (int s = 0; s < 16; ++s) qf[s] = ld16(QM + tokq * 1024 + h * 256 + 16 * s + 8 * hh);
    f32x16 o[4];
#pragma unroll
    for (int c = 0; c < 4; ++c) o[c] = zero16();
    float m = -INFINITY, l = 0.f;
    const bf16_t* ksrc[4]; const bf16_t* vsrc[4];
#pragma unroll
    for (int i = 0; i < 4; ++i) {
        const int row = 2 * (wv + 4 * i) + (lane >> 5), pch = lane & 31;
        const size_t mrow = (size_t)b * 256 + row;
        ksrc[i] = KVM + mrow * 2048 + h * 256 + 8 * (pch ^ (row & 15));
        vsrc[i] = KVM + mrow * 2048 + 1024 + h * 256 + 8 * (pch ^ ((row & 3) << 2));
    }
    char* ldst = lds + wv * 1024 + lane * 16;
    auto stage_tile = [&](int kt, char* sb) {
#pragma unroll
        for (int i = 0; i < 4; ++i) { GLDS16(ksrc[i] + (size_t)kt * 32 * 2048, sb + i * 4096); GLDS16(vsrc[i] + (size_t)kt * 32 * 2048, sb + 16384 + i * 4096); }
    };
    __syncthreads();
    stage_tile(0, ldst);
    __syncthreads();
#pragma unroll 1
    for (int kt = 0; kt < 8; ++kt) {
        if (kt + 1 < 8) stage_tile(kt + 1, ldst + ((kt + 1) & 1) * 32768);
        const char* sb = lds + (kt & 1) * 32768;
        const unsigned vb = (unsigned)(uintptr_t)(sb + 16384);
        f32x16 s = zero16();
#pragma unroll
        for (int ss = 0; ss < 16; ++ss) s = MFMA32(ld16(sb + m512_off(r, 2 * ss + hh)), qf[ss], s);
        float mx = s[0];
#pragma unroll
        for (int i = 1; i < 16; ++i) mx = fmaxf(mx, s[i]);
        mx = xhalf_max(mx);
        const float mn = fmaxf(m, mx);
        const float alpha = fast_exp2(m - mn);
        float ps = 0.f;
#pragma unroll
        for (int i = 0; i < 16; ++i) { const float e = fast_exp2(s[i] - mn); s[i] = e; ps += e; }
        l = l * alpha + ps;
        m = mn;
#pragma unroll
        for (int c = 0; c < 4; ++c)
#pragma unroll
            for (int i = 0; i < 16; ++i) o[c][i] *= alpha;
        const int blk = (lane >> 4) & 1, qq = (lane & 15) >> 2, pp = lane & 3;
#pragma unroll
        for (int st = 0; st < 2; ++st) {
            const bf16x8 pb = pack_step(s, st);
#pragma unroll
            for (int c = 0; c < 4; ++c) {
                const int ch = 16 * dh + 4 * c + 2 * blk + (pp >> 1);
                const s16x4 lo = tr_read(vb + v512_off(16 * st + 4 * hh + qq, ch) + 8 * (pp & 1));
                const s16x4 hi = tr_read(vb + v512_off(16 * st + 8 + 4 * hh + qq, ch) + 8 * (pp & 1));
                o[c] = MFMA32(cat44(lo, hi), pb, o[c]);
            }
        }
        __syncthreads();
    }
    const float inv = 1.0f / xhalf_sum(l);
    bf16_t* dst = (bf16_t*)(ws + OFF_OM) + tokq * 1024 + h * 256 + 128 * dh + 4 * hh;
#pragma unroll
    for (int c = 0; c < 4; ++c)
#pragma unroll
        for (int g = 0; g < 4; ++g)
            *(u32x2*)(dst + 32 * c + 8 * g) = pack4(o[c][4 * g] * inv, o[c][4 * g + 1] * inv, o[c][4 * g + 2] * inv, o[c][4 * g + 3] * inv);
}

DI void phase_memattn(const Params& p, char* lds) {
    for (int item = vbid(); item < 1024; item += vgrid()) {
        const int b = item >> 8, h = (item >> 6) & 3, tt = item & 63;
        memattn_unit(p, lds, b, h, tt);
    }
}
DI unsigned f2sort(float f) { const unsigned b = __float_as_uint(f); return b ^ ((b & 0x80000000u) ? 0xFFFFFFFFu : 0x80000000u); }
DI float sort2f(unsigned u) { const unsigned b = (u & 0x80000000u) ? (u ^ 0x80000000u) : ~u; return __uint_as_float(b); }
DI void cswap(unsigned& a, unsigned& b) { const unsigned hi = max(a, b), lo = min(a, b); a = hi; b = lo; }

template <int LO, int N> struct BClean {
    template <int M> static DI void run(unsigned (&a)[M]) {
#pragma unroll
        for (int i = 0; i < N / 2; ++i) cswap(a[LO + i], a[LO + i + N / 2]);
        BClean<LO, N / 2>::run(a); BClean<LO + N / 2, N / 2>::run(a);
    }
};
template <int LO> struct BClean<LO, 1> { template <int M> static DI void run(unsigned (&)[M]) {} };
template <int LO, int N> struct BSort {
    template <int M> static DI void run(unsigned (&a)[M]) {
        BSort<LO, N / 2>::run(a); BSort<LO + N / 2, N / 2>::run(a);
#pragma unroll
        for (int i = 0; i < N / 2; ++i) cswap(a[LO + i], a[LO + N - 1 - i]);
        BClean<LO, N / 2>::run(a); BClean<LO + N / 2, N / 2>::run(a);
    }
};
template <int LO> struct BSort<LO, 1> { template <int M> static DI void run(unsigned (&)[M]) {} };
DI void merge_top16(unsigned (&a)[16], const unsigned (&b)[16]) {
#pragma unroll
    for (int i = 0; i < 16; ++i) a[i] = max(a[i], b[15 - i]);
    BClean<0, 16>::run(a);
}

DI void peer_top16(const bf16_t* __restrict__ keys_hp, const bf16_t* __restrict__ pq_row_hp, int r, int hh, unsigned (&top)[16]) {
    bf16x8 qf[8];
#pragma unroll
    for (int s = 0; s < 8; ++s) qf[s] = ld16(pq_row_hp + 16 * s + 8 * hh);
    unsigned cur[16];
#pragma unroll
    for (int kt = 0; kt < 4; ++kt) {
        f32x16 acc = zero16();
#pragma unroll
        for (int s = 0; s < 8; ++s) acc = MFMA32(ld16(keys_hp + (size_t)(32 * kt + r) * 128 + 16 * s + 8 * hh), qf[s], acc);
        unsigned k[16];
#pragma unroll
        for (int i = 0; i < 16; ++i) k[i] = (f2sort(acc[i]) & ~0x7Fu) | (unsigned)(32 * kt + crow(i, hh));
        BSort<0, 16>::run(k);
        if (kt == 0) {
#pragma unroll
            for (int i = 0; i < 16; ++i) cur[i] = k[i];
        } else merge_top16(cur, k);
    }
    unsigned r0[16], r1[16];
#pragma unroll
    for (int i = 0; i < 16; ++i) { auto rr = __builtin_amdgcn_permlane32_swap(cur[i], cur[i], false, false); r0[i] = rr[0]; r1[i] = rr[1]; }
#pragma unroll
    for (int i = 0; i < 16; ++i) top[i] = max(r0[i], r1[15 - i]);
    BClean<0, 16>::run(top);
}

DI void peer_select_unit(const Params& p, char* lds, int mt, int h) {
    char* ws = p.ws;
    const int t = otid(), lane = t & 63, wv = t >> 6, r = lane & 31, hh = lane >> 5;
    const size_t tok = (size_t)mt * 128 + 32 * wv + r;
    const bf16_t* KEYS = (const bf16_t*)(ws + OFF_KEYS);
    const bf16_t* PQ = (const bf16_t*)((const char*)p.out + OUT_PQ);
    unsigned tA[16], tB[16];
    peer_top16(KEYS + (size_t)(2 * h) * 16384, PQ + tok * 2048 + (2 * h) * 128, r, hh, tA);
    peer_top16(KEYS + (size_t)(2 * h + 1) * 16384, PQ + tok * 2048 + (2 * h + 1) * 128, r, hh, tB);
    float fA[16], fB[16];
#pragma unroll
    for (int i = 0; i < 16; ++i) { fA[i] = sort2f(tA[i] & ~0x7Fu); fB[i] = sort2f(tB[i] & ~0x7Fu); }
    unsigned* tab = (unsigned*)lds + wv * 1024;
    __syncthreads();
#pragma unroll
    for (int i = 0; i < 16; ++i) tab[i * 64 + lane] = (tA[i] & 0x7Fu) | ((tB[i] & 0x7Fu) << 16);
    unsigned c[64];
#pragma unroll
    for (int i = 0; i < 64; ++i) c[i] = 0u;
    {
        int n = 0;
#pragma unroll
        for (int a = 0; a < 16; ++a)
#pragma unroll
            for (int b = 0; b < 16; ++b)
                if ((a + 1) * (b + 1) <= 16) { c[n] = (f2sort(fA[a] + fB[b]) & ~0xFFu) | (unsigned)(a * 16 + b); ++n; }
    }
    unsigned g0[16], g1[16], g2[16], g3[16];
#pragma unroll
    for (int i = 0; i < 16; ++i) { g0[i] = c[i]; g1[i] = c[16 + i]; g2[i] = c[32 + i]; g3[i] = c[48 + i]; }
    BSort<0, 16>::run(g0); BSort<0, 16>::run(g1); BSort<0, 16>::run(g2); BSort<0, 16>::run(g3);
    merge_top16(g0, g1); merge_top16(g2, g3); merge_top16(g0, g2);
    float e[16]; float sum = 0.f;
    const float v0 = sort2f(g0[0] & ~0xFFu);
    unsigned ids[16];
#pragma unroll
    for (int i = 0; i < 16; ++i) {
        const float v = sort2f(g0[i] & ~0xFFu);
        e[i] = fast_exp2((v - v0) * LOG2E); sum += e[i];
        const unsigned a = (g0[i] >> 4) & 15u, b = g0[i] & 15u;
        const unsigned ia = tab[a * 64 + lane] & 0x7Fu, ib = (tab[b * 64 + lane] >> 16) & 0x7Fu;
        ids[i] = ia * 128u + ib;
    }
    const float inv = 1.0f / sum;
    if (hh == 0) {
        unsigned short* SID = (unsigned short*)(ws + OFF_SELID) + tok * 128 + h * 16;
        float* SG = (float*)(ws + OFF_SELG) + tok * 128 + h * 16;
        u32x4 w0, w1;
        w0[0] = ids[0] | (ids[1] << 16); w0[1] = ids[2] | (ids[3] << 16); w0[2] = ids[4] | (ids[5] << 16); w0[3] = ids[6] | (ids[7] << 16);
        w1[0] = ids[8] | (ids[9] << 16); w1[1] = ids[10] | (ids[11] << 16); w1[2] = ids[12] | (ids[13] << 16); w1[3] = ids[14] | (ids[15] << 16);
        *(u32x4*)SID = w0; *(u32x4*)(SID + 8) = w1;
#pragma unroll
        for (int q = 0; q < 4; ++q) *(f32x4*)(SG + 4 * q) = (f32x4){e[4 * q] * inv, e[4 * q + 1] * inv, e[4 * q + 2] * inv, e[4 * q + 3] * inv};
    }
}

DI void phase_select(const Params& p, char* lds) {
    for (int item = vbid(); item < 1024; item += vgrid()) peer_select_unit(p, lds, item >> 3, item & 7);
}

DI float gelu_erf(float v) {
    const float av = fabsf(v), t = __builtin_amdgcn_rcpf(av * 0.2316418882f + 1.0f);
    float q = t * 0.5307027145f + (-0.7265760135f); q = q * t + 0.7107068705f; q = q * t + (-0.142248368f); q = q * t + 0.127414796f; q = q * t;
    const float e = __builtin_amdgcn_exp2f((v * v) * (-0.72134752044f));
    const float m = v * (q * e), r = v - m;
    return v < 0.f ? m : r;
}
DI int dppi(int v, const int ctrl) { return v; }
#define DPP_I(v, ctrl) __builtin_amdgcn_update_dpp(0, (v), (ctrl), 0xf, 0xf, true)
DI float ub0(unsigned w) { return (float)(w & 0xFFu); }
DI float ub1(unsigned w) { return (float)((w >> 8) & 0xFFu); }
DI float ub2(unsigned w) { return (float)((w >> 16) & 0xFFu); }
DI float ub3(unsigned w) { return (float)(w >> 24); }

struct GBatch { u32x4 U[4], V[4]; float su[4], sv[4], gate[4]; };

DI void gather_load(GBatch& B, const char* __restrict__ ws, unsigned idpair, f32x2 gpair, int eb, int lane) {
#pragma unroll
    for (int j = 0; j < 4; ++j) {
        const int e = eb + j;
        const unsigned pr = __shfl(idpair, e >> 1);
        const unsigned id = (j & 1) ? (pr >> 16) : (pr & 0xFFFFu);
        const float g0 = __shfl(gpair[0], e >> 1), g1 = __shfl(gpair[1], e >> 1);
        B.gate[j] = (j & 1) ? g1 : g0;
        B.U[j] = ldu4(ws + OFF_UQ + (size_t)id * 1024 + 16 * lane);
        B.V[j] = ldu4(ws + OFF_VQ + (size_t)id * 1024 + 16 * lane);
        B.su[j] = ((const float*)(ws + OFF_SU))[id];
        B.sv[j] = ((const float*)(ws + OFF_SV))[id];
    }
}

DI void gather_compute(const GBatch& B, const unsigned (&qx)[4], float sx, float (&acc)[16], float& csum, int lane) {
    int pd[4];
#pragma unroll
    for (int j = 0; j < 4; ++j) {
        int d = 0;
#pragma unroll
        for (int q = 0; q < 4; ++q) d = __builtin_amdgcn_sdot4((int)B.U[j][q], (int)qx[q], d, false);
        pd[j] = d;
    }
    const bool b0 = lane & 1, b1 = lane & 2;
    const int kA = b0 ? pd[1] : pd[0], kB = b0 ? pd[3] : pd[2], sA = b0 ? pd[0] : pd[1], sB = b0 ? pd[2] : pd[3];
    const int qA = kA + DPP_I(sA, 0xB1), qB = kB + DPP_I(sB, 0xB1);
    const int kp = b1 ? qB : qA, sd = b1 ? qA : qB;
    int tot = kp + DPP_I(sd, 0x4E);
    tot += DPP_I(tot, 0x124);
    tot += DPP_I(tot, 0x128);
    tot += __builtin_amdgcn_ds_swizzle(tot, 0x401F);
    { auto rr = __builtin_amdgcn_permlane32_swap((unsigned)tot, (unsigned)tot, false, false); tot = (int)rr[0] + (int)rr[1]; }
    const int j3 = lane & 3;
    const float su_sel = (j3 == 0) ? B.su[0] : (j3 == 1 ? B.su[1] : (j3 == 2 ? B.su[2] : B.su[3]));
    const float ge = gelu_erf((float)tot * sx * su_sel);
#pragma unroll
    for (int j = 0; j < 4; ++j) {
        const float cf = B.gate[j] * B.sv[j] * __uint_as_float((unsigned)__builtin_amdgcn_readlane((int)__float_as_uint(ge), j));
#pragma unroll
        for (int q = 0; q < 4; ++q) {
            const int w = (int)B.V[j][q];
            const f32x2 lo = __builtin_amdgcn_cvt_pk_f32_fp8(w, false), hi = __builtin_amdgcn_cvt_pk_f32_fp8(w, true);
            acc[4 * q] += cf * lo[0]; acc[4 * q + 1] += cf * lo[1]; acc[4 * q + 2] += cf * hi[0]; acc[4 * q + 3] += cf * hi[1];
        }
    }
}

DI void gather_token(const Params& p, size_t tok, int lane, float* dst_base) {
    char* ws = p.ws;
    const bf16_t* hrow = (const bf16_t*)(ws + OFF_HB) + tok * 1024 + 16 * lane;
    float hv[16];
    {
        const u32x4 w0 = ldu4(hrow), w1 = ldu4(hrow + 8);
#pragma unroll
        for (int e = 0; e < 4; ++e) { hv[2 * e] = bf_lo(w0[e]); hv[2 * e + 1] = bf_hi(w0[e]); hv[8 + 2 * e] = bf_lo(w1[e]); hv[8 + 2 * e + 1] = bf_hi(w1[e]); }
    }
    float rs;
    {
        const float* SS = (const float*)(ws + OFF_SS2) + tok * 16;
        const f32x4 s0 = *(const f32x4*)SS, s1 = *(const f32x4*)(SS + 4), s2 = *(const f32x4*)(SS + 8), s3 = *(const f32x4*)(SS + 12);
        const float tot = (s0[0] + s0[1] + s0[2] + s0[3]) + (s1[0] + s1[1] + s1[2] + s1[3]) + (s2[0] + s2[1] + s2[2] + s2[3]) + (s3[0] + s3[1] + s3[2] + s3[3]);
        rs = rsqrtf(tot * (1.0f / 1024.0f) + 1e-6f);
    }
    float xf[16]; float am = 0.f;
#pragma unroll
    for (int i = 0; i < 4; ++i) {
        const f32x4 g = *(const f32x4*)(p.norm_ffn + 16 * lane + 4 * i);
#pragma unroll
        for (int e = 0; e < 4; ++e) { xf[4 * i + e] = hv[4 * i + e] * rs * g[e]; am = fmaxf(am, fabsf(xf[4 * i + e])); }
    }
#pragma unroll
    for (int o = 32; o; o >>= 1) am = fmaxf(am, __shfl_xor(am, o));
    const float sx = (am > 0.f) ? am * (1.0f / 127.0f) : 1.0f;
    const float isx = 1.0f / sx;
    unsigned qx[4];
#pragma unroll
    for (int i = 0; i < 4; ++i) {
        unsigned w = 0u;
#pragma unroll
        for (int e = 0; e < 4; ++e) w |= ((unsigned)(int)rintf(xf[4 * i + e] * isx) & 0xFFu) << (8 * e);
        qx[i] = w;
    }
    const unsigned idpair = *((const unsigned*)(ws + OFF_SELID) + tok * 64 + lane);
    const f32x2 gpair = *((const f32x2*)(ws + OFF_SELG) + tok * 64 + lane);
    float acc[16]; float csum = 0.f;
#pragma unroll
    for (int i = 0; i < 16; ++i) acc[i] = 0.f;
    GBatch B0, B1;
    gather_load(B0, ws, idpair, gpair, 0, lane);
#pragma unroll 1
    for (int eb = 0; eb < 128; eb += 8) {
        gather_load(B1, ws, idpair, gpair, eb + 4, lane);
        gather_compute(B0, qx, sx, acc, csum, lane);
        if (eb + 8 < 128) gather_load(B0, ws, idpair, gpair, eb + 8, lane);
        gather_compute(B1, qx, sx, acc, csum, lane);
    }
    float ss = 0.f;
#pragma unroll
    for (int i = 0; i < 16; ++i) { acc[i] = acc[i] - 128.0f * csum + hv[i]; ss += acc[i] * acc[i]; }
#pragma unroll
    for (int o = 32; o; o >>= 1) ss += __shfl_xor(ss, o);
    const float rf = rsqrtf(ss * (1.0f / 1024.0f) + 1e-6f);
    float* drow = dst_base + tok * 1024 + 16 * lane;
#pragma unroll
    for (int i = 0; i < 4; ++i) {
        const f32x4 n = *(const f32x4*)(p.norm_final + 16 * lane + 4 * i);
        *(f32x4*)(drow + 4 * i) = (f32x4){acc[4 * i] * rf * n[0], acc[4 * i + 1] * rf * n[1], acc[4 * i + 2] * rf * n[2], acc[4 * i + 3] * rf * n[3]};
    }
}

DI void phase_gather(const Params& p, bool dry = false) {
    const int lane = otid() & 63, wv = otid() >> 6;
    float* dst = dry ? (float*)(p.ws + OFF_A) : p.out;
    for (int item = vbid(); item < T_TOK / 4; item += vgrid()) gather_token(p, (size_t)item * 4 + wv, lane, dst);
}

constexpr size_t GS_SIDS = OFF_A;
constexpr size_t GS_SGS = GS_SIDS + (size_t)T_TOK * 256;
constexpr size_t GS_OFF = GS_SGS + (size_t)T_TOK * 512;
constexpr size_t GS_XQ = GS_OFF + (size_t)T_TOK * 64;
constexpr size_t GS_SX = GS_XQ + (size_t)T_TOK * 1024;
constexpr size_t GS_ACC = GS_SX + (size_t)T_TOK * 4;
static_assert(GS_ACC + (size_t)T_TOK * 2048 <= OFF_A + 69 * MiB, "gather scratch overflows region A");

DI void gs_load(GBatch& B, const char* __restrict__ ws, unsigned myid, float mygate, int j0, int n, int lane) {
#pragma unroll
    for (int j = 0; j < 4; ++j) {
        const int e = __builtin_amdgcn_readfirstlane(j0 + j);
        const bool ok = e < n;
        const int src = ok ? e : 0;
        const unsigned id = (unsigned)__builtin_amdgcn_readlane((int)myid, src);
        const float g = __uint_as_float((unsigned)__builtin_amdgcn_readlane((int)__float_as_uint(mygate), src));
        B.gate[j] = ok ? g : 0.f;
        const char* urow = ws + OFF_UQ + (size_t)id * 1024;
        const char* vrow = ws + OFF_VQ + (size_t)id * 1024;
        B.U[j] = ldu4(urow + 16 * lane);
        B.V[j] = ldu4(vrow + 16 * lane);
        B.su[j] = ((const float*)(ws + OFF_SU))[id];
        B.sv[j] = ((const float*)(ws + OFF_SV))[id];
    }
}

DI void phase_gather_sliced(const Params& p, char* smem) {
    char* ws = p.ws;
    if ((T_TOK / 8) > 8 * (((int)gridDim.x >> 3) * 8) || ((int)gridDim.x & 7)) { phase_gather(p); return; }
    char* lacc = smem + (threadIdx.x >> 6) * 16384 + (threadIdx.x & 63) * 32;
    unsigned short* lids = (unsigned short*)(smem + 131072 + (threadIdx.x >> 6) * 2048);
    unsigned char* loff = (unsigned char*)(smem + 131072 + 16384 + (threadIdx.x >> 6) * 128);
    const int lane = threadIdx.x & 63;
    const int x = (int)blockIdx.x & 7, nW = ((int)gridDim.x >> 3) * 8, lw = ((int)blockIdx.x >> 3) * 8 + (int)(threadIdx.x >> 6);
    const int TPX = T_TOK / 8;
    for (int tl = lw; tl < TPX; tl += nW) {
        const size_t tok = (size_t)x * TPX + tl;
        const bf16_t* hrow = (const bf16_t*)(ws + OFF_HB) + tok * 1024 + 16 * lane;
        float hv[16];
        {
            const u32x4 w0 = ldu4(hrow), w1 = ldu4(hrow + 8);
#pragma unroll
            for (int e = 0; e < 4; ++e) { hv[2 * e] = bf_lo(w0[e]); hv[2 * e + 1] = bf_hi(w0[e]); hv[8 + 2 * e] = bf_lo(w1[e]); hv[8 + 2 * e + 1] = bf_hi(w1[e]); }
        }
        float rs;
        {
            const float* SS = (const float*)(ws + OFF_SS2) + tok * 16;
            const f32x4 s0 = *(const f32x4*)SS, s1 = *(const f32x4*)(SS + 4), s2 = *(const f32x4*)(SS + 8), s3 = *(const f32x4*)(SS + 12);
            const float tot = (s0[0] + s0[1] + s0[2] + s0[3]) + (s1[0] + s1[1] + s1[2] + s1[3]) + (s2[0] + s2[1] + s2[2] + s2[3]) + (s3[0] + s3[1] + s3[2] + s3[3]);
            rs = rsqrtf(tot * (1.0f / 1024.0f) + 1e-6f);
        }
        float xf[16]; float am = 0.f;
#pragma unroll
        for (int i = 0; i < 4; ++i) {
            const f32x4 g = *(const f32x4*)(p.norm_ffn + 16 * lane + 4 * i);
#pragma unroll
            for (int e = 0; e < 4; ++e) { xf[4 * i + e] = hv[4 * i + e] * rs * g[e]; am = fmaxf(am, fabsf(xf[4 * i + e])); }
        }
#pragma unroll
        for (int o = 32; o; o >>= 1) am = fmaxf(am, __shfl_xor(am, o));
        const float sx = (am > 0.f) ? am * (1.0f / 127.0f) : 1.0f;
        const float isx = 1.0f / sx;
        u32x4 qx;
#pragma unroll
        for (int i = 0; i < 4; ++i) {
            unsigned w = 0u;
#pragma unroll
            for (int e = 0; e < 4; ++e) w |= ((unsigned)(int)rintf(xf[4 * i + e] * isx) & 0xFFu) << (8 * e);
            qx[i] = w;
        }
        *(u32x4*)(ws + GS_XQ + tok * 1024 + 16 * lane) = qx;
        if (lane == 0) ((float*)(ws + GS_SX))[tok] = sx;
        const unsigned idpair = *((const unsigned*)(ws + OFF_SELID) + tok * 64 + lane);
        const f32x2 gpair = *((const f32x2*)(ws + OFF_SELG) + tok * 64 + lane);
        const unsigned id0 = idpair & 0xFFFFu, id1 = idpair >> 16;
        const int sl0 = (int)(id0 >> 11), sl1 = (int)(id1 >> 11);
        const unsigned long long lt = (1ull << lane) - 1ull;
        int base = 0, pos0 = 0, pos1 = 0, myoff = 0;
#pragma unroll
        for (int s = 0; s < 8; ++s) {
            const unsigned long long m0 = __ballot(sl0 == s), m1 = __ballot(sl1 == s);
            const int c0 = __popcll(m0), c1 = __popcll(m1);
            if (sl0 == s) pos0 = base + __popcll(m0 & lt);
            if (sl1 == s) pos1 = base + c0 + __popcll(m1 & lt);
            if (lane == s) myoff = base;
            base += c0 + c1;
        }
        if (lane == 8) myoff = base;
        unsigned short* sid = (unsigned short*)(ws + GS_SIDS) + tok * 128;
        float* sg = (float*)(ws + GS_SGS) + tok * 128;
        sid[pos0] = (unsigned short)id0; sid[pos1] = (unsigned short)id1;
        { const int k = (tl - lw) / nW; lids[k * 128 + pos0] = (unsigned short)id0; lids[k * 128 + pos1] = (unsigned short)id1; if (lane < 9) loff[k * 16 + lane] = (unsigned char)myoff; }
        sg[pos0] = gpair[0]; sg[pos1] = gpair[1];
        if (lane < 9) ((int*)(ws + GS_OFF))[tok * 16 + lane] = myoff;
    }
    __syncthreads();
#pragma unroll 1
    for (int pass = 0; pass < 8; ++pass) {
        const int slice = (pass + x) & 7;
#pragma unroll 1
        for (int tl = lw; tl < TPX; tl += nW) {
            const size_t tok = (size_t)x * TPX + tl;
            const int* offp = (const int*)(ws + GS_OFF) + tok * 16;
            const int kslot = (tl - lw) / nW;
            const int o0 = __builtin_amdgcn_readfirstlane((int)loff[kslot * 16 + slice]), o1 = __builtin_amdgcn_readfirstlane((int)loff[kslot * 16 + slice + 1]);
            const int n = o1 - o0;
            if (n == 0 && pass != 0 && pass != 7) continue;
            float acc[16]; float csum = 0.f;
            if (pass == 0) {
#pragma unroll
                for (int i = 0; i < 16; ++i) acc[i] = 0.f;
            } else {
                const bf16_t* ap = (const bf16_t*)(ws + GS_ACC) + tok * 1024 + 16 * lane;
                const char* la = lacc + ((tl - lw) / nW) * 2048;
                const u32x4 w0 = *(const u32x4*)la, w1 = *(const u32x4*)(la + 16);
#pragma unroll
                for (int e = 0; e < 4; ++e) { acc[2 * e] = bf_lo(w0[e]); acc[2 * e + 1] = bf_hi(w0[e]); acc[8 + 2 * e] = bf_lo(w1[e]); acc[8 + 2 * e + 1] = bf_hi(w1[e]); }
            }
            if (n > 0) {
                const u32x4 qv = ldu4(ws + GS_XQ + tok * 1024 + 16 * lane);
                const unsigned qx[4] = {qv[0], qv[1], qv[2], qv[3]};
                const float sx = ((const float*)(ws + GS_SX))[tok];
#pragma unroll 1
                for (int c0 = 0; c0 < n; c0 += 64) {
                    const int nc = (n - c0) < 64 ? (n - c0) : 64;
                    const int li = (lane < nc) ? lane : 0;
                    const unsigned myid = (unsigned)lids[kslot * 128 + o0 + c0 + li];
                    const float mygate = ((const float*)(ws + GS_SGS))[tok * 128 + o0 + c0 + li];
                    GBatch B0, B1;
                    gs_load(B0, ws, myid, mygate, 0, nc, lane);
#pragma unroll 1
                    for (int j0 = 0; j0 < nc; j0 += 8) {
                        if (j0 + 4 < nc) gs_load(B1, ws, myid, mygate, j0 + 4, nc, lane);
                        gather_compute(B0, qx, sx, acc, csum, lane);
                        if (j0 + 4 < nc) {
                            if (j0 + 8 < nc) gs_load(B0, ws, myid, mygate, j0 + 8, nc, lane);
                            gather_compute(B1, qx, sx, acc, csum, lane);
                        }
                    }
                }
#pragma unroll
                for (int i = 0; i < 16; ++i) acc[i] -= 128.0f * csum;
            }
            if (pass < 7) {
                bf16_t* ap = (bf16_t*)(ws + GS_ACC) + tok * 1024 + 16 * lane;
                u32x4 w0, w1;
#pragma unroll
                for (int e = 0; e < 4; ++e) { w0[e] = pack2(acc[2 * e], acc[2 * e + 1]); w1[e] = pack2(acc[8 + 2 * e], acc[8 + 2 * e + 1]); }
                char* la = lacc + ((tl - lw) / nW) * 2048;
                *(u32x4*)la = w0; *(u32x4*)(la + 16) = w1;
            } else {
                const bf16_t* hrow = (const bf16_t*)(ws + OFF_HB) + tok * 1024 + 16 * lane;
                const u32x4 w0 = ldu4(hrow), w1 = ldu4(hrow + 8);
                float ss = 0.f;
#pragma unroll
                for (int e = 0; e < 4; ++e) {
                    acc[2 * e] += bf_lo(w0[e]); acc[2 * e + 1] += bf_hi(w0[e]); acc[8 + 2 * e] += bf_lo(w1[e]); acc[8 + 2 * e + 1] += bf_hi(w1[e]);
                }
#pragma unroll
                for (int i = 0; i < 16; ++i) ss += acc[i] * acc[i];
#pragma unroll
                for (int o = 32; o; o >>= 1) ss += __shfl_xor(ss, o);
                const float rf = rsqrtf(ss * (1.0f / 1024.0f) + 1e-6f);
                float* drow = p.out + tok * 1024 + 16 * lane;
#pragma unroll
                for (int i = 0; i < 4; ++i) {
                    const f32x4 nn = *(const f32x4*)(p.norm_final + 16 * lane + 4 * i);
                    *(f32x4*)(drow + 4 * i) = (f32x4){acc[4 * i] * rf * nn[0], acc[4 * i + 1] * rf * nn[1], acc[4 * i + 2] * rf * nn[2], acc[4 * i + 3] * rf * nn[3]};
                }
            }
        }
    }
}
constexpr int LDS_BYTES = 131072 + 16384 + 1024;
constexpr int NPHASE = 12;
template <int PH> DI void run_phase(const Params& p, char* smem) {
    char* lds = smem + vhalf() * 65536;
    if (PH == 0) phase_prep(p, lds);
    else if (PH == 1) phase_p1(p, smem);
    else if (PH == 2) phase_p2(p, smem);
    else if (PH == 3) phase_p3(p, lds);
    else if (PH == 4) phase_p35(p, lds);
    else if (PH == 5) phase_resid<false>(p, smem, OFF_WT_OUT, OFF_MIXED, p.x, OFF_SS1);
    else if (PH == 6) phase_rowscale(p, smem, OFF_WT_MQ, 1024, (bf16_t*)(p.ws + OFF_QM), OFF_SS1, 0.0625f * LOG2E);
    else if (PH == 7) phase_memattn(p, lds);
    else if (PH == 8) phase_resid<true>(p, smem, OFF_WT_MO, OFF_OM, p.ws + OFF_HB, OFF_SS2);
    else if (PH == 9) phase_rowscale(p, smem, OFF_WT_PQ, 2048, (bf16_t*)((char*)p.out + OUT_PQ), OFF_SS2, 1.0f);
    else if (PH == 10) phase_select(p, lds);
    else if (PH == 11) phase_gather_sliced(p, smem);
}

template <int PH> __global__ void __launch_bounds__(512, 2) k_phase(Params p) {
    __shared__ __attribute__((aligned(16))) char smem[LDS_BYTES];
    run_phase<PH>(p, smem);
}

static Params make_params(void* const* d_in, void* d_out, void* d_ws) {
    Params p;
    memset(&p, 0, sizeof(p));
    p.x = (const float*)d_in[0]; p.mem = (const float*)d_in[1]; p.norm_mix = (const float*)d_in[2]; p.w_in = (const float*)d_in[3];
    p.q_norm = (const float*)d_in[4]; p.kv_norm = (const float*)d_in[5]; p.w_uq = (const float*)d_in[6]; p.w_ukv = (const float*)d_in[7];
    p.gn_mla = (const float*)d_in[8]; p.gn_dil = (const float*)d_in[9]; p.w_out = (const float*)d_in[10]; p.norm_mem_q = (const float*)d_in[11];
    p.norm_mem_kv = (const float*)d_in[12]; p.w_mem_q = (const float*)d_in[13]; p.w_mem_kv = (const float*)d_in[14]; p.w_mem_o = (const float*)d_in[15];
    p.norm_ffn = (const float*)d_in[16]; p.peer_w_q = (const float*)d_in[17]; p.sub_keys = (const float*)d_in[18]; p.peer_u = (const float*)d_in[19];
    p.peer_v = (const float*)d_in[20]; p.norm_final = (const float*)d_in[21];
    p.out = (float*)d_out; p.ws = (char*)d_ws;
    for (int i = 0; i < 16; ++i) p.inv_freq[i] = 1.0f / powf(10000.0f, (float)(2 * i) / 32.0f);
    return p;
}
__global__ void __launch_bounds__(512, 2) k_mega(Params p) {
    __shared__ __attribute__((aligned(16))) char smem[LDS_BYTES + 16];
    volatile LAS unsigned* st = (volatile LAS unsigned*)(LAS char*)(smem + LDS_BYTES);
    if (threadIdx.x == 0) { st[0] = 0u; st[1] = 0u; st[2] = 0u; st[3] = 0u; }
    __syncthreads();
    const XcdBarrier xb = xcd_barrier_post((unsigned*)(p.ws + OFF_BAR), st);
#define RP(n) run_phase<n>(p, smem); xcd_barrier(xb);
    RP(0) RP(1) RP(2) RP(3) RP(4) RP(5) RP(6) RP(7) RP(8) RP(9) RP(10)
    run_phase<11>(p, smem);
}

extern "C" void kernel_launch(void* const* d_in, const int* in_sizes, int n_in, void* d_out, int out_size, void* d_ws, size_t ws_size,
                              hipStream_t stream) {
    static int grid_blocks = 0;
    if (!grid_blocks) {
        int dev = 0, cus = 0, per_cu = 0;
        (void)hipGetDevice(&dev);
        (void)hipDeviceGetAttribute(&cus, hipDeviceAttributeMultiprocessorCount, dev);
        (void)hipOccupancyMaxActiveBlocksPerMultiprocessor(&per_cu, k_mega, 512, 0);
        if (per_cu > 1) per_cu = 1;
        if (per_cu < 1) per_cu = 1;
        grid_blocks = cus * per_cu;
    }
    Params p = make_params(d_in, d_out, d_ws);
    (void)hipMemsetAsync((char*)d_ws + OFF_BAR, 0, XCD_BAR_WORDS * 4, stream);
    void* args[] = {&p};
    hipError_t e = hipLaunchCooperativeKernel((const void*)k_mega, dim3(grid_blocks), dim3(512), args, 0, stream);
    if (e != hipSuccess) fprintf(stderr, "cooperative launch failed: %s (grid %d)\n", hipGetErrorString(e), grid_blocks);
}
```

```cpp
#include <hip/hip_runtime.h>
#include <hip/hip_cooperative_groups.h>
#include <math.h>
#include <stdint.h>
#include <stdio.h>
#include <string.h>
#define DI __device__ __forceinline__
typedef unsigned short bf16_t;
typedef short bf16x8 __attribute__((ext_vector_type(8)));
typedef short s16x4 __attribute__((ext_vector_type(4)));
typedef float f32x16 __attribute__((ext_vector_type(16)));
typedef float f32x4 __attribute__((ext_vector_type(4)));
typedef float f32x2 __attribute__((ext_vector_type(2)));
typedef unsigned u32x4 __attribute__((ext_vector_type(4)));
typedef unsigned u32x2 __attribute__((ext_vector_type(2)));
typedef __bf16 bf16x2v __attribute__((ext_vector_type(2)));
#define LAS __attribute__((address_space(3)))
#define MFMA32(a, b, c) __builtin_amdgcn_mfma_f32_32x32x16_bf16((a), (b), (c), 0, 0, 0)

constexpr int T_TOK = 16384, SEQ_L = 4096, DM = 1024, INC = 2208;
constexpr float LOG2E = 1.4426950408889634f;

DI int otid() { int t = threadIdx.x & 255; asm volatile("" : "+v"(t)); return t; }
DI int vhalf() { return __builtin_amdgcn_readfirstlane((int)(threadIdx.x >> 8)); }
DI int vbid() { return (int)blockIdx.x * 2 + vhalf(); }
DI int vgrid() { return (int)gridDim.x * 2; }
DI unsigned pack2(float lo, float hi) { f32x2 f = {lo, hi}; return __builtin_bit_cast(unsigned, __builtin_convertvector(f, bf16x2v)); }
DI float bf_lo(unsigned u) { return __uint_as_float(u << 16); }
DI float bf_hi(unsigned u) { return __uint_as_float(u & 0xffff0000u); }
DI float bf2f(bf16_t v) { return __uint_as_float(((unsigned)v) << 16); }
DI int crow(int reg, int hh) { return (reg & 3) + 8 * (reg >> 2) + 4 * hh; }
DI f32x16 zero16() { f32x16 z;
#pragma unroll
    for (int i = 0; i < 16; ++i) z[i] = 0.f; return z; }
DI float xhalf_max(float v) { auto r = __builtin_amdgcn_permlane32_swap(__float_as_uint(v), __float_as_uint(v), false, false); return fmaxf(__uint_as_float(r[0]), __uint_as_float(r[1])); }
DI float xhalf_other(float v, int lane) { auto r = __builtin_amdgcn_permlane32_swap(__float_as_uint(v), __float_as_uint(v), false, false); return __uint_as_float((lane & 32) ? r[0] : r[1]); }
DI float xhalf_sum(float v) { auto r = __builtin_amdgcn_permlane32_swap(__float_as_uint(v), __float_as_uint(v), false, false); return __uint_as_float(r[0]) + __uint_as_float(r[1]); }
DI bf16x8 ld16(const void* p) { return *(const bf16x8*)p; }
DI u32x4 ldu4(const void* p) { return *(const u32x4*)p; }
DI float fast_exp2(float x) { return __builtin_amdgcn_exp2f(x); }
DI bf16x8 pack_step(const f32x16& x, int s) {
    u32x4 p;
    p[0] = pack2(x[8 * s + 0], x[8 * s + 1]); p[1] = pack2(x[8 * s + 2], x[8 * s + 3]);
    p[2] = pack2(x[8 * s + 4], x[8 * s + 5]); p[3] = pack2(x[8 * s + 6], x[8 * s + 7]);
    return __builtin_bit_cast(bf16x8, p);
}
DI s16x4 tr_read_a(unsigned lds_byte_addr) { s16x4 r; asm volatile("ds_read_b64_tr_b16 %0, %1" : "=v"(r) : "v"(lds_byte_addr)); return r; }
#define TR_WAIT() do { asm volatile("s_waitcnt lgkmcnt(0)" ::: "memory"); __builtin_amdgcn_sched_barrier(0); } while (0)
DI s16x4 tr_read(unsigned lds_byte_addr) {
    return __builtin_amdgcn_ds_read_tr16_b64_v4i16((LAS s16x4*)(uintptr_t)lds_byte_addr);
}

constexpr size_t MiB = 1ull << 20;
constexpr size_t OFF_BAR = 0;
constexpr size_t OFF_WT_IN = 65536;
constexpr size_t OFF_WT_UQ = OFF_WT_IN + 2304ull * 1024 * 2;
constexpr size_t OFF_WT_UKV = OFF_WT_UQ + 768ull * 384 * 2;
constexpr size_t OFF_WT_OUT = OFF_WT_UKV + 1024ull * 256 * 2;
constexpr size_t OFF_WT_MQ = OFF_WT_OUT + 1024ull * 1024 * 2;
constexpr size_t OFF_WT_MKV = OFF_WT_MQ + 1024ull * 1024 * 2;
constexpr size_t OFF_WT_MO = OFF_WT_MKV + 2048ull * 1024 * 2;
constexpr size_t OFF_WT_PQ = OFF_WT_MO + 1024ull * 1024 * 2;
constexpr size_t OFF_KEYS = OFF_WT_PQ + 2048ull * 1024 * 2;
constexpr size_t OFF_ROPE = OFF_KEYS + 16ull * 128 * 128 * 2;
constexpr size_t OFF_KR = OFF_ROPE + 2ull * 4096 * 16 * 4;
constexpr size_t OFF_LSE = OFF_KR + (size_t)T_TOK * 32 * 2;
constexpr size_t OFF_SS1 = OFF_LSE + 3ull * T_TOK * 8 * 4;
constexpr size_t OFF_SS2 = OFF_SS1 + (size_t)T_TOK * 16 * 4;
constexpr size_t OFF_MEMN = OFF_SS2 + (size_t)T_TOK * 16 * 4;
constexpr size_t OFF_SMALL_END = OFF_MEMN + 1024ull * 1024 * 2;
static_assert(OFF_SMALL_END <= 28 * MiB, "small region overflow");
constexpr size_t OFF_A = 28 * MiB;
constexpr size_t OFF_PROJ = OFF_A;
constexpr size_t OFF_UQ = 193 * MiB;
constexpr size_t OFF_VQ = 209 * MiB;
constexpr size_t OFF_SU = 243 * MiB;
constexpr size_t OFF_SV = OFF_SU + 65536;
constexpr size_t OUT_ODIL = 0;
constexpr size_t OUT_OMLA = 48 * MiB;
constexpr size_t OUT_PQ = 0;
constexpr size_t OFF_B = 97 * MiB;
constexpr size_t OFF_XN = OFF_B, OFF_QMLA = OFF_B, OFF_MIXED = OFF_B, OFF_QM = OFF_B;
constexpr size_t OFF_C = 129 * MiB;
constexpr size_t OFF_KVMLA = OFF_C, OFF_HB = OFF_C;
constexpr size_t OFF_D = 161 * MiB;
constexpr size_t OFF_OM = OFF_D;
constexpr size_t OFF_SELID = 225 * MiB;
constexpr size_t OFF_SELG = 229 * MiB;
constexpr size_t OFF_KVM = 237 * MiB;
constexpr size_t OFF_SSQ = 241 * MiB;
constexpr size_t WS_NEEDED = 244 * MiB;

struct Params {
    const float* x; const float* mem; const float* norm_mix; const float* w_in; const float* q_norm; const float* kv_norm;
    const float* w_uq; const float* w_ukv; const float* gn_mla; const float* gn_dil; const float* w_out; const float* norm_mem_q;
    const float* norm_mem_kv; const float* w_mem_q; const float* w_mem_kv; const float* w_mem_o; const float* norm_ffn;
    const float* peer_w_q; const float* sub_keys; const float* peer_u; const float* peer_v; const float* norm_final;
    float* out; char* ws;
    float inv_freq[16];
    int prof; int pad_;
};
#define XB_TMO      128
#define XB_XCNT(j)  (256  + 64 * (j))
#define XB_XSUB(j)  (1280 + 64 * (j))
#define XB_XGEN(j)  (2304 + 64 * (j))
#define XB_TOP      3328
#define XB_TOPGEN   3392
#define XCD_BAR_WORDS 3456
#define XB_SPIN_CAP (1u << 20)
DI unsigned xb_ld(unsigned* p) { return __hip_atomic_load(p, __ATOMIC_RELAXED, __HIP_MEMORY_SCOPE_AGENT); }
DI unsigned xb_add(unsigned* p, unsigned v) { return __hip_atomic_fetch_add(p, v, __ATOMIC_RELAXED, __HIP_MEMORY_SCOPE_AGENT); }
DI unsigned xb_xcc_id() { return (unsigned)__builtin_amdgcn_s_getreg((3 << 11) | 20) & 0xFu; }
#define XB_SPIN(cond, bar) do { unsigned _sp = 0; while (cond) { __builtin_amdgcn_s_sleep(1); \
    if ((++_sp & 255u) == 0u) { if (xb_ld(&(bar)[XB_TMO])) break; if (_sp > XB_SPIN_CAP) { atomicAdd(&(bar)[XB_TMO], 1u); break; } } } } while (0)
struct XcdBarrier { unsigned* bar; unsigned x; volatile LAS unsigned* st; };
DI XcdBarrier xcd_barrier_post(unsigned* bar, volatile LAS unsigned* st) {
    XcdBarrier b; b.bar = bar; b.x = xb_xcc_id(); b.st = st;
    if (threadIdx.x == 0) (void)xb_add(&bar[XB_XCNT(b.x)], 1u);
    return b;
}
DI void xcd_barrier_complete(unsigned* bar, unsigned x, unsigned& nloc, unsigned& nx) {
    const unsigned G = gridDim.x * gridDim.y * gridDim.z;
    unsigned sum, cnt, mine, sp = 0u;
    for (;;) {
        sum = 0u; cnt = 0u; mine = 0u;
#pragma unroll
        for (unsigned j = 0; j < 16; ++j) { const unsigned c = xb_ld(&bar[XB_XCNT(j)]); sum += c; cnt += (c > 0u) ? 1u : 0u; mine = (j == x) ? c : mine; }
        if (sum == G) break;
        __builtin_amdgcn_s_sleep(1);
        if ((++sp & 255u) == 0u) { if (xb_ld(&bar[XB_TMO])) break; if (sp > XB_SPIN_CAP) { atomicAdd(&bar[XB_TMO], 1u); break; } }
    }
    nloc = mine > 0u ? mine : 1u; nx = cnt > 0u ? cnt : 1u;
}
DI void xcd_barrier(const XcdBarrier& b) {
    asm volatile("s_waitcnt vmcnt(0)" ::: "memory");
    __syncthreads();
    if (threadIdx.x == 0) {
        unsigned* bar = b.bar;
        __builtin_amdgcn_s_waitcnt(0);
        unsigned nloc = b.st[0], nx = b.st[1];
        if (nloc == 0u) { xcd_barrier_complete(bar, b.x, nloc, nx); b.st[0] = nloc; b.st[1] = nx; }
        const unsigned old = xb_add(&bar[XB_XSUB(b.x)], 1u);
        const unsigned gen = old / nloc;
        if (old + 1u == (gen + 1u) * nloc) {
            __builtin_amdgcn_fence(__ATOMIC_RELEASE, "agent");
            asm volatile("s_waitcnt vmcnt(0)" ::: "memory");
            const unsigned og = xb_add(&bar[XB_TOP], 1u);
            const unsigned tg = og / nx;
            if (og + 1u == (tg + 1u) * nx) xb_add(&bar[XB_TOPGEN], 1u);
            else XB_SPIN(xb_ld(&bar[XB_TOPGEN]) == tg, bar);
            __builtin_amdgcn_fence(__ATOMIC_ACQUIRE, "agent");
            xb_add(&bar[XB_XGEN(b.x)], 1u);
            asm volatile("s_waitcnt vmcnt(0)" ::: "memory");
        } else {
            XB_SPIN(xb_ld(&bar[XB_XGEN(b.x)]) == gen, bar);
            __builtin_amdgcn_fence(__ATOMIC_ACQUIRE, "agent");
            asm volatile("s_waitcnt vmcnt(0)" ::: "memory");
        }
    }
    __syncthreads();
}
DI void transpose_tile(const float* __restrict__ W, int K, int N, const float* __restrict__ g, bf16_t* __restrict__ Wt, int kt, int nt, char* lds, bool valid) {
    float* sm = (float*)lds;
    const int t = otid();
    const int k0 = kt * 64, n0 = nt * 64;
    __syncthreads();
#pragma unroll
    for (int i = 0; i < 16; ++i) {
        const int id = t + 256 * i, k = id >> 6, n = id & 63;
        float v = 0.f;
        if (valid && n0 + n < N) { v = W[(size_t)(k0 + k) * N + n0 + n]; if (g) v *= g[k0 + k]; }
        sm[k * 65 + n] = v;
    }
    __syncthreads();
    const int n = t >> 2, kc = (t & 3) * 16;
    u32x4 o0, o1;
    o0[0] = pack2(sm[(kc + 0) * 65 + n], sm[(kc + 1) * 65 + n]); o0[1] = pack2(sm[(kc + 2) * 65 + n], sm[(kc + 3) * 65 + n]);
    o0[2] = pack2(sm[(kc + 4) * 65 + n], sm[(kc + 5) * 65 + n]); o0[3] = pack2(sm[(kc + 6) * 65 + n], sm[(kc + 7) * 65 + n]);
    o1[0] = pack2(sm[(kc + 8) * 65 + n], sm[(kc + 9) * 65 + n]); o1[1] = pack2(sm[(kc + 10) * 65 + n], sm[(kc + 11) * 65 + n]);
    o1[2] = pack2(sm[(kc + 12) * 65 + n], sm[(kc + 13) * 65 + n]); o1[3] = pack2(sm[(kc + 14) * 65 + n], sm[(kc + 15) * 65 + n]);
    bf16_t* dst = Wt + (size_t)(n0 + n) * K + k0 + kc;
    if (valid) { *(u32x4*)dst = o0; *(u32x4*)(dst + 8) = o1; }
}

DI void rmsnorm_row_bf16(const float* __restrict__ in, const float* __restrict__ g, bf16_t* __restrict__ out, int lane) {
    f32x4 v[4]; float ss = 0.f;
#pragma unroll
    for (int i = 0; i < 4; ++i) { v[i] = *(const f32x4*)(in + 4 * lane + 256 * i); ss += v[i][0] * v[i][0] + v[i][1] * v[i][1] + v[i][2] * v[i][2] + v[i][3] * v[i][3]; }
#pragma unroll
    for (int o = 32; o; o >>= 1) ss += __shfl_xor(ss, o);
    const float rs = rsqrtf(ss * (1.0f / 1024.0f) + 1e-6f);
#pragma unroll
    for (int i = 0; i < 4; ++i) {
        const f32x4 gg = *(const f32x4*)(g + 4 * lane + 256 * i);
        u32x2 o; o[0] = pack2(v[i][0] * rs * gg[0], v[i][1] * rs * gg[1]); o[1] = pack2(v[i][2] * rs * gg[2], v[i][3] * rs * gg[3]);
        *(u32x2*)(out + 4 * lane + 256 * i) = o;
    }
}

struct TrJob { const float* W; const float* g; size_t off; int K, N, Npad; };

DI void phase_prep(const Params& p, char* lds) {
    char* ws = p.ws;
    const int t = otid(), lane = t & 63, wv = t >> 6;
    const int c0 = 576, c1 = c0 + 72, c2 = c1 + 64, c3 = c2 + 256, c4 = c3 + 256, c5 = c4 + 512, c6 = c5 + 256, c7 = c6 + 512;
    const int nrow = (T_TOK + 1024) / 4;
    const int nkeys = 128, nrope = 256;
    const int total = c7 + nrow + nkeys + nrope;
    for (int k = 0; k < (c7 + vgrid() - 1) / vgrid(); ++k) {
        const int raw = vbid() + k * vgrid();
        const bool valid = raw < c7;
        const int item = valid ? raw : 0;
        const float* W; const float* g; size_t off; int K, N, Npad, local;
        if (item < c0)      { W = p.w_in;     g = nullptr;      off = OFF_WT_IN;  K = 1024; N = 2208; Npad = 2304; local = item; }
        else if (item < c1) { W = p.w_uq;     g = p.q_norm;     off = OFF_WT_UQ;  K = 384;  N = 768;  Npad = 768;  local = item - c0; }
        else if (item < c2) { W = p.w_ukv;    g = p.kv_norm;    off = OFF_WT_UKV; K = 256;  N = 1024; Npad = 1024; local = item - c1; }
        else if (item < c3) { W = p.w_out;    g = nullptr;      off = OFF_WT_OUT; K = 1024; N = 1024; Npad = 1024; local = item - c2; }
        else if (item < c4) { W = p.w_mem_q;  g = p.norm_mem_q; off = OFF_WT_MQ;  K = 1024; N = 1024; Npad = 1024; local = item - c3; }
        else if (item < c5) { W = p.w_mem_kv; g = nullptr;      off = OFF_WT_MKV; K = 1024; N = 2048; Npad = 2048; local = item - c4; }
        else if (item < c6) { W = p.w_mem_o;  g = nullptr;      off = OFF_WT_MO;  K = 1024; N = 1024; Npad = 1024; local = item - c5; }
        else                { W = p.peer_w_q; g = p.norm_ffn;   off = OFF_WT_PQ;  K = 1024; N = 2048; Npad = 2048; local = item - c6; }
        const int ntn = Npad / 64;
        transpose_tile(W, K, N, g, (bf16_t*)(ws + off), local / ntn, local % ntn, lds, valid);
    }
    for (int item = c7 + vbid(); item < total; item += vgrid()) {
        if (item < c7 + nrow) {
            const int row = (item - c7) * 4 + wv;
            if (row < T_TOK) rmsnorm_row_bf16(p.x + (size_t)row * 1024, p.norm_mix, (bf16_t*)(ws + OFF_XN) + (size_t)row * 1024, lane);
            else rmsnorm_row_bf16(p.mem + (size_t)(row - T_TOK) * 1024, p.norm_mem_kv, (bf16_t*)(ws + OFF_MEMN) + (size_t)(row - T_TOK) * 1024, lane);
        } else if (item < c7 + nrow + nkeys) {
            const int idx = ((item - c7 - nrow) * 256 + t) * 8;
            const f32x4 a = *(const f32x4*)(p.sub_keys + idx), b = *(const f32x4*)(p.sub_keys + idx + 4);
            u32x4 o; o[0] = pack2(a[0], a[1]); o[1] = pack2(a[2], a[3]); o[2] = pack2(b[0], b[1]); o[3] = pack2(b[2], b[3]);
            *(u32x4*)((bf16_t*)(ws + OFF_KEYS) + idx) = o;
        } else {
            const int idx = (item - c7 - nrow - nkeys) * 256 + t;
            const int s = idx >> 4, i = idx & 15;
            const float ang = (float)s * p.inv_freq[i];
            const double a = (double)ang;
            const double twopi = 6.283185307179586476925;
            const float rf = (float)(a - twopi * rint(a / twopi));
            float* cs = (float*)(ws + OFF_ROPE);
            cs[idx] = cosf(rf); cs[65536 + idx] = sinf(rf);
        }
    }
}
namespace pg8 {
#define PG8_LAS __attribute__((address_space(3)))
typedef unsigned short bf16_t;
typedef short bf16x8 __attribute__((ext_vector_type(8)));
typedef float f32x4 __attribute__((ext_vector_type(4)));
typedef unsigned u32x4 __attribute__((ext_vector_type(4)));
constexpr int BM = 256, BK = 64, HALF = 128, HTB = HALF * BK * 2  , STAGE_BYTES = 8 * HTB, NXCD = 8, WGM = 8;

__host__ __device__ __forceinline__ int lds_byte(int r, int c) { const int st = (r >> 4) * 2 + (c >> 5), rr = r & 15, cc = c & 31, ob = rr * 64 + cc * 2; return st * 1024 + (ob ^ (((ob >> 9) & 1) << 5)); }
__host__ __device__ __forceinline__ void stage_rc(int b, int& R, int& C) { const int st = b / 1024, sb = b % 1024, swz = sb ^ (((sb >> 9) & 1) << 5); R = (st >> 1) * 16 + swz / 64; C = (st & 1) * 32 + (swz % 64) / 2; }
__host__ __device__ __forceinline__ int perm32(int rho) { const int n = rho >> 4, i = rho & 15; return 8 * (i >> 2) + 4 * n + (i & 3); }

struct Unit { int pm, pn; };
struct Gemm { const bf16_t* A; const bf16_t* Bt; int M, N, K, lda; };

struct StaticOrder {
    int nM, nN, nwg, G, c;
    __host__ __device__ void init(int M, int N, int G_, int c_) { nM = M / BM; nN = N / BM; nwg = nM * nN; G = G_; c = c_; }
    __host__ __device__ bool next(int i, Unit& u) const {
        const long L = (long)i * G + c; if (L >= nwg) return false;
        int wgid = (int)L; { const int q = nwg / NXCD, r = nwg % NXCD, xcd = wgid % NXCD, off = wgid / NXCD; wgid = (xcd < r ? xcd * (q + 1) : r * (q + 1) + (xcd - r) * q) + off; }
        const int nig = WGM * nN, gid = wgid / nig, fm = gid * WGM, gsz = (nM - fm) < WGM ? (nM - fm) : WGM;
        u.pm = fm + ((wgid % nig) % gsz); u.pn = (wgid % nig) / gsz; return true;
    }
    __device__ __forceinline__ void a_ready(const Unit&) const {}
    __device__ __forceinline__ void done(const Unit&) const {}
};

template <class Epi, class Sched, bool ALIGN_EPI = false, bool SP2 = false>
__device__ __forceinline__ void gemm_phase(PG8_LAS unsigned char* lds, const Gemm g, const Sched& S, const Epi& E) {
    int tid_ = threadIdx.x; asm volatile("" : "+v"(tid_));
    const int tid = tid_, wid = __builtin_amdgcn_readfirstlane(tid >> 6), lane = tid & 63, wr = wid >> 2, wc = wid & 3, fr = lane & 15, fq = lane >> 4;
    const int K = g.K, nt = K / BK, lda = g.lda;
    unsigned voffA[2], voffB[2];
#pragma unroll
    for (int i = 0; i < 2; ++i) { int R, C; stage_rc(tid * 16 + i * 8192, R, C); const int Rb = Epi::PERM ? ((R & ~31) + perm32(R & 31)) : R;
        voffA[i] = (unsigned)(R * lda + C) * 2u; voffB[i] = (unsigned)(Rb * K + C) * 2u; }
    const size_t kstep = (size_t)(BK * 2);
    const size_t hstepB = (size_t)HALF * K * 2, hstepA = (size_t)HALF * lda * 2;
    const size_t tstepB = 2 * hstepB, tstepA = 2 * hstepA;
    const unsigned ldsw = (unsigned)wid * 1024u;
    const int aoff = lds_byte(wr * 64 + fr, fq * 8), boff = lds_byte(wc * 32 + fr, fq * 8);
#define PG8_SA(b, h) (((b) * 2 + (h)) * HTB)
#define PG8_SB(b, h) ((4 + (b) * 2 + (h)) * HTB)
#define PG8_STAGE(bufoff, gbase, voff) do { _Pragma("unroll") for (int _i = 0; _i < 2; ++_i) \
        __builtin_amdgcn_global_load_lds((const unsigned*)((const char*)(gbase) + (voff)[_i]), (PG8_LAS unsigned*)(lds + (bufoff) + ldsw + _i * 8192), 16, 0, 0); } while (0)
#define PG8_LDA(dst, b, h) do { _Pragma("unroll") for (int m = 0; m < 4; ++m) _Pragma("unroll") for (int k = 0; k < 2; ++k) dst[m][k] = *(const PG8_LAS bf16x8*)(lds + PG8_SA(b, h) + aoff + m * 2048 + k * 1024); } while (0)
#define PG8_LDB(dst, b, h) do { _Pragma("unroll") for (int n = 0; n < 2; ++n) _Pragma("unroll") for (int k = 0; k < 2; ++k) dst[n][k] = *(const PG8_LAS bf16x8*)(lds + PG8_SB(b, h) + boff + n * 2048 + k * 1024); } while (0)
#define PG8_MMA(ai, bj, At, Bt) do { __builtin_amdgcn_s_setprio(1); _Pragma("unroll") for (int m = 0; m < 4; ++m) _Pragma("unroll") for (int n = 0; n < 2; ++n) _Pragma("unroll") for (int k = 0; k < 2; ++k) \
        acc[ai][bj][m][n] = __builtin_amdgcn_mfma_f32_16x16x32_bf16(Bt[n][k], At[m][k], acc[ai][bj][m][n], 0, 0, 0); __builtin_amdgcn_s_setprio(0); } while (0)
#define PG8_WAIT_V(n) asm volatile("s_waitcnt vmcnt(" #n ")" ::: "memory")
#define PG8_WAIT_L(n) asm volatile("s_waitcnt lgkmcnt(" #n ")" ::: "memory")
#define PG8_BAR __builtin_amdgcn_s_barrier()
#define PG8_SCHED __builtin_amdgcn_sched_barrier(0)
    Unit cur, nxt; int ui = 0;
    if (!S.next(0, cur)) return;
    f32x4 acc[2][2][4][2];
#pragma unroll
    for (int a = 0; a < 2; ++a)
#pragma unroll
        for (int b = 0; b < 2; ++b)
#pragma unroll
            for (int m = 0; m < 4; ++m)
#pragma unroll
                for (int n = 0; n < 2; ++n) acc[a][b][m][n] = (f32x4){0.f, 0.f, 0.f, 0.f};
    bf16x8 At[4][2], B0[2][2], B1[2][2];
    const char* cA = (const char*)g.A + (size_t)cur.pm * tstepA; const char* cB = (const char*)g.Bt + (size_t)cur.pn * tstepB;
    S.a_ready(cur);
    if constexpr (SP2) {
        PG8_STAGE(PG8_SB(0, 0), cB, voffB); PG8_STAGE(PG8_SB(0, 1), cB + hstepB, voffB); PG8_STAGE(PG8_SA(0, 0), cA, voffA); PG8_STAGE(PG8_SA(0, 1), cA + hstepA, voffA);
        if (wr == 1) PG8_BAR;
        PG8_WAIT_V(2); PG8_BAR;
        PG8_STAGE(PG8_SB(1, 0), cB + kstep, voffB); PG8_STAGE(PG8_SA(1, 0), cA + kstep, voffA); PG8_STAGE(PG8_SB(1, 1), cB + hstepB + kstep, voffB);
        PG8_WAIT_V(6); PG8_BAR;
    } else {
        PG8_STAGE(PG8_SB(0, 0), cB, voffB); PG8_STAGE(PG8_SA(0, 0), cA, voffA); PG8_STAGE(PG8_SB(0, 1), cB + hstepB, voffB); PG8_STAGE(PG8_SA(0, 1), cA + hstepA, voffA);
        if (wr == 1) PG8_BAR;
        PG8_WAIT_V(4); PG8_BAR;
        PG8_STAGE(PG8_SB(1, 0), cB + kstep, voffB); PG8_STAGE(PG8_SA(1, 0), cA + kstep, voffA); PG8_STAGE(PG8_SB(1, 1), cB + hstepB + kstep, voffB);
        PG8_WAIT_V(6); PG8_BAR;
    }
    for (;;) {
        const bool has_next = S.next(ui + 1, nxt);
        const char* nA = has_next ? (const char*)g.A + (size_t)nxt.pm * tstepA : cA; const char* nB = has_next ? (const char*)g.Bt + (size_t)nxt.pn * tstepB : cB;
#pragma unroll 1
        for (int t = 0; t < nt; t += 2) {
            const bool last = (t == nt - 2);
            const char* a1 = cA + (size_t)(t + 1) * kstep;
            const char* a2 = last ? nA : cA + (size_t)(t + 2) * kstep; const char* b2 = last ? nB : cB + (size_t)(t + 2) * kstep;
            const char* a3 = a2 + kstep; const char* b3 = b2 + kstep;
            if (last && has_next) S.a_ready(nxt);
            if constexpr (SP2) {
            PG8_LDB(B0, 0, 0); PG8_LDB(B1, 0, 1); PG8_SCHED; PG8_LDA(At, 0, 0); PG8_STAGE(PG8_SA(1, 1), a1 + hstepA, voffA);
            PG8_WAIT_V(8); PG8_WAIT_L(0); PG8_BAR; PG8_MMA(0, 0, At, B0); PG8_MMA(0, 1, At, B1); PG8_BAR; PG8_SCHED;
            PG8_LDA(At, 0, 1); PG8_STAGE(PG8_SB(0, 0), b2, voffB); PG8_STAGE(PG8_SB(0, 1), b2 + hstepB, voffB); PG8_STAGE(PG8_SA(0, 0), a2, voffA);
            PG8_WAIT_V(8); PG8_WAIT_L(0); PG8_BAR; PG8_MMA(1, 0, At, B0); PG8_MMA(1, 1, At, B1); PG8_BAR; PG8_SCHED;
            PG8_LDB(B0, 1, 0); PG8_LDB(B1, 1, 1); PG8_SCHED; PG8_LDA(At, 1, 0); PG8_STAGE(PG8_SA(0, 1), a2 + hstepA, voffA);
            PG8_WAIT_V(8); PG8_WAIT_L(0); PG8_BAR; PG8_MMA(0, 0, At, B0); PG8_MMA(0, 1, At, B1); PG8_BAR; PG8_SCHED;
            PG8_LDA(At, 1, 1); PG8_STAGE(PG8_SB(1, 0), b3, voffB); PG8_STAGE(PG8_SB(1, 1), b3 + hstepB, voffB); PG8_STAGE(PG8_SA(1, 0), a3, voffA);
            PG8_WAIT_V(8); PG8_WAIT_L(0); PG8_BAR; PG8_MMA(1, 0, At, B0); PG8_MMA(1, 1, At, B1); PG8_BAR; PG8_SCHED;
            } else {
            PG8_LDB(B0, 0, 0); PG8_SCHED; PG8_LDA(At, 0, 0); PG8_STAGE(PG8_SA(1, 1), a1 + hstepA, voffA);
            PG8_WAIT_L(8); PG8_BAR; PG8_WAIT_L(0); PG8_MMA(0, 0, At, B0); PG8_BAR; PG8_SCHED;
            PG8_LDB(B1, 0, 1); PG8_STAGE(PG8_SB(0, 0), b2, voffB);
            PG8_BAR; PG8_WAIT_L(0); PG8_MMA(0, 1, At, B1); PG8_BAR;
            PG8_LDA(At, 0, 1); PG8_STAGE(PG8_SA(0, 0), a2, voffA);
            PG8_BAR; PG8_WAIT_L(0); PG8_MMA(1, 0, At, B0); PG8_BAR; PG8_SCHED;
            PG8_STAGE(PG8_SB(0, 1), b2 + hstepB, voffB);
            PG8_WAIT_V(6); PG8_BAR; PG8_MMA(1, 1, At, B1); PG8_BAR;
            PG8_LDB(B0, 1, 0); PG8_SCHED; PG8_LDA(At, 1, 0); PG8_STAGE(PG8_SA(0, 1), a2 + hstepA, voffA);
            PG8_WAIT_L(8); PG8_BAR; PG8_WAIT_L(0); PG8_MMA(0, 0, At, B0); PG8_BAR; PG8_SCHED;
            PG8_LDB(B1, 1, 1); PG8_STAGE(PG8_SB(1, 0), b3, voffB);
            PG8_BAR; PG8_WAIT_L(0); PG8_MMA(0, 1, At, B1); PG8_BAR;
            PG8_LDA(At, 1, 1); PG8_STAGE(PG8_SA(1, 0), a3, voffA);
            PG8_BAR; PG8_WAIT_L(0); PG8_MMA(1, 0, At, B0); PG8_BAR; PG8_SCHED;
            PG8_STAGE(PG8_SB(1, 1), b3 + hstepB, voffB);
            PG8_WAIT_V(6); PG8_BAR; PG8_MMA(1, 1, At, B1); PG8_BAR;
            }
        }
        if constexpr (ALIGN_EPI) { if (wr == 0) PG8_BAR; }
        if constexpr (!Epi::AFTER_DRAIN) { E(acc, cur, wr, wc, fr, fq); S.done(cur); }
        if (!has_next) break;
#pragma unroll
        for (int a = 0; a < 2; ++a)
#pragma unroll
            for (int b = 0; b < 2; ++b)
#pragma unroll
                for (int m = 0; m < 4; ++m)
#pragma unroll
                    for (int n = 0; n < 2; ++n) acc[a][b][m][n] = (f32x4){0.f, 0.f, 0.f, 0.f};
        cur = nxt; cA = nA; cB = nB; ++ui;
        if constexpr (ALIGN_EPI) { if (wr == 1) PG8_BAR; }
    }
    PG8_WAIT_V(0);
    if constexpr (!ALIGN_EPI) { if (wr == 0) PG8_BAR; }
    PG8_BAR;
    if constexpr (Epi::AFTER_DRAIN) { E.fused(acc, cur, wr, wc, fr, fq, lds, wid, lane); S.done(cur); }
#undef PG8_SA
#undef PG8_SB
#undef PG8_STAGE
#undef PG8_LDA
#undef PG8_LDB
#undef PG8_MMA
#undef PG8_WAIT_V
#undef PG8_WAIT_L
#undef PG8_BAR
#undef PG8_SCHED
}
}
DI unsigned sw_off(int row, int chunk) { return (unsigned)(row * 128 + ((chunk ^ ((row >> 1) & 7)) << 4)); }
#define GLDS16(gsrc, ldst) __builtin_amdgcn_global_load_lds((const unsigned*)(gsrc), (unsigned*)(ldst), 16, 0, 0)
DI u32x2 pack4(float a, float b, float c, float d) { u32x2 o; o[0] = pack2(a, b); o[1] = pack2(c, d); return o; }
#define EPI_ARGS const f32x4 (&acc)[2][2][4][2], const pg8::Unit& u, int wr, int wc, int fr, int fq
DI float xq_sum(float v) {
    v += __uint_as_float((unsigned)__builtin_amdgcn_ds_swizzle((int)__float_as_uint(v), 0x401F));
    return xhalf_sum(v);
}
DI u32x4 pack8(const float (&v)[8], float sc) {
    u32x4 o; o[0] = pack2(v[0] * sc, v[1] * sc); o[1] = pack2(v[2] * sc, v[3] * sc); o[2] = pack2(v[4] * sc, v[5] * sc); o[3] = pack2(v[6] * sc, v[7] * sc); return o;
}
DI void rope8(const float (&v)[8], float sc, const float* __restrict__ cs, int pos, int fq, int lane, bf16_t* dst32  ) {
    const int i0 = 8 * (fq & 1);
    const f32x4 c0 = *(const f32x4*)(cs + pos * 16 + i0), c1 = *(const f32x4*)(cs + pos * 16 + i0 + 4);
    const f32x4 s0 = *(const f32x4*)(cs + 65536 + pos * 16 + i0), s1 = *(const f32x4*)(cs + 65536 + pos * 16 + i0 + 4);
    const float sg = (fq < 2) ? -1.0f : 1.0f;
    float o[8];
#pragma unroll
    for (int e = 0; e < 8; ++e) {
        const float own = v[e] * sc, oth = xhalf_other(own, lane);
        const float c = (e < 4) ? c0[e & 3] : c1[e & 3], s = (e < 4) ? s0[e & 3] : s1[e & 3];
        o[e] = own * c + sg * oth * s;
    }
    *(u32x4*)(dst32 + 8 * fq) = pack8(o, 1.0f);
}
#define EPI_LOAD8(v, ai, bj, m) float v[8]; { const f32x4 x0_ = acc[ai][bj][m][0], x1_ = acc[ai][bj][m][1]; v[0] = x0_[0]; v[1] = x0_[1]; v[2] = x0_[2]; v[3] = x0_[3]; v[4] = x1_[0]; v[5] = x1_[1]; v[6] = x1_[2]; v[7] = x1_[3]; }

struct EpiPlain8 {
    static constexpr bool PERM = true, AFTER_DRAIN = false;
    bf16_t* out; int ld;
    DI void operator()(EPI_ARGS) const {
#pragma unroll
        for (int ai = 0; ai < 2; ++ai)
#pragma unroll
            for (int m = 0; m < 4; ++m) {
                int fr_ = fr; asm volatile("" : "+v"(fr_));
                const size_t tok = (size_t)u.pm * 256 + ai * 128 + wr * 64 + m * 16 + fr_;
#pragma unroll
                for (int bj = 0; bj < 2; ++bj) { EPI_LOAD8(v, ai, bj, m); *(u32x4*)(out + tok * ld + u.pn * 256 + bj * 128 + wc * 32 + 8 * fq) = pack8(v, 1.0f); }
            }
    }
};

struct EpiProj8 {
    static constexpr bool PERM = true, AFTER_DRAIN = false;
    bf16_t* proj; bf16_t* kr; const float* cs; float* ssq;
    DI void operator()(EPI_ARGS) const {
        const int lane = fr + 16 * fq;
#pragma unroll
        for (int bj = 0; bj < 2; ++bj) {
            const int cg = u.pn * 256 + bj * 128 + wc * 32;
            if (cg >= INC) continue;
            const int g32 = cg >> 5;
            const float sc = (cg >= 672 && cg < 1184) ? 0.125f * LOG2E : 1.0f;
#pragma unroll
            for (int ai = 0; ai < 2; ++ai)
#pragma unroll
                for (int m = 0; m < 4; ++m) {
                    int fr_ = fr; asm volatile("" : "+v"(fr_));
                const size_t tok = (size_t)u.pm * 256 + ai * 128 + wr * 64 + m * 16 + fr_;
                    EPI_LOAD8(v, ai, bj, m);
                    if (g32 < 20) {
                        float ss = 0.f;
#pragma unroll
                        for (int e = 0; e < 8; ++e) ss += v[e] * v[e];
                        ss = xq_sum(ss);
                        if (fq == 0) ssq[tok * 24 + g32] = ss;
                    }
                    if (cg == 640) rope8(v, 1.0f, cs, (int)(tok & (SEQ_L - 1)), fq, lane, kr + tok * 32);
                    else *(u32x4*)(proj + tok * INC + cg + 8 * fq) = pack8(v, sc);
                }
        }
    }
};

struct EpiUpQ8 {
    static constexpr bool PERM = true, AFTER_DRAIN = false;
    bf16_t* q; const float* cs; const float* ssq;
    DI void operator()(EPI_ARGS) const {
        const int lane = fr + 16 * fq;
        const float qs = 0.10206207261596575f * LOG2E;
#pragma unroll
        for (int ai = 0; ai < 2; ++ai)
#pragma unroll
            for (int m = 0; m < 4; ++m) {
                int fr_ = fr; asm volatile("" : "+v"(fr_));
                const size_t tok = (size_t)u.pm * 256 + ai * 128 + wr * 64 + m * 16 + fr_;
                const f32x4 a0 = *(const f32x4*)(ssq + tok * 24), a1 = *(const f32x4*)(ssq + tok * 24 + 4), a2 = *(const f32x4*)(ssq + tok * 24 + 8);
                const float tot = (a0[0] + a0[1] + a0[2] + a0[3]) + (a1[0] + a1[1] + a1[2] + a1[3]) + (a2[0] + a2[1] + a2[2] + a2[3]);
                const float sc = rsqrtf(tot * (1.0f / 384.0f) + 1e-6f) * qs;
#pragma unroll
                for (int bj = 0; bj < 2; ++bj) {
                    const int cg = u.pn * 256 + bj * 128 + wc * 32;
                    EPI_LOAD8(v, ai, bj, m);
                    if ((cg % 96) == 64) rope8(v, sc, cs, (int)(tok & (SEQ_L - 1)), fq, lane, q + tok * 768 + cg);
                    else *(u32x4*)(q + tok * 768 + cg + 8 * fq) = pack8(v, sc);
                }
            }
    }
};

struct EpiUpKV8 {
    static constexpr bool PERM = true, AFTER_DRAIN = false;
    bf16_t* kv; const float* ssq;
    DI void operator()(EPI_ARGS) const {
#pragma unroll
        for (int ai = 0; ai < 2; ++ai)
#pragma unroll
            for (int m = 0; m < 4; ++m) {
                int fr_ = fr; asm volatile("" : "+v"(fr_));
                const size_t tok = (size_t)u.pm * 256 + ai * 128 + wr * 64 + m * 16 + fr_;
                const f32x4 a0 = *(const f32x4*)(ssq + tok * 24 + 12), a1 = *(const f32x4*)(ssq + tok * 24 + 16);
                const float tot = (a0[0] + a0[1] + a0[2] + a0[3]) + (a1[0] + a1[1] + a1[2] + a1[3]);
                const float sc = rsqrtf(tot * (1.0f / 256.0f) + 1e-6f);
#pragma unroll
                for (int bj = 0; bj < 2; ++bj) { EPI_LOAD8(v, ai, bj, m); *(u32x4*)(kv + tok * 1024 + u.pn * 256 + bj * 128 + wc * 32 + 8 * fq) = pack8(v, sc); }
            }
    }
};

template <bool RBF16>
struct EpiResid8 {
    static constexpr bool PERM = true, AFTER_DRAIN = false;
    const void* R; bf16_t* HB; float* SS;
    DI void operator()(EPI_ARGS) const {
#pragma unroll
        for (int ai = 0; ai < 2; ++ai) {
            f32x4 rv[4][2][2];
#pragma unroll
            for (int m = 0; m < 4; ++m)
#pragma unroll
                for (int bj = 0; bj < 2; ++bj) {
                    const size_t off = ((size_t)u.pm * 256 + ai * 128 + wr * 64 + m * 16 + fr) * 1024 + u.pn * 256 + bj * 128 + wc * 32 + 8 * fq;
                    if (RBF16) {
                        const u32x4 w = ldu4((const bf16_t*)R + off);
                        rv[m][bj][0] = (f32x4){bf_lo(w[0]), bf_hi(w[0]), bf_lo(w[1]), bf_hi(w[1])};
                        rv[m][bj][1] = (f32x4){bf_lo(w[2]), bf_hi(w[2]), bf_lo(w[3]), bf_hi(w[3])};
                    } else {
                        rv[m][bj][0] = *(const f32x4*)((const float*)R + off); rv[m][bj][1] = *(const f32x4*)((const float*)R + off + 4);
                    }
                }
#pragma unroll
            for (int m = 0; m < 4; ++m) {
                int fr_ = fr; asm volatile("" : "+v"(fr_));
                const size_t tok = (size_t)u.pm * 256 + ai * 128 + wr * 64 + m * 16 + fr_;
                float ss = 0.f;
#pragma unroll
                for (int bj = 0; bj < 2; ++bj) {
                    const size_t off = tok * 1024 + u.pn * 256 + bj * 128 + wc * 32 + 8 * fq;
                    const f32x4 h0 = rv[m][bj][0] + acc[ai][bj][m][0], h1 = rv[m][bj][1] + acc[ai][bj][m][1];
                    u32x4 o; o[0] = pack2(h0[0], h0[1]); o[1] = pack2(h0[2], h0[3]); o[2] = pack2(h1[0], h1[1]); o[3] = pack2(h1[2], h1[3]);
                    *(u32x4*)(HB + off) = o;
                    const float a0 = bf_lo(o[0]), a1 = bf_hi(o[0]), a2 = bf_lo(o[1]), a3 = bf_hi(o[1]), a4 = bf_lo(o[2]), a5 = bf_hi(o[2]), a6 = bf_lo(o[3]), a7 = bf_hi(o[3]);
                    ss += (a0 * a0 + a1 * a1) + (a2 * a2 + a3 * a3) + (a4 * a4 + a5 * a5) + (a6 * a6 + a7 * a7);
                }
                ss = xq_sum(ss);
                if (fq == 0) SS[tok * 16 + 4 * u.pn + wc] = ss;
            }
        }
    }
};

struct EpiRowScale8 {
    static constexpr bool PERM = true, AFTER_DRAIN = false;
    bf16_t* out; int ld; const float* SS; float extra;
    DI void operator()(EPI_ARGS) const {
#pragma unroll
        for (int ai = 0; ai < 2; ++ai)
#pragma unroll
            for (int m = 0; m < 4; ++m) {
                int fr_ = fr; asm volatile("" : "+v"(fr_));
                const size_t tok = (size_t)u.pm * 256 + ai * 128 + wr * 64 + m * 16 + fr_;
                const f32x4 s0 = *(const f32x4*)(SS + tok * 16), s1 = *(const f32x4*)(SS + tok * 16 + 4), s2 = *(const f32x4*)(SS + tok * 16 + 8), s3 = *(const f32x4*)(SS + tok * 16 + 12);
                const float tot = (s0[0] + s0[1] + s0[2] + s0[3]) + (s1[0] + s1[1] + s1[2] + s1[3]) + (s2[0] + s2[1] + s2[2] + s2[3]) + (s3[0] + s3[1] + s3[2] + s3[3]);
                const float sc = rsqrtf(tot * (1.0f / 1024.0f) + 1e-6f) * extra;
#pragma unroll
                for (int bj = 0; bj < 2; ++bj) { EPI_LOAD8(v, ai, bj, m); *(u32x4*)(out + tok * ld + u.pn * 256 + bj * 128 + wc * 32 + 8 * fq) = pack8(v, sc); }
            }
    }
};

template <class Epi>
DI void gemm8(char* smem, const bf16_t* A, int lda, const bf16_t* Bt, int M, int N, int K, const Epi& e, int cshift = 0) {
    pg8::Gemm g; g.A = A; g.Bt = Bt; g.M = M; g.N = N; g.K = K; g.lda = lda;
    const int G = (int)gridDim.x;
    pg8::StaticOrder S; S.init(M, N, G, ((int)blockIdx.x + G - cshift) % G);
    pg8::gemm_phase<Epi, pg8::StaticOrder, true, true>((PG8_LAS unsigned char*)smem, g, S, e);
}

DI void quant_rows4(const Params& p, int it, int wv, int lane);
DI void phase_p1(const Params& p, char* smem) {
    char* ws = p.ws;
    const int G = (int)gridDim.x, nproj = 9 * 64, nkvm = 8 * 4;
    const int last = nproj % G;
    { EpiProj8 e{(bf16_t*)(ws + OFF_PROJ), (bf16_t*)(ws + OFF_KR), (const float*)(ws + OFF_ROPE), (float*)(ws + OFF_SSQ)};
      gemm8(smem, (const bf16_t*)(ws + OFF_XN), 1024, (const bf16_t*)(ws + OFF_WT_IN), T_TOK, 2304, 1024, e); }
    { EpiPlain8 e{(bf16_t*)(ws + OFF_KVM), 2048};
      gemm8(smem, (const bf16_t*)(ws + OFF_MEMN), 1024, (const bf16_t*)(ws + OFF_WT_MKV), 1024, 2048, 1024, e, last); }
    int q0 = last + nkvm, nq = G - q0;
    if (last == 0 || nq <= 0) { q0 = 0; nq = G; }
    if ((int)blockIdx.x >= q0) {
        const int t = otid(), lane = t & 63, wv = t >> 6;
        for (int it = ((int)blockIdx.x - q0) * 2 + vhalf(); it < 8192; it += 2 * nq) quant_rows4(p, it, wv, lane);
    }
}
DI void phase_p2(const Params& p, char* smem) {
    char* ws = p.ws;
    { EpiUpQ8 e{(bf16_t*)(ws + OFF_QMLA), (const float*)(ws + OFF_ROPE), (const float*)(ws + OFF_SSQ)};
      gemm8(smem, (const bf16_t*)(ws + OFF_PROJ), INC, (const bf16_t*)(ws + OFF_WT_UQ), T_TOK, 768, 384, e); }
    { EpiUpKV8 e{(bf16_t*)(ws + OFF_KVMLA), (const float*)(ws + OFF_SSQ)};
      gemm8(smem, (const bf16_t*)(ws + OFF_PROJ) + 384, INC, (const bf16_t*)(ws + OFF_WT_UKV), T_TOK, 1024, 256, e); }
}
template <bool RBF16>
DI void phase_resid(const Params& p, char* smem, size_t off_w, size_t off_a, const void* R, size_t off_ss, bool dry = false) {
    char* ws = p.ws;
    EpiResid8<RBF16> e{R, (bf16_t*)(ws + OFF_HB), (float*)(ws + off_ss)};
    if (dry) { e.HB = (bf16_t*)(ws + OFF_B); e.SS = (float*)(ws + OFF_SS1); }
    gemm8(smem, (const bf16_t*)(ws + off_a), 1024, (const bf16_t*)(ws + off_w), T_TOK, 1024, 1024, e);
}
DI void phase_rowscale(const Params& p, char* smem, size_t off_w, int N, bf16_t* outp, size_t off_ss, float extra) {
    char* ws = p.ws;
    EpiRowScale8 e{outp, N, (const float*)(ws + off_ss), extra};
    gemm8(smem, (const bf16_t*)(ws + OFF_HB), 1024, (const bf16_t*)(ws + off_w), T_TOK, N, 1024, e);
}
DI unsigned v128_off(int row, int chunk) { return (unsigned)(row * 128 + ((chunk ^ (((row >> 1) & 1) << 2)) << 4)); }
DI unsigned v128_tr_addr(unsigned base, int R0, int c, int lane) {
    const int blk = (lane >> 4) & 1, qq = (lane & 15) >> 2, pp = lane & 3;
    return base + v128_off(R0 + qq, 4 * c + 2 * blk + (pp >> 1)) + 8 * (pp & 1);
}
DI bf16x8 cat44(s16x4 lo, s16x4 hi) { return __builtin_shufflevector(lo, hi, 0, 1, 2, 3, 4, 5, 6, 7); }

constexpr int MLA_STAGE = 64 * 192 + 64 * 128;
DI unsigned k192_off(int row, int chunk) { return (unsigned)(row * 192 + (((chunk & ~3) | ((chunk & 3) ^ ((row >> 2) & 3))) << 4)); }
DI void mla_unit(const Params& p, char* lds, int b, int h, int qt) {
    char* ws = p.ws;
    const int t = otid(), lane = t & 63, wv = t >> 6, r = lane & 31, hh = lane >> 5;
    const bf16_t* Q = (const bf16_t*)(ws + OFF_QMLA);
    const bf16_t* KV = (const bf16_t*)(ws + OFF_KVMLA);
    const bf16_t* KR = (const bf16_t*)(ws + OFF_KR);
    const int q0 = qt * 128 + 32 * wv;
    const size_t tokq = (size_t)b * SEQ_L + q0 + r;
    const size_t tokb = (size_t)b * SEQ_L;
    bf16x8 qf[6];
#pragma unroll
    for (int s = 0; s < 6; ++s) qf[s] = ld16(Q + tokq * 768 + h * 96 + 16 * s + 8 * hh);
    f32x16 o[2]; o[0] = zero16(); o[1] = zero16();
    float m = -INFINITY, l = 0.f;
    const bf16_t* ksrc[3]; int kadv[3]; const bf16_t* vsrc[2];
#pragma unroll
    for (int i = 0; i < 3; ++i) {
        const int o_ = 1024 * (wv + 4 * i) + 16 * lane, row = o_ / 192, pch = (o_ % 192) >> 4;
        const int c = (pch & ~3) | ((pch & 3) ^ ((row >> 2) & 3));
        if (c < 8) { ksrc[i] = KV + (tokb + row) * 1024 + h * 128 + 8 * c; kadv[i] = 64 * 1024; }
        else       { ksrc[i] = KR + (tokb + row) * 32 + 8 * (c - 8);       kadv[i] = 64 * 32; }
    }
#pragma unroll
    for (int i = 0; i < 2; ++i) {
        const int row = 8 * (wv + 4 * i) + (lane >> 3), pch = lane & 7;
        vsrc[i] = KV + (tokb + row) * 1024 + h * 128 + 64 + 8 * (pch ^ (((row >> 1) & 1) << 2));
    }
    char* ldst = lds + wv * 1024 + lane * 16;
    auto issue = [&](int kt) {
        char* d = ldst + (kt % 3) * MLA_STAGE;
#pragma unroll
        for (int i = 0; i < 3; ++i) GLDS16(ksrc[i] + (size_t)kt * kadv[i], d + i * 4096);
#pragma unroll
        for (int i = 0; i < 2; ++i) GLDS16(vsrc[i] + (size_t)kt * (64 * 1024), d + 12288 + i * 4096);
    };
    const int ntiles = 2 * qt + 2;
    __syncthreads();
    issue(0); issue(1);
#pragma unroll
    for (int s = 0; s < 6; ++s) asm volatile("" :: "v"(qf[s]));
#pragma unroll 1
    for (int kt = 0; kt < ntiles; ++kt) {
        if (kt + 1 < ntiles) asm volatile("s_waitcnt vmcnt(5)\n\ts_barrier" ::: "memory");
        else asm volatile("s_waitcnt vmcnt(0)\n\ts_barrier" ::: "memory");
        if (kt + 2 < ntiles) issue(kt + 2);
        const char* sb = lds + (kt % 3) * MLA_STAGE;
        const unsigned vb = (unsigned)(uintptr_t)(sb + 12288);
        f32x16 s[2];
#pragma unroll
        for (int k2 = 0; k2 < 2; ++k2) {
            s[k2] = zero16();
#pragma unroll
            for (int ss = 0; ss < 6; ++ss) s[k2] = MFMA32(ld16(sb + k192_off(32 * k2 + r, 2 * ss + hh)), qf[ss], s[k2]);
        }
        s16x4 vt[2][2][2][2];
#pragma unroll
        for (int k2 = 0; k2 < 2; ++k2)
#pragma unroll
            for (int st = 0; st < 2; ++st)
#pragma unroll
                for (int c = 0; c < 2; ++c) {
                    vt[k2][st][c][0] = tr_read_a(v128_tr_addr(vb, 32 * k2 + 16 * st + 4 * hh, c, lane));
                    vt[k2][st][c][1] = tr_read_a(v128_tr_addr(vb, 32 * k2 + 16 * st + 8 + 4 * hh, c, lane));
                }
        if (__builtin_amdgcn_readfirstlane(kt >= 2 * qt)) {
            asm volatile("");
            const int qpos = q0 + r;
#pragma unroll
            for (int k2 = 0; k2 < 2; ++k2)
#pragma unroll
                for (int i = 0; i < 16; ++i) { const int kpos = 64 * kt + 32 * k2 + crow(i, hh); if (kpos > qpos) s[k2][i] = -INFINITY; }
        }
        float mx = s[0][0];
#pragma unroll
        for (int k2 = 0; k2 < 2; ++k2)
#pragma unroll
            for (int i = 0; i < 16; ++i) mx = fmaxf(mx, s[k2][i]);
        mx = xhalf_max(mx);
        if (__any(mx > m + 8.0f)) {
            asm volatile("");
            const float mn = fmaxf(m, mx);
            const float alpha = fast_exp2(m - mn);
            l *= alpha;
            m = mn;
#pragma unroll
            for (int c = 0; c < 2; ++c)
#pragma unroll
                for (int i = 0; i < 16; ++i) o[c][i] *= alpha;
        }
        f32x2 ps2 = {0.f, 0.f};
        const f32x2 m2 = {m, m};
#pragma unroll
        for (int k2 = 0; k2 < 2; ++k2)
#pragma unroll
            for (int i = 0; i < 16; i += 2) {
                f32x2 x = {s[k2][i], s[k2][i + 1]};
                x = x - m2;
                f32x2 e; e[0] = fast_exp2(x[0]); e[1] = fast_exp2(x[1]);
                s[k2][i] = e[0]; s[k2][i + 1] = e[1];
                ps2 += e;
            }
        l += ps2[0] + ps2[1];
        TR_WAIT();
#pragma unroll
        for (int k2 = 0; k2 < 2; ++k2)
#pragma unroll
            for (int st = 0; st < 2; ++st) {
                const bf16x8 pb = pack_step(s[k2], st);
#pragma unroll
                for (int c = 0; c < 2; ++c) o[c] = MFMA32(cat44(vt[k2][st][c][0], vt[k2][st][c][1]), pb, o[c]);
            }
    }
    const float inv = 1.0f / xhalf_sum(l);
    bf16_t* dst = (bf16_t*)((char*)p.out + OUT_OMLA) + tokq * 512 + h * 64 + 4 * hh;
#pragma unroll
    for (int c = 0; c < 2; ++c)
#pragma unroll
        for (int g = 0; g < 4; ++g)
            *(u32x2*)(dst + 32 * c + 8 * g) = pack4(o[c][4 * g] * inv, o[c][4 * g + 1] * inv, o[c][4 * g + 2] * inv, o[c][4 * g + 3] * inv);
}

DI void dil_unit(const Params& p, char* lds, int g, int b, int h, int rr, int lb) {
    char* ws = p.ws;
    const int t = otid(), lane = t & 63, wv = t >> 6, r = lane & 31, hh = lane >> 5;
    const int d = (g == 0) ? 1 : (g == 1 ? 4 : 16);
    const bf16_t* PJ = (const bf16_t*)(ws + OFF_PROJ);
    const size_t tokb = (size_t)b * SEQ_L;
    char* kimg = lds;
    char* vimg = lds + 32768;
    __syncthreads();
    {
        const int c = t & 7;
#pragma unroll
        for (int half = 0; half < 2; ++half) {
            u32x4 kk[4], vv[4];
#pragma unroll
            for (int i = 0; i < 4; ++i) {
                const int key = (t >> 3) + 32 * (4 * half + i);
                const int lk = 128 * lb - 128 + key;
                if (lk >= 0) {
                    const size_t tk = tokb + (size_t)lk * d + rr;
                    kk[i] = ldu4(PJ + tk * INC + 1184 + h * 64 + 8 * c);
                    vv[i] = ldu4(PJ + tk * INC + 1696 + h * 64 + 8 * c);
                } else { kk[i] = (u32x4){0u, 0u, 0u, 0u}; vv[i] = (u32x4){0u, 0u, 0u, 0u}; }
            }
#pragma unroll
            for (int i = 0; i < 4; ++i) {
                const int key = (t >> 3) + 32 * (4 * half + i);
                *(u32x4*)(kimg + sw_off(key, c)) = kk[i];
                *(u32x4*)(vimg + v128_off(key, c)) = vv[i];
            }
        }
    }
    const int lq = 128 * lb + 32 * wv + r;
    const size_t tokq = tokb + (size_t)lq * d + rr;
    bf16x8 qf[4];
#pragma unroll
    for (int s = 0; s < 4; ++s) qf[s] = ld16(PJ + tokq * INC + 672 + h * 64 + 16 * s + 8 * hh);
    __syncthreads();
    const float slope2 = exp2f(-(float)(h + 1)) * (float)d * LOG2E;
    const int u0 = (lb == 0) ? (4 - wv) : 0;
    f32x16 o[2]; o[0] = zero16(); o[1] = zero16();
    float m = -INFINITY, lsum = 0.f;
    const unsigned vb = (unsigned)(uintptr_t)vimg;
    float cb[16];
#pragma unroll
    for (int i = 0; i < 16; ++i) cb[i] = slope2 * (float)crow(i, hh);
#pragma unroll 1
    for (int u = u0; u < 5; ++u) {
        const int rowb = 32 * (wv + u);
        f32x16 s = zero16();
#pragma unroll
        for (int ss = 0; ss < 4; ++ss) s = MFMA32(ld16(kimg + sw_off(rowb + r, 2 * ss + hh)), qf[ss], s);
        const int dbase = r + 128 - 32 * u;
        const float b0 = -slope2 * (float)dbase;
#pragma unroll
        for (int i = 0; i < 16; ++i) s[i] += cb[i];
        if (__builtin_amdgcn_readfirstlane(u == 0 || u == 4)) {
            asm volatile("");
#pragma unroll
            for (int i = 0; i < 16; ++i) { const int dist = dbase - crow(i, hh); if (dist < 0 || dist > 128) s[i] = -INFINITY; }
        }
        float mx = s[0];
#pragma unroll
        for (int i = 1; i < 16; ++i) mx = fmaxf(mx, s[i]);
        mx = xhalf_max(mx) + b0;
        if (__any(mx > m + 8.0f)) {
            asm volatile("");
            const float mn = fmaxf(m, mx);
            const float alpha = fast_exp2(m - mn);
            lsum *= alpha;
            m = mn;
#pragma unroll
            for (int c = 0; c < 2; ++c)
#pragma unroll
                for (int i = 0; i < 16; ++i) o[c][i] *= alpha;
        }
        f32x2 ps2 = {0.f, 0.f};
        const float mb = m - b0;
        const f32x2 m2 = {mb, mb};
#pragma unroll
        for (int i = 0; i < 16; i += 2) {
            f32x2 xx = {s[i], s[i + 1]};
            xx = xx - m2;
            f32x2 e; e[0] = fast_exp2(xx[0]); e[1] = fast_exp2(xx[1]);
            s[i] = e[0]; s[i + 1] = e[1];
            ps2 += e;
        }
        lsum += ps2[0] + ps2[1];
#pragma unroll
        for (int st = 0; st < 2; ++st) {
            const bf16x8 pb = pack_step(s, st);
#pragma unroll
            for (int c = 0; c < 2; ++c) {
                const s16x4 lo = tr_read(v128_tr_addr(vb, rowb + 16 * st + 4 * hh, c, lane));
                const s16x4 hi = tr_read(v128_tr_addr(vb, rowb + 16 * st + 8 + 4 * hh, c, lane));
                o[c] = MFMA32(cat44(lo, hi), pb, o[c]);
            }
        }
    }
    const float ltot = xhalf_sum(lsum);
    const float mx = m;
    const float inv = 1.0f / ltot;
    bf16_t* dst = (bf16_t*)((char*)p.out + OUT_ODIL) + ((size_t)g * T_TOK + tokq) * 512 + h * 64 + 4 * hh;
#pragma unroll
    for (int c = 0; c < 2; ++c)
#pragma unroll
        for (int gg = 0; gg < 4; ++gg)
            *(u32x2*)(dst + 32 * c + 8 * gg) = pack4(o[c][4 * gg] * inv, o[c][4 * gg + 1] * inv, o[c][4 * gg + 2] * inv, o[c][4 * gg + 3] * inv);
    if (hh == 0) ((float*)(ws + OFF_LSE))[((size_t)g * T_TOK + tokq) * 8 + h] = mx + __log2f(ltot);
}

DI void phase_p3(const Params& p, char* lds, int which = 3) {
    const int xg = (int)blockIdx.x & 7, nloc = (vgrid() >> 3), loc = ((int)blockIdx.x >> 3) * 2 + vhalf();
    if (which & 1) for (int i = loc; i < 64; i += nloc) {
        const int bh = xg * 4 + (i >> 4), pr = i & 15, b = bh >> 3, h = bh & 7;
#pragma unroll 1
        for (int rep = 0; rep < 2; ++rep) mla_unit(p, lds, b, h, rep ? pr : 31 - pr);
    }
    if (which & 2) for (int i = loc; i < 384; i += nloc) {
        const int bh = xg * 4 + i / 96, k96 = i % 96, g = k96 >> 5, k = k96 & 31, b = bh >> 3, h = bh & 7;
        int rr, lb;
        if (g == 0) { rr = 0; lb = k; } else if (g == 1) { rr = k >> 3; lb = k & 7; } else { rr = k >> 1; lb = k & 1; }
        dil_unit(p, lds, g, b, h, rr, lb);
    }
}

DI void quant_rows4(const Params& p, int it, int wv, int lane) {
    char* ws = p.ws;
    const int ncv = 4096;
    const bool isv = it >= ncv;
    const size_t row = (size_t)(isv ? it - ncv : it) * 4 + wv;
    const float* src = (isv ? p.peer_v : p.peer_u) + row * 1024 + 16 * lane;
    f32x4 v[4]; float am = 0.f;
#pragma unroll
    for (int i = 0; i < 4; ++i) { v[i] = *(const f32x4*)(src + 4 * i); am = fmaxf(am, fmaxf(fmaxf(fabsf(v[i][0]), fabsf(v[i][1])), fmaxf(fabsf(v[i][2]), fabsf(v[i][3])))); }
#pragma unroll
    for (int o = 32; o; o >>= 1) am = fmaxf(am, __shfl_xor(am, o));
    const float sc = (am > 0.f) ? am * (isv ? (1.0f / 384.0f) : (1.0f / 127.0f)) : 1.0f;
    const float inv = 1.0f / sc;
    u32x4 o;
#pragma unroll
    for (int i = 0; i < 4; ++i) {
        if (isv) {
            int w = 0;
            w = __builtin_amdgcn_cvt_pk_fp8_f32(v[i][0] * inv, v[i][1] * inv, w, false);
            w = __builtin_amdgcn_cvt_pk_fp8_f32(v[i][2] * inv, v[i][3] * inv, w, true);
            o[i] = (unsigned)w;
        } else {
            unsigned w = 0u;
#pragma unroll
            for (int e = 0; e < 4; ++e) { const int q = (int)rintf(v[i][e] * inv); w |= ((unsigned)q & 0xFFu) << (8 * e); }
            o[i] = w;
        }
    }
    *(u32x4*)(ws + (isv ? OFF_VQ : OFF_UQ) + row * 1024 + 16 * lane) = o;
    if (lane == 0) ((float*)(ws + (isv ? OFF_SV : OFF_SU)))[row] = sc;
}

DI void phase_p35(const Params& p, char* lds) {
    char* ws = p.ws;
    const int t = otid(), lane = t & 63, wv = t >> 6;
    const int ntok = T_TOK / 4;
    for (int item = vbid(); item < ntok; item += vgrid()) {
        {
            const size_t tok = (size_t)item * 4 + wv;
            const int head = lane >> 3;
            const float* LS = (const float*)(ws + OFF_LSE);
            const float l0 = LS[tok * 8 + head], l1 = LS[((size_t)T_TOK + tok) * 8 + head], l2 = LS[((size_t)2 * T_TOK + tok) * 8 + head];
            const float mx = fmaxf(l0, fmaxf(l1, l2));
            float w0 = fast_exp2(l0 - mx), w1 = fast_exp2(l1 - mx), w2 = fast_exp2(l2 - mx);
            const float wi = 1.0f / (w0 + w1 + w2);
            w0 *= wi; w1 *= wi; w2 *= wi;
            const bf16_t* OD = (const bf16_t*)((const char*)p.out + OUT_ODIL);
            const u32x4 a0 = ldu4(OD + tok * 512 + 8 * lane), a1 = ldu4(OD + ((size_t)T_TOK + tok) * 512 + 8 * lane),
                        a2 = ldu4(OD + ((size_t)2 * T_TOK + tok) * 512 + 8 * lane);
            const u32x4 am = ldu4((const bf16_t*)((const char*)p.out + OUT_OMLA) + tok * 512 + 8 * lane);
            float od[8], om[8]; float sd = 0.f, sm = 0.f;
#pragma unroll
            for (int e = 0; e < 4; ++e) {
                od[2 * e] = w0 * bf_lo(a0[e]) + w1 * bf_lo(a1[e]) + w2 * bf_lo(a2[e]);
                od[2 * e + 1] = w0 * bf_hi(a0[e]) + w1 * bf_hi(a1[e]) + w2 * bf_hi(a2[e]);
                om[2 * e] = bf_lo(am[e]); om[2 * e + 1] = bf_hi(am[e]);
                sd += od[2 * e] * od[2 * e] + od[2 * e + 1] * od[2 * e + 1];
                sm += om[2 * e] * om[2 * e] + om[2 * e + 1] * om[2 * e + 1];
            }
#pragma unroll
            for (int o = 32; o; o >>= 1) { sd += __shfl_xor(sd, o); sm += __shfl_xor(sm, o); }
            const float rd = rsqrtf(sd * (1.0f / 512.0f) + 1e-6f), rm = rsqrtf(sm * (1.0f / 512.0f) + 1e-6f);
            const f32x4 gm0 = *(const f32x4*)(p.gn_mla + 8 * lane), gm1 = *(const f32x4*)(p.gn_mla + 8 * lane + 4);
            const f32x4 gd0 = *(const f32x4*)(p.gn_dil + 8 * lane), gd1 = *(const f32x4*)(p.gn_dil + 8 * lane + 4);
            u32x4 o1, o2;
            o1[0] = pack2(om[0] * rm * gm0[0], om[1] * rm * gm0[1]); o1[1] = pack2(om[2] * rm * gm0[2], om[3] * rm * gm0[3]);
            o1[2] = pack2(om[4] * rm * gm1[0], om[5] * rm * gm1[1]); o1[3] = pack2(om[6] * rm * gm1[2], om[7] * rm * gm1[3]);
            o2[0] = pack2(od[0] * rd * gd0[0], od[1] * rd * gd0[1]); o2[1] = pack2(od[2] * rd * gd0[2], od[3] * rd * gd0[3]);
            o2[2] = pack2(od[4] * rd * gd1[0], od[5] * rd * gd1[1]); o2[3] = pack2(od[6] * rd * gd1[2], od[7] * rd * gd1[3]);
            bf16_t* MX = (bf16_t*)(ws + OFF_MIXED) + tok * 1024;
            *(u32x4*)(MX + 8 * lane) = o1;
            *(u32x4*)(MX + 512 + 8 * lane) = o2;
        }
    }
}

DI unsigned m512_off(int row, int chunk) { return (unsigned)(row * 512 + ((chunk ^ (row & 15)) << 4)); }
DI unsigned v512_off(int row, int chunk) { return (unsigned)(row * 512 + ((chunk ^ ((row & 3) << 2)) << 4)); }
DI void memattn_unit(const Params& p, char* lds, int b, int h, int tt) {
    char* ws = p.ws;
    const int t = otid(), lane = t & 63, wv = t >> 6, r = lane & 31, hh = lane >> 5;
    const int qg = wv & 1, dh = wv >> 1;
    const bf16_t* QM = (const bf16_t*)(ws + OFF_QM);
    const bf16_t* KVM = (const bf16_t*)(ws + OFF_KVM);
    const size_t tokq = (size_t)b * SEQ_L + tt * 64 + 32 * qg + r;
    bf16x8 qf[16];
#pragma unroll
    for (int s = 0; s < 16; ++s) qf[s] = ld16(QM + tokq * 1024 + h * 256 + 16 * s + 8 * hh);
    f32x16 o[4];
#pragma unroll
    for (int c = 0; c < 4; ++c) o[c] = zero16();
    float m = -INFINITY, l = 0.f;
    const bf16_t* ksrc[4]; const bf16_t* vsrc[4];
#pragma unroll
    for (int i = 0; i < 4; ++i) {
        const int row = 2 * (wv + 4 * i) + (lane >> 5), pch = lane & 31;
        const size_t mrow = (size_t)b * 256 + row;
        ksrc[i] = KVM + mrow * 2048 + h * 256 + 8 * (pch ^ (row & 15));
        vsrc[i] = KVM + mrow * 2048 + 1024 + h * 256 + 8 * (pch ^ ((row & 3) << 2));
    }
    char* ldst = lds + wv * 1024 + lane * 16;
    auto stage_tile = [&](int kt, char* sb) {
#pragma unroll
        for (int i = 0; i < 4; ++i) { GLDS16(ksrc[i] + (size_t)kt * 32 * 2048, sb + i * 4096); GLDS16(vsrc[i] + (size_t)kt * 32 * 2048, sb + 16384 + i * 4096); }
    };
    __syncthreads();
    stage_tile(0, ldst);
    __syncthreads();
#pragma unroll 1
    for (int kt = 0; kt < 8; ++kt) {
        if (kt + 1 < 8) stage_tile(kt + 1, ldst + ((kt + 1) & 1) * 32768);
        const char* sb = lds + (kt & 1) * 32768;
        const unsigned vb = (unsigned)(uintptr_t)(sb + 16384);
        f32x16 s = zero16();
#pragma unroll
        for (int ss = 0; ss < 16; ++ss) s = MFMA32(ld16(sb + m512_off(r, 2 * ss + hh)), qf[ss], s);
        float mx = s[0];
#pragma unroll
        for (int i = 1; i < 16; ++i) mx = fmaxf(mx, s[i]);
        mx = xhalf_max(mx);
        const float mn = fmaxf(m, mx);
        const float alpha = fast_exp2(m - mn);
        float ps = 0.f;
#pragma unroll
        for (int i = 0; i < 16; ++i) { const float e = fast_exp2(s[i] - mn); s[i] = e; ps += e; }
        l = l * alpha + ps;
        m = mn;
#pragma unroll
        for (int c = 0; c < 4; ++c)
#pragma unroll
            for (int i = 0; i < 16; ++i) o[c][i] *= alpha;
        const int blk = (lane >> 4) & 1, qq = (lane & 15) >> 2, pp = lane & 3;
#pragma unroll
        for (int st = 0; st < 2; ++st) {
            const bf16x8 pb = pack_step(s, st);
#pragma unroll
            for (int c = 0; c < 4; ++c) {
                const int ch = 16 * dh + 4 * c + 2 * blk + (pp >> 1);
                const s16x4 lo = tr_read(vb + v512_off(16 * st + 4 * hh + qq, ch) + 8 * (pp & 1));
                const s16x4 hi = tr_read(vb + v512_off(16 * st + 8 + 4 * hh + qq, ch) + 8 * (pp & 1));
                o[c] = MFMA32(cat44(lo, hi), pb, o[c]);
            }
        }
        __syncthreads();
    }
    const float inv = 1.0f / xhalf_sum(l);
    bf16_t* dst = (bf16_t*)(ws + OFF_OM) + tokq * 1024 + h * 256 + 128 * dh + 4 * hh;
#pragma unroll
    for (int c = 0; c < 4; ++c)
#pragma unroll
        for (int g = 0; g < 4; ++g)
            *(u32x2*)(dst + 32 * c + 8 * g) = pack4(o[c][4 * g] * inv, o[c][4 * g + 1] * inv, o[c][4 * g + 2] * inv, o[c][4 * g + 3] * inv);
}

DI void phase_memattn(const Params& p, char* lds) {
    for (int item = vbid(); item < 1024; item += vgrid()) {
        const int b = item >> 8, h = (item >> 6) & 3, tt = item & 63;
        memattn_unit(p, lds, b, h, tt);
    }
}
DI unsigned f2sort(float f) { const unsigned b = __float_as_uint(f); return b ^ ((b & 0x80000000u) ? 0xFFFFFFFFu : 0x80000000u); }
DI float sort2f(unsigned u) { const unsigned b = (u & 0x80000000u) ? (u ^ 0x80000000u) : ~u; return __uint_as_float(b); }
DI void cswap(unsigned& a, unsigned& b) { const unsigned hi = max(a, b), lo = min(a, b); a = hi; b = lo; }

template <int LO, int N> struct BClean {
    template <int M> static DI void run(unsigned (&a)[M]) {
#pragma unroll
        for (int i = 0; i < N / 2; ++i) cswap(a[LO + i], a[LO + i + N / 2]);
        BClean<LO, N / 2>::run(a); BClean<LO + N / 2, N / 2>::run(a);
    }
};
template <int LO> struct BClean<LO, 1> { template <int M> static DI void run(unsigned (&)[M]) {} };
template <int LO, int N> struct BSort {
    template <int M> static DI void run(unsigned (&a)[M]) {
        BSort<LO, N / 2>::run(a); BSort<LO + N / 2, N / 2>::run(a);
#pragma unroll
        for (int i = 0; i < N / 2; ++i) cswap(a[LO + i], a[LO + N - 1 - i]);
        BClean<LO, N / 2>::run(a); BClean<LO + N / 2, N / 2>::run(a);
    }
};
template <int LO> struct BSort<LO, 1> { template <int M> static DI void run(unsigned (&)[M]) {} };
DI void merge_top16(unsigned (&a)[16], const unsigned (&b)[16]) {
#pragma unroll
    for (int i = 0; i < 16; ++i) a[i] = max(a[i], b[15 - i]);
    BClean<0, 16>::run(a);
}

DI void peer_top16(const bf16_t* __restrict__ keys_hp, const bf16_t* __restrict__ pq_row_hp, int r, int hh, unsigned (&top)[16]) {
    bf16x8 qf[8];
#pragma unroll
    for (int s = 0; s < 8; ++s) qf[s] = ld16(pq_row_hp + 16 * s + 8 * hh);
    unsigned cur[16];
#pragma unroll
    for (int kt = 0; kt < 4; ++kt) {
        f32x16 acc = zero16();
#pragma unroll
        for (int s = 0; s < 8; ++s) acc = MFMA32(ld16(keys_hp + (size_t)(32 * kt + r) * 128 + 16 * s + 8 * hh), qf[s], acc);
        unsigned k[16];
#pragma unroll
        for (int i = 0; i < 16; ++i) k[i] = (f2sort(acc[i]) & ~0x7Fu) | (unsigned)(32 * kt + crow(i, hh));
        BSort<0, 16>::run(k);
        if (kt == 0) {
#pragma unroll
            for (int i = 0; i < 16; ++i) cur[i] = k[i];
        } else merge_top16(cur, k);
    }
    unsigned r0[16], r1[16];
#pragma unroll
    for (int i = 0; i < 16; ++i) { auto rr = __builtin_amdgcn_permlane32_swap(cur[i], cur[i], false, false); r0[i] = rr[0]; r1[i] = rr[1]; }
#pragma unroll
    for (int i = 0; i < 16; ++i) top[i] = max(r0[i], r1[15 - i]);
    BClean<0, 16>::run(top);
}

DI void peer_select_unit(const Params& p, char* lds, int mt, int h) {
    char* ws = p.ws;
    const int t = otid(), lane = t & 63, wv = t >> 6, r = lane & 31, hh = lane >> 5;
    const size_t tok = (size_t)mt * 128 + 32 * wv + r;
    const bf16_t* KEYS = (const bf16_t*)(ws + OFF_KEYS);
    const bf16_t* PQ = (const bf16_t*)((const char*)p.out + OUT_PQ);
    unsigned tA[16], tB[16];
    peer_top16(KEYS + (size_t)(2 * h) * 16384, PQ + tok * 2048 + (2 * h) * 128, r, hh, tA);
    peer_top16(KEYS + (size_t)(2 * h + 1) * 16384, PQ + tok * 2048 + (2 * h + 1) * 128, r, hh, tB);
    float fA[16], fB[16];
#pragma unroll
    for (int i = 0; i < 16; ++i) { fA[i] = sort2f(tA[i] & ~0x7Fu); fB[i] = sort2f(tB[i] & ~0x7Fu); }
    unsigned* tab = (unsigned*)lds + wv * 1024;
    __syncthreads();
#pragma unroll
    for (int i = 0; i < 16; ++i) tab[i * 64 + lane] = (tA[i] & 0x7Fu) | ((tB[i] & 0x7Fu) << 16);
    unsigned c[64];
#pragma unroll
    for (int i = 0; i < 64; ++i) c[i] = 0u;
    {
        int n = 0;
#pragma unroll
        for (int a = 0; a < 16; ++a)
#pragma unroll
            for (int b = 0; b < 16; ++b)
                if ((a + 1) * (b + 1) <= 16) { c[n] = (f2sort(fA[a] + fB[b]) & ~0xFFu) | (unsigned)(a * 16 + b); ++n; }
    }
    unsigned g0[16], g1[16], g2[16], g3[16];
#pragma unroll
    for (int i = 0; i < 16; ++i) { g0[i] = c[i]; g1[i] = c[16 + i]; g2[i] = c[32 + i]; g3[i] = c[48 + i]; }
    BSort<0, 16>::run(g0); BSort<0, 16>::run(g1); BSort<0, 16>::run(g2); BSort<0, 16>::run(g3);
    merge_top16(g0, g1); merge_top16(g2, g3); merge_top16(g0, g2);
    float e[16]; float sum = 0.f;
    const float v0 = sort2f(g0[0] & ~0xFFu);
    unsigned ids[16];
#pragma unroll
    for (int i = 0; i < 16; ++i) {
        const float v = sort2f(g0[i] & ~0xFFu);
        e[i] = fast_exp2((v - v0) * LOG2E); sum += e[i];
        const unsigned a = (g0[i] >> 4) & 15u, b = g0[i] & 15u;
        const unsigned ia = tab[a * 64 + lane] & 0x7Fu, ib = (tab[b * 64 + lane] >> 16) & 0x7Fu;
        ids[i] = ia * 128u + ib;
    }
    const float inv = 1.0f / sum;
    if (hh == 0) {
        unsigned short* SID = (unsigned short*)(ws + OFF_SELID) + tok * 128 + h * 16;
        float* SG = (float*)(ws + OFF_SELG) + tok * 128 + h * 16;
        u32x4 w0, w1;
        w0[0] = ids[0] | (ids[1] << 16); w0[1] = ids[2] | (ids[3] << 16); w0[2] = ids[4] | (ids[5] << 16); w0[3] = ids[6] | (ids[7] << 16);
        w1[0] = ids[8] | (ids[9] << 16); w1[1] = ids[10] | (ids[11] << 16); w1[2] = ids[12] | (ids[13] << 16); w1[3] = ids[14] | (ids[15] << 16);
        *(u32x4*)SID = w0; *(u32x4*)(SID + 8) = w1;
#pragma unroll
        for (int q = 0; q < 4; ++q) *(f32x4*)(SG + 4 * q) = (f32x4){e[4 * q] * inv, e[4 * q + 1] * inv, e[4 * q + 2] * inv, e[4 * q + 3] * inv};
    }
}

DI void phase_select(const Params& p, char* lds) {
    for (int item = vbid(); item < 1024; item += vgrid()) peer_select_unit(p, lds, item >> 3, item & 7);
}

DI float gelu_erf(float v) {
    const float av = fabsf(v), t = __builtin_amdgcn_rcpf(av * 0.2316418882f + 1.0f);
    float q = t * 0.5307027145f + (-0.7265760135f); q = q * t + 0.7107068705f; q = q * t + (-0.142248368f); q = q * t + 0.127414796f; q = q * t;
    const float e = __builtin_amdgcn_exp2f((v * v) * (-0.72134752044f));
    const float m = v * (q * e), r = v - m;
    return v < 0.f ? m : r;
}
DI int dppi(int v, const int ctrl) { return v; }
#define DPP_I(v, ctrl) __builtin_amdgcn_update_dpp(0, (v), (ctrl), 0xf, 0xf, true)
DI float ub0(unsigned w) { return (float)(w & 0xFFu); }
DI float ub1(unsigned w) { return (float)((w >> 8) & 0xFFu); }
DI float ub2(unsigned w) { return (float)((w >> 16) & 0xFFu); }
DI float ub3(unsigned w) { return (float)(w >> 24); }

struct GBatch { u32x4 U[4], V[4]; float su[4], sv[4], gate[4]; };

DI void gather_load(GBatch& B, const char* __restrict__ ws, unsigned idpair, f32x2 gpair, int eb, int lane) {
#pragma unroll
    for (int j = 0; j < 4; ++j) {
        const int e = eb + j;
        const unsigned pr = __shfl(idpair, e >> 1);
        const unsigned id = (j & 1) ? (pr >> 16) : (pr & 0xFFFFu);
        const float g0 = __shfl(gpair[0], e >> 1), g1 = __shfl(gpair[1], e >> 1);
        B.gate[j] = (j & 1) ? g1 : g0;
        B.U[j] = ldu4(ws + OFF_UQ + (size_t)id * 1024 + 16 * lane);
        B.V[j] = ldu4(ws + OFF_VQ + (size_t)id * 1024 + 16 * lane);
        B.su[j] = ((const float*)(ws + OFF_SU))[id];
        B.sv[j] = ((const float*)(ws + OFF_SV))[id];
    }
}

DI void gather_compute(const GBatch& B, const unsigned (&qx)[4], float sx, float (&acc)[16], float& csum, int lane) {
    int pd[4];
#pragma unroll
    for (int j = 0; j < 4; ++j) {
        int d = 0;
#pragma unroll
        for (int q = 0; q < 4; ++q) d = __builtin_amdgcn_sdot4((int)B.U[j][q], (int)qx[q], d, false);
        pd[j] = d;
    }
    const bool b0 = lane & 1, b1 = lane & 2;
    const int kA = b0 ? pd[1] : pd[0], kB = b0 ? pd[3] : pd[2], sA = b0 ? pd[0] : pd[1], sB = b0 ? pd[2] : pd[3];
    const int qA = kA + DPP_I(sA, 0xB1), qB = kB + DPP_I(sB, 0xB1);
    const int kp = b1 ? qB : qA, sd = b1 ? qA : qB;
    int tot = kp + DPP_I(sd, 0x4E);
    tot += DPP_I(tot, 0x124);
    tot += DPP_I(tot, 0x128);
    tot += __builtin_amdgcn_ds_swizzle(tot, 0x401F);
    { auto rr = __builtin_amdgcn_permlane32_swap((unsigned)tot, (unsigned)tot, false, false); tot = (int)rr[0] + (int)rr[1]; }
    const int j3 = lane & 3;
    const float su_sel = (j3 == 0) ? B.su[0] : (j3 == 1 ? B.su[1] : (j3 == 2 ? B.su[2] : B.su[3]));
    const float ge = gelu_erf((float)tot * sx * su_sel);
#pragma unroll
    for (int j = 0; j < 4; ++j) {
        const float cf = B.gate[j] * B.sv[j] * __uint_as_float((unsigned)__builtin_amdgcn_readlane((int)__float_as_uint(ge), j));
#pragma unroll
        for (int q = 0; q < 4; ++q) {
            const int w = (int)B.V[j][q];
            const f32x2 lo = __builtin_amdgcn_cvt_pk_f32_fp8(w, false), hi = __builtin_amdgcn_cvt_pk_f32_fp8(w, true);
            acc[4 * q] += cf * lo[0]; acc[4 * q + 1] += cf * lo[1]; acc[4 * q + 2] += cf * hi[0]; acc[4 * q + 3] += cf * hi[1];
        }
    }
}

DI void gather_token(const Params& p, size_t tok, int lane, float* dst_base) {
    char* ws = p.ws;
    const bf16_t* hrow = (const bf16_t*)(ws + OFF_HB) + tok * 1024 + 16 * lane;
    float hv[16];
    {
        const u32x4 w0 = ldu4(hrow), w1 = ldu4(hrow + 8);
#pragma unroll
        for (int e = 0; e < 4; ++e) { hv[2 * e] = bf_lo(w0[e]); hv[2 * e + 1] = bf_hi(w0[e]); hv[8 + 2 * e] = bf_lo(w1[e]); hv[8 + 2 * e + 1] = bf_hi(w1[e]); }
    }
    float rs;
    {
        const float* SS = (const float*)(ws + OFF_SS2) + tok * 16;
        const f32x4 s0 = *(const f32x4*)SS, s1 = *(const f32x4*)(SS + 4), s2 = *(const f32x4*)(SS + 8), s3 = *(const f32x4*)(SS + 12);
        const float tot = (s0[0] + s0[1] + s0[2] + s0[3]) + (s1[0] + s1[1] + s1[2] + s1[3]) + (s2[0] + s2[1] + s2[2] + s2[3]) + (s3[0] + s3[1] + s3[2] + s3[3]);
        rs = rsqrtf(tot * (1.0f / 1024.0f) + 1e-6f);
    }
    float xf[16]; float am = 0.f;
#pragma unroll
    for (int i = 0; i < 4; ++i) {
        const f32x4 g = *(const f32x4*)(p.norm_ffn + 16 * lane + 4 * i);
#pragma unroll
        for (int e = 0; e < 4; ++e) { xf[4 * i + e] = hv[4 * i + e] * rs * g[e]; am = fmaxf(am, fabsf(xf[4 * i + e])); }
    }
#pragma unroll
    for (int o = 32; o; o >>= 1) am = fmaxf(am, __shfl_xor(am, o));
    const float sx = (am > 0.f) ? am * (1.0f / 127.0f) : 1.0f;
    const float isx = 1.0f / sx;
    unsigned qx[4];
#pragma unroll
    for (int i = 0; i < 4; ++i) {
        unsigned w = 0u;
#pragma unroll
        for (int e = 0; e < 4; ++e) w |= ((unsigned)(int)rintf(xf[4 * i + e] * isx) & 0xFFu) << (8 * e);
        qx[i] = w;
    }
    const unsigned idpair = *((const unsigned*)(ws + OFF_SELID) + tok * 64 + lane);
    const f32x2 gpair = *((const f32x2*)(ws + OFF_SELG) + tok * 64 + lane);
    float acc[16]; float csum = 0.f;
#pragma unroll
    for (int i = 0; i < 16; ++i) acc[i] = 0.f;
    GBatch B0, B1;
    gather_load(B0, ws, idpair, gpair, 0, lane);
#pragma unroll 1
    for (int eb = 0; eb < 128; eb += 8) {
        gather_load(B1, ws, idpair, gpair, eb + 4, lane);
        gather_compute(B0, qx, sx, acc, csum, lane);
        if (eb + 8 < 128) gather_load(B0, ws, idpair, gpair, eb + 8, lane);
        gather_compute(B1, qx, sx, acc, csum, lane);
    }
    float ss = 0.f;
#pragma unroll
    for (int i = 0; i < 16; ++i) { acc[i] = acc[i] - 128.0f * csum + hv[i]; ss += acc[i] * acc[i]; }
#pragma unroll
    for (int o = 32; o; o >>= 1) ss += __shfl_xor(ss, o);
    const float rf = rsqrtf(ss * (1.0f / 1024.0f) + 1e-6f);
    float* drow = dst_base + tok * 1024 + 16 * lane;
#pragma unroll
    for (int i = 0; i < 4; ++i) {
        const f32x4 n = *(const f32x4*)(p.norm_final + 16 * lane + 4 * i);
        *(f32x4*)(drow + 4 * i) = (f32x4){acc[4 * i] * rf * n[0], acc[4 * i + 1] * rf * n[1], acc[4 * i + 2] * rf * n[2], acc[4 * i + 3] * rf * n[3]};
    }
}

DI void phase_gather(const Params& p, bool dry = false) {
    const int lane = otid() & 63, wv = otid() >> 6;
    float* dst = dry ? (float*)(p.ws + OFF_A) : p.out;
    for (int item = vbid(); item < T_TOK / 4; item += vgrid()) gather_token(p, (size_t)item * 4 + wv, lane, dst);
}

constexpr size_t GS_SIDS = OFF_A;
constexpr size_t GS_SGS = GS_SIDS + (size_t)T_TOK * 256;
constexpr size_t GS_OFF = GS_SGS + (size_t)T_TOK * 512;
constexpr size_t GS_XQ = GS_OFF + (size_t)T_TOK * 64;
constexpr size_t GS_SX = GS_XQ + (size_t)T_TOK * 1024;
constexpr size_t GS_ACC = GS_SX + (size_t)T_TOK * 4;
static_assert(GS_ACC + (size_t)T_TOK * 2048 <= OFF_A + 69 * MiB, "gather scratch overflows region A");

DI void gs_load(GBatch& B, const char* __restrict__ ws, unsigned myid, float mygate, int j0, int n, int lane) {
#pragma unroll
    for (int j = 0; j < 4; ++j) {
        const int e = __builtin_amdgcn_readfirstlane(j0 + j);
        const bool ok = e < n;
        const int src = ok ? e : 0;
        const unsigned id = (unsigned)__builtin_amdgcn_readlane((int)myid, src);
        const float g = __uint_as_float((unsigned)__builtin_amdgcn_readlane((int)__float_as_uint(mygate), src));
        B.gate[j] = ok ? g : 0.f;
        const char* urow = ws + OFF_UQ + (size_t)id * 1024;
        const char* vrow = ws + OFF_VQ + (size_t)id * 1024;
        B.U[j] = ldu4(urow + 16 * lane);
        B.V[j] = ldu4(vrow + 16 * lane);
        B.su[j] = ((const float*)(ws + OFF_SU))[id];
        B.sv[j] = ((const float*)(ws + OFF_SV))[id];
    }
}

#ifndef GS_NSL
#define GS_NSL 16
#endif
constexpr int NSL = GS_NSL, NSL_SH = (GS_NSL == 8 ? 11 : (GS_NSL == 16 ? 10 : (GS_NSL == 32 ? 9 : 12))), OFFW = 64;
DI void phase_gather_sliced(const Params& p, char* smem) {
    char* ws = p.ws;
    if ((T_TOK / 8) > 8 * (((int)gridDim.x >> 3) * 8) || ((int)gridDim.x & 7)) { phase_gather(p); return; }
    char* lacc = smem + (threadIdx.x >> 6) * 16384 + (threadIdx.x & 63) * 32;
    unsigned short* lids = (unsigned short*)(smem + 131072 + (threadIdx.x >> 6) * 2048);
    unsigned char* loff = (unsigned char*)(smem + 131072 + 16384 + (threadIdx.x >> 6) * (8 * OFFW));
    const int lane = threadIdx.x & 63;
    const int x = (int)blockIdx.x & 7, nW = ((int)gridDim.x >> 3) * 8, lw = ((int)blockIdx.x >> 3) * 8 + (int)(threadIdx.x >> 6);
    const int TPX = T_TOK / 8;
    for (int tl = lw; tl < TPX; tl += nW) {
        const size_t tok = (size_t)x * TPX + tl;
        const bf16_t* hrow = (const bf16_t*)(ws + OFF_HB) + tok * 1024 + 16 * lane;
        float hv[16];
        {
            const u32x4 w0 = ldu4(hrow), w1 = ldu4(hrow + 8);
#pragma unroll
            for (int e = 0; e < 4; ++e) { hv[2 * e] = bf_lo(w0[e]); hv[2 * e + 1] = bf_hi(w0[e]); hv[8 + 2 * e] = bf_lo(w1[e]); hv[8 + 2 * e + 1] = bf_hi(w1[e]); }
        }
        float rs;
        {
            const float* SS = (const float*)(ws + OFF_SS2) + tok * 16;
            const f32x4 s0 = *(const f32x4*)SS, s1 = *(const f32x4*)(SS + 4), s2 = *(const f32x4*)(SS + 8), s3 = *(const f32x4*)(SS + 12);
            const float tot = (s0[0] + s0[1] + s0[2] + s0[3]) + (s1[0] + s1[1] + s1[2] + s1[3]) + (s2[0] + s2[1] + s2[2] + s2[3]) + (s3[0] + s3[1] + s3[2] + s3[3]);
            rs = rsqrtf(tot * (1.0f / 1024.0f) + 1e-6f);
        }
        float xf[16]; float am = 0.f;
#pragma unroll
        for (int i = 0; i < 4; ++i) {
            const f32x4 g = *(const f32x4*)(p.norm_ffn + 16 * lane + 4 * i);
#pragma unroll
            for (int e = 0; e < 4; ++e) { xf[4 * i + e] = hv[4 * i + e] * rs * g[e]; am = fmaxf(am, fabsf(xf[4 * i + e])); }
        }
#pragma unroll
        for (int o = 32; o; o >>= 1) am = fmaxf(am, __shfl_xor(am, o));
        const float sx = (am > 0.f) ? am * (1.0f / 127.0f) : 1.0f;
        const float isx = 1.0f / sx;
        u32x4 qx;
#pragma unroll
        for (int i = 0; i < 4; ++i) {
            unsigned w = 0u;
#pragma unroll
            for (int e = 0; e < 4; ++e) w |= ((unsigned)(int)rintf(xf[4 * i + e] * isx) & 0xFFu) << (8 * e);
            qx[i] = w;
        }
        *(u32x4*)(ws + GS_XQ + tok * 1024 + 16 * lane) = qx;
        if (lane == 0) ((float*)(ws + GS_SX))[tok] = sx;
        const unsigned idpair = *((const unsigned*)(ws + OFF_SELID) + tok * 64 + lane);
        const f32x2 gpair = *((const f32x2*)(ws + OFF_SELG) + tok * 64 + lane);
        const unsigned id0 = idpair & 0xFFFFu, id1 = idpair >> 16;
        const int sl0 = (int)(id0 >> NSL_SH), sl1 = (int)(id1 >> NSL_SH);
        const unsigned long long lt = (1ull << lane) - 1ull;
        int base = 0, pos0 = 0, pos1 = 0, myoff = 0;
#pragma unroll
        for (int s = 0; s < NSL; ++s) {
            const unsigned long long m0 = __ballot(sl0 == s), m1 = __ballot(sl1 == s);
            const int c0 = __popcll(m0), c1 = __popcll(m1);
            if (sl0 == s) pos0 = base + __popcll(m0 & lt);
            if (sl1 == s) pos1 = base + c0 + __popcll(m1 & lt);
            if (lane == s) myoff = base;
            base += c0 + c1;
        }
        if (lane == NSL) myoff = base;
        unsigned short* sid = (unsigned short*)(ws + GS_SIDS) + tok * 128;
        float* sg = (float*)(ws + GS_SGS) + tok * 128;
        sid[pos0] = (unsigned short)id0; sid[pos1] = (unsigned short)id1;
        { const int k = (tl - lw) / nW; lids[k * 128 + pos0] = (unsigned short)id0; lids[k * 128 + pos1] = (unsigned short)id1; if (lane <= NSL) loff[k * OFFW + lane] = (unsigned char)myoff; }
        sg[pos0] = gpair[0]; sg[pos1] = gpair[1];

    }
    __syncthreads();
    const int ntk = (TPX - lw + nW - 1) / nW;
    for (int k = 0; k < ntk; ++k) { *(u32x4*)(lacc + k * 2048) = (u32x4){0u, 0u, 0u, 0u}; *(u32x4*)(lacc + k * 2048 + 16) = (u32x4){0u, 0u, 0u, 0u}; }
    const float* SGS = (const float*)(ws + GS_SGS);
    struct SB { u32x4 U[4], V[4], qx; float su_v, gsv_v, sx; int k; };
#pragma unroll 1
    for (int pass = 0; pass < NSL; ++pass) {
        const int slice = (pass + (NSL / 8) * x) & (NSL - 1);
        int kL = 0, jL = 0, nL = 0, oL = 0;
        float acc[16]; int kC = -1;
#define GS_OPEN(k_) do { oL = __builtin_amdgcn_readfirstlane((int)loff[(k_) * OFFW + slice]); nL = __builtin_amdgcn_readfirstlane((int)loff[(k_) * OFFW + slice + 1]) - oL; jL = 0; } while (0)
#define GS_ADVANCE(ok_) do { if (jL + 4 < nL) { jL += 4; ok_ = true; } else if (kL + 1 >= ntk) ok_ = false; else { ++kL; GS_OPEN(kL); ok_ = true; } } while (0)
#define GS_LOAD(B_, valid_) do { const size_t tok_ = (size_t)x * TPX + lw + (size_t)kL * nW; \
            const int el_ = jL + (lane & 3); const bool okl_ = el_ < nL; const int il_ = oL + (okl_ ? el_ : 0);            \
            const unsigned idv_ = (unsigned)lids[kL * 128 + (il_ & 127)]; \
            const float gv_ = SGS[tok_ * 128 + (il_ & 127)]; \
            B_.su_v = ((const float*)(ws + OFF_SU))[idv_]; B_.gsv_v = (okl_ ? gv_ : 0.f) * ((const float*)(ws + OFF_SV))[idv_]; \
            _Pragma("unroll") for (int j = 0; j < 4; ++j) { const unsigned id_ = (unsigned)__builtin_amdgcn_readlane((int)idv_, j); \
                B_.U[j] = ldu4(ws + OFF_UQ + (size_t)id_ * 1024 + 16 * lane); B_.V[j] = ldu4(ws + OFF_VQ + (size_t)id_ * 1024 + 16 * lane); } \
            B_.qx = ldu4(ws + GS_XQ + tok_ * 1024 + 16 * lane); B_.sx = ((const float*)(ws + GS_SX))[tok_]; B_.k = (valid_) ? kL : -1; } while (0)
#define GS_FLUSH() do { if (kC >= 0) { const size_t tok_ = (size_t)x * TPX + lw + (size_t)kC * nW; \
            if (pass < NSL - 1) { char* la_ = lacc + kC * 2048; u32x4 w0_, w1_; \
                _Pragma("unroll") for (int e = 0; e < 4; ++e) { w0_[e] = pack2(acc[2 * e], acc[2 * e + 1]); w1_[e] = pack2(acc[8 + 2 * e], acc[8 + 2 * e + 1]); } \
                *(u32x4*)la_ = w0_; *(u32x4*)(la_ + 16) = w1_; } \
            else { const bf16_t* hrow_ = (const bf16_t*)(ws + OFF_HB) + tok_ * 1024 + 16 * lane; const u32x4 w0_ = ldu4(hrow_), w1_ = ldu4(hrow_ + 8); float ss_ = 0.f; \
                _Pragma("unroll") for (int e = 0; e < 4; ++e) { acc[2 * e] += bf_lo(w0_[e]); acc[2 * e + 1] += bf_hi(w0_[e]); acc[8 + 2 * e] += bf_lo(w1_[e]); acc[8 + 2 * e + 1] += bf_hi(w1_[e]); } \
                _Pragma("unroll") for (int i = 0; i < 16; ++i) ss_ += acc[i] * acc[i]; \
                _Pragma("unroll") for (int o = 32; o; o >>= 1) ss_ += __shfl_xor(ss_, o); \
                const float rf_ = rsqrtf(ss_ * (1.0f / 1024.0f) + 1e-6f); float* drow_ = p.out + tok_ * 1024 + 16 * lane; \
                _Pragma("unroll") for (int i = 0; i < 4; ++i) { const f32x4 nn_ = *(const f32x4*)(p.norm_final + 16 * lane + 4 * i); \
                    *(f32x4*)(drow_ + 4 * i) = (f32x4){acc[4 * i] * rf_ * nn_[0], acc[4 * i + 1] * rf_ * nn_[1], acc[4 * i + 2] * rf_ * nn_[2], acc[4 * i + 3] * rf_ * nn_[3]}; } } } } while (0)
#define GS_CONSUME(B_) do { if (B_.k >= 0) { \
            if (B_.k != kC) { GS_FLUSH(); kC = B_.k; const char* la_ = lacc + kC * 2048; const u32x4 w0_ = *(const u32x4*)la_, w1_ = *(const u32x4*)(la_ + 16); \
                _Pragma("unroll") for (int e = 0; e < 4; ++e) { acc[2 * e] = bf_lo(w0_[e]); acc[2 * e + 1] = bf_hi(w0_[e]); acc[8 + 2 * e] = bf_lo(w1_[e]); acc[8 + 2 * e + 1] = bf_hi(w1_[e]); } } \
            int pd_[4]; \
            _Pragma("unroll") for (int j = 0; j < 4; ++j) { int d_ = 0; _Pragma("unroll") for (int q = 0; q < 4; ++q) d_ = __builtin_amdgcn_sdot4((int)B_.U[j][q], (int)B_.qx[q], d_, false); pd_[j] = d_; } \
            const bool b0_ = lane & 1, b1_ = lane & 2; \
            const int kA_ = b0_ ? pd_[1] : pd_[0], kB_ = b0_ ? pd_[3] : pd_[2], sA_ = b0_ ? pd_[0] : pd_[1], sB_ = b0_ ? pd_[2] : pd_[3]; \
            const int qA_ = kA_ + DPP_I(sA_, 0xB1), qB_ = kB_ + DPP_I(sB_, 0xB1); \
            const int kp_ = b1_ ? qB_ : qA_, sd_ = b1_ ? qA_ : qB_; \
            int tot_ = kp_ + DPP_I(sd_, 0x4E); tot_ += DPP_I(tot_, 0x124); tot_ += DPP_I(tot_, 0x128); tot_ += __builtin_amdgcn_ds_swizzle(tot_, 0x401F); \
            { auto rr_ = __builtin_amdgcn_permlane32_swap((unsigned)tot_, (unsigned)tot_, false, false); tot_ = (int)rr_[0] + (int)rr_[1]; } \
            const float cfv_ = B_.gsv_v * gelu_erf((float)tot_ * B_.sx * B_.su_v); \
            _Pragma("unroll") for (int j = 0; j < 4; ++j) { const float cf_ = __uint_as_float((unsigned)__builtin_amdgcn_readlane((int)__float_as_uint(cfv_), j)); \
                _Pragma("unroll") for (int q = 0; q < 4; ++q) { const int w_ = (int)B_.V[j][q]; const f32x2 lo_ = __builtin_amdgcn_cvt_pk_f32_fp8(w_, false), hi_ = __builtin_amdgcn_cvt_pk_f32_fp8(w_, true); \
                    acc[4 * q] += cf_ * lo_[0]; acc[4 * q + 1] += cf_ * lo_[1]; acc[4 * q + 2] += cf_ * hi_[0]; acc[4 * q + 3] += cf_ * hi_[1]; } } } } while (0)
        SB S0, S1;
        bool h0, h1;
        GS_OPEN(0);
        GS_LOAD(S0, true);
#pragma unroll 1
        for (;;) {
            GS_ADVANCE(h1); GS_LOAD(S1, h1);
            GS_CONSUME(S0);
            if (!h1) break;
            GS_ADVANCE(h0); GS_LOAD(S0, h0);
            GS_CONSUME(S1);
            if (!h0) break;
        }
        GS_FLUSH();
#undef GS_OPEN
#undef GS_ADVANCE
#undef GS_LOAD
#undef GS_FLUSH
#undef GS_CONSUME
    }
}
constexpr int LDS_BYTES = 131072 + 16384 + 4096;
constexpr int NPHASE = 12;
template <int PH> DI void run_phase(const Params& p, char* smem) {
    char* lds = smem + vhalf() * 65536;
    if (PH == 0) phase_prep(p, lds);
    else if (PH == 1) phase_p1(p, smem);
    else if (PH == 2) phase_p2(p, smem);
    else if (PH == 3) phase_p3(p, lds);
    else if (PH == 4) phase_p35(p, lds);
    else if (PH == 5) phase_resid<false>(p, smem, OFF_WT_OUT, OFF_MIXED, p.x, OFF_SS1);
    else if (PH == 6) phase_rowscale(p, smem, OFF_WT_MQ, 1024, (bf16_t*)(p.ws + OFF_QM), OFF_SS1, 0.0625f * LOG2E);
    else if (PH == 7) phase_memattn(p, lds);
    else if (PH == 8) phase_resid<true>(p, smem, OFF_WT_MO, OFF_OM, p.ws + OFF_HB, OFF_SS2);
    else if (PH == 9) phase_rowscale(p, smem, OFF_WT_PQ, 2048, (bf16_t*)((char*)p.out + OUT_PQ), OFF_SS2, 1.0f);
    else if (PH == 10) phase_select(p, lds);
    else if (PH == 11) phase_gather_sliced(p, smem);
}

template <int PH> __global__ void __launch_bounds__(512, 2) k_phase(Params p) {
    __shared__ __attribute__((aligned(16))) char smem[LDS_BYTES];
    run_phase<PH>(p, smem);
}

static Params make_params(void* const* d_in, void* d_out, void* d_ws) {
    Params p;
    memset(&p, 0, sizeof(p));
    p.x = (const float*)d_in[0]; p.mem = (const float*)d_in[1]; p.norm_mix = (const float*)d_in[2]; p.w_in = (const float*)d_in[3];
    p.q_norm = (const float*)d_in[4]; p.kv_norm = (const float*)d_in[5]; p.w_uq = (const float*)d_in[6]; p.w_ukv = (const float*)d_in[7];
    p.gn_mla = (const float*)d_in[8]; p.gn_dil = (const float*)d_in[9]; p.w_out = (const float*)d_in[10]; p.norm_mem_q = (const float*)d_in[11];
    p.norm_mem_kv = (const float*)d_in[12]; p.w_mem_q = (const float*)d_in[13]; p.w_mem_kv = (const float*)d_in[14]; p.w_mem_o = (const float*)d_in[15];
    p.norm_ffn = (const float*)d_in[16]; p.peer_w_q = (const float*)d_in[17]; p.sub_keys = (const float*)d_in[18]; p.peer_u = (const float*)d_in[19];
    p.peer_v = (const float*)d_in[20]; p.norm_final = (const float*)d_in[21];
    p.out = (float*)d_out; p.ws = (char*)d_ws;
    for (int i = 0; i < 16; ++i) p.inv_freq[i] = 1.0f / powf(10000.0f, (float)(2 * i) / 32.0f);
    return p;
}
__global__ void __launch_bounds__(512, 2) k_mega(Params p) {
    __shared__ __attribute__((aligned(16))) char smem[LDS_BYTES + 16];
    volatile LAS unsigned* st = (volatile LAS unsigned*)(LAS char*)(smem + LDS_BYTES);
    if (threadIdx.x == 0) { st[0] = 0u; st[1] = 0u; st[2] = 0u; st[3] = 0u; }
    __syncthreads();
    const XcdBarrier xb = xcd_barrier_post((unsigned*)(p.ws + OFF_BAR), st);
#define RP(n) run_phase<n>(p, smem); xcd_barrier(xb);
    RP(0) RP(1) RP(2) RP(3) RP(4) RP(5) RP(6) RP(7) RP(8) RP(9) RP(10)
    run_phase<11>(p, smem);
}

extern "C" void kernel_launch(void* const* d_in, const int* in_sizes, int n_in, void* d_out, int out_size, void* d_ws, size_t ws_size,
                              hipStream_t stream) {
    static int grid_blocks = 0;
    if (!grid_blocks) {
        int dev = 0, cus = 0, per_cu = 0;
        (void)hipGetDevice(&dev);
        (void)hipDeviceGetAttribute(&cus, hipDeviceAttributeMultiprocessorCount, dev);
        (void)hipOccupancyMaxActiveBlocksPerMultiprocessor(&per_cu, k_mega, 512, 0);
        if (per_cu > 1) per_cu = 1;
        if (per_cu < 1) per_cu = 1;
        grid_blocks = cus * per_cu;
    }
    Params p = make_params(d_in, d_out, d_ws);
    (void)hipMemsetAsync((char*)d_ws + OFF_BAR, 0, XCD_BAR_WORDS * 4, stream);
    void* args[] = {&p};
    hipError_t e = hipLaunchCooperativeKernel((const void*)k_mega, dim3(grid_blocks), dim3(512), args, 0, stream);
    if (e != hipSuccess) fprintf(stderr, "cooperative launch failed: %s (grid %d)\n", hipGetErrorString(e), grid_blocks);
}
```

```cpp
#include <hip/hip_runtime.h>
#include <hip/hip_cooperative_groups.h>
#include <math.h>
#include <stdint.h>
#include <stdio.h>
#include <string.h>
#define DI __device__ __forceinline__
typedef unsigned short bf16_t;
typedef short bf16x8 __attribute__((ext_vector_type(8)));
typedef short s16x4 __attribute__((ext_vector_type(4)));
typedef float f32x16 __attribute__((ext_vector_type(16)));
typedef float f32x4 __attribute__((ext_vector_type(4)));
typedef float f32x2 __attribute__((ext_vector_type(2)));
typedef unsigned u32x4 __attribute__((ext_vector_type(4)));
typedef unsigned u32x2 __attribute__((ext_vector_type(2)));
typedef __bf16 bf16x2v __attribute__((ext_vector_type(2)));
#define LAS __attribute__((address_space(3)))
#define MFMA32(a, b, c) __builtin_amdgcn_mfma_f32_32x32x16_bf16((a), (b), (c), 0, 0, 0)

constexpr int T_TOK = 16384, SEQ_L = 4096, DM = 1024, INC = 2208;
constexpr float LOG2E = 1.4426950408889634f;

DI int otid() { int t = threadIdx.x & 255; asm volatile("" : "+v"(t)); return t; }
DI int vhalf() { return __builtin_amdgcn_readfirstlane((int)(threadIdx.x >> 8)); }
DI int vbid() { return (int)blockIdx.x * 2 + vhalf(); }
DI int vgrid() { return (int)gridDim.x * 2; }
DI unsigned pack2(float lo, float hi) { f32x2 f = {lo, hi}; return __builtin_bit_cast(unsigned, __builtin_convertvector(f, bf16x2v)); }
DI float bf_lo(unsigned u) { return __uint_as_float(u << 16); }
DI float bf_hi(unsigned u) { return __uint_as_float(u & 0xffff0000u); }
DI float bf2f(bf16_t v) { return __uint_as_float(((unsigned)v) << 16); }
DI int crow(int reg, int hh) { return (reg & 3) + 8 * (reg >> 2) + 4 * hh; }
DI f32x16 zero16() { f32x16 z;
#pragma unroll
    for (int i = 0; i < 16; ++i) z[i] = 0.f; return z; }
DI float xhalf_max(float v) { auto r = __builtin_amdgcn_permlane32_swap(__float_as_uint(v), __float_as_uint(v), false, false); return fmaxf(__uint_as_float(r[0]), __uint_as_float(r[1])); }
DI float xhalf_other(float v, int lane) { auto r = __builtin_amdgcn_permlane32_swap(__float_as_uint(v), __float_as_uint(v), false, false); return __uint_as_float((lane & 32) ? r[0] : r[1]); }
DI float xhalf_sum(float v) { auto r = __builtin_amdgcn_permlane32_swap(__float_as_uint(v), __float_as_uint(v), false, false); return __uint_as_float(r[0]) + __uint_as_float(r[1]); }
DI bf16x8 ld16(const void* p) { return *(const bf16x8*)p; }
DI u32x4 ldu4(const void* p) { return *(const u32x4*)p; }
DI float fast_exp2(float x) { return __builtin_amdgcn_exp2f(x); }
DI bf16x8 pack_step(const f32x16& x, int s) {
    u32x4 p;
    p[0] = pack2(x[8 * s + 0], x[8 * s + 1]); p[1] = pack2(x[8 * s + 2], x[8 * s + 3]);
    p[2] = pack2(x[8 * s + 4], x[8 * s + 5]); p[3] = pack2(x[8 * s + 6], x[8 * s + 7]);
    return __builtin_bit_cast(bf16x8, p);
}
DI s16x4 tr_read_a(unsigned lds_byte_addr) { s16x4 r; asm volatile("ds_read_b64_tr_b16 %0, %1" : "=v"(r) : "v"(lds_byte_addr)); return r; }
template <int OFF> DI s16x4 tr_read_ao(unsigned lds_byte_addr) { s16x4 r; asm volatile("ds_read_b64_tr_b16 %0, %1 offset:%2" : "=v"(r) : "v"(lds_byte_addr), "i"(OFF)); return r; }
#define TR_WAIT() do { asm volatile("s_waitcnt lgkmcnt(0)" ::: "memory"); __builtin_amdgcn_sched_barrier(0); } while (0)
DI s16x4 tr_read(unsigned lds_byte_addr) {
    return __builtin_amdgcn_ds_read_tr16_b64_v4i16((LAS s16x4*)(uintptr_t)lds_byte_addr);
}

constexpr size_t MiB = 1ull << 20;
constexpr size_t OFF_BAR = 0;
constexpr size_t OFF_WT_IN = 65536;
constexpr size_t OFF_WT_UQ = OFF_WT_IN + 2304ull * 1024 * 2;
constexpr size_t OFF_WT_UKV = OFF_WT_UQ + 768ull * 384 * 2;
constexpr size_t OFF_WT_OUT = OFF_WT_UKV + 1024ull * 256 * 2;
constexpr size_t OFF_WT_MQ = OFF_WT_OUT + 1024ull * 1024 * 2;
constexpr size_t OFF_WT_MKV = OFF_WT_MQ + 1024ull * 1024 * 2;
constexpr size_t OFF_WT_MO = OFF_WT_MKV + 2048ull * 1024 * 2;
constexpr size_t OFF_WT_PQ = OFF_WT_MO + 1024ull * 1024 * 2;
constexpr size_t OFF_KEYS = OFF_WT_PQ + 2048ull * 1024 * 2;
constexpr size_t OFF_ROPE = OFF_KEYS + 16ull * 128 * 128 * 2;
constexpr size_t OFF_KR = OFF_ROPE + 2ull * 4096 * 16 * 4;
constexpr size_t OFF_LSE = OFF_KR + (size_t)T_TOK * 32 * 2;
constexpr size_t OFF_SS1 = OFF_LSE + 3ull * T_TOK * 8 * 4;
constexpr size_t OFF_SS2 = OFF_SS1 + (size_t)T_TOK * 16 * 4;
constexpr size_t OFF_MEMN = OFF_SS2 + (size_t)T_TOK * 16 * 4;
constexpr size_t OFF_SMALL_END = OFF_MEMN + 1024ull * 1024 * 2;
static_assert(OFF_SMALL_END <= 28 * MiB, "small region overflow");
constexpr size_t OFF_A = 28 * MiB;
constexpr size_t OFF_PROJ = OFF_A;
constexpr size_t OFF_UQ = 193 * MiB;
constexpr size_t OFF_VQ = 209 * MiB;
constexpr size_t OFF_SU = 243 * MiB;
constexpr size_t OFF_SV = OFF_SU + 65536;
constexpr size_t OUT_ODIL = 0;
constexpr size_t OUT_OMLA = 48 * MiB;
constexpr size_t OUT_PQ = 0;
constexpr size_t OFF_B = 97 * MiB;
constexpr size_t OFF_XN = OFF_B, OFF_QMLA = OFF_B, OFF_MIXED = OFF_B, OFF_QM = OFF_B;
constexpr size_t OFF_C = 129 * MiB;
constexpr size_t OFF_KVMLA = OFF_C, OFF_HB = OFF_C;
constexpr size_t OFF_D = 161 * MiB;
constexpr size_t OFF_OM = OFF_D;
constexpr size_t OFF_SELID = 225 * MiB;
constexpr size_t OFF_SELG = 229 * MiB;
constexpr size_t OFF_KVM = 237 * MiB;
constexpr size_t OFF_SSQ = 241 * MiB;
constexpr size_t WS_NEEDED = 244 * MiB;

struct Params {
    const float* x; const float* mem; const float* norm_mix; const float* w_in; const float* q_norm; const float* kv_norm;
    const float* w_uq; const float* w_ukv; const float* gn_mla; const float* gn_dil; const float* w_out; const float* norm_mem_q;
    const float* norm_mem_kv; const float* w_mem_q; const float* w_mem_kv; const float* w_mem_o; const float* norm_ffn;
    const float* peer_w_q; const float* sub_keys; const float* peer_u; const float* peer_v; const float* norm_final;
    float* out; char* ws;
    float inv_freq[16];
    int prof; int pad_;
};
#define XB_TMO      128
#define XB_XCNT(j)  (256  + 64 * (j))
#define XB_XSUB(j)  (1280 + 64 * (j))
#define XB_XGEN(j)  (2304 + 64 * (j))
#define XB_TOP      3328
#define XB_TOPGEN   3392
#define XCD_BAR_WORDS 3456
#define XB_SPIN_CAP (1u << 20)
DI unsigned xb_ld(unsigned* p) { return __hip_atomic_load(p, __ATOMIC_RELAXED, __HIP_MEMORY_SCOPE_AGENT); }
DI unsigned xb_add(unsigned* p, unsigned v) { return __hip_atomic_fetch_add(p, v, __ATOMIC_RELAXED, __HIP_MEMORY_SCOPE_AGENT); }
DI unsigned xb_xcc_id() { return (unsigned)__builtin_amdgcn_s_getreg((3 << 11) | 20) & 0xFu; }
#define XB_SPIN(cond, bar) do { unsigned _sp = 0; while (cond) { __builtin_amdgcn_s_sleep(1); \
    if ((++_sp & 255u) == 0u) { if (xb_ld(&(bar)[XB_TMO])) break; if (_sp > XB_SPIN_CAP) { atomicAdd(&(bar)[XB_TMO], 1u); break; } } } } while (0)
struct XcdBarrier { unsigned* bar; unsigned x; volatile LAS unsigned* st; };
DI XcdBarrier xcd_barrier_post(unsigned* bar, volatile LAS unsigned* st) {
    XcdBarrier b; b.bar = bar; b.x = xb_xcc_id(); b.st = st;
    if (threadIdx.x == 0) (void)xb_add(&bar[XB_XCNT(b.x)], 1u);
    return b;
}
DI void xcd_barrier_complete(unsigned* bar, unsigned x, unsigned& nloc, unsigned& nx) {
    const unsigned G = gridDim.x * gridDim.y * gridDim.z;
    unsigned sum, cnt, mine, sp = 0u;
    for (;;) {
        sum = 0u; cnt = 0u; mine = 0u;
#pragma unroll
        for (unsigned j = 0; j < 16; ++j) { const unsigned c = xb_ld(&bar[XB_XCNT(j)]); sum += c; cnt += (c > 0u) ? 1u : 0u; mine = (j == x) ? c : mine; }
        if (sum == G) break;
        __builtin_amdgcn_s_sleep(1);
        if ((++sp & 255u) == 0u) { if (xb_ld(&bar[XB_TMO])) break; if (sp > XB_SPIN_CAP) { atomicAdd(&bar[XB_TMO], 1u); break; } }
    }
    nloc = mine > 0u ? mine : 1u; nx = cnt > 0u ? cnt : 1u;
}
DI void xcd_barrier(const XcdBarrier& b) {
    asm volatile("s_waitcnt vmcnt(0)" ::: "memory");
    __syncthreads();
    if (threadIdx.x == 0) {
        unsigned* bar = b.bar;
        __builtin_amdgcn_s_waitcnt(0);
        unsigned nloc = b.st[0], nx = b.st[1];
        if (nloc == 0u) { xcd_barrier_complete(bar, b.x, nloc, nx); b.st[0] = nloc; b.st[1] = nx; }
        const unsigned old = xb_add(&bar[XB_XSUB(b.x)], 1u);
        const unsigned gen = old / nloc;
        if (old + 1u == (gen + 1u) * nloc) {
            __builtin_amdgcn_fence(__ATOMIC_RELEASE, "agent");
            asm volatile("s_waitcnt vmcnt(0)" ::: "memory");
            const unsigned og = xb_add(&bar[XB_TOP], 1u);
            const unsigned tg = og / nx;
            if (og + 1u == (tg + 1u) * nx) xb_add(&bar[XB_TOPGEN], 1u);
            else XB_SPIN(xb_ld(&bar[XB_TOPGEN]) == tg, bar);
            __builtin_amdgcn_fence(__ATOMIC_ACQUIRE, "agent");
            xb_add(&bar[XB_XGEN(b.x)], 1u);
            asm volatile("s_waitcnt vmcnt(0)" ::: "memory");
        } else {
            XB_SPIN(xb_ld(&bar[XB_XGEN(b.x)]) == gen, bar);
            __builtin_amdgcn_fence(__ATOMIC_ACQUIRE, "agent");
            asm volatile("s_waitcnt vmcnt(0)" ::: "memory");
        }
    }
    __syncthreads();
}
DI void transpose_tile(const float* __restrict__ W, int K, int N, const float* __restrict__ g, bf16_t* __restrict__ Wt, int kt, int nt, char* lds, bool valid) {
    float* sm = (float*)lds;
    const int t = otid();
    const int k0 = kt * 64, n0 = nt * 64;
    __syncthreads();
#pragma unroll
    for (int i = 0; i < 16; ++i) {
        const int id = t + 256 * i, k = id >> 6, n = id & 63;
        float v = 0.f;
        if (valid && n0 + n < N) { v = W[(size_t)(k0 + k) * N + n0 + n]; if (g) v *= g[k0 + k]; }
        sm[k * 65 + n] = v;
    }
    __syncthreads();
    const int n = t >> 2, kc = (t & 3) * 16;
    u32x4 o0, o1;
    o0[0] = pack2(sm[(kc + 0) * 65 + n], sm[(kc + 1) * 65 + n]); o0[1] = pack2(sm[(kc + 2) * 65 + n], sm[(kc + 3) * 65 + n]);
    o0[2] = pack2(sm[(kc + 4) * 65 + n], sm[(kc + 5) * 65 + n]); o0[3] = pack2(sm[(kc + 6) * 65 + n], sm[(kc + 7) * 65 + n]);
    o1[0] = pack2(sm[(kc + 8) * 65 + n], sm[(kc + 9) * 65 + n]); o1[1] = pack2(sm[(kc + 10) * 65 + n], sm[(kc + 11) * 65 + n]);
    o1[2] = pack2(sm[(kc + 12) * 65 + n], sm[(kc + 13) * 65 + n]); o1[3] = pack2(sm[(kc + 14) * 65 + n], sm[(kc + 15) * 65 + n]);
    bf16_t* dst = Wt + (size_t)(n0 + n) * K + k0 + kc;
    if (valid) { *(u32x4*)dst = o0; *(u32x4*)(dst + 8) = o1; }
}

DI void rmsnorm_row_bf16(const float* __restrict__ in, const float* __restrict__ g, bf16_t* __restrict__ out, int lane) {
    f32x4 v[4]; float ss = 0.f;
#pragma unroll
    for (int i = 0; i < 4; ++i) { v[i] = *(const f32x4*)(in + 4 * lane + 256 * i); ss += v[i][0] * v[i][0] + v[i][1] * v[i][1] + v[i][2] * v[i][2] + v[i][3] * v[i][3]; }
#pragma unroll
    for (int o = 32; o; o >>= 1) ss += __shfl_xor(ss, o);
    const float rs = rsqrtf(ss * (1.0f / 1024.0f) + 1e-6f);
#pragma unroll
    for (int i = 0; i < 4; ++i) {
        const f32x4 gg = *(const f32x4*)(g + 4 * lane + 256 * i);
        u32x2 o; o[0] = pack2(v[i][0] * rs * gg[0], v[i][1] * rs * gg[1]); o[1] = pack2(v[i][2] * rs * gg[2], v[i][3] * rs * gg[3]);
        *(u32x2*)(out + 4 * lane + 256 * i) = o;
    }
}

struct TrJob { const float* W; const float* g; size_t off; int K, N, Npad; };

DI void phase_prep(const Params& p, char* lds) {
    char* ws = p.ws;
    const int t = otid(), lane = t & 63, wv = t >> 6;
    const int c0 = 576, c1 = c0 + 72, c2 = c1 + 64, c3 = c2 + 256, c4 = c3 + 256, c5 = c4 + 512, c6 = c5 + 256, c7 = c6 + 512;
    const int nrow = (T_TOK + 1024) / 4;
    const int nkeys = 128, nrope = 256;
    const int total = c7 + nrow + nkeys + nrope;
    for (int k = 0; k < (c7 + vgrid() - 1) / vgrid(); ++k) {
        const int raw = vbid() + k * vgrid();
        const bool valid = raw < c7;
        const int item = valid ? raw : 0;
        const float* W; const float* g; size_t off; int K, N, Npad, local;
        if (item < c0)      { W = p.w_in;     g = nullptr;      off = OFF_WT_IN;  K = 1024; N = 2208; Npad = 2304; local = item; }
        else if (item < c1) { W = p.w_uq;     g = p.q_norm;     off = OFF_WT_UQ;  K = 384;  N = 768;  Npad = 768;  local = item - c0; }
        else if (item < c2) { W = p.w_ukv;    g = p.kv_norm;    off = OFF_WT_UKV; K = 256;  N = 1024; Npad = 1024; local = item - c1; }
        else if (item < c3) { W = p.w_out;    g = nullptr;      off = OFF_WT_OUT; K = 1024; N = 1024; Npad = 1024; local = item - c2; }
        else if (item < c4) { W = p.w_mem_q;  g = p.norm_mem_q; off = OFF_WT_MQ;  K = 1024; N = 1024; Npad = 1024; local = item - c3; }
        else if (item < c5) { W = p.w_mem_kv; g = nullptr;      off = OFF_WT_MKV; K = 1024; N = 2048; Npad = 2048; local = item - c4; }
        else if (item < c6) { W = p.w_mem_o;  g = nullptr;      off = OFF_WT_MO;  K = 1024; N = 1024; Npad = 1024; local = item - c5; }
        else                { W = p.peer_w_q; g = p.norm_ffn;   off = OFF_WT_PQ;  K = 1024; N = 2048; Npad = 2048; local = item - c6; }
        const int ntn = Npad / 64;
        transpose_tile(W, K, N, g, (bf16_t*)(ws + off), local / ntn, local % ntn, lds, valid);
    }
    for (int item = c7 + vbid(); item < total; item += vgrid()) {
        if (item < c7 + nrow) {
            const int row = (item - c7) * 4 + wv;
            if (row < T_TOK) rmsnorm_row_bf16(p.x + (size_t)row * 1024, p.norm_mix, (bf16_t*)(ws + OFF_XN) + (size_t)row * 1024, lane);
            else rmsnorm_row_bf16(p.mem + (size_t)(row - T_TOK) * 1024, p.norm_mem_kv, (bf16_t*)(ws + OFF_MEMN) + (size_t)(row - T_TOK) * 1024, lane);
        } else if (item < c7 + nrow + nkeys) {
            const int idx = ((item - c7 - nrow) * 256 + t) * 8;
            const f32x4 a = *(const f32x4*)(p.sub_keys + idx), b = *(const f32x4*)(p.sub_keys + idx + 4);
            u32x4 o; o[0] = pack2(a[0], a[1]); o[1] = pack2(a[2], a[3]); o[2] = pack2(b[0], b[1]); o[3] = pack2(b[2], b[3]);
            *(u32x4*)((bf16_t*)(ws + OFF_KEYS) + idx) = o;
        } else {
            const int idx = (item - c7 - nrow - nkeys) * 256 + t;
            const int s = idx >> 4, i = idx & 15;
            const float ang = (float)s * p.inv_freq[i];
            const double a = (double)ang;
            const double twopi = 6.283185307179586476925;
            const float rf = (float)(a - twopi * rint(a / twopi));
            float* cs = (float*)(ws + OFF_ROPE);
            cs[idx] = cosf(rf); cs[65536 + idx] = sinf(rf);
        }
    }
}
namespace pg8 {
#define PG8_LAS __attribute__((address_space(3)))
typedef unsigned short bf16_t;
typedef short bf16x8 __attribute__((ext_vector_type(8)));
typedef float f32x4 __attribute__((ext_vector_type(4)));
typedef unsigned u32x4 __attribute__((ext_vector_type(4)));
constexpr int BM = 256, BK = 64, HALF = 128, HTB = HALF * BK * 2  , STAGE_BYTES = 8 * HTB, NXCD = 8, WGM = 8;

__host__ __device__ __forceinline__ int lds_byte(int r, int c) { const int st = (r >> 4) * 2 + (c >> 5), rr = r & 15, cc = c & 31, ob = rr * 64 + cc * 2; return st * 1024 + (ob ^ (((ob >> 9) & 1) << 5)); }
__host__ __device__ __forceinline__ void stage_rc(int b, int& R, int& C) { const int st = b / 1024, sb = b % 1024, swz = sb ^ (((sb >> 9) & 1) << 5); R = (st >> 1) * 16 + swz / 64; C = (st & 1) * 32 + (swz % 64) / 2; }
__host__ __device__ __forceinline__ int perm32(int rho) { const int n = rho >> 4, i = rho & 15; return 8 * (i >> 2) + 4 * n + (i & 3); }

struct Unit { int pm, pn; };
struct Gemm { const bf16_t* A; const bf16_t* Bt; int M, N, K, lda; };

struct StaticOrder {
    int nM, nN, nwg, G, c;
    __host__ __device__ void init(int M, int N, int G_, int c_) { nM = M / BM; nN = N / BM; nwg = nM * nN; G = G_; c = c_; }
    __host__ __device__ bool next(int i, Unit& u) const {
        const long L = (long)i * G + c; if (L >= nwg) return false;
        int wgid = (int)L; { const int q = nwg / NXCD, r = nwg % NXCD, xcd = wgid % NXCD, off = wgid / NXCD; wgid = (xcd < r ? xcd * (q + 1) : r * (q + 1) + (xcd - r) * q) + off; }
        const int nig = WGM * nN, gid = wgid / nig, fm = gid * WGM, gsz = (nM - fm) < WGM ? (nM - fm) : WGM;
        u.pm = fm + ((wgid % nig) % gsz); u.pn = (wgid % nig) / gsz; return true;
    }
    __device__ __forceinline__ void a_ready(const Unit&) const {}
    __device__ __forceinline__ void done(const Unit&) const {}
};

template <class Epi, class Sched, bool ALIGN_EPI = false, bool SP2 = false>
__device__ __forceinline__ void gemm_phase(PG8_LAS unsigned char* lds, const Gemm g, const Sched& S, const Epi& E) {
    int tid_ = threadIdx.x; asm volatile("" : "+v"(tid_));
    const int tid = tid_, wid = __builtin_amdgcn_readfirstlane(tid >> 6), lane = tid & 63, wr = wid >> 2, wc = wid & 3, fr = lane & 15, fq = lane >> 4;
    const int K = g.K, nt = K / BK, lda = g.lda;
    unsigned voffA[2], voffB[2];
#pragma unroll
    for (int i = 0; i < 2; ++i) { int R, C; stage_rc(tid * 16 + i * 8192, R, C); const int Rb = Epi::PERM ? ((R & ~31) + perm32(R & 31)) : R;
        voffA[i] = (unsigned)(R * lda + C) * 2u; voffB[i] = (unsigned)(Rb * K + C) * 2u; }
    const size_t kstep = (size_t)(BK * 2);
    const size_t hstepB = (size_t)HALF * K * 2, hstepA = (size_t)HALF * lda * 2;
    const size_t tstepB = 2 * hstepB, tstepA = 2 * hstepA;
    const unsigned ldsw = (unsigned)wid * 1024u;
    const int aoff = lds_byte(wr * 64 + fr, fq * 8), boff = lds_byte(wc * 32 + fr, fq * 8);
#define PG8_SA(b, h) (((b) * 2 + (h)) * HTB)
#define PG8_SB(b, h) ((4 + (b) * 2 + (h)) * HTB)
#define PG8_STAGE(bufoff, gbase, voff) do { _Pragma("unroll") for (int _i = 0; _i < 2; ++_i) \
        __builtin_amdgcn_global_load_lds((const unsigned*)((const char*)(gbase) + (voff)[_i]), (PG8_LAS unsigned*)(lds + (bufoff) + ldsw + _i * 8192), 16, 0, 0); } while (0)
#define PG8_LDA(dst, b, h) do { _Pragma("unroll") for (int m = 0; m < 4; ++m) _Pragma("unroll") for (int k = 0; k < 2; ++k) dst[m][k] = *(const PG8_LAS bf16x8*)(lds + PG8_SA(b, h) + aoff + m * 2048 + k * 1024); } while (0)
#define PG8_LDB(dst, b, h) do { _Pragma("unroll") for (int n = 0; n < 2; ++n) _Pragma("unroll") for (int k = 0; k < 2; ++k) dst[n][k] = *(const PG8_LAS bf16x8*)(lds + PG8_SB(b, h) + boff + n * 2048 + k * 1024); } while (0)
#define PG8_MMA(ai, bj, At, Bt) do { __builtin_amdgcn_s_setprio(1); _Pragma("unroll") for (int m = 0; m < 4; ++m) _Pragma("unroll") for (int n = 0; n < 2; ++n) _Pragma("unroll") for (int k = 0; k < 2; ++k) \
        acc[ai][bj][m][n] = __builtin_amdgcn_mfma_f32_16x16x32_bf16(Bt[n][k], At[m][k], acc[ai][bj][m][n], 0, 0, 0); __builtin_amdgcn_s_setprio(0); } while (0)
#define PG8_WAIT_V(n) asm volatile("s_waitcnt vmcnt(" #n ")" ::: "memory")
#define PG8_WAIT_L(n) asm volatile("s_waitcnt lgkmcnt(" #n ")" ::: "memory")
#define PG8_BAR __builtin_amdgcn_s_barrier()
#define PG8_SCHED __builtin_amdgcn_sched_barrier(0)
    Unit cur, nxt; int ui = 0;
    if (!S.next(0, cur)) return;
    f32x4 acc[2][2][4][2];
#pragma unroll
    for (int a = 0; a < 2; ++a)
#pragma unroll
        for (int b = 0; b < 2; ++b)
#pragma unroll
            for (int m = 0; m < 4; ++m)
#pragma unroll
                for (int n = 0; n < 2; ++n) acc[a][b][m][n] = (f32x4){0.f, 0.f, 0.f, 0.f};
    bf16x8 At[4][2], B0[2][2], B1[2][2];
    const char* cA = (const char*)g.A + (size_t)cur.pm * tstepA; const char* cB = (const char*)g.Bt + (size_t)cur.pn * tstepB;
    S.a_ready(cur);
    if constexpr (SP2) {
        PG8_STAGE(PG8_SB(0, 0), cB, voffB); PG8_STAGE(PG8_SB(0, 1), cB + hstepB, voffB); PG8_STAGE(PG8_SA(0, 0), cA, voffA); PG8_STAGE(PG8_SA(0, 1), cA + hstepA, voffA);
        if (wr == 1) PG8_BAR;
        PG8_WAIT_V(2); PG8_BAR;
        PG8_STAGE(PG8_SB(1, 0), cB + kstep, voffB); PG8_STAGE(PG8_SA(1, 0), cA + kstep, voffA); PG8_STAGE(PG8_SB(1, 1), cB + hstepB + kstep, voffB);
        PG8_WAIT_V(6); PG8_BAR;
    } else {
        PG8_STAGE(PG8_SB(0, 0), cB, voffB); PG8_STAGE(PG8_SA(0, 0), cA, voffA); PG8_STAGE(PG8_SB(0, 1), cB + hstepB, voffB); PG8_STAGE(PG8_SA(0, 1), cA + hstepA, voffA);
        if (wr == 1) PG8_BAR;
        PG8_WAIT_V(4); PG8_BAR;
        PG8_STAGE(PG8_SB(1, 0), cB + kstep, voffB); PG8_STAGE(PG8_SA(1, 0), cA + kstep, voffA); PG8_STAGE(PG8_SB(1, 1), cB + hstepB + kstep, voffB);
        PG8_WAIT_V(6); PG8_BAR;
    }
    for (;;) {
        const bool has_next = S.next(ui + 1, nxt);
        const char* nA = has_next ? (const char*)g.A + (size_t)nxt.pm * tstepA : cA; const char* nB = has_next ? (const char*)g.Bt + (size_t)nxt.pn * tstepB : cB;
#pragma unroll 1
        for (int t = 0; t < nt; t += 2) {
            const bool last = (t == nt - 2);
            const char* a1 = cA + (size_t)(t + 1) * kstep;
            const char* a2 = last ? nA : cA + (size_t)(t + 2) * kstep; const char* b2 = last ? nB : cB + (size_t)(t + 2) * kstep;
            const char* a3 = a2 + kstep; const char* b3 = b2 + kstep;
            if (last && has_next) S.a_ready(nxt);
            if constexpr (SP2) {
            PG8_LDB(B0, 0, 0); PG8_LDB(B1, 0, 1); PG8_SCHED; PG8_LDA(At, 0, 0); PG8_STAGE(PG8_SA(1, 1), a1 + hstepA, voffA);
            PG8_WAIT_V(8); PG8_WAIT_L(0); PG8_BAR; PG8_MMA(0, 0, At, B0); PG8_MMA(0, 1, At, B1); PG8_BAR; PG8_SCHED;
            PG8_LDA(At, 0, 1); PG8_STAGE(PG8_SB(0, 0), b2, voffB); PG8_STAGE(PG8_SB(0, 1), b2 + hstepB, voffB); PG8_STAGE(PG8_SA(0, 0), a2, voffA);
            PG8_WAIT_V(8); PG8_WAIT_L(0); PG8_BAR; PG8_MMA(1, 0, At, B0); PG8_MMA(1, 1, At, B1); PG8_BAR; PG8_SCHED;
            PG8_LDB(B0, 1, 0); PG8_LDB(B1, 1, 1); PG8_SCHED; PG8_LDA(At, 1, 0); PG8_STAGE(PG8_SA(0, 1), a2 + hstepA, voffA);
            PG8_WAIT_V(8); PG8_WAIT_L(0); PG8_BAR; PG8_MMA(0, 0, At, B0); PG8_MMA(0, 1, At, B1); PG8_BAR; PG8_SCHED;
            PG8_LDA(At, 1, 1); PG8_STAGE(PG8_SB(1, 0), b3, voffB); PG8_STAGE(PG8_SB(1, 1), b3 + hstepB, voffB); PG8_STAGE(PG8_SA(1, 0), a3, voffA);
            PG8_WAIT_V(8); PG8_WAIT_L(0); PG8_BAR; PG8_MMA(1, 0, At, B0); PG8_MMA(1, 1, At, B1); PG8_BAR; PG8_SCHED;
            } else {
            PG8_LDB(B0, 0, 0); PG8_SCHED; PG8_LDA(At, 0, 0); PG8_STAGE(PG8_SA(1, 1), a1 + hstepA, voffA);
            PG8_WAIT_L(8); PG8_BAR; PG8_WAIT_L(0); PG8_MMA(0, 0, At, B0); PG8_BAR; PG8_SCHED;
            PG8_LDB(B1, 0, 1); PG8_STAGE(PG8_SB(0, 0), b2, voffB);
            PG8_BAR; PG8_WAIT_L(0); PG8_MMA(0, 1, At, B1); PG8_BAR;
            PG8_LDA(At, 0, 1); PG8_STAGE(PG8_SA(0, 0), a2, voffA);
            PG8_BAR; PG8_WAIT_L(0); PG8_MMA(1, 0, At, B0); PG8_BAR; PG8_SCHED;
            PG8_STAGE(PG8_SB(0, 1), b2 + hstepB, voffB);
            PG8_WAIT_V(6); PG8_BAR; PG8_MMA(1, 1, At, B1); PG8_BAR;
            PG8_LDB(B0, 1, 0); PG8_SCHED; PG8_LDA(At, 1, 0); PG8_STAGE(PG8_SA(0, 1), a2 + hstepA, voffA);
            PG8_WAIT_L(8); PG8_BAR; PG8_WAIT_L(0); PG8_MMA(0, 0, At, B0); PG8_BAR; PG8_SCHED;
            PG8_LDB(B1, 1, 1); PG8_STAGE(PG8_SB(1, 0), b3, voffB);
            PG8_BAR; PG8_WAIT_L(0); PG8_MMA(0, 1, At, B1); PG8_BAR;
            PG8_LDA(At, 1, 1); PG8_STAGE(PG8_SA(1, 0), a3, voffA);
            PG8_BAR; PG8_WAIT_L(0); PG8_MMA(1, 0, At, B0); PG8_BAR; PG8_SCHED;
            PG8_STAGE(PG8_SB(1, 1), b3 + hstepB, voffB);
            PG8_WAIT_V(6); PG8_BAR; PG8_MMA(1, 1, At, B1); PG8_BAR;
            }
        }
        if constexpr (ALIGN_EPI) { if (wr == 0) PG8_BAR; }
        if constexpr (!Epi::AFTER_DRAIN) { E(acc, cur, wr, wc, fr, fq); S.done(cur); }
        if (!has_next) break;
#pragma unroll
        for (int a = 0; a < 2; ++a)
#pragma unroll
            for (int b = 0; b < 2; ++b)
#pragma unroll
                for (int m = 0; m < 4; ++m)
#pragma unroll
                    for (int n = 0; n < 2; ++n) acc[a][b][m][n] = (f32x4){0.f, 0.f, 0.f, 0.f};
        cur = nxt; cA = nA; cB = nB; ++ui;
        if constexpr (ALIGN_EPI) { if (wr == 1) PG8_BAR; }
    }
    PG8_WAIT_V(0);
    if constexpr (!ALIGN_EPI) { if (wr == 0) PG8_BAR; }
    PG8_BAR;
    if constexpr (Epi::AFTER_DRAIN) { E.fused(acc, cur, wr, wc, fr, fq, lds, wid, lane); S.done(cur); }
#undef PG8_SA
#undef PG8_SB
#undef PG8_STAGE
#undef PG8_LDA
#undef PG8_LDB
#undef PG8_MMA
#undef PG8_WAIT_V
#undef PG8_WAIT_L
#undef PG8_BAR
#undef PG8_SCHED
}
}
DI unsigned sw_off(int row, int chunk) { return (unsigned)(row * 128 + ((chunk ^ ((row >> 1) & 7)) << 4)); }
#define GLDS16(gsrc, ldst) __builtin_amdgcn_global_load_lds((const unsigned*)(gsrc), (unsigned*)(ldst), 16, 0, 0)
DI u32x2 pack4(float a, float b, float c, float d) { u32x2 o; o[0] = pack2(a, b); o[1] = pack2(c, d); return o; }
#define EPI_ARGS const f32x4 (&acc)[2][2][4][2], const pg8::Unit& u, int wr, int wc, int fr, int fq
DI float xq_sum(float v) {
    v += __uint_as_float((unsigned)__builtin_amdgcn_ds_swizzle((int)__float_as_uint(v), 0x401F));
    return xhalf_sum(v);
}
DI u32x4 pack8(const float (&v)[8], float sc) {
    u32x4 o; o[0] = pack2(v[0] * sc, v[1] * sc); o[1] = pack2(v[2] * sc, v[3] * sc); o[2] = pack2(v[4] * sc, v[5] * sc); o[3] = pack2(v[6] * sc, v[7] * sc); return o;
}
DI void rope8(const float (&v)[8], float sc, const float* __restrict__ cs, int pos, int fq, int lane, bf16_t* dst32  ) {
    const int i0 = 8 * (fq & 1);
    const f32x4 c0 = *(const f32x4*)(cs + pos * 16 + i0), c1 = *(const f32x4*)(cs + pos * 16 + i0 + 4);
    const f32x4 s0 = *(const f32x4*)(cs + 65536 + pos * 16 + i0), s1 = *(const f32x4*)(cs + 65536 + pos * 16 + i0 + 4);
    const float sg = (fq < 2) ? -1.0f : 1.0f;
    float o[8];
#pragma unroll
    for (int e = 0; e < 8; ++e) {
        const float own = v[e] * sc, oth = xhalf_other(own, lane);
        const float c = (e < 4) ? c0[e & 3] : c1[e & 3], s = (e < 4) ? s0[e & 3] : s1[e & 3];
        o[e] = own * c + sg * oth * s;
    }
    *(u32x4*)(dst32 + 8 * fq) = pack8(o, 1.0f);
}
#define EPI_LOAD8(v, ai, bj, m) float v[8]; { const f32x4 x0_ = acc[ai][bj][m][0], x1_ = acc[ai][bj][m][1]; v[0] = x0_[0]; v[1] = x0_[1]; v[2] = x0_[2]; v[3] = x0_[3]; v[4] = x1_[0]; v[5] = x1_[1]; v[6] = x1_[2]; v[7] = x1_[3]; }

struct EpiPlain8 {
    static constexpr bool PERM = true, AFTER_DRAIN = false;
    bf16_t* out; int ld;
    DI void operator()(EPI_ARGS) const {
#pragma unroll
        for (int ai = 0; ai < 2; ++ai)
#pragma unroll
            for (int m = 0; m < 4; ++m) {
                int fr_ = fr; asm volatile("" : "+v"(fr_));
                const size_t tok = (size_t)u.pm * 256 + ai * 128 + wr * 64 + m * 16 + fr_;
#pragma unroll
                for (int bj = 0; bj < 2; ++bj) { EPI_LOAD8(v, ai, bj, m); *(u32x4*)(out + tok * ld + u.pn * 256 + bj * 128 + wc * 32 + 8 * fq) = pack8(v, 1.0f); }
            }
    }
};

struct EpiProj8 {
    static constexpr bool PERM = true, AFTER_DRAIN = false;
    bf16_t* proj; bf16_t* kr; const float* cs; float* ssq;
    DI void operator()(EPI_ARGS) const {
        const int lane = fr + 16 * fq;
#pragma unroll
        for (int bj = 0; bj < 2; ++bj) {
            const int cg = u.pn * 256 + bj * 128 + wc * 32;
            if (cg >= INC) continue;
            const int g32 = cg >> 5;
            const float sc = (cg >= 672 && cg < 1184) ? 0.125f * LOG2E : 1.0f;
#pragma unroll
            for (int ai = 0; ai < 2; ++ai)
#pragma unroll
                for (int m = 0; m < 4; ++m) {
                    int fr_ = fr; asm volatile("" : "+v"(fr_));
                const size_t tok = (size_t)u.pm * 256 + ai * 128 + wr * 64 + m * 16 + fr_;
                    EPI_LOAD8(v, ai, bj, m);
                    if (g32 < 20) {
                        float ss = 0.f;
#pragma unroll
                        for (int e = 0; e < 8; ++e) ss += v[e] * v[e];
                        ss = xq_sum(ss);
                        if (fq == 0) ssq[tok * 24 + g32] = ss;
                    }
                    if (cg == 640) rope8(v, 1.0f, cs, (int)(tok & (SEQ_L - 1)), fq, lane, kr + tok * 32);
                    else *(u32x4*)(proj + tok * INC + cg + 8 * fq) = pack8(v, sc);
                }
        }
    }
};

struct EpiUpQ8 {
    static constexpr bool PERM = true, AFTER_DRAIN = false;
    bf16_t* q; const float* cs; const float* ssq;
    DI void operator()(EPI_ARGS) const {
        const int lane = fr + 16 * fq;
        const float qs = 0.10206207261596575f * LOG2E;
#pragma unroll
        for (int ai = 0; ai < 2; ++ai)
#pragma unroll
            for (int m = 0; m < 4; ++m) {
                int fr_ = fr; asm volatile("" : "+v"(fr_));
                const size_t tok = (size_t)u.pm * 256 + ai * 128 + wr * 64 + m * 16 + fr_;
                const f32x4 a0 = *(const f32x4*)(ssq + tok * 24), a1 = *(const f32x4*)(ssq + tok * 24 + 4), a2 = *(const f32x4*)(ssq + tok * 24 + 8);
                const float tot = (a0[0] + a0[1] + a0[2] + a0[3]) + (a1[0] + a1[1] + a1[2] + a1[3]) + (a2[0] + a2[1] + a2[2] + a2[3]);
                const float sc = rsqrtf(tot * (1.0f / 384.0f) + 1e-6f) * qs;
#pragma unroll
                for (int bj = 0; bj < 2; ++bj) {
                    const int cg = u.pn * 256 + bj * 128 + wc * 32;
                    EPI_LOAD8(v, ai, bj, m);
                    if ((cg % 96) == 64) rope8(v, sc, cs, (int)(tok & (SEQ_L - 1)), fq, lane, q + tok * 768 + cg);
                    else *(u32x4*)(q + tok * 768 + cg + 8 * fq) = pack8(v, sc);
                }
            }
    }
};

struct EpiUpKV8 {
    static constexpr bool PERM = true, AFTER_DRAIN = false;
    bf16_t* kv; const float* ssq;
    DI void operator()(EPI_ARGS) const {
#pragma unroll
        for (int ai = 0; ai < 2; ++ai)
#pragma unroll
            for (int m = 0; m < 4; ++m) {
                int fr_ = fr; asm volatile("" : "+v"(fr_));
                const size_t tok = (size_t)u.pm * 256 + ai * 128 + wr * 64 + m * 16 + fr_;
                const f32x4 a0 = *(const f32x4*)(ssq + tok * 24 + 12), a1 = *(const f32x4*)(ssq + tok * 24 + 16);
                const float tot = (a0[0] + a0[1] + a0[2] + a0[3]) + (a1[0] + a1[1] + a1[2] + a1[3]);
                const float sc = rsqrtf(tot * (1.0f / 256.0f) + 1e-6f);
#pragma unroll
                for (int bj = 0; bj < 2; ++bj) { EPI_LOAD8(v, ai, bj, m); *(u32x4*)(kv + tok * 1024 + u.pn * 256 + bj * 128 + wc * 32 + 8 * fq) = pack8(v, sc); }
            }
    }
};

template <bool RBF16>
struct EpiResid8 {
    static constexpr bool PERM = true, AFTER_DRAIN = false;
    const void* R; bf16_t* HB; float* SS;
    DI void operator()(EPI_ARGS) const {
#pragma unroll
        for (int ai = 0; ai < 2; ++ai) {
            f32x4 rv[4][2][2];
#pragma unroll
            for (int m = 0; m < 4; ++m)
#pragma unroll
                for (int bj = 0; bj < 2; ++bj) {
                    const size_t off = ((size_t)u.pm * 256 + ai * 128 + wr * 64 + m * 16 + fr) * 1024 + u.pn * 256 + bj * 128 + wc * 32 + 8 * fq;
                    if (RBF16) {
                        const u32x4 w = ldu4((const bf16_t*)R + off);
                        rv[m][bj][0] = (f32x4){bf_lo(w[0]), bf_hi(w[0]), bf_lo(w[1]), bf_hi(w[1])};
                        rv[m][bj][1] = (f32x4){bf_lo(w[2]), bf_hi(w[2]), bf_lo(w[3]), bf_hi(w[3])};
                    } else {
                        rv[m][bj][0] = *(const f32x4*)((const float*)R + off); rv[m][bj][1] = *(const f32x4*)((const float*)R + off + 4);
                    }
                }
#pragma unroll
            for (int m = 0; m < 4; ++m) {
                int fr_ = fr; asm volatile("" : "+v"(fr_));
                const size_t tok = (size_t)u.pm * 256 + ai * 128 + wr * 64 + m * 16 + fr_;
                float ss = 0.f;
#pragma unroll
                for (int bj = 0; bj < 2; ++bj) {
                    const size_t off = tok * 1024 + u.pn * 256 + bj * 128 + wc * 32 + 8 * fq;
                    const f32x4 h0 = rv[m][bj][0] + acc[ai][bj][m][0], h1 = rv[m][bj][1] + acc[ai][bj][m][1];
                    u32x4 o; o[0] = pack2(h0[0], h0[1]); o[1] = pack2(h0[2], h0[3]); o[2] = pack2(h1[0], h1[1]); o[3] = pack2(h1[2], h1[3]);
                    *(u32x4*)(HB + off) = o;
                    const float a0 = bf_lo(o[0]), a1 = bf_hi(o[0]), a2 = bf_lo(o[1]), a3 = bf_hi(o[1]), a4 = bf_lo(o[2]), a5 = bf_hi(o[2]), a6 = bf_lo(o[3]), a7 = bf_hi(o[3]);
                    ss += (a0 * a0 + a1 * a1) + (a2 * a2 + a3 * a3) + (a4 * a4 + a5 * a5) + (a6 * a6 + a7 * a7);
                }
                ss = xq_sum(ss);
                if (fq == 0) SS[tok * 16 + 4 * u.pn + wc] = ss;
            }
        }
    }
};

struct EpiRowScale8 {
    static constexpr bool PERM = true, AFTER_DRAIN = false;
    bf16_t* out; int ld; const float* SS; float extra;
    DI void operator()(EPI_ARGS) const {
#pragma unroll
        for (int ai = 0; ai < 2; ++ai)
#pragma unroll
            for (int m = 0; m < 4; ++m) {
                int fr_ = fr; asm volatile("" : "+v"(fr_));
                const size_t tok = (size_t)u.pm * 256 + ai * 128 + wr * 64 + m * 16 + fr_;
                const f32x4 s0 = *(const f32x4*)(SS + tok * 16), s1 = *(const f32x4*)(SS + tok * 16 + 4), s2 = *(const f32x4*)(SS + tok * 16 + 8), s3 = *(const f32x4*)(SS + tok * 16 + 12);
                const float tot = (s0[0] + s0[1] + s0[2] + s0[3]) + (s1[0] + s1[1] + s1[2] + s1[3]) + (s2[0] + s2[1] + s2[2] + s2[3]) + (s3[0] + s3[1] + s3[2] + s3[3]);
                const float sc = rsqrtf(tot * (1.0f / 1024.0f) + 1e-6f) * extra;
#pragma unroll
                for (int bj = 0; bj < 2; ++bj) { EPI_LOAD8(v, ai, bj, m); *(u32x4*)(out + tok * ld + u.pn * 256 + bj * 128 + wc * 32 + 8 * fq) = pack8(v, sc); }
            }
    }
};

template <class Epi>
DI void gemm8(char* smem, const bf16_t* A, int lda, const bf16_t* Bt, int M, int N, int K, const Epi& e, int cshift = 0) {
    pg8::Gemm g; g.A = A; g.Bt = Bt; g.M = M; g.N = N; g.K = K; g.lda = lda;
    const int G = (int)gridDim.x;
    pg8::StaticOrder S; S.init(M, N, G, ((int)blockIdx.x + G - cshift) % G);
    pg8::gemm_phase<Epi, pg8::StaticOrder, true, true>((PG8_LAS unsigned char*)smem, g, S, e);
}

DI void quant_rows4(const Params& p, int it, int wv, int lane);
DI void phase_p1(const Params& p, char* smem) {
    char* ws = p.ws;
    const int G = (int)gridDim.x, nproj = 9 * 64, nkvm = 8 * 4;
    const int last = nproj % G;
    { EpiProj8 e{(bf16_t*)(ws + OFF_PROJ), (bf16_t*)(ws + OFF_KR), (const float*)(ws + OFF_ROPE), (float*)(ws + OFF_SSQ)};
      gemm8(smem, (const bf16_t*)(ws + OFF_XN), 1024, (const bf16_t*)(ws + OFF_WT_IN), T_TOK, 2304, 1024, e); }
    { EpiPlain8 e{(bf16_t*)(ws + OFF_KVM), 2048};
      gemm8(smem, (const bf16_t*)(ws + OFF_MEMN), 1024, (const bf16_t*)(ws + OFF_WT_MKV), 1024, 2048, 1024, e, last); }
    int q0 = last + nkvm, nq = G - q0;
    if (last == 0 || nq <= 0) { q0 = 0; nq = G; }
    if ((int)blockIdx.x >= q0) {
        const int t = otid(), lane = t & 63, wv = t >> 6;
        for (int it = ((int)blockIdx.x - q0) * 2 + vhalf(); it < 8192; it += 2 * nq) quant_rows4(p, it, wv, lane);
    }
}
DI void phase_p2(const Params& p, char* smem) {
    char* ws = p.ws;
    { EpiUpQ8 e{(bf16_t*)(ws + OFF_QMLA), (const float*)(ws + OFF_ROPE), (const float*)(ws + OFF_SSQ)};
      gemm8(smem, (const bf16_t*)(ws + OFF_PROJ), INC, (const bf16_t*)(ws + OFF_WT_UQ), T_TOK, 768, 384, e); }
    { EpiUpKV8 e{(bf16_t*)(ws + OFF_KVMLA), (const float*)(ws + OFF_SSQ)};
      gemm8(smem, (const bf16_t*)(ws + OFF_PROJ) + 384, INC, (const bf16_t*)(ws + OFF_WT_UKV), T_TOK, 1024, 256, e); }
}
template <bool RBF16>
DI void phase_resid(const Params& p, char* smem, size_t off_w, size_t off_a, const void* R, size_t off_ss, bool dry = false) {
    char* ws = p.ws;
    EpiResid8<RBF16> e{R, (bf16_t*)(ws + OFF_HB), (float*)(ws + off_ss)};
    if (dry) { e.HB = (bf16_t*)(ws + OFF_B); e.SS = (float*)(ws + OFF_SS1); }
    gemm8(smem, (const bf16_t*)(ws + off_a), 1024, (const bf16_t*)(ws + off_w), T_TOK, 1024, 1024, e);
}
DI void phase_rowscale(const Params& p, char* smem, size_t off_w, int N, bf16_t* outp, size_t off_ss, float extra) {
    char* ws = p.ws;
    EpiRowScale8 e{outp, N, (const float*)(ws + off_ss), extra};
    gemm8(smem, (const bf16_t*)(ws + OFF_HB), 1024, (const bf16_t*)(ws + off_w), T_TOK, N, 1024, e);
}
DI unsigned v128_off(int row, int chunk) { return (unsigned)(row * 128 + ((chunk ^ (((row >> 1) & 1) << 2)) << 4)); }
DI unsigned v128_tr_addr(unsigned base, int R0, int c, int lane) {
    const int blk = (lane >> 4) & 1, qq = (lane & 15) >> 2, pp = lane & 3;
    return base + v128_off(R0 + qq, 4 * c + 2 * blk + (pp >> 1)) + 8 * (pp & 1);
}
DI bf16x8 cat44(s16x4 lo, s16x4 hi) { return __builtin_shufflevector(lo, hi, 0, 1, 2, 3, 4, 5, 6, 7); }

constexpr int MLA_STAGE = 64 * 192 + 64 * 128;
DI unsigned k192_off(int row, int chunk) { return (unsigned)(row * 192 + (((chunk & ~3) | ((chunk & 3) ^ ((row >> 2) & 3))) << 4)); }
DI void mla_unit(const Params& p, char* lds, int b, int h, int qt) {
    char* ws = p.ws;
    const int t = otid(), lane = t & 63, wv = t >> 6, r = lane & 31, hh = lane >> 5;
    const bf16_t* Q = (const bf16_t*)(ws + OFF_QMLA);
    const bf16_t* KV = (const bf16_t*)(ws + OFF_KVMLA);
    const bf16_t* KR = (const bf16_t*)(ws + OFF_KR);
    const int q0 = qt * 128 + 32 * wv;
    const size_t tokq = (size_t)b * SEQ_L + q0 + r;
    const size_t tokb = (size_t)b * SEQ_L;
    bf16x8 qf[6];
#pragma unroll
    for (int s = 0; s < 6; ++s) qf[s] = ld16(Q + tokq * 768 + h * 96 + 16 * s + 8 * hh);
    f32x16 o[2]; o[0] = zero16(); o[1] = zero16();
    float m = -INFINITY, l = 0.f;
    const bf16_t* ksrc[3]; int kadv[3]; const bf16_t* vsrc[2];
#pragma unroll
    for (int i = 0; i < 3; ++i) {
        const int o_ = 1024 * (wv + 4 * i) + 16 * lane, row = o_ / 192, pch = (o_ % 192) >> 4;
        const int c = (pch & ~3) | ((pch & 3) ^ ((row >> 2) & 3));
        if (c < 8) { ksrc[i] = KV + (tokb + row) * 1024 + h * 128 + 8 * c; kadv[i] = 64 * 1024; }
        else       { ksrc[i] = KR + (tokb + row) * 32 + 8 * (c - 8);       kadv[i] = 64 * 32; }
    }
#pragma unroll
    for (int i = 0; i < 2; ++i) {
        const int row = 8 * (wv + 4 * i) + (lane >> 3), pch = lane & 7;
        vsrc[i] = KV + (tokb + row) * 1024 + h * 128 + 64 + 8 * (pch ^ (((row >> 1) & 1) << 2));
    }
    char* ldst = lds + wv * 1024 + lane * 16;
    auto issue = [&](int kt) {
        char* d = ldst + (kt % 3) * MLA_STAGE;
#pragma unroll
        for (int i = 0; i < 3; ++i) GLDS16(ksrc[i] + (size_t)kt * kadv[i], d + i * 4096);
#pragma unroll
        for (int i = 0; i < 2; ++i) GLDS16(vsrc[i] + (size_t)kt * (64 * 1024), d + 12288 + i * 4096);
    };
    const int ntiles = 2 * qt + 2;
    const unsigned vlane0 = v128_tr_addr(0u, 4 * hh, 0, lane), vlane1 = v128_tr_addr(0u, 4 * hh, 1, lane);
    __syncthreads();
    issue(0); issue(1);
#pragma unroll
    for (int s = 0; s < 6; ++s) asm volatile("" :: "v"(qf[s]));
#pragma unroll 1
    for (int kt = 0; kt < ntiles; ++kt) {
        if (kt + 1 < ntiles) asm volatile("s_waitcnt vmcnt(5)\n\ts_barrier" ::: "memory");
        else asm volatile("s_waitcnt vmcnt(0)\n\ts_barrier" ::: "memory");
        if (kt + 2 < ntiles) issue(kt + 2);
        const char* sb = lds + (kt % 3) * MLA_STAGE;
        const unsigned vb = (unsigned)(uintptr_t)(sb + 12288);
        f32x16 s[2];
#pragma unroll
        for (int k2 = 0; k2 < 2; ++k2) {
            s[k2] = zero16();
#pragma unroll
            for (int ss = 0; ss < 6; ++ss) s[k2] = MFMA32(ld16(sb + k192_off(32 * k2 + r, 2 * ss + hh)), qf[ss], s[k2]);
        }
        s16x4 vt[2][2][2][2];
        {
            const unsigned a0 = vb + vlane0, a1 = vb + vlane1;
#define MLA_TR(K2, ST) vt[K2][ST][0][0] = tr_read_ao<(32 * K2 + 16 * ST) * 128>(a0); vt[K2][ST][0][1] = tr_read_ao<(32 * K2 + 16 * ST + 8) * 128>(a0); \
                       vt[K2][ST][1][0] = tr_read_ao<(32 * K2 + 16 * ST) * 128>(a1); vt[K2][ST][1][1] = tr_read_ao<(32 * K2 + 16 * ST + 8) * 128>(a1);
            MLA_TR(0, 0) MLA_TR(0, 1) MLA_TR(1, 0) MLA_TR(1, 1)
#undef MLA_TR
        }
        if (__builtin_amdgcn_readfirstlane(kt >= 2 * qt)) {
            asm volatile("");
            const int qpos = q0 + r;
#pragma unroll
            for (int k2 = 0; k2 < 2; ++k2)
#pragma unroll
                for (int i = 0; i < 16; ++i) { const int kpos = 64 * kt + 32 * k2 + crow(i, hh); if (kpos > qpos) s[k2][i] = -INFINITY; }
        }
        float mx = s[0][0];
#pragma unroll
        for (int k2 = 0; k2 < 2; ++k2)
#pragma unroll
            for (int i = 0; i < 16; ++i) mx = fmaxf(mx, s[k2][i]);
        mx = xhalf_max(mx);
        if (__any(mx > m + 8.0f)) {
            asm volatile("");
            const float mn = fmaxf(m, mx);
            const float alpha = fast_exp2(m - mn);
            l *= alpha;
            m = mn;
#pragma unroll
            for (int c = 0; c < 2; ++c)
#pragma unroll
                for (int i = 0; i < 16; ++i) o[c][i] *= alpha;
        }
        f32x2 ps2 = {0.f, 0.f};
        const f32x2 m2 = {m, m};
#pragma unroll
        for (int k2 = 0; k2 < 2; ++k2)
#pragma unroll
            for (int i = 0; i < 16; i += 2) {
                f32x2 x = {s[k2][i], s[k2][i + 1]};
                x = x - m2;
                f32x2 e; e[0] = fast_exp2(x[0]); e[1] = fast_exp2(x[1]);
                s[k2][i] = e[0]; s[k2][i + 1] = e[1];
                ps2 += e;
            }
        l += ps2[0] + ps2[1];
        TR_WAIT();
#pragma unroll
        for (int k2 = 0; k2 < 2; ++k2)
#pragma unroll
            for (int st = 0; st < 2; ++st) {
                const bf16x8 pb = pack_step(s[k2], st);
#pragma unroll
                for (int c = 0; c < 2; ++c) o[c] = MFMA32(cat44(vt[k2][st][c][0], vt[k2][st][c][1]), pb, o[c]);
            }
    }
    const float inv = 1.0f / xhalf_sum(l);
    bf16_t* dst = (bf16_t*)((char*)p.out + OUT_OMLA) + tokq * 512 + h * 64 + 4 * hh;
#pragma unroll
    for (int c = 0; c < 2; ++c)
#pragma unroll
        for (int g = 0; g < 4; ++g)
            *(u32x2*)(dst + 32 * c + 8 * g) = pack4(o[c][4 * g] * inv, o[c][4 * g + 1] * inv, o[c][4 * g + 2] * inv, o[c][4 * g + 3] * inv);
}

DI void dil_unit(const Params& p, char* lds, int g, int b, int h, int rr, int lb) {
    char* ws = p.ws;
    const int t = otid(), lane = t & 63, wv = t >> 6, r = lane & 31, hh = lane >> 5;
    const int d = (g == 0) ? 1 : (g == 1 ? 4 : 16);
    const bf16_t* PJ = (const bf16_t*)(ws + OFF_PROJ);
    const size_t tokb = (size_t)b * SEQ_L;
    char* kimg = lds;
    char* vimg = lds + 32768;
    __syncthreads();
    {
        const int c = t & 7;
#pragma unroll
        for (int half = 0; half < 2; ++half) {
            u32x4 kk[4], vv[4];
#pragma unroll
            for (int i = 0; i < 4; ++i) {
                const int key = (t >> 3) + 32 * (4 * half + i);
                const int lk = 128 * lb - 128 + key;
                if (lk >= 0) {
                    const size_t tk = tokb + (size_t)lk * d + rr;
                    kk[i] = ldu4(PJ + tk * INC + 1184 + h * 64 + 8 * c);
                    vv[i] = ldu4(PJ + tk * INC + 1696 + h * 64 + 8 * c);
                } else { kk[i] = (u32x4){0u, 0u, 0u, 0u}; vv[i] = (u32x4){0u, 0u, 0u, 0u}; }
            }
#pragma unroll
            for (int i = 0; i < 4; ++i) {
                const int key = (t >> 3) + 32 * (4 * half + i);
                *(u32x4*)(kimg + sw_off(key, c)) = kk[i];
                *(u32x4*)(vimg + v128_off(key, c)) = vv[i];
            }
        }
    }
    const int lq = 128 * lb + 32 * wv + r;
    const size_t tokq = tokb + (size_t)lq * d + rr;
    bf16x8 qf[4];
#pragma unroll
    for (int s = 0; s < 4; ++s) qf[s] = ld16(PJ + tokq * INC + 672 + h * 64 + 16 * s + 8 * hh);
    __syncthreads();
    const float slope2 = exp2f(-(float)(h + 1)) * (float)d * LOG2E;
    const int u0 = (lb == 0) ? (4 - wv) : 0;
    f32x16 o[2]; o[0] = zero16(); o[1] = zero16();
    float m = -INFINITY, lsum = 0.f;
    const unsigned vb = (unsigned)(uintptr_t)vimg;
    float cb[16];
#pragma unroll
    for (int i = 0; i < 16; ++i) cb[i] = slope2 * (float)crow(i, hh);
#pragma unroll 1
    for (int u = u0; u < 5; ++u) {
        const int rowb = 32 * (wv + u);
        f32x16 s = zero16();
#pragma unroll
        for (int ss = 0; ss < 4; ++ss) s = MFMA32(ld16(kimg + sw_off(rowb + r, 2 * ss + hh)), qf[ss], s);
        const int dbase = r + 128 - 32 * u;
        const float b0 = -slope2 * (float)dbase;
#pragma unroll
        for (int i = 0; i < 16; ++i) s[i] += cb[i];
        if (__builtin_amdgcn_readfirstlane(u == 0 || u == 4)) {
            asm volatile("");
#pragma unroll
            for (int i = 0; i < 16; ++i) { const int dist = dbase - crow(i, hh); if (dist < 0 || dist > 128) s[i] = -INFINITY; }
        }
        float mx = s[0];
#pragma unroll
        for (int i = 1; i < 16; ++i) mx = fmaxf(mx, s[i]);
        mx = xhalf_max(mx) + b0;
        if (__any(mx > m + 8.0f)) {
            asm volatile("");
            const float mn = fmaxf(m, mx);
            const float alpha = fast_exp2(m - mn);
            lsum *= alpha;
            m = mn;
#pragma unroll
            for (int c = 0; c < 2; ++c)
#pragma unroll
                for (int i = 0; i < 16; ++i) o[c][i] *= alpha;
        }
        f32x2 ps2 = {0.f, 0.f};
        const float mb = m - b0;
        const f32x2 m2 = {mb, mb};
#pragma unroll
        for (int i = 0; i < 16; i += 2) {
            f32x2 xx = {s[i], s[i + 1]};
            xx = xx - m2;
            f32x2 e; e[0] = fast_exp2(xx[0]); e[1] = fast_exp2(xx[1]);
            s[i] = e[0]; s[i + 1] = e[1];
            ps2 += e;
        }
        lsum += ps2[0] + ps2[1];
#pragma unroll
        for (int st = 0; st < 2; ++st) {
            const bf16x8 pb = pack_step(s, st);
#pragma unroll
            for (int c = 0; c < 2; ++c) {
                const s16x4 lo = tr_read(v128_tr_addr(vb, rowb + 16 * st + 4 * hh, c, lane));
                const s16x4 hi = tr_read(v128_tr_addr(vb, rowb + 16 * st + 8 + 4 * hh, c, lane));
                o[c] = MFMA32(cat44(lo, hi), pb, o[c]);
            }
        }
    }
    const float ltot = xhalf_sum(lsum);
    const float mx = m;
    const float inv = 1.0f / ltot;
    bf16_t* dst = (bf16_t*)((char*)p.out + OUT_ODIL) + ((size_t)g * T_TOK + tokq) * 512 + h * 64 + 4 * hh;
#pragma unroll
    for (int c = 0; c < 2; ++c)
#pragma unroll
        for (int gg = 0; gg < 4; ++gg)
            *(u32x2*)(dst + 32 * c + 8 * gg) = pack4(o[c][4 * gg] * inv, o[c][4 * gg + 1] * inv, o[c][4 * gg + 2] * inv, o[c][4 * gg + 3] * inv);
    if (hh == 0) ((float*)(ws + OFF_LSE))[((size_t)g * T_TOK + tokq) * 8 + h] = mx + __log2f(ltot);
}

DI void phase_p3(const Params& p, char* lds, int which = 3) {
    const int xg = (int)blockIdx.x & 7, nloc = (vgrid() >> 3), loc = ((int)blockIdx.x >> 3) * 2 + vhalf();
    if (which & 1) for (int i = loc; i < 64; i += nloc) {
        const int bh = xg * 4 + (i >> 4), pr = i & 15, b = bh >> 3, h = bh & 7;
#pragma unroll 1
        for (int rep = 0; rep < 2; ++rep) mla_unit(p, lds, b, h, rep ? pr : 31 - pr);
    }
    if (which & 2) for (int i = loc; i < 384; i += nloc) {
        const int bh = xg * 4 + i / 96, k96 = i % 96, g = k96 >> 5, k = k96 & 31, b = bh >> 3, h = bh & 7;
        int rr, lb;
        if (g == 0) { rr = 0; lb = k; } else if (g == 1) { rr = k >> 3; lb = k & 7; } else { rr = k >> 1; lb = k & 1; }
        dil_unit(p, lds, g, b, h, rr, lb);
    }
}

DI void quant_rows4(const Params& p, int it, int wv, int lane) {
    char* ws = p.ws;
    const int ncv = 4096;
    const bool isv = it >= ncv;
    const size_t row = (size_t)(isv ? it - ncv : it) * 4 + wv;
    const float* src = (isv ? p.peer_v : p.peer_u) + row * 1024 + 16 * lane;
    f32x4 v[4]; float am = 0.f;
#pragma unroll
    for (int i = 0; i < 4; ++i) { v[i] = *(const f32x4*)(src + 4 * i); am = fmaxf(am, fmaxf(fmaxf(fabsf(v[i][0]), fabsf(v[i][1])), fmaxf(fabsf(v[i][2]), fabsf(v[i][3])))); }
#pragma unroll
    for (int o = 32; o; o >>= 1) am = fmaxf(am, __shfl_xor(am, o));
    const float sc = (am > 0.f) ? am * (isv ? (1.0f / 384.0f) : (1.0f / 127.0f)) : 1.0f;
    const float inv = 1.0f / sc;
    u32x4 o;
#pragma unroll
    for (int i = 0; i < 4; ++i) {
        if (isv) {
            int w = 0;
            w = __builtin_amdgcn_cvt_pk_fp8_f32(v[i][0] * inv, v[i][1] * inv, w, false);
            w = __builtin_amdgcn_cvt_pk_fp8_f32(v[i][2] * inv, v[i][3] * inv, w, true);
            o[i] = (unsigned)w;
        } else {
            unsigned w = 0u;
#pragma unroll
            for (int e = 0; e < 4; ++e) { const int q = (int)rintf(v[i][e] * inv); w |= ((unsigned)q & 0xFFu) << (8 * e); }
            o[i] = w;
        }
    }
    *(u32x4*)(ws + (isv ? OFF_VQ : OFF_UQ) + row * 1024 + 16 * lane) = o;
    if (lane == 0) ((float*)(ws + (isv ? OFF_SV : OFF_SU)))[row] = sc;
}

DI void phase_p35(const Params& p, char* lds) {
    char* ws = p.ws;
    const int t = otid(), lane = t & 63, wv = t >> 6;
    const int ntok = T_TOK / 4;
    for (int item = vbid(); item < ntok; item += vgrid()) {
        {
            const size_t tok = (size_t)item * 4 + wv;
            const int head = lane >> 3;
            const float* LS = (const float*)(ws + OFF_LSE);
            const float l0 = LS[tok * 8 + head], l1 = LS[((size_t)T_TOK + tok) * 8 + head], l2 = LS[((size_t)2 * T_TOK + tok) * 8 + head];
            const float mx = fmaxf(l0, fmaxf(l1, l2));
            float w0 = fast_exp2(l0 - mx), w1 = fast_exp2(l1 - mx), w2 = fast_exp2(l2 - mx);
            const float wi = 1.0f / (w0 + w1 + w2);
            w0 *= wi; w1 *= wi; w2 *= wi;
            const bf16_t* OD = (const bf16_t*)((const char*)p.out + OUT_ODIL);
            const u32x4 a0 = ldu4(OD + tok * 512 + 8 * lane), a1 = ldu4(OD + ((size_t)T_TOK + tok) * 512 + 8 * lane),
                        a2 = ldu4(OD + ((size_t)2 * T_TOK + tok) * 512 + 8 * lane);
            const u32x4 am = ldu4((const bf16_t*)((const char*)p.out + OUT_OMLA) + tok * 512 + 8 * lane);
            float od[8], om[8]; float sd = 0.f, sm = 0.f;
#pragma unroll
            for (int e = 0; e < 4; ++e) {
                od[2 * e] = w0 * bf_lo(a0[e]) + w1 * bf_lo(a1[e]) + w2 * bf_lo(a2[e]);
                od[2 * e + 1] = w0 * bf_hi(a0[e]) + w1 * bf_hi(a1[e]) + w2 * bf_hi(a2[e]);
                om[2 * e] = bf_lo(am[e]); om[2 * e + 1] = bf_hi(am[e]);
                sd += od[2 * e] * od[2 * e] + od[2 * e + 1] * od[2 * e + 1];
                sm += om[2 * e] * om[2 * e] + om[2 * e + 1] * om[2 * e + 1];
            }
#pragma unroll
            for (int o = 32; o; o >>= 1) { sd += __shfl_xor(sd, o); sm += __shfl_xor(sm, o); }
            const float rd = rsqrtf(sd * (1.0f / 512.0f) + 1e-6f), rm = rsqrtf(sm * (1.0f / 512.0f) + 1e-6f);
            const f32x4 gm0 = *(const f32x4*)(p.gn_mla + 8 * lane), gm1 = *(const f32x4*)(p.gn_mla + 8 * lane + 4);
            const f32x4 gd0 = *(const f32x4*)(p.gn_dil + 8 * lane), gd1 = *(const f32x4*)(p.gn_dil + 8 * lane + 4);
            u32x4 o1, o2;
            o1[0] = pack2(om[0] * rm * gm0[0], om[1] * rm * gm0[1]); o1[1] = pack2(om[2] * rm * gm0[2], om[3] * rm * gm0[3]);
            o1[2] = pack2(om[4] * rm * gm1[0], om[5] * rm * gm1[1]); o1[3] = pack2(om[6] * rm * gm1[2], om[7] * rm * gm1[3]);
            o2[0] = pack2(od[0] * rd * gd0[0], od[1] * rd * gd0[1]); o2[1] = pack2(od[2] * rd * gd0[2], od[3] * rd * gd0[3]);
            o2[2] = pack2(od[4] * rd * gd1[0], od[5] * rd * gd1[1]); o2[3] = pack2(od[6] * rd * gd1[2], od[7] * rd * gd1[3]);
            bf16_t* MX = (bf16_t*)(ws + OFF_MIXED) + tok * 1024;
            *(u32x4*)(MX + 8 * lane) = o1;
            *(u32x4*)(MX + 512 + 8 * lane) = o2;
        }
    }
}

DI void memattn_unit(const Params& p, char* lds, int b, int h, int tt) {
    char* ws = p.ws;
    const int t = otid(), lane = t & 63, wv = t >> 6, r = lane & 31, hh = lane >> 5;
    const bf16_t* QM = (const bf16_t*)(ws + OFF_QM);
    const bf16_t* KVM = (const bf16_t*)(ws + OFF_KVM);
    const size_t tokq = (size_t)b * SEQ_L + tt * 128 + 32 * wv + r;
    const bf16_t* qrow = QM + tokq * 1024 + h * 256 + 8 * hh;
    const bf16_t* ksrc0; const bf16_t* vsrc0;
    {
        const int row = 8 * wv + (lane >> 3), pch = lane & 7;
        const size_t mrow = (size_t)b * 256 + row;
        ksrc0 = KVM + mrow * 2048 + h * 256 + 8 * (pch ^ ((row >> 1) & 7));
        vsrc0 = KVM + mrow * 2048 + 1024 + h * 256 + 8 * (pch ^ (((row >> 1) & 1) << 2));
    }
    char* ldst = lds + wv * 1024 + lane * 16;
#define MA_ISSUE(st_) do { char* d_ = ldst + ((st_) & 1) * 32768; \
        _Pragma("unroll") for (int i = 0; i < 8; ++i) GLDS16(((st_) < 4 ? ksrc0 : vsrc0) + (size_t)i * (32 * 2048) + 64 * ((st_) & 3), d_ + i * 4096); } while (0)
    f32x16 S[8];
#pragma unroll
    for (int kt = 0; kt < 8; ++kt) S[kt] = zero16();
    bf16x8 qa[4];
    __syncthreads();
    MA_ISSUE(0); MA_ISSUE(1);
#define MA_KSTAGE(c_, WAIT_) do { \
        asm volatile("s_waitcnt vmcnt(" #WAIT_ ")\n\ts_barrier" ::: "memory"); \
        _Pragma("unroll") for (int ss = 0; ss < 4; ++ss) qa[ss] = ld16(qrow + 64 * (c_) + 16 * ss); \
        { const char* sb_ = lds + ((c_) & 1) * 32768; \
          _Pragma("unroll") for (int kt = 0; kt < 8; ++kt) \
          _Pragma("unroll") for (int ss = 0; ss < 4; ++ss) S[kt] = MFMA32(ld16(sb_ + sw_off(32 * kt + r, 2 * ss + hh)), qa[ss], S[kt]); } \
        asm volatile("s_barrier" ::: "memory"); \
        MA_ISSUE((c_) + 2); } while (0)
    MA_KSTAGE(0, 8);
    MA_KSTAGE(1, 8);
    MA_KSTAGE(2, 8);
    MA_KSTAGE(3, 8);
    float mx = S[0][0];
#pragma unroll
    for (int kt = 0; kt < 8; ++kt)
#pragma unroll
        for (int i = 0; i < 16; ++i) mx = fmaxf(mx, S[kt][i]);
    mx = xhalf_max(mx);
    f32x2 ps2 = {0.f, 0.f};
    const f32x2 m2 = {mx, mx};
    bf16x8 pk[8][2];
#pragma unroll
    for (int kt = 0; kt < 8; ++kt) {
#pragma unroll
        for (int i = 0; i < 16; i += 2) {
            f32x2 xx = {S[kt][i], S[kt][i + 1]};
            xx = xx - m2;
            f32x2 e; e[0] = fast_exp2(xx[0]); e[1] = fast_exp2(xx[1]);
            S[kt][i] = e[0]; S[kt][i + 1] = e[1];
            ps2 += e;
        }
        pk[kt][0] = pack_step(S[kt], 0); pk[kt][1] = pack_step(S[kt], 1);
    }
    const float inv = 1.0f / xhalf_sum(ps2[0] + ps2[1]);
    bf16_t* dst = (bf16_t*)(ws + OFF_OM) + tokq * 1024 + h * 256 + 4 * hh;
    const unsigned vlane0 = v128_tr_addr(0u, 4 * hh, 0, lane), vlane1 = v128_tr_addr(0u, 4 * hh, 1, lane);
#define MA_PV(KT_, vb_) do { s16x4 vt_[2][2][2]; \
            vt_[0][0][0] = tr_read_ao<(32 * KT_) * 128>(vb_ + vlane0);          vt_[0][0][1] = tr_read_ao<(32 * KT_ + 8) * 128>(vb_ + vlane0); \
            vt_[0][1][0] = tr_read_ao<(32 * KT_) * 128>(vb_ + vlane1);          vt_[0][1][1] = tr_read_ao<(32 * KT_ + 8) * 128>(vb_ + vlane1); \
            vt_[1][0][0] = tr_read_ao<(32 * KT_ + 16) * 128>(vb_ + vlane0);     vt_[1][0][1] = tr_read_ao<(32 * KT_ + 24) * 128>(vb_ + vlane0); \
            vt_[1][1][0] = tr_read_ao<(32 * KT_ + 16) * 128>(vb_ + vlane1);     vt_[1][1][1] = tr_read_ao<(32 * KT_ + 24) * 128>(vb_ + vlane1); \
            TR_WAIT(); \
            _Pragma("unroll") for (int st = 0; st < 2; ++st) { \
                o0_ = MFMA32(cat44(vt_[st][0][0], vt_[st][0][1]), pk[KT_][st], o0_); \
                o1_ = MFMA32(cat44(vt_[st][1][0], vt_[st][1][1]), pk[KT_][st], o1_); } } while (0)
#define MA_VSTAGE(c_, WAIT_) do { \
        asm volatile("s_waitcnt vmcnt(" #WAIT_ ")\n\ts_barrier" ::: "memory"); \
        { const unsigned vb_ = (unsigned)(uintptr_t)(lds + ((c_) & 1) * 32768); \
          f32x16 o0_ = zero16(), o1_ = zero16(); \
          MA_PV(0, vb_); MA_PV(1, vb_); MA_PV(2, vb_); MA_PV(3, vb_); MA_PV(4, vb_); MA_PV(5, vb_); MA_PV(6, vb_); MA_PV(7, vb_); \
          _Pragma("unroll") for (int g = 0; g < 4; ++g) { \
              *(u32x2*)(dst + 64 * (c_) + 8 * g) = pack4(o0_[4 * g] * inv, o0_[4 * g + 1] * inv, o0_[4 * g + 2] * inv, o0_[4 * g + 3] * inv); \
              *(u32x2*)(dst + 64 * (c_) + 32 + 8 * g) = pack4(o1_[4 * g] * inv, o1_[4 * g + 1] * inv, o1_[4 * g + 2] * inv, o1_[4 * g + 3] * inv); } } \
        asm volatile("s_barrier" ::: "memory"); \
        if ((c_) + 2 < 4) MA_ISSUE(4 + (c_) + 2); } while (0)
    MA_VSTAGE(0, 8);
    MA_VSTAGE(1, 8);
    MA_VSTAGE(2, 8);
    MA_VSTAGE(3, 0);
#undef MA_ISSUE
#undef MA_KSTAGE
#undef MA_VSTAGE
#undef MA_PV
}

DI void phase_memattn(const Params& p, char* lds) {
    for (int item = vbid(); item < 512; item += vgrid()) {
        const int b = item >> 7, h = (item >> 5) & 3, tt = item & 31;
        memattn_unit(p, lds, b, h, tt);
    }
}
DI unsigned f2sort(float f) { const unsigned b = __float_as_uint(f); return b ^ ((b & 0x80000000u) ? 0xFFFFFFFFu : 0x80000000u); }
DI float sort2f(unsigned u) { const unsigned b = (u & 0x80000000u) ? (u ^ 0x80000000u) : ~u; return __uint_as_float(b); }
DI void cswap(unsigned& a, unsigned& b) { const unsigned hi = max(a, b), lo = min(a, b); a = hi; b = lo; }

template <int LO, int N> struct BClean {
    template <int M> static DI void run(unsigned (&a)[M]) {
#pragma unroll
        for (int i = 0; i < N / 2; ++i) cswap(a[LO + i], a[LO + i + N / 2]);
        BClean<LO, N / 2>::run(a); BClean<LO + N / 2, N / 2>::run(a);
    }
};
template <int LO> struct BClean<LO, 1> { template <int M> static DI void run(unsigned (&)[M]) {} };
template <int LO, int N> struct BSort {
    template <int M> static DI void run(unsigned (&a)[M]) {
        BSort<LO, N / 2>::run(a); BSort<LO + N / 2, N / 2>::run(a);
#pragma unroll
        for (int i = 0; i < N / 2; ++i) cswap(a[LO + i], a[LO + N - 1 - i]);
        BClean<LO, N / 2>::run(a); BClean<LO + N / 2, N / 2>::run(a);
    }
};
template <int LO> struct BSort<LO, 1> { template <int M> static DI void run(unsigned (&)[M]) {} };
DI void merge_top16(unsigned (&a)[16], const unsigned (&b)[16]) {
#pragma unroll
    for (int i = 0; i < 16; ++i) a[i] = max(a[i], b[15 - i]);
    BClean<0, 16>::run(a);
}

DI void peer_top16(const bf16_t* __restrict__ keys_hp, const bf16_t* __restrict__ pq_row_hp, int r, int hh, unsigned (&top)[16]) {
    bf16x8 qf[8];
#pragma unroll
    for (int s = 0; s < 8; ++s) qf[s] = ld16(pq_row_hp + 16 * s + 8 * hh);
    unsigned cur[16];
#pragma unroll
    for (int kt = 0; kt < 4; ++kt) {
        f32x16 acc = zero16();
#pragma unroll
        for (int s = 0; s < 8; ++s) acc = MFMA32(ld16(keys_hp + (size_t)(32 * kt + r) * 128 + 16 * s + 8 * hh), qf[s], acc);
        unsigned k[16];
#pragma unroll
        for (int i = 0; i < 16; ++i) k[i] = (f2sort(acc[i]) & ~0x7Fu) | (unsigned)(32 * kt + crow(i, hh));
        BSort<0, 16>::run(k);
        if (kt == 0) {
#pragma unroll
            for (int i = 0; i < 16; ++i) cur[i] = k[i];
        } else merge_top16(cur, k);
    }
    unsigned r0[16], r1[16];
#pragma unroll
    for (int i = 0; i < 16; ++i) { auto rr = __builtin_amdgcn_permlane32_swap(cur[i], cur[i], false, false); r0[i] = rr[0]; r1[i] = rr[1]; }
#pragma unroll
    for (int i = 0; i < 16; ++i) top[i] = max(r0[i], r1[15 - i]);
    BClean<0, 16>::run(top);
}

DI void peer_select_unit(const Params& p, char* lds, int mt, int h) {
    char* ws = p.ws;
    const int t = otid(), lane = t & 63, wv = t >> 6, r = lane & 31, hh = lane >> 5;
    const size_t tok = (size_t)mt * 128 + 32 * wv + r;
    const bf16_t* KEYS = (const bf16_t*)(ws + OFF_KEYS);
    const bf16_t* PQ = (const bf16_t*)((const char*)p.out + OUT_PQ);
    unsigned tA[16], tB[16];
    peer_top16(KEYS + (size_t)(2 * h) * 16384, PQ + tok * 2048 + (2 * h) * 128, r, hh, tA);
    peer_top16(KEYS + (size_t)(2 * h + 1) * 16384, PQ + tok * 2048 + (2 * h + 1) * 128, r, hh, tB);
    float fA[16], fB[16];
#pragma unroll
    for (int i = 0; i < 16; ++i) { fA[i] = sort2f(tA[i] & ~0x7Fu); fB[i] = sort2f(tB[i] & ~0x7Fu); }
    unsigned* tab = (unsigned*)lds + wv * 1024;
    __syncthreads();
#pragma unroll
    for (int i = 0; i < 16; ++i) tab[i * 64 + lane] = (tA[i] & 0x7Fu) | ((tB[i] & 0x7Fu) << 16);
    unsigned c[64];
#pragma unroll
    for (int i = 0; i < 64; ++i) c[i] = 0u;
    {
        int n = 0;
#pragma unroll
        for (int a = 0; a < 16; ++a)
#pragma unroll
            for (int b = 0; b < 16; ++b)
                if ((a + 1) * (b + 1) <= 16) { c[n] = (f2sort(fA[a] + fB[b]) & ~0xFFu) | (unsigned)(a * 16 + b); ++n; }
    }
    unsigned g0[16], g1[16], g2[16], g3[16];
#pragma unroll
    for (int i = 0; i < 16; ++i) { g0[i] = c[i]; g1[i] = c[16 + i]; g2[i] = c[32 + i]; g3[i] = c[48 + i]; }
    BSort<0, 16>::run(g0); BSort<0, 16>::run(g1); BSort<0, 16>::run(g2); BSort<0, 16>::run(g3);
    merge_top16(g0, g1); merge_top16(g2, g3); merge_top16(g0, g2);
    float e[16]; float sum = 0.f;
    const float v0 = sort2f(g0[0] & ~0xFFu);
    unsigned ids[16];
#pragma unroll
    for (int i = 0; i < 16; ++i) {
        const float v = sort2f(g0[i] & ~0xFFu);
        e[i] = fast_exp2((v - v0) * LOG2E); sum += e[i];
        const unsigned a = (g0[i] >> 4) & 15u, b = g0[i] & 15u;
        const unsigned ia = tab[a * 64 + lane] & 0x7Fu, ib = (tab[b * 64 + lane] >> 16) & 0x7Fu;
        ids[i] = ia * 128u + ib;
    }
    const float inv = 1.0f / sum;
    if (hh == 0) {
        unsigned short* SID = (unsigned short*)(ws + OFF_SELID) + tok * 128 + h * 16;
        float* SG = (float*)(ws + OFF_SELG) + tok * 128 + h * 16;
        u32x4 w0, w1;
        w0[0] = ids[0] | (ids[1] << 16); w0[1] = ids[2] | (ids[3] << 16); w0[2] = ids[4] | (ids[5] << 16); w0[3] = ids[6] | (ids[7] << 16);
        w1[0] = ids[8] | (ids[9] << 16); w1[1] = ids[10] | (ids[11] << 16); w1[2] = ids[12] | (ids[13] << 16); w1[3] = ids[14] | (ids[15] << 16);
        *(u32x4*)SID = w0; *(u32x4*)(SID + 8) = w1;
#pragma unroll
        for (int q = 0; q < 4; ++q) *(f32x4*)(SG + 4 * q) = (f32x4){e[4 * q] * inv, e[4 * q + 1] * inv, e[4 * q + 2] * inv, e[4 * q + 3] * inv};
    }
}

DI void phase_select(const Params& p, char* lds) {
    for (int item = vbid(); item < 1024; item += vgrid()) peer_select_unit(p, lds, item >> 3, item & 7);
}

DI float gelu_erf(float v) {
    const float av = fabsf(v), t = __builtin_amdgcn_rcpf(av * 0.2316418882f + 1.0f);
    float q = t * 0.5307027145f + (-0.7265760135f); q = q * t + 0.7107068705f; q = q * t + (-0.142248368f); q = q * t + 0.127414796f; q = q * t;
    const float e = __builtin_amdgcn_exp2f((v * v) * (-0.72134752044f));
    const float m = v * (q * e), r = v - m;
    return v < 0.f ? m : r;
}
DI int dppi(int v, const int ctrl) { return v; }
#define DPP_I(v, ctrl) __builtin_amdgcn_update_dpp(0, (v), (ctrl), 0xf, 0xf, true)
DI float ub0(unsigned w) { return (float)(w & 0xFFu); }
DI float ub1(unsigned w) { return (float)((w >> 8) & 0xFFu); }
DI float ub2(unsigned w) { return (float)((w >> 16) & 0xFFu); }
DI float ub3(unsigned w) { return (float)(w >> 24); }

struct GBatch { u32x4 U[4], V[4]; float su[4], sv[4], gate[4]; };

DI void gather_load(GBatch& B, const char* __restrict__ ws, unsigned idpair, f32x2 gpair, int eb, int lane) {
#pragma unroll
    for (int j = 0; j < 4; ++j) {
        const int e = eb + j;
        const unsigned pr = __shfl(idpair, e >> 1);
        const unsigned id = (j & 1) ? (pr >> 16) : (pr & 0xFFFFu);
        const float g0 = __shfl(gpair[0], e >> 1), g1 = __shfl(gpair[1], e >> 1);
        B.gate[j] = (j & 1) ? g1 : g0;
        B.U[j] = ldu4(ws + OFF_UQ + (size_t)id * 1024 + 16 * lane);
        B.V[j] = ldu4(ws + OFF_VQ + (size_t)id * 1024 + 16 * lane);
        B.su[j] = ((const float*)(ws + OFF_SU))[id];
        B.sv[j] = ((const float*)(ws + OFF_SV))[id];
    }
}

DI void gather_compute(const GBatch& B, const unsigned (&qx)[4], float sx, float (&acc)[16], float& csum, int lane) {
    int pd[4];
#pragma unroll
    for (int j = 0; j < 4; ++j) {
        int d = 0;
#pragma unroll
        for (int q = 0; q < 4; ++q) d = __builtin_amdgcn_sdot4((int)B.U[j][q], (int)qx[q], d, false);
        pd[j] = d;
    }
    const bool b0 = lane & 1, b1 = lane & 2;
    const int kA = b0 ? pd[1] : pd[0], kB = b0 ? pd[3] : pd[2], sA = b0 ? pd[0] : pd[1], sB = b0 ? pd[2] : pd[3];
    const int qA = kA + DPP_I(sA, 0xB1), qB = kB + DPP_I(sB, 0xB1);
    const int kp = b1 ? qB : qA, sd = b1 ? qA : qB;
    int tot = kp + DPP_I(sd, 0x4E);
    tot += DPP_I(tot, 0x124);
    tot += DPP_I(tot, 0x128);
    tot += __builtin_amdgcn_ds_swizzle(tot, 0x401F);
    { auto rr = __builtin_amdgcn_permlane32_swap((unsigned)tot, (unsigned)tot, false, false); tot = (int)rr[0] + (int)rr[1]; }
    const int j3 = lane & 3;
    const float su_sel = (j3 == 0) ? B.su[0] : (j3 == 1 ? B.su[1] : (j3 == 2 ? B.su[2] : B.su[3]));
    const float ge = gelu_erf((float)tot * sx * su_sel);
#pragma unroll
    for (int j = 0; j < 4; ++j) {
        const float cf = B.gate[j] * B.sv[j] * __uint_as_float((unsigned)__builtin_amdgcn_readlane((int)__float_as_uint(ge), j));
#pragma unroll
        for (int q = 0; q < 4; ++q) {
            const int w = (int)B.V[j][q];
            const f32x2 lo = __builtin_amdgcn_cvt_pk_f32_fp8(w, false), hi = __builtin_amdgcn_cvt_pk_f32_fp8(w, true);
            acc[4 * q] += cf * lo[0]; acc[4 * q + 1] += cf * lo[1]; acc[4 * q + 2] += cf * hi[0]; acc[4 * q + 3] += cf * hi[1];
        }
    }
}

DI void gather_token(const Params& p, size_t tok, int lane, float* dst_base) {
    char* ws = p.ws;
    const bf16_t* hrow = (const bf16_t*)(ws + OFF_HB) + tok * 1024 + 16 * lane;
    float hv[16];
    {
        const u32x4 w0 = ldu4(hrow), w1 = ldu4(hrow + 8);
#pragma unroll
        for (int e = 0; e < 4; ++e) { hv[2 * e] = bf_lo(w0[e]); hv[2 * e + 1] = bf_hi(w0[e]); hv[8 + 2 * e] = bf_lo(w1[e]); hv[8 + 2 * e + 1] = bf_hi(w1[e]); }
    }
    float rs;
    {
        const float* SS = (const float*)(ws + OFF_SS2) + tok * 16;
        const f32x4 s0 = *(const f32x4*)SS, s1 = *(const f32x4*)(SS + 4), s2 = *(const f32x4*)(SS + 8), s3 = *(const f32x4*)(SS + 12);
        const float tot = (s0[0] + s0[1] + s0[2] + s0[3]) + (s1[0] + s1[1] + s1[2] + s1[3]) + (s2[0] + s2[1] + s2[2] + s2[3]) + (s3[0] + s3[1] + s3[2] + s3[3]);
        rs = rsqrtf(tot * (1.0f / 1024.0f) + 1e-6f);
    }
    float xf[16]; float am = 0.f;
#pragma unroll
    for (int i = 0; i < 4; ++i) {
        const f32x4 g = *(const f32x4*)(p.norm_ffn + 16 * lane + 4 * i);
#pragma unroll
        for (int e = 0; e < 4; ++e) { xf[4 * i + e] = hv[4 * i + e] * rs * g[e]; am = fmaxf(am, fabsf(xf[4 * i + e])); }
    }
#pragma unroll
    for (int o = 32; o; o >>= 1) am = fmaxf(am, __shfl_xor(am, o));
    const float sx = (am > 0.f) ? am * (1.0f / 127.0f) : 1.0f;
    const float isx = 1.0f / sx;
    unsigned qx[4];
#pragma unroll
    for (int i = 0; i < 4; ++i) {
        unsigned w = 0u;
#pragma unroll
        for (int e = 0; e < 4; ++e) w |= ((unsigned)(int)rintf(xf[4 * i + e] * isx) & 0xFFu) << (8 * e);
        qx[i] = w;
    }
    const unsigned idpair = *((const unsigned*)(ws + OFF_SELID) + tok * 64 + lane);
    const f32x2 gpair = *((const f32x2*)(ws + OFF_SELG) + tok * 64 + lane);
    float acc[16]; float csum = 0.f;
#pragma unroll
    for (int i = 0; i < 16; ++i) acc[i] = 0.f;
    GBatch B0, B1;
    gather_load(B0, ws, idpair, gpair, 0, lane);
#pragma unroll 1
    for (int eb = 0; eb < 128; eb += 8) {
        gather_load(B1, ws, idpair, gpair, eb + 4, lane);
        gather_compute(B0, qx, sx, acc, csum, lane);
        if (eb + 8 < 128) gather_load(B0, ws, idpair, gpair, eb + 8, lane);
        gather_compute(B1, qx, sx, acc, csum, lane);
    }
    float ss = 0.f;
#pragma unroll
    for (int i = 0; i < 16; ++i) { acc[i] = acc[i] - 128.0f * csum + hv[i]; ss += acc[i] * acc[i]; }
#pragma unroll
    for (int o = 32; o; o >>= 1) ss += __shfl_xor(ss, o);
    const float rf = rsqrtf(ss * (1.0f / 1024.0f) + 1e-6f);
    float* drow = dst_base + tok * 1024 + 16 * lane;
#pragma unroll
    for (int i = 0; i < 4; ++i) {
        const f32x4 n = *(const f32x4*)(p.norm_final + 16 * lane + 4 * i);
        *(f32x4*)(drow + 4 * i) = (f32x4){acc[4 * i] * rf * n[0], acc[4 * i + 1] * rf * n[1], acc[4 * i + 2] * rf * n[2], acc[4 * i + 3] * rf * n[3]};
    }
}

DI void phase_gather(const Params& p, bool dry = false) {
    const int lane = otid() & 63, wv = otid() >> 6;
    float* dst = dry ? (float*)(p.ws + OFF_A) : p.out;
    for (int item = vbid(); item < T_TOK / 4; item += vgrid()) gather_token(p, (size_t)item * 4 + wv, lane, dst);
}

constexpr size_t GS_SIDS = OFF_A;
constexpr size_t GS_SGS = GS_SIDS + (size_t)T_TOK * 256;
constexpr size_t GS_OFF = GS_SGS + (size_t)T_TOK * 512;
constexpr size_t GS_XQ = GS_OFF + (size_t)T_TOK * 64;
constexpr size_t GS_SX = GS_XQ + (size_t)T_TOK * 1024;
constexpr size_t GS_ACC = GS_SX + (size_t)T_TOK * 4;
static_assert(GS_ACC + (size_t)T_TOK * 2048 <= OFF_A + 69 * MiB, "gather scratch overflows region A");

DI void gs_load(GBatch& B, const char* __restrict__ ws, unsigned myid, float mygate, int j0, int n, int lane) {
#pragma unroll
    for (int j = 0; j < 4; ++j) {
        const int e = __builtin_amdgcn_readfirstlane(j0 + j);
        const bool ok = e < n;
        const int src = ok ? e : 0;
        const unsigned id = (unsigned)__builtin_amdgcn_readlane((int)myid, src);
        const float g = __uint_as_float((unsigned)__builtin_amdgcn_readlane((int)__float_as_uint(mygate), src));
        B.gate[j] = ok ? g : 0.f;
        const char* urow = ws + OFF_UQ + (size_t)id * 1024;
        const char* vrow = ws + OFF_VQ + (size_t)id * 1024;
        B.U[j] = ldu4(urow + 16 * lane);
        B.V[j] = ldu4(vrow + 16 * lane);
        B.su[j] = ((const float*)(ws + OFF_SU))[id];
        B.sv[j] = ((const float*)(ws + OFF_SV))[id];
    }
}

#ifndef GS_NSL
#define GS_NSL 16
#endif
constexpr int NSL = GS_NSL, NSL_SH = (GS_NSL == 8 ? 11 : (GS_NSL == 16 ? 10 : (GS_NSL == 32 ? 9 : 12))), OFFW = 64;
DI void phase_gather_sliced(const Params& p, char* smem) {
    char* ws = p.ws;
    if ((T_TOK / 8) > 8 * (((int)gridDim.x >> 3) * 8) || ((int)gridDim.x & 7)) { phase_gather(p); return; }
    char* lacc = smem + (threadIdx.x >> 6) * 16384 + (threadIdx.x & 63) * 32;
    unsigned short* lids = (unsigned short*)(smem + 131072 + (threadIdx.x >> 6) * 2048);
    unsigned char* loff = (unsigned char*)(smem + 131072 + 16384 + (threadIdx.x >> 6) * (8 * OFFW));
    const int lane = threadIdx.x & 63;
    const int x = (int)blockIdx.x & 7, nW = ((int)gridDim.x >> 3) * 8, lw = ((int)blockIdx.x >> 3) * 8 + (int)(threadIdx.x >> 6);
    const int TPX = T_TOK / 8;
    for (int tl = lw; tl < TPX; tl += nW) {
        const size_t tok = (size_t)x * TPX + tl;
        const bf16_t* hrow = (const bf16_t*)(ws + OFF_HB) + tok * 1024 + 16 * lane;
        float hv[16];
        {
            const u32x4 w0 = ldu4(hrow), w1 = ldu4(hrow + 8);
#pragma unroll
            for (int e = 0; e < 4; ++e) { hv[2 * e] = bf_lo(w0[e]); hv[2 * e + 1] = bf_hi(w0[e]); hv[8 + 2 * e] = bf_lo(w1[e]); hv[8 + 2 * e + 1] = bf_hi(w1[e]); }
        }
        float rs;
        {
            const float* SS = (const float*)(ws + OFF_SS2) + tok * 16;
            const f32x4 s0 = *(const f32x4*)SS, s1 = *(const f32x4*)(SS + 4), s2 = *(const f32x4*)(SS + 8), s3 = *(const f32x4*)(SS + 12);
            const float tot = (s0[0] + s0[1] + s0[2] + s0[3]) + (s1[0] + s1[1] + s1[2] + s1[3]) + (s2[0] + s2[1] + s2[2] + s2[3]) + (s3[0] + s3[1] + s3[2] + s3[3]);
            rs = rsqrtf(tot * (1.0f / 1024.0f) + 1e-6f);
        }
        float xf[16]; float am = 0.f;
#pragma unroll
        for (int i = 0; i < 4; ++i) {
            const f32x4 g = *(const f32x4*)(p.norm_ffn + 16 * lane + 4 * i);
#pragma unroll
            for (int e = 0; e < 4; ++e) { xf[4 * i + e] = hv[4 * i + e] * rs * g[e]; am = fmaxf(am, fabsf(xf[4 * i + e])); }
        }
#pragma unroll
        for (int o = 32; o; o >>= 1) am = fmaxf(am, __shfl_xor(am, o));
        const float sx = (am > 0.f) ? am * (1.0f / 127.0f) : 1.0f;
        const float isx = 1.0f / sx;
        u32x4 qx;
#pragma unroll
        for (int i = 0; i < 4; ++i) {
            unsigned w = 0u;
#pragma unroll
            for (int e = 0; e < 4; ++e) w |= ((unsigned)(int)rintf(xf[4 * i + e] * isx) & 0xFFu) << (8 * e);
            qx[i] = w;
        }
        *(u32x4*)(ws + GS_XQ + tok * 1024 + 16 * lane) = qx;
        if (lane == 0) ((float*)(ws + GS_SX))[tok] = sx;
        const unsigned idpair = *((const unsigned*)(ws + OFF_SELID) + tok * 64 + lane);
        const f32x2 gpair = *((const f32x2*)(ws + OFF_SELG) + tok * 64 + lane);
        const unsigned id0 = idpair & 0xFFFFu, id1 = idpair >> 16;
        const int sl0 = (int)(id0 >> NSL_SH), sl1 = (int)(id1 >> NSL_SH);
        const unsigned long long lt = (1ull << lane) - 1ull;
        int base = 0, pos0 = 0, pos1 = 0, myoff = 0;
#pragma unroll
        for (int s = 0; s < NSL; ++s) {
            const unsigned long long m0 = __ballot(sl0 == s), m1 = __ballot(sl1 == s);
            const int c0 = __popcll(m0), c1 = __popcll(m1);
            if (sl0 == s) pos0 = base + __popcll(m0 & lt);
            if (sl1 == s) pos1 = base + c0 + __popcll(m1 & lt);
            if (lane == s) myoff = base;
            base += c0 + c1;
        }
        if (lane == NSL) myoff = base;
        unsigned short* sid = (unsigned short*)(ws + GS_SIDS) + tok * 128;
        float* sg = (float*)(ws + GS_SGS) + tok * 128;
        sid[pos0] = (unsigned short)id0; sid[pos1] = (unsigned short)id1;
        { const int k = (tl - lw) / nW; lids[k * 128 + pos0] = (unsigned short)id0; lids[k * 128 + pos1] = (unsigned short)id1; if (lane <= NSL) loff[k * OFFW + lane] = (unsigned char)myoff; }
        sg[pos0] = gpair[0]; sg[pos1] = gpair[1];

    }
    __syncthreads();
    const int ntk = (TPX - lw + nW - 1) / nW;
    for (int k = 0; k < ntk; ++k) { *(u32x4*)(lacc + k * 2048) = (u32x4){0u, 0u, 0u, 0u}; *(u32x4*)(lacc + k * 2048 + 16) = (u32x4){0u, 0u, 0u, 0u}; }
    const float* SGS = (const float*)(ws + GS_SGS);
    struct SB { u32x4 U[4], V[4], qx; float su_v, gsv_v, sx; int k; };
#pragma unroll 1
    for (int pass = 0; pass < NSL; ++pass) {
        const int slice = (pass + (NSL / 8) * x) & (NSL - 1);
        int kL = 0, jL = 0, nL = 0, oL = 0;
        float acc[16]; int kC = -1;
#define GS_OPEN(k_) do { oL = __builtin_amdgcn_readfirstlane((int)loff[(k_) * OFFW + slice]); nL = __builtin_amdgcn_readfirstlane((int)loff[(k_) * OFFW + slice + 1]) - oL; jL = 0; } while (0)
#define GS_ADVANCE(ok_) do { if (jL + 4 < nL) { jL += 4; ok_ = true; } else if (kL + 1 >= ntk) ok_ = false; else { ++kL; GS_OPEN(kL); ok_ = true; } } while (0)
#define GS_LOAD(B_, valid_) do { const size_t tok_ = (size_t)x * TPX + lw + (size_t)kL * nW; \
            const int el_ = jL + (lane & 3); const bool okl_ = el_ < nL; const int il_ = oL + (okl_ ? el_ : 0);            \
            const unsigned idv_ = (unsigned)lids[kL * 128 + (il_ & 127)]; \
            const float gv_ = SGS[tok_ * 128 + (il_ & 127)]; \
            B_.su_v = ((const float*)(ws + OFF_SU))[idv_]; B_.gsv_v = (okl_ ? gv_ : 0.f) * ((const float*)(ws + OFF_SV))[idv_]; \
            _Pragma("unroll") for (int j = 0; j < 4; ++j) { const unsigned id_ = (unsigned)__builtin_amdgcn_readlane((int)idv_, j); \
                B_.U[j] = ldu4(ws + OFF_UQ + (size_t)id_ * 1024 + 16 * lane); B_.V[j] = ldu4(ws + OFF_VQ + (size_t)id_ * 1024 + 16 * lane); } \
            B_.qx = ldu4(ws + GS_XQ + tok_ * 1024 + 16 * lane); B_.sx = ((const float*)(ws + GS_SX))[tok_]; B_.k = (valid_) ? kL : -1; } while (0)
#define GS_FLUSH() do { if (kC >= 0) { const size_t tok_ = (size_t)x * TPX + lw + (size_t)kC * nW; \
            if (pass < NSL - 1) { char* la_ = lacc + kC * 2048; u32x4 w0_, w1_; \
                _Pragma("unroll") for (int e = 0; e < 4; ++e) { w0_[e] = pack2(acc[2 * e], acc[2 * e + 1]); w1_[e] = pack2(acc[8 + 2 * e], acc[8 + 2 * e + 1]); } \
                *(u32x4*)la_ = w0_; *(u32x4*)(la_ + 16) = w1_; } \
            else { const bf16_t* hrow_ = (const bf16_t*)(ws + OFF_HB) + tok_ * 1024 + 16 * lane; const u32x4 w0_ = ldu4(hrow_), w1_ = ldu4(hrow_ + 8); float ss_ = 0.f; \
                _Pragma("unroll") for (int e = 0; e < 4; ++e) { acc[2 * e] += bf_lo(w0_[e]); acc[2 * e + 1] += bf_hi(w0_[e]); acc[8 + 2 * e] += bf_lo(w1_[e]); acc[8 + 2 * e + 1] += bf_hi(w1_[e]); } \
                _Pragma("unroll") for (int i = 0; i < 16; ++i) ss_ += acc[i] * acc[i]; \
                _Pragma("unroll") for (int o = 32; o; o >>= 1) ss_ += __shfl_xor(ss_, o); \
                const float rf_ = rsqrtf(ss_ * (1.0f / 1024.0f) + 1e-6f); float* drow_ = p.out + tok_ * 1024 + 16 * lane; \
                _Pragma("unroll") for (int i = 0; i < 4; ++i) { const f32x4 nn_ = *(const f32x4*)(p.norm_final + 16 * lane + 4 * i); \
                    *(f32x4*)(drow_ + 4 * i) = (f32x4){acc[4 * i] * rf_ * nn_[0], acc[4 * i + 1] * rf_ * nn_[1], acc[4 * i + 2] * rf_ * nn_[2], acc[4 * i + 3] * rf_ * nn_[3]}; } } } } while (0)
#define GS_CONSUME(B_) do { if (B_.k >= 0) { \
            if (B_.k != kC) { GS_FLUSH(); kC = B_.k; const char* la_ = lacc + kC * 2048; const u32x4 w0_ = *(const u32x4*)la_, w1_ = *(const u32x4*)(la_ + 16); \
                _Pragma("unroll") for (int e = 0; e < 4; ++e) { acc[2 * e] = bf_lo(w0_[e]); acc[2 * e + 1] = bf_hi(w0_[e]); acc[8 + 2 * e] = bf_lo(w1_[e]); acc[8 + 2 * e + 1] = bf_hi(w1_[e]); } } \
            int pd_[4]; \
            _Pragma("unroll") for (int j = 0; j < 4; ++j) { int d_ = 0; _Pragma("unroll") for (int q = 0; q < 4; ++q) d_ = __builtin_amdgcn_sdot4((int)B_.U[j][q], (int)B_.qx[q], d_, false); pd_[j] = d_; } \
            const bool b0_ = lane & 1, b1_ = lane & 2; \
            const int kA_ = b0_ ? pd_[1] : pd_[0], kB_ = b0_ ? pd_[3] : pd_[2], sA_ = b0_ ? pd_[0] : pd_[1], sB_ = b0_ ? pd_[2] : pd_[3]; \
            const int qA_ = kA_ + DPP_I(sA_, 0xB1), qB_ = kB_ + DPP_I(sB_, 0xB1); \
            const int kp_ = b1_ ? qB_ : qA_, sd_ = b1_ ? qA_ : qB_; \
            int tot_ = kp_ + DPP_I(sd_, 0x4E); tot_ += DPP_I(tot_, 0x124); tot_ += DPP_I(tot_, 0x128); tot_ += __builtin_amdgcn_ds_swizzle(tot_, 0x401F); \
            { auto rr_ = __builtin_amdgcn_permlane32_swap((unsigned)tot_, (unsigned)tot_, false, false); tot_ = (int)rr_[0] + (int)rr_[1]; } \
            const float cfv_ = B_.gsv_v * gelu_erf((float)tot_ * B_.sx * B_.su_v); \
            _Pragma("unroll") for (int j = 0; j < 4; ++j) { const float cf_ = __uint_as_float((unsigned)__builtin_amdgcn_readlane((int)__float_as_uint(cfv_), j)); \
                _Pragma("unroll") for (int q = 0; q < 4; ++q) { const int w_ = (int)B_.V[j][q]; const f32x2 lo_ = __builtin_amdgcn_cvt_pk_f32_fp8(w_, false), hi_ = __builtin_amdgcn_cvt_pk_f32_fp8(w_, true); \
                    acc[4 * q] += cf_ * lo_[0]; acc[4 * q + 1] += cf_ * lo_[1]; acc[4 * q + 2] += cf_ * hi_[0]; acc[4 * q + 3] += cf_ * hi_[1]; } } } } while (0)
        SB S0, S1;
        bool h0, h1;
        GS_OPEN(0);
        GS_LOAD(S0, true);
#pragma unroll 1
        for (;;) {
            GS_ADVANCE(h1); GS_LOAD(S1, h1);
            GS_CONSUME(S0);
            if (!h1) break;
            GS_ADVANCE(h0); GS_LOAD(S0, h0);
            GS_CONSUME(S1);
            if (!h0) break;
        }
        GS_FLUSH();
#undef GS_OPEN
#undef GS_ADVANCE
#undef GS_LOAD
#undef GS_FLUSH
#undef GS_CONSUME
    }
}
constexpr int LDS_BYTES = 131072 + 16384 + 4096;
constexpr int NPHASE = 12;
template <int PH> DI void run_phase(const Params& p, char* smem) {
    char* lds = smem + vhalf() * 65536;
    if (PH == 0) phase_prep(p, lds);
    else if (PH == 1) phase_p1(p, smem);
    else if (PH == 2) phase_p2(p, smem);
    else if (PH == 3) phase_p3(p, lds);
    else if (PH == 4) phase_p35(p, lds);
    else if (PH == 5) phase_resid<false>(p, smem, OFF_WT_OUT, OFF_MIXED, p.x, OFF_SS1);
    else if (PH == 6) phase_rowscale(p, smem, OFF_WT_MQ, 1024, (bf16_t*)(p.ws + OFF_QM), OFF_SS1, 0.0625f * LOG2E);
    else if (PH == 7) phase_memattn(p, lds);
    else if (PH == 8) phase_resid<true>(p, smem, OFF_WT_MO, OFF_OM, p.ws + OFF_HB, OFF_SS2);
    else if (PH == 9) phase_rowscale(p, smem, OFF_WT_PQ, 2048, (bf16_t*)((char*)p.out + OUT_PQ), OFF_SS2, 1.0f);
    else if (PH == 10) phase_select(p, lds);
    else if (PH == 11) phase_gather_sliced(p, smem);
}

template <int PH> __global__ void __launch_bounds__(512, 2) k_phase(Params p) {
    __shared__ __attribute__((aligned(16))) char smem[LDS_BYTES];
    run_phase<PH>(p, smem);
}

static Params make_params(void* const* d_in, void* d_out, void* d_ws) {
    Params p;
    memset(&p, 0, sizeof(p));
    p.x = (const float*)d_in[0]; p.mem = (const float*)d_in[1]; p.norm_mix = (const float*)d_in[2]; p.w_in = (const float*)d_in[3];
    p.q_norm = (const float*)d_in[4]; p.kv_norm = (const float*)d_in[5]; p.w_uq = (const float*)d_in[6]; p.w_ukv = (const float*)d_in[7];
    p.gn_mla = (const float*)d_in[8]; p.gn_dil = (const float*)d_in[9]; p.w_out = (const float*)d_in[10]; p.norm_mem_q = (const float*)d_in[11];
    p.norm_mem_kv = (const float*)d_in[12]; p.w_mem_q = (const float*)d_in[13]; p.w_mem_kv = (const float*)d_in[14]; p.w_mem_o = (const float*)d_in[15];
    p.norm_ffn = (const float*)d_in[16]; p.peer_w_q = (const float*)d_in[17]; p.sub_keys = (const float*)d_in[18]; p.peer_u = (const float*)d_in[19];
    p.peer_v = (const float*)d_in[20]; p.norm_final = (const float*)d_in[21];
    p.out = (float*)d_out; p.ws = (char*)d_ws;
    for (int i = 0; i < 16; ++i) p.inv_freq[i] = 1.0f / powf(10000.0f, (float)(2 * i) / 32.0f);
    return p;
}
__global__ void __launch_bounds__(512, 2) k_mega(Params p) {
    __shared__ __attribute__((aligned(16))) char smem[LDS_BYTES + 16];
    volatile LAS unsigned* st = (volatile LAS unsigned*)(LAS char*)(smem + LDS_BYTES);
    if (threadIdx.x == 0) { st[0] = 0u; st[1] = 0u; st[2] = 0u; st[3] = 0u; }
    __syncthreads();
    const XcdBarrier xb = xcd_barrier_post((unsigned*)(p.ws + OFF_BAR), st);
#define RP(n) run_phase<n>(p, smem); xcd_barrier(xb);
    RP(0) RP(1) RP(2) RP(3) RP(4) RP(5) RP(6) RP(7) RP(8) RP(9) RP(10)
    run_phase<11>(p, smem);
}

extern "C" void kernel_launch(void* const* d_in, const int* in_sizes, int n_in, void* d_out, int out_size, void* d_ws, size_t ws_size,
                              hipStream_t stream) {
    static int grid_blocks = 0;
    if (!grid_blocks) {
        int dev = 0, cus = 0, per_cu = 0;
        (void)hipGetDevice(&dev);
        (void)hipDeviceGetAttribute(&cus, hipDeviceAttributeMultiprocessorCount, dev);
        (void)hipOccupancyMaxActiveBlocksPerMultiprocessor(&per_cu, k_mega, 512, 0);
        if (per_cu > 1) per_cu = 1;
        if (per_cu < 1) per_cu = 1;
        grid_blocks = cus * per_cu;
    }
    Params p = make_params(d_in, d_out, d_ws);
    (void)hipMemsetAsync((char*)d_ws + OFF_BAR, 0, XCD_BAR_WORDS * 4, stream);
    void* args[] = {&p};
    hipError_t e = hipLaunchCooperativeKernel((const void*)k_mega, dim3(grid_blocks), dim3(512), args, 0, stream);
    if (e != hipSuccess) fprintf(stderr, "cooperative launch failed: %s (grid %d)\n", hipGetErrorString(e), grid_blocks);
}
```

```cpp
#include <hip/hip_runtime.h>
#include <hip/hip_cooperative_groups.h>
#include <math.h>
#include <stdint.h>
#include <stdio.h>
#include <string.h>
#define DI __device__ __forceinline__
typedef unsigned short bf16_t;
typedef short bf16x8 __attribute__((ext_vector_type(8)));
typedef short s16x4 __attribute__((ext_vector_type(4)));
typedef float f32x16 __attribute__((ext_vector_type(16)));
typedef float f32x4 __attribute__((ext_vector_type(4)));
typedef float f32x2 __attribute__((ext_vector_type(2)));
typedef unsigned u32x4 __attribute__((ext_vector_type(4)));
typedef unsigned u32x2 __attribute__((ext_vector_type(2)));
typedef __bf16 bf16x2v __attribute__((ext_vector_type(2)));
#define LAS __attribute__((address_space(3)))
#define MFMA32(a, b, c) __builtin_amdgcn_mfma_f32_32x32x16_bf16((a), (b), (c), 0, 0, 0)

constexpr int T_TOK = 16384, SEQ_L = 4096, DM = 1024, INC = 2208;
constexpr float LOG2E = 1.4426950408889634f;

DI int otid() { int t = threadIdx.x & 255; asm volatile("" : "+v"(t)); return t; }
DI int vhalf() { return __builtin_amdgcn_readfirstlane((int)(threadIdx.x >> 8)); }
DI int vbid() { return (int)blockIdx.x * 2 + vhalf(); }
DI int vgrid() { return (int)gridDim.x * 2; }
DI unsigned pack2(float lo, float hi) { f32x2 f = {lo, hi}; return __builtin_bit_cast(unsigned, __builtin_convertvector(f, bf16x2v)); }
DI float bf_lo(unsigned u) { return __uint_as_float(u << 16); }
DI float bf_hi(unsigned u) { return __uint_as_float(u & 0xffff0000u); }
DI float bf2f(bf16_t v) { return __uint_as_float(((unsigned)v) << 16); }
DI int crow(int reg, int hh) { return (reg & 3) + 8 * (reg >> 2) + 4 * hh; }
DI f32x16 zero16() { f32x16 z;
#pragma unroll
    for (int i = 0; i < 16; ++i) z[i] = 0.f; return z; }
DI float xhalf_max(float v) { auto r = __builtin_amdgcn_permlane32_swap(__float_as_uint(v), __float_as_uint(v), false, false); return fmaxf(__uint_as_float(r[0]), __uint_as_float(r[1])); }
DI float xhalf_other(float v, int lane) { auto r = __builtin_amdgcn_permlane32_swap(__float_as_uint(v), __float_as_uint(v), false, false); return __uint_as_float((lane & 32) ? r[0] : r[1]); }
DI float xhalf_sum(float v) { auto r = __builtin_amdgcn_permlane32_swap(__float_as_uint(v), __float_as_uint(v), false, false); return __uint_as_float(r[0]) + __uint_as_float(r[1]); }
DI bf16x8 ld16(const void* p) { return *(const bf16x8*)p; }
DI u32x4 ldu4(const void* p) { return *(const u32x4*)p; }
DI float fast_exp2(float x) { return __builtin_amdgcn_exp2f(x); }
DI bf16x8 pack_step(const f32x16& x, int s) {
    u32x4 p;
    p[0] = pack2(x[8 * s + 0], x[8 * s + 1]); p[1] = pack2(x[8 * s + 2], x[8 * s + 3]);
    p[2] = pack2(x[8 * s + 4], x[8 * s + 5]); p[3] = pack2(x[8 * s + 6], x[8 * s + 7]);
    return __builtin_bit_cast(bf16x8, p);
}
DI s16x4 tr_read_a(unsigned lds_byte_addr) { s16x4 r; asm volatile("ds_read_b64_tr_b16 %0, %1" : "=v"(r) : "v"(lds_byte_addr)); return r; }
template <int OFF> DI s16x4 tr_read_ao(unsigned lds_byte_addr) { s16x4 r; asm volatile("ds_read_b64_tr_b16 %0, %1 offset:%2" : "=v"(r) : "v"(lds_byte_addr), "i"(OFF)); return r; }
#define TR_WAIT() do { asm volatile("s_waitcnt lgkmcnt(0)" ::: "memory"); __builtin_amdgcn_sched_barrier(0); } while (0)
DI s16x4 tr_read(unsigned lds_byte_addr) {
    return __builtin_amdgcn_ds_read_tr16_b64_v4i16((LAS s16x4*)(uintptr_t)lds_byte_addr);
}

constexpr size_t MiB = 1ull << 20;
constexpr size_t OFF_BAR = 0;
constexpr size_t OFF_WT_IN = 65536;
constexpr size_t OFF_WT_UQ = OFF_WT_IN + 2304ull * 1024 * 2;
constexpr size_t OFF_WT_UKV = OFF_WT_UQ + 768ull * 384 * 2;
constexpr size_t OFF_WT_OUT = OFF_WT_UKV + 1024ull * 256 * 2;
constexpr size_t OFF_WT_MQ = OFF_WT_OUT + 1024ull * 1024 * 2;
constexpr size_t OFF_WT_MKV = OFF_WT_MQ + 1024ull * 1024 * 2;
constexpr size_t OFF_WT_MO = OFF_WT_MKV + 2048ull * 1024 * 2;
constexpr size_t OFF_WT_PQ = OFF_WT_MO + 1024ull * 1024 * 2;
constexpr size_t OFF_KEYS = OFF_WT_PQ + 2048ull * 1024 * 2;
constexpr size_t OFF_ROPE = OFF_KEYS + 16ull * 128 * 128 * 2;
constexpr size_t OFF_KR = OFF_ROPE + 2ull * 4096 * 16 * 4;
constexpr size_t OFF_LSE = OFF_KR + (size_t)T_TOK * 32 * 2;
constexpr size_t OFF_SS1 = OFF_LSE + 3ull * T_TOK * 8 * 4;
constexpr size_t OFF_SS2 = OFF_SS1 + (size_t)T_TOK * 16 * 4;
constexpr size_t OFF_MEMN = OFF_SS2 + (size_t)T_TOK * 16 * 4;
constexpr size_t OFF_SMALL_END = OFF_MEMN + 1024ull * 1024 * 2;
static_assert(OFF_SMALL_END <= 28 * MiB, "small region overflow");
constexpr size_t OFF_A = 28 * MiB;
constexpr size_t OFF_PROJ = OFF_A;
constexpr size_t OFF_UQ = 193 * MiB;
constexpr size_t OFF_VQ = 209 * MiB;
constexpr size_t OFF_SU = 243 * MiB;
constexpr size_t OFF_SV = OFF_SU + 65536;
constexpr size_t OUT_ODIL = 0;
constexpr size_t OUT_OMLA = 48 * MiB;
constexpr size_t OUT_PQ = 0;
constexpr size_t OFF_B = 97 * MiB;
constexpr size_t OFF_XN = OFF_B, OFF_QMLA = OFF_B, OFF_MIXED = OFF_B, OFF_QM = OFF_B;
constexpr size_t OFF_C = 129 * MiB;
constexpr size_t OFF_KVMLA = OFF_C, OFF_HB = OFF_C;
constexpr size_t OFF_D = 161 * MiB;
constexpr size_t OFF_OM = OFF_D;
constexpr size_t OFF_SELID = 225 * MiB;
constexpr size_t OFF_SELG = 229 * MiB;
constexpr size_t OFF_KVM = 237 * MiB;
constexpr size_t OFF_SSQ = 241 * MiB;
constexpr size_t WS_NEEDED = 244 * MiB;

struct Params {
    const float* x; const float* mem; const float* norm_mix; const float* w_in; const float* q_norm; const float* kv_norm;
    const float* w_uq; const float* w_ukv; const float* gn_mla; const float* gn_dil; const float* w_out; const float* norm_mem_q;
    const float* norm_mem_kv; const float* w_mem_q; const float* w_mem_kv; const float* w_mem_o; const float* norm_ffn;
    const float* peer_w_q; const float* sub_keys; const float* peer_u; const float* peer_v; const float* norm_final;
    float* out; char* ws;
    float inv_freq[16];
    int prof; int pad_;
};
#define XB_TMO      128
#define XB_XCNT(j)  (256  + 64 * (j))
#define XB_XSUB(j)  (1280 + 64 * (j))
#define XB_XGEN(j)  (2304 + 64 * (j))
#define XB_TOP      3328
#define XB_TOPGEN   3392
#define XCD_BAR_WORDS 3456
#define XB_SPIN_CAP (1u << 20)
DI unsigned xb_ld(unsigned* p) { return __hip_atomic_load(p, __ATOMIC_RELAXED, __HIP_MEMORY_SCOPE_AGENT); }
DI unsigned xb_add(unsigned* p, unsigned v) { return __hip_atomic_fetch_add(p, v, __ATOMIC_RELAXED, __HIP_MEMORY_SCOPE_AGENT); }
DI unsigned xb_xcc_id() { return (unsigned)__builtin_amdgcn_s_getreg((3 << 11) | 20) & 0xFu; }
#define XB_SPIN(cond, bar) do { unsigned _sp = 0; while (cond) { __builtin_amdgcn_s_sleep(1); \
    if ((++_sp & 255u) == 0u) { if (xb_ld(&(bar)[XB_TMO])) break; if (_sp > XB_SPIN_CAP) { atomicAdd(&(bar)[XB_TMO], 1u); break; } } } } while (0)
struct XcdBarrier { unsigned* bar; unsigned x; volatile LAS unsigned* st; };
DI XcdBarrier xcd_barrier_post(unsigned* bar, volatile LAS unsigned* st) {
    XcdBarrier b; b.bar = bar; b.x = xb_xcc_id(); b.st = st;
    if (threadIdx.x == 0) (void)xb_add(&bar[XB_XCNT(b.x)], 1u);
    return b;
}
DI void xcd_barrier_complete(unsigned* bar, unsigned x, unsigned& nloc, unsigned& nx) {
    const unsigned G = gridDim.x * gridDim.y * gridDim.z;
    unsigned sum, cnt, mine, sp = 0u;
    for (;;) {
        sum = 0u; cnt = 0u; mine = 0u;
#pragma unroll
        for (unsigned j = 0; j < 16; ++j) { const unsigned c = xb_ld(&bar[XB_XCNT(j)]); sum += c; cnt += (c > 0u) ? 1u : 0u; mine = (j == x) ? c : mine; }
        if (sum == G) break;
        __builtin_amdgcn_s_sleep(1);
        if ((++sp & 255u) == 0u) { if (xb_ld(&bar[XB_TMO])) break; if (sp > XB_SPIN_CAP) { atomicAdd(&bar[XB_TMO], 1u); break; } }
    }
    nloc = mine > 0u ? mine : 1u; nx = cnt > 0u ? cnt : 1u;
}
DI void xcd_barrier(const XcdBarrier& b) {
    asm volatile("s_waitcnt vmcnt(0)" ::: "memory");
    __syncthreads();
    if (threadIdx.x == 0) {
        unsigned* bar = b.bar;
        __builtin_amdgcn_s_waitcnt(0);
        unsigned nloc = b.st[0], nx = b.st[1];
        if (nloc == 0u) { xcd_barrier_complete(bar, b.x, nloc, nx); b.st[0] = nloc; b.st[1] = nx; }
        const unsigned old = xb_add(&bar[XB_XSUB(b.x)], 1u);
        const unsigned gen = old / nloc;
        if (old + 1u == (gen + 1u) * nloc) {
            __builtin_amdgcn_fence(__ATOMIC_RELEASE, "agent");
            asm volatile("s_waitcnt vmcnt(0)" ::: "memory");
            const unsigned og = xb_add(&bar[XB_TOP], 1u);
            const unsigned tg = og / nx;
            if (og + 1u == (tg + 1u) * nx) xb_add(&bar[XB_TOPGEN], 1u);
            else XB_SPIN(xb_ld(&bar[XB_TOPGEN]) == tg, bar);
            __builtin_amdgcn_fence(__ATOMIC_ACQUIRE, "agent");
            xb_add(&bar[XB_XGEN(b.x)], 1u);
            asm volatile("s_waitcnt vmcnt(0)" ::: "memory");
        } else {
            XB_SPIN(xb_ld(&bar[XB_XGEN(b.x)]) == gen, bar);
            __builtin_amdgcn_fence(__ATOMIC_ACQUIRE, "agent");
            asm volatile("s_waitcnt vmcnt(0)" ::: "memory");
        }
    }
    __syncthreads();
}
DI void transpose_tile(const float* __restrict__ W, int K, int N, const float* __restrict__ g, bf16_t* __restrict__ Wt, int kt, int nt, char* lds, bool valid) {
    float* sm = (float*)lds;
    const int t = otid();
    const int k0 = kt * 64, n0 = nt * 64;
    __syncthreads();
#pragma unroll
    for (int i = 0; i < 16; ++i) {
        const int id = t + 256 * i, k = id >> 6, n = id & 63;
        float v = 0.f;
        if (valid && n0 + n < N) { v = W[(size_t)(k0 + k) * N + n0 + n]; if (g) v *= g[k0 + k]; }
        sm[k * 65 + n] = v;
    }
    __syncthreads();
    const int n = t >> 2, kc = (t & 3) * 16;
    u32x4 o0, o1;
    o0[0] = pack2(sm[(kc + 0) * 65 + n], sm[(kc + 1) * 65 + n]); o0[1] = pack2(sm[(kc + 2) * 65 + n], sm[(kc + 3) * 65 + n]);
    o0[2] = pack2(sm[(kc + 4) * 65 + n], sm[(kc + 5) * 65 + n]); o0[3] = pack2(sm[(kc + 6) * 65 + n], sm[(kc + 7) * 65 + n]);
    o1[0] = pack2(sm[(kc + 8) * 65 + n], sm[(kc + 9) * 65 + n]); o1[1] = pack2(sm[(kc + 10) * 65 + n], sm[(kc + 11) * 65 + n]);
    o1[2] = pack2(sm[(kc + 12) * 65 + n], sm[(kc + 13) * 65 + n]); o1[3] = pack2(sm[(kc + 14) * 65 + n], sm[(kc + 15) * 65 + n]);
    bf16_t* dst = Wt + (size_t)(n0 + n) * K + k0 + kc;
    if (valid) { *(u32x4*)dst = o0; *(u32x4*)(dst + 8) = o1; }
}

DI void rmsnorm_row_bf16(const float* __restrict__ in, const float* __restrict__ g, bf16_t* __restrict__ out, int lane) {
    f32x4 v[4]; float ss = 0.f;
#pragma unroll
    for (int i = 0; i < 4; ++i) { v[i] = *(const f32x4*)(in + 4 * lane + 256 * i); ss += v[i][0] * v[i][0] + v[i][1] * v[i][1] + v[i][2] * v[i][2] + v[i][3] * v[i][3]; }
#pragma unroll
    for (int o = 32; o; o >>= 1) ss += __shfl_xor(ss, o);
    const float rs = rsqrtf(ss * (1.0f / 1024.0f) + 1e-6f);
#pragma unroll
    for (int i = 0; i < 4; ++i) {
        const f32x4 gg = *(const f32x4*)(g + 4 * lane + 256 * i);
        u32x2 o; o[0] = pack2(v[i][0] * rs * gg[0], v[i][1] * rs * gg[1]); o[1] = pack2(v[i][2] * rs * gg[2], v[i][3] * rs * gg[3]);
        *(u32x2*)(out + 4 * lane + 256 * i) = o;
    }
}

struct TrJob { const float* W; const float* g; size_t off; int K, N, Npad; };

DI void phase_prep(const Params& p, char* lds) {
    char* ws = p.ws;
    const int t = otid(), lane = t & 63, wv = t >> 6;
    const int c0 = 576, c1 = c0 + 72, c2 = c1 + 64, c3 = c2 + 256, c4 = c3 + 256, c5 = c4 + 512, c6 = c5 + 256, c7 = c6 + 512;
    const int nrow = (T_TOK + 1024) / 4;
    const int nkeys = 128, nrope = 256;
    const int total = c7 + nrow + nkeys + nrope;
    for (int k = 0; k < (c7 + vgrid() - 1) / vgrid(); ++k) {
        const int raw = vbid() + k * vgrid();
        const bool valid = raw < c7;
        const int item = valid ? raw : 0;
        const float* W; const float* g; size_t off; int K, N, Npad, local;
        if (item < c0)      { W = p.w_in;     g = nullptr;      off = OFF_WT_IN;  K = 1024; N = 2208; Npad = 2304; local = item; }
        else if (item < c1) { W = p.w_uq;     g = p.q_norm;     off = OFF_WT_UQ;  K = 384;  N = 768;  Npad = 768;  local = item - c0; }
        else if (item < c2) { W = p.w_ukv;    g = p.kv_norm;    off = OFF_WT_UKV; K = 256;  N = 1024; Npad = 1024; local = item - c1; }
        else if (item < c3) { W = p.w_out;    g = nullptr;      off = OFF_WT_OUT; K = 1024; N = 1024; Npad = 1024; local = item - c2; }
        else if (item < c4) { W = p.w_mem_q;  g = p.norm_mem_q; off = OFF_WT_MQ;  K = 1024; N = 1024; Npad = 1024; local = item - c3; }
        else if (item < c5) { W = p.w_mem_kv; g = nullptr;      off = OFF_WT_MKV; K = 1024; N = 2048; Npad = 2048; local = item - c4; }
        else if (item < c6) { W = p.w_mem_o;  g = nullptr;      off = OFF_WT_MO;  K = 1024; N = 1024; Npad = 1024; local = item - c5; }
        else                { W = p.peer_w_q; g = p.norm_ffn;   off = OFF_WT_PQ;  K = 1024; N = 2048; Npad = 2048; local = item - c6; }
        const int ntn = Npad / 64;
        transpose_tile(W, K, N, g, (bf16_t*)(ws + off), local / ntn, local % ntn, lds, valid);
    }
    for (int item = c7 + vbid(); item < total; item += vgrid()) {
        if (item < c7 + nrow) {
            const int row = (item - c7) * 4 + wv;
            if (row < T_TOK) rmsnorm_row_bf16(p.x + (size_t)row * 1024, p.norm_mix, (bf16_t*)(ws + OFF_XN) + (size_t)row * 1024, lane);
            else rmsnorm_row_bf16(p.mem + (size_t)(row - T_TOK) * 1024, p.norm_mem_kv, (bf16_t*)(ws + OFF_MEMN) + (size_t)(row - T_TOK) * 1024, lane);
        } else if (item < c7 + nrow + nkeys) {
            const int idx = ((item - c7 - nrow) * 256 + t) * 8;
            const f32x4 a = *(const f32x4*)(p.sub_keys + idx), b = *(const f32x4*)(p.sub_keys + idx + 4);
            u32x4 o; o[0] = pack2(a[0], a[1]); o[1] = pack2(a[2], a[3]); o[2] = pack2(b[0], b[1]); o[3] = pack2(b[2], b[3]);
            *(u32x4*)((bf16_t*)(ws + OFF_KEYS) + idx) = o;
        } else {
            const int idx = (item - c7 - nrow - nkeys) * 256 + t;
            const int s = idx >> 4, i = idx & 15;
            const float ang = (float)s * p.inv_freq[i];
            const double a = (double)ang;
            const double twopi = 6.283185307179586476925;
            const float rf = (float)(a - twopi * rint(a / twopi));
            float* cs = (float*)(ws + OFF_ROPE);
            cs[idx] = cosf(rf); cs[65536 + idx] = sinf(rf);
        }
    }
}
namespace pg8 {
#define PG8_LAS __attribute__((address_space(3)))
typedef unsigned short bf16_t;
typedef short bf16x8 __attribute__((ext_vector_type(8)));
typedef float f32x4 __attribute__((ext_vector_type(4)));
typedef unsigned u32x4 __attribute__((ext_vector_type(4)));
constexpr int BM = 256, BK = 64, HALF = 128, HTB = HALF * BK * 2  , STAGE_BYTES = 8 * HTB, NXCD = 8, WGM = 8;

__host__ __device__ __forceinline__ int lds_byte(int r, int c) { const int st = (r >> 4) * 2 + (c >> 5), rr = r & 15, cc = c & 31, ob = rr * 64 + cc * 2; return st * 1024 + (ob ^ (((ob >> 9) & 1) << 5)); }
__host__ __device__ __forceinline__ void stage_rc(int b, int& R, int& C) { const int st = b / 1024, sb = b % 1024, swz = sb ^ (((sb >> 9) & 1) << 5); R = (st >> 1) * 16 + swz / 64; C = (st & 1) * 32 + (swz % 64) / 2; }
__host__ __device__ __forceinline__ int perm32(int rho) { const int n = rho >> 4, i = rho & 15; return 8 * (i >> 2) + 4 * n + (i & 3); }

struct Unit { int pm, pn; };
struct Gemm { const bf16_t* A; const bf16_t* Bt; int M, N, K, lda; };

struct StaticOrder {
    int nM, nN, nwg, G, c;
    __host__ __device__ void init(int M, int N, int G_, int c_) { nM = M / BM; nN = N / BM; nwg = nM * nN; G = G_; c = c_; }
    __host__ __device__ bool next(int i, Unit& u) const {
        const long L = (long)i * G + c; if (L >= nwg) return false;
        int wgid = (int)L; { const int q = nwg / NXCD, r = nwg % NXCD, xcd = wgid % NXCD, off = wgid / NXCD; wgid = (xcd < r ? xcd * (q + 1) : r * (q + 1) + (xcd - r) * q) + off; }
        const int nig = WGM * nN, gid = wgid / nig, fm = gid * WGM, gsz = (nM - fm) < WGM ? (nM - fm) : WGM;
        u.pm = fm + ((wgid % nig) % gsz); u.pn = (wgid % nig) / gsz; return true;
    }
    __device__ __forceinline__ void a_ready(const Unit&) const {}
    __device__ __forceinline__ void done(const Unit&) const {}
};

template <class Epi, class Sched, bool ALIGN_EPI = false, bool SP2 = false>
__device__ __forceinline__ void gemm_phase(PG8_LAS unsigned char* lds, const Gemm g, const Sched& S, const Epi& E) {
    int tid_ = threadIdx.x; asm volatile("" : "+v"(tid_));
    const int tid = tid_, wid = __builtin_amdgcn_readfirstlane(tid >> 6), lane = tid & 63, wr = wid >> 2, wc = wid & 3, fr = lane & 15, fq = lane >> 4;
    const int K = g.K, nt = K / BK, lda = g.lda;
    unsigned voffA[2], voffB[2];
#pragma unroll
    for (int i = 0; i < 2; ++i) { int R, C; stage_rc(tid * 16 + i * 8192, R, C); const int Rb = Epi::PERM ? ((R & ~31) + perm32(R & 31)) : R;
        voffA[i] = (unsigned)(R * lda + C) * 2u; voffB[i] = (unsigned)(Rb * K + C) * 2u; }
    const size_t kstep = (size_t)(BK * 2);
    const size_t hstepB = (size_t)HALF * K * 2, hstepA = (size_t)HALF * lda * 2;
    const size_t tstepB = 2 * hstepB, tstepA = 2 * hstepA;
    const unsigned ldsw = (unsigned)wid * 1024u;
    const int aoff = lds_byte(wr * 64 + fr, fq * 8), boff = lds_byte(wc * 32 + fr, fq * 8);
#define PG8_SA(b, h) (((b) * 2 + (h)) * HTB)
#define PG8_SB(b, h) ((4 + (b) * 2 + (h)) * HTB)
#define PG8_STAGE(bufoff, gbase, voff) do { _Pragma("unroll") for (int _i = 0; _i < 2; ++_i) \
        __builtin_amdgcn_global_load_lds((const unsigned*)((const char*)(gbase) + (voff)[_i]), (PG8_LAS unsigned*)(lds + (bufoff) + ldsw + _i * 8192), 16, 0, 0); } while (0)
#define PG8_LDA(dst, b, h) do { _Pragma("unroll") for (int m = 0; m < 4; ++m) _Pragma("unroll") for (int k = 0; k < 2; ++k) dst[m][k] = *(const PG8_LAS bf16x8*)(lds + PG8_SA(b, h) + aoff + m * 2048 + k * 1024); } while (0)
#define PG8_LDB(dst, b, h) do { _Pragma("unroll") for (int n = 0; n < 2; ++n) _Pragma("unroll") for (int k = 0; k < 2; ++k) dst[n][k] = *(const PG8_LAS bf16x8*)(lds + PG8_SB(b, h) + boff + n * 2048 + k * 1024); } while (0)
#define PG8_MMA(ai, bj, At, Bt) do { __builtin_amdgcn_s_setprio(1); _Pragma("unroll") for (int m = 0; m < 4; ++m) _Pragma("unroll") for (int n = 0; n < 2; ++n) _Pragma("unroll") for (int k = 0; k < 2; ++k) \
        acc[ai][bj][m][n] = __builtin_amdgcn_mfma_f32_16x16x32_bf16(Bt[n][k], At[m][k], acc[ai][bj][m][n], 0, 0, 0); __builtin_amdgcn_s_setprio(0); } while (0)
#define PG8_WAIT_V(n) asm volatile("s_waitcnt vmcnt(" #n ")" ::: "memory")
#define PG8_WAIT_L(n) asm volatile("s_waitcnt lgkmcnt(" #n ")" ::: "memory")
#define PG8_BAR __builtin_amdgcn_s_barrier()
#define PG8_SCHED __builtin_amdgcn_sched_barrier(0)
    Unit cur, nxt; int ui = 0;
    if (!S.next(0, cur)) return;
    f32x4 acc[2][2][4][2];
#pragma unroll
    for (int a = 0; a < 2; ++a)
#pragma unroll
        for (int b = 0; b < 2; ++b)
#pragma unroll
            for (int m = 0; m < 4; ++m)
#pragma unroll
                for (int n = 0; n < 2; ++n) acc[a][b][m][n] = (f32x4){0.f, 0.f, 0.f, 0.f};
    bf16x8 At[4][2], B0[2][2], B1[2][2];
    const char* cA = (const char*)g.A + (size_t)cur.pm * tstepA; const char* cB = (const char*)g.Bt + (size_t)cur.pn * tstepB;
    S.a_ready(cur);
    if constexpr (SP2) {
        PG8_STAGE(PG8_SB(0, 0), cB, voffB); PG8_STAGE(PG8_SB(0, 1), cB + hstepB, voffB); PG8_STAGE(PG8_SA(0, 0), cA, voffA); PG8_STAGE(PG8_SA(0, 1), cA + hstepA, voffA);
        if (wr == 1) PG8_BAR;
        PG8_WAIT_V(2); PG8_BAR;
        PG8_STAGE(PG8_SB(1, 0), cB + kstep, voffB); PG8_STAGE(PG8_SA(1, 0), cA + kstep, voffA); PG8_STAGE(PG8_SB(1, 1), cB + hstepB + kstep, voffB);
        PG8_WAIT_V(6); PG8_BAR;
    } else {
        PG8_STAGE(PG8_SB(0, 0), cB, voffB); PG8_STAGE(PG8_SA(0, 0), cA, voffA); PG8_STAGE(PG8_SB(0, 1), cB + hstepB, voffB); PG8_STAGE(PG8_SA(0, 1), cA + hstepA, voffA);
        if (wr == 1) PG8_BAR;
        PG8_WAIT_V(4); PG8_BAR;
        PG8_STAGE(PG8_SB(1, 0), cB + kstep, voffB); PG8_STAGE(PG8_SA(1, 0), cA + kstep, voffA); PG8_STAGE(PG8_SB(1, 1), cB + hstepB + kstep, voffB);
        PG8_WAIT_V(6); PG8_BAR;
    }
    for (;;) {
        const bool has_next = S.next(ui + 1, nxt);
        const char* nA = has_next ? (const char*)g.A + (size_t)nxt.pm * tstepA : cA; const char* nB = has_next ? (const char*)g.Bt + (size_t)nxt.pn * tstepB : cB;
#pragma unroll 1
        for (int t = 0; t < nt; t += 2) {
            const bool last = (t == nt - 2);
            const char* a1 = cA + (size_t)(t + 1) * kstep;
            const char* a2 = last ? nA : cA + (size_t)(t + 2) * kstep; const char* b2 = last ? nB : cB + (size_t)(t + 2) * kstep;
            const char* a3 = a2 + kstep; const char* b3 = b2 + kstep;
            if (last && has_next) S.a_ready(nxt);
            if constexpr (SP2) {
            PG8_LDB(B0, 0, 0); PG8_LDB(B1, 0, 1); PG8_SCHED; PG8_LDA(At, 0, 0); PG8_STAGE(PG8_SA(1, 1), a1 + hstepA, voffA);
            PG8_WAIT_V(8); PG8_WAIT_L(0); PG8_BAR; PG8_MMA(0, 0, At, B0); PG8_MMA(0, 1, At, B1); PG8_BAR; PG8_SCHED;
            PG8_LDA(At, 0, 1); PG8_STAGE(PG8_SB(0, 0), b2, voffB); PG8_STAGE(PG8_SB(0, 1), b2 + hstepB, voffB); PG8_STAGE(PG8_SA(0, 0), a2, voffA);
            PG8_WAIT_V(8); PG8_WAIT_L(0); PG8_BAR; PG8_MMA(1, 0, At, B0); PG8_MMA(1, 1, At, B1); PG8_BAR; PG8_SCHED;
            PG8_LDB(B0, 1, 0); PG8_LDB(B1, 1, 1); PG8_SCHED; PG8_LDA(At, 1, 0); PG8_STAGE(PG8_SA(0, 1), a2 + hstepA, voffA);
            PG8_WAIT_V(8); PG8_WAIT_L(0); PG8_BAR; PG8_MMA(0, 0, At, B0); PG8_MMA(0, 1, At, B1); PG8_BAR; PG8_SCHED;
            PG8_LDA(At, 1, 1); PG8_STAGE(PG8_SB(1, 0), b3, voffB); PG8_STAGE(PG8_SB(1, 1), b3 + hstepB, voffB); PG8_STAGE(PG8_SA(1, 0), a3, voffA);
            PG8_WAIT_V(8); PG8_WAIT_L(0); PG8_BAR; PG8_MMA(1, 0, At, B0); PG8_MMA(1, 1, At, B1); PG8_BAR; PG8_SCHED;
            } else {
            PG8_LDB(B0, 0, 0); PG8_SCHED; PG8_LDA(At, 0, 0); PG8_STAGE(PG8_SA(1, 1), a1 + hstepA, voffA);
            PG8_WAIT_L(8); PG8_BAR; PG8_WAIT_L(0); PG8_MMA(0, 0, At, B0); PG8_BAR; PG8_SCHED;
            PG8_LDB(B1, 0, 1); PG8_STAGE(PG8_SB(0, 0), b2, voffB);
            PG8_BAR; PG8_WAIT_L(0); PG8_MMA(0, 1, At, B1); PG8_BAR;
            PG8_LDA(At, 0, 1); PG8_STAGE(PG8_SA(0, 0), a2, voffA);
            PG8_BAR; PG8_WAIT_L(0); PG8_MMA(1, 0, At, B0); PG8_BAR; PG8_SCHED;
            PG8_STAGE(PG8_SB(0, 1), b2 + hstepB, voffB);
            PG8_WAIT_V(6); PG8_BAR; PG8_MMA(1, 1, At, B1); PG8_BAR;
            PG8_LDB(B0, 1, 0); PG8_SCHED; PG8_LDA(At, 1, 0); PG8_STAGE(PG8_SA(0, 1), a2 + hstepA, voffA);
            PG8_WAIT_L(8); PG8_BAR; PG8_WAIT_L(0); PG8_MMA(0, 0, At, B0); PG8_BAR; PG8_SCHED;
            PG8_LDB(B1, 1, 1); PG8_STAGE(PG8_SB(1, 0), b3, voffB);
            PG8_BAR; PG8_WAIT_L(0); PG8_MMA(0, 1, At, B1); PG8_BAR;
            PG8_LDA(At, 1, 1); PG8_STAGE(PG8_SA(1, 0), a3, voffA);
            PG8_BAR; PG8_WAIT_L(0); PG8_MMA(1, 0, At, B0); PG8_BAR; PG8_SCHED;
            PG8_STAGE(PG8_SB(1, 1), b3 + hstepB, voffB);
            PG8_WAIT_V(6); PG8_BAR; PG8_MMA(1, 1, At, B1); PG8_BAR;
            }
        }
        if constexpr (ALIGN_EPI) { if (wr == 0) PG8_BAR; }
        if constexpr (!Epi::AFTER_DRAIN) { E(acc, cur, wr, wc, fr, fq); S.done(cur); }
        if (!has_next) break;
#pragma unroll
        for (int a = 0; a < 2; ++a)
#pragma unroll
            for (int b = 0; b < 2; ++b)
#pragma unroll
                for (int m = 0; m < 4; ++m)
#pragma unroll
                    for (int n = 0; n < 2; ++n) acc[a][b][m][n] = (f32x4){0.f, 0.f, 0.f, 0.f};
        cur = nxt; cA = nA; cB = nB; ++ui;
        if constexpr (ALIGN_EPI) { if (wr == 1) PG8_BAR; }
    }
    PG8_WAIT_V(0);
    if constexpr (!ALIGN_EPI) { if (wr == 0) PG8_BAR; }
    PG8_BAR;
    if constexpr (Epi::AFTER_DRAIN) { E.fused(acc, cur, wr, wc, fr, fq, lds, wid, lane); S.done(cur); }
#undef PG8_SA
#undef PG8_SB
#undef PG8_STAGE
#undef PG8_LDA
#undef PG8_LDB
#undef PG8_MMA
#undef PG8_WAIT_V
#undef PG8_WAIT_L
#undef PG8_BAR
#undef PG8_SCHED
}
}
DI unsigned sw_off(int row, int chunk) { return (unsigned)(row * 128 + ((chunk ^ ((row >> 1) & 7)) << 4)); }
#define GLDS16(gsrc, ldst) __builtin_amdgcn_global_load_lds((const unsigned*)(gsrc), (unsigned*)(ldst), 16, 0, 0)
DI u32x2 pack4(float a, float b, float c, float d) { u32x2 o; o[0] = pack2(a, b); o[1] = pack2(c, d); return o; }
#define EPI_ARGS const f32x4 (&acc)[2][2][4][2], const pg8::Unit& u, int wr, int wc, int fr, int fq
DI float xq_sum(float v) {
    v += __uint_as_float((unsigned)__builtin_amdgcn_ds_swizzle((int)__float_as_uint(v), 0x401F));
    return xhalf_sum(v);
}
DI u32x4 pack8(const float (&v)[8], float sc) {
    u32x4 o; o[0] = pack2(v[0] * sc, v[1] * sc); o[1] = pack2(v[2] * sc, v[3] * sc); o[2] = pack2(v[4] * sc, v[5] * sc); o[3] = pack2(v[6] * sc, v[7] * sc); return o;
}
DI void rope8(const float (&v)[8], float sc, const float* __restrict__ cs, int pos, int fq, int lane, bf16_t* dst32  ) {
    const int i0 = 8 * (fq & 1);
    const f32x4 c0 = *(const f32x4*)(cs + pos * 16 + i0), c1 = *(const f32x4*)(cs + pos * 16 + i0 + 4);
    const f32x4 s0 = *(const f32x4*)(cs + 65536 + pos * 16 + i0), s1 = *(const f32x4*)(cs + 65536 + pos * 16 + i0 + 4);
    const float sg = (fq < 2) ? -1.0f : 1.0f;
    float o[8];
#pragma unroll
    for (int e = 0; e < 8; ++e) {
        const float own = v[e] * sc, oth = xhalf_other(own, lane);
        const float c = (e < 4) ? c0[e & 3] : c1[e & 3], s = (e < 4) ? s0[e & 3] : s1[e & 3];
        o[e] = own * c + sg * oth * s;
    }
    *(u32x4*)(dst32 + 8 * fq) = pack8(o, 1.0f);
}
#define EPI_LOAD8(v, ai, bj, m) float v[8]; { const f32x4 x0_ = acc[ai][bj][m][0], x1_ = acc[ai][bj][m][1]; v[0] = x0_[0]; v[1] = x0_[1]; v[2] = x0_[2]; v[3] = x0_[3]; v[4] = x1_[0]; v[5] = x1_[1]; v[6] = x1_[2]; v[7] = x1_[3]; }

struct EpiPlain8 {
    static constexpr bool PERM = true, AFTER_DRAIN = false;
    bf16_t* out; int ld;
    DI void operator()(EPI_ARGS) const {
#pragma unroll
        for (int ai = 0; ai < 2; ++ai)
#pragma unroll
            for (int m = 0; m < 4; ++m) {
                int fr_ = fr; asm volatile("" : "+v"(fr_));
                const size_t tok = (size_t)u.pm * 256 + ai * 128 + wr * 64 + m * 16 + fr_;
#pragma unroll
                for (int bj = 0; bj < 2; ++bj) { EPI_LOAD8(v, ai, bj, m); *(u32x4*)(out + tok * ld + u.pn * 256 + bj * 128 + wc * 32 + 8 * fq) = pack8(v, 1.0f); }
            }
    }
};

struct EpiProj8 {
    static constexpr bool PERM = true, AFTER_DRAIN = false;
    bf16_t* proj; bf16_t* kr; const float* cs; float* ssq;
    DI void operator()(EPI_ARGS) const {
        const int lane = fr + 16 * fq;
#pragma unroll
        for (int bj = 0; bj < 2; ++bj) {
            const int cg = u.pn * 256 + bj * 128 + wc * 32;
            if (cg >= INC) continue;
            const int g32 = cg >> 5;
            const float sc = (cg >= 672 && cg < 1184) ? 0.125f * LOG2E : 1.0f;
#pragma unroll
            for (int ai = 0; ai < 2; ++ai)
#pragma unroll
                for (int m = 0; m < 4; ++m) {
                    int fr_ = fr; asm volatile("" : "+v"(fr_));
                const size_t tok = (size_t)u.pm * 256 + ai * 128 + wr * 64 + m * 16 + fr_;
                    EPI_LOAD8(v, ai, bj, m);
                    if (g32 < 20) {
                        float ss = 0.f;
#pragma unroll
                        for (int e = 0; e < 8; ++e) ss += v[e] * v[e];
                        ss = xq_sum(ss);
                        if (fq == 0) ssq[tok * 24 + g32] = ss;
                    }
                    if (cg == 640) rope8(v, 1.0f, cs, (int)(tok & (SEQ_L - 1)), fq, lane, kr + tok * 32);
                    else *(u32x4*)(proj + tok * INC + cg + 8 * fq) = pack8(v, sc);
                }
        }
    }
};

struct EpiUpQ8 {
    static constexpr bool PERM = true, AFTER_DRAIN = false;
    bf16_t* q; const float* cs; const float* ssq;
    DI void operator()(EPI_ARGS) const {
        const int lane = fr + 16 * fq;
        const float qs = 0.10206207261596575f * LOG2E;
#pragma unroll
        for (int ai = 0; ai < 2; ++ai)
#pragma unroll
            for (int m = 0; m < 4; ++m) {
                int fr_ = fr; asm volatile("" : "+v"(fr_));
                const size_t tok = (size_t)u.pm * 256 + ai * 128 + wr * 64 + m * 16 + fr_;
                const f32x4 a0 = *(const f32x4*)(ssq + tok * 24), a1 = *(const f32x4*)(ssq + tok * 24 + 4), a2 = *(const f32x4*)(ssq + tok * 24 + 8);
                const float tot = (a0[0] + a0[1] + a0[2] + a0[3]) + (a1[0] + a1[1] + a1[2] + a1[3]) + (a2[0] + a2[1] + a2[2] + a2[3]);
                const float sc = rsqrtf(tot * (1.0f / 384.0f) + 1e-6f) * qs;
#pragma unroll
                for (int bj = 0; bj < 2; ++bj) {
                    const int cg = u.pn * 256 + bj * 128 + wc * 32;
                    EPI_LOAD8(v, ai, bj, m);
                    if ((cg % 96) == 64) rope8(v, sc, cs, (int)(tok & (SEQ_L - 1)), fq, lane, q + tok * 768 + cg);
                    else *(u32x4*)(q + tok * 768 + cg + 8 * fq) = pack8(v, sc);
                }
            }
    }
};

struct EpiUpKV8 {
    static constexpr bool PERM = true, AFTER_DRAIN = false;
    bf16_t* kv; const float* ssq;
    DI void operator()(EPI_ARGS) const {
#pragma unroll
        for (int ai = 0; ai < 2; ++ai)
#pragma unroll
            for (int m = 0; m < 4; ++m) {
                int fr_ = fr; asm volatile("" : "+v"(fr_));
                const size_t tok = (size_t)u.pm * 256 + ai * 128 + wr * 64 + m * 16 + fr_;
                const f32x4 a0 = *(const f32x4*)(ssq + tok * 24 + 12), a1 = *(const f32x4*)(ssq + tok * 24 + 16);
                const float tot = (a0[0] + a0[1] + a0[2] + a0[3]) + (a1[0] + a1[1] + a1[2] + a1[3]);
                const float sc = rsqrtf(tot * (1.0f / 256.0f) + 1e-6f);
#pragma unroll
                for (int bj = 0; bj < 2; ++bj) { EPI_LOAD8(v, ai, bj, m); *(u32x4*)(kv + tok * 1024 + u.pn * 256 + bj * 128 + wc * 32 + 8 * fq) = pack8(v, sc); }
            }
    }
};

template <bool RBF16>
struct EpiResid8 {
    static constexpr bool PERM = true, AFTER_DRAIN = false;
    const void* R; bf16_t* HB; float* SS;
    DI void operator()(EPI_ARGS) const {
#pragma unroll
        for (int ai = 0; ai < 2; ++ai) {
            f32x4 rv[4][2][2];
#pragma unroll
            for (int m = 0; m < 4; ++m)
#pragma unroll
                for (int bj = 0; bj < 2; ++bj) {
                    const size_t off = ((size_t)u.pm * 256 + ai * 128 + wr * 64 + m * 16 + fr) * 1024 + u.pn * 256 + bj * 128 + wc * 32 + 8 * fq;
                    if (RBF16) {
                        const u32x4 w = ldu4((const bf16_t*)R + off);
                        rv[m][bj][0] = (f32x4){bf_lo(w[0]), bf_hi(w[0]), bf_lo(w[1]), bf_hi(w[1])};
                        rv[m][bj][1] = (f32x4){bf_lo(w[2]), bf_hi(w[2]), bf_lo(w[3]), bf_hi(w[3])};
                    } else {
                        rv[m][bj][0] = *(const f32x4*)((const float*)R + off); rv[m][bj][1] = *(const f32x4*)((const float*)R + off + 4);
                    }
                }
#pragma unroll
            for (int m = 0; m < 4; ++m) {
                int fr_ = fr; asm volatile("" : "+v"(fr_));
                const size_t tok = (size_t)u.pm * 256 + ai * 128 + wr * 64 + m * 16 + fr_;
                float ss = 0.f;
#pragma unroll
                for (int bj = 0; bj < 2; ++bj) {
                    const size_t off = tok * 1024 + u.pn * 256 + bj * 128 + wc * 32 + 8 * fq;
                    const f32x4 h0 = rv[m][bj][0] + acc[ai][bj][m][0], h1 = rv[m][bj][1] + acc[ai][bj][m][1];
                    u32x4 o; o[0] = pack2(h0[0], h0[1]); o[1] = pack2(h0[2], h0[3]); o[2] = pack2(h1[0], h1[1]); o[3] = pack2(h1[2], h1[3]);
                    *(u32x4*)(HB + off) = o;
                    const float a0 = bf_lo(o[0]), a1 = bf_hi(o[0]), a2 = bf_lo(o[1]), a3 = bf_hi(o[1]), a4 = bf_lo(o[2]), a5 = bf_hi(o[2]), a6 = bf_lo(o[3]), a7 = bf_hi(o[3]);
                    ss += (a0 * a0 + a1 * a1) + (a2 * a2 + a3 * a3) + (a4 * a4 + a5 * a5) + (a6 * a6 + a7 * a7);
                }
                ss = xq_sum(ss);
                if (fq == 0) SS[tok * 16 + 4 * u.pn + wc] = ss;
            }
        }
    }
};

struct EpiRowScale8 {
    static constexpr bool PERM = true, AFTER_DRAIN = false;
    bf16_t* out; int ld; const float* SS; float extra;
    DI void operator()(EPI_ARGS) const {
#pragma unroll
        for (int ai = 0; ai < 2; ++ai)
#pragma unroll
            for (int m = 0; m < 4; ++m) {
                int fr_ = fr; asm volatile("" : "+v"(fr_));
                const size_t tok = (size_t)u.pm * 256 + ai * 128 + wr * 64 + m * 16 + fr_;
                const f32x4 s0 = *(const f32x4*)(SS + tok * 16), s1 = *(const f32x4*)(SS + tok * 16 + 4), s2 = *(const f32x4*)(SS + tok * 16 + 8), s3 = *(const f32x4*)(SS + tok * 16 + 12);
                const float tot = (s0[0] + s0[1] + s0[2] + s0[3]) + (s1[0] + s1[1] + s1[2] + s1[3]) + (s2[0] + s2[1] + s2[2] + s2[3]) + (s3[0] + s3[1] + s3[2] + s3[3]);
                const float sc = rsqrtf(tot * (1.0f / 1024.0f) + 1e-6f) * extra;
#pragma unroll
                for (int bj = 0; bj < 2; ++bj) { EPI_LOAD8(v, ai, bj, m); *(u32x4*)(out + tok * ld + u.pn * 256 + bj * 128 + wc * 32 + 8 * fq) = pack8(v, sc); }
            }
    }
};

template <class Epi>
DI void gemm8(char* smem, const bf16_t* A, int lda, const bf16_t* Bt, int M, int N, int K, const Epi& e, int cshift = 0) {
    pg8::Gemm g; g.A = A; g.Bt = Bt; g.M = M; g.N = N; g.K = K; g.lda = lda;
    const int G = (int)gridDim.x;
    pg8::StaticOrder S; S.init(M, N, G, ((int)blockIdx.x + G - cshift) % G);
    pg8::gemm_phase<Epi, pg8::StaticOrder, true, true>((PG8_LAS unsigned char*)smem, g, S, e);
}

DI void quant_rows4(const Params& p, int it, int wv, int lane);
DI void phase_p1(const Params& p, char* smem) {
    char* ws = p.ws;
    const int G = (int)gridDim.x, nproj = 9 * 64, nkvm = 8 * 4;
    const int last = nproj % G;
    { EpiProj8 e{(bf16_t*)(ws + OFF_PROJ), (bf16_t*)(ws + OFF_KR), (const float*)(ws + OFF_ROPE), (float*)(ws + OFF_SSQ)};
      gemm8(smem, (const bf16_t*)(ws + OFF_XN), 1024, (const bf16_t*)(ws + OFF_WT_IN), T_TOK, 2304, 1024, e); }
    { EpiPlain8 e{(bf16_t*)(ws + OFF_KVM), 2048};
      gemm8(smem, (const bf16_t*)(ws + OFF_MEMN), 1024, (const bf16_t*)(ws + OFF_WT_MKV), 1024, 2048, 1024, e, last); }
    int q0 = last + nkvm, nq = G - q0;
    if (last == 0 || nq <= 0) { q0 = 0; nq = G; }
    if ((int)blockIdx.x >= q0) {
        const int t = otid(), lane = t & 63, wv = t >> 6;
        for (int it = ((int)blockIdx.x - q0) * 2 + vhalf(); it < 8192; it += 2 * nq) quant_rows4(p, it, wv, lane);
    }
}
DI void phase_p2(const Params& p, char* smem) {
    char* ws = p.ws;
    { EpiUpQ8 e{(bf16_t*)(ws + OFF_QMLA), (const float*)(ws + OFF_ROPE), (const float*)(ws + OFF_SSQ)};
      gemm8(smem, (const bf16_t*)(ws + OFF_PROJ), INC, (const bf16_t*)(ws + OFF_WT_UQ), T_TOK, 768, 384, e); }
    { EpiUpKV8 e{(bf16_t*)(ws + OFF_KVMLA), (const float*)(ws + OFF_SSQ)};
      gemm8(smem, (const bf16_t*)(ws + OFF_PROJ) + 384, INC, (const bf16_t*)(ws + OFF_WT_UKV), T_TOK, 1024, 256, e); }
}
template <bool RBF16>
DI void phase_resid(const Params& p, char* smem, size_t off_w, size_t off_a, const void* R, size_t off_ss, bool dry = false) {
    char* ws = p.ws;
    EpiResid8<RBF16> e{R, (bf16_t*)(ws + OFF_HB), (float*)(ws + off_ss)};
    if (dry) { e.HB = (bf16_t*)(ws + OFF_B); e.SS = (float*)(ws + OFF_SS1); }
    gemm8(smem, (const bf16_t*)(ws + off_a), 1024, (const bf16_t*)(ws + off_w), T_TOK, 1024, 1024, e);
}
DI void phase_rowscale(const Params& p, char* smem, size_t off_w, int N, bf16_t* outp, size_t off_ss, float extra) {
    char* ws = p.ws;
    EpiRowScale8 e{outp, N, (const float*)(ws + off_ss), extra};
    gemm8(smem, (const bf16_t*)(ws + OFF_HB), 1024, (const bf16_t*)(ws + off_w), T_TOK, N, 1024, e);
}
DI unsigned v128_off(int row, int chunk) { return (unsigned)(row * 128 + ((chunk ^ (((row >> 1) & 1) << 2)) << 4)); }
DI unsigned v128_tr_addr(unsigned base, int R0, int c, int lane) {
    const int blk = (lane >> 4) & 1, qq = (lane & 15) >> 2, pp = lane & 3;
    return base + v128_off(R0 + qq, 4 * c + 2 * blk + (pp >> 1)) + 8 * (pp & 1);
}
DI bf16x8 cat44(s16x4 lo, s16x4 hi) { return __builtin_shufflevector(lo, hi, 0, 1, 2, 3, 4, 5, 6, 7); }

constexpr int MLA_STAGE = 64 * 192 + 64 * 128;
DI unsigned k192_off(int row, int chunk) { return (unsigned)(row * 192 + (((chunk & ~3) | ((chunk & 3) ^ ((row >> 2) & 3))) << 4)); }
DI void mla_unit(const Params& p, char* lds, int b, int h, int qt) {
    char* ws = p.ws;
    const int t = otid(), lane = t & 63, wv = t >> 6, r = lane & 31, hh = lane >> 5;
    const bf16_t* Q = (const bf16_t*)(ws + OFF_QMLA);
    const bf16_t* KV = (const bf16_t*)(ws + OFF_KVMLA);
    const bf16_t* KR = (const bf16_t*)(ws + OFF_KR);
    const int q0 = qt * 128 + 32 * wv;
    const size_t tokq = (size_t)b * SEQ_L + q0 + r;
    const size_t tokb = (size_t)b * SEQ_L;
    bf16x8 qf[6];
#pragma unroll
    for (int s = 0; s < 6; ++s) qf[s] = ld16(Q + tokq * 768 + h * 96 + 16 * s + 8 * hh);
    f32x16 o[2]; o[0] = zero16(); o[1] = zero16();
    float m = -INFINITY, l = 0.f;
    const bf16_t* ksrc[3]; int kadv[3]; const bf16_t* vsrc[2];
#pragma unroll
    for (int i = 0; i < 3; ++i) {
        const int o_ = 1024 * (wv + 4 * i) + 16 * lane, row = o_ / 192, pch = (o_ % 192) >> 4;
        const int c = (pch & ~3) | ((pch & 3) ^ ((row >> 2) & 3));
        if (c < 8) { ksrc[i] = KV + (tokb + row) * 1024 + h * 128 + 8 * c; kadv[i] = 64 * 1024; }
        else       { ksrc[i] = KR + (tokb + row) * 32 + 8 * (c - 8);       kadv[i] = 64 * 32; }
    }
#pragma unroll
    for (int i = 0; i < 2; ++i) {
        const int row = 8 * (wv + 4 * i) + (lane >> 3), pch = lane & 7;
        vsrc[i] = KV + (tokb + row) * 1024 + h * 128 + 64 + 8 * (pch ^ (((row >> 1) & 1) << 2));
    }
    char* ldst = lds + wv * 1024 + lane * 16;
    auto issue = [&](int kt) {
        char* d = ldst + (kt % 3) * MLA_STAGE;
#pragma unroll
        for (int i = 0; i < 3; ++i) GLDS16(ksrc[i] + (size_t)kt * kadv[i], d + i * 4096);
#pragma unroll
        for (int i = 0; i < 2; ++i) GLDS16(vsrc[i] + (size_t)kt * (64 * 1024), d + 12288 + i * 4096);
    };
    const int ntiles = 2 * qt + 2;
    const unsigned vlane0 = v128_tr_addr(0u, 4 * hh, 0, lane), vlane1 = v128_tr_addr(0u, 4 * hh, 1, lane);
    __syncthreads();
    issue(0); issue(1);
#pragma unroll
    for (int s = 0; s < 6; ++s) asm volatile("" :: "v"(qf[s]));
#pragma unroll 1
    for (int kt = 0; kt < ntiles; ++kt) {
        if (kt + 1 < ntiles) asm volatile("s_waitcnt vmcnt(5)\n\ts_barrier" ::: "memory");
        else asm volatile("s_waitcnt vmcnt(0)\n\ts_barrier" ::: "memory");
        if (kt + 2 < ntiles) issue(kt + 2);
        const char* sb = lds + (kt % 3) * MLA_STAGE;
        const unsigned vb = (unsigned)(uintptr_t)(sb + 12288);
        f32x16 s[2];
#pragma unroll
        for (int k2 = 0; k2 < 2; ++k2) {
            s[k2] = zero16();
#pragma unroll
            for (int ss = 0; ss < 6; ++ss) s[k2] = MFMA32(ld16(sb + k192_off(32 * k2 + r, 2 * ss + hh)), qf[ss], s[k2]);
        }
        s16x4 vt[2][2][2][2];
        {
            const unsigned a0 = vb + vlane0, a1 = vb + vlane1;
#define MLA_TR(K2, ST) vt[K2][ST][0][0] = tr_read_ao<(32 * K2 + 16 * ST) * 128>(a0); vt[K2][ST][0][1] = tr_read_ao<(32 * K2 + 16 * ST + 8) * 128>(a0); \
                       vt[K2][ST][1][0] = tr_read_ao<(32 * K2 + 16 * ST) * 128>(a1); vt[K2][ST][1][1] = tr_read_ao<(32 * K2 + 16 * ST + 8) * 128>(a1);
            MLA_TR(0, 0) MLA_TR(0, 1) MLA_TR(1, 0) MLA_TR(1, 1)
#undef MLA_TR
        }
        if (__builtin_amdgcn_readfirstlane(kt >= 2 * qt)) {
            asm volatile("");
            const int qpos = q0 + r;
#pragma unroll
            for (int k2 = 0; k2 < 2; ++k2)
#pragma unroll
                for (int i = 0; i < 16; ++i) { const int kpos = 64 * kt + 32 * k2 + crow(i, hh); if (kpos > qpos) s[k2][i] = -INFINITY; }
        }
        float mx = s[0][0];
#pragma unroll
        for (int k2 = 0; k2 < 2; ++k2)
#pragma unroll
            for (int i = 0; i < 16; ++i) mx = fmaxf(mx, s[k2][i]);
        mx = xhalf_max(mx);
        if (__any(mx > m + 8.0f)) {
            asm volatile("");
            const float mn = fmaxf(m, mx);
            const float alpha = fast_exp2(m - mn);
            l *= alpha;
            m = mn;
#pragma unroll
            for (int c = 0; c < 2; ++c)
#pragma unroll
                for (int i = 0; i < 16; ++i) o[c][i] *= alpha;
        }
        f32x2 ps2 = {0.f, 0.f};
        const f32x2 m2 = {m, m};
#pragma unroll
        for (int k2 = 0; k2 < 2; ++k2)
#pragma unroll
            for (int i = 0; i < 16; i += 2) {
                f32x2 x = {s[k2][i], s[k2][i + 1]};
                x = x - m2;
                f32x2 e; e[0] = fast_exp2(x[0]); e[1] = fast_exp2(x[1]);
                s[k2][i] = e[0]; s[k2][i + 1] = e[1];
                ps2 += e;
            }
        l += ps2[0] + ps2[1];
        TR_WAIT();
#pragma unroll
        for (int k2 = 0; k2 < 2; ++k2)
#pragma unroll
            for (int st = 0; st < 2; ++st) {
                const bf16x8 pb = pack_step(s[k2], st);
#pragma unroll
                for (int c = 0; c < 2; ++c) o[c] = MFMA32(cat44(vt[k2][st][c][0], vt[k2][st][c][1]), pb, o[c]);
            }
    }
    const float inv = 1.0f / xhalf_sum(l);
    bf16_t* dst = (bf16_t*)((char*)p.out + OUT_OMLA) + tokq * 512 + h * 64 + 4 * hh;
#pragma unroll
    for (int c = 0; c < 2; ++c)
#pragma unroll
        for (int g = 0; g < 4; ++g)
            *(u32x2*)(dst + 32 * c + 8 * g) = pack4(o[c][4 * g] * inv, o[c][4 * g + 1] * inv, o[c][4 * g + 2] * inv, o[c][4 * g + 3] * inv);
}

DI void dil_unit(const Params& p, char* lds, int g, int b, int h, int rr, int lb) {
    char* ws = p.ws;
    const int t = otid(), lane = t & 63, wv = t >> 6, r = lane & 31, hh = lane >> 5;
    const int d = (g == 0) ? 1 : (g == 1 ? 4 : 16);
    const bf16_t* PJ = (const bf16_t*)(ws + OFF_PROJ);
    const size_t tokb = (size_t)b * SEQ_L;
    char* kimg = lds;
    char* vimg = lds + 32768;
    __syncthreads();
    {
        const int c = t & 7;
#pragma unroll
        for (int half = 0; half < 2; ++half) {
            u32x4 kk[4], vv[4];
#pragma unroll
            for (int i = 0; i < 4; ++i) {
                const int key = (t >> 3) + 32 * (4 * half + i);
                const int lk = 128 * lb - 128 + key;
                if (lk >= 0) {
                    const size_t tk = tokb + (size_t)lk * d + rr;
                    kk[i] = ldu4(PJ + tk * INC + 1184 + h * 64 + 8 * c);
                    vv[i] = ldu4(PJ + tk * INC + 1696 + h * 64 + 8 * c);
                } else { kk[i] = (u32x4){0u, 0u, 0u, 0u}; vv[i] = (u32x4){0u, 0u, 0u, 0u}; }
            }
#pragma unroll
            for (int i = 0; i < 4; ++i) {
                const int key = (t >> 3) + 32 * (4 * half + i);
                *(u32x4*)(kimg + sw_off(key, c)) = kk[i];
                *(u32x4*)(vimg + v128_off(key, c)) = vv[i];
            }
        }
    }
    const int lq = 128 * lb + 32 * wv + r;
    const size_t tokq = tokb + (size_t)lq * d + rr;
    bf16x8 qf[4];
#pragma unroll
    for (int s = 0; s < 4; ++s) qf[s] = ld16(PJ + tokq * INC + 672 + h * 64 + 16 * s + 8 * hh);
    __syncthreads();
    const float slope2 = exp2f(-(float)(h + 1)) * (float)d * LOG2E;
    const int u0 = (lb == 0) ? (4 - wv) : 0;
    f32x16 o[2]; o[0] = zero16(); o[1] = zero16();
    float m = -INFINITY, lsum = 0.f;
    const unsigned vb = (unsigned)(uintptr_t)vimg;
    float cb[16];
#pragma unroll
    for (int i = 0; i < 16; ++i) cb[i] = slope2 * (float)crow(i, hh);
#pragma unroll 1
    for (int u = u0; u < 5; ++u) {
        const int rowb = 32 * (wv + u);
        f32x16 s = zero16();
#pragma unroll
        for (int ss = 0; ss < 4; ++ss) s = MFMA32(ld16(kimg + sw_off(rowb + r, 2 * ss + hh)), qf[ss], s);
        const int dbase = r + 128 - 32 * u;
        const float b0 = -slope2 * (float)dbase;
#pragma unroll
        for (int i = 0; i < 16; ++i) s[i] += cb[i];
        if (__builtin_amdgcn_readfirstlane(u == 0 || u == 4)) {
            asm volatile("");
#pragma unroll
            for (int i = 0; i < 16; ++i) { const int dist = dbase - crow(i, hh); if (dist < 0 || dist > 128) s[i] = -INFINITY; }
        }
        float mx = s[0];
#pragma unroll
        for (int i = 1; i < 16; ++i) mx = fmaxf(mx, s[i]);
        mx = xhalf_max(mx) + b0;
        if (__any(mx > m + 8.0f)) {
            asm volatile("");
            const float mn = fmaxf(m, mx);
            const float alpha = fast_exp2(m - mn);
            lsum *= alpha;
            m = mn;
#pragma unroll
            for (int c = 0; c < 2; ++c)
#pragma unroll
                for (int i = 0; i < 16; ++i) o[c][i] *= alpha;
        }
        f32x2 ps2 = {0.f, 0.f};
        const float mb = m - b0;
        const f32x2 m2 = {mb, mb};
#pragma unroll
        for (int i = 0; i < 16; i += 2) {
            f32x2 xx = {s[i], s[i + 1]};
            xx = xx - m2;
            f32x2 e; e[0] = fast_exp2(xx[0]); e[1] = fast_exp2(xx[1]);
            s[i] = e[0]; s[i + 1] = e[1];
            ps2 += e;
        }
        lsum += ps2[0] + ps2[1];
#pragma unroll
        for (int st = 0; st < 2; ++st) {
            const bf16x8 pb = pack_step(s, st);
#pragma unroll
            for (int c = 0; c < 2; ++c) {
                const s16x4 lo = tr_read(v128_tr_addr(vb, rowb + 16 * st + 4 * hh, c, lane));
                const s16x4 hi = tr_read(v128_tr_addr(vb, rowb + 16 * st + 8 + 4 * hh, c, lane));
                o[c] = MFMA32(cat44(lo, hi), pb, o[c]);
            }
        }
    }
    const float ltot = xhalf_sum(lsum);
    const float mx = m;
    const float inv = 1.0f / ltot;
    bf16_t* dst = (bf16_t*)((char*)p.out + OUT_ODIL) + ((size_t)g * T_TOK + tokq) * 512 + h * 64 + 4 * hh;
#pragma unroll
    for (int c = 0; c < 2; ++c)
#pragma unroll
        for (int gg = 0; gg < 4; ++gg)
            *(u32x2*)(dst + 32 * c + 8 * gg) = pack4(o[c][4 * gg] * inv, o[c][4 * gg + 1] * inv, o[c][4 * gg + 2] * inv, o[c][4 * gg + 3] * inv);
    if (hh == 0) ((float*)(ws + OFF_LSE))[((size_t)g * T_TOK + tokq) * 8 + h] = mx + __log2f(ltot);
}

DI void phase_p3(const Params& p, char* lds, int which = 3) {
    const int xg = (int)blockIdx.x & 7, nloc = (vgrid() >> 3), loc = ((int)blockIdx.x >> 3) * 2 + vhalf();
    if (which & 1) for (int i = loc; i < 64; i += nloc) {
        const int bh = xg * 4 + (i >> 4), pr = i & 15, b = bh >> 3, h = bh & 7;
#pragma unroll 1
        for (int rep = 0; rep < 2; ++rep) mla_unit(p, lds, b, h, rep ? pr : 31 - pr);
    }
    if (which & 2) for (int i = loc; i < 384; i += nloc) {
        const int bh = xg * 4 + i / 96, k96 = i % 96, g = k96 >> 5, k = k96 & 31, b = bh >> 3, h = bh & 7;
        int rr, lb;
        if (g == 0) { rr = 0; lb = k; } else if (g == 1) { rr = k >> 3; lb = k & 7; } else { rr = k >> 1; lb = k & 1; }
        dil_unit(p, lds, g, b, h, rr, lb);
    }
}

DI void quant_rows4(const Params& p, int it, int wv, int lane) {
    char* ws = p.ws;
    const int ncv = 4096;
    const bool isv = it >= ncv;
    const size_t row = (size_t)(isv ? it - ncv : it) * 4 + wv;
    const float* src = (isv ? p.peer_v : p.peer_u) + row * 1024 + 16 * lane;
    f32x4 v[4]; float am = 0.f;
#pragma unroll
    for (int i = 0; i < 4; ++i) { v[i] = *(const f32x4*)(src + 4 * i); am = fmaxf(am, fmaxf(fmaxf(fabsf(v[i][0]), fabsf(v[i][1])), fmaxf(fabsf(v[i][2]), fabsf(v[i][3])))); }
#pragma unroll
    for (int o = 32; o; o >>= 1) am = fmaxf(am, __shfl_xor(am, o));
    const float sc = (am > 0.f) ? am * (isv ? (1.0f / 384.0f) : (1.0f / 127.0f)) : 1.0f;
    const float inv = 1.0f / sc;
    u32x4 o;
#pragma unroll
    for (int i = 0; i < 4; ++i) {
        if (isv) {
            int w = 0;
            w = __builtin_amdgcn_cvt_pk_fp8_f32(v[i][0] * inv, v[i][1] * inv, w, false);
            w = __builtin_amdgcn_cvt_pk_fp8_f32(v[i][2] * inv, v[i][3] * inv, w, true);
            o[i] = (unsigned)w;
        } else {
            unsigned w = 0u;
#pragma unroll
            for (int e = 0; e < 4; ++e) { const int q = (int)rintf(v[i][e] * inv); w |= ((unsigned)q & 0xFFu) << (8 * e); }
            o[i] = w;
        }
    }
    *(u32x4*)(ws + (isv ? OFF_VQ : OFF_UQ) + row * 1024 + 16 * lane) = o;
    if (lane == 0) ((float*)(ws + (isv ? OFF_SV : OFF_SU)))[row] = sc;
}

DI void phase_p35(const Params& p, char* lds) {
    char* ws = p.ws;
    const int t = otid(), lane = t & 63, wv = t >> 6;
    const int ntok = T_TOK / 4;
    for (int item = vbid(); item < ntok; item += vgrid()) {
        {
            const size_t tok = (size_t)item * 4 + wv;
            const int head = lane >> 3;
            const float* LS = (const float*)(ws + OFF_LSE);
            const float l0 = LS[tok * 8 + head], l1 = LS[((size_t)T_TOK + tok) * 8 + head], l2 = LS[((size_t)2 * T_TOK + tok) * 8 + head];
            const float mx = fmaxf(l0, fmaxf(l1, l2));
            float w0 = fast_exp2(l0 - mx), w1 = fast_exp2(l1 - mx), w2 = fast_exp2(l2 - mx);
            const float wi = 1.0f / (w0 + w1 + w2);
            w0 *= wi; w1 *= wi; w2 *= wi;
            const bf16_t* OD = (const bf16_t*)((const char*)p.out + OUT_ODIL);
            const u32x4 a0 = ldu4(OD + tok * 512 + 8 * lane), a1 = ldu4(OD + ((size_t)T_TOK + tok) * 512 + 8 * lane),
                        a2 = ldu4(OD + ((size_t)2 * T_TOK + tok) * 512 + 8 * lane);
            const u32x4 am = ldu4((const bf16_t*)((const char*)p.out + OUT_OMLA) + tok * 512 + 8 * lane);
            float od[8], om[8]; float sd = 0.f, sm = 0.f;
#pragma unroll
            for (int e = 0; e < 4; ++e) {
                od[2 * e] = w0 * bf_lo(a0[e]) + w1 * bf_lo(a1[e]) + w2 * bf_lo(a2[e]);
                od[2 * e + 1] = w0 * bf_hi(a0[e]) + w1 * bf_hi(a1[e]) + w2 * bf_hi(a2[e]);
                om[2 * e] = bf_lo(am[e]); om[2 * e + 1] = bf_hi(am[e]);
                sd += od[2 * e] * od[2 * e] + od[2 * e + 1] * od[2 * e + 1];
                sm += om[2 * e] * om[2 * e] + om[2 * e + 1] * om[2 * e + 1];
            }
#pragma unroll
            for (int o = 32; o; o >>= 1) { sd += __shfl_xor(sd, o); sm += __shfl_xor(sm, o); }
            const float rd = rsqrtf(sd * (1.0f / 512.0f) + 1e-6f), rm = rsqrtf(sm * (1.0f / 512.0f) + 1e-6f);
            const f32x4 gm0 = *(const f32x4*)(p.gn_mla + 8 * lane), gm1 = *(const f32x4*)(p.gn_mla + 8 * lane + 4);
            const f32x4 gd0 = *(const f32x4*)(p.gn_dil + 8 * lane), gd1 = *(const f32x4*)(p.gn_dil + 8 * lane + 4);
            u32x4 o1, o2;
            o1[0] = pack2(om[0] * rm * gm0[0], om[1] * rm * gm0[1]); o1[1] = pack2(om[2] * rm * gm0[2], om[3] * rm * gm0[3]);
            o1[2] = pack2(om[4] * rm * gm1[0], om[5] * rm * gm1[1]); o1[3] = pack2(om[6] * rm * gm1[2], om[7] * rm * gm1[3]);
            o2[0] = pack2(od[0] * rd * gd0[0], od[1] * rd * gd0[1]); o2[1] = pack2(od[2] * rd * gd0[2], od[3] * rd * gd0[3]);
            o2[2] = pack2(od[4] * rd * gd1[0], od[5] * rd * gd1[1]); o2[3] = pack2(od[6] * rd * gd1[2], od[7] * rd * gd1[3]);
            bf16_t* MX = (bf16_t*)(ws + OFF_MIXED) + tok * 1024;
            *(u32x4*)(MX + 8 * lane) = o1;
            *(u32x4*)(MX + 512 + 8 * lane) = o2;
        }
    }
}

DI void memattn_unit(const Params& p, char* lds, int b, int h, int tt) {
    char* ws = p.ws;
    const int t = otid(), lane = t & 63, wv = t >> 6, r = lane & 31, hh = lane >> 5;
    const bf16_t* QM = (const bf16_t*)(ws + OFF_QM);
    const bf16_t* KVM = (const bf16_t*)(ws + OFF_KVM);
    const size_t tokq = (size_t)b * SEQ_L + tt * 128 + 32 * wv + r;
    const bf16_t* qrow = QM + tokq * 1024 + h * 256 + 8 * hh;
    const bf16_t* ksrc0; const bf16_t* vsrc0;
    {
        const int row = 8 * wv + (lane >> 3), pch = lane & 7;
        const size_t mrow = (size_t)b * 256 + row;
        ksrc0 = KVM + mrow * 2048 + h * 256 + 8 * (pch ^ ((row >> 1) & 7));
        vsrc0 = KVM + mrow * 2048 + 1024 + h * 256 + 8 * (pch ^ (((row >> 1) & 1) << 2));
    }
    char* ldst = lds + wv * 1024 + lane * 16;
#define MA_ISSUE(st_) do { char* d_ = ldst + ((st_) & 1) * 32768; \
        _Pragma("unroll") for (int i = 0; i < 8; ++i) GLDS16(((st_) < 4 ? ksrc0 : vsrc0) + (size_t)i * (32 * 2048) + 64 * ((st_) & 3), d_ + i * 4096); } while (0)
    f32x16 S[8];
#pragma unroll
    for (int kt = 0; kt < 8; ++kt) S[kt] = zero16();
    bf16x8 qa[4];
    __syncthreads();
    MA_ISSUE(0); MA_ISSUE(1);
#define MA_KSTAGE(c_, WAIT_) do { \
        asm volatile("s_waitcnt vmcnt(" #WAIT_ ")\n\ts_barrier" ::: "memory"); \
        _Pragma("unroll") for (int ss = 0; ss < 4; ++ss) qa[ss] = ld16(qrow + 64 * (c_) + 16 * ss); \
        { const char* sb_ = lds + ((c_) & 1) * 32768; \
          _Pragma("unroll") for (int kt = 0; kt < 8; ++kt) \
          _Pragma("unroll") for (int ss = 0; ss < 4; ++ss) S[kt] = MFMA32(ld16(sb_ + sw_off(32 * kt + r, 2 * ss + hh)), qa[ss], S[kt]); } \
        asm volatile("s_barrier" ::: "memory"); \
        MA_ISSUE((c_) + 2); } while (0)
    MA_KSTAGE(0, 8);
    MA_KSTAGE(1, 8);
    MA_KSTAGE(2, 8);
    MA_KSTAGE(3, 8);
    float mx = S[0][0];
#pragma unroll
    for (int kt = 0; kt < 8; ++kt)
#pragma unroll
        for (int i = 0; i < 16; ++i) mx = fmaxf(mx, S[kt][i]);
    mx = xhalf_max(mx);
    f32x2 ps2 = {0.f, 0.f};
    const f32x2 m2 = {mx, mx};
    bf16x8 pk[8][2];
#pragma unroll
    for (int kt = 0; kt < 8; ++kt) {
#pragma unroll
        for (int i = 0; i < 16; i += 2) {
            f32x2 xx = {S[kt][i], S[kt][i + 1]};
            xx = xx - m2;
            f32x2 e; e[0] = fast_exp2(xx[0]); e[1] = fast_exp2(xx[1]);
            S[kt][i] = e[0]; S[kt][i + 1] = e[1];
            ps2 += e;
        }
        pk[kt][0] = pack_step(S[kt], 0); pk[kt][1] = pack_step(S[kt], 1);
    }
    const float inv = 1.0f / xhalf_sum(ps2[0] + ps2[1]);
    bf16_t* dst = (bf16_t*)(ws + OFF_OM) + tokq * 1024 + h * 256 + 4 * hh;
    const unsigned vlane0 = v128_tr_addr(0u, 4 * hh, 0, lane), vlane1 = v128_tr_addr(0u, 4 * hh, 1, lane);
#define MA_PV(KT_, vb_) do { s16x4 vt_[2][2][2]; \
            vt_[0][0][0] = tr_read_ao<(32 * KT_) * 128>(vb_ + vlane0);          vt_[0][0][1] = tr_read_ao<(32 * KT_ + 8) * 128>(vb_ + vlane0); \
            vt_[0][1][0] = tr_read_ao<(32 * KT_) * 128>(vb_ + vlane1);          vt_[0][1][1] = tr_read_ao<(32 * KT_ + 8) * 128>(vb_ + vlane1); \
            vt_[1][0][0] = tr_read_ao<(32 * KT_ + 16) * 128>(vb_ + vlane0);     vt_[1][0][1] = tr_read_ao<(32 * KT_ + 24) * 128>(vb_ + vlane0); \
            vt_[1][1][0] = tr_read_ao<(32 * KT_ + 16) * 128>(vb_ + vlane1);     vt_[1][1][1] = tr_read_ao<(32 * KT_ + 24) * 128>(vb_ + vlane1); \
            TR_WAIT(); \
            _Pragma("unroll") for (int st = 0; st < 2; ++st) { \
                o0_ = MFMA32(cat44(vt_[st][0][0], vt_[st][0][1]), pk[KT_][st], o0_); \
                o1_ = MFMA32(cat44(vt_[st][1][0], vt_[st][1][1]), pk[KT_][st], o1_); } } while (0)
#define MA_VSTAGE(c_, WAIT_) do { \
        asm volatile("s_waitcnt vmcnt(" #WAIT_ ")\n\ts_barrier" ::: "memory"); \
        { const unsigned vb_ = (unsigned)(uintptr_t)(lds + ((c_) & 1) * 32768); \
          f32x16 o0_ = zero16(), o1_ = zero16(); \
          MA_PV(0, vb_); MA_PV(1, vb_); MA_PV(2, vb_); MA_PV(3, vb_); MA_PV(4, vb_); MA_PV(5, vb_); MA_PV(6, vb_); MA_PV(7, vb_); \
          _Pragma("unroll") for (int g = 0; g < 4; ++g) { \
              *(u32x2*)(dst + 64 * (c_) + 8 * g) = pack4(o0_[4 * g] * inv, o0_[4 * g + 1] * inv, o0_[4 * g + 2] * inv, o0_[4 * g + 3] * inv); \
              *(u32x2*)(dst + 64 * (c_) + 32 + 8 * g) = pack4(o1_[4 * g] * inv, o1_[4 * g + 1] * inv, o1_[4 * g + 2] * inv, o1_[4 * g + 3] * inv); } } \
        asm volatile("s_barrier" ::: "memory"); \
        if ((c_) + 2 < 4) MA_ISSUE(4 + (c_) + 2); } while (0)
    MA_VSTAGE(0, 8);
    MA_VSTAGE(1, 8);
    MA_VSTAGE(2, 8);
    MA_VSTAGE(3, 0);
#undef MA_ISSUE
#undef MA_KSTAGE
#undef MA_VSTAGE
#undef MA_PV
}

DI void phase_memattn(const Params& p, char* lds) {
    for (int item = vbid(); item < 512; item += vgrid()) {
        const int b = item >> 7, h = (item >> 5) & 3, tt = item & 31;
        memattn_unit(p, lds, b, h, tt);
    }
}
DI unsigned f2sort(float f) { const unsigned b = __float_as_uint(f); return b ^ ((b & 0x80000000u) ? 0xFFFFFFFFu : 0x80000000u); }
DI float sort2f(unsigned u) { const unsigned b = (u & 0x80000000u) ? (u ^ 0x80000000u) : ~u; return __uint_as_float(b); }
DI void cswap(unsigned& a, unsigned& b) { const unsigned hi = max(a, b), lo = min(a, b); a = hi; b = lo; }

template <int LO, int N> struct BClean {
    template <int M> static DI void run(unsigned (&a)[M]) {
#pragma unroll
        for (int i = 0; i < N / 2; ++i) cswap(a[LO + i], a[LO + i + N / 2]);
        BClean<LO, N / 2>::run(a); BClean<LO + N / 2, N / 2>::run(a);
    }
};
template <int LO> struct BClean<LO, 1> { template <int M> static DI void run(unsigned (&)[M]) {} };
template <int LO, int N> struct BSort {
    template <int M> static DI void run(unsigned (&a)[M]) {
        BSort<LO, N / 2>::run(a); BSort<LO + N / 2, N / 2>::run(a);
#pragma unroll
        for (int i = 0; i < N / 2; ++i) cswap(a[LO + i], a[LO + N - 1 - i]);
        BClean<LO, N / 2>::run(a); BClean<LO + N / 2, N / 2>::run(a);
    }
};
template <int LO> struct BSort<LO, 1> { template <int M> static DI void run(unsigned (&)[M]) {} };
DI void merge_top16(unsigned (&a)[16], const unsigned (&b)[16]) {
#pragma unroll
    for (int i = 0; i < 16; ++i) a[i] = max(a[i], b[15 - i]);
    BClean<0, 16>::run(a);
}

DI void peer_top16(const bf16_t* __restrict__ keys_hp, const bf16_t* __restrict__ pq_row_hp, int r, int hh, unsigned (&top)[16]) {
    bf16x8 qf[8];
#pragma unroll
    for (int s = 0; s < 8; ++s) qf[s] = ld16(pq_row_hp + 16 * s + 8 * hh);
    unsigned cur[16];
#pragma unroll
    for (int kt = 0; kt < 4; ++kt) {
        f32x16 acc = zero16();
#pragma unroll
        for (int s = 0; s < 8; ++s) acc = MFMA32(ld16(keys_hp + (size_t)(32 * kt + r) * 128 + 16 * s + 8 * hh), qf[s], acc);
        unsigned k[16];
#pragma unroll
        for (int i = 0; i < 16; ++i) k[i] = (f2sort(acc[i]) & ~0x7Fu) | (unsigned)(32 * kt + crow(i, hh));
        BSort<0, 16>::run(k);
        if (kt == 0) {
#pragma unroll
            for (int i = 0; i < 16; ++i) cur[i] = k[i];
        } else merge_top16(cur, k);
    }
    unsigned r0[16], r1[16];
#pragma unroll
    for (int i = 0; i < 16; ++i) { auto rr = __builtin_amdgcn_permlane32_swap(cur[i], cur[i], false, false); r0[i] = rr[0]; r1[i] = rr[1]; }
#pragma unroll
    for (int i = 0; i < 16; ++i) top[i] = max(r0[i], r1[15 - i]);
    BClean<0, 16>::run(top);
}

DI void peer_select_unit(const Params& p, char* lds, int mt, int h) {
    char* ws = p.ws;
    const int t = otid(), lane = t & 63, wv = t >> 6, r = lane & 31, hh = lane >> 5;
    const size_t tok = (size_t)mt * 128 + 32 * wv + r;
    const bf16_t* KEYS = (const bf16_t*)(ws + OFF_KEYS);
    const bf16_t* PQ = (const bf16_t*)((const char*)p.out + OUT_PQ);
    unsigned tA[16], tB[16];
    peer_top16(KEYS + (size_t)(2 * h) * 16384, PQ + tok * 2048 + (2 * h) * 128, r, hh, tA);
    peer_top16(KEYS + (size_t)(2 * h + 1) * 16384, PQ + tok * 2048 + (2 * h + 1) * 128, r, hh, tB);
    float fA[16], fB[16];
#pragma unroll
    for (int i = 0; i < 16; ++i) { fA[i] = sort2f(tA[i] & ~0x7Fu); fB[i] = sort2f(tB[i] & ~0x7Fu); }
    unsigned* tab = (unsigned*)lds + wv * 1024;
    __syncthreads();
#pragma unroll
    for (int i = 0; i < 16; ++i) tab[i * 64 + lane] = (tA[i] & 0x7Fu) | ((tB[i] & 0x7Fu) << 16);
    unsigned c[64];
#pragma unroll
    for (int i = 0; i < 64; ++i) c[i] = 0u;
    {
        int n = 0;
#pragma unroll
        for (int a = 0; a < 16; ++a)
#pragma unroll
            for (int b = 0; b < 16; ++b)
                if ((a + 1) * (b + 1) <= 16) { c[n] = (f2sort(fA[a] + fB[b]) & ~0xFFu) | (unsigned)(a * 16 + b); ++n; }
    }
    unsigned g0[16], g1[16], g2[16], g3[16];
#pragma unroll
    for (int i = 0; i < 16; ++i) { g0[i] = c[i]; g1[i] = c[16 + i]; g2[i] = c[32 + i]; g3[i] = c[48 + i]; }
    BSort<0, 16>::run(g0); BSort<0, 16>::run(g1); BSort<0, 16>::run(g2); BSort<0, 16>::run(g3);
    merge_top16(g0, g1); merge_top16(g2, g3); merge_top16(g0, g2);
    float e[16]; float sum = 0.f;
    const float v0 = sort2f(g0[0] & ~0xFFu);
    unsigned ids[16];
#pragma unroll
    for (int i = 0; i < 16; ++i) {
        const float v = sort2f(g0[i] & ~0xFFu);
        e[i] = fast_exp2((v - v0) * LOG2E); sum += e[i];
        const unsigned a = (g0[i] >> 4) & 15u, b = g0[i] & 15u;
        const unsigned ia = tab[a * 64 + lane] & 0x7Fu, ib = (tab[b * 64 + lane] >> 16) & 0x7Fu;
        ids[i] = ia * 128u + ib;
    }
    const float inv = 1.0f / sum;
    if (hh == 0) {
        unsigned short* SID = (unsigned short*)(ws + OFF_SELID) + tok * 128 + h * 16;
        float* SG = (float*)(ws + OFF_SELG) + tok * 128 + h * 16;
        u32x4 w0, w1;
        w0[0] = ids[0] | (ids[1] << 16); w0[1] = ids[2] | (ids[3] << 16); w0[2] = ids[4] | (ids[5] << 16); w0[3] = ids[6] | (ids[7] << 16);
        w1[0] = ids[8] | (ids[9] << 16); w1[1] = ids[10] | (ids[11] << 16); w1[2] = ids[12] | (ids[13] << 16); w1[3] = ids[14] | (ids[15] << 16);
        *(u32x4*)SID = w0; *(u32x4*)(SID + 8) = w1;
#pragma unroll
        for (int q = 0; q < 4; ++q) *(f32x4*)(SG + 4 * q) = (f32x4){e[4 * q] * inv, e[4 * q + 1] * inv, e[4 * q + 2] * inv, e[4 * q + 3] * inv};
    }
}

DI void phase_select(const Params& p, char* lds) {
    for (int item = vbid(); item < 1024; item += vgrid()) peer_select_unit(p, lds, item >> 3, item & 7);
}

DI float gelu_erf(float v) {
    const float av = fabsf(v), t = __builtin_amdgcn_rcpf(av * 0.2316418882f + 1.0f);
    float q = t * 0.5307027145f + (-0.7265760135f); q = q * t + 0.7107068705f; q = q * t + (-0.142248368f); q = q * t + 0.127414796f; q = q * t;
    const float e = __builtin_amdgcn_exp2f((v * v) * (-0.72134752044f));
    const float m = v * (q * e), r = v - m;
    return v < 0.f ? m : r;
}
DI int dppi(int v, const int ctrl) { return v; }
#define DPP_I(v, ctrl) __builtin_amdgcn_update_dpp(0, (v), (ctrl), 0xf, 0xf, true)
DI float ub0(unsigned w) { return (float)(w & 0xFFu); }
DI float ub1(unsigned w) { return (float)((w >> 8) & 0xFFu); }
DI float ub2(unsigned w) { return (float)((w >> 16) & 0xFFu); }
DI float ub3(unsigned w) { return (float)(w >> 24); }

struct GBatch { u32x4 U[4], V[4]; float su[4], sv[4], gate[4]; };

DI void gather_load(GBatch& B, const char* __restrict__ ws, unsigned idpair, f32x2 gpair, int eb, int lane) {
#pragma unroll
    for (int j = 0; j < 4; ++j) {
        const int e = eb + j;
        const unsigned pr = __shfl(idpair, e >> 1);
        const unsigned id = (j & 1) ? (pr >> 16) : (pr & 0xFFFFu);
        const float g0 = __shfl(gpair[0], e >> 1), g1 = __shfl(gpair[1], e >> 1);
        B.gate[j] = (j & 1) ? g1 : g0;
        B.U[j] = ldu4(ws + OFF_UQ + (size_t)id * 1024 + 16 * lane);
        B.V[j] = ldu4(ws + OFF_VQ + (size_t)id * 1024 + 16 * lane);
        B.su[j] = ((const float*)(ws + OFF_SU))[id];
        B.sv[j] = ((const float*)(ws + OFF_SV))[id];
    }
}

DI void gather_compute(const GBatch& B, const unsigned (&qx)[4], float sx, float (&acc)[16], float& csum, int lane) {
    int pd[4];
#pragma unroll
    for (int j = 0; j < 4; ++j) {
        int d = 0;
#pragma unroll
        for (int q = 0; q < 4; ++q) d = __builtin_amdgcn_sdot4((int)B.U[j][q], (int)qx[q], d, false);
        pd[j] = d;
    }
    const bool b0 = lane & 1, b1 = lane & 2;
    const int kA = b0 ? pd[1] : pd[0], kB = b0 ? pd[3] : pd[2], sA = b0 ? pd[0] : pd[1], sB = b0 ? pd[2] : pd[3];
    const int qA = kA + DPP_I(sA, 0xB1), qB = kB + DPP_I(sB, 0xB1);
    const int kp = b1 ? qB : qA, sd = b1 ? qA : qB;
    int tot = kp + DPP_I(sd, 0x4E);
    tot += DPP_I(tot, 0x124);
    tot += DPP_I(tot, 0x128);
    tot += __builtin_amdgcn_ds_swizzle(tot, 0x401F);
    { auto rr = __builtin_amdgcn_permlane32_swap((unsigned)tot, (unsigned)tot, false, false); tot = (int)rr[0] + (int)rr[1]; }
    const int j3 = lane & 3;
    const float su_sel = (j3 == 0) ? B.su[0] : (j3 == 1 ? B.su[1] : (j3 == 2 ? B.su[2] : B.su[3]));
    const float ge = gelu_erf((float)tot * sx * su_sel);
#pragma unroll
    for (int j = 0; j < 4; ++j) {
        const float cf = B.gate[j] * B.sv[j] * __uint_as_float((unsigned)__builtin_amdgcn_readlane((int)__float_as_uint(ge), j));
#pragma unroll
        for (int q = 0; q < 4; ++q) {
            const int w = (int)B.V[j][q];
            const f32x2 lo = __builtin_amdgcn_cvt_pk_f32_fp8(w, false), hi = __builtin_amdgcn_cvt_pk_f32_fp8(w, true);
            acc[4 * q] += cf * lo[0]; acc[4 * q + 1] += cf * lo[1]; acc[4 * q + 2] += cf * hi[0]; acc[4 * q + 3] += cf * hi[1];
        }
    }
}

DI void gather_token(const Params& p, size_t tok, int lane, float* dst_base) {
    char* ws = p.ws;
    const bf16_t* hrow = (const bf16_t*)(ws + OFF_HB) + tok * 1024 + 16 * lane;
    float hv[16];
    {
        const u32x4 w0 = ldu4(hrow), w1 = ldu4(hrow + 8);
#pragma unroll
        for (int e = 0; e < 4; ++e) { hv[2 * e] = bf_lo(w0[e]); hv[2 * e + 1] = bf_hi(w0[e]); hv[8 + 2 * e] = bf_lo(w1[e]); hv[8 + 2 * e + 1] = bf_hi(w1[e]); }
    }
    float rs;
    {
        const float* SS = (const float*)(ws + OFF_SS2) + tok * 16;
        const f32x4 s0 = *(const f32x4*)SS, s1 = *(const f32x4*)(SS + 4), s2 = *(const f32x4*)(SS + 8), s3 = *(const f32x4*)(SS + 12);
        const float tot = (s0[0] + s0[1] + s0[2] + s0[3]) + (s1[0] + s1[1] + s1[2] + s1[3]) + (s2[0] + s2[1] + s2[2] + s2[3]) + (s3[0] + s3[1] + s3[2] + s3[3]);
        rs = rsqrtf(tot * (1.0f / 1024.0f) + 1e-6f);
    }
    float xf[16]; float am = 0.f;
#pragma unroll
    for (int i = 0; i < 4; ++i) {
        const f32x4 g = *(const f32x4*)(p.norm_ffn + 16 * lane + 4 * i);
#pragma unroll
        for (int e = 0; e < 4; ++e) { xf[4 * i + e] = hv[4 * i + e] * rs * g[e]; am = fmaxf(am, fabsf(xf[4 * i + e])); }
    }
#pragma unroll
    for (int o = 32; o; o >>= 1) am = fmaxf(am, __shfl_xor(am, o));
    const float sx = (am > 0.f) ? am * (1.0f / 127.0f) : 1.0f;
    const float isx = 1.0f / sx;
    unsigned qx[4];
#pragma unroll
    for (int i = 0; i < 4; ++i) {
        unsigned w = 0u;
#pragma unroll
        for (int e = 0; e < 4; ++e) w |= ((unsigned)(int)rintf(xf[4 * i + e] * isx) & 0xFFu) << (8 * e);
        qx[i] = w;
    }
    const unsigned idpair = *((const unsigned*)(ws + OFF_SELID) + tok * 64 + lane);
    const f32x2 gpair = *((const f32x2*)(ws + OFF_SELG) + tok * 64 + lane);
    float acc[16]; float csum = 0.f;
#pragma unroll
    for (int i = 0; i < 16; ++i) acc[i] = 0.f;
    GBatch B0, B1;
    gather_load(B0, ws, idpair, gpair, 0, lane);
#pragma unroll 1
    for (int eb = 0; eb < 128; eb += 8) {
        gather_load(B1, ws, idpair, gpair, eb + 4, lane);
        gather_compute(B0, qx, sx, acc, csum, lane);
        if (eb + 8 < 128) gather_load(B0, ws, idpair, gpair, eb + 8, lane);
        gather_compute(B1, qx, sx, acc, csum, lane);
    }
    float ss = 0.f;
#pragma unroll
    for (int i = 0; i < 16; ++i) { acc[i] = acc[i] - 128.0f * csum + hv[i]; ss += acc[i] * acc[i]; }
#pragma unroll
    for (int o = 32; o; o >>= 1) ss += __shfl_xor(ss, o);
    const float rf = rsqrtf(ss * (1.0f / 1024.0f) + 1e-6f);
    float* drow = dst_base + tok * 1024 + 16 * lane;
#pragma unroll
    for (int i = 0; i < 4; ++i) {
        const f32x4 n = *(const f32x4*)(p.norm_final + 16 * lane + 4 * i);
        *(f32x4*)(drow + 4 * i) = (f32x4){acc[4 * i] * rf * n[0], acc[4 * i + 1] * rf * n[1], acc[4 * i + 2] * rf * n[2], acc[4 * i + 3] * rf * n[3]};
    }
}

DI void phase_gather(const Params& p, bool dry = false) {
    const int lane = otid() & 63, wv = otid() >> 6;
    float* dst = dry ? (float*)(p.ws + OFF_A) : p.out;
    for (int item = vbid(); item < T_TOK / 4; item += vgrid()) gather_token(p, (size_t)item * 4 + wv, lane, dst);
}

constexpr size_t GS_SIDS = OFF_A;
constexpr size_t GS_SGS = GS_SIDS + (size_t)T_TOK * 256;
constexpr size_t GS_OFF = GS_SGS + (size_t)T_TOK * 512;
constexpr size_t GS_XQ = GS_OFF + (size_t)T_TOK * 64;
constexpr size_t GS_SX = GS_XQ + (size_t)T_TOK * 1024;
constexpr size_t GS_ACC = GS_SX + (size_t)T_TOK * 4;
static_assert(GS_ACC + (size_t)T_TOK * 2048 <= OFF_A + 69 * MiB, "gather scratch overflows region A");

DI void gs_load(GBatch& B, const char* __restrict__ ws, unsigned myid, float mygate, int j0, int n, int lane) {
#pragma unroll
    for (int j = 0; j < 4; ++j) {
        const int e = __builtin_amdgcn_readfirstlane(j0 + j);
        const bool ok = e < n;
        const int src = ok ? e : 0;
        const unsigned id = (unsigned)__builtin_amdgcn_readlane((int)myid, src);
        const float g = __uint_as_float((unsigned)__builtin_amdgcn_readlane((int)__float_as_uint(mygate), src));
        B.gate[j] = ok ? g : 0.f;
        const char* urow = ws + OFF_UQ + (size_t)id * 1024;
        const char* vrow = ws + OFF_VQ + (size_t)id * 1024;
        B.U[j] = ldu4(urow + 16 * lane);
        B.V[j] = ldu4(vrow + 16 * lane);
        B.su[j] = ((const float*)(ws + OFF_SU))[id];
        B.sv[j] = ((const float*)(ws + OFF_SV))[id];
    }
}

#ifndef GS_NSL
#define GS_NSL 16
#endif
constexpr int NSL = GS_NSL, NSL_SH = (GS_NSL == 8 ? 11 : (GS_NSL == 16 ? 10 : (GS_NSL == 32 ? 9 : 12))), OFFW = 64;
DI void phase_gather_sliced(const Params& p, char* smem) {
    char* ws = p.ws;
    if ((T_TOK / 8) > 8 * (((int)gridDim.x >> 3) * 8) || ((int)gridDim.x & 7)) { phase_gather(p); return; }
    char* lacc = smem + (threadIdx.x >> 6) * 16384 + (threadIdx.x & 63) * 32;
    unsigned short* lids = (unsigned short*)(smem + 131072 + (threadIdx.x >> 6) * 2048);
    unsigned char* loff = (unsigned char*)(smem + 131072 + 16384 + (threadIdx.x >> 6) * (8 * OFFW));
    const int lane = threadIdx.x & 63;
    const int x = (int)blockIdx.x & 7, nW = ((int)gridDim.x >> 3) * 8, lw = ((int)blockIdx.x >> 3) * 8 + (int)(threadIdx.x >> 6);
    const int TPX = T_TOK / 8;
    for (int tl = lw; tl < TPX; tl += nW) {
        const size_t tok = (size_t)x * TPX + tl;
        const bf16_t* hrow = (const bf16_t*)(ws + OFF_HB) + tok * 1024 + 16 * lane;
        float hv[16];
        {
            const u32x4 w0 = ldu4(hrow), w1 = ldu4(hrow + 8);
#pragma unroll
            for (int e = 0; e < 4; ++e) { hv[2 * e] = bf_lo(w0[e]); hv[2 * e + 1] = bf_hi(w0[e]); hv[8 + 2 * e] = bf_lo(w1[e]); hv[8 + 2 * e + 1] = bf_hi(w1[e]); }
        }
        float rs;
        {
            const float* SS = (const float*)(ws + OFF_SS2) + tok * 16;
            const f32x4 s0 = *(const f32x4*)SS, s1 = *(const f32x4*)(SS + 4), s2 = *(const f32x4*)(SS + 8), s3 = *(const f32x4*)(SS + 12);
            const float tot = (s0[0] + s0[1] + s0[2] + s0[3]) + (s1[0] + s1[1] + s1[2] + s1[3]) + (s2[0] + s2[1] + s2[2] + s2[3]) + (s3[0] + s3[1] + s3[2] + s3[3]);
            rs = rsqrtf(tot * (1.0f / 1024.0f) + 1e-6f);
        }
        float xf[16]; float am = 0.f;
#pragma unroll
        for (int i = 0; i < 4; ++i) {
            const f32x4 g = *(const f32x4*)(p.norm_ffn + 16 * lane + 4 * i);
#pragma unroll
            for (int e = 0; e < 4; ++e) { xf[4 * i + e] = hv[4 * i + e] * rs * g[e]; am = fmaxf(am, fabsf(xf[4 * i + e])); }
        }
#pragma unroll
        for (int o = 32; o; o >>= 1) am = fmaxf(am, __shfl_xor(am, o));
        const float sx = (am > 0.f) ? am * (1.0f / 127.0f) : 1.0f;
        const float isx = 1.0f / sx;
        u32x4 qx;
#pragma unroll
        for (int i = 0; i < 4; ++i) {
            unsigned w = 0u;
#pragma unroll
            for (int e = 0; e < 4; ++e) w |= ((unsigned)(int)rintf(xf[4 * i + e] * isx) & 0xFFu) << (8 * e);
            qx[i] = w;
        }
        *(u32x4*)(ws + GS_XQ + tok * 1024 + 16 * lane) = qx;
        if (lane == 0) ((float*)(ws + GS_SX))[tok] = sx;
        const unsigned idpair = *((const unsigned*)(ws + OFF_SELID) + tok * 64 + lane);
        const f32x2 gpair = *((const f32x2*)(ws + OFF_SELG) + tok * 64 + lane);
        const unsigned id0 = idpair & 0xFFFFu, id1 = idpair >> 16;
        const int sl0 = (int)(id0 >> NSL_SH), sl1 = (int)(id1 >> NSL_SH);
        const unsigned long long lt = (1ull << lane) - 1ull;
        int base = 0, pos0 = 0, pos1 = 0, myoff = 0;
#pragma unroll
        for (int s = 0; s < NSL; ++s) {
            const unsigned long long m0 = __ballot(sl0 == s), m1 = __ballot(sl1 == s);
            const int c0 = __popcll(m0), c1 = __popcll(m1);
            if (sl0 == s) pos0 = base + __popcll(m0 & lt);
            if (sl1 == s) pos1 = base + c0 + __popcll(m1 & lt);
            if (lane == s) myoff = base;
            base += c0 + c1;
        }
        if (lane == NSL) myoff = base;
        unsigned short* sid = (unsigned short*)(ws + GS_SIDS) + tok * 128;
        float* sg = (float*)(ws + GS_SGS) + tok * 128;
        sid[pos0] = (unsigned short)id0; sid[pos1] = (unsigned short)id1;
        { const int k = (tl - lw) / nW; lids[k * 128 + pos0] = (unsigned short)id0; lids[k * 128 + pos1] = (unsigned short)id1; if (lane <= NSL) loff[k * OFFW + lane] = (unsigned char)myoff; }
        sg[pos0] = gpair[0]; sg[pos1] = gpair[1];

    }
    __syncthreads();
    const int ntk = (TPX - lw + nW - 1) / nW;
    for (int k = 0; k < ntk; ++k) { *(u32x4*)(lacc + k * 2048) = (u32x4){0u, 0u, 0u, 0u}; *(u32x4*)(lacc + k * 2048 + 16) = (u32x4){0u, 0u, 0u, 0u}; }
    const float* SGS = (const float*)(ws + GS_SGS);
    struct SB { u32x4 U[4], V[4], qx; float su_v, gsv_v, sx; int k; };
#pragma unroll 1
    for (int pass = 0; pass < NSL; ++pass) {
        const int slice = pass;
        int kL = 0, jL = 0, nL = 0, oL = 0;
        float acc[16]; int kC = -1;
#define GS_OPEN(k_) do { oL = __builtin_amdgcn_readfirstlane((int)loff[(k_) * OFFW + slice]); nL = __builtin_amdgcn_readfirstlane((int)loff[(k_) * OFFW + slice + 1]) - oL; jL = 0; } while (0)
#define GS_ADVANCE(ok_) do { if (jL + 4 < nL) { jL += 4; ok_ = true; } else if (kL + 1 >= ntk) ok_ = false; else { ++kL; GS_OPEN(kL); ok_ = true; } } while (0)
#define GS_LOAD(B_, valid_) do { const size_t tok_ = (size_t)x * TPX + lw + (size_t)kL * nW; \
            const int el_ = jL + (lane & 3); const bool okl_ = el_ < nL; const int il_ = oL + (okl_ ? el_ : 0);            \
            const unsigned idv_ = (unsigned)lids[kL * 128 + (il_ & 127)]; \
            const float gv_ = SGS[tok_ * 128 + (il_ & 127)]; \
            B_.su_v = ((const float*)(ws + OFF_SU))[idv_]; B_.gsv_v = (okl_ ? gv_ : 0.f) * ((const float*)(ws + OFF_SV))[idv_]; \
            _Pragma("unroll") for (int j = 0; j < 4; ++j) { const unsigned id_ = (unsigned)__builtin_amdgcn_readlane((int)idv_, j); \
                B_.U[j] = ldu4(ws + OFF_UQ + (size_t)id_ * 1024 + 16 * lane); B_.V[j] = ldu4(ws + OFF_VQ + (size_t)id_ * 1024 + 16 * lane); } \
            B_.qx = ldu4(ws + GS_XQ + tok_ * 1024 + 16 * lane); B_.sx = ((const float*)(ws + GS_SX))[tok_]; B_.k = (valid_) ? kL : -1; } while (0)
#define GS_FLUSH() do { if (kC >= 0) { const size_t tok_ = (size_t)x * TPX + lw + (size_t)kC * nW; \
            if (pass < NSL - 1) { char* la_ = lacc + kC * 2048; u32x4 w0_, w1_; \
                _Pragma("unroll") for (int e = 0; e < 4; ++e) { w0_[e] = pack2(acc[2 * e], acc[2 * e + 1]); w1_[e] = pack2(acc[8 + 2 * e], acc[8 + 2 * e + 1]); } \
                *(u32x4*)la_ = w0_; *(u32x4*)(la_ + 16) = w1_; } \
            else { const bf16_t* hrow_ = (const bf16_t*)(ws + OFF_HB) + tok_ * 1024 + 16 * lane; const u32x4 w0_ = ldu4(hrow_), w1_ = ldu4(hrow_ + 8); float ss_ = 0.f; \
                _Pragma("unroll") for (int e = 0; e < 4; ++e) { acc[2 * e] += bf_lo(w0_[e]); acc[2 * e + 1] += bf_hi(w0_[e]); acc[8 + 2 * e] += bf_lo(w1_[e]); acc[8 + 2 * e + 1] += bf_hi(w1_[e]); } \
                _Pragma("unroll") for (int i = 0; i < 16; ++i) ss_ += acc[i] * acc[i]; \
                _Pragma("unroll") for (int o = 32; o; o >>= 1) ss_ += __shfl_xor(ss_, o); \
                const float rf_ = rsqrtf(ss_ * (1.0f / 1024.0f) + 1e-6f); float* drow_ = p.out + tok_ * 1024 + 16 * lane; \
                _Pragma("unroll") for (int i = 0; i < 4; ++i) { const f32x4 nn_ = *(const f32x4*)(p.norm_final + 16 * lane + 4 * i); \
                    *(f32x4*)(drow_ + 4 * i) = (f32x4){acc[4 * i] * rf_ * nn_[0], acc[4 * i + 1] * rf_ * nn_[1], acc[4 * i + 2] * rf_ * nn_[2], acc[4 * i + 3] * rf_ * nn_[3]}; } } } } while (0)
#define GS_CONSUME(B_) do { if (B_.k >= 0) { \
            if (B_.k != kC) { GS_FLUSH(); kC = B_.k; const char* la_ = lacc + kC * 2048; const u32x4 w0_ = *(const u32x4*)la_, w1_ = *(const u32x4*)(la_ + 16); \
                _Pragma("unroll") for (int e = 0; e < 4; ++e) { acc[2 * e] = bf_lo(w0_[e]); acc[2 * e + 1] = bf_hi(w0_[e]); acc[8 + 2 * e] = bf_lo(w1_[e]); acc[8 + 2 * e + 1] = bf_hi(w1_[e]); } } \
            int pd_[4]; \
            _Pragma("unroll") for (int j = 0; j < 4; ++j) { int d_ = 0; _Pragma("unroll") for (int q = 0; q < 4; ++q) d_ = __builtin_amdgcn_sdot4((int)B_.U[j][q], (int)B_.qx[q], d_, false); pd_[j] = d_; } \
            const bool b0_ = lane & 1, b1_ = lane & 2; \
            const int kA_ = b0_ ? pd_[1] : pd_[0], kB_ = b0_ ? pd_[3] : pd_[2], sA_ = b0_ ? pd_[0] : pd_[1], sB_ = b0_ ? pd_[2] : pd_[3]; \
            const int qA_ = kA_ + DPP_I(sA_, 0xB1), qB_ = kB_ + DPP_I(sB_, 0xB1); \
            const int kp_ = b1_ ? qB_ : qA_, sd_ = b1_ ? qA_ : qB_; \
            int tot_ = kp_ + DPP_I(sd_, 0x4E); tot_ += DPP_I(tot_, 0x124); tot_ += DPP_I(tot_, 0x128); tot_ += __builtin_amdgcn_ds_swizzle(tot_, 0x401F); \
            { auto rr_ = __builtin_amdgcn_permlane32_swap((unsigned)tot_, (unsigned)tot_, false, false); tot_ = (int)rr_[0] + (int)rr_[1]; } \
            const float cfv_ = B_.gsv_v * gelu_erf((float)tot_ * B_.sx * B_.su_v); \
            _Pragma("unroll") for (int j = 0; j < 4; ++j) { const float cf_ = __uint_as_float((unsigned)__builtin_amdgcn_readlane((int)__float_as_uint(cfv_), j)); \
                _Pragma("unroll") for (int q = 0; q < 4; ++q) { const int w_ = (int)B_.V[j][q]; const f32x2 lo_ = __builtin_amdgcn_cvt_pk_f32_fp8(w_, false), hi_ = __builtin_amdgcn_cvt_pk_f32_fp8(w_, true); \
                    acc[4 * q] += cf_ * lo_[0]; acc[4 * q + 1] += cf_ * lo_[1]; acc[4 * q + 2] += cf_ * hi_[0]; acc[4 * q + 3] += cf_ * hi_[1]; } } } } while (0)
        SB S0, S1;
        bool h0, h1;
        GS_OPEN(0);
        GS_LOAD(S0, true);
#pragma unroll 1
        for (;;) {
            GS_ADVANCE(h1); GS_LOAD(S1, h1);
            GS_CONSUME(S0);
            if (!h1) break;
            GS_ADVANCE(h0); GS_LOAD(S0, h0);
            GS_CONSUME(S1);
            if (!h0) break;
        }
        GS_FLUSH();
#undef GS_OPEN
#undef GS_ADVANCE
#undef GS_LOAD
#undef GS_FLUSH
#undef GS_CONSUME
    }
}
constexpr int LDS_BYTES = 131072 + 16384 + 4096;
constexpr int NPHASE = 12;
template <int PH> DI void run_phase(const Params& p, char* smem) {
    char* lds = smem + vhalf() * 65536;
    if (PH == 0) phase_prep(p, lds);
    else if (PH == 1) phase_p1(p, smem);
    else if (PH == 2) phase_p2(p, smem);
    else if (PH == 3) phase_p3(p, lds);
    else if (PH == 4) phase_p35(p, lds);
    else if (PH == 5) phase_resid<false>(p, smem, OFF_WT_OUT, OFF_MIXED, p.x, OFF_SS1);
    else if (PH == 6) phase_rowscale(p, smem, OFF_WT_MQ, 1024, (bf16_t*)(p.ws + OFF_QM), OFF_SS1, 0.0625f * LOG2E);
    else if (PH == 7) phase_memattn(p, lds);
    else if (PH == 8) phase_resid<true>(p, smem, OFF_WT_MO, OFF_OM, p.ws + OFF_HB, OFF_SS2);
    else if (PH == 9) phase_rowscale(p, smem, OFF_WT_PQ, 2048, (bf16_t*)((char*)p.out + OUT_PQ), OFF_SS2, 1.0f);
    else if (PH == 10) phase_select(p, lds);
    else if (PH == 11) phase_gather_sliced(p, smem);
}

template <int PH> __global__ void __launch_bounds__(512, 2) k_phase(Params p) {
    __shared__ __attribute__((aligned(16))) char smem[LDS_BYTES];
    run_phase<PH>(p, smem);
}

static Params make_params(void* const* d_in, void* d_out, void* d_ws) {
    Params p;
    memset(&p, 0, sizeof(p));
    p.x = (const float*)d_in[0]; p.mem = (const float*)d_in[1]; p.norm_mix = (const float*)d_in[2]; p.w_in = (const float*)d_in[3];
    p.q_norm = (const float*)d_in[4]; p.kv_norm = (const float*)d_in[5]; p.w_uq = (const float*)d_in[6]; p.w_ukv = (const float*)d_in[7];
    p.gn_mla = (const float*)d_in[8]; p.gn_dil = (const float*)d_in[9]; p.w_out = (const float*)d_in[10]; p.norm_mem_q = (const float*)d_in[11];
    p.norm_mem_kv = (const float*)d_in[12]; p.w_mem_q = (const float*)d_in[13]; p.w_mem_kv = (const float*)d_in[14]; p.w_mem_o = (const float*)d_in[15];
    p.norm_ffn = (const float*)d_in[16]; p.peer_w_q = (const float*)d_in[17]; p.sub_keys = (const float*)d_in[18]; p.peer_u = (const float*)d_in[19];
    p.peer_v = (const float*)d_in[20]; p.norm_final = (const float*)d_in[21];
    p.out = (float*)d_out; p.ws = (char*)d_ws;
    for (int i = 0; i < 16; ++i) p.inv_freq[i] = 1.0f / powf(10000.0f, (float)(2 * i) / 32.0f);
    return p;
}
__global__ void __launch_bounds__(512, 2) k_mega(Params p) {
    __shared__ __attribute__((aligned(16))) char smem[LDS_BYTES + 16];
    volatile LAS unsigned* st = (volatile LAS unsigned*)(LAS char*)(smem + LDS_BYTES);
    if (threadIdx.x == 0) { st[0] = 0u; st[1] = 0u; st[2] = 0u; st[3] = 0u; }
    __syncthreads();
    const XcdBarrier xb = xcd_barrier_post((unsigned*)(p.ws + OFF_BAR), st);
#define RP(n) run_phase<n>(p, smem); xcd_barrier(xb);
    RP(0) RP(1) RP(2) RP(3) RP(4) RP(5) RP(6) RP(7) RP(8) RP(9) RP(10)
    run_phase<11>(p, smem);
}

extern "C" void kernel_launch(void* const* d_in, const int* in_sizes, int n_in, void* d_out, int out_size, void* d_ws, size_t ws_size,
                              hipStream_t stream) {
    static int grid_blocks = 0;
    if (!grid_blocks) {
        int dev = 0, cus = 0, per_cu = 0;
        (void)hipGetDevice(&dev);
        (void)hipDeviceGetAttribute(&cus, hipDeviceAttributeMultiprocessorCount, dev);
        (void)hipOccupancyMaxActiveBlocksPerMultiprocessor(&per_cu, k_mega, 512, 0);
        if (per_cu > 1) per_cu = 1;
        if (per_cu < 1) per_cu = 1;
        grid_blocks = cus * per_cu;
    }
    Params p = make_params(d_in, d_out, d_ws);
    (void)hipMemsetAsync((char*)d_ws + OFF_BAR, 0, XCD_BAR_WORDS * 4, stream);
    void* args[] = {&p};
    hipError_t e = hipLaunchCooperativeKernel((const void*)k_mega, dim3(grid_blocks), dim3(512), args, 0, stream);
    if (e != hipSuccess) fprintf(stderr, "cooperative launch failed: %s (grid %d)\n", hipGetErrorString(e), grid_blocks);
}
```

```cpp
#include <hip/hip_runtime.h>
#include <hip/hip_cooperative_groups.h>
#include <math.h>
#include <stdint.h>
#include <stdio.h>
#include <string.h>
#define DI __device__ __forceinline__
typedef unsigned short bf16_t;
typedef short bf16x8 __attribute__((ext_vector_type(8)));
typedef short s16x4 __attribute__((ext_vector_type(4)));
typedef float f32x16 __attribute__((ext_vector_type(16)));
typedef float f32x4 __attribute__((ext_vector_type(4)));
typedef float f32x2 __attribute__((ext_vector_type(2)));
typedef unsigned u32x4 __attribute__((ext_vector_type(4)));
typedef unsigned u32x2 __attribute__((ext_vector_type(2)));
typedef __bf16 bf16x2v __attribute__((ext_vector_type(2)));
#define LAS __attribute__((address_space(3)))
#define MFMA32(a, b, c) __builtin_amdgcn_mfma_f32_32x32x16_bf16((a), (b), (c), 0, 0, 0)

constexpr int T_TOK = 16384, SEQ_L = 4096, DM = 1024, INC = 2208;
constexpr float LOG2E = 1.4426950408889634f;

DI int otid() { int t = threadIdx.x & 255; asm volatile("" : "+v"(t)); return t; }
DI int vhalf() { return __builtin_amdgcn_readfirstlane((int)(threadIdx.x >> 8)); }
DI int vbid() { return (int)blockIdx.x * 2 + vhalf(); }
DI int vgrid() { return (int)gridDim.x * 2; }
DI unsigned pack2(float lo, float hi) { f32x2 f = {lo, hi}; return __builtin_bit_cast(unsigned, __builtin_convertvector(f, bf16x2v)); }
DI float bf_lo(unsigned u) { return __uint_as_float(u << 16); }
DI float bf_hi(unsigned u) { return __uint_as_float(u & 0xffff0000u); }
DI float bf2f(bf16_t v) { return __uint_as_float(((unsigned)v) << 16); }
DI int crow(int reg, int hh) { return (reg & 3) + 8 * (reg >> 2) + 4 * hh; }
DI f32x16 zero16() { f32x16 z;
#pragma unroll
    for (int i = 0; i < 16; ++i) z[i] = 0.f; return z; }
DI float xhalf_max(float v) { auto r = __builtin_amdgcn_permlane32_swap(__float_as_uint(v), __float_as_uint(v), false, false); return fmaxf(__uint_as_float(r[0]), __uint_as_float(r[1])); }
DI float xhalf_other(float v, int lane) { auto r = __builtin_amdgcn_permlane32_swap(__float_as_uint(v), __float_as_uint(v), false, false); return __uint_as_float((lane & 32) ? r[0] : r[1]); }
DI float xhalf_sum(float v) { auto r = __builtin_amdgcn_permlane32_swap(__float_as_uint(v), __float_as_uint(v), false, false); return __uint_as_float(r[0]) + __uint_as_float(r[1]); }
DI bf16x8 ld16(const void* p) { return *(const bf16x8*)p; }
DI u32x4 ldu4(const void* p) { return *(const u32x4*)p; }
DI float fast_exp2(float x) { return __builtin_amdgcn_exp2f(x); }
DI bf16x8 pack_step(const f32x16& x, int s) {
    u32x4 p;
    p[0] = pack2(x[8 * s + 0], x[8 * s + 1]); p[1] = pack2(x[8 * s + 2], x[8 * s + 3]);
    p[2] = pack2(x[8 * s + 4], x[8 * s + 5]); p[3] = pack2(x[8 * s + 6], x[8 * s + 7]);
    return __builtin_bit_cast(bf16x8, p);
}
DI s16x4 tr_read_a(unsigned lds_byte_addr) { s16x4 r; asm volatile("ds_read_b64_tr_b16 %0, %1" : "=v"(r) : "v"(lds_byte_addr)); return r; }
template <int OFF> DI s16x4 tr_read_ao(unsigned lds_byte_addr) { s16x4 r; asm volatile("ds_read_b64_tr_b16 %0, %1 offset:%2" : "=v"(r) : "v"(lds_byte_addr), "i"(OFF)); return r; }
#define TR_WAIT() do { asm volatile("s_waitcnt lgkmcnt(0)" ::: "memory"); __builtin_amdgcn_sched_barrier(0); } while (0)
DI s16x4 tr_read(unsigned lds_byte_addr) {
    return __builtin_amdgcn_ds_read_tr16_b64_v4i16((LAS s16x4*)(uintptr_t)lds_byte_addr);
}

constexpr size_t MiB = 1ull << 20;
constexpr size_t OFF_BAR = 0;
constexpr size_t OFF_WT_IN = 65536;
constexpr size_t OFF_WT_UQ = OFF_WT_IN + 2304ull * 1024 * 2;
constexpr size_t OFF_WT_UKV = OFF_WT_UQ + 768ull * 384 * 2;
constexpr size_t OFF_WT_OUT = OFF_WT_UKV + 1024ull * 256 * 2;
constexpr size_t OFF_WT_MQ = OFF_WT_OUT + 1024ull * 1024 * 2;
constexpr size_t OFF_WT_MKV = OFF_WT_MQ + 1024ull * 1024 * 2;
constexpr size_t OFF_WT_MO = OFF_WT_MKV + 2048ull * 1024 * 2;
constexpr size_t OFF_WT_PQ = OFF_WT_MO + 1024ull * 1024 * 2;
constexpr size_t OFF_KEYS = OFF_WT_PQ + 2048ull * 1024 * 2;
constexpr size_t OFF_ROPE = OFF_KEYS + 16ull * 128 * 128 * 2;
constexpr size_t OFF_KR = OFF_ROPE + 2ull * 4096 * 16 * 4;
constexpr size_t OFF_LSE = OFF_KR + (size_t)T_TOK * 32 * 2;
constexpr size_t OFF_SS1 = OFF_LSE + 3ull * T_TOK * 8 * 4;
constexpr size_t OFF_SS2 = OFF_SS1 + (size_t)T_TOK * 16 * 4;
constexpr size_t OFF_MEMN = OFF_SS2 + (size_t)T_TOK * 16 * 4;
constexpr size_t OFF_SMALL_END = OFF_MEMN + 1024ull * 1024 * 2;
static_assert(OFF_SMALL_END <= 28 * MiB, "small region overflow");
constexpr size_t OFF_A = 28 * MiB;
constexpr size_t OFF_PROJ = OFF_A;
constexpr size_t OFF_UQ = 193 * MiB;
constexpr size_t OFF_SU = 243 * MiB;
constexpr size_t OFF_SV = OFF_SU + 65536;
constexpr size_t OUT_ODIL = 0;
constexpr size_t OUT_OMLA = 48 * MiB;
constexpr size_t OUT_PQ = 0;
constexpr size_t OFF_B = 97 * MiB;
constexpr size_t OFF_XN = OFF_B, OFF_QMLA = OFF_B, OFF_MIXED = OFF_B, OFF_QM = OFF_B;
constexpr size_t OFF_C = 129 * MiB;
constexpr size_t OFF_KVMLA = OFF_C, OFF_HB = OFF_C;
constexpr size_t OFF_D = 161 * MiB;
constexpr size_t OFF_OM = OFF_D;
constexpr size_t OFF_SELID = 225 * MiB;
constexpr size_t OFF_SELG = 229 * MiB;
constexpr size_t OFF_KVM = 237 * MiB;
constexpr size_t OFF_SSQ = 241 * MiB;
constexpr size_t WS_NEEDED = 244 * MiB;

struct Params {
    const float* x; const float* mem; const float* norm_mix; const float* w_in; const float* q_norm; const float* kv_norm;
    const float* w_uq; const float* w_ukv; const float* gn_mla; const float* gn_dil; const float* w_out; const float* norm_mem_q;
    const float* norm_mem_kv; const float* w_mem_q; const float* w_mem_kv; const float* w_mem_o; const float* norm_ffn;
    const float* peer_w_q; const float* sub_keys; const float* peer_u; const float* peer_v; const float* norm_final;
    float* out; char* ws;
    float inv_freq[16];
    int prof; int pad_;
};
#define XB_TMO      128
#define XB_XCNT(j)  (256  + 64 * (j))
#define XB_XSUB(j)  (1280 + 64 * (j))
#define XB_XGEN(j)  (2304 + 64 * (j))
#define XB_TOP      3328
#define XB_TOPGEN   3392
#define XCD_BAR_WORDS 3456
#define XB_SPIN_CAP (1u << 20)
DI unsigned xb_ld(unsigned* p) { return __hip_atomic_load(p, __ATOMIC_RELAXED, __HIP_MEMORY_SCOPE_AGENT); }
DI unsigned xb_add(unsigned* p, unsigned v) { return __hip_atomic_fetch_add(p, v, __ATOMIC_RELAXED, __HIP_MEMORY_SCOPE_AGENT); }
DI unsigned xb_xcc_id() { return (unsigned)__builtin_amdgcn_s_getreg((3 << 11) | 20) & 0xFu; }
#define XB_SPIN(cond, bar) do { unsigned _sp = 0; while (cond) { __builtin_amdgcn_s_sleep(1); \
    if ((++_sp & 255u) == 0u) { if (xb_ld(&(bar)[XB_TMO])) break; if (_sp > XB_SPIN_CAP) { atomicAdd(&(bar)[XB_TMO], 1u); break; } } } } while (0)
struct XcdBarrier { unsigned* bar; unsigned x; volatile LAS unsigned* st; };
DI XcdBarrier xcd_barrier_post(unsigned* bar, volatile LAS unsigned* st) {
    XcdBarrier b; b.bar = bar; b.x = xb_xcc_id(); b.st = st;
    if (threadIdx.x == 0) (void)xb_add(&bar[XB_XCNT(b.x)], 1u);
    return b;
}
DI void xcd_barrier_complete(unsigned* bar, unsigned x, unsigned& nloc, unsigned& nx) {
    const unsigned G = gridDim.x * gridDim.y * gridDim.z;
    unsigned sum, cnt, mine, sp = 0u;
    for (;;) {
        sum = 0u; cnt = 0u; mine = 0u;
#pragma unroll
        for (unsigned j = 0; j < 16; ++j) { const unsigned c = xb_ld(&bar[XB_XCNT(j)]); sum += c; cnt += (c > 0u) ? 1u : 0u; mine = (j == x) ? c : mine; }
        if (sum == G) break;
        __builtin_amdgcn_s_sleep(1);
        if ((++sp & 255u) == 0u) { if (xb_ld(&bar[XB_TMO])) break; if (sp > XB_SPIN_CAP) { atomicAdd(&bar[XB_TMO], 1u); break; } }
    }
    nloc = mine > 0u ? mine : 1u; nx = cnt > 0u ? cnt : 1u;
}
DI void xcd_barrier(const XcdBarrier& b) {
    asm volatile("s_waitcnt vmcnt(0)" ::: "memory");
    __syncthreads();
    if (threadIdx.x == 0) {
        unsigned* bar = b.bar;
        __builtin_amdgcn_s_waitcnt(0);
        unsigned nloc = b.st[0], nx = b.st[1];
        if (nloc == 0u) { xcd_barrier_complete(bar, b.x, nloc, nx); b.st[0] = nloc; b.st[1] = nx; }
        const unsigned old = xb_add(&bar[XB_XSUB(b.x)], 1u);
        const unsigned gen = old / nloc;
        if (old + 1u == (gen + 1u) * nloc) {
            __builtin_amdgcn_fence(__ATOMIC_RELEASE, "agent");
            asm volatile("s_waitcnt vmcnt(0)" ::: "memory");
            const unsigned og = xb_add(&bar[XB_TOP], 1u);
            const unsigned tg = og / nx;
            if (og + 1u == (tg + 1u) * nx) xb_add(&bar[XB_TOPGEN], 1u);
            else XB_SPIN(xb_ld(&bar[XB_TOPGEN]) == tg, bar);
            __builtin_amdgcn_fence(__ATOMIC_ACQUIRE, "agent");
            xb_add(&bar[XB_XGEN(b.x)], 1u);
            asm volatile("s_waitcnt vmcnt(0)" ::: "memory");
        } else {
            XB_SPIN(xb_ld(&bar[XB_XGEN(b.x)]) == gen, bar);
            __builtin_amdgcn_fence(__ATOMIC_ACQUIRE, "agent");
            asm volatile("s_waitcnt vmcnt(0)" ::: "memory");
        }
    }
    __syncthreads();
}
DI void transpose_tile(const float* __restrict__ W, int K, int N, const float* __restrict__ g, bf16_t* __restrict__ Wt, int kt, int nt, char* lds, bool valid) {
    float* sm = (float*)lds;
    const int t = otid();
    const int k0 = kt * 64, n0 = nt * 64;
    __syncthreads();
#pragma unroll
    for (int i = 0; i < 16; ++i) {
        const int id = t + 256 * i, k = id >> 6, n = id & 63;
        float v = 0.f;
        if (valid && n0 + n < N) { v = W[(size_t)(k0 + k) * N + n0 + n]; if (g) v *= g[k0 + k]; }
        sm[k * 65 + n] = v;
    }
    __syncthreads();
    const int n = t >> 2, kc = (t & 3) * 16;
    u32x4 o0, o1;
    o0[0] = pack2(sm[(kc + 0) * 65 + n], sm[(kc + 1) * 65 + n]); o0[1] = pack2(sm[(kc + 2) * 65 + n], sm[(kc + 3) * 65 + n]);
    o0[2] = pack2(sm[(kc + 4) * 65 + n], sm[(kc + 5) * 65 + n]); o0[3] = pack2(sm[(kc + 6) * 65 + n], sm[(kc + 7) * 65 + n]);
    o1[0] = pack2(sm[(kc + 8) * 65 + n], sm[(kc + 9) * 65 + n]); o1[1] = pack2(sm[(kc + 10) * 65 + n], sm[(kc + 11) * 65 + n]);
    o1[2] = pack2(sm[(kc + 12) * 65 + n], sm[(kc + 13) * 65 + n]); o1[3] = pack2(sm[(kc + 14) * 65 + n], sm[(kc + 15) * 65 + n]);
    bf16_t* dst = Wt + (size_t)(n0 + n) * K + k0 + kc;
    if (valid) { *(u32x4*)dst = o0; *(u32x4*)(dst + 8) = o1; }
}

DI void rmsnorm_row_bf16(const float* __restrict__ in, const float* __restrict__ g, bf16_t* __restrict__ out, int lane) {
    f32x4 v[4]; float ss = 0.f;
#pragma unroll
    for (int i = 0; i < 4; ++i) { v[i] = *(const f32x4*)(in + 4 * lane + 256 * i); ss += v[i][0] * v[i][0] + v[i][1] * v[i][1] + v[i][2] * v[i][2] + v[i][3] * v[i][3]; }
#pragma unroll
    for (int o = 32; o; o >>= 1) ss += __shfl_xor(ss, o);
    const float rs = rsqrtf(ss * (1.0f / 1024.0f) + 1e-6f);
#pragma unroll
    for (int i = 0; i < 4; ++i) {
        const f32x4 gg = *(const f32x4*)(g + 4 * lane + 256 * i);
        u32x2 o; o[0] = pack2(v[i][0] * rs * gg[0], v[i][1] * rs * gg[1]); o[1] = pack2(v[i][2] * rs * gg[2], v[i][3] * rs * gg[3]);
        *(u32x2*)(out + 4 * lane + 256 * i) = o;
    }
}

struct TrJob { const float* W; const float* g; size_t off; int K, N, Npad; };

DI void phase_prep(const Params& p, char* lds) {
    char* ws = p.ws;
    const int t = otid(), lane = t & 63, wv = t >> 6;
    const int c0 = 576, c1 = c0 + 72, c2 = c1 + 64, c3 = c2 + 256, c4 = c3 + 256, c5 = c4 + 512, c6 = c5 + 256, c7 = c6 + 512;
    const int nrow = (T_TOK + 1024) / 4;
    const int nkeys = 128, nrope = 256;
    const int total = c7 + nrow + nkeys + nrope;
    for (int k = 0; k < (c7 + vgrid() - 1) / vgrid(); ++k) {
        const int raw = vbid() + k * vgrid();
        const bool valid = raw < c7;
        const int item = valid ? raw : 0;
        const float* W; const float* g; size_t off; int K, N, Npad, local;
        if (item < c0)      { W = p.w_in;     g = nullptr;      off = OFF_WT_IN;  K = 1024; N = 2208; Npad = 2304; local = item; }
        else if (item < c1) { W = p.w_uq;     g = p.q_norm;     off = OFF_WT_UQ;  K = 384;  N = 768;  Npad = 768;  local = item - c0; }
        else if (item < c2) { W = p.w_ukv;    g = p.kv_norm;    off = OFF_WT_UKV; K = 256;  N = 1024; Npad = 1024; local = item - c1; }
        else if (item < c3) { W = p.w_out;    g = nullptr;      off = OFF_WT_OUT; K = 1024; N = 1024; Npad = 1024; local = item - c2; }
        else if (item < c4) { W = p.w_mem_q;  g = p.norm_mem_q; off = OFF_WT_MQ;  K = 1024; N = 1024; Npad = 1024; local = item - c3; }
        else if (item < c5) { W = p.w_mem_kv; g = nullptr;      off = OFF_WT_MKV; K = 1024; N = 2048; Npad = 2048; local = item - c4; }
        else if (item < c6) { W = p.w_mem_o;  g = nullptr;      off = OFF_WT_MO;  K = 1024; N = 1024; Npad = 1024; local = item - c5; }
        else                { W = p.peer_w_q; g = p.norm_ffn;   off = OFF_WT_PQ;  K = 1024; N = 2048; Npad = 2048; local = item - c6; }
        const int ntn = Npad / 64;
        transpose_tile(W, K, N, g, (bf16_t*)(ws + off), local / ntn, local % ntn, lds, valid);
    }
    for (int item = c7 + vbid(); item < total; item += vgrid()) {
        if (item < c7 + nrow) {
            const int row = (item - c7) * 4 + wv;
            if (row < T_TOK) rmsnorm_row_bf16(p.x + (size_t)row * 1024, p.norm_mix, (bf16_t*)(ws + OFF_XN) + (size_t)row * 1024, lane);
            else rmsnorm_row_bf16(p.mem + (size_t)(row - T_TOK) * 1024, p.norm_mem_kv, (bf16_t*)(ws + OFF_MEMN) + (size_t)(row - T_TOK) * 1024, lane);
        } else if (item < c7 + nrow + nkeys) {
            const int idx = ((item - c7 - nrow) * 256 + t) * 8;
            const f32x4 a = *(const f32x4*)(p.sub_keys + idx), b = *(const f32x4*)(p.sub_keys + idx + 4);
            u32x4 o; o[0] = pack2(a[0], a[1]); o[1] = pack2(a[2], a[3]); o[2] = pack2(b[0], b[1]); o[3] = pack2(b[2], b[3]);
            *(u32x4*)((bf16_t*)(ws + OFF_KEYS) + idx) = o;
        } else {
            const int idx = (item - c7 - nrow - nkeys) * 256 + t;
            const int s = idx >> 4, i = idx & 15;
            const float ang = (float)s * p.inv_freq[i];
            const double a = (double)ang;
            const double twopi = 6.283185307179586476925;
            const float rf = (float)(a - twopi * rint(a / twopi));
            float* cs = (float*)(ws + OFF_ROPE);
            cs[idx] = cosf(rf); cs[65536 + idx] = sinf(rf);
        }
    }
}
namespace pg8 {
#define PG8_LAS __attribute__((address_space(3)))
typedef unsigned short bf16_t;
typedef short bf16x8 __attribute__((ext_vector_type(8)));
typedef float f32x4 __attribute__((ext_vector_type(4)));
typedef unsigned u32x4 __attribute__((ext_vector_type(4)));
constexpr int BM = 256, BK = 64, HALF = 128, HTB = HALF * BK * 2  , STAGE_BYTES = 8 * HTB, NXCD = 8, WGM = 8;

__host__ __device__ __forceinline__ int lds_byte(int r, int c) { const int st = (r >> 4) * 2 + (c >> 5), rr = r & 15, cc = c & 31, ob = rr * 64 + cc * 2; return st * 1024 + (ob ^ (((ob >> 9) & 1) << 5)); }
__host__ __device__ __forceinline__ void stage_rc(int b, int& R, int& C) { const int st = b / 1024, sb = b % 1024, swz = sb ^ (((sb >> 9) & 1) << 5); R = (st >> 1) * 16 + swz / 64; C = (st & 1) * 32 + (swz % 64) / 2; }
__host__ __device__ __forceinline__ int perm32(int rho) { const int n = rho >> 4, i = rho & 15; return 8 * (i >> 2) + 4 * n + (i & 3); }

struct Unit { int pm, pn; };
struct Gemm { const bf16_t* A; const bf16_t* Bt; int M, N, K, lda; };

struct StaticOrder {
    int nM, nN, nwg, G, c;
    __host__ __device__ void init(int M, int N, int G_, int c_) { nM = M / BM; nN = N / BM; nwg = nM * nN; G = G_; c = c_; }
    __host__ __device__ bool next(int i, Unit& u) const {
        const long L = (long)i * G + c; if (L >= nwg) return false;
        int wgid = (int)L; { const int q = nwg / NXCD, r = nwg % NXCD, xcd = wgid % NXCD, off = wgid / NXCD; wgid = (xcd < r ? xcd * (q + 1) : r * (q + 1) + (xcd - r) * q) + off; }
        const int nig = WGM * nN, gid = wgid / nig, fm = gid * WGM, gsz = (nM - fm) < WGM ? (nM - fm) : WGM;
        u.pm = fm + ((wgid % nig) % gsz); u.pn = (wgid % nig) / gsz; return true;
    }
    __device__ __forceinline__ void a_ready(const Unit&) const {}
    __device__ __forceinline__ void done(const Unit&) const {}
};

template <class Epi, class Sched, bool ALIGN_EPI = false, bool SP2 = false>
__device__ __forceinline__ void gemm_phase(PG8_LAS unsigned char* lds, const Gemm g, const Sched& S, const Epi& E) {
    int tid_ = threadIdx.x; asm volatile("" : "+v"(tid_));
    const int tid = tid_, wid = __builtin_amdgcn_readfirstlane(tid >> 6), lane = tid & 63, wr = wid >> 2, wc = wid & 3, fr = lane & 15, fq = lane >> 4;
    const int K = g.K, nt = K / BK, lda = g.lda;
    unsigned voffA[2], voffB[2];
#pragma unroll
    for (int i = 0; i < 2; ++i) { int R, C; stage_rc(tid * 16 + i * 8192, R, C); const int Rb = Epi::PERM ? ((R & ~31) + perm32(R & 31)) : R;
        voffA[i] = (unsigned)(R * lda + C) * 2u; voffB[i] = (unsigned)(Rb * K + C) * 2u; }
    const size_t kstep = (size_t)(BK * 2);
    const size_t hstepB = (size_t)HALF * K * 2, hstepA = (size_t)HALF * lda * 2;
    const size_t tstepB = 2 * hstepB, tstepA = 2 * hstepA;
    const unsigned ldsw = (unsigned)wid * 1024u;
    const int aoff = lds_byte(wr * 64 + fr, fq * 8), boff = lds_byte(wc * 32 + fr, fq * 8);
#define PG8_SA(b, h) (((b) * 2 + (h)) * HTB)
#define PG8_SB(b, h) ((4 + (b) * 2 + (h)) * HTB)
#define PG8_STAGE(bufoff, gbase, voff) do { _Pragma("unroll") for (int _i = 0; _i < 2; ++_i) \
        __builtin_amdgcn_global_load_lds((const unsigned*)((const char*)(gbase) + (voff)[_i]), (PG8_LAS unsigned*)(lds + (bufoff) + ldsw + _i * 8192), 16, 0, 0); } while (0)
#define PG8_LDA(dst, b, h) do { _Pragma("unroll") for (int m = 0; m < 4; ++m) _Pragma("unroll") for (int k = 0; k < 2; ++k) dst[m][k] = *(const PG8_LAS bf16x8*)(lds + PG8_SA(b, h) + aoff + m * 2048 + k * 1024); } while (0)
#define PG8_LDB(dst, b, h) do { _Pragma("unroll") for (int n = 0; n < 2; ++n) _Pragma("unroll") for (int k = 0; k < 2; ++k) dst[n][k] = *(const PG8_LAS bf16x8*)(lds + PG8_SB(b, h) + boff + n * 2048 + k * 1024); } while (0)
#define PG8_MMA(ai, bj, At, Bt) do { __builtin_amdgcn_s_setprio(1); _Pragma("unroll") for (int m = 0; m < 4; ++m) _Pragma("unroll") for (int n = 0; n < 2; ++n) _Pragma("unroll") for (int k = 0; k < 2; ++k) \
        acc[ai][bj][m][n] = __builtin_amdgcn_mfma_f32_16x16x32_bf16(Bt[n][k], At[m][k], acc[ai][bj][m][n], 0, 0, 0); __builtin_amdgcn_s_setprio(0); } while (0)
#define PG8_WAIT_V(n) asm volatile("s_waitcnt vmcnt(" #n ")" ::: "memory")
#define PG8_WAIT_L(n) asm volatile("s_waitcnt lgkmcnt(" #n ")" ::: "memory")
#define PG8_BAR __builtin_amdgcn_s_barrier()
#define PG8_SCHED __builtin_amdgcn_sched_barrier(0)
    Unit cur, nxt; int ui = 0;
    if (!S.next(0, cur)) return;
    f32x4 acc[2][2][4][2];
#pragma unroll
    for (int a = 0; a < 2; ++a)
#pragma unroll
        for (int b = 0; b < 2; ++b)
#pragma unroll
            for (int m = 0; m < 4; ++m)
#pragma unroll
                for (int n = 0; n < 2; ++n) acc[a][b][m][n] = (f32x4){0.f, 0.f, 0.f, 0.f};
    bf16x8 At[4][2], B0[2][2], B1[2][2];
    const char* cA = (const char*)g.A + (size_t)cur.pm * tstepA; const char* cB = (const char*)g.Bt + (size_t)cur.pn * tstepB;
    S.a_ready(cur);
    if constexpr (SP2) {
        PG8_STAGE(PG8_SB(0, 0), cB, voffB); PG8_STAGE(PG8_SB(0, 1), cB + hstepB, voffB); PG8_STAGE(PG8_SA(0, 0), cA, voffA); PG8_STAGE(PG8_SA(0, 1), cA + hstepA, voffA);
        if (wr == 1) PG8_BAR;
        PG8_WAIT_V(2); PG8_BAR;
        PG8_STAGE(PG8_SB(1, 0), cB + kstep, voffB); PG8_STAGE(PG8_SA(1, 0), cA + kstep, voffA); PG8_STAGE(PG8_SB(1, 1), cB + hstepB + kstep, voffB);
        PG8_WAIT_V(6); PG8_BAR;
    } else {
        PG8_STAGE(PG8_SB(0, 0), cB, voffB); PG8_STAGE(PG8_SA(0, 0), cA, voffA); PG8_STAGE(PG8_SB(0, 1), cB + hstepB, voffB); PG8_STAGE(PG8_SA(0, 1), cA + hstepA, voffA);
        if (wr == 1) PG8_BAR;
        PG8_WAIT_V(4); PG8_BAR;
        PG8_STAGE(PG8_SB(1, 0), cB + kstep, voffB); PG8_STAGE(PG8_SA(1, 0), cA + kstep, voffA); PG8_STAGE(PG8_SB(1, 1), cB + hstepB + kstep, voffB);
        PG8_WAIT_V(6); PG8_BAR;
    }
    for (;;) {
        const bool has_next = S.next(ui + 1, nxt);
        const char* nA = has_next ? (const char*)g.A + (size_t)nxt.pm * tstepA : cA; const char* nB = has_next ? (const char*)g.Bt + (size_t)nxt.pn * tstepB : cB;
#pragma unroll 1
        for (int t = 0; t < nt; t += 2) {
            const bool last = (t == nt - 2);
            const char* a1 = cA + (size_t)(t + 1) * kstep;
            const char* a2 = last ? nA : cA + (size_t)(t + 2) * kstep; const char* b2 = last ? nB : cB + (size_t)(t + 2) * kstep;
            const char* a3 = a2 + kstep; const char* b3 = b2 + kstep;
            if (last && has_next) S.a_ready(nxt);
            if constexpr (SP2) {
            PG8_LDB(B0, 0, 0); PG8_LDB(B1, 0, 1); PG8_SCHED; PG8_LDA(At, 0, 0); PG8_STAGE(PG8_SA(1, 1), a1 + hstepA, voffA);
            PG8_WAIT_V(8); PG8_WAIT_L(0); PG8_BAR; PG8_MMA(0, 0, At, B0); PG8_MMA(0, 1, At, B1); PG8_BAR; PG8_SCHED;
            PG8_LDA(At, 0, 1); PG8_STAGE(PG8_SB(0, 0), b2, voffB); PG8_STAGE(PG8_SB(0, 1), b2 + hstepB, voffB); PG8_STAGE(PG8_SA(0, 0), a2, voffA);
            PG8_WAIT_V(8); PG8_WAIT_L(0); PG8_BAR; PG8_MMA(1, 0, At, B0); PG8_MMA(1, 1, At, B1); PG8_BAR; PG8_SCHED;
            PG8_LDB(B0, 1, 0); PG8_LDB(B1, 1, 1); PG8_SCHED; PG8_LDA(At, 1, 0); PG8_STAGE(PG8_SA(0, 1), a2 + hstepA, voffA);
            PG8_WAIT_V(8); PG8_WAIT_L(0); PG8_BAR; PG8_MMA(0, 0, At, B0); PG8_MMA(0, 1, At, B1); PG8_BAR; PG8_SCHED;
            PG8_LDA(At, 1, 1); PG8_STAGE(PG8_SB(1, 0), b3, voffB); PG8_STAGE(PG8_SB(1, 1), b3 + hstepB, voffB); PG8_STAGE(PG8_SA(1, 0), a3, voffA);
            PG8_WAIT_V(8); PG8_WAIT_L(0); PG8_BAR; PG8_MMA(1, 0, At, B0); PG8_MMA(1, 1, At, B1); PG8_BAR; PG8_SCHED;
            } else {
            PG8_LDB(B0, 0, 0); PG8_SCHED; PG8_LDA(At, 0, 0); PG8_STAGE(PG8_SA(1, 1), a1 + hstepA, voffA);
            PG8_WAIT_L(8); PG8_BAR; PG8_WAIT_L(0); PG8_MMA(0, 0, At, B0); PG8_BAR; PG8_SCHED;
            PG8_LDB(B1, 0, 1); PG8_STAGE(PG8_SB(0, 0), b2, voffB);
            PG8_BAR; PG8_WAIT_L(0); PG8_MMA(0, 1, At, B1); PG8_BAR;
            PG8_LDA(At, 0, 1); PG8_STAGE(PG8_SA(0, 0), a2, voffA);
            PG8_BAR; PG8_WAIT_L(0); PG8_MMA(1, 0, At, B0); PG8_BAR; PG8_SCHED;
            PG8_STAGE(PG8_SB(0, 1), b2 + hstepB, voffB);
            PG8_WAIT_V(6); PG8_BAR; PG8_MMA(1, 1, At, B1); PG8_BAR;
            PG8_LDB(B0, 1, 0); PG8_SCHED; PG8_LDA(At, 1, 0); PG8_STAGE(PG8_SA(0, 1), a2 + hstepA, voffA);
            PG8_WAIT_L(8); PG8_BAR; PG8_WAIT_L(0); PG8_MMA(0, 0, At, B0); PG8_BAR; PG8_SCHED;
            PG8_LDB(B1, 1, 1); PG8_STAGE(PG8_SB(1, 0), b3, voffB);
            PG8_BAR; PG8_WAIT_L(0); PG8_MMA(0, 1, At, B1); PG8_BAR;
            PG8_LDA(At, 1, 1); PG8_STAGE(PG8_SA(1, 0), a3, voffA);
            PG8_BAR; PG8_WAIT_L(0); PG8_MMA(1, 0, At, B0); PG8_BAR; PG8_SCHED;
            PG8_STAGE(PG8_SB(1, 1), b3 + hstepB, voffB);
            PG8_WAIT_V(6); PG8_BAR; PG8_MMA(1, 1, At, B1); PG8_BAR;
            }
        }
        if constexpr (ALIGN_EPI) { if (wr == 0) PG8_BAR; }
        if constexpr (!Epi::AFTER_DRAIN) { E(acc, cur, wr, wc, fr, fq); S.done(cur); }
        if (!has_next) break;
#pragma unroll
        for (int a = 0; a < 2; ++a)
#pragma unroll
            for (int b = 0; b < 2; ++b)
#pragma unroll
                for (int m = 0; m < 4; ++m)
#pragma unroll
                    for (int n = 0; n < 2; ++n) acc[a][b][m][n] = (f32x4){0.f, 0.f, 0.f, 0.f};
        cur = nxt; cA = nA; cB = nB; ++ui;
        if constexpr (ALIGN_EPI) { if (wr == 1) PG8_BAR; }
    }
    PG8_WAIT_V(0);
    if constexpr (!ALIGN_EPI) { if (wr == 0) PG8_BAR; }
    PG8_BAR;
    if constexpr (Epi::AFTER_DRAIN) { E.fused(acc, cur, wr, wc, fr, fq, lds, wid, lane); S.done(cur); }
#undef PG8_SA
#undef PG8_SB
#undef PG8_STAGE
#undef PG8_LDA
#undef PG8_LDB
#undef PG8_MMA
#undef PG8_WAIT_V
#undef PG8_WAIT_L
#undef PG8_BAR
#undef PG8_SCHED
}
}
DI unsigned sw_off(int row, int chunk) { return (unsigned)(row * 128 + ((chunk ^ ((row >> 1) & 7)) << 4)); }
#define GLDS16(gsrc, ldst) __builtin_amdgcn_global_load_lds((const unsigned*)(gsrc), (unsigned*)(ldst), 16, 0, 0)
DI u32x2 pack4(float a, float b, float c, float d) { u32x2 o; o[0] = pack2(a, b); o[1] = pack2(c, d); return o; }
#define EPI_ARGS const f32x4 (&acc)[2][2][4][2], const pg8::Unit& u, int wr, int wc, int fr, int fq
DI float xq_sum(float v) {
    v += __uint_as_float((unsigned)__builtin_amdgcn_ds_swizzle((int)__float_as_uint(v), 0x401F));
    return xhalf_sum(v);
}
DI u32x4 pack8(const float (&v)[8], float sc) {
    u32x4 o; o[0] = pack2(v[0] * sc, v[1] * sc); o[1] = pack2(v[2] * sc, v[3] * sc); o[2] = pack2(v[4] * sc, v[5] * sc); o[3] = pack2(v[6] * sc, v[7] * sc); return o;
}
DI void rope8(const float (&v)[8], float sc, const float* __restrict__ cs, int pos, int fq, int lane, bf16_t* dst32  ) {
    const int i0 = 8 * (fq & 1);
    const f32x4 c0 = *(const f32x4*)(cs + pos * 16 + i0), c1 = *(const f32x4*)(cs + pos * 16 + i0 + 4);
    const f32x4 s0 = *(const f32x4*)(cs + 65536 + pos * 16 + i0), s1 = *(const f32x4*)(cs + 65536 + pos * 16 + i0 + 4);
    const float sg = (fq < 2) ? -1.0f : 1.0f;
    float o[8];
#pragma unroll
    for (int e = 0; e < 8; ++e) {
        const float own = v[e] * sc, oth = xhalf_other(own, lane);
        const float c = (e < 4) ? c0[e & 3] : c1[e & 3], s = (e < 4) ? s0[e & 3] : s1[e & 3];
        o[e] = own * c + sg * oth * s;
    }
    *(u32x4*)(dst32 + 8 * fq) = pack8(o, 1.0f);
}
#define EPI_LOAD8(v, ai, bj, m) float v[8]; { const f32x4 x0_ = acc[ai][bj][m][0], x1_ = acc[ai][bj][m][1]; v[0] = x0_[0]; v[1] = x0_[1]; v[2] = x0_[2]; v[3] = x0_[3]; v[4] = x1_[0]; v[5] = x1_[1]; v[6] = x1_[2]; v[7] = x1_[3]; }

struct EpiPlain8 {
    static constexpr bool PERM = true, AFTER_DRAIN = false;
    bf16_t* out; int ld;
    DI void operator()(EPI_ARGS) const {
#pragma unroll
        for (int ai = 0; ai < 2; ++ai)
#pragma unroll
            for (int m = 0; m < 4; ++m) {
                int fr_ = fr; asm volatile("" : "+v"(fr_));
                const size_t tok = (size_t)u.pm * 256 + ai * 128 + wr * 64 + m * 16 + fr_;
#pragma unroll
                for (int bj = 0; bj < 2; ++bj) { EPI_LOAD8(v, ai, bj, m); *(u32x4*)(out + tok * ld + u.pn * 256 + bj * 128 + wc * 32 + 8 * fq) = pack8(v, 1.0f); }
            }
    }
};

struct EpiProj8 {
    static constexpr bool PERM = true, AFTER_DRAIN = false;
    bf16_t* proj; bf16_t* kr; const float* cs; float* ssq;
    DI void operator()(EPI_ARGS) const {
        const int lane = fr + 16 * fq;
#pragma unroll
        for (int bj = 0; bj < 2; ++bj) {
            const int cg = u.pn * 256 + bj * 128 + wc * 32;
            if (cg >= INC) continue;
            const int g32 = cg >> 5;
            const float sc = (cg >= 672 && cg < 1184) ? 0.125f * LOG2E : 1.0f;
#pragma unroll
            for (int ai = 0; ai < 2; ++ai)
#pragma unroll
                for (int m = 0; m < 4; ++m) {
                    int fr_ = fr; asm volatile("" : "+v"(fr_));
                const size_t tok = (size_t)u.pm * 256 + ai * 128 + wr * 64 + m * 16 + fr_;
                    EPI_LOAD8(v, ai, bj, m);
                    if (g32 < 20) {
                        float ss = 0.f;
#pragma unroll
                        for (int e = 0; e < 8; ++e) ss += v[e] * v[e];
                        ss = xq_sum(ss);
                        if (fq == 0) ssq[tok * 24 + g32] = ss;
                    }
                    if (cg == 640) rope8(v, 1.0f, cs, (int)(tok & (SEQ_L - 1)), fq, lane, kr + tok * 32);
                    else *(u32x4*)(proj + tok * INC + cg + 8 * fq) = pack8(v, sc);
                }
        }
    }
};

struct EpiUpQ8 {
    static constexpr bool PERM = true, AFTER_DRAIN = false;
    bf16_t* q; const float* cs; const float* ssq;
    DI void operator()(EPI_ARGS) const {
        const int lane = fr + 16 * fq;
        const float qs = 0.10206207261596575f * LOG2E;
#pragma unroll
        for (int ai = 0; ai < 2; ++ai)
#pragma unroll
            for (int m = 0; m < 4; ++m) {
                int fr_ = fr; asm volatile("" : "+v"(fr_));
                const size_t tok = (size_t)u.pm * 256 + ai * 128 + wr * 64 + m * 16 + fr_;
                const f32x4 a0 = *(const f32x4*)(ssq + tok * 24), a1 = *(const f32x4*)(ssq + tok * 24 + 4), a2 = *(const f32x4*)(ssq + tok * 24 + 8);
                const float tot = (a0[0] + a0[1] + a0[2] + a0[3]) + (a1[0] + a1[1] + a1[2] + a1[3]) + (a2[0] + a2[1] + a2[2] + a2[3]);
                const float sc = rsqrtf(tot * (1.0f / 384.0f) + 1e-6f) * qs;
#pragma unroll
                for (int bj = 0; bj < 2; ++bj) {
                    const int cg = u.pn * 256 + bj * 128 + wc * 32;
                    EPI_LOAD8(v, ai, bj, m);
                    if ((cg % 96) == 64) rope8(v, sc, cs, (int)(tok & (SEQ_L - 1)), fq, lane, q + tok * 768 + cg);
                    else *(u32x4*)(q + tok * 768 + cg + 8 * fq) = pack8(v, sc);
                }
            }
    }
};

struct EpiUpKV8 {
    static constexpr bool PERM = true, AFTER_DRAIN = false;
    bf16_t* kv; const float* ssq;
    DI void operator()(EPI_ARGS) const {
#pragma unroll
        for (int ai = 0; ai < 2; ++ai)
#pragma unroll
            for (int m = 0; m < 4; ++m) {
                int fr_ = fr; asm volatile("" : "+v"(fr_));
                const size_t tok = (size_t)u.pm * 256 + ai * 128 + wr * 64 + m * 16 + fr_;
                const f32x4 a0 = *(const f32x4*)(ssq + tok * 24 + 12), a1 = *(const f32x4*)(ssq + tok * 24 + 16);
                const float tot = (a0[0] + a0[1] + a0[2] + a0[3]) + (a1[0] + a1[1] + a1[2] + a1[3]);
                const float sc = rsqrtf(tot * (1.0f / 256.0f) + 1e-6f);
#pragma unroll
                for (int bj = 0; bj < 2; ++bj) { EPI_LOAD8(v, ai, bj, m); *(u32x4*)(kv + tok * 1024 + u.pn * 256 + bj * 128 + wc * 32 + 8 * fq) = pack8(v, sc); }
            }
    }
};

template <bool RBF16>
struct EpiResid8 {
    static constexpr bool PERM = true, AFTER_DRAIN = false;
    const void* R; bf16_t* HB; float* SS;
    DI void operator()(EPI_ARGS) const {
#pragma unroll
        for (int ai = 0; ai < 2; ++ai) {
            f32x4 rv[4][2][2];
#pragma unroll
            for (int m = 0; m < 4; ++m)
#pragma unroll
                for (int bj = 0; bj < 2; ++bj) {
                    const size_t off = ((size_t)u.pm * 256 + ai * 128 + wr * 64 + m * 16 + fr) * 1024 + u.pn * 256 + bj * 128 + wc * 32 + 8 * fq;
                    if (RBF16) {
                        const u32x4 w = ldu4((const bf16_t*)R + off);
                        rv[m][bj][0] = (f32x4){bf_lo(w[0]), bf_hi(w[0]), bf_lo(w[1]), bf_hi(w[1])};
                        rv[m][bj][1] = (f32x4){bf_lo(w[2]), bf_hi(w[2]), bf_lo(w[3]), bf_hi(w[3])};
                    } else {
                        rv[m][bj][0] = *(const f32x4*)((const float*)R + off); rv[m][bj][1] = *(const f32x4*)((const float*)R + off + 4);
                    }
                }
#pragma unroll
            for (int m = 0; m < 4; ++m) {
                int fr_ = fr; asm volatile("" : "+v"(fr_));
                const size_t tok = (size_t)u.pm * 256 + ai * 128 + wr * 64 + m * 16 + fr_;
                float ss = 0.f;
#pragma unroll
                for (int bj = 0; bj < 2; ++bj) {
                    const size_t off = tok * 1024 + u.pn * 256 + bj * 128 + wc * 32 + 8 * fq;
                    const f32x4 h0 = rv[m][bj][0] + acc[ai][bj][m][0], h1 = rv[m][bj][1] + acc[ai][bj][m][1];
                    u32x4 o; o[0] = pack2(h0[0], h0[1]); o[1] = pack2(h0[2], h0[3]); o[2] = pack2(h1[0], h1[1]); o[3] = pack2(h1[2], h1[3]);
                    *(u32x4*)(HB + off) = o;
                    const float a0 = bf_lo(o[0]), a1 = bf_hi(o[0]), a2 = bf_lo(o[1]), a3 = bf_hi(o[1]), a4 = bf_lo(o[2]), a5 = bf_hi(o[2]), a6 = bf_lo(o[3]), a7 = bf_hi(o[3]);
                    ss += (a0 * a0 + a1 * a1) + (a2 * a2 + a3 * a3) + (a4 * a4 + a5 * a5) + (a6 * a6 + a7 * a7);
                }
                ss = xq_sum(ss);
                if (fq == 0) SS[tok * 16 + 4 * u.pn + wc] = ss;
            }
        }
    }
};

struct EpiRowScale8 {
    static constexpr bool PERM = true, AFTER_DRAIN = false;
    bf16_t* out; int ld; const float* SS; float extra;
    DI void operator()(EPI_ARGS) const {
#pragma unroll
        for (int ai = 0; ai < 2; ++ai)
#pragma unroll
            for (int m = 0; m < 4; ++m) {
                int fr_ = fr; asm volatile("" : "+v"(fr_));
                const size_t tok = (size_t)u.pm * 256 + ai * 128 + wr * 64 + m * 16 + fr_;
                const f32x4 s0 = *(const f32x4*)(SS + tok * 16), s1 = *(const f32x4*)(SS + tok * 16 + 4), s2 = *(const f32x4*)(SS + tok * 16 + 8), s3 = *(const f32x4*)(SS + tok * 16 + 12);
                const float tot = (s0[0] + s0[1] + s0[2] + s0[3]) + (s1[0] + s1[1] + s1[2] + s1[3]) + (s2[0] + s2[1] + s2[2] + s2[3]) + (s3[0] + s3[1] + s3[2] + s3[3]);
                const float sc = rsqrtf(tot * (1.0f / 1024.0f) + 1e-6f) * extra;
#pragma unroll
                for (int bj = 0; bj < 2; ++bj) { EPI_LOAD8(v, ai, bj, m); *(u32x4*)(out + tok * ld + u.pn * 256 + bj * 128 + wc * 32 + 8 * fq) = pack8(v, sc); }
            }
    }
};

template <class Epi>
DI void gemm8(char* smem, const bf16_t* A, int lda, const bf16_t* Bt, int M, int N, int K, const Epi& e, int cshift = 0) {
    pg8::Gemm g; g.A = A; g.Bt = Bt; g.M = M; g.N = N; g.K = K; g.lda = lda;
    const int G = (int)gridDim.x;
    pg8::StaticOrder S; S.init(M, N, G, ((int)blockIdx.x + G - cshift) % G);
    pg8::gemm_phase<Epi, pg8::StaticOrder, true, true>((PG8_LAS unsigned char*)smem, g, S, e);
}

DI void quant_rows4(const Params& p, int it, int wv, int lane);
DI void phase_p1(const Params& p, char* smem) {
    char* ws = p.ws;
    const int G = (int)gridDim.x, nproj = 9 * 64, nkvm = 8 * 4;
    const int last = nproj % G;
    { EpiProj8 e{(bf16_t*)(ws + OFF_PROJ), (bf16_t*)(ws + OFF_KR), (const float*)(ws + OFF_ROPE), (float*)(ws + OFF_SSQ)};
      gemm8(smem, (const bf16_t*)(ws + OFF_XN), 1024, (const bf16_t*)(ws + OFF_WT_IN), T_TOK, 2304, 1024, e); }
    { EpiPlain8 e{(bf16_t*)(ws + OFF_KVM), 2048};
      gemm8(smem, (const bf16_t*)(ws + OFF_MEMN), 1024, (const bf16_t*)(ws + OFF_WT_MKV), 1024, 2048, 1024, e, last); }
    int q0 = last + nkvm, nq = G - q0;
    if (last == 0 || nq <= 0) { q0 = 0; nq = G; }
    if ((int)blockIdx.x >= q0) {
        const int t = otid(), lane = t & 63, wv = t >> 6;
        for (int it = ((int)blockIdx.x - q0) * 2 + vhalf(); it < 8192; it += 2 * nq) quant_rows4(p, it, wv, lane);
    }
}
DI void phase_p2(const Params& p, char* smem) {
    char* ws = p.ws;
    { EpiUpQ8 e{(bf16_t*)(ws + OFF_QMLA), (const float*)(ws + OFF_ROPE), (const float*)(ws + OFF_SSQ)};
      gemm8(smem, (const bf16_t*)(ws + OFF_PROJ), INC, (const bf16_t*)(ws + OFF_WT_UQ), T_TOK, 768, 384, e); }
    { EpiUpKV8 e{(bf16_t*)(ws + OFF_KVMLA), (const float*)(ws + OFF_SSQ)};
      gemm8(smem, (const bf16_t*)(ws + OFF_PROJ) + 384, INC, (const bf16_t*)(ws + OFF_WT_UKV), T_TOK, 1024, 256, e); }
}
template <bool RBF16>
DI void phase_resid(const Params& p, char* smem, size_t off_w, size_t off_a, const void* R, size_t off_ss, bool dry = false) {
    char* ws = p.ws;
    EpiResid8<RBF16> e{R, (bf16_t*)(ws + OFF_HB), (float*)(ws + off_ss)};
    if (dry) { e.HB = (bf16_t*)(ws + OFF_B); e.SS = (float*)(ws + OFF_SS1); }
    gemm8(smem, (const bf16_t*)(ws + off_a), 1024, (const bf16_t*)(ws + off_w), T_TOK, 1024, 1024, e);
}
DI void phase_rowscale(const Params& p, char* smem, size_t off_w, int N, bf16_t* outp, size_t off_ss, float extra) {
    char* ws = p.ws;
    EpiRowScale8 e{outp, N, (const float*)(ws + off_ss), extra};
    gemm8(smem, (const bf16_t*)(ws + OFF_HB), 1024, (const bf16_t*)(ws + off_w), T_TOK, N, 1024, e);
}
DI unsigned v128_off(int row, int chunk) { return (unsigned)(row * 128 + ((chunk ^ (((row >> 1) & 1) << 2)) << 4)); }
DI unsigned v128_tr_addr(unsigned base, int R0, int c, int lane) {
    const int blk = (lane >> 4) & 1, qq = (lane & 15) >> 2, pp = lane & 3;
    return base + v128_off(R0 + qq, 4 * c + 2 * blk + (pp >> 1)) + 8 * (pp & 1);
}
DI bf16x8 cat44(s16x4 lo, s16x4 hi) { return __builtin_shufflevector(lo, hi, 0, 1, 2, 3, 4, 5, 6, 7); }

constexpr int MLA_STAGE = 64 * 192 + 64 * 128;
DI unsigned k192_off(int row, int chunk) { return (unsigned)(row * 192 + (((chunk & ~3) | ((chunk & 3) ^ ((row >> 2) & 3))) << 4)); }
DI void mla_unit(const Params& p, char* lds, int b, int h, int qt) {
    char* ws = p.ws;
    const int t = otid(), lane = t & 63, wv = t >> 6, r = lane & 31, hh = lane >> 5;
    const bf16_t* Q = (const bf16_t*)(ws + OFF_QMLA);
    const bf16_t* KV = (const bf16_t*)(ws + OFF_KVMLA);
    const bf16_t* KR = (const bf16_t*)(ws + OFF_KR);
    const int q0 = qt * 128 + 32 * wv;
    const size_t tokq = (size_t)b * SEQ_L + q0 + r;
    const size_t tokb = (size_t)b * SEQ_L;
    bf16x8 qf[6];
#pragma unroll
    for (int s = 0; s < 6; ++s) qf[s] = ld16(Q + tokq * 768 + h * 96 + 16 * s + 8 * hh);
    f32x16 o[2]; o[0] = zero16(); o[1] = zero16();
    float m = -INFINITY, l = 0.f;
    const bf16_t* ksrc[3]; int kadv[3]; const bf16_t* vsrc[2];
#pragma unroll
    for (int i = 0; i < 3; ++i) {
        const int o_ = 1024 * (wv + 4 * i) + 16 * lane, row = o_ / 192, pch = (o_ % 192) >> 4;
        const int c = (pch & ~3) | ((pch & 3) ^ ((row >> 2) & 3));
        if (c < 8) { ksrc[i] = KV + (tokb + row) * 1024 + h * 128 + 8 * c; kadv[i] = 64 * 1024; }
        else       { ksrc[i] = KR + (tokb + row) * 32 + 8 * (c - 8);       kadv[i] = 64 * 32; }
    }
#pragma unroll
    for (int i = 0; i < 2; ++i) {
        const int row = 8 * (wv + 4 * i) + (lane >> 3), pch = lane & 7;
        vsrc[i] = KV + (tokb + row) * 1024 + h * 128 + 64 + 8 * (pch ^ (((row >> 1) & 1) << 2));
    }
    char* ldst = lds + wv * 1024 + lane * 16;
    auto issue = [&](int kt) {
        char* d = ldst + (kt % 3) * MLA_STAGE;
#pragma unroll
        for (int i = 0; i < 3; ++i) GLDS16(ksrc[i] + (size_t)kt * kadv[i], d + i * 4096);
#pragma unroll
        for (int i = 0; i < 2; ++i) GLDS16(vsrc[i] + (size_t)kt * (64 * 1024), d + 12288 + i * 4096);
    };
    const int ntiles = 2 * qt + 2;
    const unsigned vlane0 = v128_tr_addr(0u, 4 * hh, 0, lane), vlane1 = v128_tr_addr(0u, 4 * hh, 1, lane);
    __syncthreads();
    issue(0); issue(1);
#pragma unroll
    for (int s = 0; s < 6; ++s) asm volatile("" :: "v"(qf[s]));
#pragma unroll 1
    for (int kt = 0; kt < ntiles; ++kt) {
        if (kt + 1 < ntiles) asm volatile("s_waitcnt vmcnt(5)\n\ts_barrier" ::: "memory");
        else asm volatile("s_waitcnt vmcnt(0)\n\ts_barrier" ::: "memory");
        if (kt + 2 < ntiles) issue(kt + 2);
        const char* sb = lds + (kt % 3) * MLA_STAGE;
        const unsigned vb = (unsigned)(uintptr_t)(sb + 12288);
        f32x16 s[2];
#pragma unroll
        for (int k2 = 0; k2 < 2; ++k2) {
            s[k2] = zero16();
#pragma unroll
            for (int ss = 0; ss < 6; ++ss) s[k2] = MFMA32(ld16(sb + k192_off(32 * k2 + r, 2 * ss + hh)), qf[ss], s[k2]);
        }
        s16x4 vt[2][2][2][2];
        {
            const unsigned a0 = vb + vlane0, a1 = vb + vlane1;
#define MLA_TR(K2, ST) vt[K2][ST][0][0] = tr_read_ao<(32 * K2 + 16 * ST) * 128>(a0); vt[K2][ST][0][1] = tr_read_ao<(32 * K2 + 16 * ST + 8) * 128>(a0); \
                       vt[K2][ST][1][0] = tr_read_ao<(32 * K2 + 16 * ST) * 128>(a1); vt[K2][ST][1][1] = tr_read_ao<(32 * K2 + 16 * ST + 8) * 128>(a1);
            MLA_TR(0, 0) MLA_TR(0, 1) MLA_TR(1, 0) MLA_TR(1, 1)
#undef MLA_TR
        }
        if (__builtin_amdgcn_readfirstlane(kt >= 2 * qt)) {
            asm volatile("");
            const int qpos = q0 + r;
#pragma unroll
            for (int k2 = 0; k2 < 2; ++k2)
#pragma unroll
                for (int i = 0; i < 16; ++i) { const int kpos = 64 * kt + 32 * k2 + crow(i, hh); if (kpos > qpos) s[k2][i] = -INFINITY; }
        }
        float mx = s[0][0];
#pragma unroll
        for (int k2 = 0; k2 < 2; ++k2)
#pragma unroll
            for (int i = 0; i < 16; ++i) mx = fmaxf(mx, s[k2][i]);
        mx = xhalf_max(mx);
        if (__any(mx > m + 8.0f)) {
            asm volatile("");
            const float mn = fmaxf(m, mx);
            const float alpha = fast_exp2(m - mn);
            l *= alpha;
            m = mn;
#pragma unroll
            for (int c = 0; c < 2; ++c)
#pragma unroll
                for (int i = 0; i < 16; ++i) o[c][i] *= alpha;
        }
        f32x2 ps2 = {0.f, 0.f};
        const f32x2 m2 = {m, m};
#pragma unroll
        for (int k2 = 0; k2 < 2; ++k2)
#pragma unroll
            for (int i = 0; i < 16; i += 2) {
                f32x2 x = {s[k2][i], s[k2][i + 1]};
                x = x - m2;
                f32x2 e; e[0] = fast_exp2(x[0]); e[1] = fast_exp2(x[1]);
                s[k2][i] = e[0]; s[k2][i + 1] = e[1];
                ps2 += e;
            }
        l += ps2[0] + ps2[1];
        TR_WAIT();
#pragma unroll
        for (int k2 = 0; k2 < 2; ++k2)
#pragma unroll
            for (int st = 0; st < 2; ++st) {
                const bf16x8 pb = pack_step(s[k2], st);
#pragma unroll
                for (int c = 0; c < 2; ++c) o[c] = MFMA32(cat44(vt[k2][st][c][0], vt[k2][st][c][1]), pb, o[c]);
            }
    }
    const float inv = 1.0f / xhalf_sum(l);
    bf16_t* dst = (bf16_t*)((char*)p.out + OUT_OMLA) + tokq * 512 + h * 64 + 4 * hh;
#pragma unroll
    for (int c = 0; c < 2; ++c)
#pragma unroll
        for (int g = 0; g < 4; ++g)
            *(u32x2*)(dst + 32 * c + 8 * g) = pack4(o[c][4 * g] * inv, o[c][4 * g + 1] * inv, o[c][4 * g + 2] * inv, o[c][4 * g + 3] * inv);
}

DI void dil_unit(const Params& p, char* lds, int g, int b, int h, int rr, int lb) {
    char* ws = p.ws;
    const int t = otid(), lane = t & 63, wv = t >> 6, r = lane & 31, hh = lane >> 5;
    const int d = (g == 0) ? 1 : (g == 1 ? 4 : 16);
    const bf16_t* PJ = (const bf16_t*)(ws + OFF_PROJ);
    const size_t tokb = (size_t)b * SEQ_L;
    char* kimg = lds;
    char* vimg = lds + 32768;
    __syncthreads();
    {
        const int c = t & 7;
#pragma unroll
        for (int half = 0; half < 2; ++half) {
            u32x4 kk[4], vv[4];
#pragma unroll
            for (int i = 0; i < 4; ++i) {
                const int key = (t >> 3) + 32 * (4 * half + i);
                const int lk = 128 * lb - 128 + key;
                if (lk >= 0) {
                    const size_t tk = tokb + (size_t)lk * d + rr;
                    kk[i] = ldu4(PJ + tk * INC + 1184 + h * 64 + 8 * c);
                    vv[i] = ldu4(PJ + tk * INC + 1696 + h * 64 + 8 * c);
                } else { kk[i] = (u32x4){0u, 0u, 0u, 0u}; vv[i] = (u32x4){0u, 0u, 0u, 0u}; }
            }
#pragma unroll
            for (int i = 0; i < 4; ++i) {
                const int key = (t >> 3) + 32 * (4 * half + i);
                *(u32x4*)(kimg + sw_off(key, c)) = kk[i];
                *(u32x4*)(vimg + v128_off(key, c)) = vv[i];
            }
        }
    }
    const int lq = 128 * lb + 32 * wv + r;
    const size_t tokq = tokb + (size_t)lq * d + rr;
    bf16x8 qf[4];
#pragma unroll
    for (int s = 0; s < 4; ++s) qf[s] = ld16(PJ + tokq * INC + 672 + h * 64 + 16 * s + 8 * hh);
    __syncthreads();
    const float slope2 = exp2f(-(float)(h + 1)) * (float)d * LOG2E;
    const int u0 = (lb == 0) ? (4 - wv) : 0;
    f32x16 o[2]; o[0] = zero16(); o[1] = zero16();
    float m = -INFINITY, lsum = 0.f;
    const unsigned vb = (unsigned)(uintptr_t)vimg;
    float cb[16];
#pragma unroll
    for (int i = 0; i < 16; ++i) cb[i] = slope2 * (float)crow(i, hh);
#pragma unroll 1
    for (int u = u0; u < 5; ++u) {
        const int rowb = 32 * (wv + u);
        f32x16 s = zero16();
#pragma unroll
        for (int ss = 0; ss < 4; ++ss) s = MFMA32(ld16(kimg + sw_off(rowb + r, 2 * ss + hh)), qf[ss], s);
        const int dbase = r + 128 - 32 * u;
        const float b0 = -slope2 * (float)dbase;
#pragma unroll
        for (int i = 0; i < 16; ++i) s[i] += cb[i];
        if (__builtin_amdgcn_readfirstlane(u == 0 || u == 4)) {
            asm volatile("");
#pragma unroll
            for (int i = 0; i < 16; ++i) { const int dist = dbase - crow(i, hh); if (dist < 0 || dist > 128) s[i] = -INFINITY; }
        }
        float mx = s[0];
#pragma unroll
        for (int i = 1; i < 16; ++i) mx = fmaxf(mx, s[i]);
        mx = xhalf_max(mx) + b0;
        if (__any(mx > m + 8.0f)) {
            asm volatile("");
            const float mn = fmaxf(m, mx);
            const float alpha = fast_exp2(m - mn);
            lsum *= alpha;
            m = mn;
#pragma unroll
            for (int c = 0; c < 2; ++c)
#pragma unroll
                for (int i = 0; i < 16; ++i) o[c][i] *= alpha;
        }
        f32x2 ps2 = {0.f, 0.f};
        const float mb = m - b0;
        const f32x2 m2 = {mb, mb};
#pragma unroll
        for (int i = 0; i < 16; i += 2) {
            f32x2 xx = {s[i], s[i + 1]};
            xx = xx - m2;
            f32x2 e; e[0] = fast_exp2(xx[0]); e[1] = fast_exp2(xx[1]);
            s[i] = e[0]; s[i + 1] = e[1];
            ps2 += e;
        }
        lsum += ps2[0] + ps2[1];
#pragma unroll
        for (int st = 0; st < 2; ++st) {
            const bf16x8 pb = pack_step(s, st);
#pragma unroll
            for (int c = 0; c < 2; ++c) {
                const s16x4 lo = tr_read(v128_tr_addr(vb, rowb + 16 * st + 4 * hh, c, lane));
                const s16x4 hi = tr_read(v128_tr_addr(vb, rowb + 16 * st + 8 + 4 * hh, c, lane));
                o[c] = MFMA32(cat44(lo, hi), pb, o[c]);
            }
        }
    }
    const float ltot = xhalf_sum(lsum);
    const float mx = m;
    const float inv = 1.0f / ltot;
    bf16_t* dst = (bf16_t*)((char*)p.out + OUT_ODIL) + ((size_t)g * T_TOK + tokq) * 512 + h * 64 + 4 * hh;
#pragma unroll
    for (int c = 0; c < 2; ++c)
#pragma unroll
        for (int gg = 0; gg < 4; ++gg)
            *(u32x2*)(dst + 32 * c + 8 * gg) = pack4(o[c][4 * gg] * inv, o[c][4 * gg + 1] * inv, o[c][4 * gg + 2] * inv, o[c][4 * gg + 3] * inv);
    if (hh == 0) ((float*)(ws + OFF_LSE))[((size_t)g * T_TOK + tokq) * 8 + h] = mx + __log2f(ltot);
}

DI void phase_p3(const Params& p, char* lds, int which = 3) {
    const int xg = (int)blockIdx.x & 7, nloc = (vgrid() >> 3), loc = ((int)blockIdx.x >> 3) * 2 + vhalf();
    if (which & 1) for (int i = loc; i < 64; i += nloc) {
        const int bh = xg * 4 + (i >> 4), pr = i & 15, b = bh >> 3, h = bh & 7;
#pragma unroll 1
        for (int rep = 0; rep < 2; ++rep) mla_unit(p, lds, b, h, rep ? pr : 31 - pr);
    }
    if (which & 2) for (int i = loc; i < 384; i += nloc) {
        const int bh = xg * 4 + i / 96, k96 = i % 96, g = k96 >> 5, k = k96 & 31, b = bh >> 3, h = bh & 7;
        int rr, lb;
        if (g == 0) { rr = 0; lb = k; } else if (g == 1) { rr = k >> 3; lb = k & 7; } else { rr = k >> 1; lb = k & 1; }
        dil_unit(p, lds, g, b, h, rr, lb);
    }
}

DI void quant_rows4(const Params& p, int it, int wv, int lane) {
    char* ws = p.ws;
    const int ncv = 4096;
    const bool isv = it >= ncv;
    const size_t row = (size_t)(isv ? it - ncv : it) * 4 + wv;
    const float* src = (isv ? p.peer_v : p.peer_u) + row * 1024 + 16 * lane;
    f32x4 v[4]; float am = 0.f;
#pragma unroll
    for (int i = 0; i < 4; ++i) { v[i] = *(const f32x4*)(src + 4 * i); am = fmaxf(am, fmaxf(fmaxf(fabsf(v[i][0]), fabsf(v[i][1])), fmaxf(fabsf(v[i][2]), fabsf(v[i][3])))); }
#pragma unroll
    for (int o = 32; o; o >>= 1) am = fmaxf(am, __shfl_xor(am, o));
    const float sc = (am > 0.f) ? am * (isv ? (1.0f / 384.0f) : (1.0f / 127.0f)) : 1.0f;
    const float inv = 1.0f / sc;
    u32x4 o;
#pragma unroll
    for (int i = 0; i < 4; ++i) {
        if (isv) {
            int w = 0;
            w = __builtin_amdgcn_cvt_pk_fp8_f32(v[i][0] * inv, v[i][1] * inv, w, false);
            w = __builtin_amdgcn_cvt_pk_fp8_f32(v[i][2] * inv, v[i][3] * inv, w, true);
            o[i] = (unsigned)w;
        } else {
            unsigned w = 0u;
#pragma unroll
            for (int e = 0; e < 4; ++e) { const int q = (int)rintf(v[i][e] * inv); w |= ((unsigned)q & 0xFFu) << (8 * e); }
            o[i] = w;
        }
    }
    *(u32x4*)(ws + OFF_UQ + row * 2048 + (isv ? 1024 : 0) + 16 * lane) = o;
    if (lane == 0) ((float*)(ws + (isv ? OFF_SV : OFF_SU)))[row] = sc;
}

DI void phase_p35(const Params& p, char* lds) {
    char* ws = p.ws;
    const int t = otid(), lane = t & 63, wv = t >> 6;
    const int ntok = T_TOK / 4;
    for (int item = vbid(); item < ntok; item += vgrid()) {
        {
            const size_t tok = (size_t)item * 4 + wv;
            const int head = lane >> 3;
            const float* LS = (const float*)(ws + OFF_LSE);
            const float l0 = LS[tok * 8 + head], l1 = LS[((size_t)T_TOK + tok) * 8 + head], l2 = LS[((size_t)2 * T_TOK + tok) * 8 + head];
            const float mx = fmaxf(l0, fmaxf(l1, l2));
            float w0 = fast_exp2(l0 - mx), w1 = fast_exp2(l1 - mx), w2 = fast_exp2(l2 - mx);
            const float wi = 1.0f / (w0 + w1 + w2);
            w0 *= wi; w1 *= wi; w2 *= wi;
            const bf16_t* OD = (const bf16_t*)((const char*)p.out + OUT_ODIL);
            const u32x4 a0 = ldu4(OD + tok * 512 + 8 * lane), a1 = ldu4(OD + ((size_t)T_TOK + tok) * 512 + 8 * lane),
                        a2 = ldu4(OD + ((size_t)2 * T_TOK + tok) * 512 + 8 * lane);
            const u32x4 am = ldu4((const bf16_t*)((const char*)p.out + OUT_OMLA) + tok * 512 + 8 * lane);
            float od[8], om[8]; float sd = 0.f, sm = 0.f;
#pragma unroll
            for (int e = 0; e < 4; ++e) {
                od[2 * e] = w0 * bf_lo(a0[e]) + w1 * bf_lo(a1[e]) + w2 * bf_lo(a2[e]);
                od[2 * e + 1] = w0 * bf_hi(a0[e]) + w1 * bf_hi(a1[e]) + w2 * bf_hi(a2[e]);
                om[2 * e] = bf_lo(am[e]); om[2 * e + 1] = bf_hi(am[e]);
                sd += od[2 * e] * od[2 * e] + od[2 * e + 1] * od[2 * e + 1];
                sm += om[2 * e] * om[2 * e] + om[2 * e + 1] * om[2 * e + 1];
            }
#pragma unroll
            for (int o = 32; o; o >>= 1) { sd += __shfl_xor(sd, o); sm += __shfl_xor(sm, o); }
            const float rd = rsqrtf(sd * (1.0f / 512.0f) + 1e-6f), rm = rsqrtf(sm * (1.0f / 512.0f) + 1e-6f);
            const f32x4 gm0 = *(const f32x4*)(p.gn_mla + 8 * lane), gm1 = *(const f32x4*)(p.gn_mla + 8 * lane + 4);
            const f32x4 gd0 = *(const f32x4*)(p.gn_dil + 8 * lane), gd1 = *(const f32x4*)(p.gn_dil + 8 * lane + 4);
            u32x4 o1, o2;
            o1[0] = pack2(om[0] * rm * gm0[0], om[1] * rm * gm0[1]); o1[1] = pack2(om[2] * rm * gm0[2], om[3] * rm * gm0[3]);
            o1[2] = pack2(om[4] * rm * gm1[0], om[5] * rm * gm1[1]); o1[3] = pack2(om[6] * rm * gm1[2], om[7] * rm * gm1[3]);
            o2[0] = pack2(od[0] * rd * gd0[0], od[1] * rd * gd0[1]); o2[1] = pack2(od[2] * rd * gd0[2], od[3] * rd * gd0[3]);
            o2[2] = pack2(od[4] * rd * gd1[0], od[5] * rd * gd1[1]); o2[3] = pack2(od[6] * rd * gd1[2], od[7] * rd * gd1[3]);
            bf16_t* MX = (bf16_t*)(ws + OFF_MIXED) + tok * 1024;
            *(u32x4*)(MX + 8 * lane) = o1;
            *(u32x4*)(MX + 512 + 8 * lane) = o2;
        }
    }
}

DI void memattn_unit(const Params& p, char* lds, int b, int h, int tt) {
    char* ws = p.ws;
    const int t = otid(), lane = t & 63, wv = t >> 6, r = lane & 31, hh = lane >> 5;
    const bf16_t* QM = (const bf16_t*)(ws + OFF_QM);
    const bf16_t* KVM = (const bf16_t*)(ws + OFF_KVM);
    const size_t tokq = (size_t)b * SEQ_L + tt * 128 + 32 * wv + r;
    const bf16_t* qrow = QM + tokq * 1024 + h * 256 + 8 * hh;
    const bf16_t* ksrc0; const bf16_t* vsrc0;
    {
        const int row = 8 * wv + (lane >> 3), pch = lane & 7;
        const size_t mrow = (size_t)b * 256 + row;
        ksrc0 = KVM + mrow * 2048 + h * 256 + 8 * (pch ^ ((row >> 1) & 7));
        vsrc0 = KVM + mrow * 2048 + 1024 + h * 256 + 8 * (pch ^ (((row >> 1) & 1) << 2));
    }
    char* ldst = lds + wv * 1024 + lane * 16;
#define MA_ISSUE(st_) do { char* d_ = ldst + ((st_) & 1) * 32768; \
        _Pragma("unroll") for (int i = 0; i < 8; ++i) GLDS16(((st_) < 4 ? ksrc0 : vsrc0) + (size_t)i * (32 * 2048) + 64 * ((st_) & 3), d_ + i * 4096); } while (0)
    f32x16 S[8];
#pragma unroll
    for (int kt = 0; kt < 8; ++kt) S[kt] = zero16();
    bf16x8 qa[4];
    __syncthreads();
    MA_ISSUE(0); MA_ISSUE(1);
#define MA_KSTAGE(c_, WAIT_) do { \
        asm volatile("s_waitcnt vmcnt(" #WAIT_ ")\n\ts_barrier" ::: "memory"); \
        _Pragma("unroll") for (int ss = 0; ss < 4; ++ss) qa[ss] = ld16(qrow + 64 * (c_) + 16 * ss); \
        { const char* sb_ = lds + ((c_) & 1) * 32768; \
          _Pragma("unroll") for (int kt = 0; kt < 8; ++kt) \
          _Pragma("unroll") for (int ss = 0; ss < 4; ++ss) S[kt] = MFMA32(ld16(sb_ + sw_off(32 * kt + r, 2 * ss + hh)), qa[ss], S[kt]); } \
        asm volatile("s_barrier" ::: "memory"); \
        MA_ISSUE((c_) + 2); } while (0)
    MA_KSTAGE(0, 8);
    MA_KSTAGE(1, 8);
    MA_KSTAGE(2, 8);
    MA_KSTAGE(3, 8);
    float mx = S[0][0];
#pragma unroll
    for (int kt = 0; kt < 8; ++kt)
#pragma unroll
        for (int i = 0; i < 16; ++i) mx = fmaxf(mx, S[kt][i]);
    mx = xhalf_max(mx);
    f32x2 ps2 = {0.f, 0.f};
    const f32x2 m2 = {mx, mx};
    bf16x8 pk[8][2];
#pragma unroll
    for (int kt = 0; kt < 8; ++kt) {
#pragma unroll
        for (int i = 0; i < 16; i += 2) {
            f32x2 xx = {S[kt][i], S[kt][i + 1]};
            xx = xx - m2;
            f32x2 e; e[0] = fast_exp2(xx[0]); e[1] = fast_exp2(xx[1]);
            S[kt][i] = e[0]; S[kt][i + 1] = e[1];
            ps2 += e;
        }
        pk[kt][0] = pack_step(S[kt], 0); pk[kt][1] = pack_step(S[kt], 1);
    }
    const float inv = 1.0f / xhalf_sum(ps2[0] + ps2[1]);
    bf16_t* dst = (bf16_t*)(ws + OFF_OM) + tokq * 1024 + h * 256 + 4 * hh;
    const unsigned vlane0 = v128_tr_addr(0u, 4 * hh, 0, lane), vlane1 = v128_tr_addr(0u, 4 * hh, 1, lane);
#define MA_PV(KT_, vb_) do { s16x4 vt_[2][2][2]; \
            vt_[0][0][0] = tr_read_ao<(32 * KT_) * 128>(vb_ + vlane0);          vt_[0][0][1] = tr_read_ao<(32 * KT_ + 8) * 128>(vb_ + vlane0); \
            vt_[0][1][0] = tr_read_ao<(32 * KT_) * 128>(vb_ + vlane1);          vt_[0][1][1] = tr_read_ao<(32 * KT_ + 8) * 128>(vb_ + vlane1); \
            vt_[1][0][0] = tr_read_ao<(32 * KT_ + 16) * 128>(vb_ + vlane0);     vt_[1][0][1] = tr_read_ao<(32 * KT_ + 24) * 128>(vb_ + vlane0); \
            vt_[1][1][0] = tr_read_ao<(32 * KT_ + 16) * 128>(vb_ + vlane1);     vt_[1][1][1] = tr_read_ao<(32 * KT_ + 24) * 128>(vb_ + vlane1); \
            TR_WAIT(); \
            _Pragma("unroll") for (int st = 0; st < 2; ++st) { \
                o0_ = MFMA32(cat44(vt_[st][0][0], vt_[st][0][1]), pk[KT_][st], o0_); \
                o1_ = MFMA32(cat44(vt_[st][1][0], vt_[st][1][1]), pk[KT_][st], o1_); } } while (0)
#define MA_VSTAGE(c_, WAIT_) do { \
        asm volatile("s_waitcnt vmcnt(" #WAIT_ ")\n\ts_barrier" ::: "memory"); \
        { const unsigned vb_ = (unsigned)(uintptr_t)(lds + ((c_) & 1) * 32768); \
          f32x16 o0_ = zero16(), o1_ = zero16(); \
          MA_PV(0, vb_); MA_PV(1, vb_); MA_PV(2, vb_); MA_PV(3, vb_); MA_PV(4, vb_); MA_PV(5, vb_); MA_PV(6, vb_); MA_PV(7, vb_); \
          _Pragma("unroll") for (int g = 0; g < 4; ++g) { \
              *(u32x2*)(dst + 64 * (c_) + 8 * g) = pack4(o0_[4 * g] * inv, o0_[4 * g + 1] * inv, o0_[4 * g + 2] * inv, o0_[4 * g + 3] * inv); \
              *(u32x2*)(dst + 64 * (c_) + 32 + 8 * g) = pack4(o1_[4 * g] * inv, o1_[4 * g + 1] * inv, o1_[4 * g + 2] * inv, o1_[4 * g + 3] * inv); } } \
        asm volatile("s_barrier" ::: "memory"); \
        if ((c_) + 2 < 4) MA_ISSUE(4 + (c_) + 2); } while (0)
    MA_VSTAGE(0, 8);
    MA_VSTAGE(1, 8);
    MA_VSTAGE(2, 8);
    MA_VSTAGE(3, 0);
#undef MA_ISSUE
#undef MA_KSTAGE
#undef MA_VSTAGE
#undef MA_PV
}

DI void phase_memattn(const Params& p, char* lds) {
    for (int item = vbid(); item < 512; item += vgrid()) {
        const int b = item >> 7, h = (item >> 5) & 3, tt = item & 31;
        memattn_unit(p, lds, b, h, tt);
    }
}
DI unsigned f2sort(float f) { const unsigned b = __float_as_uint(f); return b ^ ((b & 0x80000000u) ? 0xFFFFFFFFu : 0x80000000u); }
DI float sort2f(unsigned u) { const unsigned b = (u & 0x80000000u) ? (u ^ 0x80000000u) : ~u; return __uint_as_float(b); }
DI void cswap(unsigned& a, unsigned& b) { const unsigned hi = max(a, b), lo = min(a, b); a = hi; b = lo; }

template <int LO, int N> struct BClean {
    template <int M> static DI void run(unsigned (&a)[M]) {
#pragma unroll
        for (int i = 0; i < N / 2; ++i) cswap(a[LO + i], a[LO + i + N / 2]);
        BClean<LO, N / 2>::run(a); BClean<LO + N / 2, N / 2>::run(a);
    }
};
template <int LO> struct BClean<LO, 1> { template <int M> static DI void run(unsigned (&)[M]) {} };
template <int LO, int N> struct BSort {
    template <int M> static DI void run(unsigned (&a)[M]) {
        BSort<LO, N / 2>::run(a); BSort<LO + N / 2, N / 2>::run(a);
#pragma unroll
        for (int i = 0; i < N / 2; ++i) cswap(a[LO + i], a[LO + N - 1 - i]);
        BClean<LO, N / 2>::run(a); BClean<LO + N / 2, N / 2>::run(a);
    }
};
template <int LO> struct BSort<LO, 1> { template <int M> static DI void run(unsigned (&)[M]) {} };
DI void merge_top16(unsigned (&a)[16], const unsigned (&b)[16]) {
#pragma unroll
    for (int i = 0; i < 16; ++i) a[i] = max(a[i], b[15 - i]);
    BClean<0, 16>::run(a);
}

DI void peer_top16(const bf16_t* __restrict__ keys_hp, const bf16_t* __restrict__ pq_row_hp, int r, int hh, unsigned (&top)[16]) {
    bf16x8 qf[8];
#pragma unroll
    for (int s = 0; s < 8; ++s) qf[s] = ld16(pq_row_hp + 16 * s + 8 * hh);
    unsigned cur[16];
#pragma unroll
    for (int kt = 0; kt < 4; ++kt) {
        f32x16 acc = zero16();
#pragma unroll
        for (int s = 0; s < 8; ++s) acc = MFMA32(ld16(keys_hp + (size_t)(32 * kt + r) * 128 + 16 * s + 8 * hh), qf[s], acc);
        unsigned k[16];
#pragma unroll
        for (int i = 0; i < 16; ++i) k[i] = (f2sort(acc[i]) & ~0x7Fu) | (unsigned)(32 * kt + crow(i, hh));
        BSort<0, 16>::run(k);
        if (kt == 0) {
#pragma unroll
            for (int i = 0; i < 16; ++i) cur[i] = k[i];
        } else merge_top16(cur, k);
    }
    unsigned r0[16], r1[16];
#pragma unroll
    for (int i = 0; i < 16; ++i) { auto rr = __builtin_amdgcn_permlane32_swap(cur[i], cur[i], false, false); r0[i] = rr[0]; r1[i] = rr[1]; }
#pragma unroll
    for (int i = 0; i < 16; ++i) top[i] = max(r0[i], r1[15 - i]);
    BClean<0, 16>::run(top);
}

DI void peer_select_unit(const Params& p, char* lds, int mt, int h) {
    char* ws = p.ws;
    const int t = otid(), lane = t & 63, wv = t >> 6, r = lane & 31, hh = lane >> 5;
    const size_t tok = (size_t)mt * 128 + 32 * wv + r;
    const bf16_t* KEYS = (const bf16_t*)(ws + OFF_KEYS);
    const bf16_t* PQ = (const bf16_t*)((const char*)p.out + OUT_PQ);
    unsigned tA[16], tB[16];
    peer_top16(KEYS + (size_t)(2 * h) * 16384, PQ + tok * 2048 + (2 * h) * 128, r, hh, tA);
    peer_top16(KEYS + (size_t)(2 * h + 1) * 16384, PQ + tok * 2048 + (2 * h + 1) * 128, r, hh, tB);
    float fA[16], fB[16];
#pragma unroll
    for (int i = 0; i < 16; ++i) { fA[i] = sort2f(tA[i] & ~0x7Fu); fB[i] = sort2f(tB[i] & ~0x7Fu); }
    unsigned* tab = (unsigned*)lds + wv * 1024;
    __syncthreads();
#pragma unroll
    for (int i = 0; i < 16; ++i) tab[i * 64 + lane] = (tA[i] & 0x7Fu) | ((tB[i] & 0x7Fu) << 16);
    unsigned c[64];
#pragma unroll
    for (int i = 0; i < 64; ++i) c[i] = 0u;
    {
        int n = 0;
#pragma unroll
        for (int a = 0; a < 16; ++a)
#pragma unroll
            for (int b = 0; b < 16; ++b)
                if ((a + 1) * (b + 1) <= 16) { c[n] = (f2sort(fA[a] + fB[b]) & ~0xFFu) | (unsigned)(a * 16 + b); ++n; }
    }
    unsigned g0[16], g1[16], g2[16], g3[16];
#pragma unroll
    for (int i = 0; i < 16; ++i) { g0[i] = c[i]; g1[i] = c[16 + i]; g2[i] = c[32 + i]; g3[i] = c[48 + i]; }
    BSort<0, 16>::run(g0); BSort<0, 16>::run(g1); BSort<0, 16>::run(g2); BSort<0, 16>::run(g3);
    merge_top16(g0, g1); merge_top16(g2, g3); merge_top16(g0, g2);
    float e[16]; float sum = 0.f;
    const float v0 = sort2f(g0[0] & ~0xFFu);
    unsigned ids[16];
#pragma unroll
    for (int i = 0; i < 16; ++i) {
        const float v = sort2f(g0[i] & ~0xFFu);
        e[i] = fast_exp2((v - v0) * LOG2E); sum += e[i];
        const unsigned a = (g0[i] >> 4) & 15u, b = g0[i] & 15u;
        const unsigned ia = tab[a * 64 + lane] & 0x7Fu, ib = (tab[b * 64 + lane] >> 16) & 0x7Fu;
        ids[i] = ia * 128u + ib;
    }
    const float inv = 1.0f / sum;
    if (hh == 0) {
        unsigned short* SID = (unsigned short*)(ws + OFF_SELID) + tok * 128 + h * 16;
        float* SG = (float*)(ws + OFF_SELG) + tok * 128 + h * 16;
        u32x4 w0, w1;
        w0[0] = ids[0] | (ids[1] << 16); w0[1] = ids[2] | (ids[3] << 16); w0[2] = ids[4] | (ids[5] << 16); w0[3] = ids[6] | (ids[7] << 16);
        w1[0] = ids[8] | (ids[9] << 16); w1[1] = ids[10] | (ids[11] << 16); w1[2] = ids[12] | (ids[13] << 16); w1[3] = ids[14] | (ids[15] << 16);
        *(u32x4*)SID = w0; *(u32x4*)(SID + 8) = w1;
#pragma unroll
        for (int q = 0; q < 4; ++q) *(f32x4*)(SG + 4 * q) = (f32x4){e[4 * q] * inv, e[4 * q + 1] * inv, e[4 * q + 2] * inv, e[4 * q + 3] * inv};
    }
}

DI void phase_select(const Params& p, char* lds) {
    for (int item = vbid(); item < 1024; item += vgrid()) peer_select_unit(p, lds, item >> 3, item & 7);
}

DI float gelu_erf(float v) {
    const float av = fabsf(v), t = __builtin_amdgcn_rcpf(av * 0.2316418882f + 1.0f);
    float q = t * 0.5307027145f + (-0.7265760135f); q = q * t + 0.7107068705f; q = q * t + (-0.142248368f); q = q * t + 0.127414796f; q = q * t;
    const float e = __builtin_amdgcn_exp2f((v * v) * (-0.72134752044f));
    const float m = v * (q * e), r = v - m;
    return v < 0.f ? m : r;
}
DI int dppi(int v, const int ctrl) { return v; }
#define DPP_I(v, ctrl) __builtin_amdgcn_update_dpp(0, (v), (ctrl), 0xf, 0xf, true)
DI float ub0(unsigned w) { return (float)(w & 0xFFu); }
DI float ub1(unsigned w) { return (float)((w >> 8) & 0xFFu); }
DI float ub2(unsigned w) { return (float)((w >> 16) & 0xFFu); }
DI float ub3(unsigned w) { return (float)(w >> 24); }

struct GBatch { u32x4 U[4], V[4]; float su[4], sv[4], gate[4]; };

DI void gather_load(GBatch& B, const char* __restrict__ ws, unsigned idpair, f32x2 gpair, int eb, int lane) {
#pragma unroll
    for (int j = 0; j < 4; ++j) {
        const int e = eb + j;
        const unsigned pr = __shfl(idpair, e >> 1);
        const unsigned id = (j & 1) ? (pr >> 16) : (pr & 0xFFFFu);
        const float g0 = __shfl(gpair[0], e >> 1), g1 = __shfl(gpair[1], e >> 1);
        B.gate[j] = (j & 1) ? g1 : g0;
        B.U[j] = ldu4(ws + OFF_UQ + (size_t)id * 2048 + 16 * lane);
        B.V[j] = ldu4(ws + OFF_UQ + (size_t)id * 2048 + 1024 + 16 * lane);
        B.su[j] = ((const float*)(ws + OFF_SU))[id];
        B.sv[j] = ((const float*)(ws + OFF_SV))[id];
    }
}

DI void gather_compute(const GBatch& B, const unsigned (&qx)[4], float sx, float (&acc)[16], float& csum, int lane) {
    int pd[4];
#pragma unroll
    for (int j = 0; j < 4; ++j) {
        int d = 0;
#pragma unroll
        for (int q = 0; q < 4; ++q) d = __builtin_amdgcn_sdot4((int)B.U[j][q], (int)qx[q], d, false);
        pd[j] = d;
    }
    const bool b0 = lane & 1, b1 = lane & 2;
    const int kA = b0 ? pd[1] : pd[0], kB = b0 ? pd[3] : pd[2], sA = b0 ? pd[0] : pd[1], sB = b0 ? pd[2] : pd[3];
    const int qA = kA + DPP_I(sA, 0xB1), qB = kB + DPP_I(sB, 0xB1);
    const int kp = b1 ? qB : qA, sd = b1 ? qA : qB;
    int tot = kp + DPP_I(sd, 0x4E);
    tot += DPP_I(tot, 0x124);
    tot += DPP_I(tot, 0x128);
    tot += __builtin_amdgcn_ds_swizzle(tot, 0x401F);
    { auto rr = __builtin_amdgcn_permlane32_swap((unsigned)tot, (unsigned)tot, false, false); tot = (int)rr[0] + (int)rr[1]; }
    const int j3 = lane & 3;
    const float su_sel = (j3 == 0) ? B.su[0] : (j3 == 1 ? B.su[1] : (j3 == 2 ? B.su[2] : B.su[3]));
    const float ge = gelu_erf((float)tot * sx * su_sel);
#pragma unroll
    for (int j = 0; j < 4; ++j) {
        const float cf = B.gate[j] * B.sv[j] * __uint_as_float((unsigned)__builtin_amdgcn_readlane((int)__float_as_uint(ge), j));
#pragma unroll
        for (int q = 0; q < 4; ++q) {
            const int w = (int)B.V[j][q];
            const f32x2 lo = __builtin_amdgcn_cvt_pk_f32_fp8(w, false), hi = __builtin_amdgcn_cvt_pk_f32_fp8(w, true);
            acc[4 * q] += cf * lo[0]; acc[4 * q + 1] += cf * lo[1]; acc[4 * q + 2] += cf * hi[0]; acc[4 * q + 3] += cf * hi[1];
        }
    }
}

DI void gather_token(const Params& p, size_t tok, int lane, float* dst_base) {
    char* ws = p.ws;
    const bf16_t* hrow = (const bf16_t*)(ws + OFF_HB) + tok * 1024 + 16 * lane;
    float hv[16];
    {
        const u32x4 w0 = ldu4(hrow), w1 = ldu4(hrow + 8);
#pragma unroll
        for (int e = 0; e < 4; ++e) { hv[2 * e] = bf_lo(w0[e]); hv[2 * e + 1] = bf_hi(w0[e]); hv[8 + 2 * e] = bf_lo(w1[e]); hv[8 + 2 * e + 1] = bf_hi(w1[e]); }
    }
    float rs;
    {
        const float* SS = (const float*)(ws + OFF_SS2) + tok * 16;
        const f32x4 s0 = *(const f32x4*)SS, s1 = *(const f32x4*)(SS + 4), s2 = *(const f32x4*)(SS + 8), s3 = *(const f32x4*)(SS + 12);
        const float tot = (s0[0] + s0[1] + s0[2] + s0[3]) + (s1[0] + s1[1] + s1[2] + s1[3]) + (s2[0] + s2[1] + s2[2] + s2[3]) + (s3[0] + s3[1] + s3[2] + s3[3]);
        rs = rsqrtf(tot * (1.0f / 1024.0f) + 1e-6f);
    }
    float xf[16]; float am = 0.f;
#pragma unroll
    for (int i = 0; i < 4; ++i) {
        const f32x4 g = *(const f32x4*)(p.norm_ffn + 16 * lane + 4 * i);
#pragma unroll
        for (int e = 0; e < 4; ++e) { xf[4 * i + e] = hv[4 * i + e] * rs * g[e]; am = fmaxf(am, fabsf(xf[4 * i + e])); }
    }
#pragma unroll
    for (int o = 32; o; o >>= 1) am = fmaxf(am, __shfl_xor(am, o));
    const float sx = (am > 0.f) ? am * (1.0f / 127.0f) : 1.0f;
    const float isx = 1.0f / sx;
    unsigned qx[4];
#pragma unroll
    for (int i = 0; i < 4; ++i) {
        unsigned w = 0u;
#pragma unroll
        for (int e = 0; e < 4; ++e) w |= ((unsigned)(int)rintf(xf[4 * i + e] * isx) & 0xFFu) << (8 * e);
        qx[i] = w;
    }
    const unsigned idpair = *((const unsigned*)(ws + OFF_SELID) + tok * 64 + lane);
    const f32x2 gpair = *((const f32x2*)(ws + OFF_SELG) + tok * 64 + lane);
    float acc[16]; float csum = 0.f;
#pragma unroll
    for (int i = 0; i < 16; ++i) acc[i] = 0.f;
    GBatch B0, B1;
    gather_load(B0, ws, idpair, gpair, 0, lane);
#pragma unroll 1
    for (int eb = 0; eb < 128; eb += 8) {
        gather_load(B1, ws, idpair, gpair, eb + 4, lane);
        gather_compute(B0, qx, sx, acc, csum, lane);
        if (eb + 8 < 128) gather_load(B0, ws, idpair, gpair, eb + 8, lane);
        gather_compute(B1, qx, sx, acc, csum, lane);
    }
    float ss = 0.f;
#pragma unroll
    for (int i = 0; i < 16; ++i) { acc[i] = acc[i] - 128.0f * csum + hv[i]; ss += acc[i] * acc[i]; }
#pragma unroll
    for (int o = 32; o; o >>= 1) ss += __shfl_xor(ss, o);
    const float rf = rsqrtf(ss * (1.0f / 1024.0f) + 1e-6f);
    float* drow = dst_base + tok * 1024 + 16 * lane;
#pragma unroll
    for (int i = 0; i < 4; ++i) {
        const f32x4 n = *(const f32x4*)(p.norm_final + 16 * lane + 4 * i);
        *(f32x4*)(drow + 4 * i) = (f32x4){acc[4 * i] * rf * n[0], acc[4 * i + 1] * rf * n[1], acc[4 * i + 2] * rf * n[2], acc[4 * i + 3] * rf * n[3]};
    }
}

DI void phase_gather(const Params& p, bool dry = false) {
    const int lane = otid() & 63, wv = otid() >> 6;
    float* dst = dry ? (float*)(p.ws + OFF_A) : p.out;
    for (int item = vbid(); item < T_TOK / 4; item += vgrid()) gather_token(p, (size_t)item * 4 + wv, lane, dst);
}

constexpr size_t GS_PSTRIDE = 1040;
constexpr size_t GS_SGS = OFF_A;
constexpr size_t GS_XQ = GS_SGS + (size_t)T_TOK * GS_PSTRIDE;
constexpr size_t GS_ACC = GS_XQ + (size_t)T_TOK * 1024;
static_assert(GS_ACC <= OFF_A + 69 * MiB, "gather scratch overflows region A");

DI void gs_load(GBatch& B, const char* __restrict__ ws, unsigned myid, float mygate, int j0, int n, int lane) {
#pragma unroll
    for (int j = 0; j < 4; ++j) {
        const int e = __builtin_amdgcn_readfirstlane(j0 + j);
        const bool ok = e < n;
        const int src = ok ? e : 0;
        const unsigned id = (unsigned)__builtin_amdgcn_readlane((int)myid, src);
        const float g = __uint_as_float((unsigned)__builtin_amdgcn_readlane((int)__float_as_uint(mygate), src));
        B.gate[j] = ok ? g : 0.f;
        const char* urow = ws + OFF_UQ + (size_t)id * 2048;
        const char* vrow = urow + 1024;
        B.U[j] = ldu4(urow + 16 * lane);
        B.V[j] = ldu4(vrow + 16 * lane);
        B.su[j] = ((const float*)(ws + OFF_SU))[id];
        B.sv[j] = ((const float*)(ws + OFF_SV))[id];
    }
}

#ifndef GS_NSL
#define GS_NSL 16
#endif
constexpr int NSL = GS_NSL, NSL_SH = (GS_NSL == 8 ? 11 : (GS_NSL == 16 ? 10 : (GS_NSL == 32 ? 9 : 12))), OFFW = 64;
DI void phase_gather_sliced(const Params& p, char* smem) {
    char* ws = p.ws;
    if ((T_TOK / 8) > 8 * (((int)gridDim.x >> 3) * 8) || ((int)gridDim.x & 7)) { phase_gather(p); return; }
    const int wvi = __builtin_amdgcn_readfirstlane((int)(threadIdx.x >> 6));
    char* lacc = smem + wvi * 16384 + (threadIdx.x & 63) * 32;
    unsigned short* lids = (unsigned short*)(smem + 131072 + wvi * 2048);
    unsigned char* loff = (unsigned char*)(smem + 131072 + 16384 + wvi * (8 * OFFW));
    const int lane = threadIdx.x & 63;
    const int x = (int)blockIdx.x & 7, nW = ((int)gridDim.x >> 3) * 8, lw = ((int)blockIdx.x >> 3) * 8 + wvi;
    const int TPX = T_TOK / 8;
    for (int tl = lw; tl < TPX; tl += nW) {
        const size_t tok = (size_t)x * TPX + tl;
        const bf16_t* hrow = (const bf16_t*)(ws + OFF_HB) + tok * 1024 + 16 * lane;
        float hv[16];
        {
            const u32x4 w0 = ldu4(hrow), w1 = ldu4(hrow + 8);
#pragma unroll
            for (int e = 0; e < 4; ++e) { hv[2 * e] = bf_lo(w0[e]); hv[2 * e + 1] = bf_hi(w0[e]); hv[8 + 2 * e] = bf_lo(w1[e]); hv[8 + 2 * e + 1] = bf_hi(w1[e]); }
        }
        float rs;
        {
            const float* SS = (const float*)(ws + OFF_SS2) + tok * 16;
            const f32x4 s0 = *(const f32x4*)SS, s1 = *(const f32x4*)(SS + 4), s2 = *(const f32x4*)(SS + 8), s3 = *(const f32x4*)(SS + 12);
            const float tot = (s0[0] + s0[1] + s0[2] + s0[3]) + (s1[0] + s1[1] + s1[2] + s1[3]) + (s2[0] + s2[1] + s2[2] + s2[3]) + (s3[0] + s3[1] + s3[2] + s3[3]);
            rs = rsqrtf(tot * (1.0f / 1024.0f) + 1e-6f);
        }
        float xf[16]; float am = 0.f;
#pragma unroll
        for (int i = 0; i < 4; ++i) {
            const f32x4 g = *(const f32x4*)(p.norm_ffn + 16 * lane + 4 * i);
#pragma unroll
            for (int e = 0; e < 4; ++e) { xf[4 * i + e] = hv[4 * i + e] * rs * g[e]; am = fmaxf(am, fabsf(xf[4 * i + e])); }
        }
#pragma unroll
        for (int o = 32; o; o >>= 1) am = fmaxf(am, __shfl_xor(am, o));
        const float sx = (am > 0.f) ? am * (1.0f / 127.0f) : 1.0f;
        const float isx = 1.0f / sx;
        u32x4 qx;
#pragma unroll
        for (int i = 0; i < 4; ++i) {
            unsigned w = 0u;
#pragma unroll
            for (int e = 0; e < 4; ++e) w |= ((unsigned)(int)rintf(xf[4 * i + e] * isx) & 0xFFu) << (8 * e);
            qx[i] = w;
        }
        *(u32x4*)(ws + GS_XQ + tok * 1024 + 16 * lane) = qx;
        const unsigned idpair = *((const unsigned*)(ws + OFF_SELID) + tok * 64 + lane);
        const f32x2 gpair = *((const f32x2*)(ws + OFF_SELG) + tok * 64 + lane);
        const unsigned id0 = idpair & 0xFFFFu, id1 = idpair >> 16;
        const int sl0 = (int)(id0 >> NSL_SH), sl1 = (int)(id1 >> NSL_SH);
        const unsigned long long lt = (1ull << lane) - 1ull;
        int base = 0, pos0 = 0, pos1 = 0, myoff = 0;
#pragma unroll
        for (int s = 0; s < NSL; ++s) {
            const unsigned long long m0 = __ballot(sl0 == s), m1 = __ballot(sl1 == s);
            const int c0 = __popcll(m0), c1 = __popcll(m1);
            if (sl0 == s) pos0 = base + __popcll(m0 & lt);
            if (sl1 == s) pos1 = base + c0 + __popcll(m1 & lt);
            if (lane == s) myoff = base;
            base += c0 + c1;
        }
        if (lane == NSL) myoff = base;
        f32x2* sg = (f32x2*)(ws + GS_SGS + tok * GS_PSTRIDE);
        { const int k = (tl - lw) / nW; lids[k * 128 + pos0] = (unsigned short)id0; lids[k * 128 + pos1] = (unsigned short)id1; if (lane <= NSL) loff[k * OFFW + lane] = (unsigned char)myoff; }
        const float* SU = (const float*)(ws + OFF_SU); const float* SV = (const float*)(ws + OFF_SV);
        sg[pos0] = (f32x2){sx * SU[id0], gpair[0] * SV[id0]}; sg[pos1] = (f32x2){sx * SU[id1], gpair[1] * SV[id1]};
        if (lane == 0) sg[128] = (f32x2){0.f, 0.f};

    }
    __syncthreads();
    const int ntk = (TPX - lw + nW - 1) / nW;
    for (int k = 0; k < ntk; ++k) { *(u32x4*)(lacc + k * 2048) = (u32x4){0u, 0u, 0u, 0u}; *(u32x4*)(lacc + k * 2048 + 16) = (u32x4){0u, 0u, 0u, 0u}; }
    const char* tab = ws + OFF_UQ;
    const unsigned lane16 = 16u * (unsigned)lane;
    struct SB { u32x4 U[4], V[4], qx; f32x2 pr; int k, m; };
#pragma unroll 1
    for (int pass = 0; pass < NSL; ++pass) {
        const int slice = pass;
        int kL = 0, jL = 0, nL = 0, oL = 0;
        float acc[16]; int kC = -1;
#define GS_OPEN(k_) do { oL = __builtin_amdgcn_readfirstlane((int)loff[(k_) * OFFW + slice]); nL = __builtin_amdgcn_readfirstlane((int)loff[(k_) * OFFW + slice + 1]) - oL; jL = 0; } while (0)
#define GS_ADVANCE(ok_) do { if (jL + 4 < nL) { jL += 4; ok_ = true; } else if (kL + 1 >= ntk) ok_ = false; else { ++kL; GS_OPEN(kL); ok_ = true; } } while (0)
#define GS_LOAD(B_, valid_) do { const size_t tok_ = (size_t)x * TPX + lw + (size_t)kL * nW; \
            const int el_ = jL + (lane & 3); const bool okl_ = el_ < nL;            \
            const unsigned idv_ = (unsigned)lids[kL * 128 + ((oL + (okl_ ? el_ : 0)) & 127)]; \
            const unsigned pro_ = okl_ ? 8u * (unsigned)((oL + el_) & 127) : 1024u;            \
            const char* prb_ = ws + GS_SGS + tok_ * GS_PSTRIDE; \
            B_.m = (valid_) ? min(4, nL - jL) : 0; \
            asm volatile("global_load_dwordx2 %0, %1, %2" : "=v"(B_.pr) : "v"(pro_), "s"(prb_)); \
            _Pragma("unroll") for (int j = 0; j < 4; ++j) if (j < B_.m) { const unsigned id_ = (unsigned)__builtin_amdgcn_readlane((int)idv_, j); const char* rb_ = tab + (size_t)id_ * 2048; \
                asm volatile("global_load_dwordx4 %0, %1, %2" : "+v"(B_.U[j]) : "v"(lane16), "s"(rb_)); \
                asm volatile("global_load_dwordx4 %0, %1, %2 offset:1024" : "+v"(B_.V[j]) : "v"(lane16), "s"(rb_)); } \
            { const char* xb_ = ws + GS_XQ + tok_ * 1024; asm volatile("global_load_dwordx4 %0, %1, %2" : "=v"(B_.qx) : "v"(lane16), "s"(xb_)); } \
            B_.k = (valid_) ? kL : -1; } while (0)
#define GS_WAITN(n_) asm volatile("s_waitcnt vmcnt(" #n_ ")" ::: "memory")
#define GS_WAIT(B_, mn_) do { if ((mn_) == 4) GS_WAITN(10); else if ((mn_) == 3) GS_WAITN(8); else if ((mn_) == 2) GS_WAITN(6); else if ((mn_) == 1) GS_WAITN(4); else GS_WAITN(2); \
            asm volatile("" : "+v"(B_.U[0]), "+v"(B_.U[1]), "+v"(B_.U[2]), "+v"(B_.U[3]), "+v"(B_.V[0]), "+v"(B_.V[1]), "+v"(B_.V[2]), "+v"(B_.V[3]), "+v"(B_.qx), "+v"(B_.pr) :: "memory"); } while (0)
#define GS_FLUSH() do { if (kC >= 0) { char* la_ = lacc + kC * 2048; u32x4 w0_, w1_; \
                _Pragma("unroll") for (int e = 0; e < 4; ++e) { w0_[e] = pack2(acc[2 * e], acc[2 * e + 1]); w1_[e] = pack2(acc[8 + 2 * e], acc[8 + 2 * e + 1]); } \
                *(u32x4*)la_ = w0_; *(u32x4*)(la_ + 16) = w1_; } } while (0)
#define GS_CONSUME(B_) do { if (B_.k >= 0) { \
            if (B_.k != kC) { GS_FLUSH(); kC = B_.k; const char* la_ = lacc + kC * 2048; const u32x4 w0_ = *(const u32x4*)la_, w1_ = *(const u32x4*)(la_ + 16); \
                _Pragma("unroll") for (int e = 0; e < 4; ++e) { acc[2 * e] = bf_lo(w0_[e]); acc[2 * e + 1] = bf_hi(w0_[e]); acc[8 + 2 * e] = bf_lo(w1_[e]); acc[8 + 2 * e + 1] = bf_hi(w1_[e]); } } \
            int pd_[4]; \
            _Pragma("unroll") for (int j = 0; j < 4; ++j) { int d_ = 0; if (j < B_.m) { _Pragma("unroll") for (int q = 0; q < 4; ++q) d_ = __builtin_amdgcn_sdot4((int)B_.U[j][q], (int)B_.qx[q], d_, false); } pd_[j] = d_; } \
            const bool b0_ = lane & 1, b1_ = lane & 2; \
            const int kA_ = b0_ ? pd_[1] : pd_[0], kB_ = b0_ ? pd_[3] : pd_[2], sA_ = b0_ ? pd_[0] : pd_[1], sB_ = b0_ ? pd_[2] : pd_[3]; \
            const int qA_ = kA_ + DPP_I(sA_, 0xB1), qB_ = kB_ + DPP_I(sB_, 0xB1); \
            const int kp_ = b1_ ? qB_ : qA_, sd_ = b1_ ? qA_ : qB_; \
            int tot_ = kp_ + DPP_I(sd_, 0x4E); tot_ += DPP_I(tot_, 0x124); tot_ += DPP_I(tot_, 0x128); tot_ += __builtin_amdgcn_ds_swizzle(tot_, 0x401F); \
            { auto rr_ = __builtin_amdgcn_permlane32_swap((unsigned)tot_, (unsigned)tot_, false, false); tot_ = (int)rr_[0] + (int)rr_[1]; } \
            const float cfv_ = B_.pr[1] * gelu_erf((float)tot_ * B_.pr[0]); \
            _Pragma("unroll") for (int j = 0; j < 4; ++j) if (j < B_.m) { const float cf_ = __uint_as_float((unsigned)__builtin_amdgcn_readlane((int)__float_as_uint(cfv_), j)); \
                _Pragma("unroll") for (int q = 0; q < 4; ++q) { const int w_ = (int)B_.V[j][q]; const f32x2 lo_ = __builtin_amdgcn_cvt_pk_f32_fp8(w_, false), hi_ = __builtin_amdgcn_cvt_pk_f32_fp8(w_, true); \
                    acc[4 * q] += cf_ * lo_[0]; acc[4 * q + 1] += cf_ * lo_[1]; acc[4 * q + 2] += cf_ * hi_[0]; acc[4 * q + 3] += cf_ * hi_[1]; } } } } while (0)
        SB S0, S1;
        _Pragma("unroll") for (int j = 0; j < 4; ++j) { S0.U[j] = S0.V[j] = S1.U[j] = S1.V[j] = (u32x4){0u, 0u, 0u, 0u}; }
        bool h0, h1;
        GS_OPEN(0);
        GS_LOAD(S0, true);
#pragma unroll 1
        for (;;) {
            GS_ADVANCE(h1); GS_LOAD(S1, h1);
            GS_WAIT(S0, S1.m); GS_CONSUME(S0);
            if (!h1) break;
            GS_ADVANCE(h0); GS_LOAD(S0, h0);
            GS_WAIT(S1, S0.m); GS_CONSUME(S1);
            if (!h0) break;
        }
        asm volatile("s_waitcnt vmcnt(0)" ::: "memory");
        GS_FLUSH();
#undef GS_OPEN
#undef GS_ADVANCE
#undef GS_LOAD
#undef GS_FLUSH
#undef GS_CONSUME
#undef GS_WAIT
#undef GS_WAITN
    }
    for (int k = 0; k < ntk; ++k) {
        const size_t tok = (size_t)x * TPX + lw + (size_t)k * nW;
        const char* la = lacc + k * 2048; const u32x4 a0 = *(const u32x4*)la, a1 = *(const u32x4*)(la + 16);
        const bf16_t* hrow = (const bf16_t*)(ws + OFF_HB) + tok * 1024 + 16 * lane; const u32x4 w0 = ldu4(hrow), w1 = ldu4(hrow + 8);
        float acc[16]; float ss = 0.f;
#pragma unroll
        for (int e = 0; e < 4; ++e) { acc[2 * e] = bf_lo(a0[e]) + bf_lo(w0[e]); acc[2 * e + 1] = bf_hi(a0[e]) + bf_hi(w0[e]); acc[8 + 2 * e] = bf_lo(a1[e]) + bf_lo(w1[e]); acc[8 + 2 * e + 1] = bf_hi(a1[e]) + bf_hi(w1[e]); }
#pragma unroll
        for (int i = 0; i < 16; ++i) ss += acc[i] * acc[i];
#pragma unroll
        for (int o = 32; o; o >>= 1) ss += __shfl_xor(ss, o);
        const float rf = rsqrtf(ss * (1.0f / 1024.0f) + 1e-6f); float* drow = p.out + tok * 1024 + 16 * lane;
#pragma unroll
        for (int i = 0; i < 4; ++i) { const f32x4 nn = *(const f32x4*)(p.norm_final + 16 * lane + 4 * i);
            *(f32x4*)(drow + 4 * i) = (f32x4){acc[4 * i] * rf * nn[0], acc[4 * i + 1] * rf * nn[1], acc[4 * i + 2] * rf * nn[2], acc[4 * i + 3] * rf * nn[3]}; }
    }
}
constexpr int LDS_BYTES = 131072 + 16384 + 4096;
constexpr int NPHASE = 12;
template <int PH> DI void run_phase(const Params& p, char* smem) {
    char* lds = smem + vhalf() * 65536;
    if (PH == 0) phase_prep(p, lds);
    else if (PH == 1) phase_p1(p, smem);
    else if (PH == 2) phase_p2(p, smem);
    else if (PH == 3) phase_p3(p, lds);
    else if (PH == 4) phase_p35(p, lds);
    else if (PH == 5) phase_resid<false>(p, smem, OFF_WT_OUT, OFF_MIXED, p.x, OFF_SS1);
    else if (PH == 6) phase_rowscale(p, smem, OFF_WT_MQ, 1024, (bf16_t*)(p.ws + OFF_QM), OFF_SS1, 0.0625f * LOG2E);
    else if (PH == 7) phase_memattn(p, lds);
    else if (PH == 8) phase_resid<true>(p, smem, OFF_WT_MO, OFF_OM, p.ws + OFF_HB, OFF_SS2);
    else if (PH == 9) phase_rowscale(p, smem, OFF_WT_PQ, 2048, (bf16_t*)((char*)p.out + OUT_PQ), OFF_SS2, 1.0f);
    else if (PH == 10) phase_select(p, lds);
    else if (PH == 11) phase_gather_sliced(p, smem);
}

template <int PH> __global__ void __launch_bounds__(512, 2) k_phase(Params p) {
    __shared__ __attribute__((aligned(16))) char smem[LDS_BYTES];
    run_phase<PH>(p, smem);
}

static Params make_params(void* const* d_in, void* d_out, void* d_ws) {
    Params p;
    memset(&p, 0, sizeof(p));
    p.x = (const float*)d_in[0]; p.mem = (const float*)d_in[1]; p.norm_mix = (const float*)d_in[2]; p.w_in = (const float*)d_in[3];
    p.q_norm = (const float*)d_in[4]; p.kv_norm = (const float*)d_in[5]; p.w_uq = (const float*)d_in[6]; p.w_ukv = (const float*)d_in[7];
    p.gn_mla = (const float*)d_in[8]; p.gn_dil = (const float*)d_in[9]; p.w_out = (const float*)d_in[10]; p.norm_mem_q = (const float*)d_in[11];
    p.norm_mem_kv = (const float*)d_in[12]; p.w_mem_q = (const float*)d_in[13]; p.w_mem_kv = (const float*)d_in[14]; p.w_mem_o = (const float*)d_in[15];
    p.norm_ffn = (const float*)d_in[16]; p.peer_w_q = (const float*)d_in[17]; p.sub_keys = (const float*)d_in[18]; p.peer_u = (const float*)d_in[19];
    p.peer_v = (const float*)d_in[20]; p.norm_final = (const float*)d_in[21];
    p.out = (float*)d_out; p.ws = (char*)d_ws;
    for (int i = 0; i < 16; ++i) p.inv_freq[i] = 1.0f / powf(10000.0f, (float)(2 * i) / 32.0f);
    return p;
}
__global__ void __launch_bounds__(512, 2) k_mega(Params p) {
    __shared__ __attribute__((aligned(16))) char smem[LDS_BYTES + 16];
    volatile LAS unsigned* st = (volatile LAS unsigned*)(LAS char*)(smem + LDS_BYTES);
    if (threadIdx.x == 0) { st[0] = 0u; st[1] = 0u; st[2] = 0u; st[3] = 0u; }
    __syncthreads();
    const XcdBarrier xb = xcd_barrier_post((unsigned*)(p.ws + OFF_BAR), st);
#define RP(n) run_phase<n>(p, smem); xcd_barrier(xb);
    RP(0) RP(1) RP(2) RP(3) RP(4) RP(5) RP(6) RP(7) RP(8) RP(9) RP(10)
    run_phase<11>(p, smem);
}

extern "C" void kernel_launch(void* const* d_in, const int* in_sizes, int n_in, void* d_out, int out_size, void* d_ws, size_t ws_size,
                              hipStream_t stream) {
    static int grid_blocks = 0;
    if (!grid_blocks) {
        int dev = 0, cus = 0, per_cu = 0;
        (void)hipGetDevice(&dev);
        (void)hipDeviceGetAttribute(&cus, hipDeviceAttributeMultiprocessorCount, dev);
        (void)hipOccupancyMaxActiveBlocksPerMultiprocessor(&per_cu, k_mega, 512, 0);
        if (per_cu > 1) per_cu = 1;
        if (per_cu < 1) per_cu = 1;
        grid_blocks = cus * per_cu;
    }
    Params p = make_params(d_in, d_out, d_ws);
    (void)hipMemsetAsync((char*)d_ws + OFF_BAR, 0, XCD_BAR_WORDS * 4, stream);
    void* args[] = {&p};
    hipError_t e = hipLaunchCooperativeKernel((const void*)k_mega, dim3(grid_blocks), dim3(512), args, 0, stream);
    if (e != hipSuccess) fprintf(stderr, "cooperative launch failed: %s (grid %d)\n", hipGetErrorString(e), grid_blocks);
}
```

```cpp
#include <hip/hip_runtime.h>
#include <hip/hip_cooperative_groups.h>
#include <math.h>
#include <stdint.h>
#include <stdio.h>
#include <string.h>
#define DI __device__ __forceinline__
typedef unsigned short bf16_t;
typedef short bf16x8 __attribute__((ext_vector_type(8)));
typedef short s16x4 __attribute__((ext_vector_type(4)));
typedef float f32x16 __attribute__((ext_vector_type(16)));
typedef float f32x4 __attribute__((ext_vector_type(4)));
typedef float f32x2 __attribute__((ext_vector_type(2)));
typedef unsigned u32x4 __attribute__((ext_vector_type(4)));
typedef unsigned u32x2 __attribute__((ext_vector_type(2)));
typedef __bf16 bf16x2v __attribute__((ext_vector_type(2)));
#define LAS __attribute__((address_space(3)))
#define MFMA32(a, b, c) __builtin_amdgcn_mfma_f32_32x32x16_bf16((a), (b), (c), 0, 0, 0)

constexpr int T_TOK = 16384, SEQ_L = 4096, DM = 1024, INC = 2208;
constexpr float LOG2E = 1.4426950408889634f;

DI int otid() { int t = threadIdx.x & 255; asm volatile("" : "+v"(t)); return t; }
DI int vhalf() { return __builtin_amdgcn_readfirstlane((int)(threadIdx.x >> 8)); }
DI int vbid() { return (int)blockIdx.x * 2 + vhalf(); }
DI int vgrid() { return (int)gridDim.x * 2; }
DI unsigned pack2(float lo, float hi) { f32x2 f = {lo, hi}; return __builtin_bit_cast(unsigned, __builtin_convertvector(f, bf16x2v)); }
DI float bf_lo(unsigned u) { return __uint_as_float(u << 16); }
DI float bf_hi(unsigned u) { return __uint_as_float(u & 0xffff0000u); }
DI float bf2f(bf16_t v) { return __uint_as_float(((unsigned)v) << 16); }
DI int crow(int reg, int hh) { return (reg & 3) + 8 * (reg >> 2) + 4 * hh; }
DI f32x16 zero16() { f32x16 z;
#pragma unroll
    for (int i = 0; i < 16; ++i) z[i] = 0.f; return z; }
DI float xhalf_max(float v) { auto r = __builtin_amdgcn_permlane32_swap(__float_as_uint(v), __float_as_uint(v), false, false); return fmaxf(__uint_as_float(r[0]), __uint_as_float(r[1])); }
DI float xhalf_other(float v, int lane) { auto r = __builtin_amdgcn_permlane32_swap(__float_as_uint(v), __float_as_uint(v), false, false); return __uint_as_float((lane & 32) ? r[0] : r[1]); }
DI float xhalf_sum(float v) { auto r = __builtin_amdgcn_permlane32_swap(__float_as_uint(v), __float_as_uint(v), false, false); return __uint_as_float(r[0]) + __uint_as_float(r[1]); }
DI bf16x8 ld16(const void* p) { return *(const bf16x8*)p; }
DI u32x4 ldu4(const void* p) { return *(const u32x4*)p; }
DI float fast_exp2(float x) { return __builtin_amdgcn_exp2f(x); }
DI bf16x8 pack_step(const f32x16& x, int s) {
    u32x4 p;
    p[0] = pack2(x[8 * s + 0], x[8 * s + 1]); p[1] = pack2(x[8 * s + 2], x[8 * s + 3]);
    p[2] = pack2(x[8 * s + 4], x[8 * s + 5]); p[3] = pack2(x[8 * s + 6], x[8 * s + 7]);
    return __builtin_bit_cast(bf16x8, p);
}
DI s16x4 tr_read_a(unsigned lds_byte_addr) { s16x4 r; asm volatile("ds_read_b64_tr_b16 %0, %1" : "=v"(r) : "v"(lds_byte_addr)); return r; }
template <int OFF> DI s16x4 tr_read_ao(unsigned lds_byte_addr) { s16x4 r; asm volatile("ds_read_b64_tr_b16 %0, %1 offset:%2" : "=v"(r) : "v"(lds_byte_addr), "i"(OFF)); return r; }
#define TR_WAIT() do { asm volatile("s_waitcnt lgkmcnt(0)" ::: "memory"); __builtin_amdgcn_sched_barrier(0); } while (0)
DI s16x4 tr_read(unsigned lds_byte_addr) {
    return __builtin_amdgcn_ds_read_tr16_b64_v4i16((LAS s16x4*)(uintptr_t)lds_byte_addr);
}

constexpr size_t MiB = 1ull << 20;
constexpr size_t OFF_BAR = 0;
constexpr size_t OFF_WT_IN = 65536;
constexpr size_t OFF_WT_UQ = OFF_WT_IN + 2304ull * 1024 * 2;
constexpr size_t OFF_WT_UKV = OFF_WT_UQ + 768ull * 384 * 2;
constexpr size_t OFF_WT_OUT = OFF_WT_UKV + 1024ull * 256 * 2;
constexpr size_t OFF_WT_MQ = OFF_WT_OUT + 1024ull * 1024 * 2;
constexpr size_t OFF_WT_MKV = OFF_WT_MQ + 1024ull * 1024 * 2;
constexpr size_t OFF_WT_MO = OFF_WT_MKV + 2048ull * 1024 * 2;
constexpr size_t OFF_WT_PQ = OFF_WT_MO + 1024ull * 1024 * 2;
constexpr size_t OFF_KEYS = OFF_WT_PQ + 2048ull * 1024 * 2;
constexpr size_t OFF_ROPE = OFF_KEYS + 16ull * 128 * 128 * 2;
constexpr size_t OFF_KR = OFF_ROPE + 2ull * 4096 * 16 * 4;
constexpr size_t OFF_LSE = OFF_KR + (size_t)T_TOK * 32 * 2;
constexpr size_t OFF_SS1 = OFF_LSE + 3ull * T_TOK * 8 * 4;
constexpr size_t OFF_SS2 = OFF_SS1 + (size_t)T_TOK * 16 * 4;
constexpr size_t OFF_MEMN = OFF_SS2 + (size_t)T_TOK * 16 * 4;
constexpr size_t OFF_SMALL_END = OFF_MEMN + 1024ull * 1024 * 2;
static_assert(OFF_SMALL_END <= 28 * MiB, "small region overflow");
constexpr size_t OFF_A = 28 * MiB;
constexpr size_t OFF_PROJ = OFF_A;
constexpr size_t OFF_UQ = 193 * MiB;
constexpr size_t OFF_SU = 243 * MiB;
constexpr size_t OFF_SV = OFF_SU + 65536;
constexpr size_t OUT_ODIL = 0;
constexpr size_t OUT_OMLA = 48 * MiB;
constexpr size_t OUT_PQ = 0;
constexpr size_t OFF_B = 97 * MiB;
constexpr size_t OFF_XN = OFF_B, OFF_QMLA = OFF_B, OFF_MIXED = OFF_B, OFF_QM = OFF_B;
constexpr size_t OFF_C = 129 * MiB;
constexpr size_t OFF_KVMLA = OFF_C, OFF_HB = OFF_C;
constexpr size_t OFF_D = 161 * MiB;
constexpr size_t OFF_OM = OFF_D;
constexpr size_t OFF_SELID = 225 * MiB;
constexpr size_t OFF_SELG = 229 * MiB;
constexpr size_t OFF_KVM = 237 * MiB;
constexpr size_t OFF_SSQ = 241 * MiB;
constexpr size_t WS_NEEDED = 244 * MiB;

struct Params {
    const float* x; const float* mem; const float* norm_mix; const float* w_in; const float* q_norm; const float* kv_norm;
    const float* w_uq; const float* w_ukv; const float* gn_mla; const float* gn_dil; const float* w_out; const float* norm_mem_q;
    const float* norm_mem_kv; const float* w_mem_q; const float* w_mem_kv; const float* w_mem_o; const float* norm_ffn;
    const float* peer_w_q; const float* sub_keys; const float* peer_u; const float* peer_v; const float* norm_final;
    float* out; char* ws;
    float inv_freq[16];
    int prof; int pad_;
};
#define XB_TMO      128
#define XB_XCNT(j)  (256  + 64 * (j))
#define XB_XSUB(j)  (1280 + 64 * (j))
#define XB_XGEN(j)  (2304 + 64 * (j))
#define XB_TOP      3328
#define XB_TOPGEN   3392
#define XCD_BAR_WORDS 3456
#define XB_SPIN_CAP (1u << 20)
DI unsigned xb_ld(unsigned* p) { return __hip_atomic_load(p, __ATOMIC_RELAXED, __HIP_MEMORY_SCOPE_AGENT); }
DI unsigned xb_add(unsigned* p, unsigned v) { return __hip_atomic_fetch_add(p, v, __ATOMIC_RELAXED, __HIP_MEMORY_SCOPE_AGENT); }
DI unsigned xb_xcc_id() { return (unsigned)__builtin_amdgcn_s_getreg((3 << 11) | 20) & 0xFu; }
#define XB_SPIN(cond, bar) do { unsigned _sp = 0; while (cond) { __builtin_amdgcn_s_sleep(1); \
    if ((++_sp & 255u) == 0u) { if (xb_ld(&(bar)[XB_TMO])) break; if (_sp > XB_SPIN_CAP) { atomicAdd(&(bar)[XB_TMO], 1u); break; } } } } while (0)
struct XcdBarrier { unsigned* bar; unsigned x; volatile LAS unsigned* st; };
DI XcdBarrier xcd_barrier_post(unsigned* bar, volatile LAS unsigned* st) {
    XcdBarrier b; b.bar = bar; b.x = xb_xcc_id(); b.st = st;
    if (threadIdx.x == 0) (void)xb_add(&bar[XB_XCNT(b.x)], 1u);
    return b;
}
DI void xcd_barrier_complete(unsigned* bar, unsigned x, unsigned& nloc, unsigned& nx) {
    const unsigned G = gridDim.x * gridDim.y * gridDim.z;
    unsigned sum, cnt, mine, sp = 0u;
    for (;;) {
        sum = 0u; cnt = 0u; mine = 0u;
#pragma unroll
        for (unsigned j = 0; j < 16; ++j) { const unsigned c = xb_ld(&bar[XB_XCNT(j)]); sum += c; cnt += (c > 0u) ? 1u : 0u; mine = (j == x) ? c : mine; }
        if (sum == G) break;
        __builtin_amdgcn_s_sleep(1);
        if ((++sp & 255u) == 0u) { if (xb_ld(&bar[XB_TMO])) break; if (sp > XB_SPIN_CAP) { atomicAdd(&bar[XB_TMO], 1u); break; } }
    }
    nloc = mine > 0u ? mine : 1u; nx = cnt > 0u ? cnt : 1u;
}
DI void xcd_barrier(const XcdBarrier& b) {
    asm volatile("s_waitcnt vmcnt(0)" ::: "memory");
    __syncthreads();
    if (threadIdx.x == 0) {
        unsigned* bar = b.bar;
        __builtin_amdgcn_s_waitcnt(0);
        unsigned nloc = b.st[0], nx = b.st[1];
        if (nloc == 0u) { xcd_barrier_complete(bar, b.x, nloc, nx); b.st[0] = nloc; b.st[1] = nx; }
        const unsigned old = xb_add(&bar[XB_XSUB(b.x)], 1u);
        const unsigned gen = old / nloc;
        if (old + 1u == (gen + 1u) * nloc) {
            __builtin_amdgcn_fence(__ATOMIC_RELEASE, "agent");
            asm volatile("s_waitcnt vmcnt(0)" ::: "memory");
            const unsigned og = xb_add(&bar[XB_TOP], 1u);
            const unsigned tg = og / nx;
            if (og + 1u == (tg + 1u) * nx) xb_add(&bar[XB_TOPGEN], 1u);
            else XB_SPIN(xb_ld(&bar[XB_TOPGEN]) == tg, bar);
            __builtin_amdgcn_fence(__ATOMIC_ACQUIRE, "agent");
            xb_add(&bar[XB_XGEN(b.x)], 1u);
            asm volatile("s_waitcnt vmcnt(0)" ::: "memory");
        } else {
            XB_SPIN(xb_ld(&bar[XB_XGEN(b.x)]) == gen, bar);
            __builtin_amdgcn_fence(__ATOMIC_ACQUIRE, "agent");
            asm volatile("s_waitcnt vmcnt(0)" ::: "memory");
        }
    }
    __syncthreads();
}
DI void transpose_tile(const float* __restrict__ W, int K, int N, const float* __restrict__ g, bf16_t* __restrict__ Wt, int kt, int nt, char* lds, bool valid) {
    float* sm = (float*)lds;
    const int t = otid();
    const int k0 = kt * 64, n0 = nt * 64;
    __syncthreads();
#pragma unroll
    for (int i = 0; i < 16; ++i) {
        const int id = t + 256 * i, k = id >> 6, n = id & 63;
        float v = 0.f;
        if (valid && n0 + n < N) { v = W[(size_t)(k0 + k) * N + n0 + n]; if (g) v *= g[k0 + k]; }
        sm[k * 65 + n] = v;
    }
    __syncthreads();
    const int n = t >> 2, kc = (t & 3) * 16;
    u32x4 o0, o1;
    o0[0] = pack2(sm[(kc + 0) * 65 + n], sm[(kc + 1) * 65 + n]); o0[1] = pack2(sm[(kc + 2) * 65 + n], sm[(kc + 3) * 65 + n]);
    o0[2] = pack2(sm[(kc + 4) * 65 + n], sm[(kc + 5) * 65 + n]); o0[3] = pack2(sm[(kc + 6) * 65 + n], sm[(kc + 7) * 65 + n]);
    o1[0] = pack2(sm[(kc + 8) * 65 + n], sm[(kc + 9) * 65 + n]); o1[1] = pack2(sm[(kc + 10) * 65 + n], sm[(kc + 11) * 65 + n]);
    o1[2] = pack2(sm[(kc + 12) * 65 + n], sm[(kc + 13) * 65 + n]); o1[3] = pack2(sm[(kc + 14) * 65 + n], sm[(kc + 15) * 65 + n]);
    bf16_t* dst = Wt + (size_t)(n0 + n) * K + k0 + kc;
    if (valid) { *(u32x4*)dst = o0; *(u32x4*)(dst + 8) = o1; }
}

DI void rmsnorm_row_bf16(const float* __restrict__ in, const float* __restrict__ g, bf16_t* __restrict__ out, int lane) {
    f32x4 v[4]; float ss = 0.f;
#pragma unroll
    for (int i = 0; i < 4; ++i) { v[i] = *(const f32x4*)(in + 4 * lane + 256 * i); ss += v[i][0] * v[i][0] + v[i][1] * v[i][1] + v[i][2] * v[i][2] + v[i][3] * v[i][3]; }
#pragma unroll
    for (int o = 32; o; o >>= 1) ss += __shfl_xor(ss, o);
    const float rs = rsqrtf(ss * (1.0f / 1024.0f) + 1e-6f);
#pragma unroll
    for (int i = 0; i < 4; ++i) {
        const f32x4 gg = *(const f32x4*)(g + 4 * lane + 256 * i);
        u32x2 o; o[0] = pack2(v[i][0] * rs * gg[0], v[i][1] * rs * gg[1]); o[1] = pack2(v[i][2] * rs * gg[2], v[i][3] * rs * gg[3]);
        *(u32x2*)(out + 4 * lane + 256 * i) = o;
    }
}

struct TrJob { const float* W; const float* g; size_t off; int K, N, Npad; };

DI void phase_prep(const Params& p, char* lds) {
    char* ws = p.ws;
    const int t = otid(), lane = t & 63, wv = t >> 6;
    const int c0 = 576, c1 = c0 + 72, c2 = c1 + 64, c3 = c2 + 256, c4 = c3 + 256, c5 = c4 + 512, c6 = c5 + 256, c7 = c6 + 512;
    const int nrow = (T_TOK + 1024) / 4;
    const int nkeys = 128, nrope = 256;
    const int total = c7 + nrow + nkeys + nrope;
    for (int k = 0; k < (c7 + vgrid() - 1) / vgrid(); ++k) {
        const int raw = vbid() + k * vgrid();
        const bool valid = raw < c7;
        const int item = valid ? raw : 0;
        const float* W; const float* g; size_t off; int K, N, Npad, local;
        if (item < c0)      { W = p.w_in;     g = nullptr;      off = OFF_WT_IN;  K = 1024; N = 2208; Npad = 2304; local = item; }
        else if (item < c1) { W = p.w_uq;     g = p.q_norm;     off = OFF_WT_UQ;  K = 384;  N = 768;  Npad = 768;  local = item - c0; }
        else if (item < c2) { W = p.w_ukv;    g = p.kv_norm;    off = OFF_WT_UKV; K = 256;  N = 1024; Npad = 1024; local = item - c1; }
        else if (item < c3) { W = p.w_out;    g = nullptr;      off = OFF_WT_OUT; K = 1024; N = 1024; Npad = 1024; local = item - c2; }
        else if (item < c4) { W = p.w_mem_q;  g = p.norm_mem_q; off = OFF_WT_MQ;  K = 1024; N = 1024; Npad = 1024; local = item - c3; }
        else if (item < c5) { W = p.w_mem_kv; g = nullptr;      off = OFF_WT_MKV; K = 1024; N = 2048; Npad = 2048; local = item - c4; }
        else if (item < c6) { W = p.w_mem_o;  g = nullptr;      off = OFF_WT_MO;  K = 1024; N = 1024; Npad = 1024; local = item - c5; }
        else                { W = p.peer_w_q; g = p.norm_ffn;   off = OFF_WT_PQ;  K = 1024; N = 2048; Npad = 2048; local = item - c6; }
        const int ntn = Npad / 64;
        transpose_tile(W, K, N, g, (bf16_t*)(ws + off), local / ntn, local % ntn, lds, valid);
    }
    for (int item = c7 + vbid(); item < total; item += vgrid()) {
        if (item < c7 + nrow) {
            const int row = (item - c7) * 4 + wv;
            if (row < T_TOK) rmsnorm_row_bf16(p.x + (size_t)row * 1024, p.norm_mix, (bf16_t*)(ws + OFF_XN) + (size_t)row * 1024, lane);
            else rmsnorm_row_bf16(p.mem + (size_t)(row - T_TOK) * 1024, p.norm_mem_kv, (bf16_t*)(ws + OFF_MEMN) + (size_t)(row - T_TOK) * 1024, lane);
        } else if (item < c7 + nrow + nkeys) {
            const int idx = ((item - c7 - nrow) * 256 + t) * 8;
            const f32x4 a = *(const f32x4*)(p.sub_keys + idx), b = *(const f32x4*)(p.sub_keys + idx + 4);
            u32x4 o; o[0] = pack2(a[0], a[1]); o[1] = pack2(a[2], a[3]); o[2] = pack2(b[0], b[1]); o[3] = pack2(b[2], b[3]);
            *(u32x4*)((bf16_t*)(ws + OFF_KEYS) + idx) = o;
        } else {
            const int idx = (item - c7 - nrow - nkeys) * 256 + t;
            const int s = idx >> 4, i = idx & 15;
            const float ang = (float)s * p.inv_freq[i];
            const double a = (double)ang;
            const double twopi = 6.283185307179586476925;
            const float rf = (float)(a - twopi * rint(a / twopi));
            float* cs = (float*)(ws + OFF_ROPE);
            cs[idx] = cosf(rf); cs[65536 + idx] = sinf(rf);
        }
    }
}
namespace pg8 {
#define PG8_LAS __attribute__((address_space(3)))
typedef unsigned short bf16_t;
typedef short bf16x8 __attribute__((ext_vector_type(8)));
typedef float f32x4 __attribute__((ext_vector_type(4)));
typedef unsigned u32x4 __attribute__((ext_vector_type(4)));
constexpr int BM = 256, BK = 64, HALF = 128, HTB = HALF * BK * 2  , STAGE_BYTES = 8 * HTB, NXCD = 8, WGM = 8;

__host__ __device__ __forceinline__ int lds_byte(int r, int c) { const int st = (r >> 4) * 2 + (c >> 5), rr = r & 15, cc = c & 31, ob = rr * 64 + cc * 2; return st * 1024 + (ob ^ (((ob >> 9) & 1) << 5)); }
__host__ __device__ __forceinline__ void stage_rc(int b, int& R, int& C) { const int st = b / 1024, sb = b % 1024, swz = sb ^ (((sb >> 9) & 1) << 5); R = (st >> 1) * 16 + swz / 64; C = (st & 1) * 32 + (swz % 64) / 2; }
__host__ __device__ __forceinline__ int perm32(int rho) { const int n = rho >> 4, i = rho & 15; return 8 * (i >> 2) + 4 * n + (i & 3); }

struct Unit { int pm, pn; };
struct Gemm { const bf16_t* A; const bf16_t* Bt; int M, N, K, lda; };

struct StaticOrder {
    int nM, nN, nwg, G, c;
    __host__ __device__ void init(int M, int N, int G_, int c_) { nM = M / BM; nN = N / BM; nwg = nM * nN; G = G_; c = c_; }
    __host__ __device__ bool next(int i, Unit& u) const {
        const long L = (long)i * G + c; if (L >= nwg) return false;
        int wgid = (int)L; { const int q = nwg / NXCD, r = nwg % NXCD, xcd = wgid % NXCD, off = wgid / NXCD; wgid = (xcd < r ? xcd * (q + 1) : r * (q + 1) + (xcd - r) * q) + off; }
        const int nig = WGM * nN, gid = wgid / nig, fm = gid * WGM, gsz = (nM - fm) < WGM ? (nM - fm) : WGM;
        u.pm = fm + ((wgid % nig) % gsz); u.pn = (wgid % nig) / gsz; return true;
    }
    __device__ __forceinline__ void a_ready(const Unit&) const {}
    __device__ __forceinline__ void done(const Unit&) const {}
};

template <class Epi, class Sched, bool ALIGN_EPI = false, bool SP2 = false>
__device__ __forceinline__ void gemm_phase(PG8_LAS unsigned char* lds, const Gemm g, const Sched& S, const Epi& E) {
    int tid_ = threadIdx.x; asm volatile("" : "+v"(tid_));
    const int tid = tid_, wid = __builtin_amdgcn_readfirstlane(tid >> 6), lane = tid & 63, wr = wid >> 2, wc = wid & 3, fr = lane & 15, fq = lane >> 4;
    const int K = g.K, nt = K / BK, lda = g.lda;
    unsigned voffA[2], voffB[2];
#pragma unroll
    for (int i = 0; i < 2; ++i) { int R, C; stage_rc(tid * 16 + i * 8192, R, C); const int Rb = Epi::PERM ? ((R & ~31) + perm32(R & 31)) : R;
        voffA[i] = (unsigned)(R * lda + C) * 2u; voffB[i] = (unsigned)(Rb * K + C) * 2u; }
    const size_t kstep = (size_t)(BK * 2);
    const size_t hstepB = (size_t)HALF * K * 2, hstepA = (size_t)HALF * lda * 2;
    const size_t tstepB = 2 * hstepB, tstepA = 2 * hstepA;
    const unsigned ldsw = (unsigned)wid * 1024u;
    const int aoff = lds_byte(wr * 64 + fr, fq * 8), boff = lds_byte(wc * 32 + fr, fq * 8);
#define PG8_SA(b, h) (((b) * 2 + (h)) * HTB)
#define PG8_SB(b, h) ((4 + (b) * 2 + (h)) * HTB)
#define PG8_STAGE(bufoff, gbase, voff) do { _Pragma("unroll") for (int _i = 0; _i < 2; ++_i) \
        __builtin_amdgcn_global_load_lds((const unsigned*)((const char*)(gbase) + (voff)[_i]), (PG8_LAS unsigned*)(lds + (bufoff) + ldsw + _i * 8192), 16, 0, 0); } while (0)
#define PG8_LDA(dst, b, h) do { _Pragma("unroll") for (int m = 0; m < 4; ++m) _Pragma("unroll") for (int k = 0; k < 2; ++k) dst[m][k] = *(const PG8_LAS bf16x8*)(lds + PG8_SA(b, h) + aoff + m * 2048 + k * 1024); } while (0)
#define PG8_LDB(dst, b, h) do { _Pragma("unroll") for (int n = 0; n < 2; ++n) _Pragma("unroll") for (int k = 0; k < 2; ++k) dst[n][k] = *(const PG8_LAS bf16x8*)(lds + PG8_SB(b, h) + boff + n * 2048 + k * 1024); } while (0)
#define PG8_MMA(ai, bj, At, Bt) do { __builtin_amdgcn_s_setprio(1); _Pragma("unroll") for (int m = 0; m < 4; ++m) _Pragma("unroll") for (int n = 0; n < 2; ++n) _Pragma("unroll") for (int k = 0; k < 2; ++k) \
        acc[ai][bj][m][n] = __builtin_amdgcn_mfma_f32_16x16x32_bf16(Bt[n][k], At[m][k], acc[ai][bj][m][n], 0, 0, 0); __builtin_amdgcn_s_setprio(0); } while (0)
#define PG8_WAIT_V(n) asm volatile("s_waitcnt vmcnt(" #n ")" ::: "memory")
#define PG8_WAIT_L(n) asm volatile("s_waitcnt lgkmcnt(" #n ")" ::: "memory")
#define PG8_BAR __builtin_amdgcn_s_barrier()
#define PG8_SCHED __builtin_amdgcn_sched_barrier(0)
    Unit cur, nxt; int ui = 0;
    if (!S.next(0, cur)) return;
    f32x4 acc[2][2][4][2];
#pragma unroll
    for (int a = 0; a < 2; ++a)
#pragma unroll
        for (int b = 0; b < 2; ++b)
#pragma unroll
            for (int m = 0; m < 4; ++m)
#pragma unroll
                for (int n = 0; n < 2; ++n) acc[a][b][m][n] = (f32x4){0.f, 0.f, 0.f, 0.f};
    bf16x8 At[4][2], B0[2][2], B1[2][2];
    const char* cA = (const char*)g.A + (size_t)cur.pm * tstepA; const char* cB = (const char*)g.Bt + (size_t)cur.pn * tstepB;
    S.a_ready(cur);
    if constexpr (SP2) {
        PG8_STAGE(PG8_SB(0, 0), cB, voffB); PG8_STAGE(PG8_SB(0, 1), cB + hstepB, voffB); PG8_STAGE(PG8_SA(0, 0), cA, voffA); PG8_STAGE(PG8_SA(0, 1), cA + hstepA, voffA);
        if (wr == 1) PG8_BAR;
        PG8_WAIT_V(2); PG8_BAR;
        PG8_STAGE(PG8_SB(1, 0), cB + kstep, voffB); PG8_STAGE(PG8_SA(1, 0), cA + kstep, voffA); PG8_STAGE(PG8_SB(1, 1), cB + hstepB + kstep, voffB);
        PG8_WAIT_V(6); PG8_BAR;
    } else {
        PG8_STAGE(PG8_SB(0, 0), cB, voffB); PG8_STAGE(PG8_SA(0, 0), cA, voffA); PG8_STAGE(PG8_SB(0, 1), cB + hstepB, voffB); PG8_STAGE(PG8_SA(0, 1), cA + hstepA, voffA);
        if (wr == 1) PG8_BAR;
        PG8_WAIT_V(4); PG8_BAR;
        PG8_STAGE(PG8_SB(1, 0), cB + kstep, voffB); PG8_STAGE(PG8_SA(1, 0), cA + kstep, voffA); PG8_STAGE(PG8_SB(1, 1), cB + hstepB + kstep, voffB);
        PG8_WAIT_V(6); PG8_BAR;
    }
    for (;;) {
        const bool has_next = S.next(ui + 1, nxt);
        const char* nA = has_next ? (const char*)g.A + (size_t)nxt.pm * tstepA : cA; const char* nB = has_next ? (const char*)g.Bt + (size_t)nxt.pn * tstepB : cB;
#pragma unroll 1
        for (int t = 0; t < nt; t += 2) {
            const bool last = (t == nt - 2);
            const char* a1 = cA + (size_t)(t + 1) * kstep;
            const char* a2 = last ? nA : cA + (size_t)(t + 2) * kstep; const char* b2 = last ? nB : cB + (size_t)(t + 2) * kstep;
            const char* a3 = a2 + kstep; const char* b3 = b2 + kstep;
            if (last && has_next) S.a_ready(nxt);
            if constexpr (SP2) {
            PG8_LDB(B0, 0, 0); PG8_LDB(B1, 0, 1); PG8_SCHED; PG8_LDA(At, 0, 0); PG8_STAGE(PG8_SA(1, 1), a1 + hstepA, voffA);
            PG8_WAIT_V(8); PG8_WAIT_L(0); PG8_BAR; PG8_MMA(0, 0, At, B0); PG8_MMA(0, 1, At, B1); PG8_BAR; PG8_SCHED;
            PG8_LDA(At, 0, 1); PG8_STAGE(PG8_SB(0, 0), b2, voffB); PG8_STAGE(PG8_SB(0, 1), b2 + hstepB, voffB); PG8_STAGE(PG8_SA(0, 0), a2, voffA);
            PG8_WAIT_V(8); PG8_WAIT_L(0); PG8_BAR; PG8_MMA(1, 0, At, B0); PG8_MMA(1, 1, At, B1); PG8_BAR; PG8_SCHED;
            PG8_LDB(B0, 1, 0); PG8_LDB(B1, 1, 1); PG8_SCHED; PG8_LDA(At, 1, 0); PG8_STAGE(PG8_SA(0, 1), a2 + hstepA, voffA);
            PG8_WAIT_V(8); PG8_WAIT_L(0); PG8_BAR; PG8_MMA(0, 0, At, B0); PG8_MMA(0, 1, At, B1); PG8_BAR; PG8_SCHED;
            PG8_LDA(At, 1, 1); PG8_STAGE(PG8_SB(1, 0), b3, voffB); PG8_STAGE(PG8_SB(1, 1), b3 + hstepB, voffB); PG8_STAGE(PG8_SA(1, 0), a3, voffA);
            PG8_WAIT_V(8); PG8_WAIT_L(0); PG8_BAR; PG8_MMA(1, 0, At, B0); PG8_MMA(1, 1, At, B1); PG8_BAR; PG8_SCHED;
            } else {
            PG8_LDB(B0, 0, 0); PG8_SCHED; PG8_LDA(At, 0, 0); PG8_STAGE(PG8_SA(1, 1), a1 + hstepA, voffA);
            PG8_WAIT_L(8); PG8_BAR; PG8_WAIT_L(0); PG8_MMA(0, 0, At, B0); PG8_BAR; PG8_SCHED;
            PG8_LDB(B1, 0, 1); PG8_STAGE(PG8_SB(0, 0), b2, voffB);
            PG8_BAR; PG8_WAIT_L(0); PG8_MMA(0, 1, At, B1); PG8_BAR;
            PG8_LDA(At, 0, 1); PG8_STAGE(PG8_SA(0, 0), a2, voffA);
            PG8_BAR; PG8_WAIT_L(0); PG8_MMA(1, 0, At, B0); PG8_BAR; PG8_SCHED;
            PG8_STAGE(PG8_SB(0, 1), b2 + hstepB, voffB);
            PG8_WAIT_V(6); PG8_BAR; PG8_MMA(1, 1, At, B1); PG8_BAR;
            PG8_LDB(B0, 1, 0); PG8_SCHED; PG8_LDA(At, 1, 0); PG8_STAGE(PG8_SA(0, 1), a2 + hstepA, voffA);
            PG8_WAIT_L(8); PG8_BAR; PG8_WAIT_L(0); PG8_MMA(0, 0, At, B0); PG8_BAR; PG8_SCHED;
            PG8_LDB(B1, 1, 1); PG8_STAGE(PG8_SB(1, 0), b3, voffB);
            PG8_BAR; PG8_WAIT_L(0); PG8_MMA(0, 1, At, B1); PG8_BAR;
            PG8_LDA(At, 1, 1); PG8_STAGE(PG8_SA(1, 0), a3, voffA);
            PG8_BAR; PG8_WAIT_L(0); PG8_MMA(1, 0, At, B0); PG8_BAR; PG8_SCHED;
            PG8_STAGE(PG8_SB(1, 1), b3 + hstepB, voffB);
            PG8_WAIT_V(6); PG8_BAR; PG8_MMA(1, 1, At, B1); PG8_BAR;
            }
        }
        if constexpr (ALIGN_EPI) { if (wr == 0) PG8_BAR; }
        if constexpr (!Epi::AFTER_DRAIN) { E(acc, cur, wr, wc, fr, fq); S.done(cur); }
        if (!has_next) break;
#pragma unroll
        for (int a = 0; a < 2; ++a)
#pragma unroll
            for (int b = 0; b < 2; ++b)
#pragma unroll
                for (int m = 0; m < 4; ++m)
#pragma unroll
                    for (int n = 0; n < 2; ++n) acc[a][b][m][n] = (f32x4){0.f, 0.f, 0.f, 0.f};
        cur = nxt; cA = nA; cB = nB; ++ui;
        if constexpr (ALIGN_EPI) { if (wr == 1) PG8_BAR; }
    }
    PG8_WAIT_V(0);
    if constexpr (!ALIGN_EPI) { if (wr == 0) PG8_BAR; }
    PG8_BAR;
    if constexpr (Epi::AFTER_DRAIN) { E.fused(acc, cur, wr, wc, fr, fq, lds, wid, lane); S.done(cur); }
#undef PG8_SA
#undef PG8_SB
#undef PG8_STAGE
#undef PG8_LDA
#undef PG8_LDB
#undef PG8_MMA
#undef PG8_WAIT_V
#undef PG8_WAIT_L
#undef PG8_BAR
#undef PG8_SCHED
}
}
DI unsigned sw_off(int row, int chunk) { return (unsigned)(row * 128 + ((chunk ^ ((row >> 1) & 7)) << 4)); }
#define GLDS16(gsrc, ldst) __builtin_amdgcn_global_load_lds((const unsigned*)(gsrc), (unsigned*)(ldst), 16, 0, 0)
DI u32x2 pack4(float a, float b, float c, float d) { u32x2 o; o[0] = pack2(a, b); o[1] = pack2(c, d); return o; }
#define EPI_ARGS const f32x4 (&acc)[2][2][4][2], const pg8::Unit& u, int wr, int wc, int fr, int fq
DI float xq_sum(float v) {
    v += __uint_as_float((unsigned)__builtin_amdgcn_ds_swizzle((int)__float_as_uint(v), 0x401F));
    return xhalf_sum(v);
}
DI u32x4 pack8(const float (&v)[8], float sc) {
    u32x4 o; o[0] = pack2(v[0] * sc, v[1] * sc); o[1] = pack2(v[2] * sc, v[3] * sc); o[2] = pack2(v[4] * sc, v[5] * sc); o[3] = pack2(v[6] * sc, v[7] * sc); return o;
}
DI void rope8(const float (&v)[8], float sc, const float* __restrict__ cs, int pos, int fq, int lane, bf16_t* dst32  ) {
    const int i0 = 8 * (fq & 1);
    const f32x4 c0 = *(const f32x4*)(cs + pos * 16 + i0), c1 = *(const f32x4*)(cs + pos * 16 + i0 + 4);
    const f32x4 s0 = *(const f32x4*)(cs + 65536 + pos * 16 + i0), s1 = *(const f32x4*)(cs + 65536 + pos * 16 + i0 + 4);
    const float sg = (fq < 2) ? -1.0f : 1.0f;
    float o[8];
#pragma unroll
    for (int e = 0; e < 8; ++e) {
        const float own = v[e] * sc, oth = xhalf_other(own, lane);
        const float c = (e < 4) ? c0[e & 3] : c1[e & 3], s = (e < 4) ? s0[e & 3] : s1[e & 3];
        o[e] = own * c + sg * oth * s;
    }
    *(u32x4*)(dst32 + 8 * fq) = pack8(o, 1.0f);
}
#define EPI_LOAD8(v, ai, bj, m) float v[8]; { const f32x4 x0_ = acc[ai][bj][m][0], x1_ = acc[ai][bj][m][1]; v[0] = x0_[0]; v[1] = x0_[1]; v[2] = x0_[2]; v[3] = x0_[3]; v[4] = x1_[0]; v[5] = x1_[1]; v[6] = x1_[2]; v[7] = x1_[3]; }

struct EpiPlain8 {
    static constexpr bool PERM = true, AFTER_DRAIN = false;
    bf16_t* out; int ld;
    DI void operator()(EPI_ARGS) const {
#pragma unroll
        for (int ai = 0; ai < 2; ++ai)
#pragma unroll
            for (int m = 0; m < 4; ++m) {
                int fr_ = fr; asm volatile("" : "+v"(fr_));
                const size_t tok = (size_t)u.pm * 256 + ai * 128 + wr * 64 + m * 16 + fr_;
#pragma unroll
                for (int bj = 0; bj < 2; ++bj) { EPI_LOAD8(v, ai, bj, m); *(u32x4*)(out + tok * ld + u.pn * 256 + bj * 128 + wc * 32 + 8 * fq) = pack8(v, 1.0f); }
            }
    }
};

struct EpiProj8 {
    static constexpr bool PERM = true, AFTER_DRAIN = false;
    bf16_t* proj; bf16_t* kr; const float* cs; float* ssq;
    DI void operator()(EPI_ARGS) const {
        const int lane = fr + 16 * fq;
#pragma unroll
        for (int bj = 0; bj < 2; ++bj) {
            const int cg = u.pn * 256 + bj * 128 + wc * 32;
            if (cg >= INC) continue;
            const int g32 = cg >> 5;
            const float sc = (cg >= 672 && cg < 1184) ? 0.125f * LOG2E : 1.0f;
#pragma unroll
            for (int ai = 0; ai < 2; ++ai)
#pragma unroll
                for (int m = 0; m < 4; ++m) {
                    int fr_ = fr; asm volatile("" : "+v"(fr_));
                const size_t tok = (size_t)u.pm * 256 + ai * 128 + wr * 64 + m * 16 + fr_;
                    EPI_LOAD8(v, ai, bj, m);
                    if (g32 < 20) {
                        float ss = 0.f;
#pragma unroll
                        for (int e = 0; e < 8; ++e) ss += v[e] * v[e];
                        ss = xq_sum(ss);
                        if (fq == 0) ssq[tok * 24 + g32] = ss;
                    }
                    if (cg == 640) rope8(v, 1.0f, cs, (int)(tok & (SEQ_L - 1)), fq, lane, kr + tok * 32);
                    else *(u32x4*)(proj + tok * INC + cg + 8 * fq) = pack8(v, sc);
                }
        }
    }
};

struct EpiUpQ8 {
    static constexpr bool PERM = true, AFTER_DRAIN = false;
    bf16_t* q; const float* cs; const float* ssq;
    DI void operator()(EPI_ARGS) const {
        const int lane = fr + 16 * fq;
        const float qs = 0.10206207261596575f * LOG2E;
#pragma unroll
        for (int ai = 0; ai < 2; ++ai)
#pragma unroll
            for (int m = 0; m < 4; ++m) {
                int fr_ = fr; asm volatile("" : "+v"(fr_));
                const size_t tok = (size_t)u.pm * 256 + ai * 128 + wr * 64 + m * 16 + fr_;
                const f32x4 a0 = *(const f32x4*)(ssq + tok * 24), a1 = *(const f32x4*)(ssq + tok * 24 + 4), a2 = *(const f32x4*)(ssq + tok * 24 + 8);
                const float tot = (a0[0] + a0[1] + a0[2] + a0[3]) + (a1[0] + a1[1] + a1[2] + a1[3]) + (a2[0] + a2[1] + a2[2] + a2[3]);
                const float sc = rsqrtf(tot * (1.0f / 384.0f) + 1e-6f) * qs;
#pragma unroll
                for (int bj = 0; bj < 2; ++bj) {
                    const int cg = u.pn * 256 + bj * 128 + wc * 32;
                    EPI_LOAD8(v, ai, bj, m);
                    if ((cg % 96) == 64) rope8(v, sc, cs, (int)(tok & (SEQ_L - 1)), fq, lane, q + tok * 768 + cg);
                    else *(u32x4*)(q + tok * 768 + cg + 8 * fq) = pack8(v, sc);
                }
            }
    }
};

struct EpiUpKV8 {
    static constexpr bool PERM = true, AFTER_DRAIN = false;
    bf16_t* kv; const float* ssq;
    DI void operator()(EPI_ARGS) const {
#pragma unroll
        for (int ai = 0; ai < 2; ++ai)
#pragma unroll
            for (int m = 0; m < 4; ++m) {
                int fr_ = fr; asm volatile("" : "+v"(fr_));
                const size_t tok = (size_t)u.pm * 256 + ai * 128 + wr * 64 + m * 16 + fr_;
                const f32x4 a0 = *(const f32x4*)(ssq + tok * 24 + 12), a1 = *(const f32x4*)(ssq + tok * 24 + 16);
                const float tot = (a0[0] + a0[1] + a0[2] + a0[3]) + (a1[0] + a1[1] + a1[2] + a1[3]);
                const float sc = rsqrtf(tot * (1.0f / 256.0f) + 1e-6f);
#pragma unroll
                for (int bj = 0; bj < 2; ++bj) { EPI_LOAD8(v, ai, bj, m); *(u32x4*)(kv + tok * 1024 + u.pn * 256 + bj * 128 + wc * 32 + 8 * fq) = pack8(v, sc); }
            }
    }
};

template <bool RBF16>
struct EpiResid8 {
    static constexpr bool PERM = true, AFTER_DRAIN = false;
    const void* R; bf16_t* HB; float* SS;
    DI void operator()(EPI_ARGS) const {
#pragma unroll
        for (int ai = 0; ai < 2; ++ai) {
            f32x4 rv[4][2][2];
#pragma unroll
            for (int m = 0; m < 4; ++m)
#pragma unroll
                for (int bj = 0; bj < 2; ++bj) {
                    const size_t off = ((size_t)u.pm * 256 + ai * 128 + wr * 64 + m * 16 + fr) * 1024 + u.pn * 256 + bj * 128 + wc * 32 + 8 * fq;
                    if (RBF16) {
                        const u32x4 w = ldu4((const bf16_t*)R + off);
                        rv[m][bj][0] = (f32x4){bf_lo(w[0]), bf_hi(w[0]), bf_lo(w[1]), bf_hi(w[1])};
                        rv[m][bj][1] = (f32x4){bf_lo(w[2]), bf_hi(w[2]), bf_lo(w[3]), bf_hi(w[3])};
                    } else {
                        rv[m][bj][0] = *(const f32x4*)((const float*)R + off); rv[m][bj][1] = *(const f32x4*)((const float*)R + off + 4);
                    }
                }
#pragma unroll
            for (int m = 0; m < 4; ++m) {
                int fr_ = fr; asm volatile("" : "+v"(fr_));
                const size_t tok = (size_t)u.pm * 256 + ai * 128 + wr * 64 + m * 16 + fr_;
                float ss = 0.f;
#pragma unroll
                for (int bj = 0; bj < 2; ++bj) {
                    const size_t off = tok * 1024 + u.pn * 256 + bj * 128 + wc * 32 + 8 * fq;
                    const f32x4 h0 = rv[m][bj][0] + acc[ai][bj][m][0], h1 = rv[m][bj][1] + acc[ai][bj][m][1];
                    u32x4 o; o[0] = pack2(h0[0], h0[1]); o[1] = pack2(h0[2], h0[3]); o[2] = pack2(h1[0], h1[1]); o[3] = pack2(h1[2], h1[3]);
                    *(u32x4*)(HB + off) = o;
                    const float a0 = bf_lo(o[0]), a1 = bf_hi(o[0]), a2 = bf_lo(o[1]), a3 = bf_hi(o[1]), a4 = bf_lo(o[2]), a5 = bf_hi(o[2]), a6 = bf_lo(o[3]), a7 = bf_hi(o[3]);
                    ss += (a0 * a0 + a1 * a1) + (a2 * a2 + a3 * a3) + (a4 * a4 + a5 * a5) + (a6 * a6 + a7 * a7);
                }
                ss = xq_sum(ss);
                if (fq == 0) SS[tok * 16 + 4 * u.pn + wc] = ss;
            }
        }
    }
};

struct EpiRowScale8 {
    static constexpr bool PERM = true, AFTER_DRAIN = false;
    bf16_t* out; int ld; const float* SS; float extra;
    DI void operator()(EPI_ARGS) const {
#pragma unroll
        for (int ai = 0; ai < 2; ++ai)
#pragma unroll
            for (int m = 0; m < 4; ++m) {
                int fr_ = fr; asm volatile("" : "+v"(fr_));
                const size_t tok = (size_t)u.pm * 256 + ai * 128 + wr * 64 + m * 16 + fr_;
                const f32x4 s0 = *(const f32x4*)(SS + tok * 16), s1 = *(const f32x4*)(SS + tok * 16 + 4), s2 = *(const f32x4*)(SS + tok * 16 + 8), s3 = *(const f32x4*)(SS + tok * 16 + 12);
                const float tot = (s0[0] + s0[1] + s0[2] + s0[3]) + (s1[0] + s1[1] + s1[2] + s1[3]) + (s2[0] + s2[1] + s2[2] + s2[3]) + (s3[0] + s3[1] + s3[2] + s3[3]);
                const float sc = rsqrtf(tot * (1.0f / 1024.0f) + 1e-6f) * extra;
#pragma unroll
                for (int bj = 0; bj < 2; ++bj) { EPI_LOAD8(v, ai, bj, m); *(u32x4*)(out + tok * ld + u.pn * 256 + bj * 128 + wc * 32 + 8 * fq) = pack8(v, sc); }
            }
    }
};

template <class Epi>
DI void gemm8(char* smem, const bf16_t* A, int lda, const bf16_t* Bt, int M, int N, int K, const Epi& e, int cshift = 0) {
    pg8::Gemm g; g.A = A; g.Bt = Bt; g.M = M; g.N = N; g.K = K; g.lda = lda;
    const int G = (int)gridDim.x;
    pg8::StaticOrder S; S.init(M, N, G, ((int)blockIdx.x + G - cshift) % G);
    pg8::gemm_phase<Epi, pg8::StaticOrder, true, true>((PG8_LAS unsigned char*)smem, g, S, e);
}

DI void quant_rows4(const Params& p, int it, int wv, int lane);
DI void phase_p1(const Params& p, char* smem) {
    char* ws = p.ws;
    const int G = (int)gridDim.x, nproj = 9 * 64, nkvm = 8 * 4;
    const int last = nproj % G;
    { EpiProj8 e{(bf16_t*)(ws + OFF_PROJ), (bf16_t*)(ws + OFF_KR), (const float*)(ws + OFF_ROPE), (float*)(ws + OFF_SSQ)};
      gemm8(smem, (const bf16_t*)(ws + OFF_XN), 1024, (const bf16_t*)(ws + OFF_WT_IN), T_TOK, 2304, 1024, e); }
    { EpiPlain8 e{(bf16_t*)(ws + OFF_KVM), 2048};
      gemm8(smem, (const bf16_t*)(ws + OFF_MEMN), 1024, (const bf16_t*)(ws + OFF_WT_MKV), 1024, 2048, 1024, e, last); }
    int q0 = last + nkvm, nq = G - q0;
    if (last == 0 || nq <= 0) { q0 = 0; nq = G; }
    if ((int)blockIdx.x >= q0) {
        const int t = otid(), lane = t & 63, wv = t >> 6;
        for (int it = ((int)blockIdx.x - q0) * 2 + vhalf(); it < 8192; it += 2 * nq) quant_rows4(p, it, wv, lane);
    }
}
DI void phase_p2(const Params& p, char* smem) {
    char* ws = p.ws;
    { EpiUpQ8 e{(bf16_t*)(ws + OFF_QMLA), (const float*)(ws + OFF_ROPE), (const float*)(ws + OFF_SSQ)};
      gemm8(smem, (const bf16_t*)(ws + OFF_PROJ), INC, (const bf16_t*)(ws + OFF_WT_UQ), T_TOK, 768, 384, e); }
    { EpiUpKV8 e{(bf16_t*)(ws + OFF_KVMLA), (const float*)(ws + OFF_SSQ)};
      gemm8(smem, (const bf16_t*)(ws + OFF_PROJ) + 384, INC, (const bf16_t*)(ws + OFF_WT_UKV), T_TOK, 1024, 256, e); }
}
template <bool RBF16>
DI void phase_resid(const Params& p, char* smem, size_t off_w, size_t off_a, const void* R, size_t off_ss, bool dry = false) {
    char* ws = p.ws;
    EpiResid8<RBF16> e{R, (bf16_t*)(ws + OFF_HB), (float*)(ws + off_ss)};
    if (dry) { e.HB = (bf16_t*)(ws + OFF_B); e.SS = (float*)(ws + OFF_SS1); }
    gemm8(smem, (const bf16_t*)(ws + off_a), 1024, (const bf16_t*)(ws + off_w), T_TOK, 1024, 1024, e);
}
DI void phase_rowscale(const Params& p, char* smem, size_t off_w, int N, bf16_t* outp, size_t off_ss, float extra) {
    char* ws = p.ws;
    EpiRowScale8 e{outp, N, (const float*)(ws + off_ss), extra};
    gemm8(smem, (const bf16_t*)(ws + OFF_HB), 1024, (const bf16_t*)(ws + off_w), T_TOK, N, 1024, e);
}
DI unsigned v128_off(int row, int chunk) { return (unsigned)(row * 128 + ((chunk ^ (((row >> 1) & 1) << 2)) << 4)); }
DI unsigned v128_tr_addr(unsigned base, int R0, int c, int lane) {
    const int blk = (lane >> 4) & 1, qq = (lane & 15) >> 2, pp = lane & 3;
    return base + v128_off(R0 + qq, 4 * c + 2 * blk + (pp >> 1)) + 8 * (pp & 1);
}
DI bf16x8 cat44(s16x4 lo, s16x4 hi) { return __builtin_shufflevector(lo, hi, 0, 1, 2, 3, 4, 5, 6, 7); }

constexpr int MLA_STAGE = 64 * 192 + 64 * 128;
DI unsigned k192_off(int row, int chunk) { return (unsigned)(row * 192 + (((chunk & ~3) | ((chunk & 3) ^ ((row >> 2) & 3))) << 4)); }
DI void mla_unit(const Params& p, char* lds, int b, int h, int qt) {
    char* ws = p.ws;
    const int t = otid(), lane = t & 63, wv = t >> 6, r = lane & 31, hh = lane >> 5;
    const bf16_t* Q = (const bf16_t*)(ws + OFF_QMLA);
    const bf16_t* KV = (const bf16_t*)(ws + OFF_KVMLA);
    const bf16_t* KR = (const bf16_t*)(ws + OFF_KR);
    const int q0 = qt * 128 + 32 * wv;
    const size_t tokq = (size_t)b * SEQ_L + q0 + r;
    const size_t tokb = (size_t)b * SEQ_L;
    bf16x8 qf[6];
#pragma unroll
    for (int s = 0; s < 6; ++s) qf[s] = ld16(Q + tokq * 768 + h * 96 + 16 * s + 8 * hh);
    f32x16 o[2]; o[0] = zero16(); o[1] = zero16();
    float m = -INFINITY, l = 0.f;
    const bf16_t* ksrc[3]; int kadv[3]; const bf16_t* vsrc[2];
#pragma unroll
    for (int i = 0; i < 3; ++i) {
        const int o_ = 1024 * (wv + 4 * i) + 16 * lane, row = o_ / 192, pch = (o_ % 192) >> 4;
        const int c = (pch & ~3) | ((pch & 3) ^ ((row >> 2) & 3));
        if (c < 8) { ksrc[i] = KV + (tokb + row) * 1024 + h * 128 + 8 * c; kadv[i] = 64 * 1024; }
        else       { ksrc[i] = KR + (tokb + row) * 32 + 8 * (c - 8);       kadv[i] = 64 * 32; }
    }
#pragma unroll
    for (int i = 0; i < 2; ++i) {
        const int row = 8 * (wv + 4 * i) + (lane >> 3), pch = lane & 7;
        vsrc[i] = KV + (tokb + row) * 1024 + h * 128 + 64 + 8 * (pch ^ (((row >> 1) & 1) << 2));
    }
    char* ldst = lds + wv * 1024 + lane * 16;
    auto issue = [&](int kt) {
        char* d = ldst + (kt % 3) * MLA_STAGE;
#pragma unroll
        for (int i = 0; i < 3; ++i) GLDS16(ksrc[i] + (size_t)kt * kadv[i], d + i * 4096);
#pragma unroll
        for (int i = 0; i < 2; ++i) GLDS16(vsrc[i] + (size_t)kt * (64 * 1024), d + 12288 + i * 4096);
    };
    const int ntiles = 2 * qt + 2;
    const unsigned vlane0 = v128_tr_addr(0u, 4 * hh, 0, lane), vlane1 = v128_tr_addr(0u, 4 * hh, 1, lane);
    __syncthreads();
    issue(0); issue(1);
#pragma unroll
    for (int s = 0; s < 6; ++s) asm volatile("" :: "v"(qf[s]));
#pragma unroll 1
    for (int kt = 0; kt < ntiles; ++kt) {
        if (kt + 1 < ntiles) asm volatile("s_waitcnt vmcnt(5)\n\ts_barrier" ::: "memory");
        else asm volatile("s_waitcnt vmcnt(0)\n\ts_barrier" ::: "memory");
        if (kt + 2 < ntiles) issue(kt + 2);
        const char* sb = lds + (kt % 3) * MLA_STAGE;
        const unsigned vb = (unsigned)(uintptr_t)(sb + 12288);
        f32x16 s[2];
#pragma unroll
        for (int k2 = 0; k2 < 2; ++k2) {
            s[k2] = zero16();
#pragma unroll
            for (int ss = 0; ss < 6; ++ss) s[k2] = MFMA32(ld16(sb + k192_off(32 * k2 + r, 2 * ss + hh)), qf[ss], s[k2]);
        }
        s16x4 vt[2][2][2][2];
        {
            const unsigned a0 = vb + vlane0, a1 = vb + vlane1;
#define MLA_TR(K2, ST) vt[K2][ST][0][0] = tr_read_ao<(32 * K2 + 16 * ST) * 128>(a0); vt[K2][ST][0][1] = tr_read_ao<(32 * K2 + 16 * ST + 8) * 128>(a0); \
                       vt[K2][ST][1][0] = tr_read_ao<(32 * K2 + 16 * ST) * 128>(a1); vt[K2][ST][1][1] = tr_read_ao<(32 * K2 + 16 * ST + 8) * 128>(a1);
            MLA_TR(0, 0) MLA_TR(0, 1) MLA_TR(1, 0) MLA_TR(1, 1)
#undef MLA_TR
        }
        if (__builtin_amdgcn_readfirstlane(kt >= 2 * qt)) {
            asm volatile("");
            const int qpos = q0 + r;
#pragma unroll
            for (int k2 = 0; k2 < 2; ++k2)
#pragma unroll
                for (int i = 0; i < 16; ++i) { const int kpos = 64 * kt + 32 * k2 + crow(i, hh); if (kpos > qpos) s[k2][i] = -INFINITY; }
        }
        float mx = s[0][0];
#pragma unroll
        for (int k2 = 0; k2 < 2; ++k2)
#pragma unroll
            for (int i = 0; i < 16; ++i) mx = fmaxf(mx, s[k2][i]);
        mx = xhalf_max(mx);
        if (__any(mx > m + 8.0f)) {
            asm volatile("");
            const float mn = fmaxf(m, mx);
            const float alpha = fast_exp2(m - mn);
            l *= alpha;
            m = mn;
#pragma unroll
            for (int c = 0; c < 2; ++c)
#pragma unroll
                for (int i = 0; i < 16; ++i) o[c][i] *= alpha;
        }
        f32x2 ps2 = {0.f, 0.f};
        const f32x2 m2 = {m, m};
#pragma unroll
        for (int k2 = 0; k2 < 2; ++k2)
#pragma unroll
            for (int i = 0; i < 16; i += 2) {
                f32x2 x = {s[k2][i], s[k2][i + 1]};
                x = x - m2;
                f32x2 e; e[0] = fast_exp2(x[0]); e[1] = fast_exp2(x[1]);
                s[k2][i] = e[0]; s[k2][i + 1] = e[1];
                ps2 += e;
            }
        l += ps2[0] + ps2[1];
        TR_WAIT();
#pragma unroll
        for (int k2 = 0; k2 < 2; ++k2)
#pragma unroll
            for (int st = 0; st < 2; ++st) {
                const bf16x8 pb = pack_step(s[k2], st);
#pragma unroll
                for (int c = 0; c < 2; ++c) o[c] = MFMA32(cat44(vt[k2][st][c][0], vt[k2][st][c][1]), pb, o[c]);
            }
    }
    const float inv = 1.0f / xhalf_sum(l);
    bf16_t* dst = (bf16_t*)((char*)p.out + OUT_OMLA) + tokq * 512 + h * 64 + 4 * hh;
#pragma unroll
    for (int c = 0; c < 2; ++c)
#pragma unroll
        for (int g = 0; g < 4; ++g)
            *(u32x2*)(dst + 32 * c + 8 * g) = pack4(o[c][4 * g] * inv, o[c][4 * g + 1] * inv, o[c][4 * g + 2] * inv, o[c][4 * g + 3] * inv);
}

DI void dil_unit(const Params& p, char* lds, int g, int b, int h, int rr, int lb) {
    char* ws = p.ws;
    const int t = otid(), lane = t & 63, wv = t >> 6, r = lane & 31, hh = lane >> 5;
    const int d = (g == 0) ? 1 : (g == 1 ? 4 : 16);
    const bf16_t* PJ = (const bf16_t*)(ws + OFF_PROJ);
    const size_t tokb = (size_t)b * SEQ_L;
    char* kimg = lds;
    char* vimg = lds + 32768;
    __syncthreads();
    {
        const int c = t & 7;
#pragma unroll
        for (int half = 0; half < 2; ++half) {
            u32x4 kk[4], vv[4];
#pragma unroll
            for (int i = 0; i < 4; ++i) {
                const int key = (t >> 3) + 32 * (4 * half + i);
                const int lk = 128 * lb - 128 + key;
                if (lk >= 0) {
                    const size_t tk = tokb + (size_t)lk * d + rr;
                    kk[i] = ldu4(PJ + tk * INC + 1184 + h * 64 + 8 * c);
                    vv[i] = ldu4(PJ + tk * INC + 1696 + h * 64 + 8 * c);
                } else { kk[i] = (u32x4){0u, 0u, 0u, 0u}; vv[i] = (u32x4){0u, 0u, 0u, 0u}; }
            }
#pragma unroll
            for (int i = 0; i < 4; ++i) {
                const int key = (t >> 3) + 32 * (4 * half + i);
                *(u32x4*)(kimg + sw_off(key, c)) = kk[i];
                *(u32x4*)(vimg + v128_off(key, c)) = vv[i];
            }
        }
    }
    const int lq = 128 * lb + 32 * wv + r;
    const size_t tokq = tokb + (size_t)lq * d + rr;
    bf16x8 qf[4];
#pragma unroll
    for (int s = 0; s < 4; ++s) qf[s] = ld16(PJ + tokq * INC + 672 + h * 64 + 16 * s + 8 * hh);
    __syncthreads();
    const float slope2 = exp2f(-(float)(h + 1)) * (float)d * LOG2E;
    const int u0 = (lb == 0) ? (4 - wv) : 0;
    f32x16 o[2]; o[0] = zero16(); o[1] = zero16();
    float m = -INFINITY, lsum = 0.f;
    const unsigned vb = (unsigned)(uintptr_t)vimg;
    float cb[16];
#pragma unroll
    for (int i = 0; i < 16; ++i) cb[i] = slope2 * (float)crow(i, hh);
#pragma unroll 1
    for (int u = u0; u < 5; ++u) {
        const int rowb = 32 * (wv + u);
        f32x16 s = zero16();
#pragma unroll
        for (int ss = 0; ss < 4; ++ss) s = MFMA32(ld16(kimg + sw_off(rowb + r, 2 * ss + hh)), qf[ss], s);
        const int dbase = r + 128 - 32 * u;
        const float b0 = -slope2 * (float)dbase;
#pragma unroll
        for (int i = 0; i < 16; ++i) s[i] += cb[i];
        if (__builtin_amdgcn_readfirstlane(u == 0 || u == 4)) {
            asm volatile("");
#pragma unroll
            for (int i = 0; i < 16; ++i) { const int dist = dbase - crow(i, hh); if (dist < 0 || dist > 128) s[i] = -INFINITY; }
        }
        float mx = s[0];
#pragma unroll
        for (int i = 1; i < 16; ++i) mx = fmaxf(mx, s[i]);
        mx = xhalf_max(mx) + b0;
        if (__any(mx > m + 8.0f)) {
            asm volatile("");
            const float mn = fmaxf(m, mx);
            const float alpha = fast_exp2(m - mn);
            lsum *= alpha;
            m = mn;
#pragma unroll
            for (int c = 0; c < 2; ++c)
#pragma unroll
                for (int i = 0; i < 16; ++i) o[c][i] *= alpha;
        }
        f32x2 ps2 = {0.f, 0.f};
        const float mb = m - b0;
        const f32x2 m2 = {mb, mb};
#pragma unroll
        for (int i = 0; i < 16; i += 2) {
            f32x2 xx = {s[i], s[i + 1]};
            xx = xx - m2;
            f32x2 e; e[0] = fast_exp2(xx[0]); e[1] = fast_exp2(xx[1]);
            s[i] = e[0]; s[i + 1] = e[1];
            ps2 += e;
        }
        lsum += ps2[0] + ps2[1];
#pragma unroll
        for (int st = 0; st < 2; ++st) {
            const bf16x8 pb = pack_step(s, st);
#pragma unroll
            for (int c = 0; c < 2; ++c) {
                const s16x4 lo = tr_read(v128_tr_addr(vb, rowb + 16 * st + 4 * hh, c, lane));
                const s16x4 hi = tr_read(v128_tr_addr(vb, rowb + 16 * st + 8 + 4 * hh, c, lane));
                o[c] = MFMA32(cat44(lo, hi), pb, o[c]);
            }
        }
    }
    const float ltot = xhalf_sum(lsum);
    const float mx = m;
    const float inv = 1.0f / ltot;
    bf16_t* dst = (bf16_t*)((char*)p.out + OUT_ODIL) + ((size_t)g * T_TOK + tokq) * 512 + h * 64 + 4 * hh;
#pragma unroll
    for (int c = 0; c < 2; ++c)
#pragma unroll
        for (int gg = 0; gg < 4; ++gg)
            *(u32x2*)(dst + 32 * c + 8 * gg) = pack4(o[c][4 * gg] * inv, o[c][4 * gg + 1] * inv, o[c][4 * gg + 2] * inv, o[c][4 * gg + 3] * inv);
    if (hh == 0) ((float*)(ws + OFF_LSE))[((size_t)g * T_TOK + tokq) * 8 + h] = mx + __log2f(ltot);
}

DI void phase_p3(const Params& p, char* lds, int which = 3) {
    const int xg = (int)blockIdx.x & 7, nloc = (vgrid() >> 3), loc = ((int)blockIdx.x >> 3) * 2 + vhalf();
    if (which & 1) for (int i = loc; i < 64; i += nloc) {
        const int bh = xg * 4 + (i >> 4), pr = i & 15, b = bh >> 3, h = bh & 7;
#pragma unroll 1
        for (int rep = 0; rep < 2; ++rep) mla_unit(p, lds, b, h, rep ? pr : 31 - pr);
    }
    if (which & 2) for (int i = loc; i < 384; i += nloc) {
        const int bh = xg * 4 + i / 96, k96 = i % 96, g = k96 >> 5, k = k96 & 31, b = bh >> 3, h = bh & 7;
        int rr, lb;
        if (g == 0) { rr = 0; lb = k; } else if (g == 1) { rr = k >> 3; lb = k & 7; } else { rr = k >> 1; lb = k & 1; }
        dil_unit(p, lds, g, b, h, rr, lb);
    }
}

DI void quant_rows4(const Params& p, int it, int wv, int lane) {
    char* ws = p.ws;
    const int ncv = 4096;
    const bool isv = it >= ncv;
    const size_t row = (size_t)(isv ? it - ncv : it) * 4 + wv;
    const float* src = (isv ? p.peer_v : p.peer_u) + row * 1024 + 16 * lane;
    f32x4 v[4]; float am = 0.f;
#pragma unroll
    for (int i = 0; i < 4; ++i) { v[i] = *(const f32x4*)(src + 4 * i); am = fmaxf(am, fmaxf(fmaxf(fabsf(v[i][0]), fabsf(v[i][1])), fmaxf(fabsf(v[i][2]), fabsf(v[i][3])))); }
#pragma unroll
    for (int o = 32; o; o >>= 1) am = fmaxf(am, __shfl_xor(am, o));
    const float sc = (am > 0.f) ? am * (isv ? (1.0f / 384.0f) : (1.0f / 127.0f)) : 1.0f;
    const float inv = 1.0f / sc;
    u32x4 o;
#pragma unroll
    for (int i = 0; i < 4; ++i) {
        if (isv) {
            int w = 0;
            w = __builtin_amdgcn_cvt_pk_fp8_f32(v[i][0] * inv, v[i][1] * inv, w, false);
            w = __builtin_amdgcn_cvt_pk_fp8_f32(v[i][2] * inv, v[i][3] * inv, w, true);
            o[i] = (unsigned)w;
        } else {
            unsigned w = 0u;
#pragma unroll
            for (int e = 0; e < 4; ++e) { const int q = (int)rintf(v[i][e] * inv); w |= ((unsigned)q & 0xFFu) << (8 * e); }
            o[i] = w;
        }
    }
    *(u32x4*)(ws + OFF_UQ + row * 2048 + (isv ? 1024 : 0) + 16 * lane) = o;
    if (lane == 0) ((float*)(ws + (isv ? OFF_SV : OFF_SU)))[row] = sc;
}

DI void phase_p35(const Params& p, char* lds) {
    char* ws = p.ws;
    const int t = otid(), lane = t & 63, wv = t >> 6;
    const int ntok = T_TOK / 4;
    for (int item = vbid(); item < ntok; item += vgrid()) {
        {
            const size_t tok = (size_t)item * 4 + wv;
            const int head = lane >> 3;
            const float* LS = (const float*)(ws + OFF_LSE);
            const float l0 = LS[tok * 8 + head], l1 = LS[((size_t)T_TOK + tok) * 8 + head], l2 = LS[((size_t)2 * T_TOK + tok) * 8 + head];
            const float mx = fmaxf(l0, fmaxf(l1, l2));
            float w0 = fast_exp2(l0 - mx), w1 = fast_exp2(l1 - mx), w2 = fast_exp2(l2 - mx);
            const float wi = 1.0f / (w0 + w1 + w2);
            w0 *= wi; w1 *= wi; w2 *= wi;
            const bf16_t* OD = (const bf16_t*)((const char*)p.out + OUT_ODIL);
            const u32x4 a0 = ldu4(OD + tok * 512 + 8 * lane), a1 = ldu4(OD + ((size_t)T_TOK + tok) * 512 + 8 * lane),
                        a2 = ldu4(OD + ((size_t)2 * T_TOK + tok) * 512 + 8 * lane);
            const u32x4 am = ldu4((const bf16_t*)((const char*)p.out + OUT_OMLA) + tok * 512 + 8 * lane);
            float od[8], om[8]; float sd = 0.f, sm = 0.f;
#pragma unroll
            for (int e = 0; e < 4; ++e) {
                od[2 * e] = w0 * bf_lo(a0[e]) + w1 * bf_lo(a1[e]) + w2 * bf_lo(a2[e]);
                od[2 * e + 1] = w0 * bf_hi(a0[e]) + w1 * bf_hi(a1[e]) + w2 * bf_hi(a2[e]);
                om[2 * e] = bf_lo(am[e]); om[2 * e + 1] = bf_hi(am[e]);
                sd += od[2 * e] * od[2 * e] + od[2 * e + 1] * od[2 * e + 1];
                sm += om[2 * e] * om[2 * e] + om[2 * e + 1] * om[2 * e + 1];
            }
#pragma unroll
            for (int o = 32; o; o >>= 1) { sd += __shfl_xor(sd, o); sm += __shfl_xor(sm, o); }
            const float rd = rsqrtf(sd * (1.0f / 512.0f) + 1e-6f), rm = rsqrtf(sm * (1.0f / 512.0f) + 1e-6f);
            const f32x4 gm0 = *(const f32x4*)(p.gn_mla + 8 * lane), gm1 = *(const f32x4*)(p.gn_mla + 8 * lane + 4);
            const f32x4 gd0 = *(const f32x4*)(p.gn_dil + 8 * lane), gd1 = *(const f32x4*)(p.gn_dil + 8 * lane + 4);
            u32x4 o1, o2;
            o1[0] = pack2(om[0] * rm * gm0[0], om[1] * rm * gm0[1]); o1[1] = pack2(om[2] * rm * gm0[2], om[3] * rm * gm0[3]);
            o1[2] = pack2(om[4] * rm * gm1[0], om[5] * rm * gm1[1]); o1[3] = pack2(om[6] * rm * gm1[2], om[7] * rm * gm1[3]);
            o2[0] = pack2(od[0] * rd * gd0[0], od[1] * rd * gd0[1]); o2[1] = pack2(od[2] * rd * gd0[2], od[3] * rd * gd0[3]);
            o2[2] = pack2(od[4] * rd * gd1[0], od[5] * rd * gd1[1]); o2[3] = pack2(od[6] * rd * gd1[2], od[7] * rd * gd1[3]);
            bf16_t* MX = (bf16_t*)(ws + OFF_MIXED) + tok * 1024;
            *(u32x4*)(MX + 8 * lane) = o1;
            *(u32x4*)(MX + 512 + 8 * lane) = o2;
        }
    }
}

DI void memattn_unit(const Params& p, char* lds, int b, int h, int tt) {
    char* ws = p.ws;
    const int t = otid(), lane = t & 63, wv = t >> 6, r = lane & 31, hh = lane >> 5;
    const bf16_t* QM = (const bf16_t*)(ws + OFF_QM);
    const bf16_t* KVM = (const bf16_t*)(ws + OFF_KVM);
    const size_t tokq = (size_t)b * SEQ_L + tt * 128 + 32 * wv + r;
    const bf16_t* qrow = QM + tokq * 1024 + h * 256 + 8 * hh;
    const bf16_t* ksrc0; const bf16_t* vsrc0;
    {
        const int row = 8 * wv + (lane >> 3), pch = lane & 7;
        const size_t mrow = (size_t)b * 256 + row;
        ksrc0 = KVM + mrow * 2048 + h * 256 + 8 * (pch ^ ((row >> 1) & 7));
        vsrc0 = KVM + mrow * 2048 + 1024 + h * 256 + 8 * (pch ^ (((row >> 1) & 1) << 2));
    }
    char* ldst = lds + wv * 1024 + lane * 16;
#define MA_ISSUE(st_) do { char* d_ = ldst + ((st_) & 1) * 32768; \
        _Pragma("unroll") for (int i = 0; i < 8; ++i) GLDS16(((st_) < 4 ? ksrc0 : vsrc0) + (size_t)i * (32 * 2048) + 64 * ((st_) & 3), d_ + i * 4096); } while (0)
    f32x16 S[8];
#pragma unroll
    for (int kt = 0; kt < 8; ++kt) S[kt] = zero16();
    bf16x8 qa[4];
    __syncthreads();
    MA_ISSUE(0); MA_ISSUE(1);
#define MA_KSTAGE(c_, WAIT_) do { \
        asm volatile("s_waitcnt vmcnt(" #WAIT_ ")\n\ts_barrier" ::: "memory"); \
        _Pragma("unroll") for (int ss = 0; ss < 4; ++ss) qa[ss] = ld16(qrow + 64 * (c_) + 16 * ss); \
        { const char* sb_ = lds + ((c_) & 1) * 32768; \
          _Pragma("unroll") for (int kt = 0; kt < 8; ++kt) \
          _Pragma("unroll") for (int ss = 0; ss < 4; ++ss) S[kt] = MFMA32(ld16(sb_ + sw_off(32 * kt + r, 2 * ss + hh)), qa[ss], S[kt]); } \
        asm volatile("s_barrier" ::: "memory"); \
        MA_ISSUE((c_) + 2); } while (0)
    MA_KSTAGE(0, 8);
    MA_KSTAGE(1, 8);
    MA_KSTAGE(2, 8);
    MA_KSTAGE(3, 8);
    float mx = S[0][0];
#pragma unroll
    for (int kt = 0; kt < 8; ++kt)
#pragma unroll
        for (int i = 0; i < 16; ++i) mx = fmaxf(mx, S[kt][i]);
    mx = xhalf_max(mx);
    f32x2 ps2 = {0.f, 0.f};
    const f32x2 m2 = {mx, mx};
    bf16x8 pk[8][2];
#pragma unroll
    for (int kt = 0; kt < 8; ++kt) {
#pragma unroll
        for (int i = 0; i < 16; i += 2) {
            f32x2 xx = {S[kt][i], S[kt][i + 1]};
            xx = xx - m2;
            f32x2 e; e[0] = fast_exp2(xx[0]); e[1] = fast_exp2(xx[1]);
            S[kt][i] = e[0]; S[kt][i + 1] = e[1];
            ps2 += e;
        }
        pk[kt][0] = pack_step(S[kt], 0); pk[kt][1] = pack_step(S[kt], 1);
    }
    const float inv = 1.0f / xhalf_sum(ps2[0] + ps2[1]);
    bf16_t* dst = (bf16_t*)(ws + OFF_OM) + tokq * 1024 + h * 256 + 4 * hh;
    const unsigned vlane0 = v128_tr_addr(0u, 4 * hh, 0, lane), vlane1 = v128_tr_addr(0u, 4 * hh, 1, lane);
#define MA_PV(KT_, vb_) do { s16x4 vt_[2][2][2]; \
            vt_[0][0][0] = tr_read_ao<(32 * KT_) * 128>(vb_ + vlane0);          vt_[0][0][1] = tr_read_ao<(32 * KT_ + 8) * 128>(vb_ + vlane0); \
            vt_[0][1][0] = tr_read_ao<(32 * KT_) * 128>(vb_ + vlane1);          vt_[0][1][1] = tr_read_ao<(32 * KT_ + 8) * 128>(vb_ + vlane1); \
            vt_[1][0][0] = tr_read_ao<(32 * KT_ + 16) * 128>(vb_ + vlane0);     vt_[1][0][1] = tr_read_ao<(32 * KT_ + 24) * 128>(vb_ + vlane0); \
            vt_[1][1][0] = tr_read_ao<(32 * KT_ + 16) * 128>(vb_ + vlane1);     vt_[1][1][1] = tr_read_ao<(32 * KT_ + 24) * 128>(vb_ + vlane1); \
            TR_WAIT(); \
            _Pragma("unroll") for (int st = 0; st < 2; ++st) { \
                o0_ = MFMA32(cat44(vt_[st][0][0], vt_[st][0][1]), pk[KT_][st], o0_); \
                o1_ = MFMA32(cat44(vt_[st][1][0], vt_[st][1][1]), pk[KT_][st], o1_); } } while (0)
#define MA_VSTAGE(c_, WAIT_) do { \
        asm volatile("s_waitcnt vmcnt(" #WAIT_ ")\n\ts_barrier" ::: "memory"); \
        { const unsigned vb_ = (unsigned)(uintptr_t)(lds + ((c_) & 1) * 32768); \
          f32x16 o0_ = zero16(), o1_ = zero16(); \
          MA_PV(0, vb_); MA_PV(1, vb_); MA_PV(2, vb_); MA_PV(3, vb_); MA_PV(4, vb_); MA_PV(5, vb_); MA_PV(6, vb_); MA_PV(7, vb_); \
          _Pragma("unroll") for (int g = 0; g < 4; ++g) { \
              *(u32x2*)(dst + 64 * (c_) + 8 * g) = pack4(o0_[4 * g] * inv, o0_[4 * g + 1] * inv, o0_[4 * g + 2] * inv, o0_[4 * g + 3] * inv); \
              *(u32x2*)(dst + 64 * (c_) + 32 + 8 * g) = pack4(o1_[4 * g] * inv, o1_[4 * g + 1] * inv, o1_[4 * g + 2] * inv, o1_[4 * g + 3] * inv); } } \
        asm volatile("s_barrier" ::: "memory"); \
        if ((c_) + 2 < 4) MA_ISSUE(4 + (c_) + 2); } while (0)
    MA_VSTAGE(0, 8);
    MA_VSTAGE(1, 8);
    MA_VSTAGE(2, 8);
    MA_VSTAGE(3, 0);
#undef MA_ISSUE
#undef MA_KSTAGE
#undef MA_VSTAGE
#undef MA_PV
}

DI void phase_memattn(const Params& p, char* lds) {
    for (int item = vbid(); item < 512; item += vgrid()) {
        const int b = item >> 7, h = (item >> 5) & 3, tt = item & 31;
        memattn_unit(p, lds, b, h, tt);
    }
}
DI unsigned f2sort(float f) { const unsigned b = __float_as_uint(f); return b ^ ((b & 0x80000000u) ? 0xFFFFFFFFu : 0x80000000u); }
DI float sort2f(unsigned u) { const unsigned b = (u & 0x80000000u) ? (u ^ 0x80000000u) : ~u; return __uint_as_float(b); }
DI void cswap(unsigned& a, unsigned& b) { const unsigned hi = max(a, b), lo = min(a, b); a = hi; b = lo; }

template <int LO, int N> struct BClean {
    template <int M> static DI void run(unsigned (&a)[M]) {
#pragma unroll
        for (int i = 0; i < N / 2; ++i) cswap(a[LO + i], a[LO + i + N / 2]);
        BClean<LO, N / 2>::run(a); BClean<LO + N / 2, N / 2>::run(a);
    }
};
template <int LO> struct BClean<LO, 1> { template <int M> static DI void run(unsigned (&)[M]) {} };
template <int LO, int N> struct BSort {
    template <int M> static DI void run(unsigned (&a)[M]) {
        BSort<LO, N / 2>::run(a); BSort<LO + N / 2, N / 2>::run(a);
#pragma unroll
        for (int i = 0; i < N / 2; ++i) cswap(a[LO + i], a[LO + N - 1 - i]);
        BClean<LO, N / 2>::run(a); BClean<LO + N / 2, N / 2>::run(a);
    }
};
template <int LO> struct BSort<LO, 1> { template <int M> static DI void run(unsigned (&)[M]) {} };
DI void merge_top16(unsigned (&a)[16], const unsigned (&b)[16]) {
#pragma unroll
    for (int i = 0; i < 16; ++i) a[i] = max(a[i], b[15 - i]);
    BClean<0, 16>::run(a);
}

DI void peer_top16(const bf16_t* __restrict__ keys_hp, const bf16_t* __restrict__ pq_row_hp, int r, int hh, unsigned (&top)[16]) {
    bf16x8 qf[8];
#pragma unroll
    for (int s = 0; s < 8; ++s) qf[s] = ld16(pq_row_hp + 16 * s + 8 * hh);
    unsigned cur[16];
#pragma unroll
    for (int kt = 0; kt < 4; ++kt) {
        f32x16 acc = zero16();
#pragma unroll
        for (int s = 0; s < 8; ++s) acc = MFMA32(ld16(keys_hp + (size_t)(32 * kt + r) * 128 + 16 * s + 8 * hh), qf[s], acc);
        unsigned k[16];
#pragma unroll
        for (int i = 0; i < 16; ++i) k[i] = (f2sort(acc[i]) & ~0x7Fu) | (unsigned)(32 * kt + crow(i, hh));
        BSort<0, 16>::run(k);
        if (kt == 0) {
#pragma unroll
            for (int i = 0; i < 16; ++i) cur[i] = k[i];
        } else merge_top16(cur, k);
    }
    unsigned r0[16], r1[16];
#pragma unroll
    for (int i = 0; i < 16; ++i) { auto rr = __builtin_amdgcn_permlane32_swap(cur[i], cur[i], false, false); r0[i] = rr[0]; r1[i] = rr[1]; }
#pragma unroll
    for (int i = 0; i < 16; ++i) top[i] = max(r0[i], r1[15 - i]);
    BClean<0, 16>::run(top);
}

DI void peer_select_unit(const Params& p, char* lds, int mt, int h) {
    char* ws = p.ws;
    const int t = otid(), lane = t & 63, wv = t >> 6, r = lane & 31, hh = lane >> 5;
    const size_t tok = (size_t)mt * 128 + 32 * wv + r;
    const bf16_t* KEYS = (const bf16_t*)(ws + OFF_KEYS);
    const bf16_t* PQ = (const bf16_t*)((const char*)p.out + OUT_PQ);
    unsigned tA[16], tB[16];
    peer_top16(KEYS + (size_t)(2 * h) * 16384, PQ + tok * 2048 + (2 * h) * 128, r, hh, tA);
    peer_top16(KEYS + (size_t)(2 * h + 1) * 16384, PQ + tok * 2048 + (2 * h + 1) * 128, r, hh, tB);
    float fA[16], fB[16];
#pragma unroll
    for (int i = 0; i < 16; ++i) { fA[i] = sort2f(tA[i] & ~0x7Fu); fB[i] = sort2f(tB[i] & ~0x7Fu); }
    unsigned* tab = (unsigned*)lds + wv * 1024;
    __syncthreads();
#pragma unroll
    for (int i = 0; i < 16; ++i) tab[i * 64 + lane] = (tA[i] & 0x7Fu) | ((tB[i] & 0x7Fu) << 16);
    unsigned c[64];
#pragma unroll
    for (int i = 0; i < 64; ++i) c[i] = 0u;
    {
        int n = 0;
#pragma unroll
        for (int a = 0; a < 16; ++a)
#pragma unroll
            for (int b = 0; b < 16; ++b)
                if ((a + 1) * (b + 1) <= 16) { c[n] = (f2sort(fA[a] + fB[b]) & ~0xFFu) | (unsigned)(a * 16 + b); ++n; }
    }
    unsigned g0[16], g1[16], g2[16], g3[16];
#pragma unroll
    for (int i = 0; i < 16; ++i) { g0[i] = c[i]; g1[i] = c[16 + i]; g2[i] = c[32 + i]; g3[i] = c[48 + i]; }
    BSort<0, 16>::run(g0); BSort<0, 16>::run(g1); BSort<0, 16>::run(g2); BSort<0, 16>::run(g3);
    merge_top16(g0, g1); merge_top16(g2, g3); merge_top16(g0, g2);
    float e[16]; float sum = 0.f;
    const float v0 = sort2f(g0[0] & ~0xFFu);
    unsigned ids[16];
#pragma unroll
    for (int i = 0; i < 16; ++i) {
        const float v = sort2f(g0[i] & ~0xFFu);
        e[i] = fast_exp2((v - v0) * LOG2E); sum += e[i];
        const unsigned a = (g0[i] >> 4) & 15u, b = g0[i] & 15u;
        const unsigned ia = tab[a * 64 + lane] & 0x7Fu, ib = (tab[b * 64 + lane] >> 16) & 0x7Fu;
        ids[i] = ia * 128u + ib;
    }
    const float inv = 1.0f / sum;
    if (hh == 0) {
        unsigned short* SID = (unsigned short*)(ws + OFF_SELID) + tok * 128 + h * 16;
        float* SG = (float*)(ws + OFF_SELG) + tok * 128 + h * 16;
        u32x4 w0, w1;
        w0[0] = ids[0] | (ids[1] << 16); w0[1] = ids[2] | (ids[3] << 16); w0[2] = ids[4] | (ids[5] << 16); w0[3] = ids[6] | (ids[7] << 16);
        w1[0] = ids[8] | (ids[9] << 16); w1[1] = ids[10] | (ids[11] << 16); w1[2] = ids[12] | (ids[13] << 16); w1[3] = ids[14] | (ids[15] << 16);
        *(u32x4*)SID = w0; *(u32x4*)(SID + 8) = w1;
#pragma unroll
        for (int q = 0; q < 4; ++q) *(f32x4*)(SG + 4 * q) = (f32x4){e[4 * q] * inv, e[4 * q + 1] * inv, e[4 * q + 2] * inv, e[4 * q + 3] * inv};
    }
}

DI void phase_select(const Params& p, char* lds) {
    for (int item = vbid(); item < 1024; item += vgrid()) peer_select_unit(p, lds, item >> 3, item & 7);
}

DI float gelu_erf(float v) {
    const float av = fabsf(v), t = __builtin_amdgcn_rcpf(av * 0.2316418882f + 1.0f);
    float q = t * 0.5307027145f + (-0.7265760135f); q = q * t + 0.7107068705f; q = q * t + (-0.142248368f); q = q * t + 0.127414796f; q = q * t;
    const float e = __builtin_amdgcn_exp2f((v * v) * (-0.72134752044f));
    const float m = v * (q * e), r = v - m;
    return v < 0.f ? m : r;
}
DI int dppi(int v, const int ctrl) { return v; }
#define DPP_I(v, ctrl) __builtin_amdgcn_update_dpp(0, (v), (ctrl), 0xf, 0xf, true)
DI float ub0(unsigned w) { return (float)(w & 0xFFu); }
DI float ub1(unsigned w) { return (float)((w >> 8) & 0xFFu); }
DI float ub2(unsigned w) { return (float)((w >> 16) & 0xFFu); }
DI float ub3(unsigned w) { return (float)(w >> 24); }

struct GBatch { u32x4 U[4], V[4]; float su[4], sv[4], gate[4]; };

DI void gather_load(GBatch& B, const char* __restrict__ ws, unsigned idpair, f32x2 gpair, int eb, int lane) {
#pragma unroll
    for (int j = 0; j < 4; ++j) {
        const int e = eb + j;
        const unsigned pr = __shfl(idpair, e >> 1);
        const unsigned id = (j & 1) ? (pr >> 16) : (pr & 0xFFFFu);
        const float g0 = __shfl(gpair[0], e >> 1), g1 = __shfl(gpair[1], e >> 1);
        B.gate[j] = (j & 1) ? g1 : g0;
        B.U[j] = ldu4(ws + OFF_UQ + (size_t)id * 2048 + 16 * lane);
        B.V[j] = ldu4(ws + OFF_UQ + (size_t)id * 2048 + 1024 + 16 * lane);
        B.su[j] = ((const float*)(ws + OFF_SU))[id];
        B.sv[j] = ((const float*)(ws + OFF_SV))[id];
    }
}

DI void gather_compute(const GBatch& B, const unsigned (&qx)[4], float sx, float (&acc)[16], float& csum, int lane) {
    int pd[4];
#pragma unroll
    for (int j = 0; j < 4; ++j) {
        int d = 0;
#pragma unroll
        for (int q = 0; q < 4; ++q) d = __builtin_amdgcn_sdot4((int)B.U[j][q], (int)qx[q], d, false);
        pd[j] = d;
    }
    const bool b0 = lane & 1, b1 = lane & 2;
    const int kA = b0 ? pd[1] : pd[0], kB = b0 ? pd[3] : pd[2], sA = b0 ? pd[0] : pd[1], sB = b0 ? pd[2] : pd[3];
    const int qA = kA + DPP_I(sA, 0xB1), qB = kB + DPP_I(sB, 0xB1);
    const int kp = b1 ? qB : qA, sd = b1 ? qA : qB;
    int tot = kp + DPP_I(sd, 0x4E);
    tot += DPP_I(tot, 0x124);
    tot += DPP_I(tot, 0x128);
    tot += __builtin_amdgcn_ds_swizzle(tot, 0x401F);
    { auto rr = __builtin_amdgcn_permlane32_swap((unsigned)tot, (unsigned)tot, false, false); tot = (int)rr[0] + (int)rr[1]; }
    const int j3 = lane & 3;
    const float su_sel = (j3 == 0) ? B.su[0] : (j3 == 1 ? B.su[1] : (j3 == 2 ? B.su[2] : B.su[3]));
    const float ge = gelu_erf((float)tot * sx * su_sel);
#pragma unroll
    for (int j = 0; j < 4; ++j) {
        const float cf = B.gate[j] * B.sv[j] * __uint_as_float((unsigned)__builtin_amdgcn_readlane((int)__float_as_uint(ge), j));
#pragma unroll
        for (int q = 0; q < 4; ++q) {
            const int w = (int)B.V[j][q];
            const f32x2 lo = __builtin_amdgcn_cvt_pk_f32_fp8(w, false), hi = __builtin_amdgcn_cvt_pk_f32_fp8(w, true);
            acc[4 * q] += cf * lo[0]; acc[4 * q + 1] += cf * lo[1]; acc[4 * q + 2] += cf * hi[0]; acc[4 * q + 3] += cf * hi[1];
        }
    }
}

DI void gather_token(const Params& p, size_t tok, int lane, float* dst_base) {
    char* ws = p.ws;
    const bf16_t* hrow = (const bf16_t*)(ws + OFF_HB) + tok * 1024 + 16 * lane;
    float hv[16];
    {
        const u32x4 w0 = ldu4(hrow), w1 = ldu4(hrow + 8);
#pragma unroll
        for (int e = 0; e < 4; ++e) { hv[2 * e] = bf_lo(w0[e]); hv[2 * e + 1] = bf_hi(w0[e]); hv[8 + 2 * e] = bf_lo(w1[e]); hv[8 + 2 * e + 1] = bf_hi(w1[e]); }
    }
    float rs;
    {
        const float* SS = (const float*)(ws + OFF_SS2) + tok * 16;
        const f32x4 s0 = *(const f32x4*)SS, s1 = *(const f32x4*)(SS + 4), s2 = *(const f32x4*)(SS + 8), s3 = *(const f32x4*)(SS + 12);
        const float tot = (s0[0] + s0[1] + s0[2] + s0[3]) + (s1[0] + s1[1] + s1[2] + s1[3]) + (s2[0] + s2[1] + s2[2] + s2[3]) + (s3[0] + s3[1] + s3[2] + s3[3]);
        rs = rsqrtf(tot * (1.0f / 1024.0f) + 1e-6f);
    }
    float xf[16]; float am = 0.f;
#pragma unroll
    for (int i = 0; i < 4; ++i) {
        const f32x4 g = *(const f32x4*)(p.norm_ffn + 16 * lane + 4 * i);
#pragma unroll
        for (int e = 0; e < 4; ++e) { xf[4 * i + e] = hv[4 * i + e] * rs * g[e]; am = fmaxf(am, fabsf(xf[4 * i + e])); }
    }
#pragma unroll
    for (int o = 32; o; o >>= 1) am = fmaxf(am, __shfl_xor(am, o));
    const float sx = (am > 0.f) ? am * (1.0f / 127.0f) : 1.0f;
    const float isx = 1.0f / sx;
    unsigned qx[4];
#pragma unroll
    for (int i = 0; i < 4; ++i) {
        unsigned w = 0u;
#pragma unroll
        for (int e = 0; e < 4; ++e) w |= ((unsigned)(int)rintf(xf[4 * i + e] * isx) & 0xFFu) << (8 * e);
        qx[i] = w;
    }
    const unsigned idpair = *((const unsigned*)(ws + OFF_SELID) + tok * 64 + lane);
    const f32x2 gpair = *((const f32x2*)(ws + OFF_SELG) + tok * 64 + lane);
    float acc[16]; float csum = 0.f;
#pragma unroll
    for (int i = 0; i < 16; ++i) acc[i] = 0.f;
    GBatch B0, B1;
    gather_load(B0, ws, idpair, gpair, 0, lane);
#pragma unroll 1
    for (int eb = 0; eb < 128; eb += 8) {
        gather_load(B1, ws, idpair, gpair, eb + 4, lane);
        gather_compute(B0, qx, sx, acc, csum, lane);
        if (eb + 8 < 128) gather_load(B0, ws, idpair, gpair, eb + 8, lane);
        gather_compute(B1, qx, sx, acc, csum, lane);
    }
    float ss = 0.f;
#pragma unroll
    for (int i = 0; i < 16; ++i) { acc[i] = acc[i] - 128.0f * csum + hv[i]; ss += acc[i] * acc[i]; }
#pragma unroll
    for (int o = 32; o; o >>= 1) ss += __shfl_xor(ss, o);
    const float rf = rsqrtf(ss * (1.0f / 1024.0f) + 1e-6f);
    float* drow = dst_base + tok * 1024 + 16 * lane;
#pragma unroll
    for (int i = 0; i < 4; ++i) {
        const f32x4 n = *(const f32x4*)(p.norm_final + 16 * lane + 4 * i);
        *(f32x4*)(drow + 4 * i) = (f32x4){acc[4 * i] * rf * n[0], acc[4 * i + 1] * rf * n[1], acc[4 * i + 2] * rf * n[2], acc[4 * i + 3] * rf * n[3]};
    }
}

DI void phase_gather(const Params& p, bool dry = false) {
    const int lane = otid() & 63, wv = otid() >> 6;
    float* dst = dry ? (float*)(p.ws + OFF_A) : p.out;
    for (int item = vbid(); item < T_TOK / 4; item += vgrid()) gather_token(p, (size_t)item * 4 + wv, lane, dst);
}

constexpr size_t GS_PSTRIDE = 1040;
constexpr size_t GS_SGS = OFF_A;
constexpr size_t GS_XQ = GS_SGS + (size_t)T_TOK * GS_PSTRIDE;
constexpr size_t GS_ACC = GS_XQ + (size_t)T_TOK * 1024;
static_assert(GS_ACC <= OFF_A + 69 * MiB, "gather scratch overflows region A");

DI void gs_load(GBatch& B, const char* __restrict__ ws, unsigned myid, float mygate, int j0, int n, int lane) {
#pragma unroll
    for (int j = 0; j < 4; ++j) {
        const int e = __builtin_amdgcn_readfirstlane(j0 + j);
        const bool ok = e < n;
        const int src = ok ? e : 0;
        const unsigned id = (unsigned)__builtin_amdgcn_readlane((int)myid, src);
        const float g = __uint_as_float((unsigned)__builtin_amdgcn_readlane((int)__float_as_uint(mygate), src));
        B.gate[j] = ok ? g : 0.f;
        const char* urow = ws + OFF_UQ + (size_t)id * 2048;
        const char* vrow = urow + 1024;
        B.U[j] = ldu4(urow + 16 * lane);
        B.V[j] = ldu4(vrow + 16 * lane);
        B.su[j] = ((const float*)(ws + OFF_SU))[id];
        B.sv[j] = ((const float*)(ws + OFF_SV))[id];
    }
}

#ifndef GS_NSL
#define GS_NSL 16
#endif
constexpr int NSL = GS_NSL, NSL_SH = (GS_NSL == 8 ? 11 : (GS_NSL == 16 ? 10 : (GS_NSL == 32 ? 9 : 12))), OFFW = 64;
DI void phase_gather_sliced(const Params& p, char* smem) {
    char* ws = p.ws;
    if ((T_TOK / 8) > 8 * (((int)gridDim.x >> 3) * 8) || ((int)gridDim.x & 7)) { phase_gather(p); return; }
    const int wvi = __builtin_amdgcn_readfirstlane((int)(threadIdx.x >> 6));
    char* lacc = smem + wvi * 16384 + (threadIdx.x & 63) * 32;
    unsigned short* lids = (unsigned short*)(smem + 131072 + wvi * 2048);
    unsigned char* loff = (unsigned char*)(smem + 131072 + 16384 + wvi * (8 * OFFW));
    const int lane = threadIdx.x & 63;
    const int x = (int)blockIdx.x & 7, nW = ((int)gridDim.x >> 3) * 8, lw = ((int)blockIdx.x >> 3) * 8 + wvi;
    const int TPX = T_TOK / 8;
    for (int tl = lw; tl < TPX; tl += nW) {
        const size_t tok = (size_t)x * TPX + tl;
        const bf16_t* hrow = (const bf16_t*)(ws + OFF_HB) + tok * 1024 + 16 * lane;
        float hv[16];
        {
            const u32x4 w0 = ldu4(hrow), w1 = ldu4(hrow + 8);
#pragma unroll
            for (int e = 0; e < 4; ++e) { hv[2 * e] = bf_lo(w0[e]); hv[2 * e + 1] = bf_hi(w0[e]); hv[8 + 2 * e] = bf_lo(w1[e]); hv[8 + 2 * e + 1] = bf_hi(w1[e]); }
        }
        float rs;
        {
            const float* SS = (const float*)(ws + OFF_SS2) + tok * 16;
            const f32x4 s0 = *(const f32x4*)SS, s1 = *(const f32x4*)(SS + 4), s2 = *(const f32x4*)(SS + 8), s3 = *(const f32x4*)(SS + 12);
            const float tot = (s0[0] + s0[1] + s0[2] + s0[3]) + (s1[0] + s1[1] + s1[2] + s1[3]) + (s2[0] + s2[1] + s2[2] + s2[3]) + (s3[0] + s3[1] + s3[2] + s3[3]);
            rs = rsqrtf(tot * (1.0f / 1024.0f) + 1e-6f);
        }
        float xf[16]; float am = 0.f;
#pragma unroll
        for (int i = 0; i < 4; ++i) {
            const f32x4 g = *(const f32x4*)(p.norm_ffn + 16 * lane + 4 * i);
#pragma unroll
            for (int e = 0; e < 4; ++e) { xf[4 * i + e] = hv[4 * i + e] * rs * g[e]; am = fmaxf(am, fabsf(xf[4 * i + e])); }
        }
#pragma unroll
        for (int o = 32; o; o >>= 1) am = fmaxf(am, __shfl_xor(am, o));
        const float sx = (am > 0.f) ? am * (1.0f / 127.0f) : 1.0f;
        const float isx = 1.0f / sx;
        u32x4 qx;
#pragma unroll
        for (int i = 0; i < 4; ++i) {
            unsigned w = 0u;
#pragma unroll
            for (int e = 0; e < 4; ++e) w |= ((unsigned)(int)rintf(xf[4 * i + e] * isx) & 0xFFu) << (8 * e);
            qx[i] = w;
        }
        *(u32x4*)(ws + GS_XQ + tok * 1024 + 16 * lane) = qx;
        const unsigned idpair = *((const unsigned*)(ws + OFF_SELID) + tok * 64 + lane);
        const f32x2 gpair = *((const f32x2*)(ws + OFF_SELG) + tok * 64 + lane);
        const unsigned id0 = idpair & 0xFFFFu, id1 = idpair >> 16;
        const int sl0 = (int)(id0 >> NSL_SH), sl1 = (int)(id1 >> NSL_SH);
        const unsigned long long lt = (1ull << lane) - 1ull;
        int base = 0, pos0 = 0, pos1 = 0, myoff = 0;
#pragma unroll
        for (int s = 0; s < NSL; ++s) {
            const unsigned long long m0 = __ballot(sl0 == s), m1 = __ballot(sl1 == s);
            const int c0 = __popcll(m0), c1 = __popcll(m1);
            if (sl0 == s) pos0 = base + __popcll(m0 & lt);
            if (sl1 == s) pos1 = base + c0 + __popcll(m1 & lt);
            if (lane == s) myoff = base;
            base += c0 + c1;
        }
        if (lane == NSL) myoff = base;
        f32x2* sg = (f32x2*)(ws + GS_SGS + tok * GS_PSTRIDE);
        { const int k = (tl - lw) / nW; lids[k * 128 + pos0] = (unsigned short)id0; lids[k * 128 + pos1] = (unsigned short)id1; if (lane <= NSL) loff[k * OFFW + lane] = (unsigned char)myoff; }
        const float* SU = (const float*)(ws + OFF_SU); const float* SV = (const float*)(ws + OFF_SV);
        sg[pos0] = (f32x2){sx * SU[id0], gpair[0] * SV[id0]}; sg[pos1] = (f32x2){sx * SU[id1], gpair[1] * SV[id1]};
        if (lane == 0) sg[128] = (f32x2){0.f, 0.f};

    }
    __syncthreads();
    const int ntk = (TPX - lw + nW - 1) / nW;
    for (int k = 0; k < ntk; ++k) { *(u32x4*)(lacc + k * 2048) = (u32x4){0u, 0u, 0u, 0u}; *(u32x4*)(lacc + k * 2048 + 16) = (u32x4){0u, 0u, 0u, 0u}; }
    const char* tab = ws + OFF_UQ;
    u32x4 QX[8];
#pragma unroll
    for (int k = 0; k < 8; ++k) { const int kk = (k < ntk) ? k : 0; QX[k] = ldu4(ws + GS_XQ + ((size_t)x * TPX + lw + (size_t)kk * nW) * 1024 + 16 * lane); }
    asm volatile("" : "+v"(QX[0]), "+v"(QX[1]), "+v"(QX[2]), "+v"(QX[3]), "+v"(QX[4]), "+v"(QX[5]), "+v"(QX[6]), "+v"(QX[7]));
    const unsigned lane16 = 16u * (unsigned)lane;
    struct SB { u32x4 U[8], V[8]; f32x2 pr; int k, m; };
#pragma unroll 1
    for (int pass = 0; pass < NSL; ++pass) {
        const int slice = pass;
        int kL = 0, jL = 0, nL = 0, oL = 0;
        float acc[16]; int kC = -1; u32x4 qxC = QX[0];
#define GS_OPEN(k_) do { oL = __builtin_amdgcn_readfirstlane((int)loff[(k_) * OFFW + slice]); nL = __builtin_amdgcn_readfirstlane((int)loff[(k_) * OFFW + slice + 1]) - oL; jL = 0; } while (0)
#define GS_ADVANCE(ok_) do { if (jL + 8 < nL) { jL += 8; ok_ = true; } else if (kL + 1 >= ntk) ok_ = false; else { ++kL; GS_OPEN(kL); ok_ = true; } } while (0)
#define GS_LOAD(B_, valid_) do { const size_t tok_ = (size_t)x * TPX + lw + (size_t)kL * nW; \
            const int el_ = jL + (lane & 7); const bool okl_ = el_ < nL;            \
            const unsigned idv_ = (unsigned)lids[kL * 128 + ((oL + (okl_ ? el_ : 0)) & 127)]; \
            const unsigned pro_ = okl_ ? 8u * (unsigned)((oL + el_) & 127) : 1024u;            \
            const char* prb_ = ws + GS_SGS + tok_ * GS_PSTRIDE; \
            B_.m = (valid_) ? min(8, nL - jL) : 0; \
            asm volatile("global_load_dwordx2 %0, %1, %2" : "=v"(B_.pr) : "v"(pro_), "s"(prb_)); \
            _Pragma("unroll") for (int j = 0; j < 8; ++j) if (j < B_.m) { const unsigned id_ = (unsigned)__builtin_amdgcn_readlane((int)idv_, j); const char* rb_ = tab + (size_t)id_ * 2048; \
                asm volatile("global_load_dwordx4 %0, %1, %2" : "+v"(B_.U[j]) : "v"(lane16), "s"(rb_)); \
                asm volatile("global_load_dwordx4 %0, %1, %2 offset:1024" : "+v"(B_.V[j]) : "v"(lane16), "s"(rb_)); } \
            B_.k = (valid_) ? kL : -1; } while (0)
#define GS_WAITN(n_) asm volatile("s_waitcnt vmcnt(" #n_ ")" ::: "memory")
#define GS_WAIT(B_, mn_) do { const int mn__ = (mn_); \
            if (mn__ >= 8) GS_WAITN(17); else if (mn__ == 7) GS_WAITN(15); else if (mn__ == 6) GS_WAITN(13); else if (mn__ == 5) GS_WAITN(11); else if (mn__ == 4) GS_WAITN(9); \
            else if (mn__ == 3) GS_WAITN(7); else if (mn__ == 2) GS_WAITN(5); else if (mn__ == 1) GS_WAITN(3); else GS_WAITN(1); \
            asm volatile("" : "+v"(B_.U[0]), "+v"(B_.U[1]), "+v"(B_.U[2]), "+v"(B_.U[3]), "+v"(B_.U[4]), "+v"(B_.U[5]), "+v"(B_.U[6]), "+v"(B_.U[7]), "+v"(B_.pr) :: "memory"); \
            asm volatile("" : "+v"(B_.V[0]), "+v"(B_.V[1]), "+v"(B_.V[2]), "+v"(B_.V[3]), "+v"(B_.V[4]), "+v"(B_.V[5]), "+v"(B_.V[6]), "+v"(B_.V[7]) :: "memory"); } while (0)
#define GS_FLUSH() do { if (kC >= 0) { char* la_ = lacc + kC * 2048; u32x4 w0_, w1_; \
                _Pragma("unroll") for (int e = 0; e < 4; ++e) { w0_[e] = pack2(acc[2 * e], acc[2 * e + 1]); w1_[e] = pack2(acc[8 + 2 * e], acc[8 + 2 * e + 1]); } \
                *(u32x4*)la_ = w0_; *(u32x4*)(la_ + 16) = w1_; } } while (0)
#define GS_CONSUME(B_) do { if (B_.k >= 0) { \
            if (B_.k != kC) { GS_FLUSH(); kC = B_.k; qxC = QX[0]; _Pragma("unroll") for (int t_ = 1; t_ < 8; ++t_) if (kC == t_) qxC = QX[t_]; const char* la_ = lacc + kC * 2048; const u32x4 w0_ = *(const u32x4*)la_, w1_ = *(const u32x4*)(la_ + 16); \
                _Pragma("unroll") for (int e = 0; e < 4; ++e) { acc[2 * e] = bf_lo(w0_[e]); acc[2 * e + 1] = bf_hi(w0_[e]); acc[8 + 2 * e] = bf_lo(w1_[e]); acc[8 + 2 * e + 1] = bf_hi(w1_[e]); } } \
            int pd_[8]; \
            _Pragma("unroll") for (int j = 0; j < 8; ++j) { int d_ = 0; if (j < B_.m) { _Pragma("unroll") for (int q = 0; q < 4; ++q) d_ = __builtin_amdgcn_sdot4((int)B_.U[j][q], (int)qxC[q], d_, false); } pd_[j] = d_; } \
            const bool b0_ = lane & 1, b1_ = lane & 2, b2_ = lane & 4; \
            int q1_[4]; _Pragma("unroll") for (int j = 0; j < 4; ++j) { const int kp_ = b0_ ? pd_[2 * j + 1] : pd_[2 * j], sd_ = b0_ ? pd_[2 * j] : pd_[2 * j + 1]; q1_[j] = kp_ + DPP_I(sd_, 0xB1); }        \
            int q2_[2]; _Pragma("unroll") for (int j = 0; j < 2; ++j) { const int kp_ = b1_ ? q1_[2 * j + 1] : q1_[2 * j], sd_ = b1_ ? q1_[2 * j] : q1_[2 * j + 1]; q2_[j] = kp_ + DPP_I(sd_, 0x4E); }     \
            int tot_; { const int kp_ = b2_ ? q2_[1] : q2_[0], sd_ = b2_ ? q2_[0] : q2_[1]; tot_ = kp_ + __builtin_amdgcn_ds_swizzle(sd_, 0x101F); }                                                \
            tot_ += DPP_I(tot_, 0x128); tot_ += __builtin_amdgcn_ds_swizzle(tot_, 0x401F); \
            { auto rr_ = __builtin_amdgcn_permlane32_swap((unsigned)tot_, (unsigned)tot_, false, false); tot_ = (int)rr_[0] + (int)rr_[1]; } \
            const float cfv_ = B_.pr[1] * gelu_erf((float)tot_ * B_.pr[0]); \
            _Pragma("unroll") for (int j = 0; j < 8; ++j) if (j < B_.m) { const float cf_ = __uint_as_float((unsigned)__builtin_amdgcn_readlane((int)__float_as_uint(cfv_), j)); \
                _Pragma("unroll") for (int q = 0; q < 4; ++q) { const int w_ = (int)B_.V[j][q]; const f32x2 lo_ = __builtin_amdgcn_cvt_pk_f32_fp8(w_, false), hi_ = __builtin_amdgcn_cvt_pk_f32_fp8(w_, true); \
                    acc[4 * q] += cf_ * lo_[0]; acc[4 * q + 1] += cf_ * lo_[1]; acc[4 * q + 2] += cf_ * hi_[0]; acc[4 * q + 3] += cf_ * hi_[1]; } } } } while (0)
        SB S0, S1;
        _Pragma("unroll") for (int j = 0; j < 8; ++j) { S0.U[j] = S0.V[j] = S1.U[j] = S1.V[j] = (u32x4){0u, 0u, 0u, 0u}; }
        bool h0, h1;
        GS_OPEN(0);
        GS_LOAD(S0, true);
#pragma unroll 1
        for (;;) {
            GS_ADVANCE(h1); GS_LOAD(S1, h1);
            GS_WAIT(S0, S1.m); GS_CONSUME(S0);
            if (!h1) break;
            GS_ADVANCE(h0); GS_LOAD(S0, h0);
            GS_WAIT(S1, S0.m); GS_CONSUME(S1);
            if (!h0) break;
        }
        asm volatile("s_waitcnt vmcnt(0)" ::: "memory");
        GS_FLUSH();
#undef GS_OPEN
#undef GS_ADVANCE
#undef GS_LOAD
#undef GS_FLUSH
#undef GS_CONSUME
#undef GS_WAIT
#undef GS_WAITN
    }
    for (int k = 0; k < ntk; ++k) {
        const size_t tok = (size_t)x * TPX + lw + (size_t)k * nW;
        const char* la = lacc + k * 2048; const u32x4 a0 = *(const u32x4*)la, a1 = *(const u32x4*)(la + 16);
        const bf16_t* hrow = (const bf16_t*)(ws + OFF_HB) + tok * 1024 + 16 * lane; const u32x4 w0 = ldu4(hrow), w1 = ldu4(hrow + 8);
        float acc[16]; float ss = 0.f;
#pragma unroll
        for (int e = 0; e < 4; ++e) { acc[2 * e] = bf_lo(a0[e]) + bf_lo(w0[e]); acc[2 * e + 1] = bf_hi(a0[e]) + bf_hi(w0[e]); acc[8 + 2 * e] = bf_lo(a1[e]) + bf_lo(w1[e]); acc[8 + 2 * e + 1] = bf_hi(a1[e]) + bf_hi(w1[e]); }
#pragma unroll
        for (int i = 0; i < 16; ++i) ss += acc[i] * acc[i];
#pragma unroll
        for (int o = 32; o; o >>= 1) ss += __shfl_xor(ss, o);
        const float rf = rsqrtf(ss * (1.0f / 1024.0f) + 1e-6f); float* drow = p.out + tok * 1024 + 16 * lane;
#pragma unroll
        for (int i = 0; i < 4; ++i) { const f32x4 nn = *(const f32x4*)(p.norm_final + 16 * lane + 4 * i);
            *(f32x4*)(drow + 4 * i) = (f32x4){acc[4 * i] * rf * nn[0], acc[4 * i + 1] * rf * nn[1], acc[4 * i + 2] * rf * nn[2], acc[4 * i + 3] * rf * nn[3]}; }
    }
}
constexpr int LDS_BYTES = 131072 + 16384 + 4096;
constexpr int NPHASE = 12;
template <int PH> DI void run_phase(const Params& p, char* smem) {
    char* lds = smem + vhalf() * 65536;
    if (PH == 0) phase_prep(p, lds);
    else if (PH == 1) phase_p1(p, smem);
    else if (PH == 2) phase_p2(p, smem);
    else if (PH == 3) phase_p3(p, lds);
    else if (PH == 4) phase_p35(p, lds);
    else if (PH == 5) phase_resid<false>(p, smem, OFF_WT_OUT, OFF_MIXED, p.x, OFF_SS1);
    else if (PH == 6) phase_rowscale(p, smem, OFF_WT_MQ, 1024, (bf16_t*)(p.ws + OFF_QM), OFF_SS1, 0.0625f * LOG2E);
    else if (PH == 7) phase_memattn(p, lds);
    else if (PH == 8) phase_resid<true>(p, smem, OFF_WT_MO, OFF_OM, p.ws + OFF_HB, OFF_SS2);
    else if (PH == 9) phase_rowscale(p, smem, OFF_WT_PQ, 2048, (bf16_t*)((char*)p.out + OUT_PQ), OFF_SS2, 1.0f);
    else if (PH == 10) phase_select(p, lds);
    else if (PH == 11) phase_gather_sliced(p, smem);
}

template <int PH> __global__ void __launch_bounds__(512, 2) k_phase(Params p) {
    __shared__ __attribute__((aligned(16))) char smem[LDS_BYTES];
    run_phase<PH>(p, smem);
}

static Params make_params(void* const* d_in, void* d_out, void* d_ws) {
    Params p;
    memset(&p, 0, sizeof(p));
    p.x = (const float*)d_in[0]; p.mem = (const float*)d_in[1]; p.norm_mix = (const float*)d_in[2]; p.w_in = (const float*)d_in[3];
    p.q_norm = (const float*)d_in[4]; p.kv_norm = (const float*)d_in[5]; p.w_uq = (const float*)d_in[6]; p.w_ukv = (const float*)d_in[7];
    p.gn_mla = (const float*)d_in[8]; p.gn_dil = (const float*)d_in[9]; p.w_out = (const float*)d_in[10]; p.norm_mem_q = (const float*)d_in[11];
    p.norm_mem_kv = (const float*)d_in[12]; p.w_mem_q = (const float*)d_in[13]; p.w_mem_kv = (const float*)d_in[14]; p.w_mem_o = (const float*)d_in[15];
    p.norm_ffn = (const float*)d_in[16]; p.peer_w_q = (const float*)d_in[17]; p.sub_keys = (const float*)d_in[18]; p.peer_u = (const float*)d_in[19];
    p.peer_v = (const float*)d_in[20]; p.norm_final = (const float*)d_in[21];
    p.out = (float*)d_out; p.ws = (char*)d_ws;
    for (int i = 0; i < 16; ++i) p.inv_freq[i] = 1.0f / powf(10000.0f, (float)(2 * i) / 32.0f);
    return p;
}
__global__ void __launch_bounds__(512, 2) k_mega(Params p) {
    __shared__ __attribute__((aligned(16))) char smem[LDS_BYTES + 16];
    volatile LAS unsigned* st = (volatile LAS unsigned*)(LAS char*)(smem + LDS_BYTES);
    if (threadIdx.x == 0) { st[0] = 0u; st[1] = 0u; st[2] = 0u; st[3] = 0u; }
    __syncthreads();
    const XcdBarrier xb = xcd_barrier_post((unsigned*)(p.ws + OFF_BAR), st);
#define RP(n) run_phase<n>(p, smem); xcd_barrier(xb);
    RP(0) RP(1) RP(2) RP(3) RP(4) RP(5) RP(6) RP(7) RP(8) RP(9) RP(10)
    run_phase<11>(p, smem);
}

extern "C" void kernel_launch(void* const* d_in, const int* in_sizes, int n_in, void* d_out, int out_size, void* d_ws, size_t ws_size,
                              hipStream_t stream) {
    static int grid_blocks = 0;
    if (!grid_blocks) {
        int dev = 0, cus = 0, per_cu = 0;
        (void)hipGetDevice(&dev);
        (void)hipDeviceGetAttribute(&cus, hipDeviceAttributeMultiprocessorCount, dev);
        (void)hipOccupancyMaxActiveBlocksPerMultiprocessor(&per_cu, k_mega, 512, 0);
        if (per_cu > 1) per_cu = 1;
        if (per_cu < 1) per_cu = 1;
        grid_blocks = cus * per_cu;
    }
    Params p = make_params(d_in, d_out, d_ws);
    (void)hipMemsetAsync((char*)d_ws + OFF_BAR, 0, XCD_BAR_WORDS * 4, stream);
    void* args[] = {&p};
    hipError_t e = hipLaunchCooperativeKernel((const void*)k_mega, dim3(grid_blocks), dim3(512), args, 0, stream);
    if (e != hipSuccess) fprintf(stderr, "cooperative launch failed: %s (grid %d)\n", hipGetErrorString(e), grid_blocks);
}
```

```cpp
#include <hip/hip_runtime.h>
#include <hip/hip_cooperative_groups.h>
#include <math.h>
#include <stdint.h>
#include <stdio.h>
#include <string.h>
#define DI __device__ __forceinline__
typedef unsigned short bf16_t;
typedef short bf16x8 __attribute__((ext_vector_type(8)));
typedef short s16x4 __attribute__((ext_vector_type(4)));
typedef float f32x16 __attribute__((ext_vector_type(16)));
typedef float f32x4 __attribute__((ext_vector_type(4)));
typedef float f32x2 __attribute__((ext_vector_type(2)));
typedef unsigned u32x4 __attribute__((ext_vector_type(4)));
typedef unsigned u32x2 __attribute__((ext_vector_type(2)));
typedef __bf16 bf16x2v __attribute__((ext_vector_type(2)));
#define LAS __attribute__((address_space(3)))
#define MFMA32(a, b, c) __builtin_amdgcn_mfma_f32_32x32x16_bf16((a), (b), (c), 0, 0, 0)

constexpr int T_TOK = 16384, SEQ_L = 4096, DM = 1024, INC = 2208;
constexpr float LOG2E = 1.4426950408889634f;

DI int otid() { int t = threadIdx.x & 255; asm volatile("" : "+v"(t)); return t; }
DI int vhalf() { return __builtin_amdgcn_readfirstlane((int)(threadIdx.x >> 8)); }
DI int vbid() { return (int)blockIdx.x * 2 + vhalf(); }
DI int vgrid() { return (int)gridDim.x * 2; }
DI unsigned pack2(float lo, float hi) { f32x2 f = {lo, hi}; return __builtin_bit_cast(unsigned, __builtin_convertvector(f, bf16x2v)); }
DI float bf_lo(unsigned u) { return __uint_as_float(u << 16); }
DI float bf_hi(unsigned u) { return __uint_as_float(u & 0xffff0000u); }
DI float bf2f(bf16_t v) { return __uint_as_float(((unsigned)v) << 16); }
DI int crow(int reg, int hh) { return (reg & 3) + 8 * (reg >> 2) + 4 * hh; }
DI f32x16 zero16() { f32x16 z;
#pragma unroll
    for (int i = 0; i < 16; ++i) z[i] = 0.f; return z; }
DI float xhalf_max(float v) { auto r = __builtin_amdgcn_permlane32_swap(__float_as_uint(v), __float_as_uint(v), false, false); return fmaxf(__uint_as_float(r[0]), __uint_as_float(r[1])); }
DI float xhalf_other(float v, int lane) { auto r = __builtin_amdgcn_permlane32_swap(__float_as_uint(v), __float_as_uint(v), false, false); return __uint_as_float((lane & 32) ? r[0] : r[1]); }
DI float xhalf_sum(float v) { auto r = __builtin_amdgcn_permlane32_swap(__float_as_uint(v), __float_as_uint(v), false, false); return __uint_as_float(r[0]) + __uint_as_float(r[1]); }
DI bf16x8 ld16(const void* p) { return *(const bf16x8*)p; }
DI u32x4 ldu4(const void* p) { return *(const u32x4*)p; }
DI float fast_exp2(float x) { return __builtin_amdgcn_exp2f(x); }
DI bf16x8 pack_step(const f32x16& x, int s) {
    u32x4 p;
    p[0] = pack2(x[8 * s + 0], x[8 * s + 1]); p[1] = pack2(x[8 * s + 2], x[8 * s + 3]);
    p[2] = pack2(x[8 * s + 4], x[8 * s + 5]); p[3] = pack2(x[8 * s + 6], x[8 * s + 7]);
    return __builtin_bit_cast(bf16x8, p);
}
DI s16x4 tr_read_a(unsigned lds_byte_addr) { s16x4 r; asm volatile("ds_read_b64_tr_b16 %0, %1" : "=v"(r) : "v"(lds_byte_addr)); return r; }
template <int OFF> DI s16x4 tr_read_ao(unsigned lds_byte_addr) { s16x4 r; asm volatile("ds_read_b64_tr_b16 %0, %1 offset:%2" : "=v"(r) : "v"(lds_byte_addr), "i"(OFF)); return r; }
#define TR_WAIT() do { asm volatile("s_waitcnt lgkmcnt(0)" ::: "memory"); __builtin_amdgcn_sched_barrier(0); } while (0)
DI s16x4 tr_read(unsigned lds_byte_addr) {
    return __builtin_amdgcn_ds_read_tr16_b64_v4i16((LAS s16x4*)(uintptr_t)lds_byte_addr);
}

constexpr size_t MiB = 1ull << 20;
constexpr size_t OFF_BAR = 0;
constexpr size_t OFF_WT_IN = 65536;
constexpr size_t OFF_WT_UQ = OFF_WT_IN + 2304ull * 1024 * 2;
constexpr size_t OFF_WT_UKV = OFF_WT_UQ + 768ull * 384 * 2;
constexpr size_t OFF_WT_OUT = OFF_WT_UKV + 1024ull * 256 * 2;
constexpr size_t OFF_WT_MQ = OFF_WT_OUT + 1024ull * 1024 * 2;
constexpr size_t OFF_WT_MKV = OFF_WT_MQ + 1024ull * 1024 * 2;
constexpr size_t OFF_WT_MO = OFF_WT_MKV + 2048ull * 1024 * 2;
constexpr size_t OFF_WT_PQ = OFF_WT_MO + 1024ull * 1024 * 2;
constexpr size_t OFF_KEYS = OFF_WT_PQ + 2048ull * 1024 * 2;
constexpr size_t OFF_ROPE = OFF_KEYS + 16ull * 128 * 128 * 2;
constexpr size_t OFF_KR = OFF_ROPE + 2ull * 4096 * 16 * 4;
constexpr size_t OFF_LSE = OFF_KR + (size_t)T_TOK * 32 * 2;
constexpr size_t OFF_SS1 = OFF_LSE + 3ull * T_TOK * 8 * 4;
constexpr size_t OFF_SS2 = OFF_SS1 + (size_t)T_TOK * 16 * 4;
constexpr size_t OFF_MEMN = OFF_SS2 + (size_t)T_TOK * 16 * 4;
constexpr size_t OFF_SMALL_END = OFF_MEMN + 1024ull * 1024 * 2;
static_assert(OFF_SMALL_END <= 28 * MiB, "small region overflow");
constexpr size_t OFF_A = 28 * MiB;
constexpr size_t OFF_PROJ = OFF_A;
constexpr size_t OFF_UQ = 193 * MiB;
constexpr size_t OFF_SU = 243 * MiB;
constexpr size_t OFF_SV = OFF_SU + 65536;
constexpr size_t OUT_ODIL = 0;
constexpr size_t OUT_OMLA = 48 * MiB;
constexpr size_t OUT_PQ = 0;
constexpr size_t OFF_B = 97 * MiB;
constexpr size_t OFF_XN = OFF_B, OFF_QMLA = OFF_B, OFF_MIXED = OFF_B, OFF_QM = OFF_B;
constexpr size_t OFF_C = 129 * MiB;
constexpr size_t OFF_KVMLA = OFF_C, OFF_HB = OFF_C;
constexpr size_t OFF_D = 161 * MiB;
constexpr size_t OFF_OM = OFF_D;
constexpr size_t OFF_SELID = 225 * MiB;
constexpr size_t OFF_SELG = 229 * MiB;
constexpr size_t OFF_KVM = 237 * MiB;
constexpr size_t OFF_SSQ = 241 * MiB;
constexpr size_t WS_NEEDED = 244 * MiB;

struct Params {
    const float* x; const float* mem; const float* norm_mix; const float* w_in; const float* q_norm; const float* kv_norm;
    const float* w_uq; const float* w_ukv; const float* gn_mla; const float* gn_dil; const float* w_out; const float* norm_mem_q;
    const float* norm_mem_kv; const float* w_mem_q; const float* w_mem_kv; const float* w_mem_o; const float* norm_ffn;
    const float* peer_w_q; const float* sub_keys; const float* peer_u; const float* peer_v; const float* norm_final;
    float* out; char* ws;
    float inv_freq[16];
    int prof; int pad_;
};
#define XB_TMO      128
#define XB_XCNT(j)  (256  + 64 * (j))
#define XB_XSUB(j)  (1280 + 64 * (j))
#define XB_XGEN(j)  (2304 + 64 * (j))
#define XB_TOP      3328
#define XB_TOPGEN   3392
#define XCD_BAR_WORDS 3456
#define XB_SPIN_CAP (1u << 20)
DI unsigned xb_ld(unsigned* p) { return __hip_atomic_load(p, __ATOMIC_RELAXED, __HIP_MEMORY_SCOPE_AGENT); }
DI unsigned xb_add(unsigned* p, unsigned v) { return __hip_atomic_fetch_add(p, v, __ATOMIC_RELAXED, __HIP_MEMORY_SCOPE_AGENT); }
DI unsigned xb_xcc_id() { return (unsigned)__builtin_amdgcn_s_getreg((3 << 11) | 20) & 0xFu; }
#define XB_SPIN(cond, bar) do { unsigned _sp = 0; while (cond) { __builtin_amdgcn_s_sleep(1); \
    if ((++_sp & 255u) == 0u) { if (xb_ld(&(bar)[XB_TMO])) break; if (_sp > XB_SPIN_CAP) { atomicAdd(&(bar)[XB_TMO], 1u); break; } } } } while (0)
struct XcdBarrier { unsigned* bar; unsigned x; volatile LAS unsigned* st; };
DI XcdBarrier xcd_barrier_post(unsigned* bar, volatile LAS unsigned* st) {
    XcdBarrier b; b.bar = bar; b.x = xb_xcc_id(); b.st = st;
    if (threadIdx.x == 0) (void)xb_add(&bar[XB_XCNT(b.x)], 1u);
    return b;
}
DI void xcd_barrier_complete(unsigned* bar, unsigned x, unsigned& nloc, unsigned& nx) {
    const unsigned G = gridDim.x * gridDim.y * gridDim.z;
    unsigned sum, cnt, mine, sp = 0u;
    for (;;) {
        sum = 0u; cnt = 0u; mine = 0u;
#pragma unroll
        for (unsigned j = 0; j < 16; ++j) { const unsigned c = xb_ld(&bar[XB_XCNT(j)]); sum += c; cnt += (c > 0u) ? 1u : 0u; mine = (j == x) ? c : mine; }
        if (sum == G) break;
        __builtin_amdgcn_s_sleep(1);
        if ((++sp & 255u) == 0u) { if (xb_ld(&bar[XB_TMO])) break; if (sp > XB_SPIN_CAP) { atomicAdd(&bar[XB_TMO], 1u); break; } }
    }
    nloc = mine > 0u ? mine : 1u; nx = cnt > 0u ? cnt : 1u;
}
DI void xcd_barrier(const XcdBarrier& b) {
    asm volatile("s_waitcnt vmcnt(0)" ::: "memory");
    __syncthreads();
    if (threadIdx.x == 0) {
        unsigned* bar = b.bar;
        __builtin_amdgcn_s_waitcnt(0);
        unsigned nloc = b.st[0], nx = b.st[1];
        if (nloc == 0u) { xcd_barrier_complete(bar, b.x, nloc, nx); b.st[0] = nloc; b.st[1] = nx; }
        const unsigned old = xb_add(&bar[XB_XSUB(b.x)], 1u);
        const unsigned gen = old / nloc;
        if (old + 1u == (gen + 1u) * nloc) {
            __builtin_amdgcn_fence(__ATOMIC_RELEASE, "agent");
            asm volatile("s_waitcnt vmcnt(0)" ::: "memory");
            const unsigned og = xb_add(&bar[XB_TOP], 1u);
            const unsigned tg = og / nx;
            if (og + 1u == (tg + 1u) * nx) xb_add(&bar[XB_TOPGEN], 1u);
            else XB_SPIN(xb_ld(&bar[XB_TOPGEN]) == tg, bar);
            __builtin_amdgcn_fence(__ATOMIC_ACQUIRE, "agent");
            xb_add(&bar[XB_XGEN(b.x)], 1u);
            asm volatile("s_waitcnt vmcnt(0)" ::: "memory");
        } else {
            XB_SPIN(xb_ld(&bar[XB_XGEN(b.x)]) == gen, bar);
            __builtin_amdgcn_fence(__ATOMIC_ACQUIRE, "agent");
            asm volatile("s_waitcnt vmcnt(0)" ::: "memory");
        }
    }
    __syncthreads();
}
DI void transpose_tile(const float* __restrict__ W, int K, int N, const float* __restrict__ g, bf16_t* __restrict__ Wt, int kt, int nt, char* lds, bool valid) {
    float* sm = (float*)lds;
    const int t = otid();
    const int k0 = kt * 64, n0 = nt * 64;
    __syncthreads();
#pragma unroll
    for (int i = 0; i < 16; ++i) {
        const int id = t + 256 * i, k = id >> 6, n = id & 63;
        float v = 0.f;
        if (valid && n0 + n < N) { v = W[(size_t)(k0 + k) * N + n0 + n]; if (g) v *= g[k0 + k]; }
        sm[k * 65 + n] = v;
    }
    __syncthreads();
    const int n = t >> 2, kc = (t & 3) * 16;
    u32x4 o0, o1;
    o0[0] = pack2(sm[(kc + 0) * 65 + n], sm[(kc + 1) * 65 + n]); o0[1] = pack2(sm[(kc + 2) * 65 + n], sm[(kc + 3) * 65 + n]);
    o0[2] = pack2(sm[(kc + 4) * 65 + n], sm[(kc + 5) * 65 + n]); o0[3] = pack2(sm[(kc + 6) * 65 + n], sm[(kc + 7) * 65 + n]);
    o1[0] = pack2(sm[(kc + 8) * 65 + n], sm[(kc + 9) * 65 + n]); o1[1] = pack2(sm[(kc + 10) * 65 + n], sm[(kc + 11) * 65 + n]);
    o1[2] = pack2(sm[(kc + 12) * 65 + n], sm[(kc + 13) * 65 + n]); o1[3] = pack2(sm[(kc + 14) * 65 + n], sm[(kc + 15) * 65 + n]);
    bf16_t* dst = Wt + (size_t)(n0 + n) * K + k0 + kc;
    if (valid) { *(u32x4*)dst = o0; *(u32x4*)(dst + 8) = o1; }
}

DI void rmsnorm_row_bf16(const float* __restrict__ in, const float* __restrict__ g, bf16_t* __restrict__ out, int lane) {
    f32x4 v[4]; float ss = 0.f;
#pragma unroll
    for (int i = 0; i < 4; ++i) { v[i] = *(const f32x4*)(in + 4 * lane + 256 * i); ss += v[i][0] * v[i][0] + v[i][1] * v[i][1] + v[i][2] * v[i][2] + v[i][3] * v[i][3]; }
#pragma unroll
    for (int o = 32; o; o >>= 1) ss += __shfl_xor(ss, o);
    const float rs = rsqrtf(ss * (1.0f / 1024.0f) + 1e-6f);
#pragma unroll
    for (int i = 0; i < 4; ++i) {
        const f32x4 gg = *(const f32x4*)(g + 4 * lane + 256 * i);
        u32x2 o; o[0] = pack2(v[i][0] * rs * gg[0], v[i][1] * rs * gg[1]); o[1] = pack2(v[i][2] * rs * gg[2], v[i][3] * rs * gg[3]);
        *(u32x2*)(out + 4 * lane + 256 * i) = o;
    }
}

struct TrJob { const float* W; const float* g; size_t off; int K, N, Npad; };

DI void phase_prep(const Params& p, char* lds) {
    char* ws = p.ws;
    const int t = otid(), lane = t & 63, wv = t >> 6;
    const int c0 = 576, c1 = c0 + 72, c2 = c1 + 64, c3 = c2 + 256, c4 = c3 + 256, c5 = c4 + 512, c6 = c5 + 256, c7 = c6 + 512;
    const int nrow = (T_TOK + 1024) / 4;
    const int nkeys = 128, nrope = 256;
    const int total = c7 + nrow + nkeys + nrope;
    for (int k = 0; k < (c7 + vgrid() - 1) / vgrid(); ++k) {
        const int raw = vbid() + k * vgrid();
        const bool valid = raw < c7;
        const int item = valid ? raw : 0;
        const float* W; const float* g; size_t off; int K, N, Npad, local;
        if (item < c0)      { W = p.w_in;     g = nullptr;      off = OFF_WT_IN;  K = 1024; N = 2208; Npad = 2304; local = item; }
        else if (item < c1) { W = p.w_uq;     g = p.q_norm;     off = OFF_WT_UQ;  K = 384;  N = 768;  Npad = 768;  local = item - c0; }
        else if (item < c2) { W = p.w_ukv;    g = p.kv_norm;    off = OFF_WT_UKV; K = 256;  N = 1024; Npad = 1024; local = item - c1; }
        else if (item < c3) { W = p.w_out;    g = nullptr;      off = OFF_WT_OUT; K = 1024; N = 1024; Npad = 1024; local = item - c2; }
        else if (item < c4) { W = p.w_mem_q;  g = p.norm_mem_q; off = OFF_WT_MQ;  K = 1024; N = 1024; Npad = 1024; local = item - c3; }
        else if (item < c5) { W = p.w_mem_kv; g = nullptr;      off = OFF_WT_MKV; K = 1024; N = 2048; Npad = 2048; local = item - c4; }
        else if (item < c6) { W = p.w_mem_o;  g = nullptr;      off = OFF_WT_MO;  K = 1024; N = 1024; Npad = 1024; local = item - c5; }
        else                { W = p.peer_w_q; g = p.norm_ffn;   off = OFF_WT_PQ;  K = 1024; N = 2048; Npad = 2048; local = item - c6; }
        const int ntn = Npad / 64;
        transpose_tile(W, K, N, g, (bf16_t*)(ws + off), local / ntn, local % ntn, lds, valid);
    }
    for (int item = c7 + vbid(); item < total; item += vgrid()) {
        if (item < c7 + nrow) {
            const int row = (item - c7) * 4 + wv;
            if (row < T_TOK) rmsnorm_row_bf16(p.x + (size_t)row * 1024, p.norm_mix, (bf16_t*)(ws + OFF_XN) + (size_t)row * 1024, lane);
            else rmsnorm_row_bf16(p.mem + (size_t)(row - T_TOK) * 1024, p.norm_mem_kv, (bf16_t*)(ws + OFF_MEMN) + (size_t)(row - T_TOK) * 1024, lane);
        } else if (item < c7 + nrow + nkeys) {
            const int idx = ((item - c7 - nrow) * 256 + t) * 8;
            const f32x4 a = *(const f32x4*)(p.sub_keys + idx), b = *(const f32x4*)(p.sub_keys + idx + 4);
            u32x4 o; o[0] = pack2(a[0], a[1]); o[1] = pack2(a[2], a[3]); o[2] = pack2(b[0], b[1]); o[3] = pack2(b[2], b[3]);
            *(u32x4*)((bf16_t*)(ws + OFF_KEYS) + idx) = o;
        } else {
            const int idx = (item - c7 - nrow - nkeys) * 256 + t;
            const int s = idx >> 4, i = idx & 15;
            const float ang = (float)s * p.inv_freq[i];
            const double a = (double)ang;
            const double twopi = 6.283185307179586476925;
            const float rf = (float)(a - twopi * rint(a / twopi));
            float* cs = (float*)(ws + OFF_ROPE);
            cs[idx] = cosf(rf); cs[65536 + idx] = sinf(rf);
        }
    }
}
namespace pg8 {
#define PG8_LAS __attribute__((address_space(3)))
typedef unsigned short bf16_t;
typedef short bf16x8 __attribute__((ext_vector_type(8)));
typedef float f32x4 __attribute__((ext_vector_type(4)));
typedef unsigned u32x4 __attribute__((ext_vector_type(4)));
constexpr int BM = 256, BK = 64, HALF = 128, HTB = HALF * BK * 2  , STAGE_BYTES = 8 * HTB, NXCD = 8, WGM = 8;

__host__ __device__ __forceinline__ int lds_byte(int r, int c) { const int st = (r >> 4) * 2 + (c >> 5), rr = r & 15, cc = c & 31, ob = rr * 64 + cc * 2; return st * 1024 + (ob ^ (((ob >> 9) & 1) << 5)); }
__host__ __device__ __forceinline__ void stage_rc(int b, int& R, int& C) { const int st = b / 1024, sb = b % 1024, swz = sb ^ (((sb >> 9) & 1) << 5); R = (st >> 1) * 16 + swz / 64; C = (st & 1) * 32 + (swz % 64) / 2; }
__host__ __device__ __forceinline__ int perm32(int rho) { const int n = rho >> 4, i = rho & 15; return 8 * (i >> 2) + 4 * n + (i & 3); }

struct Unit { int pm, pn; };
struct Gemm { const bf16_t* A; const bf16_t* Bt; int M, N, K, lda; };

struct StaticOrder {
    int nM, nN, nwg, G, c;
    __host__ __device__ void init(int M, int N, int G_, int c_) { nM = M / BM; nN = N / BM; nwg = nM * nN; G = G_; c = c_; }
    __host__ __device__ bool next(int i, Unit& u) const {
        const long L = (long)i * G + c; if (L >= nwg) return false;
        int wgid = (int)L; { const int q = nwg / NXCD, r = nwg % NXCD, xcd = wgid % NXCD, off = wgid / NXCD; wgid = (xcd < r ? xcd * (q + 1) : r * (q + 1) + (xcd - r) * q) + off; }
        const int nig = WGM * nN, gid = wgid / nig, fm = gid * WGM, gsz = (nM - fm) < WGM ? (nM - fm) : WGM;
        u.pm = fm + ((wgid % nig) % gsz); u.pn = (wgid % nig) / gsz; return true;
    }
    __device__ __forceinline__ void a_ready(const Unit&) const {}
    __device__ __forceinline__ void done(const Unit&) const {}
};

template <class Epi, class Sched, bool ALIGN_EPI = false, bool SP2 = false>
__device__ __forceinline__ void gemm_phase(PG8_LAS unsigned char* lds, const Gemm g, const Sched& S, const Epi& E) {
    int tid_ = threadIdx.x; asm volatile("" : "+v"(tid_));
    const int tid = tid_, wid = __builtin_amdgcn_readfirstlane(tid >> 6), lane = tid & 63, wr = wid >> 2, wc = wid & 3, fr = lane & 15, fq = lane >> 4;
    const int K = g.K, nt = K / BK, lda = g.lda;
    unsigned voffA[2], voffB[2];
#pragma unroll
    for (int i = 0; i < 2; ++i) { int R, C; stage_rc(tid * 16 + i * 8192, R, C); const int Rb = Epi::PERM ? ((R & ~31) + perm32(R & 31)) : R;
        voffA[i] = (unsigned)(R * lda + C) * 2u; voffB[i] = (unsigned)(Rb * K + C) * 2u; }
    const size_t kstep = (size_t)(BK * 2);
    const size_t hstepB = (size_t)HALF * K * 2, hstepA = (size_t)HALF * lda * 2;
    const size_t tstepB = 2 * hstepB, tstepA = 2 * hstepA;
    const unsigned ldsw = (unsigned)wid * 1024u;
    const int aoff = lds_byte(wr * 64 + fr, fq * 8), boff = lds_byte(wc * 32 + fr, fq * 8);
#define PG8_SA(b, h) (((b) * 2 + (h)) * HTB)
#define PG8_SB(b, h) ((4 + (b) * 2 + (h)) * HTB)
#define PG8_STAGE(bufoff, gbase, voff) do { _Pragma("unroll") for (int _i = 0; _i < 2; ++_i) \
        __builtin_amdgcn_global_load_lds((const unsigned*)((const char*)(gbase) + (voff)[_i]), (PG8_LAS unsigned*)(lds + (bufoff) + ldsw + _i * 8192), 16, 0, 0); } while (0)
#define PG8_LDA(dst, b, h) do { _Pragma("unroll") for (int m = 0; m < 4; ++m) _Pragma("unroll") for (int k = 0; k < 2; ++k) dst[m][k] = *(const PG8_LAS bf16x8*)(lds + PG8_SA(b, h) + aoff + m * 2048 + k * 1024); } while (0)
#define PG8_LDB(dst, b, h) do { _Pragma("unroll") for (int n = 0; n < 2; ++n) _Pragma("unroll") for (int k = 0; k < 2; ++k) dst[n][k] = *(const PG8_LAS bf16x8*)(lds + PG8_SB(b, h) + boff + n * 2048 + k * 1024); } while (0)
#define PG8_MMA(ai, bj, At, Bt) do { __builtin_amdgcn_s_setprio(1); _Pragma("unroll") for (int m = 0; m < 4; ++m) _Pragma("unroll") for (int n = 0; n < 2; ++n) _Pragma("unroll") for (int k = 0; k < 2; ++k) \
        acc[ai][bj][m][n] = __builtin_amdgcn_mfma_f32_16x16x32_bf16(Bt[n][k], At[m][k], acc[ai][bj][m][n], 0, 0, 0); __builtin_amdgcn_s_setprio(0); } while (0)
#define PG8_WAIT_V(n) asm volatile("s_waitcnt vmcnt(" #n ")" ::: "memory")
#define PG8_WAIT_L(n) asm volatile("s_waitcnt lgkmcnt(" #n ")" ::: "memory")
#define PG8_BAR __builtin_amdgcn_s_barrier()
#define PG8_SCHED __builtin_amdgcn_sched_barrier(0)
    Unit cur, nxt; int ui = 0;
    if (!S.next(0, cur)) return;
    f32x4 acc[2][2][4][2];
#pragma unroll
    for (int a = 0; a < 2; ++a)
#pragma unroll
        for (int b = 0; b < 2; ++b)
#pragma unroll
            for (int m = 0; m < 4; ++m)
#pragma unroll
                for (int n = 0; n < 2; ++n) acc[a][b][m][n] = (f32x4){0.f, 0.f, 0.f, 0.f};
    bf16x8 At[4][2], B0[2][2], B1[2][2];
    const char* cA = (const char*)g.A + (size_t)cur.pm * tstepA; const char* cB = (const char*)g.Bt + (size_t)cur.pn * tstepB;
    S.a_ready(cur);
    if constexpr (SP2) {
        PG8_STAGE(PG8_SB(0, 0), cB, voffB); PG8_STAGE(PG8_SB(0, 1), cB + hstepB, voffB); PG8_STAGE(PG8_SA(0, 0), cA, voffA); PG8_STAGE(PG8_SA(0, 1), cA + hstepA, voffA);
        if (wr == 1) PG8_BAR;
        PG8_WAIT_V(2); PG8_BAR;
        PG8_STAGE(PG8_SB(1, 0), cB + kstep, voffB); PG8_STAGE(PG8_SA(1, 0), cA + kstep, voffA); PG8_STAGE(PG8_SB(1, 1), cB + hstepB + kstep, voffB);
        PG8_WAIT_V(6); PG8_BAR;
    } else {
        PG8_STAGE(PG8_SB(0, 0), cB, voffB); PG8_STAGE(PG8_SA(0, 0), cA, voffA); PG8_STAGE(PG8_SB(0, 1), cB + hstepB, voffB); PG8_STAGE(PG8_SA(0, 1), cA + hstepA, voffA);
        if (wr == 1) PG8_BAR;
        PG8_WAIT_V(4); PG8_BAR;
        PG8_STAGE(PG8_SB(1, 0), cB + kstep, voffB); PG8_STAGE(PG8_SA(1, 0), cA + kstep, voffA); PG8_STAGE(PG8_SB(1, 1), cB + hstepB + kstep, voffB);
        PG8_WAIT_V(6); PG8_BAR;
    }
    for (;;) {
        const bool has_next = S.next(ui + 1, nxt);
        const char* nA = has_next ? (const char*)g.A + (size_t)nxt.pm * tstepA : cA; const char* nB = has_next ? (const char*)g.Bt + (size_t)nxt.pn * tstepB : cB;
#pragma unroll 1
        for (int t = 0; t < nt; t += 2) {
            const bool last = (t == nt - 2);
            const char* a1 = cA + (size_t)(t + 1) * kstep;
            const char* a2 = last ? nA : cA + (size_t)(t + 2) * kstep; const char* b2 = last ? nB : cB + (size_t)(t + 2) * kstep;
            const char* a3 = a2 + kstep; const char* b3 = b2 + kstep;
            if (last && has_next) S.a_ready(nxt);
            if constexpr (SP2) {
            PG8_LDB(B0, 0, 0); PG8_LDB(B1, 0, 1); PG8_SCHED; PG8_LDA(At, 0, 0); PG8_STAGE(PG8_SA(1, 1), a1 + hstepA, voffA);
            PG8_WAIT_V(8); PG8_WAIT_L(0); PG8_BAR; PG8_MMA(0, 0, At, B0); PG8_MMA(0, 1, At, B1); PG8_BAR; PG8_SCHED;
            PG8_LDA(At, 0, 1); PG8_STAGE(PG8_SB(0, 0), b2, voffB); PG8_STAGE(PG8_SB(0, 1), b2 + hstepB, voffB); PG8_STAGE(PG8_SA(0, 0), a2, voffA);
            PG8_WAIT_V(8); PG8_WAIT_L(0); PG8_BAR; PG8_MMA(1, 0, At, B0); PG8_MMA(1, 1, At, B1); PG8_BAR; PG8_SCHED;
            PG8_LDB(B0, 1, 0); PG8_LDB(B1, 1, 1); PG8_SCHED; PG8_LDA(At, 1, 0); PG8_STAGE(PG8_SA(0, 1), a2 + hstepA, voffA);
            PG8_WAIT_V(8); PG8_WAIT_L(0); PG8_BAR; PG8_MMA(0, 0, At, B0); PG8_MMA(0, 1, At, B1); PG8_BAR; PG8_SCHED;
            PG8_LDA(At, 1, 1); PG8_STAGE(PG8_SB(1, 0), b3, voffB); PG8_STAGE(PG8_SB(1, 1), b3 + hstepB, voffB); PG8_STAGE(PG8_SA(1, 0), a3, voffA);
            PG8_WAIT_V(8); PG8_WAIT_L(0); PG8_BAR; PG8_MMA(1, 0, At, B0); PG8_MMA(1, 1, At, B1); PG8_BAR; PG8_SCHED;
            } else {
            PG8_LDB(B0, 0, 0); PG8_SCHED; PG8_LDA(At, 0, 0); PG8_STAGE(PG8_SA(1, 1), a1 + hstepA, voffA);
            PG8_WAIT_L(8); PG8_BAR; PG8_WAIT_L(0); PG8_MMA(0, 0, At, B0); PG8_BAR; PG8_SCHED;
            PG8_LDB(B1, 0, 1); PG8_STAGE(PG8_SB(0, 0), b2, voffB);
            PG8_BAR; PG8_WAIT_L(0); PG8_MMA(0, 1, At, B1); PG8_BAR;
            PG8_LDA(At, 0, 1); PG8_STAGE(PG8_SA(0, 0), a2, voffA);
            PG8_BAR; PG8_WAIT_L(0); PG8_MMA(1, 0, At, B0); PG8_BAR; PG8_SCHED;
            PG8_STAGE(PG8_SB(0, 1), b2 + hstepB, voffB);
            PG8_WAIT_V(6); PG8_BAR; PG8_MMA(1, 1, At, B1); PG8_BAR;
            PG8_LDB(B0, 1, 0); PG8_SCHED; PG8_LDA(At, 1, 0); PG8_STAGE(PG8_SA(0, 1), a2 + hstepA, voffA);
            PG8_WAIT_L(8); PG8_BAR; PG8_WAIT_L(0); PG8_MMA(0, 0, At, B0); PG8_BAR; PG8_SCHED;
            PG8_LDB(B1, 1, 1); PG8_STAGE(PG8_SB(1, 0), b3, voffB);
            PG8_BAR; PG8_WAIT_L(0); PG8_MMA(0, 1, At, B1); PG8_BAR;
            PG8_LDA(At, 1, 1); PG8_STAGE(PG8_SA(1, 0), a3, voffA);
            PG8_BAR; PG8_WAIT_L(0); PG8_MMA(1, 0, At, B0); PG8_BAR; PG8_SCHED;
            PG8_STAGE(PG8_SB(1, 1), b3 + hstepB, voffB);
            PG8_WAIT_V(6); PG8_BAR; PG8_MMA(1, 1, At, B1); PG8_BAR;
            }
        }
        if constexpr (ALIGN_EPI) { if (wr == 0) PG8_BAR; }
        if constexpr (!Epi::AFTER_DRAIN) { E(acc, cur, wr, wc, fr, fq); S.done(cur); }
        if (!has_next) break;
#pragma unroll
        for (int a = 0; a < 2; ++a)
#pragma unroll
            for (int b = 0; b < 2; ++b)
#pragma unroll
                for (int m = 0; m < 4; ++m)
#pragma unroll
                    for (int n = 0; n < 2; ++n) acc[a][b][m][n] = (f32x4){0.f, 0.f, 0.f, 0.f};
        cur = nxt; cA = nA; cB = nB; ++ui;
        if constexpr (ALIGN_EPI) { if (wr == 1) PG8_BAR; }
    }
    PG8_WAIT_V(0);
    if constexpr (!ALIGN_EPI) { if (wr == 0) PG8_BAR; }
    PG8_BAR;
    if constexpr (Epi::AFTER_DRAIN) { E.fused(acc, cur, wr, wc, fr, fq, lds, wid, lane); S.done(cur); }
#undef PG8_SA
#undef PG8_SB
#undef PG8_STAGE
#undef PG8_LDA
#undef PG8_LDB
#undef PG8_MMA
#undef PG8_WAIT_V
#undef PG8_WAIT_L
#undef PG8_BAR
#undef PG8_SCHED
}
}
DI unsigned sw_off(int row, int chunk) { return (unsigned)(row * 128 + ((chunk ^ ((row >> 1) & 7)) << 4)); }
#define GLDS16(gsrc, ldst) __builtin_amdgcn_global_load_lds((const unsigned*)(gsrc), (unsigned*)(ldst), 16, 0, 0)
DI u32x2 pack4(float a, float b, float c, float d) { u32x2 o; o[0] = pack2(a, b); o[1] = pack2(c, d); return o; }
#define EPI_ARGS const f32x4 (&acc)[2][2][4][2], const pg8::Unit& u, int wr, int wc, int fr, int fq
DI float xq_sum(float v) {
    v += __uint_as_float((unsigned)__builtin_amdgcn_ds_swizzle((int)__float_as_uint(v), 0x401F));
    return xhalf_sum(v);
}
DI u32x4 pack8(const float (&v)[8], float sc) {
    u32x4 o; o[0] = pack2(v[0] * sc, v[1] * sc); o[1] = pack2(v[2] * sc, v[3] * sc); o[2] = pack2(v[4] * sc, v[5] * sc); o[3] = pack2(v[6] * sc, v[7] * sc); return o;
}
DI void rope8(const float (&v)[8], float sc, const float* __restrict__ cs, int pos, int fq, int lane, bf16_t* dst32  ) {
    const int i0 = 8 * (fq & 1);
    const f32x4 c0 = *(const f32x4*)(cs + pos * 16 + i0), c1 = *(const f32x4*)(cs + pos * 16 + i0 + 4);
    const f32x4 s0 = *(const f32x4*)(cs + 65536 + pos * 16 + i0), s1 = *(const f32x4*)(cs + 65536 + pos * 16 + i0 + 4);
    const float sg = (fq < 2) ? -1.0f : 1.0f;
    float o[8];
#pragma unroll
    for (int e = 0; e < 8; ++e) {
        const float own = v[e] * sc, oth = xhalf_other(own, lane);
        const float c = (e < 4) ? c0[e & 3] : c1[e & 3], s = (e < 4) ? s0[e & 3] : s1[e & 3];
        o[e] = own * c + sg * oth * s;
    }
    *(u32x4*)(dst32 + 8 * fq) = pack8(o, 1.0f);
}
#define EPI_LOAD8(v, ai, bj, m) float v[8]; { const f32x4 x0_ = acc[ai][bj][m][0], x1_ = acc[ai][bj][m][1]; v[0] = x0_[0]; v[1] = x0_[1]; v[2] = x0_[2]; v[3] = x0_[3]; v[4] = x1_[0]; v[5] = x1_[1]; v[6] = x1_[2]; v[7] = x1_[3]; }

struct EpiPlain8 {
    static constexpr bool PERM = true, AFTER_DRAIN = false;
    bf16_t* out; int ld;
    DI void operator()(EPI_ARGS) const {
#pragma unroll
        for (int ai = 0; ai < 2; ++ai)
#pragma unroll
            for (int m = 0; m < 4; ++m) {
                int fr_ = fr; asm volatile("" : "+v"(fr_));
                const size_t tok = (size_t)u.pm * 256 + ai * 128 + wr * 64 + m * 16 + fr_;
#pragma unroll
                for (int bj = 0; bj < 2; ++bj) { EPI_LOAD8(v, ai, bj, m); *(u32x4*)(out + tok * ld + u.pn * 256 + bj * 128 + wc * 32 + 8 * fq) = pack8(v, 1.0f); }
            }
    }
};

struct EpiProj8 {
    static constexpr bool PERM = true, AFTER_DRAIN = false;
    bf16_t* proj; bf16_t* kr; const float* cs; float* ssq;
    DI void operator()(EPI_ARGS) const {
        const int lane = fr + 16 * fq;
#pragma unroll
        for (int bj = 0; bj < 2; ++bj) {
            const int cg = u.pn * 256 + bj * 128 + wc * 32;
            if (cg >= INC) continue;
            const int g32 = cg >> 5;
            const float sc = (cg >= 672 && cg < 1184) ? 0.125f * LOG2E : 1.0f;
#pragma unroll
            for (int ai = 0; ai < 2; ++ai)
#pragma unroll
                for (int m = 0; m < 4; ++m) {
                    int fr_ = fr; asm volatile("" : "+v"(fr_));
                const size_t tok = (size_t)u.pm * 256 + ai * 128 + wr * 64 + m * 16 + fr_;
                    EPI_LOAD8(v, ai, bj, m);
                    if (g32 < 20) {
                        float ss = 0.f;
#pragma unroll
                        for (int e = 0; e < 8; ++e) ss += v[e] * v[e];
                        ss = xq_sum(ss);
                        if (fq == 0) ssq[tok * 24 + g32] = ss;
                    }
                    if (cg == 640) rope8(v, 1.0f, cs, (int)(tok & (SEQ_L - 1)), fq, lane, kr + tok * 32);
                    else *(u32x4*)(proj + tok * INC + cg + 8 * fq) = pack8(v, sc);
                }
        }
    }
};

struct EpiUpQ8 {
    static constexpr bool PERM = true, AFTER_DRAIN = false;
    bf16_t* q; const float* cs; const float* ssq;
    DI void operator()(EPI_ARGS) const {
        const int lane = fr + 16 * fq;
        const float qs = 0.10206207261596575f * LOG2E;
#pragma unroll
        for (int ai = 0; ai < 2; ++ai)
#pragma unroll
            for (int m = 0; m < 4; ++m) {
                int fr_ = fr; asm volatile("" : "+v"(fr_));
                const size_t tok = (size_t)u.pm * 256 + ai * 128 + wr * 64 + m * 16 + fr_;
                const f32x4 a0 = *(const f32x4*)(ssq + tok * 24), a1 = *(const f32x4*)(ssq + tok * 24 + 4), a2 = *(const f32x4*)(ssq + tok * 24 + 8);
                const float tot = (a0[0] + a0[1] + a0[2] + a0[3]) + (a1[0] + a1[1] + a1[2] + a1[3]) + (a2[0] + a2[1] + a2[2] + a2[3]);
                const float sc = rsqrtf(tot * (1.0f / 384.0f) + 1e-6f) * qs;
#pragma unroll
                for (int bj = 0; bj < 2; ++bj) {
                    const int cg = u.pn * 256 + bj * 128 + wc * 32;
                    EPI_LOAD8(v, ai, bj, m);
                    if ((cg % 96) == 64) rope8(v, sc, cs, (int)(tok & (SEQ_L - 1)), fq, lane, q + tok * 768 + cg);
                    else *(u32x4*)(q + tok * 768 + cg + 8 * fq) = pack8(v, sc);
                }
            }
    }
};

struct EpiUpKV8 {
    static constexpr bool PERM = true, AFTER_DRAIN = false;
    bf16_t* kv; const float* ssq;
    DI void operator()(EPI_ARGS) const {
#pragma unroll
        for (int ai = 0; ai < 2; ++ai)
#pragma unroll
            for (int m = 0; m < 4; ++m) {
                int fr_ = fr; asm volatile("" : "+v"(fr_));
                const size_t tok = (size_t)u.pm * 256 + ai * 128 + wr * 64 + m * 16 + fr_;
                const f32x4 a0 = *(const f32x4*)(ssq + tok * 24 + 12), a1 = *(const f32x4*)(ssq + tok * 24 + 16);
                const float tot = (a0[0] + a0[1] + a0[2] + a0[3]) + (a1[0] + a1[1] + a1[2] + a1[3]);
                const float sc = rsqrtf(tot * (1.0f / 256.0f) + 1e-6f);
#pragma unroll
                for (int bj = 0; bj < 2; ++bj) { EPI_LOAD8(v, ai, bj, m); *(u32x4*)(kv + tok * 1024 + u.pn * 256 + bj * 128 + wc * 32 + 8 * fq) = pack8(v, sc); }
            }
    }
};

template <bool RBF16>
struct EpiResid8 {
    static constexpr bool PERM = true, AFTER_DRAIN = false;
    const void* R; bf16_t* HB; float* SS;
    DI void operator()(EPI_ARGS) const {
#pragma unroll
        for (int ai = 0; ai < 2; ++ai) {
            f32x4 rv[4][2][2];
#pragma unroll
            for (int m = 0; m < 4; ++m)
#pragma unroll
                for (int bj = 0; bj < 2; ++bj) {
                    const size_t off = ((size_t)u.pm * 256 + ai * 128 + wr * 64 + m * 16 + fr) * 1024 + u.pn * 256 + bj * 128 + wc * 32 + 8 * fq;
                    if (RBF16) {
                        const u32x4 w = ldu4((const bf16_t*)R + off);
                        rv[m][bj][0] = (f32x4){bf_lo(w[0]), bf_hi(w[0]), bf_lo(w[1]), bf_hi(w[1])};
                        rv[m][bj][1] = (f32x4){bf_lo(w[2]), bf_hi(w[2]), bf_lo(w[3]), bf_hi(w[3])};
                    } else {
                        rv[m][bj][0] = *(const f32x4*)((const float*)R + off); rv[m][bj][1] = *(const f32x4*)((const float*)R + off + 4);
                    }
                }
#pragma unroll
            for (int m = 0; m < 4; ++m) {
                int fr_ = fr; asm volatile("" : "+v"(fr_));
                const size_t tok = (size_t)u.pm * 256 + ai * 128 + wr * 64 + m * 16 + fr_;
                float ss = 0.f;
#pragma unroll
                for (int bj = 0; bj < 2; ++bj) {
                    const size_t off = tok * 1024 + u.pn * 256 + bj * 128 + wc * 32 + 8 * fq;
                    const f32x4 h0 = rv[m][bj][0] + acc[ai][bj][m][0], h1 = rv[m][bj][1] + acc[ai][bj][m][1];
                    u32x4 o; o[0] = pack2(h0[0], h0[1]); o[1] = pack2(h0[2], h0[3]); o[2] = pack2(h1[0], h1[1]); o[3] = pack2(h1[2], h1[3]);
                    *(u32x4*)(HB + off) = o;
                    const float a0 = bf_lo(o[0]), a1 = bf_hi(o[0]), a2 = bf_lo(o[1]), a3 = bf_hi(o[1]), a4 = bf_lo(o[2]), a5 = bf_hi(o[2]), a6 = bf_lo(o[3]), a7 = bf_hi(o[3]);
                    ss += (a0 * a0 + a1 * a1) + (a2 * a2 + a3 * a3) + (a4 * a4 + a5 * a5) + (a6 * a6 + a7 * a7);
                }
                ss = xq_sum(ss);
                if (fq == 0) SS[tok * 16 + 4 * u.pn + wc] = ss;
            }
        }
    }
};

struct EpiRowScale8 {
    static constexpr bool PERM = true, AFTER_DRAIN = false;
    bf16_t* out; int ld; const float* SS; float extra;
    DI void operator()(EPI_ARGS) const {
#pragma unroll
        for (int ai = 0; ai < 2; ++ai)
#pragma unroll
            for (int m = 0; m < 4; ++m) {
                int fr_ = fr; asm volatile("" : "+v"(fr_));
                const size_t tok = (size_t)u.pm * 256 + ai * 128 + wr * 64 + m * 16 + fr_;
                const f32x4 s0 = *(const f32x4*)(SS + tok * 16), s1 = *(const f32x4*)(SS + tok * 16 + 4), s2 = *(const f32x4*)(SS + tok * 16 + 8), s3 = *(const f32x4*)(SS + tok * 16 + 12);
                const float tot = (s0[0] + s0[1] + s0[2] + s0[3]) + (s1[0] + s1[1] + s1[2] + s1[3]) + (s2[0] + s2[1] + s2[2] + s2[3]) + (s3[0] + s3[1] + s3[2] + s3[3]);
                const float sc = rsqrtf(tot * (1.0f / 1024.0f) + 1e-6f) * extra;
#pragma unroll
                for (int bj = 0; bj < 2; ++bj) { EPI_LOAD8(v, ai, bj, m); *(u32x4*)(out + tok * ld + u.pn * 256 + bj * 128 + wc * 32 + 8 * fq) = pack8(v, sc); }
            }
    }
};

template <class Epi>
DI void gemm8(char* smem, const bf16_t* A, int lda, const bf16_t* Bt, int M, int N, int K, const Epi& e, int cshift = 0) {
    pg8::Gemm g; g.A = A; g.Bt = Bt; g.M = M; g.N = N; g.K = K; g.lda = lda;
    const int G = (int)gridDim.x;
    pg8::StaticOrder S; S.init(M, N, G, ((int)blockIdx.x + G - cshift) % G);
    pg8::gemm_phase<Epi, pg8::StaticOrder, true, true>((PG8_LAS unsigned char*)smem, g, S, e);
}

DI void quant_rows4(const Params& p, int it, int wv, int lane);
DI void phase_p1(const Params& p, char* smem) {
    char* ws = p.ws;
    const int G = (int)gridDim.x, nproj = 9 * 64, nkvm = 8 * 4;
    const int last = nproj % G;
    { EpiProj8 e{(bf16_t*)(ws + OFF_PROJ), (bf16_t*)(ws + OFF_KR), (const float*)(ws + OFF_ROPE), (float*)(ws + OFF_SSQ)};
      gemm8(smem, (const bf16_t*)(ws + OFF_XN), 1024, (const bf16_t*)(ws + OFF_WT_IN), T_TOK, 2304, 1024, e); }
    { EpiPlain8 e{(bf16_t*)(ws + OFF_KVM), 2048};
      gemm8(smem, (const bf16_t*)(ws + OFF_MEMN), 1024, (const bf16_t*)(ws + OFF_WT_MKV), 1024, 2048, 1024, e, last); }
    int q0 = last + nkvm, nq = G - q0;
    if (last == 0 || nq <= 0) { q0 = 0; nq = G; }
    if ((int)blockIdx.x >= q0) {
        const int t = otid(), lane = t & 63, wv = t >> 6;
        for (int it = ((int)blockIdx.x - q0) * 2 + vhalf(); it < 8192; it += 2 * nq) quant_rows4(p, it, wv, lane);
    }
}
DI void phase_p2(const Params& p, char* smem) {
    char* ws = p.ws;
    { EpiUpQ8 e{(bf16_t*)(ws + OFF_QMLA), (const float*)(ws + OFF_ROPE), (const float*)(ws + OFF_SSQ)};
      gemm8(smem, (const bf16_t*)(ws + OFF_PROJ), INC, (const bf16_t*)(ws + OFF_WT_UQ), T_TOK, 768, 384, e); }
    { EpiUpKV8 e{(bf16_t*)(ws + OFF_KVMLA), (const float*)(ws + OFF_SSQ)};
      gemm8(smem, (const bf16_t*)(ws + OFF_PROJ) + 384, INC, (const bf16_t*)(ws + OFF_WT_UKV), T_TOK, 1024, 256, e); }
}
template <bool RBF16>
DI void phase_resid(const Params& p, char* smem, size_t off_w, size_t off_a, const void* R, size_t off_ss, bool dry = false) {
    char* ws = p.ws;
    EpiResid8<RBF16> e{R, (bf16_t*)(ws + OFF_HB), (float*)(ws + off_ss)};
    if (dry) { e.HB = (bf16_t*)(ws + OFF_B); e.SS = (float*)(ws + OFF_SS1); }
    gemm8(smem, (const bf16_t*)(ws + off_a), 1024, (const bf16_t*)(ws + off_w), T_TOK, 1024, 1024, e);
}
DI void phase_rowscale(const Params& p, char* smem, size_t off_w, int N, bf16_t* outp, size_t off_ss, float extra) {
    char* ws = p.ws;
    EpiRowScale8 e{outp, N, (const float*)(ws + off_ss), extra};
    gemm8(smem, (const bf16_t*)(ws + OFF_HB), 1024, (const bf16_t*)(ws + off_w), T_TOK, N, 1024, e);
}
DI unsigned v128_off(int row, int chunk) { return (unsigned)(row * 128 + ((chunk ^ (((row >> 1) & 1) << 2)) << 4)); }
DI unsigned v128_tr_addr(unsigned base, int R0, int c, int lane) {
    const int blk = (lane >> 4) & 1, qq = (lane & 15) >> 2, pp = lane & 3;
    return base + v128_off(R0 + qq, 4 * c + 2 * blk + (pp >> 1)) + 8 * (pp & 1);
}
DI bf16x8 cat44(s16x4 lo, s16x4 hi) { return __builtin_shufflevector(lo, hi, 0, 1, 2, 3, 4, 5, 6, 7); }

constexpr int MLA_STAGE = 64 * 192 + 64 * 128;
DI unsigned k192_off(int row, int chunk) { return (unsigned)(row * 192 + (((chunk & ~3) | ((chunk & 3) ^ ((row >> 2) & 3))) << 4)); }
DI void mla_unit(const Params& p, char* lds, int b, int h, int qt) {
    char* ws = p.ws;
    const int t = otid(), lane = t & 63, wv = t >> 6, r = lane & 31, hh = lane >> 5;
    const bf16_t* Q = (const bf16_t*)(ws + OFF_QMLA);
    const bf16_t* KV = (const bf16_t*)(ws + OFF_KVMLA);
    const bf16_t* KR = (const bf16_t*)(ws + OFF_KR);
    const int q0 = qt * 128 + 32 * wv;
    const size_t tokq = (size_t)b * SEQ_L + q0 + r;
    const size_t tokb = (size_t)b * SEQ_L;
    bf16x8 qf[6];
#pragma unroll
    for (int s = 0; s < 6; ++s) qf[s] = ld16(Q + tokq * 768 + h * 96 + 16 * s + 8 * hh);
    f32x16 o[2]; o[0] = zero16(); o[1] = zero16();
    float m = -INFINITY, l = 0.f;
    const bf16_t* ksrc[3]; int kadv[3]; const bf16_t* vsrc[2];
#pragma unroll
    for (int i = 0; i < 3; ++i) {
        const int o_ = 1024 * (wv + 4 * i) + 16 * lane, row = o_ / 192, pch = (o_ % 192) >> 4;
        const int c = (pch & ~3) | ((pch & 3) ^ ((row >> 2) & 3));
        if (c < 8) { ksrc[i] = KV + (tokb + row) * 1024 + h * 128 + 8 * c; kadv[i] = 64 * 1024; }
        else       { ksrc[i] = KR + (tokb + row) * 32 + 8 * (c - 8);       kadv[i] = 64 * 32; }
    }
#pragma unroll
    for (int i = 0; i < 2; ++i) {
        const int row = 8 * (wv + 4 * i) + (lane >> 3), pch = lane & 7;
        vsrc[i] = KV + (tokb + row) * 1024 + h * 128 + 64 + 8 * (pch ^ (((row >> 1) & 1) << 2));
    }
    char* ldst = lds + wv * 1024 + lane * 16;
    auto issue = [&](int kt) {
        char* d = ldst + (kt % 3) * MLA_STAGE;
#pragma unroll
        for (int i = 0; i < 3; ++i) GLDS16(ksrc[i] + (size_t)kt * kadv[i], d + i * 4096);
#pragma unroll
        for (int i = 0; i < 2; ++i) GLDS16(vsrc[i] + (size_t)kt * (64 * 1024), d + 12288 + i * 4096);
    };
    const int ntiles = 2 * qt + 2;
    const unsigned vlane0 = v128_tr_addr(0u, 4 * hh, 0, lane), vlane1 = v128_tr_addr(0u, 4 * hh, 1, lane);
    __syncthreads();
    issue(0); issue(1);
#pragma unroll
    for (int s = 0; s < 6; ++s) asm volatile("" :: "v"(qf[s]));
#pragma unroll 1
    for (int kt = 0; kt < ntiles; ++kt) {
        if (kt + 1 < ntiles) asm volatile("s_waitcnt vmcnt(5)\n\ts_barrier" ::: "memory");
        else asm volatile("s_waitcnt vmcnt(0)\n\ts_barrier" ::: "memory");
        if (kt + 2 < ntiles) issue(kt + 2);
        const char* sb = lds + (kt % 3) * MLA_STAGE;
        const unsigned vb = (unsigned)(uintptr_t)(sb + 12288);
        f32x16 s[2];
#pragma unroll
        for (int k2 = 0; k2 < 2; ++k2) {
            s[k2] = zero16();
#pragma unroll
            for (int ss = 0; ss < 6; ++ss) s[k2] = MFMA32(ld16(sb + k192_off(32 * k2 + r, 2 * ss + hh)), qf[ss], s[k2]);
        }
        s16x4 vt[2][2][2][2];
        {
            const unsigned a0 = vb + vlane0, a1 = vb + vlane1;
#define MLA_TR(K2, ST) vt[K2][ST][0][0] = tr_read_ao<(32 * K2 + 16 * ST) * 128>(a0); vt[K2][ST][0][1] = tr_read_ao<(32 * K2 + 16 * ST + 8) * 128>(a0); \
                       vt[K2][ST][1][0] = tr_read_ao<(32 * K2 + 16 * ST) * 128>(a1); vt[K2][ST][1][1] = tr_read_ao<(32 * K2 + 16 * ST + 8) * 128>(a1);
            MLA_TR(0, 0) MLA_TR(0, 1) MLA_TR(1, 0) MLA_TR(1, 1)
#undef MLA_TR
        }
        if (__builtin_amdgcn_readfirstlane(kt >= 2 * qt)) {
            asm volatile("");
            const int qpos = q0 + r;
#pragma unroll
            for (int k2 = 0; k2 < 2; ++k2)
#pragma unroll
                for (int i = 0; i < 16; ++i) { const int kpos = 64 * kt + 32 * k2 + crow(i, hh); if (kpos > qpos) s[k2][i] = -INFINITY; }
        }
        float mx = s[0][0];
#pragma unroll
        for (int k2 = 0; k2 < 2; ++k2)
#pragma unroll
            for (int i = 0; i < 16; ++i) mx = fmaxf(mx, s[k2][i]);
        mx = xhalf_max(mx);
        if (__any(mx > m + 8.0f)) {
            asm volatile("");
            const float mn = fmaxf(m, mx);
            const float alpha = fast_exp2(m - mn);
            l *= alpha;
            m = mn;
#pragma unroll
            for (int c = 0; c < 2; ++c)
#pragma unroll
                for (int i = 0; i < 16; ++i) o[c][i] *= alpha;
        }
        f32x2 ps2 = {0.f, 0.f};
        const f32x2 m2 = {m, m};
#pragma unroll
        for (int k2 = 0; k2 < 2; ++k2)
#pragma unroll
            for (int i = 0; i < 16; i += 2) {
                f32x2 x = {s[k2][i], s[k2][i + 1]};
                x = x - m2;
                f32x2 e; e[0] = fast_exp2(x[0]); e[1] = fast_exp2(x[1]);
                s[k2][i] = e[0]; s[k2][i + 1] = e[1];
                ps2 += e;
            }
        l += ps2[0] + ps2[1];
        TR_WAIT();
#pragma unroll
        for (int k2 = 0; k2 < 2; ++k2)
#pragma unroll
            for (int st = 0; st < 2; ++st) {
                const bf16x8 pb = pack_step(s[k2], st);
#pragma unroll
                for (int c = 0; c < 2; ++c) o[c] = MFMA32(cat44(vt[k2][st][c][0], vt[k2][st][c][1]), pb, o[c]);
            }
    }
    const float inv = 1.0f / xhalf_sum(l);
    bf16_t* dst = (bf16_t*)((char*)p.out + OUT_OMLA) + tokq * 512 + h * 64 + 4 * hh;
#pragma unroll
    for (int c = 0; c < 2; ++c)
#pragma unroll
        for (int g = 0; g < 4; ++g)
            *(u32x2*)(dst + 32 * c + 8 * g) = pack4(o[c][4 * g] * inv, o[c][4 * g + 1] * inv, o[c][4 * g + 2] * inv, o[c][4 * g + 3] * inv);
}

DI void dil_unit(const Params& p, char* lds, int g, int b, int h, int rr, int lb) {
    char* ws = p.ws;
    const int t = otid(), lane = t & 63, wv = t >> 6, r = lane & 31, hh = lane >> 5;
    const int d = (g == 0) ? 1 : (g == 1 ? 4 : 16);
    const bf16_t* PJ = (const bf16_t*)(ws + OFF_PROJ);
    const size_t tokb = (size_t)b * SEQ_L;
    char* kimg = lds;
    char* vimg = lds + 32768;
    __syncthreads();
    {
        const int c = t & 7;
#pragma unroll
        for (int half = 0; half < 2; ++half) {
            u32x4 kk[4], vv[4];
#pragma unroll
            for (int i = 0; i < 4; ++i) {
                const int key = (t >> 3) + 32 * (4 * half + i);
                const int lk = 128 * lb - 128 + key;
                if (lk >= 0) {
                    const size_t tk = tokb + (size_t)lk * d + rr;
                    kk[i] = ldu4(PJ + tk * INC + 1184 + h * 64 + 8 * c);
                    vv[i] = ldu4(PJ + tk * INC + 1696 + h * 64 + 8 * c);
                } else { kk[i] = (u32x4){0u, 0u, 0u, 0u}; vv[i] = (u32x4){0u, 0u, 0u, 0u}; }
            }
#pragma unroll
            for (int i = 0; i < 4; ++i) {
                const int key = (t >> 3) + 32 * (4 * half + i);
                *(u32x4*)(kimg + sw_off(key, c)) = kk[i];
                *(u32x4*)(vimg + v128_off(key, c)) = vv[i];
            }
        }
    }
    const int lq = 128 * lb + 32 * wv + r;
    const size_t tokq = tokb + (size_t)lq * d + rr;
    bf16x8 qf[4];
#pragma unroll
    for (int s = 0; s < 4; ++s) qf[s] = ld16(PJ + tokq * INC + 672 + h * 64 + 16 * s + 8 * hh);
    __syncthreads();
    const float slope2 = exp2f(-(float)(h + 1)) * (float)d * LOG2E;
    const int u0 = (lb == 0) ? (4 - wv) : 0;
    f32x16 o[2]; o[0] = zero16(); o[1] = zero16();
    float m = -INFINITY, lsum = 0.f;
    const unsigned vb = (unsigned)(uintptr_t)vimg;
    float cb[16];
#pragma unroll
    for (int i = 0; i < 16; ++i) cb[i] = slope2 * (float)crow(i, hh);
#pragma unroll 1
    for (int u = u0; u < 5; ++u) {
        const int rowb = 32 * (wv + u);
        f32x16 s = zero16();
#pragma unroll
        for (int ss = 0; ss < 4; ++ss) s = MFMA32(ld16(kimg + sw_off(rowb + r, 2 * ss + hh)), qf[ss], s);
        const int dbase = r + 128 - 32 * u;
        const float b0 = -slope2 * (float)dbase;
#pragma unroll
        for (int i = 0; i < 16; ++i) s[i] += cb[i];
        if (__builtin_amdgcn_readfirstlane(u == 0 || u == 4)) {
            asm volatile("");
#pragma unroll
            for (int i = 0; i < 16; ++i) { const int dist = dbase - crow(i, hh); if (dist < 0 || dist > 128) s[i] = -INFINITY; }
        }
        float mx = s[0];
#pragma unroll
        for (int i = 1; i < 16; ++i) mx = fmaxf(mx, s[i]);
        mx = xhalf_max(mx) + b0;
        if (__any(mx > m + 8.0f)) {
            asm volatile("");
            const float mn = fmaxf(m, mx);
            const float alpha = fast_exp2(m - mn);
            lsum *= alpha;
            m = mn;
#pragma unroll
            for (int c = 0; c < 2; ++c)
#pragma unroll
                for (int i = 0; i < 16; ++i) o[c][i] *= alpha;
        }
        f32x2 ps2 = {0.f, 0.f};
        const float mb = m - b0;
        const f32x2 m2 = {mb, mb};
#pragma unroll
        for (int i = 0; i < 16; i += 2) {
            f32x2 xx = {s[i], s[i + 1]};
            xx = xx - m2;
            f32x2 e; e[0] = fast_exp2(xx[0]); e[1] = fast_exp2(xx[1]);
            s[i] = e[0]; s[i + 1] = e[1];
            ps2 += e;
        }
        lsum += ps2[0] + ps2[1];
#pragma unroll
        for (int st = 0; st < 2; ++st) {
            const bf16x8 pb = pack_step(s, st);
#pragma unroll
            for (int c = 0; c < 2; ++c) {
                const s16x4 lo = tr_read(v128_tr_addr(vb, rowb + 16 * st + 4 * hh, c, lane));
                const s16x4 hi = tr_read(v128_tr_addr(vb, rowb + 16 * st + 8 + 4 * hh, c, lane));
                o[c] = MFMA32(cat44(lo, hi), pb, o[c]);
            }
        }
    }
    const float ltot = xhalf_sum(lsum);
    const float mx = m;
    const float inv = 1.0f / ltot;
    bf16_t* dst = (bf16_t*)((char*)p.out + OUT_ODIL) + ((size_t)g * T_TOK + tokq) * 512 + h * 64 + 4 * hh;
#pragma unroll
    for (int c = 0; c < 2; ++c)
#pragma unroll
        for (int gg = 0; gg < 4; ++gg)
            *(u32x2*)(dst + 32 * c + 8 * gg) = pack4(o[c][4 * gg] * inv, o[c][4 * gg + 1] * inv, o[c][4 * gg + 2] * inv, o[c][4 * gg + 3] * inv);
    if (hh == 0) ((float*)(ws + OFF_LSE))[((size_t)g * T_TOK + tokq) * 8 + h] = mx + __log2f(ltot);
}

DI void phase_p3(const Params& p, char* lds, int which = 3) {
    const int xg = (int)blockIdx.x & 7, nloc = (vgrid() >> 3), loc = ((int)blockIdx.x >> 3) * 2 + vhalf();
    if (which & 1) for (int i = loc; i < 64; i += nloc) {
        const int bh = xg * 4 + (i >> 4), pr = i & 15, b = bh >> 3, h = bh & 7;
#pragma unroll 1
        for (int rep = 0; rep < 2; ++rep) mla_unit(p, lds, b, h, rep ? pr : 31 - pr);
    }
    if (which & 2) for (int i = loc; i < 384; i += nloc) {
        const int bh = xg * 4 + i / 96, k96 = i % 96, g = k96 >> 5, k = k96 & 31, b = bh >> 3, h = bh & 7;
        int rr, lb;
        if (g == 0) { rr = 0; lb = k; } else if (g == 1) { rr = k >> 3; lb = k & 7; } else { rr = k >> 1; lb = k & 1; }
        dil_unit(p, lds, g, b, h, rr, lb);
    }
}

DI void quant_rows4(const Params& p, int it, int wv, int lane) {
    char* ws = p.ws;
    const int ncv = 4096;
    const bool isv = it >= ncv;
    const size_t row = (size_t)(isv ? it - ncv : it) * 4 + wv;
    const float* src = (isv ? p.peer_v : p.peer_u) + row * 1024 + 16 * lane;
    f32x4 v[4]; float am = 0.f;
#pragma unroll
    for (int i = 0; i < 4; ++i) { v[i] = *(const f32x4*)(src + 4 * i); am = fmaxf(am, fmaxf(fmaxf(fabsf(v[i][0]), fabsf(v[i][1])), fmaxf(fabsf(v[i][2]), fabsf(v[i][3])))); }
#pragma unroll
    for (int o = 32; o; o >>= 1) am = fmaxf(am, __shfl_xor(am, o));
    const float sc = (am > 0.f) ? am * (isv ? (1.0f / 384.0f) : (1.0f / 127.0f)) : 1.0f;
    const float inv = 1.0f / sc;
    u32x4 o;
#pragma unroll
    for (int i = 0; i < 4; ++i) {
        if (isv) {
            int w = 0;
            w = __builtin_amdgcn_cvt_pk_fp8_f32(v[i][0] * inv, v[i][1] * inv, w, false);
            w = __builtin_amdgcn_cvt_pk_fp8_f32(v[i][2] * inv, v[i][3] * inv, w, true);
            o[i] = (unsigned)w;
        } else {
            unsigned w = 0u;
#pragma unroll
            for (int e = 0; e < 4; ++e) { const int q = (int)rintf(v[i][e] * inv); w |= ((unsigned)q & 0xFFu) << (8 * e); }
            o[i] = w;
        }
    }
    *(u32x4*)(ws + OFF_UQ + row * 2048 + (isv ? 1024 : 0) + 16 * lane) = o;
    if (lane == 0) ((float*)(ws + (isv ? OFF_SV : OFF_SU)))[row] = sc;
}

DI void phase_p35(const Params& p, char* lds) {
    char* ws = p.ws;
    const int t = otid(), lane = t & 63, wv = t >> 6;
    const int ntok = T_TOK / 4;
    for (int item = vbid(); item < ntok; item += vgrid()) {
        {
            const size_t tok = (size_t)item * 4 + wv;
            const int head = lane >> 3;
            const float* LS = (const float*)(ws + OFF_LSE);
            const float l0 = LS[tok * 8 + head], l1 = LS[((size_t)T_TOK + tok) * 8 + head], l2 = LS[((size_t)2 * T_TOK + tok) * 8 + head];
            const float mx = fmaxf(l0, fmaxf(l1, l2));
            float w0 = fast_exp2(l0 - mx), w1 = fast_exp2(l1 - mx), w2 = fast_exp2(l2 - mx);
            const float wi = 1.0f / (w0 + w1 + w2);
            w0 *= wi; w1 *= wi; w2 *= wi;
            const bf16_t* OD = (const bf16_t*)((const char*)p.out + OUT_ODIL);
            const u32x4 a0 = ldu4(OD + tok * 512 + 8 * lane), a1 = ldu4(OD + ((size_t)T_TOK + tok) * 512 + 8 * lane),
                        a2 = ldu4(OD + ((size_t)2 * T_TOK + tok) * 512 + 8 * lane);
            const u32x4 am = ldu4((const bf16_t*)((const char*)p.out + OUT_OMLA) + tok * 512 + 8 * lane);
            float od[8], om[8]; float sd = 0.f, sm = 0.f;
#pragma unroll
            for (int e = 0; e < 4; ++e) {
                od[2 * e] = w0 * bf_lo(a0[e]) + w1 * bf_lo(a1[e]) + w2 * bf_lo(a2[e]);
                od[2 * e + 1] = w0 * bf_hi(a0[e]) + w1 * bf_hi(a1[e]) + w2 * bf_hi(a2[e]);
                om[2 * e] = bf_lo(am[e]); om[2 * e + 1] = bf_hi(am[e]);
                sd += od[2 * e] * od[2 * e] + od[2 * e + 1] * od[2 * e + 1];
                sm += om[2 * e] * om[2 * e] + om[2 * e + 1] * om[2 * e + 1];
            }
#pragma unroll
            for (int o = 32; o; o >>= 1) { sd += __shfl_xor(sd, o); sm += __shfl_xor(sm, o); }
            const float rd = rsqrtf(sd * (1.0f / 512.0f) + 1e-6f), rm = rsqrtf(sm * (1.0f / 512.0f) + 1e-6f);
            const f32x4 gm0 = *(const f32x4*)(p.gn_mla + 8 * lane), gm1 = *(const f32x4*)(p.gn_mla + 8 * lane + 4);
            const f32x4 gd0 = *(const f32x4*)(p.gn_dil + 8 * lane), gd1 = *(const f32x4*)(p.gn_dil + 8 * lane + 4);
            u32x4 o1, o2;
            o1[0] = pack2(om[0] * rm * gm0[0], om[1] * rm * gm0[1]); o1[1] = pack2(om[2] * rm * gm0[2], om[3] * rm * gm0[3]);
            o1[2] = pack2(om[4] * rm * gm1[0], om[5] * rm * gm1[1]); o1[3] = pack2(om[6] * rm * gm1[2], om[7] * rm * gm1[3]);
            o2[0] = pack2(od[0] * rd * gd0[0], od[1] * rd * gd0[1]); o2[1] = pack2(od[2] * rd * gd0[2], od[3] * rd * gd0[3]);
            o2[2] = pack2(od[4] * rd * gd1[0], od[5] * rd * gd1[1]); o2[3] = pack2(od[6] * rd * gd1[2], od[7] * rd * gd1[3]);
            bf16_t* MX = (bf16_t*)(ws + OFF_MIXED) + tok * 1024;
            *(u32x4*)(MX + 8 * lane) = o1;
            *(u32x4*)(MX + 512 + 8 * lane) = o2;
        }
    }
}

DI void memattn_unit(const Params& p, char* lds, int b, int h, int tt) {
    char* ws = p.ws;
    const int t = otid(), lane = t & 63, wv = t >> 6, r = lane & 31, hh = lane >> 5;
    const bf16_t* QM = (const bf16_t*)(ws + OFF_QM);
    const bf16_t* KVM = (const bf16_t*)(ws + OFF_KVM);
    const size_t tokq = (size_t)b * SEQ_L + tt * 128 + 32 * wv + r;
    const bf16_t* qrow = QM + tokq * 1024 + h * 256 + 8 * hh;
    const bf16_t* ksrc0; const bf16_t* vsrc0;
    {
        const int row = 8 * wv + (lane >> 3), pch = lane & 7;
        const size_t mrow = (size_t)b * 256 + row;
        ksrc0 = KVM + mrow * 2048 + h * 256 + 8 * (pch ^ ((row >> 1) & 7));
        vsrc0 = KVM + mrow * 2048 + 1024 + h * 256 + 8 * (pch ^ (((row >> 1) & 1) << 2));
    }
    char* ldst = lds + wv * 1024 + lane * 16;
#define MA_ISSUE(st_) do { char* d_ = ldst + ((st_) & 1) * 32768; \
        _Pragma("unroll") for (int i = 0; i < 8; ++i) GLDS16(((st_) < 4 ? ksrc0 : vsrc0) + (size_t)i * (32 * 2048) + 64 * ((st_) & 3), d_ + i * 4096); } while (0)
    f32x16 S[8];
#pragma unroll
    for (int kt = 0; kt < 8; ++kt) S[kt] = zero16();
    bf16x8 qa[4];
    __syncthreads();
    MA_ISSUE(0); MA_ISSUE(1);
#define MA_KSTAGE(c_, WAIT_) do { \
        asm volatile("s_waitcnt vmcnt(" #WAIT_ ")\n\ts_barrier" ::: "memory"); \
        _Pragma("unroll") for (int ss = 0; ss < 4; ++ss) qa[ss] = ld16(qrow + 64 * (c_) + 16 * ss); \
        { const char* sb_ = lds + ((c_) & 1) * 32768; \
          _Pragma("unroll") for (int kt = 0; kt < 8; ++kt) \
          _Pragma("unroll") for (int ss = 0; ss < 4; ++ss) S[kt] = MFMA32(ld16(sb_ + sw_off(32 * kt + r, 2 * ss + hh)), qa[ss], S[kt]); } \
        asm volatile("s_barrier" ::: "memory"); \
        MA_ISSUE((c_) + 2); } while (0)
    MA_KSTAGE(0, 8);
    MA_KSTAGE(1, 8);
    MA_KSTAGE(2, 8);
    MA_KSTAGE(3, 8);
    float mx = S[0][0];
#pragma unroll
    for (int kt = 0; kt < 8; ++kt)
#pragma unroll
        for (int i = 0; i < 16; ++i) mx = fmaxf(mx, S[kt][i]);
    mx = xhalf_max(mx);
    f32x2 ps2 = {0.f, 0.f};
    const f32x2 m2 = {mx, mx};
    bf16x8 pk[8][2];
#pragma unroll
    for (int kt = 0; kt < 8; ++kt) {
#pragma unroll
        for (int i = 0; i < 16; i += 2) {
            f32x2 xx = {S[kt][i], S[kt][i + 1]};
            xx = xx - m2;
            f32x2 e; e[0] = fast_exp2(xx[0]); e[1] = fast_exp2(xx[1]);
            S[kt][i] = e[0]; S[kt][i + 1] = e[1];
            ps2 += e;
        }
        pk[kt][0] = pack_step(S[kt], 0); pk[kt][1] = pack_step(S[kt], 1);
    }
    const float inv = 1.0f / xhalf_sum(ps2[0] + ps2[1]);
    bf16_t* dst = (bf16_t*)(ws + OFF_OM) + tokq * 1024 + h * 256 + 4 * hh;
    const unsigned vlane0 = v128_tr_addr(0u, 4 * hh, 0, lane), vlane1 = v128_tr_addr(0u, 4 * hh, 1, lane);
#define MA_PV(KT_, vb_) do { s16x4 vt_[2][2][2]; \
            vt_[0][0][0] = tr_read_ao<(32 * KT_) * 128>(vb_ + vlane0);          vt_[0][0][1] = tr_read_ao<(32 * KT_ + 8) * 128>(vb_ + vlane0); \
            vt_[0][1][0] = tr_read_ao<(32 * KT_) * 128>(vb_ + vlane1);          vt_[0][1][1] = tr_read_ao<(32 * KT_ + 8) * 128>(vb_ + vlane1); \
            vt_[1][0][0] = tr_read_ao<(32 * KT_ + 16) * 128>(vb_ + vlane0);     vt_[1][0][1] = tr_read_ao<(32 * KT_ + 24) * 128>(vb_ + vlane0); \
            vt_[1][1][0] = tr_read_ao<(32 * KT_ + 16) * 128>(vb_ + vlane1);     vt_[1][1][1] = tr_read_ao<(32 * KT_ + 24) * 128>(vb_ + vlane1); \
            TR_WAIT(); \
            _Pragma("unroll") for (int st = 0; st < 2; ++st) { \
                o0_ = MFMA32(cat44(vt_[st][0][0], vt_[st][0][1]), pk[KT_][st], o0_); \
                o1_ = MFMA32(cat44(vt_[st][1][0], vt_[st][1][1]), pk[KT_][st], o1_); } } while (0)
#define MA_VSTAGE(c_, WAIT_) do { \
        asm volatile("s_waitcnt vmcnt(" #WAIT_ ")\n\ts_barrier" ::: "memory"); \
        { const unsigned vb_ = (unsigned)(uintptr_t)(lds + ((c_) & 1) * 32768); \
          f32x16 o0_ = zero16(), o1_ = zero16(); \
          MA_PV(0, vb_); MA_PV(1, vb_); MA_PV(2, vb_); MA_PV(3, vb_); MA_PV(4, vb_); MA_PV(5, vb_); MA_PV(6, vb_); MA_PV(7, vb_); \
          _Pragma("unroll") for (int g = 0; g < 4; ++g) { \
              *(u32x2*)(dst + 64 * (c_) + 8 * g) = pack4(o0_[4 * g] * inv, o0_[4 * g + 1] * inv, o0_[4 * g + 2] * inv, o0_[4 * g + 3] * inv); \
              *(u32x2*)(dst + 64 * (c_) + 32 + 8 * g) = pack4(o1_[4 * g] * inv, o1_[4 * g + 1] * inv, o1_[4 * g + 2] * inv, o1_[4 * g + 3] * inv); } } \
        asm volatile("s_barrier" ::: "memory"); \
        if ((c_) + 2 < 4) MA_ISSUE(4 + (c_) + 2); } while (0)
    MA_VSTAGE(0, 8);
    MA_VSTAGE(1, 8);
    MA_VSTAGE(2, 8);
    MA_VSTAGE(3, 0);
#undef MA_ISSUE
#undef MA_KSTAGE
#undef MA_VSTAGE
#undef MA_PV
}

DI void phase_memattn(const Params& p, char* lds) {
    for (int item = vbid(); item < 512; item += vgrid()) {
        const int b = item >> 7, h = (item >> 5) & 3, tt = item & 31;
        memattn_unit(p, lds, b, h, tt);
    }
}
DI unsigned f2sort(float f) { const unsigned b = __float_as_uint(f); return b ^ ((b & 0x80000000u) ? 0xFFFFFFFFu : 0x80000000u); }
DI float sort2f(unsigned u) { const unsigned b = (u & 0x80000000u) ? (u ^ 0x80000000u) : ~u; return __uint_as_float(b); }
DI void cswap(unsigned& a, unsigned& b) { const unsigned hi = max(a, b), lo = min(a, b); a = hi; b = lo; }

template <int LO, int N> struct BClean {
    template <int M> static DI void run(unsigned (&a)[M]) {
#pragma unroll
        for (int i = 0; i < N / 2; ++i) cswap(a[LO + i], a[LO + i + N / 2]);
        BClean<LO, N / 2>::run(a); BClean<LO + N / 2, N / 2>::run(a);
    }
};
template <int LO> struct BClean<LO, 1> { template <int M> static DI void run(unsigned (&)[M]) {} };
template <int LO, int N> struct BSort {
    template <int M> static DI void run(unsigned (&a)[M]) {
        BSort<LO, N / 2>::run(a); BSort<LO + N / 2, N / 2>::run(a);
#pragma unroll
        for (int i = 0; i < N / 2; ++i) cswap(a[LO + i], a[LO + N - 1 - i]);
        BClean<LO, N / 2>::run(a); BClean<LO + N / 2, N / 2>::run(a);
    }
};
template <int LO> struct BSort<LO, 1> { template <int M> static DI void run(unsigned (&)[M]) {} };
DI void merge_top16(unsigned (&a)[16], const unsigned (&b)[16]) {
#pragma unroll
    for (int i = 0; i < 16; ++i) a[i] = max(a[i], b[15 - i]);
    BClean<0, 16>::run(a);
}

DI void peer_top16_core(const bf16_t* __restrict__ keys_hp, const bf16x8 (&qf)[8], int r, int hh, unsigned (&top)[16]) {
    unsigned cur[16];
#pragma unroll
    for (int kt = 0; kt < 4; ++kt) {
        f32x16 acc = zero16();
#pragma unroll
        for (int s = 0; s < 8; ++s) acc = MFMA32(ld16(keys_hp + (size_t)(32 * kt + r) * 128 + 16 * s + 8 * hh), qf[s], acc);
        unsigned k[16];
#pragma unroll
        for (int i = 0; i < 16; ++i) k[i] = (f2sort(acc[i]) & ~0x7Fu) | (unsigned)(32 * kt + crow(i, hh));
        BSort<0, 16>::run(k);
        if (kt == 0) {
#pragma unroll
            for (int i = 0; i < 16; ++i) cur[i] = k[i];
        } else merge_top16(cur, k);
    }
    unsigned r0[16], r1[16];
#pragma unroll
    for (int i = 0; i < 16; ++i) { auto rr = __builtin_amdgcn_permlane32_swap(cur[i], cur[i], false, false); r0[i] = rr[0]; r1[i] = rr[1]; }
#pragma unroll
    for (int i = 0; i < 16; ++i) top[i] = max(r0[i], r1[15 - i]);
    BClean<0, 16>::run(top);
}
DI void peer_top16(const bf16_t* __restrict__ keys_hp, const bf16_t* __restrict__ pq_row_hp, int r, int hh, unsigned (&top)[16]) {
    bf16x8 qf[8];
#pragma unroll
    for (int s = 0; s < 8; ++s) qf[s] = ld16(pq_row_hp + 16 * s + 8 * hh);
    peer_top16_core(keys_hp, qf, r, hh, top);
}
DI void peer_top16_lds(const bf16_t* __restrict__ keys_hp, const char* qrow, int rsw, int sd, int r, int hh, unsigned (&top)[16]) {
    bf16x8 qf[8];
#pragma unroll
    for (int s = 0; s < 8; ++s) qf[s] = ld16(qrow + (((16 * sd + 2 * s + hh) ^ rsw) << 4));
    peer_top16_core(keys_hp, qf, r, hh, top);
}

template <bool QLDS>
DI void peer_select_unit_t(char* ws, const bf16_t* PQ, char* lds, size_t tokbase, int h, const char* qhalf) {
    const int t = otid(), lane = t & 63, wv = t >> 6, r = lane & 31, hh = lane >> 5;
    const size_t tok = tokbase + 32 * wv + r;
    const bf16_t* KEYS = (const bf16_t*)(ws + OFF_KEYS);
    unsigned tA[16], tB[16];
    if (QLDS) {
        const int row = 32 * wv + r; const char* qrow = qhalf + row * 512;
        peer_top16_lds(KEYS + (size_t)(2 * h) * 16384, qrow, row & 31, 0, r, hh, tA);
        peer_top16_lds(KEYS + (size_t)(2 * h + 1) * 16384, qrow, row & 31, 1, r, hh, tB);
    } else {
        peer_top16(KEYS + (size_t)(2 * h) * 16384, PQ + tok * 2048 + (2 * h) * 128, r, hh, tA);
        peer_top16(KEYS + (size_t)(2 * h + 1) * 16384, PQ + tok * 2048 + (2 * h + 1) * 128, r, hh, tB);
    }
    float fA[16], fB[16];
#pragma unroll
    for (int i = 0; i < 16; ++i) { fA[i] = sort2f(tA[i] & ~0x7Fu); fB[i] = sort2f(tB[i] & ~0x7Fu); }
    unsigned* tab = (unsigned*)lds + wv * 1024;
    __syncthreads();
#pragma unroll
    for (int i = 0; i < 16; ++i) tab[i * 64 + lane] = (tA[i] & 0x7Fu) | ((tB[i] & 0x7Fu) << 16);
    unsigned c[64];
#pragma unroll
    for (int i = 0; i < 64; ++i) c[i] = 0u;
    {
        int n = 0;
#pragma unroll
        for (int a = 0; a < 16; ++a)
#pragma unroll
            for (int b = 0; b < 16; ++b)
                if ((a + 1) * (b + 1) <= 16) { c[n] = (f2sort(fA[a] + fB[b]) & ~0xFFu) | (unsigned)(a * 16 + b); ++n; }
    }
    unsigned g0[16], g1[16], g2[16], g3[16];
#pragma unroll
    for (int i = 0; i < 16; ++i) { g0[i] = c[i]; g1[i] = c[16 + i]; g2[i] = c[32 + i]; g3[i] = c[48 + i]; }
    BSort<0, 16>::run(g0); BSort<0, 16>::run(g1); BSort<0, 16>::run(g2); BSort<0, 16>::run(g3);
    merge_top16(g0, g1); merge_top16(g2, g3); merge_top16(g0, g2);
    float e[16]; float sum = 0.f;
    const float v0 = sort2f(g0[0] & ~0xFFu);
    unsigned ids[16];
#pragma unroll
    for (int i = 0; i < 16; ++i) {
        const float v = sort2f(g0[i] & ~0xFFu);
        e[i] = fast_exp2((v - v0) * LOG2E); sum += e[i];
        const unsigned a = (g0[i] >> 4) & 15u, b = g0[i] & 15u;
        const unsigned ia = tab[a * 64 + lane] & 0x7Fu, ib = (tab[b * 64 + lane] >> 16) & 0x7Fu;
        ids[i] = ia * 128u + ib;
    }
    const float inv = 1.0f / sum;
    if (hh == 0) {
        unsigned short* SID = (unsigned short*)(ws + OFF_SELID) + tok * 128 + h * 16;
        float* SG = (float*)(ws + OFF_SELG) + tok * 128 + h * 16;
        u32x4 w0, w1;
        w0[0] = ids[0] | (ids[1] << 16); w0[1] = ids[2] | (ids[3] << 16); w0[2] = ids[4] | (ids[5] << 16); w0[3] = ids[6] | (ids[7] << 16);
        w1[0] = ids[8] | (ids[9] << 16); w1[1] = ids[10] | (ids[11] << 16); w1[2] = ids[12] | (ids[13] << 16); w1[3] = ids[14] | (ids[15] << 16);
        *(u32x4*)SID = w0; *(u32x4*)(SID + 8) = w1;
#pragma unroll
        for (int q = 0; q < 4; ++q) *(f32x4*)(SG + 4 * q) = (f32x4){e[4 * q] * inv, e[4 * q + 1] * inv, e[4 * q + 2] * inv, e[4 * q + 3] * inv};
    }
}

DI void phase_select(const Params& p, char* lds) {
    for (int item = vbid(); item < 1024; item += vgrid()) peer_select_unit_t<false>(p.ws, (const bf16_t*)((const char*)p.out + OUT_PQ), lds, (size_t)(item >> 3) * 128, item & 7, nullptr);
}

DI float gelu_erf(float v) {
    const float av = fabsf(v), t = __builtin_amdgcn_rcpf(av * 0.2316418882f + 1.0f);
    float q = t * 0.5307027145f + (-0.7265760135f); q = q * t + 0.7107068705f; q = q * t + (-0.142248368f); q = q * t + 0.127414796f; q = q * t;
    const float e = __builtin_amdgcn_exp2f((v * v) * (-0.72134752044f));
    const float m = v * (q * e), r = v - m;
    return v < 0.f ? m : r;
}
DI int dppi(int v, const int ctrl) { return v; }
#define DPP_I(v, ctrl) __builtin_amdgcn_update_dpp(0, (v), (ctrl), 0xf, 0xf, true)
DI float ub0(unsigned w) { return (float)(w & 0xFFu); }
DI float ub1(unsigned w) { return (float)((w >> 8) & 0xFFu); }
DI float ub2(unsigned w) { return (float)((w >> 16) & 0xFFu); }
DI float ub3(unsigned w) { return (float)(w >> 24); }

struct GBatch { u32x4 U[4], V[4]; float su[4], sv[4], gate[4]; };

DI void gather_load(GBatch& B, const char* __restrict__ ws, unsigned idpair, f32x2 gpair, int eb, int lane) {
#pragma unroll
    for (int j = 0; j < 4; ++j) {
        const int e = eb + j;
        const unsigned pr = __shfl(idpair, e >> 1);
        const unsigned id = (j & 1) ? (pr >> 16) : (pr & 0xFFFFu);
        const float g0 = __shfl(gpair[0], e >> 1), g1 = __shfl(gpair[1], e >> 1);
        B.gate[j] = (j & 1) ? g1 : g0;
        B.U[j] = ldu4(ws + OFF_UQ + (size_t)id * 2048 + 16 * lane);
        B.V[j] = ldu4(ws + OFF_UQ + (size_t)id * 2048 + 1024 + 16 * lane);
        B.su[j] = ((const float*)(ws + OFF_SU))[id];
        B.sv[j] = ((const float*)(ws + OFF_SV))[id];
    }
}

DI void gather_compute(const GBatch& B, const unsigned (&qx)[4], float sx, float (&acc)[16], float& csum, int lane) {
    int pd[4];
#pragma unroll
    for (int j = 0; j < 4; ++j) {
        int d = 0;
#pragma unroll
        for (int q = 0; q < 4; ++q) d = __builtin_amdgcn_sdot4((int)B.U[j][q], (int)qx[q], d, false);
        pd[j] = d;
    }
    const bool b0 = lane & 1, b1 = lane & 2;
    const int kA = b0 ? pd[1] : pd[0], kB = b0 ? pd[3] : pd[2], sA = b0 ? pd[0] : pd[1], sB = b0 ? pd[2] : pd[3];
    const int qA = kA + DPP_I(sA, 0xB1), qB = kB + DPP_I(sB, 0xB1);
    const int kp = b1 ? qB : qA, sd = b1 ? qA : qB;
    int tot = kp + DPP_I(sd, 0x4E);
    tot += DPP_I(tot, 0x124);
    tot += DPP_I(tot, 0x128);
    tot += __builtin_amdgcn_ds_swizzle(tot, 0x401F);
    { auto rr = __builtin_amdgcn_permlane32_swap((unsigned)tot, (unsigned)tot, false, false); tot = (int)rr[0] + (int)rr[1]; }
    const int j3 = lane & 3;
    const float su_sel = (j3 == 0) ? B.su[0] : (j3 == 1 ? B.su[1] : (j3 == 2 ? B.su[2] : B.su[3]));
    const float ge = gelu_erf((float)tot * sx * su_sel);
#pragma unroll
    for (int j = 0; j < 4; ++j) {
        const float cf = B.gate[j] * B.sv[j] * __uint_as_float((unsigned)__builtin_amdgcn_readlane((int)__float_as_uint(ge), j));
#pragma unroll
        for (int q = 0; q < 4; ++q) {
            const int w = (int)B.V[j][q];
            const f32x2 lo = __builtin_amdgcn_cvt_pk_f32_fp8(w, false), hi = __builtin_amdgcn_cvt_pk_f32_fp8(w, true);
            acc[4 * q] += cf * lo[0]; acc[4 * q + 1] += cf * lo[1]; acc[4 * q + 2] += cf * hi[0]; acc[4 * q + 3] += cf * hi[1];
        }
    }
}

DI void gather_token(const Params& p, size_t tok, int lane, float* dst_base) {
    char* ws = p.ws;
    const bf16_t* hrow = (const bf16_t*)(ws + OFF_HB) + tok * 1024 + 16 * lane;
    float hv[16];
    {
        const u32x4 w0 = ldu4(hrow), w1 = ldu4(hrow + 8);
#pragma unroll
        for (int e = 0; e < 4; ++e) { hv[2 * e] = bf_lo(w0[e]); hv[2 * e + 1] = bf_hi(w0[e]); hv[8 + 2 * e] = bf_lo(w1[e]); hv[8 + 2 * e + 1] = bf_hi(w1[e]); }
    }
    float rs;
    {
        const float* SS = (const float*)(ws + OFF_SS2) + tok * 16;
        const f32x4 s0 = *(const f32x4*)SS, s1 = *(const f32x4*)(SS + 4), s2 = *(const f32x4*)(SS + 8), s3 = *(const f32x4*)(SS + 12);
        const float tot = (s0[0] + s0[1] + s0[2] + s0[3]) + (s1[0] + s1[1] + s1[2] + s1[3]) + (s2[0] + s2[1] + s2[2] + s2[3]) + (s3[0] + s3[1] + s3[2] + s3[3]);
        rs = rsqrtf(tot * (1.0f / 1024.0f) + 1e-6f);
    }
    float xf[16]; float am = 0.f;
#pragma unroll
    for (int i = 0; i < 4; ++i) {
        const f32x4 g = *(const f32x4*)(p.norm_ffn + 16 * lane + 4 * i);
#pragma unroll
        for (int e = 0; e < 4; ++e) { xf[4 * i + e] = hv[4 * i + e] * rs * g[e]; am = fmaxf(am, fabsf(xf[4 * i + e])); }
    }
#pragma unroll
    for (int o = 32; o; o >>= 1) am = fmaxf(am, __shfl_xor(am, o));
    const float sx = (am > 0.f) ? am * (1.0f / 127.0f) : 1.0f;
    const float isx = 1.0f / sx;
    unsigned qx[4];
#pragma unroll
    for (int i = 0; i < 4; ++i) {
        unsigned w = 0u;
#pragma unroll
        for (int e = 0; e < 4; ++e) w |= ((unsigned)(int)rintf(xf[4 * i + e] * isx) & 0xFFu) << (8 * e);
        qx[i] = w;
    }
    const unsigned idpair = *((const unsigned*)(ws + OFF_SELID) + tok * 64 + lane);
    const f32x2 gpair = *((const f32x2*)(ws + OFF_SELG) + tok * 64 + lane);
    float acc[16]; float csum = 0.f;
#pragma unroll
    for (int i = 0; i < 16; ++i) acc[i] = 0.f;
    GBatch B0, B1;
    gather_load(B0, ws, idpair, gpair, 0, lane);
#pragma unroll 1
    for (int eb = 0; eb < 128; eb += 8) {
        gather_load(B1, ws, idpair, gpair, eb + 4, lane);
        gather_compute(B0, qx, sx, acc, csum, lane);
        if (eb + 8 < 128) gather_load(B0, ws, idpair, gpair, eb + 8, lane);
        gather_compute(B1, qx, sx, acc, csum, lane);
    }
    float ss = 0.f;
#pragma unroll
    for (int i = 0; i < 16; ++i) { acc[i] = acc[i] - 128.0f * csum + hv[i]; ss += acc[i] * acc[i]; }
#pragma unroll
    for (int o = 32; o; o >>= 1) ss += __shfl_xor(ss, o);
    const float rf = rsqrtf(ss * (1.0f / 1024.0f) + 1e-6f);
    float* drow = dst_base + tok * 1024 + 16 * lane;
#pragma unroll
    for (int i = 0; i < 4; ++i) {
        const f32x4 n = *(const f32x4*)(p.norm_final + 16 * lane + 4 * i);
        *(f32x4*)(drow + 4 * i) = (f32x4){acc[4 * i] * rf * n[0], acc[4 * i + 1] * rf * n[1], acc[4 * i + 2] * rf * n[2], acc[4 * i + 3] * rf * n[3]};
    }
}

DI void phase_gather(const Params& p, bool dry = false) {
    const int lane = otid() & 63, wv = otid() >> 6;
    float* dst = dry ? (float*)(p.ws + OFF_A) : p.out;
    for (int item = vbid(); item < T_TOK / 4; item += vgrid()) gather_token(p, (size_t)item * 4 + wv, lane, dst);
}

constexpr size_t GS_PSTRIDE = 1040;
constexpr size_t GS_SGS = OFF_A;
constexpr size_t GS_XQ = GS_SGS + (size_t)T_TOK * GS_PSTRIDE;
constexpr size_t GS_ACC = GS_XQ + (size_t)T_TOK * 1024;
static_assert(GS_ACC <= OFF_A + 69 * MiB, "gather scratch overflows region A");

DI void gs_load(GBatch& B, const char* __restrict__ ws, unsigned myid, float mygate, int j0, int n, int lane) {
#pragma unroll
    for (int j = 0; j < 4; ++j) {
        const int e = __builtin_amdgcn_readfirstlane(j0 + j);
        const bool ok = e < n;
        const int src = ok ? e : 0;
        const unsigned id = (unsigned)__builtin_amdgcn_readlane((int)myid, src);
        const float g = __uint_as_float((unsigned)__builtin_amdgcn_readlane((int)__float_as_uint(mygate), src));
        B.gate[j] = ok ? g : 0.f;
        const char* urow = ws + OFF_UQ + (size_t)id * 2048;
        const char* vrow = urow + 1024;
        B.U[j] = ldu4(urow + 16 * lane);
        B.V[j] = ldu4(vrow + 16 * lane);
        B.su[j] = ((const float*)(ws + OFF_SU))[id];
        B.sv[j] = ((const float*)(ws + OFF_SV))[id];
    }
}

#ifndef GS_NSL
#define GS_NSL 16
#endif
constexpr int NSL = GS_NSL, NSL_SH = (GS_NSL == 8 ? 11 : (GS_NSL == 16 ? 10 : (GS_NSL == 32 ? 9 : 12))), OFFW = 64;
DI void phase_gather_sliced(const Params& p, char* smem) {
    char* ws = p.ws;
    if ((T_TOK / 8) > 8 * (((int)gridDim.x >> 3) * 8) || ((int)gridDim.x & 7)) { phase_gather(p); return; }
    const int wvi = __builtin_amdgcn_readfirstlane((int)(threadIdx.x >> 6));
    char* lacc = smem + wvi * 16384 + (threadIdx.x & 63) * 32;
    unsigned short* lids = (unsigned short*)(smem + 131072 + wvi * 2048);
    unsigned char* loff = (unsigned char*)(smem + 131072 + 16384 + wvi * (8 * OFFW));
    const int lane = threadIdx.x & 63;
    const int x = (int)blockIdx.x & 7, nW = ((int)gridDim.x >> 3) * 8, lw = ((int)blockIdx.x >> 3) * 8 + wvi;
    const int TPX = T_TOK / 8;
    for (int tl = lw; tl < TPX; tl += nW) {
        const size_t tok = (size_t)x * TPX + tl;
        const bf16_t* hrow = (const bf16_t*)(ws + OFF_HB) + tok * 1024 + 16 * lane;
        float hv[16];
        {
            const u32x4 w0 = ldu4(hrow), w1 = ldu4(hrow + 8);
#pragma unroll
            for (int e = 0; e < 4; ++e) { hv[2 * e] = bf_lo(w0[e]); hv[2 * e + 1] = bf_hi(w0[e]); hv[8 + 2 * e] = bf_lo(w1[e]); hv[8 + 2 * e + 1] = bf_hi(w1[e]); }
        }
        float rs;
        {
            const float* SS = (const float*)(ws + OFF_SS2) + tok * 16;
            const f32x4 s0 = *(const f32x4*)SS, s1 = *(const f32x4*)(SS + 4), s2 = *(const f32x4*)(SS + 8), s3 = *(const f32x4*)(SS + 12);
            const float tot = (s0[0] + s0[1] + s0[2] + s0[3]) + (s1[0] + s1[1] + s1[2] + s1[3]) + (s2[0] + s2[1] + s2[2] + s2[3]) + (s3[0] + s3[1] + s3[2] + s3[3]);
            rs = rsqrtf(tot * (1.0f / 1024.0f) + 1e-6f);
        }
        float xf[16]; float am = 0.f;
#pragma unroll
        for (int i = 0; i < 4; ++i) {
            const f32x4 g = *(const f32x4*)(p.norm_ffn + 16 * lane + 4 * i);
#pragma unroll
            for (int e = 0; e < 4; ++e) { xf[4 * i + e] = hv[4 * i + e] * rs * g[e]; am = fmaxf(am, fabsf(xf[4 * i + e])); }
        }
#pragma unroll
        for (int o = 32; o; o >>= 1) am = fmaxf(am, __shfl_xor(am, o));
        const float sx = (am > 0.f) ? am * (1.0f / 127.0f) : 1.0f;
        const float isx = 1.0f / sx;
        u32x4 qx;
#pragma unroll
        for (int i = 0; i < 4; ++i) {
            unsigned w = 0u;
#pragma unroll
            for (int e = 0; e < 4; ++e) w |= ((unsigned)(int)rintf(xf[4 * i + e] * isx) & 0xFFu) << (8 * e);
            qx[i] = w;
        }
        *(u32x4*)(ws + GS_XQ + tok * 1024 + 16 * lane) = qx;
        const unsigned idpair = *((const unsigned*)(ws + OFF_SELID) + tok * 64 + lane);
        const f32x2 gpair = *((const f32x2*)(ws + OFF_SELG) + tok * 64 + lane);
        const unsigned id0 = idpair & 0xFFFFu, id1 = idpair >> 16;
        const int sl0 = (int)(id0 >> NSL_SH), sl1 = (int)(id1 >> NSL_SH);
        const unsigned long long lt = (1ull << lane) - 1ull;
        int base = 0, pos0 = 0, pos1 = 0, myoff = 0;
#pragma unroll
        for (int s = 0; s < NSL; ++s) {
            const unsigned long long m0 = __ballot(sl0 == s), m1 = __ballot(sl1 == s);
            const int c0 = __popcll(m0), c1 = __popcll(m1);
            if (sl0 == s) pos0 = base + __popcll(m0 & lt);
            if (sl1 == s) pos1 = base + c0 + __popcll(m1 & lt);
            if (lane == s) myoff = base;
            base += c0 + c1;
        }
        if (lane == NSL) myoff = base;
        f32x2* sg = (f32x2*)(ws + GS_SGS + tok * GS_PSTRIDE);
        { const int k = (tl - lw) / nW; lids[k * 128 + pos0] = (unsigned short)id0; lids[k * 128 + pos1] = (unsigned short)id1; if (lane <= NSL) loff[k * OFFW + lane] = (unsigned char)myoff; }
        const float* SU = (const float*)(ws + OFF_SU); const float* SV = (const float*)(ws + OFF_SV);
        sg[pos0] = (f32x2){sx * SU[id0], gpair[0] * SV[id0]}; sg[pos1] = (f32x2){sx * SU[id1], gpair[1] * SV[id1]};
        if (lane == 0) sg[128] = (f32x2){0.f, 0.f};

    }
    __syncthreads();
    const int ntk = (TPX - lw + nW - 1) / nW;
    for (int k = 0; k < ntk; ++k) { *(u32x4*)(lacc + k * 2048) = (u32x4){0u, 0u, 0u, 0u}; *(u32x4*)(lacc + k * 2048 + 16) = (u32x4){0u, 0u, 0u, 0u}; }
    const char* tab = ws + OFF_UQ;
    u32x4 QX[8];
#pragma unroll
    for (int k = 0; k < 8; ++k) { const int kk = (k < ntk) ? k : 0; QX[k] = ldu4(ws + GS_XQ + ((size_t)x * TPX + lw + (size_t)kk * nW) * 1024 + 16 * lane); }
    asm volatile("" : "+v"(QX[0]), "+v"(QX[1]), "+v"(QX[2]), "+v"(QX[3]), "+v"(QX[4]), "+v"(QX[5]), "+v"(QX[6]), "+v"(QX[7]));
    const unsigned lane16 = 16u * (unsigned)lane;
    struct SB { u32x4 U[8], V[8]; f32x2 pr; int k, m; };
#pragma unroll 1
    for (int pass = 0; pass < NSL; ++pass) {
        const int slice = pass;
        int kL = 0, jL = 0, nL = 0, oL = 0;
        float acc[16]; int kC = -1; u32x4 qxC = QX[0];
#define GS_OPEN(k_) do { oL = __builtin_amdgcn_readfirstlane((int)loff[(k_) * OFFW + slice]); nL = __builtin_amdgcn_readfirstlane((int)loff[(k_) * OFFW + slice + 1]) - oL; jL = 0; } while (0)
#define GS_ADVANCE(ok_) do { if (jL + 8 < nL) { jL += 8; ok_ = true; } else if (kL + 1 >= ntk) ok_ = false; else { ++kL; GS_OPEN(kL); ok_ = true; } } while (0)
#define GS_LOAD(B_, valid_) do { const size_t tok_ = (size_t)x * TPX + lw + (size_t)kL * nW; \
            const int el_ = jL + (lane & 7); const bool okl_ = el_ < nL;            \
            const unsigned idv_ = (unsigned)lids[kL * 128 + ((oL + (okl_ ? el_ : 0)) & 127)]; \
            const unsigned pro_ = okl_ ? 8u * (unsigned)((oL + el_) & 127) : 1024u;            \
            const char* prb_ = ws + GS_SGS + tok_ * GS_PSTRIDE; \
            B_.m = (valid_) ? min(8, nL - jL) : 0; \
            asm volatile("global_load_dwordx2 %0, %1, %2" : "=v"(B_.pr) : "v"(pro_), "s"(prb_)); \
            _Pragma("unroll") for (int j = 0; j < 8; ++j) if (j < B_.m) { const unsigned id_ = (unsigned)__builtin_amdgcn_readlane((int)idv_, j); const char* rb_ = tab + (size_t)id_ * 2048; \
                asm volatile("global_load_dwordx4 %0, %1, %2" : "+v"(B_.U[j]) : "v"(lane16), "s"(rb_)); \
                asm volatile("global_load_dwordx4 %0, %1, %2 offset:1024" : "+v"(B_.V[j]) : "v"(lane16), "s"(rb_)); } \
            B_.k = (valid_) ? kL : -1; } while (0)
#define GS_WAITN(n_) asm volatile("s_waitcnt vmcnt(" #n_ ")" ::: "memory")
#define GS_WAIT(B_, mn_) do { const int mn__ = (mn_); \
            if (mn__ >= 8) GS_WAITN(17); else if (mn__ == 7) GS_WAITN(15); else if (mn__ == 6) GS_WAITN(13); else if (mn__ == 5) GS_WAITN(11); else if (mn__ == 4) GS_WAITN(9); \
            else if (mn__ == 3) GS_WAITN(7); else if (mn__ == 2) GS_WAITN(5); else if (mn__ == 1) GS_WAITN(3); else GS_WAITN(1); \
            asm volatile("" : "+v"(B_.U[0]), "+v"(B_.U[1]), "+v"(B_.U[2]), "+v"(B_.U[3]), "+v"(B_.U[4]), "+v"(B_.U[5]), "+v"(B_.U[6]), "+v"(B_.U[7]), "+v"(B_.pr) :: "memory"); \
            asm volatile("" : "+v"(B_.V[0]), "+v"(B_.V[1]), "+v"(B_.V[2]), "+v"(B_.V[3]), "+v"(B_.V[4]), "+v"(B_.V[5]), "+v"(B_.V[6]), "+v"(B_.V[7]) :: "memory"); } while (0)
#define GS_FLUSH() do { if (kC >= 0) { char* la_ = lacc + kC * 2048; u32x4 w0_, w1_; \
                _Pragma("unroll") for (int e = 0; e < 4; ++e) { w0_[e] = pack2(acc[2 * e], acc[2 * e + 1]); w1_[e] = pack2(acc[8 + 2 * e], acc[8 + 2 * e + 1]); } \
                *(u32x4*)la_ = w0_; *(u32x4*)(la_ + 16) = w1_; } } while (0)
#define GS_CONSUME(B_) do { if (B_.k >= 0) { \
            if (B_.k != kC) { GS_FLUSH(); kC = B_.k; qxC = QX[0]; _Pragma("unroll") for (int t_ = 1; t_ < 8; ++t_) if (kC == t_) qxC = QX[t_]; const char* la_ = lacc + kC * 2048; const u32x4 w0_ = *(const u32x4*)la_, w1_ = *(const u32x4*)(la_ + 16); \
                _Pragma("unroll") for (int e = 0; e < 4; ++e) { acc[2 * e] = bf_lo(w0_[e]); acc[2 * e + 1] = bf_hi(w0_[e]); acc[8 + 2 * e] = bf_lo(w1_[e]); acc[8 + 2 * e + 1] = bf_hi(w1_[e]); } } \
            int pd_[8]; \
            _Pragma("unroll") for (int j = 0; j < 8; ++j) { int d_ = 0; if (j < B_.m) { _Pragma("unroll") for (int q = 0; q < 4; ++q) d_ = __builtin_amdgcn_sdot4((int)B_.U[j][q], (int)qxC[q], d_, false); } pd_[j] = d_; } \
            const bool b0_ = lane & 1, b1_ = lane & 2, b2_ = lane & 4; \
            int q1_[4]; _Pragma("unroll") for (int j = 0; j < 4; ++j) { const int kp_ = b0_ ? pd_[2 * j + 1] : pd_[2 * j], sd_ = b0_ ? pd_[2 * j] : pd_[2 * j + 1]; q1_[j] = kp_ + DPP_I(sd_, 0xB1); }        \
            int q2_[2]; _Pragma("unroll") for (int j = 0; j < 2; ++j) { const int kp_ = b1_ ? q1_[2 * j + 1] : q1_[2 * j], sd_ = b1_ ? q1_[2 * j] : q1_[2 * j + 1]; q2_[j] = kp_ + DPP_I(sd_, 0x4E); }     \
            int tot_; { const int kp_ = b2_ ? q2_[1] : q2_[0], sd_ = b2_ ? q2_[0] : q2_[1]; tot_ = kp_ + __builtin_amdgcn_ds_swizzle(sd_, 0x101F); }                                                \
            tot_ += DPP_I(tot_, 0x128); tot_ += __builtin_amdgcn_ds_swizzle(tot_, 0x401F); \
            { auto rr_ = __builtin_amdgcn_permlane32_swap((unsigned)tot_, (unsigned)tot_, false, false); tot_ = (int)rr_[0] + (int)rr_[1]; } \
            const float cfv_ = B_.pr[1] * gelu_erf((float)tot_ * B_.pr[0]); \
            _Pragma("unroll") for (int j = 0; j < 8; ++j) if (j < B_.m) { const float cf_ = __uint_as_float((unsigned)__builtin_amdgcn_readlane((int)__float_as_uint(cfv_), j)); \
                _Pragma("unroll") for (int q = 0; q < 4; ++q) { const int w_ = (int)B_.V[j][q]; const f32x2 lo_ = __builtin_amdgcn_cvt_pk_f32_fp8(w_, false), hi_ = __builtin_amdgcn_cvt_pk_f32_fp8(w_, true); \
                    acc[4 * q] += cf_ * lo_[0]; acc[4 * q + 1] += cf_ * lo_[1]; acc[4 * q + 2] += cf_ * hi_[0]; acc[4 * q + 3] += cf_ * hi_[1]; } } } } while (0)
        SB S0, S1;
        _Pragma("unroll") for (int j = 0; j < 8; ++j) { S0.U[j] = S0.V[j] = S1.U[j] = S1.V[j] = (u32x4){0u, 0u, 0u, 0u}; }
        bool h0, h1;
        GS_OPEN(0);
        GS_LOAD(S0, true);
#pragma unroll 1
        for (;;) {
            GS_ADVANCE(h1); GS_LOAD(S1, h1);
            GS_WAIT(S0, S1.m); GS_CONSUME(S0);
            if (!h1) break;
            GS_ADVANCE(h0); GS_LOAD(S0, h0);
            GS_WAIT(S1, S0.m); GS_CONSUME(S1);
            if (!h0) break;
        }
        asm volatile("s_waitcnt vmcnt(0)" ::: "memory");
        GS_FLUSH();
#undef GS_OPEN
#undef GS_ADVANCE
#undef GS_LOAD
#undef GS_FLUSH
#undef GS_CONSUME
#undef GS_WAIT
#undef GS_WAITN
    }
    for (int k = 0; k < ntk; ++k) {
        const size_t tok = (size_t)x * TPX + lw + (size_t)k * nW;
        const char* la = lacc + k * 2048; const u32x4 a0 = *(const u32x4*)la, a1 = *(const u32x4*)(la + 16);
        const bf16_t* hrow = (const bf16_t*)(ws + OFF_HB) + tok * 1024 + 16 * lane; const u32x4 w0 = ldu4(hrow), w1 = ldu4(hrow + 8);
        float acc[16]; float ss = 0.f;
#pragma unroll
        for (int e = 0; e < 4; ++e) { acc[2 * e] = bf_lo(a0[e]) + bf_lo(w0[e]); acc[2 * e + 1] = bf_hi(a0[e]) + bf_hi(w0[e]); acc[8 + 2 * e] = bf_lo(a1[e]) + bf_lo(w1[e]); acc[8 + 2 * e + 1] = bf_hi(a1[e]) + bf_hi(w1[e]); }
#pragma unroll
        for (int i = 0; i < 16; ++i) ss += acc[i] * acc[i];
#pragma unroll
        for (int o = 32; o; o >>= 1) ss += __shfl_xor(ss, o);
        const float rf = rsqrtf(ss * (1.0f / 1024.0f) + 1e-6f); float* drow = p.out + tok * 1024 + 16 * lane;
#pragma unroll
        for (int i = 0; i < 4; ++i) { const f32x4 nn = *(const f32x4*)(p.norm_final + 16 * lane + 4 * i);
            *(f32x4*)(drow + 4 * i) = (f32x4){acc[4 * i] * rf * nn[0], acc[4 * i + 1] * rf * nn[1], acc[4 * i + 2] * rf * nn[2], acc[4 * i + 3] * rf * nn[3]}; }
    }
}

struct EpiPQSel8 {
    static constexpr bool PERM = true, AFTER_DRAIN = true;
    char* ws; const float* SS; char* smem;
    DI void operator()(EPI_ARGS) const {}
    DI void fused(EPI_ARGS, PG8_LAS unsigned char*, int, int) const {
#pragma unroll
        for (int ai = 0; ai < 2; ++ai)
#pragma unroll
            for (int m = 0; m < 4; ++m) {
                int fr_ = fr; asm volatile("" : "+v"(fr_));
                const int row = ai * 128 + wr * 64 + m * 16 + fr_;
                const size_t tok = (size_t)u.pm * 256 + row;
                const f32x4 s0 = *(const f32x4*)(SS + tok * 16), s1 = *(const f32x4*)(SS + tok * 16 + 4), s2 = *(const f32x4*)(SS + tok * 16 + 8), s3 = *(const f32x4*)(SS + tok * 16 + 12);
                const float tot = (s0[0] + s0[1] + s0[2] + s0[3]) + (s1[0] + s1[1] + s1[2] + s1[3]) + (s2[0] + s2[1] + s2[2] + s2[3]) + (s3[0] + s3[1] + s3[2] + s3[3]);
                const float sc = rsqrtf(tot * (1.0f / 1024.0f) + 1e-6f);
#pragma unroll
                for (int bj = 0; bj < 2; ++bj) { EPI_LOAD8(v, ai, bj, m); *(u32x4*)(smem + row * 512 + (((16 * bj + 4 * wc + fq) ^ (row & 31)) << 4)) = pack8(v, sc); }
            }
        __syncthreads();
        char* half = smem + vhalf() * 65536;
        peer_select_unit_t<true>(ws, nullptr, half, (size_t)u.pm * 256 + 128 * vhalf(), u.pn, half);
        __syncthreads();
    }
};
struct OneUnit {
    pg8::StaticOrder S; int rep;
    DI bool next(int i, pg8::Unit& u) const { return i == 0 && S.next(rep, u); }
    DI void a_ready(const pg8::Unit&) const {}
    DI void done(const pg8::Unit&) const {}
};
DI void phase_pqsel(const Params& p, char* smem) {
    char* ws = p.ws;
    pg8::Gemm g; g.A = (const bf16_t*)(ws + OFF_HB); g.Bt = (const bf16_t*)(ws + OFF_WT_PQ); g.M = T_TOK; g.N = 2048; g.K = 1024; g.lda = 1024;
    const int G = (int)gridDim.x;
    OneUnit S; S.S.init(T_TOK, 2048, G, (int)blockIdx.x); S.rep = 0;
    EpiPQSel8 e{ws, (const float*)(ws + OFF_SS2), smem};
    const int nrep = (64 * 8 + G - 1) / G;
#pragma unroll 1
    for (int rep = 0; rep < nrep; ++rep) { S.rep = rep; pg8::gemm_phase<EpiPQSel8, OneUnit, true, true>((PG8_LAS unsigned char*)smem, g, S, e); }
}
constexpr int LDS_BYTES = 131072 + 16384 + 4096;
constexpr int NPHASE = 12;
template <int PH> DI void run_phase(const Params& p, char* smem) {
    char* lds = smem + vhalf() * 65536;
    if (PH == 0) phase_prep(p, lds);
    else if (PH == 1) phase_p1(p, smem);
    else if (PH == 2) phase_p2(p, smem);
    else if (PH == 3) phase_p3(p, lds);
    else if (PH == 4) phase_p35(p, lds);
    else if (PH == 5) phase_resid<false>(p, smem, OFF_WT_OUT, OFF_MIXED, p.x, OFF_SS1);
    else if (PH == 6) phase_rowscale(p, smem, OFF_WT_MQ, 1024, (bf16_t*)(p.ws + OFF_QM), OFF_SS1, 0.0625f * LOG2E);
    else if (PH == 7) phase_memattn(p, lds);
    else if (PH == 8) phase_resid<true>(p, smem, OFF_WT_MO, OFF_OM, p.ws + OFF_HB, OFF_SS2);
    else if (PH == 9) phase_pqsel(p, smem);
    else if (PH == 11) phase_gather_sliced(p, smem);
}

template <int PH> __global__ void __launch_bounds__(512, 2) k_phase(Params p) {
    __shared__ __attribute__((aligned(16))) char smem[LDS_BYTES];
    run_phase<PH>(p, smem);
}

static Params make_params(void* const* d_in, void* d_out, void* d_ws) {
    Params p;
    memset(&p, 0, sizeof(p));
    p.x = (const float*)d_in[0]; p.mem = (const float*)d_in[1]; p.norm_mix = (const float*)d_in[2]; p.w_in = (const float*)d_in[3];
    p.q_norm = (const float*)d_in[4]; p.kv_norm = (const float*)d_in[5]; p.w_uq = (const float*)d_in[6]; p.w_ukv = (const float*)d_in[7];
    p.gn_mla = (const float*)d_in[8]; p.gn_dil = (const float*)d_in[9]; p.w_out = (const float*)d_in[10]; p.norm_mem_q = (const float*)d_in[11];
    p.norm_mem_kv = (const float*)d_in[12]; p.w_mem_q = (const float*)d_in[13]; p.w_mem_kv = (const float*)d_in[14]; p.w_mem_o = (const float*)d_in[15];
    p.norm_ffn = (const float*)d_in[16]; p.peer_w_q = (const float*)d_in[17]; p.sub_keys = (const float*)d_in[18]; p.peer_u = (const float*)d_in[19];
    p.peer_v = (const float*)d_in[20]; p.norm_final = (const float*)d_in[21];
    p.out = (float*)d_out; p.ws = (char*)d_ws;
    for (int i = 0; i < 16; ++i) p.inv_freq[i] = 1.0f / powf(10000.0f, (float)(2 * i) / 32.0f);
    return p;
}
__global__ void __launch_bounds__(512, 2) k_mega(Params p) {
    __shared__ __attribute__((aligned(16))) char smem[LDS_BYTES + 16];
    volatile LAS unsigned* st = (volatile LAS unsigned*)(LAS char*)(smem + LDS_BYTES);
    if (threadIdx.x == 0) { st[0] = 0u; st[1] = 0u; st[2] = 0u; st[3] = 0u; }
    __syncthreads();
    const XcdBarrier xb = xcd_barrier_post((unsigned*)(p.ws + OFF_BAR), st);
#define RP(n) run_phase<n>(p, smem); xcd_barrier(xb);
    RP(0) RP(1) RP(2) RP(3) RP(4) RP(5) RP(6) RP(7) RP(8) RP(9)
    run_phase<11>(p, smem);
}

extern "C" void kernel_launch(void* const* d_in, const int* in_sizes, int n_in, void* d_out, int out_size, void* d_ws, size_t ws_size,
                              hipStream_t stream) {
    static int grid_blocks = 0;
    if (!grid_blocks) {
        int dev = 0, cus = 0, per_cu = 0;
        (void)hipGetDevice(&dev);
        (void)hipDeviceGetAttribute(&cus, hipDeviceAttributeMultiprocessorCount, dev);
        (void)hipOccupancyMaxActiveBlocksPerMultiprocessor(&per_cu, k_mega, 512, 0);
        if (per_cu > 1) per_cu = 1;
        if (per_cu < 1) per_cu = 1;
        grid_blocks = cus * per_cu;
    }
    Params p = make_params(d_in, d_out, d_ws);
    (void)hipMemsetAsync((char*)d_ws + OFF_BAR, 0, XCD_BAR_WORDS * 4, stream);
    void* args[] = {&p};
    hipError_t e = hipLaunchCooperativeKernel((const void*)k_mega, dim3(grid_blocks), dim3(512), args, 0, stream);
    if (e != hipSuccess) fprintf(stderr, "cooperative launch failed: %s (grid %d)\n", hipGetErrorString(e), grid_blocks);
}
```

```cpp
#include <hip/hip_runtime.h>
#include <hip/hip_cooperative_groups.h>
#include <math.h>
#include <stdint.h>
#include <stdio.h>
#include <string.h>
#define DI __device__ __forceinline__
typedef unsigned short bf16_t;
typedef short bf16x8 __attribute__((ext_vector_type(8)));
typedef short s16x4 __attribute__((ext_vector_type(4)));
typedef float f32x16 __attribute__((ext_vector_type(16)));
typedef float f32x4 __attribute__((ext_vector_type(4)));
typedef float f32x2 __attribute__((ext_vector_type(2)));
typedef unsigned u32x4 __attribute__((ext_vector_type(4)));
typedef unsigned u32x2 __attribute__((ext_vector_type(2)));
typedef __bf16 bf16x2v __attribute__((ext_vector_type(2)));
#define LAS __attribute__((address_space(3)))
#define MFMA32(a, b, c) __builtin_amdgcn_mfma_f32_32x32x16_bf16((a), (b), (c), 0, 0, 0)

constexpr int T_TOK = 16384, SEQ_L = 4096, DM = 1024, INC = 2208;
constexpr float LOG2E = 1.4426950408889634f;

DI int otid() { int t = threadIdx.x & 255; asm volatile("" : "+v"(t)); return t; }
DI int vhalf() { return __builtin_amdgcn_readfirstlane((int)(threadIdx.x >> 8)); }
DI int vbid() { return (int)blockIdx.x * 2 + vhalf(); }
DI int vgrid() { return (int)gridDim.x * 2; }
DI unsigned pack2(float lo, float hi) { f32x2 f = {lo, hi}; return __builtin_bit_cast(unsigned, __builtin_convertvector(f, bf16x2v)); }
DI float bf_lo(unsigned u) { return __uint_as_float(u << 16); }
DI float bf_hi(unsigned u) { return __uint_as_float(u & 0xffff0000u); }
DI float bf2f(bf16_t v) { return __uint_as_float(((unsigned)v) << 16); }
DI int crow(int reg, int hh) { return (reg & 3) + 8 * (reg >> 2) + 4 * hh; }
DI f32x16 zero16() { f32x16 z;
#pragma unroll
    for (int i = 0; i < 16; ++i) z[i] = 0.f; return z; }
DI float xhalf_max(float v) { auto r = __builtin_amdgcn_permlane32_swap(__float_as_uint(v), __float_as_uint(v), false, false); return fmaxf(__uint_as_float(r[0]), __uint_as_float(r[1])); }
DI float xhalf_other(float v, int lane) { auto r = __builtin_amdgcn_permlane32_swap(__float_as_uint(v), __float_as_uint(v), false, false); return __uint_as_float((lane & 32) ? r[0] : r[1]); }
DI float xhalf_sum(float v) { auto r = __builtin_amdgcn_permlane32_swap(__float_as_uint(v), __float_as_uint(v), false, false); return __uint_as_float(r[0]) + __uint_as_float(r[1]); }
DI bf16x8 ld16(const void* p) { return *(const bf16x8*)p; }
DI u32x4 ldu4(const void* p) { return *(const u32x4*)p; }
DI float fast_exp2(float x) { return __builtin_amdgcn_exp2f(x); }
DI bf16x8 pack_step(const f32x16& x, int s) {
    u32x4 p;
    p[0] = pack2(x[8 * s + 0], x[8 * s + 1]); p[1] = pack2(x[8 * s + 2], x[8 * s + 3]);
    p[2] = pack2(x[8 * s + 4], x[8 * s + 5]); p[3] = pack2(x[8 * s + 6], x[8 * s + 7]);
    return __builtin_bit_cast(bf16x8, p);
}
DI s16x4 tr_read_a(unsigned lds_byte_addr) { s16x4 r; asm volatile("ds_read_b64_tr_b16 %0, %1" : "=v"(r) : "v"(lds_byte_addr)); return r; }
template <int OFF> DI s16x4 tr_read_ao(unsigned lds_byte_addr) { s16x4 r; asm volatile("ds_read_b64_tr_b16 %0, %1 offset:%2" : "=v"(r) : "v"(lds_byte_addr), "i"(OFF)); return r; }
#define TR_WAIT() do { asm volatile("s_waitcnt lgkmcnt(0)" ::: "memory"); __builtin_amdgcn_sched_barrier(0); } while (0)
DI s16x4 tr_read(unsigned lds_byte_addr) {
    return __builtin_amdgcn_ds_read_tr16_b64_v4i16((LAS s16x4*)(uintptr_t)lds_byte_addr);
}

constexpr size_t MiB = 1ull << 20;
constexpr size_t OFF_BAR = 0;
constexpr size_t OFF_WT_IN = 65536;
constexpr size_t OFF_WT_UQ = OFF_WT_IN + 2304ull * 1024 * 2;
constexpr size_t OFF_WT_UKV = OFF_WT_UQ + 768ull * 384 * 2;
constexpr size_t OFF_WT_OUT = OFF_WT_UKV + 1024ull * 256 * 2;
constexpr size_t OFF_WT_MQ = OFF_WT_OUT + 1024ull * 1024 * 2;
constexpr size_t OFF_WT_MKV = OFF_WT_MQ + 1024ull * 1024 * 2;
constexpr size_t OFF_WT_MO = OFF_WT_MKV + 2048ull * 1024 * 2;
constexpr size_t OFF_WT_PQ = OFF_WT_MO + 1024ull * 1024 * 2;
constexpr size_t OFF_KEYS = OFF_WT_PQ + 2048ull * 1024 * 2;
constexpr size_t OFF_ROPE = OFF_KEYS + 16ull * 128 * 128 * 2;
constexpr size_t OFF_KR = OFF_ROPE + 2ull * 4096 * 16 * 4;
constexpr size_t OFF_LSE = OFF_KR + (size_t)T_TOK * 32 * 2;
constexpr size_t OFF_SS1 = OFF_LSE + 3ull * T_TOK * 8 * 4;
constexpr size_t OFF_SS2 = OFF_SS1 + (size_t)T_TOK * 16 * 4;
constexpr size_t OFF_MEMN = OFF_SS2 + (size_t)T_TOK * 16 * 4;
constexpr size_t OFF_SMALL_END = OFF_MEMN + 1024ull * 1024 * 2;
static_assert(OFF_SMALL_END <= 28 * MiB, "small region overflow");
constexpr size_t OFF_A = 28 * MiB;
constexpr size_t OFF_PROJ = OFF_A;
constexpr size_t OFF_UQ = 193 * MiB;
constexpr size_t OFF_SU = 243 * MiB;
constexpr size_t OFF_SV = OFF_SU + 65536;
constexpr size_t OUT_ODIL = 0;
constexpr size_t OUT_OMLA = 48 * MiB;
constexpr size_t OUT_PQ = 0;
constexpr size_t OFF_B = 97 * MiB;
constexpr size_t OFF_XN = OFF_B, OFF_QMLA = OFF_B, OFF_MIXED = OFF_B, OFF_QM = OFF_B;
constexpr size_t OFF_C = 129 * MiB;
constexpr size_t OFF_KVMLA = OFF_C, OFF_HB = OFF_C;
constexpr size_t OFF_D = 161 * MiB;
constexpr size_t OFF_OM = OFF_D;
constexpr size_t OFF_SELID = 225 * MiB;
constexpr size_t OFF_SELG = 229 * MiB;
constexpr size_t OFF_KVM = 237 * MiB;
constexpr size_t OFF_SSQ = 241 * MiB;
constexpr size_t WS_NEEDED = 244 * MiB;

struct Params {
    const float* x; const float* mem; const float* norm_mix; const float* w_in; const float* q_norm; const float* kv_norm;
    const float* w_uq; const float* w_ukv; const float* gn_mla; const float* gn_dil; const float* w_out; const float* norm_mem_q;
    const float* norm_mem_kv; const float* w_mem_q; const float* w_mem_kv; const float* w_mem_o; const float* norm_ffn;
    const float* peer_w_q; const float* sub_keys; const float* peer_u; const float* peer_v; const float* norm_final;
    float* out; char* ws;
    float inv_freq[16];
    int prof; int pad_;
};
#define XB_TMO      128
#define XB_XCNT(j)  (256  + 64 * (j))
#define XB_XSUB(j)  (1280 + 64 * (j))
#define XB_XGEN(j)  (2304 + 64 * (j))
#define XB_TOP      3328
#define XB_TOPGEN   3392
#define XCD_BAR_WORDS 3456
#define XB_SPIN_CAP (1u << 20)
DI unsigned xb_ld(unsigned* p) { return __hip_atomic_load(p, __ATOMIC_RELAXED, __HIP_MEMORY_SCOPE_AGENT); }
DI unsigned xb_add(unsigned* p, unsigned v) { return __hip_atomic_fetch_add(p, v, __ATOMIC_RELAXED, __HIP_MEMORY_SCOPE_AGENT); }
DI unsigned xb_xcc_id() { return (unsigned)__builtin_amdgcn_s_getreg((3 << 11) | 20) & 0xFu; }
#define XB_SPIN(cond, bar) do { unsigned _sp = 0; while (cond) { __builtin_amdgcn_s_sleep(1); \
    if ((++_sp & 255u) == 0u) { if (xb_ld(&(bar)[XB_TMO])) break; if (_sp > XB_SPIN_CAP) { atomicAdd(&(bar)[XB_TMO], 1u); break; } } } } while (0)
struct XcdBarrier { unsigned* bar; unsigned x; volatile LAS unsigned* st; };
DI XcdBarrier xcd_barrier_post(unsigned* bar, volatile LAS unsigned* st) {
    XcdBarrier b; b.bar = bar; b.x = xb_xcc_id(); b.st = st;
    if (threadIdx.x == 0) (void)xb_add(&bar[XB_XCNT(b.x)], 1u);
    return b;
}
DI void xcd_barrier_complete(unsigned* bar, unsigned x, unsigned& nloc, unsigned& nx) {
    const unsigned G = gridDim.x * gridDim.y * gridDim.z;
    unsigned sum, cnt, mine, sp = 0u;
    for (;;) {
        sum = 0u; cnt = 0u; mine = 0u;
#pragma unroll
        for (unsigned j = 0; j < 16; ++j) { const unsigned c = xb_ld(&bar[XB_XCNT(j)]); sum += c; cnt += (c > 0u) ? 1u : 0u; mine = (j == x) ? c : mine; }
        if (sum == G) break;
        __builtin_amdgcn_s_sleep(1);
        if ((++sp & 255u) == 0u) { if (xb_ld(&bar[XB_TMO])) break; if (sp > XB_SPIN_CAP) { atomicAdd(&bar[XB_TMO], 1u); break; } }
    }
    nloc = mine > 0u ? mine : 1u; nx = cnt > 0u ? cnt : 1u;
}
DI void xcd_barrier(const XcdBarrier& b) {
    asm volatile("s_waitcnt vmcnt(0)" ::: "memory");
    __syncthreads();
    if (threadIdx.x == 0) {
        unsigned* bar = b.bar;
        __builtin_amdgcn_s_waitcnt(0);
        unsigned nloc = b.st[0], nx = b.st[1];
        if (nloc == 0u) { xcd_barrier_complete(bar, b.x, nloc, nx); b.st[0] = nloc; b.st[1] = nx; }
        const unsigned old = xb_add(&bar[XB_XSUB(b.x)], 1u);
        const unsigned gen = old / nloc;
        if (old + 1u == (gen + 1u) * nloc) {
            __builtin_amdgcn_fence(__ATOMIC_RELEASE, "agent");
            asm volatile("s_waitcnt vmcnt(0)" ::: "memory");
            const unsigned og = xb_add(&bar[XB_TOP], 1u);
            const unsigned tg = og / nx;
            if (og + 1u == (tg + 1u) * nx) xb_add(&bar[XB_TOPGEN], 1u);
            else XB_SPIN(xb_ld(&bar[XB_TOPGEN]) == tg, bar);
            __builtin_amdgcn_fence(__ATOMIC_ACQUIRE, "agent");
            xb_add(&bar[XB_XGEN(b.x)], 1u);
            asm volatile("s_waitcnt vmcnt(0)" ::: "memory");
        } else {
            XB_SPIN(xb_ld(&bar[XB_XGEN(b.x)]) == gen, bar);
            __builtin_amdgcn_fence(__ATOMIC_ACQUIRE, "agent");
            asm volatile("s_waitcnt vmcnt(0)" ::: "memory");
        }
    }
    __syncthreads();
}
DI void transpose_tile(const float* __restrict__ W, int K, int N, const float* __restrict__ g, bf16_t* __restrict__ Wt, int kt, int nt, char* lds, bool valid) {
    float* sm = (float*)lds;
    const int t = otid();
    const int k0 = kt * 64, n0 = nt * 64;
    __syncthreads();
#pragma unroll
    for (int i = 0; i < 16; ++i) {
        const int id = t + 256 * i, k = id >> 6, n = id & 63;
        float v = 0.f;
        if (valid && n0 + n < N) { v = W[(size_t)(k0 + k) * N + n0 + n]; if (g) v *= g[k0 + k]; }
        sm[k * 65 + n] = v;
    }
    __syncthreads();
    const int n = t >> 2, kc = (t & 3) * 16;
    u32x4 o0, o1;
    o0[0] = pack2(sm[(kc + 0) * 65 + n], sm[(kc + 1) * 65 + n]); o0[1] = pack2(sm[(kc + 2) * 65 + n], sm[(kc + 3) * 65 + n]);
    o0[2] = pack2(sm[(kc + 4) * 65 + n], sm[(kc + 5) * 65 + n]); o0[3] = pack2(sm[(kc + 6) * 65 + n], sm[(kc + 7) * 65 + n]);
    o1[0] = pack2(sm[(kc + 8) * 65 + n], sm[(kc + 9) * 65 + n]); o1[1] = pack2(sm[(kc + 10) * 65 + n], sm[(kc + 11) * 65 + n]);
    o1[2] = pack2(sm[(kc + 12) * 65 + n], sm[(kc + 13) * 65 + n]); o1[3] = pack2(sm[(kc + 14) * 65 + n], sm[(kc + 15) * 65 + n]);
    bf16_t* dst = Wt + (size_t)(n0 + n) * K + k0 + kc;
    if (valid) { *(u32x4*)dst = o0; *(u32x4*)(dst + 8) = o1; }
}

DI void rmsnorm_row_bf16(const float* __restrict__ in, const float* __restrict__ g, bf16_t* __restrict__ out, int lane) {
    f32x4 v[4]; float ss = 0.f;
#pragma unroll
    for (int i = 0; i < 4; ++i) { v[i] = *(const f32x4*)(in + 4 * lane + 256 * i); ss += v[i][0] * v[i][0] + v[i][1] * v[i][1] + v[i][2] * v[i][2] + v[i][3] * v[i][3]; }
#pragma unroll
    for (int o = 32; o; o >>= 1) ss += __shfl_xor(ss, o);
    const float rs = rsqrtf(ss * (1.0f / 1024.0f) + 1e-6f);
#pragma unroll
    for (int i = 0; i < 4; ++i) {
        const f32x4 gg = *(const f32x4*)(g + 4 * lane + 256 * i);
        u32x2 o; o[0] = pack2(v[i][0] * rs * gg[0], v[i][1] * rs * gg[1]); o[1] = pack2(v[i][2] * rs * gg[2], v[i][3] * rs * gg[3]);
        *(u32x2*)(out + 4 * lane + 256 * i) = o;
    }
}

struct TrJob { const float* W; const float* g; size_t off; int K, N, Npad; };

DI void phase_prep(const Params& p, char* lds) {
    char* ws = p.ws;
    const int t = otid(), lane = t & 63, wv = t >> 6;
    const int c0 = 576, c1 = c0 + 72, c2 = c1 + 64, c3 = c2 + 256, c4 = c3 + 256, c5 = c4 + 512, c6 = c5 + 256, c7 = c6 + 512;
    const int nrow = (T_TOK + 1024) / 4;
    const int nkeys = 128, nrope = 256;
    const int total = c7 + nrow + nkeys + nrope;
    for (int k = 0; k < (c7 + vgrid() - 1) / vgrid(); ++k) {
        const int raw = vbid() + k * vgrid();
        const bool valid = raw < c7;
        const int item = valid ? raw : 0;
        const float* W; const float* g; size_t off; int K, N, Npad, local;
        if (item < c0)      { W = p.w_in;     g = nullptr;      off = OFF_WT_IN;  K = 1024; N = 2208; Npad = 2304; local = item; }
        else if (item < c1) { W = p.w_uq;     g = p.q_norm;     off = OFF_WT_UQ;  K = 384;  N = 768;  Npad = 768;  local = item - c0; }
        else if (item < c2) { W = p.w_ukv;    g = p.kv_norm;    off = OFF_WT_UKV; K = 256;  N = 1024; Npad = 1024; local = item - c1; }
        else if (item < c3) { W = p.w_out;    g = nullptr;      off = OFF_WT_OUT; K = 1024; N = 1024; Npad = 1024; local = item - c2; }
        else if (item < c4) { W = p.w_mem_q;  g = p.norm_mem_q; off = OFF_WT_MQ;  K = 1024; N = 1024; Npad = 1024; local = item - c3; }
        else if (item < c5) { W = p.w_mem_kv; g = nullptr;      off = OFF_WT_MKV; K = 1024; N = 2048; Npad = 2048; local = item - c4; }
        else if (item < c6) { W = p.w_mem_o;  g = nullptr;      off = OFF_WT_MO;  K = 1024; N = 1024; Npad = 1024; local = item - c5; }
        else                { W = p.peer_w_q; g = p.norm_ffn;   off = OFF_WT_PQ;  K = 1024; N = 2048; Npad = 2048; local = item - c6; }
        const int ntn = Npad / 64;
        transpose_tile(W, K, N, g, (bf16_t*)(ws + off), local / ntn, local % ntn, lds, valid);
    }
    for (int item = c7 + vbid(); item < total; item += vgrid()) {
        if (item < c7 + nrow) {
            const int row = (item - c7) * 4 + wv;
            if (row < T_TOK) rmsnorm_row_bf16(p.x + (size_t)row * 1024, p.norm_mix, (bf16_t*)(ws + OFF_XN) + (size_t)row * 1024, lane);
            else rmsnorm_row_bf16(p.mem + (size_t)(row - T_TOK) * 1024, p.norm_mem_kv, (bf16_t*)(ws + OFF_MEMN) + (size_t)(row - T_TOK) * 1024, lane);
        } else if (item < c7 + nrow + nkeys) {
            const int idx = ((item - c7 - nrow) * 256 + t) * 8;
            const f32x4 a = *(const f32x4*)(p.sub_keys + idx), b = *(const f32x4*)(p.sub_keys + idx + 4);
            u32x4 o; o[0] = pack2(a[0], a[1]); o[1] = pack2(a[2], a[3]); o[2] = pack2(b[0], b[1]); o[3] = pack2(b[2], b[3]);
            *(u32x4*)((bf16_t*)(ws + OFF_KEYS) + idx) = o;
        } else {
            const int idx = (item - c7 - nrow - nkeys) * 256 + t;
            const int s = idx >> 4, i = idx & 15;
            const float ang = (float)s * p.inv_freq[i];
            const double a = (double)ang;
            const double twopi = 6.283185307179586476925;
            const float rf = (float)(a - twopi * rint(a / twopi));
            float* cs = (float*)(ws + OFF_ROPE);
            cs[idx] = cosf(rf); cs[65536 + idx] = sinf(rf);
        }
    }
}
namespace pg8 {
#define PG8_LAS __attribute__((address_space(3)))
typedef unsigned short bf16_t;
typedef short bf16x8 __attribute__((ext_vector_type(8)));
typedef float f32x4 __attribute__((ext_vector_type(4)));
typedef unsigned u32x4 __attribute__((ext_vector_type(4)));
constexpr int BM = 256, BK = 64, HALF = 128, HTB = HALF * BK * 2  , STAGE_BYTES = 8 * HTB, NXCD = 8, WGM = 8;

__host__ __device__ __forceinline__ int lds_byte(int r, int c) { const int st = (r >> 4) * 2 + (c >> 5), rr = r & 15, cc = c & 31, ob = rr * 64 + cc * 2; return st * 1024 + (ob ^ (((ob >> 9) & 1) << 5)); }
__host__ __device__ __forceinline__ void stage_rc(int b, int& R, int& C) { const int st = b / 1024, sb = b % 1024, swz = sb ^ (((sb >> 9) & 1) << 5); R = (st >> 1) * 16 + swz / 64; C = (st & 1) * 32 + (swz % 64) / 2; }
__host__ __device__ __forceinline__ int perm32(int rho) { const int n = rho >> 4, i = rho & 15; return 8 * (i >> 2) + 4 * n + (i & 3); }

struct Unit { int pm, pn; };
struct Gemm { const bf16_t* A; const bf16_t* Bt; int M, N, K, lda; };

struct StaticOrder {
    int nM, nN, nwg, G, c;
    __host__ __device__ void init(int M, int N, int G_, int c_) { nM = M / BM; nN = N / BM; nwg = nM * nN; G = G_; c = c_; }
    __host__ __device__ bool next(int i, Unit& u) const {
        const long L = (long)i * G + c; if (L >= nwg) return false;
        int wgid = (int)L; { const int q = nwg / NXCD, r = nwg % NXCD, xcd = wgid % NXCD, off = wgid / NXCD; wgid = (xcd < r ? xcd * (q + 1) : r * (q + 1) + (xcd - r) * q) + off; }
        const int nig = WGM * nN, gid = wgid / nig, fm = gid * WGM, gsz = (nM - fm) < WGM ? (nM - fm) : WGM;
        u.pm = fm + ((wgid % nig) % gsz); u.pn = (wgid % nig) / gsz; return true;
    }
    __device__ __forceinline__ void a_ready(const Unit&) const {}
    __device__ __forceinline__ void done(const Unit&) const {}
};

template <class Epi, class Sched, bool ALIGN_EPI = false, bool SP2 = false>
__device__ __forceinline__ void gemm_phase(PG8_LAS unsigned char* lds, const Gemm g, const Sched& S, const Epi& E) {
    int tid_ = threadIdx.x; asm volatile("" : "+v"(tid_));
    const int tid = tid_, wid = __builtin_amdgcn_readfirstlane(tid >> 6), lane = tid & 63, wr = wid >> 2, wc = wid & 3, fr = lane & 15, fq = lane >> 4;
    const int K = g.K, nt = K / BK, lda = g.lda;
    unsigned voffA[2], voffB[2];
#pragma unroll
    for (int i = 0; i < 2; ++i) { int R, C; stage_rc(tid * 16 + i * 8192, R, C); const int Rb = Epi::PERM ? ((R & ~31) + perm32(R & 31)) : R;
        voffA[i] = (unsigned)(R * lda + C) * 2u; voffB[i] = (unsigned)(Rb * K + C) * 2u; }
    const size_t kstep = (size_t)(BK * 2);
    const size_t hstepB = (size_t)HALF * K * 2, hstepA = (size_t)HALF * lda * 2;
    const size_t tstepB = 2 * hstepB, tstepA = 2 * hstepA;
    const unsigned ldsw = (unsigned)wid * 1024u;
    const int aoff = lds_byte(wr * 64 + fr, fq * 8), boff = lds_byte(wc * 32 + fr, fq * 8);
#define PG8_SA(b, h) (((b) * 2 + (h)) * HTB)
#define PG8_SB(b, h) ((4 + (b) * 2 + (h)) * HTB)
#define PG8_STAGE(bufoff, gbase, voff) do { _Pragma("unroll") for (int _i = 0; _i < 2; ++_i) \
        __builtin_amdgcn_global_load_lds((const unsigned*)((const char*)(gbase) + (voff)[_i]), (PG8_LAS unsigned*)(lds + (bufoff) + ldsw + _i * 8192), 16, 0, 0); } while (0)
#define PG8_LDA(dst, b, h) do { _Pragma("unroll") for (int m = 0; m < 4; ++m) _Pragma("unroll") for (int k = 0; k < 2; ++k) dst[m][k] = *(const PG8_LAS bf16x8*)(lds + PG8_SA(b, h) + aoff + m * 2048 + k * 1024); } while (0)
#define PG8_LDB(dst, b, h) do { _Pragma("unroll") for (int n = 0; n < 2; ++n) _Pragma("unroll") for (int k = 0; k < 2; ++k) dst[n][k] = *(const PG8_LAS bf16x8*)(lds + PG8_SB(b, h) + boff + n * 2048 + k * 1024); } while (0)
#define PG8_MMA(ai, bj, At, Bt) do { __builtin_amdgcn_s_setprio(1); _Pragma("unroll") for (int m = 0; m < 4; ++m) _Pragma("unroll") for (int n = 0; n < 2; ++n) _Pragma("unroll") for (int k = 0; k < 2; ++k) \
        acc[ai][bj][m][n] = __builtin_amdgcn_mfma_f32_16x16x32_bf16(Bt[n][k], At[m][k], acc[ai][bj][m][n], 0, 0, 0); __builtin_amdgcn_s_setprio(0); } while (0)
#define PG8_WAIT_V(n) asm volatile("s_waitcnt vmcnt(" #n ")" ::: "memory")
#define PG8_WAIT_L(n) asm volatile("s_waitcnt lgkmcnt(" #n ")" ::: "memory")
#define PG8_BAR __builtin_amdgcn_s_barrier()
#define PG8_SCHED __builtin_amdgcn_sched_barrier(0)
    Unit cur, nxt; int ui = 0;
    if (!S.next(0, cur)) return;
    f32x4 acc[2][2][4][2];
#pragma unroll
    for (int a = 0; a < 2; ++a)
#pragma unroll
        for (int b = 0; b < 2; ++b)
#pragma unroll
            for (int m = 0; m < 4; ++m)
#pragma unroll
                for (int n = 0; n < 2; ++n) acc[a][b][m][n] = (f32x4){0.f, 0.f, 0.f, 0.f};
    bf16x8 At[4][2], B0[2][2], B1[2][2];
    const char* cA = (const char*)g.A + (size_t)cur.pm * tstepA; const char* cB = (const char*)g.Bt + (size_t)cur.pn * tstepB;
    S.a_ready(cur);
    if constexpr (SP2) {
        PG8_STAGE(PG8_SB(0, 0), cB, voffB); PG8_STAGE(PG8_SB(0, 1), cB + hstepB, voffB); PG8_STAGE(PG8_SA(0, 0), cA, voffA); PG8_STAGE(PG8_SA(0, 1), cA + hstepA, voffA);
        if (wr == 1) PG8_BAR;
        PG8_WAIT_V(2); PG8_BAR;
        PG8_STAGE(PG8_SB(1, 0), cB + kstep, voffB); PG8_STAGE(PG8_SA(1, 0), cA + kstep, voffA); PG8_STAGE(PG8_SB(1, 1), cB + hstepB + kstep, voffB);
        PG8_WAIT_V(6); PG8_BAR;
    } else {
        PG8_STAGE(PG8_SB(0, 0), cB, voffB); PG8_STAGE(PG8_SA(0, 0), cA, voffA); PG8_STAGE(PG8_SB(0, 1), cB + hstepB, voffB); PG8_STAGE(PG8_SA(0, 1), cA + hstepA, voffA);
        if (wr == 1) PG8_BAR;
        PG8_WAIT_V(4); PG8_BAR;
        PG8_STAGE(PG8_SB(1, 0), cB + kstep, voffB); PG8_STAGE(PG8_SA(1, 0), cA + kstep, voffA); PG8_STAGE(PG8_SB(1, 1), cB + hstepB + kstep, voffB);
        PG8_WAIT_V(6); PG8_BAR;
    }
    for (;;) {
        const bool has_next = S.next(ui + 1, nxt);
        const char* nA = has_next ? (const char*)g.A + (size_t)nxt.pm * tstepA : cA; const char* nB = has_next ? (const char*)g.Bt + (size_t)nxt.pn * tstepB : cB;
#pragma unroll 1
        for (int t = 0; t < nt; t += 2) {
            const bool last = (t == nt - 2);
            const char* a1 = cA + (size_t)(t + 1) * kstep;
            const char* a2 = last ? nA : cA + (size_t)(t + 2) * kstep; const char* b2 = last ? nB : cB + (size_t)(t + 2) * kstep;
            const char* a3 = a2 + kstep; const char* b3 = b2 + kstep;
            if (last && has_next) S.a_ready(nxt);
            if constexpr (SP2) {
            PG8_LDB(B0, 0, 0); PG8_LDB(B1, 0, 1); PG8_SCHED; PG8_LDA(At, 0, 0); PG8_STAGE(PG8_SA(1, 1), a1 + hstepA, voffA);
            PG8_WAIT_V(8); PG8_WAIT_L(0); PG8_BAR; PG8_MMA(0, 0, At, B0); PG8_MMA(0, 1, At, B1); PG8_BAR; PG8_SCHED;
            PG8_LDA(At, 0, 1); PG8_STAGE(PG8_SB(0, 0), b2, voffB); PG8_STAGE(PG8_SB(0, 1), b2 + hstepB, voffB); PG8_STAGE(PG8_SA(0, 0), a2, voffA);
            PG8_WAIT_V(8); PG8_WAIT_L(0); PG8_BAR; PG8_MMA(1, 0, At, B0); PG8_MMA(1, 1, At, B1); PG8_BAR; PG8_SCHED;
            PG8_LDB(B0, 1, 0); PG8_LDB(B1, 1, 1); PG8_SCHED; PG8_LDA(At, 1, 0); PG8_STAGE(PG8_SA(0, 1), a2 + hstepA, voffA);
            PG8_WAIT_V(8); PG8_WAIT_L(0); PG8_BAR; PG8_MMA(0, 0, At, B0); PG8_MMA(0, 1, At, B1); PG8_BAR; PG8_SCHED;
            PG8_LDA(At, 1, 1); PG8_STAGE(PG8_SB(1, 0), b3, voffB); PG8_STAGE(PG8_SB(1, 1), b3 + hstepB, voffB); PG8_STAGE(PG8_SA(1, 0), a3, voffA);
            PG8_WAIT_V(8); PG8_WAIT_L(0); PG8_BAR; PG8_MMA(1, 0, At, B0); PG8_MMA(1, 1, At, B1); PG8_BAR; PG8_SCHED;
            } else {
            PG8_LDB(B0, 0, 0); PG8_SCHED; PG8_LDA(At, 0, 0); PG8_STAGE(PG8_SA(1, 1), a1 + hstepA, voffA);
            PG8_WAIT_L(8); PG8_BAR; PG8_WAIT_L(0); PG8_MMA(0, 0, At, B0); PG8_BAR; PG8_SCHED;
            PG8_LDB(B1, 0, 1); PG8_STAGE(PG8_SB(0, 0), b2, voffB);
            PG8_BAR; PG8_WAIT_L(0); PG8_MMA(0, 1, At, B1); PG8_BAR;
            PG8_LDA(At, 0, 1); PG8_STAGE(PG8_SA(0, 0), a2, voffA);
            PG8_BAR; PG8_WAIT_L(0); PG8_MMA(1, 0, At, B0); PG8_BAR; PG8_SCHED;
            PG8_STAGE(PG8_SB(0, 1), b2 + hstepB, voffB);
            PG8_WAIT_V(6); PG8_BAR; PG8_MMA(1, 1, At, B1); PG8_BAR;
            PG8_LDB(B0, 1, 0); PG8_SCHED; PG8_LDA(At, 1, 0); PG8_STAGE(PG8_SA(0, 1), a2 + hstepA, voffA);
            PG8_WAIT_L(8); PG8_BAR; PG8_WAIT_L(0); PG8_MMA(0, 0, At, B0); PG8_BAR; PG8_SCHED;
            PG8_LDB(B1, 1, 1); PG8_STAGE(PG8_SB(1, 0), b3, voffB);
            PG8_BAR; PG8_WAIT_L(0); PG8_MMA(0, 1, At, B1); PG8_BAR;
            PG8_LDA(At, 1, 1); PG8_STAGE(PG8_SA(1, 0), a3, voffA);
            PG8_BAR; PG8_WAIT_L(0); PG8_MMA(1, 0, At, B0); PG8_BAR; PG8_SCHED;
            PG8_STAGE(PG8_SB(1, 1), b3 + hstepB, voffB);
            PG8_WAIT_V(6); PG8_BAR; PG8_MMA(1, 1, At, B1); PG8_BAR;
            }
        }
        if constexpr (ALIGN_EPI) { if (wr == 0) PG8_BAR; }
        if constexpr (!Epi::AFTER_DRAIN) { E(acc, cur, wr, wc, fr, fq); S.done(cur); }
        if (!has_next) break;
#pragma unroll
        for (int a = 0; a < 2; ++a)
#pragma unroll
            for (int b = 0; b < 2; ++b)
#pragma unroll
                for (int m = 0; m < 4; ++m)
#pragma unroll
                    for (int n = 0; n < 2; ++n) acc[a][b][m][n] = (f32x4){0.f, 0.f, 0.f, 0.f};
        cur = nxt; cA = nA; cB = nB; ++ui;
        if constexpr (ALIGN_EPI) { if (wr == 1) PG8_BAR; }
    }
    PG8_WAIT_V(0);
    if constexpr (!ALIGN_EPI) { if (wr == 0) PG8_BAR; }
    PG8_BAR;
    if constexpr (Epi::AFTER_DRAIN) { E.fused(acc, cur, wr, wc, fr, fq, lds, wid, lane); S.done(cur); }
#undef PG8_SA
#undef PG8_SB
#undef PG8_STAGE
#undef PG8_LDA
#undef PG8_LDB
#undef PG8_MMA
#undef PG8_WAIT_V
#undef PG8_WAIT_L
#undef PG8_BAR
#undef PG8_SCHED
}
}
DI unsigned sw_off(int row, int chunk) { return (unsigned)(row * 128 + ((chunk ^ ((row >> 1) & 7)) << 4)); }
#define GLDS16(gsrc, ldst) __builtin_amdgcn_global_load_lds((const unsigned*)(gsrc), (unsigned*)(ldst), 16, 0, 0)
DI u32x2 pack4(float a, float b, float c, float d) { u32x2 o; o[0] = pack2(a, b); o[1] = pack2(c, d); return o; }
#define EPI_ARGS const f32x4 (&acc)[2][2][4][2], const pg8::Unit& u, int wr, int wc, int fr, int fq
DI float xq_sum(float v) {
    v += __uint_as_float((unsigned)__builtin_amdgcn_ds_swizzle((int)__float_as_uint(v), 0x401F));
    return xhalf_sum(v);
}
DI u32x4 pack8(const float (&v)[8], float sc) {
    u32x4 o; o[0] = pack2(v[0] * sc, v[1] * sc); o[1] = pack2(v[2] * sc, v[3] * sc); o[2] = pack2(v[4] * sc, v[5] * sc); o[3] = pack2(v[6] * sc, v[7] * sc); return o;
}
DI void rope8(const float (&v)[8], float sc, const float* __restrict__ cs, int pos, int fq, int lane, bf16_t* dst32  ) {
    const int i0 = 8 * (fq & 1);
    const f32x4 c0 = *(const f32x4*)(cs + pos * 16 + i0), c1 = *(const f32x4*)(cs + pos * 16 + i0 + 4);
    const f32x4 s0 = *(const f32x4*)(cs + 65536 + pos * 16 + i0), s1 = *(const f32x4*)(cs + 65536 + pos * 16 + i0 + 4);
    const float sg = (fq < 2) ? -1.0f : 1.0f;
    float o[8];
#pragma unroll
    for (int e = 0; e < 8; ++e) {
        const float own = v[e] * sc, oth = xhalf_other(own, lane);
        const float c = (e < 4) ? c0[e & 3] : c1[e & 3], s = (e < 4) ? s0[e & 3] : s1[e & 3];
        o[e] = own * c + sg * oth * s;
    }
    *(u32x4*)(dst32 + 8 * fq) = pack8(o, 1.0f);
}
#define EPI_LOAD8(v, ai, bj, m) float v[8]; { const f32x4 x0_ = acc[ai][bj][m][0], x1_ = acc[ai][bj][m][1]; v[0] = x0_[0]; v[1] = x0_[1]; v[2] = x0_[2]; v[3] = x0_[3]; v[4] = x1_[0]; v[5] = x1_[1]; v[6] = x1_[2]; v[7] = x1_[3]; }

struct EpiPlain8 {
    static constexpr bool PERM = true, AFTER_DRAIN = false;
    bf16_t* out; int ld;
    DI void operator()(EPI_ARGS) const {
#pragma unroll
        for (int ai = 0; ai < 2; ++ai)
#pragma unroll
            for (int m = 0; m < 4; ++m) {
                int fr_ = fr; asm volatile("" : "+v"(fr_));
                const size_t tok = (size_t)u.pm * 256 + ai * 128 + wr * 64 + m * 16 + fr_;
#pragma unroll
                for (int bj = 0; bj < 2; ++bj) { EPI_LOAD8(v, ai, bj, m); *(u32x4*)(out + tok * ld + u.pn * 256 + bj * 128 + wc * 32 + 8 * fq) = pack8(v, 1.0f); }
            }
    }
};

struct EpiProj8 {
    static constexpr bool PERM = true, AFTER_DRAIN = false;
    bf16_t* proj; bf16_t* kr; const float* cs; float* ssq;
    DI void operator()(EPI_ARGS) const {
        const int lane = fr + 16 * fq;
#pragma unroll
        for (int bj = 0; bj < 2; ++bj) {
            const int cg = u.pn * 256 + bj * 128 + wc * 32;
            if (cg >= INC) continue;
            const int g32 = cg >> 5;
            const float sc = (cg >= 672 && cg < 1184) ? 0.125f * LOG2E : 1.0f;
#pragma unroll
            for (int ai = 0; ai < 2; ++ai)
#pragma unroll
                for (int m = 0; m < 4; ++m) {
                    int fr_ = fr; asm volatile("" : "+v"(fr_));
                const size_t tok = (size_t)u.pm * 256 + ai * 128 + wr * 64 + m * 16 + fr_;
                    EPI_LOAD8(v, ai, bj, m);
                    if (g32 < 20) {
                        float ss = 0.f;
#pragma unroll
                        for (int e = 0; e < 8; ++e) ss += v[e] * v[e];
                        ss = xq_sum(ss);
                        if (fq == 0) ssq[tok * 24 + g32] = ss;
                    }
                    if (cg == 640) rope8(v, 1.0f, cs, (int)(tok & (SEQ_L - 1)), fq, lane, kr + tok * 32);
                    else *(u32x4*)(proj + tok * INC + cg + 8 * fq) = pack8(v, sc);
                }
        }
    }
};

struct EpiUpQ8 {
    static constexpr bool PERM = true, AFTER_DRAIN = false;
    bf16_t* q; const float* cs; const float* ssq;
    DI void operator()(EPI_ARGS) const {
        const int lane = fr + 16 * fq;
        const float qs = 0.10206207261596575f * LOG2E;
#pragma unroll
        for (int ai = 0; ai < 2; ++ai)
#pragma unroll
            for (int m = 0; m < 4; ++m) {
                int fr_ = fr; asm volatile("" : "+v"(fr_));
                const size_t tok = (size_t)u.pm * 256 + ai * 128 + wr * 64 + m * 16 + fr_;
                const f32x4 a0 = *(const f32x4*)(ssq + tok * 24), a1 = *(const f32x4*)(ssq + tok * 24 + 4), a2 = *(const f32x4*)(ssq + tok * 24 + 8);
                const float tot = (a0[0] + a0[1] + a0[2] + a0[3]) + (a1[0] + a1[1] + a1[2] + a1[3]) + (a2[0] + a2[1] + a2[2] + a2[3]);
                const float sc = rsqrtf(tot * (1.0f / 384.0f) + 1e-6f) * qs;
#pragma unroll
                for (int bj = 0; bj < 2; ++bj) {
                    const int cg = u.pn * 256 + bj * 128 + wc * 32;
                    EPI_LOAD8(v, ai, bj, m);
                    if ((cg % 96) == 64) rope8(v, sc, cs, (int)(tok & (SEQ_L - 1)), fq, lane, q + tok * 768 + cg);
                    else *(u32x4*)(q + tok * 768 + cg + 8 * fq) = pack8(v, sc);
                }
            }
    }
};

struct EpiUpKV8 {
    static constexpr bool PERM = true, AFTER_DRAIN = false;
    bf16_t* kv; const float* ssq;
    DI void operator()(EPI_ARGS) const {
#pragma unroll
        for (int ai = 0; ai < 2; ++ai)
#pragma unroll
            for (int m = 0; m < 4; ++m) {
                int fr_ = fr; asm volatile("" : "+v"(fr_));
                const size_t tok = (size_t)u.pm * 256 + ai * 128 + wr * 64 + m * 16 + fr_;
                const f32x4 a0 = *(const f32x4*)(ssq + tok * 24 + 12), a1 = *(const f32x4*)(ssq + tok * 24 + 16);
                const float tot = (a0[0] + a0[1] + a0[2] + a0[3]) + (a1[0] + a1[1] + a1[2] + a1[3]);
                const float sc = rsqrtf(tot * (1.0f / 256.0f) + 1e-6f);
#pragma unroll
                for (int bj = 0; bj < 2; ++bj) { EPI_LOAD8(v, ai, bj, m); *(u32x4*)(kv + tok * 1024 + u.pn * 256 + bj * 128 + wc * 32 + 8 * fq) = pack8(v, sc); }
            }
    }
};

template <bool RBF16>
struct EpiResid8 {
    static constexpr bool PERM = true, AFTER_DRAIN = false;
    const void* R; bf16_t* HB; float* SS;
    DI void operator()(EPI_ARGS) const {
#pragma unroll
        for (int ai = 0; ai < 2; ++ai) {
            f32x4 rv[4][2][2];
#pragma unroll
            for (int m = 0; m < 4; ++m)
#pragma unroll
                for (int bj = 0; bj < 2; ++bj) {
                    const size_t off = ((size_t)u.pm * 256 + ai * 128 + wr * 64 + m * 16 + fr) * 1024 + u.pn * 256 + bj * 128 + wc * 32 + 8 * fq;
                    if (RBF16) {
                        const u32x4 w = ldu4((const bf16_t*)R + off);
                        rv[m][bj][0] = (f32x4){bf_lo(w[0]), bf_hi(w[0]), bf_lo(w[1]), bf_hi(w[1])};
                        rv[m][bj][1] = (f32x4){bf_lo(w[2]), bf_hi(w[2]), bf_lo(w[3]), bf_hi(w[3])};
                    } else {
                        rv[m][bj][0] = *(const f32x4*)((const float*)R + off); rv[m][bj][1] = *(const f32x4*)((const float*)R + off + 4);
                    }
                }
#pragma unroll
            for (int m = 0; m < 4; ++m) {
                int fr_ = fr; asm volatile("" : "+v"(fr_));
                const size_t tok = (size_t)u.pm * 256 + ai * 128 + wr * 64 + m * 16 + fr_;
                float ss = 0.f;
#pragma unroll
                for (int bj = 0; bj < 2; ++bj) {
                    const size_t off = tok * 1024 + u.pn * 256 + bj * 128 + wc * 32 + 8 * fq;
                    const f32x4 h0 = rv[m][bj][0] + acc[ai][bj][m][0], h1 = rv[m][bj][1] + acc[ai][bj][m][1];
                    u32x4 o; o[0] = pack2(h0[0], h0[1]); o[1] = pack2(h0[2], h0[3]); o[2] = pack2(h1[0], h1[1]); o[3] = pack2(h1[2], h1[3]);
                    *(u32x4*)(HB + off) = o;
                    const float a0 = bf_lo(o[0]), a1 = bf_hi(o[0]), a2 = bf_lo(o[1]), a3 = bf_hi(o[1]), a4 = bf_lo(o[2]), a5 = bf_hi(o[2]), a6 = bf_lo(o[3]), a7 = bf_hi(o[3]);
                    ss += (a0 * a0 + a1 * a1) + (a2 * a2 + a3 * a3) + (a4 * a4 + a5 * a5) + (a6 * a6 + a7 * a7);
                }
                ss = xq_sum(ss);
                if (fq == 0) SS[tok * 16 + 4 * u.pn + wc] = ss;
            }
        }
    }
};

struct EpiRowScale8 {
    static constexpr bool PERM = true, AFTER_DRAIN = false;
    bf16_t* out; int ld; const float* SS; float extra;
    DI void operator()(EPI_ARGS) const {
#pragma unroll
        for (int ai = 0; ai < 2; ++ai)
#pragma unroll
            for (int m = 0; m < 4; ++m) {
                int fr_ = fr; asm volatile("" : "+v"(fr_));
                const size_t tok = (size_t)u.pm * 256 + ai * 128 + wr * 64 + m * 16 + fr_;
                const f32x4 s0 = *(const f32x4*)(SS + tok * 16), s1 = *(const f32x4*)(SS + tok * 16 + 4), s2 = *(const f32x4*)(SS + tok * 16 + 8), s3 = *(const f32x4*)(SS + tok * 16 + 12);
                const float tot = (s0[0] + s0[1] + s0[2] + s0[3]) + (s1[0] + s1[1] + s1[2] + s1[3]) + (s2[0] + s2[1] + s2[2] + s2[3]) + (s3[0] + s3[1] + s3[2] + s3[3]);
                const float sc = rsqrtf(tot * (1.0f / 1024.0f) + 1e-6f) * extra;
#pragma unroll
                for (int bj = 0; bj < 2; ++bj) { EPI_LOAD8(v, ai, bj, m); *(u32x4*)(out + tok * ld + u.pn * 256 + bj * 128 + wc * 32 + 8 * fq) = pack8(v, sc); }
            }
    }
};

template <class Epi>
DI void gemm8(char* smem, const bf16_t* A, int lda, const bf16_t* Bt, int M, int N, int K, const Epi& e, int cshift = 0) {
    pg8::Gemm g; g.A = A; g.Bt = Bt; g.M = M; g.N = N; g.K = K; g.lda = lda;
    const int G = (int)gridDim.x;
    pg8::StaticOrder S; S.init(M, N, G, ((int)blockIdx.x + G - cshift) % G);
    pg8::gemm_phase<Epi, pg8::StaticOrder, true, true>((PG8_LAS unsigned char*)smem, g, S, e);
}

DI void quant_rows4(const Params& p, int it, int wv, int lane);
DI void phase_p1(const Params& p, char* smem) {
    char* ws = p.ws;
    const int G = (int)gridDim.x, nproj = 9 * 64, nkvm = 8 * 4;
    const int last = nproj % G;
    { EpiProj8 e{(bf16_t*)(ws + OFF_PROJ), (bf16_t*)(ws + OFF_KR), (const float*)(ws + OFF_ROPE), (float*)(ws + OFF_SSQ)};
      gemm8(smem, (const bf16_t*)(ws + OFF_XN), 1024, (const bf16_t*)(ws + OFF_WT_IN), T_TOK, 2304, 1024, e); }
    { EpiPlain8 e{(bf16_t*)(ws + OFF_KVM), 2048};
      gemm8(smem, (const bf16_t*)(ws + OFF_MEMN), 1024, (const bf16_t*)(ws + OFF_WT_MKV), 1024, 2048, 1024, e, last); }
    int q0 = last + nkvm, nq = G - q0;
    if (last == 0 || nq <= 0) { q0 = 0; nq = G; }
    if ((int)blockIdx.x >= q0) {
        const int t = otid(), lane = t & 63, wv = t >> 6;
        for (int it = ((int)blockIdx.x - q0) * 2 + vhalf(); it < 8192; it += 2 * nq) quant_rows4(p, it, wv, lane);
    }
}
DI void phase_p2(const Params& p, char* smem) {
    char* ws = p.ws;
    { EpiUpQ8 e{(bf16_t*)(ws + OFF_QMLA), (const float*)(ws + OFF_ROPE), (const float*)(ws + OFF_SSQ)};
      gemm8(smem, (const bf16_t*)(ws + OFF_PROJ), INC, (const bf16_t*)(ws + OFF_WT_UQ), T_TOK, 768, 384, e); }
    { EpiUpKV8 e{(bf16_t*)(ws + OFF_KVMLA), (const float*)(ws + OFF_SSQ)};
      gemm8(smem, (const bf16_t*)(ws + OFF_PROJ) + 384, INC, (const bf16_t*)(ws + OFF_WT_UKV), T_TOK, 1024, 256, e); }
}
template <bool RBF16>
DI void phase_resid(const Params& p, char* smem, size_t off_w, size_t off_a, const void* R, size_t off_ss, bool dry = false) {
    char* ws = p.ws;
    EpiResid8<RBF16> e{R, (bf16_t*)(ws + OFF_HB), (float*)(ws + off_ss)};
    if (dry) { e.HB = (bf16_t*)(ws + OFF_B); e.SS = (float*)(ws + OFF_SS1); }
    gemm8(smem, (const bf16_t*)(ws + off_a), 1024, (const bf16_t*)(ws + off_w), T_TOK, 1024, 1024, e);
}
DI void phase_rowscale(const Params& p, char* smem, size_t off_w, int N, bf16_t* outp, size_t off_ss, float extra) {
    char* ws = p.ws;
    EpiRowScale8 e{outp, N, (const float*)(ws + off_ss), extra};
    gemm8(smem, (const bf16_t*)(ws + OFF_HB), 1024, (const bf16_t*)(ws + off_w), T_TOK, N, 1024, e);
}
DI unsigned v128_off(int row, int chunk) { return (unsigned)(row * 128 + ((chunk ^ (((row >> 1) & 1) << 2)) << 4)); }
DI unsigned v128_tr_addr(unsigned base, int R0, int c, int lane) {
    const int blk = (lane >> 4) & 1, qq = (lane & 15) >> 2, pp = lane & 3;
    return base + v128_off(R0 + qq, 4 * c + 2 * blk + (pp >> 1)) + 8 * (pp & 1);
}
DI bf16x8 cat44(s16x4 lo, s16x4 hi) { return __builtin_shufflevector(lo, hi, 0, 1, 2, 3, 4, 5, 6, 7); }

constexpr int MLA_STAGE = 64 * 192 + 64 * 128;
DI unsigned k192_off(int row, int chunk) { return (unsigned)(row * 192 + (((chunk & ~3) | ((chunk & 3) ^ ((row >> 2) & 3))) << 4)); }
DI void mla_unit(const Params& p, char* lds, int b, int h, int qt) {
    char* ws = p.ws;
    const int t = otid(), lane = t & 63, wv = t >> 6, r = lane & 31, hh = lane >> 5;
    const bf16_t* Q = (const bf16_t*)(ws + OFF_QMLA);
    const bf16_t* KV = (const bf16_t*)(ws + OFF_KVMLA);
    const bf16_t* KR = (const bf16_t*)(ws + OFF_KR);
    const int q0 = qt * 128 + 32 * wv;
    const size_t tokq = (size_t)b * SEQ_L + q0 + r;
    const size_t tokb = (size_t)b * SEQ_L;
    bf16x8 qf[6];
#pragma unroll
    for (int s = 0; s < 6; ++s) qf[s] = ld16(Q + tokq * 768 + h * 96 + 16 * s + 8 * hh);
    f32x16 o[2]; o[0] = zero16(); o[1] = zero16();
    float m = -INFINITY, l = 0.f;
    const bf16_t* ksrc[3]; int kadv[3]; const bf16_t* vsrc[2];
#pragma unroll
    for (int i = 0; i < 3; ++i) {
        const int o_ = 1024 * (wv + 4 * i) + 16 * lane, row = o_ / 192, pch = (o_ % 192) >> 4;
        const int c = (pch & ~3) | ((pch & 3) ^ ((row >> 2) & 3));
        if (c < 8) { ksrc[i] = KV + (tokb + row) * 1024 + h * 128 + 8 * c; kadv[i] = 64 * 1024; }
        else       { ksrc[i] = KR + (tokb + row) * 32 + 8 * (c - 8);       kadv[i] = 64 * 32; }
    }
#pragma unroll
    for (int i = 0; i < 2; ++i) {
        const int row = 8 * (wv + 4 * i) + (lane >> 3), pch = lane & 7;
        vsrc[i] = KV + (tokb + row) * 1024 + h * 128 + 64 + 8 * (pch ^ (((row >> 1) & 1) << 2));
    }
    char* ldst = lds + wv * 1024 + lane * 16;
    auto issue = [&](int kt) {
        char* d = ldst + (kt % 3) * MLA_STAGE;
#pragma unroll
        for (int i = 0; i < 3; ++i) GLDS16(ksrc[i] + (size_t)kt * kadv[i], d + i * 4096);
#pragma unroll
        for (int i = 0; i < 2; ++i) GLDS16(vsrc[i] + (size_t)kt * (64 * 1024), d + 12288 + i * 4096);
    };
    const int ntiles = 2 * qt + 2;
    const unsigned vlane0 = v128_tr_addr(0u, 4 * hh, 0, lane), vlane1 = v128_tr_addr(0u, 4 * hh, 1, lane);
    __syncthreads();
    issue(0); issue(1);
#pragma unroll
    for (int s = 0; s < 6; ++s) asm volatile("" :: "v"(qf[s]));
#pragma unroll 1
    for (int kt = 0; kt < ntiles; ++kt) {
        if (kt + 1 < ntiles) asm volatile("s_waitcnt vmcnt(5)\n\ts_barrier" ::: "memory");
        else asm volatile("s_waitcnt vmcnt(0)\n\ts_barrier" ::: "memory");
        if (kt + 2 < ntiles) issue(kt + 2);
        const char* sb = lds + (kt % 3) * MLA_STAGE;
        const unsigned vb = (unsigned)(uintptr_t)(sb + 12288);
        f32x16 s[2];
#pragma unroll
        for (int k2 = 0; k2 < 2; ++k2) {
            s[k2] = zero16();
#pragma unroll
            for (int ss = 0; ss < 6; ++ss) s[k2] = MFMA32(ld16(sb + k192_off(32 * k2 + r, 2 * ss + hh)), qf[ss], s[k2]);
        }
        s16x4 vt[2][2][2][2];
        {
            const unsigned a0 = vb + vlane0, a1 = vb + vlane1;
#define MLA_TR(K2, ST) vt[K2][ST][0][0] = tr_read_ao<(32 * K2 + 16 * ST) * 128>(a0); vt[K2][ST][0][1] = tr_read_ao<(32 * K2 + 16 * ST + 8) * 128>(a0); \
                       vt[K2][ST][1][0] = tr_read_ao<(32 * K2 + 16 * ST) * 128>(a1); vt[K2][ST][1][1] = tr_read_ao<(32 * K2 + 16 * ST + 8) * 128>(a1);
            MLA_TR(0, 0) MLA_TR(0, 1) MLA_TR(1, 0) MLA_TR(1, 1)
#undef MLA_TR
        }
        if (__builtin_amdgcn_readfirstlane(kt >= 2 * qt)) {
            asm volatile("");
            const int qpos = q0 + r;
#pragma unroll
            for (int k2 = 0; k2 < 2; ++k2)
#pragma unroll
                for (int i = 0; i < 16; ++i) { const int kpos = 64 * kt + 32 * k2 + crow(i, hh); if (kpos > qpos) s[k2][i] = -INFINITY; }
        }
        float mx = s[0][0];
#pragma unroll
        for (int k2 = 0; k2 < 2; ++k2)
#pragma unroll
            for (int i = 0; i < 16; ++i) mx = fmaxf(mx, s[k2][i]);
        mx = xhalf_max(mx);
        if (__any(mx > m + 8.0f)) {
            asm volatile("");
            const float mn = fmaxf(m, mx);
            const float alpha = fast_exp2(m - mn);
            l *= alpha;
            m = mn;
#pragma unroll
            for (int c = 0; c < 2; ++c)
#pragma unroll
                for (int i = 0; i < 16; ++i) o[c][i] *= alpha;
        }
        f32x2 ps2 = {0.f, 0.f};
        const f32x2 m2 = {m, m};
#pragma unroll
        for (int k2 = 0; k2 < 2; ++k2)
#pragma unroll
            for (int i = 0; i < 16; i += 2) {
                f32x2 x = {s[k2][i], s[k2][i + 1]};
                x = x - m2;
                f32x2 e; e[0] = fast_exp2(x[0]); e[1] = fast_exp2(x[1]);
                s[k2][i] = e[0]; s[k2][i + 1] = e[1];
                ps2 += e;
            }
        l += ps2[0] + ps2[1];
        TR_WAIT();
#pragma unroll
        for (int k2 = 0; k2 < 2; ++k2)
#pragma unroll
            for (int st = 0; st < 2; ++st) {
                const bf16x8 pb = pack_step(s[k2], st);
#pragma unroll
                for (int c = 0; c < 2; ++c) o[c] = MFMA32(cat44(vt[k2][st][c][0], vt[k2][st][c][1]), pb, o[c]);
            }
    }
    const float inv = 1.0f / xhalf_sum(l);
    bf16_t* dst = (bf16_t*)((char*)p.out + OUT_OMLA) + tokq * 512 + h * 64 + 4 * hh;
#pragma unroll
    for (int c = 0; c < 2; ++c)
#pragma unroll
        for (int g = 0; g < 4; ++g)
            *(u32x2*)(dst + 32 * c + 8 * g) = pack4(o[c][4 * g] * inv, o[c][4 * g + 1] * inv, o[c][4 * g + 2] * inv, o[c][4 * g + 3] * inv);
}

DI void dil_unit(const Params& p, char* lds, int g, int b, int h, int rr, int lb) {
    char* ws = p.ws;
    const int t = otid(), lane = t & 63, wv = t >> 6, r = lane & 31, hh = lane >> 5;
    const int d = (g == 0) ? 1 : (g == 1 ? 4 : 16);
    const bf16_t* PJ = (const bf16_t*)(ws + OFF_PROJ);
    const size_t tokb = (size_t)b * SEQ_L;
    char* kimg = lds;
    char* vimg = lds + 32768;
    __syncthreads();
    {
        const int c = t & 7;
#pragma unroll
        for (int half = 0; half < 2; ++half) {
            u32x4 kk[4], vv[4];
#pragma unroll
            for (int i = 0; i < 4; ++i) {
                const int key = (t >> 3) + 32 * (4 * half + i);
                const int lk = 128 * lb - 128 + key;
                if (lk >= 0) {
                    const size_t tk = tokb + (size_t)lk * d + rr;
                    kk[i] = ldu4(PJ + tk * INC + 1184 + h * 64 + 8 * c);
                    vv[i] = ldu4(PJ + tk * INC + 1696 + h * 64 + 8 * c);
                } else { kk[i] = (u32x4){0u, 0u, 0u, 0u}; vv[i] = (u32x4){0u, 0u, 0u, 0u}; }
            }
#pragma unroll
            for (int i = 0; i < 4; ++i) {
                const int key = (t >> 3) + 32 * (4 * half + i);
                *(u32x4*)(kimg + sw_off(key, c)) = kk[i];
                *(u32x4*)(vimg + v128_off(key, c)) = vv[i];
            }
        }
    }
    const int lq = 128 * lb + 32 * wv + r;
    const size_t tokq = tokb + (size_t)lq * d + rr;
    bf16x8 qf[4];
#pragma unroll
    for (int s = 0; s < 4; ++s) qf[s] = ld16(PJ + tokq * INC + 672 + h * 64 + 16 * s + 8 * hh);
    __syncthreads();
    const float slope2 = exp2f(-(float)(h + 1)) * (float)d * LOG2E;
    const int u0 = (lb == 0) ? (4 - wv) : 0;
    f32x16 o[2]; o[0] = zero16(); o[1] = zero16();
    float m = -INFINITY, lsum = 0.f;
    const unsigned vb = (unsigned)(uintptr_t)vimg;
    float cb[16];
#pragma unroll
    for (int i = 0; i < 16; ++i) cb[i] = slope2 * (float)crow(i, hh);
#pragma unroll 1
    for (int u = u0; u < 5; ++u) {
        const int rowb = 32 * (wv + u);
        f32x16 s = zero16();
#pragma unroll
        for (int ss = 0; ss < 4; ++ss) s = MFMA32(ld16(kimg + sw_off(rowb + r, 2 * ss + hh)), qf[ss], s);
        const int dbase = r + 128 - 32 * u;
        const float b0 = -slope2 * (float)dbase;
#pragma unroll
        for (int i = 0; i < 16; ++i) s[i] += cb[i];
        if (__builtin_amdgcn_readfirstlane(u == 0 || u == 4)) {
            asm volatile("");
#pragma unroll
            for (int i = 0; i < 16; ++i) { const int dist = dbase - crow(i, hh); if (dist < 0 || dist > 128) s[i] = -INFINITY; }
        }
        float mx = s[0];
#pragma unroll
        for (int i = 1; i < 16; ++i) mx = fmaxf(mx, s[i]);
        mx = xhalf_max(mx) + b0;
        if (__any(mx > m + 8.0f)) {
            asm volatile("");
            const float mn = fmaxf(m, mx);
            const float alpha = fast_exp2(m - mn);
            lsum *= alpha;
            m = mn;
#pragma unroll
            for (int c = 0; c < 2; ++c)
#pragma unroll
                for (int i = 0; i < 16; ++i) o[c][i] *= alpha;
        }
        f32x2 ps2 = {0.f, 0.f};
        const float mb = m - b0;
        const f32x2 m2 = {mb, mb};
#pragma unroll
        for (int i = 0; i < 16; i += 2) {
            f32x2 xx = {s[i], s[i + 1]};
            xx = xx - m2;
            f32x2 e; e[0] = fast_exp2(xx[0]); e[1] = fast_exp2(xx[1]);
            s[i] = e[0]; s[i + 1] = e[1];
            ps2 += e;
        }
        lsum += ps2[0] + ps2[1];
#pragma unroll
        for (int st = 0; st < 2; ++st) {
            const bf16x8 pb = pack_step(s, st);
#pragma unroll
            for (int c = 0; c < 2; ++c) {
                const s16x4 lo = tr_read(v128_tr_addr(vb, rowb + 16 * st + 4 * hh, c, lane));
                const s16x4 hi = tr_read(v128_tr_addr(vb, rowb + 16 * st + 8 + 4 * hh, c, lane));
                o[c] = MFMA32(cat44(lo, hi), pb, o[c]);
            }
        }
    }
    const float ltot = xhalf_sum(lsum);
    const float mx = m;
    const float inv = 1.0f / ltot;
    bf16_t* dst = (bf16_t*)((char*)p.out + OUT_ODIL) + ((size_t)g * T_TOK + tokq) * 512 + h * 64 + 4 * hh;
#pragma unroll
    for (int c = 0; c < 2; ++c)
#pragma unroll
        for (int gg = 0; gg < 4; ++gg)
            *(u32x2*)(dst + 32 * c + 8 * gg) = pack4(o[c][4 * gg] * inv, o[c][4 * gg + 1] * inv, o[c][4 * gg + 2] * inv, o[c][4 * gg + 3] * inv);
    if (hh == 0) ((float*)(ws + OFF_LSE))[((size_t)g * T_TOK + tokq) * 8 + h] = mx + __log2f(ltot);
}

DI void phase_p3(const Params& p, char* lds, int which = 3) {
    const int xg = (int)blockIdx.x & 7, nloc = (vgrid() >> 3), loc = ((int)blockIdx.x >> 3) * 2 + vhalf();
    if (which & 1) for (int i = loc; i < 64; i += nloc) {
        const int bh = xg * 4 + (i >> 4), pr = i & 15, b = bh >> 3, h = bh & 7;
#pragma unroll 1
        for (int rep = 0; rep < 2; ++rep) mla_unit(p, lds, b, h, rep ? pr : 31 - pr);
    }
    if (which & 2) for (int i = loc; i < 384; i += nloc) {
        const int bh = xg * 4 + i / 96, k96 = i % 96, g = k96 >> 5, k = k96 & 31, b = bh >> 3, h = bh & 7;
        int rr, lb;
        if (g == 0) { rr = 0; lb = k; } else if (g == 1) { rr = k >> 3; lb = k & 7; } else { rr = k >> 1; lb = k & 1; }
        dil_unit(p, lds, g, b, h, rr, lb);
    }
}

DI void quant_rows4(const Params& p, int it, int wv, int lane) {
    char* ws = p.ws;
    const int ncv = 4096;
    const bool isv = it >= ncv;
    const size_t row = (size_t)(isv ? it - ncv : it) * 4 + wv;
    const float* src = (isv ? p.peer_v : p.peer_u) + row * 1024 + 16 * lane;
    f32x4 v[4]; float am = 0.f;
#pragma unroll
    for (int i = 0; i < 4; ++i) { v[i] = *(const f32x4*)(src + 4 * i); am = fmaxf(am, fmaxf(fmaxf(fabsf(v[i][0]), fabsf(v[i][1])), fmaxf(fabsf(v[i][2]), fabsf(v[i][3])))); }
#pragma unroll
    for (int o = 32; o; o >>= 1) am = fmaxf(am, __shfl_xor(am, o));
    const float sc = (am > 0.f) ? am * (isv ? (1.0f / 384.0f) : (1.0f / 127.0f)) : 1.0f;
    const float inv = 1.0f / sc;
    u32x4 o;
#pragma unroll
    for (int i = 0; i < 4; ++i) {
        if (isv) {
            int w = 0;
            w = __builtin_amdgcn_cvt_pk_fp8_f32(v[i][0] * inv, v[i][1] * inv, w, false);
            w = __builtin_amdgcn_cvt_pk_fp8_f32(v[i][2] * inv, v[i][3] * inv, w, true);
            o[i] = (unsigned)w;
        } else {
            unsigned w = 0u;
#pragma unroll
            for (int e = 0; e < 4; ++e) { const int q = (int)rintf(v[i][e] * inv); w |= ((unsigned)q & 0xFFu) << (8 * e); }
            o[i] = w;
        }
    }
    *(u32x4*)(ws + OFF_UQ + row * 2048 + (isv ? 1024 : 0) + 16 * lane) = o;
    if (lane == 0) ((float*)(ws + (isv ? OFF_SV : OFF_SU)))[row] = sc;
}

DI void phase_p35(const Params& p, char* lds) {
    char* ws = p.ws;
    const int t = otid(), lane = t & 63, wv = t >> 6;
    const int ntok = T_TOK / 4;
    for (int item = vbid(); item < ntok; item += vgrid()) {
        {
            const size_t tok = (size_t)item * 4 + wv;
            const int head = lane >> 3;
            const float* LS = (const float*)(ws + OFF_LSE);
            const float l0 = LS[tok * 8 + head], l1 = LS[((size_t)T_TOK + tok) * 8 + head], l2 = LS[((size_t)2 * T_TOK + tok) * 8 + head];
            const float mx = fmaxf(l0, fmaxf(l1, l2));
            float w0 = fast_exp2(l0 - mx), w1 = fast_exp2(l1 - mx), w2 = fast_exp2(l2 - mx);
            const float wi = 1.0f / (w0 + w1 + w2);
            w0 *= wi; w1 *= wi; w2 *= wi;
            const bf16_t* OD = (const bf16_t*)((const char*)p.out + OUT_ODIL);
            const u32x4 a0 = ldu4(OD + tok * 512 + 8 * lane), a1 = ldu4(OD + ((size_t)T_TOK + tok) * 512 + 8 * lane),
                        a2 = ldu4(OD + ((size_t)2 * T_TOK + tok) * 512 + 8 * lane);
            const u32x4 am = ldu4((const bf16_t*)((const char*)p.out + OUT_OMLA) + tok * 512 + 8 * lane);
            float od[8], om[8]; float sd = 0.f, sm = 0.f;
#pragma unroll
            for (int e = 0; e < 4; ++e) {
                od[2 * e] = w0 * bf_lo(a0[e]) + w1 * bf_lo(a1[e]) + w2 * bf_lo(a2[e]);
                od[2 * e + 1] = w0 * bf_hi(a0[e]) + w1 * bf_hi(a1[e]) + w2 * bf_hi(a2[e]);
                om[2 * e] = bf_lo(am[e]); om[2 * e + 1] = bf_hi(am[e]);
                sd += od[2 * e] * od[2 * e] + od[2 * e + 1] * od[2 * e + 1];
                sm += om[2 * e] * om[2 * e] + om[2 * e + 1] * om[2 * e + 1];
            }
#pragma unroll
            for (int o = 32; o; o >>= 1) { sd += __shfl_xor(sd, o); sm += __shfl_xor(sm, o); }
            const float rd = rsqrtf(sd * (1.0f / 512.0f) + 1e-6f), rm = rsqrtf(sm * (1.0f / 512.0f) + 1e-6f);
            const f32x4 gm0 = *(const f32x4*)(p.gn_mla + 8 * lane), gm1 = *(const f32x4*)(p.gn_mla + 8 * lane + 4);
            const f32x4 gd0 = *(const f32x4*)(p.gn_dil + 8 * lane), gd1 = *(const f32x4*)(p.gn_dil + 8 * lane + 4);
            u32x4 o1, o2;
            o1[0] = pack2(om[0] * rm * gm0[0], om[1] * rm * gm0[1]); o1[1] = pack2(om[2] * rm * gm0[2], om[3] * rm * gm0[3]);
            o1[2] = pack2(om[4] * rm * gm1[0], om[5] * rm * gm1[1]); o1[3] = pack2(om[6] * rm * gm1[2], om[7] * rm * gm1[3]);
            o2[0] = pack2(od[0] * rd * gd0[0], od[1] * rd * gd0[1]); o2[1] = pack2(od[2] * rd * gd0[2], od[3] * rd * gd0[3]);
            o2[2] = pack2(od[4] * rd * gd1[0], od[5] * rd * gd1[1]); o2[3] = pack2(od[6] * rd * gd1[2], od[7] * rd * gd1[3]);
            bf16_t* MX = (bf16_t*)(ws + OFF_MIXED) + tok * 1024;
            *(u32x4*)(MX + 8 * lane) = o1;
            *(u32x4*)(MX + 512 + 8 * lane) = o2;
        }
    }
}

template <bool QLDS>
DI void memattn_unit_t(char* ws, char* lds, int b, int h, int tt, const char* qhalf) {
    const int t = otid(), lane = t & 63, wv = t >> 6, r = lane & 31, hh = lane >> 5;
    bf16x8 qall[16];
    if (QLDS) {
        const int row = 32 * wv + r; const char* qr = qhalf + row * 512;
#pragma unroll
        for (int i = 0; i < 16; ++i) qall[i] = ld16(qr + (((2 * i + hh) ^ (row & 31)) << 4));
    }
    const bf16_t* QM = (const bf16_t*)(ws + OFF_QM);
    const bf16_t* KVM = (const bf16_t*)(ws + OFF_KVM);
    const size_t tokq = (size_t)b * SEQ_L + tt * 128 + 32 * wv + r;
    const bf16_t* qrow = QM + tokq * 1024 + h * 256 + 8 * hh;
    const bf16_t* ksrc0; const bf16_t* vsrc0;
    {
        const int row = 8 * wv + (lane >> 3), pch = lane & 7;
        const size_t mrow = (size_t)b * 256 + row;
        ksrc0 = KVM + mrow * 2048 + h * 256 + 8 * (pch ^ ((row >> 1) & 7));
        vsrc0 = KVM + mrow * 2048 + 1024 + h * 256 + 8 * (pch ^ (((row >> 1) & 1) << 2));
    }
    char* ldst = lds + wv * 1024 + lane * 16;
#define MA_ISSUE(st_) do { char* d_ = ldst + ((st_) & 1) * 32768; \
        _Pragma("unroll") for (int i = 0; i < 8; ++i) GLDS16(((st_) < 4 ? ksrc0 : vsrc0) + (size_t)i * (32 * 2048) + 64 * ((st_) & 3), d_ + i * 4096); } while (0)
    f32x16 S[8];
#pragma unroll
    for (int kt = 0; kt < 8; ++kt) S[kt] = zero16();
    bf16x8 qa[4];
    __syncthreads();
    MA_ISSUE(0); MA_ISSUE(1);
#define MA_KSTAGE(c_, WAIT_) do { \
        asm volatile("s_waitcnt vmcnt(" #WAIT_ ")\n\ts_barrier" ::: "memory"); \
        _Pragma("unroll") for (int ss = 0; ss < 4; ++ss) { if (QLDS) qa[ss] = qall[4 * (c_) + ss]; else qa[ss] = ld16(qrow + 64 * (c_) + 16 * ss); } \
        { const char* sb_ = lds + ((c_) & 1) * 32768; \
          _Pragma("unroll") for (int kt = 0; kt < 8; ++kt) \
          _Pragma("unroll") for (int ss = 0; ss < 4; ++ss) S[kt] = MFMA32(ld16(sb_ + sw_off(32 * kt + r, 2 * ss + hh)), qa[ss], S[kt]); } \
        asm volatile("s_barrier" ::: "memory"); \
        MA_ISSUE((c_) + 2); } while (0)
    MA_KSTAGE(0, 8);
    MA_KSTAGE(1, 8);
    MA_KSTAGE(2, 8);
    MA_KSTAGE(3, 8);
    float mx = S[0][0];
#pragma unroll
    for (int kt = 0; kt < 8; ++kt)
#pragma unroll
        for (int i = 0; i < 16; ++i) mx = fmaxf(mx, S[kt][i]);
    mx = xhalf_max(mx);
    f32x2 ps2 = {0.f, 0.f};
    const f32x2 m2 = {mx, mx};
    bf16x8 pk[8][2];
#pragma unroll
    for (int kt = 0; kt < 8; ++kt) {
#pragma unroll
        for (int i = 0; i < 16; i += 2) {
            f32x2 xx = {S[kt][i], S[kt][i + 1]};
            xx = xx - m2;
            f32x2 e; e[0] = fast_exp2(xx[0]); e[1] = fast_exp2(xx[1]);
            S[kt][i] = e[0]; S[kt][i + 1] = e[1];
            ps2 += e;
        }
        pk[kt][0] = pack_step(S[kt], 0); pk[kt][1] = pack_step(S[kt], 1);
    }
    const float inv = 1.0f / xhalf_sum(ps2[0] + ps2[1]);
    bf16_t* dst = (bf16_t*)(ws + OFF_OM) + tokq * 1024 + h * 256 + 4 * hh;
    const unsigned vlane0 = v128_tr_addr(0u, 4 * hh, 0, lane), vlane1 = v128_tr_addr(0u, 4 * hh, 1, lane);
#define MA_PV(KT_, vb_) do { s16x4 vt_[2][2][2]; \
            vt_[0][0][0] = tr_read_ao<(32 * KT_) * 128>(vb_ + vlane0);          vt_[0][0][1] = tr_read_ao<(32 * KT_ + 8) * 128>(vb_ + vlane0); \
            vt_[0][1][0] = tr_read_ao<(32 * KT_) * 128>(vb_ + vlane1);          vt_[0][1][1] = tr_read_ao<(32 * KT_ + 8) * 128>(vb_ + vlane1); \
            vt_[1][0][0] = tr_read_ao<(32 * KT_ + 16) * 128>(vb_ + vlane0);     vt_[1][0][1] = tr_read_ao<(32 * KT_ + 24) * 128>(vb_ + vlane0); \
            vt_[1][1][0] = tr_read_ao<(32 * KT_ + 16) * 128>(vb_ + vlane1);     vt_[1][1][1] = tr_read_ao<(32 * KT_ + 24) * 128>(vb_ + vlane1); \
            TR_WAIT(); \
            _Pragma("unroll") for (int st = 0; st < 2; ++st) { \
                o0_ = MFMA32(cat44(vt_[st][0][0], vt_[st][0][1]), pk[KT_][st], o0_); \
                o1_ = MFMA32(cat44(vt_[st][1][0], vt_[st][1][1]), pk[KT_][st], o1_); } } while (0)
#define MA_VSTAGE(c_, WAIT_) do { \
        asm volatile("s_waitcnt vmcnt(" #WAIT_ ")\n\ts_barrier" ::: "memory"); \
        { const unsigned vb_ = (unsigned)(uintptr_t)(lds + ((c_) & 1) * 32768); \
          f32x16 o0_ = zero16(), o1_ = zero16(); \
          MA_PV(0, vb_); MA_PV(1, vb_); MA_PV(2, vb_); MA_PV(3, vb_); MA_PV(4, vb_); MA_PV(5, vb_); MA_PV(6, vb_); MA_PV(7, vb_); \
          _Pragma("unroll") for (int g = 0; g < 4; ++g) { \
              *(u32x2*)(dst + 64 * (c_) + 8 * g) = pack4(o0_[4 * g] * inv, o0_[4 * g + 1] * inv, o0_[4 * g + 2] * inv, o0_[4 * g + 3] * inv); \
              *(u32x2*)(dst + 64 * (c_) + 32 + 8 * g) = pack4(o1_[4 * g] * inv, o1_[4 * g + 1] * inv, o1_[4 * g + 2] * inv, o1_[4 * g + 3] * inv); } } \
        asm volatile("s_barrier" ::: "memory"); \
        if ((c_) + 2 < 4) MA_ISSUE(4 + (c_) + 2); } while (0)
    MA_VSTAGE(0, 8);
    MA_VSTAGE(1, 8);
    MA_VSTAGE(2, 8);
    MA_VSTAGE(3, 0);
#undef MA_ISSUE
#undef MA_KSTAGE
#undef MA_VSTAGE
#undef MA_PV
}

DI void phase_memattn(const Params& p, char* lds) {
    for (int item = vbid(); item < 512; item += vgrid()) {
        const int b = item >> 7, h = (item >> 5) & 3, tt = item & 31;
        memattn_unit_t<false>(p.ws, lds, b, h, tt, nullptr);
    }
}
DI unsigned f2sort(float f) { const unsigned b = __float_as_uint(f); return b ^ ((b & 0x80000000u) ? 0xFFFFFFFFu : 0x80000000u); }
DI float sort2f(unsigned u) { const unsigned b = (u & 0x80000000u) ? (u ^ 0x80000000u) : ~u; return __uint_as_float(b); }
DI void cswap(unsigned& a, unsigned& b) { const unsigned hi = max(a, b), lo = min(a, b); a = hi; b = lo; }

template <int LO, int N> struct BClean {
    template <int M> static DI void run(unsigned (&a)[M]) {
#pragma unroll
        for (int i = 0; i < N / 2; ++i) cswap(a[LO + i], a[LO + i + N / 2]);
        BClean<LO, N / 2>::run(a); BClean<LO + N / 2, N / 2>::run(a);
    }
};
template <int LO> struct BClean<LO, 1> { template <int M> static DI void run(unsigned (&)[M]) {} };
template <int LO, int N> struct BSort {
    template <int M> static DI void run(unsigned (&a)[M]) {
        BSort<LO, N / 2>::run(a); BSort<LO + N / 2, N / 2>::run(a);
#pragma unroll
        for (int i = 0; i < N / 2; ++i) cswap(a[LO + i], a[LO + N - 1 - i]);
        BClean<LO, N / 2>::run(a); BClean<LO + N / 2, N / 2>::run(a);
    }
};
template <int LO> struct BSort<LO, 1> { template <int M> static DI void run(unsigned (&)[M]) {} };
DI void merge_top16(unsigned (&a)[16], const unsigned (&b)[16]) {
#pragma unroll
    for (int i = 0; i < 16; ++i) a[i] = max(a[i], b[15 - i]);
    BClean<0, 16>::run(a);
}

DI void peer_top16_core(const bf16_t* __restrict__ keys_hp, const bf16x8 (&qf)[8], int r, int hh, unsigned (&top)[16]) {
    unsigned cur[16];
#pragma unroll
    for (int kt = 0; kt < 4; ++kt) {
        f32x16 acc = zero16();
#pragma unroll
        for (int s = 0; s < 8; ++s) acc = MFMA32(ld16(keys_hp + (size_t)(32 * kt + r) * 128 + 16 * s + 8 * hh), qf[s], acc);
        unsigned k[16];
#pragma unroll
        for (int i = 0; i < 16; ++i) k[i] = (f2sort(acc[i]) & ~0x7Fu) | (unsigned)(32 * kt + crow(i, hh));
        BSort<0, 16>::run(k);
        if (kt == 0) {
#pragma unroll
            for (int i = 0; i < 16; ++i) cur[i] = k[i];
        } else merge_top16(cur, k);
    }
    unsigned r0[16], r1[16];
#pragma unroll
    for (int i = 0; i < 16; ++i) { auto rr = __builtin_amdgcn_permlane32_swap(cur[i], cur[i], false, false); r0[i] = rr[0]; r1[i] = rr[1]; }
#pragma unroll
    for (int i = 0; i < 16; ++i) top[i] = max(r0[i], r1[15 - i]);
    BClean<0, 16>::run(top);
}
DI void peer_top16(const bf16_t* __restrict__ keys_hp, const bf16_t* __restrict__ pq_row_hp, int r, int hh, unsigned (&top)[16]) {
    bf16x8 qf[8];
#pragma unroll
    for (int s = 0; s < 8; ++s) qf[s] = ld16(pq_row_hp + 16 * s + 8 * hh);
    peer_top16_core(keys_hp, qf, r, hh, top);
}
DI void peer_top16_lds(const bf16_t* __restrict__ keys_hp, const char* qrow, int rsw, int sd, int r, int hh, unsigned (&top)[16]) {
    bf16x8 qf[8];
#pragma unroll
    for (int s = 0; s < 8; ++s) qf[s] = ld16(qrow + (((16 * sd + 2 * s + hh) ^ rsw) << 4));
    peer_top16_core(keys_hp, qf, r, hh, top);
}

template <bool QLDS>
DI void peer_select_unit_t(char* ws, const bf16_t* PQ, char* lds, size_t tokbase, int h, const char* qhalf) {
    const int t = otid(), lane = t & 63, wv = t >> 6, r = lane & 31, hh = lane >> 5;
    const size_t tok = tokbase + 32 * wv + r;
    const bf16_t* KEYS = (const bf16_t*)(ws + OFF_KEYS);
    unsigned tA[16], tB[16];
    if (QLDS) {
        const int row = 32 * wv + r; const char* qrow = qhalf + row * 512;
        peer_top16_lds(KEYS + (size_t)(2 * h) * 16384, qrow, row & 31, 0, r, hh, tA);
        peer_top16_lds(KEYS + (size_t)(2 * h + 1) * 16384, qrow, row & 31, 1, r, hh, tB);
    } else {
        peer_top16(KEYS + (size_t)(2 * h) * 16384, PQ + tok * 2048 + (2 * h) * 128, r, hh, tA);
        peer_top16(KEYS + (size_t)(2 * h + 1) * 16384, PQ + tok * 2048 + (2 * h + 1) * 128, r, hh, tB);
    }
    float fA[16], fB[16];
#pragma unroll
    for (int i = 0; i < 16; ++i) { fA[i] = sort2f(tA[i] & ~0x7Fu); fB[i] = sort2f(tB[i] & ~0x7Fu); }
    unsigned* tab = (unsigned*)lds + wv * 1024;
    __syncthreads();
#pragma unroll
    for (int i = 0; i < 16; ++i) tab[i * 64 + lane] = (tA[i] & 0x7Fu) | ((tB[i] & 0x7Fu) << 16);
    unsigned c[64];
#pragma unroll
    for (int i = 0; i < 64; ++i) c[i] = 0u;
    {
        int n = 0;
#pragma unroll
        for (int a = 0; a < 16; ++a)
#pragma unroll
            for (int b = 0; b < 16; ++b)
                if ((a + 1) * (b + 1) <= 16) { c[n] = (f2sort(fA[a] + fB[b]) & ~0xFFu) | (unsigned)(a * 16 + b); ++n; }
    }
    unsigned g0[16], g1[16], g2[16], g3[16];
#pragma unroll
    for (int i = 0; i < 16; ++i) { g0[i] = c[i]; g1[i] = c[16 + i]; g2[i] = c[32 + i]; g3[i] = c[48 + i]; }
    BSort<0, 16>::run(g0); BSort<0, 16>::run(g1); BSort<0, 16>::run(g2); BSort<0, 16>::run(g3);
    merge_top16(g0, g1); merge_top16(g2, g3); merge_top16(g0, g2);
    float e[16]; float sum = 0.f;
    const float v0 = sort2f(g0[0] & ~0xFFu);
    unsigned ids[16];
#pragma unroll
    for (int i = 0; i < 16; ++i) {
        const float v = sort2f(g0[i] & ~0xFFu);
        e[i] = fast_exp2((v - v0) * LOG2E); sum += e[i];
        const unsigned a = (g0[i] >> 4) & 15u, b = g0[i] & 15u;
        const unsigned ia = tab[a * 64 + lane] & 0x7Fu, ib = (tab[b * 64 + lane] >> 16) & 0x7Fu;
        ids[i] = ia * 128u + ib;
    }
    const float inv = 1.0f / sum;
    if (hh == 0) {
        unsigned short* SID = (unsigned short*)(ws + OFF_SELID) + tok * 128 + h * 16;
        float* SG = (float*)(ws + OFF_SELG) + tok * 128 + h * 16;
        u32x4 w0, w1;
        w0[0] = ids[0] | (ids[1] << 16); w0[1] = ids[2] | (ids[3] << 16); w0[2] = ids[4] | (ids[5] << 16); w0[3] = ids[6] | (ids[7] << 16);
        w1[0] = ids[8] | (ids[9] << 16); w1[1] = ids[10] | (ids[11] << 16); w1[2] = ids[12] | (ids[13] << 16); w1[3] = ids[14] | (ids[15] << 16);
        *(u32x4*)SID = w0; *(u32x4*)(SID + 8) = w1;
#pragma unroll
        for (int q = 0; q < 4; ++q) *(f32x4*)(SG + 4 * q) = (f32x4){e[4 * q] * inv, e[4 * q + 1] * inv, e[4 * q + 2] * inv, e[4 * q + 3] * inv};
    }
}

DI void phase_select(const Params& p, char* lds) {
    for (int item = vbid(); item < 1024; item += vgrid()) peer_select_unit_t<false>(p.ws, (const bf16_t*)((const char*)p.out + OUT_PQ), lds, (size_t)(item >> 3) * 128, item & 7, nullptr);
}

DI float gelu_erf(float v) {
    const float av = fabsf(v), t = __builtin_amdgcn_rcpf(av * 0.2316418882f + 1.0f);
    float q = t * 0.5307027145f + (-0.7265760135f); q = q * t + 0.7107068705f; q = q * t + (-0.142248368f); q = q * t + 0.127414796f; q = q * t;
    const float e = __builtin_amdgcn_exp2f((v * v) * (-0.72134752044f));
    const float m = v * (q * e), r = v - m;
    return v < 0.f ? m : r;
}
DI int dppi(int v, const int ctrl) { return v; }
#define DPP_I(v, ctrl) __builtin_amdgcn_update_dpp(0, (v), (ctrl), 0xf, 0xf, true)
DI float ub0(unsigned w) { return (float)(w & 0xFFu); }
DI float ub1(unsigned w) { return (float)((w >> 8) & 0xFFu); }
DI float ub2(unsigned w) { return (float)((w >> 16) & 0xFFu); }
DI float ub3(unsigned w) { return (float)(w >> 24); }

struct GBatch { u32x4 U[4], V[4]; float su[4], sv[4], gate[4]; };

DI void gather_load(GBatch& B, const char* __restrict__ ws, unsigned idpair, f32x2 gpair, int eb, int lane) {
#pragma unroll
    for (int j = 0; j < 4; ++j) {
        const int e = eb + j;
        const unsigned pr = __shfl(idpair, e >> 1);
        const unsigned id = (j & 1) ? (pr >> 16) : (pr & 0xFFFFu);
        const float g0 = __shfl(gpair[0], e >> 1), g1 = __shfl(gpair[1], e >> 1);
        B.gate[j] = (j & 1) ? g1 : g0;
        B.U[j] = ldu4(ws + OFF_UQ + (size_t)id * 2048 + 16 * lane);
        B.V[j] = ldu4(ws + OFF_UQ + (size_t)id * 2048 + 1024 + 16 * lane);
        B.su[j] = ((const float*)(ws + OFF_SU))[id];
        B.sv[j] = ((const float*)(ws + OFF_SV))[id];
    }
}

DI void gather_compute(const GBatch& B, const unsigned (&qx)[4], float sx, float (&acc)[16], float& csum, int lane) {
    int pd[4];
#pragma unroll
    for (int j = 0; j < 4; ++j) {
        int d = 0;
#pragma unroll
        for (int q = 0; q < 4; ++q) d = __builtin_amdgcn_sdot4((int)B.U[j][q], (int)qx[q], d, false);
        pd[j] = d;
    }
    const bool b0 = lane & 1, b1 = lane & 2;
    const int kA = b0 ? pd[1] : pd[0], kB = b0 ? pd[3] : pd[2], sA = b0 ? pd[0] : pd[1], sB = b0 ? pd[2] : pd[3];
    const int qA = kA + DPP_I(sA, 0xB1), qB = kB + DPP_I(sB, 0xB1);
    const int kp = b1 ? qB : qA, sd = b1 ? qA : qB;
    int tot = kp + DPP_I(sd, 0x4E);
    tot += DPP_I(tot, 0x124);
    tot += DPP_I(tot, 0x128);
    tot += __builtin_amdgcn_ds_swizzle(tot, 0x401F);
    { auto rr = __builtin_amdgcn_permlane32_swap((unsigned)tot, (unsigned)tot, false, false); tot = (int)rr[0] + (int)rr[1]; }
    const int j3 = lane & 3;
    const float su_sel = (j3 == 0) ? B.su[0] : (j3 == 1 ? B.su[1] : (j3 == 2 ? B.su[2] : B.su[3]));
    const float ge = gelu_erf((float)tot * sx * su_sel);
#pragma unroll
    for (int j = 0; j < 4; ++j) {
        const float cf = B.gate[j] * B.sv[j] * __uint_as_float((unsigned)__builtin_amdgcn_readlane((int)__float_as_uint(ge), j));
#pragma unroll
        for (int q = 0; q < 4; ++q) {
            const int w = (int)B.V[j][q];
            const f32x2 lo = __builtin_amdgcn_cvt_pk_f32_fp8(w, false), hi = __builtin_amdgcn_cvt_pk_f32_fp8(w, true);
            acc[4 * q] += cf * lo[0]; acc[4 * q + 1] += cf * lo[1]; acc[4 * q + 2] += cf * hi[0]; acc[4 * q + 3] += cf * hi[1];
        }
    }
}

DI void gather_token(const Params& p, size_t tok, int lane, float* dst_base) {
    char* ws = p.ws;
    const bf16_t* hrow = (const bf16_t*)(ws + OFF_HB) + tok * 1024 + 16 * lane;
    float hv[16];
    {
        const u32x4 w0 = ldu4(hrow), w1 = ldu4(hrow + 8);
#pragma unroll
        for (int e = 0; e < 4; ++e) { hv[2 * e] = bf_lo(w0[e]); hv[2 * e + 1] = bf_hi(w0[e]); hv[8 + 2 * e] = bf_lo(w1[e]); hv[8 + 2 * e + 1] = bf_hi(w1[e]); }
    }
    float rs;
    {
        const float* SS = (const float*)(ws + OFF_SS2) + tok * 16;
        const f32x4 s0 = *(const f32x4*)SS, s1 = *(const f32x4*)(SS + 4), s2 = *(const f32x4*)(SS + 8), s3 = *(const f32x4*)(SS + 12);
        const float tot = (s0[0] + s0[1] + s0[2] + s0[3]) + (s1[0] + s1[1] + s1[2] + s1[3]) + (s2[0] + s2[1] + s2[2] + s2[3]) + (s3[0] + s3[1] + s3[2] + s3[3]);
        rs = rsqrtf(tot * (1.0f / 1024.0f) + 1e-6f);
    }
    float xf[16]; float am = 0.f;
#pragma unroll
    for (int i = 0; i < 4; ++i) {
        const f32x4 g = *(const f32x4*)(p.norm_ffn + 16 * lane + 4 * i);
#pragma unroll
        for (int e = 0; e < 4; ++e) { xf[4 * i + e] = hv[4 * i + e] * rs * g[e]; am = fmaxf(am, fabsf(xf[4 * i + e])); }
    }
#pragma unroll
    for (int o = 32; o; o >>= 1) am = fmaxf(am, __shfl_xor(am, o));
    const float sx = (am > 0.f) ? am * (1.0f / 127.0f) : 1.0f;
    const float isx = 1.0f / sx;
    unsigned qx[4];
#pragma unroll
    for (int i = 0; i < 4; ++i) {
        unsigned w = 0u;
#pragma unroll
        for (int e = 0; e < 4; ++e) w |= ((unsigned)(int)rintf(xf[4 * i + e] * isx) & 0xFFu) << (8 * e);
        qx[i] = w;
    }
    const unsigned idpair = *((const unsigned*)(ws + OFF_SELID) + tok * 64 + lane);
    const f32x2 gpair = *((const f32x2*)(ws + OFF_SELG) + tok * 64 + lane);
    float acc[16]; float csum = 0.f;
#pragma unroll
    for (int i = 0; i < 16; ++i) acc[i] = 0.f;
    GBatch B0, B1;
    gather_load(B0, ws, idpair, gpair, 0, lane);
#pragma unroll 1
    for (int eb = 0; eb < 128; eb += 8) {
        gather_load(B1, ws, idpair, gpair, eb + 4, lane);
        gather_compute(B0, qx, sx, acc, csum, lane);
        if (eb + 8 < 128) gather_load(B0, ws, idpair, gpair, eb + 8, lane);
        gather_compute(B1, qx, sx, acc, csum, lane);
    }
    float ss = 0.f;
#pragma unroll
    for (int i = 0; i < 16; ++i) { acc[i] = acc[i] - 128.0f * csum + hv[i]; ss += acc[i] * acc[i]; }
#pragma unroll
    for (int o = 32; o; o >>= 1) ss += __shfl_xor(ss, o);
    const float rf = rsqrtf(ss * (1.0f / 1024.0f) + 1e-6f);
    float* drow = dst_base + tok * 1024 + 16 * lane;
#pragma unroll
    for (int i = 0; i < 4; ++i) {
        const f32x4 n = *(const f32x4*)(p.norm_final + 16 * lane + 4 * i);
        *(f32x4*)(drow + 4 * i) = (f32x4){acc[4 * i] * rf * n[0], acc[4 * i + 1] * rf * n[1], acc[4 * i + 2] * rf * n[2], acc[4 * i + 3] * rf * n[3]};
    }
}

DI void phase_gather(const Params& p, bool dry = false) {
    const int lane = otid() & 63, wv = otid() >> 6;
    float* dst = dry ? (float*)(p.ws + OFF_A) : p.out;
    for (int item = vbid(); item < T_TOK / 4; item += vgrid()) gather_token(p, (size_t)item * 4 + wv, lane, dst);
}

constexpr size_t GS_PSTRIDE = 1040;
constexpr size_t GS_SGS = OFF_A;
constexpr size_t GS_XQ = GS_SGS + (size_t)T_TOK * GS_PSTRIDE;
constexpr size_t GS_ACC = GS_XQ + (size_t)T_TOK * 1024;
static_assert(GS_ACC <= OFF_A + 69 * MiB, "gather scratch overflows region A");

DI void gs_load(GBatch& B, const char* __restrict__ ws, unsigned myid, float mygate, int j0, int n, int lane) {
#pragma unroll
    for (int j = 0; j < 4; ++j) {
        const int e = __builtin_amdgcn_readfirstlane(j0 + j);
        const bool ok = e < n;
        const int src = ok ? e : 0;
        const unsigned id = (unsigned)__builtin_amdgcn_readlane((int)myid, src);
        const float g = __uint_as_float((unsigned)__builtin_amdgcn_readlane((int)__float_as_uint(mygate), src));
        B.gate[j] = ok ? g : 0.f;
        const char* urow = ws + OFF_UQ + (size_t)id * 2048;
        const char* vrow = urow + 1024;
        B.U[j] = ldu4(urow + 16 * lane);
        B.V[j] = ldu4(vrow + 16 * lane);
        B.su[j] = ((const float*)(ws + OFF_SU))[id];
        B.sv[j] = ((const float*)(ws + OFF_SV))[id];
    }
}

#ifndef GS_NSL
#define GS_NSL 16
#endif
constexpr int NSL = GS_NSL, NSL_SH = (GS_NSL == 8 ? 11 : (GS_NSL == 16 ? 10 : (GS_NSL == 32 ? 9 : 12))), OFFW = 64;
DI void phase_gather_sliced(const Params& p, char* smem) {
    char* ws = p.ws;
    if ((T_TOK / 8) > 8 * (((int)gridDim.x >> 3) * 8) || ((int)gridDim.x & 7)) { phase_gather(p); return; }
    const int wvi = __builtin_amdgcn_readfirstlane((int)(threadIdx.x >> 6));
    char* lacc = smem + wvi * 16384 + (threadIdx.x & 63) * 32;
    unsigned short* lids = (unsigned short*)(smem + 131072 + wvi * 2048);
    unsigned char* loff = (unsigned char*)(smem + 131072 + 16384 + wvi * (8 * OFFW));
    const int lane = threadIdx.x & 63;
    const int x = (int)blockIdx.x & 7, nW = ((int)gridDim.x >> 3) * 8, lw = ((int)blockIdx.x >> 3) * 8 + wvi;
    const int TPX = T_TOK / 8;
    for (int tl = lw; tl < TPX; tl += nW) {
        const size_t tok = (size_t)x * TPX + tl;
        const bf16_t* hrow = (const bf16_t*)(ws + OFF_HB) + tok * 1024 + 16 * lane;
        float hv[16];
        {
            const u32x4 w0 = ldu4(hrow), w1 = ldu4(hrow + 8);
#pragma unroll
            for (int e = 0; e < 4; ++e) { hv[2 * e] = bf_lo(w0[e]); hv[2 * e + 1] = bf_hi(w0[e]); hv[8 + 2 * e] = bf_lo(w1[e]); hv[8 + 2 * e + 1] = bf_hi(w1[e]); }
        }
        float rs;
        {
            const float* SS = (const float*)(ws + OFF_SS2) + tok * 16;
            const f32x4 s0 = *(const f32x4*)SS, s1 = *(const f32x4*)(SS + 4), s2 = *(const f32x4*)(SS + 8), s3 = *(const f32x4*)(SS + 12);
            const float tot = (s0[0] + s0[1] + s0[2] + s0[3]) + (s1[0] + s1[1] + s1[2] + s1[3]) + (s2[0] + s2[1] + s2[2] + s2[3]) + (s3[0] + s3[1] + s3[2] + s3[3]);
            rs = rsqrtf(tot * (1.0f / 1024.0f) + 1e-6f);
        }
        float xf[16]; float am = 0.f;
#pragma unroll
        for (int i = 0; i < 4; ++i) {
            const f32x4 g = *(const f32x4*)(p.norm_ffn + 16 * lane + 4 * i);
#pragma unroll
            for (int e = 0; e < 4; ++e) { xf[4 * i + e] = hv[4 * i + e] * rs * g[e]; am = fmaxf(am, fabsf(xf[4 * i + e])); }
        }
#pragma unroll
        for (int o = 32; o; o >>= 1) am = fmaxf(am, __shfl_xor(am, o));
        const float sx = (am > 0.f) ? am * (1.0f / 127.0f) : 1.0f;
        const float isx = 1.0f / sx;
        u32x4 qx;
#pragma unroll
        for (int i = 0; i < 4; ++i) {
            unsigned w = 0u;
#pragma unroll
            for (int e = 0; e < 4; ++e) w |= ((unsigned)(int)rintf(xf[4 * i + e] * isx) & 0xFFu) << (8 * e);
            qx[i] = w;
        }
        *(u32x4*)(ws + GS_XQ + tok * 1024 + 16 * lane) = qx;
        const unsigned idpair = *((const unsigned*)(ws + OFF_SELID) + tok * 64 + lane);
        const f32x2 gpair = *((const f32x2*)(ws + OFF_SELG) + tok * 64 + lane);
        const unsigned id0 = idpair & 0xFFFFu, id1 = idpair >> 16;
        const int sl0 = (int)(id0 >> NSL_SH), sl1 = (int)(id1 >> NSL_SH);
        const unsigned long long lt = (1ull << lane) - 1ull;
        int base = 0, pos0 = 0, pos1 = 0, myoff = 0;
#pragma unroll
        for (int s = 0; s < NSL; ++s) {
            const unsigned long long m0 = __ballot(sl0 == s), m1 = __ballot(sl1 == s);
            const int c0 = __popcll(m0), c1 = __popcll(m1);
            if (sl0 == s) pos0 = base + __popcll(m0 & lt);
            if (sl1 == s) pos1 = base + c0 + __popcll(m1 & lt);
            if (lane == s) myoff = base;
            base += c0 + c1;
        }
        if (lane == NSL) myoff = base;
        f32x2* sg = (f32x2*)(ws + GS_SGS + tok * GS_PSTRIDE);
        { const int k = (tl - lw) / nW; lids[k * 128 + pos0] = (unsigned short)id0; lids[k * 128 + pos1] = (unsigned short)id1; if (lane <= NSL) loff[k * OFFW + lane] = (unsigned char)myoff; }
        const float* SU = (const float*)(ws + OFF_SU); const float* SV = (const float*)(ws + OFF_SV);
        sg[pos0] = (f32x2){sx * SU[id0], gpair[0] * SV[id0]}; sg[pos1] = (f32x2){sx * SU[id1], gpair[1] * SV[id1]};
        if (lane == 0) sg[128] = (f32x2){0.f, 0.f};

    }
    __syncthreads();
    const int ntk = (TPX - lw + nW - 1) / nW;
    for (int k = 0; k < ntk; ++k) { *(u32x4*)(lacc + k * 2048) = (u32x4){0u, 0u, 0u, 0u}; *(u32x4*)(lacc + k * 2048 + 16) = (u32x4){0u, 0u, 0u, 0u}; }
    const char* tab = ws + OFF_UQ;
    u32x4 QX[8];
#pragma unroll
    for (int k = 0; k < 8; ++k) { const int kk = (k < ntk) ? k : 0; QX[k] = ldu4(ws + GS_XQ + ((size_t)x * TPX + lw + (size_t)kk * nW) * 1024 + 16 * lane); }
    asm volatile("" : "+v"(QX[0]), "+v"(QX[1]), "+v"(QX[2]), "+v"(QX[3]), "+v"(QX[4]), "+v"(QX[5]), "+v"(QX[6]), "+v"(QX[7]));
    const unsigned lane16 = 16u * (unsigned)lane;
    struct SB { u32x4 U[8], V[8]; f32x2 pr; int k, m; };
#pragma unroll 1
    for (int pass = 0; pass < NSL; ++pass) {
        const int slice = pass;
        int kL = 0, jL = 0, nL = 0, oL = 0;
        float acc[16]; int kC = -1; u32x4 qxC = QX[0];
#define GS_OPEN(k_) do { oL = __builtin_amdgcn_readfirstlane((int)loff[(k_) * OFFW + slice]); nL = __builtin_amdgcn_readfirstlane((int)loff[(k_) * OFFW + slice + 1]) - oL; jL = 0; } while (0)
#define GS_ADVANCE(ok_) do { if (jL + 8 < nL) { jL += 8; ok_ = true; } else if (kL + 1 >= ntk) ok_ = false; else { ++kL; GS_OPEN(kL); ok_ = true; } } while (0)
#define GS_LOAD(B_, valid_) do { const size_t tok_ = (size_t)x * TPX + lw + (size_t)kL * nW; \
            const int el_ = jL + (lane & 7); const bool okl_ = el_ < nL;            \
            const unsigned idv_ = (unsigned)lids[kL * 128 + ((oL + (okl_ ? el_ : 0)) & 127)]; \
            const unsigned pro_ = okl_ ? 8u * (unsigned)((oL + el_) & 127) : 1024u;            \
            const char* prb_ = ws + GS_SGS + tok_ * GS_PSTRIDE; \
            B_.m = (valid_) ? min(8, nL - jL) : 0; \
            asm volatile("global_load_dwordx2 %0, %1, %2" : "=v"(B_.pr) : "v"(pro_), "s"(prb_)); \
            _Pragma("unroll") for (int j = 0; j < 8; ++j) if (j < B_.m) { const unsigned id_ = (unsigned)__builtin_amdgcn_readlane((int)idv_, j); const char* rb_ = tab + (size_t)id_ * 2048; \
                asm volatile("global_load_dwordx4 %0, %1, %2" : "+v"(B_.U[j]) : "v"(lane16), "s"(rb_)); \
                asm volatile("global_load_dwordx4 %0, %1, %2 offset:1024" : "+v"(B_.V[j]) : "v"(lane16), "s"(rb_)); } \
            B_.k = (valid_) ? kL : -1; } while (0)
#define GS_WAITN(n_) asm volatile("s_waitcnt vmcnt(" #n_ ")" ::: "memory")
#define GS_WAIT(B_, mn_) do { const int mn__ = (mn_); \
            if (mn__ >= 8) GS_WAITN(17); else if (mn__ == 7) GS_WAITN(15); else if (mn__ == 6) GS_WAITN(13); else if (mn__ == 5) GS_WAITN(11); else if (mn__ == 4) GS_WAITN(9); \
            else if (mn__ == 3) GS_WAITN(7); else if (mn__ == 2) GS_WAITN(5); else if (mn__ == 1) GS_WAITN(3); else GS_WAITN(1); \
            asm volatile("" : "+v"(B_.U[0]), "+v"(B_.U[1]), "+v"(B_.U[2]), "+v"(B_.U[3]), "+v"(B_.U[4]), "+v"(B_.U[5]), "+v"(B_.U[6]), "+v"(B_.U[7]), "+v"(B_.pr) :: "memory"); \
            asm volatile("" : "+v"(B_.V[0]), "+v"(B_.V[1]), "+v"(B_.V[2]), "+v"(B_.V[3]), "+v"(B_.V[4]), "+v"(B_.V[5]), "+v"(B_.V[6]), "+v"(B_.V[7]) :: "memory"); } while (0)
#define GS_FLUSH() do { if (kC >= 0) { char* la_ = lacc + kC * 2048; u32x4 w0_, w1_; \
                _Pragma("unroll") for (int e = 0; e < 4; ++e) { w0_[e] = pack2(acc[2 * e], acc[2 * e + 1]); w1_[e] = pack2(acc[8 + 2 * e], acc[8 + 2 * e + 1]); } \
                *(u32x4*)la_ = w0_; *(u32x4*)(la_ + 16) = w1_; } } while (0)
#define GS_CONSUME(B_) do { if (B_.k >= 0) { \
            if (B_.k != kC) { GS_FLUSH(); kC = B_.k; qxC = QX[0]; _Pragma("unroll") for (int t_ = 1; t_ < 8; ++t_) if (kC == t_) qxC = QX[t_]; const char* la_ = lacc + kC * 2048; const u32x4 w0_ = *(const u32x4*)la_, w1_ = *(const u32x4*)(la_ + 16); \
                _Pragma("unroll") for (int e = 0; e < 4; ++e) { acc[2 * e] = bf_lo(w0_[e]); acc[2 * e + 1] = bf_hi(w0_[e]); acc[8 + 2 * e] = bf_lo(w1_[e]); acc[8 + 2 * e + 1] = bf_hi(w1_[e]); } } \
            int pd_[8]; \
            _Pragma("unroll") for (int j = 0; j < 8; ++j) { int d_ = 0; if (j < B_.m) { _Pragma("unroll") for (int q = 0; q < 4; ++q) d_ = __builtin_amdgcn_sdot4((int)B_.U[j][q], (int)qxC[q], d_, false); } pd_[j] = d_; } \
            const bool b0_ = lane & 1, b1_ = lane & 2, b2_ = lane & 4; \
            int q1_[4]; _Pragma("unroll") for (int j = 0; j < 4; ++j) { const int kp_ = b0_ ? pd_[2 * j + 1] : pd_[2 * j], sd_ = b0_ ? pd_[2 * j] : pd_[2 * j + 1]; q1_[j] = kp_ + DPP_I(sd_, 0xB1); }        \
            int q2_[2]; _Pragma("unroll") for (int j = 0; j < 2; ++j) { const int kp_ = b1_ ? q1_[2 * j + 1] : q1_[2 * j], sd_ = b1_ ? q1_[2 * j] : q1_[2 * j + 1]; q2_[j] = kp_ + DPP_I(sd_, 0x4E); }     \
            int tot_; { const int kp_ = b2_ ? q2_[1] : q2_[0], sd_ = b2_ ? q2_[0] : q2_[1]; tot_ = kp_ + __builtin_amdgcn_ds_swizzle(sd_, 0x101F); }                                                \
            tot_ += DPP_I(tot_, 0x128); tot_ += __builtin_amdgcn_ds_swizzle(tot_, 0x401F); \
            { auto rr_ = __builtin_amdgcn_permlane32_swap((unsigned)tot_, (unsigned)tot_, false, false); tot_ = (int)rr_[0] + (int)rr_[1]; } \
            const float cfv_ = B_.pr[1] * gelu_erf((float)tot_ * B_.pr[0]); \
            _Pragma("unroll") for (int j = 0; j < 8; ++j) if (j < B_.m) { const float cf_ = __uint_as_float((unsigned)__builtin_amdgcn_readlane((int)__float_as_uint(cfv_), j)); \
                _Pragma("unroll") for (int q = 0; q < 4; ++q) { const int w_ = (int)B_.V[j][q]; const f32x2 lo_ = __builtin_amdgcn_cvt_pk_f32_fp8(w_, false), hi_ = __builtin_amdgcn_cvt_pk_f32_fp8(w_, true); \
                    acc[4 * q] += cf_ * lo_[0]; acc[4 * q + 1] += cf_ * lo_[1]; acc[4 * q + 2] += cf_ * hi_[0]; acc[4 * q + 3] += cf_ * hi_[1]; } } } } while (0)
        SB S0, S1;
        _Pragma("unroll") for (int j = 0; j < 8; ++j) { S0.U[j] = S0.V[j] = S1.U[j] = S1.V[j] = (u32x4){0u, 0u, 0u, 0u}; }
        bool h0, h1;
        GS_OPEN(0);
        GS_LOAD(S0, true);
#pragma unroll 1
        for (;;) {
            GS_ADVANCE(h1); GS_LOAD(S1, h1);
            GS_WAIT(S0, S1.m); GS_CONSUME(S0);
            if (!h1) break;
            GS_ADVANCE(h0); GS_LOAD(S0, h0);
            GS_WAIT(S1, S0.m); GS_CONSUME(S1);
            if (!h0) break;
        }
        asm volatile("s_waitcnt vmcnt(0)" ::: "memory");
        GS_FLUSH();
#undef GS_OPEN
#undef GS_ADVANCE
#undef GS_LOAD
#undef GS_FLUSH
#undef GS_CONSUME
#undef GS_WAIT
#undef GS_WAITN
    }
    for (int k = 0; k < ntk; ++k) {
        const size_t tok = (size_t)x * TPX + lw + (size_t)k * nW;
        const char* la = lacc + k * 2048; const u32x4 a0 = *(const u32x4*)la, a1 = *(const u32x4*)(la + 16);
        const bf16_t* hrow = (const bf16_t*)(ws + OFF_HB) + tok * 1024 + 16 * lane; const u32x4 w0 = ldu4(hrow), w1 = ldu4(hrow + 8);
        float acc[16]; float ss = 0.f;
#pragma unroll
        for (int e = 0; e < 4; ++e) { acc[2 * e] = bf_lo(a0[e]) + bf_lo(w0[e]); acc[2 * e + 1] = bf_hi(a0[e]) + bf_hi(w0[e]); acc[8 + 2 * e] = bf_lo(a1[e]) + bf_lo(w1[e]); acc[8 + 2 * e + 1] = bf_hi(a1[e]) + bf_hi(w1[e]); }
#pragma unroll
        for (int i = 0; i < 16; ++i) ss += acc[i] * acc[i];
#pragma unroll
        for (int o = 32; o; o >>= 1) ss += __shfl_xor(ss, o);
        const float rf = rsqrtf(ss * (1.0f / 1024.0f) + 1e-6f); float* drow = p.out + tok * 1024 + 16 * lane;
#pragma unroll
        for (int i = 0; i < 4; ++i) { const f32x4 nn = *(const f32x4*)(p.norm_final + 16 * lane + 4 * i);
            *(f32x4*)(drow + 4 * i) = (f32x4){acc[4 * i] * rf * nn[0], acc[4 * i + 1] * rf * nn[1], acc[4 * i + 2] * rf * nn[2], acc[4 * i + 3] * rf * nn[3]}; }
    }
}

struct EpiPQSel8 {
    static constexpr bool PERM = true, AFTER_DRAIN = true;
    char* ws; const float* SS; char* smem;
    DI void operator()(EPI_ARGS) const {}
    DI void fused(EPI_ARGS, PG8_LAS unsigned char*, int, int) const {
#pragma unroll
        for (int ai = 0; ai < 2; ++ai)
#pragma unroll
            for (int m = 0; m < 4; ++m) {
                int fr_ = fr; asm volatile("" : "+v"(fr_));
                const int row = ai * 128 + wr * 64 + m * 16 + fr_;
                const size_t tok = (size_t)u.pm * 256 + row;
                const f32x4 s0 = *(const f32x4*)(SS + tok * 16), s1 = *(const f32x4*)(SS + tok * 16 + 4), s2 = *(const f32x4*)(SS + tok * 16 + 8), s3 = *(const f32x4*)(SS + tok * 16 + 12);
                const float tot = (s0[0] + s0[1] + s0[2] + s0[3]) + (s1[0] + s1[1] + s1[2] + s1[3]) + (s2[0] + s2[1] + s2[2] + s2[3]) + (s3[0] + s3[1] + s3[2] + s3[3]);
                const float sc = rsqrtf(tot * (1.0f / 1024.0f) + 1e-6f);
#pragma unroll
                for (int bj = 0; bj < 2; ++bj) { EPI_LOAD8(v, ai, bj, m); *(u32x4*)(smem + row * 512 + (((16 * bj + 4 * wc + fq) ^ (row & 31)) << 4)) = pack8(v, sc); }
            }
        __syncthreads();
        char* half = smem + vhalf() * 65536;
        peer_select_unit_t<true>(ws, nullptr, half, (size_t)u.pm * 256 + 128 * vhalf(), u.pn, half);
        __syncthreads();
    }
};
struct EpiMQAttn8 {
    static constexpr bool PERM = true, AFTER_DRAIN = true;
    char* ws; const float* SS; char* smem; float extra;
    DI void operator()(EPI_ARGS) const {}
    DI void fused(EPI_ARGS, PG8_LAS unsigned char*, int, int) const {
#pragma unroll
        for (int ai = 0; ai < 2; ++ai)
#pragma unroll
            for (int m = 0; m < 4; ++m) {
                int fr_ = fr; asm volatile("" : "+v"(fr_));
                const int row = ai * 128 + wr * 64 + m * 16 + fr_;
                const size_t tok = (size_t)u.pm * 256 + row;
                const f32x4 s0 = *(const f32x4*)(SS + tok * 16), s1 = *(const f32x4*)(SS + tok * 16 + 4), s2 = *(const f32x4*)(SS + tok * 16 + 8), s3 = *(const f32x4*)(SS + tok * 16 + 12);
                const float tot = (s0[0] + s0[1] + s0[2] + s0[3]) + (s1[0] + s1[1] + s1[2] + s1[3]) + (s2[0] + s2[1] + s2[2] + s2[3]) + (s3[0] + s3[1] + s3[2] + s3[3]);
                const float sc = rsqrtf(tot * (1.0f / 1024.0f) + 1e-6f) * extra;
#pragma unroll
                for (int bj = 0; bj < 2; ++bj) { EPI_LOAD8(v, ai, bj, m); *(u32x4*)(smem + row * 512 + (((16 * bj + 4 * wc + fq) ^ (row & 31)) << 4)) = pack8(v, sc); }
            }
        __syncthreads();
        char* half = smem + vhalf() * 65536;
        const int tok0 = u.pm * 256 + 128 * vhalf();
        memattn_unit_t<true>(ws, half, tok0 / SEQ_L, u.pn, (tok0 % SEQ_L) / 128, half);
        __syncthreads();
    }
};
struct OneUnit {
    pg8::StaticOrder S; int rep;
    DI bool next(int i, pg8::Unit& u) const { return i == 0 && S.next(rep, u); }
    DI void a_ready(const pg8::Unit&) const {}
    DI void done(const pg8::Unit&) const {}
};
DI void phase_pqsel(const Params& p, char* smem) {
    char* ws = p.ws;
    pg8::Gemm g; g.A = (const bf16_t*)(ws + OFF_HB); g.Bt = (const bf16_t*)(ws + OFF_WT_PQ); g.M = T_TOK; g.N = 2048; g.K = 1024; g.lda = 1024;
    const int G = (int)gridDim.x;
    OneUnit S; S.S.init(T_TOK, 2048, G, (int)blockIdx.x); S.rep = 0;
    EpiPQSel8 e{ws, (const float*)(ws + OFF_SS2), smem};
    const int nrep = (64 * 8 + G - 1) / G;
#pragma unroll 1
    for (int rep = 0; rep < nrep; ++rep) { S.rep = rep; pg8::gemm_phase<EpiPQSel8, OneUnit, true, true>((PG8_LAS unsigned char*)smem, g, S, e); }
}
DI void phase_mqattn(const Params& p, char* smem) {
    char* ws = p.ws;
    pg8::Gemm g; g.A = (const bf16_t*)(ws + OFF_HB); g.Bt = (const bf16_t*)(ws + OFF_WT_MQ); g.M = T_TOK; g.N = 1024; g.K = 1024; g.lda = 1024;
    const int G = (int)gridDim.x;
    OneUnit S; S.S.init(T_TOK, 1024, G, (int)blockIdx.x); S.rep = 0;
    EpiMQAttn8 e{ws, (const float*)(ws + OFF_SS1), smem, 0.0625f * LOG2E};
    const int nrep = (64 * 4 + G - 1) / G;
#pragma unroll 1
    for (int rep = 0; rep < nrep; ++rep) { S.rep = rep; pg8::gemm_phase<EpiMQAttn8, OneUnit, true, true>((PG8_LAS unsigned char*)smem, g, S, e); }
}
constexpr int LDS_BYTES = 131072 + 16384 + 4096;
constexpr int NPHASE = 12;
template <int PH> DI void run_phase(const Params& p, char* smem) {
    char* lds = smem + vhalf() * 65536;
    if (PH == 0) phase_prep(p, lds);
    else if (PH == 1) phase_p1(p, smem);
    else if (PH == 2) phase_p2(p, smem);
    else if (PH == 3) phase_p3(p, lds);
    else if (PH == 4) phase_p35(p, lds);
    else if (PH == 5) phase_resid<false>(p, smem, OFF_WT_OUT, OFF_MIXED, p.x, OFF_SS1);
    else if (PH == 6) phase_mqattn(p, smem);
    else if (PH == 8) phase_resid<true>(p, smem, OFF_WT_MO, OFF_OM, p.ws + OFF_HB, OFF_SS2);
    else if (PH == 9) phase_pqsel(p, smem);
    else if (PH == 11) phase_gather_sliced(p, smem);
}

template <int PH> __global__ void __launch_bounds__(512, 2) k_phase(Params p) {
    __shared__ __attribute__((aligned(16))) char smem[LDS_BYTES];
    run_phase<PH>(p, smem);
}

static Params make_params(void* const* d_in, void* d_out, void* d_ws) {
    Params p;
    memset(&p, 0, sizeof(p));
    p.x = (const float*)d_in[0]; p.mem = (const float*)d_in[1]; p.norm_mix = (const float*)d_in[2]; p.w_in = (const float*)d_in[3];
    p.q_norm = (const float*)d_in[4]; p.kv_norm = (const float*)d_in[5]; p.w_uq = (const float*)d_in[6]; p.w_ukv = (const float*)d_in[7];
    p.gn_mla = (const float*)d_in[8]; p.gn_dil = (const float*)d_in[9]; p.w_out = (const float*)d_in[10]; p.norm_mem_q = (const float*)d_in[11];
    p.norm_mem_kv = (const float*)d_in[12]; p.w_mem_q = (const float*)d_in[13]; p.w_mem_kv = (const float*)d_in[14]; p.w_mem_o = (const float*)d_in[15];
    p.norm_ffn = (const float*)d_in[16]; p.peer_w_q = (const float*)d_in[17]; p.sub_keys = (const float*)d_in[18]; p.peer_u = (const float*)d_in[19];
    p.peer_v = (const float*)d_in[20]; p.norm_final = (const float*)d_in[21];
    p.out = (float*)d_out; p.ws = (char*)d_ws;
    for (int i = 0; i < 16; ++i) p.inv_freq[i] = 1.0f / powf(10000.0f, (float)(2 * i) / 32.0f);
    return p;
}
__global__ void __launch_bounds__(512, 2) k_mega(Params p) {
    __shared__ __attribute__((aligned(16))) char smem[LDS_BYTES + 16];
    volatile LAS unsigned* st = (volatile LAS unsigned*)(LAS char*)(smem + LDS_BYTES);
    if (threadIdx.x == 0) { st[0] = 0u; st[1] = 0u; st[2] = 0u; st[3] = 0u; }
    __syncthreads();
    const XcdBarrier xb = xcd_barrier_post((unsigned*)(p.ws + OFF_BAR), st);
#define RP(n) run_phase<n>(p, smem); xcd_barrier(xb);
    RP(0) RP(1) RP(2) RP(3) RP(4) RP(5) RP(6) RP(8) RP(9)
    run_phase<11>(p, smem);
}

extern "C" void kernel_launch(void* const* d_in, const int* in_sizes, int n_in, void* d_out, int out_size, void* d_ws, size_t ws_size,
                              hipStream_t stream) {
    static int grid_blocks = 0;
    if (!grid_blocks) {
        int dev = 0, cus = 0, per_cu = 0;
        (void)hipGetDevice(&dev);
        (void)hipDeviceGetAttribute(&cus, hipDeviceAttributeMultiprocessorCount, dev);
        (void)hipOccupancyMaxActiveBlocksPerMultiprocessor(&per_cu, k_mega, 512, 0);
        if (per_cu > 1) per_cu = 1;
        if (per_cu < 1) per_cu = 1;
        grid_blocks = cus * per_cu;
    }
    Params p = make_params(d_in, d_out, d_ws);
    (void)hipMemsetAsync((char*)d_ws + OFF_BAR, 0, XCD_BAR_WORDS * 4, stream);
    void* args[] = {&p};
    hipError_t e = hipLaunchCooperativeKernel((const void*)k_mega, dim3(grid_blocks), dim3(512), args, 0, stream);
    if (e != hipSuccess) fprintf(stderr, "cooperative launch failed: %s (grid %d)\n", hipGetErrorString(e), grid_blocks);
}
```

```cpp
#include <hip/hip_runtime.h>
#include <hip/hip_cooperative_groups.h>
#include <math.h>
#include <stdint.h>
#include <stdio.h>
#include <string.h>
#define DI __device__ __forceinline__
typedef unsigned short bf16_t;
typedef short bf16x8 __attribute__((ext_vector_type(8)));
typedef short s16x4 __attribute__((ext_vector_type(4)));
typedef float f32x16 __attribute__((ext_vector_type(16)));
typedef float f32x4 __attribute__((ext_vector_type(4)));
typedef float f32x2 __attribute__((ext_vector_type(2)));
typedef unsigned u32x4 __attribute__((ext_vector_type(4)));
typedef unsigned u32x2 __attribute__((ext_vector_type(2)));
typedef __bf16 bf16x2v __attribute__((ext_vector_type(2)));
#define LAS __attribute__((address_space(3)))
#define MFMA32(a, b, c) __builtin_amdgcn_mfma_f32_32x32x16_bf16((a), (b), (c), 0, 0, 0)

constexpr int T_TOK = 16384, SEQ_L = 4096, DM = 1024, INC = 2208;
constexpr float LOG2E = 1.4426950408889634f;

DI int otid() { int t = threadIdx.x & 255; asm volatile("" : "+v"(t)); return t; }
DI int vhalf() { return __builtin_amdgcn_readfirstlane((int)(threadIdx.x >> 8)); }
DI int vbid() { return (int)blockIdx.x * 2 + vhalf(); }
DI int vgrid() { return (int)gridDim.x * 2; }
DI unsigned pack2(float lo, float hi) { f32x2 f = {lo, hi}; return __builtin_bit_cast(unsigned, __builtin_convertvector(f, bf16x2v)); }
DI float bf_lo(unsigned u) { return __uint_as_float(u << 16); }
DI float bf_hi(unsigned u) { return __uint_as_float(u & 0xffff0000u); }
DI float bf2f(bf16_t v) { return __uint_as_float(((unsigned)v) << 16); }
DI int crow(int reg, int hh) { return (reg & 3) + 8 * (reg >> 2) + 4 * hh; }
DI f32x16 zero16() { f32x16 z;
#pragma unroll
    for (int i = 0; i < 16; ++i) z[i] = 0.f; return z; }
DI float xhalf_max(float v) { auto r = __builtin_amdgcn_permlane32_swap(__float_as_uint(v), __float_as_uint(v), false, false); return fmaxf(__uint_as_float(r[0]), __uint_as_float(r[1])); }
DI float xhalf_other(float v, int lane) { auto r = __builtin_amdgcn_permlane32_swap(__float_as_uint(v), __float_as_uint(v), false, false); return __uint_as_float((lane & 32) ? r[0] : r[1]); }
DI float xhalf_sum(float v) { auto r = __builtin_amdgcn_permlane32_swap(__float_as_uint(v), __float_as_uint(v), false, false); return __uint_as_float(r[0]) + __uint_as_float(r[1]); }
DI bf16x8 ld16(const void* p) { return *(const bf16x8*)p; }
DI u32x4 ldu4(const void* p) { return *(const u32x4*)p; }
DI float fast_exp2(float x) { return __builtin_amdgcn_exp2f(x); }
DI bf16x8 pack_step(const f32x16& x, int s) {
    u32x4 p;
    p[0] = pack2(x[8 * s + 0], x[8 * s + 1]); p[1] = pack2(x[8 * s + 2], x[8 * s + 3]);
    p[2] = pack2(x[8 * s + 4], x[8 * s + 5]); p[3] = pack2(x[8 * s + 6], x[8 * s + 7]);
    return __builtin_bit_cast(bf16x8, p);
}
DI s16x4 tr_read_a(unsigned lds_byte_addr) { s16x4 r; asm volatile("ds_read_b64_tr_b16 %0, %1" : "=v"(r) : "v"(lds_byte_addr)); return r; }
template <int OFF> DI s16x4 tr_read_ao(unsigned lds_byte_addr) { s16x4 r; asm volatile("ds_read_b64_tr_b16 %0, %1 offset:%2" : "=v"(r) : "v"(lds_byte_addr), "i"(OFF)); return r; }
#define TR_WAIT() do { asm volatile("s_waitcnt lgkmcnt(0)" ::: "memory"); __builtin_amdgcn_sched_barrier(0); } while (0)
DI s16x4 tr_read(unsigned lds_byte_addr) {
    return __builtin_amdgcn_ds_read_tr16_b64_v4i16((LAS s16x4*)(uintptr_t)lds_byte_addr);
}

constexpr size_t MiB = 1ull << 20;
constexpr size_t OFF_BAR = 0;
constexpr size_t OFF_WT_IN = 65536;
constexpr size_t OFF_WT_UQ = OFF_WT_IN + 2304ull * 1024 * 2;
constexpr size_t OFF_WT_UKV = OFF_WT_UQ + 768ull * 384 * 2;
constexpr size_t OFF_WT_OUT = OFF_WT_UKV + 1024ull * 256 * 2;
constexpr size_t OFF_WT_MQ = OFF_WT_OUT + 1024ull * 1024 * 2;
constexpr size_t OFF_WT_MKV = OFF_WT_MQ + 1024ull * 1024 * 2;
constexpr size_t OFF_WT_MO = OFF_WT_MKV + 2048ull * 1024 * 2;
constexpr size_t OFF_WT_PQ = OFF_WT_MO + 1024ull * 1024 * 2;
constexpr size_t OFF_KEYS = OFF_WT_PQ + 2048ull * 1024 * 2;
constexpr size_t OFF_ROPE = OFF_KEYS + 16ull * 128 * 128 * 2;
constexpr size_t OFF_KR = OFF_ROPE + 2ull * 4096 * 16 * 4;
constexpr size_t OFF_LSE = OFF_KR + (size_t)T_TOK * 32 * 2;
constexpr size_t OFF_SS1 = OFF_LSE + 3ull * T_TOK * 8 * 4;
constexpr size_t OFF_SS2 = OFF_SS1 + (size_t)T_TOK * 16 * 4;
constexpr size_t OFF_MEMN = OFF_SS2 + (size_t)T_TOK * 16 * 4;
constexpr size_t OFF_SMALL_END = OFF_MEMN + 1024ull * 1024 * 2;
static_assert(OFF_SMALL_END <= 28 * MiB, "small region overflow");
constexpr size_t OFF_A = 28 * MiB;
constexpr size_t OFF_PROJ = OFF_A;
constexpr size_t OFF_UQ = 193 * MiB;
constexpr size_t OFF_SU = 243 * MiB;
constexpr size_t OFF_SV = OFF_SU + 65536;
constexpr size_t OUT_ODIL = 0;
constexpr size_t OUT_OMLA = 48 * MiB;
constexpr size_t OUT_PQ = 0;
constexpr size_t OFF_B = 97 * MiB;
constexpr size_t OFF_XN = OFF_B, OFF_QMLA = OFF_B, OFF_MIXED = OFF_B, OFF_QM = OFF_B;
constexpr size_t OFF_C = 129 * MiB;
constexpr size_t OFF_KVMLA = OFF_C, OFF_HB = OFF_C;
constexpr size_t OFF_D = 161 * MiB;
constexpr size_t OFF_OM = OFF_D;
constexpr size_t OFF_SELID = 225 * MiB;
constexpr size_t OFF_SELG = 229 * MiB;
constexpr size_t OFF_KVM = 237 * MiB;
constexpr size_t OFF_SSQ = 241 * MiB;
constexpr size_t WS_NEEDED = 244 * MiB;

struct Params {
    const float* x; const float* mem; const float* norm_mix; const float* w_in; const float* q_norm; const float* kv_norm;
    const float* w_uq; const float* w_ukv; const float* gn_mla; const float* gn_dil; const float* w_out; const float* norm_mem_q;
    const float* norm_mem_kv; const float* w_mem_q; const float* w_mem_kv; const float* w_mem_o; const float* norm_ffn;
    const float* peer_w_q; const float* sub_keys; const float* peer_u; const float* peer_v; const float* norm_final;
    float* out; char* ws;
    float inv_freq[16];
    int prof; int pad_;
};
#define XB_TMO      128
#define XB_XCNT(j)  (256  + 64 * (j))
#define XB_XSUB(j)  (1280 + 64 * (j))
#define XB_XGEN(j)  (2304 + 64 * (j))
#define XB_TOP      3328
#define XB_TOPGEN   3392
#define XCD_BAR_WORDS 3456
#define XB_SPIN_CAP (1u << 20)
DI unsigned xb_ld(unsigned* p) { return __hip_atomic_load(p, __ATOMIC_RELAXED, __HIP_MEMORY_SCOPE_AGENT); }
DI unsigned xb_add(unsigned* p, unsigned v) { return __hip_atomic_fetch_add(p, v, __ATOMIC_RELAXED, __HIP_MEMORY_SCOPE_AGENT); }
DI unsigned xb_xcc_id() { return (unsigned)__builtin_amdgcn_s_getreg((3 << 11) | 20) & 0xFu; }
#define XB_SPIN(cond, bar) do { unsigned _sp = 0; while (cond) { __builtin_amdgcn_s_sleep(1); \
    if ((++_sp & 255u) == 0u) { if (xb_ld(&(bar)[XB_TMO])) break; if (_sp > XB_SPIN_CAP) { atomicAdd(&(bar)[XB_TMO], 1u); break; } } } } while (0)
struct XcdBarrier { unsigned* bar; unsigned x; volatile LAS unsigned* st; };
DI XcdBarrier xcd_barrier_post(unsigned* bar, volatile LAS unsigned* st) {
    XcdBarrier b; b.bar = bar; b.x = xb_xcc_id(); b.st = st;
    if (threadIdx.x == 0) (void)xb_add(&bar[XB_XCNT(b.x)], 1u);
    return b;
}
DI void xcd_barrier_complete(unsigned* bar, unsigned x, unsigned& nloc, unsigned& nx) {
    const unsigned G = gridDim.x * gridDim.y * gridDim.z;
    unsigned sum, cnt, mine, sp = 0u;
    for (;;) {
        sum = 0u; cnt = 0u; mine = 0u;
#pragma unroll
        for (unsigned j = 0; j < 16; ++j) { const unsigned c = xb_ld(&bar[XB_XCNT(j)]); sum += c; cnt += (c > 0u) ? 1u : 0u; mine = (j == x) ? c : mine; }
        if (sum == G) break;
        __builtin_amdgcn_s_sleep(1);
        if ((++sp & 255u) == 0u) { if (xb_ld(&bar[XB_TMO])) break; if (sp > XB_SPIN_CAP) { atomicAdd(&bar[XB_TMO], 1u); break; } }
    }
    nloc = mine > 0u ? mine : 1u; nx = cnt > 0u ? cnt : 1u;
}
DI void xcd_barrier(const XcdBarrier& b) {
    asm volatile("s_waitcnt vmcnt(0)" ::: "memory");
    __syncthreads();
    if (threadIdx.x == 0) {
        unsigned* bar = b.bar;
        __builtin_amdgcn_s_waitcnt(0);
        unsigned nloc = b.st[0], nx = b.st[1];
        if (nloc == 0u) { xcd_barrier_complete(bar, b.x, nloc, nx); b.st[0] = nloc; b.st[1] = nx; }
        const unsigned old = xb_add(&bar[XB_XSUB(b.x)], 1u);
        const unsigned gen = old / nloc;
        if (old + 1u == (gen + 1u) * nloc) {
            __builtin_amdgcn_fence(__ATOMIC_RELEASE, "agent");
            asm volatile("s_waitcnt vmcnt(0)" ::: "memory");
            const unsigned og = xb_add(&bar[XB_TOP], 1u);
            const unsigned tg = og / nx;
            if (og + 1u == (tg + 1u) * nx) xb_add(&bar[XB_TOPGEN], 1u);
            else XB_SPIN(xb_ld(&bar[XB_TOPGEN]) == tg, bar);
            __builtin_amdgcn_fence(__ATOMIC_ACQUIRE, "agent");
            xb_add(&bar[XB_XGEN(b.x)], 1u);
            asm volatile("s_waitcnt vmcnt(0)" ::: "memory");
        } else {
            XB_SPIN(xb_ld(&bar[XB_XGEN(b.x)]) == gen, bar);
            __builtin_amdgcn_fence(__ATOMIC_ACQUIRE, "agent");
            asm volatile("s_waitcnt vmcnt(0)" ::: "memory");
        }
    }
    __syncthreads();
}
DI void transpose_tile(const float* __restrict__ W, int K, int N, const float* __restrict__ g, bf16_t* __restrict__ Wt, int kt, int nt, char* lds, bool valid) {
    float* sm = (float*)lds;
    const int t = otid();
    const int k0 = kt * 64, n0 = nt * 64;
    __syncthreads();
#pragma unroll
    for (int i = 0; i < 16; ++i) {
        const int id = t + 256 * i, k = id >> 6, n = id & 63;
        float v = 0.f;
        if (valid && n0 + n < N) { v = W[(size_t)(k0 + k) * N + n0 + n]; if (g) v *= g[k0 + k]; }
        sm[k * 65 + n] = v;
    }
    __syncthreads();
    const int n = t >> 2, kc = (t & 3) * 16;
    u32x4 o0, o1;
    o0[0] = pack2(sm[(kc + 0) * 65 + n], sm[(kc + 1) * 65 + n]); o0[1] = pack2(sm[(kc + 2) * 65 + n], sm[(kc + 3) * 65 + n]);
    o0[2] = pack2(sm[(kc + 4) * 65 + n], sm[(kc + 5) * 65 + n]); o0[3] = pack2(sm[(kc + 6) * 65 + n], sm[(kc + 7) * 65 + n]);
    o1[0] = pack2(sm[(kc + 8) * 65 + n], sm[(kc + 9) * 65 + n]); o1[1] = pack2(sm[(kc + 10) * 65 + n], sm[(kc + 11) * 65 + n]);
    o1[2] = pack2(sm[(kc + 12) * 65 + n], sm[(kc + 13) * 65 + n]); o1[3] = pack2(sm[(kc + 14) * 65 + n], sm[(kc + 15) * 65 + n]);
    bf16_t* dst = Wt + (size_t)(n0 + n) * K + k0 + kc;
    if (valid) { *(u32x4*)dst = o0; *(u32x4*)(dst + 8) = o1; }
}

DI void rmsnorm_row_bf16(const float* __restrict__ in, const float* __restrict__ g, bf16_t* __restrict__ out, int lane) {
    f32x4 v[4]; float ss = 0.f;
#pragma unroll
    for (int i = 0; i < 4; ++i) { v[i] = *(const f32x4*)(in + 4 * lane + 256 * i); ss += v[i][0] * v[i][0] + v[i][1] * v[i][1] + v[i][2] * v[i][2] + v[i][3] * v[i][3]; }
#pragma unroll
    for (int o = 32; o; o >>= 1) ss += __shfl_xor(ss, o);
    const float rs = rsqrtf(ss * (1.0f / 1024.0f) + 1e-6f);
#pragma unroll
    for (int i = 0; i < 4; ++i) {
        const f32x4 gg = *(const f32x4*)(g + 4 * lane + 256 * i);
        u32x2 o; o[0] = pack2(v[i][0] * rs * gg[0], v[i][1] * rs * gg[1]); o[1] = pack2(v[i][2] * rs * gg[2], v[i][3] * rs * gg[3]);
        *(u32x2*)(out + 4 * lane + 256 * i) = o;
    }
}

struct TrJob { const float* W; const float* g; size_t off; int K, N, Npad; };

DI void phase_prep(const Params& p, char* lds) {
    char* ws = p.ws;
    const int t = otid(), lane = t & 63, wv = t >> 6;
    const int c0 = 576, c1 = c0 + 72, c2 = c1 + 64, c3 = c2 + 256, c4 = c3 + 256, c5 = c4 + 512, c6 = c5 + 256, c7 = c6 + 512;
    const int nrow = (T_TOK + 1024) / 4;
    const int nkeys = 128, nrope = 256;
    const int total = c7 + nrow + nkeys + nrope;
    for (int k = 0; k < (c7 + vgrid() - 1) / vgrid(); ++k) {
        const int raw = vbid() + k * vgrid();
        const bool valid = raw < c7;
        const int item = valid ? raw : 0;
        const float* W; const float* g; size_t off; int K, N, Npad, local;
        if (item < c0)      { W = p.w_in;     g = nullptr;      off = OFF_WT_IN;  K = 1024; N = 2208; Npad = 2304; local = item; }
        else if (item < c1) { W = p.w_uq;     g = p.q_norm;     off = OFF_WT_UQ;  K = 384;  N = 768;  Npad = 768;  local = item - c0; }
        else if (item < c2) { W = p.w_ukv;    g = p.kv_norm;    off = OFF_WT_UKV; K = 256;  N = 1024; Npad = 1024; local = item - c1; }
        else if (item < c3) { W = p.w_out;    g = nullptr;      off = OFF_WT_OUT; K = 1024; N = 1024; Npad = 1024; local = item - c2; }
        else if (item < c4) { W = p.w_mem_q;  g = p.norm_mem_q; off = OFF_WT_MQ;  K = 1024; N = 1024; Npad = 1024; local = item - c3; }
        else if (item < c5) { W = p.w_mem_kv; g = nullptr;      off = OFF_WT_MKV; K = 1024; N = 2048; Npad = 2048; local = item - c4; }
        else if (item < c6) { W = p.w_mem_o;  g = nullptr;      off = OFF_WT_MO;  K = 1024; N = 1024; Npad = 1024; local = item - c5; }
        else                { W = p.peer_w_q; g = p.norm_ffn;   off = OFF_WT_PQ;  K = 1024; N = 2048; Npad = 2048; local = item - c6; }
        const int ntn = Npad / 64;
        transpose_tile(W, K, N, g, (bf16_t*)(ws + off), local / ntn, local % ntn, lds, valid);
    }
    for (int item = c7 + vbid(); item < total; item += vgrid()) {
        if (item < c7 + nrow) {
            const int row = (item - c7) * 4 + wv;
            if (row < T_TOK) rmsnorm_row_bf16(p.x + (size_t)row * 1024, p.norm_mix, (bf16_t*)(ws + OFF_XN) + (size_t)row * 1024, lane);
            else rmsnorm_row_bf16(p.mem + (size_t)(row - T_TOK) * 1024, p.norm_mem_kv, (bf16_t*)(ws + OFF_MEMN) + (size_t)(row - T_TOK) * 1024, lane);
        } else if (item < c7 + nrow + nkeys) {
            const int idx = ((item - c7 - nrow) * 256 + t) * 8;
            const f32x4 a = *(const f32x4*)(p.sub_keys + idx), b = *(const f32x4*)(p.sub_keys + idx + 4);
            u32x4 o; o[0] = pack2(a[0], a[1]); o[1] = pack2(a[2], a[3]); o[2] = pack2(b[0], b[1]); o[3] = pack2(b[2], b[3]);
            *(u32x4*)((bf16_t*)(ws + OFF_KEYS) + idx) = o;
        } else {
            const int idx = (item - c7 - nrow - nkeys) * 256 + t;
            const int s = idx >> 4, i = idx & 15;
            const float ang = (float)s * p.inv_freq[i];
            const double a = (double)ang;
            const double twopi = 6.283185307179586476925;
            const float rf = (float)(a - twopi * rint(a / twopi));
            float* cs = (float*)(ws + OFF_ROPE);
            cs[idx] = cosf(rf); cs[65536 + idx] = sinf(rf);
        }
    }
}
namespace pg8 {
#define PG8_LAS __attribute__((address_space(3)))
typedef unsigned short bf16_t;
typedef short bf16x8 __attribute__((ext_vector_type(8)));
typedef float f32x4 __attribute__((ext_vector_type(4)));
typedef unsigned u32x4 __attribute__((ext_vector_type(4)));
constexpr int BM = 256, BK = 64, HALF = 128, HTB = HALF * BK * 2  , STAGE_BYTES = 8 * HTB, NXCD = 8, WGM = 8;

__host__ __device__ __forceinline__ int lds_byte(int r, int c) { const int st = (r >> 4) * 2 + (c >> 5), rr = r & 15, cc = c & 31, ob = rr * 64 + cc * 2; return st * 1024 + (ob ^ (((ob >> 9) & 1) << 5)); }
__host__ __device__ __forceinline__ void stage_rc(int b, int& R, int& C) { const int st = b / 1024, sb = b % 1024, swz = sb ^ (((sb >> 9) & 1) << 5); R = (st >> 1) * 16 + swz / 64; C = (st & 1) * 32 + (swz % 64) / 2; }
__host__ __device__ __forceinline__ int perm32(int rho) { const int n = rho >> 4, i = rho & 15; return 8 * (i >> 2) + 4 * n + (i & 3); }

struct Unit { int pm, pn; };
struct Gemm { const bf16_t* A; const bf16_t* Bt; int M, N, K, lda; };

struct StaticOrder {
    int nM, nN, nwg, G, c;
    __host__ __device__ void init(int M, int N, int G_, int c_) { nM = M / BM; nN = N / BM; nwg = nM * nN; G = G_; c = c_; }
    __host__ __device__ bool next(int i, Unit& u) const {
        const long L = (long)i * G + c; if (L >= nwg) return false;
        int wgid = (int)L; { const int q = nwg / NXCD, r = nwg % NXCD, xcd = wgid % NXCD, off = wgid / NXCD; wgid = (xcd < r ? xcd * (q + 1) : r * (q + 1) + (xcd - r) * q) + off; }
        const int nig = WGM * nN, gid = wgid / nig, fm = gid * WGM, gsz = (nM - fm) < WGM ? (nM - fm) : WGM;
        u.pm = fm + ((wgid % nig) % gsz); u.pn = (wgid % nig) / gsz; return true;
    }
    __device__ __forceinline__ void a_ready(const Unit&) const {}
    __device__ __forceinline__ void done(const Unit&) const {}
};

template <class Epi, class Sched, bool ALIGN_EPI = false, bool SP2 = false>
__device__ __forceinline__ void gemm_phase(PG8_LAS unsigned char* lds, const Gemm g, const Sched& S, const Epi& E) {
    int tid_ = threadIdx.x; asm volatile("" : "+v"(tid_));
    const int tid = tid_, wid = __builtin_amdgcn_readfirstlane(tid >> 6), lane = tid & 63, wr = wid >> 2, wc = wid & 3, fr = lane & 15, fq = lane >> 4;
    const int K = g.K, nt = K / BK, lda = g.lda;
    unsigned voffA[2], voffB[2];
#pragma unroll
    for (int i = 0; i < 2; ++i) { int R, C; stage_rc(tid * 16 + i * 8192, R, C); const int Rb = Epi::PERM ? ((R & ~31) + perm32(R & 31)) : R;
        voffA[i] = (unsigned)(R * lda + C) * 2u; voffB[i] = (unsigned)(Rb * K + C) * 2u; }
    const size_t kstep = (size_t)(BK * 2);
    const size_t hstepB = (size_t)HALF * K * 2, hstepA = (size_t)HALF * lda * 2;
    const size_t tstepB = 2 * hstepB, tstepA = 2 * hstepA;
    const unsigned ldsw = (unsigned)wid * 1024u;
    const int aoff = lds_byte(wr * 64 + fr, fq * 8), boff = lds_byte(wc * 32 + fr, fq * 8);
#define PG8_SA(b, h) (((b) * 2 + (h)) * HTB)
#define PG8_SB(b, h) ((4 + (b) * 2 + (h)) * HTB)
#define PG8_STAGE(bufoff, gbase, voff) do { _Pragma("unroll") for (int _i = 0; _i < 2; ++_i) \
        __builtin_amdgcn_global_load_lds((const unsigned*)((const char*)(gbase) + (voff)[_i]), (PG8_LAS unsigned*)(lds + (bufoff) + ldsw + _i * 8192), 16, 0, 0); } while (0)
#define PG8_LDA(dst, b, h) do { _Pragma("unroll") for (int m = 0; m < 4; ++m) _Pragma("unroll") for (int k = 0; k < 2; ++k) dst[m][k] = *(const PG8_LAS bf16x8*)(lds + PG8_SA(b, h) + aoff + m * 2048 + k * 1024); } while (0)
#define PG8_LDB(dst, b, h) do { _Pragma("unroll") for (int n = 0; n < 2; ++n) _Pragma("unroll") for (int k = 0; k < 2; ++k) dst[n][k] = *(const PG8_LAS bf16x8*)(lds + PG8_SB(b, h) + boff + n * 2048 + k * 1024); } while (0)
#define PG8_MMA(ai, bj, At, Bt) do { __builtin_amdgcn_s_setprio(1); _Pragma("unroll") for (int m = 0; m < 4; ++m) _Pragma("unroll") for (int n = 0; n < 2; ++n) _Pragma("unroll") for (int k = 0; k < 2; ++k) \
        acc[ai][bj][m][n] = __builtin_amdgcn_mfma_f32_16x16x32_bf16(Bt[n][k], At[m][k], acc[ai][bj][m][n], 0, 0, 0); __builtin_amdgcn_s_setprio(0); } while (0)
#define PG8_WAIT_V(n) asm volatile("s_waitcnt vmcnt(" #n ")" ::: "memory")
#define PG8_WAIT_L(n) asm volatile("s_waitcnt lgkmcnt(" #n ")" ::: "memory")
#define PG8_BAR __builtin_amdgcn_s_barrier()
#define PG8_SCHED __builtin_amdgcn_sched_barrier(0)
    Unit cur, nxt; int ui = 0;
    if (!S.next(0, cur)) return;
    f32x4 acc[2][2][4][2];
#pragma unroll
    for (int a = 0; a < 2; ++a)
#pragma unroll
        for (int b = 0; b < 2; ++b)
#pragma unroll
            for (int m = 0; m < 4; ++m)
#pragma unroll
                for (int n = 0; n < 2; ++n) acc[a][b][m][n] = (f32x4){0.f, 0.f, 0.f, 0.f};
    bf16x8 At[4][2], B0[2][2], B1[2][2];
    const char* cA = (const char*)g.A + (size_t)cur.pm * tstepA; const char* cB = (const char*)g.Bt + (size_t)cur.pn * tstepB;
    S.a_ready(cur);
    if constexpr (SP2) {
        PG8_STAGE(PG8_SB(0, 0), cB, voffB); PG8_STAGE(PG8_SB(0, 1), cB + hstepB, voffB); PG8_STAGE(PG8_SA(0, 0), cA, voffA); PG8_STAGE(PG8_SA(0, 1), cA + hstepA, voffA);
        if (wr == 1) PG8_BAR;
        PG8_WAIT_V(2); PG8_BAR;
        PG8_STAGE(PG8_SB(1, 0), cB + kstep, voffB); PG8_STAGE(PG8_SA(1, 0), cA + kstep, voffA); PG8_STAGE(PG8_SB(1, 1), cB + hstepB + kstep, voffB);
        PG8_WAIT_V(6); PG8_BAR;
    } else {
        PG8_STAGE(PG8_SB(0, 0), cB, voffB); PG8_STAGE(PG8_SA(0, 0), cA, voffA); PG8_STAGE(PG8_SB(0, 1), cB + hstepB, voffB); PG8_STAGE(PG8_SA(0, 1), cA + hstepA, voffA);
        if (wr == 1) PG8_BAR;
        PG8_WAIT_V(4); PG8_BAR;
        PG8_STAGE(PG8_SB(1, 0), cB + kstep, voffB); PG8_STAGE(PG8_SA(1, 0), cA + kstep, voffA); PG8_STAGE(PG8_SB(1, 1), cB + hstepB + kstep, voffB);
        PG8_WAIT_V(6); PG8_BAR;
    }
    for (;;) {
        const bool has_next = S.next(ui + 1, nxt);
        const char* nA = has_next ? (const char*)g.A + (size_t)nxt.pm * tstepA : cA; const char* nB = has_next ? (const char*)g.Bt + (size_t)nxt.pn * tstepB : cB;
#pragma unroll 1
        for (int t = 0; t < nt; t += 2) {
            const bool last = (t == nt - 2);
            const char* a1 = cA + (size_t)(t + 1) * kstep;
            const char* a2 = last ? nA : cA + (size_t)(t + 2) * kstep; const char* b2 = last ? nB : cB + (size_t)(t + 2) * kstep;
            const char* a3 = a2 + kstep; const char* b3 = b2 + kstep;
            if (last && has_next) S.a_ready(nxt);
            if constexpr (SP2) {
            PG8_LDB(B0, 0, 0); PG8_LDB(B1, 0, 1); PG8_SCHED; PG8_LDA(At, 0, 0); PG8_STAGE(PG8_SA(1, 1), a1 + hstepA, voffA);
            PG8_WAIT_V(8); PG8_WAIT_L(0); PG8_BAR; PG8_MMA(0, 0, At, B0); PG8_MMA(0, 1, At, B1); PG8_BAR; PG8_SCHED;
            PG8_LDA(At, 0, 1); PG8_STAGE(PG8_SB(0, 0), b2, voffB); PG8_STAGE(PG8_SB(0, 1), b2 + hstepB, voffB); PG8_STAGE(PG8_SA(0, 0), a2, voffA);
            PG8_WAIT_V(8); PG8_WAIT_L(0); PG8_BAR; PG8_MMA(1, 0, At, B0); PG8_MMA(1, 1, At, B1); PG8_BAR; PG8_SCHED;
            PG8_LDB(B0, 1, 0); PG8_LDB(B1, 1, 1); PG8_SCHED; PG8_LDA(At, 1, 0); PG8_STAGE(PG8_SA(0, 1), a2 + hstepA, voffA);
            PG8_WAIT_V(8); PG8_WAIT_L(0); PG8_BAR; PG8_MMA(0, 0, At, B0); PG8_MMA(0, 1, At, B1); PG8_BAR; PG8_SCHED;
            PG8_LDA(At, 1, 1); PG8_STAGE(PG8_SB(1, 0), b3, voffB); PG8_STAGE(PG8_SB(1, 1), b3 + hstepB, voffB); PG8_STAGE(PG8_SA(1, 0), a3, voffA);
            PG8_WAIT_V(8); PG8_WAIT_L(0); PG8_BAR; PG8_MMA(1, 0, At, B0); PG8_MMA(1, 1, At, B1); PG8_BAR; PG8_SCHED;
            } else {
            PG8_LDB(B0, 0, 0); PG8_SCHED; PG8_LDA(At, 0, 0); PG8_STAGE(PG8_SA(1, 1), a1 + hstepA, voffA);
            PG8_WAIT_L(8); PG8_BAR; PG8_WAIT_L(0); PG8_MMA(0, 0, At, B0); PG8_BAR; PG8_SCHED;
            PG8_LDB(B1, 0, 1); PG8_STAGE(PG8_SB(0, 0), b2, voffB);
            PG8_BAR; PG8_WAIT_L(0); PG8_MMA(0, 1, At, B1); PG8_BAR;
            PG8_LDA(At, 0, 1); PG8_STAGE(PG8_SA(0, 0), a2, voffA);
            PG8_BAR; PG8_WAIT_L(0); PG8_MMA(1, 0, At, B0); PG8_BAR; PG8_SCHED;
            PG8_STAGE(PG8_SB(0, 1), b2 + hstepB, voffB);
            PG8_WAIT_V(6); PG8_BAR; PG8_MMA(1, 1, At, B1); PG8_BAR;
            PG8_LDB(B0, 1, 0); PG8_SCHED; PG8_LDA(At, 1, 0); PG8_STAGE(PG8_SA(0, 1), a2 + hstepA, voffA);
            PG8_WAIT_L(8); PG8_BAR; PG8_WAIT_L(0); PG8_MMA(0, 0, At, B0); PG8_BAR; PG8_SCHED;
            PG8_LDB(B1, 1, 1); PG8_STAGE(PG8_SB(1, 0), b3, voffB);
            PG8_BAR; PG8_WAIT_L(0); PG8_MMA(0, 1, At, B1); PG8_BAR;
            PG8_LDA(At, 1, 1); PG8_STAGE(PG8_SA(1, 0), a3, voffA);
            PG8_BAR; PG8_WAIT_L(0); PG8_MMA(1, 0, At, B0); PG8_BAR; PG8_SCHED;
            PG8_STAGE(PG8_SB(1, 1), b3 + hstepB, voffB);
            PG8_WAIT_V(6); PG8_BAR; PG8_MMA(1, 1, At, B1); PG8_BAR;
            }
        }
        if constexpr (ALIGN_EPI) { if (wr == 0) PG8_BAR; }
        if constexpr (!Epi::AFTER_DRAIN) { E(acc, cur, wr, wc, fr, fq); S.done(cur); }
        if (!has_next) break;
#pragma unroll
        for (int a = 0; a < 2; ++a)
#pragma unroll
            for (int b = 0; b < 2; ++b)
#pragma unroll
                for (int m = 0; m < 4; ++m)
#pragma unroll
                    for (int n = 0; n < 2; ++n) acc[a][b][m][n] = (f32x4){0.f, 0.f, 0.f, 0.f};
        cur = nxt; cA = nA; cB = nB; ++ui;
        if constexpr (ALIGN_EPI) { if (wr == 1) PG8_BAR; }
    }
    PG8_WAIT_V(0);
    if constexpr (!ALIGN_EPI) { if (wr == 0) PG8_BAR; }
    PG8_BAR;
    if constexpr (Epi::AFTER_DRAIN) { E.fused(acc, cur, wr, wc, fr, fq, lds, wid, lane); S.done(cur); }
#undef PG8_SA
#undef PG8_SB
#undef PG8_STAGE
#undef PG8_LDA
#undef PG8_LDB
#undef PG8_MMA
#undef PG8_WAIT_V
#undef PG8_WAIT_L
#undef PG8_BAR
#undef PG8_SCHED
}
}
DI unsigned sw_off(int row, int chunk) { return (unsigned)(row * 128 + ((chunk ^ ((row >> 1) & 7)) << 4)); }
#define GLDS16(gsrc, ldst) __builtin_amdgcn_global_load_lds((const unsigned*)(gsrc), (unsigned*)(ldst), 16, 0, 0)
DI u32x2 pack4(float a, float b, float c, float d) { u32x2 o; o[0] = pack2(a, b); o[1] = pack2(c, d); return o; }
#define EPI_ARGS const f32x4 (&acc)[2][2][4][2], const pg8::Unit& u, int wr, int wc, int fr, int fq
DI float xq_sum(float v) {
    v += __uint_as_float((unsigned)__builtin_amdgcn_ds_swizzle((int)__float_as_uint(v), 0x401F));
    return xhalf_sum(v);
}
DI u32x4 pack8(const float (&v)[8], float sc) {
    u32x4 o; o[0] = pack2(v[0] * sc, v[1] * sc); o[1] = pack2(v[2] * sc, v[3] * sc); o[2] = pack2(v[4] * sc, v[5] * sc); o[3] = pack2(v[6] * sc, v[7] * sc); return o;
}
DI void rope8(const float (&v)[8], float sc, const float* __restrict__ cs, int pos, int fq, int lane, bf16_t* dst32  ) {
    const int i0 = 8 * (fq & 1);
    const f32x4 c0 = *(const f32x4*)(cs + pos * 16 + i0), c1 = *(const f32x4*)(cs + pos * 16 + i0 + 4);
    const f32x4 s0 = *(const f32x4*)(cs + 65536 + pos * 16 + i0), s1 = *(const f32x4*)(cs + 65536 + pos * 16 + i0 + 4);
    const float sg = (fq < 2) ? -1.0f : 1.0f;
    float o[8];
#pragma unroll
    for (int e = 0; e < 8; ++e) {
        const float own = v[e] * sc, oth = xhalf_other(own, lane);
        const float c = (e < 4) ? c0[e & 3] : c1[e & 3], s = (e < 4) ? s0[e & 3] : s1[e & 3];
        o[e] = own * c + sg * oth * s;
    }
    *(u32x4*)(dst32 + 8 * fq) = pack8(o, 1.0f);
}
#define EPI_LOAD8(v, ai, bj, m) float v[8]; { const f32x4 x0_ = acc[ai][bj][m][0], x1_ = acc[ai][bj][m][1]; v[0] = x0_[0]; v[1] = x0_[1]; v[2] = x0_[2]; v[3] = x0_[3]; v[4] = x1_[0]; v[5] = x1_[1]; v[6] = x1_[2]; v[7] = x1_[3]; }

struct EpiPlain8 {
    static constexpr bool PERM = true, AFTER_DRAIN = false;
    bf16_t* out; int ld;
    DI void operator()(EPI_ARGS) const {
#pragma unroll
        for (int ai = 0; ai < 2; ++ai)
#pragma unroll
            for (int m = 0; m < 4; ++m) {
                int fr_ = fr; asm volatile("" : "+v"(fr_));
                const size_t tok = (size_t)u.pm * 256 + ai * 128 + wr * 64 + m * 16 + fr_;
#pragma unroll
                for (int bj = 0; bj < 2; ++bj) { EPI_LOAD8(v, ai, bj, m); *(u32x4*)(out + tok * ld + u.pn * 256 + bj * 128 + wc * 32 + 8 * fq) = pack8(v, 1.0f); }
            }
    }
};

struct EpiProj8 {
    static constexpr bool PERM = true, AFTER_DRAIN = false;
    bf16_t* proj; bf16_t* kr; const float* cs; float* ssq;
    DI void operator()(EPI_ARGS) const {
        const int lane = fr + 16 * fq;
#pragma unroll
        for (int bj = 0; bj < 2; ++bj) {
            const int cg = u.pn * 256 + bj * 128 + wc * 32;
            if (cg >= INC) continue;
            const int g32 = cg >> 5;
            const float sc = (cg >= 672 && cg < 1184) ? 0.125f * LOG2E : 1.0f;
#pragma unroll
            for (int ai = 0; ai < 2; ++ai)
#pragma unroll
                for (int m = 0; m < 4; ++m) {
                    int fr_ = fr; asm volatile("" : "+v"(fr_));
                const size_t tok = (size_t)u.pm * 256 + ai * 128 + wr * 64 + m * 16 + fr_;
                    EPI_LOAD8(v, ai, bj, m);
                    if (g32 < 20) {
                        float ss = 0.f;
#pragma unroll
                        for (int e = 0; e < 8; ++e) ss += v[e] * v[e];
                        ss = xq_sum(ss);
                        if (fq == 0) ssq[tok * 24 + g32] = ss;
                    }
                    if (cg == 640) rope8(v, 1.0f, cs, (int)(tok & (SEQ_L - 1)), fq, lane, kr + tok * 32);
                    else *(u32x4*)(proj + tok * INC + cg + 8 * fq) = pack8(v, sc);
                }
        }
    }
};

struct EpiUpQ8 {
    static constexpr bool PERM = true, AFTER_DRAIN = false;
    bf16_t* q; const float* cs; const float* ssq;
    DI void operator()(EPI_ARGS) const {
        const int lane = fr + 16 * fq;
        const float qs = 0.10206207261596575f * LOG2E;
#pragma unroll
        for (int ai = 0; ai < 2; ++ai)
#pragma unroll
            for (int m = 0; m < 4; ++m) {
                int fr_ = fr; asm volatile("" : "+v"(fr_));
                const size_t tok = (size_t)u.pm * 256 + ai * 128 + wr * 64 + m * 16 + fr_;
                const f32x4 a0 = *(const f32x4*)(ssq + tok * 24), a1 = *(const f32x4*)(ssq + tok * 24 + 4), a2 = *(const f32x4*)(ssq + tok * 24 + 8);
                const float tot = (a0[0] + a0[1] + a0[2] + a0[3]) + (a1[0] + a1[1] + a1[2] + a1[3]) + (a2[0] + a2[1] + a2[2] + a2[3]);
                const float sc = rsqrtf(tot * (1.0f / 384.0f) + 1e-6f) * qs;
#pragma unroll
                for (int bj = 0; bj < 2; ++bj) {
                    const int cg = u.pn * 256 + bj * 128 + wc * 32;
                    EPI_LOAD8(v, ai, bj, m);
                    if ((cg % 96) == 64) rope8(v, sc, cs, (int)(tok & (SEQ_L - 1)), fq, lane, q + tok * 768 + cg);
                    else *(u32x4*)(q + tok * 768 + cg + 8 * fq) = pack8(v, sc);
                }
            }
    }
};

struct EpiUpKV8 {
    static constexpr bool PERM = true, AFTER_DRAIN = false;
    bf16_t* kv; const float* ssq;
    DI void operator()(EPI_ARGS) const {
#pragma unroll
        for (int ai = 0; ai < 2; ++ai)
#pragma unroll
            for (int m = 0; m < 4; ++m) {
                int fr_ = fr; asm volatile("" : "+v"(fr_));
                const size_t tok = (size_t)u.pm * 256 + ai * 128 + wr * 64 + m * 16 + fr_;
                const f32x4 a0 = *(const f32x4*)(ssq + tok * 24 + 12), a1 = *(const f32x4*)(ssq + tok * 24 + 16);
                const float tot = (a0[0] + a0[1] + a0[2] + a0[3]) + (a1[0] + a1[1] + a1[2] + a1[3]);
                const float sc = rsqrtf(tot * (1.0f / 256.0f) + 1e-6f);
#pragma unroll
                for (int bj = 0; bj < 2; ++bj) { EPI_LOAD8(v, ai, bj, m); *(u32x4*)(kv + tok * 1024 + u.pn * 256 + bj * 128 + wc * 32 + 8 * fq) = pack8(v, sc); }
            }
    }
};

template <bool RBF16>
struct EpiResid8 {
    static constexpr bool PERM = true, AFTER_DRAIN = false;
    const void* R; bf16_t* HB; float* SS;
    DI void operator()(EPI_ARGS) const {
#pragma unroll
        for (int ai = 0; ai < 2; ++ai) {
            f32x4 rv[4][2][2];
#pragma unroll
            for (int m = 0; m < 4; ++m)
#pragma unroll
                for (int bj = 0; bj < 2; ++bj) {
                    const size_t off = ((size_t)u.pm * 256 + ai * 128 + wr * 64 + m * 16 + fr) * 1024 + u.pn * 256 + bj * 128 + wc * 32 + 8 * fq;
                    if (RBF16) {
                        const u32x4 w = ldu4((const bf16_t*)R + off);
                        rv[m][bj][0] = (f32x4){bf_lo(w[0]), bf_hi(w[0]), bf_lo(w[1]), bf_hi(w[1])};
                        rv[m][bj][1] = (f32x4){bf_lo(w[2]), bf_hi(w[2]), bf_lo(w[3]), bf_hi(w[3])};
                    } else {
                        rv[m][bj][0] = *(const f32x4*)((const float*)R + off); rv[m][bj][1] = *(const f32x4*)((const float*)R + off + 4);
                    }
                }
#pragma unroll
            for (int m = 0; m < 4; ++m) {
                int fr_ = fr; asm volatile("" : "+v"(fr_));
                const size_t tok = (size_t)u.pm * 256 + ai * 128 + wr * 64 + m * 16 + fr_;
                float ss = 0.f;
#pragma unroll
                for (int bj = 0; bj < 2; ++bj) {
                    const size_t off = tok * 1024 + u.pn * 256 + bj * 128 + wc * 32 + 8 * fq;
                    const f32x4 h0 = rv[m][bj][0] + acc[ai][bj][m][0], h1 = rv[m][bj][1] + acc[ai][bj][m][1];
                    u32x4 o; o[0] = pack2(h0[0], h0[1]); o[1] = pack2(h0[2], h0[3]); o[2] = pack2(h1[0], h1[1]); o[3] = pack2(h1[2], h1[3]);
                    *(u32x4*)(HB + off) = o;
                    const float a0 = bf_lo(o[0]), a1 = bf_hi(o[0]), a2 = bf_lo(o[1]), a3 = bf_hi(o[1]), a4 = bf_lo(o[2]), a5 = bf_hi(o[2]), a6 = bf_lo(o[3]), a7 = bf_hi(o[3]);
                    ss += (a0 * a0 + a1 * a1) + (a2 * a2 + a3 * a3) + (a4 * a4 + a5 * a5) + (a6 * a6 + a7 * a7);
                }
                ss = xq_sum(ss);
                if (fq == 0) SS[tok * 16 + 4 * u.pn + wc] = ss;
            }
        }
    }
};

struct EpiRowScale8 {
    static constexpr bool PERM = true, AFTER_DRAIN = false;
    bf16_t* out; int ld; const float* SS; float extra;
    DI void operator()(EPI_ARGS) const {
#pragma unroll
        for (int ai = 0; ai < 2; ++ai)
#pragma unroll
            for (int m = 0; m < 4; ++m) {
                int fr_ = fr; asm volatile("" : "+v"(fr_));
                const size_t tok = (size_t)u.pm * 256 + ai * 128 + wr * 64 + m * 16 + fr_;
                const f32x4 s0 = *(const f32x4*)(SS + tok * 16), s1 = *(const f32x4*)(SS + tok * 16 + 4), s2 = *(const f32x4*)(SS + tok * 16 + 8), s3 = *(const f32x4*)(SS + tok * 16 + 12);
                const float tot = (s0[0] + s0[1] + s0[2] + s0[3]) + (s1[0] + s1[1] + s1[2] + s1[3]) + (s2[0] + s2[1] + s2[2] + s2[3]) + (s3[0] + s3[1] + s3[2] + s3[3]);
                const float sc = rsqrtf(tot * (1.0f / 1024.0f) + 1e-6f) * extra;
#pragma unroll
                for (int bj = 0; bj < 2; ++bj) { EPI_LOAD8(v, ai, bj, m); *(u32x4*)(out + tok * ld + u.pn * 256 + bj * 128 + wc * 32 + 8 * fq) = pack8(v, sc); }
            }
    }
};

template <class Epi>
DI void gemm8(char* smem, const bf16_t* A, int lda, const bf16_t* Bt, int M, int N, int K, const Epi& e, int cshift = 0) {
    pg8::Gemm g; g.A = A; g.Bt = Bt; g.M = M; g.N = N; g.K = K; g.lda = lda;
    const int G = (int)gridDim.x;
    pg8::StaticOrder S; S.init(M, N, G, ((int)blockIdx.x + G - cshift) % G);
    pg8::gemm_phase<Epi, pg8::StaticOrder, true, true>((PG8_LAS unsigned char*)smem, g, S, e);
}

DI void quant_rows4(const Params& p, int it, int wv, int lane);
DI void phase_p1(const Params& p, char* smem) {
    char* ws = p.ws;
    const int G = (int)gridDim.x, nproj = 9 * 64, nkvm = 8 * 4;
    const int last = nproj % G;
    { EpiProj8 e{(bf16_t*)(ws + OFF_PROJ), (bf16_t*)(ws + OFF_KR), (const float*)(ws + OFF_ROPE), (float*)(ws + OFF_SSQ)};
      gemm8(smem, (const bf16_t*)(ws + OFF_XN), 1024, (const bf16_t*)(ws + OFF_WT_IN), T_TOK, 2304, 1024, e); }
    { EpiPlain8 e{(bf16_t*)(ws + OFF_KVM), 2048};
      gemm8(smem, (const bf16_t*)(ws + OFF_MEMN), 1024, (const bf16_t*)(ws + OFF_WT_MKV), 1024, 2048, 1024, e, last); }
    int q0 = last + nkvm, nq = G - q0;
    if (last == 0 || nq <= 0) { q0 = 0; nq = G; }
    if ((int)blockIdx.x >= q0) {
        const int t = otid(), lane = t & 63, wv = t >> 6;
        for (int it = ((int)blockIdx.x - q0) * 2 + vhalf(); it < 8192; it += 2 * nq) quant_rows4(p, it, wv, lane);
    }
}
DI void phase_p2(const Params& p, char* smem) {
    char* ws = p.ws;
    { EpiUpQ8 e{(bf16_t*)(ws + OFF_QMLA), (const float*)(ws + OFF_ROPE), (const float*)(ws + OFF_SSQ)};
      gemm8(smem, (const bf16_t*)(ws + OFF_PROJ), INC, (const bf16_t*)(ws + OFF_WT_UQ), T_TOK, 768, 384, e); }
    { EpiUpKV8 e{(bf16_t*)(ws + OFF_KVMLA), (const float*)(ws + OFF_SSQ)};
      gemm8(smem, (const bf16_t*)(ws + OFF_PROJ) + 384, INC, (const bf16_t*)(ws + OFF_WT_UKV), T_TOK, 1024, 256, e); }
}
template <bool RBF16>
DI void phase_resid(const Params& p, char* smem, size_t off_w, size_t off_a, const void* R, size_t off_ss, bool dry = false) {
    char* ws = p.ws;
    EpiResid8<RBF16> e{R, (bf16_t*)(ws + OFF_HB), (float*)(ws + off_ss)};
    if (dry) { e.HB = (bf16_t*)(ws + OFF_B); e.SS = (float*)(ws + OFF_SS1); }
    gemm8(smem, (const bf16_t*)(ws + off_a), 1024, (const bf16_t*)(ws + off_w), T_TOK, 1024, 1024, e);
}
DI void phase_rowscale(const Params& p, char* smem, size_t off_w, int N, bf16_t* outp, size_t off_ss, float extra) {
    char* ws = p.ws;
    EpiRowScale8 e{outp, N, (const float*)(ws + off_ss), extra};
    gemm8(smem, (const bf16_t*)(ws + OFF_HB), 1024, (const bf16_t*)(ws + off_w), T_TOK, N, 1024, e);
}
DI unsigned v128_off(int row, int chunk) { return (unsigned)(row * 128 + ((chunk ^ (((row >> 1) & 1) << 2)) << 4)); }
DI unsigned v128_tr_addr(unsigned base, int R0, int c, int lane) {
    const int blk = (lane >> 4) & 1, qq = (lane & 15) >> 2, pp = lane & 3;
    return base + v128_off(R0 + qq, 4 * c + 2 * blk + (pp >> 1)) + 8 * (pp & 1);
}
DI bf16x8 cat44(s16x4 lo, s16x4 hi) { return __builtin_shufflevector(lo, hi, 0, 1, 2, 3, 4, 5, 6, 7); }

constexpr int MLA_STAGE = 64 * 192 + 64 * 128;
DI unsigned k192_off(int row, int chunk) { return (unsigned)(row * 192 + (((chunk & ~3) | ((chunk & 3) ^ ((row >> 2) & 3))) << 4)); }
DI void mla_unit(const Params& p, char* lds, int b, int h, int qt) {
    char* ws = p.ws;
    const int t = otid(), lane = t & 63, wv = t >> 6, r = lane & 31, hh = lane >> 5;
    const bf16_t* Q = (const bf16_t*)(ws + OFF_QMLA);
    const bf16_t* KV = (const bf16_t*)(ws + OFF_KVMLA);
    const bf16_t* KR = (const bf16_t*)(ws + OFF_KR);
    const int q0 = qt * 128 + 32 * wv;
    const size_t tokq = (size_t)b * SEQ_L + q0 + r;
    const size_t tokb = (size_t)b * SEQ_L;
    bf16x8 qf[6];
#pragma unroll
    for (int s = 0; s < 6; ++s) qf[s] = ld16(Q + tokq * 768 + h * 96 + 16 * s + 8 * hh);
    f32x16 o[2]; o[0] = zero16(); o[1] = zero16();
    float m = -INFINITY, l = 0.f;
    const bf16_t* ksrc[3]; int kadv[3]; const bf16_t* vsrc[2];
#pragma unroll
    for (int i = 0; i < 3; ++i) {
        const int o_ = 1024 * (wv + 4 * i) + 16 * lane, row = o_ / 192, pch = (o_ % 192) >> 4;
        const int c = (pch & ~3) | ((pch & 3) ^ ((row >> 2) & 3));
        if (c < 8) { ksrc[i] = KV + (tokb + row) * 1024 + h * 128 + 8 * c; kadv[i] = 64 * 1024; }
        else       { ksrc[i] = KR + (tokb + row) * 32 + 8 * (c - 8);       kadv[i] = 64 * 32; }
    }
#pragma unroll
    for (int i = 0; i < 2; ++i) {
        const int row = 8 * (wv + 4 * i) + (lane >> 3), pch = lane & 7;
        vsrc[i] = KV + (tokb + row) * 1024 + h * 128 + 64 + 8 * (pch ^ (((row >> 1) & 1) << 2));
    }
    char* ldst = lds + wv * 1024 + lane * 16;
    auto issue = [&](int kt) {
        char* d = ldst + (kt % 3) * MLA_STAGE;
#pragma unroll
        for (int i = 0; i < 3; ++i) GLDS16(ksrc[i] + (size_t)kt * kadv[i], d + i * 4096);
#pragma unroll
        for (int i = 0; i < 2; ++i) GLDS16(vsrc[i] + (size_t)kt * (64 * 1024), d + 12288 + i * 4096);
    };
    const int ntiles = 2 * qt + 2;
    const unsigned vlane0 = v128_tr_addr(0u, 4 * hh, 0, lane), vlane1 = v128_tr_addr(0u, 4 * hh, 1, lane);
    __syncthreads();
    issue(0); issue(1);
#pragma unroll
    for (int s = 0; s < 6; ++s) asm volatile("" :: "v"(qf[s]));
#pragma unroll 1
    for (int kt = 0; kt < ntiles; ++kt) {
        if (kt + 1 < ntiles) asm volatile("s_waitcnt vmcnt(5)\n\ts_barrier" ::: "memory");
        else asm volatile("s_waitcnt vmcnt(0)\n\ts_barrier" ::: "memory");
        if (kt + 2 < ntiles) issue(kt + 2);
        const char* sb = lds + (kt % 3) * MLA_STAGE;
        const unsigned vb = (unsigned)(uintptr_t)(sb + 12288);
        f32x16 s[2];
#pragma unroll
        for (int k2 = 0; k2 < 2; ++k2) {
            s[k2] = zero16();
#pragma unroll
            for (int ss = 0; ss < 6; ++ss) s[k2] = MFMA32(ld16(sb + k192_off(32 * k2 + r, 2 * ss + hh)), qf[ss], s[k2]);
        }
        s16x4 vt[2][2][2][2];
        {
            const unsigned a0 = vb + vlane0, a1 = vb + vlane1;
#define MLA_TR(K2, ST) vt[K2][ST][0][0] = tr_read_ao<(32 * K2 + 16 * ST) * 128>(a0); vt[K2][ST][0][1] = tr_read_ao<(32 * K2 + 16 * ST + 8) * 128>(a0); \
                       vt[K2][ST][1][0] = tr_read_ao<(32 * K2 + 16 * ST) * 128>(a1); vt[K2][ST][1][1] = tr_read_ao<(32 * K2 + 16 * ST + 8) * 128>(a1);
            MLA_TR(0, 0) MLA_TR(0, 1) MLA_TR(1, 0) MLA_TR(1, 1)
#undef MLA_TR
        }
        if (__builtin_amdgcn_readfirstlane(kt >= 2 * qt)) {
            asm volatile("");
            const int qpos = q0 + r;
#pragma unroll
            for (int k2 = 0; k2 < 2; ++k2)
#pragma unroll
                for (int i = 0; i < 16; ++i) { const int kpos = 64 * kt + 32 * k2 + crow(i, hh); if (kpos > qpos) s[k2][i] = -INFINITY; }
        }
        float mx = s[0][0];
#pragma unroll
        for (int k2 = 0; k2 < 2; ++k2)
#pragma unroll
            for (int i = 0; i < 16; ++i) mx = fmaxf(mx, s[k2][i]);
        mx = xhalf_max(mx);
        if (__any(mx > m + 8.0f)) {
            asm volatile("");
            const float mn = fmaxf(m, mx);
            const float alpha = fast_exp2(m - mn);
            l *= alpha;
            m = mn;
#pragma unroll
            for (int c = 0; c < 2; ++c)
#pragma unroll
                for (int i = 0; i < 16; ++i) o[c][i] *= alpha;
        }
        f32x2 ps2 = {0.f, 0.f};
        const f32x2 m2 = {m, m};
#pragma unroll
        for (int k2 = 0; k2 < 2; ++k2)
#pragma unroll
            for (int i = 0; i < 16; i += 2) {
                f32x2 x = {s[k2][i], s[k2][i + 1]};
                x = x - m2;
                f32x2 e; e[0] = fast_exp2(x[0]); e[1] = fast_exp2(x[1]);
                s[k2][i] = e[0]; s[k2][i + 1] = e[1];
                ps2 += e;
            }
        l += ps2[0] + ps2[1];
        TR_WAIT();
#pragma unroll
        for (int k2 = 0; k2 < 2; ++k2)
#pragma unroll
            for (int st = 0; st < 2; ++st) {
                const bf16x8 pb = pack_step(s[k2], st);
#pragma unroll
                for (int c = 0; c < 2; ++c) o[c] = MFMA32(cat44(vt[k2][st][c][0], vt[k2][st][c][1]), pb, o[c]);
            }
    }
    const float inv = 1.0f / xhalf_sum(l);
    bf16_t* dst = (bf16_t*)((char*)p.out + OUT_OMLA) + tokq * 512 + h * 64 + 4 * hh;
#pragma unroll
    for (int c = 0; c < 2; ++c)
#pragma unroll
        for (int g = 0; g < 4; ++g)
            *(u32x2*)(dst + 32 * c + 8 * g) = pack4(o[c][4 * g] * inv, o[c][4 * g + 1] * inv, o[c][4 * g + 2] * inv, o[c][4 * g + 3] * inv);
}

DI void dil_unit(const Params& p, char* lds, int g, int b, int h, int rr, int lb) {
    char* ws = p.ws;
    const int t = otid(), lane = t & 63, wv = t >> 6, r = lane & 31, hh = lane >> 5;
    const int d = (g == 0) ? 1 : (g == 1 ? 4 : 16);
    const bf16_t* PJ = (const bf16_t*)(ws + OFF_PROJ);
    const size_t tokb = (size_t)b * SEQ_L;
    char* kimg = lds;
    char* vimg = lds + 32768;
    __syncthreads();
    {
        const int c = t & 7;
#pragma unroll
        for (int half = 0; half < 2; ++half) {
            u32x4 kk[4], vv[4];
#pragma unroll
            for (int i = 0; i < 4; ++i) {
                const int key = (t >> 3) + 32 * (4 * half + i);
                const int lk = 128 * lb - 128 + key;
                if (lk >= 0) {
                    const size_t tk = tokb + (size_t)lk * d + rr;
                    kk[i] = ldu4(PJ + tk * INC + 1184 + h * 64 + 8 * c);
                    vv[i] = ldu4(PJ + tk * INC + 1696 + h * 64 + 8 * c);
                } else { kk[i] = (u32x4){0u, 0u, 0u, 0u}; vv[i] = (u32x4){0u, 0u, 0u, 0u}; }
            }
#pragma unroll
            for (int i = 0; i < 4; ++i) {
                const int key = (t >> 3) + 32 * (4 * half + i);
                *(u32x4*)(kimg + sw_off(key, c)) = kk[i];
                *(u32x4*)(vimg + v128_off(key, c)) = vv[i];
            }
        }
    }
    const int lq = 128 * lb + 32 * wv + r;
    const size_t tokq = tokb + (size_t)lq * d + rr;
    bf16x8 qf[4];
#pragma unroll
    for (int s = 0; s < 4; ++s) qf[s] = ld16(PJ + tokq * INC + 672 + h * 64 + 16 * s + 8 * hh);
    __syncthreads();
    const float slope2 = exp2f(-(float)(h + 1)) * (float)d * LOG2E;
    const int u0 = (lb == 0) ? (4 - wv) : 0;
    f32x16 o[2]; o[0] = zero16(); o[1] = zero16();
    float m = -INFINITY, lsum = 0.f;
    const unsigned vb = (unsigned)(uintptr_t)vimg;
    float cb[16];
#pragma unroll
    for (int i = 0; i < 16; ++i) cb[i] = slope2 * (float)crow(i, hh);
#pragma unroll 1
    for (int u = u0; u < 5; ++u) {
        const int rowb = 32 * (wv + u);
        f32x16 s = zero16();
#pragma unroll
        for (int ss = 0; ss < 4; ++ss) s = MFMA32(ld16(kimg + sw_off(rowb + r, 2 * ss + hh)), qf[ss], s);
        const int dbase = r + 128 - 32 * u;
        const float b0 = -slope2 * (float)dbase;
#pragma unroll
        for (int i = 0; i < 16; ++i) s[i] += cb[i];
        if (__builtin_amdgcn_readfirstlane(u == 0 || u == 4)) {
            asm volatile("");
#pragma unroll
            for (int i = 0; i < 16; ++i) { const int dist = dbase - crow(i, hh); if (dist < 0 || dist > 128) s[i] = -INFINITY; }
        }
        float mx = s[0];
#pragma unroll
        for (int i = 1; i < 16; ++i) mx = fmaxf(mx, s[i]);
        mx = xhalf_max(mx) + b0;
        if (__any(mx > m + 8.0f)) {
            asm volatile("");
            const float mn = fmaxf(m, mx);
            const float alpha = fast_exp2(m - mn);
            lsum *= alpha;
            m = mn;
#pragma unroll
            for (int c = 0; c < 2; ++c)
#pragma unroll
                for (int i = 0; i < 16; ++i) o[c][i] *= alpha;
        }
        f32x2 ps2 = {0.f, 0.f};
        const float mb = m - b0;
        const f32x2 m2 = {mb, mb};
#pragma unroll
        for (int i = 0; i < 16; i += 2) {
            f32x2 xx = {s[i], s[i + 1]};
            xx = xx - m2;
            f32x2 e; e[0] = fast_exp2(xx[0]); e[1] = fast_exp2(xx[1]);
            s[i] = e[0]; s[i + 1] = e[1];
            ps2 += e;
        }
        lsum += ps2[0] + ps2[1];
#pragma unroll
        for (int st = 0; st < 2; ++st) {
            const bf16x8 pb = pack_step(s, st);
#pragma unroll
            for (int c = 0; c < 2; ++c) {
                const s16x4 lo = tr_read(v128_tr_addr(vb, rowb + 16 * st + 4 * hh, c, lane));
                const s16x4 hi = tr_read(v128_tr_addr(vb, rowb + 16 * st + 8 + 4 * hh, c, lane));
                o[c] = MFMA32(cat44(lo, hi), pb, o[c]);
            }
        }
    }
    const float ltot = xhalf_sum(lsum);
    const float mx = m;
    const float inv = 1.0f / ltot;
    bf16_t* dst = (bf16_t*)((char*)p.out + OUT_ODIL) + ((size_t)g * T_TOK + tokq) * 512 + h * 64 + 4 * hh;
#pragma unroll
    for (int c = 0; c < 2; ++c)
#pragma unroll
        for (int gg = 0; gg < 4; ++gg)
            *(u32x2*)(dst + 32 * c + 8 * gg) = pack4(o[c][4 * gg] * inv, o[c][4 * gg + 1] * inv, o[c][4 * gg + 2] * inv, o[c][4 * gg + 3] * inv);
    if (hh == 0) ((float*)(ws + OFF_LSE))[((size_t)g * T_TOK + tokq) * 8 + h] = mx + __log2f(ltot);
}

DI void phase_p3(const Params& p, char* lds, int which = 3) {
    const int xg = (int)blockIdx.x & 7, nloc = (vgrid() >> 3), loc = ((int)blockIdx.x >> 3) * 2 + vhalf();
    if (which & 1) for (int i = loc; i < 64; i += nloc) {
        const int bh = xg * 4 + (i >> 4), pr = i & 15, b = bh >> 3, h = bh & 7;
#pragma unroll 1
        for (int rep = 0; rep < 2; ++rep) mla_unit(p, lds, b, h, rep ? pr : 31 - pr);
    }
    if (which & 2) for (int i = loc; i < 384; i += nloc) {
        const int bh = xg * 4 + i / 96, k96 = i % 96, g = k96 >> 5, k = k96 & 31, b = bh >> 3, h = bh & 7;
        int rr, lb;
        if (g == 0) { rr = 0; lb = k; } else if (g == 1) { rr = k >> 3; lb = k & 7; } else { rr = k >> 1; lb = k & 1; }
        dil_unit(p, lds, g, b, h, rr, lb);
    }
}

DI void quant_rows4(const Params& p, int it, int wv, int lane) {
    char* ws = p.ws;
    const int ncv = 4096;
    const bool isv = it >= ncv;
    const size_t row = (size_t)(isv ? it - ncv : it) * 4 + wv;
    const float* src = (isv ? p.peer_v : p.peer_u) + row * 1024 + 16 * lane;
    f32x4 v[4]; float am = 0.f;
#pragma unroll
    for (int i = 0; i < 4; ++i) { v[i] = *(const f32x4*)(src + 4 * i); am = fmaxf(am, fmaxf(fmaxf(fabsf(v[i][0]), fabsf(v[i][1])), fmaxf(fabsf(v[i][2]), fabsf(v[i][3])))); }
#pragma unroll
    for (int o = 32; o; o >>= 1) am = fmaxf(am, __shfl_xor(am, o));
    const float sc = (am > 0.f) ? am * (isv ? (1.0f / 384.0f) : (1.0f / 127.0f)) : 1.0f;
    const float inv = 1.0f / sc;
    u32x4 o;
#pragma unroll
    for (int i = 0; i < 4; ++i) {
        if (isv) {
            int w = 0;
            w = __builtin_amdgcn_cvt_pk_fp8_f32(v[i][0] * inv, v[i][1] * inv, w, false);
            w = __builtin_amdgcn_cvt_pk_fp8_f32(v[i][2] * inv, v[i][3] * inv, w, true);
            o[i] = (unsigned)w;
        } else {
            unsigned w = 0u;
#pragma unroll
            for (int e = 0; e < 4; ++e) { const int q = (int)rintf(v[i][e] * inv); w |= ((unsigned)q & 0xFFu) << (8 * e); }
            o[i] = w;
        }
    }
    *(u32x4*)(ws + OFF_UQ + row * 2048 + (isv ? 1024 : 0) + 16 * lane) = o;
    if (lane == 0) ((float*)(ws + (isv ? OFF_SV : OFF_SU)))[row] = sc;
}

DI void phase_p35(const Params& p, char* lds) {
    char* ws = p.ws;
    const int t = otid(), lane = t & 63, wv = t >> 6;
    const int ntok = T_TOK / 4;
    for (int item = vbid(); item < ntok; item += vgrid()) {
        {
            const size_t tok = (size_t)item * 4 + wv;
            const int head = lane >> 3;
            const float* LS = (const float*)(ws + OFF_LSE);
            const float l0 = LS[tok * 8 + head], l1 = LS[((size_t)T_TOK + tok) * 8 + head], l2 = LS[((size_t)2 * T_TOK + tok) * 8 + head];
            const float mx = fmaxf(l0, fmaxf(l1, l2));
            float w0 = fast_exp2(l0 - mx), w1 = fast_exp2(l1 - mx), w2 = fast_exp2(l2 - mx);
            const float wi = 1.0f / (w0 + w1 + w2);
            w0 *= wi; w1 *= wi; w2 *= wi;
            const bf16_t* OD = (const bf16_t*)((const char*)p.out + OUT_ODIL);
            const u32x4 a0 = ldu4(OD + tok * 512 + 8 * lane), a1 = ldu4(OD + ((size_t)T_TOK + tok) * 512 + 8 * lane),
                        a2 = ldu4(OD + ((size_t)2 * T_TOK + tok) * 512 + 8 * lane);
            const u32x4 am = ldu4((const bf16_t*)((const char*)p.out + OUT_OMLA) + tok * 512 + 8 * lane);
            float od[8], om[8]; float sd = 0.f, sm = 0.f;
#pragma unroll
            for (int e = 0; e < 4; ++e) {
                od[2 * e] = w0 * bf_lo(a0[e]) + w1 * bf_lo(a1[e]) + w2 * bf_lo(a2[e]);
                od[2 * e + 1] = w0 * bf_hi(a0[e]) + w1 * bf_hi(a1[e]) + w2 * bf_hi(a2[e]);
                om[2 * e] = bf_lo(am[e]); om[2 * e + 1] = bf_hi(am[e]);
                sd += od[2 * e] * od[2 * e] + od[2 * e + 1] * od[2 * e + 1];
                sm += om[2 * e] * om[2 * e] + om[2 * e + 1] * om[2 * e + 1];
            }
#pragma unroll
            for (int o = 32; o; o >>= 1) { sd += __shfl_xor(sd, o); sm += __shfl_xor(sm, o); }
            const float rd = rsqrtf(sd * (1.0f / 512.0f) + 1e-6f), rm = rsqrtf(sm * (1.0f / 512.0f) + 1e-6f);
            const f32x4 gm0 = *(const f32x4*)(p.gn_mla + 8 * lane), gm1 = *(const f32x4*)(p.gn_mla + 8 * lane + 4);
            const f32x4 gd0 = *(const f32x4*)(p.gn_dil + 8 * lane), gd1 = *(const f32x4*)(p.gn_dil + 8 * lane + 4);
            u32x4 o1, o2;
            o1[0] = pack2(om[0] * rm * gm0[0], om[1] * rm * gm0[1]); o1[1] = pack2(om[2] * rm * gm0[2], om[3] * rm * gm0[3]);
            o1[2] = pack2(om[4] * rm * gm1[0], om[5] * rm * gm1[1]); o1[3] = pack2(om[6] * rm * gm1[2], om[7] * rm * gm1[3]);
            o2[0] = pack2(od[0] * rd * gd0[0], od[1] * rd * gd0[1]); o2[1] = pack2(od[2] * rd * gd0[2], od[3] * rd * gd0[3]);
            o2[2] = pack2(od[4] * rd * gd1[0], od[5] * rd * gd1[1]); o2[3] = pack2(od[6] * rd * gd1[2], od[7] * rd * gd1[3]);
            bf16_t* MX = (bf16_t*)(ws + OFF_MIXED) + tok * 1024;
            *(u32x4*)(MX + 8 * lane) = o1;
            *(u32x4*)(MX + 512 + 8 * lane) = o2;
        }
    }
}

template <bool QLDS>
DI void memattn_unit_t(char* ws, char* lds, int b, int h, int tt, const char* qhalf) {
    const int t = otid(), lane = t & 63, wv = t >> 6, r = lane & 31, hh = lane >> 5;
    bf16x8 qall[16];
    if (QLDS) {
        const int row = 32 * wv + r; const char* qr = qhalf + row * 512;
#pragma unroll
        for (int i = 0; i < 16; ++i) qall[i] = ld16(qr + (((2 * i + hh) ^ (row & 31)) << 4));
    }
    const bf16_t* QM = (const bf16_t*)(ws + OFF_QM);
    const bf16_t* KVM = (const bf16_t*)(ws + OFF_KVM);
    const size_t tokq = (size_t)b * SEQ_L + tt * 128 + 32 * wv + r;
    const bf16_t* qrow = QM + tokq * 1024 + h * 256 + 8 * hh;
    const bf16_t* ksrc0; const bf16_t* vsrc0;
    {
        const int row = 8 * wv + (lane >> 3), pch = lane & 7;
        const size_t mrow = (size_t)b * 256 + row;
        ksrc0 = KVM + mrow * 2048 + h * 256 + 8 * (pch ^ ((row >> 1) & 7));
        vsrc0 = KVM + mrow * 2048 + 1024 + h * 256 + 8 * (pch ^ (((row >> 1) & 1) << 2));
    }
    char* ldst = lds + wv * 1024 + lane * 16;
#define MA_ISSUE(st_) do { char* d_ = ldst + ((st_) & 1) * 32768; \
        _Pragma("unroll") for (int i = 0; i < 8; ++i) GLDS16(((st_) < 4 ? ksrc0 : vsrc0) + (size_t)i * (32 * 2048) + 64 * ((st_) & 3), d_ + i * 4096); } while (0)
    f32x16 S[8];
#pragma unroll
    for (int kt = 0; kt < 8; ++kt) S[kt] = zero16();
    bf16x8 qa[4];
    __syncthreads();
    MA_ISSUE(0); MA_ISSUE(1);
#define MA_KSTAGE(c_, WAIT_) do { \
        asm volatile("s_waitcnt vmcnt(" #WAIT_ ")\n\ts_barrier" ::: "memory"); \
        _Pragma("unroll") for (int ss = 0; ss < 4; ++ss) { if (QLDS) qa[ss] = qall[4 * (c_) + ss]; else qa[ss] = ld16(qrow + 64 * (c_) + 16 * ss); } \
        { const char* sb_ = lds + ((c_) & 1) * 32768; \
          _Pragma("unroll") for (int kt = 0; kt < 8; ++kt) \
          _Pragma("unroll") for (int ss = 0; ss < 4; ++ss) S[kt] = MFMA32(ld16(sb_ + sw_off(32 * kt + r, 2 * ss + hh)), qa[ss], S[kt]); } \
        asm volatile("s_barrier" ::: "memory"); \
        MA_ISSUE((c_) + 2); } while (0)
    MA_KSTAGE(0, 8);
    MA_KSTAGE(1, 8);
    MA_KSTAGE(2, 8);
    MA_KSTAGE(3, 8);
    float mx = S[0][0];
#pragma unroll
    for (int kt = 0; kt < 8; ++kt)
#pragma unroll
        for (int i = 0; i < 16; ++i) mx = fmaxf(mx, S[kt][i]);
    mx = xhalf_max(mx);
    f32x2 ps2 = {0.f, 0.f};
    const f32x2 m2 = {mx, mx};
    bf16x8 pk[8][2];
#pragma unroll
    for (int kt = 0; kt < 8; ++kt) {
#pragma unroll
        for (int i = 0; i < 16; i += 2) {
            f32x2 xx = {S[kt][i], S[kt][i + 1]};
            xx = xx - m2;
            f32x2 e; e[0] = fast_exp2(xx[0]); e[1] = fast_exp2(xx[1]);
            S[kt][i] = e[0]; S[kt][i + 1] = e[1];
            ps2 += e;
        }
        pk[kt][0] = pack_step(S[kt], 0); pk[kt][1] = pack_step(S[kt], 1);
    }
    const float inv = 1.0f / xhalf_sum(ps2[0] + ps2[1]);
    bf16_t* dst = (bf16_t*)(ws + OFF_OM) + tokq * 1024 + h * 256 + 4 * hh;
    const unsigned vlane0 = v128_tr_addr(0u, 4 * hh, 0, lane), vlane1 = v128_tr_addr(0u, 4 * hh, 1, lane);
#define MA_PV(KT_, vb_) do { s16x4 vt_[2][2][2]; \
            vt_[0][0][0] = tr_read_ao<(32 * KT_) * 128>(vb_ + vlane0);          vt_[0][0][1] = tr_read_ao<(32 * KT_ + 8) * 128>(vb_ + vlane0); \
            vt_[0][1][0] = tr_read_ao<(32 * KT_) * 128>(vb_ + vlane1);          vt_[0][1][1] = tr_read_ao<(32 * KT_ + 8) * 128>(vb_ + vlane1); \
            vt_[1][0][0] = tr_read_ao<(32 * KT_ + 16) * 128>(vb_ + vlane0);     vt_[1][0][1] = tr_read_ao<(32 * KT_ + 24) * 128>(vb_ + vlane0); \
            vt_[1][1][0] = tr_read_ao<(32 * KT_ + 16) * 128>(vb_ + vlane1);     vt_[1][1][1] = tr_read_ao<(32 * KT_ + 24) * 128>(vb_ + vlane1); \
            TR_WAIT(); \
            _Pragma("unroll") for (int st = 0; st < 2; ++st) { \
                o0_ = MFMA32(cat44(vt_[st][0][0], vt_[st][0][1]), pk[KT_][st], o0_); \
                o1_ = MFMA32(cat44(vt_[st][1][0], vt_[st][1][1]), pk[KT_][st], o1_); } } while (0)
#define MA_VSTAGE(c_, WAIT_) do { \
        asm volatile("s_waitcnt vmcnt(" #WAIT_ ")\n\ts_barrier" ::: "memory"); \
        { const unsigned vb_ = (unsigned)(uintptr_t)(lds + ((c_) & 1) * 32768); \
          f32x16 o0_ = zero16(), o1_ = zero16(); \
          MA_PV(0, vb_); MA_PV(1, vb_); MA_PV(2, vb_); MA_PV(3, vb_); MA_PV(4, vb_); MA_PV(5, vb_); MA_PV(6, vb_); MA_PV(7, vb_); \
          _Pragma("unroll") for (int g = 0; g < 4; ++g) { \
              *(u32x2*)(dst + 64 * (c_) + 8 * g) = pack4(o0_[4 * g] * inv, o0_[4 * g + 1] * inv, o0_[4 * g + 2] * inv, o0_[4 * g + 3] * inv); \
              *(u32x2*)(dst + 64 * (c_) + 32 + 8 * g) = pack4(o1_[4 * g] * inv, o1_[4 * g + 1] * inv, o1_[4 * g + 2] * inv, o1_[4 * g + 3] * inv); } } \
        asm volatile("s_barrier" ::: "memory"); \
        if ((c_) + 2 < 4) MA_ISSUE(4 + (c_) + 2); } while (0)
    MA_VSTAGE(0, 8);
    MA_VSTAGE(1, 8);
    MA_VSTAGE(2, 8);
    MA_VSTAGE(3, 0);
#undef MA_ISSUE
#undef MA_KSTAGE
#undef MA_VSTAGE
#undef MA_PV
}

DI void phase_memattn(const Params& p, char* lds) {
    for (int item = vbid(); item < 512; item += vgrid()) {
        const int b = item >> 7, h = (item >> 5) & 3, tt = item & 31;
        memattn_unit_t<false>(p.ws, lds, b, h, tt, nullptr);
    }
}
DI unsigned f2sort(float f) { const unsigned b = __float_as_uint(f); return b ^ ((b & 0x80000000u) ? 0xFFFFFFFFu : 0x80000000u); }
DI float sort2f(unsigned u) { const unsigned b = (u & 0x80000000u) ? (u ^ 0x80000000u) : ~u; return __uint_as_float(b); }
DI void cswap(unsigned& a, unsigned& b) { const unsigned hi = max(a, b), lo = min(a, b); a = hi; b = lo; }

template <int LO, int N> struct BClean {
    template <int M> static DI void run(unsigned (&a)[M]) {
#pragma unroll
        for (int i = 0; i < N / 2; ++i) cswap(a[LO + i], a[LO + i + N / 2]);
        BClean<LO, N / 2>::run(a); BClean<LO + N / 2, N / 2>::run(a);
    }
};
template <int LO> struct BClean<LO, 1> { template <int M> static DI void run(unsigned (&)[M]) {} };
template <int LO, int N> struct BSort {
    template <int M> static DI void run(unsigned (&a)[M]) {
        BSort<LO, N / 2>::run(a); BSort<LO + N / 2, N / 2>::run(a);
#pragma unroll
        for (int i = 0; i < N / 2; ++i) cswap(a[LO + i], a[LO + N - 1 - i]);
        BClean<LO, N / 2>::run(a); BClean<LO + N / 2, N / 2>::run(a);
    }
};
template <int LO> struct BSort<LO, 1> { template <int M> static DI void run(unsigned (&)[M]) {} };
DI void merge_top16(unsigned (&a)[16], const unsigned (&b)[16]) {
#pragma unroll
    for (int i = 0; i < 16; ++i) a[i] = max(a[i], b[15 - i]);
    BClean<0, 16>::run(a);
}

DI void peer_top16_core(const bf16_t* __restrict__ keys_hp, const bf16x8 (&qf)[8], int r, int hh, unsigned (&top)[16]) {
    unsigned cur[16];
#pragma unroll
    for (int kt = 0; kt < 4; ++kt) {
        f32x16 acc = zero16();
#pragma unroll
        for (int s = 0; s < 8; ++s) acc = MFMA32(ld16(keys_hp + (size_t)(32 * kt + r) * 128 + 16 * s + 8 * hh), qf[s], acc);
        unsigned k[16];
#pragma unroll
        for (int i = 0; i < 16; ++i) k[i] = (f2sort(acc[i]) & ~0x7Fu) | (unsigned)(32 * kt + crow(i, hh));
        BSort<0, 16>::run(k);
        if (kt == 0) {
#pragma unroll
            for (int i = 0; i < 16; ++i) cur[i] = k[i];
        } else merge_top16(cur, k);
    }
    unsigned r0[16], r1[16];
#pragma unroll
    for (int i = 0; i < 16; ++i) { auto rr = __builtin_amdgcn_permlane32_swap(cur[i], cur[i], false, false); r0[i] = rr[0]; r1[i] = rr[1]; }
#pragma unroll
    for (int i = 0; i < 16; ++i) top[i] = max(r0[i], r1[15 - i]);
    BClean<0, 16>::run(top);
}
DI void peer_top16(const bf16_t* __restrict__ keys_hp, const bf16_t* __restrict__ pq_row_hp, int r, int hh, unsigned (&top)[16]) {
    bf16x8 qf[8];
#pragma unroll
    for (int s = 0; s < 8; ++s) qf[s] = ld16(pq_row_hp + 16 * s + 8 * hh);
    peer_top16_core(keys_hp, qf, r, hh, top);
}
DI void peer_top16_lds(const bf16_t* __restrict__ keys_hp, const char* qrow, int rsw, int sd, int r, int hh, unsigned (&top)[16]) {
    bf16x8 qf[8];
#pragma unroll
    for (int s = 0; s < 8; ++s) qf[s] = ld16(qrow + (((16 * sd + 2 * s + hh) ^ rsw) << 4));
    peer_top16_core(keys_hp, qf, r, hh, top);
}

template <bool QLDS>
DI void peer_select_unit_t(char* ws, const bf16_t* PQ, char* lds, size_t tokbase, int h, const char* qhalf) {
    const int t = otid(), lane = t & 63, wv = t >> 6, r = lane & 31, hh = lane >> 5;
    const size_t tok = tokbase + 32 * wv + r;
    const bf16_t* KEYS = (const bf16_t*)(ws + OFF_KEYS);
    unsigned tA[16], tB[16];
    if (QLDS) {
        const int row = 32 * wv + r; const char* qrow = qhalf + row * 512;
        peer_top16_lds(KEYS + (size_t)(2 * h) * 16384, qrow, row & 31, 0, r, hh, tA);
        peer_top16_lds(KEYS + (size_t)(2 * h + 1) * 16384, qrow, row & 31, 1, r, hh, tB);
    } else {
        peer_top16(KEYS + (size_t)(2 * h) * 16384, PQ + tok * 2048 + (2 * h) * 128, r, hh, tA);
        peer_top16(KEYS + (size_t)(2 * h + 1) * 16384, PQ + tok * 2048 + (2 * h + 1) * 128, r, hh, tB);
    }
    float fA[16], fB[16];
#pragma unroll
    for (int i = 0; i < 16; ++i) { fA[i] = sort2f(tA[i] & ~0x7Fu); fB[i] = sort2f(tB[i] & ~0x7Fu); }
    unsigned* tab = (unsigned*)lds + wv * 1024;
    __syncthreads();
#pragma unroll
    for (int i = 0; i < 16; ++i) tab[i * 64 + lane] = (tA[i] & 0x7Fu) | ((tB[i] & 0x7Fu) << 16);
    unsigned c[64];
#pragma unroll
    for (int i = 0; i < 64; ++i) c[i] = 0u;
    {
        int n = 0;
#pragma unroll
        for (int a = 0; a < 16; ++a)
#pragma unroll
            for (int b = 0; b < 16; ++b)
                if ((a + 1) * (b + 1) <= 16) { c[n] = (f2sort(fA[a] + fB[b]) & ~0xFFu) | (unsigned)(a * 16 + b); ++n; }
    }
    unsigned g0[16], g1[16], g2[16], g3[16];
#pragma unroll
    for (int i = 0; i < 16; ++i) { g0[i] = c[i]; g1[i] = c[16 + i]; g2[i] = c[32 + i]; g3[i] = c[48 + i]; }
    BSort<0, 16>::run(g0); BSort<0, 16>::run(g1); BSort<0, 16>::run(g2); BSort<0, 16>::run(g3);
    merge_top16(g0, g1); merge_top16(g2, g3); merge_top16(g0, g2);
    float e[16]; float sum = 0.f;
    const float v0 = sort2f(g0[0] & ~0xFFu);
    unsigned ids[16];
#pragma unroll
    for (int i = 0; i < 16; ++i) {
        const float v = sort2f(g0[i] & ~0xFFu);
        e[i] = fast_exp2((v - v0) * LOG2E); sum += e[i];
        const unsigned a = (g0[i] >> 4) & 15u, b = g0[i] & 15u;
        const unsigned ia = tab[a * 64 + lane] & 0x7Fu, ib = (tab[b * 64 + lane] >> 16) & 0x7Fu;
        ids[i] = ia * 128u + ib;
    }
    const float inv = 1.0f / sum;
    if (hh == 0) {
        unsigned short* SID = (unsigned short*)(ws + OFF_SELID) + tok * 128 + h * 16;
        float* SG = (float*)(ws + OFF_SELG) + tok * 128 + h * 16;
        u32x4 w0, w1;
        w0[0] = ids[0] | (ids[1] << 16); w0[1] = ids[2] | (ids[3] << 16); w0[2] = ids[4] | (ids[5] << 16); w0[3] = ids[6] | (ids[7] << 16);
        w1[0] = ids[8] | (ids[9] << 16); w1[1] = ids[10] | (ids[11] << 16); w1[2] = ids[12] | (ids[13] << 16); w1[3] = ids[14] | (ids[15] << 16);
        *(u32x4*)SID = w0; *(u32x4*)(SID + 8) = w1;
#pragma unroll
        for (int q = 0; q < 4; ++q) *(f32x4*)(SG + 4 * q) = (f32x4){e[4 * q] * inv, e[4 * q + 1] * inv, e[4 * q + 2] * inv, e[4 * q + 3] * inv};
    }
}

DI void phase_select(const Params& p, char* lds) {
    for (int item = vbid(); item < 1024; item += vgrid()) peer_select_unit_t<false>(p.ws, (const bf16_t*)((const char*)p.out + OUT_PQ), lds, (size_t)(item >> 3) * 128, item & 7, nullptr);
}

DI float gelu_erf(float v) {
    const float av = fabsf(v), t = __builtin_amdgcn_rcpf(av * 0.2316418882f + 1.0f);
    float q = t * 0.5307027145f + (-0.7265760135f); q = q * t + 0.7107068705f; q = q * t + (-0.142248368f); q = q * t + 0.127414796f; q = q * t;
    const float e = __builtin_amdgcn_exp2f((v * v) * (-0.72134752044f));
    const float m = v * (q * e), r = v - m;
    return v < 0.f ? m : r;
}
DI int dppi(int v, const int ctrl) { return v; }
#define DPP_I(v, ctrl) __builtin_amdgcn_update_dpp(0, (v), (ctrl), 0xf, 0xf, true)
DI float ub0(unsigned w) { return (float)(w & 0xFFu); }
DI float ub1(unsigned w) { return (float)((w >> 8) & 0xFFu); }
DI float ub2(unsigned w) { return (float)((w >> 16) & 0xFFu); }
DI float ub3(unsigned w) { return (float)(w >> 24); }

struct GBatch { u32x4 U[4], V[4]; float su[4], sv[4], gate[4]; };

DI void gather_load(GBatch& B, const char* __restrict__ ws, unsigned idpair, f32x2 gpair, int eb, int lane) {
#pragma unroll
    for (int j = 0; j < 4; ++j) {
        const int e = eb + j;
        const unsigned pr = __shfl(idpair, e >> 1);
        const unsigned id = (j & 1) ? (pr >> 16) : (pr & 0xFFFFu);
        const float g0 = __shfl(gpair[0], e >> 1), g1 = __shfl(gpair[1], e >> 1);
        B.gate[j] = (j & 1) ? g1 : g0;
        B.U[j] = ldu4(ws + OFF_UQ + (size_t)id * 2048 + 16 * lane);
        B.V[j] = ldu4(ws + OFF_UQ + (size_t)id * 2048 + 1024 + 16 * lane);
        B.su[j] = ((const float*)(ws + OFF_SU))[id];
        B.sv[j] = ((const float*)(ws + OFF_SV))[id];
    }
}

DI void gather_compute(const GBatch& B, const unsigned (&qx)[4], float sx, float (&acc)[16], float& csum, int lane) {
    int pd[4];
#pragma unroll
    for (int j = 0; j < 4; ++j) {
        int d = 0;
#pragma unroll
        for (int q = 0; q < 4; ++q) d = __builtin_amdgcn_sdot4((int)B.U[j][q], (int)qx[q], d, false);
        pd[j] = d;
    }
    const bool b0 = lane & 1, b1 = lane & 2;
    const int kA = b0 ? pd[1] : pd[0], kB = b0 ? pd[3] : pd[2], sA = b0 ? pd[0] : pd[1], sB = b0 ? pd[2] : pd[3];
    const int qA = kA + DPP_I(sA, 0xB1), qB = kB + DPP_I(sB, 0xB1);
    const int kp = b1 ? qB : qA, sd = b1 ? qA : qB;
    int tot = kp + DPP_I(sd, 0x4E);
    tot += DPP_I(tot, 0x124);
    tot += DPP_I(tot, 0x128);
    tot += __builtin_amdgcn_ds_swizzle(tot, 0x401F);
    { auto rr = __builtin_amdgcn_permlane32_swap((unsigned)tot, (unsigned)tot, false, false); tot = (int)rr[0] + (int)rr[1]; }
    const int j3 = lane & 3;
    const float su_sel = (j3 == 0) ? B.su[0] : (j3 == 1 ? B.su[1] : (j3 == 2 ? B.su[2] : B.su[3]));
    const float ge = gelu_erf((float)tot * sx * su_sel);
#pragma unroll
    for (int j = 0; j < 4; ++j) {
        const float cf = B.gate[j] * B.sv[j] * __uint_as_float((unsigned)__builtin_amdgcn_readlane((int)__float_as_uint(ge), j));
#pragma unroll
        for (int q = 0; q < 4; ++q) {
            const int w = (int)B.V[j][q];
            const f32x2 lo = __builtin_amdgcn_cvt_pk_f32_fp8(w, false), hi = __builtin_amdgcn_cvt_pk_f32_fp8(w, true);
            acc[4 * q] += cf * lo[0]; acc[4 * q + 1] += cf * lo[1]; acc[4 * q + 2] += cf * hi[0]; acc[4 * q + 3] += cf * hi[1];
        }
    }
}

DI void gather_token(const Params& p, size_t tok, int lane, float* dst_base) {
    char* ws = p.ws;
    const bf16_t* hrow = (const bf16_t*)(ws + OFF_HB) + tok * 1024 + 16 * lane;
    float hv[16];
    {
        const u32x4 w0 = ldu4(hrow), w1 = ldu4(hrow + 8);
#pragma unroll
        for (int e = 0; e < 4; ++e) { hv[2 * e] = bf_lo(w0[e]); hv[2 * e + 1] = bf_hi(w0[e]); hv[8 + 2 * e] = bf_lo(w1[e]); hv[8 + 2 * e + 1] = bf_hi(w1[e]); }
    }
    float rs;
    {
        const float* SS = (const float*)(ws + OFF_SS2) + tok * 16;
        const f32x4 s0 = *(const f32x4*)SS, s1 = *(const f32x4*)(SS + 4), s2 = *(const f32x4*)(SS + 8), s3 = *(const f32x4*)(SS + 12);
        const float tot = (s0[0] + s0[1] + s0[2] + s0[3]) + (s1[0] + s1[1] + s1[2] + s1[3]) + (s2[0] + s2[1] + s2[2] + s2[3]) + (s3[0] + s3[1] + s3[2] + s3[3]);
        rs = rsqrtf(tot * (1.0f / 1024.0f) + 1e-6f);
    }
    float xf[16]; float am = 0.f;
#pragma unroll
    for (int i = 0; i < 4; ++i) {
        const f32x4 g = *(const f32x4*)(p.norm_ffn + 16 * lane + 4 * i);
#pragma unroll
        for (int e = 0; e < 4; ++e) { xf[4 * i + e] = hv[4 * i + e] * rs * g[e]; am = fmaxf(am, fabsf(xf[4 * i + e])); }
    }
#pragma unroll
    for (int o = 32; o; o >>= 1) am = fmaxf(am, __shfl_xor(am, o));
    const float sx = (am > 0.f) ? am * (1.0f / 127.0f) : 1.0f;
    const float isx = 1.0f / sx;
    unsigned qx[4];
#pragma unroll
    for (int i = 0; i < 4; ++i) {
        unsigned w = 0u;
#pragma unroll
        for (int e = 0; e < 4; ++e) w |= ((unsigned)(int)rintf(xf[4 * i + e] * isx) & 0xFFu) << (8 * e);
        qx[i] = w;
    }
    const unsigned idpair = *((const unsigned*)(ws + OFF_SELID) + tok * 64 + lane);
    const f32x2 gpair = *((const f32x2*)(ws + OFF_SELG) + tok * 64 + lane);
    float acc[16]; float csum = 0.f;
#pragma unroll
    for (int i = 0; i < 16; ++i) acc[i] = 0.f;
    GBatch B0, B1;
    gather_load(B0, ws, idpair, gpair, 0, lane);
#pragma unroll 1
    for (int eb = 0; eb < 128; eb += 8) {
        gather_load(B1, ws, idpair, gpair, eb + 4, lane);
        gather_compute(B0, qx, sx, acc, csum, lane);
        if (eb + 8 < 128) gather_load(B0, ws, idpair, gpair, eb + 8, lane);
        gather_compute(B1, qx, sx, acc, csum, lane);
    }
    float ss = 0.f;
#pragma unroll
    for (int i = 0; i < 16; ++i) { acc[i] = acc[i] - 128.0f * csum + hv[i]; ss += acc[i] * acc[i]; }
#pragma unroll
    for (int o = 32; o; o >>= 1) ss += __shfl_xor(ss, o);
    const float rf = rsqrtf(ss * (1.0f / 1024.0f) + 1e-6f);
    float* drow = dst_base + tok * 1024 + 16 * lane;
#pragma unroll
    for (int i = 0; i < 4; ++i) {
        const f32x4 n = *(const f32x4*)(p.norm_final + 16 * lane + 4 * i);
        *(f32x4*)(drow + 4 * i) = (f32x4){acc[4 * i] * rf * n[0], acc[4 * i + 1] * rf * n[1], acc[4 * i + 2] * rf * n[2], acc[4 * i + 3] * rf * n[3]};
    }
}

DI void phase_gather(const Params& p, bool dry = false) {
    const int lane = otid() & 63, wv = otid() >> 6;
    float* dst = dry ? (float*)(p.ws + OFF_A) : p.out;
    for (int item = vbid(); item < T_TOK / 4; item += vgrid()) gather_token(p, (size_t)item * 4 + wv, lane, dst);
}

constexpr size_t GS_PSTRIDE = 1040;
constexpr size_t GS_SGS = OFF_A;
constexpr size_t GS_XQ = GS_SGS + (size_t)T_TOK * GS_PSTRIDE;
constexpr size_t GS_ACC = GS_XQ + (size_t)T_TOK * 1024;
static_assert(GS_ACC <= OFF_A + 69 * MiB, "gather scratch overflows region A");

DI void gs_load(GBatch& B, const char* __restrict__ ws, unsigned myid, float mygate, int j0, int n, int lane) {
#pragma unroll
    for (int j = 0; j < 4; ++j) {
        const int e = __builtin_amdgcn_readfirstlane(j0 + j);
        const bool ok = e < n;
        const int src = ok ? e : 0;
        const unsigned id = (unsigned)__builtin_amdgcn_readlane((int)myid, src);
        const float g = __uint_as_float((unsigned)__builtin_amdgcn_readlane((int)__float_as_uint(mygate), src));
        B.gate[j] = ok ? g : 0.f;
        const char* urow = ws + OFF_UQ + (size_t)id * 2048;
        const char* vrow = urow + 1024;
        B.U[j] = ldu4(urow + 16 * lane);
        B.V[j] = ldu4(vrow + 16 * lane);
        B.su[j] = ((const float*)(ws + OFF_SU))[id];
        B.sv[j] = ((const float*)(ws + OFF_SV))[id];
    }
}

#ifndef GS_NSL
#define GS_NSL 16
#endif
constexpr int NSL = GS_NSL, NSL_SH = (GS_NSL == 8 ? 11 : (GS_NSL == 16 ? 10 : (GS_NSL == 32 ? 9 : 12))), OFFW = 64;
DI void phase_gather_sliced(const Params& p, char* smem) {
    char* ws = p.ws;
    if ((T_TOK / 8) > 8 * (((int)gridDim.x >> 3) * 8) || ((int)gridDim.x & 7)) { phase_gather(p); return; }
    const int wvi = __builtin_amdgcn_readfirstlane((int)(threadIdx.x >> 6));
    char* lacc = smem + wvi * 16384 + (threadIdx.x & 63) * 32;
    unsigned short* lids = (unsigned short*)(smem + 131072 + wvi * 2048);
    unsigned char* loff = (unsigned char*)(smem + 131072 + 16384 + wvi * (8 * OFFW));
    const int lane = threadIdx.x & 63;
    const int x = (int)blockIdx.x & 7, nW = ((int)gridDim.x >> 3) * 8, lw = ((int)blockIdx.x >> 3) * 8 + wvi;
    const int TPX = T_TOK / 8;
    for (int tl = lw; tl < TPX; tl += nW) {
        const size_t tok = (size_t)x * TPX + tl;
        const bf16_t* hrow = (const bf16_t*)(ws + OFF_HB) + tok * 1024 + 16 * lane;
        float hv[16];
        {
            const u32x4 w0 = ldu4(hrow), w1 = ldu4(hrow + 8);
#pragma unroll
            for (int e = 0; e < 4; ++e) { hv[2 * e] = bf_lo(w0[e]); hv[2 * e + 1] = bf_hi(w0[e]); hv[8 + 2 * e] = bf_lo(w1[e]); hv[8 + 2 * e + 1] = bf_hi(w1[e]); }
        }
        float rs;
        {
            const float* SS = (const float*)(ws + OFF_SS2) + tok * 16;
            const f32x4 s0 = *(const f32x4*)SS, s1 = *(const f32x4*)(SS + 4), s2 = *(const f32x4*)(SS + 8), s3 = *(const f32x4*)(SS + 12);
            const float tot = (s0[0] + s0[1] + s0[2] + s0[3]) + (s1[0] + s1[1] + s1[2] + s1[3]) + (s2[0] + s2[1] + s2[2] + s2[3]) + (s3[0] + s3[1] + s3[2] + s3[3]);
            rs = rsqrtf(tot * (1.0f / 1024.0f) + 1e-6f);
        }
        float xf[16]; float am = 0.f;
#pragma unroll
        for (int i = 0; i < 4; ++i) {
            const f32x4 g = *(const f32x4*)(p.norm_ffn + 16 * lane + 4 * i);
#pragma unroll
            for (int e = 0; e < 4; ++e) { xf[4 * i + e] = hv[4 * i + e] * rs * g[e]; am = fmaxf(am, fabsf(xf[4 * i + e])); }
        }
#pragma unroll
        for (int o = 32; o; o >>= 1) am = fmaxf(am, __shfl_xor(am, o));
        const float sx = (am > 0.f) ? am * (1.0f / 127.0f) : 1.0f;
        const float isx = 1.0f / sx;
        u32x4 qx;
#pragma unroll
        for (int i = 0; i < 4; ++i) {
            unsigned w = 0u;
#pragma unroll
            for (int e = 0; e < 4; ++e) w |= ((unsigned)(int)rintf(xf[4 * i + e] * isx) & 0xFFu) << (8 * e);
            qx[i] = w;
        }
        *(u32x4*)(ws + GS_XQ + tok * 1024 + 16 * lane) = qx;
        const unsigned idpair = *((const unsigned*)(ws + OFF_SELID) + tok * 64 + lane);
        const f32x2 gpair = *((const f32x2*)(ws + OFF_SELG) + tok * 64 + lane);
        const unsigned id0 = idpair & 0xFFFFu, id1 = idpair >> 16;
        const int sl0 = (int)(id0 >> NSL_SH), sl1 = (int)(id1 >> NSL_SH);
        const unsigned long long lt = (1ull << lane) - 1ull;
        int base = 0, pos0 = 0, pos1 = 0, myoff = 0;
#pragma unroll
        for (int s = 0; s < NSL; ++s) {
            const unsigned long long m0 = __ballot(sl0 == s), m1 = __ballot(sl1 == s);
            const int c0 = __popcll(m0), c1 = __popcll(m1);
            if (sl0 == s) pos0 = base + __popcll(m0 & lt);
            if (sl1 == s) pos1 = base + c0 + __popcll(m1 & lt);
            if (lane == s) myoff = base;
            base += c0 + c1;
        }
        if (lane == NSL) myoff = base;
        f32x2* sg = (f32x2*)(ws + GS_SGS + tok * GS_PSTRIDE);
        { const int k = (tl - lw) / nW; lids[k * 128 + pos0] = (unsigned short)id0; lids[k * 128 + pos1] = (unsigned short)id1; if (lane <= NSL) loff[k * OFFW + lane] = (unsigned char)myoff; }
        const float* SU = (const float*)(ws + OFF_SU); const float* SV = (const float*)(ws + OFF_SV);
        sg[pos0] = (f32x2){sx * SU[id0], gpair[0] * SV[id0]}; sg[pos1] = (f32x2){sx * SU[id1], gpair[1] * SV[id1]};
        if (lane == 0) sg[128] = (f32x2){0.f, 0.f};

    }
    __syncthreads();
    const int ntk = (TPX - lw + nW - 1) / nW;
    for (int k = 0; k < ntk; ++k) { *(u32x4*)(lacc + k * 2048) = (u32x4){0u, 0u, 0u, 0u}; *(u32x4*)(lacc + k * 2048 + 16) = (u32x4){0u, 0u, 0u, 0u}; }
    const char* tab = ws + OFF_UQ;
    u32x4 QX[8];
#pragma unroll
    for (int k = 0; k < 8; ++k) { const int kk = (k < ntk) ? k : 0; QX[k] = ldu4(ws + GS_XQ + ((size_t)x * TPX + lw + (size_t)kk * nW) * 1024 + 16 * lane); }
    asm volatile("" : "+v"(QX[0]), "+v"(QX[1]), "+v"(QX[2]), "+v"(QX[3]), "+v"(QX[4]), "+v"(QX[5]), "+v"(QX[6]), "+v"(QX[7]));
    const unsigned lane16 = 16u * (unsigned)lane;
    struct SB { u32x4 U[8], V[8]; f32x2 pr; int k, m; };
    {
        int slice = 0;
        int kL = 0, jL = 0, nL = 0, oL = 0;
        float acc[16]; int kC = -1; u32x4 qxC = QX[0];
#define GS_OPEN(k_) do { oL = __builtin_amdgcn_readfirstlane((int)loff[(k_) * OFFW + slice]); nL = __builtin_amdgcn_readfirstlane((int)loff[(k_) * OFFW + slice + 1]) - oL; jL = 0; } while (0)
#define GS_ADVANCE(ok_) do { if (jL + 8 < nL) { jL += 8; ok_ = true; } else { ok_ = true; if (kL + 1 < ntk) ++kL; else if (slice + 1 < NSL) { ++slice; kL = 0; } else ok_ = false; if (ok_) GS_OPEN(kL); } } while (0)
#define GS_LOAD(B_, valid_) do { const size_t tok_ = (size_t)x * TPX + lw + (size_t)kL * nW; \
            const int el_ = jL + (lane & 7); const bool okl_ = el_ < nL;            \
            const unsigned idv_ = (unsigned)lids[kL * 128 + ((oL + (okl_ ? el_ : 0)) & 127)]; \
            const unsigned pro_ = okl_ ? 8u * (unsigned)((oL + el_) & 127) : 1024u;            \
            const char* prb_ = ws + GS_SGS + tok_ * GS_PSTRIDE; \
            B_.m = (valid_) ? min(8, nL - jL) : 0; \
            asm volatile("global_load_dwordx2 %0, %1, %2" : "=v"(B_.pr) : "v"(pro_), "s"(prb_)); \
            _Pragma("unroll") for (int j = 0; j < 8; ++j) { const unsigned id_ = (unsigned)__builtin_amdgcn_readlane((int)idv_, j); const char* rb_ = tab + (size_t)id_ * 2048; \
                  \
                asm volatile("s_cmp_gt_i32 %3, %4\n\ts_cselect_b64 exec, -1, 0\n\tglobal_load_dwordx4 %0, %2, %5\n\tglobal_load_dwordx4 %1, %2, %5 offset:1024\n\ts_mov_b64 exec, -1" \
                             : "+v"(B_.U[j]), "+v"(B_.V[j]) : "v"(lane16), "s"(B_.m), "n"(j), "s"(rb_) : "scc"); } \
            B_.k = (valid_) ? kL : -1; } while (0)
#define GS_WAIT(B_, mn_) do { asm volatile("s_waitcnt vmcnt(17)" ::: "memory"); \
            asm volatile("" : "+v"(B_.U[0]), "+v"(B_.U[1]), "+v"(B_.U[2]), "+v"(B_.U[3]), "+v"(B_.U[4]), "+v"(B_.U[5]), "+v"(B_.U[6]), "+v"(B_.U[7]), "+v"(B_.pr) :: "memory"); \
            asm volatile("" : "+v"(B_.V[0]), "+v"(B_.V[1]), "+v"(B_.V[2]), "+v"(B_.V[3]), "+v"(B_.V[4]), "+v"(B_.V[5]), "+v"(B_.V[6]), "+v"(B_.V[7]) :: "memory"); } while (0)
#define GS_FLUSH() do { if (kC >= 0) { char* la_ = lacc + kC * 2048; u32x4 w0_, w1_; \
                _Pragma("unroll") for (int e = 0; e < 4; ++e) { w0_[e] = pack2(acc[2 * e], acc[2 * e + 1]); w1_[e] = pack2(acc[8 + 2 * e], acc[8 + 2 * e + 1]); } \
                *(u32x4*)la_ = w0_; *(u32x4*)(la_ + 16) = w1_; } } while (0)
#define GS_CONSUME(B_) do { if (B_.k >= 0) { \
            if (B_.k != kC) { GS_FLUSH(); kC = B_.k; qxC = QX[0]; _Pragma("unroll") for (int t_ = 1; t_ < 8; ++t_) if (kC == t_) qxC = QX[t_]; const char* la_ = lacc + kC * 2048; const u32x4 w0_ = *(const u32x4*)la_, w1_ = *(const u32x4*)(la_ + 16); \
                _Pragma("unroll") for (int e = 0; e < 4; ++e) { acc[2 * e] = bf_lo(w0_[e]); acc[2 * e + 1] = bf_hi(w0_[e]); acc[8 + 2 * e] = bf_lo(w1_[e]); acc[8 + 2 * e + 1] = bf_hi(w1_[e]); } } \
            int pd_[8]; \
            _Pragma("unroll") for (int j = 0; j < 8; ++j) { int d_ = 0; _Pragma("unroll") for (int q = 0; q < 4; ++q) d_ = __builtin_amdgcn_sdot4((int)B_.U[j][q], (int)qxC[q], d_, false); pd_[j] = d_; }     \
            const bool b0_ = lane & 1, b1_ = lane & 2, b2_ = lane & 4; \
            int q1_[4]; _Pragma("unroll") for (int j = 0; j < 4; ++j) { const int kp_ = b0_ ? pd_[2 * j + 1] : pd_[2 * j], sd_ = b0_ ? pd_[2 * j] : pd_[2 * j + 1]; q1_[j] = kp_ + DPP_I(sd_, 0xB1); }        \
            int q2_[2]; _Pragma("unroll") for (int j = 0; j < 2; ++j) { const int kp_ = b1_ ? q1_[2 * j + 1] : q1_[2 * j], sd_ = b1_ ? q1_[2 * j] : q1_[2 * j + 1]; q2_[j] = kp_ + DPP_I(sd_, 0x4E); }     \
            int tot_; { const int kp_ = b2_ ? q2_[1] : q2_[0], sd_ = b2_ ? q2_[0] : q2_[1]; tot_ = kp_ + __builtin_amdgcn_ds_swizzle(sd_, 0x101F); }                                                \
            tot_ += DPP_I(tot_, 0x128); tot_ += __builtin_amdgcn_ds_swizzle(tot_, 0x401F); \
            { auto rr_ = __builtin_amdgcn_permlane32_swap((unsigned)tot_, (unsigned)tot_, false, false); tot_ = (int)rr_[0] + (int)rr_[1]; } \
            const float cfv_ = B_.pr[1] * gelu_erf((float)tot_ * B_.pr[0]); \
            _Pragma("unroll") for (int j = 0; j < 8; ++j) if (j < B_.m) { const float cf_ = __uint_as_float((unsigned)__builtin_amdgcn_readlane((int)__float_as_uint(cfv_), j)); \
                _Pragma("unroll") for (int q = 0; q < 4; ++q) { const int w_ = (int)B_.V[j][q]; const f32x2 lo_ = __builtin_amdgcn_cvt_pk_f32_fp8(w_, false), hi_ = __builtin_amdgcn_cvt_pk_f32_fp8(w_, true); \
                    acc[4 * q] += cf_ * lo_[0]; acc[4 * q + 1] += cf_ * lo_[1]; acc[4 * q + 2] += cf_ * hi_[0]; acc[4 * q + 3] += cf_ * hi_[1]; } } } } while (0)
        SB S0, S1;
        _Pragma("unroll") for (int j = 0; j < 8; ++j) { S0.U[j] = S0.V[j] = S1.U[j] = S1.V[j] = (u32x4){0u, 0u, 0u, 0u}; }
        bool h0, h1;
        GS_OPEN(0);
        GS_LOAD(S0, true);
#pragma unroll 1
        for (;;) {
            GS_ADVANCE(h1); GS_LOAD(S1, h1);
            GS_WAIT(S0, S1.m); GS_CONSUME(S0);
            if (!h1) break;
            GS_ADVANCE(h0); GS_LOAD(S0, h0);
            GS_WAIT(S1, S0.m); GS_CONSUME(S1);
            if (!h0) break;
        }
        asm volatile("s_waitcnt vmcnt(0)" ::: "memory");
        GS_FLUSH();
#undef GS_OPEN
#undef GS_ADVANCE
#undef GS_LOAD
#undef GS_FLUSH
#undef GS_CONSUME
#undef GS_WAIT
    }
    for (int k = 0; k < ntk; ++k) {
        const size_t tok = (size_t)x * TPX + lw + (size_t)k * nW;
        const char* la = lacc + k * 2048; const u32x4 a0 = *(const u32x4*)la, a1 = *(const u32x4*)(la + 16);
        const bf16_t* hrow = (const bf16_t*)(ws + OFF_HB) + tok * 1024 + 16 * lane; const u32x4 w0 = ldu4(hrow), w1 = ldu4(hrow + 8);
        float acc[16]; float ss = 0.f;
#pragma unroll
        for (int e = 0; e < 4; ++e) { acc[2 * e] = bf_lo(a0[e]) + bf_lo(w0[e]); acc[2 * e + 1] = bf_hi(a0[e]) + bf_hi(w0[e]); acc[8 + 2 * e] = bf_lo(a1[e]) + bf_lo(w1[e]); acc[8 + 2 * e + 1] = bf_hi(a1[e]) + bf_hi(w1[e]); }
#pragma unroll
        for (int i = 0; i < 16; ++i) ss += acc[i] * acc[i];
#pragma unroll
        for (int o = 32; o; o >>= 1) ss += __shfl_xor(ss, o);
        const float rf = rsqrtf(ss * (1.0f / 1024.0f) + 1e-6f); float* drow = p.out + tok * 1024 + 16 * lane;
#pragma unroll
        for (int i = 0; i < 4; ++i) { const f32x4 nn = *(const f32x4*)(p.norm_final + 16 * lane + 4 * i);
            *(f32x4*)(drow + 4 * i) = (f32x4){acc[4 * i] * rf * nn[0], acc[4 * i + 1] * rf * nn[1], acc[4 * i + 2] * rf * nn[2], acc[4 * i + 3] * rf * nn[3]}; }
    }
}

struct EpiPQSel8 {
    static constexpr bool PERM = true, AFTER_DRAIN = true;
    char* ws; const float* SS; char* smem;
    DI void operator()(EPI_ARGS) const {}
    DI void fused(EPI_ARGS, PG8_LAS unsigned char*, int, int) const {
#pragma unroll
        for (int ai = 0; ai < 2; ++ai)
#pragma unroll
            for (int m = 0; m < 4; ++m) {
                int fr_ = fr; asm volatile("" : "+v"(fr_));
                const int row = ai * 128 + wr * 64 + m * 16 + fr_;
                const size_t tok = (size_t)u.pm * 256 + row;
                const f32x4 s0 = *(const f32x4*)(SS + tok * 16), s1 = *(const f32x4*)(SS + tok * 16 + 4), s2 = *(const f32x4*)(SS + tok * 16 + 8), s3 = *(const f32x4*)(SS + tok * 16 + 12);
                const float tot = (s0[0] + s0[1] + s0[2] + s0[3]) + (s1[0] + s1[1] + s1[2] + s1[3]) + (s2[0] + s2[1] + s2[2] + s2[3]) + (s3[0] + s3[1] + s3[2] + s3[3]);
                const float sc = rsqrtf(tot * (1.0f / 1024.0f) + 1e-6f);
#pragma unroll
                for (int bj = 0; bj < 2; ++bj) { EPI_LOAD8(v, ai, bj, m); *(u32x4*)(smem + row * 512 + (((16 * bj + 4 * wc + fq) ^ (row & 31)) << 4)) = pack8(v, sc); }
            }
        __syncthreads();
        char* half = smem + vhalf() * 65536;
        peer_select_unit_t<true>(ws, nullptr, half, (size_t)u.pm * 256 + 128 * vhalf(), u.pn, half);
        __syncthreads();
    }
};
struct EpiMQAttn8 {
    static constexpr bool PERM = true, AFTER_DRAIN = true;
    char* ws; const float* SS; char* smem; float extra;
    DI void operator()(EPI_ARGS) const {}
    DI void fused(EPI_ARGS, PG8_LAS unsigned char*, int, int) const {
#pragma unroll
        for (int ai = 0; ai < 2; ++ai)
#pragma unroll
            for (int m = 0; m < 4; ++m) {
                int fr_ = fr; asm volatile("" : "+v"(fr_));
                const int row = ai * 128 + wr * 64 + m * 16 + fr_;
                const size_t tok = (size_t)u.pm * 256 + row;
                const f32x4 s0 = *(const f32x4*)(SS + tok * 16), s1 = *(const f32x4*)(SS + tok * 16 + 4), s2 = *(const f32x4*)(SS + tok * 16 + 8), s3 = *(const f32x4*)(SS + tok * 16 + 12);
                const float tot = (s0[0] + s0[1] + s0[2] + s0[3]) + (s1[0] + s1[1] + s1[2] + s1[3]) + (s2[0] + s2[1] + s2[2] + s2[3]) + (s3[0] + s3[1] + s3[2] + s3[3]);
                const float sc = rsqrtf(tot * (1.0f / 1024.0f) + 1e-6f) * extra;
#pragma unroll
                for (int bj = 0; bj < 2; ++bj) { EPI_LOAD8(v, ai, bj, m); *(u32x4*)(smem + row * 512 + (((16 * bj + 4 * wc + fq) ^ (row & 31)) << 4)) = pack8(v, sc); }
            }
        __syncthreads();
        char* half = smem + vhalf() * 65536;
        const int tok0 = u.pm * 256 + 128 * vhalf();
        memattn_unit_t<true>(ws, half, tok0 / SEQ_L, u.pn, (tok0 % SEQ_L) / 128, half);
        __syncthreads();
    }
};
struct OneUnit {
    pg8::StaticOrder S; int rep;
    DI bool next(int i, pg8::Unit& u) const { return i == 0 && S.next(rep, u); }
    DI void a_ready(const pg8::Unit&) const {}
    DI void done(const pg8::Unit&) const {}
};
DI void phase_pqsel(const Params& p, char* smem) {
    char* ws = p.ws;
    pg8::Gemm g; g.A = (const bf16_t*)(ws + OFF_HB); g.Bt = (const bf16_t*)(ws + OFF_WT_PQ); g.M = T_TOK; g.N = 2048; g.K = 1024; g.lda = 1024;
    const int G = (int)gridDim.x;
    OneUnit S; S.S.init(T_TOK, 2048, G, (int)blockIdx.x); S.rep = 0;
    EpiPQSel8 e{ws, (const float*)(ws + OFF_SS2), smem};
    const int nrep = (64 * 8 + G - 1) / G;
#pragma unroll 1
    for (int rep = 0; rep < nrep; ++rep) { S.rep = rep; pg8::gemm_phase<EpiPQSel8, OneUnit, true, true>((PG8_LAS unsigned char*)smem, g, S, e); }
}
DI void phase_mqattn(const Params& p, char* smem) {
    char* ws = p.ws;
    pg8::Gemm g; g.A = (const bf16_t*)(ws + OFF_HB); g.Bt = (const bf16_t*)(ws + OFF_WT_MQ); g.M = T_TOK; g.N = 1024; g.K = 1024; g.lda = 1024;
    const int G = (int)gridDim.x;
    OneUnit S; S.S.init(T_TOK, 1024, G, (int)blockIdx.x); S.rep = 0;
    EpiMQAttn8 e{ws, (const float*)(ws + OFF_SS1), smem, 0.0625f * LOG2E};
    const int nrep = (64 * 4 + G - 1) / G;
#pragma unroll 1
    for (int rep = 0; rep < nrep; ++rep) { S.rep = rep; pg8::gemm_phase<EpiMQAttn8, OneUnit, true, true>((PG8_LAS unsigned char*)smem, g, S, e); }
}
constexpr int LDS_BYTES = 131072 + 16384 + 4096;
constexpr int NPHASE = 12;
template <int PH> DI void run_phase(const Params& p, char* smem) {
    char* lds = smem + vhalf() * 65536;
    if (PH == 0) phase_prep(p, lds);
    else if (PH == 1) phase_p1(p, smem);
    else if (PH == 2) phase_p2(p, smem);
    else if (PH == 3) phase_p3(p, lds);
    else if (PH == 4) phase_p35(p, lds);
    else if (PH == 5) phase_resid<false>(p, smem, OFF_WT_OUT, OFF_MIXED, p.x, OFF_SS1);
    else if (PH == 6) phase_mqattn(p, smem);
    else if (PH == 8) phase_resid<true>(p, smem, OFF_WT_MO, OFF_OM, p.ws + OFF_HB, OFF_SS2);
    else if (PH == 9) phase_pqsel(p, smem);
    else if (PH == 11) phase_gather_sliced(p, smem);
}

template <int PH> __global__ void __launch_bounds__(512, 2) k_phase(Params p) {
    __shared__ __attribute__((aligned(16))) char smem[LDS_BYTES];
    run_phase<PH>(p, smem);
}

static Params make_params(void* const* d_in, void* d_out, void* d_ws) {
    Params p;
    memset(&p, 0, sizeof(p));
    p.x = (const float*)d_in[0]; p.mem = (const float*)d_in[1]; p.norm_mix = (const float*)d_in[2]; p.w_in = (const float*)d_in[3];
    p.q_norm = (const float*)d_in[4]; p.kv_norm = (const float*)d_in[5]; p.w_uq = (const float*)d_in[6]; p.w_ukv = (const float*)d_in[7];
    p.gn_mla = (const float*)d_in[8]; p.gn_dil = (const float*)d_in[9]; p.w_out = (const float*)d_in[10]; p.norm_mem_q = (const float*)d_in[11];
    p.norm_mem_kv = (const float*)d_in[12]; p.w_mem_q = (const float*)d_in[13]; p.w_mem_kv = (const float*)d_in[14]; p.w_mem_o = (const float*)d_in[15];
    p.norm_ffn = (const float*)d_in[16]; p.peer_w_q = (const float*)d_in[17]; p.sub_keys = (const float*)d_in[18]; p.peer_u = (const float*)d_in[19];
    p.peer_v = (const float*)d_in[20]; p.norm_final = (const float*)d_in[21];
    p.out = (float*)d_out; p.ws = (char*)d_ws;
    for (int i = 0; i < 16; ++i) p.inv_freq[i] = 1.0f / powf(10000.0f, (float)(2 * i) / 32.0f);
    return p;
}
__global__ void __launch_bounds__(512, 2) k_mega(Params p) {
    __shared__ __attribute__((aligned(16))) char smem[LDS_BYTES + 16];
    volatile LAS unsigned* st = (volatile LAS unsigned*)(LAS char*)(smem + LDS_BYTES);
    if (threadIdx.x == 0) { st[0] = 0u; st[1] = 0u; st[2] = 0u; st[3] = 0u; }
    __syncthreads();
    const XcdBarrier xb = xcd_barrier_post((unsigned*)(p.ws + OFF_BAR), st);
#define RP(n) run_phase<n>(p, smem); xcd_barrier(xb);
    RP(0) RP(1) RP(2) RP(3) RP(4) RP(5) RP(6) RP(8) RP(9)
    run_phase<11>(p, smem);
}

extern "C" void kernel_launch(void* const* d_in, const int* in_sizes, int n_in, void* d_out, int out_size, void* d_ws, size_t ws_size,
                              hipStream_t stream) {
    static int grid_blocks = 0;
    if (!grid_blocks) {
        int dev = 0, cus = 0, per_cu = 0;
        (void)hipGetDevice(&dev);
        (void)hipDeviceGetAttribute(&cus, hipDeviceAttributeMultiprocessorCount, dev);
        (void)hipOccupancyMaxActiveBlocksPerMultiprocessor(&per_cu, k_mega, 512, 0);
        if (per_cu > 1) per_cu = 1;
        if (per_cu < 1) per_cu = 1;
        grid_blocks = cus * per_cu;
    }
    Params p = make_params(d_in, d_out, d_ws);
    (void)hipMemsetAsync((char*)d_ws + OFF_BAR, 0, XCD_BAR_WORDS * 4, stream);
    void* args[] = {&p};
    hipError_t e = hipLaunchCooperativeKernel((const void*)k_mega, dim3(grid_blocks), dim3(512), args, 0, stream);
    if (e != hipSuccess) fprintf(stderr, "cooperative launch failed: %s (grid %d)\n", hipGetErrorString(e), grid_blocks);
}
```
